# Optimizing an MI355X kernel written in HIP

```python
import jax
import jax.numpy as jnp
from jax import lax
import numpy as np

D_MODEL = 1024
BATCH = 32
SEQ = 2048
DEPTH = 2

HEAD_DIM = 64
ROPE_THETA = 10000.0
NORM_EPS = 1e-6
QUERY_BLOCK = 128
A_Q_HEADS = 8
A_KV_HEADS = 2
A_WINDOW = 128
B_HEADS = 8
C_HEADS = 8
C_PATTERNS = ((128, 1), (512, 4), (2048, 16))
D_HEADS = 8
MOBA_BLOCK = 256
MOBA_TOPK = 3
MOBA_Q_CHUNK = 16
PEER_HEADS = 8
PEER_N_KEYS = 128
PEER_N_EXPERTS = PEER_N_KEYS * PEER_N_KEYS
PEER_TOPK = 16
PEER_D_KEY = 256
PEER_TOKEN_CHUNK = 128

N_EVEN = (DEPTH + 1) // 2
N_ODD = DEPTH // 2
AB_IN = (A_Q_HEADS + 2 * A_KV_HEADS + 3 * B_HEADS) * HEAD_DIM
AB_OUT = (A_Q_HEADS + B_HEADS) * HEAD_DIM
CD_IN = 3 * (C_HEADS + D_HEADS) * HEAD_DIM
CD_OUT = (C_HEADS + D_HEADS) * HEAD_DIM

kernel_name = 'hybrid_swa_stick_dilated_moba_peer'


def rms_norm(x, g):
    xf = x.astype(jnp.float32)
    y = xf * lax.rsqrt(jnp.mean(xf * xf, axis=-1, keepdims=True) + NORM_EPS)
    return (y * g.astype(jnp.float32)).astype(x.dtype)


def adaln(x, g, shift, scale):
    return rms_norm(x, g) * (1.0 + scale) + shift


def rope(x, pos):
    half = HEAD_DIM // 2
    inv_freq = ROPE_THETA ** (-jnp.arange(half, dtype=jnp.float32) / half)
    ang = pos.astype(jnp.float32)[:, None] * inv_freq[None, :]
    cos = jnp.cos(ang)[None, :, None, :]
    sin = jnp.sin(ang)[None, :, None, :]
    xf = x.astype(jnp.float32)
    x1, x2 = xf[..., :half], xf[..., half:]
    out = jnp.concatenate([x1 * cos - x2 * sin, x2 * cos + x1 * sin], axis=-1)
    return out.astype(x.dtype)


def qk_prepare(q, k, gq, gk, pos):
    return rope(rms_norm(q, gq), pos), rope(rms_norm(k, gk), pos)


def split_cols(x, widths):
    outs, start = [], 0
    for w in widths:
        outs.append(x[..., start:start + w])
        start += w
    return outs


def banded_attention(q, k, v, max_offset, sink=None):
    n, length, hkv, grp, dh = q.shape
    blk = QUERY_BLOCK
    nb = -(-length // blk)
    pad = nb * blk - length
    qb = jnp.pad(q, ((0, 0), (0, pad), (0, 0), (0, 0), (0, 0))).reshape(n, nb, blk, hkv, grp, dh)

    def band(t):
        tp = jnp.pad(t, ((0, 0), (blk, pad), (0, 0), (0, 0))).reshape(n, nb + 1, blk, hkv, dh)
        return jnp.concatenate([tp[:, :-1], tp[:, 1:]], axis=2)

    kb, vb = band(k), band(v)
    s = jnp.einsum('nbqhgd,nbkhd->nbhgqk', qb, kb, preferred_element_type=jnp.float32) * (dh ** -0.5)
    qi = jnp.arange(blk)[:, None]
    ki = jnp.arange(2 * blk)[None, :]
    dist = blk + qi - ki
    key_pos = jnp.arange(nb)[:, None, None] * blk - blk + ki[None]
    valid = (dist >= 0) & (dist <= max_offset) & (key_pos >= 0)
    s = jnp.where(valid[None, :, None, None], s, -jnp.inf)
    lse = jax.nn.logsumexp(s, axis=-1)
    if sink is not None:
        lse = jnp.logaddexp(lse, sink.astype(jnp.float32)[None, None, :, :, None])
    p = jnp.exp(s - lse[..., None])
    o = jnp.einsum('nbhgqk,nbkhd->nbqhgd', p.astype(v.dtype), vb)
    o = o.reshape(n, nb * blk, hkv, grp, dh)[:, :length]
    lse = lse.transpose(0, 1, 4, 2, 3).reshape(n, nb * blk, hkv, grp)[:, :length]
    return o, lse


def stick_breaking_attention(q, k, v):
    b, s_len, h, dh = q.shape
    nb = s_len // QUERY_BLOCK
    qb = q.reshape(b, nb, QUERY_BLOCK, h, dh).transpose(1, 0, 2, 3, 4)
    key_pos = jnp.arange(s_len)

    def one_block(args):
        q_blk, i = args
        z = jnp.einsum('bqhd,bkhd->bhqk', q_blk, k, preferred_element_type=jnp.float32) * (dh ** -0.5)
        q_pos = i * QUERY_BLOCK + jnp.arange(QUERY_BLOCK)
        past = key_pos[None, :] < q_pos[:, None]
        log_keep = jnp.where(past, jax.nn.log_sigmoid(-z), 0.0)
        later = lax.cumsum(log_keep, axis=3, reverse=True) - log_keep
        w = jnp.where(past, jnp.exp(jax.nn.log_sigmoid(z) + later), 0.0)
        return jnp.einsum('bhqk,bkhd->bqhd', w.astype(v.dtype), v)

    out = lax.map(one_block, (qb, jnp.arange(nb)))
    return out.transpose(1, 0, 2, 3, 4).reshape(b, s_len, h, dh)


def dilated_attention(q, k, v):
    b, s_len, h, dh = q.shape
    outs, lses = [], []
    for window, dil in C_PATTERNS:
        m = s_len // dil

        def to_sub(t):
            return t.reshape(b, m, dil, h, dh).transpose(0, 2, 1, 3, 4).reshape(b * dil, m, h, dh)

        o, lse = banded_attention(to_sub(q)[:, :, :, None], to_sub(k), to_sub(v), window // dil)
        outs.append(o[:, :, :, 0].reshape(b, dil, m, h, dh).transpose(0, 2, 1, 3, 4).reshape(b, s_len, h, dh))
        lses.append(lse[..., 0].reshape(b, dil, m, h).transpose(0, 2, 1, 3).reshape(b, s_len, h))
    wts = jax.nn.softmax(jnp.stack(lses), axis=0)
    return jnp.einsum('pbsh,pbshd->bshd', wts.astype(v.dtype), jnp.stack(outs))


def moba_attention(q, k, v):
    b, s_len, h, dh = q.shape
    nblk = -(-s_len // MOBA_BLOCK)
    pad = nblk * MOBA_BLOCK - s_len

    def blocks(t):
        tp = jnp.pad(t, ((0, 0), (0, pad), (0, 0), (0, 0)))
        return tp.reshape(b, nblk, MOBA_BLOCK, h, dh).transpose(0, 3, 1, 2, 4)

    kb, vb = blocks(k), blocks(v)
    k_mean = jnp.mean(kb.astype(jnp.float32), axis=3)
    n_sel = min(MOBA_TOPK, nblk - 1)
    scale = dh ** -0.5
    nq = s_len // MOBA_Q_CHUNK
    qc = q.reshape(b, nq, MOBA_Q_CHUNK, h, dh).transpose(1, 0, 2, 3, 4)
    bi = jnp.arange(b)[:, None, None, None]
    hi = jnp.arange(h)[None, :, None, None]

    def one_chunk(args):
        q_blk, ci = args
        q_pos = ci * MOBA_Q_CHUNK + jnp.arange(MOBA_Q_CHUNK)
        own = (ci * MOBA_Q_CHUNK) // MOBA_BLOCK
        k_own = lax.dynamic_index_in_dim(kb, own, axis=2, keepdims=False)
        v_own = lax.dynamic_index_in_dim(vb, own, axis=2, keepdims=False)
        own_pos = own * MOBA_BLOCK + jnp.arange(MOBA_BLOCK)
        s_own = jnp.einsum('bqhd,bhkd->bhqk', q_blk, k_own, preferred_element_type=jnp.float32) * scale
        s_own = jnp.where(own_pos[None, :] <= q_pos[:, None], s_own, -jnp.inf)
        if n_sel == 0:
            p = jax.nn.softmax(s_own, axis=-1)
            return jnp.einsum('bhqk,bhkd->bqhd', p.astype(v.dtype), v_own)
        gate = jnp.einsum('bqhd,bhnd->bhqn', q_blk, k_mean, preferred_element_type=jnp.float32)
        gate = jnp.where(jnp.arange(nblk) < own, gate, -jnp.inf)
        _, idx = lax.top_k(gate, n_sel)
        k_sel = kb[bi, hi, idx]
        v_sel = vb[bi, hi, idx].reshape(b, h, MOBA_Q_CHUNK, n_sel * MOBA_BLOCK, dh)
        s_sel = jnp.einsum('bqhd,bhqnkd->bhqnk', q_blk, k_sel, preferred_element_type=jnp.float32) * scale
        s_sel = jnp.where((idx < own)[..., None], s_sel, -jnp.inf).reshape(b, h, MOBA_Q_CHUNK, n_sel * MOBA_BLOCK)
        p = jax.nn.softmax(jnp.concatenate([s_sel, s_own], axis=-1), axis=-1).astype(v.dtype)
        p_sel, p_own = p[..., :n_sel * MOBA_BLOCK], p[..., n_sel * MOBA_BLOCK:]
        return (jnp.einsum('bhqk,bhqkd->bqhd', p_sel, v_sel)
                + jnp.einsum('bhqk,bhkd->bqhd', p_own, v_own))

    out = lax.map(one_chunk, (qc, jnp.arange(nq)))
    return out.transpose(1, 0, 2, 3, 4).reshape(b, s_len, h, dh)


def heads_of(t):
    return t.reshape(t.shape[0], t.shape[1], -1, HEAD_DIM)


def mixer_window_and_stick(h, w_in, w_out, sinks, gq, gk, pos):
    b, s_len, _ = h.shape
    qa, ka, va, qb, kb, vb = split_cols(h @ w_in, (A_Q_HEADS * HEAD_DIM, A_KV_HEADS * HEAD_DIM, A_KV_HEADS * HEAD_DIM,
                                                   B_HEADS * HEAD_DIM, B_HEADS * HEAD_DIM, B_HEADS * HEAD_DIM))
    qa, ka = qk_prepare(heads_of(qa), heads_of(ka), gq, gk, pos)
    grp = A_Q_HEADS // A_KV_HEADS
    oa, _ = banded_attention(qa.reshape(b, s_len, A_KV_HEADS, grp, HEAD_DIM), ka, heads_of(va),
                             A_WINDOW - 1, sinks.reshape(A_KV_HEADS, grp))
    ob = stick_breaking_attention(heads_of(qb), heads_of(kb), heads_of(vb))
    y = jnp.concatenate([oa.reshape(b, s_len, -1), ob.reshape(b, s_len, -1)], axis=-1)
    return y @ w_out


def mixer_dilated_and_moba(h, w_in, w_out, gq_c, gk_c, gq_d, gk_d, pos):
    b, s_len, _ = h.shape
    wc, wd = C_HEADS * HEAD_DIM, D_HEADS * HEAD_DIM
    qc, kc, vc, qd, kd, vd = split_cols(h @ w_in, (wc, wc, wc, wd, wd, wd))
    qc, kc = qk_prepare(heads_of(qc), heads_of(kc), gq_c, gk_c, pos)
    qd, kd = qk_prepare(heads_of(qd), heads_of(kd), gq_d, gk_d, pos)
    oc = dilated_attention(qc, kc, heads_of(vc))
    od = moba_attention(qd, kd, heads_of(vd))
    y = jnp.concatenate([oc.reshape(b, s_len, -1), od.reshape(b, s_len, -1)], axis=-1)
    return y @ w_out


def peer_ffn(h, w_query, sub_keys, expert_u, expert_v):
    b, s_len, d = h.shape
    tokens = h.reshape(-1, PEER_TOKEN_CHUNK, d)
    half = PEER_D_KEY // 2

    def one_chunk(x_c):
        qry = (x_c @ w_query).reshape(PEER_TOKEN_CHUNK, PEER_HEADS, 2, half)
        s1 = jnp.einsum('thd,nd->thn', qry[:, :, 0], sub_keys[0], preferred_element_type=jnp.float32)
        s2 = jnp.einsum('thd,nd->thn', qry[:, :, 1], sub_keys[1], preferred_element_type=jnp.float32)
        v1, i1 = lax.top_k(s1, PEER_TOPK)
        v2, i2 = lax.top_k(s2, PEER_TOPK)
        cand = (v1[..., :, None] + v2[..., None, :]).reshape(PEER_TOKEN_CHUNK, PEER_HEADS, PEER_TOPK * PEER_TOPK)
        cand_idx = (i1[..., :, None] * PEER_N_KEYS + i2[..., None, :]).reshape(PEER_TOKEN_CHUNK, PEER_HEADS, PEER_TOPK * PEER_TOPK)
        top_s, pos = lax.top_k(cand, PEER_TOPK)
        experts = jnp.take_along_axis(cand_idx, pos, axis=-1)
        g = jax.nn.softmax(top_s, axis=-1)
        act = jax.nn.gelu(jnp.einsum('td,thkd->thk', x_c, expert_u[experts], preferred_element_type=jnp.float32),
                          approximate=False)
        return jnp.einsum('thk,thkd->td', (g * act).astype(x_c.dtype), expert_v[experts])

    out = lax.map(one_chunk, tokens)
    return out.reshape(b, s_len, d)


def setup_inputs(seed: int = 0) -> dict:
    key = jax.random.key(seed)
    ks = jax.random.split(key, 21)
    D = D_MODEL

    def nrm(k, shape, scale):
        return jax.random.normal(k, shape, jnp.float32) * scale

    return {
        'x': nrm(ks[0], (BATCH, SEQ, D), 1.0),
        'c': nrm(ks[1], (BATCH, D), 1.0),
        'ada_w': nrm(ks[2], (DEPTH, D, 6 * D), 0.5 * D ** -0.5),
        'ada_b': nrm(ks[3], (DEPTH, 6 * D), 0.02),
        'norm_mix_g': 1.0 + nrm(ks[4], (DEPTH, D), 0.02),
        'norm_ffn_g': 1.0 + nrm(ks[5], (DEPTH, D), 0.02),
        'w_in_ab': nrm(ks[6], (N_EVEN, D, AB_IN), D ** -0.5),
        'w_out_ab': nrm(ks[7], (N_EVEN, AB_OUT, D), AB_OUT ** -0.5),
        'sinks_a': nrm(ks[8], (N_EVEN, A_Q_HEADS), 1.0),
        'qnorm_a': 1.0 + nrm(ks[9], (N_EVEN, HEAD_DIM), 0.02),
        'knorm_a': 1.0 + nrm(ks[10], (N_EVEN, HEAD_DIM), 0.02),
        'w_in_cd': nrm(ks[11], (N_ODD, D, CD_IN), D ** -0.5),
        'w_out_cd': nrm(ks[12], (N_ODD, CD_OUT, D), CD_OUT ** -0.5),
        'qnorm_c': 1.0 + nrm(ks[13], (N_ODD, HEAD_DIM), 0.02),
        'knorm_c': 1.0 + nrm(ks[14], (N_ODD, HEAD_DIM), 0.02),
        'qnorm_d': 1.0 + nrm(ks[15], (N_ODD, HEAD_DIM), 0.02),
        'knorm_d': 1.0 + nrm(ks[16], (N_ODD, HEAD_DIM), 0.02),
        'peer_wq': nrm(ks[17], (DEPTH, D, PEER_HEADS * PEER_D_KEY), D ** -0.5),
        'peer_subkeys': nrm(ks[18], (DEPTH, 2, PEER_N_KEYS, PEER_D_KEY // 2), (PEER_D_KEY // 2) ** -0.5),
        'peer_u': nrm(ks[19], (DEPTH, PEER_N_EXPERTS, D), D ** -0.5),
        'peer_v': nrm(ks[20], (DEPTH, PEER_N_EXPERTS, D), 1.0),
    }


def reference(x, c, ada_w, ada_b, norm_mix_g, norm_ffn_g, w_in_ab, w_out_ab, sinks_a, qnorm_a, knorm_a,
              w_in_cd, w_out_cd, qnorm_c, knorm_c, qnorm_d, knorm_d, peer_wq, peer_subkeys, peer_u, peer_v):
    pos = jnp.arange(x.shape[1])
    cond = jax.nn.silu(c)
    for layer in range(DEPTH):
        mod = cond @ ada_w[layer] + ada_b[layer]
        shift_m, scale_m, gate_m, shift_f, scale_f, gate_f = [m[:, None, :] for m in jnp.split(mod, 6, axis=-1)]
        h = adaln(x, norm_mix_g[layer], shift_m, scale_m)
        if layer % 2 == 0:
            i = layer // 2
            y = mixer_window_and_stick(h, w_in_ab[i], w_out_ab[i], sinks_a[i], qnorm_a[i], knorm_a[i], pos)
        else:
            i = layer // 2
            y = mixer_dilated_and_moba(h, w_in_cd[i], w_out_cd[i], qnorm_c[i], knorm_c[i],
                                       qnorm_d[i], knorm_d[i], pos)
        x = x + gate_m * y
        h = adaln(x, norm_ffn_g[layer], shift_f, scale_f)
        x = x + gate_f * peer_ffn(h, peer_wq[layer], peer_subkeys[layer], peer_u[layer], peer_v[layer])
    return x
```

```cpp
#include <hip/hip_runtime.h>
#include <cstdio>
#include <cstdint>
#include <cmath>

typedef unsigned short bf16;
typedef short bf16x8 __attribute__((ext_vector_type(8)));
typedef float f32x4 __attribute__((ext_vector_type(4)));
typedef unsigned u32x4 __attribute__((ext_vector_type(4)));
typedef unsigned u32x2 __attribute__((ext_vector_type(2)));

constexpr int DM = 1024, NB = 32, SQ = 2048, MT = NB * SQ;
constexpr int HD = 64;
constexpr int AB_IN = 2304, CD_IN = 3072, QKV_LD = 3072;
constexpr int NEXP = 16384, PQ = 2048;
constexpr float EPS = 1e-6f;
constexpr int NT = 512;

constexpr size_t MiB = 1u << 20;
constexpr size_t WS_X1 = 0;
constexpr size_t WS_QKV = 256 * MiB;
constexpr size_t WS_HY = 640 * MiB;
constexpr size_t WS_PU = 768 * MiB;
constexpr size_t WS_PV = 832 * MiB;
constexpr size_t WS_WIN0 = 896 * MiB;
constexpr size_t WS_WIN1 = 901 * MiB;
constexpr size_t WS_WO0 = 907 * MiB;
constexpr size_t WS_WO1 = 909 * MiB;
constexpr size_t WS_WQ = 911 * MiB;
constexpr size_t WS_MOD = 919 * MiB;
constexpr size_t WS_ROPE = 921 * MiB;
constexpr size_t WS_KMEAN = 922 * MiB;
constexpr size_t WS_END = 923 * MiB;

struct Params {
    const float* in[21];
    float* out;
    unsigned char* ws;
};

__device__ __forceinline__ float bf2f(unsigned b) { return __uint_as_float(b << 16); }
__device__ __forceinline__ unsigned f2bf(float f) { unsigned u = __float_as_uint(f); return (u + 0x7fffu + ((u >> 16) & 1u)) >> 16; }
__device__ __forceinline__ unsigned pk2(float lo, float hi) { return f2bf(lo) | (f2bf(hi) << 16); }
__device__ __forceinline__ float wave_sum(float v) {
#pragma unroll
    for (int o = 1; o < 64; o <<= 1) v += __shfl_xor(v, o);
    return v;
}
__device__ __forceinline__ float gelu_erf(float x) { return 0.5f * x * (1.0f + erff(x * 0.70710678118654752f)); }

__device__ void ph_transpose(const float* W, bf16* Wt, int K, int N, float* tile  , int bid, int nb) {
    const int tid = threadIdx.x;
    const int nkt = K / 64, nnt = N / 64;
    for (int it = bid; it < nkt * nnt; it += nb) {
        const int k0 = (it / nnt) * 64, n0 = (it % nnt) * 64;
        __syncthreads();
        for (int e = tid; e < 64 * 64; e += NT) { const int r = e >> 6, c = e & 63; tile[r * 65 + c] = W[(size_t)(k0 + r) * N + n0 + c]; }
        __syncthreads();
        {
            const int n = tid >> 3, k8 = (tid & 7) * 8;
            u32x4 v;
            v.x = pk2(tile[(k8 + 0) * 65 + n], tile[(k8 + 1) * 65 + n]);
            v.y = pk2(tile[(k8 + 2) * 65 + n], tile[(k8 + 3) * 65 + n]);
            v.z = pk2(tile[(k8 + 4) * 65 + n], tile[(k8 + 5) * 65 + n]);
            v.w = pk2(tile[(k8 + 6) * 65 + n], tile[(k8 + 7) * 65 + n]);
            *(u32x4*)(Wt + (size_t)(n0 + n) * K + k0 + k8) = v;
        }
    }
}
__device__ void ph_convert(const float* src, bf16* dst, size_t n, int bid, int nb) {
    const size_t n8 = n / 8;
    for (size_t i = (size_t)bid * NT + threadIdx.x; i < n8; i += (size_t)nb * NT) {
        const f32x4 a = *(const f32x4*)(src + i * 8), b = *(const f32x4*)(src + i * 8 + 4);
        u32x4 v; v.x = pk2(a[0], a[1]); v.y = pk2(a[2], a[3]); v.z = pk2(b[0], b[1]); v.w = pk2(b[2], b[3]);
        *(u32x4*)(dst + i * 8) = v;
    }
}
__device__ void ph_mod(const float* c, const float* ada_w, const float* ada_b, float* mod, float* lds  , int bid, int nb) {
    const int tid = threadIdx.x, lane = tid & 63, w = tid >> 6;
    for (int it = bid; it < 2 * 96; it += nb) {
        const int l = it / 96, j = (it % 96) * 64 + lane;
        float acc[32];
#pragma unroll
        for (int b = 0; b < 32; ++b) acc[b] = 0.f;
        for (int kh = 0; kh < 2; ++kh) {
            __syncthreads();
            for (int e = tid; e < 32 * 512; e += NT) { const int b = e >> 9, k = e & 511; const float cv = c[b * 1024 + kh * 512 + k]; lds[e] = cv / (1.0f + __expf(-cv)); }
            __syncthreads();
            for (int kk = 0; kk < 64; ++kk) {
                const int k = w * 64 + kk;
                const float wv = ada_w[((size_t)l * 1024 + kh * 512 + k) * 6144 + j];
#pragma unroll
                for (int b = 0; b < 32; ++b) acc[b] += lds[b * 512 + k] * wv;
            }
        }
        __syncthreads();
#pragma unroll
        for (int b = 0; b < 32; ++b) lds[(w * 32 + b) * 64 + lane] = acc[b];
        __syncthreads();
        for (int e = tid; e < 32 * 64; e += NT) {
            const int b = e >> 6, jj = e & 63; float s = 0.f;
#pragma unroll
            for (int ww = 0; ww < 8; ++ww) s += lds[(ww * 32 + b) * 64 + jj];
            const int jo = (it % 96) * 64 + jj;
            mod[((size_t)l * 32 + b) * 6144 + jo] = s + ada_b[l * 6144 + jo];
        }
    }
}
__device__ void ph_rope_table(float* rope, int bid, int nb) {
    for (int i = bid * NT + threadIdx.x; i < SQ * 32; i += nb * NT) {
        const int t = i >> 5, f = i & 31;
        const float inv = powf(10000.0f, -(float)f / 32.0f);
        const float ang = (float)t * inv;
        float s, c; sincosf(ang, &s, &c);
        rope[i * 2] = c; rope[i * 2 + 1] = s;
    }
}

__device__ void ph_adaln(const float* x, const float* g, const float* mod_shift  , const float* mod_scale, bf16* h, int bid, int nb) {
    const int lane = threadIdx.x & 63, w = threadIdx.x >> 6;
    for (int t = bid * 8 + w; t < MT; t += nb * 8) {
        const int b = t >> 11;
        const float* xr = x + (size_t)t * DM;
        f32x4 v[4]; float ss = 0.f;
#pragma unroll
        for (int i = 0; i < 4; ++i) { v[i] = *(const f32x4*)(xr + i * 256 + lane * 4); ss += v[i][0] * v[i][0] + v[i][1] * v[i][1] + v[i][2] * v[i][2] + v[i][3] * v[i][3]; }
        ss = wave_sum(ss);
        const float r = rsqrtf(ss * (1.0f / DM) + EPS);
#pragma unroll
        for (int i = 0; i < 4; ++i) {
            const int c = i * 256 + lane * 4;
            const f32x4 gg = *(const f32x4*)(g + c), sc = *(const f32x4*)(mod_scale + (size_t)b * 6144 + c), sh = *(const f32x4*)(mod_shift + (size_t)b * 6144 + c);
            float y[4];
#pragma unroll
            for (int e = 0; e < 4; ++e) y[e] = v[i][e] * r * gg[e] * (1.0f + sc[e]) + sh[e];
            u32x2 o; o.x = pk2(y[0], y[1]); o.y = pk2(y[2], y[3]);
            *(u32x2*)(h + (size_t)t * DM + c) = o;
        }
    }
}

struct EpiBf16 {
    bf16* O; int ldo;
    __device__ __forceinline__ void operator()(int m, int n, f32x4 a) const { u32x2 o; o.x = pk2(a[0], a[1]); o.y = pk2(a[2], a[3]); *(u32x2*)(O + (size_t)m * ldo + n) = o; }
};
struct EpiResid {
    const float* xin; float* xout; const float* gate;
    __device__ __forceinline__ void operator()(int m, int n, f32x4 a) const {
        const int b = m >> 11;
        const f32x4 xi = *(const f32x4*)(xin + (size_t)m * DM + n), gt = *(const f32x4*)(gate + (size_t)b * 6144 + n);
        f32x4 o; o[0] = xi[0] + gt[0] * a[0]; o[1] = xi[1] + gt[1] * a[1]; o[2] = xi[2] + gt[2] * a[2]; o[3] = xi[3] + gt[3] * a[3];
        *(f32x4*)(xout + (size_t)m * DM + n) = o;
    }
};
template <class Epi>
__device__ void ph_gemm(const bf16* A, const bf16* Bt, int M, int N, int K, const Epi epi, bf16* lds, int bid, int nb) {
    bf16* sA = lds; bf16* sB = lds + 128 * 40;
    const int tid = threadIdx.x, lane = tid & 63, wid = tid >> 6, wm = wid >> 2, wn = wid & 3;
    const int lr = tid >> 2, lc = (tid & 3) * 8;
    const int fr = lane & 15, fq = lane >> 4;
    const int ntn = N / 128, ntiles = (M / 128) * ntn;
    for (int tile = bid; tile < ntiles; tile += nb) {
        const int tm = tile / ntn, tn = tile % ntn;
        f32x4 acc[4][2];
#pragma unroll
        for (int i = 0; i < 4; ++i)
#pragma unroll
            for (int j = 0; j < 2; ++j) acc[i][j] = (f32x4){0.f, 0.f, 0.f, 0.f};
        const bf16* ap = A + (size_t)(tm * 128 + lr) * K + lc;
        const bf16* bp = Bt + (size_t)(tn * 128 + lr) * K + lc;
        for (int k0 = 0; k0 < K; k0 += 32) {
            const u32x4 va = *(const u32x4*)(ap + k0), vb = *(const u32x4*)(bp + k0);
            __syncthreads();
            *(u32x4*)(sA + lr * 40 + lc) = va; *(u32x4*)(sB + lr * 40 + lc) = vb;
            __syncthreads();
            bf16x8 af[4], bfr[2];
#pragma unroll
            for (int i = 0; i < 4; ++i) af[i] = *(const bf16x8*)(sA + (wm * 64 + i * 16 + fr) * 40 + fq * 8);
#pragma unroll
            for (int j = 0; j < 2; ++j) bfr[j] = *(const bf16x8*)(sB + (wn * 32 + j * 16 + fr) * 40 + fq * 8);
#pragma unroll
            for (int i = 0; i < 4; ++i)
#pragma unroll
                for (int j = 0; j < 2; ++j) acc[i][j] = __builtin_amdgcn_mfma_f32_16x16x32_bf16(bfr[j], af[i], acc[i][j], 0, 0, 0);
        }
#pragma unroll
        for (int i = 0; i < 4; ++i)
#pragma unroll
            for (int j = 0; j < 2; ++j) epi(tm * 128 + wm * 64 + i * 16 + fr, tn * 128 + wn * 32 + j * 16 + fq * 4, acc[i][j]);
    }
}

__device__ void ph_qkprep(bf16* qkv, const float* rope, int nslots, const int* slot_col  , int c0a, int na, const float* ga, int c0b, int nbh, const float* gb, int bid, int nb) {
    const int tid = threadIdx.x, half = tid >> 5, li = tid & 31;
    const int per_tok = na + nbh;
    const size_t nitems = (size_t)MT * per_tok;
    for (size_t it = (size_t)bid * 16 + half; it < nitems; it += (size_t)nb * 16) {
        const int t = (int)(it / per_tok), hs = (int)(it % per_tok);
        const int col = hs < na ? c0a + hs * 64 : c0b + (hs - na) * 64;
        const float* g = hs < na ? ga : gb;
        bf16* p = qkv + (size_t)t * QKV_LD + col;
        const float x1 = bf2f(p[li]), x2 = bf2f(p[li + 32]);
        float ss = x1 * x1 + x2 * x2;
#pragma unroll
        for (int o = 1; o < 32; o <<= 1) ss += __shfl_xor(ss, o);
        const float r = rsqrtf(ss * (1.0f / 64.0f) + EPS);
        const float y1 = x1 * r * g[li], y2 = x2 * r * g[li + 32];
        const int pos = t & (SQ - 1);
        const float cs = rope[(pos * 32 + li) * 2], sn = rope[(pos * 32 + li) * 2 + 1];
        p[li] = (bf16)f2bf(y1 * cs - y2 * sn);
        p[li + 32] = (bf16)f2bf(y2 * cs + y1 * sn);
    }
}

__device__ void ph_kmean(const bf16* qkv, int kcol0, float* kmean, int bid, int nb) {
    const int lane = threadIdx.x & 63, w = threadIdx.x >> 6;
    for (int it = bid * 8 + w; it < 32 * 8 * 8; it += nb * 8) {
        const int blk = it & 7, h = (it >> 3) & 7, b = it >> 6;
        float s = 0.f;
        const bf16* p = qkv + (size_t)(b * SQ + blk * 256) * QKV_LD + kcol0 + h * 64 + lane;
        for (int i = 0; i < 256; ++i) s += bf2f(p[(size_t)i * QKV_LD]);
        kmean[(size_t)it * 64 + lane] = s * (1.0f / 256.0f);
    }
}

__device__ __forceinline__ void load_row64(const bf16* p, float* v) {
#pragma unroll
    for (int i = 0; i < 8; ++i) {
        const u32x4 u = *(const u32x4*)(p + i * 8);
        v[i * 8 + 0] = bf2f(u.x & 0xffffu); v[i * 8 + 1] = __uint_as_float(u.x & 0xffff0000u);
        v[i * 8 + 2] = bf2f(u.y & 0xffffu); v[i * 8 + 3] = __uint_as_float(u.y & 0xffff0000u);
        v[i * 8 + 4] = bf2f(u.z & 0xffffu); v[i * 8 + 5] = __uint_as_float(u.z & 0xffff0000u);
        v[i * 8 + 6] = bf2f(u.w & 0xffffu); v[i * 8 + 7] = __uint_as_float(u.w & 0xffff0000u);
    }
}
__device__ __forceinline__ float dot_row64(const bf16* p, const float* q) {
    float s0 = 0.f, s1 = 0.f;
#pragma unroll
    for (int i = 0; i < 8; ++i) {
        const u32x4 u = *(const u32x4*)(p + i * 8);
        s0 += q[i * 8 + 0] * bf2f(u.x & 0xffffu); s1 += q[i * 8 + 1] * __uint_as_float(u.x & 0xffff0000u);
        s0 += q[i * 8 + 2] * bf2f(u.y & 0xffffu); s1 += q[i * 8 + 3] * __uint_as_float(u.y & 0xffff0000u);
        s0 += q[i * 8 + 4] * bf2f(u.z & 0xffffu); s1 += q[i * 8 + 5] * __uint_as_float(u.z & 0xffff0000u);
        s0 += q[i * 8 + 6] * bf2f(u.w & 0xffffu); s1 += q[i * 8 + 7] * __uint_as_float(u.w & 0xffff0000u);
    }
    return s0 + s1;
}
__device__ __forceinline__ void axpy_row64(const bf16* p, float w, float* o) {
#pragma unroll
    for (int i = 0; i < 8; ++i) {
        const u32x4 u = *(const u32x4*)(p + i * 8);
        o[i * 8 + 0] += w * bf2f(u.x & 0xffffu); o[i * 8 + 1] += w * __uint_as_float(u.x & 0xffff0000u);
        o[i * 8 + 2] += w * bf2f(u.y & 0xffffu); o[i * 8 + 3] += w * __uint_as_float(u.y & 0xffff0000u);
        o[i * 8 + 4] += w * bf2f(u.z & 0xffffu); o[i * 8 + 5] += w * __uint_as_float(u.z & 0xffff0000u);
        o[i * 8 + 6] += w * bf2f(u.w & 0xffffu); o[i * 8 + 7] += w * __uint_as_float(u.w & 0xffff0000u);
    }
}
__device__ __forceinline__ void store_row64(bf16* p, const float* o, float sc) {
#pragma unroll
    for (int i = 0; i < 8; ++i) {
        u32x4 u; u.x = pk2(o[i * 8] * sc, o[i * 8 + 1] * sc); u.y = pk2(o[i * 8 + 2] * sc, o[i * 8 + 3] * sc); u.z = pk2(o[i * 8 + 4] * sc, o[i * 8 + 5] * sc); u.w = pk2(o[i * 8 + 6] * sc, o[i * 8 + 7] * sc);
        *(u32x4*)(p + i * 8) = u;
    }
}
#define OSM_STEP(sc, mult, vrow) do { \
    const float mn_ = (mult) > 0.f ? fmaxf(m, (sc)) : m; \
    const float al_ = (m == mn_) ? 1.0f : __expf(m - mn_); \
    const float p_ = (mult) > 0.f ? (mult) * __expf((sc) - mn_) : 0.f; \
    l = l * al_ + p_; m = mn_; \
    if (al_ != 1.0f) { _Pragma("unroll") for (int d_ = 0; d_ < 64; ++d_) o[d_] *= al_; } \
    axpy_row64((vrow), p_, o); } while (0)

__device__ void ph_attn0(const bf16* qkv, const float* sinks, bf16* y, int bid, int nb) {
    const int lane = threadIdx.x & 63, w = threadIdx.x >> 6;
    const int nitems = NB * 16 * (SQ / 64);
    for (int it = bid * 8 + w; it < nitems; it += nb * 8) {
        const int chunk = it & 31, hs = (it >> 5) & 15, b = it >> 9;
        const int t0 = chunk * 64, t = t0 + lane;
        const bf16* base = qkv + (size_t)b * SQ * QKV_LD;
        float q[64], o[64];
#pragma unroll
        for (int d = 0; d < 64; ++d) o[d] = 0.f;
        if (hs < 8) {
            const int kvh = hs >> 2;
            load_row64(base + (size_t)t * QKV_LD + hs * 64, q);
            float m = -INFINITY, l = 0.f;
            const int slo = t0 - 127 > 0 ? t0 - 127 : 0;
            for (int s = slo; s <= t0 + 63; ++s) {
                const bf16* kr = base + (size_t)s * QKV_LD + 512 + kvh * 64;
                const float sc = dot_row64(kr, q) * 0.125f;
                const float mult = (s <= t && t - s <= 127) ? 1.0f : 0.0f;
                OSM_STEP(sc, mult, kr + 128);
            }
            l += __expf(sinks[hs] - m);
            store_row64(y + (size_t)(b * SQ + t) * DM + hs * 64, o, 1.0f / l);
        } else {
            const int h = hs - 8;
            load_row64(base + (size_t)t * QKV_LD + 768 + h * 64, q);
            float later = 0.f;
            for (int s = t0 + 62; s >= 0; --s) {
                const bf16* kr = base + (size_t)s * QKV_LD + 1280 + h * 64;
                const float z = dot_row64(kr, q) * 0.125f;
                const float sp = fmaxf(z, 0.f) + log1pf(__expf(-fabsf(z)));
                const bool valid = s < t;
                const float wgt = valid ? __expf(z - sp + later) : 0.f;
                if (valid) later -= sp;
                axpy_row64(kr + 512, wgt, o);
            }
            store_row64(y + (size_t)(b * SQ + t) * DM + 512 + h * 64, o, 1.0f);
        }
    }
}
__device__ void ph_attn1(const bf16* qkv, const float* kmean, bf16* y, int bid, int nb) {
    const int lane = threadIdx.x & 63, w = threadIdx.x >> 6;
    const int nitems = NB * 16 * (SQ / 64);
    for (int it = bid * 8 + w; it < nitems; it += nb * 8) {
        const int chunk = it & 31, hs = (it >> 5) & 15, b = it >> 9;
        const int t0 = chunk * 64, t = t0 + lane;
        const bf16* base = qkv + (size_t)b * SQ * QKV_LD;
        float q[64], o[64];
#pragma unroll
        for (int d = 0; d < 64; ++d) o[d] = 0.f;
        float m = -INFINITY, l = 0.f;
        if (hs < 8) {
            load_row64(base + (size_t)t * QKV_LD + hs * 64, q);
            for (int s = 0; s <= t0 + 63; ++s) {
                const int dist = t - s;
                float mult = 0.f;
                if (dist >= 0) mult = (dist <= 128 ? 1.f : 0.f) + (((dist & 3) == 0 && dist <= 512) ? 1.f : 0.f) + (((dist & 15) == 0) ? 1.f : 0.f);
                if (__ballot(mult > 0.f) == 0ull) continue;
                const bf16* kr = base + (size_t)s * QKV_LD + 512 + hs * 64;
                const float sc = dot_row64(kr, q) * 0.125f;
                OSM_STEP(sc, mult, kr + 512);
            }
            store_row64(y + (size_t)(b * SQ + t) * DM + hs * 64, o, 1.0f / l);
        } else {
            const int h = hs - 8;
            load_row64(base + (size_t)t * QKV_LD + 1536 + h * 64, q);
            const int own = t0 >> 8;
            unsigned sel = 0u;
            {
                float gt[8];
#pragma unroll
                for (int n = 0; n < 8; ++n) {
                    gt[n] = -INFINITY;
                    if (n < own) { const float* km = kmean + ((size_t)((b * 8 + h) * 8 + n)) * 64; float s = 0.f;
#pragma unroll
                        for (int d = 0; d < 64; ++d) s += q[d] * km[d];
                        gt[n] = s; }
                }
                const int nsel = own < 3 ? own : 3;
                for (int r = 0; r < nsel; ++r) {
                    float best = -INFINITY; int bi = -1;
#pragma unroll
                    for (int n = 0; n < 8; ++n) { const bool ok = n < own && !((sel >> n) & 1u) && (bi < 0 || gt[n] > best); if (ok) { best = gt[n]; bi = n; } }
                    if (bi >= 0) sel |= 1u << bi;
                }
            }
            for (int s = 0; s <= t0 + 63; ++s) {
                const int blk = s >> 8;
                const float mult = (blk == own) ? (s <= t ? 1.f : 0.f) : (((sel >> blk) & 1u) ? 1.f : 0.f);
                if (__ballot(mult > 0.f) == 0ull) continue;
                const bf16* kr = base + (size_t)s * QKV_LD + 2048 + h * 64;
                const float sc = dot_row64(kr, q) * 0.125f;
                OSM_STEP(sc, mult, kr + 512);
            }
            store_row64(y + (size_t)(b * SQ + t) * DM + 512 + h * 64, o, 1.0f / l);
        }
    }
}

__device__ void ph_peer_select(const bf16* qry, const float* subkeys  , int* eidx, float* egate, int bid, int nb) {
    const size_t nitems = (size_t)MT * 8;
    for (size_t it = (size_t)bid * NT + threadIdx.x; it < nitems; it += (size_t)nb * NT) {
        const int t = (int)(it >> 3), h = (int)(it & 7);
        float tk[2][16];
#pragma unroll
        for (int hf = 0; hf < 2; ++hf) {
            float q[128];
            const bf16* qp = qry + (size_t)t * PQ + h * 256 + hf * 128;
#pragma unroll
            for (int i = 0; i < 16; ++i) {
                const u32x4 u = *(const u32x4*)(qp + i * 8);
                q[i * 8 + 0] = bf2f(u.x & 0xffffu); q[i * 8 + 1] = __uint_as_float(u.x & 0xffff0000u);
                q[i * 8 + 2] = bf2f(u.y & 0xffffu); q[i * 8 + 3] = __uint_as_float(u.y & 0xffff0000u);
                q[i * 8 + 4] = bf2f(u.z & 0xffffu); q[i * 8 + 5] = __uint_as_float(u.z & 0xffff0000u);
                q[i * 8 + 6] = bf2f(u.w & 0xffffu); q[i * 8 + 7] = __uint_as_float(u.w & 0xffff0000u);
            }
#pragma unroll
            for (int i = 0; i < 16; ++i) tk[hf][i] = -INFINITY;
#pragma unroll 1
            for (int n = 0; n < 128; ++n) {
                const float* kr = subkeys + ((size_t)hf * 128 + n) * 128;
                float s0 = 0.f, s1 = 0.f;
#pragma unroll
                for (int d = 0; d < 128; d += 2) { s0 += q[d] * kr[d]; s1 += q[d + 1] * kr[d + 1]; }
                float x = __uint_as_float((__float_as_uint(s0 + s1) & 0xffffff80u) | (unsigned)n);
#pragma unroll
                for (int i = 0; i < 16; ++i) { const float hi = fmaxf(tk[hf][i], x), lo = fminf(tk[hf][i], x); tk[hf][i] = hi; x = lo; }
            }
        }
        float cv[16]; int ci[16];
#pragma unroll
        for (int i = 0; i < 16; ++i) { cv[i] = -INFINITY; ci[i] = 0; }
#pragma unroll
        for (int i = 0; i < 16; ++i) {
#pragma unroll
            for (int j = 0; j < 16; ++j) {
                if ((i + 1) * (j + 1) <= 16) {
                    float x = tk[0][i] + tk[1][j];
                    int xi = (int)((__float_as_uint(tk[0][i]) & 127u) * 128u + (__float_as_uint(tk[1][j]) & 127u));
#pragma unroll
                    for (int k = 0; k < 16; ++k) { const bool gt = x > cv[k]; const float tf = gt ? cv[k] : x; const int tt = gt ? ci[k] : xi; cv[k] = gt ? x : cv[k]; ci[k] = gt ? xi : ci[k]; x = tf; xi = tt; }
                }
            }
        }
        float sum = 0.f, e[16];
#pragma unroll
        for (int k = 0; k < 16; ++k) { e[k] = __expf(cv[k] - cv[0]); sum += e[k]; }
        const float inv = 1.0f / sum;
#pragma unroll
        for (int k = 0; k < 16; ++k) { eidx[(size_t)t * 128 + h * 16 + k] = ci[k]; egate[(size_t)t * 128 + h * 16 + k] = e[k] * inv; }
    }
}

__device__ void ph_peer_gather(const bf16* h2, const bf16* pu, const bf16* pv, const int* eidx, const float* egate, const float* xin, const float* gate  , float* xout, int bid, int nb) {
    const int lane = threadIdx.x & 63, w = threadIdx.x >> 6;
    for (int t = bid * 8 + w; t < MT; t += nb * 8) {
        const int b = t >> 11;
        float hx[16], acc[16];
#pragma unroll
        for (int i = 0; i < 2; ++i) {
            const u32x4 u = *(const u32x4*)(h2 + (size_t)t * DM + i * 512 + lane * 8);
            hx[i * 8 + 0] = bf2f(u.x & 0xffffu); hx[i * 8 + 1] = __uint_as_float(u.x & 0xffff0000u);
            hx[i * 8 + 2] = bf2f(u.y & 0xffffu); hx[i * 8 + 3] = __uint_as_float(u.y & 0xffff0000u);
            hx[i * 8 + 4] = bf2f(u.z & 0xffffu); hx[i * 8 + 5] = __uint_as_float(u.z & 0xffff0000u);
            hx[i * 8 + 6] = bf2f(u.w & 0xffffu); hx[i * 8 + 7] = __uint_as_float(u.w & 0xffff0000u);
        }
#pragma unroll
        for (int i = 0; i < 16; ++i) acc[i] = 0.f;
        const int e0 = eidx[(size_t)t * 128 + lane], e1 = eidx[(size_t)t * 128 + 64 + lane];
        const float g0 = egate[(size_t)t * 128 + lane], g1 = egate[(size_t)t * 128 + 64 + lane];
        for (int k = 0; k < 128; ++k) {
            const int e = __shfl(k < 64 ? e0 : e1, k & 63);
            const float g = __shfl(k < 64 ? g0 : g1, k & 63);
            const bf16* ur = pu + (size_t)e * DM;
            float d = 0.f;
#pragma unroll
            for (int i = 0; i < 2; ++i) {
                const u32x4 u = *(const u32x4*)(ur + i * 512 + lane * 8);
                d += hx[i * 8 + 0] * bf2f(u.x & 0xffffu) + hx[i * 8 + 1] * __uint_as_float(u.x & 0xffff0000u);
                d += hx[i * 8 + 2] * bf2f(u.y & 0xffffu) + hx[i * 8 + 3] * __uint_as_float(u.y & 0xffff0000u);
                d += hx[i * 8 + 4] * bf2f(u.z & 0xffffu) + hx[i * 8 + 5] * __uint_as_float(u.z & 0xffff0000u);
                d += hx[i * 8 + 6] * bf2f(u.w & 0xffffu) + hx[i * 8 + 7] * __uint_as_float(u.w & 0xffff0000u);
            }
            d = wave_sum(d);
            const float cf = g * gelu_erf(d);
            const bf16* vr = pv + (size_t)e * DM;
#pragma unroll
            for (int i = 0; i < 2; ++i) {
                const u32x4 u = *(const u32x4*)(vr + i * 512 + lane * 8);
                acc[i * 8 + 0] += cf * bf2f(u.x & 0xffffu); acc[i * 8 + 1] += cf * __uint_as_float(u.x & 0xffff0000u);
                acc[i * 8 + 2] += cf * bf2f(u.y & 0xffffu); acc[i * 8 + 3] += cf * __uint_as_float(u.y & 0xffff0000u);
                acc[i * 8 + 4] += cf * bf2f(u.z & 0xffffu); acc[i * 8 + 5] += cf * __uint_as_float(u.z & 0xffff0000u);
                acc[i * 8 + 6] += cf * bf2f(u.w & 0xffffu); acc[i * 8 + 7] += cf * __uint_as_float(u.w & 0xffff0000u);
            }
        }
#pragma unroll
        for (int i = 0; i < 2; ++i) {
#pragma unroll
            for (int j = 0; j < 2; ++j) {
                const int c = i * 512 + lane * 8 + j * 4;
                const f32x4 xi = *(const f32x4*)(xin + (size_t)t * DM + c), gt = *(const f32x4*)(gate + (size_t)b * 6144 + c);
                f32x4 o;
#pragma unroll
                for (int e = 0; e < 4; ++e) o[e] = xi[e] + gt[e] * acc[i * 8 + j * 4 + e];
                *(f32x4*)(xout + (size_t)t * DM + c) = o;
            }
        }
    }
}

extern __shared__ __attribute__((aligned(16))) unsigned char dyn_lds[];

__global__ void __launch_bounds__(NT) k_prep(Params p) {
    unsigned char* ws = p.ws; const int bid = blockIdx.x, nb = gridDim.x;
    float* tile = (float*)dyn_lds;
    ph_transpose(p.in[6], (bf16*)(ws + WS_WIN0), 1024, AB_IN, tile, bid, nb);
    ph_transpose(p.in[11], (bf16*)(ws + WS_WIN1), 1024, CD_IN, tile, bid, nb);
    ph_transpose(p.in[7], (bf16*)(ws + WS_WO0), 1024, 1024, tile, bid, nb);
    ph_transpose(p.in[12], (bf16*)(ws + WS_WO1), 1024, 1024, tile, bid, nb);
    ph_transpose(p.in[17], (bf16*)(ws + WS_WQ), 1024, PQ, tile, bid, nb);
    ph_transpose(p.in[17] + (size_t)1024 * PQ, (bf16*)(ws + WS_WQ) + (size_t)PQ * 1024, 1024, PQ, tile, bid, nb);
    ph_convert(p.in[19], (bf16*)(ws + WS_PU), (size_t)2 * NEXP * DM, bid, nb);
    ph_convert(p.in[20], (bf16*)(ws + WS_PV), (size_t)2 * NEXP * DM, bid, nb);
    ph_mod(p.in[1], p.in[2], p.in[3], (float*)(ws + WS_MOD), (float*)dyn_lds, bid, nb);
    ph_rope_table((float*)(ws + WS_ROPE), bid, nb);
}
__global__ void __launch_bounds__(NT) k_adaln_mix(Params p, int layer) {
    const float* xin = layer == 0 ? p.in[0] : p.out;
    const float* mod = (const float*)(p.ws + WS_MOD) + (size_t)layer * 32 * 6144;
    ph_adaln(xin, p.in[4] + layer * DM, mod + 0, mod + 1024, (bf16*)(p.ws + WS_HY), blockIdx.x, gridDim.x);
}
__global__ void __launch_bounds__(NT) k_gemm_in(Params p, int layer) {
    EpiBf16 e{(bf16*)(p.ws + WS_QKV), QKV_LD};
    ph_gemm((const bf16*)(p.ws + WS_HY), (const bf16*)(p.ws + (layer == 0 ? WS_WIN0 : WS_WIN1)), MT, layer == 0 ? AB_IN : CD_IN, DM, e, (bf16*)dyn_lds, blockIdx.x, gridDim.x);
}
__global__ void __launch_bounds__(NT) k_qkprep(Params p, int layer) {
    bf16* qkv = (bf16*)(p.ws + WS_QKV); const float* rope = (const float*)(p.ws + WS_ROPE);
    if (layer == 0) ph_qkprep(qkv, rope, 0, nullptr, 0, 8, p.in[9], 512, 2, p.in[10], blockIdx.x, gridDim.x);
    else { ph_qkprep(qkv, rope, 0, nullptr, 0, 8, p.in[13], 512, 8, p.in[14], blockIdx.x, gridDim.x);
           ph_qkprep(qkv, rope, 0, nullptr, 1536, 8, p.in[15], 2048, 8, p.in[16], blockIdx.x, gridDim.x); }
}
__global__ void __launch_bounds__(NT) k_kmean(Params p) { ph_kmean((const bf16*)(p.ws + WS_QKV), 2048, (float*)(p.ws + WS_KMEAN), blockIdx.x, gridDim.x); }
__global__ void __launch_bounds__(NT) k_attn(Params p, int layer) {
    if (layer == 0) ph_attn0((const bf16*)(p.ws + WS_QKV), p.in[8], (bf16*)(p.ws + WS_HY), blockIdx.x, gridDim.x);
    else ph_attn1((const bf16*)(p.ws + WS_QKV), (const float*)(p.ws + WS_KMEAN), (bf16*)(p.ws + WS_HY), blockIdx.x, gridDim.x);
}
__global__ void __launch_bounds__(NT) k_gemm_out(Params p, int layer) {
    const float* mod = (const float*)(p.ws + WS_MOD) + (size_t)layer * 32 * 6144;
    EpiResid e{layer == 0 ? p.in[0] : p.out, (float*)(p.ws + WS_X1), mod + 2048};
    ph_gemm((const bf16*)(p.ws + WS_HY), (const bf16*)(p.ws + (layer == 0 ? WS_WO0 : WS_WO1)), MT, DM, DM, e, (bf16*)dyn_lds, blockIdx.x, gridDim.x);
}
__global__ void __launch_bounds__(NT) k_adaln_ffn(Params p, int layer) {
    const float* mod = (const float*)(p.ws + WS_MOD) + (size_t)layer * 32 * 6144;
    ph_adaln((const float*)(p.ws + WS_X1), p.in[5] + layer * DM, mod + 3072, mod + 4096, (bf16*)(p.ws + WS_QKV), blockIdx.x, gridDim.x);
}
__global__ void __launch_bounds__(NT) k_gemm_q(Params p, int layer) {
    EpiBf16 e{(bf16*)(p.ws + WS_QKV + 128 * MiB), PQ};
    ph_gemm((const bf16*)(p.ws + WS_QKV), (const bf16*)(p.ws + WS_WQ) + (size_t)layer * PQ * DM, MT, PQ, DM, e, (bf16*)dyn_lds, blockIdx.x, gridDim.x);
}
__global__ void __launch_bounds__(NT) k_select(Params p, int layer) {
    ph_peer_select((const bf16*)(p.ws + WS_QKV + 128 * MiB), p.in[18] + (size_t)layer * 2 * 128 * 128, (int*)(p.ws + WS_HY), (float*)(p.ws + WS_HY + 32 * MiB), blockIdx.x, gridDim.x);
}
__global__ void __launch_bounds__(NT) k_gather(Params p, int layer) {
    const float* mod = (const float*)(p.ws + WS_MOD) + (size_t)layer * 32 * 6144;
    ph_peer_gather((const bf16*)(p.ws + WS_QKV), (const bf16*)(p.ws + WS_PU) + (size_t)layer * NEXP * DM, (const bf16*)(p.ws + WS_PV) + (size_t)layer * NEXP * DM,
                   (const int*)(p.ws + WS_HY), (const float*)(p.ws + WS_HY + 32 * MiB), (const float*)(p.ws + WS_X1), mod + 5120, p.out, blockIdx.x, gridDim.x);
}

extern "C" void kernel_launch(void* const* d_in, const int* in_sizes, int n_in, void* d_out, int out_size, void* d_ws, size_t ws_size, hipStream_t stream) {
    if (n_in != 21 || ws_size < WS_END) { fprintf(stderr, "kernel_launch: bad args n_in=%d ws=%zu\n", n_in, ws_size); return; }
    Params p{};
    for (int i = 0; i < 21; ++i) p.in[i] = (const float*)d_in[i];
    p.out = (float*)d_out; p.ws = (unsigned char*)d_ws;
    const int G = 2048; const size_t L = 65536;
    static bool attr = false;
    if (!attr) { (void)hipFuncSetAttribute((const void*)k_prep, hipFuncAttributeMaxDynamicSharedMemorySize, (int)L); attr = true; }
    k_prep<<<1024, NT, L, stream>>>(p);
    for (int layer = 0; layer < 2; ++layer) {
        k_adaln_mix<<<G, NT, 0, stream>>>(p, layer);
        k_gemm_in<<<G, NT, 32768, stream>>>(p, layer);
        k_qkprep<<<G, NT, 0, stream>>>(p, layer);
        if (layer == 1) k_kmean<<<256, NT, 0, stream>>>(p);
        k_attn<<<G, NT, 0, stream>>>(p, layer);
        k_gemm_out<<<G, NT, 32768, stream>>>(p, layer);
        k_adaln_ffn<<<G, NT, 0, stream>>>(p, layer);
        k_gemm_q<<<G, NT, 32768, stream>>>(p, layer);
        k_select<<<G, NT, 0, stream>>>(p, layer);
        k_gather<<<G, NT, 0, stream>>>(p, layer);
    }
}
```

```cpp
#include <hip/hip_runtime.h>
#ifndef REP_A
#define REP_A 1
#endif
#ifndef REP_B
#define REP_B 1
#endif
#ifndef REP_C
#define REP_C 1
#endif
#ifndef REP_D
#define REP_D 1
#endif
#include <hip/hip_cooperative_groups.h>
namespace cg = cooperative_groups;
#include <cstdio>
#include <cstdint>
#include <cmath>

typedef unsigned short bf16;
typedef short bf16x8 __attribute__((ext_vector_type(8)));
typedef float f32x4 __attribute__((ext_vector_type(4)));
typedef unsigned u32x4 __attribute__((ext_vector_type(4)));
typedef unsigned u32x2 __attribute__((ext_vector_type(2)));

constexpr int DM = 1024, NB = 32, SQ = 2048, MT = NB * SQ;
constexpr int HD = 64;
constexpr int AB_IN = 2304, CD_IN = 3072, QKV_LD = 3072;
constexpr int NEXP = 16384, PQ = 2048;
constexpr float EPS = 1e-6f;
constexpr int NT = 512;

constexpr size_t MiB = 1u << 20;
constexpr size_t WS_X1 = 0;
constexpr size_t WS_QKV = 256 * MiB;
constexpr size_t WS_HY = 640 * MiB;
constexpr size_t WS_PU = 768 * MiB;
constexpr size_t WS_PV = 832 * MiB;
constexpr size_t WS_WIN0 = 896 * MiB;
constexpr size_t WS_WIN1 = 901 * MiB;
constexpr size_t WS_WO0 = 907 * MiB;
constexpr size_t WS_WO1 = 909 * MiB;
constexpr size_t WS_WQ = 911 * MiB;
constexpr size_t WS_MOD = 919 * MiB;
constexpr size_t WS_ROPE = 921 * MiB;
constexpr size_t WS_KMEAN = 922 * MiB;
constexpr size_t WS_BAR = 923 * MiB;
constexpr size_t WS_END = 924 * MiB;

struct Params {
    const float* in[21];
    float* out;
    unsigned char* ws;
};

__device__ __forceinline__ int ltid() { int t = (int)__builtin_amdgcn_workitem_id_x(); asm volatile("" : "+v"(t)); return t; }
__device__ __forceinline__ float bf2f(unsigned b) { return __uint_as_float(b << 16); }
__device__ __forceinline__ unsigned f2bf(float f) { unsigned u = __float_as_uint(f); return (u + 0x7fffu + ((u >> 16) & 1u)) >> 16; }
__device__ __forceinline__ unsigned pk2(float lo, float hi) { return f2bf(lo) | (f2bf(hi) << 16); }
__device__ __forceinline__ float wave_sum(float v) {
#pragma unroll
    for (int o = 1; o < 64; o <<= 1) v += __shfl_xor(v, o);
    return v;
}
__device__ __forceinline__ float gelu_erf(float x) { return 0.5f * x * (1.0f + erff(x * 0.70710678118654752f)); }

__device__ __forceinline__ int qkv_logical_col(int p) { return (p & ~255) | (((p >> 5) & 3) << 6) | (((p >> 7) & 1) << 5) | (p & 31); }
__device__ void ph_transpose(const float* W, bf16* Wt, int K, int N, bool permute, float* tile  , int bid, int nb) {
    const int tid = ltid();
    const int nkt = K / 64, nnt = N / 64;
    for (int it = bid; it < nkt * nnt; it += nb) {
        const int k0 = (it / nnt) * 64, n0 = (it % nnt) * 64;
        __syncthreads();
        for (int e = tid; e < 64 * 64; e += NT) { const int r = e >> 6, c = e & 63; const int nl = permute ? qkv_logical_col(n0 + c) : n0 + c; tile[r * 65 + c] = W[(size_t)(k0 + r) * N + nl]; }
        __syncthreads();
        {
            const int n = tid >> 3, k8 = (tid & 7) * 8;
            u32x4 v;
            v.x = pk2(tile[(k8 + 0) * 65 + n], tile[(k8 + 1) * 65 + n]);
            v.y = pk2(tile[(k8 + 2) * 65 + n], tile[(k8 + 3) * 65 + n]);
            v.z = pk2(tile[(k8 + 4) * 65 + n], tile[(k8 + 5) * 65 + n]);
            v.w = pk2(tile[(k8 + 6) * 65 + n], tile[(k8 + 7) * 65 + n]);
            *(u32x4*)(Wt + (size_t)(n0 + n) * K + k0 + k8) = v;
        }
    }
}
__device__ void ph_convert(const float* src, bf16* dst, size_t n, int bid, int nb) {
    const size_t n8 = n / 8;
    for (size_t i = (size_t)bid * NT + ltid(); i < n8; i += (size_t)nb * NT) {
        const f32x4 a = *(const f32x4*)(src + i * 8), b = *(const f32x4*)(src + i * 8 + 4);
        u32x4 v; v.x = pk2(a[0], a[1]); v.y = pk2(a[2], a[3]); v.z = pk2(b[0], b[1]); v.w = pk2(b[2], b[3]);
        *(u32x4*)(dst + i * 8) = v;
    }
}
__device__ void ph_mod(const float* c, const float* ada_w, const float* ada_b, float* mod, float* lds  , int bid, int nb) {
    const int tid = ltid(), lane = tid & 63, w = tid >> 6;
    for (int it = bid; it < 2 * 96; it += nb) {
        const int l = it / 96, j = (it % 96) * 64 + lane;
        float acc[32];
#pragma unroll
        for (int b = 0; b < 32; ++b) acc[b] = 0.f;
        for (int kh = 0; kh < 2; ++kh) {
            __syncthreads();
            for (int e = tid; e < 32 * 512; e += NT) { const int b = e >> 9, k = e & 511; const float cv = c[b * 1024 + kh * 512 + k]; lds[e] = cv / (1.0f + __expf(-cv)); }
            __syncthreads();
            for (int kk = 0; kk < 64; ++kk) {
                const int k = w * 64 + kk;
                const float wv = ada_w[((size_t)l * 1024 + kh * 512 + k) * 6144 + j];
#pragma unroll
                for (int b = 0; b < 32; ++b) acc[b] += lds[b * 512 + k] * wv;
            }
        }
        __syncthreads();
#pragma unroll
        for (int b = 0; b < 32; ++b) lds[(w * 32 + b) * 64 + lane] = acc[b];
        __syncthreads();
        for (int e = tid; e < 32 * 64; e += NT) {
            const int b = e >> 6, jj = e & 63; float s = 0.f;
#pragma unroll
            for (int ww = 0; ww < 8; ++ww) s += lds[(ww * 32 + b) * 64 + jj];
            const int jo = (it % 96) * 64 + jj;
            mod[((size_t)l * 32 + b) * 6144 + jo] = s + ada_b[l * 6144 + jo];
        }
    }
}
__device__ void ph_rope_table(float* rope, int bid, int nb) {
    for (int i = bid * NT + ltid(); i < SQ * 32; i += nb * NT) {
        const int t = i >> 5, f = i & 31;
        const float inv = powf(10000.0f, -(float)f / 32.0f);
        const float ang = (float)t * inv;
        float s, c; sincosf(ang, &s, &c);
        rope[i * 2] = c; rope[i * 2 + 1] = s;
    }
}

#define DPP_ADD0(v, ctrl) ((v) + __builtin_bit_cast(float, __builtin_amdgcn_update_dpp(0, __builtin_bit_cast(int, (v)), (ctrl), 0xf, 0xf, true)))
__device__ void ph_adaln(const float* x, const float* g, const float* mod_shift  , const float* mod_scale, bf16* h, int bid, int nb) {
    const int lane = ltid() & 63, w = __builtin_amdgcn_readfirstlane(ltid() >> 6);
    for (int t0 = (bid * 8 + w) * 4; t0 < MT; t0 += nb * 8 * 4) {
        const int b = t0 >> 11;
        f32x4 v[4][4]; float ss[4];
#pragma unroll
        for (int r = 0; r < 4; ++r) {
            const float* xr = x + (size_t)(t0 + r) * DM;
#pragma unroll
            for (int i = 0; i < 4; ++i) v[r][i] = *(const f32x4*)(xr + i * 256 + lane * 4);
        }
#pragma unroll
        for (int r = 0; r < 4; ++r) {
            float s = 0.f;
#pragma unroll
            for (int i = 0; i < 4; ++i) s += v[r][i][0] * v[r][i][0] + v[r][i][1] * v[r][i][1] + v[r][i][2] * v[r][i][2] + v[r][i][3] * v[r][i][3];
            s = DPP_ADD0(s, 0xB1); s = DPP_ADD0(s, 0x4E); s = DPP_ADD0(s, 0x124); s = DPP_ADD0(s, 0x128);
            { auto q = __builtin_amdgcn_permlane16_swap(__float_as_uint(s), __float_as_uint(s), false, false); s = __uint_as_float(q[0]) + __uint_as_float(q[1]); }
            { auto q = __builtin_amdgcn_permlane32_swap(__float_as_uint(s), __float_as_uint(s), false, false); s = __uint_as_float(q[0]) + __uint_as_float(q[1]); }
            ss[r] = rsqrtf(s * (1.0f / DM) + EPS);
        }
#pragma unroll
        for (int i = 0; i < 4; ++i) {
            const int c = i * 256 + lane * 4;
            const f32x4 gg = *(const f32x4*)(g + c), sc = *(const f32x4*)(mod_scale + (size_t)b * 6144 + c), sh = *(const f32x4*)(mod_shift + (size_t)b * 6144 + c);
            float a[4];
#pragma unroll
            for (int e = 0; e < 4; ++e) a[e] = gg[e] * (1.0f + sc[e]);
#pragma unroll
            for (int r = 0; r < 4; ++r) {
                float y[4];
#pragma unroll
                for (int e = 0; e < 4; ++e) y[e] = v[r][i][e] * ss[r] * a[e] + sh[e];
                u32x2 o; o.x = pk2(y[0], y[1]); o.y = pk2(y[2], y[3]);
                *(u32x2*)(h + (size_t)(t0 + r) * DM + c) = o;
            }
        }
    }
}

namespace pg8 {
#define PG8_LAS __attribute__((address_space(3)))
typedef unsigned short bf16_t;
typedef short bf16x8 __attribute__((ext_vector_type(8)));
constexpr int BM = 256, BK = 64, HALF = 128, HTB = HALF * BK * 2  , STAGE_BYTES = 8 * HTB, NXCD = 8, WGM = 8;

__host__ __device__ __forceinline__ int lds_byte(int r, int c) { const int st = (r >> 4) * 2 + (c >> 5), rr = r & 15, cc = c & 31, ob = rr * 64 + cc * 2; return st * 1024 + (ob ^ (((ob >> 9) & 1) << 5)); }
__host__ __device__ __forceinline__ void stage_rc(int b, int& R, int& C) { const int st = b / 1024, sb = b % 1024, swz = sb ^ (((sb >> 9) & 1) << 5); R = (st >> 1) * 16 + swz / 64; C = (st & 1) * 32 + (swz % 64) / 2; }
__host__ __device__ __forceinline__ int perm32(int rho) { const int n = rho >> 4, i = rho & 15; return 8 * (i >> 2) + 4 * n + (i & 3); }

struct Unit { int pm, pn; };
struct Gemm { const bf16_t* A; const bf16_t* Bt; int M, N, K; };

struct StaticOrder {
    int nM, nN, nwg, G, c;
    __host__ __device__ void init(int M, int N, int G_, int c_) { nM = M / BM; nN = N / BM; nwg = nM * nN; G = G_; c = c_; }
    __host__ __device__ bool next(int i, Unit& u) const {
        const long L = (long)i * G + c; if (L >= nwg) return false;
        int wgid = (int)L; { const int q = nwg / NXCD, r = nwg % NXCD, xcd = wgid % NXCD, off = wgid / NXCD; wgid = (xcd < r ? xcd * (q + 1) : r * (q + 1) + (xcd - r) * q) + off; }
        const int nig = WGM * nN, gid = wgid / nig, fm = gid * WGM, gsz = (nM - fm) < WGM ? (nM - fm) : WGM;
        u.pm = fm + ((wgid % nig) % gsz); u.pn = (wgid % nig) / gsz; return true;
    }
    __device__ __forceinline__ void a_ready(const Unit&) const {}
    __device__ __forceinline__ void done(const Unit&) const {}
};

__device__ __forceinline__ unsigned cvt_pk_bf16(float lo, float hi) { unsigned r; asm volatile("v_cvt_pk_bf16_f32 %0, %1, %2" : "=v"(r) : "v"(lo), "v"(hi)); return r; }

struct EpiStore {
    static constexpr bool PERM = true, AFTER_DRAIN = false;
    bf16_t* O; int ldc;
    __device__ __forceinline__ void operator()(const f32x4 (&acc)[2][2][4][2], const Unit& u, int wr, int wc, int fr, int fq) const {
        const int row0 = u.pm * BM + wr * 64 + fr, col0 = u.pn * BM + wc * 32 + 8 * fq;
#pragma unroll
        for (int ai = 0; ai < 2; ++ai)
#pragma unroll
            for (int m = 0; m < 4; ++m) { bf16_t* rowp = O + (size_t)(row0 + ai * HALF + m * 16) * ldc + col0;
#pragma unroll
                for (int bj = 0; bj < 2; ++bj) { const f32x4 v0 = acc[ai][bj][m][0], v1 = acc[ai][bj][m][1];
                    u32x4 w; w.x = cvt_pk_bf16(v0[0], v0[1]); w.y = cvt_pk_bf16(v0[2], v0[3]); w.z = cvt_pk_bf16(v1[0], v1[1]); w.w = cvt_pk_bf16(v1[2], v1[3]);
                    *(u32x4*)(rowp + bj * HALF) = w; } }
    }
};
struct EpiQKV {
    static constexpr bool PERM = true, AFTER_DRAIN = false;
    bf16_t* O; int ldc; const float* rope; int layer;
    const float* gq0; const float* gk0;
    const float* gq1; const float* gk1;
    float* kmean;
    __device__ __forceinline__ void operator()(const f32x4 (&acc)[2][2][4][2], const Unit& u, int wr, int wc, int fr, int fq) const {
        const int hg = 4 * u.pn + wc;
        const float* gain = nullptr; bool km = false;
        if (layer == 0) { if (hg < 8) gain = gq0; else if (hg < 10) gain = gk0; }
        else { if (hg < 8) gain = gq0; else if (hg < 16) gain = gk0; else if (hg >= 24 && hg < 32) gain = gq1; else if (hg >= 32 && hg < 40) { gain = gk1; km = true; } }
        const int row0 = u.pm * BM + wr * 64 + fr, col0 = 64 * hg + 8 * fq;
        float g0[8], g1[8], cs0[8], cs1[8];
#pragma unroll
        for (int e = 0; e < 8; ++e) { g0[e] = gain ? gain[8 * fq + e] : 1.f; g1[e] = gain ? gain[32 + 8 * fq + e] : 1.f; cs0[e] = 0.f; cs1[e] = 0.f; }
#pragma unroll
        for (int ai = 0; ai < 2; ++ai)
#pragma unroll
            for (int m = 0; m < 4; ++m) {
                const int row = row0 + ai * HALF + m * 16;
                float v0[8], v1[8];
#pragma unroll
                for (int e = 0; e < 4; ++e) { v0[e] = acc[ai][0][m][0][e]; v0[4 + e] = acc[ai][0][m][1][e]; v1[e] = acc[ai][1][m][0][e]; v1[4 + e] = acc[ai][1][m][1][e]; }
                if (gain) {
                    float ss = 0.f;
#pragma unroll
                    for (int e = 0; e < 8; ++e) ss += v0[e] * v0[e] + v1[e] * v1[e];
                    ss += __shfl_xor(ss, 16); ss += __shfl_xor(ss, 32);
                    const float r = rsqrtf(ss * (1.0f / 64.0f) + 1e-6f);
                    const float* rp = rope + ((size_t)(row & 2047) * 32 + 8 * fq) * 2;
                    const f32x4 t0 = *(const f32x4*)(rp), t1 = *(const f32x4*)(rp + 4), t2 = *(const f32x4*)(rp + 8), t3 = *(const f32x4*)(rp + 12);
                    const float cs[8] = {t0[0], t0[2], t1[0], t1[2], t2[0], t2[2], t3[0], t3[2]}, sn[8] = {t0[1], t0[3], t1[1], t1[3], t2[1], t2[3], t3[1], t3[3]};
#pragma unroll
                    for (int e = 0; e < 8; ++e) { const float y0 = v0[e] * r * g0[e], y1 = v1[e] * r * g1[e]; v0[e] = y0 * cs[e] - y1 * sn[e]; v1[e] = y1 * cs[e] + y0 * sn[e]; }
                }
                u32x4 w0, w1;
                w0.x = cvt_pk_bf16(v0[0], v0[1]); w0.y = cvt_pk_bf16(v0[2], v0[3]); w0.z = cvt_pk_bf16(v0[4], v0[5]); w0.w = cvt_pk_bf16(v0[6], v0[7]);
                w1.x = cvt_pk_bf16(v1[0], v1[1]); w1.y = cvt_pk_bf16(v1[2], v1[3]); w1.z = cvt_pk_bf16(v1[4], v1[5]); w1.w = cvt_pk_bf16(v1[6], v1[7]);
                bf16_t* rowp = O + (size_t)row * ldc + col0;
                *(u32x4*)(rowp) = w0; *(u32x4*)(rowp + 32) = w1;
                if (km) {
#pragma unroll
                    for (int e = 0; e < 8; ++e) { cs0[e] += v0[e]; cs1[e] += v1[e]; }
                }
            }
        if (km) {
#pragma unroll
            for (int e = 0; e < 8; ++e) {
#pragma unroll
                for (int o = 1; o < 16; o <<= 1) { cs0[e] += __shfl_xor(cs0[e], o); cs1[e] += __shfl_xor(cs1[e], o); }
            }
            if (fr == 0) {
                float* kp = kmean + ((size_t)((u.pm >> 3) * 8 + (hg - 32)) * 8 + (u.pm & 7)) * 64 + 8 * fq;
#pragma unroll
                for (int e = 0; e < 8; ++e) { atomicAdd(kp + e, cs0[e] * (1.0f / 256.0f)); atomicAdd(kp + 32 + e, cs1[e] * (1.0f / 256.0f)); }
            }
        }
    }
};
struct EpiResid {
    static constexpr bool PERM = true, AFTER_DRAIN = false;
    const float* xin; float* xout; const float* gate;
    __device__ __forceinline__ void operator()(const f32x4 (&acc)[2][2][4][2], const Unit& u, int wr, int wc, int fr, int fq) const {
        const int row0 = u.pm * BM + wr * 64 + fr, col0 = u.pn * BM + wc * 32 + 8 * fq;
#pragma unroll
        for (int ai = 0; ai < 2; ++ai)
#pragma unroll
            for (int m = 0; m < 4; ++m) { const int row = row0 + ai * HALF + m * 16; const float* gp = gate + (size_t)(row >> 11) * 6144 + col0;
                const float* xi = xin + (size_t)row * 1024 + col0; float* xo = xout + (size_t)row * 1024 + col0;
#pragma unroll
                for (int bj = 0; bj < 2; ++bj)
#pragma unroll
                    for (int n = 0; n < 2; ++n) { const f32x4 a = acc[ai][bj][m][n], x = *(const f32x4*)(xi + bj * HALF + 4 * n), g = *(const f32x4*)(gp + bj * HALF + 4 * n);
                        f32x4 o; o[0] = x[0] + g[0] * a[0]; o[1] = x[1] + g[1] * a[1]; o[2] = x[2] + g[2] * a[2]; o[3] = x[3] + g[3] * a[3];
                        *(f32x4*)(xo + bj * HALF + 4 * n) = o; } }
    }
};
template <class Epi, class Sched, bool ALIGN_EPI = false, bool SP2 = false>
__device__ __forceinline__ void gemm_phase(PG8_LAS unsigned char* lds, const Gemm g, const Sched& S, const Epi& E) {
    const int tid = ltid(), wid = __builtin_amdgcn_readfirstlane(tid >> 6), lane = tid & 63, wr = wid >> 2, wc = wid & 3, fr = lane & 15, fq = lane >> 4;
    const int K = g.K, nt = K / BK;
    unsigned voffA[2], voffB[2];
#pragma unroll
    for (int i = 0; i < 2; ++i) { int R, C; stage_rc(tid * 16 + i * 8192, R, C); const int Rb = Epi::PERM ? ((R & ~31) + perm32(R & 31)) : R;
        voffA[i] = (unsigned)(R * K + C) * 2u; voffB[i] = (unsigned)(Rb * K + C) * 2u; }
    const size_t kstep = (size_t)(BK * 2);
    const size_t hstep = (size_t)HALF * K * 2;
    const size_t tstep = 2 * hstep;
    const unsigned ldsw = (unsigned)wid * 1024u;
    const int aoff = lds_byte(wr * 64 + fr, fq * 8), boff = lds_byte(wc * 32 + fr, fq * 8);
#define PG8_SA(b, h) (((b) * 2 + (h)) * HTB)
#define PG8_SB(b, h) ((4 + (b) * 2 + (h)) * HTB)
#define PG8_STAGE(bufoff, gbase, voff) do { _Pragma("unroll") for (int _i = 0; _i < 2; ++_i) \
        __builtin_amdgcn_global_load_lds((const unsigned*)((const char*)(gbase) + (voff)[_i]), (PG8_LAS unsigned*)(lds + (bufoff) + ldsw + _i * 8192), 16, 0, 0); } while (0)
#define PG8_LDA(dst, b, h) do { _Pragma("unroll") for (int m = 0; m < 4; ++m) _Pragma("unroll") for (int k = 0; k < 2; ++k) dst[m][k] = *(const PG8_LAS bf16x8*)(lds + PG8_SA(b, h) + aoff + m * 2048 + k * 1024); } while (0)
#define PG8_LDB(dst, b, h) do { _Pragma("unroll") for (int n = 0; n < 2; ++n) _Pragma("unroll") for (int k = 0; k < 2; ++k) dst[n][k] = *(const PG8_LAS bf16x8*)(lds + PG8_SB(b, h) + boff + n * 2048 + k * 1024); } while (0)
#define PG8_MMA(ai, bj, At, Bt) do { __builtin_amdgcn_s_setprio(1); _Pragma("unroll") for (int m = 0; m < 4; ++m) _Pragma("unroll") for (int n = 0; n < 2; ++n) _Pragma("unroll") for (int k = 0; k < 2; ++k) \
        acc[ai][bj][m][n] = __builtin_amdgcn_mfma_f32_16x16x32_bf16(Bt[n][k], At[m][k], acc[ai][bj][m][n], 0, 0, 0); __builtin_amdgcn_s_setprio(0); } while (0)
#define PG8_WAIT_V(n) asm volatile("s_waitcnt vmcnt(" #n ")" ::: "memory")
#define PG8_WAIT_L(n) asm volatile("s_waitcnt lgkmcnt(" #n ")" ::: "memory")
#define PG8_BAR __builtin_amdgcn_s_barrier()
#define PG8_SCHED __builtin_amdgcn_sched_barrier(0)
    Unit cur, nxt; int ui = 0;
    if (!S.next(0, cur)) return;
    f32x4 acc[2][2][4][2];
#pragma unroll
    for (int a = 0; a < 2; ++a)
#pragma unroll
        for (int b = 0; b < 2; ++b)
#pragma unroll
            for (int m = 0; m < 4; ++m)
#pragma unroll
                for (int n = 0; n < 2; ++n) acc[a][b][m][n] = (f32x4){0.f, 0.f, 0.f, 0.f};
    bf16x8 At[4][2], B0[2][2], B1[2][2];
    const char* cA = (const char*)g.A + (size_t)cur.pm * tstep; const char* cB = (const char*)g.Bt + (size_t)cur.pn * tstep;
    S.a_ready(cur);
    if constexpr (SP2) {
        PG8_STAGE(PG8_SB(0, 0), cB, voffB); PG8_STAGE(PG8_SB(0, 1), cB + hstep, voffB); PG8_STAGE(PG8_SA(0, 0), cA, voffA); PG8_STAGE(PG8_SA(0, 1), cA + hstep, voffA);
        if (wr == 1) PG8_BAR;
        PG8_WAIT_V(2); PG8_BAR;
        PG8_STAGE(PG8_SB(1, 0), cB + kstep, voffB); PG8_STAGE(PG8_SA(1, 0), cA + kstep, voffA); PG8_STAGE(PG8_SB(1, 1), cB + hstep + kstep, voffB);
        PG8_WAIT_V(6); PG8_BAR;
    } else {
        PG8_STAGE(PG8_SB(0, 0), cB, voffB); PG8_STAGE(PG8_SA(0, 0), cA, voffA); PG8_STAGE(PG8_SB(0, 1), cB + hstep, voffB); PG8_STAGE(PG8_SA(0, 1), cA + hstep, voffA);
        if (wr == 1) PG8_BAR;
        PG8_WAIT_V(4); PG8_BAR;
        PG8_STAGE(PG8_SB(1, 0), cB + kstep, voffB); PG8_STAGE(PG8_SA(1, 0), cA + kstep, voffA); PG8_STAGE(PG8_SB(1, 1), cB + hstep + kstep, voffB);
        PG8_WAIT_V(6); PG8_BAR;
    }
    for (;;) {
        const bool has_next = S.next(ui + 1, nxt);
        const char* nA = has_next ? (const char*)g.A + (size_t)nxt.pm * tstep : cA; const char* nB = has_next ? (const char*)g.Bt + (size_t)nxt.pn * tstep : cB;
        for (int t = 0; t < nt; t += 2) {
            const bool last = (t == nt - 2);
            const char* a1 = cA + (size_t)(t + 1) * kstep;
            const char* a2 = last ? nA : cA + (size_t)(t + 2) * kstep; const char* b2 = last ? nB : cB + (size_t)(t + 2) * kstep;
            const char* a3 = a2 + kstep; const char* b3 = b2 + kstep;
            if (last && has_next) S.a_ready(nxt);
            if constexpr (SP2) {
            PG8_LDB(B0, 0, 0); PG8_LDB(B1, 0, 1); PG8_SCHED; PG8_LDA(At, 0, 0); PG8_STAGE(PG8_SA(1, 1), a1 + hstep, voffA);
            PG8_WAIT_V(8); PG8_WAIT_L(0); PG8_BAR; PG8_MMA(0, 0, At, B0); PG8_MMA(0, 1, At, B1); PG8_BAR; PG8_SCHED;
            PG8_LDA(At, 0, 1); PG8_STAGE(PG8_SB(0, 0), b2, voffB); PG8_STAGE(PG8_SB(0, 1), b2 + hstep, voffB); PG8_STAGE(PG8_SA(0, 0), a2, voffA);
            PG8_WAIT_V(8); PG8_WAIT_L(0); PG8_BAR; PG8_MMA(1, 0, At, B0); PG8_MMA(1, 1, At, B1); PG8_BAR; PG8_SCHED;
            PG8_LDB(B0, 1, 0); PG8_LDB(B1, 1, 1); PG8_SCHED; PG8_LDA(At, 1, 0); PG8_STAGE(PG8_SA(0, 1), a2 + hstep, voffA);
            PG8_WAIT_V(8); PG8_WAIT_L(0); PG8_BAR; PG8_MMA(0, 0, At, B0); PG8_MMA(0, 1, At, B1); PG8_BAR; PG8_SCHED;
            PG8_LDA(At, 1, 1); PG8_STAGE(PG8_SB(1, 0), b3, voffB); PG8_STAGE(PG8_SB(1, 1), b3 + hstep, voffB); PG8_STAGE(PG8_SA(1, 0), a3, voffA);
            PG8_WAIT_V(8); PG8_WAIT_L(0); PG8_BAR; PG8_MMA(1, 0, At, B0); PG8_MMA(1, 1, At, B1); PG8_BAR; PG8_SCHED;
            } else {
            PG8_LDB(B0, 0, 0); PG8_SCHED; PG8_LDA(At, 0, 0); PG8_STAGE(PG8_SA(1, 1), a1 + hstep, voffA);
            PG8_WAIT_L(8); PG8_BAR; PG8_WAIT_L(0); PG8_MMA(0, 0, At, B0); PG8_BAR; PG8_SCHED;
            PG8_LDB(B1, 0, 1); PG8_STAGE(PG8_SB(0, 0), b2, voffB);
            PG8_BAR; PG8_WAIT_L(0); PG8_MMA(0, 1, At, B1); PG8_BAR;
            PG8_LDA(At, 0, 1); PG8_STAGE(PG8_SA(0, 0), a2, voffA);
            PG8_BAR; PG8_WAIT_L(0); PG8_MMA(1, 0, At, B0); PG8_BAR; PG8_SCHED;
            PG8_STAGE(PG8_SB(0, 1), b2 + hstep, voffB);
            PG8_WAIT_V(6); PG8_BAR; PG8_MMA(1, 1, At, B1); PG8_BAR;
            PG8_LDB(B0, 1, 0); PG8_SCHED; PG8_LDA(At, 1, 0); PG8_STAGE(PG8_SA(0, 1), a2 + hstep, voffA);
            PG8_WAIT_L(8); PG8_BAR; PG8_WAIT_L(0); PG8_MMA(0, 0, At, B0); PG8_BAR; PG8_SCHED;
            PG8_LDB(B1, 1, 1); PG8_STAGE(PG8_SB(1, 0), b3, voffB);
            PG8_BAR; PG8_WAIT_L(0); PG8_MMA(0, 1, At, B1); PG8_BAR;
            PG8_LDA(At, 1, 1); PG8_STAGE(PG8_SA(1, 0), a3, voffA);
            PG8_BAR; PG8_WAIT_L(0); PG8_MMA(1, 0, At, B0); PG8_BAR; PG8_SCHED;
            PG8_STAGE(PG8_SB(1, 1), b3 + hstep, voffB);
            PG8_WAIT_V(6); PG8_BAR; PG8_MMA(1, 1, At, B1); PG8_BAR;
            }
        }
        if constexpr (ALIGN_EPI) { if (wr == 0) PG8_BAR; }
        if constexpr (!Epi::AFTER_DRAIN) { E(acc, cur, wr, wc, fr, fq); S.done(cur); }
        if (!has_next) break;
#pragma unroll
        for (int a = 0; a < 2; ++a)
#pragma unroll
            for (int b = 0; b < 2; ++b)
#pragma unroll
                for (int m = 0; m < 4; ++m)
#pragma unroll
                    for (int n = 0; n < 2; ++n) acc[a][b][m][n] = (f32x4){0.f, 0.f, 0.f, 0.f};
        cur = nxt; cA = nA; cB = nB; ++ui;
        if constexpr (ALIGN_EPI) { if (wr == 1) PG8_BAR; }
    }
    PG8_WAIT_V(0);
    if constexpr (!ALIGN_EPI) { if (wr == 0) PG8_BAR; }
    PG8_BAR;
    if constexpr (Epi::AFTER_DRAIN) { E.fused(acc, cur, wr, wc, fr, fq, lds, wid, lane); S.done(cur); }
#undef PG8_SA
#undef PG8_SB
#undef PG8_STAGE
#undef PG8_LDA
#undef PG8_LDB
#undef PG8_MMA
#undef PG8_WAIT_V
#undef PG8_WAIT_L
#undef PG8_BAR
#undef PG8_SCHED
}
}

__device__ void ph_qkprep(bf16* qkv, const float* rope, int c0a, int na, const float* ga, int c0b, int nbh, const float* gb, int bid, int nb) {
    const int tid = ltid(), half = tid >> 5, li = tid & 31;
    const int per_tok = na + nbh;
    const size_t nitems = (size_t)MT * per_tok;
    for (size_t it = (size_t)bid * 16 + half; it < nitems; it += (size_t)nb * 16) {
        const int t = (int)(it / per_tok), hs = (int)(it % per_tok);
        const int col = hs < na ? c0a + hs * 64 : c0b + (hs - na) * 64;
        const float* g = hs < na ? ga : gb;
        bf16* p = qkv + (size_t)t * QKV_LD + col;
        const float x1 = bf2f(p[li]), x2 = bf2f(p[li + 32]);
        float ss = x1 * x1 + x2 * x2;
#pragma unroll
        for (int o = 1; o < 32; o <<= 1) ss += __shfl_xor(ss, o);
        const float r = rsqrtf(ss * (1.0f / 64.0f) + EPS);
        const float y1 = x1 * r * g[li], y2 = x2 * r * g[li + 32];
        const int pos = t & (SQ - 1);
        const float cs = rope[(pos * 32 + li) * 2], sn = rope[(pos * 32 + li) * 2 + 1];
        p[li] = (bf16)f2bf(y1 * cs - y2 * sn);
        p[li + 32] = (bf16)f2bf(y2 * cs + y1 * sn);
    }
}

__device__ void ph_kmean(const bf16* qkv, int kcol0, float* kmean, int bid, int nb) {
    const int lane = ltid() & 63, w = __builtin_amdgcn_readfirstlane(ltid() >> 6);
    for (int it = bid * 8 + w; it < 32 * 8 * 8; it += nb * 8) {
        const int blk = it & 7, h = (it >> 3) & 7, b = it >> 6;
        float s = 0.f;
        const bf16* p = qkv + (size_t)(b * SQ + blk * 256) * QKV_LD + kcol0 + h * 64 + lane;
        for (int i = 0; i < 256; ++i) s += bf2f(p[(size_t)i * QKV_LD]);
        kmean[(size_t)it * 64 + lane] = s * (1.0f / 256.0f);
    }
}

typedef float f32x16 __attribute__((ext_vector_type(16)));
typedef short s16x4 __attribute__((ext_vector_type(4)));
typedef short v4i16_t __attribute__((ext_vector_type(4)));
typedef float f32x2_t __attribute__((ext_vector_type(2)));
typedef __bf16 bf16x2_t __attribute__((ext_vector_type(2)));
#define LAS __attribute__((address_space(3)))
constexpr int VROW = 144, VBUF = 32 * VROW;
constexpr int VROWV = 192, VBUFV = 32 * VROWV;
constexpr float L2E = 1.4426950408889634f, LN2 = 0.6931471805599453f;
constexpr float SC2 = 0.125f * L2E;

__device__ __forceinline__ int crow(int r, int hi) { return (r & 3) + 8 * (r >> 2) + 4 * hi; }
__device__ __forceinline__ unsigned cvtpk(float lo, float hi) { f32x2_t v = {lo, hi}; bf16x2_t b = __builtin_convertvector(v, bf16x2_t); return __builtin_bit_cast(unsigned, b); }
__device__ __forceinline__ float xhalf(float v, int hi) {
    auto r = __builtin_amdgcn_permlane32_swap(__float_as_uint(v), __float_as_uint(v), false, false);
    return __uint_as_float(hi ? r[0] : r[1]);
}
__device__ __forceinline__ s16x4 vtr(const LAS unsigned char* p) { return __builtin_bit_cast(s16x4, __builtin_amdgcn_ds_read_tr16_b64_v4i16((LAS v4i16_t*)p)); }

struct KVRegs { u32x4 k[4]; u32x4 v[4]; };
__device__ __forceinline__ void load_kv(KVRegs& R, const bf16* base, int kp0, int kst, int kcol, int vcol, int lane) {
#pragma unroll
    for (int j = 0; j < 4; ++j) {
        const int pos = kp0 + kst * (8 * j + (lane >> 3));
        const int pc = pos < SQ - 1 ? pos : SQ - 1;
        const bf16* rp = base + (size_t)pc * QKV_LD + (lane & 7) * 8;
        R.k[j] = *(const u32x4*)(rp + kcol); R.v[j] = *(const u32x4*)(rp + vcol);
    }
}
__device__ __forceinline__ void kv_stage(const KVRegs& R, LAS unsigned char* klds, LAS unsigned char* vlds, int lane) {
#pragma unroll
    for (int j = 0; j < 4; ++j) { const int r_ = 8 * j + (lane >> 3), c_ = (lane & 7) * 16; *(LAS u32x4*)(klds + r_ * VROW + c_) = R.k[j]; *(LAS u32x4*)(vlds + r_ * VROWV + c_) = R.v[j]; }
}
__device__ __forceinline__ f32x16 qk_tile(const LAS unsigned char* klds, const bf16x8 (&qf)[4], int r32, int hi) {
    f32x16 s = {0.f, 0.f, 0.f, 0.f, 0.f, 0.f, 0.f, 0.f, 0.f, 0.f, 0.f, 0.f, 0.f, 0.f, 0.f, 0.f};
#pragma unroll
    for (int k = 0; k < 4; ++k) { const bf16x8 kf = *(const LAS bf16x8*)(klds + r32 * VROW + (2 * k + hi) * 16); s = __builtin_amdgcn_mfma_f32_32x32x16_bf16(kf, qf[k], s, 0, 0, 0); }
    return s;
}
__device__ __forceinline__ void pv_tile(f32x16 (&o)[2], const f32x16& p, const LAS unsigned char* vlds, int lane) {
    const int g = lane >> 4, i = lane & 15, h = lane >> 5;
    const LAS unsigned char* vb = vlds + (4 * h + (i >> 2)) * VROWV + (16 * (g & 1) + 4 * (i & 3)) * 2;
#pragma unroll
    for (int s = 0; s < 2; ++s) {
        u32x4 pw; pw.x = cvtpk(p[8 * s], p[8 * s + 1]); pw.y = cvtpk(p[8 * s + 2], p[8 * s + 3]); pw.z = cvtpk(p[8 * s + 4], p[8 * s + 5]); pw.w = cvtpk(p[8 * s + 6], p[8 * s + 7]);
        const bf16x8 pb = __builtin_bit_cast(bf16x8, pw);
#pragma unroll
        for (int df = 0; df < 2; ++df) {
            const s16x4 lo = vtr(vb + (16 * s) * VROWV + df * 64), hh = vtr(vb + (16 * s + 8) * VROWV + df * 64);
            const bf16x8 va = (bf16x8){lo[0], lo[1], lo[2], lo[3], hh[0], hh[1], hh[2], hh[3]};
            o[df] = __builtin_amdgcn_mfma_f32_32x32x16_bf16(va, pb, o[df], 0, 0, 0);
        }
    }
}
__device__ __forceinline__ void load_q(bf16x8 (&qf)[4], const bf16* base, int qpos, int qcol, int hi) {
    const bf16* rp = base + (size_t)qpos * QKV_LD + qcol + 8 * hi;
#pragma unroll
    for (int k = 0; k < 4; ++k) qf[k] = *(const bf16x8*)(rp + 16 * k);
}
__device__ __forceinline__ void store_o(bf16* yrow, const f32x16 (&o)[2], float inv, int hi) {
#pragma unroll
    for (int df = 0; df < 2; ++df)
#pragma unroll
        for (int g = 0; g < 4; ++g) {
            u32x2 w; w.x = cvtpk(o[df][4 * g] * inv, o[df][4 * g + 1] * inv); w.y = cvtpk(o[df][4 * g + 2] * inv, o[df][4 * g + 3] * inv);
            *(u32x2*)(yrow + 32 * df + 8 * g + 4 * hi) = w;
        }
}
__device__ __forceinline__ void osm_tile(f32x16& s, float& m, float& l, f32x16 (&o)[2]) {
    float mx = s[0];
#pragma unroll
    for (int r = 1; r < 16; ++r) mx = fmaxf(mx, s[r]);
    { auto rr = __builtin_amdgcn_permlane32_swap(__float_as_uint(mx), __float_as_uint(mx), false, false); mx = fmaxf(__uint_as_float(rr[0]), __uint_as_float(rr[1])); }
    const float mn = fmaxf(m, mx);
    const float ms = (mn == -INFINITY) ? 0.f : mn;
    const float alpha = __builtin_amdgcn_exp2f((m - ms) * SC2);
    const float mc = ms * SC2;
    float ps = 0.f;
#pragma unroll
    for (int r = 0; r < 16; ++r) { s[r] = __builtin_amdgcn_exp2f(s[r] * SC2 - mc); ps += s[r]; }
    l = l * alpha + ps; m = mn;
    if (!__all(alpha == 1.0f)) {
#pragma unroll
        for (int df = 0; df < 2; ++df)
#pragma unroll
            for (int r = 0; r < 16; ++r) o[df][r] *= alpha;
    }
}
__device__ __forceinline__ void osm_tile2(f32x16& s0, f32x16& s1, float& m, float& l, f32x16 (&o)[2]) {
    float mx = fmaxf(s0[0], s1[0]);
#pragma unroll
    for (int r = 1; r < 16; ++r) mx = fmaxf(mx, fmaxf(s0[r], s1[r]));
    { auto rr = __builtin_amdgcn_permlane32_swap(__float_as_uint(mx), __float_as_uint(mx), false, false); mx = fmaxf(__uint_as_float(rr[0]), __uint_as_float(rr[1])); }
    const float mn = fmaxf(m, mx);
    const float ms = (mn == -INFINITY) ? 0.f : mn;
    const float alpha = __builtin_amdgcn_exp2f((m - ms) * SC2);
    const float mc = ms * SC2;
    float ps0 = 0.f, ps1 = 0.f;
#pragma unroll
    for (int r = 0; r < 16; ++r) { s0[r] = __builtin_amdgcn_exp2f(s0[r] * SC2 - mc); ps0 += s0[r]; s1[r] = __builtin_amdgcn_exp2f(s1[r] * SC2 - mc); ps1 += s1[r]; }
    l = l * alpha + (ps0 + ps1); m = mn;
    if (!__all(alpha == 1.0f)) {
#pragma unroll
        for (int df = 0; df < 2; ++df)
#pragma unroll
            for (int r = 0; r < 16; ++r) o[df][r] *= alpha;
    }
}
#define ZERO16 {0.f, 0.f, 0.f, 0.f, 0.f, 0.f, 0.f, 0.f, 0.f, 0.f, 0.f, 0.f, 0.f, 0.f, 0.f, 0.f}

struct AttnCtx {
    const bf16* base; int kcol, vcol, r32, hi, lane; LAS unsigned char* vlds; LAS unsigned char* klds; bf16x8 qf[4]; f32x16 o[2];
};
#define ATTN_STEP(SC, SL, T) { \
        if (SYNC) __builtin_amdgcn_s_barrier(); \
        { int kp_, ks_; const int tl_ = (T) + 2 < nt ? (T) + 2 : nt - 1; mx.pos(tl_, kp_, ks_); load_kv(SL, c.base, kp_, ks_, c.kcol, c.vcol, c.lane); } \
        kv_stage(SC, c.klds, c.vlds, c.lane); f32x16 s_ = qk_tile(c.klds, c.qf, c.r32, c.hi); \
        const bool stop_ = mx.process((T), s_, c); pv_tile(c.o, s_, c.vlds, c.lane); \
        if ((!SYNC && stop_) || (T) + 1 >= nt) break; }
template <class M, bool SYNC> __device__ __forceinline__ void attn_run(M& mx, AttnCtx& c) {
    const int nt = mx.nt;
    KVRegs S0, S1, S2;
    { int kp, ks; mx.pos(0, kp, ks); load_kv(S0, c.base, kp, ks, c.kcol, c.vcol, c.lane);
      mx.pos(1 < nt ? 1 : nt - 1, kp, ks); load_kv(S1, c.base, kp, ks, c.kcol, c.vcol, c.lane); }
    for (int t = 0;; t += 3) {
        ATTN_STEP(S0, S2, t)
        ATTN_STEP(S1, S0, t + 1)
        ATTN_STEP(S2, S1, t + 2)
    }
}
#define SH_BAR() asm volatile("s_waitcnt lgkmcnt(0)\n\ts_barrier" ::: "memory")
constexpr int SLOT_K = 64 * VROW, SLOT_BYTES = 64 * VROW + 64 * VROWV;
struct ShRegs { u32x4 a, b; };
__device__ __forceinline__ void sh_load(ShRegs& R, const bf16* base, int kp0, int kcol, int vcol, int w, int lane) {
    const int pos = kp0 + 4 * w + ((lane & 31) >> 3);
    const int pa = pos < SQ - 1 ? pos : SQ - 1, pb = pos + 32 < SQ - 1 ? pos + 32 : SQ - 1;
    const int col = ((lane >> 5) ? vcol : kcol) + (lane & 7) * 8;
    R.a = *(const u32x4*)(base + (size_t)pa * QKV_LD + col); R.b = *(const u32x4*)(base + (size_t)pb * QKV_LD + col);
}
__device__ __forceinline__ void sh_write(LAS unsigned char* slot, const ShRegs& R, int w, int lane) {
    const int row = 4 * w + ((lane & 31) >> 3);
    LAS unsigned char* p = slot + ((lane >> 5) ? SLOT_K + row * VROWV : row * VROW) + (lane & 7) * 16;
    *(LAS u32x4*)p = R.a; *(LAS u32x4*)(p + 32 * ((lane >> 5) ? VROWV : VROW)) = R.b;
}
#define SH_STEP(RW, RL, T) { \
        SH_BAR(); \
        { const int tl_ = (T) + 2 < nt ? (T) + 2 : nt - 1; sh_load(RL, c.base, mx.pos2(tl_), c.kcol, c.vcol, w, c.lane); } \
        sh_write(slots + (((T) + 1) & 1) * SLOT_BYTES, RW, w, c.lane); \
        if (mx.active2((T), w)) { LAS unsigned char* sl_ = slots + ((T) & 1) * SLOT_BYTES; \
            f32x16 s0_ = qk_tile(sl_, c.qf, c.r32, c.hi), s1_ = qk_tile(sl_ + 32 * VROW, c.qf, c.r32, c.hi); mx.process2((T), s0_, s1_, c); \
            pv_tile(c.o, s0_, sl_ + SLOT_K, c.lane); pv_tile(c.o, s1_, sl_ + SLOT_K + 32 * VROWV, c.lane); } \
        if ((T) + 1 >= nt) break; }
template <class M> __device__ __forceinline__ void attn_run_shared(M& mx, AttnCtx& c, LAS unsigned char* slots, int w) {
    const int nt = mx.nt2;
    ShRegs R0, R1, R2;
    sh_load(R0, c.base, mx.pos2(0), c.kcol, c.vcol, w, c.lane);
    sh_load(R1, c.base, mx.pos2(1 < nt ? 1 : nt - 1), c.kcol, c.vcol, w, c.lane);
    SH_BAR();
    sh_write(slots, R0, w, c.lane);
    for (int t = 0;; t += 3) {
        SH_STEP(R1, R2, t)
        SH_STEP(R2, R0, t + 1)
        SH_STEP(R0, R1, t + 2)
    }
}
struct MixA {
    int nt, k00, qpos; float m, l;
    __device__ __forceinline__ void pos(int idx, int& kp0, int& kst) const { kp0 = k00 + 32 * idx; kst = 1; }
    __device__ __forceinline__ bool process(int idx, f32x16& s, AttnCtx& c) {
        const int k0 = k00 + 32 * idx;
#pragma unroll
        for (int r = 0; r < 16; ++r) { const int dist = qpos - (k0 + crow(r, c.hi)); if (dist < 0 || dist > 127) s[r] = -INFINITY; }
        osm_tile(s, m, l, c.o); return false;
    }
};
__device__ void attn_A(const bf16* base, int hq, int q0, float sink, bf16* ybase, LAS unsigned char* vlds, int lane) {
    AttnCtx c; c.base = base; c.r32 = lane & 31; c.hi = lane >> 5; c.lane = lane; c.vlds = vlds; c.klds = vlds + VBUFV; c.kcol = 512 + (hq >> 2) * 64; c.vcol = 640 + (hq >> 2) * 64;
    c.o[0] = (f32x16)ZERO16; c.o[1] = (f32x16)ZERO16;
    MixA mx; mx.qpos = q0 + c.r32; mx.k00 = q0 - 128 > 0 ? q0 - 128 : 0; mx.nt = 5; mx.m = -INFINITY; mx.l = 0.f;
    load_q(c.qf, base, mx.qpos, hq * 64, c.hi);
    attn_run<MixA, true>(mx, c);
    float l = mx.l + xhalf(mx.l, c.hi);
    l += __builtin_amdgcn_exp2f(sink * L2E - mx.m * SC2);
    store_o(ybase + (size_t)mx.qpos * DM + hq * 64, c.o, 1.0f / l, c.hi);
}
struct MixB {
    int nt, q0, qpos; float carry;
    __device__ __forceinline__ void pos(int idx, int& kp0, int& kst) const { kp0 = q0 - 32 * idx; kst = 1; }
    __device__ __forceinline__ bool process(int idx, f32x16& s, AttnCtx& c) {
        const int k0 = q0 - 32 * idx, hi = c.hi;
        float lk[16], G[4], Gp[4];
#pragma unroll
        for (int r = 0; r < 16; ++r) {
            const float z = s[r] * 0.125f;
            const bool valid = (k0 + crow(r, hi)) < qpos;
            const float sp = fmaxf(z, 0.f) + LN2 * __builtin_amdgcn_logf(1.0f + __builtin_amdgcn_exp2f(-fabsf(z) * L2E));
            lk[r] = valid ? -sp : 0.f;
            s[r] = valid ? (z - sp) : -INFINITY;
        }
#pragma unroll
        for (int g = 0; g < 4; ++g) { G[g] = (lk[4 * g] + lk[4 * g + 1]) + (lk[4 * g + 2] + lk[4 * g + 3]); Gp[g] = xhalf(G[g], hi); }
        float above = carry;
#pragma unroll
        for (int g = 3; g >= 0; --g) {
            float off = above + (hi == 0 ? Gp[g] : 0.f);
            s[4 * g + 3] = __builtin_amdgcn_exp2f((s[4 * g + 3] + off) * L2E); off += lk[4 * g + 3];
            s[4 * g + 2] = __builtin_amdgcn_exp2f((s[4 * g + 2] + off) * L2E); off += lk[4 * g + 2];
            s[4 * g + 1] = __builtin_amdgcn_exp2f((s[4 * g + 1] + off) * L2E); off += lk[4 * g + 1];
            s[4 * g + 0] = __builtin_amdgcn_exp2f((s[4 * g + 0] + off) * L2E);
            above += G[g] + Gp[g];
        }
        carry = above;
        return __all(carry < -40.0f) != 0;
    }
};
__device__ void attn_B(const bf16* base, int h, int q0, bf16* ybase, LAS unsigned char* vlds, int lane) {
    AttnCtx c; c.base = base; c.r32 = lane & 31; c.hi = lane >> 5; c.lane = lane; c.vlds = vlds; c.klds = vlds + VBUFV; c.kcol = 1280 + h * 64; c.vcol = 1792 + h * 64;
    c.o[0] = (f32x16)ZERO16; c.o[1] = (f32x16)ZERO16;
    MixB mx; mx.q0 = q0; mx.qpos = q0 + c.r32; mx.nt = q0 / 32 + 1; mx.carry = 0.f;
    load_q(c.qf, base, mx.qpos, 768 + h * 64, c.hi);
    attn_run<MixB, false>(mx, c);
    store_o(ybase + (size_t)mx.qpos * DM + 512 + h * 64, c.o, 1.0f, c.hi);
}
struct MixCp {
    int nt, n0, r0, j1lo, qpos; float m, l;
    __device__ __forceinline__ void pos(int t, int& kp0, int& kst) const {
        if (t < n0) { kp0 = r0 + 512 * t; kst = 16; } else { kp0 = (r0 & 3) + 4 * (j1lo + 32 * (t - n0)); kst = 4; }
    }
    __device__ __forceinline__ bool process(int t, f32x16& s, AttnCtx& c) {
        int kp0, kst; pos(t, kp0, kst);
        const int win = t < n0 ? 2048 : 512;
#pragma unroll
        for (int r = 0; r < 16; ++r) { const int dist = qpos - (kp0 + kst * crow(r, c.hi)); if (dist < 0 || dist > win) s[r] = -INFINITY; }
        osm_tile(s, m, l, c.o); return false;
    }
};
struct MixC1 {
    int nt2, p0, qpos; float m, l;
    __device__ __forceinline__ int pos2(int T) const { return p0 + 64 * T; }
    __device__ __forceinline__ bool active2(int T, int w) const { return true; }
    __device__ __forceinline__ void process2(int T, f32x16& s0, f32x16& s1, AttnCtx& c) {
        const int k0 = p0 + 64 * T;
#pragma unroll
        for (int r = 0; r < 16; ++r) { const int dist = qpos - (k0 + crow(r, c.hi)); if (dist < 0 || dist > 128) s0[r] = -INFINITY; if (dist < 32 || dist > 160) s1[r] = -INFINITY; }
        osm_tile2(s0, s1, m, l, c.o);
    }
};
__device__ void attn_C(const bf16* base, int h, int r0, int g, bf16* ybase, LAS unsigned char* vlds, LAS unsigned char* xlds, int w, int lane) {
    AttnCtx c; c.base = base; c.r32 = lane & 31; c.hi = lane >> 5; c.lane = lane; c.vlds = vlds; c.klds = vlds + VBUFV; c.kcol = 512 + h * 64; c.vcol = 1024 + h * 64;
    c.o[0] = (f32x16)ZERO16; c.o[1] = (f32x16)ZERO16;
    const int qpos = r0 + 16 * (32 * g + c.r32);
    load_q(c.qf, base, qpos, h * 64, c.hi);
    MixCp mp; mp.r0 = r0; mp.qpos = qpos; mp.m = -INFINITY; mp.l = 0.f;
    mp.n0 = g + 1;
    mp.j1lo = (r0 >> 2) + 128 * g - 128 > 0 ? (r0 >> 2) + 128 * g - 128 : 0;
    mp.nt = mp.n0 + ((r0 >> 2) + 128 * g + 124 - mp.j1lo) / 32 + 1;
    attn_run<MixCp, true>(mp, c);
    MixC1 m1; m1.qpos = qpos; m1.m = mp.m; m1.l = mp.l;
    const int ra = r0 & 8;
    m1.p0 = 512 * g + ra - 128 > 0 ? 512 * g + ra - 128 : 0;
    m1.nt2 = ((512 * g + ra + 7 + 496 - m1.p0) / 32 + 2) / 2;
    attn_run_shared<MixC1>(m1, c, xlds + 64, w);
    const float l = m1.l + xhalf(m1.l, c.hi);
    store_o(ybase + (size_t)qpos * DM + h * 64, c.o, 1.0f / l, c.hi);
}
struct MixD {
    int nt, nt2, npast, own, q0, qpos; unsigned U, sel; float m, l;
    __device__ __forceinline__ int blk_of(int j) const {
        unsigned u = U; int b = 0;
#pragma unroll
        for (int i = 0; i < 7; ++i) { if (i < j) u &= u - 1u; }
        b = __builtin_ctz(u | 0x100u); return b;
    }
    __device__ __forceinline__ void pos(int t, int& kp0, int& kst) const {
        kst = 1;
        if (t < 8 * npast) kp0 = blk_of(t >> 3) * 256 + (t & 7) * 32; else kp0 = own * 256 + (t - 8 * npast) * 32;
    }
    __device__ __forceinline__ int pos2(int T) const { int kp, ks; pos(2 * T, kp, ks); return kp; }
    __device__ __forceinline__ bool active2(int T, int w) const { return T < 4 * npast || 2 * (T - 4 * npast) <= w; }
    __device__ __forceinline__ void process2(int T, f32x16& s0, f32x16& s1, AttnCtx& c) {
        if (T < 4 * npast) {
            const int blk = blk_of(T >> 2);
            if (!((sel >> blk) & 1u)) {
#pragma unroll
                for (int r = 0; r < 16; ++r) { s0[r] = -INFINITY; s1[r] = -INFINITY; }
            }
        } else {
            const int k0 = own * 256 + (T - 4 * npast) * 64;
#pragma unroll
            for (int r = 0; r < 16; ++r) { const int kk = k0 + crow(r, c.hi); if (kk > qpos) s0[r] = -INFINITY; if (kk + 32 > qpos) s1[r] = -INFINITY; }
        }
        osm_tile2(s0, s1, m, l, c.o);
    }
};
__device__ void attn_D(const bf16* base, const float* kmean  , int h, int q0, bf16* ybase, LAS unsigned char* vlds, LAS unsigned char* xlds, int lane) {
    AttnCtx c; c.base = base; c.r32 = lane & 31; c.hi = lane >> 5; c.lane = lane; c.vlds = vlds; c.klds = vlds + VBUFV; c.kcol = 2048 + h * 64; c.vcol = 2560 + h * 64;
    c.o[0] = (f32x16)ZERO16; c.o[1] = (f32x16)ZERO16;
    const int r32 = c.r32, hi = c.hi, own = q0 >> 8;
    MixD mx; mx.own = own; mx.q0 = q0; mx.qpos = q0 + r32; mx.m = -INFINITY; mx.l = 0.f;
    load_q(c.qf, base, mx.qpos, 1536 + h * 64, hi);
    unsigned sel = 0u;
    if (own > 0) {
        bf16x8 kf[4];
#pragma unroll
        for (int k = 0; k < 4; ++k) {
            u32x4 w = {0u, 0u, 0u, 0u};
            if (r32 < 8) { const float* kp = kmean + r32 * 64 + 16 * k + 8 * hi; const f32x4 a = *(const f32x4*)kp, b = *(const f32x4*)(kp + 4);
                w.x = cvtpk(a[0], a[1]); w.y = cvtpk(a[2], a[3]); w.z = cvtpk(b[0], b[1]); w.w = cvtpk(b[2], b[3]); }
            kf[k] = __builtin_bit_cast(bf16x8, w);
        }
        f32x16 gs = ZERO16;
#pragma unroll
        for (int k = 0; k < 4; ++k) gs = __builtin_amdgcn_mfma_f32_32x32x16_bf16(kf[k], c.qf[k], gs, 0, 0, 0);
        float gt[8];
#pragma unroll
        for (int r = 0; r < 4; ++r) { const float mine = gs[r], oth = xhalf(mine, hi); gt[r] = hi == 0 ? mine : oth; gt[4 + r] = hi == 0 ? oth : mine; }
        const int nsel = own < 3 ? own : 3;
        for (int rr = 0; rr < nsel; ++rr) {
            float best = -INFINITY; int bi = -1;
#pragma unroll
            for (int n = 0; n < 8; ++n) { const bool ok = n < own && !((sel >> n) & 1u) && (bi < 0 || gt[n] > best); if (ok) { best = gt[n]; bi = n; } }
            if (bi >= 0) sel |= 1u << bi;
        }
    }
    unsigned U = 0u;
#pragma unroll
    for (int n = 0; n < 8; ++n) if (__ballot((sel >> n) & 1u) != 0ull) U |= 1u << n;
    {
        volatile LAS unsigned* ux = (volatile LAS unsigned*)xlds;
        __builtin_amdgcn_s_barrier();
        if (lane == 0) ux[(q0 >> 5) & 7] = U;
        asm volatile("s_waitcnt lgkmcnt(0)" ::: "memory");
        __builtin_amdgcn_s_barrier();
        U = ux[0] | ux[1] | ux[2] | ux[3] | ux[4] | ux[5] | ux[6] | ux[7];
        U = __builtin_amdgcn_readfirstlane(U);
    }
    mx.U = U; mx.sel = sel; mx.npast = __builtin_popcount(U); mx.nt = 8 * mx.npast + 8; mx.nt2 = 4 * mx.npast + 4;
    attn_run_shared<MixD>(mx, c, xlds + 64, (q0 >> 5) & 7);
    const float l = mx.l + xhalf(mx.l, c.hi);
    store_o(ybase + (size_t)mx.qpos * DM + 512 + h * 64, c.o, 1.0f / l, hi);
}

__device__ void ph_attn0(const bf16* qkv, const float* sinks, bf16* y, LAS unsigned char* lds, int bid, int nb) {
    const int lane = ltid() & 63, w = __builtin_amdgcn_readfirstlane(ltid() >> 6);
    LAS unsigned char* vlds = lds + w * (VBUF + VBUFV);
    for (int pid = bid; pid < NB * 8; pid += nb) {
        const int b = pid >> 3, h = pid & 7;
        const bf16* base = qkv + (size_t)b * SQ * QKV_LD; bf16* ybase = y + (size_t)b * SQ * DM;
        const float sink = sinks[h];
        for (int rd = 0; rd < 8; ++rd) attn_A(base, h, (rd * 8 + w) * 32, sink, ybase, vlds, lane);
        for (int rd = 0; rd < 8; ++rd) attn_B(base, h, (rd * 8 + w) * 32, ybase, vlds, lane);
    }
}
__device__ void ph_attn1(const bf16* qkv, const float* kmean, bf16* y, LAS unsigned char* lds, int bid, int nb) {
    const int lane = ltid() & 63, w = __builtin_amdgcn_readfirstlane(ltid() >> 6);
    LAS unsigned char* vlds = lds + w * (VBUF + VBUFV);
    for (int pid = bid; pid < NB * 8; pid += nb) {
        const int b = pid >> 3, h = pid & 7;
        const bf16* base = qkv + (size_t)b * SQ * QKV_LD; bf16* ybase = y + (size_t)b * SQ * DM;
        for (int rd = 0; rd < 8; ++rd) { const int it = rd * 8 + w; attn_C(base, h, it & 15, it >> 4, ybase, vlds, lds + 8 * (VBUF + VBUFV), w, lane); }
        for (int rd = 0; rd < 8; ++rd) attn_D(base, kmean + (size_t)pid * 8 * 64, h, (rd * 8 + w) * 32, ybase, vlds, lds + 8 * (VBUF + VBUFV), lane);
    }
}

#define CE_D(a, b) { const float hi_ = fmaxf((a), (b)), lo_ = fminf((a), (b)); (a) = hi_; (b) = lo_; }
#define BSTAGE(arr, k, j) _Pragma("unroll") for (int i_ = 0; i_ < 16; ++i_) { const int l_ = i_ ^ (j); if (l_ > i_) { if ((i_ & (k)) == 0) CE_D(arr[i_], arr[l_]) else CE_D(arr[l_], arr[i_]) } }
__device__ __forceinline__ void bsort16(float (&a)[16]) {
    BSTAGE(a, 2, 1) BSTAGE(a, 4, 2) BSTAGE(a, 4, 1) BSTAGE(a, 8, 4) BSTAGE(a, 8, 2) BSTAGE(a, 8, 1) BSTAGE(a, 16, 8) BSTAGE(a, 16, 4) BSTAGE(a, 16, 2) BSTAGE(a, 16, 1)
}
__device__ __forceinline__ void bmerge16(float (&a)[16]) {
    BSTAGE(a, 16, 8) BSTAGE(a, 16, 4) BSTAGE(a, 16, 2) BSTAGE(a, 16, 1)
}
__device__ __forceinline__ void merge_top16(float (&a)[16], const float (&b)[16]) {
#pragma unroll
    for (int i = 0; i < 16; ++i) a[i] = fmaxf(a[i], b[15 - i]);
    bmerge16(a);
}
__device__ __forceinline__ void xmerge16(float (&a)[16]) {
    {
        float A[16], B[16];
#pragma unroll
        for (int i = 0; i < 16; ++i) { auto r = __builtin_amdgcn_permlane16_swap(__float_as_uint(a[i]), __float_as_uint(a[i]), false, false); A[i] = __uint_as_float(r[0]); B[i] = __uint_as_float(r[1]); }
#pragma unroll
        for (int i = 0; i < 16; ++i) a[i] = fmaxf(A[i], B[15 - i]);
        bmerge16(a);
    }
    {
        float A[16], B[16];
#pragma unroll
        for (int i = 0; i < 16; ++i) { auto r = __builtin_amdgcn_permlane32_swap(__float_as_uint(a[i]), __float_as_uint(a[i]), false, false); A[i] = __uint_as_float(r[0]); B[i] = __uint_as_float(r[1]); }
#pragma unroll
        for (int i = 0; i < 16; ++i) a[i] = fmaxf(A[i], B[15 - i]);
        bmerge16(a);
    }
}
__host__ __device__ constexpr int pair_i(int id) {
    int c = 0;
    for (int i = 0; i < 16; ++i) { const int nj = 16 / (i + 1); if (id < c + nj) return i; c += nj; }
    return 0;
}
__host__ __device__ constexpr int pair_j(int id) {
    int c = 0;
    for (int i = 0; i < 16; ++i) { const int nj = 16 / (i + 1); if (id < c + nj) return id - c; c += nj; }
    return 0;
}
constexpr int SK_ROW = 272;
constexpr int SEL_SK_BYTES = 2 * 128 * SK_ROW;
constexpr int SEL_TAB_OFF = SEL_SK_BYTES;
constexpr int SEL_IDX_OFF = SEL_SK_BYTES + 64;

template <int S> __device__ __forceinline__ float cand_slot(const float (&L1)[16], const float (&L2)[16], int g) {
    constexpr int p0 = S, p1 = 16 + S, p2 = 32 + S, p3 = 48 + S;
    const float c0 = L1[pair_i(p0)] + L2[pair_j(p0)], c1 = L1[pair_i(p1)] + L2[pair_j(p1)], c2 = L1[pair_i(p2)] + L2[pair_j(p2)];
    const float c3 = p3 < 50 ? L1[pair_i(p3 < 50 ? p3 : 0)] + L2[pair_j(p3 < 50 ? p3 : 0)] : -1.0e30f;
    const float c = g == 0 ? c0 : (g == 1 ? c1 : (g == 2 ? c2 : c3));
    return __uint_as_float((__float_as_uint(c) & 0xffffffc0u) | (unsigned)(16 * g + S));
}

__device__ void ph_peer_select(const bf16* qry, const float* subkeys  , int* eidx, float* egate, LAS unsigned char* lds, int bid, int nb) {
    const int tid = ltid(), lane = tid & 63, w = __builtin_amdgcn_readfirstlane(tid >> 6);
    const int tk = lane & 15, g = lane >> 4;
    __syncthreads();
    for (int e = tid; e < 2 * 128 * 128 / 2; e += NT) {
        const int row = e >> 6, c2 = (e & 63) * 2;
        const float a = subkeys[(size_t)row * 128 + c2], b = subkeys[(size_t)row * 128 + c2 + 1];
        *(LAS unsigned*)(lds + row * SK_ROW + c2 * 2) = pk2(a, b);
    }
    if (tid < 64) { int id = tid; int c = 0, pi = 0, pj = 0;
        for (int i = 0; i < 16; ++i) { const int nj = 16 / (i + 1); if (id >= c && id < c + nj) { pi = i; pj = id - c; } c += nj; }
        lds[SEL_TAB_OFF + tid] = (unsigned char)((pi << 4) | pj); }
    __syncthreads();
    LAS unsigned* widx = (LAS unsigned*)(lds + SEL_IDX_OFF + w * 512);
    const LAS unsigned char* widx8 = (const LAS unsigned char*)widx;
    const int nitems = (MT / 16) * 8;
    for (int it = bid * 8 + w; it < nitems; it += nb * 8) {
        const int h = it & 7, t0 = (it >> 3) * 16;
        float L[2][16];
#pragma unroll
        for (int hf = 0; hf < 2; ++hf) {
            bf16x8 qf[4];
            const bf16* qp = qry + (size_t)(t0 + tk) * PQ + h * 256 + hf * 128 + 8 * g;
#pragma unroll
            for (int ks = 0; ks < 4; ++ks) qf[ks] = *(const bf16x8*)(qp + 32 * ks);
            float key[32];
#pragma unroll
            for (int tile = 0; tile < 8; ++tile) {
                f32x4 acc = {0.f, 0.f, 0.f, 0.f};
#pragma unroll
                for (int ks = 0; ks < 4; ++ks) {
                    const bf16x8 af = *(const LAS bf16x8*)(lds + (hf * 128 + tile * 16 + tk) * SK_ROW + (32 * ks + 8 * g) * 2);
                    acc = __builtin_amdgcn_mfma_f32_16x16x32_bf16(af, qf[ks], acc, 0, 0, 0);
                }
#pragma unroll
                for (int r = 0; r < 4; ++r) key[tile * 4 + r] = __uint_as_float((__float_as_uint(acc[r]) & 0xffffff80u) | (unsigned)(16 * tile + 4 * g + r));
            }
            float a[16], b[16];
#pragma unroll
            for (int i = 0; i < 16; ++i) { a[i] = key[i]; b[i] = key[16 + i]; }
            bsort16(a); bsort16(b);
            merge_top16(a, b);
            xmerge16(a);
#pragma unroll
            for (int i = 0; i < 16; ++i) L[hf][i] = a[i];
            unsigned pk = 0u;
#pragma unroll
            for (int s = 0; s < 4; ++s) {
                const float v = g == 0 ? a[s] : (g == 1 ? a[4 + s] : (g == 2 ? a[8 + s] : a[12 + s]));
                pk |= (__float_as_uint(v) & 127u) << (8 * s);
            }
            widx[tk * 8 + hf * 4 + g] = pk;
        }
        float c[16];
        c[0] = cand_slot<0>(L[0], L[1], g); c[1] = cand_slot<1>(L[0], L[1], g); c[2] = cand_slot<2>(L[0], L[1], g); c[3] = cand_slot<3>(L[0], L[1], g);
        c[4] = cand_slot<4>(L[0], L[1], g); c[5] = cand_slot<5>(L[0], L[1], g); c[6] = cand_slot<6>(L[0], L[1], g); c[7] = cand_slot<7>(L[0], L[1], g);
        c[8] = cand_slot<8>(L[0], L[1], g); c[9] = cand_slot<9>(L[0], L[1], g); c[10] = cand_slot<10>(L[0], L[1], g); c[11] = cand_slot<11>(L[0], L[1], g);
        c[12] = cand_slot<12>(L[0], L[1], g); c[13] = cand_slot<13>(L[0], L[1], g); c[14] = cand_slot<14>(L[0], L[1], g); c[15] = cand_slot<15>(L[0], L[1], g);
        bsort16(c);
        xmerge16(c);
        float sum = 0.f, ex[16];
#pragma unroll
        for (int i = 0; i < 16; ++i) { ex[i] = __builtin_amdgcn_exp2f((c[i] - c[0]) * L2E); sum += ex[i]; }
        const float inv = 1.0f / sum;
        int oi[4]; float og[4];
#pragma unroll
        for (int s = 0; s < 4; ++s) {
            const float kv = g == 0 ? c[s] : (g == 1 ? c[4 + s] : (g == 2 ? c[8 + s] : c[12 + s]));
            const float ev = g == 0 ? ex[s] : (g == 1 ? ex[4 + s] : (g == 2 ? ex[8 + s] : ex[12 + s]));
            const unsigned pid = __float_as_uint(kv) & 63u;
            const unsigned ij = lds[SEL_TAB_OFF + pid];
            const unsigned i1 = widx8[tk * 32 + (ij >> 4)], i2 = widx8[tk * 32 + 16 + (ij & 15u)];
            oi[s] = (int)(i1 * 128u + i2); og[s] = ev * inv;
        }
        const size_t ob = (size_t)(t0 + tk) * 128 + h * 16 + 4 * g;
        *(u32x4*)(eidx + ob) = (u32x4){(unsigned)oi[0], (unsigned)oi[1], (unsigned)oi[2], (unsigned)oi[3]};
        *(f32x4*)(egate + ob) = (f32x4){og[0], og[1], og[2], og[3]};
    }
    __syncthreads();
}

typedef float v32f_t __attribute__((ext_vector_type(32)));
typedef unsigned v6u_t __attribute__((ext_vector_type(6)));
typedef unsigned v16u_t __attribute__((ext_vector_type(16)));
typedef __bf16 v32bf_t __attribute__((ext_vector_type(32)));
typedef __bf16 v2bf_t __attribute__((ext_vector_type(2)));
typedef _Float16 v32h_t __attribute__((ext_vector_type(32)));
typedef unsigned u32x3 __attribute__((ext_vector_type(3)));
constexpr int TROW = 768;
__device__ void ph_tab_fp6(const float* src, unsigned char* dst, float* scale, int nrows, int bid, int nb) {
    const int lane = ltid() & 63, w = __builtin_amdgcn_readfirstlane(ltid() >> 6);
    for (int rp = bid * 8 + w; rp < nrows / 2; rp += nb * 8) {
        v32h_t hv; float sc[2];
#pragma unroll
        for (int rr = 0; rr < 2; ++rr) {
            const float* sp = src + (size_t)(2 * rp + rr) * DM + lane * 16;
            f32x4 v[4]; float am = 0.f;
#pragma unroll
            for (int i = 0; i < 4; ++i) { v[i] = *(const f32x4*)(sp + i * 4); am = fmaxf(am, fmaxf(fmaxf(fabsf(v[i][0]), fabsf(v[i][1])), fmaxf(fabsf(v[i][2]), fabsf(v[i][3])))); }
#pragma unroll
            for (int o = 1; o < 64; o <<= 1) am = fmaxf(am, __shfl_xor(am, o));
            const float s = am > 0.f ? am * (1.0f / 7.5f) : 1.0f, inv = 1.0f / s;
            sc[rr] = s;
#pragma unroll
            for (int i = 0; i < 4; ++i)
#pragma unroll
                for (int e = 0; e < 4; ++e) hv[rr * 16 + i * 4 + e] = (_Float16)fminf(fmaxf(v[i][e] * inv, -7.5f), 7.5f);
        }
        const v6u_t pk = __builtin_amdgcn_cvt_scalef32_pk32_fp6_f16(hv, 1.0f);
        unsigned* d0 = (unsigned*)(dst + (size_t)(2 * rp) * TROW + lane * 12);
        unsigned* d1 = (unsigned*)(dst + (size_t)(2 * rp + 1) * TROW + lane * 12);
        d0[0] = pk[0]; d0[1] = pk[1]; d0[2] = pk[2]; d1[0] = pk[3]; d1[1] = pk[4]; d1[2] = pk[5];
        if (lane == 0) { scale[2 * rp] = sc[0]; scale[2 * rp + 1] = sc[1]; }
    }
}

constexpr int TROW4 = 512;
__device__ void ph_tab_fp4(const float* src, unsigned char* dst, float* scale, int nrows, int bid, int nb) {
    const int lane = ltid() & 63, w = __builtin_amdgcn_readfirstlane(ltid() >> 6);
    for (int row = bid * 8 + w; row < nrows; row += nb * 8) {
        const float* sp = src + (size_t)row * DM + lane * 16;
        f32x4 v[4]; float am = 0.f;
#pragma unroll
        for (int i = 0; i < 4; ++i) { v[i] = *(const f32x4*)(sp + i * 4); am = fmaxf(am, fmaxf(fmaxf(fabsf(v[i][0]), fabsf(v[i][1])), fmaxf(fabsf(v[i][2]), fabsf(v[i][3])))); }
#pragma unroll
        for (int o = 1; o < 64; o <<= 1) am = fmaxf(am, __shfl_xor(am, o));
        const float s = am > 0.f ? am * (1.0f / 6.0f) : 1.0f, inv = 1.0f / s;
        unsigned d0 = 0u, d1 = 0u;
        d0 = __builtin_amdgcn_cvt_scalef32_pk_fp4_f32(d0, v[0][0] * inv, v[0][1] * inv, 1.0f, 0); d0 = __builtin_amdgcn_cvt_scalef32_pk_fp4_f32(d0, v[0][2] * inv, v[0][3] * inv, 1.0f, 1);
        d0 = __builtin_amdgcn_cvt_scalef32_pk_fp4_f32(d0, v[1][0] * inv, v[1][1] * inv, 1.0f, 2); d0 = __builtin_amdgcn_cvt_scalef32_pk_fp4_f32(d0, v[1][2] * inv, v[1][3] * inv, 1.0f, 3);
        d1 = __builtin_amdgcn_cvt_scalef32_pk_fp4_f32(d1, v[2][0] * inv, v[2][1] * inv, 1.0f, 0); d1 = __builtin_amdgcn_cvt_scalef32_pk_fp4_f32(d1, v[2][2] * inv, v[2][3] * inv, 1.0f, 1);
        d1 = __builtin_amdgcn_cvt_scalef32_pk_fp4_f32(d1, v[3][0] * inv, v[3][1] * inv, 1.0f, 2); d1 = __builtin_amdgcn_cvt_scalef32_pk_fp4_f32(d1, v[3][2] * inv, v[3][3] * inv, 1.0f, 3);
        *(u32x2*)(dst + (size_t)row * TROW4 + lane * 8) = (u32x2){d0, d1};
        if (lane == 0) scale[row] = s;
    }
}

#define DPP_ADD(v, ctrl) ((v) + __builtin_bit_cast(float, __builtin_amdgcn_update_dpp(0, __builtin_bit_cast(int, (v)), (ctrl), 0xf, 0xf, true)))
struct GSet { v6u_t uq[2]; u32x2 vq[4]; float g, su, sv; };
__device__ __forceinline__ void gather_issue(GSet& S, int bt, int ev0, int ev1, int lane, int kslot, const unsigned char* pu, const unsigned char* pv,
                                             const float* su, const float* sv, const int* etok, const float* gtok) {
    const int evs = bt < 16 ? ev0 : ev1;
    const int lb = (bt * 4) & 63;
#pragma unroll
    for (int k = 0; k < 2; ++k) {
        const unsigned e0 = (unsigned)__builtin_amdgcn_readlane(evs, lb + 2 * k) * (unsigned)TROW + (unsigned)lane * 12u, e1 = (unsigned)__builtin_amdgcn_readlane(evs, lb + 2 * k + 1) * (unsigned)TROW + (unsigned)lane * 12u;
        const u32x3 a = *(const u32x3*)(pu + e0), c = *(const u32x3*)(pu + e1);
        S.uq[k] = (v6u_t){a.x, a.y, a.z, c.x, c.y, c.z};
        const unsigned f0 = (unsigned)__builtin_amdgcn_readlane(evs, lb + 2 * k) * (unsigned)TROW4 + (unsigned)lane * 8u, f1 = (unsigned)__builtin_amdgcn_readlane(evs, lb + 2 * k + 1) * (unsigned)TROW4 + (unsigned)lane * 8u;
        S.vq[2 * k] = *(const u32x2*)(pv + f0); S.vq[2 * k + 1] = *(const u32x2*)(pv + f1);
    }
    { const int ej = etok[bt * 4 + kslot]; S.g = gtok[bt * 4 + kslot]; S.su = su[ej]; S.sv = sv[ej]; }
}
__device__ __forceinline__ void gather_consume(const GSet& S, const float (&hx)[16], float (&acc)[16]) {
    float d[4];
#pragma unroll
    for (int k = 0; k < 2; ++k) {
        const v32f_t uf = __builtin_amdgcn_cvt_scalef32_pk32_f32_fp6(S.uq[k], 1.0f);
        float s0 = 0.f, s1 = 0.f;
#pragma unroll
        for (int i = 0; i < 16; ++i) { s0 += uf[i] * hx[i]; s1 += uf[16 + i] * hx[i]; }
        s0 = DPP_ADD(s0, 0xB1); s0 = DPP_ADD(s0, 0x4E); s0 = DPP_ADD(s0, 0x124); s0 = DPP_ADD(s0, 0x128);
        s1 = DPP_ADD(s1, 0xB1); s1 = DPP_ADD(s1, 0x4E); s1 = DPP_ADD(s1, 0x124); s1 = DPP_ADD(s1, 0x128);
        d[2 * k] = s0; d[2 * k + 1] = s1;
    }
    float e2[2], f1;
#pragma unroll
    for (int k = 0; k < 2; ++k) { auto r = __builtin_amdgcn_permlane16_swap(__float_as_uint(d[k]), __float_as_uint(d[k + 2]), false, false); e2[k] = __uint_as_float(r[0]) + __uint_as_float(r[1]); }
    { auto r = __builtin_amdgcn_permlane32_swap(__float_as_uint(e2[0]), __float_as_uint(e2[1]), false, false); f1 = __uint_as_float(r[0]) + __uint_as_float(r[1]); }
    const float cf = S.g * gelu_erf(f1 * S.su) * S.sv;
#pragma unroll
    for (int k = 0; k < 4; ++k) {
        const int r = ((k >> 1) & 1) | ((k & 1) << 1);
        const float c = __builtin_bit_cast(float, __builtin_amdgcn_readlane(__builtin_bit_cast(int, cf), 16 * r));
        const unsigned q0 = S.vq[k].x, q1 = S.vq[k].y;
        const f32x2_t a0 = __builtin_amdgcn_cvt_scalef32_pk_f32_fp4(q0, 1.0f, 0), a1 = __builtin_amdgcn_cvt_scalef32_pk_f32_fp4(q0, 1.0f, 1), a2 = __builtin_amdgcn_cvt_scalef32_pk_f32_fp4(q0, 1.0f, 2), a3 = __builtin_amdgcn_cvt_scalef32_pk_f32_fp4(q0, 1.0f, 3);
        const f32x2_t b0 = __builtin_amdgcn_cvt_scalef32_pk_f32_fp4(q1, 1.0f, 0), b1 = __builtin_amdgcn_cvt_scalef32_pk_f32_fp4(q1, 1.0f, 1), b2 = __builtin_amdgcn_cvt_scalef32_pk_f32_fp4(q1, 1.0f, 2), b3 = __builtin_amdgcn_cvt_scalef32_pk_f32_fp4(q1, 1.0f, 3);
        acc[0] += c * a0[0]; acc[1] += c * a0[1]; acc[2] += c * a1[0]; acc[3] += c * a1[1]; acc[4] += c * a2[0]; acc[5] += c * a2[1]; acc[6] += c * a3[0]; acc[7] += c * a3[1];
        acc[8] += c * b0[0]; acc[9] += c * b0[1]; acc[10] += c * b1[0]; acc[11] += c * b1[1]; acc[12] += c * b2[0]; acc[13] += c * b2[1]; acc[14] += c * b3[0]; acc[15] += c * b3[1];
    }
}
__device__ void ph_peer_gather(const bf16* h2, const unsigned char* pu, const unsigned char* pv, const float* su, const float* sv,
                               const int* eidx, const float* egate, const float* xin, const float* gate  , float* xout, int bid, int nb) {
    const int lane0 = ltid() & 63, w = __builtin_amdgcn_readfirstlane(ltid() >> 6);
    for (int t = bid * 8 + w; t < MT; t += nb * 8) {
        int lane = lane0; asm volatile("" : "+v"(lane));
        const int row = lane >> 4;
        const int kslot = 2 * (row & 1) + (row >> 1);
        const int b = t >> 11;
        const int* etok = eidx + (size_t)t * 128; const float* gtok = egate + (size_t)t * 128;
        const int ev0 = etok[lane], ev1 = etok[64 + lane];
        float hx[16], acc[16];
        {
            const u32x4 u0 = *(const u32x4*)(h2 + (size_t)t * DM + lane * 16), u1 = *(const u32x4*)(h2 + (size_t)t * DM + lane * 16 + 8);
#pragma unroll
            for (int i = 0; i < 4; ++i) { hx[2 * i] = bf2f(u0[i] & 0xffffu); hx[2 * i + 1] = __uint_as_float(u0[i] & 0xffff0000u); hx[8 + 2 * i] = bf2f(u1[i] & 0xffffu); hx[8 + 2 * i + 1] = __uint_as_float(u1[i] & 0xffff0000u); }
        }
#pragma unroll
        for (int i = 0; i < 16; ++i) acc[i] = 0.f;
        GSet A, B, C;
        gather_issue(A, 0, ev0, ev1, lane, kslot, pu, pv, su, sv, etok, gtok);
        gather_issue(B, 1, ev0, ev1, lane, kslot, pu, pv, su, sv, etok, gtok);
#pragma unroll 1
        for (int bt = 0; bt < 30; bt += 3) {
            gather_issue(C, bt + 2, ev0, ev1, lane, kslot, pu, pv, su, sv, etok, gtok);
            gather_consume(A, hx, acc);
            gather_issue(A, bt + 3, ev0, ev1, lane, kslot, pu, pv, su, sv, etok, gtok);
            gather_consume(B, hx, acc);
            gather_issue(B, bt + 4 < 32 ? bt + 4 : 31, ev0, ev1, lane, kslot, pu, pv, su, sv, etok, gtok);
            gather_consume(C, hx, acc);
        }
        gather_consume(A, hx, acc);
        gather_consume(B, hx, acc);
#pragma unroll
        for (int i = 0; i < 4; ++i) {
            const int c = lane * 16 + i * 4;
            const f32x4 xi = *(const f32x4*)(xin + (size_t)t * DM + c), gt = *(const f32x4*)(gate + (size_t)b * 6144 + c);
            f32x4 o;
#pragma unroll
            for (int e = 0; e < 4; ++e) o[e] = xi[e] + gt[e] * acc[i * 4 + e];
            *(f32x4*)(xout + (size_t)t * DM + c) = o;
        }
    }
}

#define XB_TMO      128
#define XB_XCNT(j)  (256  + 64 * (j))
#define XB_XSUB(j)  (1280 + 64 * (j))
#define XB_XGEN(j)  (2304 + 64 * (j))
#define XB_TOP      3328
#define XB_TOPGEN   3392
#define XCD_BAR_WORDS 3456
#define XB_SPIN_CAP (1u << 18)

__device__ __forceinline__ unsigned xb_ld(unsigned* p)              { return __hip_atomic_load(p, __ATOMIC_RELAXED, __HIP_MEMORY_SCOPE_AGENT); }
__device__ __forceinline__ unsigned xb_add(unsigned* p, unsigned v) { return __hip_atomic_fetch_add(p, v, __ATOMIC_RELAXED, __HIP_MEMORY_SCOPE_AGENT); }
__device__ __forceinline__ unsigned xb_xcc_id() { return (unsigned)__builtin_amdgcn_s_getreg((3 << 11) | 20) & 0xFu; }
#define XB_SPIN(cond, bar) do { unsigned _sp = 0; while (cond) { __builtin_amdgcn_s_sleep(1); \
    if ((++_sp & 255u) == 0u) { if (xb_ld(&(bar)[XB_TMO])) break; if (_sp > XB_SPIN_CAP) { atomicAdd(&(bar)[XB_TMO], 1u); break; } } } } while (0)

struct XcdBarrier {
    unsigned* bar; unsigned x;
    volatile LAS unsigned* st;
};

__device__ __forceinline__ XcdBarrier xcd_barrier_post(unsigned* bar, volatile LAS unsigned* st) {
    XcdBarrier b; b.bar = bar; b.x = xb_xcc_id(); b.st = st;
    if (threadIdx.x == 0) (void)xb_add(&bar[XB_XCNT(b.x)], 1u);
    return b;
}
__device__ __forceinline__ void xcd_barrier_complete(unsigned* bar, unsigned x, unsigned& nloc, unsigned& nx) {
    const unsigned G = gridDim.x * gridDim.y * gridDim.z;
    unsigned sum, cnt, mine, sp = 0u;
    for (;;) {
        sum = 0u; cnt = 0u; mine = 0u;
#pragma unroll
        for (unsigned j = 0; j < 16; ++j) { const unsigned c = xb_ld(&bar[XB_XCNT(j)]); sum += c; cnt += (c > 0u) ? 1u : 0u; mine = (j == x) ? c : mine; }
        if (sum == G) break;
        __builtin_amdgcn_s_sleep(1);
        if ((++sp & 255u) == 0u) { if (xb_ld(&bar[XB_TMO])) break; if (sp > XB_SPIN_CAP) { atomicAdd(&bar[XB_TMO], 1u); break; } }
    }
    nloc = mine > 0u ? mine : 1u; nx = cnt > 0u ? cnt : 1u;
}

__device__ __forceinline__ void xcd_barrier(const XcdBarrier& b) {
    asm volatile("s_waitcnt vmcnt(0)" ::: "memory");
    __syncthreads();
    if (threadIdx.x == 0) {
        unsigned* bar = b.bar;
        __builtin_amdgcn_s_waitcnt(0);
        unsigned nloc = b.st[0], nx = b.st[1];
        if (nloc == 0u) { xcd_barrier_complete(bar, b.x, nloc, nx); b.st[0] = nloc; b.st[1] = nx; }
        const unsigned old = xb_add(&bar[XB_XSUB(b.x)], 1u);
        const unsigned gen = old / nloc;
        if (old + 1u == (gen + 1u) * nloc) {
            __builtin_amdgcn_fence(__ATOMIC_RELEASE, "agent");
            asm volatile("s_waitcnt vmcnt(0)" ::: "memory");
            const unsigned og = xb_add(&bar[XB_TOP], 1u);
            const unsigned tg = og / nx;
            if (og + 1u == (tg + 1u) * nx) xb_add(&bar[XB_TOPGEN], 1u);
            else XB_SPIN(xb_ld(&bar[XB_TOPGEN]) == tg, bar);
            __builtin_amdgcn_fence(__ATOMIC_ACQUIRE, "agent");
            xb_add(&bar[XB_XGEN(b.x)], 1u);
            asm volatile("s_waitcnt vmcnt(0)" ::: "memory");
        } else {
            XB_SPIN(xb_ld(&bar[XB_XGEN(b.x)]) == gen, bar);
            __builtin_amdgcn_fence(__ATOMIC_ACQUIRE, "agent");
            asm volatile("s_waitcnt vmcnt(0)" ::: "memory");
        }
    }
    __syncthreads();
}


extern __shared__ __attribute__((aligned(16))) unsigned char dyn_lds[];
#ifndef REP_PREP
#define REP_PREP 1
#endif
#ifndef REP_ATTN
#define REP_ATTN 1
#endif
#ifndef REP_SEL
#define REP_SEL 1
#endif
#ifndef REP_GATH
#define REP_GATH 1
#endif
#ifndef REP_GEMM
#define REP_GEMM 1
#endif
#ifndef REP_ADALN
#define REP_ADALN 1
#endif
constexpr int LDS_BYTES = 147456;

template <class T> __device__ __forceinline__ T* launder(T* p) { size_t off = 0; asm volatile("" : "+s"(off)); return (T*)((unsigned char*)p + off); }
__global__ void __launch_bounds__(NT) mega_fwd(Params p) {
    cg::grid_group grid = cg::this_grid();
    const int bid = blockIdx.x, nb = gridDim.x;
    volatile LAS unsigned* bst = (volatile LAS unsigned*)((LAS unsigned char*)dyn_lds + LDS_BYTES - 64);
    if (ltid() < 16) bst[ltid()] = 0u;
    __syncthreads();
    const XcdBarrier xbar = xcd_barrier_post((unsigned*)(p.ws + WS_BAR), bst);
    for (int rep = 0; rep < REP_PREP; ++rep) {
        unsigned char* ws = launder(p.ws);
        float* tile = (float*)dyn_lds;
        ph_transpose(p.in[6], (bf16*)(ws + WS_WIN0), 1024, AB_IN, true, tile, bid, nb);
        ph_transpose(p.in[11], (bf16*)(ws + WS_WIN1), 1024, CD_IN, true, tile, bid, nb);
        ph_transpose(p.in[7], (bf16*)(ws + WS_WO0), 1024, 1024, false, tile, bid, nb);
        ph_transpose(p.in[12], (bf16*)(ws + WS_WO1), 1024, 1024, false, tile, bid, nb);
        ph_transpose(p.in[17], (bf16*)(ws + WS_WQ), 1024, PQ, false, tile, bid, nb);
        ph_transpose(p.in[17] + (size_t)1024 * PQ, (bf16*)(ws + WS_WQ) + (size_t)PQ * 1024, 1024, PQ, false, tile, bid, nb);
        ws = launder(ws);
        ph_tab_fp6(p.in[19], ws + WS_PU, (float*)(ws + WS_PV), 2 * NEXP, bid, nb);
        ph_tab_fp4(p.in[20], ws + WS_PU + 32 * MiB, (float*)(ws + WS_PV + 1 * MiB), 2 * NEXP, bid, nb);
        ws = launder(ws);
        ph_mod(p.in[1], p.in[2], p.in[3], (float*)(ws + WS_MOD), (float*)dyn_lds, bid, nb);
        ph_rope_table((float*)(ws + WS_ROPE), bid, nb);
        for (int i = bid * NT + ltid(); i < NB * 8 * 8 * 64; i += nb * NT) ((float*)(ws + WS_KMEAN))[i] = 0.f;
    }
    grid.sync();
#pragma unroll 1
    for (int layer = 0; layer < 2; ++layer) {
        for (int rep = 0; rep < REP_ADALN; ++rep) {
            unsigned char* ws = launder(p.ws); const float* mod = (const float*)(ws + WS_MOD) + (size_t)layer * 32 * 6144;
            ph_adaln(layer == 0 ? p.in[0] : p.out, p.in[4] + layer * DM, mod + 0, mod + 1024, (bf16*)(ws + WS_HY), bid, nb);
        }
        xcd_barrier(xbar);
        for (int rep = 0; rep < REP_GEMM; ++rep) {
            unsigned char* ws = launder(p.ws);
            pg8::Gemm g{(const bf16*)(ws + WS_HY), (const bf16*)(ws + (layer == 0 ? WS_WIN0 : WS_WIN1)), MT, layer == 0 ? AB_IN : CD_IN, DM};
            pg8::StaticOrder S; S.init(g.M, g.N, nb, bid);
            pg8::EpiQKV e{(bf16*)(ws + WS_QKV), QKV_LD, (const float*)(ws + WS_ROPE), layer, layer == 0 ? p.in[9] : p.in[13], layer == 0 ? p.in[10] : p.in[14], p.in[15], p.in[16], (float*)(ws + WS_KMEAN)};
            pg8::gemm_phase<pg8::EpiQKV, pg8::StaticOrder, true, true>((LAS unsigned char*)dyn_lds, g, S, e);
        }
        xcd_barrier(xbar);
        for (int rep = 0; rep < REP_ATTN; ++rep) {
            unsigned char* ws = launder(p.ws);
            if (layer == 0) ph_attn0((const bf16*)(ws + WS_QKV), p.in[8], (bf16*)(ws + WS_HY), (LAS unsigned char*)dyn_lds, bid, nb);
            else ph_attn1((const bf16*)(ws + WS_QKV), (const float*)(ws + WS_KMEAN), (bf16*)(ws + WS_HY), (LAS unsigned char*)dyn_lds, bid, nb);
        }
        xcd_barrier(xbar);
        for (int rep = 0; rep < REP_GEMM; ++rep) {
            unsigned char* ws = launder(p.ws); const float* mod = (const float*)(ws + WS_MOD) + (size_t)layer * 32 * 6144;
            pg8::Gemm g{(const bf16*)(ws + WS_HY), (const bf16*)(ws + (layer == 0 ? WS_WO0 : WS_WO1)), MT, DM, DM};
            pg8::StaticOrder S; S.init(g.M, g.N, nb, bid); pg8::EpiResid e{layer == 0 ? p.in[0] : p.out, (float*)(ws + WS_X1), mod + 2048};
            pg8::gemm_phase<pg8::EpiResid, pg8::StaticOrder, true, true>((LAS unsigned char*)dyn_lds, g, S, e);
        }
        xcd_barrier(xbar);
        for (int rep = 0; rep < REP_ADALN; ++rep) {
            unsigned char* ws = launder(p.ws); const float* mod = (const float*)(ws + WS_MOD) + (size_t)layer * 32 * 6144;
            ph_adaln((const float*)(ws + WS_X1), p.in[5] + layer * DM, mod + 3072, mod + 4096, (bf16*)(ws + WS_QKV), bid, nb);
        }
        xcd_barrier(xbar);
        for (int rep = 0; rep < REP_GEMM; ++rep) {
            unsigned char* ws = launder(p.ws);
            pg8::Gemm g{(const bf16*)(ws + WS_QKV), (const bf16*)(ws + WS_WQ) + (size_t)layer * PQ * DM, MT, PQ, DM};
            pg8::StaticOrder S; S.init(g.M, g.N, nb, bid); pg8::EpiStore e{(bf16*)(ws + WS_QKV + 128 * MiB), PQ};
            pg8::gemm_phase<pg8::EpiStore, pg8::StaticOrder, true, true>((LAS unsigned char*)dyn_lds, g, S, e);
        }
        xcd_barrier(xbar);
        for (int rep = 0; rep < REP_SEL; ++rep) {
            unsigned char* ws = launder(p.ws);
            ph_peer_select((const bf16*)(ws + WS_QKV + 128 * MiB), p.in[18] + (size_t)layer * 2 * 128 * 128, (int*)(ws + WS_HY), (float*)(ws + WS_HY + 32 * MiB), (LAS unsigned char*)dyn_lds, bid, nb);
        }
        xcd_barrier(xbar);
        for (int rep = 0; rep < REP_GATH; ++rep) {
            unsigned char* ws = launder(p.ws); const float* mod = (const float*)(ws + WS_MOD) + (size_t)layer * 32 * 6144;
            ph_peer_gather((const bf16*)(ws + WS_QKV), ws + WS_PU + (size_t)layer * NEXP * TROW, ws + WS_PU + 32 * MiB + (size_t)layer * NEXP * TROW4,
                           (const float*)(ws + WS_PV) + layer * NEXP, (const float*)(ws + WS_PV + 1 * MiB) + layer * NEXP, (const int*)(ws + WS_HY), (const float*)(ws + WS_HY + 32 * MiB), (const float*)(ws + WS_X1), mod + 5120, p.out, bid, nb);
        }
        if (layer == 0) xcd_barrier(xbar);
    }
}

extern "C" void kernel_launch(void* const* d_in, const int* in_sizes, int n_in, void* d_out, int out_size, void* d_ws, size_t ws_size, hipStream_t stream) {
    if (n_in != 21 || ws_size < WS_END) { fprintf(stderr, "kernel_launch: bad args n_in=%d ws=%zu\n", n_in, ws_size); return; }
    static int grid_blocks = 0;
    if (!grid_blocks) {
        int dev = 0, cus = 0, per_cu = 0;
        (void)hipGetDevice(&dev);
        (void)hipDeviceGetAttribute(&cus, hipDeviceAttributeMultiprocessorCount, dev);
        (void)hipFuncSetAttribute((const void*)mega_fwd, hipFuncAttributeMaxDynamicSharedMemorySize, LDS_BYTES);
        (void)hipOccupancyMaxActiveBlocksPerMultiprocessor(&per_cu, (const void*)mega_fwd, NT, LDS_BYTES);
        if (per_cu < 1) { fprintf(stderr, "kernel_launch: occupancy query returned %d\n", per_cu); per_cu = 1; }
        if (per_cu > 1) per_cu = 1;
        grid_blocks = cus * per_cu;
    }
    Params p{};
    for (int i = 0; i < 21; ++i) p.in[i] = (const float*)d_in[i];
    p.out = (float*)d_out; p.ws = (unsigned char*)d_ws;
    (void)hipMemsetAsync((char*)d_ws + WS_BAR, 0, 16384, stream);
    void* args[] = {&p};
    hipError_t e = hipLaunchCooperativeKernel((const void*)mega_fwd, dim3(grid_blocks), dim3(NT), args, LDS_BYTES, stream);
    if (e != hipSuccess) fprintf(stderr, "cooperative launch failed: %s (grid %d)\n", hipGetErrorString(e), grid_blocks);
}
```

```cpp
#include <hip/hip_runtime.h>
#ifndef REP_A
#define REP_A 1
#endif
#ifndef REP_B
#define REP_B 1
#endif
#ifndef REP_C
#define REP_C 1
#endif
#ifndef REP_D
#define REP_D 1
#endif
#include <hip/hip_cooperative_groups.h>
namespace cg = cooperative_groups;
#include <cstdio>
#include <cstdint>
#include <cmath>

typedef unsigned short bf16;
typedef short bf16x8 __attribute__((ext_vector_type(8)));
typedef float f32x4 __attribute__((ext_vector_type(4)));
typedef unsigned u32x4 __attribute__((ext_vector_type(4)));
typedef unsigned u32x2 __attribute__((ext_vector_type(2)));

constexpr int DM = 1024, NB = 32, SQ = 2048, MT = NB * SQ;
constexpr int HD = 64;
constexpr int AB_IN = 2304, CD_IN = 3072, QKV_LD = 3072;
constexpr int NEXP = 16384, PQ = 2048;
constexpr float EPS = 1e-6f;
constexpr int NT = 512;

constexpr size_t MiB = 1u << 20;
constexpr size_t WS_X1 = 0;
constexpr size_t WS_QKV = 256 * MiB;
constexpr size_t WS_HY = 640 * MiB;
constexpr size_t WS_PU = 768 * MiB;
constexpr size_t WS_PV = 832 * MiB;
constexpr size_t WS_WIN0 = 896 * MiB;
constexpr size_t WS_WIN1 = 901 * MiB;
constexpr size_t WS_WO0 = 907 * MiB;
constexpr size_t WS_WO1 = 909 * MiB;
constexpr size_t WS_WQ = 911 * MiB;
constexpr size_t WS_MOD = 919 * MiB;
constexpr size_t WS_ROPE = 921 * MiB;
constexpr size_t WS_KMEAN = 922 * MiB;
constexpr size_t WS_BAR = 923 * MiB;
constexpr size_t WS_END = 924 * MiB;

struct Params {
    const float* in[21];
    float* out;
    unsigned char* ws;
};

__device__ __forceinline__ int ltid() { int t = (int)__builtin_amdgcn_workitem_id_x(); asm volatile("" : "+v"(t)); return t; }
__device__ __forceinline__ float bf2f(unsigned b) { return __uint_as_float(b << 16); }
__device__ __forceinline__ unsigned f2bf(float f) { unsigned u = __float_as_uint(f); return (u + 0x7fffu + ((u >> 16) & 1u)) >> 16; }
__device__ __forceinline__ unsigned pk2(float lo, float hi) { return f2bf(lo) | (f2bf(hi) << 16); }
#define DPPV(v, ctrl) __builtin_bit_cast(float, __builtin_amdgcn_update_dpp(0, __builtin_bit_cast(int, (v)), (ctrl), 0xf, 0xf, true))
__device__ __forceinline__ float row16_sum(float v) { v += DPPV(v, 0xB1); v += DPPV(v, 0x4E); v += DPPV(v, 0x124); v += DPPV(v, 0x128); return v; }
__device__ __forceinline__ float rows_sum(float v) {
    { auto r = __builtin_amdgcn_permlane16_swap(__float_as_uint(v), __float_as_uint(v), false, false); v = __uint_as_float(r[0]) + __uint_as_float(r[1]); }
    { auto r = __builtin_amdgcn_permlane32_swap(__float_as_uint(v), __float_as_uint(v), false, false); v = __uint_as_float(r[0]) + __uint_as_float(r[1]); }
    return v;
}
__device__ __forceinline__ float wave_sum(float v) { return rows_sum(row16_sum(v)); }
__device__ __forceinline__ float wave_max(float v) {
    v = fmaxf(v, DPPV(v, 0xB1)); v = fmaxf(v, DPPV(v, 0x4E)); v = fmaxf(v, DPPV(v, 0x124)); v = fmaxf(v, DPPV(v, 0x128));
    { auto r = __builtin_amdgcn_permlane16_swap(__float_as_uint(v), __float_as_uint(v), false, false); v = fmaxf(__uint_as_float(r[0]), __uint_as_float(r[1])); }
    { auto r = __builtin_amdgcn_permlane32_swap(__float_as_uint(v), __float_as_uint(v), false, false); v = fmaxf(__uint_as_float(r[0]), __uint_as_float(r[1])); }
    return v;
}
__device__ __forceinline__ float gelu_erf(float x) { return 0.5f * x * (1.0f + erff(x * 0.70710678118654752f)); }

__device__ __forceinline__ int qkv_logical_col(int p) { return (p & ~255) | (((p >> 5) & 3) << 6) | (((p >> 7) & 1) << 5) | (p & 31); }
__device__ void ph_transpose(const float* W, bf16* Wt, int K, int N, bool permute, float* tile  , int bid, int nb) {
    const int tid = ltid();
    const int nkt = K / 64, nnt = N / 64;
    for (int it = bid; it < nkt * nnt; it += nb) {
        const int k0 = (it / nnt) * 64, n0 = (it % nnt) * 64;
        __syncthreads();
        for (int e = tid; e < 64 * 64; e += NT) { const int r = e >> 6, c = e & 63; const int nl = permute ? qkv_logical_col(n0 + c) : n0 + c; tile[r * 65 + c] = W[(size_t)(k0 + r) * N + nl]; }
        __syncthreads();
        {
            const int n = tid >> 3, k8 = (tid & 7) * 8;
            u32x4 v;
            v.x = pk2(tile[(k8 + 0) * 65 + n], tile[(k8 + 1) * 65 + n]);
            v.y = pk2(tile[(k8 + 2) * 65 + n], tile[(k8 + 3) * 65 + n]);
            v.z = pk2(tile[(k8 + 4) * 65 + n], tile[(k8 + 5) * 65 + n]);
            v.w = pk2(tile[(k8 + 6) * 65 + n], tile[(k8 + 7) * 65 + n]);
            *(u32x4*)(Wt + (size_t)(n0 + n) * K + k0 + k8) = v;
        }
    }
}
__device__ void ph_convert(const float* src, bf16* dst, size_t n, int bid, int nb) {
    const size_t n8 = n / 8;
    for (size_t i = (size_t)bid * NT + ltid(); i < n8; i += (size_t)nb * NT) {
        const f32x4 a = *(const f32x4*)(src + i * 8), b = *(const f32x4*)(src + i * 8 + 4);
        u32x4 v; v.x = pk2(a[0], a[1]); v.y = pk2(a[2], a[3]); v.z = pk2(b[0], b[1]); v.w = pk2(b[2], b[3]);
        *(u32x4*)(dst + i * 8) = v;
    }
}
__device__ void ph_mod(const float* c, const float* ada_w, const float* ada_b, float* mod, float* lds  , int bid, int nb) {
    const int tid = ltid(), lane = tid & 63, w = tid >> 6;
    for (int it = bid; it < 2 * 96; it += nb) {
        const int l = it / 96, j = (it % 96) * 64 + lane;
        float acc[32];
#pragma unroll
        for (int b = 0; b < 32; ++b) acc[b] = 0.f;
        for (int kh = 0; kh < 2; ++kh) {
            __syncthreads();
            for (int e = tid; e < 32 * 512; e += NT) { const int b = e >> 9, k = e & 511; const float cv = c[b * 1024 + kh * 512 + k]; lds[e] = cv / (1.0f + __expf(-cv)); }
            __syncthreads();
            for (int kk = 0; kk < 64; ++kk) {
                const int k = w * 64 + kk;
                const float wv = ada_w[((size_t)l * 1024 + kh * 512 + k) * 6144 + j];
#pragma unroll
                for (int b = 0; b < 32; ++b) acc[b] += lds[b * 512 + k] * wv;
            }
        }
        __syncthreads();
#pragma unroll
        for (int b = 0; b < 32; ++b) lds[(w * 32 + b) * 64 + lane] = acc[b];
        __syncthreads();
        for (int e = tid; e < 32 * 64; e += NT) {
            const int b = e >> 6, jj = e & 63; float s = 0.f;
#pragma unroll
            for (int ww = 0; ww < 8; ++ww) s += lds[(ww * 32 + b) * 64 + jj];
            const int jo = (it % 96) * 64 + jj;
            mod[((size_t)l * 32 + b) * 6144 + jo] = s + ada_b[l * 6144 + jo];
        }
    }
}
__device__ void ph_rope_table(float* rope, int bid, int nb) {
    for (int i = bid * NT + ltid(); i < SQ * 32; i += nb * NT) {
        const int t = i >> 5, f = i & 31;
        const float inv = powf(10000.0f, -(float)f / 32.0f);
        const float ang = (float)t * inv;
        float s, c; sincosf(ang, &s, &c);
        rope[i * 2] = c; rope[i * 2 + 1] = s;
    }
}

#define DPP_ADD0(v, ctrl) ((v) + __builtin_bit_cast(float, __builtin_amdgcn_update_dpp(0, __builtin_bit_cast(int, (v)), (ctrl), 0xf, 0xf, true)))
__device__ void ph_adaln(const float* x, const float* g, const float* mod_shift  , const float* mod_scale, bf16* h, int bid, int nb) {
    const int lane = ltid() & 63, w = __builtin_amdgcn_readfirstlane(ltid() >> 6);
    for (int t0 = (bid * 8 + w) * 4; t0 < MT; t0 += nb * 8 * 4) {
        const int b = t0 >> 11;
        f32x4 v[4][4]; float ss[4];
#pragma unroll
        for (int r = 0; r < 4; ++r) {
            const float* xr = x + (size_t)(t0 + r) * DM;
#pragma unroll
            for (int i = 0; i < 4; ++i) v[r][i] = *(const f32x4*)(xr + i * 256 + lane * 4);
        }
#pragma unroll
        for (int r = 0; r < 4; ++r) {
            float s = 0.f;
#pragma unroll
            for (int i = 0; i < 4; ++i) s += v[r][i][0] * v[r][i][0] + v[r][i][1] * v[r][i][1] + v[r][i][2] * v[r][i][2] + v[r][i][3] * v[r][i][3];
            s = DPP_ADD0(s, 0xB1); s = DPP_ADD0(s, 0x4E); s = DPP_ADD0(s, 0x124); s = DPP_ADD0(s, 0x128);
            { auto q = __builtin_amdgcn_permlane16_swap(__float_as_uint(s), __float_as_uint(s), false, false); s = __uint_as_float(q[0]) + __uint_as_float(q[1]); }
            { auto q = __builtin_amdgcn_permlane32_swap(__float_as_uint(s), __float_as_uint(s), false, false); s = __uint_as_float(q[0]) + __uint_as_float(q[1]); }
            ss[r] = rsqrtf(s * (1.0f / DM) + EPS);
        }
#pragma unroll
        for (int i = 0; i < 4; ++i) {
            const int c = i * 256 + lane * 4;
            const f32x4 gg = *(const f32x4*)(g + c), sc = *(const f32x4*)(mod_scale + (size_t)b * 6144 + c), sh = *(const f32x4*)(mod_shift + (size_t)b * 6144 + c);
            float a[4];
#pragma unroll
            for (int e = 0; e < 4; ++e) a[e] = gg[e] * (1.0f + sc[e]);
#pragma unroll
            for (int r = 0; r < 4; ++r) {
                float y[4];
#pragma unroll
                for (int e = 0; e < 4; ++e) y[e] = v[r][i][e] * ss[r] * a[e] + sh[e];
                u32x2 o; o.x = pk2(y[0], y[1]); o.y = pk2(y[2], y[3]);
                *(u32x2*)(h + (size_t)(t0 + r) * DM + c) = o;
            }
        }
    }
}

namespace pg8 {
#define PG8_LAS __attribute__((address_space(3)))
typedef unsigned short bf16_t;
typedef short bf16x8 __attribute__((ext_vector_type(8)));
constexpr int BM = 256, BK = 64, HALF = 128, HTB = HALF * BK * 2  , STAGE_BYTES = 8 * HTB, NXCD = 8, WGM = 8;

__host__ __device__ __forceinline__ int lds_byte(int r, int c) { const int st = (r >> 4) * 2 + (c >> 5), rr = r & 15, cc = c & 31, ob = rr * 64 + cc * 2; return st * 1024 + (ob ^ (((ob >> 9) & 1) << 5)); }
__host__ __device__ __forceinline__ void stage_rc(int b, int& R, int& C) { const int st = b / 1024, sb = b % 1024, swz = sb ^ (((sb >> 9) & 1) << 5); R = (st >> 1) * 16 + swz / 64; C = (st & 1) * 32 + (swz % 64) / 2; }
__host__ __device__ __forceinline__ int perm32(int rho) { const int n = rho >> 4, i = rho & 15; return 8 * (i >> 2) + 4 * n + (i & 3); }

struct Unit { int pm, pn; };
struct Gemm { const bf16_t* A; const bf16_t* Bt; int M, N, K; };

struct StaticOrder {
    int nM, nN, nwg, G, c;
    __host__ __device__ void init(int M, int N, int G_, int c_) { nM = M / BM; nN = N / BM; nwg = nM * nN; G = G_; c = c_; }
    __host__ __device__ bool next(int i, Unit& u) const {
        const long L = (long)i * G + c; if (L >= nwg) return false;
        int wgid = (int)L; { const int q = nwg / NXCD, r = nwg % NXCD, xcd = wgid % NXCD, off = wgid / NXCD; wgid = (xcd < r ? xcd * (q + 1) : r * (q + 1) + (xcd - r) * q) + off; }
        const int nig = WGM * nN, gid = wgid / nig, fm = gid * WGM, gsz = (nM - fm) < WGM ? (nM - fm) : WGM;
        u.pm = fm + ((wgid % nig) % gsz); u.pn = (wgid % nig) / gsz; return true;
    }
    __device__ __forceinline__ void a_ready(const Unit&) const {}
    __device__ __forceinline__ void done(const Unit&) const {}
};

__device__ __forceinline__ unsigned cvt_pk_bf16(float lo, float hi) { unsigned r; asm volatile("v_cvt_pk_bf16_f32 %0, %1, %2" : "=v"(r) : "v"(lo), "v"(hi)); return r; }

struct EpiStore {
    static constexpr bool PERM = true, AFTER_DRAIN = false;
    bf16_t* O; int ldc;
    __device__ __forceinline__ void operator()(const f32x4 (&acc)[2][2][4][2], const Unit& u, int wr, int wc, int fr_, int fq_) const {
        int fr = fr_, fq = fq_; asm volatile("" : "+v"(fr), "+v"(fq));
        const int row0 = u.pm * BM + wr * 64 + fr, col0 = u.pn * BM + wc * 32 + 8 * fq;
#pragma unroll
        for (int ai = 0; ai < 2; ++ai)
#pragma unroll
            for (int m = 0; m < 4; ++m) { bf16_t* rowp = O + (size_t)(row0 + ai * HALF + m * 16) * ldc + col0;
#pragma unroll
                for (int bj = 0; bj < 2; ++bj) { const f32x4 v0 = acc[ai][bj][m][0], v1 = acc[ai][bj][m][1];
                    u32x4 w; w.x = cvt_pk_bf16(v0[0], v0[1]); w.y = cvt_pk_bf16(v0[2], v0[3]); w.z = cvt_pk_bf16(v1[0], v1[1]); w.w = cvt_pk_bf16(v1[2], v1[3]);
                    *(u32x4*)(rowp + bj * HALF) = w; } }
    }
};
struct EpiQKV {
    static constexpr bool PERM = true, AFTER_DRAIN = false;
    bf16_t* O; int ldc; const float* rope; int layer;
    const float* gq0; const float* gk0;
    const float* gq1; const float* gk1;
    float* kmean;
    __device__ __forceinline__ void operator()(const f32x4 (&acc)[2][2][4][2], const Unit& u, int wr, int wc, int fr_, int fq_) const {
        int fr = fr_, fq = fq_; asm volatile("" : "+v"(fr), "+v"(fq));
        const int hg = 4 * u.pn + wc;
        const float* gain = nullptr; bool km = false;
        if (layer == 0) { if (hg < 8) gain = gq0; else if (hg < 10) gain = gk0; }
        else { if (hg < 8) gain = gq0; else if (hg < 16) gain = gk0; else if (hg >= 24 && hg < 32) gain = gq1; else if (hg >= 32 && hg < 40) { gain = gk1; km = true; } }
        const int row0 = u.pm * BM + wr * 64 + fr, col0 = 64 * hg + 8 * fq;
        float g0[8], g1[8], cs0[8], cs1[8];
#pragma unroll
        for (int e = 0; e < 8; ++e) { g0[e] = gain ? gain[8 * fq + e] : 1.f; g1[e] = gain ? gain[32 + 8 * fq + e] : 1.f; cs0[e] = 0.f; cs1[e] = 0.f; }
#pragma unroll
        for (int ai = 0; ai < 2; ++ai)
#pragma unroll
            for (int m = 0; m < 4; ++m) {
                const int row = row0 + ai * HALF + m * 16;
                float v0[8], v1[8];
#pragma unroll
                for (int e = 0; e < 4; ++e) { v0[e] = acc[ai][0][m][0][e]; v0[4 + e] = acc[ai][0][m][1][e]; v1[e] = acc[ai][1][m][0][e]; v1[4 + e] = acc[ai][1][m][1][e]; }
                if (gain) {
                    float ss = 0.f;
#pragma unroll
                    for (int e = 0; e < 8; ++e) ss += v0[e] * v0[e] + v1[e] * v1[e];
                    ss = rows_sum(ss);
                    const float r = rsqrtf(ss * (1.0f / 64.0f) + 1e-6f);
                    const float* rp = rope + ((size_t)(row & 2047) * 32 + 8 * fq) * 2;
                    const f32x4 t0 = *(const f32x4*)(rp), t1 = *(const f32x4*)(rp + 4), t2 = *(const f32x4*)(rp + 8), t3 = *(const f32x4*)(rp + 12);
                    const float cs[8] = {t0[0], t0[2], t1[0], t1[2], t2[0], t2[2], t3[0], t3[2]}, sn[8] = {t0[1], t0[3], t1[1], t1[3], t2[1], t2[3], t3[1], t3[3]};
#pragma unroll
                    for (int e = 0; e < 8; ++e) { const float y0 = v0[e] * r * g0[e], y1 = v1[e] * r * g1[e]; v0[e] = y0 * cs[e] - y1 * sn[e]; v1[e] = y1 * cs[e] + y0 * sn[e]; }
                }
                u32x4 w0, w1;
                w0.x = cvt_pk_bf16(v0[0], v0[1]); w0.y = cvt_pk_bf16(v0[2], v0[3]); w0.z = cvt_pk_bf16(v0[4], v0[5]); w0.w = cvt_pk_bf16(v0[6], v0[7]);
                w1.x = cvt_pk_bf16(v1[0], v1[1]); w1.y = cvt_pk_bf16(v1[2], v1[3]); w1.z = cvt_pk_bf16(v1[4], v1[5]); w1.w = cvt_pk_bf16(v1[6], v1[7]);
                bf16_t* rowp = O + (size_t)row * ldc + col0;
                *(u32x4*)(rowp) = w0; *(u32x4*)(rowp + 32) = w1;
                if (km) {
#pragma unroll
                    for (int e = 0; e < 8; ++e) { cs0[e] += v0[e]; cs1[e] += v1[e]; }
                }
            }
        if (km) {
#pragma unroll
            for (int e = 0; e < 8; ++e) {
                cs0[e] = row16_sum(cs0[e]); cs1[e] = row16_sum(cs1[e]);
            }
            if (fr == 0) {
                float* kp = kmean + ((size_t)((u.pm >> 3) * 8 + (hg - 32)) * 8 + (u.pm & 7)) * 64 + 8 * fq;
#pragma unroll
                for (int e = 0; e < 8; ++e) { atomicAdd(kp + e, cs0[e] * (1.0f / 256.0f)); atomicAdd(kp + 32 + e, cs1[e] * (1.0f / 256.0f)); }
            }
        }
    }
};
struct EpiResid {
    static constexpr bool PERM = true, AFTER_DRAIN = false;
    const float* xin; float* xout; const float* gate;
    __device__ __forceinline__ void operator()(const f32x4 (&acc)[2][2][4][2], const Unit& u, int wr, int wc, int fr_, int fq_) const {
        int fr = fr_, fq = fq_; asm volatile("" : "+v"(fr), "+v"(fq));
        const int row0 = u.pm * BM + wr * 64 + fr, col0 = u.pn * BM + wc * 32 + 8 * fq;
#pragma unroll
        for (int ai = 0; ai < 2; ++ai)
#pragma unroll
            for (int m = 0; m < 4; ++m) { const int row = row0 + ai * HALF + m * 16; const float* gp = gate + (size_t)(row >> 11) * 6144 + col0;
                const float* xi = xin + (size_t)row * 1024 + col0; float* xo = xout + (size_t)row * 1024 + col0;
#pragma unroll
                for (int bj = 0; bj < 2; ++bj)
#pragma unroll
                    for (int n = 0; n < 2; ++n) { const f32x4 a = acc[ai][bj][m][n], x = *(const f32x4*)(xi + bj * HALF + 4 * n), g = *(const f32x4*)(gp + bj * HALF + 4 * n);
                        f32x4 o; o[0] = x[0] + g[0] * a[0]; o[1] = x[1] + g[1] * a[1]; o[2] = x[2] + g[2] * a[2]; o[3] = x[3] + g[3] * a[3];
                        *(f32x4*)(xo + bj * HALF + 4 * n) = o; } }
    }
};
template <class Epi, class Sched, bool ALIGN_EPI = false, bool SP2 = false>
__device__ __forceinline__ void gemm_phase(PG8_LAS unsigned char* lds, const Gemm g, const Sched& S, const Epi& E) {
    const int tid = ltid(), wid = __builtin_amdgcn_readfirstlane(tid >> 6), lane = tid & 63, wr = wid >> 2, wc = wid & 3, fr = lane & 15, fq = lane >> 4;
    const int K = g.K, nt = K / BK;
    unsigned voffA[2], voffB[2];
#pragma unroll
    for (int i = 0; i < 2; ++i) { int R, C; stage_rc(tid * 16 + i * 8192, R, C); const int Rb = Epi::PERM ? ((R & ~31) + perm32(R & 31)) : R;
        voffA[i] = (unsigned)(R * K + C) * 2u; voffB[i] = (unsigned)(Rb * K + C) * 2u; }
    const size_t kstep = (size_t)(BK * 2);
    const size_t hstep = (size_t)HALF * K * 2;
    const size_t tstep = 2 * hstep;
    const unsigned ldsw = (unsigned)wid * 1024u;
    const int aoff = lds_byte(wr * 64 + fr, fq * 8), boff = lds_byte(wc * 32 + fr, fq * 8);
#define PG8_SA(b, h) (((b) * 2 + (h)) * HTB)
#define PG8_SB(b, h) ((4 + (b) * 2 + (h)) * HTB)
#define PG8_STAGE(bufoff, gbase, voff) do { _Pragma("unroll") for (int _i = 0; _i < 2; ++_i) \
        __builtin_amdgcn_global_load_lds((const unsigned*)((const char*)(gbase) + (voff)[_i]), (PG8_LAS unsigned*)(lds + (bufoff) + ldsw + _i * 8192), 16, 0, 0); } while (0)
#define PG8_LDA(dst, b, h) do { _Pragma("unroll") for (int m = 0; m < 4; ++m) _Pragma("unroll") for (int k = 0; k < 2; ++k) dst[m][k] = *(const PG8_LAS bf16x8*)(lds + PG8_SA(b, h) + aoff + m * 2048 + k * 1024); } while (0)
#define PG8_LDB(dst, b, h) do { _Pragma("unroll") for (int n = 0; n < 2; ++n) _Pragma("unroll") for (int k = 0; k < 2; ++k) dst[n][k] = *(const PG8_LAS bf16x8*)(lds + PG8_SB(b, h) + boff + n * 2048 + k * 1024); } while (0)
#define PG8_MMA(ai, bj, At, Bt) do { __builtin_amdgcn_s_setprio(1); _Pragma("unroll") for (int m = 0; m < 4; ++m) _Pragma("unroll") for (int n = 0; n < 2; ++n) _Pragma("unroll") for (int k = 0; k < 2; ++k) \
        acc[ai][bj][m][n] = __builtin_amdgcn_mfma_f32_16x16x32_bf16(Bt[n][k], At[m][k], acc[ai][bj][m][n], 0, 0, 0); __builtin_amdgcn_s_setprio(0); } while (0)
#define PG8_WAIT_V(n) asm volatile("s_waitcnt vmcnt(" #n ")" ::: "memory")
#define PG8_WAIT_L(n) asm volatile("s_waitcnt lgkmcnt(" #n ")" ::: "memory")
#define PG8_BAR __builtin_amdgcn_s_barrier()
#define PG8_SCHED __builtin_amdgcn_sched_barrier(0)
    Unit cur, nxt; int ui = 0;
    if (!S.next(0, cur)) return;
    f32x4 acc[2][2][4][2];
#pragma unroll
    for (int a = 0; a < 2; ++a)
#pragma unroll
        for (int b = 0; b < 2; ++b)
#pragma unroll
            for (int m = 0; m < 4; ++m)
#pragma unroll
                for (int n = 0; n < 2; ++n) acc[a][b][m][n] = (f32x4){0.f, 0.f, 0.f, 0.f};
    bf16x8 At[4][2], B0[2][2], B1[2][2];
    const char* cA = (const char*)g.A + (size_t)cur.pm * tstep; const char* cB = (const char*)g.Bt + (size_t)cur.pn * tstep;
    S.a_ready(cur);
    if constexpr (SP2) {
        PG8_STAGE(PG8_SB(0, 0), cB, voffB); PG8_STAGE(PG8_SB(0, 1), cB + hstep, voffB); PG8_STAGE(PG8_SA(0, 0), cA, voffA); PG8_STAGE(PG8_SA(0, 1), cA + hstep, voffA);
        if (wr == 1) PG8_BAR;
        PG8_WAIT_V(2); PG8_BAR;
        PG8_STAGE(PG8_SB(1, 0), cB + kstep, voffB); PG8_STAGE(PG8_SA(1, 0), cA + kstep, voffA); PG8_STAGE(PG8_SB(1, 1), cB + hstep + kstep, voffB);
        PG8_WAIT_V(6); PG8_BAR;
    } else {
        PG8_STAGE(PG8_SB(0, 0), cB, voffB); PG8_STAGE(PG8_SA(0, 0), cA, voffA); PG8_STAGE(PG8_SB(0, 1), cB + hstep, voffB); PG8_STAGE(PG8_SA(0, 1), cA + hstep, voffA);
        if (wr == 1) PG8_BAR;
        PG8_WAIT_V(4); PG8_BAR;
        PG8_STAGE(PG8_SB(1, 0), cB + kstep, voffB); PG8_STAGE(PG8_SA(1, 0), cA + kstep, voffA); PG8_STAGE(PG8_SB(1, 1), cB + hstep + kstep, voffB);
        PG8_WAIT_V(6); PG8_BAR;
    }
    for (;;) {
        const bool has_next = S.next(ui + 1, nxt);
        const char* nA = has_next ? (const char*)g.A + (size_t)nxt.pm * tstep : cA; const char* nB = has_next ? (const char*)g.Bt + (size_t)nxt.pn * tstep : cB;
        for (int t = 0; t < nt; t += 2) {
            const bool last = (t == nt - 2);
            const char* a1 = cA + (size_t)(t + 1) * kstep;
            const char* a2 = last ? nA : cA + (size_t)(t + 2) * kstep; const char* b2 = last ? nB : cB + (size_t)(t + 2) * kstep;
            const char* a3 = a2 + kstep; const char* b3 = b2 + kstep;
            if (last && has_next) S.a_ready(nxt);
            if constexpr (SP2) {
            PG8_LDB(B0, 0, 0); PG8_LDB(B1, 0, 1); PG8_SCHED; PG8_LDA(At, 0, 0); PG8_STAGE(PG8_SA(1, 1), a1 + hstep, voffA);
            PG8_WAIT_V(8); PG8_WAIT_L(0); PG8_BAR; PG8_MMA(0, 0, At, B0); PG8_MMA(0, 1, At, B1); PG8_BAR; PG8_SCHED;
            PG8_LDA(At, 0, 1); PG8_STAGE(PG8_SB(0, 0), b2, voffB); PG8_STAGE(PG8_SB(0, 1), b2 + hstep, voffB); PG8_STAGE(PG8_SA(0, 0), a2, voffA);
            PG8_WAIT_V(8); PG8_WAIT_L(0); PG8_BAR; PG8_MMA(1, 0, At, B0); PG8_MMA(1, 1, At, B1); PG8_BAR; PG8_SCHED;
            PG8_LDB(B0, 1, 0); PG8_LDB(B1, 1, 1); PG8_SCHED; PG8_LDA(At, 1, 0); PG8_STAGE(PG8_SA(0, 1), a2 + hstep, voffA);
            PG8_WAIT_V(8); PG8_WAIT_L(0); PG8_BAR; PG8_MMA(0, 0, At, B0); PG8_MMA(0, 1, At, B1); PG8_BAR; PG8_SCHED;
            PG8_LDA(At, 1, 1); PG8_STAGE(PG8_SB(1, 0), b3, voffB); PG8_STAGE(PG8_SB(1, 1), b3 + hstep, voffB); PG8_STAGE(PG8_SA(1, 0), a3, voffA);
            PG8_WAIT_V(8); PG8_WAIT_L(0); PG8_BAR; PG8_MMA(1, 0, At, B0); PG8_MMA(1, 1, At, B1); PG8_BAR; PG8_SCHED;
            } else {
            PG8_LDB(B0, 0, 0); PG8_SCHED; PG8_LDA(At, 0, 0); PG8_STAGE(PG8_SA(1, 1), a1 + hstep, voffA);
            PG8_WAIT_L(8); PG8_BAR; PG8_WAIT_L(0); PG8_MMA(0, 0, At, B0); PG8_BAR; PG8_SCHED;
            PG8_LDB(B1, 0, 1); PG8_STAGE(PG8_SB(0, 0), b2, voffB);
            PG8_BAR; PG8_WAIT_L(0); PG8_MMA(0, 1, At, B1); PG8_BAR;
            PG8_LDA(At, 0, 1); PG8_STAGE(PG8_SA(0, 0), a2, voffA);
            PG8_BAR; PG8_WAIT_L(0); PG8_MMA(1, 0, At, B0); PG8_BAR; PG8_SCHED;
            PG8_STAGE(PG8_SB(0, 1), b2 + hstep, voffB);
            PG8_WAIT_V(6); PG8_BAR; PG8_MMA(1, 1, At, B1); PG8_BAR;
            PG8_LDB(B0, 1, 0); PG8_SCHED; PG8_LDA(At, 1, 0); PG8_STAGE(PG8_SA(0, 1), a2 + hstep, voffA);
            PG8_WAIT_L(8); PG8_BAR; PG8_WAIT_L(0); PG8_MMA(0, 0, At, B0); PG8_BAR; PG8_SCHED;
            PG8_LDB(B1, 1, 1); PG8_STAGE(PG8_SB(1, 0), b3, voffB);
            PG8_BAR; PG8_WAIT_L(0); PG8_MMA(0, 1, At, B1); PG8_BAR;
            PG8_LDA(At, 1, 1); PG8_STAGE(PG8_SA(1, 0), a3, voffA);
            PG8_BAR; PG8_WAIT_L(0); PG8_MMA(1, 0, At, B0); PG8_BAR; PG8_SCHED;
            PG8_STAGE(PG8_SB(1, 1), b3 + hstep, voffB);
            PG8_WAIT_V(6); PG8_BAR; PG8_MMA(1, 1, At, B1); PG8_BAR;
            }
        }
        if constexpr (ALIGN_EPI) { if (wr == 0) PG8_BAR; }
        if constexpr (!Epi::AFTER_DRAIN) { E(acc, cur, wr, wc, fr, fq); S.done(cur); }
        if (!has_next) break;
#pragma unroll
        for (int a = 0; a < 2; ++a)
#pragma unroll
            for (int b = 0; b < 2; ++b)
#pragma unroll
                for (int m = 0; m < 4; ++m)
#pragma unroll
                    for (int n = 0; n < 2; ++n) acc[a][b][m][n] = (f32x4){0.f, 0.f, 0.f, 0.f};
        cur = nxt; cA = nA; cB = nB; ++ui;
        if constexpr (ALIGN_EPI) { if (wr == 1) PG8_BAR; }
    }
    PG8_WAIT_V(0);
    if constexpr (!ALIGN_EPI) { if (wr == 0) PG8_BAR; }
    PG8_BAR;
    if constexpr (Epi::AFTER_DRAIN) { E.fused(acc, cur, wr, wc, fr, fq, lds, wid, lane); S.done(cur); }
#undef PG8_SA
#undef PG8_SB
#undef PG8_STAGE
#undef PG8_LDA
#undef PG8_LDB
#undef PG8_MMA
#undef PG8_WAIT_V
#undef PG8_WAIT_L
#undef PG8_BAR
#undef PG8_SCHED
}
}

typedef float f32x16 __attribute__((ext_vector_type(16)));
typedef short s16x4 __attribute__((ext_vector_type(4)));
typedef short v4i16_t __attribute__((ext_vector_type(4)));
typedef float f32x2_t __attribute__((ext_vector_type(2)));
typedef __bf16 bf16x2_t __attribute__((ext_vector_type(2)));
#define LAS __attribute__((address_space(3)))
constexpr int VROW = 144, VBUF = 32 * VROW;
constexpr int VROWV = 192, VBUFV = 32 * VROWV;
constexpr float L2E = 1.4426950408889634f, LN2 = 0.6931471805599453f;
constexpr float SC2 = 0.125f * L2E;

__device__ __forceinline__ int crow(int r, int hi) { return (r & 3) + 8 * (r >> 2) + 4 * hi; }
__device__ __forceinline__ unsigned cvtpk(float lo, float hi) { f32x2_t v = {lo, hi}; bf16x2_t b = __builtin_convertvector(v, bf16x2_t); return __builtin_bit_cast(unsigned, b); }
__device__ __forceinline__ float xhalf(float v, int hi) {
    auto r = __builtin_amdgcn_permlane32_swap(__float_as_uint(v), __float_as_uint(v), false, false);
    return __uint_as_float(hi ? r[0] : r[1]);
}
__device__ __forceinline__ s16x4 vtr(const LAS unsigned char* p) { return __builtin_bit_cast(s16x4, __builtin_amdgcn_ds_read_tr16_b64_v4i16((LAS v4i16_t*)p)); }

struct KVRegs { u32x4 k[4]; u32x4 v[4]; };
__device__ __forceinline__ void load_kv(KVRegs& R, const bf16* base, int kp0, int kst, int kcol, int vcol, int lane) {
#pragma unroll
    for (int j = 0; j < 4; ++j) {
        const int pos = kp0 + kst * (8 * j + (lane >> 3));
        const int pc = pos < SQ - 1 ? pos : SQ - 1;
        const bf16* rp = base + (size_t)pc * QKV_LD + (lane & 7) * 8;
        R.k[j] = *(const u32x4*)(rp + kcol); R.v[j] = *(const u32x4*)(rp + vcol);
    }
}
__device__ __forceinline__ void kv_stage(const KVRegs& R, LAS unsigned char* klds, LAS unsigned char* vlds, int lane) {
#pragma unroll
    for (int j = 0; j < 4; ++j) { const int r_ = 8 * j + (lane >> 3), c_ = (lane & 7) * 16; *(LAS u32x4*)(klds + r_ * VROW + c_) = R.k[j]; *(LAS u32x4*)(vlds + r_ * VROWV + c_) = R.v[j]; }
}
__device__ __forceinline__ f32x16 qk_tile(const LAS unsigned char* klds, const bf16x8 (&qf)[4], int r32, int hi) {
    f32x16 s = {0.f, 0.f, 0.f, 0.f, 0.f, 0.f, 0.f, 0.f, 0.f, 0.f, 0.f, 0.f, 0.f, 0.f, 0.f, 0.f};
#pragma unroll
    for (int k = 0; k < 4; ++k) { const bf16x8 kf = *(const LAS bf16x8*)(klds + r32 * VROW + (2 * k + hi) * 16); s = __builtin_amdgcn_mfma_f32_32x32x16_bf16(kf, qf[k], s, 0, 0, 0); }
    return s;
}
__device__ __forceinline__ void pv_tile(f32x16 (&o)[2], const f32x16& p, const LAS unsigned char* vlds, int lane) {
    const int g = lane >> 4, i = lane & 15, h = lane >> 5;
    const LAS unsigned char* vb = vlds + (4 * h + (i >> 2)) * VROWV + (16 * (g & 1) + 4 * (i & 3)) * 2;
#pragma unroll
    for (int s = 0; s < 2; ++s) {
        u32x4 pw; pw.x = cvtpk(p[8 * s], p[8 * s + 1]); pw.y = cvtpk(p[8 * s + 2], p[8 * s + 3]); pw.z = cvtpk(p[8 * s + 4], p[8 * s + 5]); pw.w = cvtpk(p[8 * s + 6], p[8 * s + 7]);
        const bf16x8 pb = __builtin_bit_cast(bf16x8, pw);
#pragma unroll
        for (int df = 0; df < 2; ++df) {
            const s16x4 lo = vtr(vb + (16 * s) * VROWV + df * 64), hh = vtr(vb + (16 * s + 8) * VROWV + df * 64);
            const bf16x8 va = (bf16x8){lo[0], lo[1], lo[2], lo[3], hh[0], hh[1], hh[2], hh[3]};
            o[df] = __builtin_amdgcn_mfma_f32_32x32x16_bf16(va, pb, o[df], 0, 0, 0);
        }
    }
}
__device__ __forceinline__ void load_q(bf16x8 (&qf)[4], const bf16* base, int qpos, int qcol, int hi) {
    const bf16* rp = base + (size_t)qpos * QKV_LD + qcol + 8 * hi;
#pragma unroll
    for (int k = 0; k < 4; ++k) qf[k] = *(const bf16x8*)(rp + 16 * k);
}
__device__ __forceinline__ void store_o(bf16* yrow, const f32x16 (&o)[2], float inv, int hi) {
#pragma unroll
    for (int df = 0; df < 2; ++df)
#pragma unroll
        for (int g = 0; g < 4; ++g) {
            u32x2 w; w.x = cvtpk(o[df][4 * g] * inv, o[df][4 * g + 1] * inv); w.y = cvtpk(o[df][4 * g + 2] * inv, o[df][4 * g + 3] * inv);
            *(u32x2*)(yrow + 32 * df + 8 * g + 4 * hi) = w;
        }
}
__device__ __forceinline__ void osm_tile(f32x16& s, float& m, float& l, f32x16 (&o)[2]) {
    float mx = s[0];
#pragma unroll
    for (int r = 1; r < 16; ++r) mx = fmaxf(mx, s[r]);
    { auto rr = __builtin_amdgcn_permlane32_swap(__float_as_uint(mx), __float_as_uint(mx), false, false); mx = fmaxf(__uint_as_float(rr[0]), __uint_as_float(rr[1])); }
    const float mn = fmaxf(m, mx);
    const float ms = (mn == -INFINITY) ? 0.f : mn;
    const float alpha = __builtin_amdgcn_exp2f((m - ms) * SC2);
    const float mc = ms * SC2;
    float ps = 0.f;
#pragma unroll
    for (int r = 0; r < 16; ++r) { s[r] = __builtin_amdgcn_exp2f(s[r] * SC2 - mc); ps += s[r]; }
    l = l * alpha + ps; m = mn;
    if (!__all(alpha == 1.0f)) {
#pragma unroll
        for (int df = 0; df < 2; ++df)
#pragma unroll
            for (int r = 0; r < 16; ++r) o[df][r] *= alpha;
    }
}
__device__ __forceinline__ void osm_tile2(f32x16& s0, f32x16& s1, float& m, float& l, f32x16 (&o)[2]) {
    float mx = fmaxf(s0[0], s1[0]);
#pragma unroll
    for (int r = 1; r < 16; ++r) mx = fmaxf(mx, fmaxf(s0[r], s1[r]));
    { auto rr = __builtin_amdgcn_permlane32_swap(__float_as_uint(mx), __float_as_uint(mx), false, false); mx = fmaxf(__uint_as_float(rr[0]), __uint_as_float(rr[1])); }
    const float mn = fmaxf(m, mx);
    const float ms = (mn == -INFINITY) ? 0.f : mn;
    const float alpha = __builtin_amdgcn_exp2f((m - ms) * SC2);
    const float mc = ms * SC2;
    float ps0 = 0.f, ps1 = 0.f;
#pragma unroll
    for (int r = 0; r < 16; ++r) { s0[r] = __builtin_amdgcn_exp2f(s0[r] * SC2 - mc); ps0 += s0[r]; s1[r] = __builtin_amdgcn_exp2f(s1[r] * SC2 - mc); ps1 += s1[r]; }
    l = l * alpha + (ps0 + ps1); m = mn;
    if (!__all(alpha == 1.0f)) {
#pragma unroll
        for (int df = 0; df < 2; ++df)
#pragma unroll
            for (int r = 0; r < 16; ++r) o[df][r] *= alpha;
    }
}
#define ZERO16 {0.f, 0.f, 0.f, 0.f, 0.f, 0.f, 0.f, 0.f, 0.f, 0.f, 0.f, 0.f, 0.f, 0.f, 0.f, 0.f}

struct AttnCtx {
    const bf16* base; int kcol, vcol, r32, hi, lane; LAS unsigned char* vlds; LAS unsigned char* klds; bf16x8 qf[4]; f32x16 o[2];
};
#define ATTN_STEP(SC, SL, T) { \
        if (SYNC) __builtin_amdgcn_s_barrier(); \
        { int kp_, ks_; const int tl_ = (T) + 2 < nt ? (T) + 2 : nt - 1; mx.pos(tl_, kp_, ks_); load_kv(SL, c.base, kp_, ks_, c.kcol, c.vcol, c.lane); } \
        kv_stage(SC, c.klds, c.vlds, c.lane); f32x16 s_ = qk_tile(c.klds, c.qf, c.r32, c.hi); \
        const bool stop_ = mx.process((T), s_, c); pv_tile(c.o, s_, c.vlds, c.lane); \
        if ((!SYNC && stop_) || (T) + 1 >= nt) break; }
template <class M, bool SYNC> __device__ __forceinline__ void attn_run(M& mx, AttnCtx& c) {
    const int nt = mx.nt;
    KVRegs S0, S1, S2;
    { int kp, ks; mx.pos(0, kp, ks); load_kv(S0, c.base, kp, ks, c.kcol, c.vcol, c.lane);
      mx.pos(1 < nt ? 1 : nt - 1, kp, ks); load_kv(S1, c.base, kp, ks, c.kcol, c.vcol, c.lane); }
    for (int t = 0;; t += 3) {
        ATTN_STEP(S0, S2, t)
        ATTN_STEP(S1, S0, t + 1)
        ATTN_STEP(S2, S1, t + 2)
    }
}
#define SH_BAR() asm volatile("s_waitcnt lgkmcnt(0)\n\ts_barrier" ::: "memory")
constexpr int SLOT_K = 64 * VROW, SLOT_BYTES = 64 * VROW + 64 * VROWV;
struct ShRegs { u32x4 a, b; };
__device__ __forceinline__ void sh_load(ShRegs& R, const bf16* base, int kp0, int kcol, int vcol, int w, int lane) {
    const int pos = kp0 + 4 * w + ((lane & 31) >> 3);
    const int pa = pos < SQ - 1 ? pos : SQ - 1, pb = pos + 32 < SQ - 1 ? pos + 32 : SQ - 1;
    const int col = ((lane >> 5) ? vcol : kcol) + (lane & 7) * 8;
    R.a = *(const u32x4*)(base + (size_t)pa * QKV_LD + col); R.b = *(const u32x4*)(base + (size_t)pb * QKV_LD + col);
}
__device__ __forceinline__ void sh_write(LAS unsigned char* slot, const ShRegs& R, int w, int lane) {
    const int row = 4 * w + ((lane & 31) >> 3);
    LAS unsigned char* p = slot + ((lane >> 5) ? SLOT_K + row * VROWV : row * VROW) + (lane & 7) * 16;
    *(LAS u32x4*)p = R.a; *(LAS u32x4*)(p + 32 * ((lane >> 5) ? VROWV : VROW)) = R.b;
}
#define SH_STEP(RW, RL, T) { \
        SH_BAR(); \
        { const int tl_ = (T) + 2 < nt ? (T) + 2 : nt - 1; sh_load(RL, c.base, mx.pos2(tl_), c.kcol, c.vcol, w, c.lane); } \
        sh_write(slots + (((T) + 1) & 1) * SLOT_BYTES, RW, w, c.lane); \
        if (mx.active2((T), w)) { LAS unsigned char* sl_ = slots + ((T) & 1) * SLOT_BYTES; \
            f32x16 s0_ = qk_tile(sl_, c.qf, c.r32, c.hi), s1_ = qk_tile(sl_ + 32 * VROW, c.qf, c.r32, c.hi); mx.process2((T), s0_, s1_, c); \
            pv_tile(c.o, s0_, sl_ + SLOT_K, c.lane); pv_tile(c.o, s1_, sl_ + SLOT_K + 32 * VROWV, c.lane); } \
        if ((T) + 1 >= nt) break; }
template <class M> __device__ __forceinline__ void attn_run_shared(M& mx, AttnCtx& c, LAS unsigned char* slots, int w) {
    const int nt = mx.nt2;
    ShRegs R0, R1, R2;
    sh_load(R0, c.base, mx.pos2(0), c.kcol, c.vcol, w, c.lane);
    sh_load(R1, c.base, mx.pos2(1 < nt ? 1 : nt - 1), c.kcol, c.vcol, w, c.lane);
    SH_BAR();
    sh_write(slots, R0, w, c.lane);
    for (int t = 0;; t += 3) {
        SH_STEP(R1, R2, t)
        SH_STEP(R2, R0, t + 1)
        SH_STEP(R0, R1, t + 2)
    }
}
struct MixA {
    int nt, k00, qpos; float m, l;
    __device__ __forceinline__ void pos(int idx, int& kp0, int& kst) const { kp0 = k00 + 32 * idx; kst = 1; }
    __device__ __forceinline__ bool process(int idx, f32x16& s, AttnCtx& c) {
        const int k0 = k00 + 32 * idx;
#pragma unroll
        for (int r = 0; r < 16; ++r) { const int dist = qpos - (k0 + crow(r, c.hi)); if (dist < 0 || dist > 127) s[r] = -INFINITY; }
        osm_tile(s, m, l, c.o); return false;
    }
};
__device__ void attn_A(const bf16* base, int hq, int q0, float sink, bf16* ybase, LAS unsigned char* vlds, int lane) {
    AttnCtx c; c.base = base; c.r32 = lane & 31; c.hi = lane >> 5; c.lane = lane; c.vlds = vlds; c.klds = vlds + VBUFV; c.kcol = 512 + (hq >> 2) * 64; c.vcol = 640 + (hq >> 2) * 64;
    c.o[0] = (f32x16)ZERO16; c.o[1] = (f32x16)ZERO16;
    MixA mx; mx.qpos = q0 + c.r32; mx.k00 = q0 - 128 > 0 ? q0 - 128 : 0; mx.nt = 5; mx.m = -INFINITY; mx.l = 0.f;
    load_q(c.qf, base, mx.qpos, hq * 64, c.hi);
    attn_run<MixA, true>(mx, c);
    float l = mx.l + xhalf(mx.l, c.hi);
    l += __builtin_amdgcn_exp2f(sink * L2E - mx.m * SC2);
    store_o(ybase + (size_t)mx.qpos * DM + hq * 64, c.o, 1.0f / l, c.hi);
}
struct MixB {
    int nt, q0, qpos; float carry;
    __device__ __forceinline__ void pos(int idx, int& kp0, int& kst) const { kp0 = q0 - 32 * idx; kst = 1; }
    __device__ __forceinline__ bool process(int idx, f32x16& s, AttnCtx& c) {
        const int k0 = q0 - 32 * idx, hi = c.hi;
        float lk[16], G[4], Gp[4];
#pragma unroll
        for (int r = 0; r < 16; ++r) {
            const float z = s[r] * 0.125f;
            const bool valid = (k0 + crow(r, hi)) < qpos;
            const float sp = fmaxf(z, 0.f) + LN2 * __builtin_amdgcn_logf(1.0f + __builtin_amdgcn_exp2f(-fabsf(z) * L2E));
            lk[r] = valid ? -sp : 0.f;
            s[r] = valid ? (z - sp) : -INFINITY;
        }
#pragma unroll
        for (int g = 0; g < 4; ++g) { G[g] = (lk[4 * g] + lk[4 * g + 1]) + (lk[4 * g + 2] + lk[4 * g + 3]); Gp[g] = xhalf(G[g], hi); }
        float above = carry;
#pragma unroll
        for (int g = 3; g >= 0; --g) {
            float off = above + (hi == 0 ? Gp[g] : 0.f);
            s[4 * g + 3] = __builtin_amdgcn_exp2f((s[4 * g + 3] + off) * L2E); off += lk[4 * g + 3];
            s[4 * g + 2] = __builtin_amdgcn_exp2f((s[4 * g + 2] + off) * L2E); off += lk[4 * g + 2];
            s[4 * g + 1] = __builtin_amdgcn_exp2f((s[4 * g + 1] + off) * L2E); off += lk[4 * g + 1];
            s[4 * g + 0] = __builtin_amdgcn_exp2f((s[4 * g + 0] + off) * L2E);
            above += G[g] + Gp[g];
        }
        carry = above;
        return __all(carry < -40.0f) != 0;
    }
};
__device__ void attn_B(const bf16* base, int h, int q0, bf16* ybase, LAS unsigned char* vlds, int lane) {
    AttnCtx c; c.base = base; c.r32 = lane & 31; c.hi = lane >> 5; c.lane = lane; c.vlds = vlds; c.klds = vlds + VBUFV; c.kcol = 1280 + h * 64; c.vcol = 1792 + h * 64;
    c.o[0] = (f32x16)ZERO16; c.o[1] = (f32x16)ZERO16;
    MixB mx; mx.q0 = q0; mx.qpos = q0 + c.r32; mx.nt = q0 / 32 + 1; mx.carry = 0.f;
    load_q(c.qf, base, mx.qpos, 768 + h * 64, c.hi);
    attn_run<MixB, false>(mx, c);
    store_o(ybase + (size_t)mx.qpos * DM + 512 + h * 64, c.o, 1.0f, c.hi);
}
struct MixCp {
    int nt, n0, r0, j1lo, qpos; float m, l;
    __device__ __forceinline__ void pos(int t, int& kp0, int& kst) const {
        if (t < n0) { kp0 = r0 + 512 * t; kst = 16; } else { kp0 = (r0 & 3) + 4 * (j1lo + 32 * (t - n0)); kst = 4; }
    }
    __device__ __forceinline__ bool process(int t, f32x16& s, AttnCtx& c) {
        int kp0, kst; pos(t, kp0, kst);
        const int win = t < n0 ? 2048 : 512;
#pragma unroll
        for (int r = 0; r < 16; ++r) { const int dist = qpos - (kp0 + kst * crow(r, c.hi)); if (dist < 0 || dist > win) s[r] = -INFINITY; }
        osm_tile(s, m, l, c.o); return false;
    }
};
struct MixC1 {
    int nt2, p0, qpos; float m, l;
    __device__ __forceinline__ int pos2(int T) const { return p0 + 64 * T; }
    __device__ __forceinline__ bool active2(int T, int w) const { return true; }
    __device__ __forceinline__ void process2(int T, f32x16& s0, f32x16& s1, AttnCtx& c) {
        const int k0 = p0 + 64 * T;
#pragma unroll
        for (int r = 0; r < 16; ++r) { const int dist = qpos - (k0 + crow(r, c.hi)); if (dist < 0 || dist > 128) s0[r] = -INFINITY; if (dist < 32 || dist > 160) s1[r] = -INFINITY; }
        osm_tile2(s0, s1, m, l, c.o);
    }
};
__device__ void attn_C(const bf16* base, int h, int r0, int g, bf16* ybase, LAS unsigned char* vlds, LAS unsigned char* xlds, int w, int lane) {
    AttnCtx c; c.base = base; c.r32 = lane & 31; c.hi = lane >> 5; c.lane = lane; c.vlds = vlds; c.klds = vlds + VBUFV; c.kcol = 512 + h * 64; c.vcol = 1024 + h * 64;
    c.o[0] = (f32x16)ZERO16; c.o[1] = (f32x16)ZERO16;
    const int qpos = r0 + 16 * (32 * g + c.r32);
    load_q(c.qf, base, qpos, h * 64, c.hi);
    MixCp mp; mp.r0 = r0; mp.qpos = qpos; mp.m = -INFINITY; mp.l = 0.f;
    mp.n0 = g + 1;
    mp.j1lo = (r0 >> 2) + 128 * g - 128 > 0 ? (r0 >> 2) + 128 * g - 128 : 0;
    mp.nt = mp.n0 + ((r0 >> 2) + 128 * g + 124 - mp.j1lo) / 32 + 1;
    attn_run<MixCp, true>(mp, c);
    MixC1 m1; m1.qpos = qpos; m1.m = mp.m; m1.l = mp.l;
    const int ra = r0 & 8;
    m1.p0 = 512 * g + ra - 128 > 0 ? 512 * g + ra - 128 : 0;
    m1.nt2 = ((512 * g + ra + 7 + 496 - m1.p0) / 32 + 2) / 2;
    attn_run_shared<MixC1>(m1, c, xlds + 64, w);
    const float l = m1.l + xhalf(m1.l, c.hi);
    store_o(ybase + (size_t)qpos * DM + h * 64, c.o, 1.0f / l, c.hi);
}
struct MixD {
    int nt, nt2, npast, own, q0, qpos; unsigned U, sel; float m, l;
    __device__ __forceinline__ int blk_of(int j) const {
        unsigned u = U; int b = 0;
#pragma unroll
        for (int i = 0; i < 7; ++i) { if (i < j) u &= u - 1u; }
        b = __builtin_ctz(u | 0x100u); return b;
    }
    __device__ __forceinline__ void pos(int t, int& kp0, int& kst) const {
        kst = 1;
        if (t < 8 * npast) kp0 = blk_of(t >> 3) * 256 + (t & 7) * 32; else kp0 = own * 256 + (t - 8 * npast) * 32;
    }
    __device__ __forceinline__ int pos2(int T) const { int kp, ks; pos(2 * T, kp, ks); return kp; }
    __device__ __forceinline__ bool active2(int T, int w) const { return T < 4 * npast || 2 * (T - 4 * npast) <= w; }
    __device__ __forceinline__ void process2(int T, f32x16& s0, f32x16& s1, AttnCtx& c) {
        if (T < 4 * npast) {
            const int blk = blk_of(T >> 2);
            if (!((sel >> blk) & 1u)) {
#pragma unroll
                for (int r = 0; r < 16; ++r) { s0[r] = -INFINITY; s1[r] = -INFINITY; }
            }
        } else {
            const int k0 = own * 256 + (T - 4 * npast) * 64;
#pragma unroll
            for (int r = 0; r < 16; ++r) { const int kk = k0 + crow(r, c.hi); if (kk > qpos) s0[r] = -INFINITY; if (kk + 32 > qpos) s1[r] = -INFINITY; }
        }
        osm_tile2(s0, s1, m, l, c.o);
    }
};
__device__ void attn_D(const bf16* base, const float* kmean  , int h, int q0, bf16* ybase, LAS unsigned char* vlds, LAS unsigned char* xlds, int lane) {
    AttnCtx c; c.base = base; c.r32 = lane & 31; c.hi = lane >> 5; c.lane = lane; c.vlds = vlds; c.klds = vlds + VBUFV; c.kcol = 2048 + h * 64; c.vcol = 2560 + h * 64;
    c.o[0] = (f32x16)ZERO16; c.o[1] = (f32x16)ZERO16;
    const int r32 = c.r32, hi = c.hi, own = q0 >> 8;
    MixD mx; mx.own = own; mx.q0 = q0; mx.qpos = q0 + r32; mx.m = -INFINITY; mx.l = 0.f;
    load_q(c.qf, base, mx.qpos, 1536 + h * 64, hi);
    unsigned sel = 0u;
    if (own > 0) {
        bf16x8 kf[4];
#pragma unroll
        for (int k = 0; k < 4; ++k) {
            u32x4 w = {0u, 0u, 0u, 0u};
            if (r32 < 8) { const float* kp = kmean + r32 * 64 + 16 * k + 8 * hi; const f32x4 a = *(const f32x4*)kp, b = *(const f32x4*)(kp + 4);
                w.x = cvtpk(a[0], a[1]); w.y = cvtpk(a[2], a[3]); w.z = cvtpk(b[0], b[1]); w.w = cvtpk(b[2], b[3]); }
            kf[k] = __builtin_bit_cast(bf16x8, w);
        }
        f32x16 gs = ZERO16;
#pragma unroll
        for (int k = 0; k < 4; ++k) gs = __builtin_amdgcn_mfma_f32_32x32x16_bf16(kf[k], c.qf[k], gs, 0, 0, 0);
        float gt[8];
#pragma unroll
        for (int r = 0; r < 4; ++r) { const float mine = gs[r], oth = xhalf(mine, hi); gt[r] = hi == 0 ? mine : oth; gt[4 + r] = hi == 0 ? oth : mine; }
        const int nsel = own < 3 ? own : 3;
        for (int rr = 0; rr < nsel; ++rr) {
            float best = -INFINITY; int bi = -1;
#pragma unroll
            for (int n = 0; n < 8; ++n) { const bool ok = n < own && !((sel >> n) & 1u) && (bi < 0 || gt[n] > best); if (ok) { best = gt[n]; bi = n; } }
            if (bi >= 0) sel |= 1u << bi;
        }
    }
    unsigned U = 0u;
#pragma unroll
    for (int n = 0; n < 8; ++n) if (__ballot((sel >> n) & 1u) != 0ull) U |= 1u << n;
    {
        volatile LAS unsigned* ux = (volatile LAS unsigned*)xlds;
        __builtin_amdgcn_s_barrier();
        if (lane == 0) ux[(q0 >> 5) & 7] = U;
        asm volatile("s_waitcnt lgkmcnt(0)" ::: "memory");
        __builtin_amdgcn_s_barrier();
        U = ux[0] | ux[1] | ux[2] | ux[3] | ux[4] | ux[5] | ux[6] | ux[7];
        U = __builtin_amdgcn_readfirstlane(U);
    }
    mx.U = U; mx.sel = sel; mx.npast = __builtin_popcount(U); mx.nt = 8 * mx.npast + 8; mx.nt2 = 4 * mx.npast + 4;
    attn_run_shared<MixD>(mx, c, xlds + 64, (q0 >> 5) & 7);
    const float l = mx.l + xhalf(mx.l, c.hi);
    store_o(ybase + (size_t)mx.qpos * DM + 512 + h * 64, c.o, 1.0f / l, hi);
}

__device__ void ph_attn0(const bf16* qkv, const float* sinks, bf16* y, LAS unsigned char* lds, int bid, int nb) {
    const int lane = ltid() & 63, w = __builtin_amdgcn_readfirstlane(ltid() >> 6);
    LAS unsigned char* vlds = lds + w * (VBUF + VBUFV);
    for (int pid = bid; pid < NB * 8; pid += nb) {
        const int b = pid >> 3, h = pid & 7;
        const bf16* base = qkv + (size_t)b * SQ * QKV_LD; bf16* ybase = y + (size_t)b * SQ * DM;
        const float sink = sinks[h];
        for (int rd = 0; rd < 8; ++rd) attn_A(base, h, (rd * 8 + w) * 32, sink, ybase, vlds, lane);
        for (int rd = 0; rd < 8; ++rd) attn_B(base, h, (rd * 8 + w) * 32, ybase, vlds, lane);
    }
}
__device__ void ph_attn1(const bf16* qkv, const float* kmean, bf16* y, LAS unsigned char* lds, int bid, int nb) {
    const int lane = ltid() & 63, w = __builtin_amdgcn_readfirstlane(ltid() >> 6);
    LAS unsigned char* vlds = lds + w * (VBUF + VBUFV);
    for (int pid = bid; pid < NB * 8; pid += nb) {
        const int b = pid >> 3, h = pid & 7;
        const bf16* base = qkv + (size_t)b * SQ * QKV_LD; bf16* ybase = y + (size_t)b * SQ * DM;
        for (int rd = 0; rd < 8; ++rd) { const int it = rd * 8 + w; attn_C(base, h, it & 15, it >> 4, ybase, vlds, lds + 8 * (VBUF + VBUFV), w, lane); }
        for (int rd = 0; rd < 8; ++rd) attn_D(base, kmean + (size_t)pid * 8 * 64, h, (rd * 8 + w) * 32, ybase, vlds, lds + 8 * (VBUF + VBUFV), lane);
    }
}

#define CE_D(a, b) { const float hi_ = fmaxf((a), (b)), lo_ = fminf((a), (b)); (a) = hi_; (b) = lo_; }
#define BSTAGE(arr, k, j) _Pragma("unroll") for (int i_ = 0; i_ < 16; ++i_) { const int l_ = i_ ^ (j); if (l_ > i_) { if ((i_ & (k)) == 0) CE_D(arr[i_], arr[l_]) else CE_D(arr[l_], arr[i_]) } }
__device__ __forceinline__ void bsort16(float (&a)[16]) {
    BSTAGE(a, 2, 1) BSTAGE(a, 4, 2) BSTAGE(a, 4, 1) BSTAGE(a, 8, 4) BSTAGE(a, 8, 2) BSTAGE(a, 8, 1) BSTAGE(a, 16, 8) BSTAGE(a, 16, 4) BSTAGE(a, 16, 2) BSTAGE(a, 16, 1)
}
__device__ __forceinline__ void bmerge16(float (&a)[16]) {
    BSTAGE(a, 16, 8) BSTAGE(a, 16, 4) BSTAGE(a, 16, 2) BSTAGE(a, 16, 1)
}
__device__ __forceinline__ void merge_top16(float (&a)[16], const float (&b)[16]) {
#pragma unroll
    for (int i = 0; i < 16; ++i) a[i] = fmaxf(a[i], b[15 - i]);
    bmerge16(a);
}
__device__ __forceinline__ void xmerge16(float (&a)[16]) {
    {
        float A[16], B[16];
#pragma unroll
        for (int i = 0; i < 16; ++i) { auto r = __builtin_amdgcn_permlane16_swap(__float_as_uint(a[i]), __float_as_uint(a[i]), false, false); A[i] = __uint_as_float(r[0]); B[i] = __uint_as_float(r[1]); }
#pragma unroll
        for (int i = 0; i < 16; ++i) a[i] = fmaxf(A[i], B[15 - i]);
        bmerge16(a);
    }
    {
        float A[16], B[16];
#pragma unroll
        for (int i = 0; i < 16; ++i) { auto r = __builtin_amdgcn_permlane32_swap(__float_as_uint(a[i]), __float_as_uint(a[i]), false, false); A[i] = __uint_as_float(r[0]); B[i] = __uint_as_float(r[1]); }
#pragma unroll
        for (int i = 0; i < 16; ++i) a[i] = fmaxf(A[i], B[15 - i]);
        bmerge16(a);
    }
}
__host__ __device__ constexpr int pair_i(int id) {
    int c = 0;
    for (int i = 0; i < 16; ++i) { const int nj = 16 / (i + 1); if (id < c + nj) return i; c += nj; }
    return 0;
}
__host__ __device__ constexpr int pair_j(int id) {
    int c = 0;
    for (int i = 0; i < 16; ++i) { const int nj = 16 / (i + 1); if (id < c + nj) return id - c; c += nj; }
    return 0;
}
constexpr int SK_ROW = 272;
constexpr int SEL_SK_BYTES = 2 * 128 * SK_ROW;
constexpr int SEL_TAB_OFF = SEL_SK_BYTES;
constexpr int SEL_IDX_OFF = SEL_SK_BYTES + 64;

template <int S> __device__ __forceinline__ float cand_slot(const float (&L1)[16], const float (&L2)[16], int g) {
    constexpr int p0 = S, p1 = 16 + S, p2 = 32 + S, p3 = 48 + S;
    const float c0 = L1[pair_i(p0)] + L2[pair_j(p0)], c1 = L1[pair_i(p1)] + L2[pair_j(p1)], c2 = L1[pair_i(p2)] + L2[pair_j(p2)];
    const float c3 = p3 < 50 ? L1[pair_i(p3 < 50 ? p3 : 0)] + L2[pair_j(p3 < 50 ? p3 : 0)] : -1.0e30f;
    const float c = g == 0 ? c0 : (g == 1 ? c1 : (g == 2 ? c2 : c3));
    return __uint_as_float((__float_as_uint(c) & 0xffffffc0u) | (unsigned)(16 * g + S));
}

__device__ void ph_peer_select(const bf16* qry, const float* subkeys  , int* eidx, float* egate, LAS unsigned char* lds, int bid, int nb) {
    const int tid = ltid(), lane = tid & 63, w = __builtin_amdgcn_readfirstlane(tid >> 6);
    const int tk = lane & 15, g = lane >> 4;
    __syncthreads();
    for (int e = tid; e < 2 * 128 * 128 / 2; e += NT) {
        const int row = e >> 6, c2 = (e & 63) * 2;
        const float a = subkeys[(size_t)row * 128 + c2], b = subkeys[(size_t)row * 128 + c2 + 1];
        *(LAS unsigned*)(lds + row * SK_ROW + c2 * 2) = pk2(a, b);
    }
    if (tid < 64) { int id = tid; int c = 0, pi = 0, pj = 0;
        for (int i = 0; i < 16; ++i) { const int nj = 16 / (i + 1); if (id >= c && id < c + nj) { pi = i; pj = id - c; } c += nj; }
        lds[SEL_TAB_OFF + tid] = (unsigned char)((pi << 4) | pj); }
    __syncthreads();
    LAS unsigned* widx = (LAS unsigned*)(lds + SEL_IDX_OFF + w * 512);
    const LAS unsigned char* widx8 = (const LAS unsigned char*)widx;
    const int nitems = (MT / 16) * 8;
    for (int it = bid * 8 + w; it < nitems; it += nb * 8) {
        const int h = it & 7, t0 = (it >> 3) * 16;
        float L[2][16];
#pragma unroll
        for (int hf = 0; hf < 2; ++hf) {
            bf16x8 qf[4];
            const bf16* qp = qry + (size_t)(t0 + tk) * PQ + h * 256 + hf * 128 + 8 * g;
#pragma unroll
            for (int ks = 0; ks < 4; ++ks) qf[ks] = *(const bf16x8*)(qp + 32 * ks);
            float key[32];
#pragma unroll
            for (int tile = 0; tile < 8; ++tile) {
                f32x4 acc = {0.f, 0.f, 0.f, 0.f};
#pragma unroll
                for (int ks = 0; ks < 4; ++ks) {
                    const bf16x8 af = *(const LAS bf16x8*)(lds + (hf * 128 + tile * 16 + tk) * SK_ROW + (32 * ks + 8 * g) * 2);
                    acc = __builtin_amdgcn_mfma_f32_16x16x32_bf16(af, qf[ks], acc, 0, 0, 0);
                }
#pragma unroll
                for (int r = 0; r < 4; ++r) key[tile * 4 + r] = __uint_as_float((__float_as_uint(acc[r]) & 0xffffff80u) | (unsigned)(16 * tile + 4 * g + r));
            }
            float a[16], b[16];
#pragma unroll
            for (int i = 0; i < 16; ++i) { a[i] = key[i]; b[i] = key[16 + i]; }
            bsort16(a); bsort16(b);
            merge_top16(a, b);
            xmerge16(a);
#pragma unroll
            for (int i = 0; i < 16; ++i) L[hf][i] = a[i];
            unsigned pk = 0u;
#pragma unroll
            for (int s = 0; s < 4; ++s) {
                const float v = g == 0 ? a[s] : (g == 1 ? a[4 + s] : (g == 2 ? a[8 + s] : a[12 + s]));
                pk |= (__float_as_uint(v) & 127u) << (8 * s);
            }
            widx[tk * 8 + hf * 4 + g] = pk;
        }
        float c[16];
        c[0] = cand_slot<0>(L[0], L[1], g); c[1] = cand_slot<1>(L[0], L[1], g); c[2] = cand_slot<2>(L[0], L[1], g); c[3] = cand_slot<3>(L[0], L[1], g);
        c[4] = cand_slot<4>(L[0], L[1], g); c[5] = cand_slot<5>(L[0], L[1], g); c[6] = cand_slot<6>(L[0], L[1], g); c[7] = cand_slot<7>(L[0], L[1], g);
        c[8] = cand_slot<8>(L[0], L[1], g); c[9] = cand_slot<9>(L[0], L[1], g); c[10] = cand_slot<10>(L[0], L[1], g); c[11] = cand_slot<11>(L[0], L[1], g);
        c[12] = cand_slot<12>(L[0], L[1], g); c[13] = cand_slot<13>(L[0], L[1], g); c[14] = cand_slot<14>(L[0], L[1], g); c[15] = cand_slot<15>(L[0], L[1], g);
        bsort16(c);
        xmerge16(c);
        float sum = 0.f, ex[16];
#pragma unroll
        for (int i = 0; i < 16; ++i) { ex[i] = __builtin_amdgcn_exp2f((c[i] - c[0]) * L2E); sum += ex[i]; }
        const float inv = 1.0f / sum;
        int oi[4]; float og[4];
#pragma unroll
        for (int s = 0; s < 4; ++s) {
            const float kv = g == 0 ? c[s] : (g == 1 ? c[4 + s] : (g == 2 ? c[8 + s] : c[12 + s]));
            const float ev = g == 0 ? ex[s] : (g == 1 ? ex[4 + s] : (g == 2 ? ex[8 + s] : ex[12 + s]));
            const unsigned pid = __float_as_uint(kv) & 63u;
            const unsigned ij = lds[SEL_TAB_OFF + pid];
            const unsigned i1 = widx8[tk * 32 + (ij >> 4)], i2 = widx8[tk * 32 + 16 + (ij & 15u)];
            oi[s] = (int)(i1 * 128u + i2); og[s] = ev * inv;
        }
        const size_t ob = (size_t)(t0 + tk) * 128 + h * 16 + 4 * g;
        *(u32x4*)(eidx + ob) = (u32x4){(unsigned)oi[0], (unsigned)oi[1], (unsigned)oi[2], (unsigned)oi[3]};
        *(f32x4*)(egate + ob) = (f32x4){og[0], og[1], og[2], og[3]};
    }
    __syncthreads();
}

typedef float v32f_t __attribute__((ext_vector_type(32)));
typedef unsigned v6u_t __attribute__((ext_vector_type(6)));
typedef unsigned v16u_t __attribute__((ext_vector_type(16)));
typedef __bf16 v32bf_t __attribute__((ext_vector_type(32)));
typedef __bf16 v2bf_t __attribute__((ext_vector_type(2)));
typedef _Float16 v32h_t __attribute__((ext_vector_type(32)));
typedef unsigned u32x3 __attribute__((ext_vector_type(3)));
constexpr int TROW = 768;
__device__ void ph_tab_fp6(const float* src, unsigned char* dst, float* scale, int nrows, int bid, int nb) {
    const int lane = ltid() & 63, w = __builtin_amdgcn_readfirstlane(ltid() >> 6);
    for (int rp = bid * 8 + w; rp < nrows / 2; rp += nb * 8) {
        v32h_t hv; float sc[2];
#pragma unroll
        for (int rr = 0; rr < 2; ++rr) {
            const float* sp = src + (size_t)(2 * rp + rr) * DM + lane * 16;
            f32x4 v[4]; float am = 0.f;
#pragma unroll
            for (int i = 0; i < 4; ++i) { v[i] = *(const f32x4*)(sp + i * 4); am = fmaxf(am, fmaxf(fmaxf(fabsf(v[i][0]), fabsf(v[i][1])), fmaxf(fabsf(v[i][2]), fabsf(v[i][3])))); }
            am = wave_max(am);
            const float s = am > 0.f ? am * (1.0f / 7.5f) : 1.0f, inv = 1.0f / s;
            sc[rr] = s;
#pragma unroll
            for (int i = 0; i < 4; ++i)
#pragma unroll
                for (int e = 0; e < 4; ++e) hv[rr * 16 + i * 4 + e] = (_Float16)fminf(fmaxf(v[i][e] * inv, -7.5f), 7.5f);
        }
        const v6u_t pk = __builtin_amdgcn_cvt_scalef32_pk32_fp6_f16(hv, 1.0f);
        unsigned* d0 = (unsigned*)(dst + (size_t)(2 * rp) * TROW + lane * 12);
        unsigned* d1 = (unsigned*)(dst + (size_t)(2 * rp + 1) * TROW + lane * 12);
        d0[0] = pk[0]; d0[1] = pk[1]; d0[2] = pk[2]; d1[0] = pk[3]; d1[1] = pk[4]; d1[2] = pk[5];
        if (lane == 0) { scale[2 * rp] = sc[0]; scale[2 * rp + 1] = sc[1]; }
    }
}

constexpr int TROW4 = 512;
__device__ void ph_tab_fp4(const float* src, unsigned char* dst, float* scale, int nrows, int bid, int nb) {
    const int lane = ltid() & 63, w = __builtin_amdgcn_readfirstlane(ltid() >> 6);
    for (int row = bid * 8 + w; row < nrows; row += nb * 8) {
        const float* sp = src + (size_t)row * DM + lane * 16;
        f32x4 v[4]; float am = 0.f;
#pragma unroll
        for (int i = 0; i < 4; ++i) { v[i] = *(const f32x4*)(sp + i * 4); am = fmaxf(am, fmaxf(fmaxf(fabsf(v[i][0]), fabsf(v[i][1])), fmaxf(fabsf(v[i][2]), fabsf(v[i][3])))); }
        am = wave_max(am);
        const float s = am > 0.f ? am * (1.0f / 6.0f) : 1.0f, inv = 1.0f / s;
        unsigned d0 = 0u, d1 = 0u;
        d0 = __builtin_amdgcn_cvt_scalef32_pk_fp4_f32(d0, v[0][0] * inv, v[0][1] * inv, 1.0f, 0); d0 = __builtin_amdgcn_cvt_scalef32_pk_fp4_f32(d0, v[0][2] * inv, v[0][3] * inv, 1.0f, 1);
        d0 = __builtin_amdgcn_cvt_scalef32_pk_fp4_f32(d0, v[1][0] * inv, v[1][1] * inv, 1.0f, 2); d0 = __builtin_amdgcn_cvt_scalef32_pk_fp4_f32(d0, v[1][2] * inv, v[1][3] * inv, 1.0f, 3);
        d1 = __builtin_amdgcn_cvt_scalef32_pk_fp4_f32(d1, v[2][0] * inv, v[2][1] * inv, 1.0f, 0); d1 = __builtin_amdgcn_cvt_scalef32_pk_fp4_f32(d1, v[2][2] * inv, v[2][3] * inv, 1.0f, 1);
        d1 = __builtin_amdgcn_cvt_scalef32_pk_fp4_f32(d1, v[3][0] * inv, v[3][1] * inv, 1.0f, 2); d1 = __builtin_amdgcn_cvt_scalef32_pk_fp4_f32(d1, v[3][2] * inv, v[3][3] * inv, 1.0f, 3);
        *(u32x2*)(dst + (size_t)row * TROW4 + lane * 8) = (u32x2){d0, d1};
        if (lane == 0) scale[row] = s;
    }
}

#define DPP_ADD(v, ctrl) ((v) + __builtin_bit_cast(float, __builtin_amdgcn_update_dpp(0, __builtin_bit_cast(int, (v)), (ctrl), 0xf, 0xf, true)))
typedef int i32x4_t __attribute__((ext_vector_type(4)));
struct GSet { v6u_t uq[2]; u32x2 vq[4]; float g, su, sv; };
__device__ __forceinline__ void gather_issue(GSet& S, int bt, int lane, int kslot, const unsigned char* pu, const unsigned char* pv,
                                             const float* su, const float* sv, const LAS int* etok, const LAS float* gtok) {
    const i32x4_t ev = *(const LAS i32x4_t*)(etok + bt * 4);
    const int es[4] = {__builtin_amdgcn_readfirstlane(ev.x), __builtin_amdgcn_readfirstlane(ev.y), __builtin_amdgcn_readfirstlane(ev.z), __builtin_amdgcn_readfirstlane(ev.w)};
#pragma unroll
    for (int k = 0; k < 2; ++k) {
        const unsigned e0 = (unsigned)es[2 * k] * (unsigned)TROW + (unsigned)lane * 12u, e1 = (unsigned)es[2 * k + 1] * (unsigned)TROW + (unsigned)lane * 12u;
        const u32x3 a = *(const u32x3*)(pu + e0), c = *(const u32x3*)(pu + e1);
        S.uq[k] = (v6u_t){a.x, a.y, a.z, c.x, c.y, c.z};
        const unsigned f0 = (unsigned)es[2 * k] * (unsigned)TROW4 + (unsigned)lane * 8u, f1 = (unsigned)es[2 * k + 1] * (unsigned)TROW4 + (unsigned)lane * 8u;
        S.vq[2 * k] = *(const u32x2*)(pv + f0); S.vq[2 * k + 1] = *(const u32x2*)(pv + f1);
    }
    { const int ej = etok[bt * 4 + kslot]; S.g = gtok[bt * 4 + kslot]; S.su = su[ej]; S.sv = sv[ej]; }
}
__device__ __forceinline__ void gather_consume(const GSet& S, const unsigned (&hp)[8], float (&acc)[16]) {
    typedef _Float16 h2v_t __attribute__((ext_vector_type(2)));
    float d[4];
#pragma unroll
    for (int k = 0; k < 2; ++k) {
        const v32f_t uf = __builtin_amdgcn_cvt_scalef32_pk32_f32_fp6(S.uq[k], 1.0f);
        float s0 = 0.f, s1 = 0.f;
#pragma unroll
        for (int i = 0; i < 8; ++i) { const h2v_t hh = __builtin_bit_cast(h2v_t, hp[i]);
            s0 += uf[2 * i] * (float)hh[0]; s0 += uf[2 * i + 1] * (float)hh[1]; s1 += uf[16 + 2 * i] * (float)hh[0]; s1 += uf[16 + 2 * i + 1] * (float)hh[1]; }
        s0 = DPP_ADD(s0, 0xB1); s0 = DPP_ADD(s0, 0x4E); s0 = DPP_ADD(s0, 0x124); s0 = DPP_ADD(s0, 0x128);
        s1 = DPP_ADD(s1, 0xB1); s1 = DPP_ADD(s1, 0x4E); s1 = DPP_ADD(s1, 0x124); s1 = DPP_ADD(s1, 0x128);
        d[2 * k] = s0; d[2 * k + 1] = s1;
    }
    float e2[2], f1;
#pragma unroll
    for (int k = 0; k < 2; ++k) { auto r = __builtin_amdgcn_permlane16_swap(__float_as_uint(d[k]), __float_as_uint(d[k + 2]), false, false); e2[k] = __uint_as_float(r[0]) + __uint_as_float(r[1]); }
    { auto r = __builtin_amdgcn_permlane32_swap(__float_as_uint(e2[0]), __float_as_uint(e2[1]), false, false); f1 = __uint_as_float(r[0]) + __uint_as_float(r[1]); }
    const float cf = S.g * gelu_erf(f1 * S.su) * S.sv;
#pragma unroll
    for (int k = 0; k < 4; ++k) {
        const int r = ((k >> 1) & 1) | ((k & 1) << 1);
        const float c = __builtin_bit_cast(float, __builtin_amdgcn_readlane(__builtin_bit_cast(int, cf), 16 * r));
        const unsigned q0 = S.vq[k].x, q1 = S.vq[k].y;
        const f32x2_t a0 = __builtin_amdgcn_cvt_scalef32_pk_f32_fp4(q0, 1.0f, 0), a1 = __builtin_amdgcn_cvt_scalef32_pk_f32_fp4(q0, 1.0f, 1), a2 = __builtin_amdgcn_cvt_scalef32_pk_f32_fp4(q0, 1.0f, 2), a3 = __builtin_amdgcn_cvt_scalef32_pk_f32_fp4(q0, 1.0f, 3);
        const f32x2_t b0 = __builtin_amdgcn_cvt_scalef32_pk_f32_fp4(q1, 1.0f, 0), b1 = __builtin_amdgcn_cvt_scalef32_pk_f32_fp4(q1, 1.0f, 1), b2 = __builtin_amdgcn_cvt_scalef32_pk_f32_fp4(q1, 1.0f, 2), b3 = __builtin_amdgcn_cvt_scalef32_pk_f32_fp4(q1, 1.0f, 3);
        acc[0] += c * a0[0]; acc[1] += c * a0[1]; acc[2] += c * a1[0]; acc[3] += c * a1[1]; acc[4] += c * a2[0]; acc[5] += c * a2[1]; acc[6] += c * a3[0]; acc[7] += c * a3[1];
        acc[8] += c * b0[0]; acc[9] += c * b0[1]; acc[10] += c * b1[0]; acc[11] += c * b1[1]; acc[12] += c * b2[0]; acc[13] += c * b2[1]; acc[14] += c * b3[0]; acc[15] += c * b3[1];
    }
}
__device__ __forceinline__ void xcd_pace(unsigned* bar, volatile LAS unsigned* st);
constexpr int GT = 4;
constexpr int GNS = 8, GBPS = 32 / GNS, GSHIFT = 11;
constexpr int GATH_LDS_WAVE = GT * 128 * 8;
#define GATH_SEG(J, NJ, nbt) { \
        const LAS int* le_ = lse + (J) * 128; const LAS float* lg_ = lsg + (J) * 128; \
        _Pragma("unroll 1") for (int i_ = 0; i_ < GBPS / 2; ++i_) { \
            gather_issue(B, GBPS * c + 2 * i_ + 1, lane, kslot, pu, pv, su, sv, le_, lg_); \
            gather_consume(A, hx[J], acc[J]); \
            if (i_ < GBPS / 2 - 1) gather_issue(A, GBPS * c + 2 * i_ + 2, lane, kslot, pu, pv, su, sv, le_, lg_); \
            else gather_issue(A, (nbt), lane, kslot, pu, pv, su, sv, lse + (NJ) * 128, lsg + (NJ) * 128); \
            gather_consume(B, hx[J], acc[J]); } }
__device__ void ph_peer_gather(const bf16* h2, const unsigned char* pu, const unsigned char* pv, const float* su, const float* sv,
                               const int* eidx, const float* egate, const float* xin, const float* gate  , float* xout, LAS unsigned char* lds, unsigned* pace_bar, volatile LAS unsigned* pace_st, int bid, int nb) {
    const int lane0 = ltid() & 63, w = __builtin_amdgcn_readfirstlane(ltid() >> 6);
    LAS int* lse = (LAS int*)(lds + w * GATH_LDS_WAVE); LAS float* lsg = (LAS float*)(lds + w * GATH_LDS_WAVE + GT * 128 * 4);
    for (int t0 = (bid * 8 + w) * GT; t0 < MT; t0 += nb * 8 * GT) {
        int lane = lane0; asm volatile("" : "+v"(lane));
        const int row = lane >> 4;
        const int kslot = 2 * (row & 1) + (row >> 1);
        const int b = t0 >> 11;
        unsigned hx[GT][8]; float acc[GT][16];
#pragma unroll
        for (int j = 0; j < GT; ++j) {
            const int t = t0 + j;
            const int e0 = eidx[(size_t)t * 128 + lane], e1 = eidx[(size_t)t * 128 + 64 + lane];
            const float g0 = egate[(size_t)t * 128 + lane], g1 = egate[(size_t)t * 128 + 64 + lane];
            const int k0 = e0 >> GSHIFT, k1 = e1 >> GSHIFT;
            int off = 0, d0 = 0, d1 = 0;
#pragma unroll
            for (int s = 0; s < GNS; ++s) {
                const unsigned long long m0 = __ballot(k0 == s), m1 = __ballot(k1 == s);
                const int r0 = (int)__builtin_amdgcn_mbcnt_hi((unsigned)(m0 >> 32), __builtin_amdgcn_mbcnt_lo((unsigned)m0, 0u));
                const int r1 = (int)__builtin_amdgcn_mbcnt_hi((unsigned)(m1 >> 32), __builtin_amdgcn_mbcnt_lo((unsigned)m1, 0u));
                const int c0 = __builtin_popcountll(m0);
                if (k0 == s) d0 = off + r0;
                if (k1 == s) d1 = off + c0 + r1;
                off += c0 + __builtin_popcountll(m1);
            }
            lse[j * 128 + d0] = e0; lsg[j * 128 + d0] = g0; lse[j * 128 + d1] = e1; lsg[j * 128 + d1] = g1;
            const u32x4 u0 = *(const u32x4*)(h2 + (size_t)t * DM + lane * 16), u1 = *(const u32x4*)(h2 + (size_t)t * DM + lane * 16 + 8);
#pragma unroll
            for (int i = 0; i < 4; ++i) {
                hx[j][i] = __builtin_bit_cast(unsigned, __builtin_amdgcn_cvt_pkrtz(__uint_as_float(u0[i] << 16), __uint_as_float(u0[i] & 0xffff0000u)));
                hx[j][4 + i] = __builtin_bit_cast(unsigned, __builtin_amdgcn_cvt_pkrtz(__uint_as_float(u1[i] << 16), __uint_as_float(u1[i] & 0xffff0000u)));
            }
#pragma unroll
            for (int i = 0; i < 16; ++i) acc[j][i] = 0.f;
        }
        GSet A, B;
        gather_issue(A, 0, lane, kslot, pu, pv, su, sv, lse, lsg);
#pragma unroll 1
        for (int c = 0; c < GNS; ++c) {
            if (c == 0) xcd_pace(pace_bar, pace_st);
            GATH_SEG(0, 1, GBPS * c)
            GATH_SEG(1, 2, GBPS * c)
            GATH_SEG(2, 3, GBPS * c)
            GATH_SEG(3, 0, c < GNS - 1 ? GBPS * c + GBPS : 0)
        }
#pragma unroll
        for (int j = 0; j < GT; ++j) {
            const int t = t0 + j;
#pragma unroll
            for (int i = 0; i < 4; ++i) {
                const int cc = lane * 16 + i * 4;
                const f32x4 xi = *(const f32x4*)(xin + (size_t)t * DM + cc), gt = *(const f32x4*)(gate + (size_t)b * 6144 + cc);
                f32x4 o;
#pragma unroll
                for (int e = 0; e < 4; ++e) o[e] = xi[e] + gt[e] * acc[j][i * 4 + e];
                *(f32x4*)(xout + (size_t)t * DM + cc) = o;
            }
        }
    }
}

#define XB_TMO      128
#define XB_XCNT(j)  (256  + 64 * (j))
#define XB_XSUB(j)  (1280 + 64 * (j))
#define XB_XGEN(j)  (2304 + 64 * (j))
#define XB_TOP      3328
#define XB_TOPGEN   3392
#define XCD_BAR_WORDS 3456
#define XB_SPIN_CAP (1u << 18)

__device__ __forceinline__ unsigned xb_ld(unsigned* p)              { return __hip_atomic_load(p, __ATOMIC_RELAXED, __HIP_MEMORY_SCOPE_AGENT); }
__device__ __forceinline__ unsigned xb_add(unsigned* p, unsigned v) { return __hip_atomic_fetch_add(p, v, __ATOMIC_RELAXED, __HIP_MEMORY_SCOPE_AGENT); }
__device__ __forceinline__ unsigned xb_xcc_id() { return (unsigned)__builtin_amdgcn_s_getreg((3 << 11) | 20) & 0xFu; }
#define XB_SPIN(cond, bar) do { unsigned _sp = 0; while (cond) { __builtin_amdgcn_s_sleep(1); \
    if ((++_sp & 255u) == 0u) { if (xb_ld(&(bar)[XB_TMO])) break; if (_sp > XB_SPIN_CAP) { atomicAdd(&(bar)[XB_TMO], 1u); break; } } } } while (0)

struct XcdBarrier {
    unsigned* bar; unsigned x;
    volatile LAS unsigned* st;
};

__device__ __forceinline__ XcdBarrier xcd_barrier_post(unsigned* bar, volatile LAS unsigned* st) {
    XcdBarrier b; b.bar = bar; b.x = xb_xcc_id(); b.st = st;
    if (threadIdx.x == 0) (void)xb_add(&bar[XB_XCNT(b.x)], 1u);
    return b;
}
__device__ __forceinline__ void xcd_barrier_complete(unsigned* bar, unsigned x, unsigned& nloc, unsigned& nx) {
    const unsigned G = gridDim.x * gridDim.y * gridDim.z;
    unsigned sum, cnt, mine, sp = 0u;
    for (;;) {
        sum = 0u; cnt = 0u; mine = 0u;
#pragma unroll
        for (unsigned j = 0; j < 16; ++j) { const unsigned c = xb_ld(&bar[XB_XCNT(j)]); sum += c; cnt += (c > 0u) ? 1u : 0u; mine = (j == x) ? c : mine; }
        if (sum == G) break;
        __builtin_amdgcn_s_sleep(1);
        if ((++sp & 255u) == 0u) { if (xb_ld(&bar[XB_TMO])) break; if (sp > XB_SPIN_CAP) { atomicAdd(&bar[XB_TMO], 1u); break; } }
    }
    nloc = mine > 0u ? mine : 1u; nx = cnt > 0u ? cnt : 1u;
}

__device__ __forceinline__ void xcd_barrier(const XcdBarrier& b) {
    asm volatile("s_waitcnt vmcnt(0)" ::: "memory");
    __syncthreads();
    if (threadIdx.x == 0) {
        unsigned* bar = b.bar;
        __builtin_amdgcn_s_waitcnt(0);
        unsigned nloc = b.st[0], nx = b.st[1];
        if (nloc == 0u) { xcd_barrier_complete(bar, b.x, nloc, nx); b.st[0] = nloc; b.st[1] = nx; }
        const unsigned old = xb_add(&bar[XB_XSUB(b.x)], 1u);
        const unsigned gen = old / nloc;
        if (old + 1u == (gen + 1u) * nloc) {
            __builtin_amdgcn_fence(__ATOMIC_RELEASE, "agent");
            asm volatile("s_waitcnt vmcnt(0)" ::: "memory");
            const unsigned og = xb_add(&bar[XB_TOP], 1u);
            const unsigned tg = og / nx;
            if (og + 1u == (tg + 1u) * nx) xb_add(&bar[XB_TOPGEN], 1u);
            else XB_SPIN(xb_ld(&bar[XB_TOPGEN]) == tg, bar);
            __builtin_amdgcn_fence(__ATOMIC_ACQUIRE, "agent");
            xb_add(&bar[XB_XGEN(b.x)], 1u);
            asm volatile("s_waitcnt vmcnt(0)" ::: "memory");
        } else {
            XB_SPIN(xb_ld(&bar[XB_XGEN(b.x)]) == gen, bar);
            __builtin_amdgcn_fence(__ATOMIC_ACQUIRE, "agent");
            asm volatile("s_waitcnt vmcnt(0)" ::: "memory");
        }
    }
    __syncthreads();
}


#define XB_PACE(j) (3584 + 64 * (j))
__device__ __forceinline__ void xcd_pace(unsigned* bar, volatile LAS unsigned* st) {
    __syncthreads();
    if (threadIdx.x == 0) {
        const unsigned nloc = st[0] ? st[0] : 1u, x = xb_xcc_id(), gen = st[4] + 1u;
        st[4] = gen;
        xb_add(&bar[XB_PACE(x)], 1u);
        unsigned sp = 0;
        while (xb_ld(&bar[XB_PACE(x)]) < gen * nloc) { __builtin_amdgcn_s_sleep(1); if (++sp > (1u << 16)) break; }
    }
    __syncthreads();
}
extern __shared__ __attribute__((aligned(16))) unsigned char dyn_lds[];
#ifndef REP_PREP
#define REP_PREP 1
#endif
#ifndef REP_ATTN
#define REP_ATTN 1
#endif
#ifndef REP_SEL
#define REP_SEL 1
#endif
#ifndef REP_GATH
#define REP_GATH 1
#endif
#ifndef REP_GEMM
#define REP_GEMM 1
#endif
#ifndef REP_ADALN
#define REP_ADALN 1
#endif
constexpr int LDS_BYTES = 147456;

template <class T> __device__ __forceinline__ T* karg(int byte_off) {
    const __attribute__((address_space(4))) char* base = (const __attribute__((address_space(4))) char*)__builtin_amdgcn_kernarg_segment_ptr();
    unsigned long long v = *(const __attribute__((address_space(4))) unsigned long long*)(base + byte_off);
    asm volatile("" : "+s"(v));
    return (T*)(__attribute__((address_space(1))) T*)v;
}
#define KIN(i) karg<const float>(8 * (i))
#define KOUT() karg<float>(168)
#define KWS() karg<unsigned char>(176)
static_assert(sizeof(Params) == 184, "Params layout");
template <class T> __device__ __forceinline__ T* launder(T* p) { size_t off = 0; asm volatile("" : "+s"(off)); return (T*)((unsigned char*)p + off); }
__global__ void __launch_bounds__(NT) mega_fwd(Params p) {
    cg::grid_group grid = cg::this_grid();
    const int bid = blockIdx.x, nb = gridDim.x;
    volatile LAS unsigned* bst = (volatile LAS unsigned*)((LAS unsigned char*)dyn_lds + LDS_BYTES - 64);
    if (ltid() < 16) bst[ltid()] = 0u;
    __syncthreads();
    const XcdBarrier xbar = xcd_barrier_post((unsigned*)(KWS() + WS_BAR), bst);
    for (int rep = 0; rep < REP_PREP; ++rep) {
        unsigned char* ws = KWS();
        float* tile = (float*)dyn_lds;
        ph_transpose(KIN(6), (bf16*)(ws + WS_WIN0), 1024, AB_IN, true, tile, bid, nb);
        ph_transpose(KIN(11), (bf16*)(ws + WS_WIN1), 1024, CD_IN, true, tile, bid, nb);
        ph_transpose(KIN(7), (bf16*)(ws + WS_WO0), 1024, 1024, false, tile, bid, nb);
        ph_transpose(KIN(12), (bf16*)(ws + WS_WO1), 1024, 1024, false, tile, bid, nb);
        ph_transpose(KIN(17), (bf16*)(ws + WS_WQ), 1024, PQ, false, tile, bid, nb);
        ph_transpose(KIN(17) + (size_t)1024 * PQ, (bf16*)(ws + WS_WQ) + (size_t)PQ * 1024, 1024, PQ, false, tile, bid, nb);
        ws = launder(ws);
        ph_tab_fp6(KIN(19), ws + WS_PU, (float*)(ws + WS_PV), 2 * NEXP, bid, nb);
        ph_tab_fp4(KIN(20), ws + WS_PU + 32 * MiB, (float*)(ws + WS_PV + 1 * MiB), 2 * NEXP, bid, nb);
        ws = launder(ws);
        ph_mod(KIN(1), KIN(2), KIN(3), (float*)(ws + WS_MOD), (float*)dyn_lds, bid, nb);
        ph_rope_table((float*)(ws + WS_ROPE), bid, nb);
        for (int i = bid * NT + ltid(); i < NB * 8 * 8 * 64; i += nb * NT) ((float*)(ws + WS_KMEAN))[i] = 0.f;
    }
    grid.sync();
#pragma unroll 1
    for (int layer = 0; layer < 2; ++layer) {
        for (int rep = 0; rep < REP_ADALN; ++rep) {
            unsigned char* ws = KWS(); const float* mod = (const float*)(ws + WS_MOD) + (size_t)layer * 32 * 6144;
            ph_adaln(layer == 0 ? KIN(0) : KOUT(), KIN(4) + layer * DM, mod + 0, mod + 1024, (bf16*)(ws + WS_HY), bid, nb);
        }
        xcd_barrier(xbar);
        for (int rep = 0; rep < REP_GEMM; ++rep) {
            unsigned char* ws = KWS();
            pg8::Gemm g{(const bf16*)(ws + WS_HY), (const bf16*)(ws + (layer == 0 ? WS_WIN0 : WS_WIN1)), MT, layer == 0 ? AB_IN : CD_IN, DM};
            pg8::StaticOrder S; S.init(g.M, g.N, nb, bid);
            pg8::EpiQKV e{(bf16*)(ws + WS_QKV), QKV_LD, (const float*)(ws + WS_ROPE), layer, layer == 0 ? KIN(9) : KIN(13), layer == 0 ? KIN(10) : KIN(14), KIN(15), KIN(16), (float*)(ws + WS_KMEAN)};
            pg8::gemm_phase<pg8::EpiQKV, pg8::StaticOrder, true, true>((LAS unsigned char*)dyn_lds, g, S, e);
        }
        xcd_barrier(xbar);
        for (int rep = 0; rep < REP_ATTN; ++rep) {
            unsigned char* ws = KWS();
            if (layer == 0) ph_attn0((const bf16*)(ws + WS_QKV), KIN(8), (bf16*)(ws + WS_HY), (LAS unsigned char*)dyn_lds, bid, nb);
            else ph_attn1((const bf16*)(ws + WS_QKV), (const float*)(ws + WS_KMEAN), (bf16*)(ws + WS_HY), (LAS unsigned char*)dyn_lds, bid, nb);
        }
        xcd_barrier(xbar);
        for (int rep = 0; rep < REP_GEMM; ++rep) {
            unsigned char* ws = KWS(); const float* mod = (const float*)(ws + WS_MOD) + (size_t)layer * 32 * 6144;
            pg8::Gemm g{(const bf16*)(ws + WS_HY), (const bf16*)(ws + (layer == 0 ? WS_WO0 : WS_WO1)), MT, DM, DM};
            pg8::StaticOrder S; S.init(g.M, g.N, nb, bid); pg8::EpiResid e{layer == 0 ? KIN(0) : KOUT(), (float*)(ws + WS_X1), mod + 2048};
            pg8::gemm_phase<pg8::EpiResid, pg8::StaticOrder, true, true>((LAS unsigned char*)dyn_lds, g, S, e);
        }
        xcd_barrier(xbar);
        for (int rep = 0; rep < REP_ADALN; ++rep) {
            unsigned char* ws = KWS(); const float* mod = (const float*)(ws + WS_MOD) + (size_t)layer * 32 * 6144;
            ph_adaln((const float*)(ws + WS_X1), KIN(5) + layer * DM, mod + 3072, mod + 4096, (bf16*)(ws + WS_QKV), bid, nb);
        }
        xcd_barrier(xbar);
        for (int rep = 0; rep < REP_GEMM; ++rep) {
            unsigned char* ws = KWS();
            pg8::Gemm g{(const bf16*)(ws + WS_QKV), (const bf16*)(ws + WS_WQ) + (size_t)layer * PQ * DM, MT, PQ, DM};
            pg8::StaticOrder S; S.init(g.M, g.N, nb, bid); pg8::EpiStore e{(bf16*)(ws + WS_QKV + 128 * MiB), PQ};
            pg8::gemm_phase<pg8::EpiStore, pg8::StaticOrder, true, true>((LAS unsigned char*)dyn_lds, g, S, e);
        }
        xcd_barrier(xbar);
        for (int rep = 0; rep < REP_SEL; ++rep) {
            unsigned char* ws = KWS();
            ph_peer_select((const bf16*)(ws + WS_QKV + 128 * MiB), KIN(18) + (size_t)layer * 2 * 128 * 128, (int*)(ws + WS_HY), (float*)(ws + WS_HY + 32 * MiB), (LAS unsigned char*)dyn_lds, bid, nb);
        }
        xcd_barrier(xbar);
        for (int rep = 0; rep < REP_GATH; ++rep) {
            unsigned char* ws = KWS(); const float* mod = (const float*)(ws + WS_MOD) + (size_t)layer * 32 * 6144;
            ph_peer_gather((const bf16*)(ws + WS_QKV), ws + WS_PU + (size_t)layer * NEXP * TROW, ws + WS_PU + 32 * MiB + (size_t)layer * NEXP * TROW4,
                           (const float*)(ws + WS_PV) + layer * NEXP, (const float*)(ws + WS_PV + 1 * MiB) + layer * NEXP, (const int*)(ws + WS_HY), (const float*)(ws + WS_HY + 32 * MiB), (const float*)(ws + WS_X1), mod + 5120, KOUT(), (LAS unsigned char*)dyn_lds, (unsigned*)(ws + WS_BAR), bst, bid, nb);
        }
        if (layer == 0) xcd_barrier(xbar);
    }
}

extern "C" void kernel_launch(void* const* d_in, const int* in_sizes, int n_in, void* d_out, int out_size, void* d_ws, size_t ws_size, hipStream_t stream) {
    if (n_in != 21 || ws_size < WS_END) { fprintf(stderr, "kernel_launch: bad args n_in=%d ws=%zu\n", n_in, ws_size); return; }
    static int grid_blocks = 0;
    if (!grid_blocks) {
        int dev = 0, cus = 0, per_cu = 0;
        (void)hipGetDevice(&dev);
        (void)hipDeviceGetAttribute(&cus, hipDeviceAttributeMultiprocessorCount, dev);
        (void)hipFuncSetAttribute((const void*)mega_fwd, hipFuncAttributeMaxDynamicSharedMemorySize, LDS_BYTES);
        (void)hipOccupancyMaxActiveBlocksPerMultiprocessor(&per_cu, (const void*)mega_fwd, NT, LDS_BYTES);
        if (per_cu < 1) { fprintf(stderr, "kernel_launch: occupancy query returned %d\n", per_cu); per_cu = 1; }
        if (per_cu > 1) per_cu = 1;
        grid_blocks = cus * per_cu;
    }
    Params p{};
    for (int i = 0; i < 21; ++i) p.in[i] = (const float*)d_in[i];
    p.out = (float*)d_out; p.ws = (unsigned char*)d_ws;
    (void)hipMemsetAsync((char*)d_ws + WS_BAR, 0, 16384, stream);
    void* args[] = {&p};
    hipError_t e = hipLaunchCooperativeKernel((const void*)mega_fwd, dim3(grid_blocks), dim3(NT), args, LDS_BYTES, stream);
    if (e != hipSuccess) fprintf(stderr, "cooperative launch failed: %s (grid %d)\n", hipGetErrorString(e), grid_blocks);
}
```

```cpp
#include <hip/hip_runtime.h>
#ifndef REP_A
#define REP_A 1
#endif
#ifndef REP_B
#define REP_B 1
#endif
#ifndef REP_C
#define REP_C 1
#endif
#ifndef REP_D
#define REP_D 1
#endif
#include <hip/hip_cooperative_groups.h>
namespace cg = cooperative_groups;
#include <cstdio>
#include <cstdint>
#include <cmath>

typedef unsigned short bf16;
typedef short bf16x8 __attribute__((ext_vector_type(8)));
typedef float f32x4 __attribute__((ext_vector_type(4)));
typedef unsigned u32x4 __attribute__((ext_vector_type(4)));
typedef unsigned u32x2 __attribute__((ext_vector_type(2)));

constexpr int DM = 1024, NB = 32, SQ = 2048, MT = NB * SQ;
constexpr int HD = 64;
constexpr int AB_IN = 2304, CD_IN = 3072, QKV_LD = 3072;
constexpr int NEXP = 16384, PQ = 2048;
constexpr float EPS = 1e-6f;
constexpr int NT = 512;

constexpr size_t MiB = 1u << 20;
constexpr size_t WS_X1 = 0;
constexpr size_t WS_QKV = 256 * MiB;
constexpr size_t WS_HY = 640 * MiB;
constexpr size_t WS_PU = 768 * MiB;
constexpr size_t WS_PV = 832 * MiB;
constexpr size_t WS_WIN0 = 896 * MiB;
constexpr size_t WS_WIN1 = 901 * MiB;
constexpr size_t WS_WO0 = 907 * MiB;
constexpr size_t WS_WO1 = 909 * MiB;
constexpr size_t WS_WQ = 911 * MiB;
constexpr size_t WS_MOD = 919 * MiB;
constexpr size_t WS_ROPE = 921 * MiB;
constexpr size_t WS_KMEAN = 922 * MiB;
constexpr size_t WS_BAR = 923 * MiB;
constexpr size_t WS_END = 924 * MiB;

struct Params {
    const float* in[21];
    float* out;
    unsigned char* ws;
};

__device__ __forceinline__ int ltid() { int t = (int)__builtin_amdgcn_workitem_id_x(); asm volatile("" : "+v"(t)); return t; }
__device__ __forceinline__ float bf2f(unsigned b) { return __uint_as_float(b << 16); }
__device__ __forceinline__ unsigned f2bf(float f) { unsigned u = __float_as_uint(f); return (u + 0x7fffu + ((u >> 16) & 1u)) >> 16; }
__device__ __forceinline__ unsigned pk2(float lo, float hi) { return f2bf(lo) | (f2bf(hi) << 16); }
#define DPPV(v, ctrl) __builtin_bit_cast(float, __builtin_amdgcn_update_dpp(0, __builtin_bit_cast(int, (v)), (ctrl), 0xf, 0xf, true))
__device__ __forceinline__ float row16_sum(float v) { v += DPPV(v, 0xB1); v += DPPV(v, 0x4E); v += DPPV(v, 0x124); v += DPPV(v, 0x128); return v; }
__device__ __forceinline__ float rows_sum(float v) {
    { auto r = __builtin_amdgcn_permlane16_swap(__float_as_uint(v), __float_as_uint(v), false, false); v = __uint_as_float(r[0]) + __uint_as_float(r[1]); }
    { auto r = __builtin_amdgcn_permlane32_swap(__float_as_uint(v), __float_as_uint(v), false, false); v = __uint_as_float(r[0]) + __uint_as_float(r[1]); }
    return v;
}
__device__ __forceinline__ float wave_sum(float v) { return rows_sum(row16_sum(v)); }
__device__ __forceinline__ float wave_max(float v) {
    v = fmaxf(v, DPPV(v, 0xB1)); v = fmaxf(v, DPPV(v, 0x4E)); v = fmaxf(v, DPPV(v, 0x124)); v = fmaxf(v, DPPV(v, 0x128));
    { auto r = __builtin_amdgcn_permlane16_swap(__float_as_uint(v), __float_as_uint(v), false, false); v = fmaxf(__uint_as_float(r[0]), __uint_as_float(r[1])); }
    { auto r = __builtin_amdgcn_permlane32_swap(__float_as_uint(v), __float_as_uint(v), false, false); v = fmaxf(__uint_as_float(r[0]), __uint_as_float(r[1])); }
    return v;
}
__device__ __forceinline__ float gelu_erf(float x) { return 0.5f * x * (1.0f + erff(x * 0.70710678118654752f)); }

__device__ __forceinline__ int qkv_logical_col(int p) { return (p & ~255) | (((p >> 5) & 3) << 6) | (((p >> 7) & 1) << 5) | (p & 31); }
__device__ void ph_transpose(const float* W, bf16* Wt, int K, int N, bool permute, float* tile  , int bid, int nb) {
    const int tid = ltid();
    const int nkt = K / 64, nnt = N / 64;
    for (int it = bid; it < nkt * nnt; it += nb) {
        const int k0 = (it / nnt) * 64, n0 = (it % nnt) * 64;
        __syncthreads();
        for (int e = tid; e < 64 * 64; e += NT) { const int r = e >> 6, c = e & 63; const int nl = permute ? qkv_logical_col(n0 + c) : n0 + c; tile[r * 65 + c] = W[(size_t)(k0 + r) * N + nl]; }
        __syncthreads();
        {
            const int n = tid >> 3, k8 = (tid & 7) * 8;
            u32x4 v;
            v.x = pk2(tile[(k8 + 0) * 65 + n], tile[(k8 + 1) * 65 + n]);
            v.y = pk2(tile[(k8 + 2) * 65 + n], tile[(k8 + 3) * 65 + n]);
            v.z = pk2(tile[(k8 + 4) * 65 + n], tile[(k8 + 5) * 65 + n]);
            v.w = pk2(tile[(k8 + 6) * 65 + n], tile[(k8 + 7) * 65 + n]);
            *(u32x4*)(Wt + (size_t)(n0 + n) * K + k0 + k8) = v;
        }
    }
}
__device__ void ph_convert(const float* src, bf16* dst, size_t n, int bid, int nb) {
    const size_t n8 = n / 8;
    for (size_t i = (size_t)bid * NT + ltid(); i < n8; i += (size_t)nb * NT) {
        const f32x4 a = *(const f32x4*)(src + i * 8), b = *(const f32x4*)(src + i * 8 + 4);
        u32x4 v; v.x = pk2(a[0], a[1]); v.y = pk2(a[2], a[3]); v.z = pk2(b[0], b[1]); v.w = pk2(b[2], b[3]);
        *(u32x4*)(dst + i * 8) = v;
    }
}
__device__ void ph_mod(const float* c, const float* ada_w, const float* ada_b, float* mod, float* lds  , int bid, int nb) {
    const int tid = ltid(), lane = tid & 63, w = tid >> 6;
    for (int it = bid; it < 2 * 96; it += nb) {
        const int l = it / 96, j = (it % 96) * 64 + lane;
        float acc[32];
#pragma unroll
        for (int b = 0; b < 32; ++b) acc[b] = 0.f;
        for (int kh = 0; kh < 2; ++kh) {
            __syncthreads();
            for (int e = tid; e < 32 * 512; e += NT) { const int b = e >> 9, k = e & 511; const float cv = c[b * 1024 + kh * 512 + k]; lds[e] = cv / (1.0f + __expf(-cv)); }
            __syncthreads();
            for (int kk = 0; kk < 64; ++kk) {
                const int k = w * 64 + kk;
                const float wv = ada_w[((size_t)l * 1024 + kh * 512 + k) * 6144 + j];
#pragma unroll
                for (int b = 0; b < 32; ++b) acc[b] += lds[b * 512 + k] * wv;
            }
        }
        __syncthreads();
#pragma unroll
        for (int b = 0; b < 32; ++b) lds[(w * 32 + b) * 64 + lane] = acc[b];
        __syncthreads();
        for (int e = tid; e < 32 * 64; e += NT) {
            const int b = e >> 6, jj = e & 63; float s = 0.f;
#pragma unroll
            for (int ww = 0; ww < 8; ++ww) s += lds[(ww * 32 + b) * 64 + jj];
            const int jo = (it % 96) * 64 + jj;
            mod[((size_t)l * 32 + b) * 6144 + jo] = s + ada_b[l * 6144 + jo];
        }
    }
}
__device__ void ph_rope_table(float* rope, int bid, int nb) {
    for (int i = bid * NT + ltid(); i < SQ * 32; i += nb * NT) {
        const int t = i >> 5, f = i & 31;
        const float inv = powf(10000.0f, -(float)f / 32.0f);
        const float ang = (float)t * inv;
        float s, c; sincosf(ang, &s, &c);
        rope[i * 2] = c; rope[i * 2 + 1] = s;
    }
}

#define DPP_ADD0(v, ctrl) ((v) + __builtin_bit_cast(float, __builtin_amdgcn_update_dpp(0, __builtin_bit_cast(int, (v)), (ctrl), 0xf, 0xf, true)))
__device__ void ph_adaln(const float* x, const float* g, const float* mod_shift  , const float* mod_scale, bf16* h, int bid, int nb) {
    const int lane = ltid() & 63, w = __builtin_amdgcn_readfirstlane(ltid() >> 6);
    for (int t0 = (bid * 8 + w) * 4; t0 < MT; t0 += nb * 8 * 4) {
        const int b = t0 >> 11;
        f32x4 v[4][4]; float ss[4];
#pragma unroll
        for (int r = 0; r < 4; ++r) {
            const float* xr = x + (size_t)(t0 + r) * DM;
#pragma unroll
            for (int i = 0; i < 4; ++i) v[r][i] = *(const f32x4*)(xr + i * 256 + lane * 4);
        }
#pragma unroll
        for (int r = 0; r < 4; ++r) {
            float s = 0.f;
#pragma unroll
            for (int i = 0; i < 4; ++i) s += v[r][i][0] * v[r][i][0] + v[r][i][1] * v[r][i][1] + v[r][i][2] * v[r][i][2] + v[r][i][3] * v[r][i][3];
            s = DPP_ADD0(s, 0xB1); s = DPP_ADD0(s, 0x4E); s = DPP_ADD0(s, 0x124); s = DPP_ADD0(s, 0x128);
            { auto q = __builtin_amdgcn_permlane16_swap(__float_as_uint(s), __float_as_uint(s), false, false); s = __uint_as_float(q[0]) + __uint_as_float(q[1]); }
            { auto q = __builtin_amdgcn_permlane32_swap(__float_as_uint(s), __float_as_uint(s), false, false); s = __uint_as_float(q[0]) + __uint_as_float(q[1]); }
            ss[r] = rsqrtf(s * (1.0f / DM) + EPS);
        }
#pragma unroll
        for (int i = 0; i < 4; ++i) {
            const int c = i * 256 + lane * 4;
            const f32x4 gg = *(const f32x4*)(g + c), sc = *(const f32x4*)(mod_scale + (size_t)b * 6144 + c), sh = *(const f32x4*)(mod_shift + (size_t)b * 6144 + c);
            float a[4];
#pragma unroll
            for (int e = 0; e < 4; ++e) a[e] = gg[e] * (1.0f + sc[e]);
#pragma unroll
            for (int r = 0; r < 4; ++r) {
                float y[4];
#pragma unroll
                for (int e = 0; e < 4; ++e) y[e] = v[r][i][e] * ss[r] * a[e] + sh[e];
                u32x2 o; o.x = pk2(y[0], y[1]); o.y = pk2(y[2], y[3]);
                *(u32x2*)(h + (size_t)(t0 + r) * DM + c) = o;
            }
        }
    }
}

namespace pg8 {
#define PG8_LAS __attribute__((address_space(3)))
typedef unsigned short bf16_t;
typedef short bf16x8 __attribute__((ext_vector_type(8)));
constexpr int BM = 256, BK = 64, HALF = 128, HTB = HALF * BK * 2  , STAGE_BYTES = 8 * HTB, NXCD = 8, WGM = 8;

__host__ __device__ __forceinline__ int lds_byte(int r, int c) { const int st = (r >> 4) * 2 + (c >> 5), rr = r & 15, cc = c & 31, ob = rr * 64 + cc * 2; return st * 1024 + (ob ^ (((ob >> 9) & 1) << 5)); }
__host__ __device__ __forceinline__ void stage_rc(int b, int& R, int& C) { const int st = b / 1024, sb = b % 1024, swz = sb ^ (((sb >> 9) & 1) << 5); R = (st >> 1) * 16 + swz / 64; C = (st & 1) * 32 + (swz % 64) / 2; }
__host__ __device__ __forceinline__ int perm32(int rho) { const int n = rho >> 4, i = rho & 15; return 8 * (i >> 2) + 4 * n + (i & 3); }

struct Unit { int pm, pn; };
struct Gemm { const bf16_t* A; const bf16_t* Bt; int M, N, K; };

struct StaticOrder {
    int nM, nN, nwg, G, c;
    __host__ __device__ void init(int M, int N, int G_, int c_) { nM = M / BM; nN = N / BM; nwg = nM * nN; G = G_; c = c_; }
    __host__ __device__ bool next(int i, Unit& u) const {
        const long L = (long)i * G + c; if (L >= nwg) return false;
        int wgid = (int)L; { const int q = nwg / NXCD, r = nwg % NXCD, xcd = wgid % NXCD, off = wgid / NXCD; wgid = (xcd < r ? xcd * (q + 1) : r * (q + 1) + (xcd - r) * q) + off; }
        const int nig = WGM * nN, gid = wgid / nig, fm = gid * WGM, gsz = (nM - fm) < WGM ? (nM - fm) : WGM;
        u.pm = fm + ((wgid % nig) % gsz); u.pn = (wgid % nig) / gsz; return true;
    }
    __device__ __forceinline__ void a_ready(const Unit&) const {}
    __device__ __forceinline__ void done(const Unit&) const {}
};

__device__ __forceinline__ unsigned cvt_pk_bf16(float lo, float hi) { unsigned r; asm volatile("v_cvt_pk_bf16_f32 %0, %1, %2" : "=v"(r) : "v"(lo), "v"(hi)); return r; }

struct EpiStore {
    static constexpr bool PERM = true, AFTER_DRAIN = false;
    bf16_t* O; int ldc;
    __device__ __forceinline__ void operator()(const f32x4 (&acc)[2][2][4][2], const Unit& u, int wr, int wc, int fr_, int fq_) const {
        int fr = fr_, fq = fq_; asm volatile("" : "+v"(fr), "+v"(fq));
        const int row0 = u.pm * BM + wr * 64 + fr, col0 = u.pn * BM + wc * 32 + 8 * fq;
#pragma unroll
        for (int ai = 0; ai < 2; ++ai)
#pragma unroll
            for (int m = 0; m < 4; ++m) { bf16_t* rowp = O + (size_t)(row0 + ai * HALF + m * 16) * ldc + col0;
#pragma unroll
                for (int bj = 0; bj < 2; ++bj) { const f32x4 v0 = acc[ai][bj][m][0], v1 = acc[ai][bj][m][1];
                    u32x4 w; w.x = cvt_pk_bf16(v0[0], v0[1]); w.y = cvt_pk_bf16(v0[2], v0[3]); w.z = cvt_pk_bf16(v1[0], v1[1]); w.w = cvt_pk_bf16(v1[2], v1[3]);
                    *(u32x4*)(rowp + bj * HALF) = w; } }
    }
};
struct EpiQKV {
    static constexpr bool PERM = true, AFTER_DRAIN = false;
    bf16_t* O; int ldc; const float* rope; int layer;
    const float* gq0; const float* gk0;
    const float* gq1; const float* gk1;
    float* kmean;
    __device__ __forceinline__ void operator()(const f32x4 (&acc)[2][2][4][2], const Unit& u, int wr, int wc, int fr_, int fq_) const {
        int fr = fr_, fq = fq_; asm volatile("" : "+v"(fr), "+v"(fq));
        const int hg = 4 * u.pn + wc;
        const float* gain = nullptr; bool km = false;
        if (layer == 0) { if (hg < 8) gain = gq0; else if (hg < 10) gain = gk0; }
        else { if (hg < 8) gain = gq0; else if (hg < 16) gain = gk0; else if (hg >= 24 && hg < 32) gain = gq1; else if (hg >= 32 && hg < 40) { gain = gk1; km = true; } }
        const int row0 = u.pm * BM + wr * 64 + fr, col0 = 64 * hg + 8 * fq;
        float g0[8], g1[8], cs0[8], cs1[8];
#pragma unroll
        for (int e = 0; e < 8; ++e) { g0[e] = gain ? gain[8 * fq + e] : 1.f; g1[e] = gain ? gain[32 + 8 * fq + e] : 1.f; cs0[e] = 0.f; cs1[e] = 0.f; }
#pragma unroll
        for (int ai = 0; ai < 2; ++ai)
#pragma unroll
            for (int m = 0; m < 4; ++m) {
                const int row = row0 + ai * HALF + m * 16;
                float v0[8], v1[8];
#pragma unroll
                for (int e = 0; e < 4; ++e) { v0[e] = acc[ai][0][m][0][e]; v0[4 + e] = acc[ai][0][m][1][e]; v1[e] = acc[ai][1][m][0][e]; v1[4 + e] = acc[ai][1][m][1][e]; }
                if (gain) {
                    float ss = 0.f;
#pragma unroll
                    for (int e = 0; e < 8; ++e) ss += v0[e] * v0[e] + v1[e] * v1[e];
                    ss = rows_sum(ss);
                    const float r = rsqrtf(ss * (1.0f / 64.0f) + 1e-6f);
                    const float* rp = rope + ((size_t)(row & 2047) * 32 + 8 * fq) * 2;
                    const f32x4 t0 = *(const f32x4*)(rp), t1 = *(const f32x4*)(rp + 4), t2 = *(const f32x4*)(rp + 8), t3 = *(const f32x4*)(rp + 12);
                    const float cs[8] = {t0[0], t0[2], t1[0], t1[2], t2[0], t2[2], t3[0], t3[2]}, sn[8] = {t0[1], t0[3], t1[1], t1[3], t2[1], t2[3], t3[1], t3[3]};
#pragma unroll
                    for (int e = 0; e < 8; ++e) { const float y0 = v0[e] * r * g0[e], y1 = v1[e] * r * g1[e]; v0[e] = y0 * cs[e] - y1 * sn[e]; v1[e] = y1 * cs[e] + y0 * sn[e]; }
                }
                u32x4 w0, w1;
                w0.x = cvt_pk_bf16(v0[0], v0[1]); w0.y = cvt_pk_bf16(v0[2], v0[3]); w0.z = cvt_pk_bf16(v0[4], v0[5]); w0.w = cvt_pk_bf16(v0[6], v0[7]);
                w1.x = cvt_pk_bf16(v1[0], v1[1]); w1.y = cvt_pk_bf16(v1[2], v1[3]); w1.z = cvt_pk_bf16(v1[4], v1[5]); w1.w = cvt_pk_bf16(v1[6], v1[7]);
                bf16_t* rowp = O + (size_t)row * ldc + col0;
                *(u32x4*)(rowp) = w0; *(u32x4*)(rowp + 32) = w1;
                if (km) {
#pragma unroll
                    for (int e = 0; e < 8; ++e) { cs0[e] += v0[e]; cs1[e] += v1[e]; }
                }
            }
        if (km) {
#pragma unroll
            for (int e = 0; e < 8; ++e) {
                cs0[e] = row16_sum(cs0[e]); cs1[e] = row16_sum(cs1[e]);
            }
            if (fr == 0) {
                float* kp = kmean + ((size_t)((u.pm >> 3) * 8 + (hg - 32)) * 8 + (u.pm & 7)) * 64 + 8 * fq;
#pragma unroll
                for (int e = 0; e < 8; ++e) { atomicAdd(kp + e, cs0[e] * (1.0f / 256.0f)); atomicAdd(kp + 32 + e, cs1[e] * (1.0f / 256.0f)); }
            }
        }
    }
};
struct EpiResid {
    static constexpr bool PERM = true, AFTER_DRAIN = false;
    const float* xin; float* xout; const float* gate;
    __device__ __forceinline__ void operator()(const f32x4 (&acc)[2][2][4][2], const Unit& u, int wr, int wc, int fr_, int fq_) const {
        int fr = fr_, fq = fq_; asm volatile("" : "+v"(fr), "+v"(fq));
        const int row0 = u.pm * BM + wr * 64 + fr, col0 = u.pn * BM + wc * 32 + 8 * fq;
#pragma unroll
        for (int ai = 0; ai < 2; ++ai)
#pragma unroll
            for (int m = 0; m < 4; ++m) { const int row = row0 + ai * HALF + m * 16; const float* gp = gate + (size_t)(row >> 11) * 6144 + col0;
                const float* xi = xin + (size_t)row * 1024 + col0; float* xo = xout + (size_t)row * 1024 + col0;
#pragma unroll
                for (int bj = 0; bj < 2; ++bj)
#pragma unroll
                    for (int n = 0; n < 2; ++n) { const f32x4 a = acc[ai][bj][m][n], x = *(const f32x4*)(xi + bj * HALF + 4 * n), g = *(const f32x4*)(gp + bj * HALF + 4 * n);
                        f32x4 o; o[0] = x[0] + g[0] * a[0]; o[1] = x[1] + g[1] * a[1]; o[2] = x[2] + g[2] * a[2]; o[3] = x[3] + g[3] * a[3];
                        *(f32x4*)(xo + bj * HALF + 4 * n) = o; } }
    }
};
template <class Epi, class Sched, bool ALIGN_EPI = false, bool SP2 = false>
__device__ __forceinline__ void gemm_phase(PG8_LAS unsigned char* lds, const Gemm g, const Sched& S, const Epi& E) {
    const int tid = ltid(), wid = __builtin_amdgcn_readfirstlane(tid >> 6), lane = tid & 63, wr = wid >> 2, wc = wid & 3, fr = lane & 15, fq = lane >> 4;
    const int K = g.K, nt = K / BK;
    unsigned voffA[2], voffB[2];
#pragma unroll
    for (int i = 0; i < 2; ++i) { int R, C; stage_rc(tid * 16 + i * 8192, R, C); const int Rb = Epi::PERM ? ((R & ~31) + perm32(R & 31)) : R;
        voffA[i] = (unsigned)(R * K + C) * 2u; voffB[i] = (unsigned)(Rb * K + C) * 2u; }
    const size_t kstep = (size_t)(BK * 2);
    const size_t hstep = (size_t)HALF * K * 2;
    const size_t tstep = 2 * hstep;
    const unsigned ldsw = (unsigned)wid * 1024u;
    const int aoff = lds_byte(wr * 64 + fr, fq * 8), boff = lds_byte(wc * 32 + fr, fq * 8);
#define PG8_SA(b, h) (((b) * 2 + (h)) * HTB)
#define PG8_SB(b, h) ((4 + (b) * 2 + (h)) * HTB)
#define PG8_STAGE(bufoff, gbase, voff) do { _Pragma("unroll") for (int _i = 0; _i < 2; ++_i) \
        __builtin_amdgcn_global_load_lds((const unsigned*)((const char*)(gbase) + (voff)[_i]), (PG8_LAS unsigned*)(lds + (bufoff) + ldsw + _i * 8192), 16, 0, 0); } while (0)
#define PG8_LDA(dst, b, h) do { _Pragma("unroll") for (int m = 0; m < 4; ++m) _Pragma("unroll") for (int k = 0; k < 2; ++k) dst[m][k] = *(const PG8_LAS bf16x8*)(lds + PG8_SA(b, h) + aoff + m * 2048 + k * 1024); } while (0)
#define PG8_LDB(dst, b, h) do { _Pragma("unroll") for (int n = 0; n < 2; ++n) _Pragma("unroll") for (int k = 0; k < 2; ++k) dst[n][k] = *(const PG8_LAS bf16x8*)(lds + PG8_SB(b, h) + boff + n * 2048 + k * 1024); } while (0)
#define PG8_MMA(ai, bj, At, Bt) do { __builtin_amdgcn_s_setprio(1); _Pragma("unroll") for (int m = 0; m < 4; ++m) _Pragma("unroll") for (int n = 0; n < 2; ++n) _Pragma("unroll") for (int k = 0; k < 2; ++k) \
        acc[ai][bj][m][n] = __builtin_amdgcn_mfma_f32_16x16x32_bf16(Bt[n][k], At[m][k], acc[ai][bj][m][n], 0, 0, 0); __builtin_amdgcn_s_setprio(0); } while (0)
#define PG8_WAIT_V(n) asm volatile("s_waitcnt vmcnt(" #n ")" ::: "memory")
#define PG8_WAIT_L(n) asm volatile("s_waitcnt lgkmcnt(" #n ")" ::: "memory")
#define PG8_BAR __builtin_amdgcn_s_barrier()
#define PG8_SCHED __builtin_amdgcn_sched_barrier(0)
    Unit cur, nxt; int ui = 0;
    if (!S.next(0, cur)) return;
    f32x4 acc[2][2][4][2];
#pragma unroll
    for (int a = 0; a < 2; ++a)
#pragma unroll
        for (int b = 0; b < 2; ++b)
#pragma unroll
            for (int m = 0; m < 4; ++m)
#pragma unroll
                for (int n = 0; n < 2; ++n) acc[a][b][m][n] = (f32x4){0.f, 0.f, 0.f, 0.f};
    bf16x8 At[4][2], B0[2][2], B1[2][2];
    const char* cA = (const char*)g.A + (size_t)cur.pm * tstep; const char* cB = (const char*)g.Bt + (size_t)cur.pn * tstep;
    S.a_ready(cur);
    if constexpr (SP2) {
        PG8_STAGE(PG8_SB(0, 0), cB, voffB); PG8_STAGE(PG8_SB(0, 1), cB + hstep, voffB); PG8_STAGE(PG8_SA(0, 0), cA, voffA); PG8_STAGE(PG8_SA(0, 1), cA + hstep, voffA);
        if (wr == 1) PG8_BAR;
        PG8_WAIT_V(2); PG8_BAR;
        PG8_STAGE(PG8_SB(1, 0), cB + kstep, voffB); PG8_STAGE(PG8_SA(1, 0), cA + kstep, voffA); PG8_STAGE(PG8_SB(1, 1), cB + hstep + kstep, voffB);
        PG8_WAIT_V(6); PG8_BAR;
    } else {
        PG8_STAGE(PG8_SB(0, 0), cB, voffB); PG8_STAGE(PG8_SA(0, 0), cA, voffA); PG8_STAGE(PG8_SB(0, 1), cB + hstep, voffB); PG8_STAGE(PG8_SA(0, 1), cA + hstep, voffA);
        if (wr == 1) PG8_BAR;
        PG8_WAIT_V(4); PG8_BAR;
        PG8_STAGE(PG8_SB(1, 0), cB + kstep, voffB); PG8_STAGE(PG8_SA(1, 0), cA + kstep, voffA); PG8_STAGE(PG8_SB(1, 1), cB + hstep + kstep, voffB);
        PG8_WAIT_V(6); PG8_BAR;
    }
    for (;;) {
        const bool has_next = S.next(ui + 1, nxt);
        const char* nA = has_next ? (const char*)g.A + (size_t)nxt.pm * tstep : cA; const char* nB = has_next ? (const char*)g.Bt + (size_t)nxt.pn * tstep : cB;
        for (int t = 0; t < nt; t += 2) {
            const bool last = (t == nt - 2);
            const char* a1 = cA + (size_t)(t + 1) * kstep;
            const char* a2 = last ? nA : cA + (size_t)(t + 2) * kstep; const char* b2 = last ? nB : cB + (size_t)(t + 2) * kstep;
            const char* a3 = a2 + kstep; const char* b3 = b2 + kstep;
            if (last && has_next) S.a_ready(nxt);
            if constexpr (SP2) {
            PG8_LDB(B0, 0, 0); PG8_LDB(B1, 0, 1); PG8_SCHED; PG8_LDA(At, 0, 0); PG8_STAGE(PG8_SA(1, 1), a1 + hstep, voffA);
            PG8_WAIT_V(8); PG8_WAIT_L(0); PG8_BAR; PG8_MMA(0, 0, At, B0); PG8_MMA(0, 1, At, B1); PG8_BAR; PG8_SCHED;
            PG8_LDA(At, 0, 1); PG8_STAGE(PG8_SB(0, 0), b2, voffB); PG8_STAGE(PG8_SB(0, 1), b2 + hstep, voffB); PG8_STAGE(PG8_SA(0, 0), a2, voffA);
            PG8_WAIT_V(8); PG8_WAIT_L(0); PG8_BAR; PG8_MMA(1, 0, At, B0); PG8_MMA(1, 1, At, B1); PG8_BAR; PG8_SCHED;
            PG8_LDB(B0, 1, 0); PG8_LDB(B1, 1, 1); PG8_SCHED; PG8_LDA(At, 1, 0); PG8_STAGE(PG8_SA(0, 1), a2 + hstep, voffA);
            PG8_WAIT_V(8); PG8_WAIT_L(0); PG8_BAR; PG8_MMA(0, 0, At, B0); PG8_MMA(0, 1, At, B1); PG8_BAR; PG8_SCHED;
            PG8_LDA(At, 1, 1); PG8_STAGE(PG8_SB(1, 0), b3, voffB); PG8_STAGE(PG8_SB(1, 1), b3 + hstep, voffB); PG8_STAGE(PG8_SA(1, 0), a3, voffA);
            PG8_WAIT_V(8); PG8_WAIT_L(0); PG8_BAR; PG8_MMA(1, 0, At, B0); PG8_MMA(1, 1, At, B1); PG8_BAR; PG8_SCHED;
            } else {
            PG8_LDB(B0, 0, 0); PG8_SCHED; PG8_LDA(At, 0, 0); PG8_STAGE(PG8_SA(1, 1), a1 + hstep, voffA);
            PG8_WAIT_L(8); PG8_BAR; PG8_WAIT_L(0); PG8_MMA(0, 0, At, B0); PG8_BAR; PG8_SCHED;
            PG8_LDB(B1, 0, 1); PG8_STAGE(PG8_SB(0, 0), b2, voffB);
            PG8_BAR; PG8_WAIT_L(0); PG8_MMA(0, 1, At, B1); PG8_BAR;
            PG8_LDA(At, 0, 1); PG8_STAGE(PG8_SA(0, 0), a2, voffA);
            PG8_BAR; PG8_WAIT_L(0); PG8_MMA(1, 0, At, B0); PG8_BAR; PG8_SCHED;
            PG8_STAGE(PG8_SB(0, 1), b2 + hstep, voffB);
            PG8_WAIT_V(6); PG8_BAR; PG8_MMA(1, 1, At, B1); PG8_BAR;
            PG8_LDB(B0, 1, 0); PG8_SCHED; PG8_LDA(At, 1, 0); PG8_STAGE(PG8_SA(0, 1), a2 + hstep, voffA);
            PG8_WAIT_L(8); PG8_BAR; PG8_WAIT_L(0); PG8_MMA(0, 0, At, B0); PG8_BAR; PG8_SCHED;
            PG8_LDB(B1, 1, 1); PG8_STAGE(PG8_SB(1, 0), b3, voffB);
            PG8_BAR; PG8_WAIT_L(0); PG8_MMA(0, 1, At, B1); PG8_BAR;
            PG8_LDA(At, 1, 1); PG8_STAGE(PG8_SA(1, 0), a3, voffA);
            PG8_BAR; PG8_WAIT_L(0); PG8_MMA(1, 0, At, B0); PG8_BAR; PG8_SCHED;
            PG8_STAGE(PG8_SB(1, 1), b3 + hstep, voffB);
            PG8_WAIT_V(6); PG8_BAR; PG8_MMA(1, 1, At, B1); PG8_BAR;
            }
        }
        if constexpr (ALIGN_EPI) { if (wr == 0) PG8_BAR; }
        if constexpr (!Epi::AFTER_DRAIN) { E(acc, cur, wr, wc, fr, fq); S.done(cur); }
        if (!has_next) break;
#pragma unroll
        for (int a = 0; a < 2; ++a)
#pragma unroll
            for (int b = 0; b < 2; ++b)
#pragma unroll
                for (int m = 0; m < 4; ++m)
#pragma unroll
                    for (int n = 0; n < 2; ++n) acc[a][b][m][n] = (f32x4){0.f, 0.f, 0.f, 0.f};
        cur = nxt; cA = nA; cB = nB; ++ui;
        if constexpr (ALIGN_EPI) { if (wr == 1) PG8_BAR; }
    }
    PG8_WAIT_V(0);
    if constexpr (!ALIGN_EPI) { if (wr == 0) PG8_BAR; }
    PG8_BAR;
    if constexpr (Epi::AFTER_DRAIN) { E.fused(acc, cur, wr, wc, fr, fq, lds, wid, lane); S.done(cur); }
#undef PG8_SA
#undef PG8_SB
#undef PG8_STAGE
#undef PG8_LDA
#undef PG8_LDB
#undef PG8_MMA
#undef PG8_WAIT_V
#undef PG8_WAIT_L
#undef PG8_BAR
#undef PG8_SCHED
}
}

typedef float f32x16 __attribute__((ext_vector_type(16)));
typedef short s16x4 __attribute__((ext_vector_type(4)));
typedef short v4i16_t __attribute__((ext_vector_type(4)));
typedef float f32x2_t __attribute__((ext_vector_type(2)));
typedef __bf16 bf16x2_t __attribute__((ext_vector_type(2)));
#define LAS __attribute__((address_space(3)))
constexpr int VROW = 144, VBUF = 32 * VROW;
constexpr int VROWV = 192, VBUFV = 32 * VROWV;
constexpr float L2E = 1.4426950408889634f, LN2 = 0.6931471805599453f;
constexpr float SC2 = 0.125f * L2E;

__device__ __forceinline__ int crow(int r, int hi) { return (r & 3) + 8 * (r >> 2) + 4 * hi; }
__device__ __forceinline__ unsigned cvtpk(float lo, float hi) { f32x2_t v = {lo, hi}; bf16x2_t b = __builtin_convertvector(v, bf16x2_t); return __builtin_bit_cast(unsigned, b); }
__device__ __forceinline__ float xhalf(float v, int hi) {
    auto r = __builtin_amdgcn_permlane32_swap(__float_as_uint(v), __float_as_uint(v), false, false);
    return __uint_as_float(hi ? r[0] : r[1]);
}
__device__ __forceinline__ s16x4 vtr(const LAS unsigned char* p) { return __builtin_bit_cast(s16x4, __builtin_amdgcn_ds_read_tr16_b64_v4i16((LAS v4i16_t*)p)); }

struct KVRegs { u32x4 k[4]; u32x4 v[4]; };
__device__ __forceinline__ void load_kv(KVRegs& R, const bf16* base, int kp0, int kst, int kcol, int vcol, int lane) {
#pragma unroll
    for (int j = 0; j < 4; ++j) {
        const int pos = kp0 + kst * (8 * j + (lane >> 3));
        const int pc = pos < SQ - 1 ? pos : SQ - 1;
        const bf16* rp = base + (size_t)pc * QKV_LD + (lane & 7) * 8;
        R.k[j] = *(const u32x4*)(rp + kcol); R.v[j] = *(const u32x4*)(rp + vcol);
    }
}
__device__ __forceinline__ void kv_stage(const KVRegs& R, LAS unsigned char* klds, LAS unsigned char* vlds, int lane) {
#pragma unroll
    for (int j = 0; j < 4; ++j) { const int r_ = 8 * j + (lane >> 3), c_ = (lane & 7) * 16; *(LAS u32x4*)(klds + r_ * VROW + c_) = R.k[j]; *(LAS u32x4*)(vlds + r_ * VROWV + c_) = R.v[j]; }
}
__device__ __forceinline__ f32x16 qk_tile(const LAS unsigned char* klds, const bf16x8 (&qf)[4], int r32, int hi) {
    f32x16 s = {0.f, 0.f, 0.f, 0.f, 0.f, 0.f, 0.f, 0.f, 0.f, 0.f, 0.f, 0.f, 0.f, 0.f, 0.f, 0.f};
#pragma unroll
    for (int k = 0; k < 4; ++k) { const bf16x8 kf = *(const LAS bf16x8*)(klds + r32 * VROW + (2 * k + hi) * 16); s = __builtin_amdgcn_mfma_f32_32x32x16_bf16(kf, qf[k], s, 0, 0, 0); }
    return s;
}
__device__ __forceinline__ void pv_tile(f32x16 (&o)[2], const f32x16& p, const LAS unsigned char* vlds, int lane) {
    const int g = lane >> 4, i = lane & 15, h = lane >> 5;
    const LAS unsigned char* vb = vlds + (4 * h + (i >> 2)) * VROWV + (16 * (g & 1) + 4 * (i & 3)) * 2;
#pragma unroll
    for (int s = 0; s < 2; ++s) {
        u32x4 pw; pw.x = cvtpk(p[8 * s], p[8 * s + 1]); pw.y = cvtpk(p[8 * s + 2], p[8 * s + 3]); pw.z = cvtpk(p[8 * s + 4], p[8 * s + 5]); pw.w = cvtpk(p[8 * s + 6], p[8 * s + 7]);
        const bf16x8 pb = __builtin_bit_cast(bf16x8, pw);
#pragma unroll
        for (int df = 0; df < 2; ++df) {
            const s16x4 lo = vtr(vb + (16 * s) * VROWV + df * 64), hh = vtr(vb + (16 * s + 8) * VROWV + df * 64);
            const bf16x8 va = (bf16x8){lo[0], lo[1], lo[2], lo[3], hh[0], hh[1], hh[2], hh[3]};
            o[df] = __builtin_amdgcn_mfma_f32_32x32x16_bf16(va, pb, o[df], 0, 0, 0);
        }
    }
}
__device__ __forceinline__ void load_q(bf16x8 (&qf)[4], const bf16* base, int qpos, int qcol, int hi) {
    const bf16* rp = base + (size_t)qpos * QKV_LD + qcol + 8 * hi;
#pragma unroll
    for (int k = 0; k < 4; ++k) qf[k] = *(const bf16x8*)(rp + 16 * k);
}
__device__ __forceinline__ void store_o(bf16* yrow, const f32x16 (&o)[2], float inv, int hi) {
#pragma unroll
    for (int df = 0; df < 2; ++df)
#pragma unroll
        for (int g = 0; g < 4; ++g) {
            u32x2 w; w.x = cvtpk(o[df][4 * g] * inv, o[df][4 * g + 1] * inv); w.y = cvtpk(o[df][4 * g + 2] * inv, o[df][4 * g + 3] * inv);
            *(u32x2*)(yrow + 32 * df + 8 * g + 4 * hi) = w;
        }
}
__device__ __forceinline__ void osm_tile(f32x16& s, float& m, float& l, f32x16 (&o)[2]) {
    float mx = s[0];
#pragma unroll
    for (int r = 1; r < 16; ++r) mx = fmaxf(mx, s[r]);
    { auto rr = __builtin_amdgcn_permlane32_swap(__float_as_uint(mx), __float_as_uint(mx), false, false); mx = fmaxf(__uint_as_float(rr[0]), __uint_as_float(rr[1])); }
    const float mn = fmaxf(m, mx);
    const float ms = (mn == -INFINITY) ? 0.f : mn;
    const float alpha = __builtin_amdgcn_exp2f((m - ms) * SC2);
    const float mc = ms * SC2;
    float ps = 0.f;
#pragma unroll
    for (int r = 0; r < 16; ++r) { s[r] = __builtin_amdgcn_exp2f(s[r] * SC2 - mc); ps += s[r]; }
    l = l * alpha + ps; m = mn;
    if (!__all(alpha == 1.0f)) {
#pragma unroll
        for (int df = 0; df < 2; ++df)
#pragma unroll
            for (int r = 0; r < 16; ++r) o[df][r] *= alpha;
    }
}
__device__ __forceinline__ void osm_tile2(f32x16& s0, f32x16& s1, float& m, float& l, f32x16 (&o)[2]) {
    float mx = fmaxf(s0[0], s1[0]);
#pragma unroll
    for (int r = 1; r < 16; ++r) mx = fmaxf(mx, fmaxf(s0[r], s1[r]));
    { auto rr = __builtin_amdgcn_permlane32_swap(__float_as_uint(mx), __float_as_uint(mx), false, false); mx = fmaxf(__uint_as_float(rr[0]), __uint_as_float(rr[1])); }
    const float mn = fmaxf(m, mx);
    const float ms = (mn == -INFINITY) ? 0.f : mn;
    const float alpha = __builtin_amdgcn_exp2f((m - ms) * SC2);
    const float mc = ms * SC2;
    float ps0 = 0.f, ps1 = 0.f;
#pragma unroll
    for (int r = 0; r < 16; ++r) { s0[r] = __builtin_amdgcn_exp2f(s0[r] * SC2 - mc); ps0 += s0[r]; s1[r] = __builtin_amdgcn_exp2f(s1[r] * SC2 - mc); ps1 += s1[r]; }
    l = l * alpha + (ps0 + ps1); m = mn;
    if (!__all(alpha == 1.0f)) {
#pragma unroll
        for (int df = 0; df < 2; ++df)
#pragma unroll
            for (int r = 0; r < 16; ++r) o[df][r] *= alpha;
    }
}
#define ZERO16 {0.f, 0.f, 0.f, 0.f, 0.f, 0.f, 0.f, 0.f, 0.f, 0.f, 0.f, 0.f, 0.f, 0.f, 0.f, 0.f}

struct AttnCtx {
    const bf16* base; int kcol, vcol, r32, hi, lane; LAS unsigned char* vlds; LAS unsigned char* klds; bf16x8 qf[4]; f32x16 o[2];
};
#define ATTN_STEP(SC, SL, T) { \
        if (SYNC) __builtin_amdgcn_s_barrier(); \
        { int kp_, ks_; const int tl_ = (T) + 2 < nt ? (T) + 2 : nt - 1; mx.pos(tl_, kp_, ks_); load_kv(SL, c.base, kp_, ks_, c.kcol, c.vcol, c.lane); } \
        kv_stage(SC, c.klds, c.vlds, c.lane); f32x16 s_ = qk_tile(c.klds, c.qf, c.r32, c.hi); \
        const bool stop_ = mx.process((T), s_, c); pv_tile(c.o, s_, c.vlds, c.lane); \
        if ((!SYNC && stop_) || (T) + 1 >= nt) break; }
template <class M, bool SYNC> __device__ __forceinline__ void attn_run(M& mx, AttnCtx& c) {
    const int nt = mx.nt;
    KVRegs S0, S1, S2;
    { int kp, ks; mx.pos(0, kp, ks); load_kv(S0, c.base, kp, ks, c.kcol, c.vcol, c.lane);
      mx.pos(1 < nt ? 1 : nt - 1, kp, ks); load_kv(S1, c.base, kp, ks, c.kcol, c.vcol, c.lane); }
    for (int t = 0;; t += 3) {
        ATTN_STEP(S0, S2, t)
        ATTN_STEP(S1, S0, t + 1)
        ATTN_STEP(S2, S1, t + 2)
    }
}
#define SH_BAR() asm volatile("s_waitcnt lgkmcnt(0)\n\ts_barrier" ::: "memory")
constexpr int SLOT_K = 64 * VROW, SLOT_BYTES = 64 * VROW + 64 * VROWV;
struct ShRegs { u32x4 a, b; };
__device__ __forceinline__ void sh_load(ShRegs& R, const bf16* base, int kp0, int kcol, int vcol, int w, int lane) {
    const int pos = kp0 + 4 * w + ((lane & 31) >> 3);
    const int pa = pos < SQ - 1 ? pos : SQ - 1, pb = pos + 32 < SQ - 1 ? pos + 32 : SQ - 1;
    const int col = ((lane >> 5) ? vcol : kcol) + (lane & 7) * 8;
    R.a = *(const u32x4*)(base + (size_t)pa * QKV_LD + col); R.b = *(const u32x4*)(base + (size_t)pb * QKV_LD + col);
}
__device__ __forceinline__ void sh_write(LAS unsigned char* slot, const ShRegs& R, int w, int lane) {
    const int row = 4 * w + ((lane & 31) >> 3);
    LAS unsigned char* p = slot + ((lane >> 5) ? SLOT_K + row * VROWV : row * VROW) + (lane & 7) * 16;
    *(LAS u32x4*)p = R.a; *(LAS u32x4*)(p + 32 * ((lane >> 5) ? VROWV : VROW)) = R.b;
}
#define SH_STEP(RW, RL, T) { \
        SH_BAR(); \
        { const int tl_ = (T) + 2 < nt ? (T) + 2 : nt - 1; sh_load(RL, c.base, mx.pos2(tl_), c.kcol, c.vcol, w, c.lane); } \
        sh_write(slots + (((T) + 1) & 1) * SLOT_BYTES, RW, w, c.lane); \
        if (mx.active2((T), w)) { LAS unsigned char* sl_ = slots + ((T) & 1) * SLOT_BYTES; \
            f32x16 s0_ = qk_tile(sl_, c.qf, c.r32, c.hi), s1_ = qk_tile(sl_ + 32 * VROW, c.qf, c.r32, c.hi); mx.process2((T), s0_, s1_, c); \
            pv_tile(c.o, s0_, sl_ + SLOT_K, c.lane); pv_tile(c.o, s1_, sl_ + SLOT_K + 32 * VROWV, c.lane); } \
        if ((T) + 1 >= nt) break; }
template <class M> __device__ __forceinline__ void attn_run_shared(M& mx, AttnCtx& c, LAS unsigned char* slots, int w) {
    const int nt = mx.nt2;
    ShRegs R0, R1, R2;
    sh_load(R0, c.base, mx.pos2(0), c.kcol, c.vcol, w, c.lane);
    sh_load(R1, c.base, mx.pos2(1 < nt ? 1 : nt - 1), c.kcol, c.vcol, w, c.lane);
    SH_BAR();
    sh_write(slots, R0, w, c.lane);
    for (int t = 0;; t += 3) {
        SH_STEP(R1, R2, t)
        SH_STEP(R2, R0, t + 1)
        SH_STEP(R0, R1, t + 2)
    }
}
struct MixA {
    int nt, k00, qpos; float m, l;
    __device__ __forceinline__ void pos(int idx, int& kp0, int& kst) const { kp0 = k00 + 32 * idx; kst = 1; }
    __device__ __forceinline__ bool process(int idx, f32x16& s, AttnCtx& c) {
        const int k0 = k00 + 32 * idx;
#pragma unroll
        for (int r = 0; r < 16; ++r) { const int dist = qpos - (k0 + crow(r, c.hi)); if (dist < 0 || dist > 127) s[r] = -INFINITY; }
        osm_tile(s, m, l, c.o); return false;
    }
};
__device__ void attn_A(const bf16* base, int hq, int q0, float sink, bf16* ybase, LAS unsigned char* vlds, int lane) {
    AttnCtx c; c.base = base; c.r32 = lane & 31; c.hi = lane >> 5; c.lane = lane; c.vlds = vlds; c.klds = vlds + VBUFV; c.kcol = 512 + (hq >> 2) * 64; c.vcol = 640 + (hq >> 2) * 64;
    c.o[0] = (f32x16)ZERO16; c.o[1] = (f32x16)ZERO16;
    MixA mx; mx.qpos = q0 + c.r32; mx.k00 = q0 - 128 > 0 ? q0 - 128 : 0; mx.nt = 5; mx.m = -INFINITY; mx.l = 0.f;
    load_q(c.qf, base, mx.qpos, hq * 64, c.hi);
    attn_run<MixA, true>(mx, c);
    float l = mx.l + xhalf(mx.l, c.hi);
    l += __builtin_amdgcn_exp2f(sink * L2E - mx.m * SC2);
    store_o(ybase + (size_t)mx.qpos * DM + hq * 64, c.o, 1.0f / l, c.hi);
}
struct MixB {
    int nt, q0, qpos; float carry;
    __device__ __forceinline__ void pos(int idx, int& kp0, int& kst) const { kp0 = q0 - 32 * idx; kst = 1; }
    __device__ __forceinline__ bool process(int idx, f32x16& s, AttnCtx& c) {
        const int k0 = q0 - 32 * idx, hi = c.hi;
        float lk[16], G[4], Gp[4];
#pragma unroll
        for (int r = 0; r < 16; ++r) {
            const float z = s[r] * 0.125f;
            const bool valid = (k0 + crow(r, hi)) < qpos;
            const float sp = fmaxf(z, 0.f) + LN2 * __builtin_amdgcn_logf(1.0f + __builtin_amdgcn_exp2f(-fabsf(z) * L2E));
            lk[r] = valid ? -sp : 0.f;
            s[r] = valid ? (z - sp) : -INFINITY;
        }
#pragma unroll
        for (int g = 0; g < 4; ++g) { G[g] = (lk[4 * g] + lk[4 * g + 1]) + (lk[4 * g + 2] + lk[4 * g + 3]); Gp[g] = xhalf(G[g], hi); }
        float above = carry;
#pragma unroll
        for (int g = 3; g >= 0; --g) {
            float off = above + (hi == 0 ? Gp[g] : 0.f);
            s[4 * g + 3] = __builtin_amdgcn_exp2f((s[4 * g + 3] + off) * L2E); off += lk[4 * g + 3];
            s[4 * g + 2] = __builtin_amdgcn_exp2f((s[4 * g + 2] + off) * L2E); off += lk[4 * g + 2];
            s[4 * g + 1] = __builtin_amdgcn_exp2f((s[4 * g + 1] + off) * L2E); off += lk[4 * g + 1];
            s[4 * g + 0] = __builtin_amdgcn_exp2f((s[4 * g + 0] + off) * L2E);
            above += G[g] + Gp[g];
        }
        carry = above;
        return __all(carry < -40.0f) != 0;
    }
};
__device__ void attn_B(const bf16* base, int h, int q0, bf16* ybase, LAS unsigned char* vlds, int lane) {
    AttnCtx c; c.base = base; c.r32 = lane & 31; c.hi = lane >> 5; c.lane = lane; c.vlds = vlds; c.klds = vlds + VBUFV; c.kcol = 1280 + h * 64; c.vcol = 1792 + h * 64;
    c.o[0] = (f32x16)ZERO16; c.o[1] = (f32x16)ZERO16;
    MixB mx; mx.q0 = q0; mx.qpos = q0 + c.r32; mx.nt = q0 / 32 + 1; mx.carry = 0.f;
    load_q(c.qf, base, mx.qpos, 768 + h * 64, c.hi);
    attn_run<MixB, false>(mx, c);
    store_o(ybase + (size_t)mx.qpos * DM + 512 + h * 64, c.o, 1.0f, c.hi);
}
struct MixCp {
    int nt, n0, r0, j1lo, qpos; float m, l;
    __device__ __forceinline__ void pos(int t, int& kp0, int& kst) const {
        if (t < n0) { kp0 = r0 + 512 * t; kst = 16; } else { kp0 = (r0 & 3) + 4 * (j1lo + 32 * (t - n0)); kst = 4; }
    }
    __device__ __forceinline__ bool process(int t, f32x16& s, AttnCtx& c) {
        int kp0, kst; pos(t, kp0, kst);
        const int win = t < n0 ? 2048 : 512;
#pragma unroll
        for (int r = 0; r < 16; ++r) { const int dist = qpos - (kp0 + kst * crow(r, c.hi)); if (dist < 0 || dist > win) s[r] = -INFINITY; }
        osm_tile(s, m, l, c.o); return false;
    }
};
struct MixC1 {
    int nt2, p0, qpos; float m, l;
    __device__ __forceinline__ int pos2(int T) const { return p0 + 64 * T; }
    __device__ __forceinline__ bool active2(int T, int w) const { return true; }
    __device__ __forceinline__ void process2(int T, f32x16& s0, f32x16& s1, AttnCtx& c) {
        const int k0 = p0 + 64 * T;
#pragma unroll
        for (int r = 0; r < 16; ++r) { const int dist = qpos - (k0 + crow(r, c.hi)); if (dist < 0 || dist > 128) s0[r] = -INFINITY; if (dist < 32 || dist > 160) s1[r] = -INFINITY; }
        osm_tile2(s0, s1, m, l, c.o);
    }
};
__device__ void attn_C(const bf16* base, int h, int r0, int g, bf16* ybase, LAS unsigned char* vlds, LAS unsigned char* xlds, int w, int lane) {
    AttnCtx c; c.base = base; c.r32 = lane & 31; c.hi = lane >> 5; c.lane = lane; c.vlds = vlds; c.klds = vlds + VBUFV; c.kcol = 512 + h * 64; c.vcol = 1024 + h * 64;
    c.o[0] = (f32x16)ZERO16; c.o[1] = (f32x16)ZERO16;
    const int qpos = r0 + 16 * (32 * g + c.r32);
    load_q(c.qf, base, qpos, h * 64, c.hi);
    MixCp mp; mp.r0 = r0; mp.qpos = qpos; mp.m = -INFINITY; mp.l = 0.f;
    mp.n0 = g + 1;
    mp.j1lo = (r0 >> 2) + 128 * g - 128 > 0 ? (r0 >> 2) + 128 * g - 128 : 0;
    mp.nt = mp.n0 + ((r0 >> 2) + 128 * g + 124 - mp.j1lo) / 32 + 1;
    attn_run<MixCp, true>(mp, c);
    MixC1 m1; m1.qpos = qpos; m1.m = mp.m; m1.l = mp.l;
    const int ra = r0 & 8;
    m1.p0 = 512 * g + ra - 128 > 0 ? 512 * g + ra - 128 : 0;
    m1.nt2 = ((512 * g + ra + 7 + 496 - m1.p0) / 32 + 2) / 2;
    attn_run_shared<MixC1>(m1, c, xlds + 64, w);
    const float l = m1.l + xhalf(m1.l, c.hi);
    store_o(ybase + (size_t)qpos * DM + h * 64, c.o, 1.0f / l, c.hi);
}
struct MixD {
    int nt, nt2, npast, own, q0, qpos; unsigned U, sel; float m, l;
    __device__ __forceinline__ int blk_of(int j) const {
        unsigned u = U; int b = 0;
#pragma unroll
        for (int i = 0; i < 7; ++i) { if (i < j) u &= u - 1u; }
        b = __builtin_ctz(u | 0x100u); return b;
    }
    __device__ __forceinline__ void pos(int t, int& kp0, int& kst) const {
        kst = 1;
        if (t < 8 * npast) kp0 = blk_of(t >> 3) * 256 + (t & 7) * 32; else kp0 = own * 256 + (t - 8 * npast) * 32;
    }
    __device__ __forceinline__ int pos2(int T) const { int kp, ks; pos(2 * T, kp, ks); return kp; }
    __device__ __forceinline__ bool active2(int T, int w) const { return T < 4 * npast || 2 * (T - 4 * npast) <= w; }
    __device__ __forceinline__ void process2(int T, f32x16& s0, f32x16& s1, AttnCtx& c) {
        if (T < 4 * npast) {
            const int blk = blk_of(T >> 2);
            if (!((sel >> blk) & 1u)) {
#pragma unroll
                for (int r = 0; r < 16; ++r) { s0[r] = -INFINITY; s1[r] = -INFINITY; }
            }
        } else {
            const int k0 = own * 256 + (T - 4 * npast) * 64;
#pragma unroll
            for (int r = 0; r < 16; ++r) { const int kk = k0 + crow(r, c.hi); if (kk > qpos) s0[r] = -INFINITY; if (kk + 32 > qpos) s1[r] = -INFINITY; }
        }
        osm_tile2(s0, s1, m, l, c.o);
    }
};
__device__ void attn_D(const bf16* base, const float* kmean  , int h, int q0, bf16* ybase, LAS unsigned char* vlds, LAS unsigned char* xlds, int lane) {
    AttnCtx c; c.base = base; c.r32 = lane & 31; c.hi = lane >> 5; c.lane = lane; c.vlds = vlds; c.klds = vlds + VBUFV; c.kcol = 2048 + h * 64; c.vcol = 2560 + h * 64;
    c.o[0] = (f32x16)ZERO16; c.o[1] = (f32x16)ZERO16;
    const int r32 = c.r32, hi = c.hi, own = q0 >> 8;
    MixD mx; mx.own = own; mx.q0 = q0; mx.qpos = q0 + r32; mx.m = -INFINITY; mx.l = 0.f;
    load_q(c.qf, base, mx.qpos, 1536 + h * 64, hi);
    unsigned sel = 0u;
    if (own > 0) {
        bf16x8 kf[4];
#pragma unroll
        for (int k = 0; k < 4; ++k) {
            u32x4 w = {0u, 0u, 0u, 0u};
            if (r32 < 8) { const float* kp = kmean + r32 * 64 + 16 * k + 8 * hi; const f32x4 a = *(const f32x4*)kp, b = *(const f32x4*)(kp + 4);
                w.x = cvtpk(a[0], a[1]); w.y = cvtpk(a[2], a[3]); w.z = cvtpk(b[0], b[1]); w.w = cvtpk(b[2], b[3]); }
            kf[k] = __builtin_bit_cast(bf16x8, w);
        }
        f32x16 gs = ZERO16;
#pragma unroll
        for (int k = 0; k < 4; ++k) gs = __builtin_amdgcn_mfma_f32_32x32x16_bf16(kf[k], c.qf[k], gs, 0, 0, 0);
        float gt[8];
#pragma unroll
        for (int r = 0; r < 4; ++r) { const float mine = gs[r], oth = xhalf(mine, hi); gt[r] = hi == 0 ? mine : oth; gt[4 + r] = hi == 0 ? oth : mine; }
        const int nsel = own < 3 ? own : 3;
        for (int rr = 0; rr < nsel; ++rr) {
            float best = -INFINITY; int bi = -1;
#pragma unroll
            for (int n = 0; n < 8; ++n) { const bool ok = n < own && !((sel >> n) & 1u) && (bi < 0 || gt[n] > best); if (ok) { best = gt[n]; bi = n; } }
            if (bi >= 0) sel |= 1u << bi;
        }
    }
    unsigned U = 0u;
#pragma unroll
    for (int n = 0; n < 8; ++n) if (__ballot((sel >> n) & 1u) != 0ull) U |= 1u << n;
    {
        volatile LAS unsigned* ux = (volatile LAS unsigned*)xlds;
        __builtin_amdgcn_s_barrier();
        if (lane == 0) ux[(q0 >> 5) & 7] = U;
        asm volatile("s_waitcnt lgkmcnt(0)" ::: "memory");
        __builtin_amdgcn_s_barrier();
        U = ux[0] | ux[1] | ux[2] | ux[3] | ux[4] | ux[5] | ux[6] | ux[7];
        U = __builtin_amdgcn_readfirstlane(U);
    }
    mx.U = U; mx.sel = sel; mx.npast = __builtin_popcount(U); mx.nt = 8 * mx.npast + 8; mx.nt2 = 4 * mx.npast + 4;
    attn_run_shared<MixD>(mx, c, xlds + 64, (q0 >> 5) & 7);
    const float l = mx.l + xhalf(mx.l, c.hi);
    store_o(ybase + (size_t)mx.qpos * DM + 512 + h * 64, c.o, 1.0f / l, hi);
}

__device__ void ph_attn0(const bf16* qkv, const float* sinks, bf16* y, LAS unsigned char* lds, int bid, int nb) {
    const int lane = ltid() & 63, w = __builtin_amdgcn_readfirstlane(ltid() >> 6);
    LAS unsigned char* vlds = lds + w * (VBUF + VBUFV);
    for (int pid = bid; pid < NB * 8; pid += nb) {
        const int b = pid >> 3, h = pid & 7;
        const bf16* base = qkv + (size_t)b * SQ * QKV_LD; bf16* ybase = y + (size_t)b * SQ * DM;
        const float sink = sinks[h];
        for (int rd = 0; rd < 8; ++rd) attn_A(base, h, (rd * 8 + w) * 32, sink, ybase, vlds, lane);
        for (int rd = 0; rd < 8; ++rd) attn_B(base, h, (rd * 8 + w) * 32, ybase, vlds, lane);
    }
}
__device__ void ph_attn1(const bf16* qkv, const float* kmean, bf16* y, LAS unsigned char* lds, int bid, int nb) {
    const int lane = ltid() & 63, w = __builtin_amdgcn_readfirstlane(ltid() >> 6);
    LAS unsigned char* vlds = lds + w * (VBUF + VBUFV);
    for (int pid = bid; pid < NB * 8; pid += nb) {
        const int b = pid >> 3, h = pid & 7;
        const bf16* base = qkv + (size_t)b * SQ * QKV_LD; bf16* ybase = y + (size_t)b * SQ * DM;
        for (int rd = 0; rd < 8; ++rd) { const int it = rd * 8 + w; attn_C(base, h, it & 15, it >> 4, ybase, vlds, lds + 8 * (VBUF + VBUFV), w, lane); }
        for (int rd = 0; rd < 8; ++rd) attn_D(base, kmean + (size_t)pid * 8 * 64, h, (rd * 8 + w) * 32, ybase, vlds, lds + 8 * (VBUF + VBUFV), lane);
    }
}

#define CE_D(a, b) { const float hi_ = fmaxf((a), (b)), lo_ = fminf((a), (b)); (a) = hi_; (b) = lo_; }
#define BSTAGE(arr, k, j) _Pragma("unroll") for (int i_ = 0; i_ < 16; ++i_) { const int l_ = i_ ^ (j); if (l_ > i_) { if ((i_ & (k)) == 0) CE_D(arr[i_], arr[l_]) else CE_D(arr[l_], arr[i_]) } }
__device__ __forceinline__ void bsort16(float (&a)[16]) {
    BSTAGE(a, 2, 1) BSTAGE(a, 4, 2) BSTAGE(a, 4, 1) BSTAGE(a, 8, 4) BSTAGE(a, 8, 2) BSTAGE(a, 8, 1) BSTAGE(a, 16, 8) BSTAGE(a, 16, 4) BSTAGE(a, 16, 2) BSTAGE(a, 16, 1)
}
__device__ __forceinline__ void bmerge16(float (&a)[16]) {
    BSTAGE(a, 16, 8) BSTAGE(a, 16, 4) BSTAGE(a, 16, 2) BSTAGE(a, 16, 1)
}
__device__ __forceinline__ void merge_top16(float (&a)[16], const float (&b)[16]) {
#pragma unroll
    for (int i = 0; i < 16; ++i) a[i] = fmaxf(a[i], b[15 - i]);
    bmerge16(a);
}
__device__ __forceinline__ void xmerge16(float (&a)[16]) {
    {
        float A[16], B[16];
#pragma unroll
        for (int i = 0; i < 16; ++i) { auto r = __builtin_amdgcn_permlane16_swap(__float_as_uint(a[i]), __float_as_uint(a[i]), false, false); A[i] = __uint_as_float(r[0]); B[i] = __uint_as_float(r[1]); }
#pragma unroll
        for (int i = 0; i < 16; ++i) a[i] = fmaxf(A[i], B[15 - i]);
        bmerge16(a);
    }
    {
        float A[16], B[16];
#pragma unroll
        for (int i = 0; i < 16; ++i) { auto r = __builtin_amdgcn_permlane32_swap(__float_as_uint(a[i]), __float_as_uint(a[i]), false, false); A[i] = __uint_as_float(r[0]); B[i] = __uint_as_float(r[1]); }
#pragma unroll
        for (int i = 0; i < 16; ++i) a[i] = fmaxf(A[i], B[15 - i]);
        bmerge16(a);
    }
}
__host__ __device__ constexpr int pair_i(int id) {
    int c = 0;
    for (int i = 0; i < 16; ++i) { const int nj = 16 / (i + 1); if (id < c + nj) return i; c += nj; }
    return 0;
}
__host__ __device__ constexpr int pair_j(int id) {
    int c = 0;
    for (int i = 0; i < 16; ++i) { const int nj = 16 / (i + 1); if (id < c + nj) return id - c; c += nj; }
    return 0;
}
constexpr int SK_ROW = 272;
constexpr int SEL_SK_BYTES = 2 * 128 * SK_ROW;
constexpr int SEL_TAB_OFF = SEL_SK_BYTES;
constexpr int SEL_IDX_OFF = SEL_SK_BYTES + 64;

template <int S> __device__ __forceinline__ float cand_slot(const float (&L1)[16], const float (&L2)[16], int g) {
    constexpr int p0 = S, p1 = 16 + S, p2 = 32 + S, p3 = 48 + S;
    const float c0 = L1[pair_i(p0)] + L2[pair_j(p0)], c1 = L1[pair_i(p1)] + L2[pair_j(p1)], c2 = L1[pair_i(p2)] + L2[pair_j(p2)];
    const float c3 = p3 < 50 ? L1[pair_i(p3 < 50 ? p3 : 0)] + L2[pair_j(p3 < 50 ? p3 : 0)] : -1.0e30f;
    const float c = g == 0 ? c0 : (g == 1 ? c1 : (g == 2 ? c2 : c3));
    return __uint_as_float((__float_as_uint(c) & 0xffffffc0u) | (unsigned)(16 * g + S));
}

__device__ void ph_peer_select(const bf16* qry, const float* subkeys  , int* eidx, float* egate, LAS unsigned char* lds, int bid, int nb) {
    const int tid = ltid(), lane = tid & 63, w = __builtin_amdgcn_readfirstlane(tid >> 6);
    const int tk = lane & 15, g = lane >> 4;
    __syncthreads();
    for (int e = tid; e < 2 * 128 * 128 / 2; e += NT) {
        const int row = e >> 6, c2 = (e & 63) * 2;
        const float a = subkeys[(size_t)row * 128 + c2], b = subkeys[(size_t)row * 128 + c2 + 1];
        *(LAS unsigned*)(lds + row * SK_ROW + c2 * 2) = pk2(a, b);
    }
    if (tid < 64) { int id = tid; int c = 0, pi = 0, pj = 0;
        for (int i = 0; i < 16; ++i) { const int nj = 16 / (i + 1); if (id >= c && id < c + nj) { pi = i; pj = id - c; } c += nj; }
        lds[SEL_TAB_OFF + tid] = (unsigned char)((pi << 4) | pj); }
    __syncthreads();
    LAS unsigned* widx = (LAS unsigned*)(lds + SEL_IDX_OFF + w * 512);
    const LAS unsigned char* widx8 = (const LAS unsigned char*)widx;
    const int nitems = (MT / 16) * 8;
    for (int it = bid * 8 + w; it < nitems; it += nb * 8) {
        const int h = it & 7, t0 = (it >> 3) * 16;
        float L[2][16];
#pragma unroll
        for (int hf = 0; hf < 2; ++hf) {
            bf16x8 qf[4];
            const bf16* qp = qry + (size_t)(t0 + tk) * PQ + h * 256 + hf * 128 + 8 * g;
#pragma unroll
            for (int ks = 0; ks < 4; ++ks) qf[ks] = *(const bf16x8*)(qp + 32 * ks);
            float key[32];
#pragma unroll
            for (int tile = 0; tile < 8; ++tile) {
                f32x4 acc = {0.f, 0.f, 0.f, 0.f};
#pragma unroll
                for (int ks = 0; ks < 4; ++ks) {
                    const bf16x8 af = *(const LAS bf16x8*)(lds + (hf * 128 + tile * 16 + tk) * SK_ROW + (32 * ks + 8 * g) * 2);
                    acc = __builtin_amdgcn_mfma_f32_16x16x32_bf16(af, qf[ks], acc, 0, 0, 0);
                }
#pragma unroll
                for (int r = 0; r < 4; ++r) key[tile * 4 + r] = __uint_as_float((__float_as_uint(acc[r]) & 0xffffff80u) | (unsigned)(16 * tile + 4 * g + r));
            }
            float a[16], b[16];
#pragma unroll
            for (int i = 0; i < 16; ++i) { a[i] = key[i]; b[i] = key[16 + i]; }
            bsort16(a); bsort16(b);
            merge_top16(a, b);
            xmerge16(a);
#pragma unroll
            for (int i = 0; i < 16; ++i) L[hf][i] = a[i];
            unsigned pk = 0u;
#pragma unroll
            for (int s = 0; s < 4; ++s) {
                const float v = g == 0 ? a[s] : (g == 1 ? a[4 + s] : (g == 2 ? a[8 + s] : a[12 + s]));
                pk |= (__float_as_uint(v) & 127u) << (8 * s);
            }
            widx[tk * 8 + hf * 4 + g] = pk;
        }
        float c[16];
        c[0] = cand_slot<0>(L[0], L[1], g); c[1] = cand_slot<1>(L[0], L[1], g); c[2] = cand_slot<2>(L[0], L[1], g); c[3] = cand_slot<3>(L[0], L[1], g);
        c[4] = cand_slot<4>(L[0], L[1], g); c[5] = cand_slot<5>(L[0], L[1], g); c[6] = cand_slot<6>(L[0], L[1], g); c[7] = cand_slot<7>(L[0], L[1], g);
        c[8] = cand_slot<8>(L[0], L[1], g); c[9] = cand_slot<9>(L[0], L[1], g); c[10] = cand_slot<10>(L[0], L[1], g); c[11] = cand_slot<11>(L[0], L[1], g);
        c[12] = cand_slot<12>(L[0], L[1], g); c[13] = cand_slot<13>(L[0], L[1], g); c[14] = cand_slot<14>(L[0], L[1], g); c[15] = cand_slot<15>(L[0], L[1], g);
        bsort16(c);
        xmerge16(c);
        float sum = 0.f, ex[16];
#pragma unroll
        for (int i = 0; i < 16; ++i) { ex[i] = __builtin_amdgcn_exp2f((c[i] - c[0]) * L2E); sum += ex[i]; }
        const float inv = 1.0f / sum;
        int oi[4]; float og[4];
#pragma unroll
        for (int s = 0; s < 4; ++s) {
            const float kv = g == 0 ? c[s] : (g == 1 ? c[4 + s] : (g == 2 ? c[8 + s] : c[12 + s]));
            const float ev = g == 0 ? ex[s] : (g == 1 ? ex[4 + s] : (g == 2 ? ex[8 + s] : ex[12 + s]));
            const unsigned pid = __float_as_uint(kv) & 63u;
            const unsigned ij = lds[SEL_TAB_OFF + pid];
            const unsigned i1 = widx8[tk * 32 + (ij >> 4)], i2 = widx8[tk * 32 + 16 + (ij & 15u)];
            oi[s] = (int)(i1 * 128u + i2); og[s] = ev * inv;
        }
        const size_t ob = (size_t)(t0 + tk) * 128 + h * 16 + 4 * g;
        *(u32x4*)(eidx + ob) = (u32x4){(unsigned)oi[0], (unsigned)oi[1], (unsigned)oi[2], (unsigned)oi[3]};
        *(f32x4*)(egate + ob) = (f32x4){og[0], og[1], og[2], og[3]};
    }
    __syncthreads();
}

typedef float v32f_t __attribute__((ext_vector_type(32)));
typedef unsigned v6u_t __attribute__((ext_vector_type(6)));
typedef unsigned v16u_t __attribute__((ext_vector_type(16)));
typedef __bf16 v32bf_t __attribute__((ext_vector_type(32)));
typedef __bf16 v2bf_t __attribute__((ext_vector_type(2)));
typedef _Float16 v32h_t __attribute__((ext_vector_type(32)));
typedef unsigned u32x3 __attribute__((ext_vector_type(3)));
constexpr int TROW = 768;
__device__ void ph_tab_fp6(const float* src, unsigned char* dst, float* scale, int nrows, int bid, int nb) {
    const int lane = ltid() & 63, w = __builtin_amdgcn_readfirstlane(ltid() >> 6);
    for (int rp = bid * 8 + w; rp < nrows / 2; rp += nb * 8) {
        v32h_t hv; float sc[2];
#pragma unroll
        for (int rr = 0; rr < 2; ++rr) {
            const float* sp = src + (size_t)(2 * rp + rr) * DM + lane * 16;
            f32x4 v[4]; float am = 0.f;
#pragma unroll
            for (int i = 0; i < 4; ++i) { v[i] = *(const f32x4*)(sp + i * 4); am = fmaxf(am, fmaxf(fmaxf(fabsf(v[i][0]), fabsf(v[i][1])), fmaxf(fabsf(v[i][2]), fabsf(v[i][3])))); }
            am = wave_max(am);
            const float s = am > 0.f ? am * (1.0f / 7.5f) : 1.0f, inv = 1.0f / s;
            sc[rr] = s;
#pragma unroll
            for (int i = 0; i < 4; ++i)
#pragma unroll
                for (int e = 0; e < 4; ++e) hv[rr * 16 + i * 4 + e] = (_Float16)fminf(fmaxf(v[i][e] * inv, -7.5f), 7.5f);
        }
        const v6u_t pk = __builtin_amdgcn_cvt_scalef32_pk32_fp6_f16(hv, 1.0f);
        unsigned* d0 = (unsigned*)(dst + (size_t)(2 * rp) * TROW + lane * 12);
        unsigned* d1 = (unsigned*)(dst + (size_t)(2 * rp + 1) * TROW + lane * 12);
        d0[0] = pk[0]; d0[1] = pk[1]; d0[2] = pk[2]; d1[0] = pk[3]; d1[1] = pk[4]; d1[2] = pk[5];
        if (lane == 0) { scale[2 * rp] = sc[0]; scale[2 * rp + 1] = sc[1]; }
    }
}

constexpr int TROW4 = 512;
__device__ void ph_tab_fp4(const float* src, unsigned char* dst, float* scale, int nrows, int bid, int nb) {
    const int lane = ltid() & 63, w = __builtin_amdgcn_readfirstlane(ltid() >> 6);
    for (int row = bid * 8 + w; row < nrows; row += nb * 8) {
        const float* sp = src + (size_t)row * DM + lane * 16;
        f32x4 v[4]; float am = 0.f;
#pragma unroll
        for (int i = 0; i < 4; ++i) { v[i] = *(const f32x4*)(sp + i * 4); am = fmaxf(am, fmaxf(fmaxf(fabsf(v[i][0]), fabsf(v[i][1])), fmaxf(fabsf(v[i][2]), fabsf(v[i][3])))); }
        am = wave_max(am);
        const float s = am > 0.f ? am * (1.0f / 6.0f) : 1.0f, inv = 1.0f / s;
        unsigned d0 = 0u, d1 = 0u;
        d0 = __builtin_amdgcn_cvt_scalef32_pk_fp4_f32(d0, v[0][0] * inv, v[0][1] * inv, 1.0f, 0); d0 = __builtin_amdgcn_cvt_scalef32_pk_fp4_f32(d0, v[0][2] * inv, v[0][3] * inv, 1.0f, 1);
        d0 = __builtin_amdgcn_cvt_scalef32_pk_fp4_f32(d0, v[1][0] * inv, v[1][1] * inv, 1.0f, 2); d0 = __builtin_amdgcn_cvt_scalef32_pk_fp4_f32(d0, v[1][2] * inv, v[1][3] * inv, 1.0f, 3);
        d1 = __builtin_amdgcn_cvt_scalef32_pk_fp4_f32(d1, v[2][0] * inv, v[2][1] * inv, 1.0f, 0); d1 = __builtin_amdgcn_cvt_scalef32_pk_fp4_f32(d1, v[2][2] * inv, v[2][3] * inv, 1.0f, 1);
        d1 = __builtin_amdgcn_cvt_scalef32_pk_fp4_f32(d1, v[3][0] * inv, v[3][1] * inv, 1.0f, 2); d1 = __builtin_amdgcn_cvt_scalef32_pk_fp4_f32(d1, v[3][2] * inv, v[3][3] * inv, 1.0f, 3);
        *(u32x2*)(dst + (size_t)row * TROW4 + lane * 8) = (u32x2){d0, d1};
        if (lane == 0) scale[row] = s;
    }
}

#define DPP_ADD(v, ctrl) ((v) + __builtin_bit_cast(float, __builtin_amdgcn_update_dpp(0, __builtin_bit_cast(int, (v)), (ctrl), 0xf, 0xf, true)))
typedef int i32x4_t __attribute__((ext_vector_type(4)));
struct GSet { v6u_t uq[2]; u32x2 vq[4]; float g, su, sv; };
__device__ __forceinline__ void gather_issue(GSet& S, int bt, int lane, int kslot, const unsigned char* pu, const unsigned char* pv,
                                             const float* su, const float* sv, const LAS int* etok, const LAS float* gtok) {
    const i32x4_t ev = *(const LAS i32x4_t*)(etok + bt * 4);
    const int es[4] = {__builtin_amdgcn_readfirstlane(ev.x), __builtin_amdgcn_readfirstlane(ev.y), __builtin_amdgcn_readfirstlane(ev.z), __builtin_amdgcn_readfirstlane(ev.w)};
#pragma unroll
    for (int k = 0; k < 2; ++k) {
        const unsigned e0 = (unsigned)es[2 * k] * (unsigned)TROW + (unsigned)lane * 12u, e1 = (unsigned)es[2 * k + 1] * (unsigned)TROW + (unsigned)lane * 12u;
        const u32x3 a = *(const u32x3*)(pu + e0), c = *(const u32x3*)(pu + e1);
        S.uq[k] = (v6u_t){a.x, a.y, a.z, c.x, c.y, c.z};
        const unsigned f0 = (unsigned)es[2 * k] * (unsigned)TROW4 + (unsigned)lane * 8u, f1 = (unsigned)es[2 * k + 1] * (unsigned)TROW4 + (unsigned)lane * 8u;
        S.vq[2 * k] = *(const u32x2*)(pv + f0); S.vq[2 * k + 1] = *(const u32x2*)(pv + f1);
    }
    { const int ej = etok[bt * 4 + kslot]; S.g = gtok[bt * 4 + kslot]; S.su = su[ej]; S.sv = sv[ej]; }
}
__device__ __forceinline__ void gather_consume(const GSet& S, const unsigned (&hp)[8], float (&acc)[16]) {
    typedef _Float16 h2v_t __attribute__((ext_vector_type(2)));
    float d[4];
#pragma unroll
    for (int k = 0; k < 2; ++k) {
        const v32h_t uf = __builtin_amdgcn_cvt_scalef32_pk32_f16_fp6(S.uq[k], 1.0f);
        float s0 = 0.f, s1 = 0.f;
#pragma unroll
        for (int i = 0; i < 8; ++i) { const h2v_t hh = __builtin_bit_cast(h2v_t, hp[i]);
            const h2v_t ua = {uf[2 * i], uf[2 * i + 1]}, ub = {uf[16 + 2 * i], uf[16 + 2 * i + 1]};
            s0 = __builtin_amdgcn_fdot2(ua, hh, s0, false); s1 = __builtin_amdgcn_fdot2(ub, hh, s1, false); }
        s0 = DPP_ADD(s0, 0xB1); s0 = DPP_ADD(s0, 0x4E); s0 = DPP_ADD(s0, 0x124); s0 = DPP_ADD(s0, 0x128);
        s1 = DPP_ADD(s1, 0xB1); s1 = DPP_ADD(s1, 0x4E); s1 = DPP_ADD(s1, 0x124); s1 = DPP_ADD(s1, 0x128);
        d[2 * k] = s0; d[2 * k + 1] = s1;
    }
    float e2[2], f1;
#pragma unroll
    for (int k = 0; k < 2; ++k) { auto r = __builtin_amdgcn_permlane16_swap(__float_as_uint(d[k]), __float_as_uint(d[k + 2]), false, false); e2[k] = __uint_as_float(r[0]) + __uint_as_float(r[1]); }
    { auto r = __builtin_amdgcn_permlane32_swap(__float_as_uint(e2[0]), __float_as_uint(e2[1]), false, false); f1 = __uint_as_float(r[0]) + __uint_as_float(r[1]); }
    const float cf = S.g * gelu_erf(f1 * S.su) * S.sv;
#pragma unroll
    for (int k = 0; k < 4; ++k) {
        const int r = ((k >> 1) & 1) | ((k & 1) << 1);
        const float c = __builtin_bit_cast(float, __builtin_amdgcn_readlane(__builtin_bit_cast(int, cf), 16 * r));
        const unsigned q0 = S.vq[k].x, q1 = S.vq[k].y;
        const f32x2_t a0 = __builtin_amdgcn_cvt_scalef32_pk_f32_fp4(q0, 1.0f, 0), a1 = __builtin_amdgcn_cvt_scalef32_pk_f32_fp4(q0, 1.0f, 1), a2 = __builtin_amdgcn_cvt_scalef32_pk_f32_fp4(q0, 1.0f, 2), a3 = __builtin_amdgcn_cvt_scalef32_pk_f32_fp4(q0, 1.0f, 3);
        const f32x2_t b0 = __builtin_amdgcn_cvt_scalef32_pk_f32_fp4(q1, 1.0f, 0), b1 = __builtin_amdgcn_cvt_scalef32_pk_f32_fp4(q1, 1.0f, 1), b2 = __builtin_amdgcn_cvt_scalef32_pk_f32_fp4(q1, 1.0f, 2), b3 = __builtin_amdgcn_cvt_scalef32_pk_f32_fp4(q1, 1.0f, 3);
        acc[0] += c * a0[0]; acc[1] += c * a0[1]; acc[2] += c * a1[0]; acc[3] += c * a1[1]; acc[4] += c * a2[0]; acc[5] += c * a2[1]; acc[6] += c * a3[0]; acc[7] += c * a3[1];
        acc[8] += c * b0[0]; acc[9] += c * b0[1]; acc[10] += c * b1[0]; acc[11] += c * b1[1]; acc[12] += c * b2[0]; acc[13] += c * b2[1]; acc[14] += c * b3[0]; acc[15] += c * b3[1];
    }
}
__device__ __forceinline__ void xcd_pace(unsigned* bar, volatile LAS unsigned* st);
constexpr int GT = 4;
constexpr int GNS = 8, GBPS = 32 / GNS, GSHIFT = 11;
constexpr int GATH_LDS_WAVE = GT * 128 * 8;
#define GATH_SEG(J, NJ, nbt) { \
        const LAS int* le_ = lse + (J) * 128; const LAS float* lg_ = lsg + (J) * 128; \
        _Pragma("unroll 1") for (int i_ = 0; i_ < GBPS / 2; ++i_) { \
            gather_issue(B, GBPS * c + 2 * i_ + 1, lane, kslot, pu, pv, su, sv, le_, lg_); \
            gather_consume(A, hx[J], acc[J]); \
            if (i_ < GBPS / 2 - 1) gather_issue(A, GBPS * c + 2 * i_ + 2, lane, kslot, pu, pv, su, sv, le_, lg_); \
            else gather_issue(A, (nbt), lane, kslot, pu, pv, su, sv, lse + (NJ) * 128, lsg + (NJ) * 128); \
            gather_consume(B, hx[J], acc[J]); } }
__device__ void ph_peer_gather(const bf16* h2, const unsigned char* pu, const unsigned char* pv, const float* su, const float* sv,
                               const int* eidx, const float* egate, const float* xin, const float* gate  , float* xout, LAS unsigned char* lds, unsigned* pace_bar, volatile LAS unsigned* pace_st, int bid, int nb) {
    const int lane0 = ltid() & 63, w = __builtin_amdgcn_readfirstlane(ltid() >> 6);
    LAS int* lse = (LAS int*)(lds + w * GATH_LDS_WAVE); LAS float* lsg = (LAS float*)(lds + w * GATH_LDS_WAVE + GT * 128 * 4);
    for (int t0 = (bid * 8 + w) * GT; t0 < MT; t0 += nb * 8 * GT) {
        int lane = lane0; asm volatile("" : "+v"(lane));
        const int row = lane >> 4;
        const int kslot = 2 * (row & 1) + (row >> 1);
        const int b = t0 >> 11;
        unsigned hx[GT][8]; float acc[GT][16];
#pragma unroll
        for (int j = 0; j < GT; ++j) {
            const int t = t0 + j;
            const int e0 = eidx[(size_t)t * 128 + lane], e1 = eidx[(size_t)t * 128 + 64 + lane];
            const float g0 = egate[(size_t)t * 128 + lane], g1 = egate[(size_t)t * 128 + 64 + lane];
            const int k0 = e0 >> GSHIFT, k1 = e1 >> GSHIFT;
            int off = 0, d0 = 0, d1 = 0;
#pragma unroll
            for (int s = 0; s < GNS; ++s) {
                const unsigned long long m0 = __ballot(k0 == s), m1 = __ballot(k1 == s);
                const int r0 = (int)__builtin_amdgcn_mbcnt_hi((unsigned)(m0 >> 32), __builtin_amdgcn_mbcnt_lo((unsigned)m0, 0u));
                const int r1 = (int)__builtin_amdgcn_mbcnt_hi((unsigned)(m1 >> 32), __builtin_amdgcn_mbcnt_lo((unsigned)m1, 0u));
                const int c0 = __builtin_popcountll(m0);
                if (k0 == s) d0 = off + r0;
                if (k1 == s) d1 = off + c0 + r1;
                off += c0 + __builtin_popcountll(m1);
            }
            lse[j * 128 + d0] = e0; lsg[j * 128 + d0] = g0; lse[j * 128 + d1] = e1; lsg[j * 128 + d1] = g1;
            const u32x4 u0 = *(const u32x4*)(h2 + (size_t)t * DM + lane * 16), u1 = *(const u32x4*)(h2 + (size_t)t * DM + lane * 16 + 8);
#pragma unroll
            for (int i = 0; i < 4; ++i) {
                hx[j][i] = __builtin_bit_cast(unsigned, __builtin_amdgcn_cvt_pkrtz(__uint_as_float(u0[i] << 16), __uint_as_float(u0[i] & 0xffff0000u)));
                hx[j][4 + i] = __builtin_bit_cast(unsigned, __builtin_amdgcn_cvt_pkrtz(__uint_as_float(u1[i] << 16), __uint_as_float(u1[i] & 0xffff0000u)));
            }
#pragma unroll
            for (int i = 0; i < 16; ++i) acc[j][i] = 0.f;
        }
        GSet A, B;
        gather_issue(A, 0, lane, kslot, pu, pv, su, sv, lse, lsg);
#pragma unroll 1
        for (int c = 0; c < GNS; ++c) {
            if (c == 0) xcd_pace(pace_bar, pace_st);
            GATH_SEG(0, 1, GBPS * c)
            GATH_SEG(1, 2, GBPS * c)
            GATH_SEG(2, 3, GBPS * c)
            GATH_SEG(3, 0, c < GNS - 1 ? GBPS * c + GBPS : 0)
        }
#pragma unroll
        for (int j = 0; j < GT; ++j) {
            const int t = t0 + j;
#pragma unroll
            for (int i = 0; i < 4; ++i) {
                const int cc = lane * 16 + i * 4;
                const f32x4 xi = *(const f32x4*)(xin + (size_t)t * DM + cc), gt = *(const f32x4*)(gate + (size_t)b * 6144 + cc);
                f32x4 o;
#pragma unroll
                for (int e = 0; e < 4; ++e) o[e] = xi[e] + gt[e] * acc[j][i * 4 + e];
                *(f32x4*)(xout + (size_t)t * DM + cc) = o;
            }
        }
    }
}

#define XB_TMO      128
#define XB_XCNT(j)  (256  + 64 * (j))
#define XB_XSUB(j)  (1280 + 64 * (j))
#define XB_XGEN(j)  (2304 + 64 * (j))
#define XB_TOP      3328
#define XB_TOPGEN   3392
#define XCD_BAR_WORDS 3456
#define XB_SPIN_CAP (1u << 18)

__device__ __forceinline__ unsigned xb_ld(unsigned* p)              { return __hip_atomic_load(p, __ATOMIC_RELAXED, __HIP_MEMORY_SCOPE_AGENT); }
__device__ __forceinline__ unsigned xb_add(unsigned* p, unsigned v) { return __hip_atomic_fetch_add(p, v, __ATOMIC_RELAXED, __HIP_MEMORY_SCOPE_AGENT); }
__device__ __forceinline__ unsigned xb_xcc_id() { return (unsigned)__builtin_amdgcn_s_getreg((3 << 11) | 20) & 0xFu; }
#define XB_SPIN(cond, bar) do { unsigned _sp = 0; while (cond) { __builtin_amdgcn_s_sleep(1); \
    if ((++_sp & 255u) == 0u) { if (xb_ld(&(bar)[XB_TMO])) break; if (_sp > XB_SPIN_CAP) { atomicAdd(&(bar)[XB_TMO], 1u); break; } } } } while (0)

struct XcdBarrier {
    unsigned* bar; unsigned x;
    volatile LAS unsigned* st;
};

__device__ __forceinline__ XcdBarrier xcd_barrier_post(unsigned* bar, volatile LAS unsigned* st) {
    XcdBarrier b; b.bar = bar; b.x = xb_xcc_id(); b.st = st;
    if (threadIdx.x == 0) (void)xb_add(&bar[XB_XCNT(b.x)], 1u);
    return b;
}
__device__ __forceinline__ void xcd_barrier_complete(unsigned* bar, unsigned x, unsigned& nloc, unsigned& nx) {
    const unsigned G = gridDim.x * gridDim.y * gridDim.z;
    unsigned sum, cnt, mine, sp = 0u;
    for (;;) {
        sum = 0u; cnt = 0u; mine = 0u;
#pragma unroll
        for (unsigned j = 0; j < 16; ++j) { const unsigned c = xb_ld(&bar[XB_XCNT(j)]); sum += c; cnt += (c > 0u) ? 1u : 0u; mine = (j == x) ? c : mine; }
        if (sum == G) break;
        __builtin_amdgcn_s_sleep(1);
        if ((++sp & 255u) == 0u) { if (xb_ld(&bar[XB_TMO])) break; if (sp > XB_SPIN_CAP) { atomicAdd(&bar[XB_TMO], 1u); break; } }
    }
    nloc = mine > 0u ? mine : 1u; nx = cnt > 0u ? cnt : 1u;
}

__device__ __forceinline__ void xcd_barrier(const XcdBarrier& b) {
    asm volatile("s_waitcnt vmcnt(0)" ::: "memory");
    __syncthreads();
    if (threadIdx.x == 0) {
        unsigned* bar = b.bar;
        __builtin_amdgcn_s_waitcnt(0);
        unsigned nloc = b.st[0], nx = b.st[1];
        if (nloc == 0u) { xcd_barrier_complete(bar, b.x, nloc, nx); b.st[0] = nloc; b.st[1] = nx; }
        const unsigned old = xb_add(&bar[XB_XSUB(b.x)], 1u);
        const unsigned gen = old / nloc;
        if (old + 1u == (gen + 1u) * nloc) {
            __builtin_amdgcn_fence(__ATOMIC_RELEASE, "agent");
            asm volatile("s_waitcnt vmcnt(0)" ::: "memory");
            const unsigned og = xb_add(&bar[XB_TOP], 1u);
            const unsigned tg = og / nx;
            if (og + 1u == (tg + 1u) * nx) xb_add(&bar[XB_TOPGEN], 1u);
            else XB_SPIN(xb_ld(&bar[XB_TOPGEN]) == tg, bar);
            __builtin_amdgcn_fence(__ATOMIC_ACQUIRE, "agent");
            xb_add(&bar[XB_XGEN(b.x)], 1u);
            asm volatile("s_waitcnt vmcnt(0)" ::: "memory");
        } else {
            XB_SPIN(xb_ld(&bar[XB_XGEN(b.x)]) == gen, bar);
            __builtin_amdgcn_fence(__ATOMIC_ACQUIRE, "agent");
            asm volatile("s_waitcnt vmcnt(0)" ::: "memory");
        }
    }
    __syncthreads();
}


#define XB_PACE(j) (3584 + 64 * (j))
__device__ __forceinline__ void xcd_pace(unsigned* bar, volatile LAS unsigned* st) {
    __syncthreads();
    if (threadIdx.x == 0) {
        const unsigned nloc = st[0] ? st[0] : 1u, x = xb_xcc_id(), gen = st[4] + 1u;
        st[4] = gen;
        xb_add(&bar[XB_PACE(x)], 1u);
        unsigned sp = 0;
        while (xb_ld(&bar[XB_PACE(x)]) < gen * nloc) { __builtin_amdgcn_s_sleep(1); if (++sp > (1u << 16)) break; }
    }
    __syncthreads();
}
extern __shared__ __attribute__((aligned(16))) unsigned char dyn_lds[];
#ifndef REP_PREP
#define REP_PREP 1
#endif
#ifndef REP_ATTN
#define REP_ATTN 1
#endif
#ifndef REP_SEL
#define REP_SEL 1
#endif
#ifndef REP_GATH
#define REP_GATH 1
#endif
#ifndef REP_GEMM
#define REP_GEMM 1
#endif
#ifndef REP_ADALN
#define REP_ADALN 1
#endif
constexpr int LDS_BYTES = 147456;

template <class T> __device__ __forceinline__ T* karg(int byte_off) {
    const __attribute__((address_space(4))) char* base = (const __attribute__((address_space(4))) char*)__builtin_amdgcn_kernarg_segment_ptr();
    unsigned long long v = *(const __attribute__((address_space(4))) unsigned long long*)(base + byte_off);
    asm volatile("" : "+s"(v));
    return (T*)(__attribute__((address_space(1))) T*)v;
}
#define KIN(i) karg<const float>(8 * (i))
#define KOUT() karg<float>(168)
#define KWS() karg<unsigned char>(176)
static_assert(sizeof(Params) == 184, "Params layout");
template <class T> __device__ __forceinline__ T* launder(T* p) { size_t off = 0; asm volatile("" : "+s"(off)); return (T*)((unsigned char*)p + off); }
__global__ void __launch_bounds__(NT) mega_fwd(Params p) {
    cg::grid_group grid = cg::this_grid();
    const int bid = blockIdx.x, nb = gridDim.x;
    volatile LAS unsigned* bst = (volatile LAS unsigned*)((LAS unsigned char*)dyn_lds + LDS_BYTES - 64);
    if (ltid() < 16) bst[ltid()] = 0u;
    __syncthreads();
    const XcdBarrier xbar = xcd_barrier_post((unsigned*)(KWS() + WS_BAR), bst);
    for (int rep = 0; rep < REP_PREP; ++rep) {
        unsigned char* ws = KWS();
        float* tile = (float*)dyn_lds;
        ph_transpose(KIN(6), (bf16*)(ws + WS_WIN0), 1024, AB_IN, true, tile, bid, nb);
        ph_transpose(KIN(11), (bf16*)(ws + WS_WIN1), 1024, CD_IN, true, tile, bid, nb);
        ph_transpose(KIN(7), (bf16*)(ws + WS_WO0), 1024, 1024, false, tile, bid, nb);
        ph_transpose(KIN(12), (bf16*)(ws + WS_WO1), 1024, 1024, false, tile, bid, nb);
        ph_transpose(KIN(17), (bf16*)(ws + WS_WQ), 1024, PQ, false, tile, bid, nb);
        ph_transpose(KIN(17) + (size_t)1024 * PQ, (bf16*)(ws + WS_WQ) + (size_t)PQ * 1024, 1024, PQ, false, tile, bid, nb);
        ws = launder(ws);
        ph_tab_fp6(KIN(19), ws + WS_PU, (float*)(ws + WS_PV), 2 * NEXP, bid, nb);
        ph_tab_fp4(KIN(20), ws + WS_PU + 32 * MiB, (float*)(ws + WS_PV + 1 * MiB), 2 * NEXP, bid, nb);
        ws = launder(ws);
        ph_mod(KIN(1), KIN(2), KIN(3), (float*)(ws + WS_MOD), (float*)dyn_lds, bid, nb);
        ph_rope_table((float*)(ws + WS_ROPE), bid, nb);
        for (int i = bid * NT + ltid(); i < NB * 8 * 8 * 64; i += nb * NT) ((float*)(ws + WS_KMEAN))[i] = 0.f;
    }
    grid.sync();
#pragma unroll 1
    for (int layer = 0; layer < 2; ++layer) {
        for (int rep = 0; rep < REP_ADALN; ++rep) {
            unsigned char* ws = KWS(); const float* mod = (const float*)(ws + WS_MOD) + (size_t)layer * 32 * 6144;
            ph_adaln(layer == 0 ? KIN(0) : KOUT(), KIN(4) + layer * DM, mod + 0, mod + 1024, (bf16*)(ws + WS_HY), bid, nb);
        }
        xcd_barrier(xbar);
        for (int rep = 0; rep < REP_GEMM; ++rep) {
            unsigned char* ws = KWS();
            pg8::Gemm g{(const bf16*)(ws + WS_HY), (const bf16*)(ws + (layer == 0 ? WS_WIN0 : WS_WIN1)), MT, layer == 0 ? AB_IN : CD_IN, DM};
            pg8::StaticOrder S; S.init(g.M, g.N, nb, bid);
            pg8::EpiQKV e{(bf16*)(ws + WS_QKV), QKV_LD, (const float*)(ws + WS_ROPE), layer, layer == 0 ? KIN(9) : KIN(13), layer == 0 ? KIN(10) : KIN(14), KIN(15), KIN(16), (float*)(ws + WS_KMEAN)};
            pg8::gemm_phase<pg8::EpiQKV, pg8::StaticOrder, true, true>((LAS unsigned char*)dyn_lds, g, S, e);
        }
        xcd_barrier(xbar);
        for (int rep = 0; rep < REP_ATTN; ++rep) {
            unsigned char* ws = KWS();
            if (layer == 0) ph_attn0((const bf16*)(ws + WS_QKV), KIN(8), (bf16*)(ws + WS_HY), (LAS unsigned char*)dyn_lds, bid, nb);
            else ph_attn1((const bf16*)(ws + WS_QKV), (const float*)(ws + WS_KMEAN), (bf16*)(ws + WS_HY), (LAS unsigned char*)dyn_lds, bid, nb);
        }
        xcd_barrier(xbar);
        for (int rep = 0; rep < REP_GEMM; ++rep) {
            unsigned char* ws = KWS(); const float* mod = (const float*)(ws + WS_MOD) + (size_t)layer * 32 * 6144;
            pg8::Gemm g{(const bf16*)(ws + WS_HY), (const bf16*)(ws + (layer == 0 ? WS_WO0 : WS_WO1)), MT, DM, DM};
            pg8::StaticOrder S; S.init(g.M, g.N, nb, bid); pg8::EpiResid e{layer == 0 ? KIN(0) : KOUT(), (float*)(ws + WS_X1), mod + 2048};
            pg8::gemm_phase<pg8::EpiResid, pg8::StaticOrder, true, true>((LAS unsigned char*)dyn_lds, g, S, e);
        }
        xcd_barrier(xbar);
        for (int rep = 0; rep < REP_ADALN; ++rep) {
            unsigned char* ws = KWS(); const float* mod = (const float*)(ws + WS_MOD) + (size_t)layer * 32 * 6144;
            ph_adaln((const float*)(ws + WS_X1), KIN(5) + layer * DM, mod + 3072, mod + 4096, (bf16*)(ws + WS_QKV), bid, nb);
        }
        xcd_barrier(xbar);
        for (int rep = 0; rep < REP_GEMM; ++rep) {
            unsigned char* ws = KWS();
            pg8::Gemm g{(const bf16*)(ws + WS_QKV), (const bf16*)(ws + WS_WQ) + (size_t)layer * PQ * DM, MT, PQ, DM};
            pg8::StaticOrder S; S.init(g.M, g.N, nb, bid); pg8::EpiStore e{(bf16*)(ws + WS_QKV + 128 * MiB), PQ};
            pg8::gemm_phase<pg8::EpiStore, pg8::StaticOrder, true, true>((LAS unsigned char*)dyn_lds, g, S, e);
        }
        xcd_barrier(xbar);
        for (int rep = 0; rep < REP_SEL; ++rep) {
            unsigned char* ws = KWS();
            ph_peer_select((const bf16*)(ws + WS_QKV + 128 * MiB), KIN(18) + (size_t)layer * 2 * 128 * 128, (int*)(ws + WS_HY), (float*)(ws + WS_HY + 32 * MiB), (LAS unsigned char*)dyn_lds, bid, nb);
        }
        xcd_barrier(xbar);
        for (int rep = 0; rep < REP_GATH; ++rep) {
            unsigned char* ws = KWS(); const float* mod = (const float*)(ws + WS_MOD) + (size_t)layer * 32 * 6144;
            ph_peer_gather((const bf16*)(ws + WS_QKV), ws + WS_PU + (size_t)layer * NEXP * TROW, ws + WS_PU + 32 * MiB + (size_t)layer * NEXP * TROW4,
                           (const float*)(ws + WS_PV) + layer * NEXP, (const float*)(ws + WS_PV + 1 * MiB) + layer * NEXP, (const int*)(ws + WS_HY), (const float*)(ws + WS_HY + 32 * MiB), (const float*)(ws + WS_X1), mod + 5120, KOUT(), (LAS unsigned char*)dyn_lds, (unsigned*)(ws + WS_BAR), bst, bid, nb);
        }
        if (layer == 0) xcd_barrier(xbar);
    }
}

extern "C" void kernel_launch(void* const* d_in, const int* in_sizes, int n_in, void* d_out, int out_size, void* d_ws, size_t ws_size, hipStream_t stream) {
    if (n_in != 21 || ws_size < WS_END) { fprintf(stderr, "kernel_launch: bad args n_in=%d ws=%zu\n", n_in, ws_size); return; }
    static int grid_blocks = 0;
    if (!grid_blocks) {
        int dev = 0, cus = 0, per_cu = 0;
        (void)hipGetDevice(&dev);
        (void)hipDeviceGetAttribute(&cus, hipDeviceAttributeMultiprocessorCount, dev);
        (void)hipFuncSetAttribute((const void*)mega_fwd, hipFuncAttributeMaxDynamicSharedMemorySize, LDS_BYTES);
        (void)hipOccupancyMaxActiveBlocksPerMultiprocessor(&per_cu, (const void*)mega_fwd, NT, LDS_BYTES);
        if (per_cu < 1) { fprintf(stderr, "kernel_launch: occupancy query returned %d\n", per_cu); per_cu = 1; }
        if (per_cu > 1) per_cu = 1;
        grid_blocks = cus * per_cu;
    }
    Params p{};
    for (int i = 0; i < 21; ++i) p.in[i] = (const float*)d_in[i];
    p.out = (float*)d_out; p.ws = (unsigned char*)d_ws;
    (void)hipMemsetAsync((char*)d_ws + WS_BAR, 0, 16384, stream);
    void* args[] = {&p};
    hipError_t e = hipLaunchCooperativeKernel((const void*)mega_fwd, dim3(grid_blocks), dim3(NT), args, LDS_BYTES, stream);
    if (e != hipSuccess) fprintf(stderr, "cooperative launch failed: %s (grid %d)\n", hipGetErrorString(e), grid_blocks);
}
```

```cpp
#include <hip/hip_runtime.h>
#ifndef REP_A
#define REP_A 1
#endif
#ifndef REP_B
#define REP_B 1
#endif
#ifndef REP_C
#define REP_C 1
#endif
#ifndef REP_D
#define REP_D 1
#endif
#include <hip/hip_cooperative_groups.h>
namespace cg = cooperative_groups;
#include <cstdio>
#include <cstdint>
#include <cmath>

typedef unsigned short bf16;
typedef short bf16x8 __attribute__((ext_vector_type(8)));
typedef float f32x4 __attribute__((ext_vector_type(4)));
typedef unsigned u32x4 __attribute__((ext_vector_type(4)));
typedef unsigned u32x2 __attribute__((ext_vector_type(2)));

constexpr int DM = 1024, NB = 32, SQ = 2048, MT = NB * SQ;
constexpr int HD = 64;
constexpr int AB_IN = 2304, CD_IN = 3072, QKV_LD = 3072;
constexpr int NEXP = 16384, PQ = 2048;
constexpr float EPS = 1e-6f;
constexpr int NT = 512;

constexpr size_t MiB = 1u << 20;
constexpr size_t WS_X1 = 0;
constexpr size_t WS_QKV = 256 * MiB;
constexpr size_t WS_HY = 640 * MiB;
constexpr size_t WS_PU = 768 * MiB;
constexpr size_t WS_PV = 832 * MiB;
constexpr size_t WS_WIN0 = 896 * MiB;
constexpr size_t WS_WIN1 = 901 * MiB;
constexpr size_t WS_WO0 = 907 * MiB;
constexpr size_t WS_WO1 = 909 * MiB;
constexpr size_t WS_WQ = 911 * MiB;
constexpr size_t WS_MOD = 919 * MiB;
constexpr size_t WS_ROPE = 921 * MiB;
constexpr size_t WS_KMEAN = 922 * MiB;
constexpr size_t WS_BAR = 923 * MiB;
constexpr size_t WS_END = 924 * MiB;

struct Params {
    const float* in[21];
    float* out;
    unsigned char* ws;
};

__device__ __forceinline__ int ltid() { int t = (int)__builtin_amdgcn_workitem_id_x(); asm volatile("" : "+v"(t)); return t; }
__device__ __forceinline__ float bf2f(unsigned b) { return __uint_as_float(b << 16); }
__device__ __forceinline__ unsigned f2bf(float f) { unsigned u = __float_as_uint(f); return (u + 0x7fffu + ((u >> 16) & 1u)) >> 16; }
__device__ __forceinline__ unsigned pk2(float lo, float hi) { return f2bf(lo) | (f2bf(hi) << 16); }
#define DPPV(v, ctrl) __builtin_bit_cast(float, __builtin_amdgcn_update_dpp(0, __builtin_bit_cast(int, (v)), (ctrl), 0xf, 0xf, true))
__device__ __forceinline__ float row16_sum(float v) { v += DPPV(v, 0xB1); v += DPPV(v, 0x4E); v += DPPV(v, 0x124); v += DPPV(v, 0x128); return v; }
__device__ __forceinline__ float rows_sum(float v) {
    { auto r = __builtin_amdgcn_permlane16_swap(__float_as_uint(v), __float_as_uint(v), false, false); v = __uint_as_float(r[0]) + __uint_as_float(r[1]); }
    { auto r = __builtin_amdgcn_permlane32_swap(__float_as_uint(v), __float_as_uint(v), false, false); v = __uint_as_float(r[0]) + __uint_as_float(r[1]); }
    return v;
}
__device__ __forceinline__ float wave_sum(float v) { return rows_sum(row16_sum(v)); }
__device__ __forceinline__ float wave_max(float v) {
    v = fmaxf(v, DPPV(v, 0xB1)); v = fmaxf(v, DPPV(v, 0x4E)); v = fmaxf(v, DPPV(v, 0x124)); v = fmaxf(v, DPPV(v, 0x128));
    { auto r = __builtin_amdgcn_permlane16_swap(__float_as_uint(v), __float_as_uint(v), false, false); v = fmaxf(__uint_as_float(r[0]), __uint_as_float(r[1])); }
    { auto r = __builtin_amdgcn_permlane32_swap(__float_as_uint(v), __float_as_uint(v), false, false); v = fmaxf(__uint_as_float(r[0]), __uint_as_float(r[1])); }
    return v;
}
__device__ __forceinline__ float gelu_erf(float x) {
    const float z = x * 0.70710678118654752f, az = fabsf(z);
    const float t = __builtin_amdgcn_rcpf(fmaf(0.3275911f, az, 1.0f));
    float pl = fmaf(t, 1.061405429f, -1.453152027f); pl = fmaf(t, pl, 1.421413741f); pl = fmaf(t, pl, -0.284496736f); pl = fmaf(t, pl, 0.254829592f); pl *= t;
    const float ex = __builtin_amdgcn_exp2f(az * (az * -1.4426950408889634f));
    const float er = copysignf(fmaf(-pl, ex, 1.0f), z);
    const float hx = 0.5f * x;
    return fmaf(hx, er, hx);
}

__device__ __forceinline__ int qkv_logical_col(int p) { return (p & ~255) | (((p >> 5) & 3) << 6) | (((p >> 7) & 1) << 5) | (p & 31); }
__device__ void ph_transpose(const float* W, bf16* Wt, int K, int N, bool permute, float* tile  , int bid, int nb) {
    const int tid = ltid();
    const int nkt = K / 64, nnt = N / 64;
    for (int it = bid; it < nkt * nnt; it += nb) {
        const int k0 = (it / nnt) * 64, n0 = (it % nnt) * 64;
        __syncthreads();
        for (int e = tid; e < 64 * 64; e += NT) { const int r = e >> 6, c = e & 63; const int nl = permute ? qkv_logical_col(n0 + c) : n0 + c; tile[r * 65 + c] = W[(size_t)(k0 + r) * N + nl]; }
        __syncthreads();
        {
            const int n = tid >> 3, k8 = (tid & 7) * 8;
            u32x4 v;
            v.x = pk2(tile[(k8 + 0) * 65 + n], tile[(k8 + 1) * 65 + n]);
            v.y = pk2(tile[(k8 + 2) * 65 + n], tile[(k8 + 3) * 65 + n]);
            v.z = pk2(tile[(k8 + 4) * 65 + n], tile[(k8 + 5) * 65 + n]);
            v.w = pk2(tile[(k8 + 6) * 65 + n], tile[(k8 + 7) * 65 + n]);
            *(u32x4*)(Wt + (size_t)(n0 + n) * K + k0 + k8) = v;
        }
    }
}
__device__ void ph_convert(const float* src, bf16* dst, size_t n, int bid, int nb) {
    const size_t n8 = n / 8;
    for (size_t i = (size_t)bid * NT + ltid(); i < n8; i += (size_t)nb * NT) {
        const f32x4 a = *(const f32x4*)(src + i * 8), b = *(const f32x4*)(src + i * 8 + 4);
        u32x4 v; v.x = pk2(a[0], a[1]); v.y = pk2(a[2], a[3]); v.z = pk2(b[0], b[1]); v.w = pk2(b[2], b[3]);
        *(u32x4*)(dst + i * 8) = v;
    }
}
__device__ void ph_mod(const float* c, const float* ada_w, const float* ada_b, float* mod, float* lds  , int bid, int nb) {
    const int tid = ltid(), lane = tid & 63, w = tid >> 6;
    for (int it = bid; it < 2 * 96; it += nb) {
        const int l = it / 96, j = (it % 96) * 64 + lane;
        float acc[32];
#pragma unroll
        for (int b = 0; b < 32; ++b) acc[b] = 0.f;
        for (int kh = 0; kh < 2; ++kh) {
            __syncthreads();
            for (int e = tid; e < 32 * 512; e += NT) { const int b = e >> 9, k = e & 511; const float cv = c[b * 1024 + kh * 512 + k]; lds[e] = cv / (1.0f + __expf(-cv)); }
            __syncthreads();
            for (int kk = 0; kk < 64; ++kk) {
                const int k = w * 64 + kk;
                const float wv = ada_w[((size_t)l * 1024 + kh * 512 + k) * 6144 + j];
#pragma unroll
                for (int b = 0; b < 32; ++b) acc[b] += lds[b * 512 + k] * wv;
            }
        }
        __syncthreads();
#pragma unroll
        for (int b = 0; b < 32; ++b) lds[(w * 32 + b) * 64 + lane] = acc[b];
        __syncthreads();
        for (int e = tid; e < 32 * 64; e += NT) {
            const int b = e >> 6, jj = e & 63; float s = 0.f;
#pragma unroll
            for (int ww = 0; ww < 8; ++ww) s += lds[(ww * 32 + b) * 64 + jj];
            const int jo = (it % 96) * 64 + jj;
            mod[((size_t)l * 32 + b) * 6144 + jo] = s + ada_b[l * 6144 + jo];
        }
    }
}
__device__ void ph_rope_table(float* rope, int bid, int nb) {
    for (int i = bid * NT + ltid(); i < SQ * 32; i += nb * NT) {
        const int t = i >> 5, f = i & 31;
        const float inv = powf(10000.0f, -(float)f / 32.0f);
        const float ang = (float)t * inv;
        float s, c; sincosf(ang, &s, &c);
        rope[i * 2] = c; rope[i * 2 + 1] = s;
    }
}

#define DPP_ADD0(v, ctrl) ((v) + __builtin_bit_cast(float, __builtin_amdgcn_update_dpp(0, __builtin_bit_cast(int, (v)), (ctrl), 0xf, 0xf, true)))
__device__ void ph_adaln(const float* x, const float* g, const float* mod_shift  , const float* mod_scale, bf16* h, int bid, int nb) {
    const int lane = ltid() & 63, w = __builtin_amdgcn_readfirstlane(ltid() >> 6);
    for (int t0 = (bid * 8 + w) * 4; t0 < MT; t0 += nb * 8 * 4) {
        const int b = t0 >> 11;
        f32x4 v[4][4]; float ss[4];
#pragma unroll
        for (int r = 0; r < 4; ++r) {
            const float* xr = x + (size_t)(t0 + r) * DM;
#pragma unroll
            for (int i = 0; i < 4; ++i) v[r][i] = *(const f32x4*)(xr + i * 256 + lane * 4);
        }
#pragma unroll
        for (int r = 0; r < 4; ++r) {
            float s = 0.f;
#pragma unroll
            for (int i = 0; i < 4; ++i) s += v[r][i][0] * v[r][i][0] + v[r][i][1] * v[r][i][1] + v[r][i][2] * v[r][i][2] + v[r][i][3] * v[r][i][3];
            s = DPP_ADD0(s, 0xB1); s = DPP_ADD0(s, 0x4E); s = DPP_ADD0(s, 0x124); s = DPP_ADD0(s, 0x128);
            { auto q = __builtin_amdgcn_permlane16_swap(__float_as_uint(s), __float_as_uint(s), false, false); s = __uint_as_float(q[0]) + __uint_as_float(q[1]); }
            { auto q = __builtin_amdgcn_permlane32_swap(__float_as_uint(s), __float_as_uint(s), false, false); s = __uint_as_float(q[0]) + __uint_as_float(q[1]); }
            ss[r] = rsqrtf(s * (1.0f / DM) + EPS);
        }
#pragma unroll
        for (int i = 0; i < 4; ++i) {
            const int c = i * 256 + lane * 4;
            const f32x4 gg = *(const f32x4*)(g + c), sc = *(const f32x4*)(mod_scale + (size_t)b * 6144 + c), sh = *(const f32x4*)(mod_shift + (size_t)b * 6144 + c);
            float a[4];
#pragma unroll
            for (int e = 0; e < 4; ++e) a[e] = gg[e] * (1.0f + sc[e]);
#pragma unroll
            for (int r = 0; r < 4; ++r) {
                float y[4];
#pragma unroll
                for (int e = 0; e < 4; ++e) y[e] = v[r][i][e] * ss[r] * a[e] + sh[e];
                u32x2 o; o.x = pk2(y[0], y[1]); o.y = pk2(y[2], y[3]);
                *(u32x2*)(h + (size_t)(t0 + r) * DM + c) = o;
            }
        }
    }
}

namespace pg8 {
#define PG8_LAS __attribute__((address_space(3)))
typedef unsigned short bf16_t;
typedef short bf16x8 __attribute__((ext_vector_type(8)));
constexpr int BM = 256, BK = 64, HALF = 128, HTB = HALF * BK * 2  , STAGE_BYTES = 8 * HTB, NXCD = 8, WGM = 8;

__host__ __device__ __forceinline__ int lds_byte(int r, int c) { const int st = (r >> 4) * 2 + (c >> 5), rr = r & 15, cc = c & 31, ob = rr * 64 + cc * 2; return st * 1024 + (ob ^ (((ob >> 9) & 1) << 5)); }
__host__ __device__ __forceinline__ void stage_rc(int b, int& R, int& C) { const int st = b / 1024, sb = b % 1024, swz = sb ^ (((sb >> 9) & 1) << 5); R = (st >> 1) * 16 + swz / 64; C = (st & 1) * 32 + (swz % 64) / 2; }
__host__ __device__ __forceinline__ int perm32(int rho) { const int n = rho >> 4, i = rho & 15; return 8 * (i >> 2) + 4 * n + (i & 3); }

struct Unit { int pm, pn; };
struct Gemm { const bf16_t* A; const bf16_t* Bt; int M, N, K; };

struct StaticOrder {
    int nM, nN, nwg, G, c;
    __host__ __device__ void init(int M, int N, int G_, int c_) { nM = M / BM; nN = N / BM; nwg = nM * nN; G = G_; c = c_; }
    __host__ __device__ bool next(int i, Unit& u) const {
        const long L = (long)i * G + c; if (L >= nwg) return false;
        int wgid = (int)L; { const int q = nwg / NXCD, r = nwg % NXCD, xcd = wgid % NXCD, off = wgid / NXCD; wgid = (xcd < r ? xcd * (q + 1) : r * (q + 1) + (xcd - r) * q) + off; }
        const int nig = WGM * nN, gid = wgid / nig, fm = gid * WGM, gsz = (nM - fm) < WGM ? (nM - fm) : WGM;
        u.pm = fm + ((wgid % nig) % gsz); u.pn = (wgid % nig) / gsz; return true;
    }
    __device__ __forceinline__ void a_ready(const Unit&) const {}
    __device__ __forceinline__ void done(const Unit&) const {}
};

__device__ __forceinline__ unsigned cvt_pk_bf16(float lo, float hi) { unsigned r; asm volatile("v_cvt_pk_bf16_f32 %0, %1, %2" : "=v"(r) : "v"(lo), "v"(hi)); return r; }

struct EpiStore {
    static constexpr bool PERM = true, AFTER_DRAIN = false;
    bf16_t* O; int ldc;
    __device__ __forceinline__ void operator()(const f32x4 (&acc)[2][2][4][2], const Unit& u, int wr, int wc, int fr_, int fq_) const {
        int fr = fr_, fq = fq_; asm volatile("" : "+v"(fr), "+v"(fq));
        const int row0 = u.pm * BM + wr * 64 + fr, col0 = u.pn * BM + wc * 32 + 8 * fq;
#pragma unroll
        for (int ai = 0; ai < 2; ++ai)
#pragma unroll
            for (int m = 0; m < 4; ++m) { bf16_t* rowp = O + (size_t)(row0 + ai * HALF + m * 16) * ldc + col0;
#pragma unroll
                for (int bj = 0; bj < 2; ++bj) { const f32x4 v0 = acc[ai][bj][m][0], v1 = acc[ai][bj][m][1];
                    u32x4 w; w.x = cvt_pk_bf16(v0[0], v0[1]); w.y = cvt_pk_bf16(v0[2], v0[3]); w.z = cvt_pk_bf16(v1[0], v1[1]); w.w = cvt_pk_bf16(v1[2], v1[3]);
                    *(u32x4*)(rowp + bj * HALF) = w; } }
    }
};
struct EpiQKV {
    static constexpr bool PERM = true, AFTER_DRAIN = false;
    bf16_t* O; int ldc; const float* rope; int layer;
    const float* gq0; const float* gk0;
    const float* gq1; const float* gk1;
    float* kmean;
    __device__ __forceinline__ void operator()(const f32x4 (&acc)[2][2][4][2], const Unit& u, int wr, int wc, int fr_, int fq_) const {
        int fr = fr_, fq = fq_; asm volatile("" : "+v"(fr), "+v"(fq));
        const int hg = 4 * u.pn + wc;
        const float* gain = nullptr; bool km = false;
        if (layer == 0) { if (hg < 8) gain = gq0; else if (hg < 10) gain = gk0; }
        else { if (hg < 8) gain = gq0; else if (hg < 16) gain = gk0; else if (hg >= 24 && hg < 32) gain = gq1; else if (hg >= 32 && hg < 40) { gain = gk1; km = true; } }
        const int row0 = u.pm * BM + wr * 64 + fr, col0 = 64 * hg + 8 * fq;
        float g0[8], g1[8], cs0[8], cs1[8];
#pragma unroll
        for (int e = 0; e < 8; ++e) { g0[e] = gain ? gain[8 * fq + e] : 1.f; g1[e] = gain ? gain[32 + 8 * fq + e] : 1.f; cs0[e] = 0.f; cs1[e] = 0.f; }
#pragma unroll
        for (int ai = 0; ai < 2; ++ai)
#pragma unroll
            for (int m = 0; m < 4; ++m) {
                const int row = row0 + ai * HALF + m * 16;
                float v0[8], v1[8];
#pragma unroll
                for (int e = 0; e < 4; ++e) { v0[e] = acc[ai][0][m][0][e]; v0[4 + e] = acc[ai][0][m][1][e]; v1[e] = acc[ai][1][m][0][e]; v1[4 + e] = acc[ai][1][m][1][e]; }
                if (gain) {
                    float ss = 0.f;
#pragma unroll
                    for (int e = 0; e < 8; ++e) ss += v0[e] * v0[e] + v1[e] * v1[e];
                    ss = rows_sum(ss);
                    const float r = rsqrtf(ss * (1.0f / 64.0f) + 1e-6f);
                    const float* rp = rope + ((size_t)(row & 2047) * 32 + 8 * fq) * 2;
                    const f32x4 t0 = *(const f32x4*)(rp), t1 = *(const f32x4*)(rp + 4), t2 = *(const f32x4*)(rp + 8), t3 = *(const f32x4*)(rp + 12);
                    const float cs[8] = {t0[0], t0[2], t1[0], t1[2], t2[0], t2[2], t3[0], t3[2]}, sn[8] = {t0[1], t0[3], t1[1], t1[3], t2[1], t2[3], t3[1], t3[3]};
#pragma unroll
                    for (int e = 0; e < 8; ++e) { const float y0 = v0[e] * r * g0[e], y1 = v1[e] * r * g1[e]; v0[e] = y0 * cs[e] - y1 * sn[e]; v1[e] = y1 * cs[e] + y0 * sn[e]; }
                }
                u32x4 w0, w1;
                w0.x = cvt_pk_bf16(v0[0], v0[1]); w0.y = cvt_pk_bf16(v0[2], v0[3]); w0.z = cvt_pk_bf16(v0[4], v0[5]); w0.w = cvt_pk_bf16(v0[6], v0[7]);
                w1.x = cvt_pk_bf16(v1[0], v1[1]); w1.y = cvt_pk_bf16(v1[2], v1[3]); w1.z = cvt_pk_bf16(v1[4], v1[5]); w1.w = cvt_pk_bf16(v1[6], v1[7]);
                bf16_t* rowp = O + (size_t)row * ldc + col0;
                *(u32x4*)(rowp) = w0; *(u32x4*)(rowp + 32) = w1;
                if (km) {
#pragma unroll
                    for (int e = 0; e < 8; ++e) { cs0[e] += v0[e]; cs1[e] += v1[e]; }
                }
            }
        if (km) {
#pragma unroll
            for (int e = 0; e < 8; ++e) {
                cs0[e] = row16_sum(cs0[e]); cs1[e] = row16_sum(cs1[e]);
            }
            if (fr == 0) {
                float* kp = kmean + ((size_t)((u.pm >> 3) * 8 + (hg - 32)) * 8 + (u.pm & 7)) * 64 + 8 * fq;
#pragma unroll
                for (int e = 0; e < 8; ++e) { atomicAdd(kp + e, cs0[e] * (1.0f / 256.0f)); atomicAdd(kp + 32 + e, cs1[e] * (1.0f / 256.0f)); }
            }
        }
    }
};
struct EpiResid {
    static constexpr bool PERM = true, AFTER_DRAIN = false;
    const float* xin; float* xout; const float* gate;
    __device__ __forceinline__ void operator()(const f32x4 (&acc)[2][2][4][2], const Unit& u, int wr, int wc, int fr_, int fq_) const {
        int fr = fr_, fq = fq_; asm volatile("" : "+v"(fr), "+v"(fq));
        const int row0 = u.pm * BM + wr * 64 + fr, col0 = u.pn * BM + wc * 32 + 8 * fq;
#pragma unroll
        for (int ai = 0; ai < 2; ++ai)
#pragma unroll
            for (int m = 0; m < 4; ++m) { const int row = row0 + ai * HALF + m * 16; const float* gp = gate + (size_t)(row >> 11) * 6144 + col0;
                const float* xi = xin + (size_t)row * 1024 + col0; float* xo = xout + (size_t)row * 1024 + col0;
#pragma unroll
                for (int bj = 0; bj < 2; ++bj)
#pragma unroll
                    for (int n = 0; n < 2; ++n) { const f32x4 a = acc[ai][bj][m][n], x = *(const f32x4*)(xi + bj * HALF + 4 * n), g = *(const f32x4*)(gp + bj * HALF + 4 * n);
                        f32x4 o; o[0] = x[0] + g[0] * a[0]; o[1] = x[1] + g[1] * a[1]; o[2] = x[2] + g[2] * a[2]; o[3] = x[3] + g[3] * a[3];
                        *(f32x4*)(xo + bj * HALF + 4 * n) = o; } }
    }
};
template <class Epi, class Sched, bool ALIGN_EPI = false, bool SP2 = false>
__device__ __forceinline__ void gemm_phase(PG8_LAS unsigned char* lds, const Gemm g, const Sched& S, const Epi& E) {
    const int tid = ltid(), wid = __builtin_amdgcn_readfirstlane(tid >> 6), lane = tid & 63, wr = wid >> 2, wc = wid & 3, fr = lane & 15, fq = lane >> 4;
    const int K = g.K, nt = K / BK;
    unsigned voffA[2], voffB[2];
#pragma unroll
    for (int i = 0; i < 2; ++i) { int R, C; stage_rc(tid * 16 + i * 8192, R, C); const int Rb = Epi::PERM ? ((R & ~31) + perm32(R & 31)) : R;
        voffA[i] = (unsigned)(R * K + C) * 2u; voffB[i] = (unsigned)(Rb * K + C) * 2u; }
    const size_t kstep = (size_t)(BK * 2);
    const size_t hstep = (size_t)HALF * K * 2;
    const size_t tstep = 2 * hstep;
    const unsigned ldsw = (unsigned)wid * 1024u;
    const int aoff = lds_byte(wr * 64 + fr, fq * 8), boff = lds_byte(wc * 32 + fr, fq * 8);
#define PG8_SA(b, h) (((b) * 2 + (h)) * HTB)
#define PG8_SB(b, h) ((4 + (b) * 2 + (h)) * HTB)
#define PG8_STAGE(bufoff, gbase, voff) do { _Pragma("unroll") for (int _i = 0; _i < 2; ++_i) \
        __builtin_amdgcn_global_load_lds((const unsigned*)((const char*)(gbase) + (voff)[_i]), (PG8_LAS unsigned*)(lds + (bufoff) + ldsw + _i * 8192), 16, 0, 0); } while (0)
#define PG8_LDA(dst, b, h) do { _Pragma("unroll") for (int m = 0; m < 4; ++m) _Pragma("unroll") for (int k = 0; k < 2; ++k) dst[m][k] = *(const PG8_LAS bf16x8*)(lds + PG8_SA(b, h) + aoff + m * 2048 + k * 1024); } while (0)
#define PG8_LDB(dst, b, h) do { _Pragma("unroll") for (int n = 0; n < 2; ++n) _Pragma("unroll") for (int k = 0; k < 2; ++k) dst[n][k] = *(const PG8_LAS bf16x8*)(lds + PG8_SB(b, h) + boff + n * 2048 + k * 1024); } while (0)
#define PG8_MMA(ai, bj, At, Bt) do { __builtin_amdgcn_s_setprio(1); _Pragma("unroll") for (int m = 0; m < 4; ++m) _Pragma("unroll") for (int n = 0; n < 2; ++n) _Pragma("unroll") for (int k = 0; k < 2; ++k) \
        acc[ai][bj][m][n] = __builtin_amdgcn_mfma_f32_16x16x32_bf16(Bt[n][k], At[m][k], acc[ai][bj][m][n], 0, 0, 0); __builtin_amdgcn_s_setprio(0); } while (0)
#define PG8_WAIT_V(n) asm volatile("s_waitcnt vmcnt(" #n ")" ::: "memory")
#define PG8_WAIT_L(n) asm volatile("s_waitcnt lgkmcnt(" #n ")" ::: "memory")
#define PG8_BAR __builtin_amdgcn_s_barrier()
#define PG8_SCHED __builtin_amdgcn_sched_barrier(0)
    Unit cur, nxt; int ui = 0;
    if (!S.next(0, cur)) return;
    f32x4 acc[2][2][4][2];
#pragma unroll
    for (int a = 0; a < 2; ++a)
#pragma unroll
        for (int b = 0; b < 2; ++b)
#pragma unroll
            for (int m = 0; m < 4; ++m)
#pragma unroll
                for (int n = 0; n < 2; ++n) acc[a][b][m][n] = (f32x4){0.f, 0.f, 0.f, 0.f};
    bf16x8 At[4][2], B0[2][2], B1[2][2];
    const char* cA = (const char*)g.A + (size_t)cur.pm * tstep; const char* cB = (const char*)g.Bt + (size_t)cur.pn * tstep;
    S.a_ready(cur);
    if constexpr (SP2) {
        PG8_STAGE(PG8_SB(0, 0), cB, voffB); PG8_STAGE(PG8_SB(0, 1), cB + hstep, voffB); PG8_STAGE(PG8_SA(0, 0), cA, voffA); PG8_STAGE(PG8_SA(0, 1), cA + hstep, voffA);
        if (wr == 1) PG8_BAR;
        PG8_WAIT_V(2); PG8_BAR;
        PG8_STAGE(PG8_SB(1, 0), cB + kstep, voffB); PG8_STAGE(PG8_SA(1, 0), cA + kstep, voffA); PG8_STAGE(PG8_SB(1, 1), cB + hstep + kstep, voffB);
        PG8_WAIT_V(6); PG8_BAR;
    } else {
        PG8_STAGE(PG8_SB(0, 0), cB, voffB); PG8_STAGE(PG8_SA(0, 0), cA, voffA); PG8_STAGE(PG8_SB(0, 1), cB + hstep, voffB); PG8_STAGE(PG8_SA(0, 1), cA + hstep, voffA);
        if (wr == 1) PG8_BAR;
        PG8_WAIT_V(4); PG8_BAR;
        PG8_STAGE(PG8_SB(1, 0), cB + kstep, voffB); PG8_STAGE(PG8_SA(1, 0), cA + kstep, voffA); PG8_STAGE(PG8_SB(1, 1), cB + hstep + kstep, voffB);
        PG8_WAIT_V(6); PG8_BAR;
    }
    for (;;) {
        const bool has_next = S.next(ui + 1, nxt);
        const char* nA = has_next ? (const char*)g.A + (size_t)nxt.pm * tstep : cA; const char* nB = has_next ? (const char*)g.Bt + (size_t)nxt.pn * tstep : cB;
        for (int t = 0; t < nt; t += 2) {
            const bool last = (t == nt - 2);
            const char* a1 = cA + (size_t)(t + 1) * kstep;
            const char* a2 = last ? nA : cA + (size_t)(t + 2) * kstep; const char* b2 = last ? nB : cB + (size_t)(t + 2) * kstep;
            const char* a3 = a2 + kstep; const char* b3 = b2 + kstep;
            if (last && has_next) S.a_ready(nxt);
            if constexpr (SP2) {
            PG8_LDB(B0, 0, 0); PG8_LDB(B1, 0, 1); PG8_SCHED; PG8_LDA(At, 0, 0); PG8_STAGE(PG8_SA(1, 1), a1 + hstep, voffA);
            PG8_WAIT_V(8); PG8_WAIT_L(0); PG8_BAR; PG8_MMA(0, 0, At, B0); PG8_MMA(0, 1, At, B1); PG8_BAR; PG8_SCHED;
            PG8_LDA(At, 0, 1); PG8_STAGE(PG8_SB(0, 0), b2, voffB); PG8_STAGE(PG8_SB(0, 1), b2 + hstep, voffB); PG8_STAGE(PG8_SA(0, 0), a2, voffA);
            PG8_WAIT_V(8); PG8_WAIT_L(0); PG8_BAR; PG8_MMA(1, 0, At, B0); PG8_MMA(1, 1, At, B1); PG8_BAR; PG8_SCHED;
            PG8_LDB(B0, 1, 0); PG8_LDB(B1, 1, 1); PG8_SCHED; PG8_LDA(At, 1, 0); PG8_STAGE(PG8_SA(0, 1), a2 + hstep, voffA);
            PG8_WAIT_V(8); PG8_WAIT_L(0); PG8_BAR; PG8_MMA(0, 0, At, B0); PG8_MMA(0, 1, At, B1); PG8_BAR; PG8_SCHED;
            PG8_LDA(At, 1, 1); PG8_STAGE(PG8_SB(1, 0), b3, voffB); PG8_STAGE(PG8_SB(1, 1), b3 + hstep, voffB); PG8_STAGE(PG8_SA(1, 0), a3, voffA);
            PG8_WAIT_V(8); PG8_WAIT_L(0); PG8_BAR; PG8_MMA(1, 0, At, B0); PG8_MMA(1, 1, At, B1); PG8_BAR; PG8_SCHED;
            } else {
            PG8_LDB(B0, 0, 0); PG8_SCHED; PG8_LDA(At, 0, 0); PG8_STAGE(PG8_SA(1, 1), a1 + hstep, voffA);
            PG8_WAIT_L(8); PG8_BAR; PG8_WAIT_L(0); PG8_MMA(0, 0, At, B0); PG8_BAR; PG8_SCHED;
            PG8_LDB(B1, 0, 1); PG8_STAGE(PG8_SB(0, 0), b2, voffB);
            PG8_BAR; PG8_WAIT_L(0); PG8_MMA(0, 1, At, B1); PG8_BAR;
            PG8_LDA(At, 0, 1); PG8_STAGE(PG8_SA(0, 0), a2, voffA);
            PG8_BAR; PG8_WAIT_L(0); PG8_MMA(1, 0, At, B0); PG8_BAR; PG8_SCHED;
            PG8_STAGE(PG8_SB(0, 1), b2 + hstep, voffB);
            PG8_WAIT_V(6); PG8_BAR; PG8_MMA(1, 1, At, B1); PG8_BAR;
            PG8_LDB(B0, 1, 0); PG8_SCHED; PG8_LDA(At, 1, 0); PG8_STAGE(PG8_SA(0, 1), a2 + hstep, voffA);
            PG8_WAIT_L(8); PG8_BAR; PG8_WAIT_L(0); PG8_MMA(0, 0, At, B0); PG8_BAR; PG8_SCHED;
            PG8_LDB(B1, 1, 1); PG8_STAGE(PG8_SB(1, 0), b3, voffB);
            PG8_BAR; PG8_WAIT_L(0); PG8_MMA(0, 1, At, B1); PG8_BAR;
            PG8_LDA(At, 1, 1); PG8_STAGE(PG8_SA(1, 0), a3, voffA);
            PG8_BAR; PG8_WAIT_L(0); PG8_MMA(1, 0, At, B0); PG8_BAR; PG8_SCHED;
            PG8_STAGE(PG8_SB(1, 1), b3 + hstep, voffB);
            PG8_WAIT_V(6); PG8_BAR; PG8_MMA(1, 1, At, B1); PG8_BAR;
            }
        }
        if constexpr (ALIGN_EPI) { if (wr == 0) PG8_BAR; }
        if constexpr (!Epi::AFTER_DRAIN) { E(acc, cur, wr, wc, fr, fq); S.done(cur); }
        if (!has_next) break;
#pragma unroll
        for (int a = 0; a < 2; ++a)
#pragma unroll
            for (int b = 0; b < 2; ++b)
#pragma unroll
                for (int m = 0; m < 4; ++m)
#pragma unroll
                    for (int n = 0; n < 2; ++n) acc[a][b][m][n] = (f32x4){0.f, 0.f, 0.f, 0.f};
        cur = nxt; cA = nA; cB = nB; ++ui;
        if constexpr (ALIGN_EPI) { if (wr == 1) PG8_BAR; }
    }
    PG8_WAIT_V(0);
    if constexpr (!ALIGN_EPI) { if (wr == 0) PG8_BAR; }
    PG8_BAR;
    if constexpr (Epi::AFTER_DRAIN) { E.fused(acc, cur, wr, wc, fr, fq, lds, wid, lane); S.done(cur); }
#undef PG8_SA
#undef PG8_SB
#undef PG8_STAGE
#undef PG8_LDA
#undef PG8_LDB
#undef PG8_MMA
#undef PG8_WAIT_V
#undef PG8_WAIT_L
#undef PG8_BAR
#undef PG8_SCHED
}
}

typedef float f32x16 __attribute__((ext_vector_type(16)));
typedef short s16x4 __attribute__((ext_vector_type(4)));
typedef short v4i16_t __attribute__((ext_vector_type(4)));
typedef float f32x2_t __attribute__((ext_vector_type(2)));
typedef __bf16 bf16x2_t __attribute__((ext_vector_type(2)));
#define LAS __attribute__((address_space(3)))
constexpr int VROW = 144, VBUF = 32 * VROW;
constexpr int VROWV = 192, VBUFV = 32 * VROWV;
constexpr float L2E = 1.4426950408889634f, LN2 = 0.6931471805599453f;
constexpr float SC2 = 0.125f * L2E;

__device__ __forceinline__ int crow(int r, int hi) { return (r & 3) + 8 * (r >> 2) + 4 * hi; }
__device__ __forceinline__ unsigned cvtpk(float lo, float hi) { f32x2_t v = {lo, hi}; bf16x2_t b = __builtin_convertvector(v, bf16x2_t); return __builtin_bit_cast(unsigned, b); }
__device__ __forceinline__ float xhalf(float v, int hi) {
    auto r = __builtin_amdgcn_permlane32_swap(__float_as_uint(v), __float_as_uint(v), false, false);
    return __uint_as_float(hi ? r[0] : r[1]);
}
__device__ __forceinline__ s16x4 vtr(const LAS unsigned char* p) { return __builtin_bit_cast(s16x4, __builtin_amdgcn_ds_read_tr16_b64_v4i16((LAS v4i16_t*)p)); }

struct KVRegs { u32x4 k[4]; u32x4 v[4]; };
__device__ __forceinline__ void load_kv(KVRegs& R, const bf16* base, int kp0, int kst, int kcol, int vcol, int lane) {
#pragma unroll
    for (int j = 0; j < 4; ++j) {
        const int pos = kp0 + kst * (8 * j + (lane >> 3));
        const int pc = pos < SQ - 1 ? pos : SQ - 1;
        const bf16* rp = base + (size_t)pc * QKV_LD + (lane & 7) * 8;
        R.k[j] = *(const u32x4*)(rp + kcol); R.v[j] = *(const u32x4*)(rp + vcol);
    }
}
__device__ __forceinline__ void kv_stage(const KVRegs& R, LAS unsigned char* klds, LAS unsigned char* vlds, int lane) {
#pragma unroll
    for (int j = 0; j < 4; ++j) { const int r_ = 8 * j + (lane >> 3), c_ = (lane & 7) * 16; *(LAS u32x4*)(klds + r_ * VROW + c_) = R.k[j]; *(LAS u32x4*)(vlds + r_ * VROWV + c_) = R.v[j]; }
}
__device__ __forceinline__ f32x16 qk_tile(const LAS unsigned char* klds, const bf16x8 (&qf)[4], int r32, int hi) {
    f32x16 s = {0.f, 0.f, 0.f, 0.f, 0.f, 0.f, 0.f, 0.f, 0.f, 0.f, 0.f, 0.f, 0.f, 0.f, 0.f, 0.f};
#pragma unroll
    for (int k = 0; k < 4; ++k) { const bf16x8 kf = *(const LAS bf16x8*)(klds + r32 * VROW + (2 * k + hi) * 16); s = __builtin_amdgcn_mfma_f32_32x32x16_bf16(kf, qf[k], s, 0, 0, 0); }
    return s;
}
__device__ __forceinline__ void pv_tile(f32x16 (&o)[2], const f32x16& p, const LAS unsigned char* vlds, int lane) {
    const int g = lane >> 4, i = lane & 15, h = lane >> 5;
    const LAS unsigned char* vb = vlds + (4 * h + (i >> 2)) * VROWV + (16 * (g & 1) + 4 * (i & 3)) * 2;
#pragma unroll
    for (int s = 0; s < 2; ++s) {
        u32x4 pw; pw.x = cvtpk(p[8 * s], p[8 * s + 1]); pw.y = cvtpk(p[8 * s + 2], p[8 * s + 3]); pw.z = cvtpk(p[8 * s + 4], p[8 * s + 5]); pw.w = cvtpk(p[8 * s + 6], p[8 * s + 7]);
        const bf16x8 pb = __builtin_bit_cast(bf16x8, pw);
#pragma unroll
        for (int df = 0; df < 2; ++df) {
            const s16x4 lo = vtr(vb + (16 * s) * VROWV + df * 64), hh = vtr(vb + (16 * s + 8) * VROWV + df * 64);
            const bf16x8 va = (bf16x8){lo[0], lo[1], lo[2], lo[3], hh[0], hh[1], hh[2], hh[3]};
            o[df] = __builtin_amdgcn_mfma_f32_32x32x16_bf16(va, pb, o[df], 0, 0, 0);
        }
    }
}
__device__ __forceinline__ void load_q(bf16x8 (&qf)[4], const bf16* base, int qpos, int qcol, int hi) {
    const bf16* rp = base + (size_t)qpos * QKV_LD + qcol + 8 * hi;
#pragma unroll
    for (int k = 0; k < 4; ++k) qf[k] = *(const bf16x8*)(rp + 16 * k);
}
__device__ __forceinline__ void store_o(bf16* yrow, const f32x16 (&o)[2], float inv, int hi) {
#pragma unroll
    for (int df = 0; df < 2; ++df)
#pragma unroll
        for (int g = 0; g < 4; ++g) {
            u32x2 w; w.x = cvtpk(o[df][4 * g] * inv, o[df][4 * g + 1] * inv); w.y = cvtpk(o[df][4 * g + 2] * inv, o[df][4 * g + 3] * inv);
            *(u32x2*)(yrow + 32 * df + 8 * g + 4 * hi) = w;
        }
}
__device__ __forceinline__ void osm_tile(f32x16& s, float& m, float& l, f32x16 (&o)[2]) {
    float mx = s[0];
#pragma unroll
    for (int r = 1; r < 16; ++r) mx = fmaxf(mx, s[r]);
    { auto rr = __builtin_amdgcn_permlane32_swap(__float_as_uint(mx), __float_as_uint(mx), false, false); mx = fmaxf(__uint_as_float(rr[0]), __uint_as_float(rr[1])); }
    const float mn = fmaxf(m, mx);
    const float ms = (mn == -INFINITY) ? 0.f : mn;
    const float alpha = __builtin_amdgcn_exp2f((m - ms) * SC2);
    const float mc = ms * SC2;
    float ps = 0.f;
#pragma unroll
    for (int r = 0; r < 16; ++r) { s[r] = __builtin_amdgcn_exp2f(s[r] * SC2 - mc); ps += s[r]; }
    l = l * alpha + ps; m = mn;
    if (!__all(alpha == 1.0f)) {
#pragma unroll
        for (int df = 0; df < 2; ++df)
#pragma unroll
            for (int r = 0; r < 16; ++r) o[df][r] *= alpha;
    }
}
__device__ __forceinline__ void osm_tile2(f32x16& s0, f32x16& s1, float& m, float& l, f32x16 (&o)[2]) {
    float mx = fmaxf(s0[0], s1[0]);
#pragma unroll
    for (int r = 1; r < 16; ++r) mx = fmaxf(mx, fmaxf(s0[r], s1[r]));
    { auto rr = __builtin_amdgcn_permlane32_swap(__float_as_uint(mx), __float_as_uint(mx), false, false); mx = fmaxf(__uint_as_float(rr[0]), __uint_as_float(rr[1])); }
    const float mn = fmaxf(m, mx);
    const float ms = (mn == -INFINITY) ? 0.f : mn;
    const float alpha = __builtin_amdgcn_exp2f((m - ms) * SC2);
    const float mc = ms * SC2;
    float ps0 = 0.f, ps1 = 0.f;
#pragma unroll
    for (int r = 0; r < 16; ++r) { s0[r] = __builtin_amdgcn_exp2f(s0[r] * SC2 - mc); ps0 += s0[r]; s1[r] = __builtin_amdgcn_exp2f(s1[r] * SC2 - mc); ps1 += s1[r]; }
    l = l * alpha + (ps0 + ps1); m = mn;
    if (!__all(alpha == 1.0f)) {
#pragma unroll
        for (int df = 0; df < 2; ++df)
#pragma unroll
            for (int r = 0; r < 16; ++r) o[df][r] *= alpha;
    }
}
#define ZERO16 {0.f, 0.f, 0.f, 0.f, 0.f, 0.f, 0.f, 0.f, 0.f, 0.f, 0.f, 0.f, 0.f, 0.f, 0.f, 0.f}

struct AttnCtx {
    const bf16* base; int kcol, vcol, r32, hi, lane; LAS unsigned char* vlds; LAS unsigned char* klds; bf16x8 qf[4]; f32x16 o[2];
};
#define ATTN_STEP(SC, SL, T) { \
        if (SYNC) __builtin_amdgcn_s_barrier(); \
        { int kp_, ks_; const int tl_ = (T) + 2 < nt ? (T) + 2 : nt - 1; mx.pos(tl_, kp_, ks_); load_kv(SL, c.base, kp_, ks_, c.kcol, c.vcol, c.lane); } \
        kv_stage(SC, c.klds, c.vlds, c.lane); f32x16 s_ = qk_tile(c.klds, c.qf, c.r32, c.hi); \
        const bool stop_ = mx.process((T), s_, c); pv_tile(c.o, s_, c.vlds, c.lane); \
        if ((!SYNC && stop_) || (T) + 1 >= nt) break; }
template <class M, bool SYNC> __device__ __forceinline__ void attn_run(M& mx, AttnCtx& c) {
    const int nt = mx.nt;
    KVRegs S0, S1, S2;
    { int kp, ks; mx.pos(0, kp, ks); load_kv(S0, c.base, kp, ks, c.kcol, c.vcol, c.lane);
      mx.pos(1 < nt ? 1 : nt - 1, kp, ks); load_kv(S1, c.base, kp, ks, c.kcol, c.vcol, c.lane); }
    for (int t = 0;; t += 3) {
        ATTN_STEP(S0, S2, t)
        ATTN_STEP(S1, S0, t + 1)
        ATTN_STEP(S2, S1, t + 2)
    }
}
#define SH_BAR() asm volatile("s_waitcnt lgkmcnt(0)\n\ts_barrier" ::: "memory")
constexpr int SLOT_K = 64 * VROW, SLOT_BYTES = 64 * VROW + 64 * VROWV;
struct ShRegs { u32x4 a, b; };
__device__ __forceinline__ void sh_load(ShRegs& R, const bf16* base, int kp0, int kcol, int vcol, int w, int lane) {
    const int pos = kp0 + 4 * w + ((lane & 31) >> 3);
    const int pa = pos < SQ - 1 ? pos : SQ - 1, pb = pos + 32 < SQ - 1 ? pos + 32 : SQ - 1;
    const int col = ((lane >> 5) ? vcol : kcol) + (lane & 7) * 8;
    R.a = *(const u32x4*)(base + (size_t)pa * QKV_LD + col); R.b = *(const u32x4*)(base + (size_t)pb * QKV_LD + col);
}
__device__ __forceinline__ void sh_write(LAS unsigned char* slot, const ShRegs& R, int w, int lane) {
    const int row = 4 * w + ((lane & 31) >> 3);
    LAS unsigned char* p = slot + ((lane >> 5) ? SLOT_K + row * VROWV : row * VROW) + (lane & 7) * 16;
    *(LAS u32x4*)p = R.a; *(LAS u32x4*)(p + 32 * ((lane >> 5) ? VROWV : VROW)) = R.b;
}
#define SH_STEP(RW, RL, T) { \
        SH_BAR(); \
        { const int tl_ = (T) + 2 < nt ? (T) + 2 : nt - 1; sh_load(RL, c.base, mx.pos2(tl_), c.kcol, c.vcol, w, c.lane); } \
        sh_write(slots + (((T) + 1) & 1) * SLOT_BYTES, RW, w, c.lane); \
        if (mx.active2((T), w)) { LAS unsigned char* sl_ = slots + ((T) & 1) * SLOT_BYTES; \
            f32x16 s0_ = qk_tile(sl_, c.qf, c.r32, c.hi), s1_ = qk_tile(sl_ + 32 * VROW, c.qf, c.r32, c.hi); mx.process2((T), s0_, s1_, c); \
            pv_tile(c.o, s0_, sl_ + SLOT_K, c.lane); pv_tile(c.o, s1_, sl_ + SLOT_K + 32 * VROWV, c.lane); } \
        if ((T) + 1 >= nt) break; }
template <class M> __device__ __forceinline__ void attn_run_shared(M& mx, AttnCtx& c, LAS unsigned char* slots, int w) {
    const int nt = mx.nt2;
    ShRegs R0, R1, R2;
    sh_load(R0, c.base, mx.pos2(0), c.kcol, c.vcol, w, c.lane);
    sh_load(R1, c.base, mx.pos2(1 < nt ? 1 : nt - 1), c.kcol, c.vcol, w, c.lane);
    SH_BAR();
    sh_write(slots, R0, w, c.lane);
    for (int t = 0;; t += 3) {
        SH_STEP(R1, R2, t)
        SH_STEP(R2, R0, t + 1)
        SH_STEP(R0, R1, t + 2)
    }
}
struct MixA {
    int nt, k00, qpos; float m, l;
    __device__ __forceinline__ void pos(int idx, int& kp0, int& kst) const { kp0 = k00 + 32 * idx; kst = 1; }
    __device__ __forceinline__ bool process(int idx, f32x16& s, AttnCtx& c) {
        const int k0 = k00 + 32 * idx;
#pragma unroll
        for (int r = 0; r < 16; ++r) { const int dist = qpos - (k0 + crow(r, c.hi)); if (dist < 0 || dist > 127) s[r] = -INFINITY; }
        osm_tile(s, m, l, c.o); return false;
    }
};
__device__ void attn_A(const bf16* base, int hq, int q0, float sink, bf16* ybase, LAS unsigned char* vlds, int lane) {
    AttnCtx c; c.base = base; c.r32 = lane & 31; c.hi = lane >> 5; c.lane = lane; c.vlds = vlds; c.klds = vlds + VBUFV; c.kcol = 512 + (hq >> 2) * 64; c.vcol = 640 + (hq >> 2) * 64;
    c.o[0] = (f32x16)ZERO16; c.o[1] = (f32x16)ZERO16;
    MixA mx; mx.qpos = q0 + c.r32; mx.k00 = q0 - 128 > 0 ? q0 - 128 : 0; mx.nt = 5; mx.m = -INFINITY; mx.l = 0.f;
    load_q(c.qf, base, mx.qpos, hq * 64, c.hi);
    attn_run<MixA, true>(mx, c);
    float l = mx.l + xhalf(mx.l, c.hi);
    l += __builtin_amdgcn_exp2f(sink * L2E - mx.m * SC2);
    store_o(ybase + (size_t)mx.qpos * DM + hq * 64, c.o, 1.0f / l, c.hi);
}
struct MixB {
    int nt, q0, qpos; float carry;
    __device__ __forceinline__ void pos(int idx, int& kp0, int& kst) const { kp0 = q0 - 32 * idx; kst = 1; }
    __device__ __forceinline__ bool process(int idx, f32x16& s, AttnCtx& c) {
        const int k0 = q0 - 32 * idx, hi = c.hi;
        float lk[16], G[4], Gp[4];
#pragma unroll
        for (int r = 0; r < 16; ++r) {
            const float z = s[r] * 0.125f;
            const bool valid = (k0 + crow(r, hi)) < qpos;
            const float sp = fmaxf(z, 0.f) + LN2 * __builtin_amdgcn_logf(1.0f + __builtin_amdgcn_exp2f(-fabsf(z) * L2E));
            lk[r] = valid ? -sp : 0.f;
            s[r] = valid ? (z - sp) : -INFINITY;
        }
#pragma unroll
        for (int g = 0; g < 4; ++g) { G[g] = (lk[4 * g] + lk[4 * g + 1]) + (lk[4 * g + 2] + lk[4 * g + 3]); Gp[g] = xhalf(G[g], hi); }
        float above = carry;
#pragma unroll
        for (int g = 3; g >= 0; --g) {
            float off = above + (hi == 0 ? Gp[g] : 0.f);
            s[4 * g + 3] = __builtin_amdgcn_exp2f((s[4 * g + 3] + off) * L2E); off += lk[4 * g + 3];
            s[4 * g + 2] = __builtin_amdgcn_exp2f((s[4 * g + 2] + off) * L2E); off += lk[4 * g + 2];
            s[4 * g + 1] = __builtin_amdgcn_exp2f((s[4 * g + 1] + off) * L2E); off += lk[4 * g + 1];
            s[4 * g + 0] = __builtin_amdgcn_exp2f((s[4 * g + 0] + off) * L2E);
            above += G[g] + Gp[g];
        }
        carry = above;
        return __all(carry < -40.0f) != 0;
    }
};
__device__ void attn_B(const bf16* base, int h, int q0, bf16* ybase, LAS unsigned char* vlds, int lane) {
    AttnCtx c; c.base = base; c.r32 = lane & 31; c.hi = lane >> 5; c.lane = lane; c.vlds = vlds; c.klds = vlds + VBUFV; c.kcol = 1280 + h * 64; c.vcol = 1792 + h * 64;
    c.o[0] = (f32x16)ZERO16; c.o[1] = (f32x16)ZERO16;
    MixB mx; mx.q0 = q0; mx.qpos = q0 + c.r32; mx.nt = q0 / 32 + 1; mx.carry = 0.f;
    load_q(c.qf, base, mx.qpos, 768 + h * 64, c.hi);
    attn_run<MixB, false>(mx, c);
    store_o(ybase + (size_t)mx.qpos * DM + 512 + h * 64, c.o, 1.0f, c.hi);
}
struct MixCp {
    int nt, n0, r0, j1lo, qpos; float m, l;
    __device__ __forceinline__ void pos(int t, int& kp0, int& kst) const {
        if (t < n0) { kp0 = r0 + 512 * t; kst = 16; } else { kp0 = (r0 & 3) + 4 * (j1lo + 32 * (t - n0)); kst = 4; }
    }
    __device__ __forceinline__ bool process(int t, f32x16& s, AttnCtx& c) {
        int kp0, kst; pos(t, kp0, kst);
        const int win = t < n0 ? 2048 : 512;
#pragma unroll
        for (int r = 0; r < 16; ++r) { const int dist = qpos - (kp0 + kst * crow(r, c.hi)); if (dist < 0 || dist > win) s[r] = -INFINITY; }
        osm_tile(s, m, l, c.o); return false;
    }
};
struct MixC1 {
    int nt2, p0, qpos; float m, l;
    __device__ __forceinline__ int pos2(int T) const { return p0 + 64 * T; }
    __device__ __forceinline__ bool active2(int T, int w) const { return true; }
    __device__ __forceinline__ void process2(int T, f32x16& s0, f32x16& s1, AttnCtx& c) {
        const int k0 = p0 + 64 * T;
#pragma unroll
        for (int r = 0; r < 16; ++r) { const int dist = qpos - (k0 + crow(r, c.hi)); if (dist < 0 || dist > 128) s0[r] = -INFINITY; if (dist < 32 || dist > 160) s1[r] = -INFINITY; }
        osm_tile2(s0, s1, m, l, c.o);
    }
};
__device__ void attn_C(const bf16* base, int h, int r0, int g, bf16* ybase, LAS unsigned char* vlds, LAS unsigned char* xlds, int w, int lane) {
    AttnCtx c; c.base = base; c.r32 = lane & 31; c.hi = lane >> 5; c.lane = lane; c.vlds = vlds; c.klds = vlds + VBUFV; c.kcol = 512 + h * 64; c.vcol = 1024 + h * 64;
    c.o[0] = (f32x16)ZERO16; c.o[1] = (f32x16)ZERO16;
    const int qpos = r0 + 16 * (32 * g + c.r32);
    load_q(c.qf, base, qpos, h * 64, c.hi);
    MixCp mp; mp.r0 = r0; mp.qpos = qpos; mp.m = -INFINITY; mp.l = 0.f;
    mp.n0 = g + 1;
    mp.j1lo = (r0 >> 2) + 128 * g - 128 > 0 ? (r0 >> 2) + 128 * g - 128 : 0;
    mp.nt = mp.n0 + ((r0 >> 2) + 128 * g + 124 - mp.j1lo) / 32 + 1;
    attn_run<MixCp, true>(mp, c);
    MixC1 m1; m1.qpos = qpos; m1.m = mp.m; m1.l = mp.l;
    const int ra = r0 & 8;
    m1.p0 = 512 * g + ra - 128 > 0 ? 512 * g + ra - 128 : 0;
    m1.nt2 = ((512 * g + ra + 7 + 496 - m1.p0) / 32 + 2) / 2;
    attn_run_shared<MixC1>(m1, c, xlds + 64, w);
    const float l = m1.l + xhalf(m1.l, c.hi);
    store_o(ybase + (size_t)qpos * DM + h * 64, c.o, 1.0f / l, c.hi);
}
struct MixD {
    int nt, nt2, npast, own, q0, qpos; unsigned U, sel; float m, l;
    __device__ __forceinline__ int blk_of(int j) const {
        unsigned u = U; int b = 0;
#pragma unroll
        for (int i = 0; i < 7; ++i) { if (i < j) u &= u - 1u; }
        b = __builtin_ctz(u | 0x100u); return b;
    }
    __device__ __forceinline__ void pos(int t, int& kp0, int& kst) const {
        kst = 1;
        if (t < 8 * npast) kp0 = blk_of(t >> 3) * 256 + (t & 7) * 32; else kp0 = own * 256 + (t - 8 * npast) * 32;
    }
    __device__ __forceinline__ int pos2(int T) const { int kp, ks; pos(2 * T, kp, ks); return kp; }
    __device__ __forceinline__ bool active2(int T, int w) const { return T < 4 * npast || 2 * (T - 4 * npast) <= w; }
    __device__ __forceinline__ void process2(int T, f32x16& s0, f32x16& s1, AttnCtx& c) {
        if (T < 4 * npast) {
            const int blk = blk_of(T >> 2);
            if (!((sel >> blk) & 1u)) {
#pragma unroll
                for (int r = 0; r < 16; ++r) { s0[r] = -INFINITY; s1[r] = -INFINITY; }
            }
        } else {
            const int k0 = own * 256 + (T - 4 * npast) * 64;
#pragma unroll
            for (int r = 0; r < 16; ++r) { const int kk = k0 + crow(r, c.hi); if (kk > qpos) s0[r] = -INFINITY; if (kk + 32 > qpos) s1[r] = -INFINITY; }
        }
        osm_tile2(s0, s1, m, l, c.o);
    }
};
__device__ void attn_D(const bf16* base, const float* kmean  , int h, int q0, bf16* ybase, LAS unsigned char* vlds, LAS unsigned char* xlds, int lane) {
    AttnCtx c; c.base = base; c.r32 = lane & 31; c.hi = lane >> 5; c.lane = lane; c.vlds = vlds; c.klds = vlds + VBUFV; c.kcol = 2048 + h * 64; c.vcol = 2560 + h * 64;
    c.o[0] = (f32x16)ZERO16; c.o[1] = (f32x16)ZERO16;
    const int r32 = c.r32, hi = c.hi, own = q0 >> 8;
    MixD mx; mx.own = own; mx.q0 = q0; mx.qpos = q0 + r32; mx.m = -INFINITY; mx.l = 0.f;
    load_q(c.qf, base, mx.qpos, 1536 + h * 64, hi);
    unsigned sel = 0u;
    if (own > 0) {
        bf16x8 kf[4];
#pragma unroll
        for (int k = 0; k < 4; ++k) {
            u32x4 w = {0u, 0u, 0u, 0u};
            if (r32 < 8) { const float* kp = kmean + r32 * 64 + 16 * k + 8 * hi; const f32x4 a = *(const f32x4*)kp, b = *(const f32x4*)(kp + 4);
                w.x = cvtpk(a[0], a[1]); w.y = cvtpk(a[2], a[3]); w.z = cvtpk(b[0], b[1]); w.w = cvtpk(b[2], b[3]); }
            kf[k] = __builtin_bit_cast(bf16x8, w);
        }
        f32x16 gs = ZERO16;
#pragma unroll
        for (int k = 0; k < 4; ++k) gs = __builtin_amdgcn_mfma_f32_32x32x16_bf16(kf[k], c.qf[k], gs, 0, 0, 0);
        float gt[8];
#pragma unroll
        for (int r = 0; r < 4; ++r) { const float mine = gs[r], oth = xhalf(mine, hi); gt[r] = hi == 0 ? mine : oth; gt[4 + r] = hi == 0 ? oth : mine; }
        const int nsel = own < 3 ? own : 3;
        for (int rr = 0; rr < nsel; ++rr) {
            float best = -INFINITY; int bi = -1;
#pragma unroll
            for (int n = 0; n < 8; ++n) { const bool ok = n < own && !((sel >> n) & 1u) && (bi < 0 || gt[n] > best); if (ok) { best = gt[n]; bi = n; } }
            if (bi >= 0) sel |= 1u << bi;
        }
    }
    unsigned U = 0u;
#pragma unroll
    for (int n = 0; n < 8; ++n) if (__ballot((sel >> n) & 1u) != 0ull) U |= 1u << n;
    {
        volatile LAS unsigned* ux = (volatile LAS unsigned*)xlds;
        __builtin_amdgcn_s_barrier();
        if (lane == 0) ux[(q0 >> 5) & 7] = U;
        asm volatile("s_waitcnt lgkmcnt(0)" ::: "memory");
        __builtin_amdgcn_s_barrier();
        U = ux[0] | ux[1] | ux[2] | ux[3] | ux[4] | ux[5] | ux[6] | ux[7];
        U = __builtin_amdgcn_readfirstlane(U);
    }
    mx.U = U; mx.sel = sel; mx.npast = __builtin_popcount(U); mx.nt = 8 * mx.npast + 8; mx.nt2 = 4 * mx.npast + 4;
    attn_run_shared<MixD>(mx, c, xlds + 64, (q0 >> 5) & 7);
    const float l = mx.l + xhalf(mx.l, c.hi);
    store_o(ybase + (size_t)mx.qpos * DM + 512 + h * 64, c.o, 1.0f / l, hi);
}

__device__ void ph_attn0(const bf16* qkv, const float* sinks, bf16* y, LAS unsigned char* lds, int bid, int nb) {
    const int lane = ltid() & 63, w = __builtin_amdgcn_readfirstlane(ltid() >> 6);
    LAS unsigned char* vlds = lds + w * (VBUF + VBUFV);
    for (int pid = bid; pid < NB * 8; pid += nb) {
        const int b = pid >> 3, h = pid & 7;
        const bf16* base = qkv + (size_t)b * SQ * QKV_LD; bf16* ybase = y + (size_t)b * SQ * DM;
        const float sink = sinks[h];
        for (int rd = 0; rd < 8; ++rd) attn_A(base, h, (rd * 8 + w) * 32, sink, ybase, vlds, lane);
        for (int rd = 0; rd < 8; ++rd) attn_B(base, h, (rd * 8 + w) * 32, ybase, vlds, lane);
    }
}
__device__ void ph_attn1(const bf16* qkv, const float* kmean, bf16* y, LAS unsigned char* lds, int bid, int nb) {
    const int lane = ltid() & 63, w = __builtin_amdgcn_readfirstlane(ltid() >> 6);
    LAS unsigned char* vlds = lds + w * (VBUF + VBUFV);
    for (int pid = bid; pid < NB * 8; pid += nb) {
        const int b = pid >> 3, h = pid & 7;
        const bf16* base = qkv + (size_t)b * SQ * QKV_LD; bf16* ybase = y + (size_t)b * SQ * DM;
        for (int rd = 0; rd < 8; ++rd) { const int it = rd * 8 + w; attn_C(base, h, it & 15, it >> 4, ybase, vlds, lds + 8 * (VBUF + VBUFV), w, lane); }
        for (int rd = 0; rd < 8; ++rd) attn_D(base, kmean + (size_t)pid * 8 * 64, h, (rd * 8 + w) * 32, ybase, vlds, lds + 8 * (VBUF + VBUFV), lane);
    }
}

#define CE_D(a, b) { const float hi_ = fmaxf((a), (b)), lo_ = fminf((a), (b)); (a) = hi_; (b) = lo_; }
#define BSTAGE(arr, k, j) _Pragma("unroll") for (int i_ = 0; i_ < 16; ++i_) { const int l_ = i_ ^ (j); if (l_ > i_) { if ((i_ & (k)) == 0) CE_D(arr[i_], arr[l_]) else CE_D(arr[l_], arr[i_]) } }
__device__ __forceinline__ void bsort16(float (&a)[16]) {
    BSTAGE(a, 2, 1) BSTAGE(a, 4, 2) BSTAGE(a, 4, 1) BSTAGE(a, 8, 4) BSTAGE(a, 8, 2) BSTAGE(a, 8, 1) BSTAGE(a, 16, 8) BSTAGE(a, 16, 4) BSTAGE(a, 16, 2) BSTAGE(a, 16, 1)
}
__device__ __forceinline__ void bmerge16(float (&a)[16]) {
    BSTAGE(a, 16, 8) BSTAGE(a, 16, 4) BSTAGE(a, 16, 2) BSTAGE(a, 16, 1)
}
__device__ __forceinline__ void merge_top16(float (&a)[16], const float (&b)[16]) {
#pragma unroll
    for (int i = 0; i < 16; ++i) a[i] = fmaxf(a[i], b[15 - i]);
    bmerge16(a);
}
__device__ __forceinline__ void xmerge16(float (&a)[16]) {
    {
        float A[16], B[16];
#pragma unroll
        for (int i = 0; i < 16; ++i) { auto r = __builtin_amdgcn_permlane16_swap(__float_as_uint(a[i]), __float_as_uint(a[i]), false, false); A[i] = __uint_as_float(r[0]); B[i] = __uint_as_float(r[1]); }
#pragma unroll
        for (int i = 0; i < 16; ++i) a[i] = fmaxf(A[i], B[15 - i]);
        bmerge16(a);
    }
    {
        float A[16], B[16];
#pragma unroll
        for (int i = 0; i < 16; ++i) { auto r = __builtin_amdgcn_permlane32_swap(__float_as_uint(a[i]), __float_as_uint(a[i]), false, false); A[i] = __uint_as_float(r[0]); B[i] = __uint_as_float(r[1]); }
#pragma unroll
        for (int i = 0; i < 16; ++i) a[i] = fmaxf(A[i], B[15 - i]);
        bmerge16(a);
    }
}
__host__ __device__ constexpr int pair_i(int id) {
    int c = 0;
    for (int i = 0; i < 16; ++i) { const int nj = 16 / (i + 1); if (id < c + nj) return i; c += nj; }
    return 0;
}
__host__ __device__ constexpr int pair_j(int id) {
    int c = 0;
    for (int i = 0; i < 16; ++i) { const int nj = 16 / (i + 1); if (id < c + nj) return id - c; c += nj; }
    return 0;
}
constexpr int SK_ROW = 272;
constexpr int SEL_SK_BYTES = 2 * 128 * SK_ROW;
constexpr int SEL_TAB_OFF = SEL_SK_BYTES;
constexpr int SEL_IDX_OFF = SEL_SK_BYTES + 64;

template <int S> __device__ __forceinline__ float cand_slot(const float (&L1)[16], const float (&L2)[16], int g) {
    constexpr int p0 = S, p1 = 16 + S, p2 = 32 + S, p3 = 48 + S;
    const float c0 = L1[pair_i(p0)] + L2[pair_j(p0)], c1 = L1[pair_i(p1)] + L2[pair_j(p1)], c2 = L1[pair_i(p2)] + L2[pair_j(p2)];
    const float c3 = p3 < 50 ? L1[pair_i(p3 < 50 ? p3 : 0)] + L2[pair_j(p3 < 50 ? p3 : 0)] : -1.0e30f;
    const float c = g == 0 ? c0 : (g == 1 ? c1 : (g == 2 ? c2 : c3));
    return __uint_as_float((__float_as_uint(c) & 0xffffffc0u) | (unsigned)(16 * g + S));
}

__device__ void ph_peer_select(const bf16* qry, const float* subkeys  , int* eidx, float* egate, LAS unsigned char* lds, int bid, int nb) {
    const int tid = ltid(), lane = tid & 63, w = __builtin_amdgcn_readfirstlane(tid >> 6);
    const int tk = lane & 15, g = lane >> 4;
    __syncthreads();
    for (int e = tid; e < 2 * 128 * 128 / 2; e += NT) {
        const int row = e >> 6, c2 = (e & 63) * 2;
        const float a = subkeys[(size_t)row * 128 + c2], b = subkeys[(size_t)row * 128 + c2 + 1];
        *(LAS unsigned*)(lds + row * SK_ROW + c2 * 2) = pk2(a, b);
    }
    if (tid < 64) { int id = tid; int c = 0, pi = 0, pj = 0;
        for (int i = 0; i < 16; ++i) { const int nj = 16 / (i + 1); if (id >= c && id < c + nj) { pi = i; pj = id - c; } c += nj; }
        lds[SEL_TAB_OFF + tid] = (unsigned char)((pi << 4) | pj); }
    __syncthreads();
    LAS unsigned* widx = (LAS unsigned*)(lds + SEL_IDX_OFF + w * 512);
    const LAS unsigned char* widx8 = (const LAS unsigned char*)widx;
    const int nitems = (MT / 16) * 8;
    for (int it = bid * 8 + w; it < nitems; it += nb * 8) {
        const int h = it & 7, t0 = (it >> 3) * 16;
        float L[2][16];
#pragma unroll
        for (int hf = 0; hf < 2; ++hf) {
            bf16x8 qf[4];
            const bf16* qp = qry + (size_t)(t0 + tk) * PQ + h * 256 + hf * 128 + 8 * g;
#pragma unroll
            for (int ks = 0; ks < 4; ++ks) qf[ks] = *(const bf16x8*)(qp + 32 * ks);
            float key[32];
#pragma unroll
            for (int tile = 0; tile < 8; ++tile) {
                f32x4 acc = {0.f, 0.f, 0.f, 0.f};
#pragma unroll
                for (int ks = 0; ks < 4; ++ks) {
                    const bf16x8 af = *(const LAS bf16x8*)(lds + (hf * 128 + tile * 16 + tk) * SK_ROW + (32 * ks + 8 * g) * 2);
                    acc = __builtin_amdgcn_mfma_f32_16x16x32_bf16(af, qf[ks], acc, 0, 0, 0);
                }
#pragma unroll
                for (int r = 0; r < 4; ++r) key[tile * 4 + r] = __uint_as_float((__float_as_uint(acc[r]) & 0xffffff80u) | (unsigned)(16 * tile + 4 * g + r));
            }
            float a[16], b[16];
#pragma unroll
            for (int i = 0; i < 16; ++i) { a[i] = key[i]; b[i] = key[16 + i]; }
            bsort16(a); bsort16(b);
            merge_top16(a, b);
            xmerge16(a);
#pragma unroll
            for (int i = 0; i < 16; ++i) L[hf][i] = a[i];
            unsigned pk = 0u;
#pragma unroll
            for (int s = 0; s < 4; ++s) {
                const float v = g == 0 ? a[s] : (g == 1 ? a[4 + s] : (g == 2 ? a[8 + s] : a[12 + s]));
                pk |= (__float_as_uint(v) & 127u) << (8 * s);
            }
            widx[tk * 8 + hf * 4 + g] = pk;
        }
        float c[16];
        c[0] = cand_slot<0>(L[0], L[1], g); c[1] = cand_slot<1>(L[0], L[1], g); c[2] = cand_slot<2>(L[0], L[1], g); c[3] = cand_slot<3>(L[0], L[1], g);
        c[4] = cand_slot<4>(L[0], L[1], g); c[5] = cand_slot<5>(L[0], L[1], g); c[6] = cand_slot<6>(L[0], L[1], g); c[7] = cand_slot<7>(L[0], L[1], g);
        c[8] = cand_slot<8>(L[0], L[1], g); c[9] = cand_slot<9>(L[0], L[1], g); c[10] = cand_slot<10>(L[0], L[1], g); c[11] = cand_slot<11>(L[0], L[1], g);
        c[12] = cand_slot<12>(L[0], L[1], g); c[13] = cand_slot<13>(L[0], L[1], g); c[14] = cand_slot<14>(L[0], L[1], g); c[15] = cand_slot<15>(L[0], L[1], g);
        bsort16(c);
        xmerge16(c);
        float sum = 0.f, ex[16];
#pragma unroll
        for (int i = 0; i < 16; ++i) { ex[i] = __builtin_amdgcn_exp2f((c[i] - c[0]) * L2E); sum += ex[i]; }
        const float inv = 1.0f / sum;
        int oi[4]; float og[4];
#pragma unroll
        for (int s = 0; s < 4; ++s) {
            const float kv = g == 0 ? c[s] : (g == 1 ? c[4 + s] : (g == 2 ? c[8 + s] : c[12 + s]));
            const float ev = g == 0 ? ex[s] : (g == 1 ? ex[4 + s] : (g == 2 ? ex[8 + s] : ex[12 + s]));
            const unsigned pid = __float_as_uint(kv) & 63u;
            const unsigned ij = lds[SEL_TAB_OFF + pid];
            const unsigned i1 = widx8[tk * 32 + (ij >> 4)], i2 = widx8[tk * 32 + 16 + (ij & 15u)];
            oi[s] = (int)(i1 * 128u + i2); og[s] = ev * inv;
        }
        const size_t ob = (size_t)(t0 + tk) * 128 + h * 16 + 4 * g;
        *(u32x4*)(eidx + ob) = (u32x4){(unsigned)oi[0], (unsigned)oi[1], (unsigned)oi[2], (unsigned)oi[3]};
        *(f32x4*)(egate + ob) = (f32x4){og[0], og[1], og[2], og[3]};
    }
    __syncthreads();
}

typedef float v32f_t __attribute__((ext_vector_type(32)));
typedef unsigned v6u_t __attribute__((ext_vector_type(6)));
typedef unsigned v16u_t __attribute__((ext_vector_type(16)));
typedef __bf16 v32bf_t __attribute__((ext_vector_type(32)));
typedef __bf16 v2bf_t __attribute__((ext_vector_type(2)));
typedef _Float16 v32h_t __attribute__((ext_vector_type(32)));
typedef unsigned u32x3 __attribute__((ext_vector_type(3)));
constexpr int TROW = 768;
__device__ void ph_tab_fp6(const float* src, unsigned char* dst, float* scale, int nrows, int bid, int nb) {
    const int lane = ltid() & 63, w = __builtin_amdgcn_readfirstlane(ltid() >> 6);
    for (int rp = bid * 8 + w; rp < nrows / 2; rp += nb * 8) {
        v32h_t hv; float sc[2];
#pragma unroll
        for (int rr = 0; rr < 2; ++rr) {
            const float* sp = src + (size_t)(2 * rp + rr) * DM + lane * 16;
            f32x4 v[4]; float am = 0.f;
#pragma unroll
            for (int i = 0; i < 4; ++i) { v[i] = *(const f32x4*)(sp + i * 4); am = fmaxf(am, fmaxf(fmaxf(fabsf(v[i][0]), fabsf(v[i][1])), fmaxf(fabsf(v[i][2]), fabsf(v[i][3])))); }
            am = wave_max(am);
            const float s = am > 0.f ? am * (1.0f / 7.5f) : 1.0f, inv = 1.0f / s;
            sc[rr] = s;
#pragma unroll
            for (int i = 0; i < 4; ++i)
#pragma unroll
                for (int e = 0; e < 4; ++e) hv[rr * 16 + i * 4 + e] = (_Float16)fminf(fmaxf(v[i][e] * inv, -7.5f), 7.5f);
        }
        const v6u_t pk = __builtin_amdgcn_cvt_scalef32_pk32_fp6_f16(hv, 1.0f);
        unsigned* d0 = (unsigned*)(dst + (size_t)(2 * rp) * TROW + lane * 12);
        unsigned* d1 = (unsigned*)(dst + (size_t)(2 * rp + 1) * TROW + lane * 12);
        d0[0] = pk[0]; d0[1] = pk[1]; d0[2] = pk[2]; d1[0] = pk[3]; d1[1] = pk[4]; d1[2] = pk[5];
        if (lane == 0) { scale[2 * rp] = sc[0]; scale[2 * rp + 1] = sc[1]; }
    }
}

constexpr int TROW4 = 512;
__device__ void ph_tab_fp4(const float* src, unsigned char* dst, float* scale, int nrows, int bid, int nb) {
    const int lane = ltid() & 63, w = __builtin_amdgcn_readfirstlane(ltid() >> 6);
    for (int row = bid * 8 + w; row < nrows; row += nb * 8) {
        const float* sp = src + (size_t)row * DM + lane * 16;
        f32x4 v[4]; float am = 0.f;
#pragma unroll
        for (int i = 0; i < 4; ++i) { v[i] = *(const f32x4*)(sp + i * 4); am = fmaxf(am, fmaxf(fmaxf(fabsf(v[i][0]), fabsf(v[i][1])), fmaxf(fabsf(v[i][2]), fabsf(v[i][3])))); }
        am = wave_max(am);
        const float s = am > 0.f ? am * (1.0f / 6.0f) : 1.0f, inv = 1.0f / s;
        unsigned d0 = 0u, d1 = 0u;
        d0 = __builtin_amdgcn_cvt_scalef32_pk_fp4_f32(d0, v[0][0] * inv, v[0][1] * inv, 1.0f, 0); d0 = __builtin_amdgcn_cvt_scalef32_pk_fp4_f32(d0, v[0][2] * inv, v[0][3] * inv, 1.0f, 1);
        d0 = __builtin_amdgcn_cvt_scalef32_pk_fp4_f32(d0, v[1][0] * inv, v[1][1] * inv, 1.0f, 2); d0 = __builtin_amdgcn_cvt_scalef32_pk_fp4_f32(d0, v[1][2] * inv, v[1][3] * inv, 1.0f, 3);
        d1 = __builtin_amdgcn_cvt_scalef32_pk_fp4_f32(d1, v[2][0] * inv, v[2][1] * inv, 1.0f, 0); d1 = __builtin_amdgcn_cvt_scalef32_pk_fp4_f32(d1, v[2][2] * inv, v[2][3] * inv, 1.0f, 1);
        d1 = __builtin_amdgcn_cvt_scalef32_pk_fp4_f32(d1, v[3][0] * inv, v[3][1] * inv, 1.0f, 2); d1 = __builtin_amdgcn_cvt_scalef32_pk_fp4_f32(d1, v[3][2] * inv, v[3][3] * inv, 1.0f, 3);
        *(u32x2*)(dst + (size_t)row * TROW4 + lane * 8) = (u32x2){d0, d1};
        if (lane == 0) scale[row] = s;
    }
}

#define DPP_ADD(v, ctrl) ((v) + __builtin_bit_cast(float, __builtin_amdgcn_update_dpp(0, __builtin_bit_cast(int, (v)), (ctrl), 0xf, 0xf, true)))
typedef int i32x4_t __attribute__((ext_vector_type(4)));
constexpr int GT = 4;
struct GSet { v6u_t uq[2]; u32x2 vq[4]; float g, su; };
__device__ __forceinline__ void gather_issue(GSet& S, int bt, int lane, int kslot, const unsigned char* pu, const unsigned char* pv,
                                             const LAS int* etok, const LAS float* gtok  ) {
    const i32x4_t ev = *(const LAS i32x4_t*)(etok + bt * 4);
    const int es[4] = {__builtin_amdgcn_readfirstlane(ev.x), __builtin_amdgcn_readfirstlane(ev.y), __builtin_amdgcn_readfirstlane(ev.z), __builtin_amdgcn_readfirstlane(ev.w)};
#pragma unroll
    for (int k = 0; k < 2; ++k) {
        const unsigned e0 = (unsigned)es[2 * k] * (unsigned)TROW + (unsigned)lane * 12u, e1 = (unsigned)es[2 * k + 1] * (unsigned)TROW + (unsigned)lane * 12u;
        const u32x3 a = *(const u32x3*)(pu + e0), c = *(const u32x3*)(pu + e1);
        S.uq[k] = (v6u_t){a.x, a.y, a.z, c.x, c.y, c.z};
        const unsigned f0 = (unsigned)es[2 * k] * (unsigned)TROW4 + (unsigned)lane * 8u, f1 = (unsigned)es[2 * k + 1] * (unsigned)TROW4 + (unsigned)lane * 8u;
        S.vq[2 * k] = *(const u32x2*)(pv + f0); S.vq[2 * k + 1] = *(const u32x2*)(pv + f1);
    }
    S.g = gtok[bt * 4 + kslot]; S.su = gtok[GT * 128 + bt * 4 + kslot];
}
__device__ __forceinline__ void gather_consume(const GSet& S, const unsigned (&hp)[8], float (&acc)[16]) {
    typedef _Float16 h2v_t __attribute__((ext_vector_type(2)));
    float d[4];
#pragma unroll
    for (int k = 0; k < 2; ++k) {
        const v32h_t uf = __builtin_amdgcn_cvt_scalef32_pk32_f16_fp6(S.uq[k], 1.0f);
        float s0 = 0.f, s1 = 0.f;
#pragma unroll
        for (int i = 0; i < 8; ++i) { const h2v_t hh = __builtin_bit_cast(h2v_t, hp[i]);
            const h2v_t ua = {uf[2 * i], uf[2 * i + 1]}, ub = {uf[16 + 2 * i], uf[16 + 2 * i + 1]};
            s0 = __builtin_amdgcn_fdot2(ua, hh, s0, false); s1 = __builtin_amdgcn_fdot2(ub, hh, s1, false); }
        s0 = DPP_ADD(s0, 0xB1); s0 = DPP_ADD(s0, 0x4E); s0 = DPP_ADD(s0, 0x124); s0 = DPP_ADD(s0, 0x128);
        s1 = DPP_ADD(s1, 0xB1); s1 = DPP_ADD(s1, 0x4E); s1 = DPP_ADD(s1, 0x124); s1 = DPP_ADD(s1, 0x128);
        d[2 * k] = s0; d[2 * k + 1] = s1;
    }
    float e2[2], f1;
#pragma unroll
    for (int k = 0; k < 2; ++k) { auto r = __builtin_amdgcn_permlane16_swap(__float_as_uint(d[k]), __float_as_uint(d[k + 2]), false, false); e2[k] = __uint_as_float(r[0]) + __uint_as_float(r[1]); }
    { auto r = __builtin_amdgcn_permlane32_swap(__float_as_uint(e2[0]), __float_as_uint(e2[1]), false, false); f1 = __uint_as_float(r[0]) + __uint_as_float(r[1]); }
    const float cf = S.g * gelu_erf(f1 * S.su);
#pragma unroll
    for (int k = 0; k < 4; ++k) {
        const int r = ((k >> 1) & 1) | ((k & 1) << 1);
        const float c = __builtin_bit_cast(float, __builtin_amdgcn_readlane(__builtin_bit_cast(int, cf), 16 * r));
        const unsigned q0 = S.vq[k].x, q1 = S.vq[k].y;
        const f32x2_t a0 = __builtin_amdgcn_cvt_scalef32_pk_f32_fp4(q0, 1.0f, 0), a1 = __builtin_amdgcn_cvt_scalef32_pk_f32_fp4(q0, 1.0f, 1), a2 = __builtin_amdgcn_cvt_scalef32_pk_f32_fp4(q0, 1.0f, 2), a3 = __builtin_amdgcn_cvt_scalef32_pk_f32_fp4(q0, 1.0f, 3);
        const f32x2_t b0 = __builtin_amdgcn_cvt_scalef32_pk_f32_fp4(q1, 1.0f, 0), b1 = __builtin_amdgcn_cvt_scalef32_pk_f32_fp4(q1, 1.0f, 1), b2 = __builtin_amdgcn_cvt_scalef32_pk_f32_fp4(q1, 1.0f, 2), b3 = __builtin_amdgcn_cvt_scalef32_pk_f32_fp4(q1, 1.0f, 3);
        acc[0] += c * a0[0]; acc[1] += c * a0[1]; acc[2] += c * a1[0]; acc[3] += c * a1[1]; acc[4] += c * a2[0]; acc[5] += c * a2[1]; acc[6] += c * a3[0]; acc[7] += c * a3[1];
        acc[8] += c * b0[0]; acc[9] += c * b0[1]; acc[10] += c * b1[0]; acc[11] += c * b1[1]; acc[12] += c * b2[0]; acc[13] += c * b2[1]; acc[14] += c * b3[0]; acc[15] += c * b3[1];
    }
}
__device__ __forceinline__ void xcd_pace(unsigned* bar, volatile LAS unsigned* st);
constexpr int GNS = 8, GBPS = 32 / GNS, GSHIFT = 11;
constexpr int GATH_LDS_WAVE = GT * 128 * 12;
#define GATH_SEG(J, NJ, nbt) { \
        const LAS int* le_ = lse + (J) * 128; const LAS float* lg_ = lsg + (J) * 128; \
        _Pragma("unroll 1") for (int i_ = 0; i_ < GBPS / 2; ++i_) { \
            gather_issue(B, GBPS * c + 2 * i_ + 1, lane, kslot, pu, pv, le_, lg_); \
            gather_consume(A, hx[J], acc[J]); \
            if (i_ < GBPS / 2 - 1) gather_issue(A, GBPS * c + 2 * i_ + 2, lane, kslot, pu, pv, le_, lg_); \
            else gather_issue(A, (nbt), lane, kslot, pu, pv, lse + (NJ) * 128, lsg + (NJ) * 128); \
            gather_consume(B, hx[J], acc[J]); } }
__device__ void ph_peer_gather(const bf16* h2, const unsigned char* pu, const unsigned char* pv, const float* su, const float* sv,
                               const int* eidx, const float* egate, const float* xin, const float* gate  , float* xout, LAS unsigned char* lds, unsigned* pace_bar, volatile LAS unsigned* pace_st, int bid, int nb) {
    const int lane0 = ltid() & 63, w = __builtin_amdgcn_readfirstlane(ltid() >> 6);
    LAS int* lse = (LAS int*)(lds + w * GATH_LDS_WAVE); LAS float* lsg = (LAS float*)(lds + w * GATH_LDS_WAVE + GT * 128 * 4);
    for (int t0 = (bid * 8 + w) * GT; t0 < MT; t0 += nb * 8 * GT) {
        int lane = lane0; asm volatile("" : "+v"(lane));
        const int row = lane >> 4;
        const int kslot = 2 * (row & 1) + (row >> 1);
        const int b = t0 >> 11;
        unsigned hx[GT][8]; float acc[GT][16];
#pragma unroll
        for (int j = 0; j < GT; ++j) {
            const int t = t0 + j;
            const int e0 = eidx[(size_t)t * 128 + lane], e1 = eidx[(size_t)t * 128 + 64 + lane];
            const float g0 = egate[(size_t)t * 128 + lane], g1 = egate[(size_t)t * 128 + 64 + lane];
            const int k0 = e0 >> GSHIFT, k1 = e1 >> GSHIFT;
            int off = 0, d0 = 0, d1 = 0;
#pragma unroll
            for (int s = 0; s < GNS; ++s) {
                const unsigned long long m0 = __ballot(k0 == s), m1 = __ballot(k1 == s);
                const int r0 = (int)__builtin_amdgcn_mbcnt_hi((unsigned)(m0 >> 32), __builtin_amdgcn_mbcnt_lo((unsigned)m0, 0u));
                const int r1 = (int)__builtin_amdgcn_mbcnt_hi((unsigned)(m1 >> 32), __builtin_amdgcn_mbcnt_lo((unsigned)m1, 0u));
                const int c0 = __builtin_popcountll(m0);
                if (k0 == s) d0 = off + r0;
                if (k1 == s) d1 = off + c0 + r1;
                off += c0 + __builtin_popcountll(m1);
            }
            lse[j * 128 + d0] = e0; lsg[j * 128 + d0] = g0 * sv[e0]; lse[j * 128 + d1] = e1; lsg[j * 128 + d1] = g1 * sv[e1];
            lsg[GT * 128 + j * 128 + d0] = su[e0]; lsg[GT * 128 + j * 128 + d1] = su[e1];
            const u32x4 u0 = *(const u32x4*)(h2 + (size_t)t * DM + lane * 16), u1 = *(const u32x4*)(h2 + (size_t)t * DM + lane * 16 + 8);
#pragma unroll
            for (int i = 0; i < 4; ++i) {
                hx[j][i] = __builtin_bit_cast(unsigned, __builtin_amdgcn_cvt_pkrtz(__uint_as_float(u0[i] << 16), __uint_as_float(u0[i] & 0xffff0000u)));
                hx[j][4 + i] = __builtin_bit_cast(unsigned, __builtin_amdgcn_cvt_pkrtz(__uint_as_float(u1[i] << 16), __uint_as_float(u1[i] & 0xffff0000u)));
            }
#pragma unroll
            for (int i = 0; i < 16; ++i) acc[j][i] = 0.f;
        }
        GSet A, B;
        gather_issue(A, 0, lane, kslot, pu, pv, lse, lsg);
#pragma unroll 1
        for (int c = 0; c < GNS; ++c) {
            if (c == 0) xcd_pace(pace_bar, pace_st);
            GATH_SEG(0, 1, GBPS * c)
            GATH_SEG(1, 2, GBPS * c)
            GATH_SEG(2, 3, GBPS * c)
            GATH_SEG(3, 0, c < GNS - 1 ? GBPS * c + GBPS : 0)
        }
#pragma unroll
        for (int j = 0; j < GT; ++j) {
            const int t = t0 + j;
#pragma unroll
            for (int i = 0; i < 4; ++i) {
                const int cc = lane * 16 + i * 4;
                const f32x4 xi = *(const f32x4*)(xin + (size_t)t * DM + cc), gt = *(const f32x4*)(gate + (size_t)b * 6144 + cc);
                f32x4 o;
#pragma unroll
                for (int e = 0; e < 4; ++e) o[e] = xi[e] + gt[e] * acc[j][i * 4 + e];
                *(f32x4*)(xout + (size_t)t * DM + cc) = o;
            }
        }
    }
}

#define XB_TMO      128
#define XB_XCNT(j)  (256  + 64 * (j))
#define XB_XSUB(j)  (1280 + 64 * (j))
#define XB_XGEN(j)  (2304 + 64 * (j))
#define XB_TOP      3328
#define XB_TOPGEN   3392
#define XCD_BAR_WORDS 3456
#define XB_SPIN_CAP (1u << 18)

__device__ __forceinline__ unsigned xb_ld(unsigned* p)              { return __hip_atomic_load(p, __ATOMIC_RELAXED, __HIP_MEMORY_SCOPE_AGENT); }
__device__ __forceinline__ unsigned xb_add(unsigned* p, unsigned v) { return __hip_atomic_fetch_add(p, v, __ATOMIC_RELAXED, __HIP_MEMORY_SCOPE_AGENT); }
__device__ __forceinline__ unsigned xb_xcc_id() { return (unsigned)__builtin_amdgcn_s_getreg((3 << 11) | 20) & 0xFu; }
#define XB_SPIN(cond, bar) do { unsigned _sp = 0; while (cond) { __builtin_amdgcn_s_sleep(1); \
    if ((++_sp & 255u) == 0u) { if (xb_ld(&(bar)[XB_TMO])) break; if (_sp > XB_SPIN_CAP) { atomicAdd(&(bar)[XB_TMO], 1u); break; } } } } while (0)

struct XcdBarrier {
    unsigned* bar; unsigned x;
    volatile LAS unsigned* st;
};

__device__ __forceinline__ XcdBarrier xcd_barrier_post(unsigned* bar, volatile LAS unsigned* st) {
    XcdBarrier b; b.bar = bar; b.x = xb_xcc_id(); b.st = st;
    if (threadIdx.x == 0) (void)xb_add(&bar[XB_XCNT(b.x)], 1u);
    return b;
}
__device__ __forceinline__ void xcd_barrier_complete(unsigned* bar, unsigned x, unsigned& nloc, unsigned& nx) {
    const unsigned G = gridDim.x * gridDim.y * gridDim.z;
    unsigned sum, cnt, mine, sp = 0u;
    for (;;) {
        sum = 0u; cnt = 0u; mine = 0u;
#pragma unroll
        for (unsigned j = 0; j < 16; ++j) { const unsigned c = xb_ld(&bar[XB_XCNT(j)]); sum += c; cnt += (c > 0u) ? 1u : 0u; mine = (j == x) ? c : mine; }
        if (sum == G) break;
        __builtin_amdgcn_s_sleep(1);
        if ((++sp & 255u) == 0u) { if (xb_ld(&bar[XB_TMO])) break; if (sp > XB_SPIN_CAP) { atomicAdd(&bar[XB_TMO], 1u); break; } }
    }
    nloc = mine > 0u ? mine : 1u; nx = cnt > 0u ? cnt : 1u;
}

__device__ __forceinline__ void xcd_barrier(const XcdBarrier& b) {
    asm volatile("s_waitcnt vmcnt(0)" ::: "memory");
    __syncthreads();
    if (threadIdx.x == 0) {
        unsigned* bar = b.bar;
        __builtin_amdgcn_s_waitcnt(0);
        unsigned nloc = b.st[0], nx = b.st[1];
        if (nloc == 0u) { xcd_barrier_complete(bar, b.x, nloc, nx); b.st[0] = nloc; b.st[1] = nx; }
        const unsigned old = xb_add(&bar[XB_XSUB(b.x)], 1u);
        const unsigned gen = old / nloc;
        if (old + 1u == (gen + 1u) * nloc) {
            __builtin_amdgcn_fence(__ATOMIC_RELEASE, "agent");
            asm volatile("s_waitcnt vmcnt(0)" ::: "memory");
            const unsigned og = xb_add(&bar[XB_TOP], 1u);
            const unsigned tg = og / nx;
            if (og + 1u == (tg + 1u) * nx) xb_add(&bar[XB_TOPGEN], 1u);
            else XB_SPIN(xb_ld(&bar[XB_TOPGEN]) == tg, bar);
            __builtin_amdgcn_fence(__ATOMIC_ACQUIRE, "agent");
            xb_add(&bar[XB_XGEN(b.x)], 1u);
            asm volatile("s_waitcnt vmcnt(0)" ::: "memory");
        } else {
            XB_SPIN(xb_ld(&bar[XB_XGEN(b.x)]) == gen, bar);
            __builtin_amdgcn_fence(__ATOMIC_ACQUIRE, "agent");
            asm volatile("s_waitcnt vmcnt(0)" ::: "memory");
        }
    }
    __syncthreads();
}


#define XB_PACE(j) (3584 + 64 * (j))
__device__ __forceinline__ void xcd_pace(unsigned* bar, volatile LAS unsigned* st) {
    __syncthreads();
    if (threadIdx.x == 0) {
        const unsigned nloc = st[0] ? st[0] : 1u, x = xb_xcc_id(), gen = st[4] + 1u;
        st[4] = gen;
        xb_add(&bar[XB_PACE(x)], 1u);
        unsigned sp = 0;
        while (xb_ld(&bar[XB_PACE(x)]) < gen * nloc) { __builtin_amdgcn_s_sleep(1); if (++sp > (1u << 16)) break; }
    }
    __syncthreads();
}
extern __shared__ __attribute__((aligned(16))) unsigned char dyn_lds[];
#ifndef REP_PREP
#define REP_PREP 1
#endif
#ifndef REP_ATTN
#define REP_ATTN 1
#endif
#ifndef REP_SEL
#define REP_SEL 1
#endif
#ifndef REP_GATH
#define REP_GATH 1
#endif
#ifndef REP_GEMM
#define REP_GEMM 1
#endif
#ifndef REP_ADALN
#define REP_ADALN 1
#endif
constexpr int LDS_BYTES = 147456;

template <class T> __device__ __forceinline__ T* karg(int byte_off) {
    const __attribute__((address_space(4))) char* base = (const __attribute__((address_space(4))) char*)__builtin_amdgcn_kernarg_segment_ptr();
    unsigned long long v = *(const __attribute__((address_space(4))) unsigned long long*)(base + byte_off);
    asm volatile("" : "+s"(v));
    return (T*)(__attribute__((address_space(1))) T*)v;
}
#define KIN(i) karg<const float>(8 * (i))
#define KOUT() karg<float>(168)
#define KWS() karg<unsigned char>(176)
static_assert(sizeof(Params) == 184, "Params layout");
template <class T> __device__ __forceinline__ T* launder(T* p) { size_t off = 0; asm volatile("" : "+s"(off)); return (T*)((unsigned char*)p + off); }
__global__ void __launch_bounds__(NT) mega_fwd(Params p) {
    cg::grid_group grid = cg::this_grid();
    const int bid = blockIdx.x, nb = gridDim.x;
    volatile LAS unsigned* bst = (volatile LAS unsigned*)((LAS unsigned char*)dyn_lds + LDS_BYTES - 64);
    if (ltid() < 16) bst[ltid()] = 0u;
    __syncthreads();
    const XcdBarrier xbar = xcd_barrier_post((unsigned*)(KWS() + WS_BAR), bst);
    for (int rep = 0; rep < REP_PREP; ++rep) {
        unsigned char* ws = KWS();
        float* tile = (float*)dyn_lds;
        ph_transpose(KIN(6), (bf16*)(ws + WS_WIN0), 1024, AB_IN, true, tile, bid, nb);
        ph_transpose(KIN(11), (bf16*)(ws + WS_WIN1), 1024, CD_IN, true, tile, bid, nb);
        ph_transpose(KIN(7), (bf16*)(ws + WS_WO0), 1024, 1024, false, tile, bid, nb);
        ph_transpose(KIN(12), (bf16*)(ws + WS_WO1), 1024, 1024, false, tile, bid, nb);
        ph_transpose(KIN(17), (bf16*)(ws + WS_WQ), 1024, PQ, false, tile, bid, nb);
        ph_transpose(KIN(17) + (size_t)1024 * PQ, (bf16*)(ws + WS_WQ) + (size_t)PQ * 1024, 1024, PQ, false, tile, bid, nb);
        ws = launder(ws);
        ph_tab_fp6(KIN(19), ws + WS_PU, (float*)(ws + WS_PV), 2 * NEXP, bid, nb);
        ph_tab_fp4(KIN(20), ws + WS_PU + 32 * MiB, (float*)(ws + WS_PV + 1 * MiB), 2 * NEXP, bid, nb);
        ws = launder(ws);
        ph_mod(KIN(1), KIN(2), KIN(3), (float*)(ws + WS_MOD), (float*)dyn_lds, bid, nb);
        ph_rope_table((float*)(ws + WS_ROPE), bid, nb);
        for (int i = bid * NT + ltid(); i < NB * 8 * 8 * 64; i += nb * NT) ((float*)(ws + WS_KMEAN))[i] = 0.f;
    }
    grid.sync();
#pragma unroll 1
    for (int layer = 0; layer < 2; ++layer) {
        for (int rep = 0; rep < REP_ADALN; ++rep) {
            unsigned char* ws = KWS(); const float* mod = (const float*)(ws + WS_MOD) + (size_t)layer * 32 * 6144;
            ph_adaln(layer == 0 ? KIN(0) : KOUT(), KIN(4) + layer * DM, mod + 0, mod + 1024, (bf16*)(ws + WS_HY), bid, nb);
        }
        xcd_barrier(xbar);
        for (int rep = 0; rep < REP_GEMM; ++rep) {
            unsigned char* ws = KWS();
            pg8::Gemm g{(const bf16*)(ws + WS_HY), (const bf16*)(ws + (layer == 0 ? WS_WIN0 : WS_WIN1)), MT, layer == 0 ? AB_IN : CD_IN, DM};
            pg8::StaticOrder S; S.init(g.M, g.N, nb, bid);
            pg8::EpiQKV e{(bf16*)(ws + WS_QKV), QKV_LD, (const float*)(ws + WS_ROPE), layer, layer == 0 ? KIN(9) : KIN(13), layer == 0 ? KIN(10) : KIN(14), KIN(15), KIN(16), (float*)(ws + WS_KMEAN)};
            pg8::gemm_phase<pg8::EpiQKV, pg8::StaticOrder, true, true>((LAS unsigned char*)dyn_lds, g, S, e);
        }
        xcd_barrier(xbar);
        for (int rep = 0; rep < REP_ATTN; ++rep) {
            unsigned char* ws = KWS();
            if (layer == 0) ph_attn0((const bf16*)(ws + WS_QKV), KIN(8), (bf16*)(ws + WS_HY), (LAS unsigned char*)dyn_lds, bid, nb);
            else ph_attn1((const bf16*)(ws + WS_QKV), (const float*)(ws + WS_KMEAN), (bf16*)(ws + WS_HY), (LAS unsigned char*)dyn_lds, bid, nb);
        }
        xcd_barrier(xbar);
        for (int rep = 0; rep < REP_GEMM; ++rep) {
            unsigned char* ws = KWS(); const float* mod = (const float*)(ws + WS_MOD) + (size_t)layer * 32 * 6144;
            pg8::Gemm g{(const bf16*)(ws + WS_HY), (const bf16*)(ws + (layer == 0 ? WS_WO0 : WS_WO1)), MT, DM, DM};
            pg8::StaticOrder S; S.init(g.M, g.N, nb, bid); pg8::EpiResid e{layer == 0 ? KIN(0) : KOUT(), (float*)(ws + WS_X1), mod + 2048};
            pg8::gemm_phase<pg8::EpiResid, pg8::StaticOrder, true, true>((LAS unsigned char*)dyn_lds, g, S, e);
        }
        xcd_barrier(xbar);
        for (int rep = 0; rep < REP_ADALN; ++rep) {
            unsigned char* ws = KWS(); const float* mod = (const float*)(ws + WS_MOD) + (size_t)layer * 32 * 6144;
            ph_adaln((const float*)(ws + WS_X1), KIN(5) + layer * DM, mod + 3072, mod + 4096, (bf16*)(ws + WS_QKV), bid, nb);
        }
        xcd_barrier(xbar);
        for (int rep = 0; rep < REP_GEMM; ++rep) {
            unsigned char* ws = KWS();
            pg8::Gemm g{(const bf16*)(ws + WS_QKV), (const bf16*)(ws + WS_WQ) + (size_t)layer * PQ * DM, MT, PQ, DM};
            pg8::StaticOrder S; S.init(g.M, g.N, nb, bid); pg8::EpiStore e{(bf16*)(ws + WS_QKV + 128 * MiB), PQ};
            pg8::gemm_phase<pg8::EpiStore, pg8::StaticOrder, true, true>((LAS unsigned char*)dyn_lds, g, S, e);
        }
        xcd_barrier(xbar);
        for (int rep = 0; rep < REP_SEL; ++rep) {
            unsigned char* ws = KWS();
            ph_peer_select((const bf16*)(ws + WS_QKV + 128 * MiB), KIN(18) + (size_t)layer * 2 * 128 * 128, (int*)(ws + WS_HY), (float*)(ws + WS_HY + 32 * MiB), (LAS unsigned char*)dyn_lds, bid, nb);
        }
        xcd_barrier(xbar);
        for (int rep = 0; rep < REP_GATH; ++rep) {
            unsigned char* ws = KWS(); const float* mod = (const float*)(ws + WS_MOD) + (size_t)layer * 32 * 6144;
            ph_peer_gather((const bf16*)(ws + WS_QKV), ws + WS_PU + (size_t)layer * NEXP * TROW, ws + WS_PU + 32 * MiB + (size_t)layer * NEXP * TROW4,
                           (const float*)(ws + WS_PV) + layer * NEXP, (const float*)(ws + WS_PV + 1 * MiB) + layer * NEXP, (const int*)(ws + WS_HY), (const float*)(ws + WS_HY + 32 * MiB), (const float*)(ws + WS_X1), mod + 5120, KOUT(), (LAS unsigned char*)dyn_lds, (unsigned*)(ws + WS_BAR), bst, bid, nb);
        }
        if (layer == 0) xcd_barrier(xbar);
    }
}

extern "C" void kernel_launch(void* const* d_in, const int* in_sizes, int n_in, void* d_out, int out_size, void* d_ws, size_t ws_size, hipStream_t stream) {
    if (n_in != 21 || ws_size < WS_END) { fprintf(stderr, "kernel_launch: bad args n_in=%d ws=%zu\n", n_in, ws_size); return; }
    static int grid_blocks = 0;
    if (!grid_blocks) {
        int dev = 0, cus = 0, per_cu = 0;
        (void)hipGetDevice(&dev);
        (void)hipDeviceGetAttribute(&cus, hipDeviceAttributeMultiprocessorCount, dev);
        (void)hipFuncSetAttribute((const void*)mega_fwd, hipFuncAttributeMaxDynamicSharedMemorySize, LDS_BYTES);
        (void)hipOccupancyMaxActiveBlocksPerMultiprocessor(&per_cu, (const void*)mega_fwd, NT, LDS_BYTES);
        if (per_cu < 1) { fprintf(stderr, "kernel_launch: occupancy query returned %d\n", per_cu); per_cu = 1; }
        if (per_cu > 1) per_cu = 1;
        grid_blocks = cus * per_cu;
    }
    Params p{};
    for (int i = 0; i < 21; ++i) p.in[i] = (const float*)d_in[i];
    p.out = (float*)d_out; p.ws = (unsigned char*)d_ws;
    (void)hipMemsetAsync((char*)d_ws + WS_BAR, 0, 16384, stream);
    void* args[] = {&p};
    hipError_t e = hipLaunchCooperativeKernel((const void*)mega_fwd, dim3(grid_blocks), dim3(NT), args, LDS_BYTES, stream);
    if (e != hipSuccess) fprintf(stderr, "cooperative launch failed: %s (grid %d)\n", hipGetErrorString(e), grid_blocks);
}
```

```cpp
#include <hip/hip_runtime.h>
#ifndef REP_A
#define REP_A 1
#endif
#ifndef REP_B
#define REP_B 1
#endif
#ifndef REP_C
#define REP_C 1
#endif
#ifndef REP_D
#define REP_D 1
#endif
#include <hip/hip_cooperative_groups.h>
namespace cg = cooperative_groups;
#include <cstdio>
#include <cstdint>
#include <cmath>

typedef unsigned short bf16;
typedef short bf16x8 __attribute__((ext_vector_type(8)));
typedef float f32x4 __attribute__((ext_vector_type(4)));
typedef unsigned u32x4 __attribute__((ext_vector_type(4)));
typedef unsigned u32x2 __attribute__((ext_vector_type(2)));

constexpr int DM = 1024, NB = 32, SQ = 2048, MT = NB * SQ;
constexpr int HD = 64;
constexpr int AB_IN = 2304, CD_IN = 3072, QKV_LD = 3072;
constexpr int NEXP = 16384, PQ = 2048;
constexpr float EPS = 1e-6f;
constexpr int NT = 512;

constexpr size_t MiB = 1u << 20;
constexpr size_t WS_X1 = 0;
constexpr size_t WS_QKV = 256 * MiB;
constexpr size_t WS_HY = 640 * MiB;
constexpr size_t WS_PU = 768 * MiB;
constexpr size_t WS_PV = 832 * MiB;
constexpr size_t WS_WIN0 = 896 * MiB;
constexpr size_t WS_WIN1 = 901 * MiB;
constexpr size_t WS_WO0 = 907 * MiB;
constexpr size_t WS_WO1 = 909 * MiB;
constexpr size_t WS_WQ = 911 * MiB;
constexpr size_t WS_MOD = 919 * MiB;
constexpr size_t WS_ROPE = 921 * MiB;
constexpr size_t WS_KMEAN = 922 * MiB;
constexpr size_t WS_BAR = 923 * MiB;
constexpr size_t WS_END = 924 * MiB;

struct Params {
    const float* in[21];
    float* out;
    unsigned char* ws;
};

__device__ __forceinline__ int ltid() { int t = (int)__builtin_amdgcn_workitem_id_x(); asm volatile("" : "+v"(t)); return t; }
__device__ __forceinline__ float bf2f(unsigned b) { return __uint_as_float(b << 16); }
__device__ __forceinline__ unsigned f2bf(float f) { unsigned u = __float_as_uint(f); return (u + 0x7fffu + ((u >> 16) & 1u)) >> 16; }
__device__ __forceinline__ unsigned pk2(float lo, float hi) { return f2bf(lo) | (f2bf(hi) << 16); }
#define DPPV(v, ctrl) __builtin_bit_cast(float, __builtin_amdgcn_update_dpp(0, __builtin_bit_cast(int, (v)), (ctrl), 0xf, 0xf, true))
__device__ __forceinline__ float row16_sum(float v) { v += DPPV(v, 0xB1); v += DPPV(v, 0x4E); v += DPPV(v, 0x124); v += DPPV(v, 0x128); return v; }
__device__ __forceinline__ float rows_sum(float v) {
    { auto r = __builtin_amdgcn_permlane16_swap(__float_as_uint(v), __float_as_uint(v), false, false); v = __uint_as_float(r[0]) + __uint_as_float(r[1]); }
    { auto r = __builtin_amdgcn_permlane32_swap(__float_as_uint(v), __float_as_uint(v), false, false); v = __uint_as_float(r[0]) + __uint_as_float(r[1]); }
    return v;
}
__device__ __forceinline__ float wave_sum(float v) { return rows_sum(row16_sum(v)); }
__device__ __forceinline__ float wave_max(float v) {
    v = fmaxf(v, DPPV(v, 0xB1)); v = fmaxf(v, DPPV(v, 0x4E)); v = fmaxf(v, DPPV(v, 0x124)); v = fmaxf(v, DPPV(v, 0x128));
    { auto r = __builtin_amdgcn_permlane16_swap(__float_as_uint(v), __float_as_uint(v), false, false); v = fmaxf(__uint_as_float(r[0]), __uint_as_float(r[1])); }
    { auto r = __builtin_amdgcn_permlane32_swap(__float_as_uint(v), __float_as_uint(v), false, false); v = fmaxf(__uint_as_float(r[0]), __uint_as_float(r[1])); }
    return v;
}
__device__ __forceinline__ float gelu_erf(float x) {
    const float z = x * 0.70710678118654752f, az = fabsf(z);
    const float t = __builtin_amdgcn_rcpf(fmaf(0.3275911f, az, 1.0f));
    float pl = fmaf(t, 1.061405429f, -1.453152027f); pl = fmaf(t, pl, 1.421413741f); pl = fmaf(t, pl, -0.284496736f); pl = fmaf(t, pl, 0.254829592f); pl *= t;
    const float ex = __builtin_amdgcn_exp2f(az * (az * -1.4426950408889634f));
    const float er = copysignf(fmaf(-pl, ex, 1.0f), z);
    const float hx = 0.5f * x;
    return fmaf(hx, er, hx);
}

__device__ __forceinline__ int qkv_logical_col(int p) { return (p & ~255) | (((p >> 5) & 3) << 6) | (((p >> 7) & 1) << 5) | (p & 31); }
__device__ void ph_transpose(const float* W, bf16* Wt, int K, int N, bool permute, float* tile  , int bid, int nb) {
    const int tid = ltid();
    const int nkt = K / 64, nnt = N / 64;
    for (int it = bid; it < nkt * nnt; it += nb) {
        const int k0 = (it / nnt) * 64, n0 = (it % nnt) * 64;
        __syncthreads();
        for (int e = tid; e < 64 * 64; e += NT) { const int r = e >> 6, c = e & 63; const int nl = permute ? qkv_logical_col(n0 + c) : n0 + c; tile[r * 65 + c] = W[(size_t)(k0 + r) * N + nl]; }
        __syncthreads();
        {
            const int n = tid >> 3, k8 = (tid & 7) * 8;
            u32x4 v;
            v.x = pk2(tile[(k8 + 0) * 65 + n], tile[(k8 + 1) * 65 + n]);
            v.y = pk2(tile[(k8 + 2) * 65 + n], tile[(k8 + 3) * 65 + n]);
            v.z = pk2(tile[(k8 + 4) * 65 + n], tile[(k8 + 5) * 65 + n]);
            v.w = pk2(tile[(k8 + 6) * 65 + n], tile[(k8 + 7) * 65 + n]);
            *(u32x4*)(Wt + (size_t)(n0 + n) * K + k0 + k8) = v;
        }
    }
}
__device__ void ph_convert(const float* src, bf16* dst, size_t n, int bid, int nb) {
    const size_t n8 = n / 8;
    for (size_t i = (size_t)bid * NT + ltid(); i < n8; i += (size_t)nb * NT) {
        const f32x4 a = *(const f32x4*)(src + i * 8), b = *(const f32x4*)(src + i * 8 + 4);
        u32x4 v; v.x = pk2(a[0], a[1]); v.y = pk2(a[2], a[3]); v.z = pk2(b[0], b[1]); v.w = pk2(b[2], b[3]);
        *(u32x4*)(dst + i * 8) = v;
    }
}
__device__ void ph_mod(const float* c, const float* ada_w, const float* ada_b, float* mod, float* lds  , int bid, int nb) {
    const int tid = ltid(), lane = tid & 63, w = tid >> 6;
    for (int it = bid; it < 2 * 96; it += nb) {
        const int l = it / 96, j = (it % 96) * 64 + lane;
        float acc[32];
#pragma unroll
        for (int b = 0; b < 32; ++b) acc[b] = 0.f;
        for (int kh = 0; kh < 2; ++kh) {
            __syncthreads();
            for (int e = tid; e < 32 * 512; e += NT) { const int b = e >> 9, k = e & 511; const float cv = c[b * 1024 + kh * 512 + k]; lds[e] = cv / (1.0f + __expf(-cv)); }
            __syncthreads();
            for (int kk = 0; kk < 64; ++kk) {
                const int k = w * 64 + kk;
                const float wv = ada_w[((size_t)l * 1024 + kh * 512 + k) * 6144 + j];
#pragma unroll
                for (int b = 0; b < 32; ++b) acc[b] += lds[b * 512 + k] * wv;
            }
        }
        __syncthreads();
#pragma unroll
        for (int b = 0; b < 32; ++b) lds[(w * 32 + b) * 64 + lane] = acc[b];
        __syncthreads();
        for (int e = tid; e < 32 * 64; e += NT) {
            const int b = e >> 6, jj = e & 63; float s = 0.f;
#pragma unroll
            for (int ww = 0; ww < 8; ++ww) s += lds[(ww * 32 + b) * 64 + jj];
            const int jo = (it % 96) * 64 + jj;
            mod[((size_t)l * 32 + b) * 6144 + jo] = s + ada_b[l * 6144 + jo];
        }
    }
}
__device__ void ph_rope_table(float* rope, int bid, int nb) {
    for (int i = bid * NT + ltid(); i < SQ * 32; i += nb * NT) {
        const int t = i >> 5, f = i & 31;
        const float inv = powf(10000.0f, -(float)f / 32.0f);
        const float ang = (float)t * inv;
        float s, c; sincosf(ang, &s, &c);
        rope[i * 2] = c; rope[i * 2 + 1] = s;
    }
}

#define DPP_ADD0(v, ctrl) ((v) + __builtin_bit_cast(float, __builtin_amdgcn_update_dpp(0, __builtin_bit_cast(int, (v)), (ctrl), 0xf, 0xf, true)))
__device__ void ph_adaln(const float* x, const float* g, const float* mod_shift  , const float* mod_scale, bf16* h, int bid, int nb) {
    const int lane = ltid() & 63, w = __builtin_amdgcn_readfirstlane(ltid() >> 6);
    for (int t0 = (bid * 8 + w) * 4; t0 < MT; t0 += nb * 8 * 4) {
        const int b = t0 >> 11;
        f32x4 v[4][4]; float ss[4];
#pragma unroll
        for (int r = 0; r < 4; ++r) {
            const float* xr = x + (size_t)(t0 + r) * DM;
#pragma unroll
            for (int i = 0; i < 4; ++i) v[r][i] = *(const f32x4*)(xr + i * 256 + lane * 4);
        }
#pragma unroll
        for (int r = 0; r < 4; ++r) {
            float s = 0.f;
#pragma unroll
            for (int i = 0; i < 4; ++i) s += v[r][i][0] * v[r][i][0] + v[r][i][1] * v[r][i][1] + v[r][i][2] * v[r][i][2] + v[r][i][3] * v[r][i][3];
            s = DPP_ADD0(s, 0xB1); s = DPP_ADD0(s, 0x4E); s = DPP_ADD0(s, 0x124); s = DPP_ADD0(s, 0x128);
            { auto q = __builtin_amdgcn_permlane16_swap(__float_as_uint(s), __float_as_uint(s), false, false); s = __uint_as_float(q[0]) + __uint_as_float(q[1]); }
            { auto q = __builtin_amdgcn_permlane32_swap(__float_as_uint(s), __float_as_uint(s), false, false); s = __uint_as_float(q[0]) + __uint_as_float(q[1]); }
            ss[r] = rsqrtf(s * (1.0f / DM) + EPS);
        }
#pragma unroll
        for (int i = 0; i < 4; ++i) {
            const int c = i * 256 + lane * 4;
            const f32x4 gg = *(const f32x4*)(g + c), sc = *(const f32x4*)(mod_scale + (size_t)b * 6144 + c), sh = *(const f32x4*)(mod_shift + (size_t)b * 6144 + c);
            float a[4];
#pragma unroll
            for (int e = 0; e < 4; ++e) a[e] = gg[e] * (1.0f + sc[e]);
#pragma unroll
            for (int r = 0; r < 4; ++r) {
                float y[4];
#pragma unroll
                for (int e = 0; e < 4; ++e) y[e] = v[r][i][e] * ss[r] * a[e] + sh[e];
                u32x2 o; o.x = pk2(y[0], y[1]); o.y = pk2(y[2], y[3]);
                *(u32x2*)(h + (size_t)(t0 + r) * DM + c) = o;
            }
        }
    }
}

namespace pg8 {
#define PG8_LAS __attribute__((address_space(3)))
typedef unsigned short bf16_t;
typedef short bf16x8 __attribute__((ext_vector_type(8)));
constexpr int BM = 256, BK = 64, HALF = 128, HTB = HALF * BK * 2  , STAGE_BYTES = 8 * HTB, NXCD = 8, WGM = 8;

__host__ __device__ __forceinline__ int lds_byte(int r, int c) { const int st = (r >> 4) * 2 + (c >> 5), rr = r & 15, cc = c & 31, ob = rr * 64 + cc * 2; return st * 1024 + (ob ^ (((ob >> 9) & 1) << 5)); }
__host__ __device__ __forceinline__ void stage_rc(int b, int& R, int& C) { const int st = b / 1024, sb = b % 1024, swz = sb ^ (((sb >> 9) & 1) << 5); R = (st >> 1) * 16 + swz / 64; C = (st & 1) * 32 + (swz % 64) / 2; }
__host__ __device__ __forceinline__ int perm32(int rho) { const int n = rho >> 4, i = rho & 15; return 8 * (i >> 2) + 4 * n + (i & 3); }

struct Unit { int pm, pn; };
struct Gemm { const bf16_t* A; const bf16_t* Bt; int M, N, K; };

struct StaticOrder {
    int nM, nN, nwg, G, c;
    __host__ __device__ void init(int M, int N, int G_, int c_) { nM = M / BM; nN = N / BM; nwg = nM * nN; G = G_; c = c_; }
    __host__ __device__ bool next(int i, Unit& u) const {
        const long L = (long)i * G + c; if (L >= nwg) return false;
        int wgid = (int)L; { const int q = nwg / NXCD, r = nwg % NXCD, xcd = wgid % NXCD, off = wgid / NXCD; wgid = (xcd < r ? xcd * (q + 1) : r * (q + 1) + (xcd - r) * q) + off; }
        const int nig = WGM * nN, gid = wgid / nig, fm = gid * WGM, gsz = (nM - fm) < WGM ? (nM - fm) : WGM;
        u.pm = fm + ((wgid % nig) % gsz); u.pn = (wgid % nig) / gsz; return true;
    }
    __device__ __forceinline__ void a_ready(const Unit&) const {}
    __device__ __forceinline__ void done(const Unit&) const {}
};

__device__ __forceinline__ unsigned cvt_pk_bf16(float lo, float hi) { unsigned r; asm volatile("v_cvt_pk_bf16_f32 %0, %1, %2" : "=v"(r) : "v"(lo), "v"(hi)); return r; }

struct EpiStore {
    static constexpr bool PERM = true, AFTER_DRAIN = false;
    bf16_t* O; int ldc;
    __device__ __forceinline__ void operator()(const f32x4 (&acc)[2][2][4][2], const Unit& u, int wr, int wc, int fr_, int fq_) const {
        int fr = fr_, fq = fq_; asm volatile("" : "+v"(fr), "+v"(fq));
        const int row0 = u.pm * BM + wr * 64 + fr, col0 = u.pn * BM + wc * 32 + 8 * fq;
#pragma unroll
        for (int ai = 0; ai < 2; ++ai)
#pragma unroll
            for (int m = 0; m < 4; ++m) { bf16_t* rowp = O + (size_t)(row0 + ai * HALF + m * 16) * ldc + col0;
#pragma unroll
                for (int bj = 0; bj < 2; ++bj) { const f32x4 v0 = acc[ai][bj][m][0], v1 = acc[ai][bj][m][1];
                    u32x4 w; w.x = cvt_pk_bf16(v0[0], v0[1]); w.y = cvt_pk_bf16(v0[2], v0[3]); w.z = cvt_pk_bf16(v1[0], v1[1]); w.w = cvt_pk_bf16(v1[2], v1[3]);
                    *(u32x4*)(rowp + bj * HALF) = w; } }
    }
};
struct EpiQKV {
    static constexpr bool PERM = true, AFTER_DRAIN = false;
    bf16_t* O; int ldc; const float* rope; int layer;
    const float* gq0; const float* gk0;
    const float* gq1; const float* gk1;
    float* kmean;
    __device__ __forceinline__ void operator()(const f32x4 (&acc)[2][2][4][2], const Unit& u, int wr, int wc, int fr_, int fq_) const {
        int fr = fr_, fq = fq_; asm volatile("" : "+v"(fr), "+v"(fq));
        const int hg = 4 * u.pn + wc;
        const float* gain = nullptr; bool km = false;
        if (layer == 0) { if (hg < 8) gain = gq0; else if (hg < 10) gain = gk0; }
        else { if (hg < 8) gain = gq0; else if (hg < 16) gain = gk0; else if (hg >= 24 && hg < 32) gain = gq1; else if (hg >= 32 && hg < 40) { gain = gk1; km = true; } }
        const int row0 = u.pm * BM + wr * 64 + fr, col0 = 64 * hg + 8 * fq;
        float g0[8], g1[8], cs0[8], cs1[8];
#pragma unroll
        for (int e = 0; e < 8; ++e) { g0[e] = gain ? gain[8 * fq + e] : 1.f; g1[e] = gain ? gain[32 + 8 * fq + e] : 1.f; cs0[e] = 0.f; cs1[e] = 0.f; }
#pragma unroll
        for (int ai = 0; ai < 2; ++ai)
#pragma unroll
            for (int m = 0; m < 4; ++m) {
                const int row = row0 + ai * HALF + m * 16;
                float v0[8], v1[8];
#pragma unroll
                for (int e = 0; e < 4; ++e) { v0[e] = acc[ai][0][m][0][e]; v0[4 + e] = acc[ai][0][m][1][e]; v1[e] = acc[ai][1][m][0][e]; v1[4 + e] = acc[ai][1][m][1][e]; }
                if (gain) {
                    float ss = 0.f;
#pragma unroll
                    for (int e = 0; e < 8; ++e) ss += v0[e] * v0[e] + v1[e] * v1[e];
                    ss = rows_sum(ss);
                    const float r = rsqrtf(ss * (1.0f / 64.0f) + 1e-6f);
                    const float* rp = rope + ((size_t)(row & 2047) * 32 + 8 * fq) * 2;
                    const f32x4 t0 = *(const f32x4*)(rp), t1 = *(const f32x4*)(rp + 4), t2 = *(const f32x4*)(rp + 8), t3 = *(const f32x4*)(rp + 12);
                    const float cs[8] = {t0[0], t0[2], t1[0], t1[2], t2[0], t2[2], t3[0], t3[2]}, sn[8] = {t0[1], t0[3], t1[1], t1[3], t2[1], t2[3], t3[1], t3[3]};
#pragma unroll
                    for (int e = 0; e < 8; ++e) { const float y0 = v0[e] * r * g0[e], y1 = v1[e] * r * g1[e]; v0[e] = y0 * cs[e] - y1 * sn[e]; v1[e] = y1 * cs[e] + y0 * sn[e]; }
                }
                u32x4 w0, w1;
                w0.x = cvt_pk_bf16(v0[0], v0[1]); w0.y = cvt_pk_bf16(v0[2], v0[3]); w0.z = cvt_pk_bf16(v0[4], v0[5]); w0.w = cvt_pk_bf16(v0[6], v0[7]);
                w1.x = cvt_pk_bf16(v1[0], v1[1]); w1.y = cvt_pk_bf16(v1[2], v1[3]); w1.z = cvt_pk_bf16(v1[4], v1[5]); w1.w = cvt_pk_bf16(v1[6], v1[7]);
                bf16_t* rowp = O + (size_t)row * ldc + col0;
                *(u32x4*)(rowp) = w0; *(u32x4*)(rowp + 32) = w1;
                if (km) {
#pragma unroll
                    for (int e = 0; e < 8; ++e) { cs0[e] += v0[e]; cs1[e] += v1[e]; }
                }
            }
        if (km) {
#pragma unroll
            for (int e = 0; e < 8; ++e) {
                cs0[e] = row16_sum(cs0[e]); cs1[e] = row16_sum(cs1[e]);
            }
            if (fr == 0) {
                float* kp = kmean + ((size_t)((u.pm >> 3) * 8 + (hg - 32)) * 8 + (u.pm & 7)) * 64 + 8 * fq;
#pragma unroll
                for (int e = 0; e < 8; ++e) { atomicAdd(kp + e, cs0[e] * (1.0f / 256.0f)); atomicAdd(kp + 32 + e, cs1[e] * (1.0f / 256.0f)); }
            }
        }
    }
};
struct EpiResid {
    static constexpr bool PERM = true, AFTER_DRAIN = false;
    const float* xin; float* xout; const float* gate;
    __device__ __forceinline__ void operator()(const f32x4 (&acc)[2][2][4][2], const Unit& u, int wr, int wc, int fr_, int fq_) const {
        int fr = fr_, fq = fq_; asm volatile("" : "+v"(fr), "+v"(fq));
        const int row0 = u.pm * BM + wr * 64 + fr, col0 = u.pn * BM + wc * 32 + 8 * fq;
#pragma unroll
        for (int ai = 0; ai < 2; ++ai)
#pragma unroll
            for (int m = 0; m < 4; ++m) { const int row = row0 + ai * HALF + m * 16; const float* gp = gate + (size_t)(row >> 11) * 6144 + col0;
                const float* xi = xin + (size_t)row * 1024 + col0; float* xo = xout + (size_t)row * 1024 + col0;
#pragma unroll
                for (int bj = 0; bj < 2; ++bj)
#pragma unroll
                    for (int n = 0; n < 2; ++n) { const f32x4 a = acc[ai][bj][m][n], x = *(const f32x4*)(xi + bj * HALF + 4 * n), g = *(const f32x4*)(gp + bj * HALF + 4 * n);
                        f32x4 o; o[0] = x[0] + g[0] * a[0]; o[1] = x[1] + g[1] * a[1]; o[2] = x[2] + g[2] * a[2]; o[3] = x[3] + g[3] * a[3];
                        *(f32x4*)(xo + bj * HALF + 4 * n) = o; } }
    }
};
template <class Epi, class Sched, bool ALIGN_EPI = false, bool SP2 = false>
__device__ __forceinline__ void gemm_phase(PG8_LAS unsigned char* lds, const Gemm g, const Sched& S, const Epi& E) {
    const int tid = ltid(), wid = __builtin_amdgcn_readfirstlane(tid >> 6), lane = tid & 63, wr = wid >> 2, wc = wid & 3, fr = lane & 15, fq = lane >> 4;
    const int K = g.K, nt = K / BK;
    unsigned voffA[2], voffB[2];
#pragma unroll
    for (int i = 0; i < 2; ++i) { int R, C; stage_rc(tid * 16 + i * 8192, R, C); const int Rb = Epi::PERM ? ((R & ~31) + perm32(R & 31)) : R;
        voffA[i] = (unsigned)(R * K + C) * 2u; voffB[i] = (unsigned)(Rb * K + C) * 2u; }
    const size_t kstep = (size_t)(BK * 2);
    const size_t hstep = (size_t)HALF * K * 2;
    const size_t tstep = 2 * hstep;
    const unsigned ldsw = (unsigned)wid * 1024u;
    const int aoff = lds_byte(wr * 64 + fr, fq * 8), boff = lds_byte(wc * 32 + fr, fq * 8);
#define PG8_SA(b, h) (((b) * 2 + (h)) * HTB)
#define PG8_SB(b, h) ((4 + (b) * 2 + (h)) * HTB)
#define PG8_STAGE(bufoff, gbase, voff) do { _Pragma("unroll") for (int _i = 0; _i < 2; ++_i) \
        __builtin_amdgcn_global_load_lds((const unsigned*)((const char*)(gbase) + (voff)[_i]), (PG8_LAS unsigned*)(lds + (bufoff) + ldsw + _i * 8192), 16, 0, 0); } while (0)
#define PG8_LDA(dst, b, h) do { _Pragma("unroll") for (int m = 0; m < 4; ++m) _Pragma("unroll") for (int k = 0; k < 2; ++k) dst[m][k] = *(const PG8_LAS bf16x8*)(lds + PG8_SA(b, h) + aoff + m * 2048 + k * 1024); } while (0)
#define PG8_LDB(dst, b, h) do { _Pragma("unroll") for (int n = 0; n < 2; ++n) _Pragma("unroll") for (int k = 0; k < 2; ++k) dst[n][k] = *(const PG8_LAS bf16x8*)(lds + PG8_SB(b, h) + boff + n * 2048 + k * 1024); } while (0)
#define PG8_MMA(ai, bj, At, Bt) do { __builtin_amdgcn_s_setprio(1); _Pragma("unroll") for (int m = 0; m < 4; ++m) _Pragma("unroll") for (int n = 0; n < 2; ++n) _Pragma("unroll") for (int k = 0; k < 2; ++k) \
        acc[ai][bj][m][n] = __builtin_amdgcn_mfma_f32_16x16x32_bf16(Bt[n][k], At[m][k], acc[ai][bj][m][n], 0, 0, 0); __builtin_amdgcn_s_setprio(0); } while (0)
#define PG8_WAIT_V(n) asm volatile("s_waitcnt vmcnt(" #n ")" ::: "memory")
#define PG8_WAIT_L(n) asm volatile("s_waitcnt lgkmcnt(" #n ")" ::: "memory")
#define PG8_BAR __builtin_amdgcn_s_barrier()
#define PG8_SCHED __builtin_amdgcn_sched_barrier(0)
    Unit cur, nxt; int ui = 0;
    if (!S.next(0, cur)) return;
    f32x4 acc[2][2][4][2];
#pragma unroll
    for (int a = 0; a < 2; ++a)
#pragma unroll
        for (int b = 0; b < 2; ++b)
#pragma unroll
            for (int m = 0; m < 4; ++m)
#pragma unroll
                for (int n = 0; n < 2; ++n) acc[a][b][m][n] = (f32x4){0.f, 0.f, 0.f, 0.f};
    bf16x8 At[4][2], B0[2][2], B1[2][2];
    const char* cA = (const char*)g.A + (size_t)cur.pm * tstep; const char* cB = (const char*)g.Bt + (size_t)cur.pn * tstep;
    S.a_ready(cur);
    if constexpr (SP2) {
        PG8_STAGE(PG8_SB(0, 0), cB, voffB); PG8_STAGE(PG8_SB(0, 1), cB + hstep, voffB); PG8_STAGE(PG8_SA(0, 0), cA, voffA); PG8_STAGE(PG8_SA(0, 1), cA + hstep, voffA);
        if (wr == 1) PG8_BAR;
        PG8_WAIT_V(2); PG8_BAR;
        PG8_STAGE(PG8_SB(1, 0), cB + kstep, voffB); PG8_STAGE(PG8_SA(1, 0), cA + kstep, voffA); PG8_STAGE(PG8_SB(1, 1), cB + hstep + kstep, voffB);
        PG8_WAIT_V(6); PG8_BAR;
    } else {
        PG8_STAGE(PG8_SB(0, 0), cB, voffB); PG8_STAGE(PG8_SA(0, 0), cA, voffA); PG8_STAGE(PG8_SB(0, 1), cB + hstep, voffB); PG8_STAGE(PG8_SA(0, 1), cA + hstep, voffA);
        if (wr == 1) PG8_BAR;
        PG8_WAIT_V(4); PG8_BAR;
        PG8_STAGE(PG8_SB(1, 0), cB + kstep, voffB); PG8_STAGE(PG8_SA(1, 0), cA + kstep, voffA); PG8_STAGE(PG8_SB(1, 1), cB + hstep + kstep, voffB);
        PG8_WAIT_V(6); PG8_BAR;
    }
    for (;;) {
        const bool has_next = S.next(ui + 1, nxt);
        const char* nA = has_next ? (const char*)g.A + (size_t)nxt.pm * tstep : cA; const char* nB = has_next ? (const char*)g.Bt + (size_t)nxt.pn * tstep : cB;
        for (int t = 0; t < nt; t += 2) {
            const bool last = (t == nt - 2);
            const char* a1 = cA + (size_t)(t + 1) * kstep;
            const char* a2 = last ? nA : cA + (size_t)(t + 2) * kstep; const char* b2 = last ? nB : cB + (size_t)(t + 2) * kstep;
            const char* a3 = a2 + kstep; const char* b3 = b2 + kstep;
            if (last && has_next) S.a_ready(nxt);
            if constexpr (SP2) {
            PG8_LDB(B0, 0, 0); PG8_LDB(B1, 0, 1); PG8_SCHED; PG8_LDA(At, 0, 0); PG8_STAGE(PG8_SA(1, 1), a1 + hstep, voffA);
            PG8_WAIT_V(8); PG8_WAIT_L(0); PG8_BAR; PG8_MMA(0, 0, At, B0); PG8_MMA(0, 1, At, B1); PG8_BAR; PG8_SCHED;
            PG8_LDA(At, 0, 1); PG8_STAGE(PG8_SB(0, 0), b2, voffB); PG8_STAGE(PG8_SB(0, 1), b2 + hstep, voffB); PG8_STAGE(PG8_SA(0, 0), a2, voffA);
            PG8_WAIT_V(8); PG8_WAIT_L(0); PG8_BAR; PG8_MMA(1, 0, At, B0); PG8_MMA(1, 1, At, B1); PG8_BAR; PG8_SCHED;
            PG8_LDB(B0, 1, 0); PG8_LDB(B1, 1, 1); PG8_SCHED; PG8_LDA(At, 1, 0); PG8_STAGE(PG8_SA(0, 1), a2 + hstep, voffA);
            PG8_WAIT_V(8); PG8_WAIT_L(0); PG8_BAR; PG8_MMA(0, 0, At, B0); PG8_MMA(0, 1, At, B1); PG8_BAR; PG8_SCHED;
            PG8_LDA(At, 1, 1); PG8_STAGE(PG8_SB(1, 0), b3, voffB); PG8_STAGE(PG8_SB(1, 1), b3 + hstep, voffB); PG8_STAGE(PG8_SA(1, 0), a3, voffA);
            PG8_WAIT_V(8); PG8_WAIT_L(0); PG8_BAR; PG8_MMA(1, 0, At, B0); PG8_MMA(1, 1, At, B1); PG8_BAR; PG8_SCHED;
            } else {
            PG8_LDB(B0, 0, 0); PG8_SCHED; PG8_LDA(At, 0, 0); PG8_STAGE(PG8_SA(1, 1), a1 + hstep, voffA);
            PG8_WAIT_L(8); PG8_BAR; PG8_WAIT_L(0); PG8_MMA(0, 0, At, B0); PG8_BAR; PG8_SCHED;
            PG8_LDB(B1, 0, 1); PG8_STAGE(PG8_SB(0, 0), b2, voffB);
            PG8_BAR; PG8_WAIT_L(0); PG8_MMA(0, 1, At, B1); PG8_BAR;
            PG8_LDA(At, 0, 1); PG8_STAGE(PG8_SA(0, 0), a2, voffA);
            PG8_BAR; PG8_WAIT_L(0); PG8_MMA(1, 0, At, B0); PG8_BAR; PG8_SCHED;
            PG8_STAGE(PG8_SB(0, 1), b2 + hstep, voffB);
            PG8_WAIT_V(6); PG8_BAR; PG8_MMA(1, 1, At, B1); PG8_BAR;
            PG8_LDB(B0, 1, 0); PG8_SCHED; PG8_LDA(At, 1, 0); PG8_STAGE(PG8_SA(0, 1), a2 + hstep, voffA);
            PG8_WAIT_L(8); PG8_BAR; PG8_WAIT_L(0); PG8_MMA(0, 0, At, B0); PG8_BAR; PG8_SCHED;
            PG8_LDB(B1, 1, 1); PG8_STAGE(PG8_SB(1, 0), b3, voffB);
            PG8_BAR; PG8_WAIT_L(0); PG8_MMA(0, 1, At, B1); PG8_BAR;
            PG8_LDA(At, 1, 1); PG8_STAGE(PG8_SA(1, 0), a3, voffA);
            PG8_BAR; PG8_WAIT_L(0); PG8_MMA(1, 0, At, B0); PG8_BAR; PG8_SCHED;
            PG8_STAGE(PG8_SB(1, 1), b3 + hstep, voffB);
            PG8_WAIT_V(6); PG8_BAR; PG8_MMA(1, 1, At, B1); PG8_BAR;
            }
        }
        if constexpr (ALIGN_EPI) { if (wr == 0) PG8_BAR; }
        if constexpr (!Epi::AFTER_DRAIN) { E(acc, cur, wr, wc, fr, fq); S.done(cur); }
        if (!has_next) break;
#pragma unroll
        for (int a = 0; a < 2; ++a)
#pragma unroll
            for (int b = 0; b < 2; ++b)
#pragma unroll
                for (int m = 0; m < 4; ++m)
#pragma unroll
                    for (int n = 0; n < 2; ++n) acc[a][b][m][n] = (f32x4){0.f, 0.f, 0.f, 0.f};
        cur = nxt; cA = nA; cB = nB; ++ui;
        if constexpr (ALIGN_EPI) { if (wr == 1) PG8_BAR; }
    }
    PG8_WAIT_V(0);
    if constexpr (!ALIGN_EPI) { if (wr == 0) PG8_BAR; }
    PG8_BAR;
    if constexpr (Epi::AFTER_DRAIN) { E.fused(acc, cur, wr, wc, fr, fq, lds, wid, lane); S.done(cur); }
#undef PG8_SA
#undef PG8_SB
#undef PG8_STAGE
#undef PG8_LDA
#undef PG8_LDB
#undef PG8_MMA
#undef PG8_WAIT_V
#undef PG8_WAIT_L
#undef PG8_BAR
#undef PG8_SCHED
}
}

typedef float f32x16 __attribute__((ext_vector_type(16)));
typedef short s16x4 __attribute__((ext_vector_type(4)));
typedef short v4i16_t __attribute__((ext_vector_type(4)));
typedef float f32x2_t __attribute__((ext_vector_type(2)));
typedef __bf16 bf16x2_t __attribute__((ext_vector_type(2)));
#define LAS __attribute__((address_space(3)))
constexpr int VROW = 144, VBUF = 32 * VROW;
constexpr int VROWV = 192, VBUFV = 32 * VROWV;
constexpr float L2E = 1.4426950408889634f, LN2 = 0.6931471805599453f;
constexpr float SC2 = 0.125f * L2E;

__device__ __forceinline__ int crow(int r, int hi) { return (r & 3) + 8 * (r >> 2) + 4 * hi; }
__device__ __forceinline__ unsigned cvtpk(float lo, float hi) { f32x2_t v = {lo, hi}; bf16x2_t b = __builtin_convertvector(v, bf16x2_t); return __builtin_bit_cast(unsigned, b); }
__device__ __forceinline__ float xhalf(float v, int hi) {
    auto r = __builtin_amdgcn_permlane32_swap(__float_as_uint(v), __float_as_uint(v), false, false);
    return __uint_as_float(hi ? r[0] : r[1]);
}
__device__ __forceinline__ s16x4 vtr(const LAS unsigned char* p) { return __builtin_bit_cast(s16x4, __builtin_amdgcn_ds_read_tr16_b64_v4i16((LAS v4i16_t*)p)); }

struct KVRegs { u32x4 k[4]; u32x4 v[4]; };
__device__ __forceinline__ void load_kv(KVRegs& R, const bf16* base, int kp0, int kst, int kcol, int vcol, int lane) {
#pragma unroll
    for (int j = 0; j < 4; ++j) {
        const int pos = kp0 + kst * (8 * j + (lane >> 3));
        const int pc = pos < SQ - 1 ? pos : SQ - 1;
        const bf16* rp = base + (size_t)pc * QKV_LD + (lane & 7) * 8;
        R.k[j] = *(const u32x4*)(rp + kcol); R.v[j] = *(const u32x4*)(rp + vcol);
    }
}
__device__ __forceinline__ void kv_stage(const KVRegs& R, LAS unsigned char* klds, LAS unsigned char* vlds, int lane) {
#pragma unroll
    for (int j = 0; j < 4; ++j) { const int r_ = 8 * j + (lane >> 3), c_ = (lane & 7) * 16; *(LAS u32x4*)(klds + r_ * VROW + c_) = R.k[j]; *(LAS u32x4*)(vlds + r_ * VROWV + c_) = R.v[j]; }
}
__device__ __forceinline__ f32x16 qk_tile(const LAS unsigned char* klds, const bf16x8 (&qf)[4], int r32, int hi) {
    f32x16 s = {0.f, 0.f, 0.f, 0.f, 0.f, 0.f, 0.f, 0.f, 0.f, 0.f, 0.f, 0.f, 0.f, 0.f, 0.f, 0.f};
#pragma unroll
    for (int k = 0; k < 4; ++k) { const bf16x8 kf = *(const LAS bf16x8*)(klds + r32 * VROW + (2 * k + hi) * 16); s = __builtin_amdgcn_mfma_f32_32x32x16_bf16(kf, qf[k], s, 0, 0, 0); }
    return s;
}
__device__ __forceinline__ void pv_tile(f32x16 (&o)[2], const f32x16& p, const LAS unsigned char* vlds, int lane) {
    const int g = lane >> 4, i = lane & 15, h = lane >> 5;
    const LAS unsigned char* vb = vlds + (4 * h + (i >> 2)) * VROWV + (16 * (g & 1) + 4 * (i & 3)) * 2;
#pragma unroll
    for (int s = 0; s < 2; ++s) {
        u32x4 pw; pw.x = cvtpk(p[8 * s], p[8 * s + 1]); pw.y = cvtpk(p[8 * s + 2], p[8 * s + 3]); pw.z = cvtpk(p[8 * s + 4], p[8 * s + 5]); pw.w = cvtpk(p[8 * s + 6], p[8 * s + 7]);
        const bf16x8 pb = __builtin_bit_cast(bf16x8, pw);
#pragma unroll
        for (int df = 0; df < 2; ++df) {
            const s16x4 lo = vtr(vb + (16 * s) * VROWV + df * 64), hh = vtr(vb + (16 * s + 8) * VROWV + df * 64);
            const bf16x8 va = (bf16x8){lo[0], lo[1], lo[2], lo[3], hh[0], hh[1], hh[2], hh[3]};
            o[df] = __builtin_amdgcn_mfma_f32_32x32x16_bf16(va, pb, o[df], 0, 0, 0);
        }
    }
}
__device__ __forceinline__ void load_q(bf16x8 (&qf)[4], const bf16* base, int qpos, int qcol, int hi) {
    const bf16* rp = base + (size_t)qpos * QKV_LD + qcol + 8 * hi;
#pragma unroll
    for (int k = 0; k < 4; ++k) qf[k] = *(const bf16x8*)(rp + 16 * k);
}
__device__ __forceinline__ void store_o(bf16* yrow, const f32x16 (&o)[2], float inv, int hi) {
#pragma unroll
    for (int df = 0; df < 2; ++df)
#pragma unroll
        for (int g = 0; g < 4; ++g) {
            u32x2 w; w.x = cvtpk(o[df][4 * g] * inv, o[df][4 * g + 1] * inv); w.y = cvtpk(o[df][4 * g + 2] * inv, o[df][4 * g + 3] * inv);
            *(u32x2*)(yrow + 32 * df + 8 * g + 4 * hi) = w;
        }
}
__device__ __forceinline__ void osm_tile(f32x16& s, float& m, float& l, f32x16 (&o)[2]) {
    float mx = s[0];
#pragma unroll
    for (int r = 1; r < 16; ++r) mx = fmaxf(mx, s[r]);
    { auto rr = __builtin_amdgcn_permlane32_swap(__float_as_uint(mx), __float_as_uint(mx), false, false); mx = fmaxf(__uint_as_float(rr[0]), __uint_as_float(rr[1])); }
    const float mn = fmaxf(m, mx);
    const float ms = (mn == -INFINITY) ? 0.f : mn;
    const float alpha = __builtin_amdgcn_exp2f((m - ms) * SC2);
    const float mc = ms * SC2;
    float ps = 0.f;
#pragma unroll
    for (int r = 0; r < 16; ++r) { s[r] = __builtin_amdgcn_exp2f(s[r] * SC2 - mc); ps += s[r]; }
    l = l * alpha + ps; m = mn;
    if (!__all(alpha == 1.0f)) {
#pragma unroll
        for (int df = 0; df < 2; ++df)
#pragma unroll
            for (int r = 0; r < 16; ++r) o[df][r] *= alpha;
    }
}
__device__ __forceinline__ void osm_tile2(f32x16& s0, f32x16& s1, float& m, float& l, f32x16 (&o)[2]) {
    float mx = fmaxf(s0[0], s1[0]);
#pragma unroll
    for (int r = 1; r < 16; ++r) mx = fmaxf(mx, fmaxf(s0[r], s1[r]));
    { auto rr = __builtin_amdgcn_permlane32_swap(__float_as_uint(mx), __float_as_uint(mx), false, false); mx = fmaxf(__uint_as_float(rr[0]), __uint_as_float(rr[1])); }
    const float mn = fmaxf(m, mx);
    const float ms = (mn == -INFINITY) ? 0.f : mn;
    const float alpha = __builtin_amdgcn_exp2f((m - ms) * SC2);
    const float mc = ms * SC2;
    float ps0 = 0.f, ps1 = 0.f;
#pragma unroll
    for (int r = 0; r < 16; ++r) { s0[r] = __builtin_amdgcn_exp2f(s0[r] * SC2 - mc); ps0 += s0[r]; s1[r] = __builtin_amdgcn_exp2f(s1[r] * SC2 - mc); ps1 += s1[r]; }
    l = l * alpha + (ps0 + ps1); m = mn;
    if (!__all(alpha == 1.0f)) {
#pragma unroll
        for (int df = 0; df < 2; ++df)
#pragma unroll
            for (int r = 0; r < 16; ++r) o[df][r] *= alpha;
    }
}
#define ZERO16 {0.f, 0.f, 0.f, 0.f, 0.f, 0.f, 0.f, 0.f, 0.f, 0.f, 0.f, 0.f, 0.f, 0.f, 0.f, 0.f}

struct AttnCtx {
    const bf16* base; int kcol, vcol, r32, hi, lane; LAS unsigned char* vlds; LAS unsigned char* klds; bf16x8 qf[4]; f32x16 o[2];
};
#define ATTN_STEP(SC, SL, T) { \
        if (SYNC) __builtin_amdgcn_s_barrier(); \
        { int kp_, ks_; const int tl_ = (T) + 2 < nt ? (T) + 2 : nt - 1; mx.pos(tl_, kp_, ks_); load_kv(SL, c.base, kp_, ks_, c.kcol, c.vcol, c.lane); } \
        kv_stage(SC, c.klds, c.vlds, c.lane); f32x16 s_ = qk_tile(c.klds, c.qf, c.r32, c.hi); \
        const bool stop_ = mx.process((T), s_, c); pv_tile(c.o, s_, c.vlds, c.lane); \
        if ((!SYNC && stop_) || (T) + 1 >= nt) break; }
template <class M, bool SYNC> __device__ __forceinline__ void attn_run(M& mx, AttnCtx& c) {
    const int nt = mx.nt;
    KVRegs S0, S1, S2;
    { int kp, ks; mx.pos(0, kp, ks); load_kv(S0, c.base, kp, ks, c.kcol, c.vcol, c.lane);
      mx.pos(1 < nt ? 1 : nt - 1, kp, ks); load_kv(S1, c.base, kp, ks, c.kcol, c.vcol, c.lane); }
    for (int t = 0;; t += 3) {
        ATTN_STEP(S0, S2, t)
        ATTN_STEP(S1, S0, t + 1)
        ATTN_STEP(S2, S1, t + 2)
    }
}
#define SH_BAR() asm volatile("s_waitcnt lgkmcnt(0)\n\ts_barrier" ::: "memory")
constexpr int SLOT_K = 64 * VROW, SLOT_BYTES = 64 * VROW + 64 * VROWV;
struct ShRegs { u32x4 a, b; };
__device__ __forceinline__ void sh_load(ShRegs& R, const bf16* base, int kp0, int kcol, int vcol, int w, int lane) {
    const int pos = kp0 + 4 * w + ((lane & 31) >> 3);
    const int pa = pos < SQ - 1 ? pos : SQ - 1, pb = pos + 32 < SQ - 1 ? pos + 32 : SQ - 1;
    const int col = ((lane >> 5) ? vcol : kcol) + (lane & 7) * 8;
    R.a = *(const u32x4*)(base + (size_t)pa * QKV_LD + col); R.b = *(const u32x4*)(base + (size_t)pb * QKV_LD + col);
}
__device__ __forceinline__ void sh_write(LAS unsigned char* slot, const ShRegs& R, int w, int lane) {
    const int row = 4 * w + ((lane & 31) >> 3);
    LAS unsigned char* p = slot + ((lane >> 5) ? SLOT_K + row * VROWV : row * VROW) + (lane & 7) * 16;
    *(LAS u32x4*)p = R.a; *(LAS u32x4*)(p + 32 * ((lane >> 5) ? VROWV : VROW)) = R.b;
}
#define SH_STEP(RW, RL, T) { \
        SH_BAR(); \
        { const int tl_ = (T) + 2 < nt ? (T) + 2 : nt - 1; sh_load(RL, c.base, mx.pos2(tl_), c.kcol, c.vcol, w, c.lane); } \
        sh_write(slots + (((T) + 1) & 1) * SLOT_BYTES, RW, w, c.lane); \
        if (mx.active2((T), w)) { LAS unsigned char* sl_ = slots + ((T) & 1) * SLOT_BYTES; \
            f32x16 s0_ = qk_tile(sl_, c.qf, c.r32, c.hi), s1_ = qk_tile(sl_ + 32 * VROW, c.qf, c.r32, c.hi); mx.process2((T), s0_, s1_, c); \
            pv_tile(c.o, s0_, sl_ + SLOT_K, c.lane); pv_tile(c.o, s1_, sl_ + SLOT_K + 32 * VROWV, c.lane); } \
        if ((T) + 1 >= nt) break; }
template <class M> __device__ __forceinline__ void attn_run_shared(M& mx, AttnCtx& c, LAS unsigned char* slots, int w) {
    const int nt = mx.nt2;
    ShRegs R0, R1, R2;
    sh_load(R0, c.base, mx.pos2(0), c.kcol, c.vcol, w, c.lane);
    sh_load(R1, c.base, mx.pos2(1 < nt ? 1 : nt - 1), c.kcol, c.vcol, w, c.lane);
    SH_BAR();
    sh_write(slots, R0, w, c.lane);
    for (int t = 0;; t += 3) {
        SH_STEP(R1, R2, t)
        SH_STEP(R2, R0, t + 1)
        SH_STEP(R0, R1, t + 2)
    }
}
struct MixA {
    int nt, k00, qpos; float m, l;
    __device__ __forceinline__ void pos(int idx, int& kp0, int& kst) const { kp0 = k00 + 32 * idx; kst = 1; }
    __device__ __forceinline__ bool process(int idx, f32x16& s, AttnCtx& c) {
        const int k0 = k00 + 32 * idx;
#pragma unroll
        for (int r = 0; r < 16; ++r) { const int dist = qpos - (k0 + crow(r, c.hi)); if (dist < 0 || dist > 127) s[r] = -INFINITY; }
        osm_tile(s, m, l, c.o); return false;
    }
};
__device__ void attn_A(const bf16* base, int hq, int q0, float sink, bf16* ybase, LAS unsigned char* vlds, int lane) {
    AttnCtx c; c.base = base; c.r32 = lane & 31; c.hi = lane >> 5; c.lane = lane; c.vlds = vlds; c.klds = vlds + VBUFV; c.kcol = 512 + (hq >> 2) * 64; c.vcol = 640 + (hq >> 2) * 64;
    c.o[0] = (f32x16)ZERO16; c.o[1] = (f32x16)ZERO16;
    MixA mx; mx.qpos = q0 + c.r32; mx.k00 = q0 - 128 > 0 ? q0 - 128 : 0; mx.nt = 5; mx.m = -INFINITY; mx.l = 0.f;
    load_q(c.qf, base, mx.qpos, hq * 64, c.hi);
    attn_run<MixA, true>(mx, c);
    float l = mx.l + xhalf(mx.l, c.hi);
    l += __builtin_amdgcn_exp2f(sink * L2E - mx.m * SC2);
    store_o(ybase + (size_t)mx.qpos * DM + hq * 64, c.o, 1.0f / l, c.hi);
}
struct MixB {
    int nt, q0, qpos; float carry;
    __device__ __forceinline__ void pos(int idx, int& kp0, int& kst) const { kp0 = q0 - 32 * idx; kst = 1; }
    __device__ __forceinline__ bool process(int idx, f32x16& s, AttnCtx& c) {
        const int k0 = q0 - 32 * idx, hi = c.hi;
        float lk[16], G[4], Gp[4];
#pragma unroll
        for (int r = 0; r < 16; ++r) {
            const float z = s[r] * 0.125f;
            const bool valid = (k0 + crow(r, hi)) < qpos;
            const float sp = fmaxf(z, 0.f) + LN2 * __builtin_amdgcn_logf(1.0f + __builtin_amdgcn_exp2f(-fabsf(z) * L2E));
            lk[r] = valid ? -sp : 0.f;
            s[r] = valid ? (z - sp) : -INFINITY;
        }
#pragma unroll
        for (int g = 0; g < 4; ++g) { G[g] = (lk[4 * g] + lk[4 * g + 1]) + (lk[4 * g + 2] + lk[4 * g + 3]); Gp[g] = xhalf(G[g], hi); }
        float above = carry;
#pragma unroll
        for (int g = 3; g >= 0; --g) {
            float off = above + (hi == 0 ? Gp[g] : 0.f);
            s[4 * g + 3] = __builtin_amdgcn_exp2f((s[4 * g + 3] + off) * L2E); off += lk[4 * g + 3];
            s[4 * g + 2] = __builtin_amdgcn_exp2f((s[4 * g + 2] + off) * L2E); off += lk[4 * g + 2];
            s[4 * g + 1] = __builtin_amdgcn_exp2f((s[4 * g + 1] + off) * L2E); off += lk[4 * g + 1];
            s[4 * g + 0] = __builtin_amdgcn_exp2f((s[4 * g + 0] + off) * L2E);
            above += G[g] + Gp[g];
        }
        carry = above;
        return __all(carry < -40.0f) != 0;
    }
};
__device__ void attn_B(const bf16* base, int h, int q0, bf16* ybase, LAS unsigned char* vlds, int lane) {
    AttnCtx c; c.base = base; c.r32 = lane & 31; c.hi = lane >> 5; c.lane = lane; c.vlds = vlds; c.klds = vlds + VBUFV; c.kcol = 1280 + h * 64; c.vcol = 1792 + h * 64;
    c.o[0] = (f32x16)ZERO16; c.o[1] = (f32x16)ZERO16;
    MixB mx; mx.q0 = q0; mx.qpos = q0 + c.r32; mx.nt = q0 / 32 + 1; mx.carry = 0.f;
    load_q(c.qf, base, mx.qpos, 768 + h * 64, c.hi);
    attn_run<MixB, false>(mx, c);
    store_o(ybase + (size_t)mx.qpos * DM + 512 + h * 64, c.o, 1.0f, c.hi);
}
struct MixCp {
    int nt, n0, r0, j1lo, qpos; float m, l;
    __device__ __forceinline__ void pos(int t, int& kp0, int& kst) const {
        if (t < n0) { kp0 = r0 + 512 * t; kst = 16; } else { kp0 = (r0 & 3) + 4 * (j1lo + 32 * (t - n0)); kst = 4; }
    }
    __device__ __forceinline__ bool process(int t, f32x16& s, AttnCtx& c) {
        int kp0, kst; pos(t, kp0, kst);
        const int win = t < n0 ? 2048 : 512;
#pragma unroll
        for (int r = 0; r < 16; ++r) { const int dist = qpos - (kp0 + kst * crow(r, c.hi)); if (dist < 0 || dist > win) s[r] = -INFINITY; }
        osm_tile(s, m, l, c.o); return false;
    }
};
struct MixC1 {
    int nt2, p0, qpos; float m, l;
    __device__ __forceinline__ int pos2(int T) const { return p0 + 64 * T; }
    __device__ __forceinline__ bool active2(int T, int w) const { return true; }
    __device__ __forceinline__ void process2(int T, f32x16& s0, f32x16& s1, AttnCtx& c) {
        const int k0 = p0 + 64 * T;
#pragma unroll
        for (int r = 0; r < 16; ++r) { const int dist = qpos - (k0 + crow(r, c.hi)); if (dist < 0 || dist > 128) s0[r] = -INFINITY; if (dist < 32 || dist > 160) s1[r] = -INFINITY; }
        osm_tile2(s0, s1, m, l, c.o);
    }
};
__device__ void attn_C(const bf16* base, int h, int r0, int g, bf16* ybase, LAS unsigned char* vlds, LAS unsigned char* xlds, int w, int lane) {
    AttnCtx c; c.base = base; c.r32 = lane & 31; c.hi = lane >> 5; c.lane = lane; c.vlds = vlds; c.klds = vlds + VBUFV; c.kcol = 512 + h * 64; c.vcol = 1024 + h * 64;
    c.o[0] = (f32x16)ZERO16; c.o[1] = (f32x16)ZERO16;
    const int qpos = r0 + 16 * (32 * g + c.r32);
    load_q(c.qf, base, qpos, h * 64, c.hi);
    MixCp mp; mp.r0 = r0; mp.qpos = qpos; mp.m = -INFINITY; mp.l = 0.f;
    mp.n0 = g + 1;
    mp.j1lo = (r0 >> 2) + 128 * g - 128 > 0 ? (r0 >> 2) + 128 * g - 128 : 0;
    mp.nt = mp.n0 + ((r0 >> 2) + 128 * g + 124 - mp.j1lo) / 32 + 1;
    attn_run<MixCp, true>(mp, c);
    MixC1 m1; m1.qpos = qpos; m1.m = mp.m; m1.l = mp.l;
    const int ra = r0 & 8;
    m1.p0 = 512 * g + ra - 128 > 0 ? 512 * g + ra - 128 : 0;
    m1.nt2 = ((512 * g + ra + 7 + 496 - m1.p0) / 32 + 2) / 2;
    attn_run_shared<MixC1>(m1, c, xlds + 64, w);
    const float l = m1.l + xhalf(m1.l, c.hi);
    store_o(ybase + (size_t)qpos * DM + h * 64, c.o, 1.0f / l, c.hi);
}
struct MixD {
    int nt, nt2, npast, own, q0, qpos; unsigned U, sel; float m, l;
    __device__ __forceinline__ int blk_of(int j) const {
        unsigned u = U; int b = 0;
#pragma unroll
        for (int i = 0; i < 7; ++i) { if (i < j) u &= u - 1u; }
        b = __builtin_ctz(u | 0x100u); return b;
    }
    __device__ __forceinline__ void pos(int t, int& kp0, int& kst) const {
        kst = 1;
        if (t < 8 * npast) kp0 = blk_of(t >> 3) * 256 + (t & 7) * 32; else kp0 = own * 256 + (t - 8 * npast) * 32;
    }
    __device__ __forceinline__ int pos2(int T) const { int kp, ks; pos(2 * T, kp, ks); return kp; }
    __device__ __forceinline__ bool active2(int T, int w) const { return T < 4 * npast || 2 * (T - 4 * npast) <= w; }
    __device__ __forceinline__ void process2(int T, f32x16& s0, f32x16& s1, AttnCtx& c) {
        if (T < 4 * npast) {
            const int blk = blk_of(T >> 2);
            if (!((sel >> blk) & 1u)) {
#pragma unroll
                for (int r = 0; r < 16; ++r) { s0[r] = -INFINITY; s1[r] = -INFINITY; }
            }
        } else {
            const int k0 = own * 256 + (T - 4 * npast) * 64;
#pragma unroll
            for (int r = 0; r < 16; ++r) { const int kk = k0 + crow(r, c.hi); if (kk > qpos) s0[r] = -INFINITY; if (kk + 32 > qpos) s1[r] = -INFINITY; }
        }
        osm_tile2(s0, s1, m, l, c.o);
    }
};
__device__ void attn_D(const bf16* base, const float* kmean  , int h, int q0, bf16* ybase, LAS unsigned char* vlds, LAS unsigned char* xlds, int lane) {
    AttnCtx c; c.base = base; c.r32 = lane & 31; c.hi = lane >> 5; c.lane = lane; c.vlds = vlds; c.klds = vlds + VBUFV; c.kcol = 2048 + h * 64; c.vcol = 2560 + h * 64;
    c.o[0] = (f32x16)ZERO16; c.o[1] = (f32x16)ZERO16;
    const int r32 = c.r32, hi = c.hi, own = q0 >> 8;
    MixD mx; mx.own = own; mx.q0 = q0; mx.qpos = q0 + r32; mx.m = -INFINITY; mx.l = 0.f;
    load_q(c.qf, base, mx.qpos, 1536 + h * 64, hi);
    unsigned sel = 0u;
    if (own > 0) {
        bf16x8 kf[4];
#pragma unroll
        for (int k = 0; k < 4; ++k) {
            u32x4 w = {0u, 0u, 0u, 0u};
            if (r32 < 8) { const float* kp = kmean + r32 * 64 + 16 * k + 8 * hi; const f32x4 a = *(const f32x4*)kp, b = *(const f32x4*)(kp + 4);
                w.x = cvtpk(a[0], a[1]); w.y = cvtpk(a[2], a[3]); w.z = cvtpk(b[0], b[1]); w.w = cvtpk(b[2], b[3]); }
            kf[k] = __builtin_bit_cast(bf16x8, w);
        }
        f32x16 gs = ZERO16;
#pragma unroll
        for (int k = 0; k < 4; ++k) gs = __builtin_amdgcn_mfma_f32_32x32x16_bf16(kf[k], c.qf[k], gs, 0, 0, 0);
        float gt[8];
#pragma unroll
        for (int r = 0; r < 4; ++r) { const float mine = gs[r], oth = xhalf(mine, hi); gt[r] = hi == 0 ? mine : oth; gt[4 + r] = hi == 0 ? oth : mine; }
        const int nsel = own < 3 ? own : 3;
        for (int rr = 0; rr < nsel; ++rr) {
            float best = -INFINITY; int bi = -1;
#pragma unroll
            for (int n = 0; n < 8; ++n) { const bool ok = n < own && !((sel >> n) & 1u) && (bi < 0 || gt[n] > best); if (ok) { best = gt[n]; bi = n; } }
            if (bi >= 0) sel |= 1u << bi;
        }
    }
    unsigned U = 0u;
#pragma unroll
    for (int n = 0; n < 8; ++n) if (__ballot((sel >> n) & 1u) != 0ull) U |= 1u << n;
    {
        volatile LAS unsigned* ux = (volatile LAS unsigned*)xlds;
        __builtin_amdgcn_s_barrier();
        if (lane == 0) ux[(q0 >> 5) & 7] = U;
        asm volatile("s_waitcnt lgkmcnt(0)" ::: "memory");
        __builtin_amdgcn_s_barrier();
        U = ux[0] | ux[1] | ux[2] | ux[3] | ux[4] | ux[5] | ux[6] | ux[7];
        U = __builtin_amdgcn_readfirstlane(U);
    }
    mx.U = U; mx.sel = sel; mx.npast = __builtin_popcount(U); mx.nt = 8 * mx.npast + 8; mx.nt2 = 4 * mx.npast + 4;
    attn_run_shared<MixD>(mx, c, xlds + 64, (q0 >> 5) & 7);
    const float l = mx.l + xhalf(mx.l, c.hi);
    store_o(ybase + (size_t)mx.qpos * DM + 512 + h * 64, c.o, 1.0f / l, hi);
}

__device__ void ph_attn0(const bf16* qkv, const float* sinks, bf16* y, LAS unsigned char* lds, int bid, int nb) {
    const int lane = ltid() & 63, w = __builtin_amdgcn_readfirstlane(ltid() >> 6);
    LAS unsigned char* vlds = lds + w * (VBUF + VBUFV);
    for (int pid = bid; pid < NB * 8; pid += nb) {
        const int b = pid >> 3, h = pid & 7;
        const bf16* base = qkv + (size_t)b * SQ * QKV_LD; bf16* ybase = y + (size_t)b * SQ * DM;
        const float sink = sinks[h];
        for (int rd = 0; rd < 8; ++rd) attn_A(base, h, (rd * 8 + w) * 32, sink, ybase, vlds, lane);
        for (int rd = 0; rd < 8; ++rd) attn_B(base, h, (rd * 8 + w) * 32, ybase, vlds, lane);
    }
}
__device__ void ph_attn1(const bf16* qkv, const float* kmean, bf16* y, LAS unsigned char* lds, int bid, int nb) {
    const int lane = ltid() & 63, w = __builtin_amdgcn_readfirstlane(ltid() >> 6);
    LAS unsigned char* vlds = lds + w * (VBUF + VBUFV);
    for (int pid = bid; pid < NB * 8; pid += nb) {
        const int b = pid >> 3, h = pid & 7;
        const bf16* base = qkv + (size_t)b * SQ * QKV_LD; bf16* ybase = y + (size_t)b * SQ * DM;
        for (int rd = 0; rd < 8; ++rd) { const int it = rd * 8 + w; attn_C(base, h, it & 15, it >> 4, ybase, vlds, lds + 8 * (VBUF + VBUFV), w, lane); }
        for (int rd = 0; rd < 8; ++rd) attn_D(base, kmean + (size_t)pid * 8 * 64, h, (rd * 8 + w) * 32, ybase, vlds, lds + 8 * (VBUF + VBUFV), lane);
    }
}

#define CE_D(a, b) { const float hi_ = fmaxf((a), (b)), lo_ = fminf((a), (b)); (a) = hi_; (b) = lo_; }
#define BSTAGE(arr, k, j) _Pragma("unroll") for (int i_ = 0; i_ < 16; ++i_) { const int l_ = i_ ^ (j); if (l_ > i_) { if ((i_ & (k)) == 0) CE_D(arr[i_], arr[l_]) else CE_D(arr[l_], arr[i_]) } }
__device__ __forceinline__ void bsort16(float (&a)[16]) {
    BSTAGE(a, 2, 1) BSTAGE(a, 4, 2) BSTAGE(a, 4, 1) BSTAGE(a, 8, 4) BSTAGE(a, 8, 2) BSTAGE(a, 8, 1) BSTAGE(a, 16, 8) BSTAGE(a, 16, 4) BSTAGE(a, 16, 2) BSTAGE(a, 16, 1)
}
__device__ __forceinline__ void bmerge16(float (&a)[16]) {
    BSTAGE(a, 16, 8) BSTAGE(a, 16, 4) BSTAGE(a, 16, 2) BSTAGE(a, 16, 1)
}
__device__ __forceinline__ void merge_top16(float (&a)[16], const float (&b)[16]) {
#pragma unroll
    for (int i = 0; i < 16; ++i) a[i] = fmaxf(a[i], b[15 - i]);
    bmerge16(a);
}
__device__ __forceinline__ void xmerge16(float (&a)[16]) {
    {
        float A[16], B[16];
#pragma unroll
        for (int i = 0; i < 16; ++i) { auto r = __builtin_amdgcn_permlane16_swap(__float_as_uint(a[i]), __float_as_uint(a[i]), false, false); A[i] = __uint_as_float(r[0]); B[i] = __uint_as_float(r[1]); }
#pragma unroll
        for (int i = 0; i < 16; ++i) a[i] = fmaxf(A[i], B[15 - i]);
        bmerge16(a);
    }
    {
        float A[16], B[16];
#pragma unroll
        for (int i = 0; i < 16; ++i) { auto r = __builtin_amdgcn_permlane32_swap(__float_as_uint(a[i]), __float_as_uint(a[i]), false, false); A[i] = __uint_as_float(r[0]); B[i] = __uint_as_float(r[1]); }
#pragma unroll
        for (int i = 0; i < 16; ++i) a[i] = fmaxf(A[i], B[15 - i]);
        bmerge16(a);
    }
}
__host__ __device__ constexpr int pair_i(int id) {
    int c = 0;
    for (int i = 0; i < 16; ++i) { const int nj = 16 / (i + 1); if (id < c + nj) return i; c += nj; }
    return 0;
}
__host__ __device__ constexpr int pair_j(int id) {
    int c = 0;
    for (int i = 0; i < 16; ++i) { const int nj = 16 / (i + 1); if (id < c + nj) return id - c; c += nj; }
    return 0;
}
constexpr int SK_ROW = 272;
constexpr int SEL_SK_BYTES = 2 * 128 * SK_ROW;
constexpr int SEL_TAB_OFF = SEL_SK_BYTES;
constexpr int SEL_IDX_OFF = SEL_SK_BYTES + 64;

template <int S> __device__ __forceinline__ float cand_slot(const float (&L1)[16], const float (&L2)[16], int g) {
    constexpr int p0 = S, p1 = 16 + S, p2 = 32 + S, p3 = 48 + S;
    const float c0 = L1[pair_i(p0)] + L2[pair_j(p0)], c1 = L1[pair_i(p1)] + L2[pair_j(p1)], c2 = L1[pair_i(p2)] + L2[pair_j(p2)];
    const float c3 = p3 < 50 ? L1[pair_i(p3 < 50 ? p3 : 0)] + L2[pair_j(p3 < 50 ? p3 : 0)] : -1.0e30f;
    const float c = g == 0 ? c0 : (g == 1 ? c1 : (g == 2 ? c2 : c3));
    return __uint_as_float((__float_as_uint(c) & 0xffffffc0u) | (unsigned)(16 * g + S));
}

__device__ void ph_peer_select(const bf16* qry, const float* subkeys  , int* eidx, float* egate, LAS unsigned char* lds, int bid, int nb) {
    const int tid = ltid(), lane = tid & 63, w = __builtin_amdgcn_readfirstlane(tid >> 6);
    const int tk = lane & 15, g = lane >> 4;
    __syncthreads();
    for (int e = tid; e < 2 * 128 * 128 / 2; e += NT) {
        const int row = e >> 6, c2 = (e & 63) * 2;
        const float a = subkeys[(size_t)row * 128 + c2], b = subkeys[(size_t)row * 128 + c2 + 1];
        *(LAS unsigned*)(lds + row * SK_ROW + c2 * 2) = pk2(a, b);
    }
    if (tid < 64) { int id = tid; int c = 0, pi = 0, pj = 0;
        for (int i = 0; i < 16; ++i) { const int nj = 16 / (i + 1); if (id >= c && id < c + nj) { pi = i; pj = id - c; } c += nj; }
        lds[SEL_TAB_OFF + tid] = (unsigned char)((pi << 4) | pj); }
    __syncthreads();
    LAS unsigned* widx = (LAS unsigned*)(lds + SEL_IDX_OFF + w * 512);
    const LAS unsigned char* widx8 = (const LAS unsigned char*)widx;
    const int nitems = (MT / 16) * 8;
    for (int it = bid * 8 + w; it < nitems; it += nb * 8) {
        const int h = it & 7, t0 = (it >> 3) * 16;
        float L[2][16];
#pragma unroll
        for (int hf = 0; hf < 2; ++hf) {
            bf16x8 qf[4];
            const bf16* qp = qry + (size_t)(t0 + tk) * PQ + h * 256 + hf * 128 + 8 * g;
#pragma unroll
            for (int ks = 0; ks < 4; ++ks) qf[ks] = *(const bf16x8*)(qp + 32 * ks);
            float key[32];
#pragma unroll
            for (int tile = 0; tile < 8; ++tile) {
                f32x4 acc = {0.f, 0.f, 0.f, 0.f};
#pragma unroll
                for (int ks = 0; ks < 4; ++ks) {
                    const bf16x8 af = *(const LAS bf16x8*)(lds + (hf * 128 + tile * 16 + tk) * SK_ROW + (32 * ks + 8 * g) * 2);
                    acc = __builtin_amdgcn_mfma_f32_16x16x32_bf16(af, qf[ks], acc, 0, 0, 0);
                }
#pragma unroll
                for (int r = 0; r < 4; ++r) key[tile * 4 + r] = __uint_as_float((__float_as_uint(acc[r]) & 0xffffff80u) | (unsigned)(16 * tile + 4 * g + r));
            }
            float a[16], b[16];
#pragma unroll
            for (int i = 0; i < 16; ++i) { a[i] = key[i]; b[i] = key[16 + i]; }
            bsort16(a); bsort16(b);
            merge_top16(a, b);
            xmerge16(a);
#pragma unroll
            for (int i = 0; i < 16; ++i) L[hf][i] = a[i];
            unsigned pk = 0u;
#pragma unroll
            for (int s = 0; s < 4; ++s) {
                const float v = g == 0 ? a[s] : (g == 1 ? a[4 + s] : (g == 2 ? a[8 + s] : a[12 + s]));
                pk |= (__float_as_uint(v) & 127u) << (8 * s);
            }
            widx[tk * 8 + hf * 4 + g] = pk;
        }
        float c[16];
        c[0] = cand_slot<0>(L[0], L[1], g); c[1] = cand_slot<1>(L[0], L[1], g); c[2] = cand_slot<2>(L[0], L[1], g); c[3] = cand_slot<3>(L[0], L[1], g);
        c[4] = cand_slot<4>(L[0], L[1], g); c[5] = cand_slot<5>(L[0], L[1], g); c[6] = cand_slot<6>(L[0], L[1], g); c[7] = cand_slot<7>(L[0], L[1], g);
        c[8] = cand_slot<8>(L[0], L[1], g); c[9] = cand_slot<9>(L[0], L[1], g); c[10] = cand_slot<10>(L[0], L[1], g); c[11] = cand_slot<11>(L[0], L[1], g);
        c[12] = cand_slot<12>(L[0], L[1], g); c[13] = cand_slot<13>(L[0], L[1], g); c[14] = cand_slot<14>(L[0], L[1], g); c[15] = cand_slot<15>(L[0], L[1], g);
        bsort16(c);
        xmerge16(c);
        float sum = 0.f, ex[16];
#pragma unroll
        for (int i = 0; i < 16; ++i) { ex[i] = __builtin_amdgcn_exp2f((c[i] - c[0]) * L2E); sum += ex[i]; }
        const float inv = 1.0f / sum;
        int oi[4]; float og[4];
#pragma unroll
        for (int s = 0; s < 4; ++s) {
            const float kv = g == 0 ? c[s] : (g == 1 ? c[4 + s] : (g == 2 ? c[8 + s] : c[12 + s]));
            const float ev = g == 0 ? ex[s] : (g == 1 ? ex[4 + s] : (g == 2 ? ex[8 + s] : ex[12 + s]));
            const unsigned pid = __float_as_uint(kv) & 63u;
            const unsigned ij = lds[SEL_TAB_OFF + pid];
            const unsigned i1 = widx8[tk * 32 + (ij >> 4)], i2 = widx8[tk * 32 + 16 + (ij & 15u)];
            oi[s] = (int)(i1 * 128u + i2); og[s] = ev * inv;
        }
        const size_t ob = (size_t)(t0 + tk) * 128 + h * 16 + 4 * g;
        *(u32x4*)(eidx + ob) = (u32x4){(unsigned)oi[0], (unsigned)oi[1], (unsigned)oi[2], (unsigned)oi[3]};
        *(f32x4*)(egate + ob) = (f32x4){og[0], og[1], og[2], og[3]};
    }
    __syncthreads();
}

typedef float v32f_t __attribute__((ext_vector_type(32)));
typedef unsigned v6u_t __attribute__((ext_vector_type(6)));
typedef unsigned v16u_t __attribute__((ext_vector_type(16)));
typedef __bf16 v32bf_t __attribute__((ext_vector_type(32)));
typedef __bf16 v2bf_t __attribute__((ext_vector_type(2)));
typedef _Float16 v32h_t __attribute__((ext_vector_type(32)));
typedef unsigned u32x3 __attribute__((ext_vector_type(3)));
constexpr int TROW = 768;
__device__ void ph_tab_fp6(const float* src, unsigned char* dst, float* scale, int nrows, int bid, int nb) {
    const int lane = ltid() & 63, w = __builtin_amdgcn_readfirstlane(ltid() >> 6);
    for (int rp = bid * 8 + w; rp < nrows / 2; rp += nb * 8) {
        v32h_t hv; float sc[2];
#pragma unroll
        for (int rr = 0; rr < 2; ++rr) {
            const float* sp = src + (size_t)(2 * rp + rr) * DM + lane * 16;
            f32x4 v[4]; float am = 0.f;
#pragma unroll
            for (int i = 0; i < 4; ++i) { v[i] = *(const f32x4*)(sp + i * 4); am = fmaxf(am, fmaxf(fmaxf(fabsf(v[i][0]), fabsf(v[i][1])), fmaxf(fabsf(v[i][2]), fabsf(v[i][3])))); }
            am = wave_max(am);
            const float s = am > 0.f ? am * (1.0f / 7.5f) : 1.0f, inv = 1.0f / s;
            sc[rr] = s;
#pragma unroll
            for (int i = 0; i < 4; ++i)
#pragma unroll
                for (int e = 0; e < 4; ++e) hv[rr * 16 + i * 4 + e] = (_Float16)fminf(fmaxf(v[i][e] * inv, -7.5f), 7.5f);
        }
        const v6u_t pk = __builtin_amdgcn_cvt_scalef32_pk32_fp6_f16(hv, 1.0f);
        unsigned* d0 = (unsigned*)(dst + (size_t)(2 * rp) * TROW + lane * 12);
        unsigned* d1 = (unsigned*)(dst + (size_t)(2 * rp + 1) * TROW + lane * 12);
        d0[0] = pk[0]; d0[1] = pk[1]; d0[2] = pk[2]; d1[0] = pk[3]; d1[1] = pk[4]; d1[2] = pk[5];
        if (lane == 0) { scale[2 * rp] = sc[0]; scale[2 * rp + 1] = sc[1]; }
    }
}

constexpr int TROW4 = 512;
__device__ void ph_tab_fp4(const float* src, unsigned char* dst, float* scale, int nrows, int bid, int nb) {
    const int lane = ltid() & 63, w = __builtin_amdgcn_readfirstlane(ltid() >> 6);
    for (int row = bid * 8 + w; row < nrows; row += nb * 8) {
        const float* sp = src + (size_t)row * DM + lane * 16;
        f32x4 v[4]; float am = 0.f;
#pragma unroll
        for (int i = 0; i < 4; ++i) { v[i] = *(const f32x4*)(sp + i * 4); am = fmaxf(am, fmaxf(fmaxf(fabsf(v[i][0]), fabsf(v[i][1])), fmaxf(fabsf(v[i][2]), fabsf(v[i][3])))); }
        am = wave_max(am);
        const float s = am > 0.f ? am * (1.0f / 6.0f) : 1.0f, inv = 1.0f / s;
        unsigned d0 = 0u, d1 = 0u;
        d0 = __builtin_amdgcn_cvt_scalef32_pk_fp4_f32(d0, v[0][0] * inv, v[0][1] * inv, 1.0f, 0); d0 = __builtin_amdgcn_cvt_scalef32_pk_fp4_f32(d0, v[0][2] * inv, v[0][3] * inv, 1.0f, 1);
        d0 = __builtin_amdgcn_cvt_scalef32_pk_fp4_f32(d0, v[1][0] * inv, v[1][1] * inv, 1.0f, 2); d0 = __builtin_amdgcn_cvt_scalef32_pk_fp4_f32(d0, v[1][2] * inv, v[1][3] * inv, 1.0f, 3);
        d1 = __builtin_amdgcn_cvt_scalef32_pk_fp4_f32(d1, v[2][0] * inv, v[2][1] * inv, 1.0f, 0); d1 = __builtin_amdgcn_cvt_scalef32_pk_fp4_f32(d1, v[2][2] * inv, v[2][3] * inv, 1.0f, 1);
        d1 = __builtin_amdgcn_cvt_scalef32_pk_fp4_f32(d1, v[3][0] * inv, v[3][1] * inv, 1.0f, 2); d1 = __builtin_amdgcn_cvt_scalef32_pk_fp4_f32(d1, v[3][2] * inv, v[3][3] * inv, 1.0f, 3);
        *(u32x2*)(dst + (size_t)row * TROW4 + lane * 8) = (u32x2){d0, d1};
        if (lane == 0) scale[row] = s;
    }
}

#define DPP_ADD(v, ctrl) ((v) + __builtin_bit_cast(float, __builtin_amdgcn_update_dpp(0, __builtin_bit_cast(int, (v)), (ctrl), 0xf, 0xf, true)))
typedef int i32x4_t __attribute__((ext_vector_type(4)));
constexpr int GT = 4;
struct GSet { v6u_t uq[2]; u32x2 vq[4]; float g, su; };
__device__ __forceinline__ void gather_issue(GSet& S, int bt, int lane, int kslot, const unsigned char* pu, const unsigned char* pv,
                                             const LAS int* etok, const LAS float* gtok  ) {
    const i32x4_t ev = *(const LAS i32x4_t*)(etok + bt * 4);
    const int es[4] = {__builtin_amdgcn_readfirstlane(ev.x), __builtin_amdgcn_readfirstlane(ev.y), __builtin_amdgcn_readfirstlane(ev.z), __builtin_amdgcn_readfirstlane(ev.w)};
#pragma unroll
    for (int k = 0; k < 2; ++k) {
        const unsigned e0 = (unsigned)es[2 * k] * (unsigned)TROW + (unsigned)lane * 12u, e1 = (unsigned)es[2 * k + 1] * (unsigned)TROW + (unsigned)lane * 12u;
        const u32x3 a = *(const u32x3*)(pu + e0), c = *(const u32x3*)(pu + e1);
        S.uq[k] = (v6u_t){a.x, a.y, a.z, c.x, c.y, c.z};
        const unsigned f0 = (unsigned)es[2 * k] * (unsigned)TROW4 + (unsigned)lane * 8u, f1 = (unsigned)es[2 * k + 1] * (unsigned)TROW4 + (unsigned)lane * 8u;
        S.vq[2 * k] = *(const u32x2*)(pv + f0); S.vq[2 * k + 1] = *(const u32x2*)(pv + f1);
    }
    S.g = gtok[bt * 4 + kslot]; S.su = gtok[GT * 128 + bt * 4 + kslot];
}
__device__ __forceinline__ void gather_consume(const GSet& S, const unsigned (&hp)[8], float (&acc)[16]) {
    typedef _Float16 h2v_t __attribute__((ext_vector_type(2)));
    float d[4];
#pragma unroll
    for (int k = 0; k < 2; ++k) {
        const v32h_t uf = __builtin_amdgcn_cvt_scalef32_pk32_f16_fp6(S.uq[k], 1.0f);
        float s0 = 0.f, s1 = 0.f;
#pragma unroll
        for (int i = 0; i < 8; ++i) { const h2v_t hh = __builtin_bit_cast(h2v_t, hp[i]);
            const h2v_t ua = {uf[2 * i], uf[2 * i + 1]}, ub = {uf[16 + 2 * i], uf[16 + 2 * i + 1]};
            s0 = __builtin_amdgcn_fdot2(ua, hh, s0, false); s1 = __builtin_amdgcn_fdot2(ub, hh, s1, false); }
        d[2 * k] = s0; d[2 * k + 1] = s1;
    }
    float e2[2], f1;
#pragma unroll
    for (int k = 0; k < 2; ++k) { auto r = __builtin_amdgcn_permlane16_swap(__float_as_uint(d[k]), __float_as_uint(d[k + 2]), false, false); e2[k] = __uint_as_float(r[0]) + __uint_as_float(r[1]); }
    { auto r = __builtin_amdgcn_permlane32_swap(__float_as_uint(e2[0]), __float_as_uint(e2[1]), false, false); f1 = __uint_as_float(r[0]) + __uint_as_float(r[1]); }
    f1 = DPP_ADD(f1, 0xB1); f1 = DPP_ADD(f1, 0x4E); f1 = DPP_ADD(f1, 0x124); f1 = DPP_ADD(f1, 0x128);
    const float cf = S.g * gelu_erf(f1 * S.su);
#pragma unroll
    for (int k = 0; k < 4; ++k) {
        const int r = ((k >> 1) & 1) | ((k & 1) << 1);
        const float c = __builtin_bit_cast(float, __builtin_amdgcn_readlane(__builtin_bit_cast(int, cf), 16 * r));
        const unsigned q0 = S.vq[k].x, q1 = S.vq[k].y;
        const f32x2_t a0 = __builtin_amdgcn_cvt_scalef32_pk_f32_fp4(q0, 1.0f, 0), a1 = __builtin_amdgcn_cvt_scalef32_pk_f32_fp4(q0, 1.0f, 1), a2 = __builtin_amdgcn_cvt_scalef32_pk_f32_fp4(q0, 1.0f, 2), a3 = __builtin_amdgcn_cvt_scalef32_pk_f32_fp4(q0, 1.0f, 3);
        const f32x2_t b0 = __builtin_amdgcn_cvt_scalef32_pk_f32_fp4(q1, 1.0f, 0), b1 = __builtin_amdgcn_cvt_scalef32_pk_f32_fp4(q1, 1.0f, 1), b2 = __builtin_amdgcn_cvt_scalef32_pk_f32_fp4(q1, 1.0f, 2), b3 = __builtin_amdgcn_cvt_scalef32_pk_f32_fp4(q1, 1.0f, 3);
        acc[0] += c * a0[0]; acc[1] += c * a0[1]; acc[2] += c * a1[0]; acc[3] += c * a1[1]; acc[4] += c * a2[0]; acc[5] += c * a2[1]; acc[6] += c * a3[0]; acc[7] += c * a3[1];
        acc[8] += c * b0[0]; acc[9] += c * b0[1]; acc[10] += c * b1[0]; acc[11] += c * b1[1]; acc[12] += c * b2[0]; acc[13] += c * b2[1]; acc[14] += c * b3[0]; acc[15] += c * b3[1];
    }
}
__device__ __forceinline__ void xcd_pace(unsigned* bar, volatile LAS unsigned* st);
constexpr int GNS = 8, GBPS = 32 / GNS, GSHIFT = 11;
constexpr int GATH_LDS_WAVE = GT * 128 * 12;
#define GATH_SEG(J, NJ, nbt) { \
        const LAS int* le_ = lse + (J) * 128; const LAS float* lg_ = lsg + (J) * 128; \
        _Pragma("unroll 1") for (int i_ = 0; i_ < GBPS / 2; ++i_) { \
            gather_issue(B, GBPS * c + 2 * i_ + 1, lane, kslot, pu, pv, le_, lg_); \
            gather_consume(A, hx[J], acc[J]); \
            if (i_ < GBPS / 2 - 1) gather_issue(A, GBPS * c + 2 * i_ + 2, lane, kslot, pu, pv, le_, lg_); \
            else gather_issue(A, (nbt), lane, kslot, pu, pv, lse + (NJ) * 128, lsg + (NJ) * 128); \
            gather_consume(B, hx[J], acc[J]); } }
__device__ void ph_peer_gather(const bf16* h2, const unsigned char* pu, const unsigned char* pv, const float* su, const float* sv,
                               const int* eidx, const float* egate, const float* xin, const float* gate  , float* xout, LAS unsigned char* lds, unsigned* pace_bar, volatile LAS unsigned* pace_st, int bid, int nb) {
    const int lane0 = ltid() & 63, w = __builtin_amdgcn_readfirstlane(ltid() >> 6);
    LAS int* lse = (LAS int*)(lds + w * GATH_LDS_WAVE); LAS float* lsg = (LAS float*)(lds + w * GATH_LDS_WAVE + GT * 128 * 4);
    for (int t0 = (bid * 8 + w) * GT; t0 < MT; t0 += nb * 8 * GT) {
        int lane = lane0; asm volatile("" : "+v"(lane));
        const int row = lane >> 4;
        const int kslot = 2 * (row & 1) + (row >> 1);
        const int b = t0 >> 11;
        unsigned hx[GT][8]; float acc[GT][16];
#pragma unroll
        for (int j = 0; j < GT; ++j) {
            const int t = t0 + j;
            const int e0 = eidx[(size_t)t * 128 + lane], e1 = eidx[(size_t)t * 128 + 64 + lane];
            const float g0 = egate[(size_t)t * 128 + lane], g1 = egate[(size_t)t * 128 + 64 + lane];
            const int k0 = e0 >> GSHIFT, k1 = e1 >> GSHIFT;
            int off = 0, d0 = 0, d1 = 0;
#pragma unroll
            for (int s = 0; s < GNS; ++s) {
                const unsigned long long m0 = __ballot(k0 == s), m1 = __ballot(k1 == s);
                const int r0 = (int)__builtin_amdgcn_mbcnt_hi((unsigned)(m0 >> 32), __builtin_amdgcn_mbcnt_lo((unsigned)m0, 0u));
                const int r1 = (int)__builtin_amdgcn_mbcnt_hi((unsigned)(m1 >> 32), __builtin_amdgcn_mbcnt_lo((unsigned)m1, 0u));
                const int c0 = __builtin_popcountll(m0);
                if (k0 == s) d0 = off + r0;
                if (k1 == s) d1 = off + c0 + r1;
                off += c0 + __builtin_popcountll(m1);
            }
            lse[j * 128 + d0] = e0; lsg[j * 128 + d0] = g0 * sv[e0]; lse[j * 128 + d1] = e1; lsg[j * 128 + d1] = g1 * sv[e1];
            lsg[GT * 128 + j * 128 + d0] = su[e0]; lsg[GT * 128 + j * 128 + d1] = su[e1];
            const u32x4 u0 = *(const u32x4*)(h2 + (size_t)t * DM + lane * 16), u1 = *(const u32x4*)(h2 + (size_t)t * DM + lane * 16 + 8);
#pragma unroll
            for (int i = 0; i < 4; ++i) {
                hx[j][i] = __builtin_bit_cast(unsigned, __builtin_amdgcn_cvt_pkrtz(__uint_as_float(u0[i] << 16), __uint_as_float(u0[i] & 0xffff0000u)));
                hx[j][4 + i] = __builtin_bit_cast(unsigned, __builtin_amdgcn_cvt_pkrtz(__uint_as_float(u1[i] << 16), __uint_as_float(u1[i] & 0xffff0000u)));
            }
#pragma unroll
            for (int i = 0; i < 16; ++i) acc[j][i] = 0.f;
        }
        GSet A, B;
        gather_issue(A, 0, lane, kslot, pu, pv, lse, lsg);
#pragma unroll 1
        for (int c = 0; c < GNS; ++c) {
            if (c == 0) xcd_pace(pace_bar, pace_st);
            GATH_SEG(0, 1, GBPS * c)
            GATH_SEG(1, 2, GBPS * c)
            GATH_SEG(2, 3, GBPS * c)
            GATH_SEG(3, 0, c < GNS - 1 ? GBPS * c + GBPS : 0)
        }
#pragma unroll
        for (int j = 0; j < GT; ++j) {
            const int t = t0 + j;
#pragma unroll
            for (int i = 0; i < 4; ++i) {
                const int cc = lane * 16 + i * 4;
                const f32x4 xi = *(const f32x4*)(xin + (size_t)t * DM + cc), gt = *(const f32x4*)(gate + (size_t)b * 6144 + cc);
                f32x4 o;
#pragma unroll
                for (int e = 0; e < 4; ++e) o[e] = xi[e] + gt[e] * acc[j][i * 4 + e];
                *(f32x4*)(xout + (size_t)t * DM + cc) = o;
            }
        }
    }
}

#define XB_TMO      128
#define XB_XCNT(j)  (256  + 64 * (j))
#define XB_XSUB(j)  (1280 + 64 * (j))
#define XB_XGEN(j)  (2304 + 64 * (j))
#define XB_TOP      3328
#define XB_TOPGEN   3392
#define XCD_BAR_WORDS 3456
#define XB_SPIN_CAP (1u << 18)

__device__ __forceinline__ unsigned xb_ld(unsigned* p)              { return __hip_atomic_load(p, __ATOMIC_RELAXED, __HIP_MEMORY_SCOPE_AGENT); }
__device__ __forceinline__ unsigned xb_add(unsigned* p, unsigned v) { return __hip_atomic_fetch_add(p, v, __ATOMIC_RELAXED, __HIP_MEMORY_SCOPE_AGENT); }
__device__ __forceinline__ unsigned xb_xcc_id() { return (unsigned)__builtin_amdgcn_s_getreg((3 << 11) | 20) & 0xFu; }
#define XB_SPIN(cond, bar) do { unsigned _sp = 0; while (cond) { __builtin_amdgcn_s_sleep(1); \
    if ((++_sp & 255u) == 0u) { if (xb_ld(&(bar)[XB_TMO])) break; if (_sp > XB_SPIN_CAP) { atomicAdd(&(bar)[XB_TMO], 1u); break; } } } } while (0)

struct XcdBarrier {
    unsigned* bar; unsigned x;
    volatile LAS unsigned* st;
};

__device__ __forceinline__ XcdBarrier xcd_barrier_post(unsigned* bar, volatile LAS unsigned* st) {
    XcdBarrier b; b.bar = bar; b.x = xb_xcc_id(); b.st = st;
    if (threadIdx.x == 0) (void)xb_add(&bar[XB_XCNT(b.x)], 1u);
    return b;
}
__device__ __forceinline__ void xcd_barrier_complete(unsigned* bar, unsigned x, unsigned& nloc, unsigned& nx) {
    const unsigned G = gridDim.x * gridDim.y * gridDim.z;
    unsigned sum, cnt, mine, sp = 0u;
    for (;;) {
        sum = 0u; cnt = 0u; mine = 0u;
#pragma unroll
        for (unsigned j = 0; j < 16; ++j) { const unsigned c = xb_ld(&bar[XB_XCNT(j)]); sum += c; cnt += (c > 0u) ? 1u : 0u; mine = (j == x) ? c : mine; }
        if (sum == G) break;
        __builtin_amdgcn_s_sleep(1);
        if ((++sp & 255u) == 0u) { if (xb_ld(&bar[XB_TMO])) break; if (sp > XB_SPIN_CAP) { atomicAdd(&bar[XB_TMO], 1u); break; } }
    }
    nloc = mine > 0u ? mine : 1u; nx = cnt > 0u ? cnt : 1u;
}

__device__ __forceinline__ void xcd_barrier(const XcdBarrier& b) {
    asm volatile("s_waitcnt vmcnt(0)" ::: "memory");
    __syncthreads();
    if (threadIdx.x == 0) {
        unsigned* bar = b.bar;
        __builtin_amdgcn_s_waitcnt(0);
        unsigned nloc = b.st[0], nx = b.st[1];
        if (nloc == 0u) { xcd_barrier_complete(bar, b.x, nloc, nx); b.st[0] = nloc; b.st[1] = nx; }
        const unsigned old = xb_add(&bar[XB_XSUB(b.x)], 1u);
        const unsigned gen = old / nloc;
        if (old + 1u == (gen + 1u) * nloc) {
            __builtin_amdgcn_fence(__ATOMIC_RELEASE, "agent");
            asm volatile("s_waitcnt vmcnt(0)" ::: "memory");
            const unsigned og = xb_add(&bar[XB_TOP], 1u);
            const unsigned tg = og / nx;
            if (og + 1u == (tg + 1u) * nx) xb_add(&bar[XB_TOPGEN], 1u);
            else XB_SPIN(xb_ld(&bar[XB_TOPGEN]) == tg, bar);
            __builtin_amdgcn_fence(__ATOMIC_ACQUIRE, "agent");
            xb_add(&bar[XB_XGEN(b.x)], 1u);
            asm volatile("s_waitcnt vmcnt(0)" ::: "memory");
        } else {
            XB_SPIN(xb_ld(&bar[XB_XGEN(b.x)]) == gen, bar);
            __builtin_amdgcn_fence(__ATOMIC_ACQUIRE, "agent");
            asm volatile("s_waitcnt vmcnt(0)" ::: "memory");
        }
    }
    __syncthreads();
}


#define XB_PACE(j) (3584 + 64 * (j))
__device__ __forceinline__ void xcd_pace(unsigned* bar, volatile LAS unsigned* st) {
    __syncthreads();
    if (threadIdx.x == 0) {
        const unsigned nloc = st[0] ? st[0] : 1u, x = xb_xcc_id(), gen = st[4] + 1u;
        st[4] = gen;
        xb_add(&bar[XB_PACE(x)], 1u);
        unsigned sp = 0;
        while (xb_ld(&bar[XB_PACE(x)]) < gen * nloc) { __builtin_amdgcn_s_sleep(1); if (++sp > (1u << 16)) break; }
    }
    __syncthreads();
}
extern __shared__ __attribute__((aligned(16))) unsigned char dyn_lds[];
#ifndef REP_PREP
#define REP_PREP 1
#endif
#ifndef REP_ATTN
#define REP_ATTN 1
#endif
#ifndef REP_SEL
#define REP_SEL 1
#endif
#ifndef REP_GATH
#define REP_GATH 1
#endif
#ifndef REP_GEMM
#define REP_GEMM 1
#endif
#ifndef REP_ADALN
#define REP_ADALN 1
#endif
constexpr int LDS_BYTES = 147456;

template <class T> __device__ __forceinline__ T* karg(int byte_off) {
    const __attribute__((address_space(4))) char* base = (const __attribute__((address_space(4))) char*)__builtin_amdgcn_kernarg_segment_ptr();
    unsigned long long v = *(const __attribute__((address_space(4))) unsigned long long*)(base + byte_off);
    asm volatile("" : "+s"(v));
    return (T*)(__attribute__((address_space(1))) T*)v;
}
#define KIN(i) karg<const float>(8 * (i))
#define KOUT() karg<float>(168)
#define KWS() karg<unsigned char>(176)
static_assert(sizeof(Params) == 184, "Params layout");
template <class T> __device__ __forceinline__ T* launder(T* p) { size_t off = 0; asm volatile("" : "+s"(off)); return (T*)((unsigned char*)p + off); }
__global__ void __launch_bounds__(NT) mega_fwd(Params p) {
    cg::grid_group grid = cg::this_grid();
    const int bid = blockIdx.x, nb = gridDim.x;
    volatile LAS unsigned* bst = (volatile LAS unsigned*)((LAS unsigned char*)dyn_lds + LDS_BYTES - 64);
    if (ltid() < 16) bst[ltid()] = 0u;
    __syncthreads();
    const XcdBarrier xbar = xcd_barrier_post((unsigned*)(KWS() + WS_BAR), bst);
    for (int rep = 0; rep < REP_PREP; ++rep) {
        unsigned char* ws = KWS();
        float* tile = (float*)dyn_lds;
        ph_transpose(KIN(6), (bf16*)(ws + WS_WIN0), 1024, AB_IN, true, tile, bid, nb);
        ph_transpose(KIN(11), (bf16*)(ws + WS_WIN1), 1024, CD_IN, true, tile, bid, nb);
        ph_transpose(KIN(7), (bf16*)(ws + WS_WO0), 1024, 1024, false, tile, bid, nb);
        ph_transpose(KIN(12), (bf16*)(ws + WS_WO1), 1024, 1024, false, tile, bid, nb);
        ph_transpose(KIN(17), (bf16*)(ws + WS_WQ), 1024, PQ, false, tile, bid, nb);
        ph_transpose(KIN(17) + (size_t)1024 * PQ, (bf16*)(ws + WS_WQ) + (size_t)PQ * 1024, 1024, PQ, false, tile, bid, nb);
        ws = launder(ws);
        ph_tab_fp6(KIN(19), ws + WS_PU, (float*)(ws + WS_PV), 2 * NEXP, bid, nb);
        ph_tab_fp4(KIN(20), ws + WS_PU + 32 * MiB, (float*)(ws + WS_PV + 1 * MiB), 2 * NEXP, bid, nb);
        ws = launder(ws);
        ph_mod(KIN(1), KIN(2), KIN(3), (float*)(ws + WS_MOD), (float*)dyn_lds, bid, nb);
        ph_rope_table((float*)(ws + WS_ROPE), bid, nb);
        for (int i = bid * NT + ltid(); i < NB * 8 * 8 * 64; i += nb * NT) ((float*)(ws + WS_KMEAN))[i] = 0.f;
    }
    grid.sync();
#pragma unroll 1
    for (int layer = 0; layer < 2; ++layer) {
        for (int rep = 0; rep < REP_ADALN; ++rep) {
            unsigned char* ws = KWS(); const float* mod = (const float*)(ws + WS_MOD) + (size_t)layer * 32 * 6144;
            ph_adaln(layer == 0 ? KIN(0) : KOUT(), KIN(4) + layer * DM, mod + 0, mod + 1024, (bf16*)(ws + WS_HY), bid, nb);
        }
        xcd_barrier(xbar);
        for (int rep = 0; rep < REP_GEMM; ++rep) {
            unsigned char* ws = KWS();
            pg8::Gemm g{(const bf16*)(ws + WS_HY), (const bf16*)(ws + (layer == 0 ? WS_WIN0 : WS_WIN1)), MT, layer == 0 ? AB_IN : CD_IN, DM};
            pg8::StaticOrder S; S.init(g.M, g.N, nb, bid);
            pg8::EpiQKV e{(bf16*)(ws + WS_QKV), QKV_LD, (const float*)(ws + WS_ROPE), layer, layer == 0 ? KIN(9) : KIN(13), layer == 0 ? KIN(10) : KIN(14), KIN(15), KIN(16), (float*)(ws + WS_KMEAN)};
            pg8::gemm_phase<pg8::EpiQKV, pg8::StaticOrder, true, true>((LAS unsigned char*)dyn_lds, g, S, e);
        }
        xcd_barrier(xbar);
        for (int rep = 0; rep < REP_ATTN; ++rep) {
            unsigned char* ws = KWS();
            if (layer == 0) ph_attn0((const bf16*)(ws + WS_QKV), KIN(8), (bf16*)(ws + WS_HY), (LAS unsigned char*)dyn_lds, bid, nb);
            else ph_attn1((const bf16*)(ws + WS_QKV), (const float*)(ws + WS_KMEAN), (bf16*)(ws + WS_HY), (LAS unsigned char*)dyn_lds, bid, nb);
        }
        xcd_barrier(xbar);
        for (int rep = 0; rep < REP_GEMM; ++rep) {
            unsigned char* ws = KWS(); const float* mod = (const float*)(ws + WS_MOD) + (size_t)layer * 32 * 6144;
            pg8::Gemm g{(const bf16*)(ws + WS_HY), (const bf16*)(ws + (layer == 0 ? WS_WO0 : WS_WO1)), MT, DM, DM};
            pg8::StaticOrder S; S.init(g.M, g.N, nb, bid); pg8::EpiResid e{layer == 0 ? KIN(0) : KOUT(), (float*)(ws + WS_X1), mod + 2048};
            pg8::gemm_phase<pg8::EpiResid, pg8::StaticOrder, true, true>((LAS unsigned char*)dyn_lds, g, S, e);
        }
        xcd_barrier(xbar);
        for (int rep = 0; rep < REP_ADALN; ++rep) {
            unsigned char* ws = KWS(); const float* mod = (const float*)(ws + WS_MOD) + (size_t)layer * 32 * 6144;
            ph_adaln((const float*)(ws + WS_X1), KIN(5) + layer * DM, mod + 3072, mod + 4096, (bf16*)(ws + WS_QKV), bid, nb);
        }
        xcd_barrier(xbar);
        for (int rep = 0; rep < REP_GEMM; ++rep) {
            unsigned char* ws = KWS();
            pg8::Gemm g{(const bf16*)(ws + WS_QKV), (const bf16*)(ws + WS_WQ) + (size_t)layer * PQ * DM, MT, PQ, DM};
            pg8::StaticOrder S; S.init(g.M, g.N, nb, bid); pg8::EpiStore e{(bf16*)(ws + WS_QKV + 128 * MiB), PQ};
            pg8::gemm_phase<pg8::EpiStore, pg8::StaticOrder, true, true>((LAS unsigned char*)dyn_lds, g, S, e);
        }
        xcd_barrier(xbar);
        for (int rep = 0; rep < REP_SEL; ++rep) {
            unsigned char* ws = KWS();
            ph_peer_select((const bf16*)(ws + WS_QKV + 128 * MiB), KIN(18) + (size_t)layer * 2 * 128 * 128, (int*)(ws + WS_HY), (float*)(ws + WS_HY + 32 * MiB), (LAS unsigned char*)dyn_lds, bid, nb);
        }
        xcd_barrier(xbar);
        for (int rep = 0; rep < REP_GATH; ++rep) {
            unsigned char* ws = KWS(); const float* mod = (const float*)(ws + WS_MOD) + (size_t)layer * 32 * 6144;
            ph_peer_gather((const bf16*)(ws + WS_QKV), ws + WS_PU + (size_t)layer * NEXP * TROW, ws + WS_PU + 32 * MiB + (size_t)layer * NEXP * TROW4,
                           (const float*)(ws + WS_PV) + layer * NEXP, (const float*)(ws + WS_PV + 1 * MiB) + layer * NEXP, (const int*)(ws + WS_HY), (const float*)(ws + WS_HY + 32 * MiB), (const float*)(ws + WS_X1), mod + 5120, KOUT(), (LAS unsigned char*)dyn_lds, (unsigned*)(ws + WS_BAR), bst, bid, nb);
        }
        if (layer == 0) xcd_barrier(xbar);
    }
}

extern "C" void kernel_launch(void* const* d_in, const int* in_sizes, int n_in, void* d_out, int out_size, void* d_ws, size_t ws_size, hipStream_t stream) {
    if (n_in != 21 || ws_size < WS_END) { fprintf(stderr, "kernel_launch: bad args n_in=%d ws=%zu\n", n_in, ws_size); return; }
    static int grid_blocks = 0;
    if (!grid_blocks) {
        int dev = 0, cus = 0, per_cu = 0;
        (void)hipGetDevice(&dev);
        (void)hipDeviceGetAttribute(&cus, hipDeviceAttributeMultiprocessorCount, dev);
        (void)hipFuncSetAttribute((const void*)mega_fwd, hipFuncAttributeMaxDynamicSharedMemorySize, LDS_BYTES);
        (void)hipOccupancyMaxActiveBlocksPerMultiprocessor(&per_cu, (const void*)mega_fwd, NT, LDS_BYTES);
        if (per_cu < 1) { fprintf(stderr, "kernel_launch: occupancy query returned %d\n", per_cu); per_cu = 1; }
        if (per_cu > 1) per_cu = 1;
        grid_blocks = cus * per_cu;
    }
    Params p{};
    for (int i = 0; i < 21; ++i) p.in[i] = (const float*)d_in[i];
    p.out = (float*)d_out; p.ws = (unsigned char*)d_ws;
    (void)hipMemsetAsync((char*)d_ws + WS_BAR, 0, 16384, stream);
    void* args[] = {&p};
    hipError_t e = hipLaunchCooperativeKernel((const void*)mega_fwd, dim3(grid_blocks), dim3(NT), args, LDS_BYTES, stream);
    if (e != hipSuccess) fprintf(stderr, "cooperative launch failed: %s (grid %d)\n", hipGetErrorString(e), grid_blocks);
}
```

```cpp
#include <hip/hip_runtime.h>
#ifndef REP_A
#define REP_A 1
#endif
#ifndef REP_B
#define REP_B 1
#endif
#ifndef REP_C
#define REP_C 1
#endif
#ifndef REP_D
#define REP_D 1
#endif
#include <hip/hip_cooperative_groups.h>
namespace cg = cooperative_groups;
#include <cstdio>
#include <cstdint>
#include <cmath>

typedef unsigned short bf16;
typedef short bf16x8 __attribute__((ext_vector_type(8)));
typedef float f32x4 __attribute__((ext_vector_type(4)));
typedef unsigned u32x4 __attribute__((ext_vector_type(4)));
typedef unsigned u32x2 __attribute__((ext_vector_type(2)));

constexpr int DM = 1024, NB = 32, SQ = 2048, MT = NB * SQ;
constexpr int HD = 64;
constexpr int AB_IN = 2304, CD_IN = 3072, QKV_LD = 3072;
constexpr int NEXP = 16384, PQ = 2048;
constexpr float EPS = 1e-6f;
constexpr int NT = 512;

constexpr size_t MiB = 1u << 20;
constexpr size_t WS_X1 = 0;
constexpr size_t WS_QKV = 256 * MiB;
constexpr size_t WS_HY = 640 * MiB;
constexpr size_t WS_PU = 768 * MiB;
constexpr size_t WS_PV = 832 * MiB;
constexpr size_t WS_WIN0 = 896 * MiB;
constexpr size_t WS_WIN1 = 901 * MiB;
constexpr size_t WS_WO0 = 907 * MiB;
constexpr size_t WS_WO1 = 909 * MiB;
constexpr size_t WS_WQ = 911 * MiB;
constexpr size_t WS_MOD = 919 * MiB;
constexpr size_t WS_ROPE = 921 * MiB;
constexpr size_t WS_KMEAN = 922 * MiB;
constexpr size_t WS_BAR = 923 * MiB;
constexpr size_t WS_END = 924 * MiB;

struct Params {
    const float* in[21];
    float* out;
    unsigned char* ws;
};

__device__ __forceinline__ int ltid() { int t = (int)__builtin_amdgcn_workitem_id_x(); asm volatile("" : "+v"(t)); return t; }
__device__ __forceinline__ float bf2f(unsigned b) { return __uint_as_float(b << 16); }
__device__ __forceinline__ unsigned f2bf(float f) { unsigned u = __float_as_uint(f); return (u + 0x7fffu + ((u >> 16) & 1u)) >> 16; }
__device__ __forceinline__ unsigned pk2(float lo, float hi) { return f2bf(lo) | (f2bf(hi) << 16); }
#define DPPV(v, ctrl) __builtin_bit_cast(float, __builtin_amdgcn_update_dpp(0, __builtin_bit_cast(int, (v)), (ctrl), 0xf, 0xf, true))
__device__ __forceinline__ float row16_sum(float v) { v += DPPV(v, 0xB1); v += DPPV(v, 0x4E); v += DPPV(v, 0x124); v += DPPV(v, 0x128); return v; }
__device__ __forceinline__ float rows_sum(float v) {
    { auto r = __builtin_amdgcn_permlane16_swap(__float_as_uint(v), __float_as_uint(v), false, false); v = __uint_as_float(r[0]) + __uint_as_float(r[1]); }
    { auto r = __builtin_amdgcn_permlane32_swap(__float_as_uint(v), __float_as_uint(v), false, false); v = __uint_as_float(r[0]) + __uint_as_float(r[1]); }
    return v;
}
__device__ __forceinline__ float wave_sum(float v) { return rows_sum(row16_sum(v)); }
__device__ __forceinline__ float wave_max(float v) {
    v = fmaxf(v, DPPV(v, 0xB1)); v = fmaxf(v, DPPV(v, 0x4E)); v = fmaxf(v, DPPV(v, 0x124)); v = fmaxf(v, DPPV(v, 0x128));
    { auto r = __builtin_amdgcn_permlane16_swap(__float_as_uint(v), __float_as_uint(v), false, false); v = fmaxf(__uint_as_float(r[0]), __uint_as_float(r[1])); }
    { auto r = __builtin_amdgcn_permlane32_swap(__float_as_uint(v), __float_as_uint(v), false, false); v = fmaxf(__uint_as_float(r[0]), __uint_as_float(r[1])); }
    return v;
}
__device__ __forceinline__ float gelu_erf(float x) {
    const float z = x * 0.70710678118654752f, az = fabsf(z);
    const float t = __builtin_amdgcn_rcpf(fmaf(0.3275911f, az, 1.0f));
    float pl = fmaf(t, 1.061405429f, -1.453152027f); pl = fmaf(t, pl, 1.421413741f); pl = fmaf(t, pl, -0.284496736f); pl = fmaf(t, pl, 0.254829592f); pl *= t;
    const float ex = __builtin_amdgcn_exp2f(az * (az * -1.4426950408889634f));
    const float er = copysignf(fmaf(-pl, ex, 1.0f), z);
    const float hx = 0.5f * x;
    return fmaf(hx, er, hx);
}

__device__ __forceinline__ int qkv_logical_col(int p) { return (p & ~255) | (((p >> 5) & 3) << 6) | (((p >> 7) & 1) << 5) | (p & 31); }
__device__ void ph_transpose(const float* W, bf16* Wt, int K, int N, bool permute, float* tile  , int bid, int nb) {
    const int tid = ltid();
    const int nkt = K / 64, nnt = N / 64;
    for (int it = bid; it < nkt * nnt; it += nb) {
        const int k0 = (it / nnt) * 64, n0 = (it % nnt) * 64;
        __syncthreads();
        for (int e = tid; e < 64 * 64; e += NT) { const int r = e >> 6, c = e & 63; const int nl = permute ? qkv_logical_col(n0 + c) : n0 + c; tile[r * 65 + c] = W[(size_t)(k0 + r) * N + nl]; }
        __syncthreads();
        {
            const int n = tid >> 3, k8 = (tid & 7) * 8;
            u32x4 v;
            v.x = pk2(tile[(k8 + 0) * 65 + n], tile[(k8 + 1) * 65 + n]);
            v.y = pk2(tile[(k8 + 2) * 65 + n], tile[(k8 + 3) * 65 + n]);
            v.z = pk2(tile[(k8 + 4) * 65 + n], tile[(k8 + 5) * 65 + n]);
            v.w = pk2(tile[(k8 + 6) * 65 + n], tile[(k8 + 7) * 65 + n]);
            *(u32x4*)(Wt + (size_t)(n0 + n) * K + k0 + k8) = v;
        }
    }
}
__device__ void ph_convert(const float* src, bf16* dst, size_t n, int bid, int nb) {
    const size_t n8 = n / 8;
    for (size_t i = (size_t)bid * NT + ltid(); i < n8; i += (size_t)nb * NT) {
        const f32x4 a = *(const f32x4*)(src + i * 8), b = *(const f32x4*)(src + i * 8 + 4);
        u32x4 v; v.x = pk2(a[0], a[1]); v.y = pk2(a[2], a[3]); v.z = pk2(b[0], b[1]); v.w = pk2(b[2], b[3]);
        *(u32x4*)(dst + i * 8) = v;
    }
}
__device__ void ph_mod(const float* c, const float* ada_w, const float* ada_b, float* mod, float* lds  , int bid, int nb) {
    const int tid = ltid(), lane = tid & 63, w = tid >> 6;
    for (int it = bid; it < 2 * 96; it += nb) {
        const int l = it / 96, j = (it % 96) * 64 + lane;
        float acc[32];
#pragma unroll
        for (int b = 0; b < 32; ++b) acc[b] = 0.f;
        for (int kh = 0; kh < 2; ++kh) {
            __syncthreads();
            for (int e = tid; e < 32 * 512; e += NT) { const int b = e >> 9, k = e & 511; const float cv = c[b * 1024 + kh * 512 + k]; lds[e] = cv / (1.0f + __expf(-cv)); }
            __syncthreads();
            for (int kk = 0; kk < 64; ++kk) {
                const int k = w * 64 + kk;
                const float wv = ada_w[((size_t)l * 1024 + kh * 512 + k) * 6144 + j];
#pragma unroll
                for (int b = 0; b < 32; ++b) acc[b] += lds[b * 512 + k] * wv;
            }
        }
        __syncthreads();
#pragma unroll
        for (int b = 0; b < 32; ++b) lds[(w * 32 + b) * 64 + lane] = acc[b];
        __syncthreads();
        for (int e = tid; e < 32 * 64; e += NT) {
            const int b = e >> 6, jj = e & 63; float s = 0.f;
#pragma unroll
            for (int ww = 0; ww < 8; ++ww) s += lds[(ww * 32 + b) * 64 + jj];
            const int jo = (it % 96) * 64 + jj;
            mod[((size_t)l * 32 + b) * 6144 + jo] = s + ada_b[l * 6144 + jo];
        }
    }
}
__device__ void ph_rope_table(float* rope, int bid, int nb) {
    for (int i = bid * NT + ltid(); i < SQ * 32; i += nb * NT) {
        const int t = i >> 5, f = i & 31;
        const float inv = powf(10000.0f, -(float)f / 32.0f);
        const float ang = (float)t * inv;
        float s, c; sincosf(ang, &s, &c);
        rope[i * 2] = c; rope[i * 2 + 1] = s;
    }
}

#define DPP_ADD0(v, ctrl) ((v) + __builtin_bit_cast(float, __builtin_amdgcn_update_dpp(0, __builtin_bit_cast(int, (v)), (ctrl), 0xf, 0xf, true)))
__device__ void ph_adaln(const float* x, const float* g, const float* mod_shift  , const float* mod_scale, bf16* h, int bid, int nb) {
    const int lane = ltid() & 63, w = __builtin_amdgcn_readfirstlane(ltid() >> 6);
    for (int t0 = (bid * 8 + w) * 4; t0 < MT; t0 += nb * 8 * 4) {
        const int b = t0 >> 11;
        f32x4 v[4][4]; float ss[4];
#pragma unroll
        for (int r = 0; r < 4; ++r) {
            const float* xr = x + (size_t)(t0 + r) * DM;
#pragma unroll
            for (int i = 0; i < 4; ++i) v[r][i] = *(const f32x4*)(xr + i * 256 + lane * 4);
        }
#pragma unroll
        for (int r = 0; r < 4; ++r) {
            float s = 0.f;
#pragma unroll
            for (int i = 0; i < 4; ++i) s += v[r][i][0] * v[r][i][0] + v[r][i][1] * v[r][i][1] + v[r][i][2] * v[r][i][2] + v[r][i][3] * v[r][i][3];
            s = DPP_ADD0(s, 0xB1); s = DPP_ADD0(s, 0x4E); s = DPP_ADD0(s, 0x124); s = DPP_ADD0(s, 0x128);
            { auto q = __builtin_amdgcn_permlane16_swap(__float_as_uint(s), __float_as_uint(s), false, false); s = __uint_as_float(q[0]) + __uint_as_float(q[1]); }
            { auto q = __builtin_amdgcn_permlane32_swap(__float_as_uint(s), __float_as_uint(s), false, false); s = __uint_as_float(q[0]) + __uint_as_float(q[1]); }
            ss[r] = rsqrtf(s * (1.0f / DM) + EPS);
        }
#pragma unroll
        for (int i = 0; i < 4; ++i) {
            const int c = i * 256 + lane * 4;
            const f32x4 gg = *(const f32x4*)(g + c), sc = *(const f32x4*)(mod_scale + (size_t)b * 6144 + c), sh = *(const f32x4*)(mod_shift + (size_t)b * 6144 + c);
            float a[4];
#pragma unroll
            for (int e = 0; e < 4; ++e) a[e] = gg[e] * (1.0f + sc[e]);
#pragma unroll
            for (int r = 0; r < 4; ++r) {
                float y[4];
#pragma unroll
                for (int e = 0; e < 4; ++e) y[e] = v[r][i][e] * ss[r] * a[e] + sh[e];
                u32x2 o; o.x = pk2(y[0], y[1]); o.y = pk2(y[2], y[3]);
                *(u32x2*)(h + (size_t)(t0 + r) * DM + c) = o;
            }
        }
    }
}

namespace pg8 {
#define PG8_LAS __attribute__((address_space(3)))
typedef unsigned short bf16_t;
typedef short bf16x8 __attribute__((ext_vector_type(8)));
constexpr int BM = 256, BK = 64, HALF = 128, HTB = HALF * BK * 2  , STAGE_BYTES = 8 * HTB, NXCD = 8, WGM = 8;

__host__ __device__ __forceinline__ int lds_byte(int r, int c) { const int st = (r >> 4) * 2 + (c >> 5), rr = r & 15, cc = c & 31, ob = rr * 64 + cc * 2; return st * 1024 + (ob ^ (((ob >> 9) & 1) << 5)); }
__host__ __device__ __forceinline__ void stage_rc(int b, int& R, int& C) { const int st = b / 1024, sb = b % 1024, swz = sb ^ (((sb >> 9) & 1) << 5); R = (st >> 1) * 16 + swz / 64; C = (st & 1) * 32 + (swz % 64) / 2; }
__host__ __device__ __forceinline__ int perm32(int rho) { const int n = rho >> 4, i = rho & 15; return 8 * (i >> 2) + 4 * n + (i & 3); }

struct Unit { int pm, pn; };
struct Gemm { const bf16_t* A; const bf16_t* Bt; int M, N, K; };

struct StaticOrder {
    int nM, nN, nwg, G, c;
    __host__ __device__ void init(int M, int N, int G_, int c_) { nM = M / BM; nN = N / BM; nwg = nM * nN; G = G_; c = c_; }
    __host__ __device__ bool next(int i, Unit& u) const {
        const long L = (long)i * G + c; if (L >= nwg) return false;
        int wgid = (int)L; { const int q = nwg / NXCD, r = nwg % NXCD, xcd = wgid % NXCD, off = wgid / NXCD; wgid = (xcd < r ? xcd * (q + 1) : r * (q + 1) + (xcd - r) * q) + off; }
        const int nig = WGM * nN, gid = wgid / nig, fm = gid * WGM, gsz = (nM - fm) < WGM ? (nM - fm) : WGM;
        u.pm = fm + ((wgid % nig) % gsz); u.pn = (wgid % nig) / gsz; return true;
    }
    __device__ __forceinline__ void a_ready(const Unit&) const {}
    __device__ __forceinline__ void done(const Unit&) const {}
};

__device__ __forceinline__ unsigned cvt_pk_bf16(float lo, float hi) { unsigned r; asm volatile("v_cvt_pk_bf16_f32 %0, %1, %2" : "=v"(r) : "v"(lo), "v"(hi)); return r; }

struct EpiStore {
    static constexpr bool PERM = true, AFTER_DRAIN = false;
    bf16_t* O; int ldc;
    __device__ __forceinline__ void operator()(const f32x4 (&acc)[2][2][4][2], const Unit& u, int wr, int wc, int fr_, int fq_) const {
        int fr = fr_, fq = fq_; asm volatile("" : "+v"(fr), "+v"(fq));
        const int row0 = u.pm * BM + wr * 64 + fr, col0 = u.pn * BM + wc * 32 + 8 * fq;
#pragma unroll
        for (int ai = 0; ai < 2; ++ai)
#pragma unroll
            for (int m = 0; m < 4; ++m) { bf16_t* rowp = O + (size_t)(row0 + ai * HALF + m * 16) * ldc + col0;
#pragma unroll
                for (int bj = 0; bj < 2; ++bj) { const f32x4 v0 = acc[ai][bj][m][0], v1 = acc[ai][bj][m][1];
                    u32x4 w; w.x = cvt_pk_bf16(v0[0], v0[1]); w.y = cvt_pk_bf16(v0[2], v0[3]); w.z = cvt_pk_bf16(v1[0], v1[1]); w.w = cvt_pk_bf16(v1[2], v1[3]);
                    *(u32x4*)(rowp + bj * HALF) = w; } }
    }
};
struct EpiQKV {
    static constexpr bool PERM = true, AFTER_DRAIN = false;
    bf16_t* O; int ldc; const float* rope; int layer;
    const float* gq0; const float* gk0;
    const float* gq1; const float* gk1;
    float* kmean;
    __device__ __forceinline__ void operator()(const f32x4 (&acc)[2][2][4][2], const Unit& u, int wr, int wc, int fr_, int fq_) const {
        int fr = fr_, fq = fq_; asm volatile("" : "+v"(fr), "+v"(fq));
        const int hg = 4 * u.pn + wc;
        const float* gain = nullptr; bool km = false;
        if (layer == 0) { if (hg < 8) gain = gq0; else if (hg < 10) gain = gk0; }
        else { if (hg < 8) gain = gq0; else if (hg < 16) gain = gk0; else if (hg >= 24 && hg < 32) gain = gq1; else if (hg >= 32 && hg < 40) { gain = gk1; km = true; } }
        const int row0 = u.pm * BM + wr * 64 + fr, col0 = 64 * hg + 8 * fq;
        float g0[8], g1[8], cs0[8], cs1[8];
#pragma unroll
        for (int e = 0; e < 8; ++e) { g0[e] = gain ? gain[8 * fq + e] : 1.f; g1[e] = gain ? gain[32 + 8 * fq + e] : 1.f; cs0[e] = 0.f; cs1[e] = 0.f; }
#pragma unroll
        for (int ai = 0; ai < 2; ++ai)
#pragma unroll
            for (int m = 0; m < 4; ++m) {
                const int row = row0 + ai * HALF + m * 16;
                float v0[8], v1[8];
#pragma unroll
                for (int e = 0; e < 4; ++e) { v0[e] = acc[ai][0][m][0][e]; v0[4 + e] = acc[ai][0][m][1][e]; v1[e] = acc[ai][1][m][0][e]; v1[4 + e] = acc[ai][1][m][1][e]; }
                if (gain) {
                    float ss = 0.f;
#pragma unroll
                    for (int e = 0; e < 8; ++e) ss += v0[e] * v0[e] + v1[e] * v1[e];
                    ss = rows_sum(ss);
                    const float r = rsqrtf(ss * (1.0f / 64.0f) + 1e-6f);
                    const float* rp = rope + ((size_t)(row & 2047) * 32 + 8 * fq) * 2;
                    const f32x4 t0 = *(const f32x4*)(rp), t1 = *(const f32x4*)(rp + 4), t2 = *(const f32x4*)(rp + 8), t3 = *(const f32x4*)(rp + 12);
                    const float cs[8] = {t0[0], t0[2], t1[0], t1[2], t2[0], t2[2], t3[0], t3[2]}, sn[8] = {t0[1], t0[3], t1[1], t1[3], t2[1], t2[3], t3[1], t3[3]};
#pragma unroll
                    for (int e = 0; e < 8; ++e) { const float y0 = v0[e] * r * g0[e], y1 = v1[e] * r * g1[e]; v0[e] = y0 * cs[e] - y1 * sn[e]; v1[e] = y1 * cs[e] + y0 * sn[e]; }
                }
                u32x4 w0, w1;
                w0.x = cvt_pk_bf16(v0[0], v0[1]); w0.y = cvt_pk_bf16(v0[2], v0[3]); w0.z = cvt_pk_bf16(v0[4], v0[5]); w0.w = cvt_pk_bf16(v0[6], v0[7]);
                w1.x = cvt_pk_bf16(v1[0], v1[1]); w1.y = cvt_pk_bf16(v1[2], v1[3]); w1.z = cvt_pk_bf16(v1[4], v1[5]); w1.w = cvt_pk_bf16(v1[6], v1[7]);
                bf16_t* rowp = O + (size_t)row * ldc + col0;
                *(u32x4*)(rowp) = w0; *(u32x4*)(rowp + 32) = w1;
                if (km) {
#pragma unroll
                    for (int e = 0; e < 8; ++e) { cs0[e] += v0[e]; cs1[e] += v1[e]; }
                }
            }
        if (km) {
#pragma unroll
            for (int e = 0; e < 8; ++e) {
                cs0[e] = row16_sum(cs0[e]); cs1[e] = row16_sum(cs1[e]);
            }
            if (fr == 0) {
                float* kp = kmean + ((size_t)((u.pm >> 3) * 8 + (hg - 32)) * 8 + (u.pm & 7)) * 64 + 8 * fq;
#pragma unroll
                for (int e = 0; e < 8; ++e) { atomicAdd(kp + e, cs0[e] * (1.0f / 256.0f)); atomicAdd(kp + 32 + e, cs1[e] * (1.0f / 256.0f)); }
            }
        }
    }
};
struct EpiResid {
    static constexpr bool PERM = true, AFTER_DRAIN = false;
    const float* xin; float* xout; const float* gate;
    __device__ __forceinline__ void operator()(const f32x4 (&acc)[2][2][4][2], const Unit& u, int wr, int wc, int fr_, int fq_) const {
        int fr = fr_, fq = fq_; asm volatile("" : "+v"(fr), "+v"(fq));
        const int row0 = u.pm * BM + wr * 64 + fr, col0 = u.pn * BM + wc * 32 + 8 * fq;
#pragma unroll
        for (int ai = 0; ai < 2; ++ai)
#pragma unroll
            for (int m = 0; m < 4; ++m) { const int row = row0 + ai * HALF + m * 16; const float* gp = gate + (size_t)(row >> 11) * 6144 + col0;
                const float* xi = xin + (size_t)row * 1024 + col0; float* xo = xout + (size_t)row * 1024 + col0;
#pragma unroll
                for (int bj = 0; bj < 2; ++bj)
#pragma unroll
                    for (int n = 0; n < 2; ++n) { const f32x4 a = acc[ai][bj][m][n], x = *(const f32x4*)(xi + bj * HALF + 4 * n), g = *(const f32x4*)(gp + bj * HALF + 4 * n);
                        f32x4 o; o[0] = x[0] + g[0] * a[0]; o[1] = x[1] + g[1] * a[1]; o[2] = x[2] + g[2] * a[2]; o[3] = x[3] + g[3] * a[3];
                        *(f32x4*)(xo + bj * HALF + 4 * n) = o; } }
    }
};
template <class Epi, class Sched, bool ALIGN_EPI = false, bool SP2 = false>
__device__ __forceinline__ void gemm_phase(PG8_LAS unsigned char* lds, const Gemm g, const Sched& S, const Epi& E) {
    const int tid = ltid(), wid = __builtin_amdgcn_readfirstlane(tid >> 6), lane = tid & 63, wr = wid >> 2, wc = wid & 3, fr = lane & 15, fq = lane >> 4;
    const int K = g.K, nt = K / BK;
    unsigned voffA[2], voffB[2];
#pragma unroll
    for (int i = 0; i < 2; ++i) { int R, C; stage_rc(tid * 16 + i * 8192, R, C); const int Rb = Epi::PERM ? ((R & ~31) + perm32(R & 31)) : R;
        voffA[i] = (unsigned)(R * K + C) * 2u; voffB[i] = (unsigned)(Rb * K + C) * 2u; }
    const size_t kstep = (size_t)(BK * 2);
    const size_t hstep = (size_t)HALF * K * 2;
    const size_t tstep = 2 * hstep;
    const unsigned ldsw = (unsigned)wid * 1024u;
    const int aoff = lds_byte(wr * 64 + fr, fq * 8), boff = lds_byte(wc * 32 + fr, fq * 8);
#define PG8_SA(b, h) (((b) * 2 + (h)) * HTB)
#define PG8_SB(b, h) ((4 + (b) * 2 + (h)) * HTB)
#define PG8_STAGE(bufoff, gbase, voff) do { _Pragma("unroll") for (int _i = 0; _i < 2; ++_i) \
        __builtin_amdgcn_global_load_lds((const unsigned*)((const char*)(gbase) + (voff)[_i]), (PG8_LAS unsigned*)(lds + (bufoff) + ldsw + _i * 8192), 16, 0, 0); } while (0)
#define PG8_LDA(dst, b, h) do { _Pragma("unroll") for (int m = 0; m < 4; ++m) _Pragma("unroll") for (int k = 0; k < 2; ++k) dst[m][k] = *(const PG8_LAS bf16x8*)(lds + PG8_SA(b, h) + aoff + m * 2048 + k * 1024); } while (0)
#define PG8_LDB(dst, b, h) do { _Pragma("unroll") for (int n = 0; n < 2; ++n) _Pragma("unroll") for (int k = 0; k < 2; ++k) dst[n][k] = *(const PG8_LAS bf16x8*)(lds + PG8_SB(b, h) + boff + n * 2048 + k * 1024); } while (0)
#define PG8_MMA(ai, bj, At, Bt) do { __builtin_amdgcn_s_setprio(1); _Pragma("unroll") for (int m = 0; m < 4; ++m) _Pragma("unroll") for (int n = 0; n < 2; ++n) _Pragma("unroll") for (int k = 0; k < 2; ++k) \
        acc[ai][bj][m][n] = __builtin_amdgcn_mfma_f32_16x16x32_bf16(Bt[n][k], At[m][k], acc[ai][bj][m][n], 0, 0, 0); __builtin_amdgcn_s_setprio(0); } while (0)
#define PG8_WAIT_V(n) asm volatile("s_waitcnt vmcnt(" #n ")" ::: "memory")
#define PG8_WAIT_L(n) asm volatile("s_waitcnt lgkmcnt(" #n ")" ::: "memory")
#define PG8_BAR __builtin_amdgcn_s_barrier()
#define PG8_SCHED __builtin_amdgcn_sched_barrier(0)
    Unit cur, nxt; int ui = 0;
    if (!S.next(0, cur)) return;
    f32x4 acc[2][2][4][2];
#pragma unroll
    for (int a = 0; a < 2; ++a)
#pragma unroll
        for (int b = 0; b < 2; ++b)
#pragma unroll
            for (int m = 0; m < 4; ++m)
#pragma unroll
                for (int n = 0; n < 2; ++n) acc[a][b][m][n] = (f32x4){0.f, 0.f, 0.f, 0.f};
    bf16x8 At[4][2], B0[2][2], B1[2][2];
    const char* cA = (const char*)g.A + (size_t)cur.pm * tstep; const char* cB = (const char*)g.Bt + (size_t)cur.pn * tstep;
    S.a_ready(cur);
    if constexpr (SP2) {
        PG8_STAGE(PG8_SB(0, 0), cB, voffB); PG8_STAGE(PG8_SB(0, 1), cB + hstep, voffB); PG8_STAGE(PG8_SA(0, 0), cA, voffA); PG8_STAGE(PG8_SA(0, 1), cA + hstep, voffA);
        if (wr == 1) PG8_BAR;
        PG8_WAIT_V(2); PG8_BAR;
        PG8_STAGE(PG8_SB(1, 0), cB + kstep, voffB); PG8_STAGE(PG8_SA(1, 0), cA + kstep, voffA); PG8_STAGE(PG8_SB(1, 1), cB + hstep + kstep, voffB);
        PG8_WAIT_V(6); PG8_BAR;
    } else {
        PG8_STAGE(PG8_SB(0, 0), cB, voffB); PG8_STAGE(PG8_SA(0, 0), cA, voffA); PG8_STAGE(PG8_SB(0, 1), cB + hstep, voffB); PG8_STAGE(PG8_SA(0, 1), cA + hstep, voffA);
        if (wr == 1) PG8_BAR;
        PG8_WAIT_V(4); PG8_BAR;
        PG8_STAGE(PG8_SB(1, 0), cB + kstep, voffB); PG8_STAGE(PG8_SA(1, 0), cA + kstep, voffA); PG8_STAGE(PG8_SB(1, 1), cB + hstep + kstep, voffB);
        PG8_WAIT_V(6); PG8_BAR;
    }
    for (;;) {
        const bool has_next = S.next(ui + 1, nxt);
        const char* nA = has_next ? (const char*)g.A + (size_t)nxt.pm * tstep : cA; const char* nB = has_next ? (const char*)g.Bt + (size_t)nxt.pn * tstep : cB;
        for (int t = 0; t < nt; t += 2) {
            const bool last = (t == nt - 2);
            const char* a1 = cA + (size_t)(t + 1) * kstep;
            const char* a2 = last ? nA : cA + (size_t)(t + 2) * kstep; const char* b2 = last ? nB : cB + (size_t)(t + 2) * kstep;
            const char* a3 = a2 + kstep; const char* b3 = b2 + kstep;
            if (last && has_next) S.a_ready(nxt);
            if constexpr (SP2) {
            PG8_LDB(B0, 0, 0); PG8_LDB(B1, 0, 1); PG8_SCHED; PG8_LDA(At, 0, 0); PG8_STAGE(PG8_SA(1, 1), a1 + hstep, voffA);
            PG8_WAIT_V(8); PG8_WAIT_L(0); PG8_BAR; PG8_MMA(0, 0, At, B0); PG8_MMA(0, 1, At, B1); PG8_BAR; PG8_SCHED;
            PG8_LDA(At, 0, 1); PG8_STAGE(PG8_SB(0, 0), b2, voffB); PG8_STAGE(PG8_SB(0, 1), b2 + hstep, voffB); PG8_STAGE(PG8_SA(0, 0), a2, voffA);
            PG8_WAIT_V(8); PG8_WAIT_L(0); PG8_BAR; PG8_MMA(1, 0, At, B0); PG8_MMA(1, 1, At, B1); PG8_BAR; PG8_SCHED;
            PG8_LDB(B0, 1, 0); PG8_LDB(B1, 1, 1); PG8_SCHED; PG8_LDA(At, 1, 0); PG8_STAGE(PG8_SA(0, 1), a2 + hstep, voffA);
            PG8_WAIT_V(8); PG8_WAIT_L(0); PG8_BAR; PG8_MMA(0, 0, At, B0); PG8_MMA(0, 1, At, B1); PG8_BAR; PG8_SCHED;
            PG8_LDA(At, 1, 1); PG8_STAGE(PG8_SB(1, 0), b3, voffB); PG8_STAGE(PG8_SB(1, 1), b3 + hstep, voffB); PG8_STAGE(PG8_SA(1, 0), a3, voffA);
            PG8_WAIT_V(8); PG8_WAIT_L(0); PG8_BAR; PG8_MMA(1, 0, At, B0); PG8_MMA(1, 1, At, B1); PG8_BAR; PG8_SCHED;
            } else {
            PG8_LDB(B0, 0, 0); PG8_SCHED; PG8_LDA(At, 0, 0); PG8_STAGE(PG8_SA(1, 1), a1 + hstep, voffA);
            PG8_WAIT_L(8); PG8_BAR; PG8_WAIT_L(0); PG8_MMA(0, 0, At, B0); PG8_BAR; PG8_SCHED;
            PG8_LDB(B1, 0, 1); PG8_STAGE(PG8_SB(0, 0), b2, voffB);
            PG8_BAR; PG8_WAIT_L(0); PG8_MMA(0, 1, At, B1); PG8_BAR;
            PG8_LDA(At, 0, 1); PG8_STAGE(PG8_SA(0, 0), a2, voffA);
            PG8_BAR; PG8_WAIT_L(0); PG8_MMA(1, 0, At, B0); PG8_BAR; PG8_SCHED;
            PG8_STAGE(PG8_SB(0, 1), b2 + hstep, voffB);
            PG8_WAIT_V(6); PG8_BAR; PG8_MMA(1, 1, At, B1); PG8_BAR;
            PG8_LDB(B0, 1, 0); PG8_SCHED; PG8_LDA(At, 1, 0); PG8_STAGE(PG8_SA(0, 1), a2 + hstep, voffA);
            PG8_WAIT_L(8); PG8_BAR; PG8_WAIT_L(0); PG8_MMA(0, 0, At, B0); PG8_BAR; PG8_SCHED;
            PG8_LDB(B1, 1, 1); PG8_STAGE(PG8_SB(1, 0), b3, voffB);
            PG8_BAR; PG8_WAIT_L(0); PG8_MMA(0, 1, At, B1); PG8_BAR;
            PG8_LDA(At, 1, 1); PG8_STAGE(PG8_SA(1, 0), a3, voffA);
            PG8_BAR; PG8_WAIT_L(0); PG8_MMA(1, 0, At, B0); PG8_BAR; PG8_SCHED;
            PG8_STAGE(PG8_SB(1, 1), b3 + hstep, voffB);
            PG8_WAIT_V(6); PG8_BAR; PG8_MMA(1, 1, At, B1); PG8_BAR;
            }
        }
        if constexpr (ALIGN_EPI) { if (wr == 0) PG8_BAR; }
        if constexpr (!Epi::AFTER_DRAIN) { E(acc, cur, wr, wc, fr, fq); S.done(cur); }
        if (!has_next) break;
#pragma unroll
        for (int a = 0; a < 2; ++a)
#pragma unroll
            for (int b = 0; b < 2; ++b)
#pragma unroll
                for (int m = 0; m < 4; ++m)
#pragma unroll
                    for (int n = 0; n < 2; ++n) acc[a][b][m][n] = (f32x4){0.f, 0.f, 0.f, 0.f};
        cur = nxt; cA = nA; cB = nB; ++ui;
        if constexpr (ALIGN_EPI) { if (wr == 1) PG8_BAR; }
    }
    PG8_WAIT_V(0);
    if constexpr (!ALIGN_EPI) { if (wr == 0) PG8_BAR; }
    PG8_BAR;
    if constexpr (Epi::AFTER_DRAIN) { E.fused(acc, cur, wr, wc, fr, fq, lds, wid, lane); S.done(cur); }
#undef PG8_SA
#undef PG8_SB
#undef PG8_STAGE
#undef PG8_LDA
#undef PG8_LDB
#undef PG8_MMA
#undef PG8_WAIT_V
#undef PG8_WAIT_L
#undef PG8_BAR
#undef PG8_SCHED
}
}

typedef float f32x16 __attribute__((ext_vector_type(16)));
typedef short s16x4 __attribute__((ext_vector_type(4)));
typedef short v4i16_t __attribute__((ext_vector_type(4)));
typedef float f32x2_t __attribute__((ext_vector_type(2)));
typedef __bf16 bf16x2_t __attribute__((ext_vector_type(2)));
#define LAS __attribute__((address_space(3)))
constexpr int VROW = 144, VBUF = 32 * VROW;
constexpr int VROWV = 192, VBUFV = 32 * VROWV;
constexpr float L2E = 1.4426950408889634f, LN2 = 0.6931471805599453f;
constexpr float SC2 = 0.125f * L2E;

__device__ __forceinline__ int crow(int r, int hi) { return (r & 3) + 8 * (r >> 2) + 4 * hi; }
__device__ __forceinline__ unsigned cvtpk(float lo, float hi) { f32x2_t v = {lo, hi}; bf16x2_t b = __builtin_convertvector(v, bf16x2_t); return __builtin_bit_cast(unsigned, b); }
__device__ __forceinline__ float xhalf(float v, int hi) {
    auto r = __builtin_amdgcn_permlane32_swap(__float_as_uint(v), __float_as_uint(v), false, false);
    return __uint_as_float(hi ? r[0] : r[1]);
}
__device__ __forceinline__ s16x4 vtr(const LAS unsigned char* p) { return __builtin_bit_cast(s16x4, __builtin_amdgcn_ds_read_tr16_b64_v4i16((LAS v4i16_t*)p)); }

struct KVRegs { u32x4 k[4]; u32x4 v[4]; };
__device__ __forceinline__ void load_kv(KVRegs& R, const bf16* base, int kp0, int kst, int kcol, int vcol, int lane) {
#pragma unroll
    for (int j = 0; j < 4; ++j) {
        const int pos = kp0 + kst * (8 * j + (lane >> 3));
        const int pc = pos < SQ - 1 ? pos : SQ - 1;
        const bf16* rp = base + (size_t)pc * QKV_LD + (lane & 7) * 8;
        R.k[j] = *(const u32x4*)(rp + kcol); R.v[j] = *(const u32x4*)(rp + vcol);
    }
}
__device__ __forceinline__ void kv_stage(const KVRegs& R, LAS unsigned char* klds, LAS unsigned char* vlds, int lane) {
#pragma unroll
    for (int j = 0; j < 4; ++j) { const int r_ = 8 * j + (lane >> 3), c_ = (lane & 7) * 16; *(LAS u32x4*)(klds + r_ * VROW + c_) = R.k[j]; *(LAS u32x4*)(vlds + r_ * VROWV + c_) = R.v[j]; }
}
__device__ __forceinline__ f32x16 qk_tile(const LAS unsigned char* klds, const bf16x8 (&qf)[4], int r32, int hi) {
    f32x16 s = {0.f, 0.f, 0.f, 0.f, 0.f, 0.f, 0.f, 0.f, 0.f, 0.f, 0.f, 0.f, 0.f, 0.f, 0.f, 0.f};
#pragma unroll
    for (int k = 0; k < 4; ++k) { const bf16x8 kf = *(const LAS bf16x8*)(klds + r32 * VROW + (2 * k + hi) * 16); s = __builtin_amdgcn_mfma_f32_32x32x16_bf16(kf, qf[k], s, 0, 0, 0); }
    return s;
}
__device__ __forceinline__ void pv_tile(f32x16 (&o)[2], const f32x16& p, const LAS unsigned char* vlds, int lane) {
    const int g = lane >> 4, i = lane & 15, h = lane >> 5;
    const LAS unsigned char* vb = vlds + (4 * h + (i >> 2)) * VROWV + (16 * (g & 1) + 4 * (i & 3)) * 2;
#pragma unroll
    for (int s = 0; s < 2; ++s) {
        u32x4 pw; pw.x = cvtpk(p[8 * s], p[8 * s + 1]); pw.y = cvtpk(p[8 * s + 2], p[8 * s + 3]); pw.z = cvtpk(p[8 * s + 4], p[8 * s + 5]); pw.w = cvtpk(p[8 * s + 6], p[8 * s + 7]);
        const bf16x8 pb = __builtin_bit_cast(bf16x8, pw);
#pragma unroll
        for (int df = 0; df < 2; ++df) {
            const s16x4 lo = vtr(vb + (16 * s) * VROWV + df * 64), hh = vtr(vb + (16 * s + 8) * VROWV + df * 64);
            const bf16x8 va = (bf16x8){lo[0], lo[1], lo[2], lo[3], hh[0], hh[1], hh[2], hh[3]};
            o[df] = __builtin_amdgcn_mfma_f32_32x32x16_bf16(va, pb, o[df], 0, 0, 0);
        }
    }
}
__device__ __forceinline__ void load_q(bf16x8 (&qf)[4], const bf16* base, int qpos, int qcol, int hi) {
    const bf16* rp = base + (size_t)qpos * QKV_LD + qcol + 8 * hi;
#pragma unroll
    for (int k = 0; k < 4; ++k) qf[k] = *(const bf16x8*)(rp + 16 * k);
}
__device__ __forceinline__ void store_o(bf16* yrow, const f32x16 (&o)[2], float inv, int hi) {
#pragma unroll
    for (int df = 0; df < 2; ++df)
#pragma unroll
        for (int g = 0; g < 4; ++g) {
            u32x2 w; w.x = cvtpk(o[df][4 * g] * inv, o[df][4 * g + 1] * inv); w.y = cvtpk(o[df][4 * g + 2] * inv, o[df][4 * g + 3] * inv);
            *(u32x2*)(yrow + 32 * df + 8 * g + 4 * hi) = w;
        }
}
__device__ __forceinline__ void osm_tile(f32x16& s, float& m, float& l, f32x16 (&o)[2]) {
    float mx = s[0];
#pragma unroll
    for (int r = 1; r < 16; ++r) mx = fmaxf(mx, s[r]);
    { auto rr = __builtin_amdgcn_permlane32_swap(__float_as_uint(mx), __float_as_uint(mx), false, false); mx = fmaxf(__uint_as_float(rr[0]), __uint_as_float(rr[1])); }
    const float mn = fmaxf(m, mx);
    const float ms = (mn == -INFINITY) ? 0.f : mn;
    const float alpha = __builtin_amdgcn_exp2f((m - ms) * SC2);
    const float mc = ms * SC2;
    float ps = 0.f;
#pragma unroll
    for (int r = 0; r < 16; ++r) { s[r] = __builtin_amdgcn_exp2f(s[r] * SC2 - mc); ps += s[r]; }
    l = l * alpha + ps; m = mn;
    if (!__all(alpha == 1.0f)) {
#pragma unroll
        for (int df = 0; df < 2; ++df)
#pragma unroll
            for (int r = 0; r < 16; ++r) o[df][r] *= alpha;
    }
}
__device__ __forceinline__ void osm_tile2(f32x16& s0, f32x16& s1, float& m, float& l, f32x16 (&o)[2]) {
    float mx = fmaxf(s0[0], s1[0]);
#pragma unroll
    for (int r = 1; r < 16; ++r) mx = fmaxf(mx, fmaxf(s0[r], s1[r]));
    { auto rr = __builtin_amdgcn_permlane32_swap(__float_as_uint(mx), __float_as_uint(mx), false, false); mx = fmaxf(__uint_as_float(rr[0]), __uint_as_float(rr[1])); }
    const float mn = fmaxf(m, mx);
    const float ms = (mn == -INFINITY) ? 0.f : mn;
    const float alpha = __builtin_amdgcn_exp2f((m - ms) * SC2);
    const float mc = ms * SC2;
    float ps0 = 0.f, ps1 = 0.f;
#pragma unroll
    for (int r = 0; r < 16; ++r) { s0[r] = __builtin_amdgcn_exp2f(s0[r] * SC2 - mc); ps0 += s0[r]; s1[r] = __builtin_amdgcn_exp2f(s1[r] * SC2 - mc); ps1 += s1[r]; }
    l = l * alpha + (ps0 + ps1); m = mn;
    if (!__all(alpha == 1.0f)) {
#pragma unroll
        for (int df = 0; df < 2; ++df)
#pragma unroll
            for (int r = 0; r < 16; ++r) o[df][r] *= alpha;
    }
}
#define ZERO16 {0.f, 0.f, 0.f, 0.f, 0.f, 0.f, 0.f, 0.f, 0.f, 0.f, 0.f, 0.f, 0.f, 0.f, 0.f, 0.f}

struct AttnCtx {
    const bf16* base; int kcol, vcol, r32, hi, lane; LAS unsigned char* vlds; LAS unsigned char* klds; bf16x8 qf[4]; f32x16 o[2];
};
#define ATTN_STEP(SC, SL, T) { \
        if (SYNC) __builtin_amdgcn_s_barrier(); \
        { int kp_, ks_; const int tl_ = (T) + 2 < nt ? (T) + 2 : nt - 1; mx.pos(tl_, kp_, ks_); load_kv(SL, c.base, kp_, ks_, c.kcol, c.vcol, c.lane); } \
        kv_stage(SC, c.klds, c.vlds, c.lane); f32x16 s_ = qk_tile(c.klds, c.qf, c.r32, c.hi); \
        const bool stop_ = mx.process((T), s_, c); pv_tile(c.o, s_, c.vlds, c.lane); \
        if ((!SYNC && stop_) || (T) + 1 >= nt) break; }
template <class M, bool SYNC> __device__ __forceinline__ void attn_run(M& mx, AttnCtx& c) {
    const int nt = mx.nt;
    KVRegs S0, S1, S2;
    { int kp, ks; mx.pos(0, kp, ks); load_kv(S0, c.base, kp, ks, c.kcol, c.vcol, c.lane);
      mx.pos(1 < nt ? 1 : nt - 1, kp, ks); load_kv(S1, c.base, kp, ks, c.kcol, c.vcol, c.lane); }
    for (int t = 0;; t += 3) {
        ATTN_STEP(S0, S2, t)
        ATTN_STEP(S1, S0, t + 1)
        ATTN_STEP(S2, S1, t + 2)
    }
}
#define SH_BAR() asm volatile("s_waitcnt lgkmcnt(0)\n\ts_barrier" ::: "memory")
constexpr int SLOT_K = 64 * VROW, SLOT_BYTES = 64 * VROW + 64 * VROWV;
struct ShRegs { u32x4 a, b; };
__device__ __forceinline__ void sh_load(ShRegs& R, const bf16* base, int kp0, int kcol, int vcol, int w, int lane) {
    const int pos = kp0 + 4 * w + ((lane & 31) >> 3);
    const int pa = pos < SQ - 1 ? pos : SQ - 1, pb = pos + 32 < SQ - 1 ? pos + 32 : SQ - 1;
    const int col = ((lane >> 5) ? vcol : kcol) + (lane & 7) * 8;
    R.a = *(const u32x4*)(base + (size_t)pa * QKV_LD + col); R.b = *(const u32x4*)(base + (size_t)pb * QKV_LD + col);
}
__device__ __forceinline__ void sh_write(LAS unsigned char* slot, const ShRegs& R, int w, int lane) {
    const int row = 4 * w + ((lane & 31) >> 3);
    LAS unsigned char* p = slot + ((lane >> 5) ? SLOT_K + row * VROWV : row * VROW) + (lane & 7) * 16;
    *(LAS u32x4*)p = R.a; *(LAS u32x4*)(p + 32 * ((lane >> 5) ? VROWV : VROW)) = R.b;
}
#define SH_STEP(RW, RL, T) { \
        SH_BAR(); \
        { const int tl_ = (T) + 2 < nt ? (T) + 2 : nt - 1; sh_load(RL, c.base, mx.pos2(tl_), c.kcol, c.vcol, w, c.lane); } \
        sh_write(slots + (((T) + 1) & 1) * SLOT_BYTES, RW, w, c.lane); \
        if (mx.active2((T), w)) { LAS unsigned char* sl_ = slots + ((T) & 1) * SLOT_BYTES; \
            f32x16 s0_ = qk_tile(sl_, c.qf, c.r32, c.hi), s1_ = qk_tile(sl_ + 32 * VROW, c.qf, c.r32, c.hi); mx.process2((T), s0_, s1_, c); \
            pv_tile(c.o, s0_, sl_ + SLOT_K, c.lane); pv_tile(c.o, s1_, sl_ + SLOT_K + 32 * VROWV, c.lane); } \
        if ((T) + 1 >= nt) break; }
template <class M> __device__ __forceinline__ void attn_run_shared(M& mx, AttnCtx& c, LAS unsigned char* slots, int w) {
    const int nt = mx.nt2;
    ShRegs R0, R1, R2;
    sh_load(R0, c.base, mx.pos2(0), c.kcol, c.vcol, w, c.lane);
    sh_load(R1, c.base, mx.pos2(1 < nt ? 1 : nt - 1), c.kcol, c.vcol, w, c.lane);
    SH_BAR();
    sh_write(slots, R0, w, c.lane);
    for (int t = 0;; t += 3) {
        SH_STEP(R1, R2, t)
        SH_STEP(R2, R0, t + 1)
        SH_STEP(R0, R1, t + 2)
    }
}
struct MixA {
    int nt, k00, qpos; float m, l;
    __device__ __forceinline__ void pos(int idx, int& kp0, int& kst) const { kp0 = k00 + 32 * idx; kst = 1; }
    __device__ __forceinline__ bool process(int idx, f32x16& s, AttnCtx& c) {
        const int k0 = k00 + 32 * idx;
#pragma unroll
        for (int r = 0; r < 16; ++r) { const int dist = qpos - (k0 + crow(r, c.hi)); if (dist < 0 || dist > 127) s[r] = -INFINITY; }
        osm_tile(s, m, l, c.o); return false;
    }
};
__device__ void attn_A(const bf16* base, int hq, int q0, float sink, bf16* ybase, LAS unsigned char* vlds, int lane) {
    AttnCtx c; c.base = base; c.r32 = lane & 31; c.hi = lane >> 5; c.lane = lane; c.vlds = vlds; c.klds = vlds + VBUFV; c.kcol = 512 + (hq >> 2) * 64; c.vcol = 640 + (hq >> 2) * 64;
    c.o[0] = (f32x16)ZERO16; c.o[1] = (f32x16)ZERO16;
    MixA mx; mx.qpos = q0 + c.r32; mx.k00 = q0 - 128 > 0 ? q0 - 128 : 0; mx.nt = 5; mx.m = -INFINITY; mx.l = 0.f;
    load_q(c.qf, base, mx.qpos, hq * 64, c.hi);
    attn_run<MixA, true>(mx, c);
    float l = mx.l + xhalf(mx.l, c.hi);
    l += __builtin_amdgcn_exp2f(sink * L2E - mx.m * SC2);
    store_o(ybase + (size_t)mx.qpos * DM + hq * 64, c.o, 1.0f / l, c.hi);
}
struct MixB {
    int nt, q0, qpos; float carry;
    __device__ __forceinline__ void pos(int idx, int& kp0, int& kst) const { kp0 = q0 - 32 * idx; kst = 1; }
    __device__ __forceinline__ bool process(int idx, f32x16& s, AttnCtx& c) {
        const int k0 = q0 - 32 * idx, hi = c.hi;
        float lk[16], G[4], Gp[4];
#pragma unroll
        for (int r = 0; r < 16; ++r) {
            const float z = s[r] * 0.125f;
            const bool valid = (k0 + crow(r, hi)) < qpos;
            const float sp = fmaxf(z, 0.f) + LN2 * __builtin_amdgcn_logf(1.0f + __builtin_amdgcn_exp2f(-fabsf(z) * L2E));
            lk[r] = valid ? -sp : 0.f;
            s[r] = valid ? (z - sp) : -INFINITY;
        }
#pragma unroll
        for (int g = 0; g < 4; ++g) { G[g] = (lk[4 * g] + lk[4 * g + 1]) + (lk[4 * g + 2] + lk[4 * g + 3]); Gp[g] = xhalf(G[g], hi); }
        float above = carry;
#pragma unroll
        for (int g = 3; g >= 0; --g) {
            float off = above + (hi == 0 ? Gp[g] : 0.f);
            s[4 * g + 3] = __builtin_amdgcn_exp2f((s[4 * g + 3] + off) * L2E); off += lk[4 * g + 3];
            s[4 * g + 2] = __builtin_amdgcn_exp2f((s[4 * g + 2] + off) * L2E); off += lk[4 * g + 2];
            s[4 * g + 1] = __builtin_amdgcn_exp2f((s[4 * g + 1] + off) * L2E); off += lk[4 * g + 1];
            s[4 * g + 0] = __builtin_amdgcn_exp2f((s[4 * g + 0] + off) * L2E);
            above += G[g] + Gp[g];
        }
        carry = above;
        return __all(carry < -40.0f) != 0;
    }
};
__device__ void attn_B(const bf16* base, int h, int q0, bf16* ybase, LAS unsigned char* vlds, int lane) {
    AttnCtx c; c.base = base; c.r32 = lane & 31; c.hi = lane >> 5; c.lane = lane; c.vlds = vlds; c.klds = vlds + VBUFV; c.kcol = 1280 + h * 64; c.vcol = 1792 + h * 64;
    c.o[0] = (f32x16)ZERO16; c.o[1] = (f32x16)ZERO16;
    MixB mx; mx.q0 = q0; mx.qpos = q0 + c.r32; mx.nt = q0 / 32 + 1; mx.carry = 0.f;
    load_q(c.qf, base, mx.qpos, 768 + h * 64, c.hi);
    attn_run<MixB, false>(mx, c);
    store_o(ybase + (size_t)mx.qpos * DM + 512 + h * 64, c.o, 1.0f, c.hi);
}
struct MixCp {
    int nt, n0, r0, j1lo, qpos; float m, l;
    __device__ __forceinline__ void pos(int t, int& kp0, int& kst) const {
        if (t < n0) { kp0 = r0 + 512 * t; kst = 16; } else { kp0 = (r0 & 3) + 4 * (j1lo + 32 * (t - n0)); kst = 4; }
    }
    __device__ __forceinline__ bool process(int t, f32x16& s, AttnCtx& c) {
        int kp0, kst; pos(t, kp0, kst);
        const int win = t < n0 ? 2048 : 512;
#pragma unroll
        for (int r = 0; r < 16; ++r) { const int dist = qpos - (kp0 + kst * crow(r, c.hi)); if (dist < 0 || dist > win) s[r] = -INFINITY; }
        osm_tile(s, m, l, c.o); return false;
    }
};
struct MixC1 {
    int nt2, p0, qpos; float m, l;
    __device__ __forceinline__ int pos2(int T) const { return p0 + 64 * T; }
    __device__ __forceinline__ bool active2(int T, int w) const { return true; }
    __device__ __forceinline__ void process2(int T, f32x16& s0, f32x16& s1, AttnCtx& c) {
        const int k0 = p0 + 64 * T;
#pragma unroll
        for (int r = 0; r < 16; ++r) { const int dist = qpos - (k0 + crow(r, c.hi)); if (dist < 0 || dist > 128) s0[r] = -INFINITY; if (dist < 32 || dist > 160) s1[r] = -INFINITY; }
        osm_tile2(s0, s1, m, l, c.o);
    }
};
__device__ void attn_C(const bf16* base, int h, int r0, int g, bf16* ybase, LAS unsigned char* vlds, LAS unsigned char* xlds, int w, int lane) {
    AttnCtx c; c.base = base; c.r32 = lane & 31; c.hi = lane >> 5; c.lane = lane; c.vlds = vlds; c.klds = vlds + VBUFV; c.kcol = 512 + h * 64; c.vcol = 1024 + h * 64;
    c.o[0] = (f32x16)ZERO16; c.o[1] = (f32x16)ZERO16;
    const int qpos = r0 + 16 * (32 * g + c.r32);
    load_q(c.qf, base, qpos, h * 64, c.hi);
    MixCp mp; mp.r0 = r0; mp.qpos = qpos; mp.m = -INFINITY; mp.l = 0.f;
    mp.n0 = g + 1;
    mp.j1lo = (r0 >> 2) + 128 * g - 128 > 0 ? (r0 >> 2) + 128 * g - 128 : 0;
    mp.nt = mp.n0 + ((r0 >> 2) + 128 * g + 124 - mp.j1lo) / 32 + 1;
    attn_run<MixCp, true>(mp, c);
    MixC1 m1; m1.qpos = qpos; m1.m = mp.m; m1.l = mp.l;
    const int ra = r0 & 8;
    m1.p0 = 512 * g + ra - 128 > 0 ? 512 * g + ra - 128 : 0;
    m1.nt2 = ((512 * g + ra + 7 + 496 - m1.p0) / 32 + 2) / 2;
    attn_run_shared<MixC1>(m1, c, xlds + 64, w);
    const float l = m1.l + xhalf(m1.l, c.hi);
    store_o(ybase + (size_t)qpos * DM + h * 64, c.o, 1.0f / l, c.hi);
}
struct MixD {
    int nt, nt2, npast, own, q0, qpos; unsigned U, sel; float m, l;
    __device__ __forceinline__ int blk_of(int j) const {
        unsigned u = U; int b = 0;
#pragma unroll
        for (int i = 0; i < 7; ++i) { if (i < j) u &= u - 1u; }
        b = __builtin_ctz(u | 0x100u); return b;
    }
    __device__ __forceinline__ void pos(int t, int& kp0, int& kst) const {
        kst = 1;
        if (t < 8 * npast) kp0 = blk_of(t >> 3) * 256 + (t & 7) * 32; else kp0 = own * 256 + (t - 8 * npast) * 32;
    }
    __device__ __forceinline__ int pos2(int T) const { int kp, ks; pos(2 * T, kp, ks); return kp; }
    __device__ __forceinline__ bool active2(int T, int w) const { return T < 4 * npast || 2 * (T - 4 * npast) <= w; }
    __device__ __forceinline__ void process2(int T, f32x16& s0, f32x16& s1, AttnCtx& c) {
        if (T < 4 * npast) {
            const int blk = blk_of(T >> 2);
            if (!((sel >> blk) & 1u)) {
#pragma unroll
                for (int r = 0; r < 16; ++r) { s0[r] = -INFINITY; s1[r] = -INFINITY; }
            }
        } else {
            const int k0 = own * 256 + (T - 4 * npast) * 64;
#pragma unroll
            for (int r = 0; r < 16; ++r) { const int kk = k0 + crow(r, c.hi); if (kk > qpos) s0[r] = -INFINITY; if (kk + 32 > qpos) s1[r] = -INFINITY; }
        }
        osm_tile2(s0, s1, m, l, c.o);
    }
};
__device__ void attn_D(const bf16* base, const float* kmean  , int h, int q0, bf16* ybase, LAS unsigned char* vlds, LAS unsigned char* xlds, int lane) {
    AttnCtx c; c.base = base; c.r32 = lane & 31; c.hi = lane >> 5; c.lane = lane; c.vlds = vlds; c.klds = vlds + VBUFV; c.kcol = 2048 + h * 64; c.vcol = 2560 + h * 64;
    c.o[0] = (f32x16)ZERO16; c.o[1] = (f32x16)ZERO16;
    const int r32 = c.r32, hi = c.hi, own = q0 >> 8;
    MixD mx; mx.own = own; mx.q0 = q0; mx.qpos = q0 + r32; mx.m = -INFINITY; mx.l = 0.f;
    load_q(c.qf, base, mx.qpos, 1536 + h * 64, hi);
    unsigned sel = 0u;
    if (own > 0) {
        bf16x8 kf[4];
#pragma unroll
        for (int k = 0; k < 4; ++k) {
            u32x4 w = {0u, 0u, 0u, 0u};
            if (r32 < 8) { const float* kp = kmean + r32 * 64 + 16 * k + 8 * hi; const f32x4 a = *(const f32x4*)kp, b = *(const f32x4*)(kp + 4);
                w.x = cvtpk(a[0], a[1]); w.y = cvtpk(a[2], a[3]); w.z = cvtpk(b[0], b[1]); w.w = cvtpk(b[2], b[3]); }
            kf[k] = __builtin_bit_cast(bf16x8, w);
        }
        f32x16 gs = ZERO16;
#pragma unroll
        for (int k = 0; k < 4; ++k) gs = __builtin_amdgcn_mfma_f32_32x32x16_bf16(kf[k], c.qf[k], gs, 0, 0, 0);
        float gt[8];
#pragma unroll
        for (int r = 0; r < 4; ++r) { const float mine = gs[r], oth = xhalf(mine, hi); gt[r] = hi == 0 ? mine : oth; gt[4 + r] = hi == 0 ? oth : mine; }
        const int nsel = own < 3 ? own : 3;
        for (int rr = 0; rr < nsel; ++rr) {
            float best = -INFINITY; int bi = -1;
#pragma unroll
            for (int n = 0; n < 8; ++n) { const bool ok = n < own && !((sel >> n) & 1u) && (bi < 0 || gt[n] > best); if (ok) { best = gt[n]; bi = n; } }
            if (bi >= 0) sel |= 1u << bi;
        }
    }
    unsigned U = 0u;
#pragma unroll
    for (int n = 0; n < 8; ++n) if (__ballot((sel >> n) & 1u) != 0ull) U |= 1u << n;
    {
        volatile LAS unsigned* ux = (volatile LAS unsigned*)xlds;
        __builtin_amdgcn_s_barrier();
        if (lane == 0) ux[(q0 >> 5) & 7] = U;
        asm volatile("s_waitcnt lgkmcnt(0)" ::: "memory");
        __builtin_amdgcn_s_barrier();
        U = ux[0] | ux[1] | ux[2] | ux[3] | ux[4] | ux[5] | ux[6] | ux[7];
        U = __builtin_amdgcn_readfirstlane(U);
    }
    mx.U = U; mx.sel = sel; mx.npast = __builtin_popcount(U); mx.nt = 8 * mx.npast + 8; mx.nt2 = 4 * mx.npast + 4;
    attn_run_shared<MixD>(mx, c, xlds + 64, (q0 >> 5) & 7);
    const float l = mx.l + xhalf(mx.l, c.hi);
    store_o(ybase + (size_t)mx.qpos * DM + 512 + h * 64, c.o, 1.0f / l, hi);
}

__device__ void ph_attn0(const bf16* qkv, const float* sinks, bf16* y, LAS unsigned char* lds, int bid, int nb) {
    const int lane = ltid() & 63, w = __builtin_amdgcn_readfirstlane(ltid() >> 6);
    LAS unsigned char* vlds = lds + w * (VBUF + VBUFV);
    for (int pid = bid; pid < NB * 8; pid += nb) {
        const int b = pid >> 3, h = pid & 7;
        const bf16* base = qkv + (size_t)b * SQ * QKV_LD; bf16* ybase = y + (size_t)b * SQ * DM;
        const float sink = sinks[h];
        for (int rd = 0; rd < 8; ++rd) attn_A(base, h, (rd * 8 + w) * 32, sink, ybase, vlds, lane);
        for (int rd = 0; rd < 8; ++rd) attn_B(base, h, (rd * 8 + w) * 32, ybase, vlds, lane);
    }
}
__device__ void ph_attn1(const bf16* qkv, const float* kmean, bf16* y, LAS unsigned char* lds, int bid, int nb) {
    const int lane = ltid() & 63, w = __builtin_amdgcn_readfirstlane(ltid() >> 6);
    LAS unsigned char* vlds = lds + w * (VBUF + VBUFV);
    for (int pid = bid; pid < NB * 8; pid += nb) {
        const int b = pid >> 3, h = pid & 7;
        const bf16* base = qkv + (size_t)b * SQ * QKV_LD; bf16* ybase = y + (size_t)b * SQ * DM;
        for (int rd = 0; rd < 8; ++rd) { const int it = rd * 8 + w; attn_C(base, h, it & 15, it >> 4, ybase, vlds, lds + 8 * (VBUF + VBUFV), w, lane); }
        for (int rd = 0; rd < 8; ++rd) attn_D(base, kmean + (size_t)pid * 8 * 64, h, (rd * 8 + w) * 32, ybase, vlds, lds + 8 * (VBUF + VBUFV), lane);
    }
}

#define CE_D(a, b) { const float hi_ = fmaxf((a), (b)), lo_ = fminf((a), (b)); (a) = hi_; (b) = lo_; }
#define BSTAGE(arr, k, j) _Pragma("unroll") for (int i_ = 0; i_ < 16; ++i_) { const int l_ = i_ ^ (j); if (l_ > i_) { if ((i_ & (k)) == 0) CE_D(arr[i_], arr[l_]) else CE_D(arr[l_], arr[i_]) } }
__device__ __forceinline__ void bsort16(float (&a)[16]) {
    BSTAGE(a, 2, 1) BSTAGE(a, 4, 2) BSTAGE(a, 4, 1) BSTAGE(a, 8, 4) BSTAGE(a, 8, 2) BSTAGE(a, 8, 1) BSTAGE(a, 16, 8) BSTAGE(a, 16, 4) BSTAGE(a, 16, 2) BSTAGE(a, 16, 1)
}
__device__ __forceinline__ void bmerge16(float (&a)[16]) {
    BSTAGE(a, 16, 8) BSTAGE(a, 16, 4) BSTAGE(a, 16, 2) BSTAGE(a, 16, 1)
}
__device__ __forceinline__ void merge_top16(float (&a)[16], const float (&b)[16]) {
#pragma unroll
    for (int i = 0; i < 16; ++i) a[i] = fmaxf(a[i], b[15 - i]);
    bmerge16(a);
}
__device__ __forceinline__ void xmerge16(float (&a)[16]) {
    {
        float A[16], B[16];
#pragma unroll
        for (int i = 0; i < 16; ++i) { auto r = __builtin_amdgcn_permlane16_swap(__float_as_uint(a[i]), __float_as_uint(a[i]), false, false); A[i] = __uint_as_float(r[0]); B[i] = __uint_as_float(r[1]); }
#pragma unroll
        for (int i = 0; i < 16; ++i) a[i] = fmaxf(A[i], B[15 - i]);
        bmerge16(a);
    }
    {
        float A[16], B[16];
#pragma unroll
        for (int i = 0; i < 16; ++i) { auto r = __builtin_amdgcn_permlane32_swap(__float_as_uint(a[i]), __float_as_uint(a[i]), false, false); A[i] = __uint_as_float(r[0]); B[i] = __uint_as_float(r[1]); }
#pragma unroll
        for (int i = 0; i < 16; ++i) a[i] = fmaxf(A[i], B[15 - i]);
        bmerge16(a);
    }
}
__host__ __device__ constexpr int pair_i(int id) {
    int c = 0;
    for (int i = 0; i < 16; ++i) { const int nj = 16 / (i + 1); if (id < c + nj) return i; c += nj; }
    return 0;
}
__host__ __device__ constexpr int pair_j(int id) {
    int c = 0;
    for (int i = 0; i < 16; ++i) { const int nj = 16 / (i + 1); if (id < c + nj) return id - c; c += nj; }
    return 0;
}
constexpr int SK_ROW = 272;
constexpr int SEL_SK_BYTES = 2 * 128 * SK_ROW;
constexpr int SEL_TAB_OFF = SEL_SK_BYTES;
constexpr int SEL_IDX_OFF = SEL_SK_BYTES + 64;

template <int S> __device__ __forceinline__ float cand_slot(const float (&L1)[16], const float (&L2)[16], int g) {
    constexpr int p0 = S, p1 = 16 + S, p2 = 32 + S, p3 = 48 + S;
    const float c0 = L1[pair_i(p0)] + L2[pair_j(p0)], c1 = L1[pair_i(p1)] + L2[pair_j(p1)], c2 = L1[pair_i(p2)] + L2[pair_j(p2)];
    const float c3 = p3 < 50 ? L1[pair_i(p3 < 50 ? p3 : 0)] + L2[pair_j(p3 < 50 ? p3 : 0)] : -1.0e30f;
    const float c = g == 0 ? c0 : (g == 1 ? c1 : (g == 2 ? c2 : c3));
    return __uint_as_float((__float_as_uint(c) & 0xffffffc0u) | (unsigned)(16 * g + S));
}

__device__ void ph_peer_select(const bf16* qry, const float* subkeys  , int* eidx, float* egate, LAS unsigned char* lds, int bid, int nb) {
    const int tid = ltid(), lane = tid & 63, w = __builtin_amdgcn_readfirstlane(tid >> 6);
    const int tk = lane & 15, g = lane >> 4;
    __syncthreads();
    for (int e = tid; e < 2 * 128 * 128 / 2; e += NT) {
        const int row = e >> 6, c2 = (e & 63) * 2;
        const float a = subkeys[(size_t)row * 128 + c2], b = subkeys[(size_t)row * 128 + c2 + 1];
        *(LAS unsigned*)(lds + row * SK_ROW + c2 * 2) = pk2(a, b);
    }
    if (tid < 64) { int id = tid; int c = 0, pi = 0, pj = 0;
        for (int i = 0; i < 16; ++i) { const int nj = 16 / (i + 1); if (id >= c && id < c + nj) { pi = i; pj = id - c; } c += nj; }
        lds[SEL_TAB_OFF + tid] = (unsigned char)((pi << 4) | pj); }
    __syncthreads();
    LAS unsigned* widx = (LAS unsigned*)(lds + SEL_IDX_OFF + w * 512);
    const LAS unsigned char* widx8 = (const LAS unsigned char*)widx;
    const int nitems = (MT / 16) * 8;
    for (int it = bid * 8 + w; it < nitems; it += nb * 8) {
        const int h = it & 7, t0 = (it >> 3) * 16;
        float L[2][16];
#pragma unroll
        for (int hf = 0; hf < 2; ++hf) {
            bf16x8 qf[4];
            const bf16* qp = qry + (size_t)(t0 + tk) * PQ + h * 256 + hf * 128 + 8 * g;
#pragma unroll
            for (int ks = 0; ks < 4; ++ks) qf[ks] = *(const bf16x8*)(qp + 32 * ks);
            float key[32];
#pragma unroll
            for (int tile = 0; tile < 8; ++tile) {
                f32x4 acc = {0.f, 0.f, 0.f, 0.f};
#pragma unroll
                for (int ks = 0; ks < 4; ++ks) {
                    const bf16x8 af = *(const LAS bf16x8*)(lds + (hf * 128 + tile * 16 + tk) * SK_ROW + (32 * ks + 8 * g) * 2);
                    acc = __builtin_amdgcn_mfma_f32_16x16x32_bf16(af, qf[ks], acc, 0, 0, 0);
                }
#pragma unroll
                for (int r = 0; r < 4; ++r) key[tile * 4 + r] = __uint_as_float((__float_as_uint(acc[r]) & 0xffffff80u) | (unsigned)(16 * tile + 4 * g + r));
            }
            float a[16], b[16];
#pragma unroll
            for (int i = 0; i < 16; ++i) { a[i] = key[i]; b[i] = key[16 + i]; }
            bsort16(a); bsort16(b);
            merge_top16(a, b);
            xmerge16(a);
#pragma unroll
            for (int i = 0; i < 16; ++i) L[hf][i] = a[i];
            unsigned pk = 0u;
#pragma unroll
            for (int s = 0; s < 4; ++s) {
                const float v = g == 0 ? a[s] : (g == 1 ? a[4 + s] : (g == 2 ? a[8 + s] : a[12 + s]));
                pk |= (__float_as_uint(v) & 127u) << (8 * s);
            }
            widx[tk * 8 + hf * 4 + g] = pk;
        }
        float c[16];
        c[0] = cand_slot<0>(L[0], L[1], g); c[1] = cand_slot<1>(L[0], L[1], g); c[2] = cand_slot<2>(L[0], L[1], g); c[3] = cand_slot<3>(L[0], L[1], g);
        c[4] = cand_slot<4>(L[0], L[1], g); c[5] = cand_slot<5>(L[0], L[1], g); c[6] = cand_slot<6>(L[0], L[1], g); c[7] = cand_slot<7>(L[0], L[1], g);
        c[8] = cand_slot<8>(L[0], L[1], g); c[9] = cand_slot<9>(L[0], L[1], g); c[10] = cand_slot<10>(L[0], L[1], g); c[11] = cand_slot<11>(L[0], L[1], g);
        c[12] = cand_slot<12>(L[0], L[1], g); c[13] = cand_slot<13>(L[0], L[1], g); c[14] = cand_slot<14>(L[0], L[1], g); c[15] = cand_slot<15>(L[0], L[1], g);
        bsort16(c);
        xmerge16(c);
        float sum = 0.f, ex[16];
#pragma unroll
        for (int i = 0; i < 16; ++i) { ex[i] = __builtin_amdgcn_exp2f((c[i] - c[0]) * L2E); sum += ex[i]; }
        const float inv = 1.0f / sum;
        int oi[4]; float og[4];
#pragma unroll
        for (int s = 0; s < 4; ++s) {
            const float kv = g == 0 ? c[s] : (g == 1 ? c[4 + s] : (g == 2 ? c[8 + s] : c[12 + s]));
            const float ev = g == 0 ? ex[s] : (g == 1 ? ex[4 + s] : (g == 2 ? ex[8 + s] : ex[12 + s]));
            const unsigned pid = __float_as_uint(kv) & 63u;
            const unsigned ij = lds[SEL_TAB_OFF + pid];
            const unsigned i1 = widx8[tk * 32 + (ij >> 4)], i2 = widx8[tk * 32 + 16 + (ij & 15u)];
            oi[s] = (int)(i1 * 128u + i2); og[s] = ev * inv;
        }
        const size_t ob = (size_t)(t0 + tk) * 128 + h * 16 + 4 * g;
        *(u32x4*)(eidx + ob) = (u32x4){(unsigned)oi[0], (unsigned)oi[1], (unsigned)oi[2], (unsigned)oi[3]};
        *(f32x4*)(egate + ob) = (f32x4){og[0], og[1], og[2], og[3]};
    }
    __syncthreads();
}

typedef float v32f_t __attribute__((ext_vector_type(32)));
typedef unsigned v6u_t __attribute__((ext_vector_type(6)));
typedef unsigned v16u_t __attribute__((ext_vector_type(16)));
typedef __bf16 v32bf_t __attribute__((ext_vector_type(32)));
typedef __bf16 v2bf_t __attribute__((ext_vector_type(2)));
typedef _Float16 v32h_t __attribute__((ext_vector_type(32)));
typedef unsigned u32x3 __attribute__((ext_vector_type(3)));
constexpr int TROW = 768;
__device__ void ph_tab_fp6(const float* src, unsigned char* dst, float* scale, int nrows, int bid, int nb) {
    const int lane = ltid() & 63, w = __builtin_amdgcn_readfirstlane(ltid() >> 6);
    for (int rp = bid * 8 + w; rp < nrows / 2; rp += nb * 8) {
        v32h_t hv; float sc[2];
#pragma unroll
        for (int rr = 0; rr < 2; ++rr) {
            const float* sp = src + (size_t)(2 * rp + rr) * DM + lane * 16;
            f32x4 v[4]; float am = 0.f;
#pragma unroll
            for (int i = 0; i < 4; ++i) { v[i] = *(const f32x4*)(sp + i * 4); am = fmaxf(am, fmaxf(fmaxf(fabsf(v[i][0]), fabsf(v[i][1])), fmaxf(fabsf(v[i][2]), fabsf(v[i][3])))); }
            am = wave_max(am);
            const float s = am > 0.f ? am * (1.0f / 7.5f) : 1.0f, inv = 1.0f / s;
            sc[rr] = s;
#pragma unroll
            for (int i = 0; i < 4; ++i)
#pragma unroll
                for (int e = 0; e < 4; ++e) hv[rr * 16 + i * 4 + e] = (_Float16)fminf(fmaxf(v[i][e] * inv, -7.5f), 7.5f);
        }
        const v6u_t pk = __builtin_amdgcn_cvt_scalef32_pk32_fp6_f16(hv, 1.0f);
        unsigned* d0 = (unsigned*)(dst + (size_t)(2 * rp) * TROW + lane * 12);
        unsigned* d1 = (unsigned*)(dst + (size_t)(2 * rp + 1) * TROW + lane * 12);
        d0[0] = pk[0]; d0[1] = pk[1]; d0[2] = pk[2]; d1[0] = pk[3]; d1[1] = pk[4]; d1[2] = pk[5];
        if (lane == 0) { scale[2 * rp] = sc[0]; scale[2 * rp + 1] = sc[1]; }
    }
}

constexpr int TROW4 = 512;
__device__ void ph_tab_fp4(const float* src, unsigned char* dst, float* scale, int nrows, int bid, int nb) {
    const int lane = ltid() & 63, w = __builtin_amdgcn_readfirstlane(ltid() >> 6);
    for (int row = bid * 8 + w; row < nrows; row += nb * 8) {
        const float* sp = src + (size_t)row * DM + lane * 16;
        f32x4 v[4]; float am = 0.f;
#pragma unroll
        for (int i = 0; i < 4; ++i) { v[i] = *(const f32x4*)(sp + i * 4); am = fmaxf(am, fmaxf(fmaxf(fabsf(v[i][0]), fabsf(v[i][1])), fmaxf(fabsf(v[i][2]), fabsf(v[i][3])))); }
        am = wave_max(am);
        const float s = am > 0.f ? am * (1.0f / 6.0f) : 1.0f, inv = 1.0f / s;
        unsigned d0 = 0u, d1 = 0u;
        d0 = __builtin_amdgcn_cvt_scalef32_pk_fp4_f32(d0, v[0][0] * inv, v[0][1] * inv, 1.0f, 0); d0 = __builtin_amdgcn_cvt_scalef32_pk_fp4_f32(d0, v[0][2] * inv, v[0][3] * inv, 1.0f, 1);
        d0 = __builtin_amdgcn_cvt_scalef32_pk_fp4_f32(d0, v[1][0] * inv, v[1][1] * inv, 1.0f, 2); d0 = __builtin_amdgcn_cvt_scalef32_pk_fp4_f32(d0, v[1][2] * inv, v[1][3] * inv, 1.0f, 3);
        d1 = __builtin_amdgcn_cvt_scalef32_pk_fp4_f32(d1, v[2][0] * inv, v[2][1] * inv, 1.0f, 0); d1 = __builtin_amdgcn_cvt_scalef32_pk_fp4_f32(d1, v[2][2] * inv, v[2][3] * inv, 1.0f, 1);
        d1 = __builtin_amdgcn_cvt_scalef32_pk_fp4_f32(d1, v[3][0] * inv, v[3][1] * inv, 1.0f, 2); d1 = __builtin_amdgcn_cvt_scalef32_pk_fp4_f32(d1, v[3][2] * inv, v[3][3] * inv, 1.0f, 3);
        *(u32x2*)(dst + (size_t)row * TROW4 + lane * 8) = (u32x2){d0, d1};
        if (lane == 0) scale[row] = s;
    }
}

#define DPP_ADD(v, ctrl) ((v) + __builtin_bit_cast(float, __builtin_amdgcn_update_dpp(0, __builtin_bit_cast(int, (v)), (ctrl), 0xf, 0xf, true)))
typedef int i32x4_t __attribute__((ext_vector_type(4)));
constexpr int GT = 2;
typedef int v8i_t __attribute__((ext_vector_type(8)));
typedef int v2i_t __attribute__((ext_vector_type(2)));
struct GSet { v6u_t uq[2]; u32x2 vq[4]; };
__device__ __forceinline__ void gather_issue(GSet& S, int bt, int lane, const unsigned char* pu, const unsigned char* pv, const LAS int* etok) {
    const i32x4_t ev = *(const LAS i32x4_t*)(etok + bt * 4);
    const int es[4] = {__builtin_amdgcn_readfirstlane(ev.x), __builtin_amdgcn_readfirstlane(ev.y), __builtin_amdgcn_readfirstlane(ev.z), __builtin_amdgcn_readfirstlane(ev.w)};
#pragma unroll
    for (int k = 0; k < 2; ++k) {
        const unsigned e0 = (unsigned)es[2 * k] * (unsigned)TROW + (unsigned)lane * 12u, e1 = (unsigned)es[2 * k + 1] * (unsigned)TROW + (unsigned)lane * 12u;
        const u32x3 a = *(const u32x3*)(pu + e0), c = *(const u32x3*)(pu + e1);
        S.uq[k] = (v6u_t){a.x, a.y, a.z, c.x, c.y, c.z};
        const unsigned f0 = (unsigned)es[2 * k] * (unsigned)TROW4 + (unsigned)lane * 8u, f1 = (unsigned)es[2 * k + 1] * (unsigned)TROW4 + (unsigned)lane * 8u;
        S.vq[2 * k] = *(const u32x2*)(pv + f0); S.vq[2 * k + 1] = *(const u32x2*)(pv + f1);
    }
}
constexpr int GV_ROW = 520;
constexpr int GV_BYTES = 16 * GV_ROW, GC_BYTES = 96;
__device__ __forceinline__ float gather_udot(const GSet& S, const unsigned (&hp)[8], LAS unsigned char* vrow) {
    typedef _Float16 h2v_t __attribute__((ext_vector_type(2)));
    float d[4];
#pragma unroll
    for (int k = 0; k < 2; ++k) {
        const v32h_t uf = __builtin_amdgcn_cvt_scalef32_pk32_f16_fp6(S.uq[k], 1.0f);
        float s0 = 0.f, s1 = 0.f;
#pragma unroll
        for (int i = 0; i < 8; ++i) { const h2v_t hh = __builtin_bit_cast(h2v_t, hp[i]);
            const h2v_t ua = {uf[2 * i], uf[2 * i + 1]}, ub = {uf[16 + 2 * i], uf[16 + 2 * i + 1]};
            s0 = __builtin_amdgcn_fdot2(ua, hh, s0, false); s1 = __builtin_amdgcn_fdot2(ub, hh, s1, false); }
        d[2 * k] = s0; d[2 * k + 1] = s1;
    }
#pragma unroll
    for (int k = 0; k < 4; ++k) *(LAS u32x2*)(vrow + k * GV_ROW) = S.vq[k];
    float e2[2], f1;
#pragma unroll
    for (int k = 0; k < 2; ++k) { auto r = __builtin_amdgcn_permlane16_swap(__float_as_uint(d[k]), __float_as_uint(d[k + 2]), false, false); e2[k] = __uint_as_float(r[0]) + __uint_as_float(r[1]); }
    { auto r = __builtin_amdgcn_permlane32_swap(__float_as_uint(e2[0]), __float_as_uint(e2[1]), false, false); f1 = __uint_as_float(r[0]) + __uint_as_float(r[1]); }
    f1 = DPP_ADD(f1, 0xB1); f1 = DPP_ADD(f1, 0x4E); f1 = DPP_ADD(f1, 0x124); f1 = DPP_ADD(f1, 0x128);
    return f1;
}
#define DPP_MAX(v, ctrl) fmaxf((v), __builtin_bit_cast(float, __builtin_amdgcn_update_dpp(0, __builtin_bit_cast(int, (v)), (ctrl), 0xf, 0xf, true)))
__device__ __forceinline__ void gather_vpart(float f0, float f1, float f2, float f3, int lane, int kslot, const LAS float* lg  ,
                                             const LAS unsigned char* vrd  , LAS unsigned char* cb, int aoff1, int aoff2, f32x4 (&acc)[8]) {
    const int q = (lane >> 2) & 3, e16 = 4 * q + kslot;
    const float fs = q == 0 ? f0 : q == 1 ? f1 : q == 2 ? f2 : f3;
    const float cv = lg[e16] * gelu_erf(fs * lg[GT * 128 + e16]);
    float mx = fabsf(cv);
    mx = DPP_MAX(mx, 0x124); mx = DPP_MAX(mx, 0x128);
    { auto r = __builtin_amdgcn_permlane16_swap(__float_as_uint(mx), __float_as_uint(mx), false, false); mx = fmaxf(__uint_as_float(r[0]), __uint_as_float(r[1])); }
    { auto r = __builtin_amdgcn_permlane32_swap(__float_as_uint(mx), __float_as_uint(mx), false, false); mx = fmaxf(__uint_as_float(r[0]), __uint_as_float(r[1])); }
    int E = (int)((__float_as_uint(mx) >> 23) & 0xffu); E = E < 8 ? 8 : E;
    const float x = cv * __uint_as_float((unsigned)(255 - E) << 23);
    const unsigned p1 = __builtin_amdgcn_cvt_scalef32_pk_fp4_f32(0u, x, 0.f, 1.0f, 0);
    const float r1 = x - __builtin_amdgcn_cvt_scalef32_pk_f32_fp4(p1, 1.0f, 0)[0];
    const unsigned p2 = __builtin_amdgcn_cvt_scalef32_pk_fp4_f32(0u, r1, 0.f, 1.0f, 0);
    const float y = (r1 - __builtin_amdgcn_cvt_scalef32_pk_f32_fp4(p2, 1.0f, 0)[0]) * 16.0f;
    const unsigned p3 = __builtin_amdgcn_cvt_scalef32_pk_fp4_f32(0u, y, 0.f, 1.0f, 0);
    const float r3 = y - __builtin_amdgcn_cvt_scalef32_pk_f32_fp4(p3, 1.0f, 0)[0];
    const unsigned p4 = __builtin_amdgcn_cvt_scalef32_pk_fp4_f32(0u, r3, 0.f, 1.0f, 0);
    const unsigned codes = (p1 & 15u) | ((p2 & 15u) << 8) | ((p3 & 15u) << 16) | ((p4 & 15u) << 24);
    { auto r = __builtin_amdgcn_permlane32_swap(codes, codes, false, false);
      const unsigned w = codes | ((r[0] ^ r[1] ^ codes) << 4);
      if (lane < 32 && (lane & 3) == 0) {
          LAS unsigned char* tb = cb + 8 + 2 * q + ((lane >> 4) & 1);
          tb[0] = (unsigned char)w; tb[16] = (unsigned char)(w >> 8); tb[32] = (unsigned char)(w >> 16); tb[48] = (unsigned char)(w >> 24);
      } }
    const u32x2 a10 = *(const LAS u32x2*)(cb + aoff1), a11 = *(const LAS u32x2*)(cb + aoff1 + 8), a20 = *(const LAS u32x2*)(cb + aoff2), a21 = *(const LAS u32x2*)(cb + aoff2 + 8);
    const v8i_t A1 = {(int)a10.x, (int)a10.y, (int)a11.x, (int)a11.y, 0, 0, 0, 0}, A2 = {(int)a20.x, (int)a20.y, (int)a21.x, (int)a21.y, 0, 0, 0, 0};
    const int sa1 = (E - 1) * 0x01010101, sa2 = (E - 5) * 0x01010101;
#pragma unroll
    for (int m = 0; m < 8; ++m) {
        const v2i_t t0 = __builtin_amdgcn_ds_read_tr4_b64_v2i32((LAS v2i_t*)(vrd + 16 * m)), t1 = __builtin_amdgcn_ds_read_tr4_b64_v2i32((LAS v2i_t*)(vrd + 16 * m + 8));
        const v8i_t B = {t0.x, t0.y, t1.x, t1.y, 0, 0, 0, 0};
        acc[m] = __builtin_amdgcn_mfma_scale_f32_16x16x128_f8f6f4(A1, B, acc[m], 4, 4, 0, sa1, 0, 0x7F7F7F7F);
        acc[m] = __builtin_amdgcn_mfma_scale_f32_16x16x128_f8f6f4(A2, B, acc[m], 4, 4, 0, sa2, 0, 0x7F7F7F7F);
    }
}
__device__ __forceinline__ void xcd_pace(unsigned* bar, volatile LAS unsigned* st);
constexpr int GNS = 8, GBPS = 32 / GNS, GSHIFT = 11;
constexpr int GATH_LDS_WAVE = GT * 128 * 12 + GV_BYTES + GC_BYTES;
#define GATH_SEG(J, NJ, nbt) { \
        const LAS int* le_ = lse + (J) * 128; const LAS int* ne_ = lse + (NJ) * 128; \
        gather_issue(D, GBPS * c + 3, lane, pu, pv, le_); \
        const float f0_ = gather_udot(A, hx[J], vwr); \
        gather_issue(A, (nbt), lane, pu, pv, ne_); \
        const float f1_ = gather_udot(B, hx[J], vwr + 4 * GV_ROW); \
        gather_issue(B, (nbt) + 1, lane, pu, pv, ne_); \
        const float f2_ = gather_udot(C, hx[J], vwr + 8 * GV_ROW); \
        gather_issue(C, (nbt) + 2, lane, pu, pv, ne_); \
        const float f3_ = gather_udot(D, hx[J], vwr + 12 * GV_ROW); \
        gather_vpart(f0_, f1_, f2_, f3_, lane, kslot, lsg + (J) * 128 + 16 * c, vrd, cb, aoff1, aoff2, acc[J]); }
__device__ void ph_peer_gather(const bf16* h2, const unsigned char* pu, const unsigned char* pv, const float* su, const float* sv,
                               const int* eidx, const float* egate, const float* xin, const float* gate  , float* xout, LAS unsigned char* lds, unsigned* pace_bar, volatile LAS unsigned* pace_st, int bid, int nb) {
    const int lane0 = ltid() & 63, w = __builtin_amdgcn_readfirstlane(ltid() >> 6);
    LAS int* lse = (LAS int*)(lds + w * GATH_LDS_WAVE); LAS float* lsg = (LAS float*)(lds + w * GATH_LDS_WAVE + GT * 128 * 4);
    LAS unsigned char* vb = lds + w * GATH_LDS_WAVE + GT * 128 * 12; LAS unsigned char* cb = vb + GV_BYTES;
    if (lane0 < GC_BYTES / 4) ((LAS unsigned*)cb)[lane0] = 0u;
    for (int t0 = (bid * 8 + w) * GT; t0 < MT; t0 += nb * 8 * GT) {
        int lane = lane0; asm volatile("" : "+v"(lane));
        const int row = lane >> 4;
        const int kslot = 2 * (row & 1) + (row >> 1);
        const int b = t0 >> 11;
        LAS unsigned char* vwr = vb + lane * 8;
        const LAS unsigned char* vrd = vb + (lane & 15) * GV_ROW + 128 * row;
        const int ai = lane & 15, au = (ai < 8 ? 1 : 3), nz = ((ai & 7) >> 1) == row;
        const int aoff1 = nz ? 8 * (au - (ai & 1)) : 64, aoff2 = nz ? 8 * (au + 4 - (ai & 1)) : 64;
        unsigned hx[GT][8]; f32x4 acc[GT][8];
#pragma unroll
        for (int j = 0; j < GT; ++j) {
            const int t = t0 + j;
            const int e0 = eidx[(size_t)t * 128 + lane], e1 = eidx[(size_t)t * 128 + 64 + lane];
            const float g0 = egate[(size_t)t * 128 + lane], g1 = egate[(size_t)t * 128 + 64 + lane];
            const int k0 = e0 >> GSHIFT, k1 = e1 >> GSHIFT;
            int off = 0, d0 = 0, d1 = 0;
#pragma unroll
            for (int s = 0; s < GNS; ++s) {
                const unsigned long long m0 = __ballot(k0 == s), m1 = __ballot(k1 == s);
                const int r0 = (int)__builtin_amdgcn_mbcnt_hi((unsigned)(m0 >> 32), __builtin_amdgcn_mbcnt_lo((unsigned)m0, 0u));
                const int r1 = (int)__builtin_amdgcn_mbcnt_hi((unsigned)(m1 >> 32), __builtin_amdgcn_mbcnt_lo((unsigned)m1, 0u));
                const int c0 = __builtin_popcountll(m0);
                if (k0 == s) d0 = off + r0;
                if (k1 == s) d1 = off + c0 + r1;
                off += c0 + __builtin_popcountll(m1);
            }
            lse[j * 128 + d0] = e0; lsg[j * 128 + d0] = g0 * sv[e0]; lse[j * 128 + d1] = e1; lsg[j * 128 + d1] = g1 * sv[e1];
            lsg[GT * 128 + j * 128 + d0] = su[e0]; lsg[GT * 128 + j * 128 + d1] = su[e1];
            const u32x4 u0 = *(const u32x4*)(h2 + (size_t)t * DM + lane * 16), u1 = *(const u32x4*)(h2 + (size_t)t * DM + lane * 16 + 8);
#pragma unroll
            for (int i = 0; i < 4; ++i) {
                hx[j][i] = __builtin_bit_cast(unsigned, __builtin_amdgcn_cvt_pkrtz(__uint_as_float(u0[i] << 16), __uint_as_float(u0[i] & 0xffff0000u)));
                hx[j][4 + i] = __builtin_bit_cast(unsigned, __builtin_amdgcn_cvt_pkrtz(__uint_as_float(u1[i] << 16), __uint_as_float(u1[i] & 0xffff0000u)));
            }
#pragma unroll
            for (int i = 0; i < 8; ++i) acc[j][i] = (f32x4){0.f, 0.f, 0.f, 0.f};
        }
        GSet A, B, C, D;
        gather_issue(A, 0, lane, pu, pv, lse); gather_issue(B, 1, lane, pu, pv, lse); gather_issue(C, 2, lane, pu, pv, lse);
#pragma unroll 1
        for (int c = 0; c < GNS; ++c) {
            GATH_SEG(0, 1, GBPS * c)
            GATH_SEG(1, 0, c < GNS - 1 ? GBPS * c + GBPS : 0)
        }
#pragma unroll
        for (int j = 0; j < GT; ++j) {
            const int t = t0 + j;
            LAS float* ob = (LAS float*)vb;
            const int nbase = 512 * (row & 1) + 32 * (row >> 1) + (lane & 15);
#pragma unroll
            for (int pm = 0; pm < 4; ++pm)
#pragma unroll
                for (int r = 0; r < 4; ++r) {
                    auto sw = __builtin_amdgcn_permlane32_swap(__float_as_uint(acc[j][2 * pm][r]), __float_as_uint(acc[j][2 * pm + 1][r]), false, false);
                    ob[nbase + 256 * (r >> 1) + 64 * pm + 16 * (r & 1)] = __uint_as_float(sw[0]) + __uint_as_float(sw[1]);
                }
#pragma unroll
            for (int i = 0; i < 4; ++i) {
                const int cc = i * 256 + lane * 4;
                const f32x4 a = *(const LAS f32x4*)(ob + cc);
                const f32x4 xi = *(const f32x4*)(xin + (size_t)t * DM + cc), gt = *(const f32x4*)(gate + (size_t)b * 6144 + cc);
                f32x4 o;
#pragma unroll
                for (int e = 0; e < 4; ++e) o[e] = xi[e] + gt[e] * a[e];
                *(f32x4*)(xout + (size_t)t * DM + cc) = o;
            }
        }
    }
}

#define XB_TMO      128
#define XB_XCNT(j)  (256  + 64 * (j))
#define XB_XSUB(j)  (1280 + 64 * (j))
#define XB_XGEN(j)  (2304 + 64 * (j))
#define XB_TOP      3328
#define XB_TOPGEN   3392
#define XCD_BAR_WORDS 3456
#define XB_SPIN_CAP (1u << 18)

__device__ __forceinline__ unsigned xb_ld(unsigned* p)              { return __hip_atomic_load(p, __ATOMIC_RELAXED, __HIP_MEMORY_SCOPE_AGENT); }
__device__ __forceinline__ unsigned xb_add(unsigned* p, unsigned v) { return __hip_atomic_fetch_add(p, v, __ATOMIC_RELAXED, __HIP_MEMORY_SCOPE_AGENT); }
__device__ __forceinline__ unsigned xb_xcc_id() { return (unsigned)__builtin_amdgcn_s_getreg((3 << 11) | 20) & 0xFu; }
#define XB_SPIN(cond, bar) do { unsigned _sp = 0; while (cond) { __builtin_amdgcn_s_sleep(1); \
    if ((++_sp & 255u) == 0u) { if (xb_ld(&(bar)[XB_TMO])) break; if (_sp > XB_SPIN_CAP) { atomicAdd(&(bar)[XB_TMO], 1u); break; } } } } while (0)

struct XcdBarrier {
    unsigned* bar; unsigned x;
    volatile LAS unsigned* st;
};

__device__ __forceinline__ XcdBarrier xcd_barrier_post(unsigned* bar, volatile LAS unsigned* st) {
    XcdBarrier b; b.bar = bar; b.x = xb_xcc_id(); b.st = st;
    if (threadIdx.x == 0) (void)xb_add(&bar[XB_XCNT(b.x)], 1u);
    return b;
}
__device__ __forceinline__ void xcd_barrier_complete(unsigned* bar, unsigned x, unsigned& nloc, unsigned& nx) {
    const unsigned G = gridDim.x * gridDim.y * gridDim.z;
    unsigned sum, cnt, mine, sp = 0u;
    for (;;) {
        sum = 0u; cnt = 0u; mine = 0u;
#pragma unroll
        for (unsigned j = 0; j < 16; ++j) { const unsigned c = xb_ld(&bar[XB_XCNT(j)]); sum += c; cnt += (c > 0u) ? 1u : 0u; mine = (j == x) ? c : mine; }
        if (sum == G) break;
        __builtin_amdgcn_s_sleep(1);
        if ((++sp & 255u) == 0u) { if (xb_ld(&bar[XB_TMO])) break; if (sp > XB_SPIN_CAP) { atomicAdd(&bar[XB_TMO], 1u); break; } }
    }
    nloc = mine > 0u ? mine : 1u; nx = cnt > 0u ? cnt : 1u;
}

__device__ __forceinline__ void xcd_barrier(const XcdBarrier& b) {
    asm volatile("s_waitcnt vmcnt(0)" ::: "memory");
    __syncthreads();
    if (threadIdx.x == 0) {
        unsigned* bar = b.bar;
        __builtin_amdgcn_s_waitcnt(0);
        unsigned nloc = b.st[0], nx = b.st[1];
        if (nloc == 0u) { xcd_barrier_complete(bar, b.x, nloc, nx); b.st[0] = nloc; b.st[1] = nx; }
        const unsigned old = xb_add(&bar[XB_XSUB(b.x)], 1u);
        const unsigned gen = old / nloc;
        if (old + 1u == (gen + 1u) * nloc) {
            __builtin_amdgcn_fence(__ATOMIC_RELEASE, "agent");
            asm volatile("s_waitcnt vmcnt(0)" ::: "memory");
            const unsigned og = xb_add(&bar[XB_TOP], 1u);
            const unsigned tg = og / nx;
            if (og + 1u == (tg + 1u) * nx) xb_add(&bar[XB_TOPGEN], 1u);
            else XB_SPIN(xb_ld(&bar[XB_TOPGEN]) == tg, bar);
            __builtin_amdgcn_fence(__ATOMIC_ACQUIRE, "agent");
            xb_add(&bar[XB_XGEN(b.x)], 1u);
            asm volatile("s_waitcnt vmcnt(0)" ::: "memory");
        } else {
            XB_SPIN(xb_ld(&bar[XB_XGEN(b.x)]) == gen, bar);
            __builtin_amdgcn_fence(__ATOMIC_ACQUIRE, "agent");
            asm volatile("s_waitcnt vmcnt(0)" ::: "memory");
        }
    }
    __syncthreads();
}


#define XB_PACE(j) (3584 + 64 * (j))
__device__ __forceinline__ void xcd_pace(unsigned* bar, volatile LAS unsigned* st) {
    __syncthreads();
    if (threadIdx.x == 0) {
        const unsigned nloc = st[0] ? st[0] : 1u, x = xb_xcc_id(), gen = st[4] + 1u;
        st[4] = gen;
        xb_add(&bar[XB_PACE(x)], 1u);
        unsigned sp = 0;
        while (xb_ld(&bar[XB_PACE(x)]) < gen * nloc) { __builtin_amdgcn_s_sleep(1); if (++sp > (1u << 16)) break; }
    }
    __syncthreads();
}
extern __shared__ __attribute__((aligned(16))) unsigned char dyn_lds[];
#ifndef REP_PREP
#define REP_PREP 1
#endif
#ifndef REP_ATTN
#define REP_ATTN 1
#endif
#ifndef REP_SEL
#define REP_SEL 1
#endif
#ifndef REP_GATH
#define REP_GATH 1
#endif
#ifndef REP_GEMM
#define REP_GEMM 1
#endif
#ifndef REP_ADALN
#define REP_ADALN 1
#endif
constexpr int LDS_BYTES = 147456;

template <class T> __device__ __forceinline__ T* karg(int byte_off) {
    const __attribute__((address_space(4))) char* base = (const __attribute__((address_space(4))) char*)__builtin_amdgcn_kernarg_segment_ptr();
    unsigned long long v = *(const __attribute__((address_space(4))) unsigned long long*)(base + byte_off);
    asm volatile("" : "+s"(v));
    return (T*)(__attribute__((address_space(1))) T*)v;
}
#define KIN(i) karg<const float>(8 * (i))
#define KOUT() karg<float>(168)
#define KWS() karg<unsigned char>(176)
static_assert(sizeof(Params) == 184, "Params layout");
template <class T> __device__ __forceinline__ T* launder(T* p) { size_t off = 0; asm volatile("" : "+s"(off)); return (T*)((unsigned char*)p + off); }
__global__ void __launch_bounds__(NT) mega_fwd(Params p) {
    cg::grid_group grid = cg::this_grid();
    const int bid = blockIdx.x, nb = gridDim.x;
    volatile LAS unsigned* bst = (volatile LAS unsigned*)((LAS unsigned char*)dyn_lds + LDS_BYTES - 64);
    if (ltid() < 16) bst[ltid()] = 0u;
    __syncthreads();
    const XcdBarrier xbar = xcd_barrier_post((unsigned*)(KWS() + WS_BAR), bst);
    for (int rep = 0; rep < REP_PREP; ++rep) {
        unsigned char* ws = KWS();
        float* tile = (float*)dyn_lds;
        ph_transpose(KIN(6), (bf16*)(ws + WS_WIN0), 1024, AB_IN, true, tile, bid, nb);
        ph_transpose(KIN(11), (bf16*)(ws + WS_WIN1), 1024, CD_IN, true, tile, bid, nb);
        ph_transpose(KIN(7), (bf16*)(ws + WS_WO0), 1024, 1024, false, tile, bid, nb);
        ph_transpose(KIN(12), (bf16*)(ws + WS_WO1), 1024, 1024, false, tile, bid, nb);
        ph_transpose(KIN(17), (bf16*)(ws + WS_WQ), 1024, PQ, false, tile, bid, nb);
        ph_transpose(KIN(17) + (size_t)1024 * PQ, (bf16*)(ws + WS_WQ) + (size_t)PQ * 1024, 1024, PQ, false, tile, bid, nb);
        ws = launder(ws);
        ph_tab_fp6(KIN(19), ws + WS_PU, (float*)(ws + WS_PV), 2 * NEXP, bid, nb);
        ph_tab_fp4(KIN(20), ws + WS_PU + 32 * MiB, (float*)(ws + WS_PV + 1 * MiB), 2 * NEXP, bid, nb);
        ws = launder(ws);
        ph_mod(KIN(1), KIN(2), KIN(3), (float*)(ws + WS_MOD), (float*)dyn_lds, bid, nb);
        ph_rope_table((float*)(ws + WS_ROPE), bid, nb);
        for (int i = bid * NT + ltid(); i < NB * 8 * 8 * 64; i += nb * NT) ((float*)(ws + WS_KMEAN))[i] = 0.f;
    }
    grid.sync();
#pragma unroll 1
    for (int layer = 0; layer < 2; ++layer) {
        for (int rep = 0; rep < REP_ADALN; ++rep) {
            unsigned char* ws = KWS(); const float* mod = (const float*)(ws + WS_MOD) + (size_t)layer * 32 * 6144;
            ph_adaln(layer == 0 ? KIN(0) : KOUT(), KIN(4) + layer * DM, mod + 0, mod + 1024, (bf16*)(ws + WS_HY), bid, nb);
        }
        xcd_barrier(xbar);
        for (int rep = 0; rep < REP_GEMM; ++rep) {
            unsigned char* ws = KWS();
            pg8::Gemm g{(const bf16*)(ws + WS_HY), (const bf16*)(ws + (layer == 0 ? WS_WIN0 : WS_WIN1)), MT, layer == 0 ? AB_IN : CD_IN, DM};
            pg8::StaticOrder S; S.init(g.M, g.N, nb, bid);
            pg8::EpiQKV e{(bf16*)(ws + WS_QKV), QKV_LD, (const float*)(ws + WS_ROPE), layer, layer == 0 ? KIN(9) : KIN(13), layer == 0 ? KIN(10) : KIN(14), KIN(15), KIN(16), (float*)(ws + WS_KMEAN)};
            pg8::gemm_phase<pg8::EpiQKV, pg8::StaticOrder, true, true>((LAS unsigned char*)dyn_lds, g, S, e);
        }
        xcd_barrier(xbar);
        for (int rep = 0; rep < REP_ATTN; ++rep) {
            unsigned char* ws = KWS();
            if (layer == 0) ph_attn0((const bf16*)(ws + WS_QKV), KIN(8), (bf16*)(ws + WS_HY), (LAS unsigned char*)dyn_lds, bid, nb);
            else ph_attn1((const bf16*)(ws + WS_QKV), (const float*)(ws + WS_KMEAN), (bf16*)(ws + WS_HY), (LAS unsigned char*)dyn_lds, bid, nb);
        }
        xcd_barrier(xbar);
        for (int rep = 0; rep < REP_GEMM; ++rep) {
            unsigned char* ws = KWS(); const float* mod = (const float*)(ws + WS_MOD) + (size_t)layer * 32 * 6144;
            pg8::Gemm g{(const bf16*)(ws + WS_HY), (const bf16*)(ws + (layer == 0 ? WS_WO0 : WS_WO1)), MT, DM, DM};
            pg8::StaticOrder S; S.init(g.M, g.N, nb, bid); pg8::EpiResid e{layer == 0 ? KIN(0) : KOUT(), (float*)(ws + WS_X1), mod + 2048};
            pg8::gemm_phase<pg8::EpiResid, pg8::StaticOrder, true, true>((LAS unsigned char*)dyn_lds, g, S, e);
        }
        xcd_barrier(xbar);
        for (int rep = 0; rep < REP_ADALN; ++rep) {
            unsigned char* ws = KWS(); const float* mod = (const float*)(ws + WS_MOD) + (size_t)layer * 32 * 6144;
            ph_adaln((const float*)(ws + WS_X1), KIN(5) + layer * DM, mod + 3072, mod + 4096, (bf16*)(ws + WS_QKV), bid, nb);
        }
        xcd_barrier(xbar);
        for (int rep = 0; rep < REP_GEMM; ++rep) {
            unsigned char* ws = KWS();
            pg8::Gemm g{(const bf16*)(ws + WS_QKV), (const bf16*)(ws + WS_WQ) + (size_t)layer * PQ * DM, MT, PQ, DM};
            pg8::StaticOrder S; S.init(g.M, g.N, nb, bid); pg8::EpiStore e{(bf16*)(ws + WS_QKV + 128 * MiB), PQ};
            pg8::gemm_phase<pg8::EpiStore, pg8::StaticOrder, true, true>((LAS unsigned char*)dyn_lds, g, S, e);
        }
        xcd_barrier(xbar);
        for (int rep = 0; rep < REP_SEL; ++rep) {
            unsigned char* ws = KWS();
            ph_peer_select((const bf16*)(ws + WS_QKV + 128 * MiB), KIN(18) + (size_t)layer * 2 * 128 * 128, (int*)(ws + WS_HY), (float*)(ws + WS_HY + 32 * MiB), (LAS unsigned char*)dyn_lds, bid, nb);
        }
        xcd_barrier(xbar);
        for (int rep = 0; rep < REP_GATH; ++rep) {
            unsigned char* ws = KWS(); const float* mod = (const float*)(ws + WS_MOD) + (size_t)layer * 32 * 6144;
            ph_peer_gather((const bf16*)(ws + WS_QKV), ws + WS_PU + (size_t)layer * NEXP * TROW, ws + WS_PU + 32 * MiB + (size_t)layer * NEXP * TROW4,
                           (const float*)(ws + WS_PV) + layer * NEXP, (const float*)(ws + WS_PV + 1 * MiB) + layer * NEXP, (const int*)(ws + WS_HY), (const float*)(ws + WS_HY + 32 * MiB), (const float*)(ws + WS_X1), mod + 5120, KOUT(), (LAS unsigned char*)dyn_lds, (unsigned*)(ws + WS_BAR), bst, bid, nb);
        }
        if (layer == 0) xcd_barrier(xbar);
    }
}

extern "C" void kernel_launch(void* const* d_in, const int* in_sizes, int n_in, void* d_out, int out_size, void* d_ws, size_t ws_size, hipStream_t stream) {
    if (n_in != 21 || ws_size < WS_END) { fprintf(stderr, "kernel_launch: bad args n_in=%d ws=%zu\n", n_in, ws_size); return; }
    static int grid_blocks = 0;
    if (!grid_blocks) {
        int dev = 0, cus = 0, per_cu = 0;
        (void)hipGetDevice(&dev);
        (void)hipDeviceGetAttribute(&cus, hipDeviceAttributeMultiprocessorCount, dev);
        (void)hipFuncSetAttribute((const void*)mega_fwd, hipFuncAttributeMaxDynamicSharedMemorySize, LDS_BYTES);
        (void)hipOccupancyMaxActiveBlocksPerMultiprocessor(&per_cu, (const void*)mega_fwd, NT, LDS_BYTES);
        if (per_cu < 1) { fprintf(stderr, "kernel_launch: occupancy query returned %d\n", per_cu); per_cu = 1; }
        if (per_cu > 1) per_cu = 1;
        grid_blocks = cus * per_cu;
    }
    Params p{};
    for (int i = 0; i < 21; ++i) p.in[i] = (const float*)d_in[i];
    p.out = (float*)d_out; p.ws = (unsigned char*)d_ws;
    (void)hipMemsetAsync((char*)d_ws + WS_BAR, 0, 16384, stream);
    void* args[] = {&p};
    hipError_t e = hipLaunchCooperativeKernel((const void*)mega_fwd, dim3(grid_blocks), dim3(NT), args, LDS_BYTES, stream);
    if (e != hipSuccess) fprintf(stderr, "cooperative launch failed: %s (grid %d)\n", hipGetErrorString(e), grid_blocks);
}
```

```cpp
#include <hip/hip_runtime.h>
#ifndef REP_A
#define REP_A 1
#endif
#ifndef REP_B
#define REP_B 1
#endif
#ifndef REP_C
#define REP_C 1
#endif
#ifndef REP_D
#define REP_D 1
#endif
#include <hip/hip_cooperative_groups.h>
namespace cg = cooperative_groups;
#include <cstdio>
#include <cstdint>
#include <cmath>

typedef unsigned short bf16;
typedef short bf16x8 __attribute__((ext_vector_type(8)));
typedef float f32x4 __attribute__((ext_vector_type(4)));
typedef unsigned u32x4 __attribute__((ext_vector_type(4)));
typedef unsigned u32x2 __attribute__((ext_vector_type(2)));

constexpr int DM = 1024, NB = 32, SQ = 2048, MT = NB * SQ;
constexpr int HD = 64;
constexpr int AB_IN = 2304, CD_IN = 3072, QKV_LD = 3072;
constexpr int NEXP = 16384, PQ = 2048;
constexpr float EPS = 1e-6f;
constexpr int NT = 512;

constexpr size_t MiB = 1u << 20;
constexpr size_t WS_X1 = 0;
constexpr size_t WS_QKV = 256 * MiB;
constexpr size_t WS_HY = 640 * MiB;
constexpr size_t WS_PU = 768 * MiB;
constexpr size_t WS_PV = 832 * MiB;
constexpr size_t WS_WIN0 = 896 * MiB;
constexpr size_t WS_WIN1 = 901 * MiB;
constexpr size_t WS_WO0 = 907 * MiB;
constexpr size_t WS_WO1 = 909 * MiB;
constexpr size_t WS_WQ = 911 * MiB;
constexpr size_t WS_MOD = 919 * MiB;
constexpr size_t WS_ROPE = 921 * MiB;
constexpr size_t WS_KMEAN = 922 * MiB;
constexpr size_t WS_BAR = 923 * MiB;
constexpr size_t WS_END = 924 * MiB;

struct Params {
    const float* in[21];
    float* out;
    unsigned char* ws;
};

__device__ __forceinline__ int ltid() { int t = (int)__builtin_amdgcn_workitem_id_x(); asm volatile("" : "+v"(t)); return t; }
__device__ __forceinline__ float bf2f(unsigned b) { return __uint_as_float(b << 16); }
__device__ __forceinline__ unsigned f2bf(float f) { unsigned u = __float_as_uint(f); return (u + 0x7fffu + ((u >> 16) & 1u)) >> 16; }
__device__ __forceinline__ unsigned pk2(float lo, float hi) { return f2bf(lo) | (f2bf(hi) << 16); }
#define DPPV(v, ctrl) __builtin_bit_cast(float, __builtin_amdgcn_update_dpp(0, __builtin_bit_cast(int, (v)), (ctrl), 0xf, 0xf, true))
__device__ __forceinline__ float row16_sum(float v) { v += DPPV(v, 0xB1); v += DPPV(v, 0x4E); v += DPPV(v, 0x124); v += DPPV(v, 0x128); return v; }
__device__ __forceinline__ float rows_sum(float v) {
    { auto r = __builtin_amdgcn_permlane16_swap(__float_as_uint(v), __float_as_uint(v), false, false); v = __uint_as_float(r[0]) + __uint_as_float(r[1]); }
    { auto r = __builtin_amdgcn_permlane32_swap(__float_as_uint(v), __float_as_uint(v), false, false); v = __uint_as_float(r[0]) + __uint_as_float(r[1]); }
    return v;
}
__device__ __forceinline__ float wave_sum(float v) { return rows_sum(row16_sum(v)); }
__device__ __forceinline__ float wave_max(float v) {
    v = fmaxf(v, DPPV(v, 0xB1)); v = fmaxf(v, DPPV(v, 0x4E)); v = fmaxf(v, DPPV(v, 0x124)); v = fmaxf(v, DPPV(v, 0x128));
    { auto r = __builtin_amdgcn_permlane16_swap(__float_as_uint(v), __float_as_uint(v), false, false); v = fmaxf(__uint_as_float(r[0]), __uint_as_float(r[1])); }
    { auto r = __builtin_amdgcn_permlane32_swap(__float_as_uint(v), __float_as_uint(v), false, false); v = fmaxf(__uint_as_float(r[0]), __uint_as_float(r[1])); }
    return v;
}
__device__ __forceinline__ float gelu_erf(float x) {
    const float z = x * 0.70710678118654752f, az = fabsf(z);
    const float t = __builtin_amdgcn_rcpf(fmaf(0.3275911f, az, 1.0f));
    float pl = fmaf(t, 1.061405429f, -1.453152027f); pl = fmaf(t, pl, 1.421413741f); pl = fmaf(t, pl, -0.284496736f); pl = fmaf(t, pl, 0.254829592f); pl *= t;
    const float ex = __builtin_amdgcn_exp2f(az * (az * -1.4426950408889634f));
    const float er = copysignf(fmaf(-pl, ex, 1.0f), z);
    const float hx = 0.5f * x;
    return fmaf(hx, er, hx);
}

__device__ __forceinline__ int qkv_logical_col(int p) { return (p & ~255) | (((p >> 5) & 3) << 6) | (((p >> 7) & 1) << 5) | (p & 31); }
__device__ void ph_transpose(const float* W, bf16* Wt, int K, int N, bool permute, float* tile  , int bid, int nb) {
    const int tid = ltid();
    const int nkt = K / 64, nnt = N / 64;
    for (int it = bid; it < nkt * nnt; it += nb) {
        const int k0 = (it / nnt) * 64, n0 = (it % nnt) * 64;
        __syncthreads();
        for (int e = tid; e < 64 * 64; e += NT) { const int r = e >> 6, c = e & 63; const int nl = permute ? qkv_logical_col(n0 + c) : n0 + c; tile[r * 65 + c] = W[(size_t)(k0 + r) * N + nl]; }
        __syncthreads();
        {
            const int n = tid >> 3, k8 = (tid & 7) * 8;
            u32x4 v;
            v.x = pk2(tile[(k8 + 0) * 65 + n], tile[(k8 + 1) * 65 + n]);
            v.y = pk2(tile[(k8 + 2) * 65 + n], tile[(k8 + 3) * 65 + n]);
            v.z = pk2(tile[(k8 + 4) * 65 + n], tile[(k8 + 5) * 65 + n]);
            v.w = pk2(tile[(k8 + 6) * 65 + n], tile[(k8 + 7) * 65 + n]);
            *(u32x4*)(Wt + (size_t)(n0 + n) * K + k0 + k8) = v;
        }
    }
}
__device__ void ph_convert(const float* src, bf16* dst, size_t n, int bid, int nb) {
    const size_t n8 = n / 8;
    for (size_t i = (size_t)bid * NT + ltid(); i < n8; i += (size_t)nb * NT) {
        const f32x4 a = *(const f32x4*)(src + i * 8), b = *(const f32x4*)(src + i * 8 + 4);
        u32x4 v; v.x = pk2(a[0], a[1]); v.y = pk2(a[2], a[3]); v.z = pk2(b[0], b[1]); v.w = pk2(b[2], b[3]);
        *(u32x4*)(dst + i * 8) = v;
    }
}
__device__ void ph_mod(const float* c, const float* ada_w, const float* ada_b, float* mod, float* lds  , int bid, int nb) {
    const int tid = ltid(), lane = tid & 63, w = tid >> 6;
    for (int it = bid; it < 2 * 96; it += nb) {
        const int l = it / 96, j = (it % 96) * 64 + lane;
        float acc[32];
#pragma unroll
        for (int b = 0; b < 32; ++b) acc[b] = 0.f;
        for (int kh = 0; kh < 2; ++kh) {
            __syncthreads();
            for (int e = tid; e < 32 * 512; e += NT) { const int b = e >> 9, k = e & 511; const float cv = c[b * 1024 + kh * 512 + k]; lds[e] = cv / (1.0f + __expf(-cv)); }
            __syncthreads();
            for (int kk = 0; kk < 64; ++kk) {
                const int k = w * 64 + kk;
                const float wv = ada_w[((size_t)l * 1024 + kh * 512 + k) * 6144 + j];
#pragma unroll
                for (int b = 0; b < 32; ++b) acc[b] += lds[b * 512 + k] * wv;
            }
        }
        __syncthreads();
#pragma unroll
        for (int b = 0; b < 32; ++b) lds[(w * 32 + b) * 64 + lane] = acc[b];
        __syncthreads();
        for (int e = tid; e < 32 * 64; e += NT) {
            const int b = e >> 6, jj = e & 63; float s = 0.f;
#pragma unroll
            for (int ww = 0; ww < 8; ++ww) s += lds[(ww * 32 + b) * 64 + jj];
            const int jo = (it % 96) * 64 + jj;
            mod[((size_t)l * 32 + b) * 6144 + jo] = s + ada_b[l * 6144 + jo];
        }
    }
}
__device__ void ph_rope_table(float* rope, int bid, int nb) {
    for (int i = bid * NT + ltid(); i < SQ * 32; i += nb * NT) {
        const int t = i >> 5, f = i & 31;
        const float inv = powf(10000.0f, -(float)f / 32.0f);
        const float ang = (float)t * inv;
        float s, c; sincosf(ang, &s, &c);
        rope[i * 2] = c; rope[i * 2 + 1] = s;
    }
}

#define DPP_ADD0(v, ctrl) ((v) + __builtin_bit_cast(float, __builtin_amdgcn_update_dpp(0, __builtin_bit_cast(int, (v)), (ctrl), 0xf, 0xf, true)))
__device__ void ph_adaln(const float* x, const float* g, const float* mod_shift  , const float* mod_scale, bf16* h, int bid, int nb) {
    const int lane = ltid() & 63, w = __builtin_amdgcn_readfirstlane(ltid() >> 6);
    for (int t0 = (bid * 8 + w) * 4; t0 < MT; t0 += nb * 8 * 4) {
        const int b = t0 >> 11;
        f32x4 v[4][4]; float ss[4];
#pragma unroll
        for (int r = 0; r < 4; ++r) {
            const float* xr = x + (size_t)(t0 + r) * DM;
#pragma unroll
            for (int i = 0; i < 4; ++i) v[r][i] = *(const f32x4*)(xr + i * 256 + lane * 4);
        }
#pragma unroll
        for (int r = 0; r < 4; ++r) {
            float s = 0.f;
#pragma unroll
            for (int i = 0; i < 4; ++i) s += v[r][i][0] * v[r][i][0] + v[r][i][1] * v[r][i][1] + v[r][i][2] * v[r][i][2] + v[r][i][3] * v[r][i][3];
            s = DPP_ADD0(s, 0xB1); s = DPP_ADD0(s, 0x4E); s = DPP_ADD0(s, 0x124); s = DPP_ADD0(s, 0x128);
            { auto q = __builtin_amdgcn_permlane16_swap(__float_as_uint(s), __float_as_uint(s), false, false); s = __uint_as_float(q[0]) + __uint_as_float(q[1]); }
            { auto q = __builtin_amdgcn_permlane32_swap(__float_as_uint(s), __float_as_uint(s), false, false); s = __uint_as_float(q[0]) + __uint_as_float(q[1]); }
            ss[r] = rsqrtf(s * (1.0f / DM) + EPS);
        }
#pragma unroll
        for (int i = 0; i < 4; ++i) {
            const int c = i * 256 + lane * 4;
            const f32x4 gg = *(const f32x4*)(g + c), sc = *(const f32x4*)(mod_scale + (size_t)b * 6144 + c), sh = *(const f32x4*)(mod_shift + (size_t)b * 6144 + c);
            float a[4];
#pragma unroll
            for (int e = 0; e < 4; ++e) a[e] = gg[e] * (1.0f + sc[e]);
#pragma unroll
            for (int r = 0; r < 4; ++r) {
                float y[4];
#pragma unroll
                for (int e = 0; e < 4; ++e) y[e] = v[r][i][e] * ss[r] * a[e] + sh[e];
                u32x2 o; o.x = pk2(y[0], y[1]); o.y = pk2(y[2], y[3]);
                *(u32x2*)(h + (size_t)(t0 + r) * DM + c) = o;
            }
        }
    }
}

namespace pg8 {
#define PG8_LAS __attribute__((address_space(3)))
typedef unsigned short bf16_t;
typedef short bf16x8 __attribute__((ext_vector_type(8)));
constexpr int BM = 256, BK = 64, HALF = 128, HTB = HALF * BK * 2  , STAGE_BYTES = 8 * HTB, NXCD = 8, WGM = 8;

__host__ __device__ __forceinline__ int lds_byte(int r, int c) { const int st = (r >> 4) * 2 + (c >> 5), rr = r & 15, cc = c & 31, ob = rr * 64 + cc * 2; return st * 1024 + (ob ^ (((ob >> 9) & 1) << 5)); }
__host__ __device__ __forceinline__ void stage_rc(int b, int& R, int& C) { const int st = b / 1024, sb = b % 1024, swz = sb ^ (((sb >> 9) & 1) << 5); R = (st >> 1) * 16 + swz / 64; C = (st & 1) * 32 + (swz % 64) / 2; }
__host__ __device__ __forceinline__ int perm32(int rho) { const int n = rho >> 4, i = rho & 15; return 8 * (i >> 2) + 4 * n + (i & 3); }

struct Unit { int pm, pn; };
struct Gemm { const bf16_t* A; const bf16_t* Bt; int M, N, K; };

struct StaticOrder {
    int nM, nN, nwg, G, c;
    __host__ __device__ void init(int M, int N, int G_, int c_) { nM = M / BM; nN = N / BM; nwg = nM * nN; G = G_; c = c_; }
    __host__ __device__ bool next(int i, Unit& u) const {
        const long L = (long)i * G + c; if (L >= nwg) return false;
        int wgid = (int)L; { const int q = nwg / NXCD, r = nwg % NXCD, xcd = wgid % NXCD, off = wgid / NXCD; wgid = (xcd < r ? xcd * (q + 1) : r * (q + 1) + (xcd - r) * q) + off; }
        const int nig = WGM * nN, gid = wgid / nig, fm = gid * WGM, gsz = (nM - fm) < WGM ? (nM - fm) : WGM;
        u.pm = fm + ((wgid % nig) % gsz); u.pn = (wgid % nig) / gsz; return true;
    }
    __device__ __forceinline__ void a_ready(const Unit&) const {}
    __device__ __forceinline__ void done(const Unit&) const {}
};

__device__ __forceinline__ unsigned cvt_pk_bf16(float lo, float hi) { unsigned r; asm volatile("v_cvt_pk_bf16_f32 %0, %1, %2" : "=v"(r) : "v"(lo), "v"(hi)); return r; }

struct EpiStore {
    static constexpr bool PERM = true, AFTER_DRAIN = false;
    bf16_t* O; int ldc;
    __device__ __forceinline__ void operator()(const f32x4 (&acc)[2][2][4][2], const Unit& u, int wr, int wc, int fr_, int fq_) const {
        int fr = fr_, fq = fq_; asm volatile("" : "+v"(fr), "+v"(fq));
        const int row0 = u.pm * BM + wr * 64 + fr, col0 = u.pn * BM + wc * 32 + 8 * fq;
#pragma unroll
        for (int ai = 0; ai < 2; ++ai)
#pragma unroll
            for (int m = 0; m < 4; ++m) { bf16_t* rowp = O + (size_t)(row0 + ai * HALF + m * 16) * ldc + col0;
#pragma unroll
                for (int bj = 0; bj < 2; ++bj) { const f32x4 v0 = acc[ai][bj][m][0], v1 = acc[ai][bj][m][1];
                    u32x4 w; w.x = cvt_pk_bf16(v0[0], v0[1]); w.y = cvt_pk_bf16(v0[2], v0[3]); w.z = cvt_pk_bf16(v1[0], v1[1]); w.w = cvt_pk_bf16(v1[2], v1[3]);
                    *(u32x4*)(rowp + bj * HALF) = w; } }
    }
};
struct EpiQKV {
    static constexpr bool PERM = true, AFTER_DRAIN = false;
    bf16_t* O; int ldc; const float* rope; int layer;
    const float* gq0; const float* gk0;
    const float* gq1; const float* gk1;
    float* kmean;
    __device__ __forceinline__ void operator()(const f32x4 (&acc)[2][2][4][2], const Unit& u, int wr, int wc, int fr_, int fq_) const {
        int fr = fr_, fq = fq_; asm volatile("" : "+v"(fr), "+v"(fq));
        const int hg = 4 * u.pn + wc;
        const float* gain = nullptr; bool km = false;
        if (layer == 0) { if (hg < 8) gain = gq0; else if (hg < 10) gain = gk0; }
        else { if (hg < 8) gain = gq0; else if (hg < 16) gain = gk0; else if (hg >= 24 && hg < 32) gain = gq1; else if (hg >= 32 && hg < 40) { gain = gk1; km = true; } }
        const int row0 = u.pm * BM + wr * 64 + fr, col0 = 64 * hg + 8 * fq;
        float g0[8], g1[8], cs0[8], cs1[8];
#pragma unroll
        for (int e = 0; e < 8; ++e) { g0[e] = gain ? gain[8 * fq + e] : 1.f; g1[e] = gain ? gain[32 + 8 * fq + e] : 1.f; cs0[e] = 0.f; cs1[e] = 0.f; }
#pragma unroll
        for (int ai = 0; ai < 2; ++ai)
#pragma unroll
            for (int m = 0; m < 4; ++m) {
                const int row = row0 + ai * HALF + m * 16;
                float v0[8], v1[8];
#pragma unroll
                for (int e = 0; e < 4; ++e) { v0[e] = acc[ai][0][m][0][e]; v0[4 + e] = acc[ai][0][m][1][e]; v1[e] = acc[ai][1][m][0][e]; v1[4 + e] = acc[ai][1][m][1][e]; }
                if (gain) {
                    float ss = 0.f;
#pragma unroll
                    for (int e = 0; e < 8; ++e) ss += v0[e] * v0[e] + v1[e] * v1[e];
                    ss = rows_sum(ss);
                    const float r = rsqrtf(ss * (1.0f / 64.0f) + 1e-6f);
                    const float* rp = rope + ((size_t)(row & 2047) * 32 + 8 * fq) * 2;
                    const f32x4 t0 = *(const f32x4*)(rp), t1 = *(const f32x4*)(rp + 4), t2 = *(const f32x4*)(rp + 8), t3 = *(const f32x4*)(rp + 12);
                    const float cs[8] = {t0[0], t0[2], t1[0], t1[2], t2[0], t2[2], t3[0], t3[2]}, sn[8] = {t0[1], t0[3], t1[1], t1[3], t2[1], t2[3], t3[1], t3[3]};
#pragma unroll
                    for (int e = 0; e < 8; ++e) { const float y0 = v0[e] * r * g0[e], y1 = v1[e] * r * g1[e]; v0[e] = y0 * cs[e] - y1 * sn[e]; v1[e] = y1 * cs[e] + y0 * sn[e]; }
                }
                u32x4 w0, w1;
                w0.x = cvt_pk_bf16(v0[0], v0[1]); w0.y = cvt_pk_bf16(v0[2], v0[3]); w0.z = cvt_pk_bf16(v0[4], v0[5]); w0.w = cvt_pk_bf16(v0[6], v0[7]);
                w1.x = cvt_pk_bf16(v1[0], v1[1]); w1.y = cvt_pk_bf16(v1[2], v1[3]); w1.z = cvt_pk_bf16(v1[4], v1[5]); w1.w = cvt_pk_bf16(v1[6], v1[7]);
                bf16_t* rowp = O + (size_t)row * ldc + col0;
                *(u32x4*)(rowp) = w0; *(u32x4*)(rowp + 32) = w1;
                if (km) {
#pragma unroll
                    for (int e = 0; e < 8; ++e) { cs0[e] += v0[e]; cs1[e] += v1[e]; }
                }
            }
        if (km) {
#pragma unroll
            for (int e = 0; e < 8; ++e) {
                cs0[e] = row16_sum(cs0[e]); cs1[e] = row16_sum(cs1[e]);
            }
            if (fr == 0) {
                float* kp = kmean + ((size_t)((u.pm >> 3) * 8 + (hg - 32)) * 8 + (u.pm & 7)) * 64 + 8 * fq;
#pragma unroll
                for (int e = 0; e < 8; ++e) { atomicAdd(kp + e, cs0[e] * (1.0f / 256.0f)); atomicAdd(kp + 32 + e, cs1[e] * (1.0f / 256.0f)); }
            }
        }
    }
};
struct EpiResid {
    static constexpr bool PERM = true, AFTER_DRAIN = false;
    const float* xin; float* xout; const float* gate;
    __device__ __forceinline__ void operator()(const f32x4 (&acc)[2][2][4][2], const Unit& u, int wr, int wc, int fr_, int fq_) const {
        int fr = fr_, fq = fq_; asm volatile("" : "+v"(fr), "+v"(fq));
        const int row0 = u.pm * BM + wr * 64 + fr, col0 = u.pn * BM + wc * 32 + 8 * fq;
#pragma unroll
        for (int ai = 0; ai < 2; ++ai)
#pragma unroll
            for (int m = 0; m < 4; ++m) { const int row = row0 + ai * HALF + m * 16; const float* gp = gate + (size_t)(row >> 11) * 6144 + col0;
                const float* xi = xin + (size_t)row * 1024 + col0; float* xo = xout + (size_t)row * 1024 + col0;
#pragma unroll
                for (int bj = 0; bj < 2; ++bj)
#pragma unroll
                    for (int n = 0; n < 2; ++n) { const f32x4 a = acc[ai][bj][m][n], x = *(const f32x4*)(xi + bj * HALF + 4 * n), g = *(const f32x4*)(gp + bj * HALF + 4 * n);
                        f32x4 o; o[0] = x[0] + g[0] * a[0]; o[1] = x[1] + g[1] * a[1]; o[2] = x[2] + g[2] * a[2]; o[3] = x[3] + g[3] * a[3];
                        *(f32x4*)(xo + bj * HALF + 4 * n) = o; } }
    }
};
template <class Epi, class Sched, bool ALIGN_EPI = false, bool SP2 = false>
__device__ __forceinline__ void gemm_phase(PG8_LAS unsigned char* lds, const Gemm g, const Sched& S, const Epi& E) {
    const int tid = ltid(), wid = __builtin_amdgcn_readfirstlane(tid >> 6), lane = tid & 63, wr = wid >> 2, wc = wid & 3, fr = lane & 15, fq = lane >> 4;
    const int K = g.K, nt = K / BK;
    unsigned voffA[2], voffB[2];
#pragma unroll
    for (int i = 0; i < 2; ++i) { int R, C; stage_rc(tid * 16 + i * 8192, R, C); const int Rb = Epi::PERM ? ((R & ~31) + perm32(R & 31)) : R;
        voffA[i] = (unsigned)(R * K + C) * 2u; voffB[i] = (unsigned)(Rb * K + C) * 2u; }
    const size_t kstep = (size_t)(BK * 2);
    const size_t hstep = (size_t)HALF * K * 2;
    const size_t tstep = 2 * hstep;
    const unsigned ldsw = (unsigned)wid * 1024u;
    const int aoff = lds_byte(wr * 64 + fr, fq * 8), boff = lds_byte(wc * 32 + fr, fq * 8);
#define PG8_SA(b, h) (((b) * 2 + (h)) * HTB)
#define PG8_SB(b, h) ((4 + (b) * 2 + (h)) * HTB)
#define PG8_STAGE(bufoff, gbase, voff) do { _Pragma("unroll") for (int _i = 0; _i < 2; ++_i) \
        __builtin_amdgcn_global_load_lds((const unsigned*)((const char*)(gbase) + (voff)[_i]), (PG8_LAS unsigned*)(lds + (bufoff) + ldsw + _i * 8192), 16, 0, 0); } while (0)
#define PG8_LDA(dst, b, h) do { _Pragma("unroll") for (int m = 0; m < 4; ++m) _Pragma("unroll") for (int k = 0; k < 2; ++k) dst[m][k] = *(const PG8_LAS bf16x8*)(lds + PG8_SA(b, h) + aoff + m * 2048 + k * 1024); } while (0)
#define PG8_LDB(dst, b, h) do { _Pragma("unroll") for (int n = 0; n < 2; ++n) _Pragma("unroll") for (int k = 0; k < 2; ++k) dst[n][k] = *(const PG8_LAS bf16x8*)(lds + PG8_SB(b, h) + boff + n * 2048 + k * 1024); } while (0)
#define PG8_MMA(ai, bj, At, Bt) do { __builtin_amdgcn_s_setprio(1); _Pragma("unroll") for (int m = 0; m < 4; ++m) _Pragma("unroll") for (int n = 0; n < 2; ++n) _Pragma("unroll") for (int k = 0; k < 2; ++k) \
        acc[ai][bj][m][n] = __builtin_amdgcn_mfma_f32_16x16x32_bf16(Bt[n][k], At[m][k], acc[ai][bj][m][n], 0, 0, 0); __builtin_amdgcn_s_setprio(0); } while (0)
#define PG8_WAIT_V(n) asm volatile("s_waitcnt vmcnt(" #n ")" ::: "memory")
#define PG8_WAIT_L(n) asm volatile("s_waitcnt lgkmcnt(" #n ")" ::: "memory")
#define PG8_BAR __builtin_amdgcn_s_barrier()
#define PG8_SCHED __builtin_amdgcn_sched_barrier(0)
    Unit cur, nxt; int ui = 0;
    if (!S.next(0, cur)) return;
    f32x4 acc[2][2][4][2];
#pragma unroll
    for (int a = 0; a < 2; ++a)
#pragma unroll
        for (int b = 0; b < 2; ++b)
#pragma unroll
            for (int m = 0; m < 4; ++m)
#pragma unroll
                for (int n = 0; n < 2; ++n) acc[a][b][m][n] = (f32x4){0.f, 0.f, 0.f, 0.f};
    bf16x8 At[4][2], B0[2][2], B1[2][2];
    const char* cA = (const char*)g.A + (size_t)cur.pm * tstep; const char* cB = (const char*)g.Bt + (size_t)cur.pn * tstep;
    S.a_ready(cur);
    if constexpr (SP2) {
        PG8_STAGE(PG8_SB(0, 0), cB, voffB); PG8_STAGE(PG8_SB(0, 1), cB + hstep, voffB); PG8_STAGE(PG8_SA(0, 0), cA, voffA); PG8_STAGE(PG8_SA(0, 1), cA + hstep, voffA);
        if (wr == 1) PG8_BAR;
        PG8_WAIT_V(2); PG8_BAR;
        PG8_STAGE(PG8_SB(1, 0), cB + kstep, voffB); PG8_STAGE(PG8_SA(1, 0), cA + kstep, voffA); PG8_STAGE(PG8_SB(1, 1), cB + hstep + kstep, voffB);
        PG8_WAIT_V(6); PG8_BAR;
    } else {
        PG8_STAGE(PG8_SB(0, 0), cB, voffB); PG8_STAGE(PG8_SA(0, 0), cA, voffA); PG8_STAGE(PG8_SB(0, 1), cB + hstep, voffB); PG8_STAGE(PG8_SA(0, 1), cA + hstep, voffA);
        if (wr == 1) PG8_BAR;
        PG8_WAIT_V(4); PG8_BAR;
        PG8_STAGE(PG8_SB(1, 0), cB + kstep, voffB); PG8_STAGE(PG8_SA(1, 0), cA + kstep, voffA); PG8_STAGE(PG8_SB(1, 1), cB + hstep + kstep, voffB);
        PG8_WAIT_V(6); PG8_BAR;
    }
    for (;;) {
        const bool has_next = S.next(ui + 1, nxt);
        const char* nA = has_next ? (const char*)g.A + (size_t)nxt.pm * tstep : cA; const char* nB = has_next ? (const char*)g.Bt + (size_t)nxt.pn * tstep : cB;
        for (int t = 0; t < nt; t += 2) {
            const bool last = (t == nt - 2);
            const char* a1 = cA + (size_t)(t + 1) * kstep;
            const char* a2 = last ? nA : cA + (size_t)(t + 2) * kstep; const char* b2 = last ? nB : cB + (size_t)(t + 2) * kstep;
            const char* a3 = a2 + kstep; const char* b3 = b2 + kstep;
            if (last && has_next) S.a_ready(nxt);
            if constexpr (SP2) {
            PG8_LDB(B0, 0, 0); PG8_LDB(B1, 0, 1); PG8_SCHED; PG8_LDA(At, 0, 0); PG8_STAGE(PG8_SA(1, 1), a1 + hstep, voffA);
            PG8_WAIT_V(8); PG8_WAIT_L(0); PG8_BAR; PG8_MMA(0, 0, At, B0); PG8_MMA(0, 1, At, B1); PG8_BAR; PG8_SCHED;
            PG8_LDA(At, 0, 1); PG8_STAGE(PG8_SB(0, 0), b2, voffB); PG8_STAGE(PG8_SB(0, 1), b2 + hstep, voffB); PG8_STAGE(PG8_SA(0, 0), a2, voffA);
            PG8_WAIT_V(8); PG8_WAIT_L(0); PG8_BAR; PG8_MMA(1, 0, At, B0); PG8_MMA(1, 1, At, B1); PG8_BAR; PG8_SCHED;
            PG8_LDB(B0, 1, 0); PG8_LDB(B1, 1, 1); PG8_SCHED; PG8_LDA(At, 1, 0); PG8_STAGE(PG8_SA(0, 1), a2 + hstep, voffA);
            PG8_WAIT_V(8); PG8_WAIT_L(0); PG8_BAR; PG8_MMA(0, 0, At, B0); PG8_MMA(0, 1, At, B1); PG8_BAR; PG8_SCHED;
            PG8_LDA(At, 1, 1); PG8_STAGE(PG8_SB(1, 0), b3, voffB); PG8_STAGE(PG8_SB(1, 1), b3 + hstep, voffB); PG8_STAGE(PG8_SA(1, 0), a3, voffA);
            PG8_WAIT_V(8); PG8_WAIT_L(0); PG8_BAR; PG8_MMA(1, 0, At, B0); PG8_MMA(1, 1, At, B1); PG8_BAR; PG8_SCHED;
            } else {
            PG8_LDB(B0, 0, 0); PG8_SCHED; PG8_LDA(At, 0, 0); PG8_STAGE(PG8_SA(1, 1), a1 + hstep, voffA);
            PG8_WAIT_L(8); PG8_BAR; PG8_WAIT_L(0); PG8_MMA(0, 0, At, B0); PG8_BAR; PG8_SCHED;
            PG8_LDB(B1, 0, 1); PG8_STAGE(PG8_SB(0, 0), b2, voffB);
            PG8_BAR; PG8_WAIT_L(0); PG8_MMA(0, 1, At, B1); PG8_BAR;
            PG8_LDA(At, 0, 1); PG8_STAGE(PG8_SA(0, 0), a2, voffA);
            PG8_BAR; PG8_WAIT_L(0); PG8_MMA(1, 0, At, B0); PG8_BAR; PG8_SCHED;
            PG8_STAGE(PG8_SB(0, 1), b2 + hstep, voffB);
            PG8_WAIT_V(6); PG8_BAR; PG8_MMA(1, 1, At, B1); PG8_BAR;
            PG8_LDB(B0, 1, 0); PG8_SCHED; PG8_LDA(At, 1, 0); PG8_STAGE(PG8_SA(0, 1), a2 + hstep, voffA);
            PG8_WAIT_L(8); PG8_BAR; PG8_WAIT_L(0); PG8_MMA(0, 0, At, B0); PG8_BAR; PG8_SCHED;
            PG8_LDB(B1, 1, 1); PG8_STAGE(PG8_SB(1, 0), b3, voffB);
            PG8_BAR; PG8_WAIT_L(0); PG8_MMA(0, 1, At, B1); PG8_BAR;
            PG8_LDA(At, 1, 1); PG8_STAGE(PG8_SA(1, 0), a3, voffA);
            PG8_BAR; PG8_WAIT_L(0); PG8_MMA(1, 0, At, B0); PG8_BAR; PG8_SCHED;
            PG8_STAGE(PG8_SB(1, 1), b3 + hstep, voffB);
            PG8_WAIT_V(6); PG8_BAR; PG8_MMA(1, 1, At, B1); PG8_BAR;
            }
        }
        if constexpr (ALIGN_EPI) { if (wr == 0) PG8_BAR; }
        if constexpr (!Epi::AFTER_DRAIN) { E(acc, cur, wr, wc, fr, fq); S.done(cur); }
        if (!has_next) break;
#pragma unroll
        for (int a = 0; a < 2; ++a)
#pragma unroll
            for (int b = 0; b < 2; ++b)
#pragma unroll
                for (int m = 0; m < 4; ++m)
#pragma unroll
                    for (int n = 0; n < 2; ++n) acc[a][b][m][n] = (f32x4){0.f, 0.f, 0.f, 0.f};
        cur = nxt; cA = nA; cB = nB; ++ui;
        if constexpr (ALIGN_EPI) { if (wr == 1) PG8_BAR; }
    }
    PG8_WAIT_V(0);
    if constexpr (!ALIGN_EPI) { if (wr == 0) PG8_BAR; }
    PG8_BAR;
    if constexpr (Epi::AFTER_DRAIN) { E.fused(acc, cur, wr, wc, fr, fq, lds, wid, lane); S.done(cur); }
#undef PG8_SA
#undef PG8_SB
#undef PG8_STAGE
#undef PG8_LDA
#undef PG8_LDB
#undef PG8_MMA
#undef PG8_WAIT_V
#undef PG8_WAIT_L
#undef PG8_BAR
#undef PG8_SCHED
}
}

typedef float f32x16 __attribute__((ext_vector_type(16)));
typedef short s16x4 __attribute__((ext_vector_type(4)));
typedef short v4i16_t __attribute__((ext_vector_type(4)));
typedef float f32x2_t __attribute__((ext_vector_type(2)));
typedef __bf16 bf16x2_t __attribute__((ext_vector_type(2)));
#define LAS __attribute__((address_space(3)))
constexpr int VROW = 144, VBUF = 32 * VROW;
constexpr int VROWV = 192, VBUFV = 32 * VROWV;
constexpr float L2E = 1.4426950408889634f, LN2 = 0.6931471805599453f;
constexpr float SC2 = 0.125f * L2E;

__device__ __forceinline__ int crow(int r, int hi) { return (r & 3) + 8 * (r >> 2) + 4 * hi; }
__device__ __forceinline__ unsigned cvtpk(float lo, float hi) { f32x2_t v = {lo, hi}; bf16x2_t b = __builtin_convertvector(v, bf16x2_t); return __builtin_bit_cast(unsigned, b); }
__device__ __forceinline__ float xhalf(float v, int hi) {
    auto r = __builtin_amdgcn_permlane32_swap(__float_as_uint(v), __float_as_uint(v), false, false);
    return __uint_as_float(hi ? r[0] : r[1]);
}
__device__ __forceinline__ s16x4 vtr(const LAS unsigned char* p) { return __builtin_bit_cast(s16x4, __builtin_amdgcn_ds_read_tr16_b64_v4i16((LAS v4i16_t*)p)); }

struct KVRegs { u32x4 k[4]; u32x4 v[4]; };
__device__ __forceinline__ void load_kv(KVRegs& R, const bf16* base, int kp0, int kst, int kcol, int vcol, int lane) {
#pragma unroll
    for (int j = 0; j < 4; ++j) {
        const int pos = kp0 + kst * (8 * j + (lane >> 3));
        const int pc = pos < SQ - 1 ? pos : SQ - 1;
        const bf16* rp = base + (size_t)pc * QKV_LD + (lane & 7) * 8;
        R.k[j] = *(const u32x4*)(rp + kcol); R.v[j] = *(const u32x4*)(rp + vcol);
    }
}
__device__ __forceinline__ void kv_stage(const KVRegs& R, LAS unsigned char* klds, LAS unsigned char* vlds, int lane) {
#pragma unroll
    for (int j = 0; j < 4; ++j) { const int r_ = 8 * j + (lane >> 3), c_ = (lane & 7) * 16; *(LAS u32x4*)(klds + r_ * VROW + c_) = R.k[j]; *(LAS u32x4*)(vlds + r_ * VROWV + c_) = R.v[j]; }
}
__device__ __forceinline__ f32x16 qk_tile(const LAS unsigned char* klds, const bf16x8 (&qf)[4], int r32, int hi) {
    f32x16 s = {0.f, 0.f, 0.f, 0.f, 0.f, 0.f, 0.f, 0.f, 0.f, 0.f, 0.f, 0.f, 0.f, 0.f, 0.f, 0.f};
#pragma unroll
    for (int k = 0; k < 4; ++k) { const bf16x8 kf = *(const LAS bf16x8*)(klds + r32 * VROW + (2 * k + hi) * 16); s = __builtin_amdgcn_mfma_f32_32x32x16_bf16(kf, qf[k], s, 0, 0, 0); }
    return s;
}
__device__ __forceinline__ void pv_tile(f32x16 (&o)[2], const f32x16& p, const LAS unsigned char* vlds, int lane) {
    const int g = lane >> 4, i = lane & 15, h = lane >> 5;
    const LAS unsigned char* vb = vlds + (4 * h + (i >> 2)) * VROWV + (16 * (g & 1) + 4 * (i & 3)) * 2;
#pragma unroll
    for (int s = 0; s < 2; ++s) {
        u32x4 pw; pw.x = cvtpk(p[8 * s], p[8 * s + 1]); pw.y = cvtpk(p[8 * s + 2], p[8 * s + 3]); pw.z = cvtpk(p[8 * s + 4], p[8 * s + 5]); pw.w = cvtpk(p[8 * s + 6], p[8 * s + 7]);
        const bf16x8 pb = __builtin_bit_cast(bf16x8, pw);
#pragma unroll
        for (int df = 0; df < 2; ++df) {
            const s16x4 lo = vtr(vb + (16 * s) * VROWV + df * 64), hh = vtr(vb + (16 * s + 8) * VROWV + df * 64);
            const bf16x8 va = (bf16x8){lo[0], lo[1], lo[2], lo[3], hh[0], hh[1], hh[2], hh[3]};
            o[df] = __builtin_amdgcn_mfma_f32_32x32x16_bf16(va, pb, o[df], 0, 0, 0);
        }
    }
}
__device__ __forceinline__ void load_q(bf16x8 (&qf)[4], const bf16* base, int qpos, int qcol, int hi) {
    const bf16* rp = base + (size_t)qpos * QKV_LD + qcol + 8 * hi;
#pragma unroll
    for (int k = 0; k < 4; ++k) qf[k] = *(const bf16x8*)(rp + 16 * k);
}
__device__ __forceinline__ void store_o(bf16* yrow, const f32x16 (&o)[2], float inv, int hi) {
#pragma unroll
    for (int df = 0; df < 2; ++df)
#pragma unroll
        for (int g = 0; g < 4; ++g) {
            u32x2 w; w.x = cvtpk(o[df][4 * g] * inv, o[df][4 * g + 1] * inv); w.y = cvtpk(o[df][4 * g + 2] * inv, o[df][4 * g + 3] * inv);
            *(u32x2*)(yrow + 32 * df + 8 * g + 4 * hi) = w;
        }
}
__device__ __forceinline__ void osm_tile(f32x16& s, float& m, float& l, f32x16 (&o)[2]) {
    float mx = s[0];
#pragma unroll
    for (int r = 1; r < 16; ++r) mx = fmaxf(mx, s[r]);
    { auto rr = __builtin_amdgcn_permlane32_swap(__float_as_uint(mx), __float_as_uint(mx), false, false); mx = fmaxf(__uint_as_float(rr[0]), __uint_as_float(rr[1])); }
    const float mn = fmaxf(m, mx);
    const float ms = (mn == -INFINITY) ? 0.f : mn;
    const float alpha = __builtin_amdgcn_exp2f((m - ms) * SC2);
    const float mc = ms * SC2;
    float ps = 0.f;
#pragma unroll
    for (int r = 0; r < 16; ++r) { s[r] = __builtin_amdgcn_exp2f(s[r] * SC2 - mc); ps += s[r]; }
    l = l * alpha + ps; m = mn;
    if (!__all(alpha == 1.0f)) {
#pragma unroll
        for (int df = 0; df < 2; ++df)
#pragma unroll
            for (int r = 0; r < 16; ++r) o[df][r] *= alpha;
    }
}
__device__ __forceinline__ void osm_tile2(f32x16& s0, f32x16& s1, float& m, float& l, f32x16 (&o)[2]) {
    float mx = fmaxf(s0[0], s1[0]);
#pragma unroll
    for (int r = 1; r < 16; ++r) mx = fmaxf(mx, fmaxf(s0[r], s1[r]));
    { auto rr = __builtin_amdgcn_permlane32_swap(__float_as_uint(mx), __float_as_uint(mx), false, false); mx = fmaxf(__uint_as_float(rr[0]), __uint_as_float(rr[1])); }
    const float mn = fmaxf(m, mx);
    const float ms = (mn == -INFINITY) ? 0.f : mn;
    const float alpha = __builtin_amdgcn_exp2f((m - ms) * SC2);
    const float mc = ms * SC2;
    float ps0 = 0.f, ps1 = 0.f;
#pragma unroll
    for (int r = 0; r < 16; ++r) { s0[r] = __builtin_amdgcn_exp2f(s0[r] * SC2 - mc); ps0 += s0[r]; s1[r] = __builtin_amdgcn_exp2f(s1[r] * SC2 - mc); ps1 += s1[r]; }
    l = l * alpha + (ps0 + ps1); m = mn;
    if (!__all(alpha == 1.0f)) {
#pragma unroll
        for (int df = 0; df < 2; ++df)
#pragma unroll
            for (int r = 0; r < 16; ++r) o[df][r] *= alpha;
    }
}
#define ZERO16 {0.f, 0.f, 0.f, 0.f, 0.f, 0.f, 0.f, 0.f, 0.f, 0.f, 0.f, 0.f, 0.f, 0.f, 0.f, 0.f}

struct AttnCtx {
    const bf16* base; int kcol, vcol, r32, hi, lane; LAS unsigned char* vlds; LAS unsigned char* klds; bf16x8 qf[4]; f32x16 o[2];
};
#define ATTN_STEP(SC, SL, T) { \
        if (SYNC) __builtin_amdgcn_s_barrier(); \
        { int kp_, ks_; const int tl_ = (T) + 2 < nt ? (T) + 2 : nt - 1; mx.pos(tl_, kp_, ks_); load_kv(SL, c.base, kp_, ks_, c.kcol, c.vcol, c.lane); } \
        kv_stage(SC, c.klds, c.vlds, c.lane); f32x16 s_ = qk_tile(c.klds, c.qf, c.r32, c.hi); \
        const bool stop_ = mx.process((T), s_, c); pv_tile(c.o, s_, c.vlds, c.lane); \
        if ((!SYNC && stop_) || (T) + 1 >= nt) break; }
template <class M, bool SYNC> __device__ __forceinline__ void attn_run(M& mx, AttnCtx& c) {
    const int nt = mx.nt;
    KVRegs S0, S1, S2;
    { int kp, ks; mx.pos(0, kp, ks); load_kv(S0, c.base, kp, ks, c.kcol, c.vcol, c.lane);
      mx.pos(1 < nt ? 1 : nt - 1, kp, ks); load_kv(S1, c.base, kp, ks, c.kcol, c.vcol, c.lane); }
    for (int t = 0;; t += 3) {
        ATTN_STEP(S0, S2, t)
        ATTN_STEP(S1, S0, t + 1)
        ATTN_STEP(S2, S1, t + 2)
    }
}
#define SH_BAR() asm volatile("s_waitcnt lgkmcnt(0)\n\ts_barrier" ::: "memory")
constexpr int SLOT_K = 64 * VROW, SLOT_BYTES = 64 * VROW + 64 * VROWV;
struct ShRegs { u32x4 a, b; };
__device__ __forceinline__ void sh_load(ShRegs& R, const bf16* base, int kp0, int kcol, int vcol, int w, int lane) {
    const int pos = kp0 + 4 * w + ((lane & 31) >> 3);
    const int pa = pos < SQ - 1 ? pos : SQ - 1, pb = pos + 32 < SQ - 1 ? pos + 32 : SQ - 1;
    const int col = ((lane >> 5) ? vcol : kcol) + (lane & 7) * 8;
    R.a = *(const u32x4*)(base + (size_t)pa * QKV_LD + col); R.b = *(const u32x4*)(base + (size_t)pb * QKV_LD + col);
}
__device__ __forceinline__ void sh_write(LAS unsigned char* slot, const ShRegs& R, int w, int lane) {
    const int row = 4 * w + ((lane & 31) >> 3);
    LAS unsigned char* p = slot + ((lane >> 5) ? SLOT_K + row * VROWV : row * VROW) + (lane & 7) * 16;
    *(LAS u32x4*)p = R.a; *(LAS u32x4*)(p + 32 * ((lane >> 5) ? VROWV : VROW)) = R.b;
}
#define SH_STEP(RW, RL, T) { \
        SH_BAR(); \
        { const int tl_ = (T) + 2 < nt ? (T) + 2 : nt - 1; sh_load(RL, c.base, mx.pos2(tl_), c.kcol, c.vcol, w, c.lane); } \
        sh_write(slots + (((T) + 1) & 1) * SLOT_BYTES, RW, w, c.lane); \
        if (mx.active2((T), w)) { LAS unsigned char* sl_ = slots + ((T) & 1) * SLOT_BYTES; \
            f32x16 s0_ = qk_tile(sl_, c.qf, c.r32, c.hi), s1_ = qk_tile(sl_ + 32 * VROW, c.qf, c.r32, c.hi); mx.process2((T), s0_, s1_, c); \
            pv_tile(c.o, s0_, sl_ + SLOT_K, c.lane); pv_tile(c.o, s1_, sl_ + SLOT_K + 32 * VROWV, c.lane); } \
        if ((T) + 1 >= nt) break; }
template <class M> __device__ __forceinline__ void attn_run_shared(M& mx, AttnCtx& c, LAS unsigned char* slots, int w) {
    const int nt = mx.nt2;
    ShRegs R0, R1, R2;
    sh_load(R0, c.base, mx.pos2(0), c.kcol, c.vcol, w, c.lane);
    sh_load(R1, c.base, mx.pos2(1 < nt ? 1 : nt - 1), c.kcol, c.vcol, w, c.lane);
    SH_BAR();
    sh_write(slots, R0, w, c.lane);
    for (int t = 0;; t += 3) {
        SH_STEP(R1, R2, t)
        SH_STEP(R2, R0, t + 1)
        SH_STEP(R0, R1, t + 2)
    }
}
struct MixA {
    int nt, k00, qpos; float m, l;
    __device__ __forceinline__ void pos(int idx, int& kp0, int& kst) const { kp0 = k00 + 32 * idx; kst = 1; }
    __device__ __forceinline__ bool process(int idx, f32x16& s, AttnCtx& c) {
        const int k0 = k00 + 32 * idx;
#pragma unroll
        for (int r = 0; r < 16; ++r) { const int dist = qpos - (k0 + crow(r, c.hi)); if (dist < 0 || dist > 127) s[r] = -INFINITY; }
        osm_tile(s, m, l, c.o); return false;
    }
};
__device__ void attn_A(const bf16* base, int hq, int q0, float sink, bf16* ybase, LAS unsigned char* vlds, int lane) {
    AttnCtx c; c.base = base; c.r32 = lane & 31; c.hi = lane >> 5; c.lane = lane; c.vlds = vlds; c.klds = vlds + VBUFV; c.kcol = 512 + (hq >> 2) * 64; c.vcol = 640 + (hq >> 2) * 64;
    c.o[0] = (f32x16)ZERO16; c.o[1] = (f32x16)ZERO16;
    MixA mx; mx.qpos = q0 + c.r32; mx.k00 = q0 - 128 > 0 ? q0 - 128 : 0; mx.nt = 5; mx.m = -INFINITY; mx.l = 0.f;
    load_q(c.qf, base, mx.qpos, hq * 64, c.hi);
    attn_run<MixA, true>(mx, c);
    float l = mx.l + xhalf(mx.l, c.hi);
    l += __builtin_amdgcn_exp2f(sink * L2E - mx.m * SC2);
    store_o(ybase + (size_t)mx.qpos * DM + hq * 64, c.o, 1.0f / l, c.hi);
}
struct MixB {
    int nt, q0, qpos; float carry;
    __device__ __forceinline__ void pos(int idx, int& kp0, int& kst) const { kp0 = q0 - 32 * idx; kst = 1; }
    __device__ __forceinline__ bool process(int idx, f32x16& s, AttnCtx& c) {
        const int k0 = q0 - 32 * idx, hi = c.hi;
        float lk[16], G[4], Gp[4];
#pragma unroll
        for (int r = 0; r < 16; ++r) {
            const float z = s[r] * 0.125f;
            const bool valid = (k0 + crow(r, hi)) < qpos;
            const float sp = fmaxf(z, 0.f) + LN2 * __builtin_amdgcn_logf(1.0f + __builtin_amdgcn_exp2f(-fabsf(z) * L2E));
            lk[r] = valid ? -sp : 0.f;
            s[r] = valid ? (z - sp) : -INFINITY;
        }
#pragma unroll
        for (int g = 0; g < 4; ++g) { G[g] = (lk[4 * g] + lk[4 * g + 1]) + (lk[4 * g + 2] + lk[4 * g + 3]); Gp[g] = xhalf(G[g], hi); }
        float above = carry;
#pragma unroll
        for (int g = 3; g >= 0; --g) {
            float off = above + (hi == 0 ? Gp[g] : 0.f);
            s[4 * g + 3] = __builtin_amdgcn_exp2f((s[4 * g + 3] + off) * L2E); off += lk[4 * g + 3];
            s[4 * g + 2] = __builtin_amdgcn_exp2f((s[4 * g + 2] + off) * L2E); off += lk[4 * g + 2];
            s[4 * g + 1] = __builtin_amdgcn_exp2f((s[4 * g + 1] + off) * L2E); off += lk[4 * g + 1];
            s[4 * g + 0] = __builtin_amdgcn_exp2f((s[4 * g + 0] + off) * L2E);
            above += G[g] + Gp[g];
        }
        carry = above;
        return __all(carry < -40.0f) != 0;
    }
};
__device__ void attn_B(const bf16* base, int h, int q0, bf16* ybase, LAS unsigned char* vlds, int lane) {
    AttnCtx c; c.base = base; c.r32 = lane & 31; c.hi = lane >> 5; c.lane = lane; c.vlds = vlds; c.klds = vlds + VBUFV; c.kcol = 1280 + h * 64; c.vcol = 1792 + h * 64;
    c.o[0] = (f32x16)ZERO16; c.o[1] = (f32x16)ZERO16;
    MixB mx; mx.q0 = q0; mx.qpos = q0 + c.r32; mx.nt = q0 / 32 + 1; mx.carry = 0.f;
    load_q(c.qf, base, mx.qpos, 768 + h * 64, c.hi);
    attn_run<MixB, false>(mx, c);
    store_o(ybase + (size_t)mx.qpos * DM + 512 + h * 64, c.o, 1.0f, c.hi);
}
struct MixCp {
    int nt, n0, r0, j1lo, qpos; float m, l;
    __device__ __forceinline__ void pos(int t, int& kp0, int& kst) const {
        if (t < n0) { kp0 = r0 + 512 * t; kst = 16; } else { kp0 = (r0 & 3) + 4 * (j1lo + 32 * (t - n0)); kst = 4; }
    }
    __device__ __forceinline__ bool process(int t, f32x16& s, AttnCtx& c) {
        int kp0, kst; pos(t, kp0, kst);
        const int win = t < n0 ? 2048 : 512;
#pragma unroll
        for (int r = 0; r < 16; ++r) { const int dist = qpos - (kp0 + kst * crow(r, c.hi)); if (dist < 0 || dist > win) s[r] = -INFINITY; }
        osm_tile(s, m, l, c.o); return false;
    }
};
struct MixC1 {
    int nt2, p0, qpos; float m, l;
    __device__ __forceinline__ int pos2(int T) const { return p0 + 64 * T; }
    __device__ __forceinline__ bool active2(int T, int w) const { return true; }
    __device__ __forceinline__ void process2(int T, f32x16& s0, f32x16& s1, AttnCtx& c) {
        const int k0 = p0 + 64 * T;
#pragma unroll
        for (int r = 0; r < 16; ++r) { const int dist = qpos - (k0 + crow(r, c.hi)); if (dist < 0 || dist > 128) s0[r] = -INFINITY; if (dist < 32 || dist > 160) s1[r] = -INFINITY; }
        osm_tile2(s0, s1, m, l, c.o);
    }
};
__device__ void attn_C(const bf16* base, int h, int r0, int g, bf16* ybase, LAS unsigned char* vlds, LAS unsigned char* xlds, int w, int lane) {
    AttnCtx c; c.base = base; c.r32 = lane & 31; c.hi = lane >> 5; c.lane = lane; c.vlds = vlds; c.klds = vlds + VBUFV; c.kcol = 512 + h * 64; c.vcol = 1024 + h * 64;
    c.o[0] = (f32x16)ZERO16; c.o[1] = (f32x16)ZERO16;
    const int qpos = r0 + 16 * (32 * g + c.r32);
    load_q(c.qf, base, qpos, h * 64, c.hi);
    MixCp mp; mp.r0 = r0; mp.qpos = qpos; mp.m = -INFINITY; mp.l = 0.f;
    mp.n0 = g + 1;
    mp.j1lo = (r0 >> 2) + 128 * g - 128 > 0 ? (r0 >> 2) + 128 * g - 128 : 0;
    mp.nt = mp.n0 + ((r0 >> 2) + 128 * g + 124 - mp.j1lo) / 32 + 1;
    attn_run<MixCp, true>(mp, c);
    MixC1 m1; m1.qpos = qpos; m1.m = mp.m; m1.l = mp.l;
    const int ra = r0 & 8;
    m1.p0 = 512 * g + ra - 128 > 0 ? 512 * g + ra - 128 : 0;
    m1.nt2 = ((512 * g + ra + 7 + 496 - m1.p0) / 32 + 2) / 2;
    attn_run_shared<MixC1>(m1, c, xlds + 64, w);
    const float l = m1.l + xhalf(m1.l, c.hi);
    store_o(ybase + (size_t)qpos * DM + h * 64, c.o, 1.0f / l, c.hi);
}
struct MixD {
    int nt, nt2, npast, own, q0, qpos; unsigned U, sel; float m, l;
    __device__ __forceinline__ int blk_of(int j) const {
        unsigned u = U; int b = 0;
#pragma unroll
        for (int i = 0; i < 7; ++i) { if (i < j) u &= u - 1u; }
        b = __builtin_ctz(u | 0x100u); return b;
    }
    __device__ __forceinline__ void pos(int t, int& kp0, int& kst) const {
        kst = 1;
        if (t < 8 * npast) kp0 = blk_of(t >> 3) * 256 + (t & 7) * 32; else kp0 = own * 256 + (t - 8 * npast) * 32;
    }
    __device__ __forceinline__ int pos2(int T) const { int kp, ks; pos(2 * T, kp, ks); return kp; }
    __device__ __forceinline__ bool active2(int T, int w) const { return T < 4 * npast || 2 * (T - 4 * npast) <= w; }
    __device__ __forceinline__ void process2(int T, f32x16& s0, f32x16& s1, AttnCtx& c) {
        if (T < 4 * npast) {
            const int blk = blk_of(T >> 2);
            if (!((sel >> blk) & 1u)) {
#pragma unroll
                for (int r = 0; r < 16; ++r) { s0[r] = -INFINITY; s1[r] = -INFINITY; }
            }
        } else {
            const int k0 = own * 256 + (T - 4 * npast) * 64;
#pragma unroll
            for (int r = 0; r < 16; ++r) { const int kk = k0 + crow(r, c.hi); if (kk > qpos) s0[r] = -INFINITY; if (kk + 32 > qpos) s1[r] = -INFINITY; }
        }
        osm_tile2(s0, s1, m, l, c.o);
    }
};
__device__ void attn_D(const bf16* base, const float* kmean  , int h, int q0, bf16* ybase, LAS unsigned char* vlds, LAS unsigned char* xlds, int lane) {
    AttnCtx c; c.base = base; c.r32 = lane & 31; c.hi = lane >> 5; c.lane = lane; c.vlds = vlds; c.klds = vlds + VBUFV; c.kcol = 2048 + h * 64; c.vcol = 2560 + h * 64;
    c.o[0] = (f32x16)ZERO16; c.o[1] = (f32x16)ZERO16;
    const int r32 = c.r32, hi = c.hi, own = q0 >> 8;
    MixD mx; mx.own = own; mx.q0 = q0; mx.qpos = q0 + r32; mx.m = -INFINITY; mx.l = 0.f;
    load_q(c.qf, base, mx.qpos, 1536 + h * 64, hi);
    unsigned sel = 0u;
    if (own > 0) {
        bf16x8 kf[4];
#pragma unroll
        for (int k = 0; k < 4; ++k) {
            u32x4 w = {0u, 0u, 0u, 0u};
            if (r32 < 8) { const float* kp = kmean + r32 * 64 + 16 * k + 8 * hi; const f32x4 a = *(const f32x4*)kp, b = *(const f32x4*)(kp + 4);
                w.x = cvtpk(a[0], a[1]); w.y = cvtpk(a[2], a[3]); w.z = cvtpk(b[0], b[1]); w.w = cvtpk(b[2], b[3]); }
            kf[k] = __builtin_bit_cast(bf16x8, w);
        }
        f32x16 gs = ZERO16;
#pragma unroll
        for (int k = 0; k < 4; ++k) gs = __builtin_amdgcn_mfma_f32_32x32x16_bf16(kf[k], c.qf[k], gs, 0, 0, 0);
        float gt[8];
#pragma unroll
        for (int r = 0; r < 4; ++r) { const float mine = gs[r], oth = xhalf(mine, hi); gt[r] = hi == 0 ? mine : oth; gt[4 + r] = hi == 0 ? oth : mine; }
        const int nsel = own < 3 ? own : 3;
        for (int rr = 0; rr < nsel; ++rr) {
            float best = -INFINITY; int bi = -1;
#pragma unroll
            for (int n = 0; n < 8; ++n) { const bool ok = n < own && !((sel >> n) & 1u) && (bi < 0 || gt[n] > best); if (ok) { best = gt[n]; bi = n; } }
            if (bi >= 0) sel |= 1u << bi;
        }
    }
    unsigned U = 0u;
#pragma unroll
    for (int n = 0; n < 8; ++n) if (__ballot((sel >> n) & 1u) != 0ull) U |= 1u << n;
    {
        volatile LAS unsigned* ux = (volatile LAS unsigned*)xlds;
        __builtin_amdgcn_s_barrier();
        if (lane == 0) ux[(q0 >> 5) & 7] = U;
        asm volatile("s_waitcnt lgkmcnt(0)" ::: "memory");
        __builtin_amdgcn_s_barrier();
        U = ux[0] | ux[1] | ux[2] | ux[3] | ux[4] | ux[5] | ux[6] | ux[7];
        U = __builtin_amdgcn_readfirstlane(U);
    }
    mx.U = U; mx.sel = sel; mx.npast = __builtin_popcount(U); mx.nt = 8 * mx.npast + 8; mx.nt2 = 4 * mx.npast + 4;
    attn_run_shared<MixD>(mx, c, xlds + 64, (q0 >> 5) & 7);
    const float l = mx.l + xhalf(mx.l, c.hi);
    store_o(ybase + (size_t)mx.qpos * DM + 512 + h * 64, c.o, 1.0f / l, hi);
}

__device__ void ph_attn0(const bf16* qkv, const float* sinks, bf16* y, LAS unsigned char* lds, int bid, int nb) {
    const int lane = ltid() & 63, w = __builtin_amdgcn_readfirstlane(ltid() >> 6);
    LAS unsigned char* vlds = lds + w * (VBUF + VBUFV);
    for (int pid = bid; pid < NB * 8; pid += nb) {
        const int b = pid >> 3, h = pid & 7;
        const bf16* base = qkv + (size_t)b * SQ * QKV_LD; bf16* ybase = y + (size_t)b * SQ * DM;
        const float sink = sinks[h];
        for (int rd = 0; rd < 8; ++rd) attn_A(base, h, (rd * 8 + w) * 32, sink, ybase, vlds, lane);
        for (int rd = 0; rd < 8; ++rd) attn_B(base, h, (rd * 8 + w) * 32, ybase, vlds, lane);
    }
}
__device__ void ph_attn1(const bf16* qkv, const float* kmean, bf16* y, LAS unsigned char* lds, int bid, int nb) {
    const int lane = ltid() & 63, w = __builtin_amdgcn_readfirstlane(ltid() >> 6);
    LAS unsigned char* vlds = lds + w * (VBUF + VBUFV);
    for (int pid = bid; pid < NB * 8; pid += nb) {
        const int b = pid >> 3, h = pid & 7;
        const bf16* base = qkv + (size_t)b * SQ * QKV_LD; bf16* ybase = y + (size_t)b * SQ * DM;
        for (int rd = 0; rd < 8; ++rd) { const int it = rd * 8 + w; attn_C(base, h, it & 15, it >> 4, ybase, vlds, lds + 8 * (VBUF + VBUFV), w, lane); }
        for (int rd = 0; rd < 8; ++rd) attn_D(base, kmean + (size_t)pid * 8 * 64, h, (rd * 8 + w) * 32, ybase, vlds, lds + 8 * (VBUF + VBUFV), lane);
    }
}

#define CE_D(a, b) { const float hi_ = fmaxf((a), (b)), lo_ = fminf((a), (b)); (a) = hi_; (b) = lo_; }
#define BSTAGE(arr, k, j) _Pragma("unroll") for (int i_ = 0; i_ < 16; ++i_) { const int l_ = i_ ^ (j); if (l_ > i_) { if ((i_ & (k)) == 0) CE_D(arr[i_], arr[l_]) else CE_D(arr[l_], arr[i_]) } }
__device__ __forceinline__ void bsort16(float (&a)[16]) {
    BSTAGE(a, 2, 1) BSTAGE(a, 4, 2) BSTAGE(a, 4, 1) BSTAGE(a, 8, 4) BSTAGE(a, 8, 2) BSTAGE(a, 8, 1) BSTAGE(a, 16, 8) BSTAGE(a, 16, 4) BSTAGE(a, 16, 2) BSTAGE(a, 16, 1)
}
__device__ __forceinline__ void bmerge16(float (&a)[16]) {
    BSTAGE(a, 16, 8) BSTAGE(a, 16, 4) BSTAGE(a, 16, 2) BSTAGE(a, 16, 1)
}
__device__ __forceinline__ void merge_top16(float (&a)[16], const float (&b)[16]) {
#pragma unroll
    for (int i = 0; i < 16; ++i) a[i] = fmaxf(a[i], b[15 - i]);
    bmerge16(a);
}
__device__ __forceinline__ void xmerge16(float (&a)[16]) {
    {
        float A[16], B[16];
#pragma unroll
        for (int i = 0; i < 16; ++i) { auto r = __builtin_amdgcn_permlane16_swap(__float_as_uint(a[i]), __float_as_uint(a[i]), false, false); A[i] = __uint_as_float(r[0]); B[i] = __uint_as_float(r[1]); }
#pragma unroll
        for (int i = 0; i < 16; ++i) a[i] = fmaxf(A[i], B[15 - i]);
        bmerge16(a);
    }
    {
        float A[16], B[16];
#pragma unroll
        for (int i = 0; i < 16; ++i) { auto r = __builtin_amdgcn_permlane32_swap(__float_as_uint(a[i]), __float_as_uint(a[i]), false, false); A[i] = __uint_as_float(r[0]); B[i] = __uint_as_float(r[1]); }
#pragma unroll
        for (int i = 0; i < 16; ++i) a[i] = fmaxf(A[i], B[15 - i]);
        bmerge16(a);
    }
}
__host__ __device__ constexpr int pair_i(int id) {
    int c = 0;
    for (int i = 0; i < 16; ++i) { const int nj = 16 / (i + 1); if (id < c + nj) return i; c += nj; }
    return 0;
}
__host__ __device__ constexpr int pair_j(int id) {
    int c = 0;
    for (int i = 0; i < 16; ++i) { const int nj = 16 / (i + 1); if (id < c + nj) return id - c; c += nj; }
    return 0;
}
constexpr int SK_ROW = 272;
constexpr int SEL_SK_BYTES = 2 * 128 * SK_ROW;
constexpr int SEL_TAB_OFF = SEL_SK_BYTES;
constexpr int SEL_IDX_OFF = SEL_SK_BYTES + 64;

template <int S> __device__ __forceinline__ float cand_slot(const float (&L1)[16], const float (&L2)[16], int g) {
    constexpr int p0 = S, p1 = 16 + S, p2 = 32 + S, p3 = 48 + S;
    const float c0 = L1[pair_i(p0)] + L2[pair_j(p0)], c1 = L1[pair_i(p1)] + L2[pair_j(p1)], c2 = L1[pair_i(p2)] + L2[pair_j(p2)];
    const float c3 = p3 < 50 ? L1[pair_i(p3 < 50 ? p3 : 0)] + L2[pair_j(p3 < 50 ? p3 : 0)] : -1.0e30f;
    const float c = g == 0 ? c0 : (g == 1 ? c1 : (g == 2 ? c2 : c3));
    return __uint_as_float((__float_as_uint(c) & 0xffffffc0u) | (unsigned)(16 * g + S));
}

__device__ void ph_peer_select(const bf16* qry, const float* subkeys  , int* eidx, float* egate, LAS unsigned char* lds, int bid, int nb) {
    const int tid = ltid(), lane = tid & 63, w = __builtin_amdgcn_readfirstlane(tid >> 6);
    const int tk = lane & 15, g = lane >> 4;
    __syncthreads();
    for (int e = tid; e < 2 * 128 * 128 / 2; e += NT) {
        const int row = e >> 6, c2 = (e & 63) * 2;
        const float a = subkeys[(size_t)row * 128 + c2], b = subkeys[(size_t)row * 128 + c2 + 1];
        *(LAS unsigned*)(lds + row * SK_ROW + c2 * 2) = pk2(a, b);
    }
    if (tid < 64) { int id = tid; int c = 0, pi = 0, pj = 0;
        for (int i = 0; i < 16; ++i) { const int nj = 16 / (i + 1); if (id >= c && id < c + nj) { pi = i; pj = id - c; } c += nj; }
        lds[SEL_TAB_OFF + tid] = (unsigned char)((pi << 4) | pj); }
    __syncthreads();
    LAS unsigned* widx = (LAS unsigned*)(lds + SEL_IDX_OFF + w * 512);
    const LAS unsigned char* widx8 = (const LAS unsigned char*)widx;
    const int nitems = (MT / 16) * 8;
    for (int it = bid * 8 + w; it < nitems; it += nb * 8) {
        const int h = it & 7, t0 = (it >> 3) * 16;
        float L[2][16];
#pragma unroll
        for (int hf = 0; hf < 2; ++hf) {
            bf16x8 qf[4];
            const bf16* qp = qry + (size_t)(t0 + tk) * PQ + h * 256 + hf * 128 + 8 * g;
#pragma unroll
            for (int ks = 0; ks < 4; ++ks) qf[ks] = *(const bf16x8*)(qp + 32 * ks);
            float key[32];
#pragma unroll
            for (int tile = 0; tile < 8; ++tile) {
                f32x4 acc = {0.f, 0.f, 0.f, 0.f};
#pragma unroll
                for (int ks = 0; ks < 4; ++ks) {
                    const bf16x8 af = *(const LAS bf16x8*)(lds + (hf * 128 + tile * 16 + tk) * SK_ROW + (32 * ks + 8 * g) * 2);
                    acc = __builtin_amdgcn_mfma_f32_16x16x32_bf16(af, qf[ks], acc, 0, 0, 0);
                }
#pragma unroll
                for (int r = 0; r < 4; ++r) key[tile * 4 + r] = __uint_as_float((__float_as_uint(acc[r]) & 0xffffff80u) | (unsigned)(16 * tile + 4 * g + r));
            }
            float a[16], b[16];
#pragma unroll
            for (int i = 0; i < 16; ++i) { a[i] = key[i]; b[i] = key[16 + i]; }
            bsort16(a); bsort16(b);
            merge_top16(a, b);
            xmerge16(a);
#pragma unroll
            for (int i = 0; i < 16; ++i) L[hf][i] = a[i];
            unsigned pk = 0u;
#pragma unroll
            for (int s = 0; s < 4; ++s) {
                const float v = g == 0 ? a[s] : (g == 1 ? a[4 + s] : (g == 2 ? a[8 + s] : a[12 + s]));
                pk |= (__float_as_uint(v) & 127u) << (8 * s);
            }
            widx[tk * 8 + hf * 4 + g] = pk;
        }
        float c[16];
        c[0] = cand_slot<0>(L[0], L[1], g); c[1] = cand_slot<1>(L[0], L[1], g); c[2] = cand_slot<2>(L[0], L[1], g); c[3] = cand_slot<3>(L[0], L[1], g);
        c[4] = cand_slot<4>(L[0], L[1], g); c[5] = cand_slot<5>(L[0], L[1], g); c[6] = cand_slot<6>(L[0], L[1], g); c[7] = cand_slot<7>(L[0], L[1], g);
        c[8] = cand_slot<8>(L[0], L[1], g); c[9] = cand_slot<9>(L[0], L[1], g); c[10] = cand_slot<10>(L[0], L[1], g); c[11] = cand_slot<11>(L[0], L[1], g);
        c[12] = cand_slot<12>(L[0], L[1], g); c[13] = cand_slot<13>(L[0], L[1], g); c[14] = cand_slot<14>(L[0], L[1], g); c[15] = cand_slot<15>(L[0], L[1], g);
        bsort16(c);
        xmerge16(c);
        float sum = 0.f, ex[16];
#pragma unroll
        for (int i = 0; i < 16; ++i) { ex[i] = __builtin_amdgcn_exp2f((c[i] - c[0]) * L2E); sum += ex[i]; }
        const float inv = 1.0f / sum;
        int oi[4]; float og[4];
#pragma unroll
        for (int s = 0; s < 4; ++s) {
            const float kv = g == 0 ? c[s] : (g == 1 ? c[4 + s] : (g == 2 ? c[8 + s] : c[12 + s]));
            const float ev = g == 0 ? ex[s] : (g == 1 ? ex[4 + s] : (g == 2 ? ex[8 + s] : ex[12 + s]));
            const unsigned pid = __float_as_uint(kv) & 63u;
            const unsigned ij = lds[SEL_TAB_OFF + pid];
            const unsigned i1 = widx8[tk * 32 + (ij >> 4)], i2 = widx8[tk * 32 + 16 + (ij & 15u)];
            oi[s] = (int)(i1 * 128u + i2); og[s] = ev * inv;
        }
        const size_t ob = (size_t)(t0 + tk) * 128 + h * 16 + 4 * g;
        *(u32x4*)(eidx + ob) = (u32x4){(unsigned)oi[0], (unsigned)oi[1], (unsigned)oi[2], (unsigned)oi[3]};
        *(f32x4*)(egate + ob) = (f32x4){og[0], og[1], og[2], og[3]};
    }
    __syncthreads();
}

typedef float v32f_t __attribute__((ext_vector_type(32)));
typedef unsigned v6u_t __attribute__((ext_vector_type(6)));
typedef unsigned v16u_t __attribute__((ext_vector_type(16)));
typedef __bf16 v32bf_t __attribute__((ext_vector_type(32)));
typedef __bf16 v2bf_t __attribute__((ext_vector_type(2)));
typedef _Float16 v32h_t __attribute__((ext_vector_type(32)));
typedef unsigned u32x3 __attribute__((ext_vector_type(3)));
constexpr int TROW = 768;
__device__ void ph_tab_fp6(const float* src, unsigned char* dst, float* scale, int nrows, int bid, int nb) {
    const int lane = ltid() & 63, w = __builtin_amdgcn_readfirstlane(ltid() >> 6);
    for (int rp = bid * 8 + w; rp < nrows / 2; rp += nb * 8) {
        v32h_t hv; float sc[2];
#pragma unroll
        for (int rr = 0; rr < 2; ++rr) {
            const float* sp = src + (size_t)(2 * rp + rr) * DM + lane * 16;
            f32x4 v[4]; float am = 0.f;
#pragma unroll
            for (int i = 0; i < 4; ++i) { v[i] = *(const f32x4*)(sp + i * 4); am = fmaxf(am, fmaxf(fmaxf(fabsf(v[i][0]), fabsf(v[i][1])), fmaxf(fabsf(v[i][2]), fabsf(v[i][3])))); }
            am = wave_max(am);
            const float s = am > 0.f ? am * (1.0f / 7.5f) : 1.0f, inv = 1.0f / s;
            sc[rr] = s;
#pragma unroll
            for (int i = 0; i < 4; ++i)
#pragma unroll
                for (int e = 0; e < 4; ++e) hv[rr * 16 + i * 4 + e] = (_Float16)fminf(fmaxf(v[i][e] * inv, -7.5f), 7.5f);
        }
        const v6u_t pk = __builtin_amdgcn_cvt_scalef32_pk32_fp6_f16(hv, 1.0f);
        unsigned* d0 = (unsigned*)(dst + (size_t)(2 * rp) * TROW + lane * 12);
        unsigned* d1 = (unsigned*)(dst + (size_t)(2 * rp + 1) * TROW + lane * 12);
        d0[0] = pk[0]; d0[1] = pk[1]; d0[2] = pk[2]; d1[0] = pk[3]; d1[1] = pk[4]; d1[2] = pk[5];
        if (lane == 0) { scale[2 * rp] = sc[0]; scale[2 * rp + 1] = sc[1]; }
    }
}

constexpr int TROW4 = 512;
__device__ void ph_tab_fp4(const float* src, unsigned char* dst, float* scale, int nrows, int bid, int nb) {
    const int lane = ltid() & 63, w = __builtin_amdgcn_readfirstlane(ltid() >> 6);
    for (int row = bid * 8 + w; row < nrows; row += nb * 8) {
        const float* sp = src + (size_t)row * DM + lane * 16;
        f32x4 v[4]; float am = 0.f;
#pragma unroll
        for (int i = 0; i < 4; ++i) { v[i] = *(const f32x4*)(sp + i * 4); am = fmaxf(am, fmaxf(fmaxf(fabsf(v[i][0]), fabsf(v[i][1])), fmaxf(fabsf(v[i][2]), fabsf(v[i][3])))); }
        am = wave_max(am);
        const float s = am > 0.f ? am * (1.0f / 6.0f) : 1.0f, inv = 1.0f / s;
        unsigned d0 = 0u, d1 = 0u;
        d0 = __builtin_amdgcn_cvt_scalef32_pk_fp4_f32(d0, v[0][0] * inv, v[0][1] * inv, 1.0f, 0); d0 = __builtin_amdgcn_cvt_scalef32_pk_fp4_f32(d0, v[0][2] * inv, v[0][3] * inv, 1.0f, 1);
        d0 = __builtin_amdgcn_cvt_scalef32_pk_fp4_f32(d0, v[1][0] * inv, v[1][1] * inv, 1.0f, 2); d0 = __builtin_amdgcn_cvt_scalef32_pk_fp4_f32(d0, v[1][2] * inv, v[1][3] * inv, 1.0f, 3);
        d1 = __builtin_amdgcn_cvt_scalef32_pk_fp4_f32(d1, v[2][0] * inv, v[2][1] * inv, 1.0f, 0); d1 = __builtin_amdgcn_cvt_scalef32_pk_fp4_f32(d1, v[2][2] * inv, v[2][3] * inv, 1.0f, 1);
        d1 = __builtin_amdgcn_cvt_scalef32_pk_fp4_f32(d1, v[3][0] * inv, v[3][1] * inv, 1.0f, 2); d1 = __builtin_amdgcn_cvt_scalef32_pk_fp4_f32(d1, v[3][2] * inv, v[3][3] * inv, 1.0f, 3);
        *(u32x2*)(dst + (size_t)row * TROW4 + lane * 8) = (u32x2){d0, d1};
        if (lane == 0) scale[row] = s;
    }
}

#define DPP_ADD(v, ctrl) ((v) + __builtin_bit_cast(float, __builtin_amdgcn_update_dpp(0, __builtin_bit_cast(int, (v)), (ctrl), 0xf, 0xf, true)))
typedef int i32x4_t __attribute__((ext_vector_type(4)));
constexpr int GT = 2;
typedef int v8i_t __attribute__((ext_vector_type(8)));
typedef int v2i_t __attribute__((ext_vector_type(2)));
struct GSet { u32x2 uq[4]; u32x2 vq[4]; };
__device__ __forceinline__ void gather_issue(GSet& S, int bt, int lane, const unsigned char* pu, const unsigned char* pv, const LAS int* etok) {
    const i32x4_t ev = *(const LAS i32x4_t*)(etok + bt * 4);
    const int es[4] = {__builtin_amdgcn_readfirstlane(ev.x), __builtin_amdgcn_readfirstlane(ev.y), __builtin_amdgcn_readfirstlane(ev.z), __builtin_amdgcn_readfirstlane(ev.w)};
#pragma unroll
    for (int k = 0; k < 2; ++k) {
        const unsigned f0 = (unsigned)es[2 * k] * (unsigned)TROW4 + (unsigned)lane * 8u, f1 = (unsigned)es[2 * k + 1] * (unsigned)TROW4 + (unsigned)lane * 8u;
        S.uq[2 * k] = *(const u32x2*)(pu + f0); S.uq[2 * k + 1] = *(const u32x2*)(pu + f1);
        S.vq[2 * k] = *(const u32x2*)(pv + f0); S.vq[2 * k + 1] = *(const u32x2*)(pv + f1);
    }
}
constexpr int GV_ROW = 520;
constexpr int GV_BYTES = 16 * GV_ROW, GC_BYTES = 96;
__device__ __forceinline__ float gather_udot(const GSet& S, const unsigned (&hp)[8], LAS unsigned char* vrow) {
    typedef _Float16 h2v_t __attribute__((ext_vector_type(2)));
    float d[4];
#pragma unroll
    for (int k = 0; k < 4; ++k) {
        const unsigned q0 = S.uq[k].x, q1 = S.uq[k].y;
        float s0 = 0.f, s1 = 0.f;
        s0 = __builtin_amdgcn_fdot2(__builtin_amdgcn_cvt_scalef32_pk_f16_fp4(q0, 1.0f, 0), __builtin_bit_cast(h2v_t, hp[0]), s0, false);
        s1 = __builtin_amdgcn_fdot2(__builtin_amdgcn_cvt_scalef32_pk_f16_fp4(q0, 1.0f, 1), __builtin_bit_cast(h2v_t, hp[1]), s1, false);
        s0 = __builtin_amdgcn_fdot2(__builtin_amdgcn_cvt_scalef32_pk_f16_fp4(q0, 1.0f, 2), __builtin_bit_cast(h2v_t, hp[2]), s0, false);
        s1 = __builtin_amdgcn_fdot2(__builtin_amdgcn_cvt_scalef32_pk_f16_fp4(q0, 1.0f, 3), __builtin_bit_cast(h2v_t, hp[3]), s1, false);
        s0 = __builtin_amdgcn_fdot2(__builtin_amdgcn_cvt_scalef32_pk_f16_fp4(q1, 1.0f, 0), __builtin_bit_cast(h2v_t, hp[4]), s0, false);
        s1 = __builtin_amdgcn_fdot2(__builtin_amdgcn_cvt_scalef32_pk_f16_fp4(q1, 1.0f, 1), __builtin_bit_cast(h2v_t, hp[5]), s1, false);
        s0 = __builtin_amdgcn_fdot2(__builtin_amdgcn_cvt_scalef32_pk_f16_fp4(q1, 1.0f, 2), __builtin_bit_cast(h2v_t, hp[6]), s0, false);
        s1 = __builtin_amdgcn_fdot2(__builtin_amdgcn_cvt_scalef32_pk_f16_fp4(q1, 1.0f, 3), __builtin_bit_cast(h2v_t, hp[7]), s1, false);
        d[k] = s0 + s1;
    }
#pragma unroll
    for (int k = 0; k < 4; ++k) *(LAS u32x2*)(vrow + k * GV_ROW) = S.vq[k];
    float e2[2], f1;
#pragma unroll
    for (int k = 0; k < 2; ++k) { auto r = __builtin_amdgcn_permlane16_swap(__float_as_uint(d[k]), __float_as_uint(d[k + 2]), false, false); e2[k] = __uint_as_float(r[0]) + __uint_as_float(r[1]); }
    { auto r = __builtin_amdgcn_permlane32_swap(__float_as_uint(e2[0]), __float_as_uint(e2[1]), false, false); f1 = __uint_as_float(r[0]) + __uint_as_float(r[1]); }
    f1 = DPP_ADD(f1, 0xB1); f1 = DPP_ADD(f1, 0x4E); f1 = DPP_ADD(f1, 0x124); f1 = DPP_ADD(f1, 0x128);
    return f1;
}
#define DPP_MAX(v, ctrl) fmaxf((v), __builtin_bit_cast(float, __builtin_amdgcn_update_dpp(0, __builtin_bit_cast(int, (v)), (ctrl), 0xf, 0xf, true)))
__device__ __forceinline__ void gather_vpart(float f0, float f1, float f2, float f3, int lane, int kslot, const LAS float* lg  ,
                                             const LAS unsigned char* vrd  , LAS unsigned char* cb, int aoff1, int aoff2, f32x4 (&acc)[8]) {
    const int q = (lane >> 2) & 3, e16 = 4 * q + kslot;
    const float fs = q == 0 ? f0 : q == 1 ? f1 : q == 2 ? f2 : f3;
    const float cv = lg[e16] * gelu_erf(fs * lg[GT * 128 + e16]);
    float mx = fabsf(cv);
    mx = DPP_MAX(mx, 0x124); mx = DPP_MAX(mx, 0x128);
    { auto r = __builtin_amdgcn_permlane16_swap(__float_as_uint(mx), __float_as_uint(mx), false, false); mx = fmaxf(__uint_as_float(r[0]), __uint_as_float(r[1])); }
    { auto r = __builtin_amdgcn_permlane32_swap(__float_as_uint(mx), __float_as_uint(mx), false, false); mx = fmaxf(__uint_as_float(r[0]), __uint_as_float(r[1])); }
    int E = (int)((__float_as_uint(mx) >> 23) & 0xffu); E = E < 8 ? 8 : E;
    const float x = cv * __uint_as_float((unsigned)(255 - E) << 23);
    const unsigned p1 = __builtin_amdgcn_cvt_scalef32_pk_fp4_f32(0u, x, 0.f, 1.0f, 0);
    const float r1 = x - __builtin_amdgcn_cvt_scalef32_pk_f32_fp4(p1, 1.0f, 0)[0];
    const unsigned p2 = __builtin_amdgcn_cvt_scalef32_pk_fp4_f32(0u, r1, 0.f, 1.0f, 0);
    const float y = (r1 - __builtin_amdgcn_cvt_scalef32_pk_f32_fp4(p2, 1.0f, 0)[0]) * 16.0f;
    const unsigned p3 = __builtin_amdgcn_cvt_scalef32_pk_fp4_f32(0u, y, 0.f, 1.0f, 0);
    const float r3 = y - __builtin_amdgcn_cvt_scalef32_pk_f32_fp4(p3, 1.0f, 0)[0];
    const unsigned p4 = __builtin_amdgcn_cvt_scalef32_pk_fp4_f32(0u, r3, 0.f, 1.0f, 0);
    const unsigned codes = (p1 & 15u) | ((p2 & 15u) << 8) | ((p3 & 15u) << 16) | ((p4 & 15u) << 24);
    { auto r = __builtin_amdgcn_permlane32_swap(codes, codes, false, false);
      const unsigned w = codes | ((r[0] ^ r[1] ^ codes) << 4);
      if (lane < 32 && (lane & 3) == 0) {
          LAS unsigned char* tb = cb + 8 + 2 * q + ((lane >> 4) & 1);
          tb[0] = (unsigned char)w; tb[16] = (unsigned char)(w >> 8); tb[32] = (unsigned char)(w >> 16); tb[48] = (unsigned char)(w >> 24);
      } }
    const u32x2 a10 = *(const LAS u32x2*)(cb + aoff1), a11 = *(const LAS u32x2*)(cb + aoff1 + 8), a20 = *(const LAS u32x2*)(cb + aoff2), a21 = *(const LAS u32x2*)(cb + aoff2 + 8);
    const v8i_t A1 = {(int)a10.x, (int)a10.y, (int)a11.x, (int)a11.y, 0, 0, 0, 0}, A2 = {(int)a20.x, (int)a20.y, (int)a21.x, (int)a21.y, 0, 0, 0, 0};
    const int sa1 = (E - 1) * 0x01010101, sa2 = (E - 5) * 0x01010101;
#pragma unroll
    for (int m = 0; m < 8; ++m) {
        const v2i_t t0 = __builtin_amdgcn_ds_read_tr4_b64_v2i32((LAS v2i_t*)(vrd + 16 * m)), t1 = __builtin_amdgcn_ds_read_tr4_b64_v2i32((LAS v2i_t*)(vrd + 16 * m + 8));
        const v8i_t B = {t0.x, t0.y, t1.x, t1.y, 0, 0, 0, 0};
        acc[m] = __builtin_amdgcn_mfma_scale_f32_16x16x128_f8f6f4(A1, B, acc[m], 4, 4, 0, sa1, 0, 0x7F7F7F7F);
        acc[m] = __builtin_amdgcn_mfma_scale_f32_16x16x128_f8f6f4(A2, B, acc[m], 4, 4, 0, sa2, 0, 0x7F7F7F7F);
    }
}
__device__ __forceinline__ void xcd_pace(unsigned* bar, volatile LAS unsigned* st);
constexpr int GNS = 8, GBPS = 32 / GNS, GSHIFT = 11;
constexpr int GATH_LDS_WAVE = GT * 128 * 12 + GV_BYTES + GC_BYTES;
#define GATH_SEG(J, NJ, nbt) { \
        const LAS int* le_ = lse + (J) * 128; const LAS int* ne_ = lse + (NJ) * 128; \
        gather_issue(D, GBPS * c + 3, lane, pu, pv, le_); \
        const float f0_ = gather_udot(A, hx[J], vwr); \
        gather_issue(A, (nbt), lane, pu, pv, ne_); \
        const float f1_ = gather_udot(B, hx[J], vwr + 4 * GV_ROW); \
        gather_issue(B, (nbt) + 1, lane, pu, pv, ne_); \
        const float f2_ = gather_udot(C, hx[J], vwr + 8 * GV_ROW); \
        gather_issue(C, (nbt) + 2, lane, pu, pv, ne_); \
        const float f3_ = gather_udot(D, hx[J], vwr + 12 * GV_ROW); \
        gather_vpart(f0_, f1_, f2_, f3_, lane, kslot, lsg + (J) * 128 + 16 * c, vrd, cb, aoff1, aoff2, acc[J]); }
__device__ void ph_peer_gather(const bf16* h2, const unsigned char* pu, const unsigned char* pv, const float* su, const float* sv,
                               const int* eidx, const float* egate, const float* xin, const float* gate  , float* xout, LAS unsigned char* lds, unsigned* pace_bar, volatile LAS unsigned* pace_st, int bid, int nb) {
    const int lane0 = ltid() & 63, w = __builtin_amdgcn_readfirstlane(ltid() >> 6);
    LAS int* lse = (LAS int*)(lds + w * GATH_LDS_WAVE); LAS float* lsg = (LAS float*)(lds + w * GATH_LDS_WAVE + GT * 128 * 4);
    LAS unsigned char* vb = lds + w * GATH_LDS_WAVE + GT * 128 * 12; LAS unsigned char* cb = vb + GV_BYTES;
    if (lane0 < GC_BYTES / 4) ((LAS unsigned*)cb)[lane0] = 0u;
    for (int t0 = (bid * 8 + w) * GT; t0 < MT; t0 += nb * 8 * GT) {
        int lane = lane0; asm volatile("" : "+v"(lane));
        const int row = lane >> 4;
        const int kslot = 2 * (row & 1) + (row >> 1);
        const int b = t0 >> 11;
        LAS unsigned char* vwr = vb + lane * 8;
        const LAS unsigned char* vrd = vb + (lane & 15) * GV_ROW + 128 * row;
        const int ai = lane & 15, au = (ai < 8 ? 1 : 3), nz = ((ai & 7) >> 1) == row;
        const int aoff1 = nz ? 8 * (au - (ai & 1)) : 64, aoff2 = nz ? 8 * (au + 4 - (ai & 1)) : 64;
        unsigned hx[GT][8]; f32x4 acc[GT][8];
#pragma unroll
        for (int j = 0; j < GT; ++j) {
            const int t = t0 + j;
            const int e0 = eidx[(size_t)t * 128 + lane], e1 = eidx[(size_t)t * 128 + 64 + lane];
            const float g0 = egate[(size_t)t * 128 + lane], g1 = egate[(size_t)t * 128 + 64 + lane];
            const int k0 = e0 >> GSHIFT, k1 = e1 >> GSHIFT;
            int off = 0, d0 = 0, d1 = 0;
#pragma unroll
            for (int s = 0; s < GNS; ++s) {
                const unsigned long long m0 = __ballot(k0 == s), m1 = __ballot(k1 == s);
                const int r0 = (int)__builtin_amdgcn_mbcnt_hi((unsigned)(m0 >> 32), __builtin_amdgcn_mbcnt_lo((unsigned)m0, 0u));
                const int r1 = (int)__builtin_amdgcn_mbcnt_hi((unsigned)(m1 >> 32), __builtin_amdgcn_mbcnt_lo((unsigned)m1, 0u));
                const int c0 = __builtin_popcountll(m0);
                if (k0 == s) d0 = off + r0;
                if (k1 == s) d1 = off + c0 + r1;
                off += c0 + __builtin_popcountll(m1);
            }
            lse[j * 128 + d0] = e0; lsg[j * 128 + d0] = g0 * sv[e0]; lse[j * 128 + d1] = e1; lsg[j * 128 + d1] = g1 * sv[e1];
            lsg[GT * 128 + j * 128 + d0] = su[e0]; lsg[GT * 128 + j * 128 + d1] = su[e1];
            const u32x4 u0 = *(const u32x4*)(h2 + (size_t)t * DM + lane * 16), u1 = *(const u32x4*)(h2 + (size_t)t * DM + lane * 16 + 8);
#pragma unroll
            for (int i = 0; i < 4; ++i) {
                hx[j][i] = __builtin_bit_cast(unsigned, __builtin_amdgcn_cvt_pkrtz(__uint_as_float(u0[i] << 16), __uint_as_float(u0[i] & 0xffff0000u)));
                hx[j][4 + i] = __builtin_bit_cast(unsigned, __builtin_amdgcn_cvt_pkrtz(__uint_as_float(u1[i] << 16), __uint_as_float(u1[i] & 0xffff0000u)));
            }
#pragma unroll
            for (int i = 0; i < 8; ++i) acc[j][i] = (f32x4){0.f, 0.f, 0.f, 0.f};
        }
        GSet A, B, C, D;
        gather_issue(A, 0, lane, pu, pv, lse); gather_issue(B, 1, lane, pu, pv, lse); gather_issue(C, 2, lane, pu, pv, lse);
#pragma unroll 1
        for (int c = 0; c < GNS; ++c) {
            GATH_SEG(0, 1, GBPS * c)
            GATH_SEG(1, 0, c < GNS - 1 ? GBPS * c + GBPS : 0)
        }
#pragma unroll
        for (int j = 0; j < GT; ++j) {
            const int t = t0 + j;
            LAS float* ob = (LAS float*)vb;
            const int nbase = 512 * (row & 1) + 32 * (row >> 1) + (lane & 15);
#pragma unroll
            for (int pm = 0; pm < 4; ++pm)
#pragma unroll
                for (int r = 0; r < 4; ++r) {
                    auto sw = __builtin_amdgcn_permlane32_swap(__float_as_uint(acc[j][2 * pm][r]), __float_as_uint(acc[j][2 * pm + 1][r]), false, false);
                    ob[nbase + 256 * (r >> 1) + 64 * pm + 16 * (r & 1)] = __uint_as_float(sw[0]) + __uint_as_float(sw[1]);
                }
#pragma unroll
            for (int i = 0; i < 4; ++i) {
                const int cc = i * 256 + lane * 4;
                const f32x4 a = *(const LAS f32x4*)(ob + cc);
                const f32x4 xi = *(const f32x4*)(xin + (size_t)t * DM + cc), gt = *(const f32x4*)(gate + (size_t)b * 6144 + cc);
                f32x4 o;
#pragma unroll
                for (int e = 0; e < 4; ++e) o[e] = xi[e] + gt[e] * a[e];
                *(f32x4*)(xout + (size_t)t * DM + cc) = o;
            }
        }
    }
}

#define XB_TMO      128
#define XB_XCNT(j)  (256  + 64 * (j))
#define XB_XSUB(j)  (1280 + 64 * (j))
#define XB_XGEN(j)  (2304 + 64 * (j))
#define XB_TOP      3328
#define XB_TOPGEN   3392
#define XCD_BAR_WORDS 3456
#define XB_SPIN_CAP (1u << 18)

__device__ __forceinline__ unsigned xb_ld(unsigned* p)              { return __hip_atomic_load(p, __ATOMIC_RELAXED, __HIP_MEMORY_SCOPE_AGENT); }
__device__ __forceinline__ unsigned xb_add(unsigned* p, unsigned v) { return __hip_atomic_fetch_add(p, v, __ATOMIC_RELAXED, __HIP_MEMORY_SCOPE_AGENT); }
__device__ __forceinline__ unsigned xb_xcc_id() { return (unsigned)__builtin_amdgcn_s_getreg((3 << 11) | 20) & 0xFu; }
#define XB_SPIN(cond, bar) do { unsigned _sp = 0; while (cond) { __builtin_amdgcn_s_sleep(1); \
    if ((++_sp & 255u) == 0u) { if (xb_ld(&(bar)[XB_TMO])) break; if (_sp > XB_SPIN_CAP) { atomicAdd(&(bar)[XB_TMO], 1u); break; } } } } while (0)

struct XcdBarrier {
    unsigned* bar; unsigned x;
    volatile LAS unsigned* st;
};

__device__ __forceinline__ XcdBarrier xcd_barrier_post(unsigned* bar, volatile LAS unsigned* st) {
    XcdBarrier b; b.bar = bar; b.x = xb_xcc_id(); b.st = st;
    if (threadIdx.x == 0) (void)xb_add(&bar[XB_XCNT(b.x)], 1u);
    return b;
}
__device__ __forceinline__ void xcd_barrier_complete(unsigned* bar, unsigned x, unsigned& nloc, unsigned& nx) {
    const unsigned G = gridDim.x * gridDim.y * gridDim.z;
    unsigned sum, cnt, mine, sp = 0u;
    for (;;) {
        sum = 0u; cnt = 0u; mine = 0u;
#pragma unroll
        for (unsigned j = 0; j < 16; ++j) { const unsigned c = xb_ld(&bar[XB_XCNT(j)]); sum += c; cnt += (c > 0u) ? 1u : 0u; mine = (j == x) ? c : mine; }
        if (sum == G) break;
        __builtin_amdgcn_s_sleep(1);
        if ((++sp & 255u) == 0u) { if (xb_ld(&bar[XB_TMO])) break; if (sp > XB_SPIN_CAP) { atomicAdd(&bar[XB_TMO], 1u); break; } }
    }
    nloc = mine > 0u ? mine : 1u; nx = cnt > 0u ? cnt : 1u;
}

__device__ __forceinline__ void xcd_barrier(const XcdBarrier& b) {
    asm volatile("s_waitcnt vmcnt(0)" ::: "memory");
    __syncthreads();
    if (threadIdx.x == 0) {
        unsigned* bar = b.bar;
        __builtin_amdgcn_s_waitcnt(0);
        unsigned nloc = b.st[0], nx = b.st[1];
        if (nloc == 0u) { xcd_barrier_complete(bar, b.x, nloc, nx); b.st[0] = nloc; b.st[1] = nx; }
        const unsigned old = xb_add(&bar[XB_XSUB(b.x)], 1u);
        const unsigned gen = old / nloc;
        if (old + 1u == (gen + 1u) * nloc) {
            __builtin_amdgcn_fence(__ATOMIC_RELEASE, "agent");
            asm volatile("s_waitcnt vmcnt(0)" ::: "memory");
            const unsigned og = xb_add(&bar[XB_TOP], 1u);
            const unsigned tg = og / nx;
            if (og + 1u == (tg + 1u) * nx) xb_add(&bar[XB_TOPGEN], 1u);
            else XB_SPIN(xb_ld(&bar[XB_TOPGEN]) == tg, bar);
            __builtin_amdgcn_fence(__ATOMIC_ACQUIRE, "agent");
            xb_add(&bar[XB_XGEN(b.x)], 1u);
            asm volatile("s_waitcnt vmcnt(0)" ::: "memory");
        } else {
            XB_SPIN(xb_ld(&bar[XB_XGEN(b.x)]) == gen, bar);
            __builtin_amdgcn_fence(__ATOMIC_ACQUIRE, "agent");
            asm volatile("s_waitcnt vmcnt(0)" ::: "memory");
        }
    }
    __syncthreads();
}


#define XB_PACE(j) (3584 + 64 * (j))
__device__ __forceinline__ void xcd_pace(unsigned* bar, volatile LAS unsigned* st) {
    __syncthreads();
    if (threadIdx.x == 0) {
        const unsigned nloc = st[0] ? st[0] : 1u, x = xb_xcc_id(), gen = st[4] + 1u;
        st[4] = gen;
        xb_add(&bar[XB_PACE(x)], 1u);
        unsigned sp = 0;
        while (xb_ld(&bar[XB_PACE(x)]) < gen * nloc) { __builtin_amdgcn_s_sleep(1); if (++sp > (1u << 16)) break; }
    }
    __syncthreads();
}
extern __shared__ __attribute__((aligned(16))) unsigned char dyn_lds[];
#ifndef REP_PREP
#define REP_PREP 1
#endif
#ifndef REP_ATTN
#define REP_ATTN 1
#endif
#ifndef REP_SEL
#define REP_SEL 1
#endif
#ifndef REP_GATH
#define REP_GATH 1
#endif
#ifndef REP_GEMM
#define REP_GEMM 1
#endif
#ifndef REP_ADALN
#define REP_ADALN 1
#endif
constexpr int LDS_BYTES = 147456;

template <class T> __device__ __forceinline__ T* karg(int byte_off) {
    const __attribute__((address_space(4))) char* base = (const __attribute__((address_space(4))) char*)__builtin_amdgcn_kernarg_segment_ptr();
    unsigned long long v = *(const __attribute__((address_space(4))) unsigned long long*)(base + byte_off);
    asm volatile("" : "+s"(v));
    return (T*)(__attribute__((address_space(1))) T*)v;
}
#define KIN(i) karg<const float>(8 * (i))
#define KOUT() karg<float>(168)
#define KWS() karg<unsigned char>(176)
static_assert(sizeof(Params) == 184, "Params layout");
template <class T> __device__ __forceinline__ T* launder(T* p) { size_t off = 0; asm volatile("" : "+s"(off)); return (T*)((unsigned char*)p + off); }
__global__ void __launch_bounds__(NT) mega_fwd(Params p) {
    cg::grid_group grid = cg::this_grid();
    const int bid = blockIdx.x, nb = gridDim.x;
    volatile LAS unsigned* bst = (volatile LAS unsigned*)((LAS unsigned char*)dyn_lds + LDS_BYTES - 64);
    if (ltid() < 16) bst[ltid()] = 0u;
    __syncthreads();
    const XcdBarrier xbar = xcd_barrier_post((unsigned*)(KWS() + WS_BAR), bst);
    for (int rep = 0; rep < REP_PREP; ++rep) {
        unsigned char* ws = KWS();
        float* tile = (float*)dyn_lds;
        ph_transpose(KIN(6), (bf16*)(ws + WS_WIN0), 1024, AB_IN, true, tile, bid, nb);
        ph_transpose(KIN(11), (bf16*)(ws + WS_WIN1), 1024, CD_IN, true, tile, bid, nb);
        ph_transpose(KIN(7), (bf16*)(ws + WS_WO0), 1024, 1024, false, tile, bid, nb);
        ph_transpose(KIN(12), (bf16*)(ws + WS_WO1), 1024, 1024, false, tile, bid, nb);
        ph_transpose(KIN(17), (bf16*)(ws + WS_WQ), 1024, PQ, false, tile, bid, nb);
        ph_transpose(KIN(17) + (size_t)1024 * PQ, (bf16*)(ws + WS_WQ) + (size_t)PQ * 1024, 1024, PQ, false, tile, bid, nb);
        ws = launder(ws);
        ph_tab_fp4(KIN(19), ws + WS_PU, (float*)(ws + WS_PV), 2 * NEXP, bid, nb);
        ph_tab_fp4(KIN(20), ws + WS_PU + 32 * MiB, (float*)(ws + WS_PV + 1 * MiB), 2 * NEXP, bid, nb);
        ws = launder(ws);
        ph_mod(KIN(1), KIN(2), KIN(3), (float*)(ws + WS_MOD), (float*)dyn_lds, bid, nb);
        ph_rope_table((float*)(ws + WS_ROPE), bid, nb);
        for (int i = bid * NT + ltid(); i < NB * 8 * 8 * 64; i += nb * NT) ((float*)(ws + WS_KMEAN))[i] = 0.f;
    }
    grid.sync();
#pragma unroll 1
    for (int layer = 0; layer < 2; ++layer) {
        for (int rep = 0; rep < REP_ADALN; ++rep) {
            unsigned char* ws = KWS(); const float* mod = (const float*)(ws + WS_MOD) + (size_t)layer * 32 * 6144;
            ph_adaln(layer == 0 ? KIN(0) : KOUT(), KIN(4) + layer * DM, mod + 0, mod + 1024, (bf16*)(ws + WS_HY), bid, nb);
        }
        xcd_barrier(xbar);
        for (int rep = 0; rep < REP_GEMM; ++rep) {
            unsigned char* ws = KWS();
            pg8::Gemm g{(const bf16*)(ws + WS_HY), (const bf16*)(ws + (layer == 0 ? WS_WIN0 : WS_WIN1)), MT, layer == 0 ? AB_IN : CD_IN, DM};
            pg8::StaticOrder S; S.init(g.M, g.N, nb, bid);
            pg8::EpiQKV e{(bf16*)(ws + WS_QKV), QKV_LD, (const float*)(ws + WS_ROPE), layer, layer == 0 ? KIN(9) : KIN(13), layer == 0 ? KIN(10) : KIN(14), KIN(15), KIN(16), (float*)(ws + WS_KMEAN)};
            pg8::gemm_phase<pg8::EpiQKV, pg8::StaticOrder, true, true>((LAS unsigned char*)dyn_lds, g, S, e);
        }
        xcd_barrier(xbar);
        for (int rep = 0; rep < REP_ATTN; ++rep) {
            unsigned char* ws = KWS();
            if (layer == 0) ph_attn0((const bf16*)(ws + WS_QKV), KIN(8), (bf16*)(ws + WS_HY), (LAS unsigned char*)dyn_lds, bid, nb);
            else ph_attn1((const bf16*)(ws + WS_QKV), (const float*)(ws + WS_KMEAN), (bf16*)(ws + WS_HY), (LAS unsigned char*)dyn_lds, bid, nb);
        }
        xcd_barrier(xbar);
        for (int rep = 0; rep < REP_GEMM; ++rep) {
            unsigned char* ws = KWS(); const float* mod = (const float*)(ws + WS_MOD) + (size_t)layer * 32 * 6144;
            pg8::Gemm g{(const bf16*)(ws + WS_HY), (const bf16*)(ws + (layer == 0 ? WS_WO0 : WS_WO1)), MT, DM, DM};
            pg8::StaticOrder S; S.init(g.M, g.N, nb, bid); pg8::EpiResid e{layer == 0 ? KIN(0) : KOUT(), (float*)(ws + WS_X1), mod + 2048};
            pg8::gemm_phase<pg8::EpiResid, pg8::StaticOrder, true, true>((LAS unsigned char*)dyn_lds, g, S, e);
        }
        xcd_barrier(xbar);
        for (int rep = 0; rep < REP_ADALN; ++rep) {
            unsigned char* ws = KWS(); const float* mod = (const float*)(ws + WS_MOD) + (size_t)layer * 32 * 6144;
            ph_adaln((const float*)(ws + WS_X1), KIN(5) + layer * DM, mod + 3072, mod + 4096, (bf16*)(ws + WS_QKV), bid, nb);
        }
        xcd_barrier(xbar);
        for (int rep = 0; rep < REP_GEMM; ++rep) {
            unsigned char* ws = KWS();
            pg8::Gemm g{(const bf16*)(ws + WS_QKV), (const bf16*)(ws + WS_WQ) + (size_t)layer * PQ * DM, MT, PQ, DM};
            pg8::StaticOrder S; S.init(g.M, g.N, nb, bid); pg8::EpiStore e{(bf16*)(ws + WS_QKV + 128 * MiB), PQ};
            pg8::gemm_phase<pg8::EpiStore, pg8::StaticOrder, true, true>((LAS unsigned char*)dyn_lds, g, S, e);
        }
        xcd_barrier(xbar);
        for (int rep = 0; rep < REP_SEL; ++rep) {
            unsigned char* ws = KWS();
            ph_peer_select((const bf16*)(ws + WS_QKV + 128 * MiB), KIN(18) + (size_t)layer * 2 * 128 * 128, (int*)(ws + WS_HY), (float*)(ws + WS_HY + 32 * MiB), (LAS unsigned char*)dyn_lds, bid, nb);
        }
        xcd_barrier(xbar);
        for (int rep = 0; rep < REP_GATH; ++rep) {
            unsigned char* ws = KWS(); const float* mod = (const float*)(ws + WS_MOD) + (size_t)layer * 32 * 6144;
            ph_peer_gather((const bf16*)(ws + WS_QKV), ws + WS_PU + (size_t)layer * NEXP * TROW4, ws + WS_PU + 32 * MiB + (size_t)layer * NEXP * TROW4,
                           (const float*)(ws + WS_PV) + layer * NEXP, (const float*)(ws + WS_PV + 1 * MiB) + layer * NEXP, (const int*)(ws + WS_HY), (const float*)(ws + WS_HY + 32 * MiB), (const float*)(ws + WS_X1), mod + 5120, KOUT(), (LAS unsigned char*)dyn_lds, (unsigned*)(ws + WS_BAR), bst, bid, nb);
        }
        if (layer == 0) xcd_barrier(xbar);
    }
}

extern "C" void kernel_launch(void* const* d_in, const int* in_sizes, int n_in, void* d_out, int out_size, void* d_ws, size_t ws_size, hipStream_t stream) {
    if (n_in != 21 || ws_size < WS_END) { fprintf(stderr, "kernel_launch: bad args n_in=%d ws=%zu\n", n_in, ws_size); return; }
    static int grid_blocks = 0;
    if (!grid_blocks) {
        int dev = 0, cus = 0, per_cu = 0;
        (void)hipGetDevice(&dev);
        (void)hipDeviceGetAttribute(&cus, hipDeviceAttributeMultiprocessorCount, dev);
        (void)hipFuncSetAttribute((const void*)mega_fwd, hipFuncAttributeMaxDynamicSharedMemorySize, LDS_BYTES);
        (void)hipOccupancyMaxActiveBlocksPerMultiprocessor(&per_cu, (const void*)mega_fwd, NT, LDS_BYTES);
        if (per_cu < 1) { fprintf(stderr, "kernel_launch: occupancy query returned %d\n", per_cu); per_cu = 1; }
        if (per_cu > 1) per_cu = 1;
        grid_blocks = cus * per_cu;
    }
    Params p{};
    for (int i = 0; i < 21; ++i) p.in[i] = (const float*)d_in[i];
    p.out = (float*)d_out; p.ws = (unsigned char*)d_ws;
    (void)hipMemsetAsync((char*)d_ws + WS_BAR, 0, 16384, stream);
    void* args[] = {&p};
    hipError_t e = hipLaunchCooperativeKernel((const void*)mega_fwd, dim3(grid_blocks), dim3(NT), args, LDS_BYTES, stream);
    if (e != hipSuccess) fprintf(stderr, "cooperative launch failed: %s (grid %d)\n", hipGetErrorString(e), grid_blocks);
}
```

```cpp
#include <hip/hip_runtime.h>
#ifndef REP_A
#define REP_A 1
#endif
#ifndef REP_B
#define REP_B 1
#endif
#ifndef REP_C
#define REP_C 1
#endif
#ifndef REP_D
#define REP_D 1
#endif
#include <hip/hip_cooperative_groups.h>
namespace cg = cooperative_groups;
#include <cstdio>
#include <cstdint>
#include <cmath>

typedef unsigned short bf16;
typedef short bf16x8 __attribute__((ext_vector_type(8)));
typedef float f32x4 __attribute__((ext_vector_type(4)));
typedef unsigned u32x4 __attribute__((ext_vector_type(4)));
typedef unsigned u32x2 __attribute__((ext_vector_type(2)));

constexpr int DM = 1024, NB = 32, SQ = 2048, MT = NB * SQ;
constexpr int HD = 64;
constexpr int AB_IN = 2304, CD_IN = 3072, QKV_LD = 3072;
constexpr int NEXP = 16384, PQ = 2048;
constexpr float EPS = 1e-6f;
constexpr int NT = 512;

constexpr size_t MiB = 1u << 20;
constexpr size_t WS_X1 = 0;
constexpr size_t WS_QKV = 256 * MiB;
constexpr size_t WS_HY = 640 * MiB;
constexpr size_t WS_PU = 768 * MiB;
constexpr size_t WS_PV = 832 * MiB;
constexpr size_t WS_WIN0 = 896 * MiB;
constexpr size_t WS_WIN1 = 901 * MiB;
constexpr size_t WS_WO0 = 907 * MiB;
constexpr size_t WS_WO1 = 909 * MiB;
constexpr size_t WS_WQ = 911 * MiB;
constexpr size_t WS_MOD = 919 * MiB;
constexpr size_t WS_ROPE = 921 * MiB;
constexpr size_t WS_KMEAN = 922 * MiB;
constexpr size_t WS_BAR = 923 * MiB;
constexpr size_t WS_END = 924 * MiB;

struct Params {
    const float* in[21];
    float* out;
    unsigned char* ws;
};

__device__ __forceinline__ int ltid() { int t = (int)__builtin_amdgcn_workitem_id_x(); asm volatile("" : "+v"(t)); return t; }
__device__ __forceinline__ float bf2f(unsigned b) { return __uint_as_float(b << 16); }
__device__ __forceinline__ unsigned f2bf(float f) { unsigned u = __float_as_uint(f); return (u + 0x7fffu + ((u >> 16) & 1u)) >> 16; }
__device__ __forceinline__ unsigned pk2(float lo, float hi) { return f2bf(lo) | (f2bf(hi) << 16); }
#define DPPV(v, ctrl) __builtin_bit_cast(float, __builtin_amdgcn_update_dpp(0, __builtin_bit_cast(int, (v)), (ctrl), 0xf, 0xf, true))
__device__ __forceinline__ float row16_sum(float v) { v += DPPV(v, 0xB1); v += DPPV(v, 0x4E); v += DPPV(v, 0x124); v += DPPV(v, 0x128); return v; }
__device__ __forceinline__ float rows_sum(float v) {
    { auto r = __builtin_amdgcn_permlane16_swap(__float_as_uint(v), __float_as_uint(v), false, false); v = __uint_as_float(r[0]) + __uint_as_float(r[1]); }
    { auto r = __builtin_amdgcn_permlane32_swap(__float_as_uint(v), __float_as_uint(v), false, false); v = __uint_as_float(r[0]) + __uint_as_float(r[1]); }
    return v;
}
__device__ __forceinline__ float wave_sum(float v) { return rows_sum(row16_sum(v)); }
__device__ __forceinline__ float wave_max(float v) {
    v = fmaxf(v, DPPV(v, 0xB1)); v = fmaxf(v, DPPV(v, 0x4E)); v = fmaxf(v, DPPV(v, 0x124)); v = fmaxf(v, DPPV(v, 0x128));
    { auto r = __builtin_amdgcn_permlane16_swap(__float_as_uint(v), __float_as_uint(v), false, false); v = fmaxf(__uint_as_float(r[0]), __uint_as_float(r[1])); }
    { auto r = __builtin_amdgcn_permlane32_swap(__float_as_uint(v), __float_as_uint(v), false, false); v = fmaxf(__uint_as_float(r[0]), __uint_as_float(r[1])); }
    return v;
}
__device__ __forceinline__ float gelu_erf(float x) {
    const float z = x * 0.70710678118654752f, az = fabsf(z);
    const float t = __builtin_amdgcn_rcpf(fmaf(0.3275911f, az, 1.0f));
    float pl = fmaf(t, 1.061405429f, -1.453152027f); pl = fmaf(t, pl, 1.421413741f); pl = fmaf(t, pl, -0.284496736f); pl = fmaf(t, pl, 0.254829592f); pl *= t;
    const float ex = __builtin_amdgcn_exp2f(az * (az * -1.4426950408889634f));
    const float er = copysignf(fmaf(-pl, ex, 1.0f), z);
    const float hx = 0.5f * x;
    return fmaf(hx, er, hx);
}

__device__ __forceinline__ int qkv_logical_col(int p) { return (p & ~255) | (((p >> 5) & 3) << 6) | (((p >> 7) & 1) << 5) | (p & 31); }
__device__ void ph_transpose(const float* W, bf16* Wt, int K, int N, bool permute, float* tile  , int bid, int nb) {
    const int tid = ltid();
    const int nkt = K / 64, nnt = N / 64;
    for (int it = bid; it < nkt * nnt; it += nb) {
        const int k0 = (it / nnt) * 64, n0 = (it % nnt) * 64;
        __syncthreads();
        for (int e = tid; e < 64 * 64; e += NT) { const int r = e >> 6, c = e & 63; const int nl = permute ? qkv_logical_col(n0 + c) : n0 + c; tile[r * 65 + c] = W[(size_t)(k0 + r) * N + nl]; }
        __syncthreads();
        {
            const int n = tid >> 3, k8 = (tid & 7) * 8;
            u32x4 v;
            v.x = pk2(tile[(k8 + 0) * 65 + n], tile[(k8 + 1) * 65 + n]);
            v.y = pk2(tile[(k8 + 2) * 65 + n], tile[(k8 + 3) * 65 + n]);
            v.z = pk2(tile[(k8 + 4) * 65 + n], tile[(k8 + 5) * 65 + n]);
            v.w = pk2(tile[(k8 + 6) * 65 + n], tile[(k8 + 7) * 65 + n]);
            *(u32x4*)(Wt + (size_t)(n0 + n) * K + k0 + k8) = v;
        }
    }
}
__device__ void ph_convert(const float* src, bf16* dst, size_t n, int bid, int nb) {
    const size_t n8 = n / 8;
    for (size_t i = (size_t)bid * NT + ltid(); i < n8; i += (size_t)nb * NT) {
        const f32x4 a = *(const f32x4*)(src + i * 8), b = *(const f32x4*)(src + i * 8 + 4);
        u32x4 v; v.x = pk2(a[0], a[1]); v.y = pk2(a[2], a[3]); v.z = pk2(b[0], b[1]); v.w = pk2(b[2], b[3]);
        *(u32x4*)(dst + i * 8) = v;
    }
}
__device__ void ph_mod(const float* c, const float* ada_w, const float* ada_b, float* mod, float* lds  , int bid, int nb) {
    const int tid = ltid(), lane = tid & 63, w = tid >> 6;
    for (int it = bid; it < 2 * 96; it += nb) {
        const int l = it / 96, j = (it % 96) * 64 + lane;
        float acc[32];
#pragma unroll
        for (int b = 0; b < 32; ++b) acc[b] = 0.f;
        for (int kh = 0; kh < 2; ++kh) {
            __syncthreads();
            for (int e = tid; e < 32 * 512; e += NT) { const int b = e >> 9, k = e & 511; const float cv = c[b * 1024 + kh * 512 + k]; lds[e] = cv / (1.0f + __expf(-cv)); }
            __syncthreads();
            for (int kk = 0; kk < 64; ++kk) {
                const int k = w * 64 + kk;
                const float wv = ada_w[((size_t)l * 1024 + kh * 512 + k) * 6144 + j];
#pragma unroll
                for (int b = 0; b < 32; ++b) acc[b] += lds[b * 512 + k] * wv;
            }
        }
        __syncthreads();
#pragma unroll
        for (int b = 0; b < 32; ++b) lds[(w * 32 + b) * 64 + lane] = acc[b];
        __syncthreads();
        for (int e = tid; e < 32 * 64; e += NT) {
            const int b = e >> 6, jj = e & 63; float s = 0.f;
#pragma unroll
            for (int ww = 0; ww < 8; ++ww) s += lds[(ww * 32 + b) * 64 + jj];
            const int jo = (it % 96) * 64 + jj;
            mod[((size_t)l * 32 + b) * 6144 + jo] = s + ada_b[l * 6144 + jo];
        }
    }
}
__device__ void ph_rope_table(float* rope, int bid, int nb) {
    for (int i = bid * NT + ltid(); i < SQ * 32; i += nb * NT) {
        const int t = i >> 5, f = i & 31;
        const float inv = powf(10000.0f, -(float)f / 32.0f);
        const float ang = (float)t * inv;
        float s, c; sincosf(ang, &s, &c);
        rope[i * 2] = c; rope[i * 2 + 1] = s;
    }
}

#define DPP_ADD0(v, ctrl) ((v) + __builtin_bit_cast(float, __builtin_amdgcn_update_dpp(0, __builtin_bit_cast(int, (v)), (ctrl), 0xf, 0xf, true)))
__device__ void ph_adaln(const float* x, const float* g, const float* mod_shift  , const float* mod_scale, bf16* h, int bid, int nb) {
    const int lane = ltid() & 63, w = __builtin_amdgcn_readfirstlane(ltid() >> 6);
    for (int t0 = (bid * 8 + w) * 4; t0 < MT; t0 += nb * 8 * 4) {
        const int b = t0 >> 11;
        f32x4 v[4][4]; float ss[4];
#pragma unroll
        for (int r = 0; r < 4; ++r) {
            const float* xr = x + (size_t)(t0 + r) * DM;
#pragma unroll
            for (int i = 0; i < 4; ++i) v[r][i] = *(const f32x4*)(xr + i * 256 + lane * 4);
        }
#pragma unroll
        for (int r = 0; r < 4; ++r) {
            float s = 0.f;
#pragma unroll
            for (int i = 0; i < 4; ++i) s += v[r][i][0] * v[r][i][0] + v[r][i][1] * v[r][i][1] + v[r][i][2] * v[r][i][2] + v[r][i][3] * v[r][i][3];
            s = DPP_ADD0(s, 0xB1); s = DPP_ADD0(s, 0x4E); s = DPP_ADD0(s, 0x124); s = DPP_ADD0(s, 0x128);
            { auto q = __builtin_amdgcn_permlane16_swap(__float_as_uint(s), __float_as_uint(s), false, false); s = __uint_as_float(q[0]) + __uint_as_float(q[1]); }
            { auto q = __builtin_amdgcn_permlane32_swap(__float_as_uint(s), __float_as_uint(s), false, false); s = __uint_as_float(q[0]) + __uint_as_float(q[1]); }
            ss[r] = rsqrtf(s * (1.0f / DM) + EPS);
        }
#pragma unroll
        for (int i = 0; i < 4; ++i) {
            const int c = i * 256 + lane * 4;
            const f32x4 gg = *(const f32x4*)(g + c), sc = *(const f32x4*)(mod_scale + (size_t)b * 6144 + c), sh = *(const f32x4*)(mod_shift + (size_t)b * 6144 + c);
            float a[4];
#pragma unroll
            for (int e = 0; e < 4; ++e) a[e] = gg[e] * (1.0f + sc[e]);
#pragma unroll
            for (int r = 0; r < 4; ++r) {
                float y[4];
#pragma unroll
                for (int e = 0; e < 4; ++e) y[e] = v[r][i][e] * ss[r] * a[e] + sh[e];
                u32x2 o; o.x = pk2(y[0], y[1]); o.y = pk2(y[2], y[3]);
                __builtin_nontemporal_store(o, (u32x2*)(h + (size_t)(t0 + r) * DM + c));
            }
        }
    }
}

namespace pg8 {
#define PG8_LAS __attribute__((address_space(3)))
typedef unsigned short bf16_t;
typedef short bf16x8 __attribute__((ext_vector_type(8)));
constexpr int BM = 256, BK = 64, HALF = 128, HTB = HALF * BK * 2  , STAGE_BYTES = 8 * HTB, NXCD = 8, WGM = 8;

__host__ __device__ __forceinline__ int lds_byte(int r, int c) { const int st = (r >> 4) * 2 + (c >> 5), rr = r & 15, cc = c & 31, ob = rr * 64 + cc * 2; return st * 1024 + (ob ^ (((ob >> 9) & 1) << 5)); }
__host__ __device__ __forceinline__ void stage_rc(int b, int& R, int& C) { const int st = b / 1024, sb = b % 1024, swz = sb ^ (((sb >> 9) & 1) << 5); R = (st >> 1) * 16 + swz / 64; C = (st & 1) * 32 + (swz % 64) / 2; }
__host__ __device__ __forceinline__ int perm32(int rho) { const int n = rho >> 4, i = rho & 15; return 8 * (i >> 2) + 4 * n + (i & 3); }

struct Unit { int pm, pn; };
struct Gemm { const bf16_t* A; const bf16_t* Bt; int M, N, K; };

struct StaticOrder {
    int nM, nN, nwg, G, c;
    __host__ __device__ void init(int M, int N, int G_, int c_) { nM = M / BM; nN = N / BM; nwg = nM * nN; G = G_; c = c_; }
    __host__ __device__ bool next(int i, Unit& u) const {
        const long L = (long)i * G + c; if (L >= nwg) return false;
        int wgid = (int)L; { const int q = nwg / NXCD, r = nwg % NXCD, xcd = wgid % NXCD, off = wgid / NXCD; wgid = (xcd < r ? xcd * (q + 1) : r * (q + 1) + (xcd - r) * q) + off; }
        const int nig = WGM * nN, gid = wgid / nig, fm = gid * WGM, gsz = (nM - fm) < WGM ? (nM - fm) : WGM;
        u.pm = fm + ((wgid % nig) % gsz); u.pn = (wgid % nig) / gsz; return true;
    }
    __device__ __forceinline__ void a_ready(const Unit&) const {}
    __device__ __forceinline__ void done(const Unit&) const {}
};

__device__ __forceinline__ unsigned cvt_pk_bf16(float lo, float hi) { unsigned r; asm volatile("v_cvt_pk_bf16_f32 %0, %1, %2" : "=v"(r) : "v"(lo), "v"(hi)); return r; }

struct EpiStore {
    static constexpr bool PERM = true, AFTER_DRAIN = false;
    bf16_t* O; int ldc;
    __device__ __forceinline__ void operator()(const f32x4 (&acc)[2][2][4][2], const Unit& u, int wr, int wc, int fr_, int fq_) const {
        int fr = fr_, fq = fq_; asm volatile("" : "+v"(fr), "+v"(fq));
        const int row0 = u.pm * BM + wr * 64 + fr, col0 = u.pn * BM + wc * 32 + 8 * fq;
#pragma unroll
        for (int ai = 0; ai < 2; ++ai)
#pragma unroll
            for (int m = 0; m < 4; ++m) { bf16_t* rowp = O + (size_t)(row0 + ai * HALF + m * 16) * ldc + col0;
#pragma unroll
                for (int bj = 0; bj < 2; ++bj) { const f32x4 v0 = acc[ai][bj][m][0], v1 = acc[ai][bj][m][1];
                    u32x4 w; w.x = cvt_pk_bf16(v0[0], v0[1]); w.y = cvt_pk_bf16(v0[2], v0[3]); w.z = cvt_pk_bf16(v1[0], v1[1]); w.w = cvt_pk_bf16(v1[2], v1[3]);
                    *(u32x4*)(rowp + bj * HALF) = w; } }
    }
};
struct EpiQKV {
    static constexpr bool PERM = true, AFTER_DRAIN = false;
    bf16_t* O; int ldc; const float* rope; int layer;
    const float* gq0; const float* gk0;
    const float* gq1; const float* gk1;
    float* kmean;
    __device__ __forceinline__ void operator()(const f32x4 (&acc)[2][2][4][2], const Unit& u, int wr, int wc, int fr_, int fq_) const {
        int fr = fr_, fq = fq_; asm volatile("" : "+v"(fr), "+v"(fq));
        const int hg = 4 * u.pn + wc;
        const float* gain = nullptr; bool km = false;
        if (layer == 0) { if (hg < 8) gain = gq0; else if (hg < 10) gain = gk0; }
        else { if (hg < 8) gain = gq0; else if (hg < 16) gain = gk0; else if (hg >= 24 && hg < 32) gain = gq1; else if (hg >= 32 && hg < 40) { gain = gk1; km = true; } }
        const int row0 = u.pm * BM + wr * 64 + fr, col0 = 64 * hg + 8 * fq;
        float g0[8], g1[8], cs0[8], cs1[8];
#pragma unroll
        for (int e = 0; e < 8; ++e) { g0[e] = gain ? gain[8 * fq + e] : 1.f; g1[e] = gain ? gain[32 + 8 * fq + e] : 1.f; cs0[e] = 0.f; cs1[e] = 0.f; }
#pragma unroll
        for (int ai = 0; ai < 2; ++ai)
#pragma unroll
            for (int m = 0; m < 4; ++m) {
                const int row = row0 + ai * HALF + m * 16;
                float v0[8], v1[8];
#pragma unroll
                for (int e = 0; e < 4; ++e) { v0[e] = acc[ai][0][m][0][e]; v0[4 + e] = acc[ai][0][m][1][e]; v1[e] = acc[ai][1][m][0][e]; v1[4 + e] = acc[ai][1][m][1][e]; }
                if (gain) {
                    float ss = 0.f;
#pragma unroll
                    for (int e = 0; e < 8; ++e) ss += v0[e] * v0[e] + v1[e] * v1[e];
                    ss = rows_sum(ss);
                    const float r = rsqrtf(ss * (1.0f / 64.0f) + 1e-6f);
                    const float* rp = rope + ((size_t)(row & 2047) * 32 + 8 * fq) * 2;
                    const f32x4 t0 = *(const f32x4*)(rp), t1 = *(const f32x4*)(rp + 4), t2 = *(const f32x4*)(rp + 8), t3 = *(const f32x4*)(rp + 12);
                    const float cs[8] = {t0[0], t0[2], t1[0], t1[2], t2[0], t2[2], t3[0], t3[2]}, sn[8] = {t0[1], t0[3], t1[1], t1[3], t2[1], t2[3], t3[1], t3[3]};
#pragma unroll
                    for (int e = 0; e < 8; ++e) { const float y0 = v0[e] * r * g0[e], y1 = v1[e] * r * g1[e]; v0[e] = y0 * cs[e] - y1 * sn[e]; v1[e] = y1 * cs[e] + y0 * sn[e]; }
                }
                u32x4 w0, w1;
                w0.x = cvt_pk_bf16(v0[0], v0[1]); w0.y = cvt_pk_bf16(v0[2], v0[3]); w0.z = cvt_pk_bf16(v0[4], v0[5]); w0.w = cvt_pk_bf16(v0[6], v0[7]);
                w1.x = cvt_pk_bf16(v1[0], v1[1]); w1.y = cvt_pk_bf16(v1[2], v1[3]); w1.z = cvt_pk_bf16(v1[4], v1[5]); w1.w = cvt_pk_bf16(v1[6], v1[7]);
                bf16_t* rowp = O + (size_t)row * ldc + col0;
                *(u32x4*)(rowp) = w0; *(u32x4*)(rowp + 32) = w1;
                if (km) {
#pragma unroll
                    for (int e = 0; e < 8; ++e) { cs0[e] += v0[e]; cs1[e] += v1[e]; }
                }
            }
        if (km) {
#pragma unroll
            for (int e = 0; e < 8; ++e) {
                cs0[e] = row16_sum(cs0[e]); cs1[e] = row16_sum(cs1[e]);
            }
            if (fr == 0) {
                float* kp = kmean + ((size_t)((u.pm >> 3) * 8 + (hg - 32)) * 8 + (u.pm & 7)) * 64 + 8 * fq;
#pragma unroll
                for (int e = 0; e < 8; ++e) { atomicAdd(kp + e, cs0[e] * (1.0f / 256.0f)); atomicAdd(kp + 32 + e, cs1[e] * (1.0f / 256.0f)); }
            }
        }
    }
};
struct EpiResid {
    static constexpr bool PERM = true, AFTER_DRAIN = false;
    const float* xin; float* xout; const float* gate;
    __device__ __forceinline__ void operator()(const f32x4 (&acc)[2][2][4][2], const Unit& u, int wr, int wc, int fr_, int fq_) const {
        int fr = fr_, fq = fq_; asm volatile("" : "+v"(fr), "+v"(fq));
        const int row0 = u.pm * BM + wr * 64 + fr, col0 = u.pn * BM + wc * 32 + 8 * fq;
#pragma unroll
        for (int ai = 0; ai < 2; ++ai)
#pragma unroll
            for (int m = 0; m < 4; ++m) { const int row = row0 + ai * HALF + m * 16; const float* gp = gate + (size_t)(row >> 11) * 6144 + col0;
                const float* xi = xin + (size_t)row * 1024 + col0; float* xo = xout + (size_t)row * 1024 + col0;
#pragma unroll
                for (int bj = 0; bj < 2; ++bj)
#pragma unroll
                    for (int n = 0; n < 2; ++n) { const f32x4 a = acc[ai][bj][m][n], x = *(const f32x4*)(xi + bj * HALF + 4 * n), g = *(const f32x4*)(gp + bj * HALF + 4 * n);
                        f32x4 o; o[0] = x[0] + g[0] * a[0]; o[1] = x[1] + g[1] * a[1]; o[2] = x[2] + g[2] * a[2]; o[3] = x[3] + g[3] * a[3];
                        *(f32x4*)(xo + bj * HALF + 4 * n) = o; } }
    }
};
template <class Epi, class Sched, bool ALIGN_EPI = false, bool SP2 = false>
__device__ __forceinline__ void gemm_phase(PG8_LAS unsigned char* lds, const Gemm g, const Sched& S, const Epi& E) {
    const int tid = ltid(), wid = __builtin_amdgcn_readfirstlane(tid >> 6), lane = tid & 63, wr = wid >> 2, wc = wid & 3, fr = lane & 15, fq = lane >> 4;
    const int K = g.K, nt = K / BK;
    unsigned voffA[2], voffB[2];
#pragma unroll
    for (int i = 0; i < 2; ++i) { int R, C; stage_rc(tid * 16 + i * 8192, R, C); const int Rb = Epi::PERM ? ((R & ~31) + perm32(R & 31)) : R;
        voffA[i] = (unsigned)(R * K + C) * 2u; voffB[i] = (unsigned)(Rb * K + C) * 2u; }
    const size_t kstep = (size_t)(BK * 2);
    const size_t hstep = (size_t)HALF * K * 2;
    const size_t tstep = 2 * hstep;
    const unsigned ldsw = (unsigned)wid * 1024u;
    const int aoff = lds_byte(wr * 64 + fr, fq * 8), boff = lds_byte(wc * 32 + fr, fq * 8);
#define PG8_SA(b, h) (((b) * 2 + (h)) * HTB)
#define PG8_SB(b, h) ((4 + (b) * 2 + (h)) * HTB)
#define PG8_STAGE(bufoff, gbase, voff) do { _Pragma("unroll") for (int _i = 0; _i < 2; ++_i) \
        __builtin_amdgcn_global_load_lds((const unsigned*)((const char*)(gbase) + (voff)[_i]), (PG8_LAS unsigned*)(lds + (bufoff) + ldsw + _i * 8192), 16, 0, 0); } while (0)
#define PG8_LDA(dst, b, h) do { _Pragma("unroll") for (int m = 0; m < 4; ++m) _Pragma("unroll") for (int k = 0; k < 2; ++k) dst[m][k] = *(const PG8_LAS bf16x8*)(lds + PG8_SA(b, h) + aoff + m * 2048 + k * 1024); } while (0)
#define PG8_LDB(dst, b, h) do { _Pragma("unroll") for (int n = 0; n < 2; ++n) _Pragma("unroll") for (int k = 0; k < 2; ++k) dst[n][k] = *(const PG8_LAS bf16x8*)(lds + PG8_SB(b, h) + boff + n * 2048 + k * 1024); } while (0)
#define PG8_MMA(ai, bj, At, Bt) do { __builtin_amdgcn_s_setprio(1); _Pragma("unroll") for (int m = 0; m < 4; ++m) _Pragma("unroll") for (int n = 0; n < 2; ++n) _Pragma("unroll") for (int k = 0; k < 2; ++k) \
        acc[ai][bj][m][n] = __builtin_amdgcn_mfma_f32_16x16x32_bf16(Bt[n][k], At[m][k], acc[ai][bj][m][n], 0, 0, 0); __builtin_amdgcn_s_setprio(0); } while (0)
#define PG8_WAIT_V(n) asm volatile("s_waitcnt vmcnt(" #n ")" ::: "memory")
#define PG8_WAIT_L(n) asm volatile("s_waitcnt lgkmcnt(" #n ")" ::: "memory")
#define PG8_BAR __builtin_amdgcn_s_barrier()
#define PG8_SCHED __builtin_amdgcn_sched_barrier(0)
    Unit cur, nxt; int ui = 0;
    if (!S.next(0, cur)) return;
    f32x4 acc[2][2][4][2];
#pragma unroll
    for (int a = 0; a < 2; ++a)
#pragma unroll
        for (int b = 0; b < 2; ++b)
#pragma unroll
            for (int m = 0; m < 4; ++m)
#pragma unroll
                for (int n = 0; n < 2; ++n) acc[a][b][m][n] = (f32x4){0.f, 0.f, 0.f, 0.f};
    bf16x8 At[4][2], B0[2][2], B1[2][2];
    const char* cA = (const char*)g.A + (size_t)cur.pm * tstep; const char* cB = (const char*)g.Bt + (size_t)cur.pn * tstep;
    S.a_ready(cur);
    if constexpr (SP2) {
        PG8_STAGE(PG8_SB(0, 0), cB, voffB); PG8_STAGE(PG8_SB(0, 1), cB + hstep, voffB); PG8_STAGE(PG8_SA(0, 0), cA, voffA); PG8_STAGE(PG8_SA(0, 1), cA + hstep, voffA);
        if (wr == 1) PG8_BAR;
        PG8_WAIT_V(2); PG8_BAR;
        PG8_STAGE(PG8_SB(1, 0), cB + kstep, voffB); PG8_STAGE(PG8_SA(1, 0), cA + kstep, voffA); PG8_STAGE(PG8_SB(1, 1), cB + hstep + kstep, voffB);
        PG8_WAIT_V(6); PG8_BAR;
    } else {
        PG8_STAGE(PG8_SB(0, 0), cB, voffB); PG8_STAGE(PG8_SA(0, 0), cA, voffA); PG8_STAGE(PG8_SB(0, 1), cB + hstep, voffB); PG8_STAGE(PG8_SA(0, 1), cA + hstep, voffA);
        if (wr == 1) PG8_BAR;
        PG8_WAIT_V(4); PG8_BAR;
        PG8_STAGE(PG8_SB(1, 0), cB + kstep, voffB); PG8_STAGE(PG8_SA(1, 0), cA + kstep, voffA); PG8_STAGE(PG8_SB(1, 1), cB + hstep + kstep, voffB);
        PG8_WAIT_V(6); PG8_BAR;
    }
    for (;;) {
        const bool has_next = S.next(ui + 1, nxt);
        const char* nA = has_next ? (const char*)g.A + (size_t)nxt.pm * tstep : cA; const char* nB = has_next ? (const char*)g.Bt + (size_t)nxt.pn * tstep : cB;
        for (int t = 0; t < nt; t += 2) {
            const bool last = (t == nt - 2);
            const char* a1 = cA + (size_t)(t + 1) * kstep;
            const char* a2 = last ? nA : cA + (size_t)(t + 2) * kstep; const char* b2 = last ? nB : cB + (size_t)(t + 2) * kstep;
            const char* a3 = a2 + kstep; const char* b3 = b2 + kstep;
            if (last && has_next) S.a_ready(nxt);
            if constexpr (SP2) {
            PG8_LDB(B0, 0, 0); PG8_LDB(B1, 0, 1); PG8_SCHED; PG8_LDA(At, 0, 0); PG8_STAGE(PG8_SA(1, 1), a1 + hstep, voffA);
            PG8_WAIT_V(8); PG8_WAIT_L(0); PG8_BAR; PG8_MMA(0, 0, At, B0); PG8_MMA(0, 1, At, B1); PG8_BAR; PG8_SCHED;
            PG8_LDA(At, 0, 1); PG8_STAGE(PG8_SB(0, 0), b2, voffB); PG8_STAGE(PG8_SB(0, 1), b2 + hstep, voffB); PG8_STAGE(PG8_SA(0, 0), a2, voffA);
            PG8_WAIT_V(8); PG8_WAIT_L(0); PG8_BAR; PG8_MMA(1, 0, At, B0); PG8_MMA(1, 1, At, B1); PG8_BAR; PG8_SCHED;
            PG8_LDB(B0, 1, 0); PG8_LDB(B1, 1, 1); PG8_SCHED; PG8_LDA(At, 1, 0); PG8_STAGE(PG8_SA(0, 1), a2 + hstep, voffA);
            PG8_WAIT_V(8); PG8_WAIT_L(0); PG8_BAR; PG8_MMA(0, 0, At, B0); PG8_MMA(0, 1, At, B1); PG8_BAR; PG8_SCHED;
            PG8_LDA(At, 1, 1); PG8_STAGE(PG8_SB(1, 0), b3, voffB); PG8_STAGE(PG8_SB(1, 1), b3 + hstep, voffB); PG8_STAGE(PG8_SA(1, 0), a3, voffA);
            PG8_WAIT_V(8); PG8_WAIT_L(0); PG8_BAR; PG8_MMA(1, 0, At, B0); PG8_MMA(1, 1, At, B1); PG8_BAR; PG8_SCHED;
            } else {
            PG8_LDB(B0, 0, 0); PG8_SCHED; PG8_LDA(At, 0, 0); PG8_STAGE(PG8_SA(1, 1), a1 + hstep, voffA);
            PG8_WAIT_L(8); PG8_BAR; PG8_WAIT_L(0); PG8_MMA(0, 0, At, B0); PG8_BAR; PG8_SCHED;
            PG8_LDB(B1, 0, 1); PG8_STAGE(PG8_SB(0, 0), b2, voffB);
            PG8_BAR; PG8_WAIT_L(0); PG8_MMA(0, 1, At, B1); PG8_BAR;
            PG8_LDA(At, 0, 1); PG8_STAGE(PG8_SA(0, 0), a2, voffA);
            PG8_BAR; PG8_WAIT_L(0); PG8_MMA(1, 0, At, B0); PG8_BAR; PG8_SCHED;
            PG8_STAGE(PG8_SB(0, 1), b2 + hstep, voffB);
            PG8_WAIT_V(6); PG8_BAR; PG8_MMA(1, 1, At, B1); PG8_BAR;
            PG8_LDB(B0, 1, 0); PG8_SCHED; PG8_LDA(At, 1, 0); PG8_STAGE(PG8_SA(0, 1), a2 + hstep, voffA);
            PG8_WAIT_L(8); PG8_BAR; PG8_WAIT_L(0); PG8_MMA(0, 0, At, B0); PG8_BAR; PG8_SCHED;
            PG8_LDB(B1, 1, 1); PG8_STAGE(PG8_SB(1, 0), b3, voffB);
            PG8_BAR; PG8_WAIT_L(0); PG8_MMA(0, 1, At, B1); PG8_BAR;
            PG8_LDA(At, 1, 1); PG8_STAGE(PG8_SA(1, 0), a3, voffA);
            PG8_BAR; PG8_WAIT_L(0); PG8_MMA(1, 0, At, B0); PG8_BAR; PG8_SCHED;
            PG8_STAGE(PG8_SB(1, 1), b3 + hstep, voffB);
            PG8_WAIT_V(6); PG8_BAR; PG8_MMA(1, 1, At, B1); PG8_BAR;
            }
        }
        if constexpr (ALIGN_EPI) { if (wr == 0) PG8_BAR; }
        if constexpr (!Epi::AFTER_DRAIN) { E(acc, cur, wr, wc, fr, fq); S.done(cur); }
        if (!has_next) break;
#pragma unroll
        for (int a = 0; a < 2; ++a)
#pragma unroll
            for (int b = 0; b < 2; ++b)
#pragma unroll
                for (int m = 0; m < 4; ++m)
#pragma unroll
                    for (int n = 0; n < 2; ++n) acc[a][b][m][n] = (f32x4){0.f, 0.f, 0.f, 0.f};
        cur = nxt; cA = nA; cB = nB; ++ui;
        if constexpr (ALIGN_EPI) { if (wr == 1) PG8_BAR; }
    }
    PG8_WAIT_V(0);
    if constexpr (!ALIGN_EPI) { if (wr == 0) PG8_BAR; }
    PG8_BAR;
    if constexpr (Epi::AFTER_DRAIN) { E.fused(acc, cur, wr, wc, fr, fq, lds, wid, lane); S.done(cur); }
#undef PG8_SA
#undef PG8_SB
#undef PG8_STAGE
#undef PG8_LDA
#undef PG8_LDB
#undef PG8_MMA
#undef PG8_WAIT_V
#undef PG8_WAIT_L
#undef PG8_BAR
#undef PG8_SCHED
}
}

typedef float f32x16 __attribute__((ext_vector_type(16)));
typedef short s16x4 __attribute__((ext_vector_type(4)));
typedef short v4i16_t __attribute__((ext_vector_type(4)));
typedef float f32x2_t __attribute__((ext_vector_type(2)));
typedef __bf16 bf16x2_t __attribute__((ext_vector_type(2)));
#define LAS __attribute__((address_space(3)))
constexpr int VROW = 144, VBUF = 32 * VROW;
constexpr int VROWV = 192, VBUFV = 32 * VROWV;
constexpr float L2E = 1.4426950408889634f, LN2 = 0.6931471805599453f;
constexpr float SC2 = 0.125f * L2E;

__device__ __forceinline__ int crow(int r, int hi) { return (r & 3) + 8 * (r >> 2) + 4 * hi; }
__device__ __forceinline__ unsigned cvtpk(float lo, float hi) { f32x2_t v = {lo, hi}; bf16x2_t b = __builtin_convertvector(v, bf16x2_t); return __builtin_bit_cast(unsigned, b); }
__device__ __forceinline__ float xhalf(float v, int hi) {
    auto r = __builtin_amdgcn_permlane32_swap(__float_as_uint(v), __float_as_uint(v), false, false);
    return __uint_as_float(hi ? r[0] : r[1]);
}
__device__ __forceinline__ s16x4 vtr(const LAS unsigned char* p) { return __builtin_bit_cast(s16x4, __builtin_amdgcn_ds_read_tr16_b64_v4i16((LAS v4i16_t*)p)); }

struct KVRegs { u32x4 k[4]; u32x4 v[4]; };
__device__ __forceinline__ void load_kv(KVRegs& R, const bf16* base, int kp0, int kst, int kcol, int vcol, int lane) {
#pragma unroll
    for (int j = 0; j < 4; ++j) {
        const int pos = kp0 + kst * (8 * j + (lane >> 3));
        const int pc = pos < SQ - 1 ? pos : SQ - 1;
        const bf16* rp = base + (size_t)pc * QKV_LD + (lane & 7) * 8;
        R.k[j] = *(const u32x4*)(rp + kcol); R.v[j] = *(const u32x4*)(rp + vcol);
    }
}
__device__ __forceinline__ void kv_stage(const KVRegs& R, LAS unsigned char* klds, LAS unsigned char* vlds, int lane) {
#pragma unroll
    for (int j = 0; j < 4; ++j) { const int r_ = 8 * j + (lane >> 3), c_ = (lane & 7) * 16; *(LAS u32x4*)(klds + r_ * VROW + c_) = R.k[j]; *(LAS u32x4*)(vlds + r_ * VROWV + c_) = R.v[j]; }
}
__device__ __forceinline__ f32x16 qk_tile(const LAS unsigned char* klds, const bf16x8 (&qf)[4], int r32, int hi) {
    f32x16 s = {0.f, 0.f, 0.f, 0.f, 0.f, 0.f, 0.f, 0.f, 0.f, 0.f, 0.f, 0.f, 0.f, 0.f, 0.f, 0.f};
#pragma unroll
    for (int k = 0; k < 4; ++k) { const bf16x8 kf = *(const LAS bf16x8*)(klds + r32 * VROW + (2 * k + hi) * 16); s = __builtin_amdgcn_mfma_f32_32x32x16_bf16(kf, qf[k], s, 0, 0, 0); }
    return s;
}
__device__ __forceinline__ void pv_tile(f32x16 (&o)[2], const f32x16& p, const LAS unsigned char* vlds, int lane) {
    const int g = lane >> 4, i = lane & 15, h = lane >> 5;
    const LAS unsigned char* vb = vlds + (4 * h + (i >> 2)) * VROWV + (16 * (g & 1) + 4 * (i & 3)) * 2;
#pragma unroll
    for (int s = 0; s < 2; ++s) {
        u32x4 pw; pw.x = cvtpk(p[8 * s], p[8 * s + 1]); pw.y = cvtpk(p[8 * s + 2], p[8 * s + 3]); pw.z = cvtpk(p[8 * s + 4], p[8 * s + 5]); pw.w = cvtpk(p[8 * s + 6], p[8 * s + 7]);
        const bf16x8 pb = __builtin_bit_cast(bf16x8, pw);
#pragma unroll
        for (int df = 0; df < 2; ++df) {
            const s16x4 lo = vtr(vb + (16 * s) * VROWV + df * 64), hh = vtr(vb + (16 * s + 8) * VROWV + df * 64);
            const bf16x8 va = (bf16x8){lo[0], lo[1], lo[2], lo[3], hh[0], hh[1], hh[2], hh[3]};
            o[df] = __builtin_amdgcn_mfma_f32_32x32x16_bf16(va, pb, o[df], 0, 0, 0);
        }
    }
}
__device__ __forceinline__ void load_q(bf16x8 (&qf)[4], const bf16* base, int qpos, int qcol, int hi) {
    const bf16* rp = base + (size_t)qpos * QKV_LD + qcol + 8 * hi;
#pragma unroll
    for (int k = 0; k < 4; ++k) qf[k] = *(const bf16x8*)(rp + 16 * k);
}
__device__ __forceinline__ void store_o(bf16* yrow, const f32x16 (&o)[2], float inv, int hi) {
#pragma unroll
    for (int df = 0; df < 2; ++df)
#pragma unroll
        for (int g = 0; g < 4; ++g) {
            u32x2 w; w.x = cvtpk(o[df][4 * g] * inv, o[df][4 * g + 1] * inv); w.y = cvtpk(o[df][4 * g + 2] * inv, o[df][4 * g + 3] * inv);
            *(u32x2*)(yrow + 32 * df + 8 * g + 4 * hi) = w;
        }
}
__device__ __forceinline__ void osm_tile(f32x16& s, float& m, float& l, f32x16 (&o)[2]) {
    float mx = s[0];
#pragma unroll
    for (int r = 1; r < 16; ++r) mx = fmaxf(mx, s[r]);
    { auto rr = __builtin_amdgcn_permlane32_swap(__float_as_uint(mx), __float_as_uint(mx), false, false); mx = fmaxf(__uint_as_float(rr[0]), __uint_as_float(rr[1])); }
    const float mn = fmaxf(m, mx);
    const float ms = (mn == -INFINITY) ? 0.f : mn;
    const float alpha = __builtin_amdgcn_exp2f((m - ms) * SC2);
    const float mc = ms * SC2;
    float ps = 0.f;
#pragma unroll
    for (int r = 0; r < 16; ++r) { s[r] = __builtin_amdgcn_exp2f(s[r] * SC2 - mc); ps += s[r]; }
    l = l * alpha + ps; m = mn;
    if (!__all(alpha == 1.0f)) {
#pragma unroll
        for (int df = 0; df < 2; ++df)
#pragma unroll
            for (int r = 0; r < 16; ++r) o[df][r] *= alpha;
    }
}
__device__ __forceinline__ void osm_tile2(f32x16& s0, f32x16& s1, float& m, float& l, f32x16 (&o)[2]) {
    float mx = fmaxf(s0[0], s1[0]);
#pragma unroll
    for (int r = 1; r < 16; ++r) mx = fmaxf(mx, fmaxf(s0[r], s1[r]));
    { auto rr = __builtin_amdgcn_permlane32_swap(__float_as_uint(mx), __float_as_uint(mx), false, false); mx = fmaxf(__uint_as_float(rr[0]), __uint_as_float(rr[1])); }
    const float mn = fmaxf(m, mx);
    const float ms = (mn == -INFINITY) ? 0.f : mn;
    const float alpha = __builtin_amdgcn_exp2f((m - ms) * SC2);
    const float mc = ms * SC2;
    float ps0 = 0.f, ps1 = 0.f;
#pragma unroll
    for (int r = 0; r < 16; ++r) { s0[r] = __builtin_amdgcn_exp2f(s0[r] * SC2 - mc); ps0 += s0[r]; s1[r] = __builtin_amdgcn_exp2f(s1[r] * SC2 - mc); ps1 += s1[r]; }
    l = l * alpha + (ps0 + ps1); m = mn;
    if (!__all(alpha == 1.0f)) {
#pragma unroll
        for (int df = 0; df < 2; ++df)
#pragma unroll
            for (int r = 0; r < 16; ++r) o[df][r] *= alpha;
    }
}
#define ZERO16 {0.f, 0.f, 0.f, 0.f, 0.f, 0.f, 0.f, 0.f, 0.f, 0.f, 0.f, 0.f, 0.f, 0.f, 0.f, 0.f}

struct AttnCtx {
    const bf16* base; int kcol, vcol, r32, hi, lane; LAS unsigned char* vlds; LAS unsigned char* klds; bf16x8 qf[4]; f32x16 o[2];
};
#define ATTN_STEP(SC, SL, T) { \
        if (SYNC) __builtin_amdgcn_s_barrier(); \
        { int kp_, ks_; const int tl_ = (T) + 2 < nt ? (T) + 2 : nt - 1; mx.pos(tl_, kp_, ks_); load_kv(SL, c.base, kp_, ks_, c.kcol, c.vcol, c.lane); } \
        kv_stage(SC, c.klds, c.vlds, c.lane); f32x16 s_ = qk_tile(c.klds, c.qf, c.r32, c.hi); \
        const bool stop_ = mx.process((T), s_, c); pv_tile(c.o, s_, c.vlds, c.lane); \
        if ((!SYNC && stop_) || (T) + 1 >= nt) break; }
template <class M, bool SYNC> __device__ __forceinline__ void attn_run(M& mx, AttnCtx& c) {
    const int nt = mx.nt;
    KVRegs S0, S1, S2;
    { int kp, ks; mx.pos(0, kp, ks); load_kv(S0, c.base, kp, ks, c.kcol, c.vcol, c.lane);
      mx.pos(1 < nt ? 1 : nt - 1, kp, ks); load_kv(S1, c.base, kp, ks, c.kcol, c.vcol, c.lane); }
    for (int t = 0;; t += 3) {
        ATTN_STEP(S0, S2, t)
        ATTN_STEP(S1, S0, t + 1)
        ATTN_STEP(S2, S1, t + 2)
    }
}
#define SH_BAR() asm volatile("s_waitcnt lgkmcnt(0)\n\ts_barrier" ::: "memory")
constexpr int SLOT_K = 64 * VROW, SLOT_BYTES = 64 * VROW + 64 * VROWV;
struct ShRegs { u32x4 a, b; };
__device__ __forceinline__ void sh_load(ShRegs& R, const bf16* base, int kp0, int kcol, int vcol, int w, int lane) {
    const int pos = kp0 + 4 * w + ((lane & 31) >> 3);
    const int pa = pos < SQ - 1 ? pos : SQ - 1, pb = pos + 32 < SQ - 1 ? pos + 32 : SQ - 1;
    const int col = ((lane >> 5) ? vcol : kcol) + (lane & 7) * 8;
    R.a = *(const u32x4*)(base + (size_t)pa * QKV_LD + col); R.b = *(const u32x4*)(base + (size_t)pb * QKV_LD + col);
}
__device__ __forceinline__ void sh_write(LAS unsigned char* slot, const ShRegs& R, int w, int lane) {
    const int row = 4 * w + ((lane & 31) >> 3);
    LAS unsigned char* p = slot + ((lane >> 5) ? SLOT_K + row * VROWV : row * VROW) + (lane & 7) * 16;
    *(LAS u32x4*)p = R.a; *(LAS u32x4*)(p + 32 * ((lane >> 5) ? VROWV : VROW)) = R.b;
}
#define SH_STEP(RW, RL, T) { \
        SH_BAR(); \
        { const int tl_ = (T) + 2 < nt ? (T) + 2 : nt - 1; sh_load(RL, c.base, mx.pos2(tl_), c.kcol, c.vcol, w, c.lane); } \
        sh_write(slots + (((T) + 1) & 1) * SLOT_BYTES, RW, w, c.lane); \
        if (mx.active2((T), w)) { LAS unsigned char* sl_ = slots + ((T) & 1) * SLOT_BYTES; \
            f32x16 s0_ = qk_tile(sl_, c.qf, c.r32, c.hi), s1_ = qk_tile(sl_ + 32 * VROW, c.qf, c.r32, c.hi); mx.process2((T), s0_, s1_, c); \
            pv_tile(c.o, s0_, sl_ + SLOT_K, c.lane); pv_tile(c.o, s1_, sl_ + SLOT_K + 32 * VROWV, c.lane); } \
        if ((T) + 1 >= nt) break; }
template <class M> __device__ __forceinline__ void attn_run_shared(M& mx, AttnCtx& c, LAS unsigned char* slots, int w) {
    const int nt = mx.nt2;
    ShRegs R0, R1, R2;
    sh_load(R0, c.base, mx.pos2(0), c.kcol, c.vcol, w, c.lane);
    sh_load(R1, c.base, mx.pos2(1 < nt ? 1 : nt - 1), c.kcol, c.vcol, w, c.lane);
    SH_BAR();
    sh_write(slots, R0, w, c.lane);
    for (int t = 0;; t += 3) {
        SH_STEP(R1, R2, t)
        SH_STEP(R2, R0, t + 1)
        SH_STEP(R0, R1, t + 2)
    }
}
struct MixA {
    int nt, k00, qpos; float m, l;
    __device__ __forceinline__ void pos(int idx, int& kp0, int& kst) const { kp0 = k00 + 32 * idx; kst = 1; }
    __device__ __forceinline__ bool process(int idx, f32x16& s, AttnCtx& c) {
        const int k0 = k00 + 32 * idx;
#pragma unroll
        for (int r = 0; r < 16; ++r) { const int dist = qpos - (k0 + crow(r, c.hi)); if (dist < 0 || dist > 127) s[r] = -INFINITY; }
        osm_tile(s, m, l, c.o); return false;
    }
};
__device__ void attn_A(const bf16* base, int hq, int q0, float sink, bf16* ybase, LAS unsigned char* vlds, int lane) {
    AttnCtx c; c.base = base; c.r32 = lane & 31; c.hi = lane >> 5; c.lane = lane; c.vlds = vlds; c.klds = vlds + VBUFV; c.kcol = 512 + (hq >> 2) * 64; c.vcol = 640 + (hq >> 2) * 64;
    c.o[0] = (f32x16)ZERO16; c.o[1] = (f32x16)ZERO16;
    MixA mx; mx.qpos = q0 + c.r32; mx.k00 = q0 - 128 > 0 ? q0 - 128 : 0; mx.nt = 5; mx.m = -INFINITY; mx.l = 0.f;
    load_q(c.qf, base, mx.qpos, hq * 64, c.hi);
    attn_run<MixA, true>(mx, c);
    float l = mx.l + xhalf(mx.l, c.hi);
    l += __builtin_amdgcn_exp2f(sink * L2E - mx.m * SC2);
    store_o(ybase + (size_t)mx.qpos * DM + hq * 64, c.o, 1.0f / l, c.hi);
}
struct MixB {
    int nt, q0, qpos; float carry;
    __device__ __forceinline__ void pos(int idx, int& kp0, int& kst) const { kp0 = q0 - 32 * idx; kst = 1; }
    __device__ __forceinline__ bool process(int idx, f32x16& s, AttnCtx& c) {
        const int k0 = q0 - 32 * idx, hi = c.hi;
        float lk[16], G[4], Gp[4];
#pragma unroll
        for (int r = 0; r < 16; ++r) {
            const float z = s[r] * 0.125f;
            const bool valid = (k0 + crow(r, hi)) < qpos;
            const float sp = fmaxf(z, 0.f) + LN2 * __builtin_amdgcn_logf(1.0f + __builtin_amdgcn_exp2f(-fabsf(z) * L2E));
            lk[r] = valid ? -sp : 0.f;
            s[r] = valid ? (z - sp) : -INFINITY;
        }
#pragma unroll
        for (int g = 0; g < 4; ++g) { G[g] = (lk[4 * g] + lk[4 * g + 1]) + (lk[4 * g + 2] + lk[4 * g + 3]); Gp[g] = xhalf(G[g], hi); }
        float above = carry;
#pragma unroll
        for (int g = 3; g >= 0; --g) {
            float off = above + (hi == 0 ? Gp[g] : 0.f);
            s[4 * g + 3] = __builtin_amdgcn_exp2f((s[4 * g + 3] + off) * L2E); off += lk[4 * g + 3];
            s[4 * g + 2] = __builtin_amdgcn_exp2f((s[4 * g + 2] + off) * L2E); off += lk[4 * g + 2];
            s[4 * g + 1] = __builtin_amdgcn_exp2f((s[4 * g + 1] + off) * L2E); off += lk[4 * g + 1];
            s[4 * g + 0] = __builtin_amdgcn_exp2f((s[4 * g + 0] + off) * L2E);
            above += G[g] + Gp[g];
        }
        carry = above;
        return __all(carry < -40.0f) != 0;
    }
};
__device__ void attn_B(const bf16* base, int h, int q0, bf16* ybase, LAS unsigned char* vlds, int lane) {
    AttnCtx c; c.base = base; c.r32 = lane & 31; c.hi = lane >> 5; c.lane = lane; c.vlds = vlds; c.klds = vlds + VBUFV; c.kcol = 1280 + h * 64; c.vcol = 1792 + h * 64;
    c.o[0] = (f32x16)ZERO16; c.o[1] = (f32x16)ZERO16;
    MixB mx; mx.q0 = q0; mx.qpos = q0 + c.r32; mx.nt = q0 / 32 + 1; mx.carry = 0.f;
    load_q(c.qf, base, mx.qpos, 768 + h * 64, c.hi);
    attn_run<MixB, false>(mx, c);
    store_o(ybase + (size_t)mx.qpos * DM + 512 + h * 64, c.o, 1.0f, c.hi);
}
struct MixCp {
    int nt, n0, r0, j1lo, qpos; float m, l;
    __device__ __forceinline__ void pos(int t, int& kp0, int& kst) const {
        if (t < n0) { kp0 = r0 + 512 * t; kst = 16; } else { kp0 = (r0 & 3) + 4 * (j1lo + 32 * (t - n0)); kst = 4; }
    }
    __device__ __forceinline__ bool process(int t, f32x16& s, AttnCtx& c) {
        int kp0, kst; pos(t, kp0, kst);
        const int win = t < n0 ? 2048 : 512;
#pragma unroll
        for (int r = 0; r < 16; ++r) { const int dist = qpos - (kp0 + kst * crow(r, c.hi)); if (dist < 0 || dist > win) s[r] = -INFINITY; }
        osm_tile(s, m, l, c.o); return false;
    }
};
struct MixC1 {
    int nt2, p0, qpos; float m, l;
    __device__ __forceinline__ int pos2(int T) const { return p0 + 64 * T; }
    __device__ __forceinline__ bool active2(int T, int w) const { return true; }
    __device__ __forceinline__ void process2(int T, f32x16& s0, f32x16& s1, AttnCtx& c) {
        const int k0 = p0 + 64 * T;
#pragma unroll
        for (int r = 0; r < 16; ++r) { const int dist = qpos - (k0 + crow(r, c.hi)); if (dist < 0 || dist > 128) s0[r] = -INFINITY; if (dist < 32 || dist > 160) s1[r] = -INFINITY; }
        osm_tile2(s0, s1, m, l, c.o);
    }
};
__device__ void attn_C(const bf16* base, int h, int r0, int g, bf16* ybase, LAS unsigned char* vlds, LAS unsigned char* xlds, int w, int lane) {
    AttnCtx c; c.base = base; c.r32 = lane & 31; c.hi = lane >> 5; c.lane = lane; c.vlds = vlds; c.klds = vlds + VBUFV; c.kcol = 512 + h * 64; c.vcol = 1024 + h * 64;
    c.o[0] = (f32x16)ZERO16; c.o[1] = (f32x16)ZERO16;
    const int qpos = r0 + 16 * (32 * g + c.r32);
    load_q(c.qf, base, qpos, h * 64, c.hi);
    MixCp mp; mp.r0 = r0; mp.qpos = qpos; mp.m = -INFINITY; mp.l = 0.f;
    mp.n0 = g + 1;
    mp.j1lo = (r0 >> 2) + 128 * g - 128 > 0 ? (r0 >> 2) + 128 * g - 128 : 0;
    mp.nt = mp.n0 + ((r0 >> 2) + 128 * g + 124 - mp.j1lo) / 32 + 1;
    attn_run<MixCp, true>(mp, c);
    MixC1 m1; m1.qpos = qpos; m1.m = mp.m; m1.l = mp.l;
    const int ra = r0 & 8;
    m1.p0 = 512 * g + ra - 128 > 0 ? 512 * g + ra - 128 : 0;
    m1.nt2 = ((512 * g + ra + 7 + 496 - m1.p0) / 32 + 2) / 2;
    attn_run_shared<MixC1>(m1, c, xlds + 64, w);
    const float l = m1.l + xhalf(m1.l, c.hi);
    store_o(ybase + (size_t)qpos * DM + h * 64, c.o, 1.0f / l, c.hi);
}
struct MixD {
    int nt, nt2, npast, own, q0, qpos; unsigned U, sel; float m, l;
    __device__ __forceinline__ int blk_of(int j) const {
        unsigned u = U; int b = 0;
#pragma unroll
        for (int i = 0; i < 7; ++i) { if (i < j) u &= u - 1u; }
        b = __builtin_ctz(u | 0x100u); return b;
    }
    __device__ __forceinline__ void pos(int t, int& kp0, int& kst) const {
        kst = 1;
        if (t < 8 * npast) kp0 = blk_of(t >> 3) * 256 + (t & 7) * 32; else kp0 = own * 256 + (t - 8 * npast) * 32;
    }
    __device__ __forceinline__ int pos2(int T) const { int kp, ks; pos(2 * T, kp, ks); return kp; }
    __device__ __forceinline__ bool active2(int T, int w) const { return T < 4 * npast || 2 * (T - 4 * npast) <= w; }
    __device__ __forceinline__ void process2(int T, f32x16& s0, f32x16& s1, AttnCtx& c) {
        if (T < 4 * npast) {
            const int blk = blk_of(T >> 2);
            if (!((sel >> blk) & 1u)) {
#pragma unroll
                for (int r = 0; r < 16; ++r) { s0[r] = -INFINITY; s1[r] = -INFINITY; }
            }
        } else {
            const int k0 = own * 256 + (T - 4 * npast) * 64;
#pragma unroll
            for (int r = 0; r < 16; ++r) { const int kk = k0 + crow(r, c.hi); if (kk > qpos) s0[r] = -INFINITY; if (kk + 32 > qpos) s1[r] = -INFINITY; }
        }
        osm_tile2(s0, s1, m, l, c.o);
    }
};
__device__ void attn_D(const bf16* base, const float* kmean  , int h, int q0, bf16* ybase, LAS unsigned char* vlds, LAS unsigned char* xlds, int lane) {
    AttnCtx c; c.base = base; c.r32 = lane & 31; c.hi = lane >> 5; c.lane = lane; c.vlds = vlds; c.klds = vlds + VBUFV; c.kcol = 2048 + h * 64; c.vcol = 2560 + h * 64;
    c.o[0] = (f32x16)ZERO16; c.o[1] = (f32x16)ZERO16;
    const int r32 = c.r32, hi = c.hi, own = q0 >> 8;
    MixD mx; mx.own = own; mx.q0 = q0; mx.qpos = q0 + r32; mx.m = -INFINITY; mx.l = 0.f;
    load_q(c.qf, base, mx.qpos, 1536 + h * 64, hi);
    unsigned sel = 0u;
    if (own > 0) {
        bf16x8 kf[4];
#pragma unroll
        for (int k = 0; k < 4; ++k) {
            u32x4 w = {0u, 0u, 0u, 0u};
            if (r32 < 8) { const float* kp = kmean + r32 * 64 + 16 * k + 8 * hi; const f32x4 a = *(const f32x4*)kp, b = *(const f32x4*)(kp + 4);
                w.x = cvtpk(a[0], a[1]); w.y = cvtpk(a[2], a[3]); w.z = cvtpk(b[0], b[1]); w.w = cvtpk(b[2], b[3]); }
            kf[k] = __builtin_bit_cast(bf16x8, w);
        }
        f32x16 gs = ZERO16;
#pragma unroll
        for (int k = 0; k < 4; ++k) gs = __builtin_amdgcn_mfma_f32_32x32x16_bf16(kf[k], c.qf[k], gs, 0, 0, 0);
        float gt[8];
#pragma unroll
        for (int r = 0; r < 4; ++r) { const float mine = gs[r], oth = xhalf(mine, hi); gt[r] = hi == 0 ? mine : oth; gt[4 + r] = hi == 0 ? oth : mine; }
        const int nsel = own < 3 ? own : 3;
        for (int rr = 0; rr < nsel; ++rr) {
            float best = -INFINITY; int bi = -1;
#pragma unroll
            for (int n = 0; n < 8; ++n) { const bool ok = n < own && !((sel >> n) & 1u) && (bi < 0 || gt[n] > best); if (ok) { best = gt[n]; bi = n; } }
            if (bi >= 0) sel |= 1u << bi;
        }
    }
    unsigned U = 0u;
#pragma unroll
    for (int n = 0; n < 8; ++n) if (__ballot((sel >> n) & 1u) != 0ull) U |= 1u << n;
    {
        volatile LAS unsigned* ux = (volatile LAS unsigned*)xlds;
        __builtin_amdgcn_s_barrier();
        if (lane == 0) ux[(q0 >> 5) & 7] = U;
        asm volatile("s_waitcnt lgkmcnt(0)" ::: "memory");
        __builtin_amdgcn_s_barrier();
        U = ux[0] | ux[1] | ux[2] | ux[3] | ux[4] | ux[5] | ux[6] | ux[7];
        U = __builtin_amdgcn_readfirstlane(U);
    }
    mx.U = U; mx.sel = sel; mx.npast = __builtin_popcount(U); mx.nt = 8 * mx.npast + 8; mx.nt2 = 4 * mx.npast + 4;
    attn_run_shared<MixD>(mx, c, xlds + 64, (q0 >> 5) & 7);
    const float l = mx.l + xhalf(mx.l, c.hi);
    store_o(ybase + (size_t)mx.qpos * DM + 512 + h * 64, c.o, 1.0f / l, hi);
}

__device__ void ph_attn0(const bf16* qkv, const float* sinks, bf16* y, LAS unsigned char* lds, int bid, int nb) {
    const int lane = ltid() & 63, w = __builtin_amdgcn_readfirstlane(ltid() >> 6);
    LAS unsigned char* vlds = lds + w * (VBUF + VBUFV);
    for (int pid = bid; pid < NB * 8; pid += nb) {
        const int b = pid >> 3, h = pid & 7;
        const bf16* base = qkv + (size_t)b * SQ * QKV_LD; bf16* ybase = y + (size_t)b * SQ * DM;
        const float sink = sinks[h];
        for (int rd = 0; rd < 8; ++rd) attn_A(base, h, (rd * 8 + w) * 32, sink, ybase, vlds, lane);
        for (int rd = 0; rd < 8; ++rd) attn_B(base, h, (rd * 8 + w) * 32, ybase, vlds, lane);
    }
}
__device__ void ph_attn1(const bf16* qkv, const float* kmean, bf16* y, LAS unsigned char* lds, int bid, int nb) {
    const int lane = ltid() & 63, w = __builtin_amdgcn_readfirstlane(ltid() >> 6);
    LAS unsigned char* vlds = lds + w * (VBUF + VBUFV);
    for (int pid = bid; pid < NB * 8; pid += nb) {
        const int b = pid >> 3, h = pid & 7;
        const bf16* base = qkv + (size_t)b * SQ * QKV_LD; bf16* ybase = y + (size_t)b * SQ * DM;
        for (int rd = 0; rd < 8; ++rd) { const int it = rd * 8 + w; attn_C(base, h, it & 15, it >> 4, ybase, vlds, lds + 8 * (VBUF + VBUFV), w, lane); }
        for (int rd = 0; rd < 8; ++rd) attn_D(base, kmean + (size_t)pid * 8 * 64, h, (rd * 8 + w) * 32, ybase, vlds, lds + 8 * (VBUF + VBUFV), lane);
    }
}

#define CE_D(a, b) { const float hi_ = fmaxf((a), (b)), lo_ = fminf((a), (b)); (a) = hi_; (b) = lo_; }
#define BSTAGE(arr, k, j) _Pragma("unroll") for (int i_ = 0; i_ < 16; ++i_) { const int l_ = i_ ^ (j); if (l_ > i_) { if ((i_ & (k)) == 0) CE_D(arr[i_], arr[l_]) else CE_D(arr[l_], arr[i_]) } }
__device__ __forceinline__ void bsort16(float (&a)[16]) {
    BSTAGE(a, 2, 1) BSTAGE(a, 4, 2) BSTAGE(a, 4, 1) BSTAGE(a, 8, 4) BSTAGE(a, 8, 2) BSTAGE(a, 8, 1) BSTAGE(a, 16, 8) BSTAGE(a, 16, 4) BSTAGE(a, 16, 2) BSTAGE(a, 16, 1)
}
__device__ __forceinline__ void bmerge16(float (&a)[16]) {
    BSTAGE(a, 16, 8) BSTAGE(a, 16, 4) BSTAGE(a, 16, 2) BSTAGE(a, 16, 1)
}
__device__ __forceinline__ void merge_top16(float (&a)[16], const float (&b)[16]) {
#pragma unroll
    for (int i = 0; i < 16; ++i) a[i] = fmaxf(a[i], b[15 - i]);
    bmerge16(a);
}
__device__ __forceinline__ void xmerge16(float (&a)[16]) {
    {
        float A[16], B[16];
#pragma unroll
        for (int i = 0; i < 16; ++i) { auto r = __builtin_amdgcn_permlane16_swap(__float_as_uint(a[i]), __float_as_uint(a[i]), false, false); A[i] = __uint_as_float(r[0]); B[i] = __uint_as_float(r[1]); }
#pragma unroll
        for (int i = 0; i < 16; ++i) a[i] = fmaxf(A[i], B[15 - i]);
        bmerge16(a);
    }
    {
        float A[16], B[16];
#pragma unroll
        for (int i = 0; i < 16; ++i) { auto r = __builtin_amdgcn_permlane32_swap(__float_as_uint(a[i]), __float_as_uint(a[i]), false, false); A[i] = __uint_as_float(r[0]); B[i] = __uint_as_float(r[1]); }
#pragma unroll
        for (int i = 0; i < 16; ++i) a[i] = fmaxf(A[i], B[15 - i]);
        bmerge16(a);
    }
}
__host__ __device__ constexpr int pair_i(int id) {
    int c = 0;
    for (int i = 0; i < 16; ++i) { const int nj = 16 / (i + 1); if (id < c + nj) return i; c += nj; }
    return 0;
}
__host__ __device__ constexpr int pair_j(int id) {
    int c = 0;
    for (int i = 0; i < 16; ++i) { const int nj = 16 / (i + 1); if (id < c + nj) return id - c; c += nj; }
    return 0;
}
constexpr int SK_ROW = 272;
constexpr int SEL_SK_BYTES = 2 * 128 * SK_ROW;
constexpr int SEL_TAB_OFF = SEL_SK_BYTES;
constexpr int SEL_IDX_OFF = SEL_SK_BYTES + 64;

template <int S> __device__ __forceinline__ float cand_slot(const float (&L1)[16], const float (&L2)[16], int g) {
    constexpr int p0 = S, p1 = 16 + S, p2 = 32 + S, p3 = 48 + S;
    const float c0 = L1[pair_i(p0)] + L2[pair_j(p0)], c1 = L1[pair_i(p1)] + L2[pair_j(p1)], c2 = L1[pair_i(p2)] + L2[pair_j(p2)];
    const float c3 = p3 < 50 ? L1[pair_i(p3 < 50 ? p3 : 0)] + L2[pair_j(p3 < 50 ? p3 : 0)] : -1.0e30f;
    const float c = g == 0 ? c0 : (g == 1 ? c1 : (g == 2 ? c2 : c3));
    return __uint_as_float((__float_as_uint(c) & 0xffffffc0u) | (unsigned)(16 * g + S));
}

__device__ void ph_peer_select(const bf16* qry, const float* subkeys  , int* eidx, float* egate, LAS unsigned char* lds, int bid, int nb) {
    const int tid = ltid(), lane = tid & 63, w = __builtin_amdgcn_readfirstlane(tid >> 6);
    const int tk = lane & 15, g = lane >> 4;
    __syncthreads();
    for (int e = tid; e < 2 * 128 * 128 / 2; e += NT) {
        const int row = e >> 6, c2 = (e & 63) * 2;
        const float a = subkeys[(size_t)row * 128 + c2], b = subkeys[(size_t)row * 128 + c2 + 1];
        *(LAS unsigned*)(lds + row * SK_ROW + c2 * 2) = pk2(a, b);
    }
    if (tid < 64) { int id = tid; int c = 0, pi = 0, pj = 0;
        for (int i = 0; i < 16; ++i) { const int nj = 16 / (i + 1); if (id >= c && id < c + nj) { pi = i; pj = id - c; } c += nj; }
        lds[SEL_TAB_OFF + tid] = (unsigned char)((pi << 4) | pj); }
    __syncthreads();
    LAS unsigned* widx = (LAS unsigned*)(lds + SEL_IDX_OFF + w * 512);
    const LAS unsigned char* widx8 = (const LAS unsigned char*)widx;
    const int nitems = (MT / 16) * 8;
    bf16x8 qc[2][4];
    { const int it = bid * 8 + w;
      if (it < nitems) { const bf16* qp = qry + (size_t)((it >> 3) * 16 + tk) * PQ + (it & 7) * 256 + 8 * g;
#pragma unroll
          for (int hf = 0; hf < 2; ++hf)
#pragma unroll
              for (int ks = 0; ks < 4; ++ks) qc[hf][ks] = *(const bf16x8*)(qp + hf * 128 + 32 * ks); } }
    for (int it = bid * 8 + w; it < nitems; it += nb * 8) {
        const int h = it & 7, t0 = (it >> 3) * 16;
        bf16x8 qn[2][4];
        { const int itn = it + nb * 8 < nitems ? it + nb * 8 : it;
          const bf16* qp = qry + (size_t)((itn >> 3) * 16 + tk) * PQ + (itn & 7) * 256 + 8 * g;
#pragma unroll
          for (int hf = 0; hf < 2; ++hf)
#pragma unroll
              for (int ks = 0; ks < 4; ++ks) qn[hf][ks] = *(const bf16x8*)(qp + hf * 128 + 32 * ks); }
        float L[2][16];
#pragma unroll
        for (int hf = 0; hf < 2; ++hf) {
            bf16x8 qf[4];
#pragma unroll
            for (int ks = 0; ks < 4; ++ks) qf[ks] = qc[hf][ks];
            float key[32];
#pragma unroll
            for (int tile = 0; tile < 8; ++tile) {
                f32x4 acc = {0.f, 0.f, 0.f, 0.f};
#pragma unroll
                for (int ks = 0; ks < 4; ++ks) {
                    const bf16x8 af = *(const LAS bf16x8*)(lds + (hf * 128 + tile * 16 + tk) * SK_ROW + (32 * ks + 8 * g) * 2);
                    acc = __builtin_amdgcn_mfma_f32_16x16x32_bf16(af, qf[ks], acc, 0, 0, 0);
                }
#pragma unroll
                for (int r = 0; r < 4; ++r) key[tile * 4 + r] = __uint_as_float((__float_as_uint(acc[r]) & 0xffffff80u) | (unsigned)(16 * tile + 4 * g + r));
            }
            float a[16], b[16];
#pragma unroll
            for (int i = 0; i < 16; ++i) { a[i] = key[i]; b[i] = key[16 + i]; }
            bsort16(a); bsort16(b);
            merge_top16(a, b);
            xmerge16(a);
#pragma unroll
            for (int i = 0; i < 16; ++i) L[hf][i] = a[i];
            unsigned pk = 0u;
#pragma unroll
            for (int s = 0; s < 4; ++s) {
                const float v = g == 0 ? a[s] : (g == 1 ? a[4 + s] : (g == 2 ? a[8 + s] : a[12 + s]));
                pk |= (__float_as_uint(v) & 127u) << (8 * s);
            }
            widx[tk * 8 + hf * 4 + g] = pk;
        }
        float c[16];
        c[0] = cand_slot<0>(L[0], L[1], g); c[1] = cand_slot<1>(L[0], L[1], g); c[2] = cand_slot<2>(L[0], L[1], g); c[3] = cand_slot<3>(L[0], L[1], g);
        c[4] = cand_slot<4>(L[0], L[1], g); c[5] = cand_slot<5>(L[0], L[1], g); c[6] = cand_slot<6>(L[0], L[1], g); c[7] = cand_slot<7>(L[0], L[1], g);
        c[8] = cand_slot<8>(L[0], L[1], g); c[9] = cand_slot<9>(L[0], L[1], g); c[10] = cand_slot<10>(L[0], L[1], g); c[11] = cand_slot<11>(L[0], L[1], g);
        c[12] = cand_slot<12>(L[0], L[1], g); c[13] = cand_slot<13>(L[0], L[1], g); c[14] = cand_slot<14>(L[0], L[1], g); c[15] = cand_slot<15>(L[0], L[1], g);
        bsort16(c);
        xmerge16(c);
        float sum = 0.f, ex[16];
#pragma unroll
        for (int i = 0; i < 16; ++i) { ex[i] = __builtin_amdgcn_exp2f((c[i] - c[0]) * L2E); sum += ex[i]; }
        const float inv = 1.0f / sum;
        int oi[4]; float og[4];
#pragma unroll
        for (int s = 0; s < 4; ++s) {
            const float kv = g == 0 ? c[s] : (g == 1 ? c[4 + s] : (g == 2 ? c[8 + s] : c[12 + s]));
            const float ev = g == 0 ? ex[s] : (g == 1 ? ex[4 + s] : (g == 2 ? ex[8 + s] : ex[12 + s]));
            const unsigned pid = __float_as_uint(kv) & 63u;
            const unsigned ij = lds[SEL_TAB_OFF + pid];
            const unsigned i1 = widx8[tk * 32 + (ij >> 4)], i2 = widx8[tk * 32 + 16 + (ij & 15u)];
            oi[s] = (int)(i1 * 128u + i2); og[s] = ev * inv;
        }
        const size_t ob = (size_t)(t0 + tk) * 128 + h * 16 + 4 * g;
        *(u32x4*)(eidx + ob) = (u32x4){(unsigned)oi[0], (unsigned)oi[1], (unsigned)oi[2], (unsigned)oi[3]};
        *(f32x4*)(egate + ob) = (f32x4){og[0], og[1], og[2], og[3]};
#pragma unroll
        for (int hf = 0; hf < 2; ++hf)
#pragma unroll
            for (int ks = 0; ks < 4; ++ks) qc[hf][ks] = qn[hf][ks];
    }
    __syncthreads();
}

typedef float v32f_t __attribute__((ext_vector_type(32)));
typedef unsigned v6u_t __attribute__((ext_vector_type(6)));
typedef unsigned v16u_t __attribute__((ext_vector_type(16)));
typedef __bf16 v32bf_t __attribute__((ext_vector_type(32)));
typedef __bf16 v2bf_t __attribute__((ext_vector_type(2)));
typedef _Float16 v32h_t __attribute__((ext_vector_type(32)));
typedef unsigned u32x3 __attribute__((ext_vector_type(3)));
constexpr int TROW = 768;
__device__ void ph_tab_fp6(const float* src, unsigned char* dst, float* scale, int nrows, int bid, int nb) {
    const int lane = ltid() & 63, w = __builtin_amdgcn_readfirstlane(ltid() >> 6);
    for (int rp = bid * 8 + w; rp < nrows / 2; rp += nb * 8) {
        v32h_t hv; float sc[2];
#pragma unroll
        for (int rr = 0; rr < 2; ++rr) {
            const float* sp = src + (size_t)(2 * rp + rr) * DM + lane * 16;
            f32x4 v[4]; float am = 0.f;
#pragma unroll
            for (int i = 0; i < 4; ++i) { v[i] = *(const f32x4*)(sp + i * 4); am = fmaxf(am, fmaxf(fmaxf(fabsf(v[i][0]), fabsf(v[i][1])), fmaxf(fabsf(v[i][2]), fabsf(v[i][3])))); }
            am = wave_max(am);
            const float s = am > 0.f ? am * (1.0f / 7.5f) : 1.0f, inv = 1.0f / s;
            sc[rr] = s;
#pragma unroll
            for (int i = 0; i < 4; ++i)
#pragma unroll
                for (int e = 0; e < 4; ++e) hv[rr * 16 + i * 4 + e] = (_Float16)fminf(fmaxf(v[i][e] * inv, -7.5f), 7.5f);
        }
        const v6u_t pk = __builtin_amdgcn_cvt_scalef32_pk32_fp6_f16(hv, 1.0f);
        unsigned* d0 = (unsigned*)(dst + (size_t)(2 * rp) * TROW + lane * 12);
        unsigned* d1 = (unsigned*)(dst + (size_t)(2 * rp + 1) * TROW + lane * 12);
        d0[0] = pk[0]; d0[1] = pk[1]; d0[2] = pk[2]; d1[0] = pk[3]; d1[1] = pk[4]; d1[2] = pk[5];
        if (lane == 0) { scale[2 * rp] = sc[0]; scale[2 * rp + 1] = sc[1]; }
    }
}

constexpr int TROW4 = 512;
__device__ void ph_tab_fp4(const float* src, unsigned char* dst, float* scale, int nrows, int bid, int nb) {
    const int lane = ltid() & 63, w = __builtin_amdgcn_readfirstlane(ltid() >> 6);
    for (int row = bid * 8 + w; row < nrows; row += nb * 8) {
        const float* sp = src + (size_t)row * DM + lane * 16;
        f32x4 v[4]; float am = 0.f;
#pragma unroll
        for (int i = 0; i < 4; ++i) { v[i] = *(const f32x4*)(sp + i * 4); am = fmaxf(am, fmaxf(fmaxf(fabsf(v[i][0]), fabsf(v[i][1])), fmaxf(fabsf(v[i][2]), fabsf(v[i][3])))); }
        am = wave_max(am);
        const float s = am > 0.f ? am * (1.0f / 6.0f) : 1.0f, inv = 1.0f / s;
        unsigned d0 = 0u, d1 = 0u;
        d0 = __builtin_amdgcn_cvt_scalef32_pk_fp4_f32(d0, v[0][0] * inv, v[0][1] * inv, 1.0f, 0); d0 = __builtin_amdgcn_cvt_scalef32_pk_fp4_f32(d0, v[0][2] * inv, v[0][3] * inv, 1.0f, 1);
        d0 = __builtin_amdgcn_cvt_scalef32_pk_fp4_f32(d0, v[1][0] * inv, v[1][1] * inv, 1.0f, 2); d0 = __builtin_amdgcn_cvt_scalef32_pk_fp4_f32(d0, v[1][2] * inv, v[1][3] * inv, 1.0f, 3);
        d1 = __builtin_amdgcn_cvt_scalef32_pk_fp4_f32(d1, v[2][0] * inv, v[2][1] * inv, 1.0f, 0); d1 = __builtin_amdgcn_cvt_scalef32_pk_fp4_f32(d1, v[2][2] * inv, v[2][3] * inv, 1.0f, 1);
        d1 = __builtin_amdgcn_cvt_scalef32_pk_fp4_f32(d1, v[3][0] * inv, v[3][1] * inv, 1.0f, 2); d1 = __builtin_amdgcn_cvt_scalef32_pk_fp4_f32(d1, v[3][2] * inv, v[3][3] * inv, 1.0f, 3);
        *(u32x2*)(dst + (size_t)row * TROW4 + lane * 8) = (u32x2){d0, d1};
        if (lane == 0) scale[row] = s;
    }
}

#define DPP_ADD(v, ctrl) ((v) + __builtin_bit_cast(float, __builtin_amdgcn_update_dpp(0, __builtin_bit_cast(int, (v)), (ctrl), 0xf, 0xf, true)))
typedef int i32x4_t __attribute__((ext_vector_type(4)));
constexpr int GT = 2;
typedef int v8i_t __attribute__((ext_vector_type(8)));
typedef int v2i_t __attribute__((ext_vector_type(2)));
struct GSet { u32x2 uq[4]; u32x2 vq[4]; };
__device__ __forceinline__ void gather_issue(GSet& S, int bt, int lane, const unsigned char* pu, const unsigned char* pv, const LAS int* etok) {
    const i32x4_t ev = *(const LAS i32x4_t*)(etok + bt * 4);
    const int es[4] = {__builtin_amdgcn_readfirstlane(ev.x), __builtin_amdgcn_readfirstlane(ev.y), __builtin_amdgcn_readfirstlane(ev.z), __builtin_amdgcn_readfirstlane(ev.w)};
#pragma unroll
    for (int k = 0; k < 2; ++k) {
        const unsigned f0 = (unsigned)es[2 * k] * (unsigned)TROW4 + (unsigned)lane * 8u, f1 = (unsigned)es[2 * k + 1] * (unsigned)TROW4 + (unsigned)lane * 8u;
        S.uq[2 * k] = *(const u32x2*)(pu + f0); S.uq[2 * k + 1] = *(const u32x2*)(pu + f1);
        S.vq[2 * k] = *(const u32x2*)(pv + f0); S.vq[2 * k + 1] = *(const u32x2*)(pv + f1);
    }
}
constexpr int GV_ROW = 520;
constexpr int GV_BYTES = 16 * GV_ROW, GC_BYTES = 96;
__device__ __forceinline__ float gather_udot(const GSet& S, const unsigned (&hp)[8], LAS unsigned char* vrow) {
    typedef _Float16 h2v_t __attribute__((ext_vector_type(2)));
    float d[4];
#pragma unroll
    for (int k = 0; k < 4; ++k) {
        const unsigned q0 = S.uq[k].x, q1 = S.uq[k].y;
        float s0 = 0.f, s1 = 0.f;
        s0 = __builtin_amdgcn_fdot2(__builtin_amdgcn_cvt_scalef32_pk_f16_fp4(q0, 1.0f, 0), __builtin_bit_cast(h2v_t, hp[0]), s0, false);
        s1 = __builtin_amdgcn_fdot2(__builtin_amdgcn_cvt_scalef32_pk_f16_fp4(q0, 1.0f, 1), __builtin_bit_cast(h2v_t, hp[1]), s1, false);
        s0 = __builtin_amdgcn_fdot2(__builtin_amdgcn_cvt_scalef32_pk_f16_fp4(q0, 1.0f, 2), __builtin_bit_cast(h2v_t, hp[2]), s0, false);
        s1 = __builtin_amdgcn_fdot2(__builtin_amdgcn_cvt_scalef32_pk_f16_fp4(q0, 1.0f, 3), __builtin_bit_cast(h2v_t, hp[3]), s1, false);
        s0 = __builtin_amdgcn_fdot2(__builtin_amdgcn_cvt_scalef32_pk_f16_fp4(q1, 1.0f, 0), __builtin_bit_cast(h2v_t, hp[4]), s0, false);
        s1 = __builtin_amdgcn_fdot2(__builtin_amdgcn_cvt_scalef32_pk_f16_fp4(q1, 1.0f, 1), __builtin_bit_cast(h2v_t, hp[5]), s1, false);
        s0 = __builtin_amdgcn_fdot2(__builtin_amdgcn_cvt_scalef32_pk_f16_fp4(q1, 1.0f, 2), __builtin_bit_cast(h2v_t, hp[6]), s0, false);
        s1 = __builtin_amdgcn_fdot2(__builtin_amdgcn_cvt_scalef32_pk_f16_fp4(q1, 1.0f, 3), __builtin_bit_cast(h2v_t, hp[7]), s1, false);
        d[k] = s0 + s1;
    }
#pragma unroll
    for (int k = 0; k < 4; ++k) *(LAS u32x2*)(vrow + k * GV_ROW) = S.vq[k];
    float e2[2], f1;
#pragma unroll
    for (int k = 0; k < 2; ++k) { auto r = __builtin_amdgcn_permlane16_swap(__float_as_uint(d[k]), __float_as_uint(d[k + 2]), false, false); e2[k] = __uint_as_float(r[0]) + __uint_as_float(r[1]); }
    { auto r = __builtin_amdgcn_permlane32_swap(__float_as_uint(e2[0]), __float_as_uint(e2[1]), false, false); f1 = __uint_as_float(r[0]) + __uint_as_float(r[1]); }
    f1 = DPP_ADD(f1, 0xB1); f1 = DPP_ADD(f1, 0x4E); f1 = DPP_ADD(f1, 0x124); f1 = DPP_ADD(f1, 0x128);
    return f1;
}
#define DPP_MAX(v, ctrl) fmaxf((v), __builtin_bit_cast(float, __builtin_amdgcn_update_dpp(0, __builtin_bit_cast(int, (v)), (ctrl), 0xf, 0xf, true)))
__device__ __forceinline__ void gather_vpart(float f0, float f1, float f2, float f3, int lane, int kslot, const LAS float* lg  ,
                                             const LAS unsigned char* vrd  , LAS unsigned char* cb, int aoff1, int aoff2, f32x4 (&acc)[8]) {
    const int q = (lane >> 2) & 3, e16 = 4 * q + kslot;
    const float fs = q == 0 ? f0 : q == 1 ? f1 : q == 2 ? f2 : f3;
    const float cv = lg[e16] * gelu_erf(fs * lg[GT * 128 + e16]);
    float mx = fabsf(cv);
    mx = DPP_MAX(mx, 0x124); mx = DPP_MAX(mx, 0x128);
    { auto r = __builtin_amdgcn_permlane16_swap(__float_as_uint(mx), __float_as_uint(mx), false, false); mx = fmaxf(__uint_as_float(r[0]), __uint_as_float(r[1])); }
    { auto r = __builtin_amdgcn_permlane32_swap(__float_as_uint(mx), __float_as_uint(mx), false, false); mx = fmaxf(__uint_as_float(r[0]), __uint_as_float(r[1])); }
    int E = (int)((__float_as_uint(mx) >> 23) & 0xffu); E = E < 8 ? 8 : E;
    const float x = cv * __uint_as_float((unsigned)(255 - E) << 23);
    const unsigned p1 = __builtin_amdgcn_cvt_scalef32_pk_fp4_f32(0u, x, 0.f, 1.0f, 0);
    const float r1 = x - __builtin_amdgcn_cvt_scalef32_pk_f32_fp4(p1, 1.0f, 0)[0];
    const unsigned p2 = __builtin_amdgcn_cvt_scalef32_pk_fp4_f32(0u, r1, 0.f, 1.0f, 0);
    const float y = (r1 - __builtin_amdgcn_cvt_scalef32_pk_f32_fp4(p2, 1.0f, 0)[0]) * 16.0f;
    const unsigned p3 = __builtin_amdgcn_cvt_scalef32_pk_fp4_f32(0u, y, 0.f, 1.0f, 0);
    const float r3 = y - __builtin_amdgcn_cvt_scalef32_pk_f32_fp4(p3, 1.0f, 0)[0];
    const unsigned p4 = __builtin_amdgcn_cvt_scalef32_pk_fp4_f32(0u, r3, 0.f, 1.0f, 0);
    const unsigned codes = (p1 & 15u) | ((p2 & 15u) << 8) | ((p3 & 15u) << 16) | ((p4 & 15u) << 24);
    { auto r = __builtin_amdgcn_permlane32_swap(codes, codes, false, false);
      const unsigned w = codes | ((r[0] ^ r[1] ^ codes) << 4);
      if (lane < 32 && (lane & 3) == 0) {
          LAS unsigned char* tb = cb + 8 + 2 * q + ((lane >> 4) & 1);
          tb[0] = (unsigned char)w; tb[16] = (unsigned char)(w >> 8); tb[32] = (unsigned char)(w >> 16); tb[48] = (unsigned char)(w >> 24);
      } }
    const u32x2 a10 = *(const LAS u32x2*)(cb + aoff1), a11 = *(const LAS u32x2*)(cb + aoff1 + 8), a20 = *(const LAS u32x2*)(cb + aoff2), a21 = *(const LAS u32x2*)(cb + aoff2 + 8);
    const v8i_t A1 = {(int)a10.x, (int)a10.y, (int)a11.x, (int)a11.y, 0, 0, 0, 0}, A2 = {(int)a20.x, (int)a20.y, (int)a21.x, (int)a21.y, 0, 0, 0, 0};
    const int sa1 = (E - 1) * 0x01010101, sa2 = (E - 5) * 0x01010101;
#pragma unroll
    for (int m = 0; m < 8; ++m) {
        const v2i_t t0 = __builtin_amdgcn_ds_read_tr4_b64_v2i32((LAS v2i_t*)(vrd + 16 * m)), t1 = __builtin_amdgcn_ds_read_tr4_b64_v2i32((LAS v2i_t*)(vrd + 16 * m + 8));
        const v8i_t B = {t0.x, t0.y, t1.x, t1.y, 0, 0, 0, 0};
        acc[m] = __builtin_amdgcn_mfma_scale_f32_16x16x128_f8f6f4(A1, B, acc[m], 4, 4, 0, sa1, 0, 0x7F7F7F7F);
        acc[m] = __builtin_amdgcn_mfma_scale_f32_16x16x128_f8f6f4(A2, B, acc[m], 4, 4, 0, sa2, 0, 0x7F7F7F7F);
    }
}
__device__ __forceinline__ void xcd_pace(unsigned* bar, volatile LAS unsigned* st);
constexpr int GNS = 8, GBPS = 32 / GNS, GSHIFT = 11;
constexpr int GATH_LDS_WAVE = GT * 128 * 12 + GV_BYTES + GC_BYTES;
#define GATH_SEG(J, NJ, nbt) { \
        const LAS int* le_ = lse + (J) * 128; const LAS int* ne_ = lse + (NJ) * 128; \
        gather_issue(D, GBPS * c + 3, lane, pu, pv, le_); \
        const float f0_ = gather_udot(A, hx[J], vwr); \
        gather_issue(A, (nbt), lane, pu, pv, ne_); \
        const float f1_ = gather_udot(B, hx[J], vwr + 4 * GV_ROW); \
        gather_issue(B, (nbt) + 1, lane, pu, pv, ne_); \
        const float f2_ = gather_udot(C, hx[J], vwr + 8 * GV_ROW); \
        gather_issue(C, (nbt) + 2, lane, pu, pv, ne_); \
        const float f3_ = gather_udot(D, hx[J], vwr + 12 * GV_ROW); \
        gather_vpart(f0_, f1_, f2_, f3_, lane, kslot, lsg + (J) * 128 + 16 * c, vrd, cb, aoff1, aoff2, acc[J]); }
__device__ void ph_peer_gather(const bf16* h2, const unsigned char* pu, const unsigned char* pv, const float* su, const float* sv,
                               const int* eidx, const float* egate, const float* xin, const float* gate  , float* xout, LAS unsigned char* lds, unsigned* pace_bar, volatile LAS unsigned* pace_st, int bid, int nb) {
    const int lane0 = ltid() & 63, w = __builtin_amdgcn_readfirstlane(ltid() >> 6);
    LAS int* lse = (LAS int*)(lds + w * GATH_LDS_WAVE); LAS float* lsg = (LAS float*)(lds + w * GATH_LDS_WAVE + GT * 128 * 4);
    LAS unsigned char* vb = lds + w * GATH_LDS_WAVE + GT * 128 * 12; LAS unsigned char* cb = vb + GV_BYTES;
    if (lane0 < GC_BYTES / 4) ((LAS unsigned*)cb)[lane0] = 0u;
    for (int t0 = (bid * 8 + w) * GT; t0 < MT; t0 += nb * 8 * GT) {
        int lane = lane0; asm volatile("" : "+v"(lane));
        const int row = lane >> 4;
        const int kslot = 2 * (row & 1) + (row >> 1);
        const int b = t0 >> 11;
        LAS unsigned char* vwr = vb + lane * 8;
        const LAS unsigned char* vrd = vb + (lane & 15) * GV_ROW + 128 * row;
        const int ai = lane & 15, au = (ai < 8 ? 1 : 3), nz = ((ai & 7) >> 1) == row;
        const int aoff1 = nz ? 8 * (au - (ai & 1)) : 64, aoff2 = nz ? 8 * (au + 4 - (ai & 1)) : 64;
        unsigned hx[GT][8]; f32x4 acc[GT][8];
#pragma unroll
        for (int j = 0; j < GT; ++j) {
            const int t = t0 + j;
            const int e0 = eidx[(size_t)t * 128 + lane], e1 = eidx[(size_t)t * 128 + 64 + lane];
            const float g0 = egate[(size_t)t * 128 + lane], g1 = egate[(size_t)t * 128 + 64 + lane];
            const int k0 = e0 >> GSHIFT, k1 = e1 >> GSHIFT;
            int off = 0, d0 = 0, d1 = 0;
#pragma unroll
            for (int s = 0; s < GNS; ++s) {
                const unsigned long long m0 = __ballot(k0 == s), m1 = __ballot(k1 == s);
                const int r0 = (int)__builtin_amdgcn_mbcnt_hi((unsigned)(m0 >> 32), __builtin_amdgcn_mbcnt_lo((unsigned)m0, 0u));
                const int r1 = (int)__builtin_amdgcn_mbcnt_hi((unsigned)(m1 >> 32), __builtin_amdgcn_mbcnt_lo((unsigned)m1, 0u));
                const int c0 = __builtin_popcountll(m0);
                if (k0 == s) d0 = off + r0;
                if (k1 == s) d1 = off + c0 + r1;
                off += c0 + __builtin_popcountll(m1);
            }
            lse[j * 128 + d0] = e0; lsg[j * 128 + d0] = g0 * sv[e0]; lse[j * 128 + d1] = e1; lsg[j * 128 + d1] = g1 * sv[e1];
            lsg[GT * 128 + j * 128 + d0] = su[e0]; lsg[GT * 128 + j * 128 + d1] = su[e1];
            const u32x4 u0 = *(const u32x4*)(h2 + (size_t)t * DM + lane * 16), u1 = *(const u32x4*)(h2 + (size_t)t * DM + lane * 16 + 8);
#pragma unroll
            for (int i = 0; i < 4; ++i) {
                hx[j][i] = __builtin_bit_cast(unsigned, __builtin_amdgcn_cvt_pkrtz(__uint_as_float(u0[i] << 16), __uint_as_float(u0[i] & 0xffff0000u)));
                hx[j][4 + i] = __builtin_bit_cast(unsigned, __builtin_amdgcn_cvt_pkrtz(__uint_as_float(u1[i] << 16), __uint_as_float(u1[i] & 0xffff0000u)));
            }
#pragma unroll
            for (int i = 0; i < 8; ++i) acc[j][i] = (f32x4){0.f, 0.f, 0.f, 0.f};
        }
        GSet A, B, C, D;
        gather_issue(A, 0, lane, pu, pv, lse); gather_issue(B, 1, lane, pu, pv, lse); gather_issue(C, 2, lane, pu, pv, lse);
#pragma unroll 1
        for (int c = 0; c < GNS; ++c) {
            GATH_SEG(0, 1, GBPS * c)
            GATH_SEG(1, 0, c < GNS - 1 ? GBPS * c + GBPS : 0)
        }
#pragma unroll
        for (int j = 0; j < GT; ++j) {
            const int t = t0 + j;
            LAS float* ob = (LAS float*)vb;
            const int nbase = 512 * (row & 1) + 32 * (row >> 1) + (lane & 15);
#pragma unroll
            for (int pm = 0; pm < 4; ++pm)
#pragma unroll
                for (int r = 0; r < 4; ++r) {
                    auto sw = __builtin_amdgcn_permlane32_swap(__float_as_uint(acc[j][2 * pm][r]), __float_as_uint(acc[j][2 * pm + 1][r]), false, false);
                    ob[nbase + 256 * (r >> 1) + 64 * pm + 16 * (r & 1)] = __uint_as_float(sw[0]) + __uint_as_float(sw[1]);
                }
#pragma unroll
            for (int i = 0; i < 4; ++i) {
                const int cc = i * 256 + lane * 4;
                const f32x4 a = *(const LAS f32x4*)(ob + cc);
                const f32x4 xi = *(const f32x4*)(xin + (size_t)t * DM + cc), gt = *(const f32x4*)(gate + (size_t)b * 6144 + cc);
                f32x4 o;
#pragma unroll
                for (int e = 0; e < 4; ++e) o[e] = xi[e] + gt[e] * a[e];
                __builtin_nontemporal_store(o, (f32x4*)(xout + (size_t)t * DM + cc));
            }
        }
    }
}

#define XB_TMO      128
#define XB_XCNT(j)  (256  + 64 * (j))
#define XB_XSUB(j)  (1280 + 64 * (j))
#define XB_XGEN(j)  (2304 + 64 * (j))
#define XB_TOP      3328
#define XB_TOPGEN   3392
#define XCD_BAR_WORDS 3456
#define XB_SPIN_CAP (1u << 18)

__device__ __forceinline__ unsigned xb_ld(unsigned* p)              { return __hip_atomic_load(p, __ATOMIC_RELAXED, __HIP_MEMORY_SCOPE_AGENT); }
__device__ __forceinline__ unsigned xb_add(unsigned* p, unsigned v) { return __hip_atomic_fetch_add(p, v, __ATOMIC_RELAXED, __HIP_MEMORY_SCOPE_AGENT); }
__device__ __forceinline__ unsigned xb_xcc_id() { return (unsigned)__builtin_amdgcn_s_getreg((3 << 11) | 20) & 0xFu; }
#define XB_SPIN(cond, bar) do { unsigned _sp = 0; while (cond) { __builtin_amdgcn_s_sleep(1); \
    if ((++_sp & 255u) == 0u) { if (xb_ld(&(bar)[XB_TMO])) break; if (_sp > XB_SPIN_CAP) { atomicAdd(&(bar)[XB_TMO], 1u); break; } } } } while (0)

struct XcdBarrier {
    unsigned* bar; unsigned x;
    volatile LAS unsigned* st;
};

__device__ __forceinline__ XcdBarrier xcd_barrier_post(unsigned* bar, volatile LAS unsigned* st) {
    XcdBarrier b; b.bar = bar; b.x = xb_xcc_id(); b.st = st;
    if (threadIdx.x == 0) (void)xb_add(&bar[XB_XCNT(b.x)], 1u);
    return b;
}
__device__ __forceinline__ void xcd_barrier_complete(unsigned* bar, unsigned x, unsigned& nloc, unsigned& nx) {
    const unsigned G = gridDim.x * gridDim.y * gridDim.z;
    unsigned sum, cnt, mine, sp = 0u;
    for (;;) {
        sum = 0u; cnt = 0u; mine = 0u;
#pragma unroll
        for (unsigned j = 0; j < 16; ++j) { const unsigned c = xb_ld(&bar[XB_XCNT(j)]); sum += c; cnt += (c > 0u) ? 1u : 0u; mine = (j == x) ? c : mine; }
        if (sum == G) break;
        __builtin_amdgcn_s_sleep(1);
        if ((++sp & 255u) == 0u) { if (xb_ld(&bar[XB_TMO])) break; if (sp > XB_SPIN_CAP) { atomicAdd(&bar[XB_TMO], 1u); break; } }
    }
    nloc = mine > 0u ? mine : 1u; nx = cnt > 0u ? cnt : 1u;
}

__device__ __forceinline__ void xcd_barrier(const XcdBarrier& b) {
    asm volatile("s_waitcnt vmcnt(0)" ::: "memory");
    __syncthreads();
    if (threadIdx.x == 0) {
        unsigned* bar = b.bar;
        __builtin_amdgcn_s_waitcnt(0);
        unsigned nloc = b.st[0], nx = b.st[1];
        if (nloc == 0u) { xcd_barrier_complete(bar, b.x, nloc, nx); b.st[0] = nloc; b.st[1] = nx; }
        const unsigned old = xb_add(&bar[XB_XSUB(b.x)], 1u);
        const unsigned gen = old / nloc;
        if (old + 1u == (gen + 1u) * nloc) {
            __builtin_amdgcn_fence(__ATOMIC_RELEASE, "agent");
            asm volatile("s_waitcnt vmcnt(0)" ::: "memory");
            const unsigned og = xb_add(&bar[XB_TOP], 1u);
            const unsigned tg = og / nx;
            if (og + 1u == (tg + 1u) * nx) xb_add(&bar[XB_TOPGEN], 1u);
            else XB_SPIN(xb_ld(&bar[XB_TOPGEN]) == tg, bar);
            __builtin_amdgcn_fence(__ATOMIC_ACQUIRE, "agent");
            xb_add(&bar[XB_XGEN(b.x)], 1u);
            asm volatile("s_waitcnt vmcnt(0)" ::: "memory");
        } else {
            XB_SPIN(xb_ld(&bar[XB_XGEN(b.x)]) == gen, bar);
            __builtin_amdgcn_fence(__ATOMIC_ACQUIRE, "agent");
            asm volatile("s_waitcnt vmcnt(0)" ::: "memory");
        }
    }
    __syncthreads();
}


#define XB_PACE(j) (3584 + 64 * (j))
__device__ __forceinline__ void xcd_pace(unsigned* bar, volatile LAS unsigned* st) {
    __syncthreads();
    if (threadIdx.x == 0) {
        const unsigned nloc = st[0] ? st[0] : 1u, x = xb_xcc_id(), gen = st[4] + 1u;
        st[4] = gen;
        xb_add(&bar[XB_PACE(x)], 1u);
        unsigned sp = 0;
        while (xb_ld(&bar[XB_PACE(x)]) < gen * nloc) { __builtin_amdgcn_s_sleep(1); if (++sp > (1u << 16)) break; }
    }
    __syncthreads();
}
extern __shared__ __attribute__((aligned(16))) unsigned char dyn_lds[];
#ifndef REP_PREP
#define REP_PREP 1
#endif
#ifndef REP_ATTN
#define REP_ATTN 1
#endif
#ifndef REP_SEL
#define REP_SEL 1
#endif
#ifndef REP_GATH
#define REP_GATH 1
#endif
#ifndef REP_GEMM
#define REP_GEMM 1
#endif
#ifndef REP_ADALN
#define REP_ADALN 1
#endif
constexpr int LDS_BYTES = 147456;

template <class T> __device__ __forceinline__ T* karg(int byte_off) {
    const __attribute__((address_space(4))) char* base = (const __attribute__((address_space(4))) char*)__builtin_amdgcn_kernarg_segment_ptr();
    unsigned long long v = *(const __attribute__((address_space(4))) unsigned long long*)(base + byte_off);
    asm volatile("" : "+s"(v));
    return (T*)(__attribute__((address_space(1))) T*)v;
}
#define KIN(i) karg<const float>(8 * (i))
#define KOUT() karg<float>(168)
#define KWS() karg<unsigned char>(176)
static_assert(sizeof(Params) == 184, "Params layout");
template <class T> __device__ __forceinline__ T* launder(T* p) { size_t off = 0; asm volatile("" : "+s"(off)); return (T*)((unsigned char*)p + off); }
__global__ void __launch_bounds__(NT) mega_fwd(Params p) {
    cg::grid_group grid = cg::this_grid();
    const int bid = blockIdx.x, nb = gridDim.x;
    volatile LAS unsigned* bst = (volatile LAS unsigned*)((LAS unsigned char*)dyn_lds + LDS_BYTES - 64);
    if (ltid() < 16) bst[ltid()] = 0u;
    __syncthreads();
    const XcdBarrier xbar = xcd_barrier_post((unsigned*)(KWS() + WS_BAR), bst);
    for (int rep = 0; rep < REP_PREP; ++rep) {
        unsigned char* ws = KWS();
        float* tile = (float*)dyn_lds;
        ph_transpose(KIN(6), (bf16*)(ws + WS_WIN0), 1024, AB_IN, true, tile, bid, nb);
        ph_transpose(KIN(11), (bf16*)(ws + WS_WIN1), 1024, CD_IN, true, tile, bid, nb);
        ph_transpose(KIN(7), (bf16*)(ws + WS_WO0), 1024, 1024, false, tile, bid, nb);
        ph_transpose(KIN(12), (bf16*)(ws + WS_WO1), 1024, 1024, false, tile, bid, nb);
        ph_transpose(KIN(17), (bf16*)(ws + WS_WQ), 1024, PQ, false, tile, bid, nb);
        ph_transpose(KIN(17) + (size_t)1024 * PQ, (bf16*)(ws + WS_WQ) + (size_t)PQ * 1024, 1024, PQ, false, tile, bid, nb);
        ws = launder(ws);
        ph_tab_fp4(KIN(19), ws + WS_PU, (float*)(ws + WS_PV), 2 * NEXP, bid, nb);
        ph_tab_fp4(KIN(20), ws + WS_PU + 32 * MiB, (float*)(ws + WS_PV + 1 * MiB), 2 * NEXP, bid, nb);
        ws = launder(ws);
        ph_mod(KIN(1), KIN(2), KIN(3), (float*)(ws + WS_MOD), (float*)dyn_lds, bid, nb);
        ph_rope_table((float*)(ws + WS_ROPE), bid, nb);
        for (int i = bid * NT + ltid(); i < NB * 8 * 8 * 64; i += nb * NT) ((float*)(ws + WS_KMEAN))[i] = 0.f;
    }
    grid.sync();
#pragma unroll 1
    for (int layer = 0; layer < 2; ++layer) {
        for (int rep = 0; rep < REP_ADALN; ++rep) {
            unsigned char* ws = KWS(); const float* mod = (const float*)(ws + WS_MOD) + (size_t)layer * 32 * 6144;
            ph_adaln(layer == 0 ? KIN(0) : KOUT(), KIN(4) + layer * DM, mod + 0, mod + 1024, (bf16*)(ws + WS_HY), bid, nb);
        }
        xcd_barrier(xbar);
        for (int rep = 0; rep < REP_GEMM; ++rep) {
            unsigned char* ws = KWS();
            pg8::Gemm g{(const bf16*)(ws + WS_HY), (const bf16*)(ws + (layer == 0 ? WS_WIN0 : WS_WIN1)), MT, layer == 0 ? AB_IN : CD_IN, DM};
            pg8::StaticOrder S; S.init(g.M, g.N, nb, bid);
            pg8::EpiQKV e{(bf16*)(ws + WS_QKV), QKV_LD, (const float*)(ws + WS_ROPE), layer, layer == 0 ? KIN(9) : KIN(13), layer == 0 ? KIN(10) : KIN(14), KIN(15), KIN(16), (float*)(ws + WS_KMEAN)};
            pg8::gemm_phase<pg8::EpiQKV, pg8::StaticOrder, true, true>((LAS unsigned char*)dyn_lds, g, S, e);
        }
        xcd_barrier(xbar);
        for (int rep = 0; rep < REP_ATTN; ++rep) {
            unsigned char* ws = KWS();
            if (layer == 0) ph_attn0((const bf16*)(ws + WS_QKV), KIN(8), (bf16*)(ws + WS_HY), (LAS unsigned char*)dyn_lds, bid, nb);
            else ph_attn1((const bf16*)(ws + WS_QKV), (const float*)(ws + WS_KMEAN), (bf16*)(ws + WS_HY), (LAS unsigned char*)dyn_lds, bid, nb);
        }
        xcd_barrier(xbar);
        for (int rep = 0; rep < REP_GEMM; ++rep) {
            unsigned char* ws = KWS(); const float* mod = (const float*)(ws + WS_MOD) + (size_t)layer * 32 * 6144;
            pg8::Gemm g{(const bf16*)(ws + WS_HY), (const bf16*)(ws + (layer == 0 ? WS_WO0 : WS_WO1)), MT, DM, DM};
            pg8::StaticOrder S; S.init(g.M, g.N, nb, bid); pg8::EpiResid e{layer == 0 ? KIN(0) : KOUT(), (float*)(ws + WS_X1), mod + 2048};
            pg8::gemm_phase<pg8::EpiResid, pg8::StaticOrder, true, true>((LAS unsigned char*)dyn_lds, g, S, e);
        }
        xcd_barrier(xbar);
        for (int rep = 0; rep < REP_ADALN; ++rep) {
            unsigned char* ws = KWS(); const float* mod = (const float*)(ws + WS_MOD) + (size_t)layer * 32 * 6144;
            ph_adaln((const float*)(ws + WS_X1), KIN(5) + layer * DM, mod + 3072, mod + 4096, (bf16*)(ws + WS_QKV), bid, nb);
        }
        xcd_barrier(xbar);
        for (int rep = 0; rep < REP_GEMM; ++rep) {
            unsigned char* ws = KWS();
            pg8::Gemm g{(const bf16*)(ws + WS_QKV), (const bf16*)(ws + WS_WQ) + (size_t)layer * PQ * DM, MT, PQ, DM};
            pg8::StaticOrder S; S.init(g.M, g.N, nb, bid); pg8::EpiStore e{(bf16*)(ws + WS_QKV + 128 * MiB), PQ};
            pg8::gemm_phase<pg8::EpiStore, pg8::StaticOrder, true, true>((LAS unsigned char*)dyn_lds, g, S, e);
        }
        xcd_barrier(xbar);
        for (int rep = 0; rep < REP_SEL; ++rep) {
            unsigned char* ws = KWS();
            ph_peer_select((const bf16*)(ws + WS_QKV + 128 * MiB), KIN(18) + (size_t)layer * 2 * 128 * 128, (int*)(ws + WS_HY), (float*)(ws + WS_HY + 32 * MiB), (LAS unsigned char*)dyn_lds, bid, nb);
        }
        xcd_barrier(xbar);
        for (int rep = 0; rep < REP_GATH; ++rep) {
            unsigned char* ws = KWS(); const float* mod = (const float*)(ws + WS_MOD) + (size_t)layer * 32 * 6144;
            ph_peer_gather((const bf16*)(ws + WS_QKV), ws + WS_PU + (size_t)layer * NEXP * TROW4, ws + WS_PU + 32 * MiB + (size_t)layer * NEXP * TROW4,
                           (const float*)(ws + WS_PV) + layer * NEXP, (const float*)(ws + WS_PV + 1 * MiB) + layer * NEXP, (const int*)(ws + WS_HY), (const float*)(ws + WS_HY + 32 * MiB), (const float*)(ws + WS_X1), mod + 5120, KOUT(), (LAS unsigned char*)dyn_lds, (unsigned*)(ws + WS_BAR), bst, bid, nb);
        }
        if (layer == 0) xcd_barrier(xbar);
    }
}

extern "C" void kernel_launch(void* const* d_in, const int* in_sizes, int n_in, void* d_out, int out_size, void* d_ws, size_t ws_size, hipStream_t stream) {
    if (n_in != 21 || ws_size < WS_END) { fprintf(stderr, "kernel_launch: bad args n_in=%d ws=%zu\n", n_in, ws_size); return; }
    static int grid_blocks = 0;
    if (!grid_blocks) {
        int dev = 0, cus = 0, per_cu = 0;
        (void)hipGetDevice(&dev);
        (void)hipDeviceGetAttribute(&cus, hipDeviceAttributeMultiprocessorCount, dev);
        (void)hipFuncSetAttribute((const void*)mega_fwd, hipFuncAttributeMaxDynamicSharedMemorySize, LDS_BYTES);
        (void)hipOccupancyMaxActiveBlocksPerMultiprocessor(&per_cu, (const void*)mega_fwd, NT, LDS_BYTES);
        if (per_cu < 1) { fprintf(stderr, "kernel_launch: occupancy query returned %d\n", per_cu); per_cu = 1; }
        if (per_cu > 1) per_cu = 1;
        grid_blocks = cus * per_cu;
    }
    Params p{};
    for (int i = 0; i < 21; ++i) p.in[i] = (const float*)d_in[i];
    p.out = (float*)d_out; p.ws = (unsigned char*)d_ws;
    (void)hipMemsetAsync((char*)d_ws + WS_BAR, 0, 16384, stream);
    void* args[] = {&p};
    hipError_t e = hipLaunchCooperativeKernel((const void*)mega_fwd, dim3(grid_blocks), dim3(NT), args, LDS_BYTES, stream);
    if (e != hipSuccess) fprintf(stderr, "cooperative launch failed: %s (grid %d)\n", hipGetErrorString(e), grid_blocks);
}
```

```cpp
#include <hip/hip_runtime.h>
#ifndef REP_A
#define REP_A 1
#endif
#ifndef REP_B
#define REP_B 1
#endif
#ifndef REP_C
#define REP_C 1
#endif
#ifndef REP_D
#define REP_D 1
#endif
#include <hip/hip_cooperative_groups.h>
namespace cg = cooperative_groups;
#include <cstdio>
#include <cstdint>
#include <cmath>

typedef unsigned short bf16;
typedef short bf16x8 __attribute__((ext_vector_type(8)));
typedef float f32x4 __attribute__((ext_vector_type(4)));
typedef unsigned u32x4 __attribute__((ext_vector_type(4)));
typedef unsigned u32x2 __attribute__((ext_vector_type(2)));

constexpr int DM = 1024, NB = 32, SQ = 2048, MT = NB * SQ;
constexpr int HD = 64;
constexpr int AB_IN = 2304, CD_IN = 3072, QKV_LD = 3072;
constexpr int NEXP = 16384, PQ = 2048;
constexpr float EPS = 1e-6f;
constexpr int NT = 512;

constexpr size_t MiB = 1u << 20;
constexpr size_t WS_X1 = 0;
constexpr size_t WS_QKV = 256 * MiB;
constexpr size_t WS_HY = 640 * MiB;
constexpr size_t WS_PU = 768 * MiB;
constexpr size_t WS_PV = 832 * MiB;
constexpr size_t WS_WIN0 = 896 * MiB;
constexpr size_t WS_WIN1 = 901 * MiB;
constexpr size_t WS_WO0 = 907 * MiB;
constexpr size_t WS_WO1 = 909 * MiB;
constexpr size_t WS_WQ = 911 * MiB;
constexpr size_t WS_MOD = 919 * MiB;
constexpr size_t WS_ROPE = 921 * MiB;
constexpr size_t WS_KMEAN = 922 * MiB;
constexpr size_t WS_BAR = 923 * MiB;
constexpr size_t WS_END = 924 * MiB;

struct Params {
    const float* in[21];
    float* out;
    unsigned char* ws;
};

__device__ __forceinline__ int ltid() { int t = (int)__builtin_amdgcn_workitem_id_x(); asm volatile("" : "+v"(t)); return t; }
__device__ __forceinline__ float bf2f(unsigned b) { return __uint_as_float(b << 16); }
__device__ __forceinline__ unsigned f2bf(float f) { unsigned u = __float_as_uint(f); return (u + 0x7fffu + ((u >> 16) & 1u)) >> 16; }
__device__ __forceinline__ unsigned pk2(float lo, float hi) { return f2bf(lo) | (f2bf(hi) << 16); }
#define DPPV(v, ctrl) __builtin_bit_cast(float, __builtin_amdgcn_update_dpp(0, __builtin_bit_cast(int, (v)), (ctrl), 0xf, 0xf, true))
__device__ __forceinline__ float row16_sum(float v) { v += DPPV(v, 0xB1); v += DPPV(v, 0x4E); v += DPPV(v, 0x124); v += DPPV(v, 0x128); return v; }
__device__ __forceinline__ float rows_sum(float v) {
    { auto r = __builtin_amdgcn_permlane16_swap(__float_as_uint(v), __float_as_uint(v), false, false); v = __uint_as_float(r[0]) + __uint_as_float(r[1]); }
    { auto r = __builtin_amdgcn_permlane32_swap(__float_as_uint(v), __float_as_uint(v), false, false); v = __uint_as_float(r[0]) + __uint_as_float(r[1]); }
    return v;
}
__device__ __forceinline__ float wave_sum(float v) { return rows_sum(row16_sum(v)); }
__device__ __forceinline__ float wave_max(float v) {
    v = fmaxf(v, DPPV(v, 0xB1)); v = fmaxf(v, DPPV(v, 0x4E)); v = fmaxf(v, DPPV(v, 0x124)); v = fmaxf(v, DPPV(v, 0x128));
    { auto r = __builtin_amdgcn_permlane16_swap(__float_as_uint(v), __float_as_uint(v), false, false); v = fmaxf(__uint_as_float(r[0]), __uint_as_float(r[1])); }
    { auto r = __builtin_amdgcn_permlane32_swap(__float_as_uint(v), __float_as_uint(v), false, false); v = fmaxf(__uint_as_float(r[0]), __uint_as_float(r[1])); }
    return v;
}
__device__ __forceinline__ float gelu_erf(float x) {
    const float z = x * 0.70710678118654752f, az = fabsf(z);
    const float t = __builtin_amdgcn_rcpf(fmaf(0.3275911f, az, 1.0f));
    float pl = fmaf(t, 1.061405429f, -1.453152027f); pl = fmaf(t, pl, 1.421413741f); pl = fmaf(t, pl, -0.284496736f); pl = fmaf(t, pl, 0.254829592f); pl *= t;
    const float ex = __builtin_amdgcn_exp2f(az * (az * -1.4426950408889634f));
    const float er = copysignf(fmaf(-pl, ex, 1.0f), z);
    const float hx = 0.5f * x;
    return fmaf(hx, er, hx);
}

__device__ __forceinline__ int qkv_logical_col(int p) { return (p & ~255) | (((p >> 5) & 3) << 6) | (((p >> 7) & 1) << 5) | (p & 31); }
__device__ void ph_transpose(const float* W, bf16* Wt, int K, int N, bool permute, float* tile  , int bid, int nb) {
    const int tid = ltid();
    const int nkt = K / 64, nnt = N / 64;
    for (int it = bid; it < nkt * nnt; it += nb) {
        const int k0 = (it / nnt) * 64, n0 = (it % nnt) * 64;
        __syncthreads();
        for (int e = tid; e < 64 * 64; e += NT) { const int r = e >> 6, c = e & 63; const int nl = permute ? qkv_logical_col(n0 + c) : n0 + c; tile[r * 65 + c] = W[(size_t)(k0 + r) * N + nl]; }
        __syncthreads();
        {
            const int n = tid >> 3, k8 = (tid & 7) * 8;
            u32x4 v;
            v.x = pk2(tile[(k8 + 0) * 65 + n], tile[(k8 + 1) * 65 + n]);
            v.y = pk2(tile[(k8 + 2) * 65 + n], tile[(k8 + 3) * 65 + n]);
            v.z = pk2(tile[(k8 + 4) * 65 + n], tile[(k8 + 5) * 65 + n]);
            v.w = pk2(tile[(k8 + 6) * 65 + n], tile[(k8 + 7) * 65 + n]);
            *(u32x4*)(Wt + (size_t)(n0 + n) * K + k0 + k8) = v;
        }
    }
}
__device__ void ph_convert(const float* src, bf16* dst, size_t n, int bid, int nb) {
    const size_t n8 = n / 8;
    for (size_t i = (size_t)bid * NT + ltid(); i < n8; i += (size_t)nb * NT) {
        const f32x4 a = *(const f32x4*)(src + i * 8), b = *(const f32x4*)(src + i * 8 + 4);
        u32x4 v; v.x = pk2(a[0], a[1]); v.y = pk2(a[2], a[3]); v.z = pk2(b[0], b[1]); v.w = pk2(b[2], b[3]);
        *(u32x4*)(dst + i * 8) = v;
    }
}
__device__ void ph_mod(const float* c, const float* ada_w, const float* ada_b, float* mod, float* lds  , int bid, int nb) {
    const int tid = ltid(), lane = tid & 63, w = tid >> 6;
    for (int it = bid; it < 2 * 96; it += nb) {
        const int l = it / 96, j = (it % 96) * 64 + lane;
        float acc[32];
#pragma unroll
        for (int b = 0; b < 32; ++b) acc[b] = 0.f;
        for (int kh = 0; kh < 2; ++kh) {
            __syncthreads();
            for (int e = tid; e < 32 * 512; e += NT) { const int b = e >> 9, k = e & 511; const float cv = c[b * 1024 + kh * 512 + k]; lds[e] = cv / (1.0f + __expf(-cv)); }
            __syncthreads();
            for (int kk = 0; kk < 64; ++kk) {
                const int k = w * 64 + kk;
                const float wv = ada_w[((size_t)l * 1024 + kh * 512 + k) * 6144 + j];
#pragma unroll
                for (int b = 0; b < 32; ++b) acc[b] += lds[b * 512 + k] * wv;
            }
        }
        __syncthreads();
#pragma unroll
        for (int b = 0; b < 32; ++b) lds[(w * 32 + b) * 64 + lane] = acc[b];
        __syncthreads();
        for (int e = tid; e < 32 * 64; e += NT) {
            const int b = e >> 6, jj = e & 63; float s = 0.f;
#pragma unroll
            for (int ww = 0; ww < 8; ++ww) s += lds[(ww * 32 + b) * 64 + jj];
            const int jo = (it % 96) * 64 + jj;
            mod[((size_t)l * 32 + b) * 6144 + jo] = s + ada_b[l * 6144 + jo];
        }
    }
}
__device__ void ph_rope_table(float* rope, int bid, int nb) {
    for (int i = bid * NT + ltid(); i < SQ * 32; i += nb * NT) {
        const int t = i >> 5, f = i & 31;
        const float inv = powf(10000.0f, -(float)f / 32.0f);
        const float ang = (float)t * inv;
        float s, c; sincosf(ang, &s, &c);
        rope[i * 2] = c; rope[i * 2 + 1] = s;
    }
}

#define DPP_ADD0(v, ctrl) ((v) + __builtin_bit_cast(float, __builtin_amdgcn_update_dpp(0, __builtin_bit_cast(int, (v)), (ctrl), 0xf, 0xf, true)))
__device__ void ph_adaln(const float* x, const float* g, const float* mod_shift  , const float* mod_scale, bf16* h, int bid, int nb) {
    const int lane = ltid() & 63, w = __builtin_amdgcn_readfirstlane(ltid() >> 6);
    for (int t0 = (bid * 8 + w) * 4; t0 < MT; t0 += nb * 8 * 4) {
        const int b = t0 >> 11;
        f32x4 v[4][4]; float ss[4];
#pragma unroll
        for (int r = 0; r < 4; ++r) {
            const float* xr = x + (size_t)(t0 + r) * DM;
#pragma unroll
            for (int i = 0; i < 4; ++i) v[r][i] = *(const f32x4*)(xr + i * 256 + lane * 4);
        }
#pragma unroll
        for (int r = 0; r < 4; ++r) {
            float s = 0.f;
#pragma unroll
            for (int i = 0; i < 4; ++i) s += v[r][i][0] * v[r][i][0] + v[r][i][1] * v[r][i][1] + v[r][i][2] * v[r][i][2] + v[r][i][3] * v[r][i][3];
            s = DPP_ADD0(s, 0xB1); s = DPP_ADD0(s, 0x4E); s = DPP_ADD0(s, 0x124); s = DPP_ADD0(s, 0x128);
            { auto q = __builtin_amdgcn_permlane16_swap(__float_as_uint(s), __float_as_uint(s), false, false); s = __uint_as_float(q[0]) + __uint_as_float(q[1]); }
            { auto q = __builtin_amdgcn_permlane32_swap(__float_as_uint(s), __float_as_uint(s), false, false); s = __uint_as_float(q[0]) + __uint_as_float(q[1]); }
            ss[r] = rsqrtf(s * (1.0f / DM) + EPS);
        }
#pragma unroll
        for (int i = 0; i < 4; ++i) {
            const int c = i * 256 + lane * 4;
            const f32x4 gg = *(const f32x4*)(g + c), sc = *(const f32x4*)(mod_scale + (size_t)b * 6144 + c), sh = *(const f32x4*)(mod_shift + (size_t)b * 6144 + c);
            float a[4];
#pragma unroll
            for (int e = 0; e < 4; ++e) a[e] = gg[e] * (1.0f + sc[e]);
#pragma unroll
            for (int r = 0; r < 4; ++r) {
                float y[4];
#pragma unroll
                for (int e = 0; e < 4; ++e) y[e] = v[r][i][e] * ss[r] * a[e] + sh[e];
                u32x2 o; o.x = pk2(y[0], y[1]); o.y = pk2(y[2], y[3]);
                __builtin_nontemporal_store(o, (u32x2*)(h + (size_t)(t0 + r) * DM + c));
            }
        }
    }
}

namespace pg8 {
#define PG8_LAS __attribute__((address_space(3)))
typedef unsigned short bf16_t;
typedef short bf16x8 __attribute__((ext_vector_type(8)));
constexpr int BM = 256, BK = 64, HALF = 128, HTB = HALF * BK * 2  , STAGE_BYTES = 8 * HTB, NXCD = 8, WGM = 8;

__host__ __device__ __forceinline__ int lds_byte(int r, int c) { const int st = (r >> 4) * 2 + (c >> 5), rr = r & 15, cc = c & 31, ob = rr * 64 + cc * 2; return st * 1024 + (ob ^ (((ob >> 9) & 1) << 5)); }
__host__ __device__ __forceinline__ void stage_rc(int b, int& R, int& C) { const int st = b / 1024, sb = b % 1024, swz = sb ^ (((sb >> 9) & 1) << 5); R = (st >> 1) * 16 + swz / 64; C = (st & 1) * 32 + (swz % 64) / 2; }
__host__ __device__ __forceinline__ int perm32(int rho) { const int n = rho >> 4, i = rho & 15; return 8 * (i >> 2) + 4 * n + (i & 3); }

struct Unit { int pm, pn; };
struct Gemm { const bf16_t* A; const bf16_t* Bt; int M, N, K; };

struct StaticOrder {
    int nM, nN, nwg, G, c;
    __host__ __device__ void init(int M, int N, int G_, int c_) { nM = M / BM; nN = N / BM; nwg = nM * nN; G = G_; c = c_; }
    __host__ __device__ bool next(int i, Unit& u) const {
        const long L = (long)i * G + c; if (L >= nwg) return false;
        int wgid = (int)L; { const int q = nwg / NXCD, r = nwg % NXCD, xcd = wgid % NXCD, off = wgid / NXCD; wgid = (xcd < r ? xcd * (q + 1) : r * (q + 1) + (xcd - r) * q) + off; }
        const int nig = WGM * nN, gid = wgid / nig, fm = gid * WGM, gsz = (nM - fm) < WGM ? (nM - fm) : WGM;
        u.pm = fm + ((wgid % nig) % gsz); u.pn = (wgid % nig) / gsz; return true;
    }
    __device__ __forceinline__ void a_ready(const Unit&) const {}
    __device__ __forceinline__ void done(const Unit&) const {}
};

__device__ __forceinline__ unsigned cvt_pk_bf16(float lo, float hi) { unsigned r; asm volatile("v_cvt_pk_bf16_f32 %0, %1, %2" : "=v"(r) : "v"(lo), "v"(hi)); return r; }

struct EpiStore {
    static constexpr bool PERM = true, AFTER_DRAIN = false;
    bf16_t* O; int ldc;
    __device__ __forceinline__ void operator()(const f32x4 (&acc)[2][2][4][2], const Unit& u, int wr, int wc, int fr_, int fq_) const {
        int fr = fr_, fq = fq_; asm volatile("" : "+v"(fr), "+v"(fq));
        const int row0 = u.pm * BM + wr * 64 + fr, col0 = u.pn * BM + wc * 32 + 8 * fq;
#pragma unroll
        for (int ai = 0; ai < 2; ++ai)
#pragma unroll
            for (int m = 0; m < 4; ++m) { bf16_t* rowp = O + (size_t)(row0 + ai * HALF + m * 16) * ldc + col0;
#pragma unroll
                for (int bj = 0; bj < 2; ++bj) { const f32x4 v0 = acc[ai][bj][m][0], v1 = acc[ai][bj][m][1];
                    u32x4 w; w.x = cvt_pk_bf16(v0[0], v0[1]); w.y = cvt_pk_bf16(v0[2], v0[3]); w.z = cvt_pk_bf16(v1[0], v1[1]); w.w = cvt_pk_bf16(v1[2], v1[3]);
                    *(u32x4*)(rowp + bj * HALF) = w; } }
    }
};
struct EpiQKV {
    static constexpr bool PERM = true, AFTER_DRAIN = false;
    bf16_t* O; int ldc; const float* rope; int layer;
    const float* gq0; const float* gk0;
    const float* gq1; const float* gk1;
    float* kmean;
    __device__ __forceinline__ void operator()(const f32x4 (&acc)[2][2][4][2], const Unit& u, int wr, int wc, int fr_, int fq_) const {
        int fr = fr_, fq = fq_; asm volatile("" : "+v"(fr), "+v"(fq));
        const int hg = 4 * u.pn + wc;
        const float* gain = nullptr; bool km = false;
        if (layer == 0) { if (hg < 8) gain = gq0; else if (hg < 10) gain = gk0; }
        else { if (hg < 8) gain = gq0; else if (hg < 16) gain = gk0; else if (hg >= 24 && hg < 32) gain = gq1; else if (hg >= 32 && hg < 40) { gain = gk1; km = true; } }
        const int row0 = u.pm * BM + wr * 64 + fr, col0 = 64 * hg + 8 * fq;
        float g0[8], g1[8], cs0[8], cs1[8];
#pragma unroll
        for (int e = 0; e < 8; ++e) { g0[e] = gain ? gain[8 * fq + e] : 1.f; g1[e] = gain ? gain[32 + 8 * fq + e] : 1.f; cs0[e] = 0.f; cs1[e] = 0.f; }
#pragma unroll
        for (int ai = 0; ai < 2; ++ai)
#pragma unroll
            for (int m = 0; m < 4; ++m) {
                const int row = row0 + ai * HALF + m * 16;
                float v0[8], v1[8];
#pragma unroll
                for (int e = 0; e < 4; ++e) { v0[e] = acc[ai][0][m][0][e]; v0[4 + e] = acc[ai][0][m][1][e]; v1[e] = acc[ai][1][m][0][e]; v1[4 + e] = acc[ai][1][m][1][e]; }
                if (gain) {
                    float ss = 0.f;
#pragma unroll
                    for (int e = 0; e < 8; ++e) ss += v0[e] * v0[e] + v1[e] * v1[e];
                    ss = rows_sum(ss);
                    const float r = rsqrtf(ss * (1.0f / 64.0f) + 1e-6f);
                    const float* rp = rope + ((size_t)(row & 2047) * 32 + 8 * fq) * 2;
                    const f32x4 t0 = *(const f32x4*)(rp), t1 = *(const f32x4*)(rp + 4), t2 = *(const f32x4*)(rp + 8), t3 = *(const f32x4*)(rp + 12);
                    const float cs[8] = {t0[0], t0[2], t1[0], t1[2], t2[0], t2[2], t3[0], t3[2]}, sn[8] = {t0[1], t0[3], t1[1], t1[3], t2[1], t2[3], t3[1], t3[3]};
#pragma unroll
                    for (int e = 0; e < 8; ++e) { const float y0 = v0[e] * r * g0[e], y1 = v1[e] * r * g1[e]; v0[e] = y0 * cs[e] - y1 * sn[e]; v1[e] = y1 * cs[e] + y0 * sn[e]; }
                }
                u32x4 w0, w1;
                w0.x = cvt_pk_bf16(v0[0], v0[1]); w0.y = cvt_pk_bf16(v0[2], v0[3]); w0.z = cvt_pk_bf16(v0[4], v0[5]); w0.w = cvt_pk_bf16(v0[6], v0[7]);
                w1.x = cvt_pk_bf16(v1[0], v1[1]); w1.y = cvt_pk_bf16(v1[2], v1[3]); w1.z = cvt_pk_bf16(v1[4], v1[5]); w1.w = cvt_pk_bf16(v1[6], v1[7]);
                bf16_t* rowp = O + (size_t)row * ldc + col0;
                *(u32x4*)(rowp) = w0; *(u32x4*)(rowp + 32) = w1;
                if (km) {
#pragma unroll
                    for (int e = 0; e < 8; ++e) { cs0[e] += v0[e]; cs1[e] += v1[e]; }
                }
            }
        if (km) {
#pragma unroll
            for (int e = 0; e < 8; ++e) {
                cs0[e] = row16_sum(cs0[e]); cs1[e] = row16_sum(cs1[e]);
            }
            if (fr == 0) {
                float* kp = kmean + ((size_t)((u.pm >> 3) * 8 + (hg - 32)) * 8 + (u.pm & 7)) * 64 + 8 * fq;
#pragma unroll
                for (int e = 0; e < 8; ++e) { atomicAdd(kp + e, cs0[e] * (1.0f / 256.0f)); atomicAdd(kp + 32 + e, cs1[e] * (1.0f / 256.0f)); }
            }
        }
    }
};
struct EpiResid {
    static constexpr bool PERM = true, AFTER_DRAIN = false;
    const float* xin; float* xout; const float* gate;
    __device__ __forceinline__ void operator()(const f32x4 (&acc)[2][2][4][2], const Unit& u, int wr, int wc, int fr_, int fq_) const {
        int fr = fr_, fq = fq_; asm volatile("" : "+v"(fr), "+v"(fq));
        const int row0 = u.pm * BM + wr * 64 + fr, col0 = u.pn * BM + wc * 32 + 8 * fq;
#pragma unroll
        for (int ai = 0; ai < 2; ++ai)
#pragma unroll
            for (int m = 0; m < 4; ++m) { const int row = row0 + ai * HALF + m * 16; const float* gp = gate + (size_t)(row >> 11) * 6144 + col0;
                const float* xi = xin + (size_t)row * 1024 + col0; float* xo = xout + (size_t)row * 1024 + col0;
#pragma unroll
                for (int bj = 0; bj < 2; ++bj)
#pragma unroll
                    for (int n = 0; n < 2; ++n) { const f32x4 a = acc[ai][bj][m][n], x = *(const f32x4*)(xi + bj * HALF + 4 * n), g = *(const f32x4*)(gp + bj * HALF + 4 * n);
                        f32x4 o; o[0] = x[0] + g[0] * a[0]; o[1] = x[1] + g[1] * a[1]; o[2] = x[2] + g[2] * a[2]; o[3] = x[3] + g[3] * a[3];
                        *(f32x4*)(xo + bj * HALF + 4 * n) = o; } }
    }
};
template <class Epi, class Sched, bool ALIGN_EPI = false, bool SP2 = false>
__device__ __forceinline__ void gemm_phase(PG8_LAS unsigned char* lds, const Gemm g, const Sched& S, const Epi& E) {
    const int tid = ltid(), wid = __builtin_amdgcn_readfirstlane(tid >> 6), lane = tid & 63, wr = wid >> 2, wc = wid & 3, fr = lane & 15, fq = lane >> 4;
    const int K = g.K, nt = K / BK;
    unsigned voffA[2], voffB[2];
#pragma unroll
    for (int i = 0; i < 2; ++i) { int R, C; stage_rc(tid * 16 + i * 8192, R, C); const int Rb = Epi::PERM ? ((R & ~31) + perm32(R & 31)) : R;
        voffA[i] = (unsigned)(R * K + C) * 2u; voffB[i] = (unsigned)(Rb * K + C) * 2u; }
    const size_t kstep = (size_t)(BK * 2);
    const size_t hstep = (size_t)HALF * K * 2;
    const size_t tstep = 2 * hstep;
    const unsigned ldsw = (unsigned)wid * 1024u;
    const int aoff = lds_byte(wr * 64 + fr, fq * 8), boff = lds_byte(wc * 32 + fr, fq * 8);
#define PG8_SA(b, h) (((b) * 2 + (h)) * HTB)
#define PG8_SB(b, h) ((4 + (b) * 2 + (h)) * HTB)
#define PG8_STAGE(bufoff, gbase, voff) do { _Pragma("unroll") for (int _i = 0; _i < 2; ++_i) \
        __builtin_amdgcn_global_load_lds((const unsigned*)((const char*)(gbase) + (voff)[_i]), (PG8_LAS unsigned*)(lds + (bufoff) + ldsw + _i * 8192), 16, 0, 0); } while (0)
#define PG8_LDA(dst, b, h) do { _Pragma("unroll") for (int m = 0; m < 4; ++m) _Pragma("unroll") for (int k = 0; k < 2; ++k) dst[m][k] = *(const PG8_LAS bf16x8*)(lds + PG8_SA(b, h) + aoff + m * 2048 + k * 1024); } while (0)
#define PG8_LDB(dst, b, h) do { _Pragma("unroll") for (int n = 0; n < 2; ++n) _Pragma("unroll") for (int k = 0; k < 2; ++k) dst[n][k] = *(const PG8_LAS bf16x8*)(lds + PG8_SB(b, h) + boff + n * 2048 + k * 1024); } while (0)
#define PG8_MMA(ai, bj, At, Bt) do { __builtin_amdgcn_s_setprio(1); _Pragma("unroll") for (int m = 0; m < 4; ++m) _Pragma("unroll") for (int n = 0; n < 2; ++n) _Pragma("unroll") for (int k = 0; k < 2; ++k) \
        acc[ai][bj][m][n] = __builtin_amdgcn_mfma_f32_16x16x32_bf16(Bt[n][k], At[m][k], acc[ai][bj][m][n], 0, 0, 0); __builtin_amdgcn_s_setprio(0); } while (0)
#define PG8_WAIT_V(n) asm volatile("s_waitcnt vmcnt(" #n ")" ::: "memory")
#define PG8_WAIT_L(n) asm volatile("s_waitcnt lgkmcnt(" #n ")" ::: "memory")
#define PG8_BAR __builtin_amdgcn_s_barrier()
#define PG8_SCHED __builtin_amdgcn_sched_barrier(0)
    Unit cur, nxt; int ui = 0;
    if (!S.next(0, cur)) return;
    f32x4 acc[2][2][4][2];
#pragma unroll
    for (int a = 0; a < 2; ++a)
#pragma unroll
        for (int b = 0; b < 2; ++b)
#pragma unroll
            for (int m = 0; m < 4; ++m)
#pragma unroll
                for (int n = 0; n < 2; ++n) acc[a][b][m][n] = (f32x4){0.f, 0.f, 0.f, 0.f};
    bf16x8 At[4][2], B0[2][2], B1[2][2];
    const char* cA = (const char*)g.A + (size_t)cur.pm * tstep; const char* cB = (const char*)g.Bt + (size_t)cur.pn * tstep;
    S.a_ready(cur);
    if constexpr (SP2) {
        PG8_STAGE(PG8_SB(0, 0), cB, voffB); PG8_STAGE(PG8_SB(0, 1), cB + hstep, voffB); PG8_STAGE(PG8_SA(0, 0), cA, voffA); PG8_STAGE(PG8_SA(0, 1), cA + hstep, voffA);
        if (wr == 1) PG8_BAR;
        PG8_WAIT_V(2); PG8_BAR;
        PG8_STAGE(PG8_SB(1, 0), cB + kstep, voffB); PG8_STAGE(PG8_SA(1, 0), cA + kstep, voffA); PG8_STAGE(PG8_SB(1, 1), cB + hstep + kstep, voffB);
        PG8_WAIT_V(6); PG8_BAR;
    } else {
        PG8_STAGE(PG8_SB(0, 0), cB, voffB); PG8_STAGE(PG8_SA(0, 0), cA, voffA); PG8_STAGE(PG8_SB(0, 1), cB + hstep, voffB); PG8_STAGE(PG8_SA(0, 1), cA + hstep, voffA);
        if (wr == 1) PG8_BAR;
        PG8_WAIT_V(4); PG8_BAR;
        PG8_STAGE(PG8_SB(1, 0), cB + kstep, voffB); PG8_STAGE(PG8_SA(1, 0), cA + kstep, voffA); PG8_STAGE(PG8_SB(1, 1), cB + hstep + kstep, voffB);
        PG8_WAIT_V(6); PG8_BAR;
    }
    for (;;) {
        const bool has_next = S.next(ui + 1, nxt);
        const char* nA = has_next ? (const char*)g.A + (size_t)nxt.pm * tstep : cA; const char* nB = has_next ? (const char*)g.Bt + (size_t)nxt.pn * tstep : cB;
        for (int t = 0; t < nt; t += 2) {
            const bool last = (t == nt - 2);
            const char* a1 = cA + (size_t)(t + 1) * kstep;
            const char* a2 = last ? nA : cA + (size_t)(t + 2) * kstep; const char* b2 = last ? nB : cB + (size_t)(t + 2) * kstep;
            const char* a3 = a2 + kstep; const char* b3 = b2 + kstep;
            if (last && has_next) S.a_ready(nxt);
            if constexpr (SP2) {
            PG8_LDB(B0, 0, 0); PG8_LDB(B1, 0, 1); PG8_SCHED; PG8_LDA(At, 0, 0); PG8_STAGE(PG8_SA(1, 1), a1 + hstep, voffA);
            PG8_WAIT_V(8); PG8_WAIT_L(0); PG8_BAR; PG8_MMA(0, 0, At, B0); PG8_MMA(0, 1, At, B1); PG8_BAR; PG8_SCHED;
            PG8_LDA(At, 0, 1); PG8_STAGE(PG8_SB(0, 0), b2, voffB); PG8_STAGE(PG8_SB(0, 1), b2 + hstep, voffB); PG8_STAGE(PG8_SA(0, 0), a2, voffA);
            PG8_WAIT_V(8); PG8_WAIT_L(0); PG8_BAR; PG8_MMA(1, 0, At, B0); PG8_MMA(1, 1, At, B1); PG8_BAR; PG8_SCHED;
            PG8_LDB(B0, 1, 0); PG8_LDB(B1, 1, 1); PG8_SCHED; PG8_LDA(At, 1, 0); PG8_STAGE(PG8_SA(0, 1), a2 + hstep, voffA);
            PG8_WAIT_V(8); PG8_WAIT_L(0); PG8_BAR; PG8_MMA(0, 0, At, B0); PG8_MMA(0, 1, At, B1); PG8_BAR; PG8_SCHED;
            PG8_LDA(At, 1, 1); PG8_STAGE(PG8_SB(1, 0), b3, voffB); PG8_STAGE(PG8_SB(1, 1), b3 + hstep, voffB); PG8_STAGE(PG8_SA(1, 0), a3, voffA);
            PG8_WAIT_V(8); PG8_WAIT_L(0); PG8_BAR; PG8_MMA(1, 0, At, B0); PG8_MMA(1, 1, At, B1); PG8_BAR; PG8_SCHED;
            } else {
            PG8_LDB(B0, 0, 0); PG8_SCHED; PG8_LDA(At, 0, 0); PG8_STAGE(PG8_SA(1, 1), a1 + hstep, voffA);
            PG8_WAIT_L(8); PG8_BAR; PG8_WAIT_L(0); PG8_MMA(0, 0, At, B0); PG8_BAR; PG8_SCHED;
            PG8_LDB(B1, 0, 1); PG8_STAGE(PG8_SB(0, 0), b2, voffB);
            PG8_BAR; PG8_WAIT_L(0); PG8_MMA(0, 1, At, B1); PG8_BAR;
            PG8_LDA(At, 0, 1); PG8_STAGE(PG8_SA(0, 0), a2, voffA);
            PG8_BAR; PG8_WAIT_L(0); PG8_MMA(1, 0, At, B0); PG8_BAR; PG8_SCHED;
            PG8_STAGE(PG8_SB(0, 1), b2 + hstep, voffB);
            PG8_WAIT_V(6); PG8_BAR; PG8_MMA(1, 1, At, B1); PG8_BAR;
            PG8_LDB(B0, 1, 0); PG8_SCHED; PG8_LDA(At, 1, 0); PG8_STAGE(PG8_SA(0, 1), a2 + hstep, voffA);
            PG8_WAIT_L(8); PG8_BAR; PG8_WAIT_L(0); PG8_MMA(0, 0, At, B0); PG8_BAR; PG8_SCHED;
            PG8_LDB(B1, 1, 1); PG8_STAGE(PG8_SB(1, 0), b3, voffB);
            PG8_BAR; PG8_WAIT_L(0); PG8_MMA(0, 1, At, B1); PG8_BAR;
            PG8_LDA(At, 1, 1); PG8_STAGE(PG8_SA(1, 0), a3, voffA);
            PG8_BAR; PG8_WAIT_L(0); PG8_MMA(1, 0, At, B0); PG8_BAR; PG8_SCHED;
            PG8_STAGE(PG8_SB(1, 1), b3 + hstep, voffB);
            PG8_WAIT_V(6); PG8_BAR; PG8_MMA(1, 1, At, B1); PG8_BAR;
            }
        }
        if constexpr (ALIGN_EPI) { if (wr == 0) PG8_BAR; }
        if constexpr (!Epi::AFTER_DRAIN) { E(acc, cur, wr, wc, fr, fq); S.done(cur); }
        if (!has_next) break;
#pragma unroll
        for (int a = 0; a < 2; ++a)
#pragma unroll
            for (int b = 0; b < 2; ++b)
#pragma unroll
                for (int m = 0; m < 4; ++m)
#pragma unroll
                    for (int n = 0; n < 2; ++n) acc[a][b][m][n] = (f32x4){0.f, 0.f, 0.f, 0.f};
        cur = nxt; cA = nA; cB = nB; ++ui;
        if constexpr (ALIGN_EPI) { if (wr == 1) PG8_BAR; }
    }
    PG8_WAIT_V(0);
    if constexpr (!ALIGN_EPI) { if (wr == 0) PG8_BAR; }
    PG8_BAR;
    if constexpr (Epi::AFTER_DRAIN) { E.fused(acc, cur, wr, wc, fr, fq, lds, wid, lane); S.done(cur); }
#undef PG8_SA
#undef PG8_SB
#undef PG8_STAGE
#undef PG8_LDA
#undef PG8_LDB
#undef PG8_MMA
#undef PG8_WAIT_V
#undef PG8_WAIT_L
#undef PG8_BAR
#undef PG8_SCHED
}
}

typedef float f32x16 __attribute__((ext_vector_type(16)));
typedef short s16x4 __attribute__((ext_vector_type(4)));
typedef short v4i16_t __attribute__((ext_vector_type(4)));
typedef float f32x2_t __attribute__((ext_vector_type(2)));
typedef __bf16 bf16x2_t __attribute__((ext_vector_type(2)));
#define LAS __attribute__((address_space(3)))
constexpr int VROW = 144, VBUF = 32 * VROW;
constexpr int VROWV = 192, VBUFV = 32 * VROWV;
constexpr float L2E = 1.4426950408889634f, LN2 = 0.6931471805599453f;
constexpr float SC2 = 0.125f * L2E;

__device__ __forceinline__ int crow(int r, int hi) { return (r & 3) + 8 * (r >> 2) + 4 * hi; }
__device__ __forceinline__ unsigned cvtpk(float lo, float hi) { f32x2_t v = {lo, hi}; bf16x2_t b = __builtin_convertvector(v, bf16x2_t); return __builtin_bit_cast(unsigned, b); }
__device__ __forceinline__ float xhalf(float v, int hi) {
    auto r = __builtin_amdgcn_permlane32_swap(__float_as_uint(v), __float_as_uint(v), false, false);
    return __uint_as_float(hi ? r[0] : r[1]);
}
__device__ __forceinline__ s16x4 vtr(const LAS unsigned char* p) { return __builtin_bit_cast(s16x4, __builtin_amdgcn_ds_read_tr16_b64_v4i16((LAS v4i16_t*)p)); }

struct KVRegs { u32x4 k[4]; u32x4 v[4]; };
__device__ __forceinline__ void load_kv(KVRegs& R, const bf16* base, int kp0, int kst, int kcol, int vcol, int lane) {
#pragma unroll
    for (int j = 0; j < 4; ++j) {
        const int pos = kp0 + kst * (8 * j + (lane >> 3));
        const int pc = pos < SQ - 1 ? pos : SQ - 1;
        const bf16* rp = base + (size_t)pc * QKV_LD + (lane & 7) * 8;
        R.k[j] = *(const u32x4*)(rp + kcol); R.v[j] = *(const u32x4*)(rp + vcol);
    }
}
__device__ __forceinline__ void kv_stage(const KVRegs& R, LAS unsigned char* klds, LAS unsigned char* vlds, int lane) {
#pragma unroll
    for (int j = 0; j < 4; ++j) { const int r_ = 8 * j + (lane >> 3), c_ = (lane & 7) * 16; *(LAS u32x4*)(klds + r_ * VROW + c_) = R.k[j]; *(LAS u32x4*)(vlds + r_ * VROWV + c_) = R.v[j]; }
}
__device__ __forceinline__ f32x16 qk_tile(const LAS unsigned char* klds, const bf16x8 (&qf)[4], int r32, int hi) {
    f32x16 s = {0.f, 0.f, 0.f, 0.f, 0.f, 0.f, 0.f, 0.f, 0.f, 0.f, 0.f, 0.f, 0.f, 0.f, 0.f, 0.f};
#pragma unroll
    for (int k = 0; k < 4; ++k) { const bf16x8 kf = *(const LAS bf16x8*)(klds + r32 * VROW + (2 * k + hi) * 16); s = __builtin_amdgcn_mfma_f32_32x32x16_bf16(kf, qf[k], s, 0, 0, 0); }
    return s;
}
__device__ __forceinline__ void pv_tile(f32x16 (&o)[2], const f32x16& p, const LAS unsigned char* vlds, int lane) {
    const int g = lane >> 4, i = lane & 15, h = lane >> 5;
    const LAS unsigned char* vb = vlds + (4 * h + (i >> 2)) * VROWV + (16 * (g & 1) + 4 * (i & 3)) * 2;
#pragma unroll
    for (int s = 0; s < 2; ++s) {
        u32x4 pw; pw.x = cvtpk(p[8 * s], p[8 * s + 1]); pw.y = cvtpk(p[8 * s + 2], p[8 * s + 3]); pw.z = cvtpk(p[8 * s + 4], p[8 * s + 5]); pw.w = cvtpk(p[8 * s + 6], p[8 * s + 7]);
        const bf16x8 pb = __builtin_bit_cast(bf16x8, pw);
#pragma unroll
        for (int df = 0; df < 2; ++df) {
            const s16x4 lo = vtr(vb + (16 * s) * VROWV + df * 64), hh = vtr(vb + (16 * s + 8) * VROWV + df * 64);
            const bf16x8 va = (bf16x8){lo[0], lo[1], lo[2], lo[3], hh[0], hh[1], hh[2], hh[3]};
            o[df] = __builtin_amdgcn_mfma_f32_32x32x16_bf16(va, pb, o[df], 0, 0, 0);
        }
    }
}
__device__ __forceinline__ void load_q(bf16x8 (&qf)[4], const bf16* base, int qpos, int qcol, int hi) {
    const bf16* rp = base + (size_t)qpos * QKV_LD + qcol + 8 * hi;
#pragma unroll
    for (int k = 0; k < 4; ++k) qf[k] = *(const bf16x8*)(rp + 16 * k);
}
__device__ __forceinline__ void store_o(bf16* yrow, const f32x16 (&o)[2], float inv, int hi) {
#pragma unroll
    for (int df = 0; df < 2; ++df)
#pragma unroll
        for (int g = 0; g < 4; ++g) {
            u32x2 w; w.x = cvtpk(o[df][4 * g] * inv, o[df][4 * g + 1] * inv); w.y = cvtpk(o[df][4 * g + 2] * inv, o[df][4 * g + 3] * inv);
            *(u32x2*)(yrow + 32 * df + 8 * g + 4 * hi) = w;
        }
}
__device__ __forceinline__ void osm_tile(f32x16& s, float& m, float& l, f32x16 (&o)[2]) {
    float mx = s[0];
#pragma unroll
    for (int r = 1; r < 16; ++r) mx = fmaxf(mx, s[r]);
    { auto rr = __builtin_amdgcn_permlane32_swap(__float_as_uint(mx), __float_as_uint(mx), false, false); mx = fmaxf(__uint_as_float(rr[0]), __uint_as_float(rr[1])); }
    const float mn = fmaxf(m, mx);
    const float ms = (mn == -INFINITY) ? 0.f : mn;
    const float alpha = __builtin_amdgcn_exp2f((m - ms) * SC2);
    const float mc = ms * SC2;
    float ps = 0.f;
#pragma unroll
    for (int r = 0; r < 16; ++r) { s[r] = __builtin_amdgcn_exp2f(s[r] * SC2 - mc); ps += s[r]; }
    l = l * alpha + ps; m = mn;
    if (!__all(alpha == 1.0f)) {
#pragma unroll
        for (int df = 0; df < 2; ++df)
#pragma unroll
            for (int r = 0; r < 16; ++r) o[df][r] *= alpha;
    }
}
__device__ __forceinline__ void osm_tile2(f32x16& s0, f32x16& s1, float& m, float& l, f32x16 (&o)[2]) {
    float mx = fmaxf(s0[0], s1[0]);
#pragma unroll
    for (int r = 1; r < 16; ++r) mx = fmaxf(mx, fmaxf(s0[r], s1[r]));
    { auto rr = __builtin_amdgcn_permlane32_swap(__float_as_uint(mx), __float_as_uint(mx), false, false); mx = fmaxf(__uint_as_float(rr[0]), __uint_as_float(rr[1])); }
    const float mn = fmaxf(m, mx);
    const float ms = (mn == -INFINITY) ? 0.f : mn;
    const float alpha = __builtin_amdgcn_exp2f((m - ms) * SC2);
    const float mc = ms * SC2;
    float ps0 = 0.f, ps1 = 0.f;
#pragma unroll
    for (int r = 0; r < 16; ++r) { s0[r] = __builtin_amdgcn_exp2f(s0[r] * SC2 - mc); ps0 += s0[r]; s1[r] = __builtin_amdgcn_exp2f(s1[r] * SC2 - mc); ps1 += s1[r]; }
    l = l * alpha + (ps0 + ps1); m = mn;
    if (!__all(alpha == 1.0f)) {
#pragma unroll
        for (int df = 0; df < 2; ++df)
#pragma unroll
            for (int r = 0; r < 16; ++r) o[df][r] *= alpha;
    }
}
#define ZERO16 {0.f, 0.f, 0.f, 0.f, 0.f, 0.f, 0.f, 0.f, 0.f, 0.f, 0.f, 0.f, 0.f, 0.f, 0.f, 0.f}

struct AttnCtx {
    const bf16* base; int kcol, vcol, r32, hi, lane; LAS unsigned char* vlds; LAS unsigned char* klds; bf16x8 qf[4]; f32x16 o[2];
};
#define ATTN_STEP(SC, SL, T) { \
        if (SYNC) __builtin_amdgcn_s_barrier(); \
        { int kp_, ks_; const int tl_ = (T) + 2 < nt ? (T) + 2 : nt - 1; mx.pos(tl_, kp_, ks_); load_kv(SL, c.base, kp_, ks_, c.kcol, c.vcol, c.lane); } \
        kv_stage(SC, c.klds, c.vlds, c.lane); f32x16 s_ = qk_tile(c.klds, c.qf, c.r32, c.hi); \
        const bool stop_ = mx.process((T), s_, c); pv_tile(c.o, s_, c.vlds, c.lane); \
        if ((!SYNC && stop_) || (T) + 1 >= nt) break; }
template <class M, bool SYNC> __device__ __forceinline__ void attn_run(M& mx, AttnCtx& c) {
    const int nt = mx.nt;
    KVRegs S0, S1, S2;
    { int kp, ks; mx.pos(0, kp, ks); load_kv(S0, c.base, kp, ks, c.kcol, c.vcol, c.lane);
      mx.pos(1 < nt ? 1 : nt - 1, kp, ks); load_kv(S1, c.base, kp, ks, c.kcol, c.vcol, c.lane); }
    for (int t = 0;; t += 3) {
        ATTN_STEP(S0, S2, t)
        ATTN_STEP(S1, S0, t + 1)
        ATTN_STEP(S2, S1, t + 2)
    }
}
#define SH_BAR() asm volatile("s_waitcnt lgkmcnt(0)\n\ts_barrier" ::: "memory")
constexpr int SLOT_K = 64 * VROW, SLOT_BYTES = 64 * VROW + 64 * VROWV;
struct ShRegs { u32x4 a, b; };
__device__ __forceinline__ void sh_load(ShRegs& R, const bf16* base, int kp0, int kcol, int vcol, int w, int lane) {
    const int pos = kp0 + 4 * w + ((lane & 31) >> 3);
    const int pa = pos < SQ - 1 ? pos : SQ - 1, pb = pos + 32 < SQ - 1 ? pos + 32 : SQ - 1;
    const int col = ((lane >> 5) ? vcol : kcol) + (lane & 7) * 8;
    R.a = *(const u32x4*)(base + (size_t)pa * QKV_LD + col); R.b = *(const u32x4*)(base + (size_t)pb * QKV_LD + col);
}
__device__ __forceinline__ void sh_write(LAS unsigned char* slot, const ShRegs& R, int w, int lane) {
    const int row = 4 * w + ((lane & 31) >> 3);
    LAS unsigned char* p = slot + ((lane >> 5) ? SLOT_K + row * VROWV : row * VROW) + (lane & 7) * 16;
    *(LAS u32x4*)p = R.a; *(LAS u32x4*)(p + 32 * ((lane >> 5) ? VROWV : VROW)) = R.b;
}
#define SH_STEP(RW, RL, T) { \
        SH_BAR(); \
        { const int tl_ = (T) + 2 < nt ? (T) + 2 : nt - 1; sh_load(RL, c.base, mx.pos2(tl_), c.kcol, c.vcol, w, c.lane); } \
        sh_write(slots + (((T) + 1) & 1) * SLOT_BYTES, RW, w, c.lane); \
        if (mx.active2((T), w)) { LAS unsigned char* sl_ = slots + ((T) & 1) * SLOT_BYTES; \
            f32x16 s0_ = qk_tile(sl_, c.qf, c.r32, c.hi), s1_ = qk_tile(sl_ + 32 * VROW, c.qf, c.r32, c.hi); mx.process2((T), s0_, s1_, c); \
            pv_tile(c.o, s0_, sl_ + SLOT_K, c.lane); pv_tile(c.o, s1_, sl_ + SLOT_K + 32 * VROWV, c.lane); } \
        if ((T) + 1 >= nt) break; }
template <class M> __device__ __forceinline__ void attn_run_shared(M& mx, AttnCtx& c, LAS unsigned char* slots, int w) {
    const int nt = mx.nt2;
    ShRegs R0, R1, R2;
    sh_load(R0, c.base, mx.pos2(0), c.kcol, c.vcol, w, c.lane);
    sh_load(R1, c.base, mx.pos2(1 < nt ? 1 : nt - 1), c.kcol, c.vcol, w, c.lane);
    SH_BAR();
    sh_write(slots, R0, w, c.lane);
    for (int t = 0;; t += 3) {
        SH_STEP(R1, R2, t)
        SH_STEP(R2, R0, t + 1)
        SH_STEP(R0, R1, t + 2)
    }
}
struct MixA {
    int nt, k00, qpos; float m, l;
    __device__ __forceinline__ void pos(int idx, int& kp0, int& kst) const { kp0 = k00 + 32 * idx; kst = 1; }
    __device__ __forceinline__ bool process(int idx, f32x16& s, AttnCtx& c) {
        const int k0 = k00 + 32 * idx;
#pragma unroll
        for (int r = 0; r < 16; ++r) { const int dist = qpos - (k0 + crow(r, c.hi)); if (dist < 0 || dist > 127) s[r] = -INFINITY; }
        osm_tile(s, m, l, c.o); return false;
    }
};
__device__ void attn_A(const bf16* base, int hq, int q0, float sink, bf16* ybase, LAS unsigned char* vlds, int lane) {
    AttnCtx c; c.base = base; c.r32 = lane & 31; c.hi = lane >> 5; c.lane = lane; c.vlds = vlds; c.klds = vlds + VBUFV; c.kcol = 512 + (hq >> 2) * 64; c.vcol = 640 + (hq >> 2) * 64;
    c.o[0] = (f32x16)ZERO16; c.o[1] = (f32x16)ZERO16;
    MixA mx; mx.qpos = q0 + c.r32; mx.k00 = q0 - 128 > 0 ? q0 - 128 : 0; mx.nt = 5; mx.m = -INFINITY; mx.l = 0.f;
    load_q(c.qf, base, mx.qpos, hq * 64, c.hi);
    attn_run<MixA, true>(mx, c);
    float l = mx.l + xhalf(mx.l, c.hi);
    l += __builtin_amdgcn_exp2f(sink * L2E - mx.m * SC2);
    store_o(ybase + (size_t)mx.qpos * DM + hq * 64, c.o, 1.0f / l, c.hi);
}
struct MixB {
    int nt, q0, qpos; float carry;
    __device__ __forceinline__ void pos(int idx, int& kp0, int& kst) const { kp0 = q0 - 32 * idx; kst = 1; }
    __device__ __forceinline__ bool process(int idx, f32x16& s, AttnCtx& c) {
        const int k0 = q0 - 32 * idx, hi = c.hi;
        float lk[16], G[4], Gp[4];
#pragma unroll
        for (int r = 0; r < 16; ++r) {
            const float z = s[r] * 0.125f;
            const bool valid = (k0 + crow(r, hi)) < qpos;
            const float sp = fmaxf(z, 0.f) + LN2 * __builtin_amdgcn_logf(1.0f + __builtin_amdgcn_exp2f(-fabsf(z) * L2E));
            lk[r] = valid ? -sp : 0.f;
            s[r] = valid ? (z - sp) : -INFINITY;
        }
#pragma unroll
        for (int g = 0; g < 4; ++g) { G[g] = (lk[4 * g] + lk[4 * g + 1]) + (lk[4 * g + 2] + lk[4 * g + 3]); Gp[g] = xhalf(G[g], hi); }
        float above = carry;
#pragma unroll
        for (int g = 3; g >= 0; --g) {
            float off = above + (hi == 0 ? Gp[g] : 0.f);
            s[4 * g + 3] = __builtin_amdgcn_exp2f((s[4 * g + 3] + off) * L2E); off += lk[4 * g + 3];
            s[4 * g + 2] = __builtin_amdgcn_exp2f((s[4 * g + 2] + off) * L2E); off += lk[4 * g + 2];
            s[4 * g + 1] = __builtin_amdgcn_exp2f((s[4 * g + 1] + off) * L2E); off += lk[4 * g + 1];
            s[4 * g + 0] = __builtin_amdgcn_exp2f((s[4 * g + 0] + off) * L2E);
            above += G[g] + Gp[g];
        }
        carry = above;
        return __all(carry < -40.0f) != 0;
    }
};
__device__ void attn_B(const bf16* base, int h, int q0, bf16* ybase, LAS unsigned char* vlds, int lane) {
    AttnCtx c; c.base = base; c.r32 = lane & 31; c.hi = lane >> 5; c.lane = lane; c.vlds = vlds; c.klds = vlds + VBUFV; c.kcol = 1280 + h * 64; c.vcol = 1792 + h * 64;
    c.o[0] = (f32x16)ZERO16; c.o[1] = (f32x16)ZERO16;
    MixB mx; mx.q0 = q0; mx.qpos = q0 + c.r32; mx.nt = q0 / 32 + 1; mx.carry = 0.f;
    load_q(c.qf, base, mx.qpos, 768 + h * 64, c.hi);
    attn_run<MixB, false>(mx, c);
    store_o(ybase + (size_t)mx.qpos * DM + 512 + h * 64, c.o, 1.0f, c.hi);
}
struct MixCp {
    int nt, n0, r0, j1lo, qpos; float m, l;
    __device__ __forceinline__ void pos(int t, int& kp0, int& kst) const {
        if (t < n0) { kp0 = r0 + 512 * t; kst = 16; } else { kp0 = (r0 & 3) + 4 * (j1lo + 32 * (t - n0)); kst = 4; }
    }
    __device__ __forceinline__ bool process(int t, f32x16& s, AttnCtx& c) {
        int kp0, kst; pos(t, kp0, kst);
        const int win = t < n0 ? 2048 : 512;
#pragma unroll
        for (int r = 0; r < 16; ++r) { const int dist = qpos - (kp0 + kst * crow(r, c.hi)); if (dist < 0 || dist > win) s[r] = -INFINITY; }
        osm_tile(s, m, l, c.o); return false;
    }
};
struct MixC1 {
    int nt2, p0, qpos; float m, l;
    __device__ __forceinline__ int pos2(int T) const { return p0 + 64 * T; }
    __device__ __forceinline__ bool active2(int T, int w) const { return true; }
    __device__ __forceinline__ void process2(int T, f32x16& s0, f32x16& s1, AttnCtx& c) {
        const int k0 = p0 + 64 * T;
#pragma unroll
        for (int r = 0; r < 16; ++r) { const int dist = qpos - (k0 + crow(r, c.hi)); if (dist < 0 || dist > 128) s0[r] = -INFINITY; if (dist < 32 || dist > 160) s1[r] = -INFINITY; }
        osm_tile2(s0, s1, m, l, c.o);
    }
};
__device__ void attn_C(const bf16* base, int h, int r0, int g, bf16* ybase, LAS unsigned char* vlds, LAS unsigned char* xlds, int w, int lane) {
    AttnCtx c; c.base = base; c.r32 = lane & 31; c.hi = lane >> 5; c.lane = lane; c.vlds = vlds; c.klds = vlds + VBUFV; c.kcol = 512 + h * 64; c.vcol = 1024 + h * 64;
    c.o[0] = (f32x16)ZERO16; c.o[1] = (f32x16)ZERO16;
    const int qpos = r0 + 16 * (32 * g + c.r32);
    load_q(c.qf, base, qpos, h * 64, c.hi);
    MixCp mp; mp.r0 = r0; mp.qpos = qpos; mp.m = -INFINITY; mp.l = 0.f;
    mp.n0 = g + 1;
    mp.j1lo = (r0 >> 2) + 128 * g - 128 > 0 ? (r0 >> 2) + 128 * g - 128 : 0;
    mp.nt = mp.n0 + ((r0 >> 2) + 128 * g + 124 - mp.j1lo) / 32 + 1;
    attn_run<MixCp, true>(mp, c);
    MixC1 m1; m1.qpos = qpos; m1.m = mp.m; m1.l = mp.l;
    const int ra = r0 & 8;
    m1.p0 = 512 * g + ra - 128 > 0 ? 512 * g + ra - 128 : 0;
    m1.nt2 = ((512 * g + ra + 7 + 496 - m1.p0) / 32 + 2) / 2;
    attn_run_shared<MixC1>(m1, c, xlds + 64, w);
    const float l = m1.l + xhalf(m1.l, c.hi);
    store_o(ybase + (size_t)qpos * DM + h * 64, c.o, 1.0f / l, c.hi);
}
struct MixD {
    int nt, nt2, npast, own, q0, qpos; unsigned U, sel; float m, l;
    __device__ __forceinline__ int blk_of(int j) const {
        unsigned u = U; int b = 0;
#pragma unroll
        for (int i = 0; i < 7; ++i) { if (i < j) u &= u - 1u; }
        b = __builtin_ctz(u | 0x100u); return b;
    }
    __device__ __forceinline__ void pos(int t, int& kp0, int& kst) const {
        kst = 1;
        if (t < 8 * npast) kp0 = blk_of(t >> 3) * 256 + (t & 7) * 32; else kp0 = own * 256 + (t - 8 * npast) * 32;
    }
    __device__ __forceinline__ int pos2(int T) const { int kp, ks; pos(2 * T, kp, ks); return kp; }
    __device__ __forceinline__ bool active2(int T, int w) const { return T < 4 * npast || 2 * (T - 4 * npast) <= w; }
    __device__ __forceinline__ void process2(int T, f32x16& s0, f32x16& s1, AttnCtx& c) {
        if (T < 4 * npast) {
            const int blk = blk_of(T >> 2);
            if (!((sel >> blk) & 1u)) {
#pragma unroll
                for (int r = 0; r < 16; ++r) { s0[r] = -INFINITY; s1[r] = -INFINITY; }
            }
        } else {
            const int k0 = own * 256 + (T - 4 * npast) * 64;
#pragma unroll
            for (int r = 0; r < 16; ++r) { const int kk = k0 + crow(r, c.hi); if (kk > qpos) s0[r] = -INFINITY; if (kk + 32 > qpos) s1[r] = -INFINITY; }
        }
        osm_tile2(s0, s1, m, l, c.o);
    }
};
__device__ void attn_D(const bf16* base, const float* kmean  , int h, int q0, bf16* ybase, LAS unsigned char* vlds, LAS unsigned char* xlds, int lane) {
    AttnCtx c; c.base = base; c.r32 = lane & 31; c.hi = lane >> 5; c.lane = lane; c.vlds = vlds; c.klds = vlds + VBUFV; c.kcol = 2048 + h * 64; c.vcol = 2560 + h * 64;
    c.o[0] = (f32x16)ZERO16; c.o[1] = (f32x16)ZERO16;
    const int r32 = c.r32, hi = c.hi, own = q0 >> 8;
    MixD mx; mx.own = own; mx.q0 = q0; mx.qpos = q0 + r32; mx.m = -INFINITY; mx.l = 0.f;
    load_q(c.qf, base, mx.qpos, 1536 + h * 64, hi);
    unsigned sel = 0u;
    if (own > 0) {
        bf16x8 kf[4];
#pragma unroll
        for (int k = 0; k < 4; ++k) {
            u32x4 w = {0u, 0u, 0u, 0u};
            if (r32 < 8) { const float* kp = kmean + r32 * 64 + 16 * k + 8 * hi; const f32x4 a = *(const f32x4*)kp, b = *(const f32x4*)(kp + 4);
                w.x = cvtpk(a[0], a[1]); w.y = cvtpk(a[2], a[3]); w.z = cvtpk(b[0], b[1]); w.w = cvtpk(b[2], b[3]); }
            kf[k] = __builtin_bit_cast(bf16x8, w);
        }
        f32x16 gs = ZERO16;
#pragma unroll
        for (int k = 0; k < 4; ++k) gs = __builtin_amdgcn_mfma_f32_32x32x16_bf16(kf[k], c.qf[k], gs, 0, 0, 0);
        float gt[8];
#pragma unroll
        for (int r = 0; r < 4; ++r) { const float mine = gs[r], oth = xhalf(mine, hi); gt[r] = hi == 0 ? mine : oth; gt[4 + r] = hi == 0 ? oth : mine; }
        const int nsel = own < 3 ? own : 3;
        for (int rr = 0; rr < nsel; ++rr) {
            float best = -INFINITY; int bi = -1;
#pragma unroll
            for (int n = 0; n < 8; ++n) { const bool ok = n < own && !((sel >> n) & 1u) && (bi < 0 || gt[n] > best); if (ok) { best = gt[n]; bi = n; } }
            if (bi >= 0) sel |= 1u << bi;
        }
    }
    unsigned U = 0u;
#pragma unroll
    for (int n = 0; n < 8; ++n) if (__ballot((sel >> n) & 1u) != 0ull) U |= 1u << n;
    {
        volatile LAS unsigned* ux = (volatile LAS unsigned*)xlds;
        __builtin_amdgcn_s_barrier();
        if (lane == 0) ux[(q0 >> 5) & 7] = U;
        asm volatile("s_waitcnt lgkmcnt(0)" ::: "memory");
        __builtin_amdgcn_s_barrier();
        U = ux[0] | ux[1] | ux[2] | ux[3] | ux[4] | ux[5] | ux[6] | ux[7];
        U = __builtin_amdgcn_readfirstlane(U);
    }
    mx.U = U; mx.sel = sel; mx.npast = __builtin_popcount(U); mx.nt = 8 * mx.npast + 8; mx.nt2 = 4 * mx.npast + 4;
    attn_run_shared<MixD>(mx, c, xlds + 64, (q0 >> 5) & 7);
    const float l = mx.l + xhalf(mx.l, c.hi);
    store_o(ybase + (size_t)mx.qpos * DM + 512 + h * 64, c.o, 1.0f / l, hi);
}

__device__ void ph_attn0(const bf16* qkv, const float* sinks, bf16* y, LAS unsigned char* lds, int bid, int nb) {
    const int lane = ltid() & 63, w = __builtin_amdgcn_readfirstlane(ltid() >> 6);
    LAS unsigned char* vlds = lds + w * (VBUF + VBUFV);
    for (int pid = bid; pid < NB * 8; pid += nb) {
        const int b = pid >> 3, h = pid & 7;
        const bf16* base = qkv + (size_t)b * SQ * QKV_LD; bf16* ybase = y + (size_t)b * SQ * DM;
        const float sink = sinks[h];
        for (int rd = 0; rd < 8; ++rd) attn_A(base, h, (rd * 8 + w) * 32, sink, ybase, vlds, lane);
        for (int rd = 0; rd < 8; ++rd) attn_B(base, h, (rd * 8 + w) * 32, ybase, vlds, lane);
    }
}
__device__ void ph_attn1(const bf16* qkv, const float* kmean, bf16* y, LAS unsigned char* lds, int bid, int nb) {
    const int lane = ltid() & 63, w = __builtin_amdgcn_readfirstlane(ltid() >> 6);
    LAS unsigned char* vlds = lds + w * (VBUF + VBUFV);
    for (int pid = bid; pid < NB * 8; pid += nb) {
        const int b = pid >> 3, h = pid & 7;
        const bf16* base = qkv + (size_t)b * SQ * QKV_LD; bf16* ybase = y + (size_t)b * SQ * DM;
        for (int rd = 0; rd < 8; ++rd) { const int it = rd * 8 + w; attn_C(base, h, it & 15, it >> 4, ybase, vlds, lds + 8 * (VBUF + VBUFV), w, lane); }
        for (int rd = 0; rd < 8; ++rd) attn_D(base, kmean + (size_t)pid * 8 * 64, h, (rd * 8 + w) * 32, ybase, vlds, lds + 8 * (VBUF + VBUFV), lane);
    }
}

#define CE_D(a, b) { const float hi_ = fmaxf((a), (b)), lo_ = fminf((a), (b)); (a) = hi_; (b) = lo_; }
#define BSTAGE(arr, k, j) _Pragma("unroll") for (int i_ = 0; i_ < 16; ++i_) { const int l_ = i_ ^ (j); if (l_ > i_) { if ((i_ & (k)) == 0) CE_D(arr[i_], arr[l_]) else CE_D(arr[l_], arr[i_]) } }
__device__ __forceinline__ void bsort16(float (&a)[16]) {
    BSTAGE(a, 2, 1) BSTAGE(a, 4, 2) BSTAGE(a, 4, 1) BSTAGE(a, 8, 4) BSTAGE(a, 8, 2) BSTAGE(a, 8, 1) BSTAGE(a, 16, 8) BSTAGE(a, 16, 4) BSTAGE(a, 16, 2) BSTAGE(a, 16, 1)
}
__device__ __forceinline__ void bmerge16(float (&a)[16]) {
    BSTAGE(a, 16, 8) BSTAGE(a, 16, 4) BSTAGE(a, 16, 2) BSTAGE(a, 16, 1)
}
__device__ __forceinline__ void merge_top16(float (&a)[16], const float (&b)[16]) {
#pragma unroll
    for (int i = 0; i < 16; ++i) a[i] = fmaxf(a[i], b[15 - i]);
    bmerge16(a);
}
__device__ __forceinline__ void xmerge16(float (&a)[16]) {
    {
        float A[16], B[16];
#pragma unroll
        for (int i = 0; i < 16; ++i) { auto r = __builtin_amdgcn_permlane16_swap(__float_as_uint(a[i]), __float_as_uint(a[i]), false, false); A[i] = __uint_as_float(r[0]); B[i] = __uint_as_float(r[1]); }
#pragma unroll
        for (int i = 0; i < 16; ++i) a[i] = fmaxf(A[i], B[15 - i]);
        bmerge16(a);
    }
    {
        float A[16], B[16];
#pragma unroll
        for (int i = 0; i < 16; ++i) { auto r = __builtin_amdgcn_permlane32_swap(__float_as_uint(a[i]), __float_as_uint(a[i]), false, false); A[i] = __uint_as_float(r[0]); B[i] = __uint_as_float(r[1]); }
#pragma unroll
        for (int i = 0; i < 16; ++i) a[i] = fmaxf(A[i], B[15 - i]);
        bmerge16(a);
    }
}
__host__ __device__ constexpr int pair_i(int id) {
    int c = 0;
    for (int i = 0; i < 16; ++i) { const int nj = 16 / (i + 1); if (id < c + nj) return i; c += nj; }
    return 0;
}
__host__ __device__ constexpr int pair_j(int id) {
    int c = 0;
    for (int i = 0; i < 16; ++i) { const int nj = 16 / (i + 1); if (id < c + nj) return id - c; c += nj; }
    return 0;
}
constexpr int SK_ROW = 272;
constexpr int SEL_SK_BYTES = 2 * 128 * SK_ROW;
constexpr int SEL_TAB_OFF = SEL_SK_BYTES;
constexpr int SEL_IDX_OFF = SEL_SK_BYTES + 64;

template <int S> __device__ __forceinline__ float cand_slot(const float (&L1)[16], const float (&L2)[16], int g) {
    constexpr int p0 = S, p1 = 16 + S, p2 = 32 + S, p3 = 48 + S;
    const float c0 = L1[pair_i(p0)] + L2[pair_j(p0)], c1 = L1[pair_i(p1)] + L2[pair_j(p1)], c2 = L1[pair_i(p2)] + L2[pair_j(p2)];
    const float c3 = p3 < 50 ? L1[pair_i(p3 < 50 ? p3 : 0)] + L2[pair_j(p3 < 50 ? p3 : 0)] : -1.0e30f;
    const float c = g == 0 ? c0 : (g == 1 ? c1 : (g == 2 ? c2 : c3));
    return __uint_as_float((__float_as_uint(c) & 0xffffffc0u) | (unsigned)(16 * g + S));
}

__device__ void ph_peer_select(const bf16* qry, const float* subkeys  , int* eidx, float* egate, LAS unsigned char* lds, int bid, int nb) {
    const int tid = ltid(), lane = tid & 63, w = __builtin_amdgcn_readfirstlane(tid >> 6);
    const int tk = lane & 15, g = lane >> 4;
    __syncthreads();
    for (int e = tid; e < 2 * 128 * 128 / 2; e += NT) {
        const int row = e >> 6, c2 = (e & 63) * 2;
        const float a = subkeys[(size_t)row * 128 + c2], b = subkeys[(size_t)row * 128 + c2 + 1];
        *(LAS unsigned*)(lds + row * SK_ROW + c2 * 2) = pk2(a, b);
    }
    if (tid < 64) { int id = tid; int c = 0, pi = 0, pj = 0;
        for (int i = 0; i < 16; ++i) { const int nj = 16 / (i + 1); if (id >= c && id < c + nj) { pi = i; pj = id - c; } c += nj; }
        lds[SEL_TAB_OFF + tid] = (unsigned char)((pi << 4) | pj); }
    __syncthreads();
    LAS unsigned* widx = (LAS unsigned*)(lds + SEL_IDX_OFF + w * 512);
    const LAS unsigned char* widx8 = (const LAS unsigned char*)widx;
    const int nitems = (MT / 16) * 8;
    bf16x8 qc[2][4];
    { const int it = bid * 8 + w;
      if (it < nitems) { const bf16* qp = qry + (size_t)((it >> 3) * 16 + tk) * PQ + (it & 7) * 256 + 8 * g;
#pragma unroll
          for (int hf = 0; hf < 2; ++hf)
#pragma unroll
              for (int ks = 0; ks < 4; ++ks) qc[hf][ks] = *(const bf16x8*)(qp + hf * 128 + 32 * ks); } }
    for (int it = bid * 8 + w; it < nitems; it += nb * 8) {
        const int h = it & 7, t0 = (it >> 3) * 16;
        bf16x8 qn[2][4];
        { const int itn = it + nb * 8 < nitems ? it + nb * 8 : it;
          const bf16* qp = qry + (size_t)((itn >> 3) * 16 + tk) * PQ + (itn & 7) * 256 + 8 * g;
#pragma unroll
          for (int hf = 0; hf < 2; ++hf)
#pragma unroll
              for (int ks = 0; ks < 4; ++ks) qn[hf][ks] = *(const bf16x8*)(qp + hf * 128 + 32 * ks); }
        float L[2][16];
#pragma unroll
        for (int hf = 0; hf < 2; ++hf) {
            bf16x8 qf[4];
#pragma unroll
            for (int ks = 0; ks < 4; ++ks) qf[ks] = qc[hf][ks];
            float key[32];
#pragma unroll
            for (int tile = 0; tile < 8; ++tile) {
                f32x4 acc = {0.f, 0.f, 0.f, 0.f};
#pragma unroll
                for (int ks = 0; ks < 4; ++ks) {
                    const bf16x8 af = *(const LAS bf16x8*)(lds + (hf * 128 + tile * 16 + tk) * SK_ROW + (32 * ks + 8 * g) * 2);
                    acc = __builtin_amdgcn_mfma_f32_16x16x32_bf16(af, qf[ks], acc, 0, 0, 0);
                }
#pragma unroll
                for (int r = 0; r < 4; ++r) key[tile * 4 + r] = __uint_as_float((__float_as_uint(acc[r]) & 0xffffff80u) | (unsigned)(16 * tile + 4 * g + r));
            }
            float a[16], b[16];
#pragma unroll
            for (int i = 0; i < 16; ++i) { a[i] = key[i]; b[i] = key[16 + i]; }
            bsort16(a); bsort16(b);
            merge_top16(a, b);
            xmerge16(a);
#pragma unroll
            for (int i = 0; i < 16; ++i) L[hf][i] = a[i];
            unsigned pk = 0u;
#pragma unroll
            for (int s = 0; s < 4; ++s) {
                const float v = g == 0 ? a[s] : (g == 1 ? a[4 + s] : (g == 2 ? a[8 + s] : a[12 + s]));
                pk |= (__float_as_uint(v) & 127u) << (8 * s);
            }
            widx[tk * 8 + hf * 4 + g] = pk;
        }
        float c[16];
        c[0] = cand_slot<0>(L[0], L[1], g); c[1] = cand_slot<1>(L[0], L[1], g); c[2] = cand_slot<2>(L[0], L[1], g); c[3] = cand_slot<3>(L[0], L[1], g);
        c[4] = cand_slot<4>(L[0], L[1], g); c[5] = cand_slot<5>(L[0], L[1], g); c[6] = cand_slot<6>(L[0], L[1], g); c[7] = cand_slot<7>(L[0], L[1], g);
        c[8] = cand_slot<8>(L[0], L[1], g); c[9] = cand_slot<9>(L[0], L[1], g); c[10] = cand_slot<10>(L[0], L[1], g); c[11] = cand_slot<11>(L[0], L[1], g);
        c[12] = cand_slot<12>(L[0], L[1], g); c[13] = cand_slot<13>(L[0], L[1], g); c[14] = cand_slot<14>(L[0], L[1], g); c[15] = cand_slot<15>(L[0], L[1], g);
        bsort16(c);
        xmerge16(c);
        float sum = 0.f, ex[16];
#pragma unroll
        for (int i = 0; i < 16; ++i) { ex[i] = __builtin_amdgcn_exp2f((c[i] - c[0]) * L2E); sum += ex[i]; }
        const float inv = 1.0f / sum;
        int oi[4]; float og[4];
#pragma unroll
        for (int s = 0; s < 4; ++s) {
            const float kv = g == 0 ? c[s] : (g == 1 ? c[4 + s] : (g == 2 ? c[8 + s] : c[12 + s]));
            const float ev = g == 0 ? ex[s] : (g == 1 ? ex[4 + s] : (g == 2 ? ex[8 + s] : ex[12 + s]));
            const unsigned pid = __float_as_uint(kv) & 63u;
            const unsigned ij = lds[SEL_TAB_OFF + pid];
            const unsigned i1 = widx8[tk * 32 + (ij >> 4)], i2 = widx8[tk * 32 + 16 + (ij & 15u)];
            oi[s] = (int)(i1 * 128u + i2); og[s] = ev * inv;
        }
        const size_t ob = (size_t)(t0 + tk) * 128 + h * 16 + 4 * g;
        *(u32x4*)(eidx + ob) = (u32x4){(unsigned)oi[0], (unsigned)oi[1], (unsigned)oi[2], (unsigned)oi[3]};
        *(f32x4*)(egate + ob) = (f32x4){og[0], og[1], og[2], og[3]};
#pragma unroll
        for (int hf = 0; hf < 2; ++hf)
#pragma unroll
            for (int ks = 0; ks < 4; ++ks) qc[hf][ks] = qn[hf][ks];
    }
    __syncthreads();
}

typedef float v32f_t __attribute__((ext_vector_type(32)));
typedef unsigned v6u_t __attribute__((ext_vector_type(6)));
typedef unsigned v16u_t __attribute__((ext_vector_type(16)));
typedef __bf16 v32bf_t __attribute__((ext_vector_type(32)));
typedef __bf16 v2bf_t __attribute__((ext_vector_type(2)));
typedef _Float16 v32h_t __attribute__((ext_vector_type(32)));
typedef unsigned u32x3 __attribute__((ext_vector_type(3)));
constexpr int TROW = 768;
__device__ void ph_tab_fp6(const float* src, unsigned char* dst, float* scale, int nrows, int bid, int nb) {
    const int lane = ltid() & 63, w = __builtin_amdgcn_readfirstlane(ltid() >> 6);
    for (int rp = bid * 8 + w; rp < nrows / 2; rp += nb * 8) {
        v32h_t hv; float sc[2];
#pragma unroll
        for (int rr = 0; rr < 2; ++rr) {
            const float* sp = src + (size_t)(2 * rp + rr) * DM + lane * 16;
            f32x4 v[4]; float am = 0.f;
#pragma unroll
            for (int i = 0; i < 4; ++i) { v[i] = *(const f32x4*)(sp + i * 4); am = fmaxf(am, fmaxf(fmaxf(fabsf(v[i][0]), fabsf(v[i][1])), fmaxf(fabsf(v[i][2]), fabsf(v[i][3])))); }
            am = wave_max(am);
            const float s = am > 0.f ? am * (1.0f / 7.5f) : 1.0f, inv = 1.0f / s;
            sc[rr] = s;
#pragma unroll
            for (int i = 0; i < 4; ++i)
#pragma unroll
                for (int e = 0; e < 4; ++e) hv[rr * 16 + i * 4 + e] = (_Float16)fminf(fmaxf(v[i][e] * inv, -7.5f), 7.5f);
        }
        const v6u_t pk = __builtin_amdgcn_cvt_scalef32_pk32_fp6_f16(hv, 1.0f);
        unsigned* d0 = (unsigned*)(dst + (size_t)(2 * rp) * TROW + lane * 12);
        unsigned* d1 = (unsigned*)(dst + (size_t)(2 * rp + 1) * TROW + lane * 12);
        d0[0] = pk[0]; d0[1] = pk[1]; d0[2] = pk[2]; d1[0] = pk[3]; d1[1] = pk[4]; d1[2] = pk[5];
        if (lane == 0) { scale[2 * rp] = sc[0]; scale[2 * rp + 1] = sc[1]; }
    }
}

constexpr int TROW4 = 512;
__device__ void ph_tab_fp4(const float* src, unsigned char* dst, float* scale, int nrows, int bid, int nb) {
    const int lane = ltid() & 63, w = __builtin_amdgcn_readfirstlane(ltid() >> 6);
    for (int row = bid * 8 + w; row < nrows; row += nb * 8) {
        const float* sp = src + (size_t)row * DM + lane * 16;
        f32x4 v[4]; float am = 0.f;
#pragma unroll
        for (int i = 0; i < 4; ++i) { v[i] = *(const f32x4*)(sp + i * 4); am = fmaxf(am, fmaxf(fmaxf(fabsf(v[i][0]), fabsf(v[i][1])), fmaxf(fabsf(v[i][2]), fabsf(v[i][3])))); }
        am = wave_max(am);
        const float s = am > 0.f ? am * (1.0f / 6.0f) : 1.0f, inv = 1.0f / s;
        unsigned d0 = 0u, d1 = 0u;
        d0 = __builtin_amdgcn_cvt_scalef32_pk_fp4_f32(d0, v[0][0] * inv, v[0][1] * inv, 1.0f, 0); d0 = __builtin_amdgcn_cvt_scalef32_pk_fp4_f32(d0, v[0][2] * inv, v[0][3] * inv, 1.0f, 1);
        d0 = __builtin_amdgcn_cvt_scalef32_pk_fp4_f32(d0, v[1][0] * inv, v[1][1] * inv, 1.0f, 2); d0 = __builtin_amdgcn_cvt_scalef32_pk_fp4_f32(d0, v[1][2] * inv, v[1][3] * inv, 1.0f, 3);
        d1 = __builtin_amdgcn_cvt_scalef32_pk_fp4_f32(d1, v[2][0] * inv, v[2][1] * inv, 1.0f, 0); d1 = __builtin_amdgcn_cvt_scalef32_pk_fp4_f32(d1, v[2][2] * inv, v[2][3] * inv, 1.0f, 1);
        d1 = __builtin_amdgcn_cvt_scalef32_pk_fp4_f32(d1, v[3][0] * inv, v[3][1] * inv, 1.0f, 2); d1 = __builtin_amdgcn_cvt_scalef32_pk_fp4_f32(d1, v[3][2] * inv, v[3][3] * inv, 1.0f, 3);
        *(u32x2*)(dst + (size_t)row * TROW4 + lane * 8) = (u32x2){d0, d1};
        if (lane == 0) scale[row] = s;
    }
}

__device__ void ph_tab_i4(const float* src, unsigned char* dst, float* scale, int nrows, int bid, int nb) {
    const int lane = ltid() & 63, w = __builtin_amdgcn_readfirstlane(ltid() >> 6);
    for (int row = bid * 8 + w; row < nrows; row += nb * 8) {
        const float* sp = src + (size_t)row * DM + lane * 16;
        f32x4 v[4]; float am = 0.f;
#pragma unroll
        for (int i = 0; i < 4; ++i) { v[i] = *(const f32x4*)(sp + i * 4); am = fmaxf(am, fmaxf(fmaxf(fabsf(v[i][0]), fabsf(v[i][1])), fmaxf(fabsf(v[i][2]), fabsf(v[i][3])))); }
        am = wave_max(am);
        const float s = am > 0.f ? am * (1.0f / 7.0f) : 1.0f, inv = 1.0f / s;
        unsigned d[2] = {0u, 0u};
#pragma unroll
        for (int i = 0; i < 16; ++i) { const int q = (int)rintf(fminf(fmaxf(v[i >> 2][i & 3] * inv, -7.0f), 7.0f)); d[i >> 3] |= ((unsigned)q & 15u) << (4 * (i & 7)); }
        *(u32x2*)(dst + (size_t)row * TROW4 + lane * 8) = (u32x2){d[0], d[1]};
        if (lane == 0) scale[row] = s;
    }
}

#define DPP_ADD(v, ctrl) ((v) + __builtin_bit_cast(float, __builtin_amdgcn_update_dpp(0, __builtin_bit_cast(int, (v)), (ctrl), 0xf, 0xf, true)))
typedef int i32x4_t __attribute__((ext_vector_type(4)));
constexpr int GT = 2;
typedef int v8i_t __attribute__((ext_vector_type(8)));
typedef int v2i_t __attribute__((ext_vector_type(2)));
struct GSet { u32x2 uq[4]; u32x2 vq[4]; };
__device__ __forceinline__ void gather_issue(GSet& S, int bt, int lane, const unsigned char* pu, const unsigned char* pv, const LAS int* etok) {
    const i32x4_t ev = *(const LAS i32x4_t*)(etok + bt * 4);
    const int es[4] = {__builtin_amdgcn_readfirstlane(ev.x), __builtin_amdgcn_readfirstlane(ev.y), __builtin_amdgcn_readfirstlane(ev.z), __builtin_amdgcn_readfirstlane(ev.w)};
#pragma unroll
    for (int k = 0; k < 2; ++k) {
        const unsigned f0 = (unsigned)es[2 * k] * (unsigned)TROW4 + (unsigned)lane * 8u, f1 = (unsigned)es[2 * k + 1] * (unsigned)TROW4 + (unsigned)lane * 8u;
        S.uq[2 * k] = *(const u32x2*)(pu + f0); S.uq[2 * k + 1] = *(const u32x2*)(pu + f1);
        S.vq[2 * k] = *(const u32x2*)(pv + f0); S.vq[2 * k + 1] = *(const u32x2*)(pv + f1);
    }
}
constexpr int GV_ROW = 520;
constexpr int GV_BYTES = 16 * GV_ROW, GC_BYTES = 96;
__device__ __forceinline__ float gather_udot(const GSet& S, const unsigned (&hd)[4], LAS unsigned char* vrow) {
    int d[4];
#pragma unroll
    for (int k = 0; k < 4; ++k) {
        const int q0 = (int)S.uq[k].x, q1 = (int)S.uq[k].y;
        int a1 = __builtin_amdgcn_sdot8(q0, (int)hd[0], 0, false); a1 = __builtin_amdgcn_sdot8(q1, (int)hd[1], a1, false);
        int a2 = __builtin_amdgcn_sdot8(q0, (int)hd[2], 0, false); a2 = __builtin_amdgcn_sdot8(q1, (int)hd[3], a2, false);
        d[k] = (a1 << 4) + a2;
    }
#pragma unroll
    for (int k = 0; k < 4; ++k) *(LAS u32x2*)(vrow + k * GV_ROW) = S.vq[k];
    int e2[2], f1;
#pragma unroll
    for (int k = 0; k < 2; ++k) { auto r = __builtin_amdgcn_permlane16_swap((unsigned)d[k], (unsigned)d[k + 2], false, false); e2[k] = (int)r[0] + (int)r[1]; }
    { auto r = __builtin_amdgcn_permlane32_swap((unsigned)e2[0], (unsigned)e2[1], false, false); f1 = (int)r[0] + (int)r[1]; }
    f1 += __builtin_amdgcn_update_dpp(0, f1, 0xB1, 0xf, 0xf, true); f1 += __builtin_amdgcn_update_dpp(0, f1, 0x4E, 0xf, 0xf, true);
    f1 += __builtin_amdgcn_update_dpp(0, f1, 0x124, 0xf, 0xf, true); f1 += __builtin_amdgcn_update_dpp(0, f1, 0x128, 0xf, 0xf, true);
    return (float)f1;
}
#define DPP_MAX(v, ctrl) fmaxf((v), __builtin_bit_cast(float, __builtin_amdgcn_update_dpp(0, __builtin_bit_cast(int, (v)), (ctrl), 0xf, 0xf, true)))
__device__ __forceinline__ void gather_vpart(float f0, float f1, float f2, float f3, int lane, int kslot, const LAS float* lg  ,
                                             const LAS unsigned char* vrd  , LAS unsigned char* cb, int aoff1, int aoff2, f32x4 (&acc)[8]) {
    const int q = (lane >> 2) & 3, e16 = 4 * q + kslot;
    const float fs = q == 0 ? f0 : q == 1 ? f1 : q == 2 ? f2 : f3;
    const float cv = lg[e16] * gelu_erf(fs * lg[GT * 128 + e16]);
    float mx = fabsf(cv);
    mx = DPP_MAX(mx, 0x124); mx = DPP_MAX(mx, 0x128);
    { auto r = __builtin_amdgcn_permlane16_swap(__float_as_uint(mx), __float_as_uint(mx), false, false); mx = fmaxf(__uint_as_float(r[0]), __uint_as_float(r[1])); }
    { auto r = __builtin_amdgcn_permlane32_swap(__float_as_uint(mx), __float_as_uint(mx), false, false); mx = fmaxf(__uint_as_float(r[0]), __uint_as_float(r[1])); }
    int E = (int)((__float_as_uint(mx) >> 23) & 0xffu); E = E < 8 ? 8 : E;
    const float x = cv * __uint_as_float((unsigned)(255 - E) << 23);
    const unsigned p1 = __builtin_amdgcn_cvt_scalef32_pk_fp4_f32(0u, x, 0.f, 1.0f, 0);
    const float r1 = x - __builtin_amdgcn_cvt_scalef32_pk_f32_fp4(p1, 1.0f, 0)[0];
    const unsigned p2 = __builtin_amdgcn_cvt_scalef32_pk_fp4_f32(0u, r1, 0.f, 1.0f, 0);
    const float y = (r1 - __builtin_amdgcn_cvt_scalef32_pk_f32_fp4(p2, 1.0f, 0)[0]) * 16.0f;
    const unsigned p3 = __builtin_amdgcn_cvt_scalef32_pk_fp4_f32(0u, y, 0.f, 1.0f, 0);
    const float r3 = y - __builtin_amdgcn_cvt_scalef32_pk_f32_fp4(p3, 1.0f, 0)[0];
    const unsigned p4 = __builtin_amdgcn_cvt_scalef32_pk_fp4_f32(0u, r3, 0.f, 1.0f, 0);
    const unsigned codes = (p1 & 15u) | ((p2 & 15u) << 8) | ((p3 & 15u) << 16) | ((p4 & 15u) << 24);
    { auto r = __builtin_amdgcn_permlane32_swap(codes, codes, false, false);
      const unsigned w = codes | ((r[0] ^ r[1] ^ codes) << 4);
      if (lane < 32 && (lane & 3) == 0) {
          LAS unsigned char* tb = cb + 8 + 2 * q + ((lane >> 4) & 1);
          tb[0] = (unsigned char)w; tb[16] = (unsigned char)(w >> 8); tb[32] = (unsigned char)(w >> 16); tb[48] = (unsigned char)(w >> 24);
      } }
    const u32x2 a10 = *(const LAS u32x2*)(cb + aoff1), a11 = *(const LAS u32x2*)(cb + aoff1 + 8), a20 = *(const LAS u32x2*)(cb + aoff2), a21 = *(const LAS u32x2*)(cb + aoff2 + 8);
    const v8i_t A1 = {(int)a10.x, (int)a10.y, (int)a11.x, (int)a11.y, 0, 0, 0, 0}, A2 = {(int)a20.x, (int)a20.y, (int)a21.x, (int)a21.y, 0, 0, 0, 0};
    const int sa1 = (E - 1) * 0x01010101, sa2 = (E - 5) * 0x01010101;
#pragma unroll
    for (int m = 0; m < 8; ++m) {
        const v2i_t t0 = __builtin_amdgcn_ds_read_tr4_b64_v2i32((LAS v2i_t*)(vrd + 16 * m)), t1 = __builtin_amdgcn_ds_read_tr4_b64_v2i32((LAS v2i_t*)(vrd + 16 * m + 8));
        const v8i_t B = {t0.x, t0.y, t1.x, t1.y, 0, 0, 0, 0};
        acc[m] = __builtin_amdgcn_mfma_scale_f32_16x16x128_f8f6f4(A1, B, acc[m], 4, 4, 0, sa1, 0, 0x7F7F7F7F);
        acc[m] = __builtin_amdgcn_mfma_scale_f32_16x16x128_f8f6f4(A2, B, acc[m], 4, 4, 0, sa2, 0, 0x7F7F7F7F);
    }
}
__device__ __forceinline__ void xcd_pace(unsigned* bar, volatile LAS unsigned* st);
constexpr int GNS = 8, GBPS = 32 / GNS, GSHIFT = 11;
constexpr int GATH_LDS_WAVE = GT * 128 * 12 + GV_BYTES + GC_BYTES;
#define GATH_SEG(J, NJ, nbt) { \
        const LAS int* le_ = lse + (J) * 128; const LAS int* ne_ = lse + (NJ) * 128; \
        gather_issue(D, GBPS * c + 3, lane, pu, pv, le_); \
        const float f0_ = hsc[J] * gather_udot(A, hd[J], vwr); \
        gather_issue(A, (nbt), lane, pu, pv, ne_); \
        const float f1_ = hsc[J] * gather_udot(B, hd[J], vwr + 4 * GV_ROW); \
        gather_issue(B, (nbt) + 1, lane, pu, pv, ne_); \
        const float f2_ = hsc[J] * gather_udot(C, hd[J], vwr + 8 * GV_ROW); \
        gather_issue(C, (nbt) + 2, lane, pu, pv, ne_); \
        const float f3_ = hsc[J] * gather_udot(D, hd[J], vwr + 12 * GV_ROW); \
        gather_vpart(f0_, f1_, f2_, f3_, lane, kslot, lsg + (J) * 128 + 16 * c, vrd, cb, aoff1, aoff2, acc[J]); }
__device__ void ph_peer_gather(const bf16* h2, const unsigned char* pu, const unsigned char* pv, const float* su, const float* sv,
                               const int* eidx, const float* egate, const float* xin, const float* gate  , float* xout, LAS unsigned char* lds, unsigned* pace_bar, volatile LAS unsigned* pace_st, int bid, int nb) {
    const int lane0 = ltid() & 63, w = __builtin_amdgcn_readfirstlane(ltid() >> 6);
    LAS int* lse = (LAS int*)(lds + w * GATH_LDS_WAVE); LAS float* lsg = (LAS float*)(lds + w * GATH_LDS_WAVE + GT * 128 * 4);
    LAS unsigned char* vb = lds + w * GATH_LDS_WAVE + GT * 128 * 12; LAS unsigned char* cb = vb + GV_BYTES;
    if (lane0 < GC_BYTES / 4) ((LAS unsigned*)cb)[lane0] = 0u;
    for (int t0 = (bid * 8 + w) * GT; t0 < MT; t0 += nb * 8 * GT) {
        int lane = lane0; asm volatile("" : "+v"(lane));
        const int row = lane >> 4;
        const int kslot = 2 * (row & 1) + (row >> 1);
        const int b = t0 >> 11;
        LAS unsigned char* vwr = vb + lane * 8;
        const LAS unsigned char* vrd = vb + (lane & 15) * GV_ROW + 128 * row;
        const int ai = lane & 15, au = (ai < 8 ? 1 : 3), nz = ((ai & 7) >> 1) == row;
        const int aoff1 = nz ? 8 * (au - (ai & 1)) : 64, aoff2 = nz ? 8 * (au + 4 - (ai & 1)) : 64;
        unsigned hd[GT][4]; float hsc[GT]; f32x4 acc[GT][8];
#pragma unroll
        for (int j = 0; j < GT; ++j) {
            const int t = t0 + j;
            const int e0 = eidx[(size_t)t * 128 + lane], e1 = eidx[(size_t)t * 128 + 64 + lane];
            const float g0 = egate[(size_t)t * 128 + lane], g1 = egate[(size_t)t * 128 + 64 + lane];
            const int k0 = e0 >> GSHIFT, k1 = e1 >> GSHIFT;
            int off = 0, d0 = 0, d1 = 0;
#pragma unroll
            for (int s = 0; s < GNS; ++s) {
                const unsigned long long m0 = __ballot(k0 == s), m1 = __ballot(k1 == s);
                const int r0 = (int)__builtin_amdgcn_mbcnt_hi((unsigned)(m0 >> 32), __builtin_amdgcn_mbcnt_lo((unsigned)m0, 0u));
                const int r1 = (int)__builtin_amdgcn_mbcnt_hi((unsigned)(m1 >> 32), __builtin_amdgcn_mbcnt_lo((unsigned)m1, 0u));
                const int c0 = __builtin_popcountll(m0);
                if (k0 == s) d0 = off + r0;
                if (k1 == s) d1 = off + c0 + r1;
                off += c0 + __builtin_popcountll(m1);
            }
            lse[j * 128 + d0] = e0; lsg[j * 128 + d0] = g0 * sv[e0]; lse[j * 128 + d1] = e1; lsg[j * 128 + d1] = g1 * sv[e1];
            lsg[GT * 128 + j * 128 + d0] = su[e0]; lsg[GT * 128 + j * 128 + d1] = su[e1];
            const u32x4 u0 = *(const u32x4*)(h2 + (size_t)t * DM + lane * 16), u1 = *(const u32x4*)(h2 + (size_t)t * DM + lane * 16 + 8);
            {
                float hf[16];
#pragma unroll
                for (int i = 0; i < 4; ++i) { hf[2 * i] = __uint_as_float(u0[i] << 16); hf[2 * i + 1] = __uint_as_float(u0[i] & 0xffff0000u); hf[8 + 2 * i] = __uint_as_float(u1[i] << 16); hf[8 + 2 * i + 1] = __uint_as_float(u1[i] & 0xffff0000u); }
                float mh = 0.f;
#pragma unroll
                for (int i = 0; i < 16; ++i) mh = fmaxf(mh, fabsf(hf[i]));
                mh = wave_max(mh);
                int Eh = (int)((__float_as_uint(mh) >> 23) & 0xffu); Eh = Eh < 8 ? 8 : Eh;
                const float up = __uint_as_float((unsigned)(255 - Eh) << 23);
                hsc[j] = __uint_as_float((unsigned)(Eh - 5) << 23);
                unsigned p1[2] = {0u, 0u}, p2[2] = {0u, 0u};
#pragma unroll
                for (int i = 0; i < 16; ++i) {
                    const float x = hf[i] * up, r1 = rintf(x);
                    int q2 = (int)rintf((x - r1) * 16.0f); q2 = q2 > 7 ? 7 : q2;
                    p1[i >> 3] |= ((unsigned)(int)r1 & 15u) << (4 * (i & 7)); p2[i >> 3] |= ((unsigned)q2 & 15u) << (4 * (i & 7));
                }
                hd[j][0] = p1[0]; hd[j][1] = p1[1]; hd[j][2] = p2[0]; hd[j][3] = p2[1];
            }
#pragma unroll
            for (int i = 0; i < 8; ++i) acc[j][i] = (f32x4){0.f, 0.f, 0.f, 0.f};
        }
        GSet A, B, C, D;
        gather_issue(A, 0, lane, pu, pv, lse); gather_issue(B, 1, lane, pu, pv, lse); gather_issue(C, 2, lane, pu, pv, lse);
#pragma unroll 1
        for (int c = 0; c < GNS; ++c) {
            GATH_SEG(0, 1, GBPS * c)
            GATH_SEG(1, 0, c < GNS - 1 ? GBPS * c + GBPS : 0)
        }
#pragma unroll
        for (int j = 0; j < GT; ++j) {
            const int t = t0 + j;
            LAS float* ob = (LAS float*)vb;
            const int nbase = 512 * (row & 1) + 32 * (row >> 1) + (lane & 15);
#pragma unroll
            for (int pm = 0; pm < 4; ++pm)
#pragma unroll
                for (int r = 0; r < 4; ++r) {
                    auto sw = __builtin_amdgcn_permlane32_swap(__float_as_uint(acc[j][2 * pm][r]), __float_as_uint(acc[j][2 * pm + 1][r]), false, false);
                    ob[nbase + 256 * (r >> 1) + 64 * pm + 16 * (r & 1)] = __uint_as_float(sw[0]) + __uint_as_float(sw[1]);
                }
#pragma unroll
            for (int i = 0; i < 4; ++i) {
                const int cc = i * 256 + lane * 4;
                const f32x4 a = *(const LAS f32x4*)(ob + cc);
                const f32x4 xi = *(const f32x4*)(xin + (size_t)t * DM + cc), gt = *(const f32x4*)(gate + (size_t)b * 6144 + cc);
                f32x4 o;
#pragma unroll
                for (int e = 0; e < 4; ++e) o[e] = xi[e] + gt[e] * a[e];
                __builtin_nontemporal_store(o, (f32x4*)(xout + (size_t)t * DM + cc));
            }
        }
    }
}

#define XB_TMO      128
#define XB_XCNT(j)  (256  + 64 * (j))
#define XB_XSUB(j)  (1280 + 64 * (j))
#define XB_XGEN(j)  (2304 + 64 * (j))
#define XB_TOP      3328
#define XB_TOPGEN   3392
#define XCD_BAR_WORDS 3456
#define XB_SPIN_CAP (1u << 18)

__device__ __forceinline__ unsigned xb_ld(unsigned* p)              { return __hip_atomic_load(p, __ATOMIC_RELAXED, __HIP_MEMORY_SCOPE_AGENT); }
__device__ __forceinline__ unsigned xb_add(unsigned* p, unsigned v) { return __hip_atomic_fetch_add(p, v, __ATOMIC_RELAXED, __HIP_MEMORY_SCOPE_AGENT); }
__device__ __forceinline__ unsigned xb_xcc_id() { return (unsigned)__builtin_amdgcn_s_getreg((3 << 11) | 20) & 0xFu; }
#define XB_SPIN(cond, bar) do { unsigned _sp = 0; while (cond) { __builtin_amdgcn_s_sleep(1); \
    if ((++_sp & 255u) == 0u) { if (xb_ld(&(bar)[XB_TMO])) break; if (_sp > XB_SPIN_CAP) { atomicAdd(&(bar)[XB_TMO], 1u); break; } } } } while (0)

struct XcdBarrier {
    unsigned* bar; unsigned x;
    volatile LAS unsigned* st;
};

__device__ __forceinline__ XcdBarrier xcd_barrier_post(unsigned* bar, volatile LAS unsigned* st) {
    XcdBarrier b; b.bar = bar; b.x = xb_xcc_id(); b.st = st;
    if (threadIdx.x == 0) (void)xb_add(&bar[XB_XCNT(b.x)], 1u);
    return b;
}
__device__ __forceinline__ void xcd_barrier_complete(unsigned* bar, unsigned x, unsigned& nloc, unsigned& nx) {
    const unsigned G = gridDim.x * gridDim.y * gridDim.z;
    unsigned sum, cnt, mine, sp = 0u;
    for (;;) {
        sum = 0u; cnt = 0u; mine = 0u;
#pragma unroll
        for (unsigned j = 0; j < 16; ++j) { const unsigned c = xb_ld(&bar[XB_XCNT(j)]); sum += c; cnt += (c > 0u) ? 1u : 0u; mine = (j == x) ? c : mine; }
        if (sum == G) break;
        __builtin_amdgcn_s_sleep(1);
        if ((++sp & 255u) == 0u) { if (xb_ld(&bar[XB_TMO])) break; if (sp > XB_SPIN_CAP) { atomicAdd(&bar[XB_TMO], 1u); break; } }
    }
    nloc = mine > 0u ? mine : 1u; nx = cnt > 0u ? cnt : 1u;
}

__device__ __forceinline__ void xcd_barrier(const XcdBarrier& b) {
    asm volatile("s_waitcnt vmcnt(0)" ::: "memory");
    __syncthreads();
    if (threadIdx.x == 0) {
        unsigned* bar = b.bar;
        __builtin_amdgcn_s_waitcnt(0);
        unsigned nloc = b.st[0], nx = b.st[1];
        if (nloc == 0u) { xcd_barrier_complete(bar, b.x, nloc, nx); b.st[0] = nloc; b.st[1] = nx; }
        const unsigned old = xb_add(&bar[XB_XSUB(b.x)], 1u);
        const unsigned gen = old / nloc;
        if (old + 1u == (gen + 1u) * nloc) {
            __builtin_amdgcn_fence(__ATOMIC_RELEASE, "agent");
            asm volatile("s_waitcnt vmcnt(0)" ::: "memory");
            const unsigned og = xb_add(&bar[XB_TOP], 1u);
            const unsigned tg = og / nx;
            if (og + 1u == (tg + 1u) * nx) xb_add(&bar[XB_TOPGEN], 1u);
            else XB_SPIN(xb_ld(&bar[XB_TOPGEN]) == tg, bar);
            __builtin_amdgcn_fence(__ATOMIC_ACQUIRE, "agent");
            xb_add(&bar[XB_XGEN(b.x)], 1u);
            asm volatile("s_waitcnt vmcnt(0)" ::: "memory");
        } else {
            XB_SPIN(xb_ld(&bar[XB_XGEN(b.x)]) == gen, bar);
            __builtin_amdgcn_fence(__ATOMIC_ACQUIRE, "agent");
            asm volatile("s_waitcnt vmcnt(0)" ::: "memory");
        }
    }
    __syncthreads();
}


#define XB_PACE(j) (3584 + 64 * (j))
__device__ __forceinline__ void xcd_pace(unsigned* bar, volatile LAS unsigned* st) {
    __syncthreads();
    if (threadIdx.x == 0) {
        const unsigned nloc = st[0] ? st[0] : 1u, x = xb_xcc_id(), gen = st[4] + 1u;
        st[4] = gen;
        xb_add(&bar[XB_PACE(x)], 1u);
        unsigned sp = 0;
        while (xb_ld(&bar[XB_PACE(x)]) < gen * nloc) { __builtin_amdgcn_s_sleep(1); if (++sp > (1u << 16)) break; }
    }
    __syncthreads();
}
extern __shared__ __attribute__((aligned(16))) unsigned char dyn_lds[];
#ifndef REP_PREP
#define REP_PREP 1
#endif
#ifndef REP_ATTN
#define REP_ATTN 1
#endif
#ifndef REP_SEL
#define REP_SEL 1
#endif
#ifndef REP_GATH
#define REP_GATH 1
#endif
#ifndef REP_GEMM
#define REP_GEMM 1
#endif
#ifndef REP_ADALN
#define REP_ADALN 1
#endif
constexpr int LDS_BYTES = 147456;

template <class T> __device__ __forceinline__ T* karg(int byte_off) {
    const __attribute__((address_space(4))) char* base = (const __attribute__((address_space(4))) char*)__builtin_amdgcn_kernarg_segment_ptr();
    unsigned long long v = *(const __attribute__((address_space(4))) unsigned long long*)(base + byte_off);
    asm volatile("" : "+s"(v));
    return (T*)(__attribute__((address_space(1))) T*)v;
}
#define KIN(i) karg<const float>(8 * (i))
#define KOUT() karg<float>(168)
#define KWS() karg<unsigned char>(176)
static_assert(sizeof(Params) == 184, "Params layout");
template <class T> __device__ __forceinline__ T* launder(T* p) { size_t off = 0; asm volatile("" : "+s"(off)); return (T*)((unsigned char*)p + off); }
__global__ void __launch_bounds__(NT) mega_fwd(Params p) {
    cg::grid_group grid = cg::this_grid();
    const int bid = blockIdx.x, nb = gridDim.x;
    volatile LAS unsigned* bst = (volatile LAS unsigned*)((LAS unsigned char*)dyn_lds + LDS_BYTES - 64);
    if (ltid() < 16) bst[ltid()] = 0u;
    __syncthreads();
    const XcdBarrier xbar = xcd_barrier_post((unsigned*)(KWS() + WS_BAR), bst);
    for (int rep = 0; rep < REP_PREP; ++rep) {
        unsigned char* ws = KWS();
        float* tile = (float*)dyn_lds;
        ph_transpose(KIN(6), (bf16*)(ws + WS_WIN0), 1024, AB_IN, true, tile, bid, nb);
        ph_transpose(KIN(11), (bf16*)(ws + WS_WIN1), 1024, CD_IN, true, tile, bid, nb);
        ph_transpose(KIN(7), (bf16*)(ws + WS_WO0), 1024, 1024, false, tile, bid, nb);
        ph_transpose(KIN(12), (bf16*)(ws + WS_WO1), 1024, 1024, false, tile, bid, nb);
        ph_transpose(KIN(17), (bf16*)(ws + WS_WQ), 1024, PQ, false, tile, bid, nb);
        ph_transpose(KIN(17) + (size_t)1024 * PQ, (bf16*)(ws + WS_WQ) + (size_t)PQ * 1024, 1024, PQ, false, tile, bid, nb);
        ws = launder(ws);
        ph_tab_i4(KIN(19), ws + WS_PU, (float*)(ws + WS_PV), 2 * NEXP, bid, nb);
        ph_tab_fp4(KIN(20), ws + WS_PU + 32 * MiB, (float*)(ws + WS_PV + 1 * MiB), 2 * NEXP, bid, nb);
        ws = launder(ws);
        ph_mod(KIN(1), KIN(2), KIN(3), (float*)(ws + WS_MOD), (float*)dyn_lds, bid, nb);
        ph_rope_table((float*)(ws + WS_ROPE), bid, nb);
        for (int i = bid * NT + ltid(); i < NB * 8 * 8 * 64; i += nb * NT) ((float*)(ws + WS_KMEAN))[i] = 0.f;
    }
    grid.sync();
#pragma unroll 1
    for (int layer = 0; layer < 2; ++layer) {
        for (int rep = 0; rep < REP_ADALN; ++rep) {
            unsigned char* ws = KWS(); const float* mod = (const float*)(ws + WS_MOD) + (size_t)layer * 32 * 6144;
            ph_adaln(layer == 0 ? KIN(0) : KOUT(), KIN(4) + layer * DM, mod + 0, mod + 1024, (bf16*)(ws + WS_HY), bid, nb);
        }
        xcd_barrier(xbar);
        for (int rep = 0; rep < REP_GEMM; ++rep) {
            unsigned char* ws = KWS();
            pg8::Gemm g{(const bf16*)(ws + WS_HY), (const bf16*)(ws + (layer == 0 ? WS_WIN0 : WS_WIN1)), MT, layer == 0 ? AB_IN : CD_IN, DM};
            pg8::StaticOrder S; S.init(g.M, g.N, nb, bid);
            pg8::EpiQKV e{(bf16*)(ws + WS_QKV), QKV_LD, (const float*)(ws + WS_ROPE), layer, layer == 0 ? KIN(9) : KIN(13), layer == 0 ? KIN(10) : KIN(14), KIN(15), KIN(16), (float*)(ws + WS_KMEAN)};
            pg8::gemm_phase<pg8::EpiQKV, pg8::StaticOrder, true, true>((LAS unsigned char*)dyn_lds, g, S, e);
        }
        xcd_barrier(xbar);
        for (int rep = 0; rep < REP_ATTN; ++rep) {
            unsigned char* ws = KWS();
            if (layer == 0) ph_attn0((const bf16*)(ws + WS_QKV), KIN(8), (bf16*)(ws + WS_HY), (LAS unsigned char*)dyn_lds, bid, nb);
            else ph_attn1((const bf16*)(ws + WS_QKV), (const float*)(ws + WS_KMEAN), (bf16*)(ws + WS_HY), (LAS unsigned char*)dyn_lds, bid, nb);
        }
        xcd_barrier(xbar);
        for (int rep = 0; rep < REP_GEMM; ++rep) {
            unsigned char* ws = KWS(); const float* mod = (const float*)(ws + WS_MOD) + (size_t)layer * 32 * 6144;
            pg8::Gemm g{(const bf16*)(ws + WS_HY), (const bf16*)(ws + (layer == 0 ? WS_WO0 : WS_WO1)), MT, DM, DM};
            pg8::StaticOrder S; S.init(g.M, g.N, nb, bid); pg8::EpiResid e{layer == 0 ? KIN(0) : KOUT(), (float*)(ws + WS_X1), mod + 2048};
            pg8::gemm_phase<pg8::EpiResid, pg8::StaticOrder, true, true>((LAS unsigned char*)dyn_lds, g, S, e);
        }
        xcd_barrier(xbar);
        for (int rep = 0; rep < REP_ADALN; ++rep) {
            unsigned char* ws = KWS(); const float* mod = (const float*)(ws + WS_MOD) + (size_t)layer * 32 * 6144;
            ph_adaln((const float*)(ws + WS_X1), KIN(5) + layer * DM, mod + 3072, mod + 4096, (bf16*)(ws + WS_QKV), bid, nb);
        }
        xcd_barrier(xbar);
        for (int rep = 0; rep < REP_GEMM; ++rep) {
            unsigned char* ws = KWS();
            pg8::Gemm g{(const bf16*)(ws + WS_QKV), (const bf16*)(ws + WS_WQ) + (size_t)layer * PQ * DM, MT, PQ, DM};
            pg8::StaticOrder S; S.init(g.M, g.N, nb, bid); pg8::EpiStore e{(bf16*)(ws + WS_QKV + 128 * MiB), PQ};
            pg8::gemm_phase<pg8::EpiStore, pg8::StaticOrder, true, true>((LAS unsigned char*)dyn_lds, g, S, e);
        }
        xcd_barrier(xbar);
        for (int rep = 0; rep < REP_SEL; ++rep) {
            unsigned char* ws = KWS();
            ph_peer_select((const bf16*)(ws + WS_QKV + 128 * MiB), KIN(18) + (size_t)layer * 2 * 128 * 128, (int*)(ws + WS_HY), (float*)(ws + WS_HY + 32 * MiB), (LAS unsigned char*)dyn_lds, bid, nb);
        }
        xcd_barrier(xbar);
        for (int rep = 0; rep < REP_GATH; ++rep) {
            unsigned char* ws = KWS(); const float* mod = (const float*)(ws + WS_MOD) + (size_t)layer * 32 * 6144;
            ph_peer_gather((const bf16*)(ws + WS_QKV), ws + WS_PU + (size_t)layer * NEXP * TROW4, ws + WS_PU + 32 * MiB + (size_t)layer * NEXP * TROW4,
                           (const float*)(ws + WS_PV) + layer * NEXP, (const float*)(ws + WS_PV + 1 * MiB) + layer * NEXP, (const int*)(ws + WS_HY), (const float*)(ws + WS_HY + 32 * MiB), (const float*)(ws + WS_X1), mod + 5120, KOUT(), (LAS unsigned char*)dyn_lds, (unsigned*)(ws + WS_BAR), bst, bid, nb);
        }
        if (layer == 0) xcd_barrier(xbar);
    }
}

extern "C" void kernel_launch(void* const* d_in, const int* in_sizes, int n_in, void* d_out, int out_size, void* d_ws, size_t ws_size, hipStream_t stream) {
    if (n_in != 21 || ws_size < WS_END) { fprintf(stderr, "kernel_launch: bad args n_in=%d ws=%zu\n", n_in, ws_size); return; }
    static int grid_blocks = 0;
    if (!grid_blocks) {
        int dev = 0, cus = 0, per_cu = 0;
        (void)hipGetDevice(&dev);
        (void)hipDeviceGetAttribute(&cus, hipDeviceAttributeMultiprocessorCount, dev);
        (void)hipFuncSetAttribute((const void*)mega_fwd, hipFuncAttributeMaxDynamicSharedMemorySize, LDS_BYTES);
        (void)hipOccupancyMaxActiveBlocksPerMultiprocessor(&per_cu, (const void*)mega_fwd, NT, LDS_BYTES);
        if (per_cu < 1) { fprintf(stderr, "kernel_launch: occupancy query returned %d\n", per_cu); per_cu = 1; }
        if (per_cu > 1) per_cu = 1;
        grid_blocks = cus * per_cu;
    }
    Params p{};
    for (int i = 0; i < 21; ++i) p.in[i] = (const float*)d_in[i];
    p.out = (float*)d_out; p.ws = (unsigned char*)d_ws;
    (void)hipMemsetAsync((char*)d_ws + WS_BAR, 0, 16384, stream);
    void* args[] = {&p};
    hipError_t e = hipLaunchCooperativeKernel((const void*)mega_fwd, dim3(grid_blocks), dim3(NT), args, LDS_BYTES, stream);
    if (e != hipSuccess) fprintf(stderr, "cooperative launch failed: %s (grid %d)\n", hipGetErrorString(e), grid_blocks);
}
```

```cpp
#include <hip/hip_runtime.h>
#ifndef REP_A
#define REP_A 1
#endif
#ifndef REP_B
#define REP_B 1
#endif
#ifndef REP_C
#define REP_C 1
#endif
#ifndef REP_D
#define REP_D 1
#endif
#include <hip/hip_cooperative_groups.h>
namespace cg = cooperative_groups;
#include <cstdio>
#include <cstdint>
#include <cmath>

typedef unsigned short bf16;
typedef short bf16x8 __attribute__((ext_vector_type(8)));
typedef float f32x4 __attribute__((ext_vector_type(4)));
typedef unsigned u32x4 __attribute__((ext_vector_type(4)));
typedef unsigned u32x2 __attribute__((ext_vector_type(2)));

constexpr int DM = 1024, NB = 32, SQ = 2048, MT = NB * SQ;
constexpr int HD = 64;
constexpr int AB_IN = 2304, CD_IN = 3072, QKV_LD = 3072;
constexpr int NEXP = 16384, PQ = 2048;
constexpr float EPS = 1e-6f;
constexpr int NT = 512;

constexpr size_t MiB = 1u << 20;
constexpr size_t WS_X1 = 0;
constexpr size_t WS_QKV = 256 * MiB;
constexpr size_t WS_HY = 640 * MiB;
constexpr size_t WS_PU = 768 * MiB;
constexpr size_t WS_PV = 832 * MiB;
constexpr size_t WS_WIN0 = 896 * MiB;
constexpr size_t WS_WIN1 = 901 * MiB;
constexpr size_t WS_WO0 = 907 * MiB;
constexpr size_t WS_WO1 = 909 * MiB;
constexpr size_t WS_WQ = 911 * MiB;
constexpr size_t WS_MOD = 919 * MiB;
constexpr size_t WS_ROPE = 921 * MiB;
constexpr size_t WS_KMEAN = 922 * MiB;
constexpr size_t WS_BAR = 923 * MiB;
constexpr size_t WS_END = 924 * MiB;

struct Params {
    const float* in[21];
    float* out;
    unsigned char* ws;
};

__device__ __forceinline__ int ltid() { int t = (int)__builtin_amdgcn_workitem_id_x(); asm volatile("" : "+v"(t)); return t; }
__device__ __forceinline__ float bf2f(unsigned b) { return __uint_as_float(b << 16); }
__device__ __forceinline__ unsigned f2bf(float f) { unsigned u = __float_as_uint(f); return (u + 0x7fffu + ((u >> 16) & 1u)) >> 16; }
__device__ __forceinline__ unsigned pk2(float lo, float hi) { return f2bf(lo) | (f2bf(hi) << 16); }
#define DPPV(v, ctrl) __builtin_bit_cast(float, __builtin_amdgcn_update_dpp(0, __builtin_bit_cast(int, (v)), (ctrl), 0xf, 0xf, true))
__device__ __forceinline__ float row16_sum(float v) { v += DPPV(v, 0xB1); v += DPPV(v, 0x4E); v += DPPV(v, 0x124); v += DPPV(v, 0x128); return v; }
__device__ __forceinline__ float rows_sum(float v) {
    { auto r = __builtin_amdgcn_permlane16_swap(__float_as_uint(v), __float_as_uint(v), false, false); v = __uint_as_float(r[0]) + __uint_as_float(r[1]); }
    { auto r = __builtin_amdgcn_permlane32_swap(__float_as_uint(v), __float_as_uint(v), false, false); v = __uint_as_float(r[0]) + __uint_as_float(r[1]); }
    return v;
}
__device__ __forceinline__ float wave_sum(float v) { return rows_sum(row16_sum(v)); }
__device__ __forceinline__ float wave_max(float v) {
    v = fmaxf(v, DPPV(v, 0xB1)); v = fmaxf(v, DPPV(v, 0x4E)); v = fmaxf(v, DPPV(v, 0x124)); v = fmaxf(v, DPPV(v, 0x128));
    { auto r = __builtin_amdgcn_permlane16_swap(__float_as_uint(v), __float_as_uint(v), false, false); v = fmaxf(__uint_as_float(r[0]), __uint_as_float(r[1])); }
    { auto r = __builtin_amdgcn_permlane32_swap(__float_as_uint(v), __float_as_uint(v), false, false); v = fmaxf(__uint_as_float(r[0]), __uint_as_float(r[1])); }
    return v;
}
__device__ __forceinline__ float gelu_erf(float x) {
    const float z = x * 0.70710678118654752f, az = fabsf(z);
    const float t = __builtin_amdgcn_rcpf(fmaf(0.3275911f, az, 1.0f));
    float pl = fmaf(t, 1.061405429f, -1.453152027f); pl = fmaf(t, pl, 1.421413741f); pl = fmaf(t, pl, -0.284496736f); pl = fmaf(t, pl, 0.254829592f); pl *= t;
    const float ex = __builtin_amdgcn_exp2f(az * (az * -1.4426950408889634f));
    const float er = copysignf(fmaf(-pl, ex, 1.0f), z);
    const float hx = 0.5f * x;
    return fmaf(hx, er, hx);
}

__device__ __forceinline__ int qkv_logical_col(int p) { return (p & ~255) | (((p >> 5) & 3) << 6) | (((p >> 7) & 1) << 5) | (p & 31); }
__device__ void ph_transpose(const float* W, bf16* Wt, int K, int N, bool permute, float* tile  , int bid, int nb) {
    const int tid = ltid();
    const int nkt = K / 64, nnt = N / 64;
    for (int it = bid; it < nkt * nnt; it += nb) {
        const int k0 = (it / nnt) * 64, n0 = (it % nnt) * 64;
        __syncthreads();
        for (int e = tid; e < 64 * 64; e += NT) { const int r = e >> 6, c = e & 63; const int nl = permute ? qkv_logical_col(n0 + c) : n0 + c; tile[r * 65 + c] = W[(size_t)(k0 + r) * N + nl]; }
        __syncthreads();
        {
            const int n = tid >> 3, k8 = (tid & 7) * 8;
            u32x4 v;
            v.x = pk2(tile[(k8 + 0) * 65 + n], tile[(k8 + 1) * 65 + n]);
            v.y = pk2(tile[(k8 + 2) * 65 + n], tile[(k8 + 3) * 65 + n]);
            v.z = pk2(tile[(k8 + 4) * 65 + n], tile[(k8 + 5) * 65 + n]);
            v.w = pk2(tile[(k8 + 6) * 65 + n], tile[(k8 + 7) * 65 + n]);
            *(u32x4*)(Wt + (size_t)(n0 + n) * K + k0 + k8) = v;
        }
    }
}
__device__ void ph_convert(const float* src, bf16* dst, size_t n, int bid, int nb) {
    const size_t n8 = n / 8;
    for (size_t i = (size_t)bid * NT + ltid(); i < n8; i += (size_t)nb * NT) {
        const f32x4 a = *(const f32x4*)(src + i * 8), b = *(const f32x4*)(src + i * 8 + 4);
        u32x4 v; v.x = pk2(a[0], a[1]); v.y = pk2(a[2], a[3]); v.z = pk2(b[0], b[1]); v.w = pk2(b[2], b[3]);
        *(u32x4*)(dst + i * 8) = v;
    }
}
__device__ void ph_mod(const float* c, const float* ada_w, const float* ada_b, float* mod, float* lds  , int bid, int nb) {
    const int tid = ltid(), lane = tid & 63, w = tid >> 6;
    for (int it = bid; it < 2 * 96; it += nb) {
        const int l = it / 96, j = (it % 96) * 64 + lane;
        float acc[32];
#pragma unroll
        for (int b = 0; b < 32; ++b) acc[b] = 0.f;
        for (int kh = 0; kh < 2; ++kh) {
            __syncthreads();
            for (int e = tid; e < 32 * 512; e += NT) { const int b = e >> 9, k = e & 511; const float cv = c[b * 1024 + kh * 512 + k]; lds[e] = cv / (1.0f + __expf(-cv)); }
            __syncthreads();
            for (int kk = 0; kk < 64; ++kk) {
                const int k = w * 64 + kk;
                const float wv = ada_w[((size_t)l * 1024 + kh * 512 + k) * 6144 + j];
#pragma unroll
                for (int b = 0; b < 32; ++b) acc[b] += lds[b * 512 + k] * wv;
            }
        }
        __syncthreads();
#pragma unroll
        for (int b = 0; b < 32; ++b) lds[(w * 32 + b) * 64 + lane] = acc[b];
        __syncthreads();
        for (int e = tid; e < 32 * 64; e += NT) {
            const int b = e >> 6, jj = e & 63; float s = 0.f;
#pragma unroll
            for (int ww = 0; ww < 8; ++ww) s += lds[(ww * 32 + b) * 64 + jj];
            const int jo = (it % 96) * 64 + jj;
            mod[((size_t)l * 32 + b) * 6144 + jo] = s + ada_b[l * 6144 + jo];
        }
    }
}
__device__ void ph_rope_table(float* rope, int bid, int nb) {
    for (int i = bid * NT + ltid(); i < SQ * 32; i += nb * NT) {
        const int t = i >> 5, f = i & 31;
        const float inv = powf(10000.0f, -(float)f / 32.0f);
        const float ang = (float)t * inv;
        float s, c; sincosf(ang, &s, &c);
        rope[i * 2] = c; rope[i * 2 + 1] = s;
    }
}

#define DPP_ADD0(v, ctrl) ((v) + __builtin_bit_cast(float, __builtin_amdgcn_update_dpp(0, __builtin_bit_cast(int, (v)), (ctrl), 0xf, 0xf, true)))
template <bool XBF> __device__ void ph_adaln(const void* xv, const float* g, const float* mod_shift  , const float* mod_scale, bf16* h, int bid, int nb) {
    const int lane = ltid() & 63, w = __builtin_amdgcn_readfirstlane(ltid() >> 6);
    for (int t0 = (bid * 8 + w) * 4; t0 < MT; t0 += nb * 8 * 4) {
        const int b = t0 >> 11;
        f32x4 v[4][4]; float ss[4];
#pragma unroll
        for (int r = 0; r < 4; ++r) {
            if constexpr (XBF) {
                const bf16* xr = (const bf16*)xv + (size_t)(t0 + r) * DM;
#pragma unroll
                for (int i = 0; i < 4; ++i) { const u32x2 q = *(const u32x2*)(xr + i * 256 + lane * 4); v[r][i] = (f32x4){__uint_as_float(q.x << 16), __uint_as_float(q.x & 0xffff0000u), __uint_as_float(q.y << 16), __uint_as_float(q.y & 0xffff0000u)}; }
            } else {
                const float* xr = (const float*)xv + (size_t)(t0 + r) * DM;
#pragma unroll
                for (int i = 0; i < 4; ++i) v[r][i] = *(const f32x4*)(xr + i * 256 + lane * 4);
            }
        }
#pragma unroll
        for (int r = 0; r < 4; ++r) {
            float s = 0.f;
#pragma unroll
            for (int i = 0; i < 4; ++i) s += v[r][i][0] * v[r][i][0] + v[r][i][1] * v[r][i][1] + v[r][i][2] * v[r][i][2] + v[r][i][3] * v[r][i][3];
            s = DPP_ADD0(s, 0xB1); s = DPP_ADD0(s, 0x4E); s = DPP_ADD0(s, 0x124); s = DPP_ADD0(s, 0x128);
            { auto q = __builtin_amdgcn_permlane16_swap(__float_as_uint(s), __float_as_uint(s), false, false); s = __uint_as_float(q[0]) + __uint_as_float(q[1]); }
            { auto q = __builtin_amdgcn_permlane32_swap(__float_as_uint(s), __float_as_uint(s), false, false); s = __uint_as_float(q[0]) + __uint_as_float(q[1]); }
            ss[r] = rsqrtf(s * (1.0f / DM) + EPS);
        }
#pragma unroll
        for (int i = 0; i < 4; ++i) {
            const int c = i * 256 + lane * 4;
            const f32x4 gg = *(const f32x4*)(g + c), sc = *(const f32x4*)(mod_scale + (size_t)b * 6144 + c), sh = *(const f32x4*)(mod_shift + (size_t)b * 6144 + c);
            float a[4];
#pragma unroll
            for (int e = 0; e < 4; ++e) a[e] = gg[e] * (1.0f + sc[e]);
#pragma unroll
            for (int r = 0; r < 4; ++r) {
                float y[4];
#pragma unroll
                for (int e = 0; e < 4; ++e) y[e] = v[r][i][e] * ss[r] * a[e] + sh[e];
                u32x2 o; o.x = pk2(y[0], y[1]); o.y = pk2(y[2], y[3]);
                __builtin_nontemporal_store(o, (u32x2*)(h + (size_t)(t0 + r) * DM + c));
            }
        }
    }
}

namespace pg8 {
#define PG8_LAS __attribute__((address_space(3)))
typedef unsigned short bf16_t;
typedef short bf16x8 __attribute__((ext_vector_type(8)));
constexpr int BM = 256, BK = 64, HALF = 128, HTB = HALF * BK * 2  , STAGE_BYTES = 8 * HTB, NXCD = 8, WGM = 8;

__host__ __device__ __forceinline__ int lds_byte(int r, int c) { const int st = (r >> 4) * 2 + (c >> 5), rr = r & 15, cc = c & 31, ob = rr * 64 + cc * 2; return st * 1024 + (ob ^ (((ob >> 9) & 1) << 5)); }
__host__ __device__ __forceinline__ void stage_rc(int b, int& R, int& C) { const int st = b / 1024, sb = b % 1024, swz = sb ^ (((sb >> 9) & 1) << 5); R = (st >> 1) * 16 + swz / 64; C = (st & 1) * 32 + (swz % 64) / 2; }
__host__ __device__ __forceinline__ int perm32(int rho) { const int n = rho >> 4, i = rho & 15; return 8 * (i >> 2) + 4 * n + (i & 3); }

struct Unit { int pm, pn; };
struct Gemm { const bf16_t* A; const bf16_t* Bt; int M, N, K; };

struct StaticOrder {
    int nM, nN, nwg, G, c;
    __host__ __device__ void init(int M, int N, int G_, int c_) { nM = M / BM; nN = N / BM; nwg = nM * nN; G = G_; c = c_; }
    __host__ __device__ bool next(int i, Unit& u) const {
        const long L = (long)i * G + c; if (L >= nwg) return false;
        int wgid = (int)L; { const int q = nwg / NXCD, r = nwg % NXCD, xcd = wgid % NXCD, off = wgid / NXCD; wgid = (xcd < r ? xcd * (q + 1) : r * (q + 1) + (xcd - r) * q) + off; }
        const int nig = WGM * nN, gid = wgid / nig, fm = gid * WGM, gsz = (nM - fm) < WGM ? (nM - fm) : WGM;
        u.pm = fm + ((wgid % nig) % gsz); u.pn = (wgid % nig) / gsz; return true;
    }
    __device__ __forceinline__ void a_ready(const Unit&) const {}
    __device__ __forceinline__ void done(const Unit&) const {}
};

__device__ __forceinline__ unsigned cvt_pk_bf16(float lo, float hi) { unsigned r; asm volatile("v_cvt_pk_bf16_f32 %0, %1, %2" : "=v"(r) : "v"(lo), "v"(hi)); return r; }

struct EpiStore {
    static constexpr bool PERM = true, AFTER_DRAIN = false;
    bf16_t* O; int ldc;
    __device__ __forceinline__ void operator()(const f32x4 (&acc)[2][2][4][2], const Unit& u, int wr, int wc, int fr_, int fq_) const {
        int fr = fr_, fq = fq_; asm volatile("" : "+v"(fr), "+v"(fq));
        const int row0 = u.pm * BM + wr * 64 + fr, col0 = u.pn * BM + wc * 32 + 8 * fq;
#pragma unroll
        for (int ai = 0; ai < 2; ++ai)
#pragma unroll
            for (int m = 0; m < 4; ++m) { bf16_t* rowp = O + (size_t)(row0 + ai * HALF + m * 16) * ldc + col0;
#pragma unroll
                for (int bj = 0; bj < 2; ++bj) { const f32x4 v0 = acc[ai][bj][m][0], v1 = acc[ai][bj][m][1];
                    u32x4 w; w.x = cvt_pk_bf16(v0[0], v0[1]); w.y = cvt_pk_bf16(v0[2], v0[3]); w.z = cvt_pk_bf16(v1[0], v1[1]); w.w = cvt_pk_bf16(v1[2], v1[3]);
                    *(u32x4*)(rowp + bj * HALF) = w; } }
    }
};
struct EpiQKV {
    static constexpr bool PERM = true, AFTER_DRAIN = false;
    bf16_t* O; int ldc; const float* rope; int layer;
    const float* gq0; const float* gk0;
    const float* gq1; const float* gk1;
    float* kmean;
    __device__ __forceinline__ void operator()(const f32x4 (&acc)[2][2][4][2], const Unit& u, int wr, int wc, int fr_, int fq_) const {
        int fr = fr_, fq = fq_; asm volatile("" : "+v"(fr), "+v"(fq));
        const int hg = 4 * u.pn + wc;
        const float* gain = nullptr; bool km = false;
        if (layer == 0) { if (hg < 8) gain = gq0; else if (hg < 10) gain = gk0; }
        else { if (hg < 8) gain = gq0; else if (hg < 16) gain = gk0; else if (hg >= 24 && hg < 32) gain = gq1; else if (hg >= 32 && hg < 40) { gain = gk1; km = true; } }
        const int row0 = u.pm * BM + wr * 64 + fr, col0 = 64 * hg + 8 * fq;
        float g0[8], g1[8], cs0[8], cs1[8];
#pragma unroll
        for (int e = 0; e < 8; ++e) { g0[e] = gain ? gain[8 * fq + e] : 1.f; g1[e] = gain ? gain[32 + 8 * fq + e] : 1.f; cs0[e] = 0.f; cs1[e] = 0.f; }
#pragma unroll
        for (int ai = 0; ai < 2; ++ai)
#pragma unroll
            for (int m = 0; m < 4; ++m) {
                const int row = row0 + ai * HALF + m * 16;
                float v0[8], v1[8];
#pragma unroll
                for (int e = 0; e < 4; ++e) { v0[e] = acc[ai][0][m][0][e]; v0[4 + e] = acc[ai][0][m][1][e]; v1[e] = acc[ai][1][m][0][e]; v1[4 + e] = acc[ai][1][m][1][e]; }
                if (gain) {
                    float ss = 0.f;
#pragma unroll
                    for (int e = 0; e < 8; ++e) ss += v0[e] * v0[e] + v1[e] * v1[e];
                    ss = rows_sum(ss);
                    const float r = rsqrtf(ss * (1.0f / 64.0f) + 1e-6f);
                    const float* rp = rope + ((size_t)(row & 2047) * 32 + 8 * fq) * 2;
                    const f32x4 t0 = *(const f32x4*)(rp), t1 = *(const f32x4*)(rp + 4), t2 = *(const f32x4*)(rp + 8), t3 = *(const f32x4*)(rp + 12);
                    const float cs[8] = {t0[0], t0[2], t1[0], t1[2], t2[0], t2[2], t3[0], t3[2]}, sn[8] = {t0[1], t0[3], t1[1], t1[3], t2[1], t2[3], t3[1], t3[3]};
#pragma unroll
                    for (int e = 0; e < 8; ++e) { const float y0 = v0[e] * r * g0[e], y1 = v1[e] * r * g1[e]; v0[e] = y0 * cs[e] - y1 * sn[e]; v1[e] = y1 * cs[e] + y0 * sn[e]; }
                }
                u32x4 w0, w1;
                w0.x = cvt_pk_bf16(v0[0], v0[1]); w0.y = cvt_pk_bf16(v0[2], v0[3]); w0.z = cvt_pk_bf16(v0[4], v0[5]); w0.w = cvt_pk_bf16(v0[6], v0[7]);
                w1.x = cvt_pk_bf16(v1[0], v1[1]); w1.y = cvt_pk_bf16(v1[2], v1[3]); w1.z = cvt_pk_bf16(v1[4], v1[5]); w1.w = cvt_pk_bf16(v1[6], v1[7]);
                bf16_t* rowp = O + (size_t)row * ldc + col0;
                *(u32x4*)(rowp) = w0; *(u32x4*)(rowp + 32) = w1;
                if (km) {
#pragma unroll
                    for (int e = 0; e < 8; ++e) { cs0[e] += v0[e]; cs1[e] += v1[e]; }
                }
            }
        if (km) {
#pragma unroll
            for (int e = 0; e < 8; ++e) {
                cs0[e] = row16_sum(cs0[e]); cs1[e] = row16_sum(cs1[e]);
            }
            if (fr == 0) {
                float* kp = kmean + ((size_t)((u.pm >> 3) * 8 + (hg - 32)) * 8 + (u.pm & 7)) * 64 + 8 * fq;
#pragma unroll
                for (int e = 0; e < 8; ++e) { atomicAdd(kp + e, cs0[e] * (1.0f / 256.0f)); atomicAdd(kp + 32 + e, cs1[e] * (1.0f / 256.0f)); }
            }
        }
    }
};
template <bool XBF> struct EpiResid {
    static constexpr bool PERM = true, AFTER_DRAIN = false;
    const void* xin; bf16_t* xout; const float* gate;
    __device__ __forceinline__ void operator()(const f32x4 (&acc)[2][2][4][2], const Unit& u, int wr, int wc, int fr_, int fq_) const {
        int fr = fr_, fq = fq_; asm volatile("" : "+v"(fr), "+v"(fq));
        const int row0 = u.pm * BM + wr * 64 + fr, col0 = u.pn * BM + wc * 32 + 8 * fq;
#pragma unroll
        for (int ai = 0; ai < 2; ++ai)
#pragma unroll
            for (int m = 0; m < 4; ++m) { const int row = row0 + ai * HALF + m * 16; const float* gp = gate + (size_t)(row >> 11) * 6144 + col0;
                bf16_t* xo = xout + (size_t)row * 1024 + col0;
#pragma unroll
                for (int bj = 0; bj < 2; ++bj) {
                    f32x4 x0, x1;
                    if constexpr (XBF) { const u32x4 q = *(const u32x4*)((const bf16_t*)xin + (size_t)row * 1024 + col0 + bj * HALF);
                        x0 = (f32x4){__uint_as_float(q.x << 16), __uint_as_float(q.x & 0xffff0000u), __uint_as_float(q.y << 16), __uint_as_float(q.y & 0xffff0000u)};
                        x1 = (f32x4){__uint_as_float(q.z << 16), __uint_as_float(q.z & 0xffff0000u), __uint_as_float(q.w << 16), __uint_as_float(q.w & 0xffff0000u)}; }
                    else { const float* xi = (const float*)xin + (size_t)row * 1024 + col0 + bj * HALF; x0 = *(const f32x4*)xi; x1 = *(const f32x4*)(xi + 4); }
                    const f32x4 a0 = acc[ai][bj][m][0], a1 = acc[ai][bj][m][1], g0 = *(const f32x4*)(gp + bj * HALF), g1 = *(const f32x4*)(gp + bj * HALF + 4);
                    u32x4 w; w.x = cvt_pk_bf16(x0[0] + g0[0] * a0[0], x0[1] + g0[1] * a0[1]); w.y = cvt_pk_bf16(x0[2] + g0[2] * a0[2], x0[3] + g0[3] * a0[3]);
                    w.z = cvt_pk_bf16(x1[0] + g1[0] * a1[0], x1[1] + g1[1] * a1[1]); w.w = cvt_pk_bf16(x1[2] + g1[2] * a1[2], x1[3] + g1[3] * a1[3]);
                    *(u32x4*)(xo + bj * HALF) = w; } }
    }
};
template <class Epi, class Sched, bool ALIGN_EPI = false, bool SP2 = false>
__device__ __forceinline__ void gemm_phase(PG8_LAS unsigned char* lds, const Gemm g, const Sched& S, const Epi& E) {
    const int tid = ltid(), wid = __builtin_amdgcn_readfirstlane(tid >> 6), lane = tid & 63, wr = wid >> 2, wc = wid & 3, fr = lane & 15, fq = lane >> 4;
    const int K = g.K, nt = K / BK;
    unsigned voffA[2], voffB[2];
#pragma unroll
    for (int i = 0; i < 2; ++i) { int R, C; stage_rc(tid * 16 + i * 8192, R, C); const int Rb = Epi::PERM ? ((R & ~31) + perm32(R & 31)) : R;
        voffA[i] = (unsigned)(R * K + C) * 2u; voffB[i] = (unsigned)(Rb * K + C) * 2u; }
    const size_t kstep = (size_t)(BK * 2);
    const size_t hstep = (size_t)HALF * K * 2;
    const size_t tstep = 2 * hstep;
    const unsigned ldsw = (unsigned)wid * 1024u;
    const int aoff = lds_byte(wr * 64 + fr, fq * 8), boff = lds_byte(wc * 32 + fr, fq * 8);
#define PG8_SA(b, h) (((b) * 2 + (h)) * HTB)
#define PG8_SB(b, h) ((4 + (b) * 2 + (h)) * HTB)
#define PG8_STAGE(bufoff, gbase, voff) do { _Pragma("unroll") for (int _i = 0; _i < 2; ++_i) \
        __builtin_amdgcn_global_load_lds((const unsigned*)((const char*)(gbase) + (voff)[_i]), (PG8_LAS unsigned*)(lds + (bufoff) + ldsw + _i * 8192), 16, 0, 0); } while (0)
#define PG8_LDA(dst, b, h) do { _Pragma("unroll") for (int m = 0; m < 4; ++m) _Pragma("unroll") for (int k = 0; k < 2; ++k) dst[m][k] = *(const PG8_LAS bf16x8*)(lds + PG8_SA(b, h) + aoff + m * 2048 + k * 1024); } while (0)
#define PG8_LDB(dst, b, h) do { _Pragma("unroll") for (int n = 0; n < 2; ++n) _Pragma("unroll") for (int k = 0; k < 2; ++k) dst[n][k] = *(const PG8_LAS bf16x8*)(lds + PG8_SB(b, h) + boff + n * 2048 + k * 1024); } while (0)
#define PG8_MMA(ai, bj, At, Bt) do { __builtin_amdgcn_s_setprio(1); _Pragma("unroll") for (int m = 0; m < 4; ++m) _Pragma("unroll") for (int n = 0; n < 2; ++n) _Pragma("unroll") for (int k = 0; k < 2; ++k) \
        acc[ai][bj][m][n] = __builtin_amdgcn_mfma_f32_16x16x32_bf16(Bt[n][k], At[m][k], acc[ai][bj][m][n], 0, 0, 0); __builtin_amdgcn_s_setprio(0); } while (0)
#define PG8_WAIT_V(n) asm volatile("s_waitcnt vmcnt(" #n ")" ::: "memory")
#define PG8_WAIT_L(n) asm volatile("s_waitcnt lgkmcnt(" #n ")" ::: "memory")
#define PG8_BAR __builtin_amdgcn_s_barrier()
#define PG8_SCHED __builtin_amdgcn_sched_barrier(0)
    Unit cur, nxt; int ui = 0;
    if (!S.next(0, cur)) return;
    f32x4 acc[2][2][4][2];
#pragma unroll
    for (int a = 0; a < 2; ++a)
#pragma unroll
        for (int b = 0; b < 2; ++b)
#pragma unroll
            for (int m = 0; m < 4; ++m)
#pragma unroll
                for (int n = 0; n < 2; ++n) acc[a][b][m][n] = (f32x4){0.f, 0.f, 0.f, 0.f};
    bf16x8 At[4][2], B0[2][2], B1[2][2];
    const char* cA = (const char*)g.A + (size_t)cur.pm * tstep; const char* cB = (const char*)g.Bt + (size_t)cur.pn * tstep;
    S.a_ready(cur);
    if constexpr (SP2) {
        PG8_STAGE(PG8_SB(0, 0), cB, voffB); PG8_STAGE(PG8_SB(0, 1), cB + hstep, voffB); PG8_STAGE(PG8_SA(0, 0), cA, voffA); PG8_STAGE(PG8_SA(0, 1), cA + hstep, voffA);
        if (wr == 1) PG8_BAR;
        PG8_WAIT_V(2); PG8_BAR;
        PG8_STAGE(PG8_SB(1, 0), cB + kstep, voffB); PG8_STAGE(PG8_SA(1, 0), cA + kstep, voffA); PG8_STAGE(PG8_SB(1, 1), cB + hstep + kstep, voffB);
        PG8_WAIT_V(6); PG8_BAR;
    } else {
        PG8_STAGE(PG8_SB(0, 0), cB, voffB); PG8_STAGE(PG8_SA(0, 0), cA, voffA); PG8_STAGE(PG8_SB(0, 1), cB + hstep, voffB); PG8_STAGE(PG8_SA(0, 1), cA + hstep, voffA);
        if (wr == 1) PG8_BAR;
        PG8_WAIT_V(4); PG8_BAR;
        PG8_STAGE(PG8_SB(1, 0), cB + kstep, voffB); PG8_STAGE(PG8_SA(1, 0), cA + kstep, voffA); PG8_STAGE(PG8_SB(1, 1), cB + hstep + kstep, voffB);
        PG8_WAIT_V(6); PG8_BAR;
    }
    for (;;) {
        const bool has_next = S.next(ui + 1, nxt);
        const char* nA = has_next ? (const char*)g.A + (size_t)nxt.pm * tstep : cA; const char* nB = has_next ? (const char*)g.Bt + (size_t)nxt.pn * tstep : cB;
        for (int t = 0; t < nt; t += 2) {
            const bool last = (t == nt - 2);
            const char* a1 = cA + (size_t)(t + 1) * kstep;
            const char* a2 = last ? nA : cA + (size_t)(t + 2) * kstep; const char* b2 = last ? nB : cB + (size_t)(t + 2) * kstep;
            const char* a3 = a2 + kstep; const char* b3 = b2 + kstep;
            if (last && has_next) S.a_ready(nxt);
            if constexpr (SP2) {
            PG8_LDB(B0, 0, 0); PG8_LDB(B1, 0, 1); PG8_SCHED; PG8_LDA(At, 0, 0); PG8_STAGE(PG8_SA(1, 1), a1 + hstep, voffA);
            PG8_WAIT_V(8); PG8_WAIT_L(0); PG8_BAR; PG8_MMA(0, 0, At, B0); PG8_MMA(0, 1, At, B1); PG8_BAR; PG8_SCHED;
            PG8_LDA(At, 0, 1); PG8_STAGE(PG8_SB(0, 0), b2, voffB); PG8_STAGE(PG8_SB(0, 1), b2 + hstep, voffB); PG8_STAGE(PG8_SA(0, 0), a2, voffA);
            PG8_WAIT_V(8); PG8_WAIT_L(0); PG8_BAR; PG8_MMA(1, 0, At, B0); PG8_MMA(1, 1, At, B1); PG8_BAR; PG8_SCHED;
            PG8_LDB(B0, 1, 0); PG8_LDB(B1, 1, 1); PG8_SCHED; PG8_LDA(At, 1, 0); PG8_STAGE(PG8_SA(0, 1), a2 + hstep, voffA);
            PG8_WAIT_V(8); PG8_WAIT_L(0); PG8_BAR; PG8_MMA(0, 0, At, B0); PG8_MMA(0, 1, At, B1); PG8_BAR; PG8_SCHED;
            PG8_LDA(At, 1, 1); PG8_STAGE(PG8_SB(1, 0), b3, voffB); PG8_STAGE(PG8_SB(1, 1), b3 + hstep, voffB); PG8_STAGE(PG8_SA(1, 0), a3, voffA);
            PG8_WAIT_V(8); PG8_WAIT_L(0); PG8_BAR; PG8_MMA(1, 0, At, B0); PG8_MMA(1, 1, At, B1); PG8_BAR; PG8_SCHED;
            } else {
            PG8_LDB(B0, 0, 0); PG8_SCHED; PG8_LDA(At, 0, 0); PG8_STAGE(PG8_SA(1, 1), a1 + hstep, voffA);
            PG8_WAIT_L(8); PG8_BAR; PG8_WAIT_L(0); PG8_MMA(0, 0, At, B0); PG8_BAR; PG8_SCHED;
            PG8_LDB(B1, 0, 1); PG8_STAGE(PG8_SB(0, 0), b2, voffB);
            PG8_BAR; PG8_WAIT_L(0); PG8_MMA(0, 1, At, B1); PG8_BAR;
            PG8_LDA(At, 0, 1); PG8_STAGE(PG8_SA(0, 0), a2, voffA);
            PG8_BAR; PG8_WAIT_L(0); PG8_MMA(1, 0, At, B0); PG8_BAR; PG8_SCHED;
            PG8_STAGE(PG8_SB(0, 1), b2 + hstep, voffB);
            PG8_WAIT_V(6); PG8_BAR; PG8_MMA(1, 1, At, B1); PG8_BAR;
            PG8_LDB(B0, 1, 0); PG8_SCHED; PG8_LDA(At, 1, 0); PG8_STAGE(PG8_SA(0, 1), a2 + hstep, voffA);
            PG8_WAIT_L(8); PG8_BAR; PG8_WAIT_L(0); PG8_MMA(0, 0, At, B0); PG8_BAR; PG8_SCHED;
            PG8_LDB(B1, 1, 1); PG8_STAGE(PG8_SB(1, 0), b3, voffB);
            PG8_BAR; PG8_WAIT_L(0); PG8_MMA(0, 1, At, B1); PG8_BAR;
            PG8_LDA(At, 1, 1); PG8_STAGE(PG8_SA(1, 0), a3, voffA);
            PG8_BAR; PG8_WAIT_L(0); PG8_MMA(1, 0, At, B0); PG8_BAR; PG8_SCHED;
            PG8_STAGE(PG8_SB(1, 1), b3 + hstep, voffB);
            PG8_WAIT_V(6); PG8_BAR; PG8_MMA(1, 1, At, B1); PG8_BAR;
            }
        }
        if constexpr (ALIGN_EPI) { if (wr == 0) PG8_BAR; }
        if constexpr (!Epi::AFTER_DRAIN) { E(acc, cur, wr, wc, fr, fq); S.done(cur); }
        if (!has_next) break;
#pragma unroll
        for (int a = 0; a < 2; ++a)
#pragma unroll
            for (int b = 0; b < 2; ++b)
#pragma unroll
                for (int m = 0; m < 4; ++m)
#pragma unroll
                    for (int n = 0; n < 2; ++n) acc[a][b][m][n] = (f32x4){0.f, 0.f, 0.f, 0.f};
        cur = nxt; cA = nA; cB = nB; ++ui;
        if constexpr (ALIGN_EPI) { if (wr == 1) PG8_BAR; }
    }
    PG8_WAIT_V(0);
    if constexpr (!ALIGN_EPI) { if (wr == 0) PG8_BAR; }
    PG8_BAR;
    if constexpr (Epi::AFTER_DRAIN) { E.fused(acc, cur, wr, wc, fr, fq, lds, wid, lane); S.done(cur); }
#undef PG8_SA
#undef PG8_SB
#undef PG8_STAGE
#undef PG8_LDA
#undef PG8_LDB
#undef PG8_MMA
#undef PG8_WAIT_V
#undef PG8_WAIT_L
#undef PG8_BAR
#undef PG8_SCHED
}
}

typedef float f32x16 __attribute__((ext_vector_type(16)));
typedef short s16x4 __attribute__((ext_vector_type(4)));
typedef short v4i16_t __attribute__((ext_vector_type(4)));
typedef float f32x2_t __attribute__((ext_vector_type(2)));
typedef __bf16 bf16x2_t __attribute__((ext_vector_type(2)));
#define LAS __attribute__((address_space(3)))
constexpr int VROW = 144, VBUF = 32 * VROW;
constexpr int VROWV = 192, VBUFV = 32 * VROWV;
constexpr float L2E = 1.4426950408889634f, LN2 = 0.6931471805599453f;
constexpr float SC2 = 0.125f * L2E;

__device__ __forceinline__ int crow(int r, int hi) { return (r & 3) + 8 * (r >> 2) + 4 * hi; }
__device__ __forceinline__ unsigned cvtpk(float lo, float hi) { f32x2_t v = {lo, hi}; bf16x2_t b = __builtin_convertvector(v, bf16x2_t); return __builtin_bit_cast(unsigned, b); }
__device__ __forceinline__ float xhalf(float v, int hi) {
    auto r = __builtin_amdgcn_permlane32_swap(__float_as_uint(v), __float_as_uint(v), false, false);
    return __uint_as_float(hi ? r[0] : r[1]);
}
__device__ __forceinline__ s16x4 vtr(const LAS unsigned char* p) { return __builtin_bit_cast(s16x4, __builtin_amdgcn_ds_read_tr16_b64_v4i16((LAS v4i16_t*)p)); }

struct KVRegs { u32x4 k[4]; u32x4 v[4]; };
__device__ __forceinline__ void load_kv(KVRegs& R, const bf16* base, int kp0, int kst, int kcol, int vcol, int lane) {
#pragma unroll
    for (int j = 0; j < 4; ++j) {
        const int pos = kp0 + kst * (8 * j + (lane >> 3));
        const int pc = pos < SQ - 1 ? pos : SQ - 1;
        const bf16* rp = base + (size_t)pc * QKV_LD + (lane & 7) * 8;
        R.k[j] = *(const u32x4*)(rp + kcol); R.v[j] = *(const u32x4*)(rp + vcol);
    }
}
__device__ __forceinline__ void kv_stage(const KVRegs& R, LAS unsigned char* klds, LAS unsigned char* vlds, int lane) {
#pragma unroll
    for (int j = 0; j < 4; ++j) { const int r_ = 8 * j + (lane >> 3), c_ = (lane & 7) * 16; *(LAS u32x4*)(klds + r_ * VROW + c_) = R.k[j]; *(LAS u32x4*)(vlds + r_ * VROWV + c_) = R.v[j]; }
}
__device__ __forceinline__ f32x16 qk_tile(const LAS unsigned char* klds, const bf16x8 (&qf)[4], int r32, int hi) {
    f32x16 s = {0.f, 0.f, 0.f, 0.f, 0.f, 0.f, 0.f, 0.f, 0.f, 0.f, 0.f, 0.f, 0.f, 0.f, 0.f, 0.f};
#pragma unroll
    for (int k = 0; k < 4; ++k) { const bf16x8 kf = *(const LAS bf16x8*)(klds + r32 * VROW + (2 * k + hi) * 16); s = __builtin_amdgcn_mfma_f32_32x32x16_bf16(kf, qf[k], s, 0, 0, 0); }
    return s;
}
__device__ __forceinline__ void pv_tile(f32x16 (&o)[2], const f32x16& p, const LAS unsigned char* vlds, int lane) {
    const int g = lane >> 4, i = lane & 15, h = lane >> 5;
    const LAS unsigned char* vb = vlds + (4 * h + (i >> 2)) * VROWV + (16 * (g & 1) + 4 * (i & 3)) * 2;
#pragma unroll
    for (int s = 0; s < 2; ++s) {
        u32x4 pw; pw.x = cvtpk(p[8 * s], p[8 * s + 1]); pw.y = cvtpk(p[8 * s + 2], p[8 * s + 3]); pw.z = cvtpk(p[8 * s + 4], p[8 * s + 5]); pw.w = cvtpk(p[8 * s + 6], p[8 * s + 7]);
        const bf16x8 pb = __builtin_bit_cast(bf16x8, pw);
#pragma unroll
        for (int df = 0; df < 2; ++df) {
            const s16x4 lo = vtr(vb + (16 * s) * VROWV + df * 64), hh = vtr(vb + (16 * s + 8) * VROWV + df * 64);
            const bf16x8 va = (bf16x8){lo[0], lo[1], lo[2], lo[3], hh[0], hh[1], hh[2], hh[3]};
            o[df] = __builtin_amdgcn_mfma_f32_32x32x16_bf16(va, pb, o[df], 0, 0, 0);
        }
    }
}
__device__ __forceinline__ void load_q(bf16x8 (&qf)[4], const bf16* base, int qpos, int qcol, int hi) {
    const bf16* rp = base + (size_t)qpos * QKV_LD + qcol + 8 * hi;
#pragma unroll
    for (int k = 0; k < 4; ++k) qf[k] = *(const bf16x8*)(rp + 16 * k);
}
__device__ __forceinline__ void store_o(bf16* yrow, const f32x16 (&o)[2], float inv, int hi) {
#pragma unroll
    for (int df = 0; df < 2; ++df)
#pragma unroll
        for (int g = 0; g < 4; ++g) {
            u32x2 w; w.x = cvtpk(o[df][4 * g] * inv, o[df][4 * g + 1] * inv); w.y = cvtpk(o[df][4 * g + 2] * inv, o[df][4 * g + 3] * inv);
            *(u32x2*)(yrow + 32 * df + 8 * g + 4 * hi) = w;
        }
}
__device__ __forceinline__ void osm_tile(f32x16& s, float& m, float& l, f32x16 (&o)[2]) {
    float mx = s[0];
#pragma unroll
    for (int r = 1; r < 16; ++r) mx = fmaxf(mx, s[r]);
    { auto rr = __builtin_amdgcn_permlane32_swap(__float_as_uint(mx), __float_as_uint(mx), false, false); mx = fmaxf(__uint_as_float(rr[0]), __uint_as_float(rr[1])); }
    const float mn = fmaxf(m, mx);
    const float ms = (mn == -INFINITY) ? 0.f : mn;
    const float alpha = __builtin_amdgcn_exp2f((m - ms) * SC2);
    const float mc = ms * SC2;
    float ps = 0.f;
#pragma unroll
    for (int r = 0; r < 16; ++r) { s[r] = __builtin_amdgcn_exp2f(s[r] * SC2 - mc); ps += s[r]; }
    l = l * alpha + ps; m = mn;
    if (!__all(alpha == 1.0f)) {
#pragma unroll
        for (int df = 0; df < 2; ++df)
#pragma unroll
            for (int r = 0; r < 16; ++r) o[df][r] *= alpha;
    }
}
__device__ __forceinline__ void osm_tile2(f32x16& s0, f32x16& s1, float& m, float& l, f32x16 (&o)[2]) {
    float mx = fmaxf(s0[0], s1[0]);
#pragma unroll
    for (int r = 1; r < 16; ++r) mx = fmaxf(mx, fmaxf(s0[r], s1[r]));
    { auto rr = __builtin_amdgcn_permlane32_swap(__float_as_uint(mx), __float_as_uint(mx), false, false); mx = fmaxf(__uint_as_float(rr[0]), __uint_as_float(rr[1])); }
    const float mn = fmaxf(m, mx);
    const float ms = (mn == -INFINITY) ? 0.f : mn;
    const float alpha = __builtin_amdgcn_exp2f((m - ms) * SC2);
    const float mc = ms * SC2;
    float ps0 = 0.f, ps1 = 0.f;
#pragma unroll
    for (int r = 0; r < 16; ++r) { s0[r] = __builtin_amdgcn_exp2f(s0[r] * SC2 - mc); ps0 += s0[r]; s1[r] = __builtin_amdgcn_exp2f(s1[r] * SC2 - mc); ps1 += s1[r]; }
    l = l * alpha + (ps0 + ps1); m = mn;
    if (!__all(alpha == 1.0f)) {
#pragma unroll
        for (int df = 0; df < 2; ++df)
#pragma unroll
            for (int r = 0; r < 16; ++r) o[df][r] *= alpha;
    }
}
#define ZERO16 {0.f, 0.f, 0.f, 0.f, 0.f, 0.f, 0.f, 0.f, 0.f, 0.f, 0.f, 0.f, 0.f, 0.f, 0.f, 0.f}

struct AttnCtx {
    const bf16* base; int kcol, vcol, r32, hi, lane; LAS unsigned char* vlds; LAS unsigned char* klds; bf16x8 qf[4]; f32x16 o[2];
};
#define ATTN_STEP(SC, SL, T) { \
        if (SYNC) __builtin_amdgcn_s_barrier(); \
        { int kp_, ks_; const int tl_ = (T) + 2 < nt ? (T) + 2 : nt - 1; mx.pos(tl_, kp_, ks_); load_kv(SL, c.base, kp_, ks_, c.kcol, c.vcol, c.lane); } \
        kv_stage(SC, c.klds, c.vlds, c.lane); f32x16 s_ = qk_tile(c.klds, c.qf, c.r32, c.hi); \
        const bool stop_ = mx.process((T), s_, c); pv_tile(c.o, s_, c.vlds, c.lane); \
        if ((!SYNC && stop_) || (T) + 1 >= nt) break; }
template <class M, bool SYNC> __device__ __forceinline__ void attn_run(M& mx, AttnCtx& c) {
    const int nt = mx.nt;
    KVRegs S0, S1, S2;
    { int kp, ks; mx.pos(0, kp, ks); load_kv(S0, c.base, kp, ks, c.kcol, c.vcol, c.lane);
      mx.pos(1 < nt ? 1 : nt - 1, kp, ks); load_kv(S1, c.base, kp, ks, c.kcol, c.vcol, c.lane); }
    for (int t = 0;; t += 3) {
        ATTN_STEP(S0, S2, t)
        ATTN_STEP(S1, S0, t + 1)
        ATTN_STEP(S2, S1, t + 2)
    }
}
#define SH_BAR() asm volatile("s_waitcnt lgkmcnt(0)\n\ts_barrier" ::: "memory")
constexpr int SLOT_K = 64 * VROW, SLOT_BYTES = 64 * VROW + 64 * VROWV;
struct ShRegs { u32x4 a, b; };
__device__ __forceinline__ void sh_load(ShRegs& R, const bf16* base, int kp0, int kcol, int vcol, int w, int lane) {
    const int pos = kp0 + 4 * w + ((lane & 31) >> 3);
    const int pa = pos < SQ - 1 ? pos : SQ - 1, pb = pos + 32 < SQ - 1 ? pos + 32 : SQ - 1;
    const int col = ((lane >> 5) ? vcol : kcol) + (lane & 7) * 8;
    R.a = *(const u32x4*)(base + (size_t)pa * QKV_LD + col); R.b = *(const u32x4*)(base + (size_t)pb * QKV_LD + col);
}
__device__ __forceinline__ void sh_write(LAS unsigned char* slot, const ShRegs& R, int w, int lane) {
    const int row = 4 * w + ((lane & 31) >> 3);
    LAS unsigned char* p = slot + ((lane >> 5) ? SLOT_K + row * VROWV : row * VROW) + (lane & 7) * 16;
    *(LAS u32x4*)p = R.a; *(LAS u32x4*)(p + 32 * ((lane >> 5) ? VROWV : VROW)) = R.b;
}
#define SH_STEP(RW, RL, T) { \
        SH_BAR(); \
        { const int tl_ = (T) + 2 < nt ? (T) + 2 : nt - 1; sh_load(RL, c.base, mx.pos2(tl_), c.kcol, c.vcol, w, c.lane); } \
        sh_write(slots + (((T) + 1) & 1) * SLOT_BYTES, RW, w, c.lane); \
        if (mx.active2((T), w)) { LAS unsigned char* sl_ = slots + ((T) & 1) * SLOT_BYTES; \
            f32x16 s0_ = qk_tile(sl_, c.qf, c.r32, c.hi), s1_ = qk_tile(sl_ + 32 * VROW, c.qf, c.r32, c.hi); mx.process2((T), s0_, s1_, c); \
            pv_tile(c.o, s0_, sl_ + SLOT_K, c.lane); pv_tile(c.o, s1_, sl_ + SLOT_K + 32 * VROWV, c.lane); } \
        if ((T) + 1 >= nt) break; }
template <class M> __device__ __forceinline__ void attn_run_shared(M& mx, AttnCtx& c, LAS unsigned char* slots, int w) {
    const int nt = mx.nt2;
    ShRegs R0, R1, R2;
    sh_load(R0, c.base, mx.pos2(0), c.kcol, c.vcol, w, c.lane);
    sh_load(R1, c.base, mx.pos2(1 < nt ? 1 : nt - 1), c.kcol, c.vcol, w, c.lane);
    SH_BAR();
    sh_write(slots, R0, w, c.lane);
    for (int t = 0;; t += 3) {
        SH_STEP(R1, R2, t)
        SH_STEP(R2, R0, t + 1)
        SH_STEP(R0, R1, t + 2)
    }
}
struct MixA {
    int nt, k00, qpos; float m, l;
    __device__ __forceinline__ void pos(int idx, int& kp0, int& kst) const { kp0 = k00 + 32 * idx; kst = 1; }
    __device__ __forceinline__ bool process(int idx, f32x16& s, AttnCtx& c) {
        const int k0 = k00 + 32 * idx;
#pragma unroll
        for (int r = 0; r < 16; ++r) { const int dist = qpos - (k0 + crow(r, c.hi)); if (dist < 0 || dist > 127) s[r] = -INFINITY; }
        osm_tile(s, m, l, c.o); return false;
    }
};
__device__ void attn_A(const bf16* base, int hq, int q0, float sink, bf16* ybase, LAS unsigned char* vlds, int lane) {
    AttnCtx c; c.base = base; c.r32 = lane & 31; c.hi = lane >> 5; c.lane = lane; c.vlds = vlds; c.klds = vlds + VBUFV; c.kcol = 512 + (hq >> 2) * 64; c.vcol = 640 + (hq >> 2) * 64;
    c.o[0] = (f32x16)ZERO16; c.o[1] = (f32x16)ZERO16;
    MixA mx; mx.qpos = q0 + c.r32; mx.k00 = q0 - 128 > 0 ? q0 - 128 : 0; mx.nt = 5; mx.m = -INFINITY; mx.l = 0.f;
    load_q(c.qf, base, mx.qpos, hq * 64, c.hi);
    attn_run<MixA, true>(mx, c);
    float l = mx.l + xhalf(mx.l, c.hi);
    l += __builtin_amdgcn_exp2f(sink * L2E - mx.m * SC2);
    store_o(ybase + (size_t)mx.qpos * DM + hq * 64, c.o, 1.0f / l, c.hi);
}
struct MixB {
    int nt, q0, qpos; float carry;
    __device__ __forceinline__ void pos(int idx, int& kp0, int& kst) const { kp0 = q0 - 32 * idx; kst = 1; }
    __device__ __forceinline__ bool process(int idx, f32x16& s, AttnCtx& c) {
        const int k0 = q0 - 32 * idx, hi = c.hi;
        float lk[16], G[4], Gp[4];
#pragma unroll
        for (int r = 0; r < 16; ++r) {
            const float z = s[r] * 0.125f;
            const bool valid = (k0 + crow(r, hi)) < qpos;
            const float sp = fmaxf(z, 0.f) + LN2 * __builtin_amdgcn_logf(1.0f + __builtin_amdgcn_exp2f(-fabsf(z) * L2E));
            lk[r] = valid ? -sp : 0.f;
            s[r] = valid ? (z - sp) : -INFINITY;
        }
#pragma unroll
        for (int g = 0; g < 4; ++g) { G[g] = (lk[4 * g] + lk[4 * g + 1]) + (lk[4 * g + 2] + lk[4 * g + 3]); Gp[g] = xhalf(G[g], hi); }
        float above = carry;
#pragma unroll
        for (int g = 3; g >= 0; --g) {
            float off = above + (hi == 0 ? Gp[g] : 0.f);
            s[4 * g + 3] = __builtin_amdgcn_exp2f((s[4 * g + 3] + off) * L2E); off += lk[4 * g + 3];
            s[4 * g + 2] = __builtin_amdgcn_exp2f((s[4 * g + 2] + off) * L2E); off += lk[4 * g + 2];
            s[4 * g + 1] = __builtin_amdgcn_exp2f((s[4 * g + 1] + off) * L2E); off += lk[4 * g + 1];
            s[4 * g + 0] = __builtin_amdgcn_exp2f((s[4 * g + 0] + off) * L2E);
            above += G[g] + Gp[g];
        }
        carry = above;
        return __all(carry < -40.0f) != 0;
    }
};
__device__ void attn_B(const bf16* base, int h, int q0, bf16* ybase, LAS unsigned char* vlds, int lane) {
    AttnCtx c; c.base = base; c.r32 = lane & 31; c.hi = lane >> 5; c.lane = lane; c.vlds = vlds; c.klds = vlds + VBUFV; c.kcol = 1280 + h * 64; c.vcol = 1792 + h * 64;
    c.o[0] = (f32x16)ZERO16; c.o[1] = (f32x16)ZERO16;
    MixB mx; mx.q0 = q0; mx.qpos = q0 + c.r32; mx.nt = q0 / 32 + 1; mx.carry = 0.f;
    load_q(c.qf, base, mx.qpos, 768 + h * 64, c.hi);
    attn_run<MixB, false>(mx, c);
    store_o(ybase + (size_t)mx.qpos * DM + 512 + h * 64, c.o, 1.0f, c.hi);
}
struct MixCp {
    int nt, n0, r0, j1lo, qpos; float m, l;
    __device__ __forceinline__ void pos(int t, int& kp0, int& kst) const {
        if (t < n0) { kp0 = r0 + 512 * t; kst = 16; } else { kp0 = (r0 & 3) + 4 * (j1lo + 32 * (t - n0)); kst = 4; }
    }
    __device__ __forceinline__ bool process(int t, f32x16& s, AttnCtx& c) {
        int kp0, kst; pos(t, kp0, kst);
        const int win = t < n0 ? 2048 : 512;
#pragma unroll
        for (int r = 0; r < 16; ++r) { const int dist = qpos - (kp0 + kst * crow(r, c.hi)); if (dist < 0 || dist > win) s[r] = -INFINITY; }
        osm_tile(s, m, l, c.o); return false;
    }
};
struct MixC1 {
    int nt2, p0, qpos; float m, l;
    __device__ __forceinline__ int pos2(int T) const { return p0 + 64 * T; }
    __device__ __forceinline__ bool active2(int T, int w) const { return true; }
    __device__ __forceinline__ void process2(int T, f32x16& s0, f32x16& s1, AttnCtx& c) {
        const int k0 = p0 + 64 * T;
#pragma unroll
        for (int r = 0; r < 16; ++r) { const int dist = qpos - (k0 + crow(r, c.hi)); if (dist < 0 || dist > 128) s0[r] = -INFINITY; if (dist < 32 || dist > 160) s1[r] = -INFINITY; }
        osm_tile2(s0, s1, m, l, c.o);
    }
};
__device__ void attn_C(const bf16* base, int h, int r0, int g, bf16* ybase, LAS unsigned char* vlds, LAS unsigned char* xlds, int w, int lane) {
    AttnCtx c; c.base = base; c.r32 = lane & 31; c.hi = lane >> 5; c.lane = lane; c.vlds = vlds; c.klds = vlds + VBUFV; c.kcol = 512 + h * 64; c.vcol = 1024 + h * 64;
    c.o[0] = (f32x16)ZERO16; c.o[1] = (f32x16)ZERO16;
    const int qpos = r0 + 16 * (32 * g + c.r32);
    load_q(c.qf, base, qpos, h * 64, c.hi);
    MixCp mp; mp.r0 = r0; mp.qpos = qpos; mp.m = -INFINITY; mp.l = 0.f;
    mp.n0 = g + 1;
    mp.j1lo = (r0 >> 2) + 128 * g - 128 > 0 ? (r0 >> 2) + 128 * g - 128 : 0;
    mp.nt = mp.n0 + ((r0 >> 2) + 128 * g + 124 - mp.j1lo) / 32 + 1;
    attn_run<MixCp, true>(mp, c);
    MixC1 m1; m1.qpos = qpos; m1.m = mp.m; m1.l = mp.l;
    const int ra = r0 & 8;
    m1.p0 = 512 * g + ra - 128 > 0 ? 512 * g + ra - 128 : 0;
    m1.nt2 = ((512 * g + ra + 7 + 496 - m1.p0) / 32 + 2) / 2;
    attn_run_shared<MixC1>(m1, c, xlds + 64, w);
    const float l = m1.l + xhalf(m1.l, c.hi);
    store_o(ybase + (size_t)qpos * DM + h * 64, c.o, 1.0f / l, c.hi);
}
struct MixD {
    int nt, nt2, npast, own, q0, qpos; unsigned U, sel; float m, l;
    __device__ __forceinline__ int blk_of(int j) const {
        unsigned u = U; int b = 0;
#pragma unroll
        for (int i = 0; i < 7; ++i) { if (i < j) u &= u - 1u; }
        b = __builtin_ctz(u | 0x100u); return b;
    }
    __device__ __forceinline__ void pos(int t, int& kp0, int& kst) const {
        kst = 1;
        if (t < 8 * npast) kp0 = blk_of(t >> 3) * 256 + (t & 7) * 32; else kp0 = own * 256 + (t - 8 * npast) * 32;
    }
    __device__ __forceinline__ int pos2(int T) const { int kp, ks; pos(2 * T, kp, ks); return kp; }
    __device__ __forceinline__ bool active2(int T, int w) const { return T < 4 * npast || 2 * (T - 4 * npast) <= w; }
    __device__ __forceinline__ void process2(int T, f32x16& s0, f32x16& s1, AttnCtx& c) {
        if (T < 4 * npast) {
            const int blk = blk_of(T >> 2);
            if (!((sel >> blk) & 1u)) {
#pragma unroll
                for (int r = 0; r < 16; ++r) { s0[r] = -INFINITY; s1[r] = -INFINITY; }
            }
        } else {
            const int k0 = own * 256 + (T - 4 * npast) * 64;
#pragma unroll
            for (int r = 0; r < 16; ++r) { const int kk = k0 + crow(r, c.hi); if (kk > qpos) s0[r] = -INFINITY; if (kk + 32 > qpos) s1[r] = -INFINITY; }
        }
        osm_tile2(s0, s1, m, l, c.o);
    }
};
__device__ void attn_D(const bf16* base, const float* kmean  , int h, int q0, bf16* ybase, LAS unsigned char* vlds, LAS unsigned char* xlds, int lane) {
    AttnCtx c; c.base = base; c.r32 = lane & 31; c.hi = lane >> 5; c.lane = lane; c.vlds = vlds; c.klds = vlds + VBUFV; c.kcol = 2048 + h * 64; c.vcol = 2560 + h * 64;
    c.o[0] = (f32x16)ZERO16; c.o[1] = (f32x16)ZERO16;
    const int r32 = c.r32, hi = c.hi, own = q0 >> 8;
    MixD mx; mx.own = own; mx.q0 = q0; mx.qpos = q0 + r32; mx.m = -INFINITY; mx.l = 0.f;
    load_q(c.qf, base, mx.qpos, 1536 + h * 64, hi);
    unsigned sel = 0u;
    if (own > 0) {
        bf16x8 kf[4];
#pragma unroll
        for (int k = 0; k < 4; ++k) {
            u32x4 w = {0u, 0u, 0u, 0u};
            if (r32 < 8) { const float* kp = kmean + r32 * 64 + 16 * k + 8 * hi; const f32x4 a = *(const f32x4*)kp, b = *(const f32x4*)(kp + 4);
                w.x = cvtpk(a[0], a[1]); w.y = cvtpk(a[2], a[3]); w.z = cvtpk(b[0], b[1]); w.w = cvtpk(b[2], b[3]); }
            kf[k] = __builtin_bit_cast(bf16x8, w);
        }
        f32x16 gs = ZERO16;
#pragma unroll
        for (int k = 0; k < 4; ++k) gs = __builtin_amdgcn_mfma_f32_32x32x16_bf16(kf[k], c.qf[k], gs, 0, 0, 0);
        float gt[8];
#pragma unroll
        for (int r = 0; r < 4; ++r) { const float mine = gs[r], oth = xhalf(mine, hi); gt[r] = hi == 0 ? mine : oth; gt[4 + r] = hi == 0 ? oth : mine; }
        const int nsel = own < 3 ? own : 3;
        for (int rr = 0; rr < nsel; ++rr) {
            float best = -INFINITY; int bi = -1;
#pragma unroll
            for (int n = 0; n < 8; ++n) { const bool ok = n < own && !((sel >> n) & 1u) && (bi < 0 || gt[n] > best); if (ok) { best = gt[n]; bi = n; } }
            if (bi >= 0) sel |= 1u << bi;
        }
    }
    unsigned U = 0u;
#pragma unroll
    for (int n = 0; n < 8; ++n) if (__ballot((sel >> n) & 1u) != 0ull) U |= 1u << n;
    {
        volatile LAS unsigned* ux = (volatile LAS unsigned*)xlds;
        __builtin_amdgcn_s_barrier();
        if (lane == 0) ux[(q0 >> 5) & 7] = U;
        asm volatile("s_waitcnt lgkmcnt(0)" ::: "memory");
        __builtin_amdgcn_s_barrier();
        U = ux[0] | ux[1] | ux[2] | ux[3] | ux[4] | ux[5] | ux[6] | ux[7];
        U = __builtin_amdgcn_readfirstlane(U);
    }
    mx.U = U; mx.sel = sel; mx.npast = __builtin_popcount(U); mx.nt = 8 * mx.npast + 8; mx.nt2 = 4 * mx.npast + 4;
    attn_run_shared<MixD>(mx, c, xlds + 64, (q0 >> 5) & 7);
    const float l = mx.l + xhalf(mx.l, c.hi);
    store_o(ybase + (size_t)mx.qpos * DM + 512 + h * 64, c.o, 1.0f / l, hi);
}

__device__ void ph_attn0(const bf16* qkv, const float* sinks, bf16* y, LAS unsigned char* lds, int bid, int nb) {
    const int lane = ltid() & 63, w = __builtin_amdgcn_readfirstlane(ltid() >> 6);
    LAS unsigned char* vlds = lds + w * (VBUF + VBUFV);
    for (int pid = bid; pid < NB * 8; pid += nb) {
        const int b = pid >> 3, h = pid & 7;
        const bf16* base = qkv + (size_t)b * SQ * QKV_LD; bf16* ybase = y + (size_t)b * SQ * DM;
        const float sink = sinks[h];
        for (int rd = 0; rd < 8; ++rd) attn_A(base, h, (rd * 8 + w) * 32, sink, ybase, vlds, lane);
        for (int rd = 0; rd < 8; ++rd) attn_B(base, h, (rd * 8 + w) * 32, ybase, vlds, lane);
    }
}
__device__ void ph_attn1(const bf16* qkv, const float* kmean, bf16* y, LAS unsigned char* lds, int bid, int nb) {
    const int lane = ltid() & 63, w = __builtin_amdgcn_readfirstlane(ltid() >> 6);
    LAS unsigned char* vlds = lds + w * (VBUF + VBUFV);
    for (int pid = bid; pid < NB * 8; pid += nb) {
        const int b = pid >> 3, h = pid & 7;
        const bf16* base = qkv + (size_t)b * SQ * QKV_LD; bf16* ybase = y + (size_t)b * SQ * DM;
        for (int rd = 0; rd < 8; ++rd) { const int it = rd * 8 + w; attn_C(base, h, it & 15, it >> 4, ybase, vlds, lds + 8 * (VBUF + VBUFV), w, lane); }
        for (int rd = 0; rd < 8; ++rd) attn_D(base, kmean + (size_t)pid * 8 * 64, h, (rd * 8 + w) * 32, ybase, vlds, lds + 8 * (VBUF + VBUFV), lane);
    }
}

#define CE_D(a, b) { const float hi_ = fmaxf((a), (b)), lo_ = fminf((a), (b)); (a) = hi_; (b) = lo_; }
#define BSTAGE(arr, k, j) _Pragma("unroll") for (int i_ = 0; i_ < 16; ++i_) { const int l_ = i_ ^ (j); if (l_ > i_) { if ((i_ & (k)) == 0) CE_D(arr[i_], arr[l_]) else CE_D(arr[l_], arr[i_]) } }
__device__ __forceinline__ void bsort16(float (&a)[16]) {
    BSTAGE(a, 2, 1) BSTAGE(a, 4, 2) BSTAGE(a, 4, 1) BSTAGE(a, 8, 4) BSTAGE(a, 8, 2) BSTAGE(a, 8, 1) BSTAGE(a, 16, 8) BSTAGE(a, 16, 4) BSTAGE(a, 16, 2) BSTAGE(a, 16, 1)
}
__device__ __forceinline__ void bmerge16(float (&a)[16]) {
    BSTAGE(a, 16, 8) BSTAGE(a, 16, 4) BSTAGE(a, 16, 2) BSTAGE(a, 16, 1)
}
__device__ __forceinline__ void merge_top16(float (&a)[16], const float (&b)[16]) {
#pragma unroll
    for (int i = 0; i < 16; ++i) a[i] = fmaxf(a[i], b[15 - i]);
    bmerge16(a);
}
__device__ __forceinline__ void xmerge16(float (&a)[16]) {
    {
        float A[16], B[16];
#pragma unroll
        for (int i = 0; i < 16; ++i) { auto r = __builtin_amdgcn_permlane16_swap(__float_as_uint(a[i]), __float_as_uint(a[i]), false, false); A[i] = __uint_as_float(r[0]); B[i] = __uint_as_float(r[1]); }
#pragma unroll
        for (int i = 0; i < 16; ++i) a[i] = fmaxf(A[i], B[15 - i]);
        bmerge16(a);
    }
    {
        float A[16], B[16];
#pragma unroll
        for (int i = 0; i < 16; ++i) { auto r = __builtin_amdgcn_permlane32_swap(__float_as_uint(a[i]), __float_as_uint(a[i]), false, false); A[i] = __uint_as_float(r[0]); B[i] = __uint_as_float(r[1]); }
#pragma unroll
        for (int i = 0; i < 16; ++i) a[i] = fmaxf(A[i], B[15 - i]);
        bmerge16(a);
    }
}
__host__ __device__ constexpr int pair_i(int id) {
    int c = 0;
    for (int i = 0; i < 16; ++i) { const int nj = 16 / (i + 1); if (id < c + nj) return i; c += nj; }
    return 0;
}
__host__ __device__ constexpr int pair_j(int id) {
    int c = 0;
    for (int i = 0; i < 16; ++i) { const int nj = 16 / (i + 1); if (id < c + nj) return id - c; c += nj; }
    return 0;
}
constexpr int SK_ROW = 272;
constexpr int SEL_SK_BYTES = 2 * 128 * SK_ROW;
constexpr int SEL_TAB_OFF = SEL_SK_BYTES;
constexpr int SEL_IDX_OFF = SEL_SK_BYTES + 64;

template <int S> __device__ __forceinline__ float cand_slot(const float (&L1)[16], const float (&L2)[16], int g) {
    constexpr int p0 = S, p1 = 16 + S, p2 = 32 + S, p3 = 48 + S;
    const float c0 = L1[pair_i(p0)] + L2[pair_j(p0)], c1 = L1[pair_i(p1)] + L2[pair_j(p1)], c2 = L1[pair_i(p2)] + L2[pair_j(p2)];
    const float c3 = p3 < 50 ? L1[pair_i(p3 < 50 ? p3 : 0)] + L2[pair_j(p3 < 50 ? p3 : 0)] : -1.0e30f;
    const float c = g == 0 ? c0 : (g == 1 ? c1 : (g == 2 ? c2 : c3));
    return __uint_as_float((__float_as_uint(c) & 0xffffffc0u) | (unsigned)(16 * g + S));
}

__device__ void ph_peer_select(const bf16* qry, const float* subkeys  , int* eidx, float* egate, LAS unsigned char* lds, int bid, int nb) {
    const int tid = ltid(), lane = tid & 63, w = __builtin_amdgcn_readfirstlane(tid >> 6);
    const int tk = lane & 15, g = lane >> 4;
    __syncthreads();
    for (int e = tid; e < 2 * 128 * 128 / 2; e += NT) {
        const int row = e >> 6, c2 = (e & 63) * 2;
        const float a = subkeys[(size_t)row * 128 + c2], b = subkeys[(size_t)row * 128 + c2 + 1];
        *(LAS unsigned*)(lds + row * SK_ROW + c2 * 2) = pk2(a, b);
    }
    if (tid < 64) { int id = tid; int c = 0, pi = 0, pj = 0;
        for (int i = 0; i < 16; ++i) { const int nj = 16 / (i + 1); if (id >= c && id < c + nj) { pi = i; pj = id - c; } c += nj; }
        lds[SEL_TAB_OFF + tid] = (unsigned char)((pi << 4) | pj); }
    __syncthreads();
    LAS unsigned* widx = (LAS unsigned*)(lds + SEL_IDX_OFF + w * 512);
    const LAS unsigned char* widx8 = (const LAS unsigned char*)widx;
    const int nitems = (MT / 16) * 8;
    bf16x8 qc[2][4];
    { const int it = bid * 8 + w;
      if (it < nitems) { const bf16* qp = qry + (size_t)((it >> 3) * 16 + tk) * PQ + (it & 7) * 256 + 8 * g;
#pragma unroll
          for (int hf = 0; hf < 2; ++hf)
#pragma unroll
              for (int ks = 0; ks < 4; ++ks) qc[hf][ks] = *(const bf16x8*)(qp + hf * 128 + 32 * ks); } }
    for (int it = bid * 8 + w; it < nitems; it += nb * 8) {
        const int h = it & 7, t0 = (it >> 3) * 16;
        bf16x8 qn[2][4];
        { const int itn = it + nb * 8 < nitems ? it + nb * 8 : it;
          const bf16* qp = qry + (size_t)((itn >> 3) * 16 + tk) * PQ + (itn & 7) * 256 + 8 * g;
#pragma unroll
          for (int hf = 0; hf < 2; ++hf)
#pragma unroll
              for (int ks = 0; ks < 4; ++ks) qn[hf][ks] = *(const bf16x8*)(qp + hf * 128 + 32 * ks); }
        float L[2][16];
#pragma unroll
        for (int hf = 0; hf < 2; ++hf) {
            bf16x8 qf[4];
#pragma unroll
            for (int ks = 0; ks < 4; ++ks) qf[ks] = qc[hf][ks];
            float key[32];
#pragma unroll
            for (int tile = 0; tile < 8; ++tile) {
                f32x4 acc = {0.f, 0.f, 0.f, 0.f};
#pragma unroll
                for (int ks = 0; ks < 4; ++ks) {
                    const bf16x8 af = *(const LAS bf16x8*)(lds + (hf * 128 + tile * 16 + tk) * SK_ROW + (32 * ks + 8 * g) * 2);
                    acc = __builtin_amdgcn_mfma_f32_16x16x32_bf16(af, qf[ks], acc, 0, 0, 0);
                }
#pragma unroll
                for (int r = 0; r < 4; ++r) key[tile * 4 + r] = __uint_as_float((__float_as_uint(acc[r]) & 0xffffff80u) | (unsigned)(16 * tile + 4 * g + r));
            }
            float a[16], b[16];
#pragma unroll
            for (int i = 0; i < 16; ++i) { a[i] = key[i]; b[i] = key[16 + i]; }
            bsort16(a); bsort16(b);
            merge_top16(a, b);
            xmerge16(a);
#pragma unroll
            for (int i = 0; i < 16; ++i) L[hf][i] = a[i];
            unsigned pk = 0u;
#pragma unroll
            for (int s = 0; s < 4; ++s) {
                const float v = g == 0 ? a[s] : (g == 1 ? a[4 + s] : (g == 2 ? a[8 + s] : a[12 + s]));
                pk |= (__float_as_uint(v) & 127u) << (8 * s);
            }
            widx[tk * 8 + hf * 4 + g] = pk;
        }
        float c[16];
        c[0] = cand_slot<0>(L[0], L[1], g); c[1] = cand_slot<1>(L[0], L[1], g); c[2] = cand_slot<2>(L[0], L[1], g); c[3] = cand_slot<3>(L[0], L[1], g);
        c[4] = cand_slot<4>(L[0], L[1], g); c[5] = cand_slot<5>(L[0], L[1], g); c[6] = cand_slot<6>(L[0], L[1], g); c[7] = cand_slot<7>(L[0], L[1], g);
        c[8] = cand_slot<8>(L[0], L[1], g); c[9] = cand_slot<9>(L[0], L[1], g); c[10] = cand_slot<10>(L[0], L[1], g); c[11] = cand_slot<11>(L[0], L[1], g);
        c[12] = cand_slot<12>(L[0], L[1], g); c[13] = cand_slot<13>(L[0], L[1], g); c[14] = cand_slot<14>(L[0], L[1], g); c[15] = cand_slot<15>(L[0], L[1], g);
        bsort16(c);
        xmerge16(c);
        float sum = 0.f, ex[16];
#pragma unroll
        for (int i = 0; i < 16; ++i) { ex[i] = __builtin_amdgcn_exp2f((c[i] - c[0]) * L2E); sum += ex[i]; }
        const float inv = 1.0f / sum;
        int oi[4]; float og[4];
#pragma unroll
        for (int s = 0; s < 4; ++s) {
            const float kv = g == 0 ? c[s] : (g == 1 ? c[4 + s] : (g == 2 ? c[8 + s] : c[12 + s]));
            const float ev = g == 0 ? ex[s] : (g == 1 ? ex[4 + s] : (g == 2 ? ex[8 + s] : ex[12 + s]));
            const unsigned pid = __float_as_uint(kv) & 63u;
            const unsigned ij = lds[SEL_TAB_OFF + pid];
            const unsigned i1 = widx8[tk * 32 + (ij >> 4)], i2 = widx8[tk * 32 + 16 + (ij & 15u)];
            oi[s] = (int)(i1 * 128u + i2); og[s] = ev * inv;
        }
        const size_t ob = (size_t)(t0 + tk) * 128 + h * 16 + 4 * g;
        *(u32x4*)(eidx + ob) = (u32x4){(unsigned)oi[0], (unsigned)oi[1], (unsigned)oi[2], (unsigned)oi[3]};
        *(f32x4*)(egate + ob) = (f32x4){og[0], og[1], og[2], og[3]};
#pragma unroll
        for (int hf = 0; hf < 2; ++hf)
#pragma unroll
            for (int ks = 0; ks < 4; ++ks) qc[hf][ks] = qn[hf][ks];
    }
    __syncthreads();
}

typedef float v32f_t __attribute__((ext_vector_type(32)));
typedef unsigned v6u_t __attribute__((ext_vector_type(6)));
typedef unsigned v16u_t __attribute__((ext_vector_type(16)));
typedef __bf16 v32bf_t __attribute__((ext_vector_type(32)));
typedef __bf16 v2bf_t __attribute__((ext_vector_type(2)));
typedef _Float16 v32h_t __attribute__((ext_vector_type(32)));
typedef unsigned u32x3 __attribute__((ext_vector_type(3)));
constexpr int TROW = 768;
__device__ void ph_tab_fp6(const float* src, unsigned char* dst, float* scale, int nrows, int bid, int nb) {
    const int lane = ltid() & 63, w = __builtin_amdgcn_readfirstlane(ltid() >> 6);
    for (int rp = bid * 8 + w; rp < nrows / 2; rp += nb * 8) {
        v32h_t hv; float sc[2];
#pragma unroll
        for (int rr = 0; rr < 2; ++rr) {
            const float* sp = src + (size_t)(2 * rp + rr) * DM + lane * 16;
            f32x4 v[4]; float am = 0.f;
#pragma unroll
            for (int i = 0; i < 4; ++i) { v[i] = *(const f32x4*)(sp + i * 4); am = fmaxf(am, fmaxf(fmaxf(fabsf(v[i][0]), fabsf(v[i][1])), fmaxf(fabsf(v[i][2]), fabsf(v[i][3])))); }
            am = wave_max(am);
            const float s = am > 0.f ? am * (1.0f / 7.5f) : 1.0f, inv = 1.0f / s;
            sc[rr] = s;
#pragma unroll
            for (int i = 0; i < 4; ++i)
#pragma unroll
                for (int e = 0; e < 4; ++e) hv[rr * 16 + i * 4 + e] = (_Float16)fminf(fmaxf(v[i][e] * inv, -7.5f), 7.5f);
        }
        const v6u_t pk = __builtin_amdgcn_cvt_scalef32_pk32_fp6_f16(hv, 1.0f);
        unsigned* d0 = (unsigned*)(dst + (size_t)(2 * rp) * TROW + lane * 12);
        unsigned* d1 = (unsigned*)(dst + (size_t)(2 * rp + 1) * TROW + lane * 12);
        d0[0] = pk[0]; d0[1] = pk[1]; d0[2] = pk[2]; d1[0] = pk[3]; d1[1] = pk[4]; d1[2] = pk[5];
        if (lane == 0) { scale[2 * rp] = sc[0]; scale[2 * rp + 1] = sc[1]; }
    }
}

constexpr int TROW4 = 512;
__device__ void ph_tab_fp4(const float* src, unsigned char* dst, float* scale, int nrows, int bid, int nb) {
    const int lane = ltid() & 63, w = __builtin_amdgcn_readfirstlane(ltid() >> 6);
    for (int row = bid * 8 + w; row < nrows; row += nb * 8) {
        const float* sp = src + (size_t)row * DM + lane * 16;
        f32x4 v[4]; float am = 0.f;
#pragma unroll
        for (int i = 0; i < 4; ++i) { v[i] = *(const f32x4*)(sp + i * 4); am = fmaxf(am, fmaxf(fmaxf(fabsf(v[i][0]), fabsf(v[i][1])), fmaxf(fabsf(v[i][2]), fabsf(v[i][3])))); }
        am = wave_max(am);
        const float s = am > 0.f ? am * (1.0f / 6.0f) : 1.0f, inv = 1.0f / s;
        unsigned d0 = 0u, d1 = 0u;
        d0 = __builtin_amdgcn_cvt_scalef32_pk_fp4_f32(d0, v[0][0] * inv, v[0][1] * inv, 1.0f, 0); d0 = __builtin_amdgcn_cvt_scalef32_pk_fp4_f32(d0, v[0][2] * inv, v[0][3] * inv, 1.0f, 1);
        d0 = __builtin_amdgcn_cvt_scalef32_pk_fp4_f32(d0, v[1][0] * inv, v[1][1] * inv, 1.0f, 2); d0 = __builtin_amdgcn_cvt_scalef32_pk_fp4_f32(d0, v[1][2] * inv, v[1][3] * inv, 1.0f, 3);
        d1 = __builtin_amdgcn_cvt_scalef32_pk_fp4_f32(d1, v[2][0] * inv, v[2][1] * inv, 1.0f, 0); d1 = __builtin_amdgcn_cvt_scalef32_pk_fp4_f32(d1, v[2][2] * inv, v[2][3] * inv, 1.0f, 1);
        d1 = __builtin_amdgcn_cvt_scalef32_pk_fp4_f32(d1, v[3][0] * inv, v[3][1] * inv, 1.0f, 2); d1 = __builtin_amdgcn_cvt_scalef32_pk_fp4_f32(d1, v[3][2] * inv, v[3][3] * inv, 1.0f, 3);
        *(u32x2*)(dst + (size_t)row * TROW4 + lane * 8) = (u32x2){d0, d1};
        if (lane == 0) scale[row] = s;
    }
}

__device__ void ph_tab_i4(const float* src, unsigned char* dst, float* scale, int nrows, int bid, int nb) {
    const int lane = ltid() & 63, w = __builtin_amdgcn_readfirstlane(ltid() >> 6);
    for (int row = bid * 8 + w; row < nrows; row += nb * 8) {
        const float* sp = src + (size_t)row * DM + lane * 16;
        f32x4 v[4]; float am = 0.f;
#pragma unroll
        for (int i = 0; i < 4; ++i) { v[i] = *(const f32x4*)(sp + i * 4); am = fmaxf(am, fmaxf(fmaxf(fabsf(v[i][0]), fabsf(v[i][1])), fmaxf(fabsf(v[i][2]), fabsf(v[i][3])))); }
        am = wave_max(am);
        const float s = am > 0.f ? am * (1.0f / 7.0f) : 1.0f, inv = 1.0f / s;
        unsigned d[2] = {0u, 0u};
#pragma unroll
        for (int i = 0; i < 16; ++i) { const int q = (int)rintf(fminf(fmaxf(v[i >> 2][i & 3] * inv, -7.0f), 7.0f)); d[i >> 3] |= ((unsigned)q & 15u) << (4 * (i & 7)); }
        *(u32x2*)(dst + (size_t)row * TROW4 + lane * 8) = (u32x2){d[0], d[1]};
        if (lane == 0) scale[row] = s;
    }
}

#define DPP_ADD(v, ctrl) ((v) + __builtin_bit_cast(float, __builtin_amdgcn_update_dpp(0, __builtin_bit_cast(int, (v)), (ctrl), 0xf, 0xf, true)))
typedef int i32x4_t __attribute__((ext_vector_type(4)));
constexpr int GT = 2;
typedef int v8i_t __attribute__((ext_vector_type(8)));
typedef int v2i_t __attribute__((ext_vector_type(2)));
struct GSet { u32x2 uq[4]; u32x2 vq[4]; };
__device__ __forceinline__ void gather_issue(GSet& S, int bt, int lane, const unsigned char* pu, const unsigned char* pv, const LAS int* etok) {
    const i32x4_t ev = *(const LAS i32x4_t*)(etok + bt * 4);
    const int es[4] = {ev.x, ev.y, ev.z, ev.w};
#pragma unroll
    for (int k = 0; k < 2; ++k) {
        const unsigned f0 = (unsigned)es[2 * k] * (unsigned)TROW4 + (unsigned)lane * 8u, f1 = (unsigned)es[2 * k + 1] * (unsigned)TROW4 + (unsigned)lane * 8u;
        S.uq[2 * k] = *(const u32x2*)(pu + f0); S.uq[2 * k + 1] = *(const u32x2*)(pu + f1);
        S.vq[2 * k] = *(const u32x2*)(pv + f0); S.vq[2 * k + 1] = *(const u32x2*)(pv + f1);
    }
}
constexpr int GV_ROW = 520;
constexpr int GV_BYTES = 16 * GV_ROW, GC_BYTES = 96;
__device__ __forceinline__ float gather_udot(const GSet& S, const unsigned (&hd)[4], LAS unsigned char* vrow) {
    int d[4];
#pragma unroll
    for (int k = 0; k < 4; ++k) {
        const int q0 = (int)S.uq[k].x, q1 = (int)S.uq[k].y;
        int a1, a2;
        asm("v_dot8_i32_i4 %0, %1, %2, 0" : "=v"(a1) : "v"(q0), "v"(hd[0]));
        asm("v_dot8_i32_i4 %0, %1, %2, 0" : "=v"(a2) : "v"(q0), "v"(hd[2]));
        a1 = __builtin_amdgcn_sdot8(q1, (int)hd[1], a1, false); a2 = __builtin_amdgcn_sdot8(q1, (int)hd[3], a2, false);
        d[k] = (a1 << 4) + a2;
    }
#pragma unroll
    for (int k = 0; k < 4; ++k) *(LAS u32x2*)(vrow + k * GV_ROW) = S.vq[k];
    int e2[2], f1;
#pragma unroll
    for (int k = 0; k < 2; ++k) { auto r = __builtin_amdgcn_permlane16_swap((unsigned)d[k], (unsigned)d[k + 2], false, false); e2[k] = (int)r[0] + (int)r[1]; }
    { auto r = __builtin_amdgcn_permlane32_swap((unsigned)e2[0], (unsigned)e2[1], false, false); f1 = (int)r[0] + (int)r[1]; }
    f1 += __builtin_amdgcn_update_dpp(0, f1, 0xB1, 0xf, 0xf, true); f1 += __builtin_amdgcn_update_dpp(0, f1, 0x4E, 0xf, 0xf, true);
    f1 += __builtin_amdgcn_update_dpp(0, f1, 0x124, 0xf, 0xf, true); f1 += __builtin_amdgcn_update_dpp(0, f1, 0x128, 0xf, 0xf, true);
    return (float)f1;
}
#define DPP_MAX(v, ctrl) fmaxf((v), __builtin_bit_cast(float, __builtin_amdgcn_update_dpp(0, __builtin_bit_cast(int, (v)), (ctrl), 0xf, 0xf, true)))
__device__ __forceinline__ void gather_vpart(float f0, float f1, float f2, float f3, int lane, int kslot, const LAS float* lg  ,
                                             const LAS unsigned char* vrd  , LAS unsigned char* cb, int aoff1, int aoff2, f32x4 (&acc)[8]) {
    const int q = (lane >> 2) & 3, e16 = 4 * q + kslot;
    const float fs = q == 0 ? f0 : q == 1 ? f1 : q == 2 ? f2 : f3;
    const float cv = lg[e16] * gelu_erf(fs * lg[GT * 128 + e16]);
    float mx = fabsf(cv);
    mx = DPP_MAX(mx, 0x124); mx = DPP_MAX(mx, 0x128);
    { auto r = __builtin_amdgcn_permlane16_swap(__float_as_uint(mx), __float_as_uint(mx), false, false); mx = fmaxf(__uint_as_float(r[0]), __uint_as_float(r[1])); }
    { auto r = __builtin_amdgcn_permlane32_swap(__float_as_uint(mx), __float_as_uint(mx), false, false); mx = fmaxf(__uint_as_float(r[0]), __uint_as_float(r[1])); }
    int E = (int)((__float_as_uint(mx) >> 23) & 0xffu); E = E < 8 ? 8 : E;
    const float x = cv * __uint_as_float((unsigned)(255 - E) << 23);
    const unsigned p1 = __builtin_amdgcn_cvt_scalef32_pk_fp4_f32(0u, x, 0.f, 1.0f, 0);
    const float r1 = x - __builtin_amdgcn_cvt_scalef32_pk_f32_fp4(p1, 1.0f, 0)[0];
    const unsigned p2 = __builtin_amdgcn_cvt_scalef32_pk_fp4_f32(0u, r1, 0.f, 1.0f, 0);
    const float y = (r1 - __builtin_amdgcn_cvt_scalef32_pk_f32_fp4(p2, 1.0f, 0)[0]) * 16.0f;
    const unsigned p3 = __builtin_amdgcn_cvt_scalef32_pk_fp4_f32(0u, y, 0.f, 1.0f, 0);
    const float r3 = y - __builtin_amdgcn_cvt_scalef32_pk_f32_fp4(p3, 1.0f, 0)[0];
    const unsigned p4 = __builtin_amdgcn_cvt_scalef32_pk_fp4_f32(0u, r3, 0.f, 1.0f, 0);
    const unsigned codes = (p1 & 15u) | ((p2 & 15u) << 8) | ((p3 & 15u) << 16) | ((p4 & 15u) << 24);
    { auto r = __builtin_amdgcn_permlane32_swap(codes, codes, false, false);
      const unsigned w = codes | ((r[0] ^ r[1] ^ codes) << 4);
      if (lane < 32 && (lane & 3) == 0) {
          LAS unsigned char* tb = cb + 8 + 2 * q + ((lane >> 4) & 1);
          tb[0] = (unsigned char)w; tb[16] = (unsigned char)(w >> 8); tb[32] = (unsigned char)(w >> 16); tb[48] = (unsigned char)(w >> 24);
      } }
    const u32x2 a10 = *(const LAS u32x2*)(cb + aoff1), a11 = *(const LAS u32x2*)(cb + aoff1 + 8), a20 = *(const LAS u32x2*)(cb + aoff2), a21 = *(const LAS u32x2*)(cb + aoff2 + 8);
    const v8i_t A1 = {(int)a10.x, (int)a10.y, (int)a11.x, (int)a11.y, 0, 0, 0, 0}, A2 = {(int)a20.x, (int)a20.y, (int)a21.x, (int)a21.y, 0, 0, 0, 0};
    const int sa1 = (E - 1) * 0x01010101, sa2 = (E - 5) * 0x01010101;
#pragma unroll
    for (int m = 0; m < 8; ++m) {
        const v2i_t t0 = __builtin_amdgcn_ds_read_tr4_b64_v2i32((LAS v2i_t*)(vrd + 16 * m)), t1 = __builtin_amdgcn_ds_read_tr4_b64_v2i32((LAS v2i_t*)(vrd + 16 * m + 8));
        const v8i_t B = {t0.x, t0.y, t1.x, t1.y, 0, 0, 0, 0};
        acc[m] = __builtin_amdgcn_mfma_scale_f32_16x16x128_f8f6f4(A1, B, acc[m], 4, 4, 0, sa1, 0, 0x7F7F7F7F);
        acc[m] = __builtin_amdgcn_mfma_scale_f32_16x16x128_f8f6f4(A2, B, acc[m], 4, 4, 0, sa2, 0, 0x7F7F7F7F);
    }
}
__device__ __forceinline__ void xcd_pace(unsigned* bar, volatile LAS unsigned* st);
constexpr int GNS = 8, GBPS = 32 / GNS, GSHIFT = 11;
constexpr int GATH_LDS_WAVE = GT * 128 * 12 + GV_BYTES + GC_BYTES;
#define GATH_SEG(J, NJ, nbt) { \
        const LAS int* le_ = lse + (J) * 128; const LAS int* ne_ = lse + (NJ) * 128; \
        gather_issue(D, GBPS * c + 3, lane, pu, pv, le_); \
        const float f0_ = hsc[J] * gather_udot(A, hd[J], vwr); \
        gather_issue(A, (nbt), lane, pu, pv, ne_); \
        const float f1_ = hsc[J] * gather_udot(B, hd[J], vwr + 4 * GV_ROW); \
        gather_issue(B, (nbt) + 1, lane, pu, pv, ne_); \
        const float f2_ = hsc[J] * gather_udot(C, hd[J], vwr + 8 * GV_ROW); \
        gather_issue(C, (nbt) + 2, lane, pu, pv, ne_); \
        const float f3_ = hsc[J] * gather_udot(D, hd[J], vwr + 12 * GV_ROW); \
        gather_vpart(f0_, f1_, f2_, f3_, lane, kslot, lsg + (J) * 128 + 16 * c, vrd, cb, aoff1, aoff2, acc[J]); }
__device__ void ph_peer_gather(const bf16* h2, const unsigned char* pu, const unsigned char* pv, const float* su, const float* sv,
                               const int* eidx, const float* egate, const bf16* xin  , const float* gate  , float* xout, LAS unsigned char* lds, unsigned* pace_bar, volatile LAS unsigned* pace_st, int bid, int nb,
                               bf16* xmid  ) {
    const int lane0 = ltid() & 63, w = __builtin_amdgcn_readfirstlane(ltid() >> 6);
    LAS int* lse = (LAS int*)(lds + w * GATH_LDS_WAVE); LAS float* lsg = (LAS float*)(lds + w * GATH_LDS_WAVE + GT * 128 * 4);
    LAS unsigned char* vb = lds + w * GATH_LDS_WAVE + GT * 128 * 12; LAS unsigned char* cb = vb + GV_BYTES;
    if (lane0 < GC_BYTES / 4) ((LAS unsigned*)cb)[lane0] = 0u;
    for (int t0 = (bid * 8 + w) * GT; t0 < MT; t0 += nb * 8 * GT) {
        int lane = lane0; asm volatile("" : "+v"(lane));
        const int row = lane >> 4;
        const int kslot = 2 * (row & 1) + (row >> 1);
        const int b = t0 >> 11;
        LAS unsigned char* vwr = vb + lane * 8;
        const LAS unsigned char* vrd = vb + (lane & 15) * GV_ROW + 128 * row;
        const int ai = lane & 15, au = (ai < 8 ? 1 : 3), nz = ((ai & 7) >> 1) == row;
        const int aoff1 = nz ? 8 * (au - (ai & 1)) : 64, aoff2 = nz ? 8 * (au + 4 - (ai & 1)) : 64;
        unsigned hd[GT][4]; float hsc[GT]; f32x4 acc[GT][8];
#pragma unroll
        for (int j = 0; j < GT; ++j) {
            const int t = t0 + j;
            const int e0 = eidx[(size_t)t * 128 + lane], e1 = eidx[(size_t)t * 128 + 64 + lane];
            const float g0 = egate[(size_t)t * 128 + lane], g1 = egate[(size_t)t * 128 + 64 + lane];
            const int k0 = e0 >> GSHIFT, k1 = e1 >> GSHIFT;
            int off = 0, d0 = 0, d1 = 0;
#pragma unroll
            for (int s = 0; s < GNS; ++s) {
                const unsigned long long m0 = __ballot(k0 == s), m1 = __ballot(k1 == s);
                const int r0 = (int)__builtin_amdgcn_mbcnt_hi((unsigned)(m0 >> 32), __builtin_amdgcn_mbcnt_lo((unsigned)m0, 0u));
                const int r1 = (int)__builtin_amdgcn_mbcnt_hi((unsigned)(m1 >> 32), __builtin_amdgcn_mbcnt_lo((unsigned)m1, 0u));
                const int c0 = __builtin_popcountll(m0);
                if (k0 == s) d0 = off + r0;
                if (k1 == s) d1 = off + c0 + r1;
                off += c0 + __builtin_popcountll(m1);
            }
            lse[j * 128 + d0] = e0; lsg[j * 128 + d0] = g0 * sv[e0]; lse[j * 128 + d1] = e1; lsg[j * 128 + d1] = g1 * sv[e1];
            lsg[GT * 128 + j * 128 + d0] = su[e0]; lsg[GT * 128 + j * 128 + d1] = su[e1];
            const u32x4 u0 = *(const u32x4*)(h2 + (size_t)t * DM + lane * 16), u1 = *(const u32x4*)(h2 + (size_t)t * DM + lane * 16 + 8);
            {
                float hf[16];
#pragma unroll
                for (int i = 0; i < 4; ++i) { hf[2 * i] = __uint_as_float(u0[i] << 16); hf[2 * i + 1] = __uint_as_float(u0[i] & 0xffff0000u); hf[8 + 2 * i] = __uint_as_float(u1[i] << 16); hf[8 + 2 * i + 1] = __uint_as_float(u1[i] & 0xffff0000u); }
                float mh = 0.f;
#pragma unroll
                for (int i = 0; i < 16; ++i) mh = fmaxf(mh, fabsf(hf[i]));
                mh = wave_max(mh);
                int Eh = (int)((__float_as_uint(mh) >> 23) & 0xffu); Eh = Eh < 8 ? 8 : Eh;
                const float up = __uint_as_float((unsigned)(255 - Eh) << 23);
                hsc[j] = __uint_as_float((unsigned)(Eh - 5) << 23);
                unsigned p1[2] = {0u, 0u}, p2[2] = {0u, 0u};
#pragma unroll
                for (int i = 0; i < 16; ++i) {
                    const float x = hf[i] * up, r1 = rintf(x);
                    int q2 = (int)rintf((x - r1) * 16.0f); q2 = q2 > 7 ? 7 : q2;
                    p1[i >> 3] |= ((unsigned)(int)r1 & 15u) << (4 * (i & 7)); p2[i >> 3] |= ((unsigned)q2 & 15u) << (4 * (i & 7));
                }
                hd[j][0] = p1[0]; hd[j][1] = p1[1]; hd[j][2] = p2[0]; hd[j][3] = p2[1];
            }
#pragma unroll
            for (int i = 0; i < 8; ++i) acc[j][i] = (f32x4){0.f, 0.f, 0.f, 0.f};
        }
        GSet A, B, C, D;
        gather_issue(A, 0, lane, pu, pv, lse); gather_issue(B, 1, lane, pu, pv, lse); gather_issue(C, 2, lane, pu, pv, lse);
#pragma unroll 1
        for (int c = 0; c < GNS; ++c) {
            GATH_SEG(0, 1, GBPS * c)
            GATH_SEG(1, 0, c < GNS - 1 ? GBPS * c + GBPS : 0)
        }
#pragma unroll
        for (int j = 0; j < GT; ++j) {
            const int t = t0 + j;
            LAS float* ob = (LAS float*)vb;
            const int nbase = 512 * (row & 1) + 32 * (row >> 1) + (lane & 15);
#pragma unroll
            for (int pm = 0; pm < 4; ++pm)
#pragma unroll
                for (int r = 0; r < 4; ++r) {
                    auto sw = __builtin_amdgcn_permlane32_swap(__float_as_uint(acc[j][2 * pm][r]), __float_as_uint(acc[j][2 * pm + 1][r]), false, false);
                    ob[nbase + 256 * (r >> 1) + 64 * pm + 16 * (r & 1)] = __uint_as_float(sw[0]) + __uint_as_float(sw[1]);
                }
#pragma unroll
            for (int i = 0; i < 4; ++i) {
                const int cc = i * 256 + lane * 4;
                const f32x4 a = *(const LAS f32x4*)(ob + cc);
                const u32x2 xq = *(const u32x2*)(xin + (size_t)t * DM + cc); const f32x4 gt = *(const f32x4*)(gate + (size_t)b * 6144 + cc);
                const f32x4 xi = {__uint_as_float(xq.x << 16), __uint_as_float(xq.x & 0xffff0000u), __uint_as_float(xq.y << 16), __uint_as_float(xq.y & 0xffff0000u)};
                f32x4 o;
#pragma unroll
                for (int e = 0; e < 4; ++e) o[e] = xi[e] + gt[e] * a[e];
                if (xmid) { u32x2 pk; pk.x = pk2(o[0], o[1]); pk.y = pk2(o[2], o[3]); *(u32x2*)(xmid + (size_t)t * DM + cc) = pk; }
                else __builtin_nontemporal_store(o, (f32x4*)(xout + (size_t)t * DM + cc));
            }
        }
    }
}

#define XB_TMO      128
#define XB_XCNT(j)  (256  + 64 * (j))
#define XB_XSUB(j)  (1280 + 64 * (j))
#define XB_XGEN(j)  (2304 + 64 * (j))
#define XB_TOP      3328
#define XB_TOPGEN   3392
#define XCD_BAR_WORDS 3456
#define XB_SPIN_CAP (1u << 18)

__device__ __forceinline__ unsigned xb_ld(unsigned* p)              { return __hip_atomic_load(p, __ATOMIC_RELAXED, __HIP_MEMORY_SCOPE_AGENT); }
__device__ __forceinline__ unsigned xb_add(unsigned* p, unsigned v) { return __hip_atomic_fetch_add(p, v, __ATOMIC_RELAXED, __HIP_MEMORY_SCOPE_AGENT); }
__device__ __forceinline__ unsigned xb_xcc_id() { return (unsigned)__builtin_amdgcn_s_getreg((3 << 11) | 20) & 0xFu; }
#define XB_SPIN(cond, bar) do { unsigned _sp = 0; while (cond) { __builtin_amdgcn_s_sleep(1); \
    if ((++_sp & 255u) == 0u) { if (xb_ld(&(bar)[XB_TMO])) break; if (_sp > XB_SPIN_CAP) { atomicAdd(&(bar)[XB_TMO], 1u); break; } } } } while (0)

struct XcdBarrier {
    unsigned* bar; unsigned x;
    volatile LAS unsigned* st;
};

__device__ __forceinline__ XcdBarrier xcd_barrier_post(unsigned* bar, volatile LAS unsigned* st) {
    XcdBarrier b; b.bar = bar; b.x = xb_xcc_id(); b.st = st;
    if (threadIdx.x == 0) (void)xb_add(&bar[XB_XCNT(b.x)], 1u);
    return b;
}
__device__ __forceinline__ void xcd_barrier_complete(unsigned* bar, unsigned x, unsigned& nloc, unsigned& nx) {
    const unsigned G = gridDim.x * gridDim.y * gridDim.z;
    unsigned sum, cnt, mine, sp = 0u;
    for (;;) {
        sum = 0u; cnt = 0u; mine = 0u;
#pragma unroll
        for (unsigned j = 0; j < 16; ++j) { const unsigned c = xb_ld(&bar[XB_XCNT(j)]); sum += c; cnt += (c > 0u) ? 1u : 0u; mine = (j == x) ? c : mine; }
        if (sum == G) break;
        __builtin_amdgcn_s_sleep(1);
        if ((++sp & 255u) == 0u) { if (xb_ld(&bar[XB_TMO])) break; if (sp > XB_SPIN_CAP) { atomicAdd(&bar[XB_TMO], 1u); break; } }
    }
    nloc = mine > 0u ? mine : 1u; nx = cnt > 0u ? cnt : 1u;
}

__device__ __forceinline__ void xcd_barrier(const XcdBarrier& b) {
    asm volatile("s_waitcnt vmcnt(0)" ::: "memory");
    __syncthreads();
    if (threadIdx.x == 0) {
        unsigned* bar = b.bar;
        __builtin_amdgcn_s_waitcnt(0);
        unsigned nloc = b.st[0], nx = b.st[1];
        if (nloc == 0u) { xcd_barrier_complete(bar, b.x, nloc, nx); b.st[0] = nloc; b.st[1] = nx; }
        const unsigned old = xb_add(&bar[XB_XSUB(b.x)], 1u);
        const unsigned gen = old / nloc;
        if (old + 1u == (gen + 1u) * nloc) {
            __builtin_amdgcn_fence(__ATOMIC_RELEASE, "agent");
            asm volatile("s_waitcnt vmcnt(0)" ::: "memory");
            const unsigned og = xb_add(&bar[XB_TOP], 1u);
            const unsigned tg = og / nx;
            if (og + 1u == (tg + 1u) * nx) xb_add(&bar[XB_TOPGEN], 1u);
            else XB_SPIN(xb_ld(&bar[XB_TOPGEN]) == tg, bar);
            __builtin_amdgcn_fence(__ATOMIC_ACQUIRE, "agent");
            xb_add(&bar[XB_XGEN(b.x)], 1u);
            asm volatile("s_waitcnt vmcnt(0)" ::: "memory");
        } else {
            XB_SPIN(xb_ld(&bar[XB_XGEN(b.x)]) == gen, bar);
            __builtin_amdgcn_fence(__ATOMIC_ACQUIRE, "agent");
            asm volatile("s_waitcnt vmcnt(0)" ::: "memory");
        }
    }
    __syncthreads();
}


#define XB_PACE(j) (3584 + 64 * (j))
__device__ __forceinline__ void xcd_pace(unsigned* bar, volatile LAS unsigned* st) {
    __syncthreads();
    if (threadIdx.x == 0) {
        const unsigned nloc = st[0] ? st[0] : 1u, x = xb_xcc_id(), gen = st[4] + 1u;
        st[4] = gen;
        xb_add(&bar[XB_PACE(x)], 1u);
        unsigned sp = 0;
        while (xb_ld(&bar[XB_PACE(x)]) < gen * nloc) { __builtin_amdgcn_s_sleep(1); if (++sp > (1u << 16)) break; }
    }
    __syncthreads();
}
extern __shared__ __attribute__((aligned(16))) unsigned char dyn_lds[];
#ifndef REP_PREP
#define REP_PREP 1
#endif
#ifndef REP_ATTN
#define REP_ATTN 1
#endif
#ifndef REP_SEL
#define REP_SEL 1
#endif
#ifndef REP_GATH
#define REP_GATH 1
#endif
#ifndef REP_GEMM
#define REP_GEMM 1
#endif
#ifndef REP_ADALN
#define REP_ADALN 1
#endif
constexpr int LDS_BYTES = 147456;

template <class T> __device__ __forceinline__ T* karg(int byte_off) {
    const __attribute__((address_space(4))) char* base = (const __attribute__((address_space(4))) char*)__builtin_amdgcn_kernarg_segment_ptr();
    unsigned long long v = *(const __attribute__((address_space(4))) unsigned long long*)(base + byte_off);
    asm volatile("" : "+s"(v));
    return (T*)(__attribute__((address_space(1))) T*)v;
}
#define KIN(i) karg<const float>(8 * (i))
#define KOUT() karg<float>(168)
#define KWS() karg<unsigned char>(176)
static_assert(sizeof(Params) == 184, "Params layout");
template <class T> __device__ __forceinline__ T* launder(T* p) { size_t off = 0; asm volatile("" : "+s"(off)); return (T*)((unsigned char*)p + off); }
__global__ void __launch_bounds__(NT) mega_fwd(Params p) {
    cg::grid_group grid = cg::this_grid();
    const int bid = blockIdx.x, nb = gridDim.x;
    volatile LAS unsigned* bst = (volatile LAS unsigned*)((LAS unsigned char*)dyn_lds + LDS_BYTES - 64);
    if (ltid() < 16) bst[ltid()] = 0u;
    __syncthreads();
    const XcdBarrier xbar = xcd_barrier_post((unsigned*)(KWS() + WS_BAR), bst);
    for (int rep = 0; rep < REP_PREP; ++rep) {
        unsigned char* ws = KWS();
        float* tile = (float*)dyn_lds;
        ph_transpose(KIN(6), (bf16*)(ws + WS_WIN0), 1024, AB_IN, true, tile, bid, nb);
        ph_transpose(KIN(11), (bf16*)(ws + WS_WIN1), 1024, CD_IN, true, tile, bid, nb);
        ph_transpose(KIN(7), (bf16*)(ws + WS_WO0), 1024, 1024, false, tile, bid, nb);
        ph_transpose(KIN(12), (bf16*)(ws + WS_WO1), 1024, 1024, false, tile, bid, nb);
        ph_transpose(KIN(17), (bf16*)(ws + WS_WQ), 1024, PQ, false, tile, bid, nb);
        ph_transpose(KIN(17) + (size_t)1024 * PQ, (bf16*)(ws + WS_WQ) + (size_t)PQ * 1024, 1024, PQ, false, tile, bid, nb);
        ws = launder(ws);
        ph_tab_i4(KIN(19), ws + WS_PU, (float*)(ws + WS_PV), 2 * NEXP, bid, nb);
        ph_tab_fp4(KIN(20), ws + WS_PU + 32 * MiB, (float*)(ws + WS_PV + 1 * MiB), 2 * NEXP, bid, nb);
        ws = launder(ws);
        ph_mod(KIN(1), KIN(2), KIN(3), (float*)(ws + WS_MOD), (float*)dyn_lds, bid, nb);
        ph_rope_table((float*)(ws + WS_ROPE), bid, nb);
        for (int i = bid * NT + ltid(); i < NB * 8 * 8 * 64; i += nb * NT) ((float*)(ws + WS_KMEAN))[i] = 0.f;
    }
    grid.sync();
#pragma unroll 1
    for (int layer = 0; layer < 2; ++layer) {
        for (int rep = 0; rep < REP_ADALN; ++rep) {
            unsigned char* ws = KWS(); const float* mod = (const float*)(ws + WS_MOD) + (size_t)layer * 32 * 6144;
            if (layer == 0) ph_adaln<false>(KIN(0), KIN(4), mod + 0, mod + 1024, (bf16*)(ws + WS_HY), bid, nb);
            else ph_adaln<true>(ws + WS_X1 + 128 * MiB, KIN(4) + DM, mod + 0, mod + 1024, (bf16*)(ws + WS_HY), bid, nb);
        }
        xcd_barrier(xbar);
        for (int rep = 0; rep < REP_GEMM; ++rep) {
            unsigned char* ws = KWS();
            pg8::Gemm g{(const bf16*)(ws + WS_HY), (const bf16*)(ws + (layer == 0 ? WS_WIN0 : WS_WIN1)), MT, layer == 0 ? AB_IN : CD_IN, DM};
            pg8::StaticOrder S; S.init(g.M, g.N, nb, bid);
            pg8::EpiQKV e{(bf16*)(ws + WS_QKV), QKV_LD, (const float*)(ws + WS_ROPE), layer, layer == 0 ? KIN(9) : KIN(13), layer == 0 ? KIN(10) : KIN(14), KIN(15), KIN(16), (float*)(ws + WS_KMEAN)};
            pg8::gemm_phase<pg8::EpiQKV, pg8::StaticOrder, true, true>((LAS unsigned char*)dyn_lds, g, S, e);
        }
        xcd_barrier(xbar);
        for (int rep = 0; rep < REP_ATTN; ++rep) {
            unsigned char* ws = KWS();
            if (layer == 0) ph_attn0((const bf16*)(ws + WS_QKV), KIN(8), (bf16*)(ws + WS_HY), (LAS unsigned char*)dyn_lds, bid, nb);
            else ph_attn1((const bf16*)(ws + WS_QKV), (const float*)(ws + WS_KMEAN), (bf16*)(ws + WS_HY), (LAS unsigned char*)dyn_lds, bid, nb);
        }
        xcd_barrier(xbar);
        for (int rep = 0; rep < REP_GEMM; ++rep) {
            unsigned char* ws = KWS(); const float* mod = (const float*)(ws + WS_MOD) + (size_t)layer * 32 * 6144;
            pg8::Gemm g{(const bf16*)(ws + WS_HY), (const bf16*)(ws + (layer == 0 ? WS_WO0 : WS_WO1)), MT, DM, DM};
            pg8::StaticOrder S; S.init(g.M, g.N, nb, bid);
            if (layer == 0) { pg8::EpiResid<false> e{KIN(0), (pg8::bf16_t*)(ws + WS_X1), mod + 2048}; pg8::gemm_phase<pg8::EpiResid<false>, pg8::StaticOrder, true, true>((LAS unsigned char*)dyn_lds, g, S, e); }
            else { pg8::EpiResid<true> e{ws + WS_X1 + 128 * MiB, (pg8::bf16_t*)(ws + WS_X1), mod + 2048}; pg8::gemm_phase<pg8::EpiResid<true>, pg8::StaticOrder, true, true>((LAS unsigned char*)dyn_lds, g, S, e); }
        }
        xcd_barrier(xbar);
        for (int rep = 0; rep < REP_ADALN; ++rep) {
            unsigned char* ws = KWS(); const float* mod = (const float*)(ws + WS_MOD) + (size_t)layer * 32 * 6144;
            ph_adaln<true>(ws + WS_X1, KIN(5) + layer * DM, mod + 3072, mod + 4096, (bf16*)(ws + WS_QKV), bid, nb);
        }
        xcd_barrier(xbar);
        for (int rep = 0; rep < REP_GEMM; ++rep) {
            unsigned char* ws = KWS();
            pg8::Gemm g{(const bf16*)(ws + WS_QKV), (const bf16*)(ws + WS_WQ) + (size_t)layer * PQ * DM, MT, PQ, DM};
            pg8::StaticOrder S; S.init(g.M, g.N, nb, bid); pg8::EpiStore e{(bf16*)(ws + WS_QKV + 128 * MiB), PQ};
            pg8::gemm_phase<pg8::EpiStore, pg8::StaticOrder, true, true>((LAS unsigned char*)dyn_lds, g, S, e);
        }
        xcd_barrier(xbar);
        for (int rep = 0; rep < REP_SEL; ++rep) {
            unsigned char* ws = KWS();
            ph_peer_select((const bf16*)(ws + WS_QKV + 128 * MiB), KIN(18) + (size_t)layer * 2 * 128 * 128, (int*)(ws + WS_HY), (float*)(ws + WS_HY + 32 * MiB), (LAS unsigned char*)dyn_lds, bid, nb);
        }
        xcd_barrier(xbar);
        for (int rep = 0; rep < REP_GATH; ++rep) {
            unsigned char* ws = KWS(); const float* mod = (const float*)(ws + WS_MOD) + (size_t)layer * 32 * 6144;
            ph_peer_gather((const bf16*)(ws + WS_QKV), ws + WS_PU + (size_t)layer * NEXP * TROW4, ws + WS_PU + 32 * MiB + (size_t)layer * NEXP * TROW4,
                           (const float*)(ws + WS_PV) + layer * NEXP, (const float*)(ws + WS_PV + 1 * MiB) + layer * NEXP, (const int*)(ws + WS_HY), (const float*)(ws + WS_HY + 32 * MiB), (const bf16*)(ws + WS_X1), mod + 5120, KOUT(), (LAS unsigned char*)dyn_lds, (unsigned*)(ws + WS_BAR), bst, bid, nb, layer == 0 ? (bf16*)(ws + WS_X1 + 128 * MiB) : (bf16*)nullptr);
        }
        if (layer == 0) xcd_barrier(xbar);
    }
}

extern "C" void kernel_launch(void* const* d_in, const int* in_sizes, int n_in, void* d_out, int out_size, void* d_ws, size_t ws_size, hipStream_t stream) {
    if (n_in != 21 || ws_size < WS_END) { fprintf(stderr, "kernel_launch: bad args n_in=%d ws=%zu\n", n_in, ws_size); return; }
    static int grid_blocks = 0;
    if (!grid_blocks) {
        int dev = 0, cus = 0, per_cu = 0;
        (void)hipGetDevice(&dev);
        (void)hipDeviceGetAttribute(&cus, hipDeviceAttributeMultiprocessorCount, dev);
        (void)hipFuncSetAttribute((const void*)mega_fwd, hipFuncAttributeMaxDynamicSharedMemorySize, LDS_BYTES);
        (void)hipOccupancyMaxActiveBlocksPerMultiprocessor(&per_cu, (const void*)mega_fwd, NT, LDS_BYTES);
        if (per_cu < 1) { fprintf(stderr, "kernel_launch: occupancy query returned %d\n", per_cu); per_cu = 1; }
        if (per_cu > 1) per_cu = 1;
        grid_blocks = cus * per_cu;
    }
    Params p{};
    for (int i = 0; i < 21; ++i) p.in[i] = (const float*)d_in[i];
    p.out = (float*)d_out; p.ws = (unsigned char*)d_ws;
    (void)hipMemsetAsync((char*)d_ws + WS_BAR, 0, 16384, stream);
    void* args[] = {&p};
    hipError_t e = hipLaunchCooperativeKernel((const void*)mega_fwd, dim3(grid_blocks), dim3(NT), args, LDS_BYTES, stream);
    if (e != hipSuccess) fprintf(stderr, "cooperative launch failed: %s (grid %d)\n", hipGetErrorString(e), grid_blocks);
}
```

```cpp
#include <hip/hip_runtime.h>
#ifndef REP_A
#define REP_A 1
#endif
#ifndef REP_B
#define REP_B 1
#endif
#ifndef REP_C
#define REP_C 1
#endif
#ifndef REP_D
#define REP_D 1
#endif
#include <hip/hip_cooperative_groups.h>
namespace cg = cooperative_groups;
#include <cstdio>
#include <cstdint>
#include <cmath>

typedef unsigned short bf16;
typedef short bf16x8 __attribute__((ext_vector_type(8)));
typedef float f32x4 __attribute__((ext_vector_type(4)));
typedef unsigned u32x4 __attribute__((ext_vector_type(4)));
typedef unsigned u32x2 __attribute__((ext_vector_type(2)));

constexpr int DM = 1024, NB = 32, SQ = 2048, MT = NB * SQ;
constexpr int HD = 64;
constexpr int AB_IN = 2304, CD_IN = 3072, QKV_LD = 3072;
constexpr int NEXP = 16384, PQ = 2048;
constexpr float EPS = 1e-6f;
constexpr int NT = 512;

constexpr size_t MiB = 1u << 20;
constexpr size_t WS_X1 = 0;
constexpr size_t WS_QKV = 256 * MiB;
constexpr size_t WS_HY = 640 * MiB;
constexpr size_t WS_PU = 768 * MiB;
constexpr size_t WS_PV = 832 * MiB;
constexpr size_t WS_WIN0 = 896 * MiB;
constexpr size_t WS_WIN1 = 901 * MiB;
constexpr size_t WS_WO0 = 907 * MiB;
constexpr size_t WS_WO1 = 909 * MiB;
constexpr size_t WS_WQ = 911 * MiB;
constexpr size_t WS_MOD = 919 * MiB;
constexpr size_t WS_ROPE = 921 * MiB;
constexpr size_t WS_KMEAN = 922 * MiB;
constexpr size_t WS_BAR = 923 * MiB;
constexpr size_t WS_END = 924 * MiB;

struct Params {
    const float* in[21];
    float* out;
    unsigned char* ws;
};

__device__ __forceinline__ int ltid() { int t = (int)__builtin_amdgcn_workitem_id_x(); asm volatile("" : "+v"(t)); return t; }
__device__ __forceinline__ float bf2f(unsigned b) { return __uint_as_float(b << 16); }
__device__ __forceinline__ unsigned f2bf(float f) { unsigned u = __float_as_uint(f); return (u + 0x7fffu + ((u >> 16) & 1u)) >> 16; }
__device__ __forceinline__ unsigned pk2(float lo, float hi) { return f2bf(lo) | (f2bf(hi) << 16); }
#define DPPV(v, ctrl) __builtin_bit_cast(float, __builtin_amdgcn_update_dpp(0, __builtin_bit_cast(int, (v)), (ctrl), 0xf, 0xf, true))
__device__ __forceinline__ float row16_sum(float v) { v += DPPV(v, 0xB1); v += DPPV(v, 0x4E); v += DPPV(v, 0x124); v += DPPV(v, 0x128); return v; }
__device__ __forceinline__ float rows_sum(float v) {
    { auto r = __builtin_amdgcn_permlane16_swap(__float_as_uint(v), __float_as_uint(v), false, false); v = __uint_as_float(r[0]) + __uint_as_float(r[1]); }
    { auto r = __builtin_amdgcn_permlane32_swap(__float_as_uint(v), __float_as_uint(v), false, false); v = __uint_as_float(r[0]) + __uint_as_float(r[1]); }
    return v;
}
__device__ __forceinline__ float wave_sum(float v) { return rows_sum(row16_sum(v)); }
__device__ __forceinline__ float wave_max(float v) {
    v = fmaxf(v, DPPV(v, 0xB1)); v = fmaxf(v, DPPV(v, 0x4E)); v = fmaxf(v, DPPV(v, 0x124)); v = fmaxf(v, DPPV(v, 0x128));
    { auto r = __builtin_amdgcn_permlane16_swap(__float_as_uint(v), __float_as_uint(v), false, false); v = fmaxf(__uint_as_float(r[0]), __uint_as_float(r[1])); }
    { auto r = __builtin_amdgcn_permlane32_swap(__float_as_uint(v), __float_as_uint(v), false, false); v = fmaxf(__uint_as_float(r[0]), __uint_as_float(r[1])); }
    return v;
}
__device__ __forceinline__ float gelu_erf(float x) {
    const float z = x * 0.70710678118654752f, az = fabsf(z);
    const float t = __builtin_amdgcn_rcpf(fmaf(0.3275911f, az, 1.0f));
    float pl = fmaf(t, 1.061405429f, -1.453152027f); pl = fmaf(t, pl, 1.421413741f); pl = fmaf(t, pl, -0.284496736f); pl = fmaf(t, pl, 0.254829592f); pl *= t;
    const float ex = __builtin_amdgcn_exp2f(az * (az * -1.4426950408889634f));
    const float er = copysignf(fmaf(-pl, ex, 1.0f), z);
    const float hx = 0.5f * x;
    return fmaf(hx, er, hx);
}

__device__ __forceinline__ int qkv_logical_col(int p) { return (p & ~255) | (((p >> 5) & 3) << 6) | (((p >> 7) & 1) << 5) | (p & 31); }
__device__ void ph_transpose(const float* W, bf16* Wt, int K, int N, bool permute, float* tile  , int bid, int nb) {
    const int tid = ltid();
    const int nkt = K / 64, nnt = N / 64;
    for (int it = bid; it < nkt * nnt; it += nb) {
        const int k0 = (it / nnt) * 64, n0 = (it % nnt) * 64;
        __syncthreads();
        for (int e = tid; e < 64 * 64; e += NT) { const int r = e >> 6, c = e & 63; const int nl = permute ? qkv_logical_col(n0 + c) : n0 + c; tile[r * 65 + c] = W[(size_t)(k0 + r) * N + nl]; }
        __syncthreads();
        {
            const int n = tid >> 3, k8 = (tid & 7) * 8;
            u32x4 v;
            v.x = pk2(tile[(k8 + 0) * 65 + n], tile[(k8 + 1) * 65 + n]);
            v.y = pk2(tile[(k8 + 2) * 65 + n], tile[(k8 + 3) * 65 + n]);
            v.z = pk2(tile[(k8 + 4) * 65 + n], tile[(k8 + 5) * 65 + n]);
            v.w = pk2(tile[(k8 + 6) * 65 + n], tile[(k8 + 7) * 65 + n]);
            *(u32x4*)(Wt + (size_t)(n0 + n) * K + k0 + k8) = v;
        }
    }
}
__device__ void ph_convert(const float* src, bf16* dst, size_t n, int bid, int nb) {
    const size_t n8 = n / 8;
    for (size_t i = (size_t)bid * NT + ltid(); i < n8; i += (size_t)nb * NT) {
        const f32x4 a = *(const f32x4*)(src + i * 8), b = *(const f32x4*)(src + i * 8 + 4);
        u32x4 v; v.x = pk2(a[0], a[1]); v.y = pk2(a[2], a[3]); v.z = pk2(b[0], b[1]); v.w = pk2(b[2], b[3]);
        *(u32x4*)(dst + i * 8) = v;
    }
}
__device__ void ph_mod(const float* c, const float* ada_w, const float* ada_b, float* mod, float* lds  , int bid, int nb) {
    const int tid = ltid(), lane = tid & 63, w = tid >> 6;
    for (int it = bid; it < 2 * 96; it += nb) {
        const int l = it / 96, j = (it % 96) * 64 + lane;
        float acc[32];
#pragma unroll
        for (int b = 0; b < 32; ++b) acc[b] = 0.f;
        for (int kh = 0; kh < 2; ++kh) {
            __syncthreads();
            for (int e = tid; e < 32 * 512; e += NT) { const int b = e >> 9, k = e & 511; const float cv = c[b * 1024 + kh * 512 + k]; lds[e] = cv / (1.0f + __expf(-cv)); }
            __syncthreads();
            for (int kk = 0; kk < 64; ++kk) {
                const int k = w * 64 + kk;
                const float wv = ada_w[((size_t)l * 1024 + kh * 512 + k) * 6144 + j];
#pragma unroll
                for (int b = 0; b < 32; ++b) acc[b] += lds[b * 512 + k] * wv;
            }
        }
        __syncthreads();
#pragma unroll
        for (int b = 0; b < 32; ++b) lds[(w * 32 + b) * 64 + lane] = acc[b];
        __syncthreads();
        for (int e = tid; e < 32 * 64; e += NT) {
            const int b = e >> 6, jj = e & 63; float s = 0.f;
#pragma unroll
            for (int ww = 0; ww < 8; ++ww) s += lds[(ww * 32 + b) * 64 + jj];
            const int jo = (it % 96) * 64 + jj;
            mod[((size_t)l * 32 + b) * 6144 + jo] = s + ada_b[l * 6144 + jo];
        }
    }
}
__device__ void ph_rope_table(float* rope, int bid, int nb) {
    for (int i = bid * NT + ltid(); i < SQ * 32; i += nb * NT) {
        const int t = i >> 5, f = i & 31;
        const float inv = powf(10000.0f, -(float)f / 32.0f);
        const float ang = (float)t * inv;
        float s, c; sincosf(ang, &s, &c);
        rope[i * 2] = c; rope[i * 2 + 1] = s;
    }
}

#define DPP_ADD0(v, ctrl) ((v) + __builtin_bit_cast(float, __builtin_amdgcn_update_dpp(0, __builtin_bit_cast(int, (v)), (ctrl), 0xf, 0xf, true)))
template <bool XBF> __device__ void ph_adaln(const void* xv, const float* g, const float* mod_shift  , const float* mod_scale, bf16* h, int bid, int nb) {
    const int lane = ltid() & 63, w = __builtin_amdgcn_readfirstlane(ltid() >> 6);
    for (int t0 = (bid * 8 + w) * 4; t0 < MT; t0 += nb * 8 * 4) {
        const int b = t0 >> 11;
        f32x4 v[4][4]; float ss[4];
#pragma unroll
        for (int r = 0; r < 4; ++r) {
            if constexpr (XBF) {
                const bf16* xr = (const bf16*)xv + (size_t)(t0 + r) * DM;
#pragma unroll
                for (int i = 0; i < 4; ++i) { const u32x2 q = *(const u32x2*)(xr + i * 256 + lane * 4); v[r][i] = (f32x4){__uint_as_float(q.x << 16), __uint_as_float(q.x & 0xffff0000u), __uint_as_float(q.y << 16), __uint_as_float(q.y & 0xffff0000u)}; }
            } else {
                const float* xr = (const float*)xv + (size_t)(t0 + r) * DM;
#pragma unroll
                for (int i = 0; i < 4; ++i) v[r][i] = *(const f32x4*)(xr + i * 256 + lane * 4);
            }
        }
#pragma unroll
        for (int r = 0; r < 4; ++r) {
            float s = 0.f;
#pragma unroll
            for (int i = 0; i < 4; ++i) s += v[r][i][0] * v[r][i][0] + v[r][i][1] * v[r][i][1] + v[r][i][2] * v[r][i][2] + v[r][i][3] * v[r][i][3];
            s = DPP_ADD0(s, 0xB1); s = DPP_ADD0(s, 0x4E); s = DPP_ADD0(s, 0x124); s = DPP_ADD0(s, 0x128);
            { auto q = __builtin_amdgcn_permlane16_swap(__float_as_uint(s), __float_as_uint(s), false, false); s = __uint_as_float(q[0]) + __uint_as_float(q[1]); }
            { auto q = __builtin_amdgcn_permlane32_swap(__float_as_uint(s), __float_as_uint(s), false, false); s = __uint_as_float(q[0]) + __uint_as_float(q[1]); }
            ss[r] = rsqrtf(s * (1.0f / DM) + EPS);
        }
#pragma unroll
        for (int i = 0; i < 4; ++i) {
            const int c = i * 256 + lane * 4;
            const f32x4 gg = *(const f32x4*)(g + c), sc = *(const f32x4*)(mod_scale + (size_t)b * 6144 + c), sh = *(const f32x4*)(mod_shift + (size_t)b * 6144 + c);
            float a[4];
#pragma unroll
            for (int e = 0; e < 4; ++e) a[e] = gg[e] * (1.0f + sc[e]);
#pragma unroll
            for (int r = 0; r < 4; ++r) {
                float y[4];
#pragma unroll
                for (int e = 0; e < 4; ++e) y[e] = v[r][i][e] * ss[r] * a[e] + sh[e];
                u32x2 o; o.x = pk2(y[0], y[1]); o.y = pk2(y[2], y[3]);
                __builtin_nontemporal_store(o, (u32x2*)(h + (size_t)(t0 + r) * DM + c));
            }
        }
    }
}

namespace pg8 {
#define PG8_LAS __attribute__((address_space(3)))
typedef unsigned short bf16_t;
typedef short bf16x8 __attribute__((ext_vector_type(8)));
constexpr int BM = 256, BK = 64, HALF = 128, HTB = HALF * BK * 2  , STAGE_BYTES = 8 * HTB, NXCD = 8, WGM = 8;

__host__ __device__ __forceinline__ int lds_byte(int r, int c) { const int st = (r >> 4) * 2 + (c >> 5), rr = r & 15, cc = c & 31, ob = rr * 64 + cc * 2; return st * 1024 + (ob ^ (((ob >> 9) & 1) << 5)); }
__host__ __device__ __forceinline__ void stage_rc(int b, int& R, int& C) { const int st = b / 1024, sb = b % 1024, swz = sb ^ (((sb >> 9) & 1) << 5); R = (st >> 1) * 16 + swz / 64; C = (st & 1) * 32 + (swz % 64) / 2; }
__host__ __device__ __forceinline__ int perm32(int rho) { const int n = rho >> 4, i = rho & 15; return 8 * (i >> 2) + 4 * n + (i & 3); }

struct Unit { int pm, pn; };
struct Gemm { const bf16_t* A; const bf16_t* Bt; int M, N, K; };

struct StaticOrder {
    int nM, nN, nwg, G, c;
    __host__ __device__ void init(int M, int N, int G_, int c_) { nM = M / BM; nN = N / BM; nwg = nM * nN; G = G_; c = c_; }
    __host__ __device__ bool next(int i, Unit& u) const {
        const long L = (long)i * G + c; if (L >= nwg) return false;
        int wgid = (int)L; { const int q = nwg / NXCD, r = nwg % NXCD, xcd = wgid % NXCD, off = wgid / NXCD; wgid = (xcd < r ? xcd * (q + 1) : r * (q + 1) + (xcd - r) * q) + off; }
        const int nig = WGM * nN, gid = wgid / nig, fm = gid * WGM, gsz = (nM - fm) < WGM ? (nM - fm) : WGM;
        u.pm = fm + ((wgid % nig) % gsz); u.pn = (wgid % nig) / gsz; return true;
    }
    __device__ __forceinline__ void a_ready(const Unit&) const {}
    __device__ __forceinline__ void done(const Unit&) const {}
};

__device__ __forceinline__ unsigned cvt_pk_bf16(float lo, float hi) { unsigned r; asm volatile("v_cvt_pk_bf16_f32 %0, %1, %2" : "=v"(r) : "v"(lo), "v"(hi)); return r; }

struct EpiStore {
    static constexpr bool PERM = true, AFTER_DRAIN = false;
    bf16_t* O; int ldc;
    __device__ __forceinline__ void operator()(const f32x4 (&acc)[2][2][4][2], const Unit& u, int wr, int wc, int fr_, int fq_) const {
        int fr = fr_, fq = fq_; asm volatile("" : "+v"(fr), "+v"(fq));
        const int row0 = u.pm * BM + wr * 64 + fr, col0 = u.pn * BM + wc * 32 + 8 * fq;
#pragma unroll
        for (int ai = 0; ai < 2; ++ai)
#pragma unroll
            for (int m = 0; m < 4; ++m) { bf16_t* rowp = O + (size_t)(row0 + ai * HALF + m * 16) * ldc + col0;
#pragma unroll
                for (int bj = 0; bj < 2; ++bj) { const f32x4 v0 = acc[ai][bj][m][0], v1 = acc[ai][bj][m][1];
                    u32x4 w; w.x = cvt_pk_bf16(v0[0], v0[1]); w.y = cvt_pk_bf16(v0[2], v0[3]); w.z = cvt_pk_bf16(v1[0], v1[1]); w.w = cvt_pk_bf16(v1[2], v1[3]);
                    *(u32x4*)(rowp + bj * HALF) = w; } }
    }
};
struct EpiQKV {
    static constexpr bool PERM = true, AFTER_DRAIN = false;
    bf16_t* O; int ldc; const float* rope; int layer;
    const float* gq0; const float* gk0;
    const float* gq1; const float* gk1;
    float* kmean;
    __device__ __forceinline__ void operator()(const f32x4 (&acc)[2][2][4][2], const Unit& u, int wr, int wc, int fr_, int fq_) const {
        int fr = fr_, fq = fq_; asm volatile("" : "+v"(fr), "+v"(fq));
        const int hg = 4 * u.pn + wc;
        const float* gain = nullptr; bool km = false;
        if (layer == 0) { if (hg < 8) gain = gq0; else if (hg < 10) gain = gk0; }
        else { if (hg < 8) gain = gq0; else if (hg < 16) gain = gk0; else if (hg >= 24 && hg < 32) gain = gq1; else if (hg >= 32 && hg < 40) { gain = gk1; km = true; } }
        const int row0 = u.pm * BM + wr * 64 + fr, col0 = 64 * hg + 8 * fq;
        float g0[8], g1[8], cs0[8], cs1[8];
#pragma unroll
        for (int e = 0; e < 8; ++e) { g0[e] = gain ? gain[8 * fq + e] : 1.f; g1[e] = gain ? gain[32 + 8 * fq + e] : 1.f; cs0[e] = 0.f; cs1[e] = 0.f; }
#pragma unroll
        for (int ai = 0; ai < 2; ++ai)
#pragma unroll
            for (int m = 0; m < 4; ++m) {
                const int row = row0 + ai * HALF + m * 16;
                float v0[8], v1[8];
#pragma unroll
                for (int e = 0; e < 4; ++e) { v0[e] = acc[ai][0][m][0][e]; v0[4 + e] = acc[ai][0][m][1][e]; v1[e] = acc[ai][1][m][0][e]; v1[4 + e] = acc[ai][1][m][1][e]; }
                if (gain) {
                    float ss = 0.f;
#pragma unroll
                    for (int e = 0; e < 8; ++e) ss += v0[e] * v0[e] + v1[e] * v1[e];
                    ss = rows_sum(ss);
                    const float r = rsqrtf(ss * (1.0f / 64.0f) + 1e-6f);
                    const float* rp = rope + ((size_t)(row & 2047) * 32 + 8 * fq) * 2;
                    const f32x4 t0 = *(const f32x4*)(rp), t1 = *(const f32x4*)(rp + 4), t2 = *(const f32x4*)(rp + 8), t3 = *(const f32x4*)(rp + 12);
                    const float cs[8] = {t0[0], t0[2], t1[0], t1[2], t2[0], t2[2], t3[0], t3[2]}, sn[8] = {t0[1], t0[3], t1[1], t1[3], t2[1], t2[3], t3[1], t3[3]};
#pragma unroll
                    for (int e = 0; e < 8; ++e) { const float y0 = v0[e] * r * g0[e], y1 = v1[e] * r * g1[e]; v0[e] = y0 * cs[e] - y1 * sn[e]; v1[e] = y1 * cs[e] + y0 * sn[e]; }
                }
                u32x4 w0, w1;
                w0.x = cvt_pk_bf16(v0[0], v0[1]); w0.y = cvt_pk_bf16(v0[2], v0[3]); w0.z = cvt_pk_bf16(v0[4], v0[5]); w0.w = cvt_pk_bf16(v0[6], v0[7]);
                w1.x = cvt_pk_bf16(v1[0], v1[1]); w1.y = cvt_pk_bf16(v1[2], v1[3]); w1.z = cvt_pk_bf16(v1[4], v1[5]); w1.w = cvt_pk_bf16(v1[6], v1[7]);
                bf16_t* rowp = O + (size_t)row * ldc + col0;
                *(u32x4*)(rowp) = w0; *(u32x4*)(rowp + 32) = w1;
                if (km) {
#pragma unroll
                    for (int e = 0; e < 8; ++e) { cs0[e] += v0[e]; cs1[e] += v1[e]; }
                }
            }
        if (km) {
#pragma unroll
            for (int e = 0; e < 8; ++e) {
                cs0[e] = row16_sum(cs0[e]); cs1[e] = row16_sum(cs1[e]);
            }
            if (fr == 0) {
                float* kp = kmean + ((size_t)((u.pm >> 3) * 8 + (hg - 32)) * 8 + (u.pm & 7)) * 64 + 8 * fq;
#pragma unroll
                for (int e = 0; e < 8; ++e) { atomicAdd(kp + e, cs0[e] * (1.0f / 256.0f)); atomicAdd(kp + 32 + e, cs1[e] * (1.0f / 256.0f)); }
            }
        }
    }
};
template <bool XBF> struct EpiResid {
    static constexpr bool PERM = true, AFTER_DRAIN = false;
    const void* xin; bf16_t* xout; const float* gate;
    __device__ __forceinline__ void operator()(const f32x4 (&acc)[2][2][4][2], const Unit& u, int wr, int wc, int fr_, int fq_) const {
        int fr = fr_, fq = fq_; asm volatile("" : "+v"(fr), "+v"(fq));
        const int row0 = u.pm * BM + wr * 64 + fr, col0 = u.pn * BM + wc * 32 + 8 * fq;
#pragma unroll
        for (int ai = 0; ai < 2; ++ai)
#pragma unroll
            for (int m = 0; m < 4; ++m) { const int row = row0 + ai * HALF + m * 16; const float* gp = gate + (size_t)(row >> 11) * 6144 + col0;
                bf16_t* xo = xout + (size_t)row * 1024 + col0;
#pragma unroll
                for (int bj = 0; bj < 2; ++bj) {
                    f32x4 x0, x1;
                    if constexpr (XBF) { const u32x4 q = *(const u32x4*)((const bf16_t*)xin + (size_t)row * 1024 + col0 + bj * HALF);
                        x0 = (f32x4){__uint_as_float(q.x << 16), __uint_as_float(q.x & 0xffff0000u), __uint_as_float(q.y << 16), __uint_as_float(q.y & 0xffff0000u)};
                        x1 = (f32x4){__uint_as_float(q.z << 16), __uint_as_float(q.z & 0xffff0000u), __uint_as_float(q.w << 16), __uint_as_float(q.w & 0xffff0000u)}; }
                    else { const float* xi = (const float*)xin + (size_t)row * 1024 + col0 + bj * HALF; x0 = *(const f32x4*)xi; x1 = *(const f32x4*)(xi + 4); }
                    const f32x4 a0 = acc[ai][bj][m][0], a1 = acc[ai][bj][m][1], g0 = *(const f32x4*)(gp + bj * HALF), g1 = *(const f32x4*)(gp + bj * HALF + 4);
                    u32x4 w; w.x = cvt_pk_bf16(x0[0] + g0[0] * a0[0], x0[1] + g0[1] * a0[1]); w.y = cvt_pk_bf16(x0[2] + g0[2] * a0[2], x0[3] + g0[3] * a0[3]);
                    w.z = cvt_pk_bf16(x1[0] + g1[0] * a1[0], x1[1] + g1[1] * a1[1]); w.w = cvt_pk_bf16(x1[2] + g1[2] * a1[2], x1[3] + g1[3] * a1[3]);
                    *(u32x4*)(xo + bj * HALF) = w; } }
    }
};
template <class Epi, class Sched, bool ALIGN_EPI = false, bool SP2 = false>
__device__ __forceinline__ void gemm_phase(PG8_LAS unsigned char* lds, const Gemm g, const Sched& S, const Epi& E) {
    const int tid = ltid(), wid = __builtin_amdgcn_readfirstlane(tid >> 6), lane = tid & 63, wr = wid >> 2, wc = wid & 3, fr = lane & 15, fq = lane >> 4;
    const int K = g.K, nt = K / BK;
    unsigned voffA[2], voffB[2];
#pragma unroll
    for (int i = 0; i < 2; ++i) { int R, C; stage_rc(tid * 16 + i * 8192, R, C); const int Rb = Epi::PERM ? ((R & ~31) + perm32(R & 31)) : R;
        voffA[i] = (unsigned)(R * K + C) * 2u; voffB[i] = (unsigned)(Rb * K + C) * 2u; }
    const size_t kstep = (size_t)(BK * 2);
    const size_t hstep = (size_t)HALF * K * 2;
    const size_t tstep = 2 * hstep;
    const unsigned ldsw = (unsigned)wid * 1024u;
    const int aoff = lds_byte(wr * 64 + fr, fq * 8), boff = lds_byte(wc * 32 + fr, fq * 8);
#define PG8_SA(b, h) (((b) * 2 + (h)) * HTB)
#define PG8_SB(b, h) ((4 + (b) * 2 + (h)) * HTB)
#define PG8_STAGE(bufoff, gbase, voff) do { _Pragma("unroll") for (int _i = 0; _i < 2; ++_i) \
        __builtin_amdgcn_global_load_lds((const unsigned*)((const char*)(gbase) + (voff)[_i]), (PG8_LAS unsigned*)(lds + (bufoff) + ldsw + _i * 8192), 16, 0, 0); } while (0)
#define PG8_LDA(dst, b, h) do { _Pragma("unroll") for (int m = 0; m < 4; ++m) _Pragma("unroll") for (int k = 0; k < 2; ++k) dst[m][k] = *(const PG8_LAS bf16x8*)(lds + PG8_SA(b, h) + aoff + m * 2048 + k * 1024); } while (0)
#define PG8_LDB(dst, b, h) do { _Pragma("unroll") for (int n = 0; n < 2; ++n) _Pragma("unroll") for (int k = 0; k < 2; ++k) dst[n][k] = *(const PG8_LAS bf16x8*)(lds + PG8_SB(b, h) + boff + n * 2048 + k * 1024); } while (0)
#define PG8_MMA(ai, bj, At, Bt) do { __builtin_amdgcn_s_setprio(1); _Pragma("unroll") for (int m = 0; m < 4; ++m) _Pragma("unroll") for (int n = 0; n < 2; ++n) _Pragma("unroll") for (int k = 0; k < 2; ++k) \
        acc[ai][bj][m][n] = __builtin_amdgcn_mfma_f32_16x16x32_bf16(Bt[n][k], At[m][k], acc[ai][bj][m][n], 0, 0, 0); __builtin_amdgcn_s_setprio(0); } while (0)
#define PG8_WAIT_V(n) asm volatile("s_waitcnt vmcnt(" #n ")" ::: "memory")
#define PG8_WAIT_L(n) asm volatile("s_waitcnt lgkmcnt(" #n ")" ::: "memory")
#define PG8_BAR __builtin_amdgcn_s_barrier()
#define PG8_SCHED __builtin_amdgcn_sched_barrier(0)
    Unit cur, nxt; int ui = 0;
    if (!S.next(0, cur)) return;
    f32x4 acc[2][2][4][2];
#pragma unroll
    for (int a = 0; a < 2; ++a)
#pragma unroll
        for (int b = 0; b < 2; ++b)
#pragma unroll
            for (int m = 0; m < 4; ++m)
#pragma unroll
                for (int n = 0; n < 2; ++n) acc[a][b][m][n] = (f32x4){0.f, 0.f, 0.f, 0.f};
    bf16x8 At[4][2], B0[2][2], B1[2][2];
    const char* cA = (const char*)g.A + (size_t)cur.pm * tstep; const char* cB = (const char*)g.Bt + (size_t)cur.pn * tstep;
    S.a_ready(cur);
    if constexpr (SP2) {
        PG8_STAGE(PG8_SB(0, 0), cB, voffB); PG8_STAGE(PG8_SB(0, 1), cB + hstep, voffB); PG8_STAGE(PG8_SA(0, 0), cA, voffA); PG8_STAGE(PG8_SA(0, 1), cA + hstep, voffA);
        if (wr == 1) PG8_BAR;
        PG8_WAIT_V(2); PG8_BAR;
        PG8_STAGE(PG8_SB(1, 0), cB + kstep, voffB); PG8_STAGE(PG8_SA(1, 0), cA + kstep, voffA); PG8_STAGE(PG8_SB(1, 1), cB + hstep + kstep, voffB);
        PG8_WAIT_V(6); PG8_BAR;
    } else {
        PG8_STAGE(PG8_SB(0, 0), cB, voffB); PG8_STAGE(PG8_SA(0, 0), cA, voffA); PG8_STAGE(PG8_SB(0, 1), cB + hstep, voffB); PG8_STAGE(PG8_SA(0, 1), cA + hstep, voffA);
        if (wr == 1) PG8_BAR;
        PG8_WAIT_V(4); PG8_BAR;
        PG8_STAGE(PG8_SB(1, 0), cB + kstep, voffB); PG8_STAGE(PG8_SA(1, 0), cA + kstep, voffA); PG8_STAGE(PG8_SB(1, 1), cB + hstep + kstep, voffB);
        PG8_WAIT_V(6); PG8_BAR;
    }
    for (;;) {
        const bool has_next = S.next(ui + 1, nxt);
        const char* nA = has_next ? (const char*)g.A + (size_t)nxt.pm * tstep : cA; const char* nB = has_next ? (const char*)g.Bt + (size_t)nxt.pn * tstep : cB;
        for (int t = 0; t < nt; t += 2) {
            const bool last = (t == nt - 2);
            const char* a1 = cA + (size_t)(t + 1) * kstep;
            const char* a2 = last ? nA : cA + (size_t)(t + 2) * kstep; const char* b2 = last ? nB : cB + (size_t)(t + 2) * kstep;
            const char* a3 = a2 + kstep; const char* b3 = b2 + kstep;
            if (last && has_next) S.a_ready(nxt);
            if constexpr (SP2) {
            PG8_LDB(B0, 0, 0); PG8_LDB(B1, 0, 1); PG8_SCHED; PG8_LDA(At, 0, 0); PG8_STAGE(PG8_SA(1, 1), a1 + hstep, voffA);
            PG8_WAIT_V(8); PG8_WAIT_L(0); PG8_BAR; PG8_MMA(0, 0, At, B0); PG8_MMA(0, 1, At, B1); PG8_BAR; PG8_SCHED;
            PG8_LDA(At, 0, 1); PG8_STAGE(PG8_SB(0, 0), b2, voffB); PG8_STAGE(PG8_SB(0, 1), b2 + hstep, voffB); PG8_STAGE(PG8_SA(0, 0), a2, voffA);
            PG8_WAIT_V(8); PG8_WAIT_L(0); PG8_BAR; PG8_MMA(1, 0, At, B0); PG8_MMA(1, 1, At, B1); PG8_BAR; PG8_SCHED;
            PG8_LDB(B0, 1, 0); PG8_LDB(B1, 1, 1); PG8_SCHED; PG8_LDA(At, 1, 0); PG8_STAGE(PG8_SA(0, 1), a2 + hstep, voffA);
            PG8_WAIT_V(8); PG8_WAIT_L(0); PG8_BAR; PG8_MMA(0, 0, At, B0); PG8_MMA(0, 1, At, B1); PG8_BAR; PG8_SCHED;
            PG8_LDA(At, 1, 1); PG8_STAGE(PG8_SB(1, 0), b3, voffB); PG8_STAGE(PG8_SB(1, 1), b3 + hstep, voffB); PG8_STAGE(PG8_SA(1, 0), a3, voffA);
            PG8_WAIT_V(8); PG8_WAIT_L(0); PG8_BAR; PG8_MMA(1, 0, At, B0); PG8_MMA(1, 1, At, B1); PG8_BAR; PG8_SCHED;
            } else {
            PG8_LDB(B0, 0, 0); PG8_SCHED; PG8_LDA(At, 0, 0); PG8_STAGE(PG8_SA(1, 1), a1 + hstep, voffA);
            PG8_WAIT_L(8); PG8_BAR; PG8_WAIT_L(0); PG8_MMA(0, 0, At, B0); PG8_BAR; PG8_SCHED;
            PG8_LDB(B1, 0, 1); PG8_STAGE(PG8_SB(0, 0), b2, voffB);
            PG8_BAR; PG8_WAIT_L(0); PG8_MMA(0, 1, At, B1); PG8_BAR;
            PG8_LDA(At, 0, 1); PG8_STAGE(PG8_SA(0, 0), a2, voffA);
            PG8_BAR; PG8_WAIT_L(0); PG8_MMA(1, 0, At, B0); PG8_BAR; PG8_SCHED;
            PG8_STAGE(PG8_SB(0, 1), b2 + hstep, voffB);
            PG8_WAIT_V(6); PG8_BAR; PG8_MMA(1, 1, At, B1); PG8_BAR;
            PG8_LDB(B0, 1, 0); PG8_SCHED; PG8_LDA(At, 1, 0); PG8_STAGE(PG8_SA(0, 1), a2 + hstep, voffA);
            PG8_WAIT_L(8); PG8_BAR; PG8_WAIT_L(0); PG8_MMA(0, 0, At, B0); PG8_BAR; PG8_SCHED;
            PG8_LDB(B1, 1, 1); PG8_STAGE(PG8_SB(1, 0), b3, voffB);
            PG8_BAR; PG8_WAIT_L(0); PG8_MMA(0, 1, At, B1); PG8_BAR;
            PG8_LDA(At, 1, 1); PG8_STAGE(PG8_SA(1, 0), a3, voffA);
            PG8_BAR; PG8_WAIT_L(0); PG8_MMA(1, 0, At, B0); PG8_BAR; PG8_SCHED;
            PG8_STAGE(PG8_SB(1, 1), b3 + hstep, voffB);
            PG8_WAIT_V(6); PG8_BAR; PG8_MMA(1, 1, At, B1); PG8_BAR;
            }
        }
        if constexpr (ALIGN_EPI) { if (wr == 0) PG8_BAR; }
        if constexpr (!Epi::AFTER_DRAIN) { E(acc, cur, wr, wc, fr, fq); S.done(cur); }
        if (!has_next) break;
#pragma unroll
        for (int a = 0; a < 2; ++a)
#pragma unroll
            for (int b = 0; b < 2; ++b)
#pragma unroll
                for (int m = 0; m < 4; ++m)
#pragma unroll
                    for (int n = 0; n < 2; ++n) acc[a][b][m][n] = (f32x4){0.f, 0.f, 0.f, 0.f};
        cur = nxt; cA = nA; cB = nB; ++ui;
        if constexpr (ALIGN_EPI) { if (wr == 1) PG8_BAR; }
    }
    PG8_WAIT_V(0);
    if constexpr (!ALIGN_EPI) { if (wr == 0) PG8_BAR; }
    PG8_BAR;
    if constexpr (Epi::AFTER_DRAIN) { E.fused(acc, cur, wr, wc, fr, fq, lds, wid, lane); S.done(cur); }
#undef PG8_SA
#undef PG8_SB
#undef PG8_STAGE
#undef PG8_LDA
#undef PG8_LDB
#undef PG8_MMA
#undef PG8_WAIT_V
#undef PG8_WAIT_L
#undef PG8_BAR
#undef PG8_SCHED
}
}

typedef float f32x16 __attribute__((ext_vector_type(16)));
typedef short s16x4 __attribute__((ext_vector_type(4)));
typedef short v4i16_t __attribute__((ext_vector_type(4)));
typedef float f32x2_t __attribute__((ext_vector_type(2)));
typedef __bf16 bf16x2_t __attribute__((ext_vector_type(2)));
#define LAS __attribute__((address_space(3)))
constexpr int VROW = 144, VBUF = 32 * VROW;
constexpr int VROWV = 192, VBUFV = 32 * VROWV;
constexpr float L2E = 1.4426950408889634f, LN2 = 0.6931471805599453f;
constexpr float SC2 = 0.125f * L2E;

__device__ __forceinline__ int crow(int r, int hi) { return (r & 3) + 8 * (r >> 2) + 4 * hi; }
__device__ __forceinline__ unsigned cvtpk(float lo, float hi) { f32x2_t v = {lo, hi}; bf16x2_t b = __builtin_convertvector(v, bf16x2_t); return __builtin_bit_cast(unsigned, b); }
__device__ __forceinline__ float xhalf(float v, int hi) {
    auto r = __builtin_amdgcn_permlane32_swap(__float_as_uint(v), __float_as_uint(v), false, false);
    return __uint_as_float(hi ? r[0] : r[1]);
}
__device__ __forceinline__ s16x4 vtr(const LAS unsigned char* p) { return __builtin_bit_cast(s16x4, __builtin_amdgcn_ds_read_tr16_b64_v4i16((LAS v4i16_t*)p)); }

struct KVRegs { u32x4 k[4]; u32x4 v[4]; };
__device__ __forceinline__ void load_kv(KVRegs& R, const bf16* base, int kp0, int kst, int kcol, int vcol, int lane) {
#pragma unroll
    for (int j = 0; j < 4; ++j) {
        const int pos = kp0 + kst * (8 * j + (lane >> 3));
        const int pc = pos < SQ - 1 ? pos : SQ - 1;
        const bf16* rp = base + (size_t)pc * QKV_LD + (lane & 7) * 8;
        R.k[j] = *(const u32x4*)(rp + kcol); R.v[j] = *(const u32x4*)(rp + vcol);
    }
}
__device__ __forceinline__ void kv_stage(const KVRegs& R, LAS unsigned char* klds, LAS unsigned char* vlds, int lane) {
#pragma unroll
    for (int j = 0; j < 4; ++j) { const int r_ = 8 * j + (lane >> 3), c_ = (lane & 7) * 16; *(LAS u32x4*)(klds + r_ * VROW + c_) = R.k[j]; *(LAS u32x4*)(vlds + r_ * VROWV + c_) = R.v[j]; }
}
__device__ __forceinline__ f32x16 qk_tile(const LAS unsigned char* klds, const bf16x8 (&qf)[4], int r32, int hi) {
    f32x16 s = {0.f, 0.f, 0.f, 0.f, 0.f, 0.f, 0.f, 0.f, 0.f, 0.f, 0.f, 0.f, 0.f, 0.f, 0.f, 0.f};
#pragma unroll
    for (int k = 0; k < 4; ++k) { const bf16x8 kf = *(const LAS bf16x8*)(klds + r32 * VROW + (2 * k + hi) * 16); s = __builtin_amdgcn_mfma_f32_32x32x16_bf16(kf, qf[k], s, 0, 0, 0); }
    return s;
}
__device__ __forceinline__ void pv_tile(f32x16 (&o)[2], const f32x16& p, const LAS unsigned char* vlds, int lane) {
    const int g = lane >> 4, i = lane & 15, h = lane >> 5;
    const LAS unsigned char* vb = vlds + (4 * h + (i >> 2)) * VROWV + (16 * (g & 1) + 4 * (i & 3)) * 2;
#pragma unroll
    for (int s = 0; s < 2; ++s) {
        u32x4 pw; pw.x = cvtpk(p[8 * s], p[8 * s + 1]); pw.y = cvtpk(p[8 * s + 2], p[8 * s + 3]); pw.z = cvtpk(p[8 * s + 4], p[8 * s + 5]); pw.w = cvtpk(p[8 * s + 6], p[8 * s + 7]);
        const bf16x8 pb = __builtin_bit_cast(bf16x8, pw);
#pragma unroll
        for (int df = 0; df < 2; ++df) {
            const s16x4 lo = vtr(vb + (16 * s) * VROWV + df * 64), hh = vtr(vb + (16 * s + 8) * VROWV + df * 64);
            const bf16x8 va = (bf16x8){lo[0], lo[1], lo[2], lo[3], hh[0], hh[1], hh[2], hh[3]};
            o[df] = __builtin_amdgcn_mfma_f32_32x32x16_bf16(va, pb, o[df], 0, 0, 0);
        }
    }
}
__device__ __forceinline__ void load_q(bf16x8 (&qf)[4], const bf16* base, int qpos, int qcol, int hi) {
    const bf16* rp = base + (size_t)qpos * QKV_LD + qcol + 8 * hi;
#pragma unroll
    for (int k = 0; k < 4; ++k) qf[k] = *(const bf16x8*)(rp + 16 * k);
}
__device__ __forceinline__ void store_o(bf16* yrow, const f32x16 (&o)[2], float inv, int hi) {
#pragma unroll
    for (int df = 0; df < 2; ++df)
#pragma unroll
        for (int g = 0; g < 4; ++g) {
            u32x2 w; w.x = cvtpk(o[df][4 * g] * inv, o[df][4 * g + 1] * inv); w.y = cvtpk(o[df][4 * g + 2] * inv, o[df][4 * g + 3] * inv);
            *(u32x2*)(yrow + 32 * df + 8 * g + 4 * hi) = w;
        }
}
__device__ __forceinline__ void osm_tile(f32x16& s, float& m, float& l, f32x16 (&o)[2]) {
    float mx = s[0];
#pragma unroll
    for (int r = 1; r < 16; ++r) mx = fmaxf(mx, s[r]);
    { auto rr = __builtin_amdgcn_permlane32_swap(__float_as_uint(mx), __float_as_uint(mx), false, false); mx = fmaxf(__uint_as_float(rr[0]), __uint_as_float(rr[1])); }
    const float mn = fmaxf(m, mx);
    const float ms = (mn == -INFINITY) ? 0.f : mn;
    const float alpha = __builtin_amdgcn_exp2f((m - ms) * SC2);
    const float mc = ms * SC2;
    float ps = 0.f;
#pragma unroll
    for (int r = 0; r < 16; ++r) { s[r] = __builtin_amdgcn_exp2f(s[r] * SC2 - mc); ps += s[r]; }
    l = l * alpha + ps; m = mn;
    if (!__all(alpha == 1.0f)) {
#pragma unroll
        for (int df = 0; df < 2; ++df)
#pragma unroll
            for (int r = 0; r < 16; ++r) o[df][r] *= alpha;
    }
}
__device__ __forceinline__ void osm_tile2(f32x16& s0, f32x16& s1, float& m, float& l, f32x16 (&o)[2]) {
    float mx = fmaxf(s0[0], s1[0]);
#pragma unroll
    for (int r = 1; r < 16; ++r) mx = fmaxf(mx, fmaxf(s0[r], s1[r]));
    { auto rr = __builtin_amdgcn_permlane32_swap(__float_as_uint(mx), __float_as_uint(mx), false, false); mx = fmaxf(__uint_as_float(rr[0]), __uint_as_float(rr[1])); }
    const float mn = fmaxf(m, mx);
    const float ms = (mn == -INFINITY) ? 0.f : mn;
    const float alpha = __builtin_amdgcn_exp2f((m - ms) * SC2);
    const float mc = ms * SC2;
    float ps0 = 0.f, ps1 = 0.f;
#pragma unroll
    for (int r = 0; r < 16; ++r) { s0[r] = __builtin_amdgcn_exp2f(s0[r] * SC2 - mc); ps0 += s0[r]; s1[r] = __builtin_amdgcn_exp2f(s1[r] * SC2 - mc); ps1 += s1[r]; }
    l = l * alpha + (ps0 + ps1); m = mn;
    if (!__all(alpha == 1.0f)) {
#pragma unroll
        for (int df = 0; df < 2; ++df)
#pragma unroll
            for (int r = 0; r < 16; ++r) o[df][r] *= alpha;
    }
}
#define ZERO16 {0.f, 0.f, 0.f, 0.f, 0.f, 0.f, 0.f, 0.f, 0.f, 0.f, 0.f, 0.f, 0.f, 0.f, 0.f, 0.f}

struct AttnCtx {
    const bf16* base; int kcol, vcol, r32, hi, lane; LAS unsigned char* vlds; LAS unsigned char* klds; bf16x8 qf[4]; f32x16 o[2];
};
#define ATTN_STEP(SC, SL, T) { \
        if (SYNC) __builtin_amdgcn_s_barrier(); \
        { int kp_, ks_; const int tl_ = (T) + 2 < nt ? (T) + 2 : nt - 1; mx.pos(tl_, kp_, ks_); load_kv(SL, c.base, kp_, ks_, c.kcol, c.vcol, c.lane); } \
        kv_stage(SC, c.klds, c.vlds, c.lane); f32x16 s_ = qk_tile(c.klds, c.qf, c.r32, c.hi); \
        const bool stop_ = mx.process((T), s_, c); pv_tile(c.o, s_, c.vlds, c.lane); \
        if ((!SYNC && stop_) || (T) + 1 >= nt) break; }
template <class M, bool SYNC> __device__ __forceinline__ void attn_run(M& mx, AttnCtx& c) {
    const int nt = mx.nt;
    KVRegs S0, S1, S2;
    { int kp, ks; mx.pos(0, kp, ks); load_kv(S0, c.base, kp, ks, c.kcol, c.vcol, c.lane);
      mx.pos(1 < nt ? 1 : nt - 1, kp, ks); load_kv(S1, c.base, kp, ks, c.kcol, c.vcol, c.lane); }
    for (int t = 0;; t += 3) {
        ATTN_STEP(S0, S2, t)
        ATTN_STEP(S1, S0, t + 1)
        ATTN_STEP(S2, S1, t + 2)
    }
}
#define SH_BAR() asm volatile("s_waitcnt lgkmcnt(0)\n\ts_barrier" ::: "memory")
constexpr int SLOT_K = 64 * VROW, SLOT_BYTES = 64 * VROW + 64 * VROWV;
struct ShRegs { u32x4 a, b; };
__device__ __forceinline__ void sh_load(ShRegs& R, const bf16* base, int kp0, int kcol, int vcol, int w, int lane) {
    const int pos = kp0 + 4 * w + ((lane & 31) >> 3);
    const int pa = pos < SQ - 1 ? pos : SQ - 1, pb = pos + 32 < SQ - 1 ? pos + 32 : SQ - 1;
    const int col = ((lane >> 5) ? vcol : kcol) + (lane & 7) * 8;
    R.a = *(const u32x4*)(base + (size_t)pa * QKV_LD + col); R.b = *(const u32x4*)(base + (size_t)pb * QKV_LD + col);
}
__device__ __forceinline__ void sh_write(LAS unsigned char* slot, const ShRegs& R, int w, int lane) {
    const int row = 4 * w + ((lane & 31) >> 3);
    LAS unsigned char* p = slot + ((lane >> 5) ? SLOT_K + row * VROWV : row * VROW) + (lane & 7) * 16;
    *(LAS u32x4*)p = R.a; *(LAS u32x4*)(p + 32 * ((lane >> 5) ? VROWV : VROW)) = R.b;
}
#define SH_STEP(RW, RL, T) { \
        SH_BAR(); \
        { const int tl_ = (T) + 2 < nt ? (T) + 2 : nt - 1; sh_load(RL, c.base, mx.pos2(tl_), c.kcol, c.vcol, w, c.lane); } \
        sh_write(slots + (((T) + 1) & 1) * SLOT_BYTES, RW, w, c.lane); \
        if (mx.active2((T), w)) { LAS unsigned char* sl_ = slots + ((T) & 1) * SLOT_BYTES; \
            f32x16 s0_ = qk_tile(sl_, c.qf, c.r32, c.hi), s1_ = qk_tile(sl_ + 32 * VROW, c.qf, c.r32, c.hi); mx.process2((T), s0_, s1_, c); \
            pv_tile(c.o, s0_, sl_ + SLOT_K, c.lane); pv_tile(c.o, s1_, sl_ + SLOT_K + 32 * VROWV, c.lane); } \
        if ((T) + 1 >= nt) break; }
template <class M> __device__ __forceinline__ void attn_run_shared(M& mx, AttnCtx& c, LAS unsigned char* slots, int w) {
    const int nt = mx.nt2;
    ShRegs R0, R1, R2;
    sh_load(R0, c.base, mx.pos2(0), c.kcol, c.vcol, w, c.lane);
    sh_load(R1, c.base, mx.pos2(1 < nt ? 1 : nt - 1), c.kcol, c.vcol, w, c.lane);
    SH_BAR();
    sh_write(slots, R0, w, c.lane);
    for (int t = 0;; t += 3) {
        SH_STEP(R1, R2, t)
        SH_STEP(R2, R0, t + 1)
        SH_STEP(R0, R1, t + 2)
    }
}
struct MixA {
    int nt, k00, qpos; float m, l;
    __device__ __forceinline__ void pos(int idx, int& kp0, int& kst) const { kp0 = k00 + 32 * idx; kst = 1; }
    __device__ __forceinline__ bool process(int idx, f32x16& s, AttnCtx& c) {
        const int k0 = k00 + 32 * idx;
#pragma unroll
        for (int r = 0; r < 16; ++r) { const int dist = qpos - (k0 + crow(r, c.hi)); if (dist < 0 || dist > 127) s[r] = -INFINITY; }
        osm_tile(s, m, l, c.o); return false;
    }
};
__device__ void attn_A(const bf16* base, int hq, int q0, float sink, bf16* ybase, LAS unsigned char* vlds, int lane) {
    AttnCtx c; c.base = base; c.r32 = lane & 31; c.hi = lane >> 5; c.lane = lane; c.vlds = vlds; c.klds = vlds + VBUFV; c.kcol = 512 + (hq >> 2) * 64; c.vcol = 640 + (hq >> 2) * 64;
    c.o[0] = (f32x16)ZERO16; c.o[1] = (f32x16)ZERO16;
    MixA mx; mx.qpos = q0 + c.r32; mx.k00 = q0 - 128 > 0 ? q0 - 128 : 0; mx.nt = 5; mx.m = -INFINITY; mx.l = 0.f;
    load_q(c.qf, base, mx.qpos, hq * 64, c.hi);
    attn_run<MixA, true>(mx, c);
    float l = mx.l + xhalf(mx.l, c.hi);
    l += __builtin_amdgcn_exp2f(sink * L2E - mx.m * SC2);
    store_o(ybase + (size_t)mx.qpos * DM + hq * 64, c.o, 1.0f / l, c.hi);
}
struct MixB {
    int nt, q0, qpos; float carry;
    __device__ __forceinline__ void pos(int idx, int& kp0, int& kst) const { kp0 = q0 - 32 * idx; kst = 1; }
    __device__ __forceinline__ bool process(int idx, f32x16& s, AttnCtx& c) {
        const int k0 = q0 - 32 * idx, hi = c.hi;
        float lk[16], G[4], Gp[4];
#pragma unroll
        for (int r = 0; r < 16; ++r) {
            const float z = s[r] * 0.125f;
            const bool valid = (k0 + crow(r, hi)) < qpos;
            const float sp = fmaxf(z, 0.f) + LN2 * __builtin_amdgcn_logf(1.0f + __builtin_amdgcn_exp2f(-fabsf(z) * L2E));
            lk[r] = valid ? -sp : 0.f;
            s[r] = valid ? (z - sp) : -INFINITY;
        }
#pragma unroll
        for (int g = 0; g < 4; ++g) { G[g] = (lk[4 * g] + lk[4 * g + 1]) + (lk[4 * g + 2] + lk[4 * g + 3]); Gp[g] = xhalf(G[g], hi); }
        float above = carry;
#pragma unroll
        for (int g = 3; g >= 0; --g) {
            float off = above + (hi == 0 ? Gp[g] : 0.f);
            s[4 * g + 3] = __builtin_amdgcn_exp2f((s[4 * g + 3] + off) * L2E); off += lk[4 * g + 3];
            s[4 * g + 2] = __builtin_amdgcn_exp2f((s[4 * g + 2] + off) * L2E); off += lk[4 * g + 2];
            s[4 * g + 1] = __builtin_amdgcn_exp2f((s[4 * g + 1] + off) * L2E); off += lk[4 * g + 1];
            s[4 * g + 0] = __builtin_amdgcn_exp2f((s[4 * g + 0] + off) * L2E);
            above += G[g] + Gp[g];
        }
        carry = above;
        return __all(carry < -40.0f) != 0;
    }
};
__device__ void attn_B(const bf16* base, int h, int q0, bf16* ybase, LAS unsigned char* vlds, int lane) {
    AttnCtx c; c.base = base; c.r32 = lane & 31; c.hi = lane >> 5; c.lane = lane; c.vlds = vlds; c.klds = vlds + VBUFV; c.kcol = 1280 + h * 64; c.vcol = 1792 + h * 64;
    c.o[0] = (f32x16)ZERO16; c.o[1] = (f32x16)ZERO16;
    MixB mx; mx.q0 = q0; mx.qpos = q0 + c.r32; mx.nt = q0 / 32 + 1; mx.carry = 0.f;
    load_q(c.qf, base, mx.qpos, 768 + h * 64, c.hi);
    attn_run<MixB, false>(mx, c);
    store_o(ybase + (size_t)mx.qpos * DM + 512 + h * 64, c.o, 1.0f, c.hi);
}
struct MixCp {
    int nt, n0, r0, j1lo, qpos; float m, l;
    __device__ __forceinline__ void pos(int t, int& kp0, int& kst) const {
        if (t < n0) { kp0 = r0 + 512 * t; kst = 16; } else { kp0 = (r0 & 3) + 4 * (j1lo + 32 * (t - n0)); kst = 4; }
    }
    __device__ __forceinline__ bool process(int t, f32x16& s, AttnCtx& c) {
        int kp0, kst; pos(t, kp0, kst);
        const int win = t < n0 ? 2048 : 512;
#pragma unroll
        for (int r = 0; r < 16; ++r) { const int dist = qpos - (kp0 + kst * crow(r, c.hi)); if (dist < 0 || dist > win) s[r] = -INFINITY; }
        osm_tile(s, m, l, c.o); return false;
    }
};
struct MixC1 {
    int nt2, p0, qpos; float m, l;
    __device__ __forceinline__ int pos2(int T) const { return p0 + 64 * T; }
    __device__ __forceinline__ bool active2(int T, int w) const { return true; }
    __device__ __forceinline__ void process2(int T, f32x16& s0, f32x16& s1, AttnCtx& c) {
        const int k0 = p0 + 64 * T;
#pragma unroll
        for (int r = 0; r < 16; ++r) { const int dist = qpos - (k0 + crow(r, c.hi)); if (dist < 0 || dist > 128) s0[r] = -INFINITY; if (dist < 32 || dist > 160) s1[r] = -INFINITY; }
        osm_tile2(s0, s1, m, l, c.o);
    }
};
__device__ void attn_C(const bf16* base, int h, int r0, int g, bf16* ybase, LAS unsigned char* vlds, LAS unsigned char* xlds, int w, int lane) {
    AttnCtx c; c.base = base; c.r32 = lane & 31; c.hi = lane >> 5; c.lane = lane; c.vlds = vlds; c.klds = vlds + VBUFV; c.kcol = 512 + h * 64; c.vcol = 1024 + h * 64;
    c.o[0] = (f32x16)ZERO16; c.o[1] = (f32x16)ZERO16;
    const int qpos = r0 + 16 * (32 * g + c.r32);
    load_q(c.qf, base, qpos, h * 64, c.hi);
    MixCp mp; mp.r0 = r0; mp.qpos = qpos; mp.m = -INFINITY; mp.l = 0.f;
    mp.n0 = g + 1;
    mp.j1lo = (r0 >> 2) + 128 * g - 128 > 0 ? (r0 >> 2) + 128 * g - 128 : 0;
    mp.nt = mp.n0 + ((r0 >> 2) + 128 * g + 124 - mp.j1lo) / 32 + 1;
    attn_run<MixCp, true>(mp, c);
    MixC1 m1; m1.qpos = qpos; m1.m = mp.m; m1.l = mp.l;
    const int ra = r0 & 8;
    m1.p0 = 512 * g + ra - 128 > 0 ? 512 * g + ra - 128 : 0;
    m1.nt2 = ((512 * g + ra + 7 + 496 - m1.p0) / 32 + 2) / 2;
    attn_run_shared<MixC1>(m1, c, xlds + 64, w);
    const float l = m1.l + xhalf(m1.l, c.hi);
    store_o(ybase + (size_t)qpos * DM + h * 64, c.o, 1.0f / l, c.hi);
}
struct MixD {
    int nt, nt2, npast, own, q0, qpos; unsigned U, sel; float m, l;
    __device__ __forceinline__ int blk_of(int j) const {
        unsigned u = U; int b = 0;
#pragma unroll
        for (int i = 0; i < 7; ++i) { if (i < j) u &= u - 1u; }
        b = __builtin_ctz(u | 0x100u); return b;
    }
    __device__ __forceinline__ void pos(int t, int& kp0, int& kst) const {
        kst = 1;
        if (t < 8 * npast) kp0 = blk_of(t >> 3) * 256 + (t & 7) * 32; else kp0 = own * 256 + (t - 8 * npast) * 32;
    }
    __device__ __forceinline__ int pos2(int T) const { int kp, ks; pos(2 * T, kp, ks); return kp; }
    __device__ __forceinline__ bool active2(int T, int w) const { return T < 4 * npast || 2 * (T - 4 * npast) <= w; }
    __device__ __forceinline__ void process2(int T, f32x16& s0, f32x16& s1, AttnCtx& c) {
        if (T < 4 * npast) {
            const int blk = blk_of(T >> 2);
            if (!((sel >> blk) & 1u)) {
#pragma unroll
                for (int r = 0; r < 16; ++r) { s0[r] = -INFINITY; s1[r] = -INFINITY; }
            }
        } else {
            const int k0 = own * 256 + (T - 4 * npast) * 64;
#pragma unroll
            for (int r = 0; r < 16; ++r) { const int kk = k0 + crow(r, c.hi); if (kk > qpos) s0[r] = -INFINITY; if (kk + 32 > qpos) s1[r] = -INFINITY; }
        }
        osm_tile2(s0, s1, m, l, c.o);
    }
};
__device__ void attn_D(const bf16* base, const float* kmean  , int h, int q0, bf16* ybase, LAS unsigned char* vlds, LAS unsigned char* xlds, int lane) {
    AttnCtx c; c.base = base; c.r32 = lane & 31; c.hi = lane >> 5; c.lane = lane; c.vlds = vlds; c.klds = vlds + VBUFV; c.kcol = 2048 + h * 64; c.vcol = 2560 + h * 64;
    c.o[0] = (f32x16)ZERO16; c.o[1] = (f32x16)ZERO16;
    const int r32 = c.r32, hi = c.hi, own = q0 >> 8;
    MixD mx; mx.own = own; mx.q0 = q0; mx.qpos = q0 + r32; mx.m = -INFINITY; mx.l = 0.f;
    load_q(c.qf, base, mx.qpos, 1536 + h * 64, hi);
    unsigned sel = 0u;
    if (own > 0) {
        bf16x8 kf[4];
#pragma unroll
        for (int k = 0; k < 4; ++k) {
            u32x4 w = {0u, 0u, 0u, 0u};
            if (r32 < 8) { const float* kp = kmean + r32 * 64 + 16 * k + 8 * hi; const f32x4 a = *(const f32x4*)kp, b = *(const f32x4*)(kp + 4);
                w.x = cvtpk(a[0], a[1]); w.y = cvtpk(a[2], a[3]); w.z = cvtpk(b[0], b[1]); w.w = cvtpk(b[2], b[3]); }
            kf[k] = __builtin_bit_cast(bf16x8, w);
        }
        f32x16 gs = ZERO16;
#pragma unroll
        for (int k = 0; k < 4; ++k) gs = __builtin_amdgcn_mfma_f32_32x32x16_bf16(kf[k], c.qf[k], gs, 0, 0, 0);
        float gt[8];
#pragma unroll
        for (int r = 0; r < 4; ++r) { const float mine = gs[r], oth = xhalf(mine, hi); gt[r] = hi == 0 ? mine : oth; gt[4 + r] = hi == 0 ? oth : mine; }
        const int nsel = own < 3 ? own : 3;
        for (int rr = 0; rr < nsel; ++rr) {
            float best = -INFINITY; int bi = -1;
#pragma unroll
            for (int n = 0; n < 8; ++n) { const bool ok = n < own && !((sel >> n) & 1u) && (bi < 0 || gt[n] > best); if (ok) { best = gt[n]; bi = n; } }
            if (bi >= 0) sel |= 1u << bi;
        }
    }
    unsigned U = 0u;
#pragma unroll
    for (int n = 0; n < 8; ++n) if (__ballot((sel >> n) & 1u) != 0ull) U |= 1u << n;
    {
        volatile LAS unsigned* ux = (volatile LAS unsigned*)xlds;
        __builtin_amdgcn_s_barrier();
        if (lane == 0) ux[(q0 >> 5) & 7] = U;
        asm volatile("s_waitcnt lgkmcnt(0)" ::: "memory");
        __builtin_amdgcn_s_barrier();
        U = ux[0] | ux[1] | ux[2] | ux[3] | ux[4] | ux[5] | ux[6] | ux[7];
        U = __builtin_amdgcn_readfirstlane(U);
    }
    mx.U = U; mx.sel = sel; mx.npast = __builtin_popcount(U); mx.nt = 8 * mx.npast + 8; mx.nt2 = 4 * mx.npast + 4;
    attn_run_shared<MixD>(mx, c, xlds + 64, (q0 >> 5) & 7);
    const float l = mx.l + xhalf(mx.l, c.hi);
    store_o(ybase + (size_t)mx.qpos * DM + 512 + h * 64, c.o, 1.0f / l, hi);
}

__device__ void ph_attn0(const bf16* qkv, const float* sinks, bf16* y, LAS unsigned char* lds, int bid, int nb) {
    const int lane = ltid() & 63, w = __builtin_amdgcn_readfirstlane(ltid() >> 6);
    LAS unsigned char* vlds = lds + w * (VBUF + VBUFV);
    for (int pid = bid; pid < NB * 8; pid += nb) {
        const int b = pid >> 3, h = pid & 7;
        const bf16* base = qkv + (size_t)b * SQ * QKV_LD; bf16* ybase = y + (size_t)b * SQ * DM;
        const float sink = sinks[h];
        for (int rd = 0; rd < 8; ++rd) attn_A(base, h, (rd * 8 + w) * 32, sink, ybase, vlds, lane);
        for (int rd = 0; rd < 8; ++rd) attn_B(base, h, (rd * 8 + w) * 32, ybase, vlds, lane);
    }
}
__device__ void ph_attn1(const bf16* qkv, const float* kmean, bf16* y, LAS unsigned char* lds, int bid, int nb) {
    const int lane = ltid() & 63, w = __builtin_amdgcn_readfirstlane(ltid() >> 6);
    LAS unsigned char* vlds = lds + w * (VBUF + VBUFV);
    for (int pid = bid; pid < NB * 8; pid += nb) {
        const int b = pid >> 3, h = pid & 7;
        const bf16* base = qkv + (size_t)b * SQ * QKV_LD; bf16* ybase = y + (size_t)b * SQ * DM;
        for (int rd = 0; rd < 8; ++rd) { const int it = rd * 8 + w; attn_C(base, h, it & 15, it >> 4, ybase, vlds, lds + 8 * (VBUF + VBUFV), w, lane); }
        for (int rd = 0; rd < 8; ++rd) attn_D(base, kmean + (size_t)pid * 8 * 64, h, (rd * 8 + w) * 32, ybase, vlds, lds + 8 * (VBUF + VBUFV), lane);
    }
}

#define CE_D(a, b) { const float hi_ = fmaxf((a), (b)), lo_ = fminf((a), (b)); (a) = hi_; (b) = lo_; }
#define BSTAGE(arr, k, j) _Pragma("unroll") for (int i_ = 0; i_ < 16; ++i_) { const int l_ = i_ ^ (j); if (l_ > i_) { if ((i_ & (k)) == 0) CE_D(arr[i_], arr[l_]) else CE_D(arr[l_], arr[i_]) } }
__device__ __forceinline__ void bsort16(float (&a)[16]) {
    CE_D(a[0], a[1]) CE_D(a[2], a[3]) CE_D(a[0], a[2]) CE_D(a[1], a[3]) CE_D(a[1], a[2]) CE_D(a[4], a[5]) CE_D(a[6], a[7]) CE_D(a[4], a[6]) CE_D(a[5], a[7]) CE_D(a[5], a[6]) CE_D(a[0], a[4]) CE_D(a[2], a[6]) CE_D(a[2], a[4]) CE_D(a[1], a[5]) CE_D(a[3], a[7]) CE_D(a[3], a[5]) CE_D(a[1], a[2]) CE_D(a[3], a[4]) CE_D(a[5], a[6]) CE_D(a[8], a[9]) CE_D(a[10], a[11]) CE_D(a[8], a[10]) CE_D(a[9], a[11]) CE_D(a[9], a[10]) CE_D(a[12], a[13]) CE_D(a[14], a[15]) CE_D(a[12], a[14]) CE_D(a[13], a[15]) CE_D(a[13], a[14]) CE_D(a[8], a[12]) CE_D(a[10], a[14]) CE_D(a[10], a[12]) CE_D(a[9], a[13]) CE_D(a[11], a[15]) CE_D(a[11], a[13]) CE_D(a[9], a[10]) CE_D(a[11], a[12]) CE_D(a[13], a[14]) CE_D(a[0], a[8]) CE_D(a[4], a[12]) CE_D(a[4], a[8]) CE_D(a[2], a[10]) CE_D(a[6], a[14]) CE_D(a[6], a[10]) CE_D(a[2], a[4]) CE_D(a[6], a[8]) CE_D(a[10], a[12]) CE_D(a[1], a[9]) CE_D(a[5], a[13]) CE_D(a[5], a[9]) CE_D(a[3], a[11]) CE_D(a[7], a[15]) CE_D(a[7], a[11]) CE_D(a[3], a[5]) CE_D(a[7], a[9]) CE_D(a[11], a[13]) CE_D(a[1], a[2]) CE_D(a[3], a[4]) CE_D(a[5], a[6]) CE_D(a[7], a[8]) CE_D(a[9], a[10]) CE_D(a[11], a[12]) CE_D(a[13], a[14])
}
__device__ __forceinline__ void bmerge16(float (&a)[16]) {
    BSTAGE(a, 16, 8) BSTAGE(a, 16, 4) BSTAGE(a, 16, 2) BSTAGE(a, 16, 1)
}
__device__ __forceinline__ void merge_top16(float (&a)[16], const float (&b)[16]) {
#pragma unroll
    for (int i = 0; i < 16; ++i) a[i] = fmaxf(a[i], b[15 - i]);
    bmerge16(a);
}
__device__ __forceinline__ void xmerge16(float (&a)[16]) {
    {
        float A[16], B[16];
#pragma unroll
        for (int i = 0; i < 16; ++i) { auto r = __builtin_amdgcn_permlane16_swap(__float_as_uint(a[i]), __float_as_uint(a[i]), false, false); A[i] = __uint_as_float(r[0]); B[i] = __uint_as_float(r[1]); }
#pragma unroll
        for (int i = 0; i < 16; ++i) a[i] = fmaxf(A[i], B[15 - i]);
        bmerge16(a);
    }
    {
        float A[16], B[16];
#pragma unroll
        for (int i = 0; i < 16; ++i) { auto r = __builtin_amdgcn_permlane32_swap(__float_as_uint(a[i]), __float_as_uint(a[i]), false, false); A[i] = __uint_as_float(r[0]); B[i] = __uint_as_float(r[1]); }
#pragma unroll
        for (int i = 0; i < 16; ++i) a[i] = fmaxf(A[i], B[15 - i]);
        bmerge16(a);
    }
}
__host__ __device__ constexpr int pair_i(int id) {
    int c = 0;
    for (int i = 0; i < 16; ++i) { const int nj = 16 / (i + 1); if (id < c + nj) return i; c += nj; }
    return 0;
}
__host__ __device__ constexpr int pair_j(int id) {
    int c = 0;
    for (int i = 0; i < 16; ++i) { const int nj = 16 / (i + 1); if (id < c + nj) return id - c; c += nj; }
    return 0;
}
constexpr int SK_ROW = 272;
constexpr int SEL_SK_BYTES = 2 * 128 * SK_ROW;
constexpr int SEL_TAB_OFF = SEL_SK_BYTES;
constexpr int SEL_IDX_OFF = SEL_SK_BYTES + 64;

template <int S> __device__ __forceinline__ float cand_slot(const float (&L1)[16], const float (&L2)[16], int g) {
    constexpr int p0 = S, p1 = 16 + S, p2 = 32 + S, p3 = 48 + S;
    const float c0 = L1[pair_i(p0)] + L2[pair_j(p0)], c1 = L1[pair_i(p1)] + L2[pair_j(p1)], c2 = L1[pair_i(p2)] + L2[pair_j(p2)];
    const float c3 = p3 < 50 ? L1[pair_i(p3 < 50 ? p3 : 0)] + L2[pair_j(p3 < 50 ? p3 : 0)] : -1.0e30f;
    const float c = g == 0 ? c0 : (g == 1 ? c1 : (g == 2 ? c2 : c3));
    return __uint_as_float((__float_as_uint(c) & 0xffffffc0u) | (unsigned)(16 * g + S));
}

__device__ void ph_peer_select(const bf16* qry, const float* subkeys  , int* eidx, float* egate, LAS unsigned char* lds, int bid, int nb) {
    const int tid = ltid(), lane = tid & 63, w = __builtin_amdgcn_readfirstlane(tid >> 6);
    const int tk = lane & 15, g = lane >> 4;
    __syncthreads();
    for (int e = tid; e < 2 * 128 * 128 / 2; e += NT) {
        const int row = e >> 6, c2 = (e & 63) * 2;
        const float a = subkeys[(size_t)row * 128 + c2], b = subkeys[(size_t)row * 128 + c2 + 1];
        *(LAS unsigned*)(lds + row * SK_ROW + c2 * 2) = pk2(a, b);
    }
    if (tid < 64) { int id = tid; int c = 0, pi = 0, pj = 0;
        for (int i = 0; i < 16; ++i) { const int nj = 16 / (i + 1); if (id >= c && id < c + nj) { pi = i; pj = id - c; } c += nj; }
        lds[SEL_TAB_OFF + tid] = (unsigned char)((pi << 4) | pj); }
    __syncthreads();
    LAS unsigned* widx = (LAS unsigned*)(lds + SEL_IDX_OFF + w * 512);
    const LAS unsigned char* widx8 = (const LAS unsigned char*)widx;
    const int nitems = (MT / 16) * 8;
    bf16x8 qc[2][4];
    { const int it = bid * 8 + w;
      if (it < nitems) { const bf16* qp = qry + (size_t)((it >> 3) * 16 + tk) * PQ + (it & 7) * 256 + 8 * g;
#pragma unroll
          for (int hf = 0; hf < 2; ++hf)
#pragma unroll
              for (int ks = 0; ks < 4; ++ks) qc[hf][ks] = *(const bf16x8*)(qp + hf * 128 + 32 * ks); } }
    for (int it = bid * 8 + w; it < nitems; it += nb * 8) {
        const int h = it & 7, t0 = (it >> 3) * 16;
        bf16x8 qn[2][4];
        { const int itn = it + nb * 8 < nitems ? it + nb * 8 : it;
          const bf16* qp = qry + (size_t)((itn >> 3) * 16 + tk) * PQ + (itn & 7) * 256 + 8 * g;
#pragma unroll
          for (int hf = 0; hf < 2; ++hf)
#pragma unroll
              for (int ks = 0; ks < 4; ++ks) qn[hf][ks] = *(const bf16x8*)(qp + hf * 128 + 32 * ks); }
        float L[2][16];
#pragma unroll
        for (int hf = 0; hf < 2; ++hf) {
            bf16x8 qf[4];
#pragma unroll
            for (int ks = 0; ks < 4; ++ks) qf[ks] = qc[hf][ks];
            float key[32];
#pragma unroll
            for (int tile = 0; tile < 8; ++tile) {
                f32x4 acc = {0.f, 0.f, 0.f, 0.f};
#pragma unroll
                for (int ks = 0; ks < 4; ++ks) {
                    const bf16x8 af = *(const LAS bf16x8*)(lds + (hf * 128 + tile * 16 + tk) * SK_ROW + (32 * ks + 8 * g) * 2);
                    acc = __builtin_amdgcn_mfma_f32_16x16x32_bf16(af, qf[ks], acc, 0, 0, 0);
                }
#pragma unroll
                for (int r = 0; r < 4; ++r) key[tile * 4 + r] = __uint_as_float((__float_as_uint(acc[r]) & 0xffffff80u) | (unsigned)(16 * tile + 4 * g + r));
            }
            float a[16], b[16];
#pragma unroll
            for (int i = 0; i < 16; ++i) { a[i] = key[i]; b[i] = key[16 + i]; }
            bsort16(a); bsort16(b);
            merge_top16(a, b);
            xmerge16(a);
#pragma unroll
            for (int i = 0; i < 16; ++i) L[hf][i] = a[i];
            unsigned pk = 0u;
#pragma unroll
            for (int s = 0; s < 4; ++s) {
                const float v = g == 0 ? a[s] : (g == 1 ? a[4 + s] : (g == 2 ? a[8 + s] : a[12 + s]));
                pk |= (__float_as_uint(v) & 127u) << (8 * s);
            }
            widx[tk * 8 + hf * 4 + g] = pk;
        }
        float c[16];
        c[0] = cand_slot<0>(L[0], L[1], g); c[1] = cand_slot<1>(L[0], L[1], g); c[2] = cand_slot<2>(L[0], L[1], g); c[3] = cand_slot<3>(L[0], L[1], g);
        c[4] = cand_slot<4>(L[0], L[1], g); c[5] = cand_slot<5>(L[0], L[1], g); c[6] = cand_slot<6>(L[0], L[1], g); c[7] = cand_slot<7>(L[0], L[1], g);
        c[8] = cand_slot<8>(L[0], L[1], g); c[9] = cand_slot<9>(L[0], L[1], g); c[10] = cand_slot<10>(L[0], L[1], g); c[11] = cand_slot<11>(L[0], L[1], g);
        c[12] = cand_slot<12>(L[0], L[1], g); c[13] = cand_slot<13>(L[0], L[1], g); c[14] = cand_slot<14>(L[0], L[1], g); c[15] = cand_slot<15>(L[0], L[1], g);
        bsort16(c);
        xmerge16(c);
        float sum = 0.f, ex[16];
#pragma unroll
        for (int i = 0; i < 16; ++i) { ex[i] = __builtin_amdgcn_exp2f((c[i] - c[0]) * L2E); sum += ex[i]; }
        const float inv = 1.0f / sum;
        int oi[4]; float og[4];
#pragma unroll
        for (int s = 0; s < 4; ++s) {
            const float kv = g == 0 ? c[s] : (g == 1 ? c[4 + s] : (g == 2 ? c[8 + s] : c[12 + s]));
            const float ev = g == 0 ? ex[s] : (g == 1 ? ex[4 + s] : (g == 2 ? ex[8 + s] : ex[12 + s]));
            const unsigned pid = __float_as_uint(kv) & 63u;
            const unsigned ij = lds[SEL_TAB_OFF + pid];
            const unsigned i1 = widx8[tk * 32 + (ij >> 4)], i2 = widx8[tk * 32 + 16 + (ij & 15u)];
            oi[s] = (int)(i1 * 128u + i2); og[s] = ev * inv;
        }
        const size_t ob = (size_t)(t0 + tk) * 128 + h * 16 + 4 * g;
        *(u32x4*)(eidx + ob) = (u32x4){(unsigned)oi[0], (unsigned)oi[1], (unsigned)oi[2], (unsigned)oi[3]};
        *(f32x4*)(egate + ob) = (f32x4){og[0], og[1], og[2], og[3]};
#pragma unroll
        for (int hf = 0; hf < 2; ++hf)
#pragma unroll
            for (int ks = 0; ks < 4; ++ks) qc[hf][ks] = qn[hf][ks];
    }
    __syncthreads();
}

typedef float v32f_t __attribute__((ext_vector_type(32)));
typedef unsigned v6u_t __attribute__((ext_vector_type(6)));
typedef unsigned v16u_t __attribute__((ext_vector_type(16)));
typedef __bf16 v32bf_t __attribute__((ext_vector_type(32)));
typedef __bf16 v2bf_t __attribute__((ext_vector_type(2)));
typedef _Float16 v32h_t __attribute__((ext_vector_type(32)));
typedef unsigned u32x3 __attribute__((ext_vector_type(3)));
constexpr int TROW = 768;
__device__ void ph_tab_fp6(const float* src, unsigned char* dst, float* scale, int nrows, int bid, int nb) {
    const int lane = ltid() & 63, w = __builtin_amdgcn_readfirstlane(ltid() >> 6);
    for (int rp = bid * 8 + w; rp < nrows / 2; rp += nb * 8) {
        v32h_t hv; float sc[2];
#pragma unroll
        for (int rr = 0; rr < 2; ++rr) {
            const float* sp = src + (size_t)(2 * rp + rr) * DM + lane * 16;
            f32x4 v[4]; float am = 0.f;
#pragma unroll
            for (int i = 0; i < 4; ++i) { v[i] = *(const f32x4*)(sp + i * 4); am = fmaxf(am, fmaxf(fmaxf(fabsf(v[i][0]), fabsf(v[i][1])), fmaxf(fabsf(v[i][2]), fabsf(v[i][3])))); }
            am = wave_max(am);
            const float s = am > 0.f ? am * (1.0f / 7.5f) : 1.0f, inv = 1.0f / s;
            sc[rr] = s;
#pragma unroll
            for (int i = 0; i < 4; ++i)
#pragma unroll
                for (int e = 0; e < 4; ++e) hv[rr * 16 + i * 4 + e] = (_Float16)fminf(fmaxf(v[i][e] * inv, -7.5f), 7.5f);
        }
        const v6u_t pk = __builtin_amdgcn_cvt_scalef32_pk32_fp6_f16(hv, 1.0f);
        unsigned* d0 = (unsigned*)(dst + (size_t)(2 * rp) * TROW + lane * 12);
        unsigned* d1 = (unsigned*)(dst + (size_t)(2 * rp + 1) * TROW + lane * 12);
        d0[0] = pk[0]; d0[1] = pk[1]; d0[2] = pk[2]; d1[0] = pk[3]; d1[1] = pk[4]; d1[2] = pk[5];
        if (lane == 0) { scale[2 * rp] = sc[0]; scale[2 * rp + 1] = sc[1]; }
    }
}

constexpr int TROW4 = 512;
__device__ void ph_tab_fp4(const float* src, unsigned char* dst, float* scale, int nrows, int bid, int nb) {
    const int lane = ltid() & 63, w = __builtin_amdgcn_readfirstlane(ltid() >> 6);
    for (int row = bid * 8 + w; row < nrows; row += nb * 8) {
        const float* sp = src + (size_t)row * DM + lane * 16;
        f32x4 v[4]; float am = 0.f;
#pragma unroll
        for (int i = 0; i < 4; ++i) { v[i] = *(const f32x4*)(sp + i * 4); am = fmaxf(am, fmaxf(fmaxf(fabsf(v[i][0]), fabsf(v[i][1])), fmaxf(fabsf(v[i][2]), fabsf(v[i][3])))); }
        am = wave_max(am);
        const float s = am > 0.f ? am * (1.0f / 6.0f) : 1.0f, inv = 1.0f / s;
        unsigned d0 = 0u, d1 = 0u;
        d0 = __builtin_amdgcn_cvt_scalef32_pk_fp4_f32(d0, v[0][0] * inv, v[0][1] * inv, 1.0f, 0); d0 = __builtin_amdgcn_cvt_scalef32_pk_fp4_f32(d0, v[0][2] * inv, v[0][3] * inv, 1.0f, 1);
        d0 = __builtin_amdgcn_cvt_scalef32_pk_fp4_f32(d0, v[1][0] * inv, v[1][1] * inv, 1.0f, 2); d0 = __builtin_amdgcn_cvt_scalef32_pk_fp4_f32(d0, v[1][2] * inv, v[1][3] * inv, 1.0f, 3);
        d1 = __builtin_amdgcn_cvt_scalef32_pk_fp4_f32(d1, v[2][0] * inv, v[2][1] * inv, 1.0f, 0); d1 = __builtin_amdgcn_cvt_scalef32_pk_fp4_f32(d1, v[2][2] * inv, v[2][3] * inv, 1.0f, 1);
        d1 = __builtin_amdgcn_cvt_scalef32_pk_fp4_f32(d1, v[3][0] * inv, v[3][1] * inv, 1.0f, 2); d1 = __builtin_amdgcn_cvt_scalef32_pk_fp4_f32(d1, v[3][2] * inv, v[3][3] * inv, 1.0f, 3);
        *(u32x2*)(dst + (size_t)row * TROW4 + lane * 8) = (u32x2){d0, d1};
        if (lane == 0) scale[row] = s;
    }
}

__device__ void ph_tab_i4(const float* src, unsigned char* dst, float* scale, int nrows, int bid, int nb) {
    const int lane = ltid() & 63, w = __builtin_amdgcn_readfirstlane(ltid() >> 6);
    for (int row = bid * 8 + w; row < nrows; row += nb * 8) {
        const float* sp = src + (size_t)row * DM + lane * 16;
        f32x4 v[4]; float am = 0.f;
#pragma unroll
        for (int i = 0; i < 4; ++i) { v[i] = *(const f32x4*)(sp + i * 4); am = fmaxf(am, fmaxf(fmaxf(fabsf(v[i][0]), fabsf(v[i][1])), fmaxf(fabsf(v[i][2]), fabsf(v[i][3])))); }
        am = wave_max(am);
        const float s = am > 0.f ? am * (1.0f / 7.0f) : 1.0f, inv = 1.0f / s;
        unsigned d[2] = {0u, 0u};
#pragma unroll
        for (int i = 0; i < 16; ++i) { const int q = (int)rintf(fminf(fmaxf(v[i >> 2][i & 3] * inv, -7.0f), 7.0f)); d[i >> 3] |= ((unsigned)q & 15u) << (4 * (i & 7)); }
        *(u32x2*)(dst + (size_t)row * TROW4 + lane * 8) = (u32x2){d[0], d[1]};
        if (lane == 0) scale[row] = s;
    }
}

#define DPP_ADD(v, ctrl) ((v) + __builtin_bit_cast(float, __builtin_amdgcn_update_dpp(0, __builtin_bit_cast(int, (v)), (ctrl), 0xf, 0xf, true)))
typedef int i32x4_t __attribute__((ext_vector_type(4)));
constexpr int GT = 2;
typedef int v8i_t __attribute__((ext_vector_type(8)));
typedef int v2i_t __attribute__((ext_vector_type(2)));
struct GSet { u32x2 uq[4]; u32x2 vq[4]; };
__device__ __forceinline__ void gather_issue(GSet& S, int bt, int lane, const unsigned char* pu, const unsigned char* pv, const LAS int* etok) {
    const i32x4_t ev = *(const LAS i32x4_t*)(etok + bt * 4);
    const int es[4] = {ev.x, ev.y, ev.z, ev.w};
#pragma unroll
    for (int k = 0; k < 2; ++k) {
        const unsigned f0 = (unsigned)es[2 * k] * (unsigned)TROW4 + (unsigned)lane * 8u, f1 = (unsigned)es[2 * k + 1] * (unsigned)TROW4 + (unsigned)lane * 8u;
        S.uq[2 * k] = *(const u32x2*)(pu + f0); S.uq[2 * k + 1] = *(const u32x2*)(pu + f1);
        S.vq[2 * k] = *(const u32x2*)(pv + f0); S.vq[2 * k + 1] = *(const u32x2*)(pv + f1);
    }
}
constexpr int GV_ROW = 520;
constexpr int GV_BYTES = 16 * GV_ROW, GC_BYTES = 96;
__device__ __forceinline__ float gather_udot(const GSet& S, const unsigned (&hd)[4], LAS unsigned char* vrow) {
    int d[4];
#pragma unroll
    for (int k = 0; k < 4; ++k) {
        const int q0 = (int)S.uq[k].x, q1 = (int)S.uq[k].y;
        int a1, a2;
        asm("v_dot8_i32_i4 %0, %1, %2, 0" : "=v"(a1) : "v"(q0), "v"(hd[0]));
        asm("v_dot8_i32_i4 %0, %1, %2, 0" : "=v"(a2) : "v"(q0), "v"(hd[2]));
        a1 = __builtin_amdgcn_sdot8(q1, (int)hd[1], a1, false); a2 = __builtin_amdgcn_sdot8(q1, (int)hd[3], a2, false);
        d[k] = (a1 << 4) + a2;
    }
#pragma unroll
    for (int k = 0; k < 4; ++k) *(LAS u32x2*)(vrow + k * GV_ROW) = S.vq[k];
    int e2[2], f1;
#pragma unroll
    for (int k = 0; k < 2; ++k) { auto r = __builtin_amdgcn_permlane16_swap((unsigned)d[k], (unsigned)d[k + 2], false, false); e2[k] = (int)r[0] + (int)r[1]; }
    { auto r = __builtin_amdgcn_permlane32_swap((unsigned)e2[0], (unsigned)e2[1], false, false); f1 = (int)r[0] + (int)r[1]; }
    f1 += __builtin_amdgcn_update_dpp(0, f1, 0xB1, 0xf, 0xf, true); f1 += __builtin_amdgcn_update_dpp(0, f1, 0x4E, 0xf, 0xf, true);
    f1 += __builtin_amdgcn_update_dpp(0, f1, 0x124, 0xf, 0xf, true); f1 += __builtin_amdgcn_update_dpp(0, f1, 0x128, 0xf, 0xf, true);
    return (float)f1;
}
#define DPP_MAX(v, ctrl) fmaxf((v), __builtin_bit_cast(float, __builtin_amdgcn_update_dpp(0, __builtin_bit_cast(int, (v)), (ctrl), 0xf, 0xf, true)))
__device__ __forceinline__ void gather_vpart(float f0, float f1, float f2, float f3, int lane, int kslot, const LAS float* lg  ,
                                             const LAS unsigned char* vrd  , LAS unsigned char* cb, int aoff1, int aoff2, f32x4 (&acc)[8]) {
    const int q = (lane >> 2) & 3, e16 = 4 * q + kslot;
    const float fs = q == 0 ? f0 : q == 1 ? f1 : q == 2 ? f2 : f3;
    const float cv = lg[e16] * gelu_erf(fs * lg[GT * 128 + e16]);
    float mx = fabsf(cv);
    mx = DPP_MAX(mx, 0x124); mx = DPP_MAX(mx, 0x128);
    { auto r = __builtin_amdgcn_permlane16_swap(__float_as_uint(mx), __float_as_uint(mx), false, false); mx = fmaxf(__uint_as_float(r[0]), __uint_as_float(r[1])); }
    { auto r = __builtin_amdgcn_permlane32_swap(__float_as_uint(mx), __float_as_uint(mx), false, false); mx = fmaxf(__uint_as_float(r[0]), __uint_as_float(r[1])); }
    int E = (int)((__float_as_uint(mx) >> 23) & 0xffu); E = E < 8 ? 8 : E;
    const float x = cv * __uint_as_float((unsigned)(255 - E) << 23);
    const unsigned p1 = __builtin_amdgcn_cvt_scalef32_pk_fp4_f32(0u, x, 0.f, 1.0f, 0);
    const float r1 = x - __builtin_amdgcn_cvt_scalef32_pk_f32_fp4(p1, 1.0f, 0)[0];
    const unsigned p2 = __builtin_amdgcn_cvt_scalef32_pk_fp4_f32(0u, r1, 0.f, 1.0f, 0);
    const float y = (r1 - __builtin_amdgcn_cvt_scalef32_pk_f32_fp4(p2, 1.0f, 0)[0]) * 16.0f;
    const unsigned p3 = __builtin_amdgcn_cvt_scalef32_pk_fp4_f32(0u, y, 0.f, 1.0f, 0);
    const float r3 = y - __builtin_amdgcn_cvt_scalef32_pk_f32_fp4(p3, 1.0f, 0)[0];
    const unsigned p4 = __builtin_amdgcn_cvt_scalef32_pk_fp4_f32(0u, r3, 0.f, 1.0f, 0);
    const unsigned codes = (p1 & 15u) | ((p2 & 15u) << 8) | ((p3 & 15u) << 16) | ((p4 & 15u) << 24);
    { auto r = __builtin_amdgcn_permlane32_swap(codes, codes, false, false);
      const unsigned w = codes | ((r[0] ^ r[1] ^ codes) << 4);
      if (lane < 32 && (lane & 3) == 0) {
          LAS unsigned char* tb = cb + 8 + 2 * q + ((lane >> 4) & 1);
          tb[0] = (unsigned char)w; tb[16] = (unsigned char)(w >> 8); tb[32] = (unsigned char)(w >> 16); tb[48] = (unsigned char)(w >> 24);
      } }
    const u32x2 a10 = *(const LAS u32x2*)(cb + aoff1), a11 = *(const LAS u32x2*)(cb + aoff1 + 8), a20 = *(const LAS u32x2*)(cb + aoff2), a21 = *(const LAS u32x2*)(cb + aoff2 + 8);
    const v8i_t A1 = {(int)a10.x, (int)a10.y, (int)a11.x, (int)a11.y, 0, 0, 0, 0}, A2 = {(int)a20.x, (int)a20.y, (int)a21.x, (int)a21.y, 0, 0, 0, 0};
    const int sa1 = (E - 1) * 0x01010101, sa2 = (E - 5) * 0x01010101;
#pragma unroll
    for (int m = 0; m < 8; ++m) {
        const v2i_t t0 = __builtin_amdgcn_ds_read_tr4_b64_v2i32((LAS v2i_t*)(vrd + 16 * m)), t1 = __builtin_amdgcn_ds_read_tr4_b64_v2i32((LAS v2i_t*)(vrd + 16 * m + 8));
        const v8i_t B = {t0.x, t0.y, t1.x, t1.y, 0, 0, 0, 0};
        acc[m] = __builtin_amdgcn_mfma_scale_f32_16x16x128_f8f6f4(A1, B, acc[m], 4, 4, 0, sa1, 0, 0x7F7F7F7F);
        acc[m] = __builtin_amdgcn_mfma_scale_f32_16x16x128_f8f6f4(A2, B, acc[m], 4, 4, 0, sa2, 0, 0x7F7F7F7F);
    }
}
__device__ __forceinline__ void xcd_pace(unsigned* bar, volatile LAS unsigned* st);
constexpr int GNS = 8, GBPS = 32 / GNS, GSHIFT = 11;
constexpr int GATH_LDS_WAVE = GT * 128 * 12 + GV_BYTES + GC_BYTES;
#define GATH_SEG(J, NJ, nbt) { \
        const LAS int* le_ = lse + (J) * 128; const LAS int* ne_ = lse + (NJ) * 128; \
        gather_issue(D, GBPS * c + 3, lane, pu, pv, le_); \
        const float f0_ = hsc[J] * gather_udot(A, hd[J], vwr); \
        gather_issue(A, (nbt), lane, pu, pv, ne_); \
        const float f1_ = hsc[J] * gather_udot(B, hd[J], vwr + 4 * GV_ROW); \
        gather_issue(B, (nbt) + 1, lane, pu, pv, ne_); \
        const float f2_ = hsc[J] * gather_udot(C, hd[J], vwr + 8 * GV_ROW); \
        gather_issue(C, (nbt) + 2, lane, pu, pv, ne_); \
        const float f3_ = hsc[J] * gather_udot(D, hd[J], vwr + 12 * GV_ROW); \
        gather_vpart(f0_, f1_, f2_, f3_, lane, kslot, lsg + (J) * 128 + 16 * c, vrd, cb, aoff1, aoff2, acc[J]); }
__device__ void ph_peer_gather(const bf16* h2, const unsigned char* pu, const unsigned char* pv, const float* su, const float* sv,
                               const int* eidx, const float* egate, const bf16* xin  , const float* gate  , float* xout, LAS unsigned char* lds, unsigned* pace_bar, volatile LAS unsigned* pace_st, int bid, int nb,
                               bf16* xmid  ) {
    const int lane0 = ltid() & 63, w = __builtin_amdgcn_readfirstlane(ltid() >> 6);
    LAS int* lse = (LAS int*)(lds + w * GATH_LDS_WAVE); LAS float* lsg = (LAS float*)(lds + w * GATH_LDS_WAVE + GT * 128 * 4);
    LAS unsigned char* vb = lds + w * GATH_LDS_WAVE + GT * 128 * 12; LAS unsigned char* cb = vb + GV_BYTES;
    if (lane0 < GC_BYTES / 4) ((LAS unsigned*)cb)[lane0] = 0u;
    for (int t0 = (bid * 8 + w) * GT; t0 < MT; t0 += nb * 8 * GT) {
        int lane = lane0; asm volatile("" : "+v"(lane));
        const int row = lane >> 4;
        const int kslot = 2 * (row & 1) + (row >> 1);
        const int b = t0 >> 11;
        LAS unsigned char* vwr = vb + lane * 8;
        const LAS unsigned char* vrd = vb + (lane & 15) * GV_ROW + 128 * row;
        const int ai = lane & 15, au = (ai < 8 ? 1 : 3), nz = ((ai & 7) >> 1) == row;
        const int aoff1 = nz ? 8 * (au - (ai & 1)) : 64, aoff2 = nz ? 8 * (au + 4 - (ai & 1)) : 64;
        unsigned hd[GT][4]; float hsc[GT]; f32x4 acc[GT][8];
#pragma unroll
        for (int j = 0; j < GT; ++j) {
            const int t = t0 + j;
            const int e0 = eidx[(size_t)t * 128 + lane], e1 = eidx[(size_t)t * 128 + 64 + lane];
            const float g0 = egate[(size_t)t * 128 + lane], g1 = egate[(size_t)t * 128 + 64 + lane];
            const int k0 = e0 >> GSHIFT, k1 = e1 >> GSHIFT;
            int off = 0, d0 = 0, d1 = 0;
#pragma unroll
            for (int s = 0; s < GNS; ++s) {
                const unsigned long long m0 = __ballot(k0 == s), m1 = __ballot(k1 == s);
                const int r0 = (int)__builtin_amdgcn_mbcnt_hi((unsigned)(m0 >> 32), __builtin_amdgcn_mbcnt_lo((unsigned)m0, 0u));
                const int r1 = (int)__builtin_amdgcn_mbcnt_hi((unsigned)(m1 >> 32), __builtin_amdgcn_mbcnt_lo((unsigned)m1, 0u));
                const int c0 = __builtin_popcountll(m0);
                if (k0 == s) d0 = off + r0;
                if (k1 == s) d1 = off + c0 + r1;
                off += c0 + __builtin_popcountll(m1);
            }
            lse[j * 128 + d0] = e0; lsg[j * 128 + d0] = g0 * sv[e0]; lse[j * 128 + d1] = e1; lsg[j * 128 + d1] = g1 * sv[e1];
            lsg[GT * 128 + j * 128 + d0] = su[e0]; lsg[GT * 128 + j * 128 + d1] = su[e1];
            const u32x4 u0 = *(const u32x4*)(h2 + (size_t)t * DM + lane * 16), u1 = *(const u32x4*)(h2 + (size_t)t * DM + lane * 16 + 8);
            {
                float hf[16];
#pragma unroll
                for (int i = 0; i < 4; ++i) { hf[2 * i] = __uint_as_float(u0[i] << 16); hf[2 * i + 1] = __uint_as_float(u0[i] & 0xffff0000u); hf[8 + 2 * i] = __uint_as_float(u1[i] << 16); hf[8 + 2 * i + 1] = __uint_as_float(u1[i] & 0xffff0000u); }
                float mh = 0.f;
#pragma unroll
                for (int i = 0; i < 16; ++i) mh = fmaxf(mh, fabsf(hf[i]));
                mh = wave_max(mh);
                int Eh = (int)((__float_as_uint(mh) >> 23) & 0xffu); Eh = Eh < 8 ? 8 : Eh;
                const float up = __uint_as_float((unsigned)(255 - Eh) << 23);
                hsc[j] = __uint_as_float((unsigned)(Eh - 5) << 23);
                unsigned p1[2] = {0u, 0u}, p2[2] = {0u, 0u};
#pragma unroll
                for (int i = 0; i < 16; ++i) {
                    const float x = hf[i] * up, r1 = rintf(x);
                    int q2 = (int)rintf((x - r1) * 16.0f); q2 = q2 > 7 ? 7 : q2;
                    p1[i >> 3] |= ((unsigned)(int)r1 & 15u) << (4 * (i & 7)); p2[i >> 3] |= ((unsigned)q2 & 15u) << (4 * (i & 7));
                }
                hd[j][0] = p1[0]; hd[j][1] = p1[1]; hd[j][2] = p2[0]; hd[j][3] = p2[1];
            }
#pragma unroll
            for (int i = 0; i < 8; ++i) acc[j][i] = (f32x4){0.f, 0.f, 0.f, 0.f};
        }
        GSet A, B, C, D;
        gather_issue(A, 0, lane, pu, pv, lse); gather_issue(B, 1, lane, pu, pv, lse); gather_issue(C, 2, lane, pu, pv, lse);
#pragma unroll 1
        for (int c = 0; c < GNS; ++c) {
            GATH_SEG(0, 1, GBPS * c)
            GATH_SEG(1, 0, c < GNS - 1 ? GBPS * c + GBPS : 0)
        }
#pragma unroll
        for (int j = 0; j < GT; ++j) {
            const int t = t0 + j;
            LAS float* ob = (LAS float*)vb;
            const int nbase = 512 * (row & 1) + 32 * (row >> 1) + (lane & 15);
#pragma unroll
            for (int pm = 0; pm < 4; ++pm)
#pragma unroll
                for (int r = 0; r < 4; ++r) {
                    auto sw = __builtin_amdgcn_permlane32_swap(__float_as_uint(acc[j][2 * pm][r]), __float_as_uint(acc[j][2 * pm + 1][r]), false, false);
                    ob[nbase + 256 * (r >> 1) + 64 * pm + 16 * (r & 1)] = __uint_as_float(sw[0]) + __uint_as_float(sw[1]);
                }
#pragma unroll
            for (int i = 0; i < 4; ++i) {
                const int cc = i * 256 + lane * 4;
                const f32x4 a = *(const LAS f32x4*)(ob + cc);
                const u32x2 xq = *(const u32x2*)(xin + (size_t)t * DM + cc); const f32x4 gt = *(const f32x4*)(gate + (size_t)b * 6144 + cc);
                const f32x4 xi = {__uint_as_float(xq.x << 16), __uint_as_float(xq.x & 0xffff0000u), __uint_as_float(xq.y << 16), __uint_as_float(xq.y & 0xffff0000u)};
                f32x4 o;
#pragma unroll
                for (int e = 0; e < 4; ++e) o[e] = xi[e] + gt[e] * a[e];
                if (xmid) { u32x2 pk; pk.x = pk2(o[0], o[1]); pk.y = pk2(o[2], o[3]); *(u32x2*)(xmid + (size_t)t * DM + cc) = pk; }
                else __builtin_nontemporal_store(o, (f32x4*)(xout + (size_t)t * DM + cc));
            }
        }
    }
}

#define XB_TMO      128
#define XB_XCNT(j)  (256  + 64 * (j))
#define XB_XSUB(j)  (1280 + 64 * (j))
#define XB_XGEN(j)  (2304 + 64 * (j))
#define XB_TOP      3328
#define XB_TOPGEN   3392
#define XCD_BAR_WORDS 3456
#define XB_SPIN_CAP (1u << 18)

__device__ __forceinline__ unsigned xb_ld(unsigned* p)              { return __hip_atomic_load(p, __ATOMIC_RELAXED, __HIP_MEMORY_SCOPE_AGENT); }
__device__ __forceinline__ unsigned xb_add(unsigned* p, unsigned v) { return __hip_atomic_fetch_add(p, v, __ATOMIC_RELAXED, __HIP_MEMORY_SCOPE_AGENT); }
__device__ __forceinline__ unsigned xb_xcc_id() { return (unsigned)__builtin_amdgcn_s_getreg((3 << 11) | 20) & 0xFu; }
#define XB_SPIN(cond, bar) do { unsigned _sp = 0; while (cond) { __builtin_amdgcn_s_sleep(1); \
    if ((++_sp & 255u) == 0u) { if (xb_ld(&(bar)[XB_TMO])) break; if (_sp > XB_SPIN_CAP) { atomicAdd(&(bar)[XB_TMO], 1u); break; } } } } while (0)

struct XcdBarrier {
    unsigned* bar; unsigned x;
    volatile LAS unsigned* st;
};

__device__ __forceinline__ XcdBarrier xcd_barrier_post(unsigned* bar, volatile LAS unsigned* st) {
    XcdBarrier b; b.bar = bar; b.x = xb_xcc_id(); b.st = st;
    if (threadIdx.x == 0) (void)xb_add(&bar[XB_XCNT(b.x)], 1u);
    return b;
}
__device__ __forceinline__ void xcd_barrier_complete(unsigned* bar, unsigned x, unsigned& nloc, unsigned& nx) {
    const unsigned G = gridDim.x * gridDim.y * gridDim.z;
    unsigned sum, cnt, mine, sp = 0u;
    for (;;) {
        sum = 0u; cnt = 0u; mine = 0u;
#pragma unroll
        for (unsigned j = 0; j < 16; ++j) { const unsigned c = xb_ld(&bar[XB_XCNT(j)]); sum += c; cnt += (c > 0u) ? 1u : 0u; mine = (j == x) ? c : mine; }
        if (sum == G) break;
        __builtin_amdgcn_s_sleep(1);
        if ((++sp & 255u) == 0u) { if (xb_ld(&bar[XB_TMO])) break; if (sp > XB_SPIN_CAP) { atomicAdd(&bar[XB_TMO], 1u); break; } }
    }
    nloc = mine > 0u ? mine : 1u; nx = cnt > 0u ? cnt : 1u;
}

__device__ __forceinline__ void xcd_barrier(const XcdBarrier& b) {
    asm volatile("s_waitcnt vmcnt(0)" ::: "memory");
    __syncthreads();
    if (threadIdx.x == 0) {
        unsigned* bar = b.bar;
        __builtin_amdgcn_s_waitcnt(0);
        unsigned nloc = b.st[0], nx = b.st[1];
        if (nloc == 0u) { xcd_barrier_complete(bar, b.x, nloc, nx); b.st[0] = nloc; b.st[1] = nx; }
        const unsigned old = xb_add(&bar[XB_XSUB(b.x)], 1u);
        const unsigned gen = old / nloc;
        if (old + 1u == (gen + 1u) * nloc) {
            __builtin_amdgcn_fence(__ATOMIC_RELEASE, "agent");
            asm volatile("s_waitcnt vmcnt(0)" ::: "memory");
            const unsigned og = xb_add(&bar[XB_TOP], 1u);
            const unsigned tg = og / nx;
            if (og + 1u == (tg + 1u) * nx) xb_add(&bar[XB_TOPGEN], 1u);
            else XB_SPIN(xb_ld(&bar[XB_TOPGEN]) == tg, bar);
            __builtin_amdgcn_fence(__ATOMIC_ACQUIRE, "agent");
            xb_add(&bar[XB_XGEN(b.x)], 1u);
            asm volatile("s_waitcnt vmcnt(0)" ::: "memory");
        } else {
            XB_SPIN(xb_ld(&bar[XB_XGEN(b.x)]) == gen, bar);
            __builtin_amdgcn_fence(__ATOMIC_ACQUIRE, "agent");
            asm volatile("s_waitcnt vmcnt(0)" ::: "memory");
        }
    }
    __syncthreads();
}


#define XB_PACE(j) (3584 + 64 * (j))
__device__ __forceinline__ void xcd_pace(unsigned* bar, volatile LAS unsigned* st) {
    __syncthreads();
    if (threadIdx.x == 0) {
        const unsigned nloc = st[0] ? st[0] : 1u, x = xb_xcc_id(), gen = st[4] + 1u;
        st[4] = gen;
        xb_add(&bar[XB_PACE(x)], 1u);
        unsigned sp = 0;
        while (xb_ld(&bar[XB_PACE(x)]) < gen * nloc) { __builtin_amdgcn_s_sleep(1); if (++sp > (1u << 16)) break; }
    }
    __syncthreads();
}
extern __shared__ __attribute__((aligned(16))) unsigned char dyn_lds[];
#ifndef REP_PREP
#define REP_PREP 1
#endif
#ifndef REP_ATTN
#define REP_ATTN 1
#endif
#ifndef REP_SEL
#define REP_SEL 1
#endif
#ifndef REP_GATH
#define REP_GATH 1
#endif
#ifndef REP_GEMM
#define REP_GEMM 1
#endif
#ifndef REP_ADALN
#define REP_ADALN 1
#endif
constexpr int LDS_BYTES = 147456;

template <class T> __device__ __forceinline__ T* karg(int byte_off) {
    const __attribute__((address_space(4))) char* base = (const __attribute__((address_space(4))) char*)__builtin_amdgcn_kernarg_segment_ptr();
    unsigned long long v = *(const __attribute__((address_space(4))) unsigned long long*)(base + byte_off);
    asm volatile("" : "+s"(v));
    return (T*)(__attribute__((address_space(1))) T*)v;
}
#define KIN(i) karg<const float>(8 * (i))
#define KOUT() karg<float>(168)
#define KWS() karg<unsigned char>(176)
static_assert(sizeof(Params) == 184, "Params layout");
template <class T> __device__ __forceinline__ T* launder(T* p) { size_t off = 0; asm volatile("" : "+s"(off)); return (T*)((unsigned char*)p + off); }
__global__ void __launch_bounds__(NT) mega_fwd(Params p) {
    cg::grid_group grid = cg::this_grid();
    const int bid = blockIdx.x, nb = gridDim.x;
    volatile LAS unsigned* bst = (volatile LAS unsigned*)((LAS unsigned char*)dyn_lds + LDS_BYTES - 64);
    if (ltid() < 16) bst[ltid()] = 0u;
    __syncthreads();
    const XcdBarrier xbar = xcd_barrier_post((unsigned*)(KWS() + WS_BAR), bst);
    for (int rep = 0; rep < REP_PREP; ++rep) {
        unsigned char* ws = KWS();
        float* tile = (float*)dyn_lds;
        ph_transpose(KIN(6), (bf16*)(ws + WS_WIN0), 1024, AB_IN, true, tile, bid, nb);
        ph_transpose(KIN(11), (bf16*)(ws + WS_WIN1), 1024, CD_IN, true, tile, bid, nb);
        ph_transpose(KIN(7), (bf16*)(ws + WS_WO0), 1024, 1024, false, tile, bid, nb);
        ph_transpose(KIN(12), (bf16*)(ws + WS_WO1), 1024, 1024, false, tile, bid, nb);
        ph_transpose(KIN(17), (bf16*)(ws + WS_WQ), 1024, PQ, false, tile, bid, nb);
        ph_transpose(KIN(17) + (size_t)1024 * PQ, (bf16*)(ws + WS_WQ) + (size_t)PQ * 1024, 1024, PQ, false, tile, bid, nb);
        ws = launder(ws);
        ph_tab_i4(KIN(19), ws + WS_PU, (float*)(ws + WS_PV), 2 * NEXP, bid, nb);
        ph_tab_fp4(KIN(20), ws + WS_PU + 32 * MiB, (float*)(ws + WS_PV + 1 * MiB), 2 * NEXP, bid, nb);
        ws = launder(ws);
        ph_mod(KIN(1), KIN(2), KIN(3), (float*)(ws + WS_MOD), (float*)dyn_lds, bid, nb);
        ph_rope_table((float*)(ws + WS_ROPE), bid, nb);
        for (int i = bid * NT + ltid(); i < NB * 8 * 8 * 64; i += nb * NT) ((float*)(ws + WS_KMEAN))[i] = 0.f;
    }
    grid.sync();
#pragma unroll 1
    for (int layer = 0; layer < 2; ++layer) {
        for (int rep = 0; rep < REP_ADALN; ++rep) {
            unsigned char* ws = KWS(); const float* mod = (const float*)(ws + WS_MOD) + (size_t)layer * 32 * 6144;
            if (layer == 0) ph_adaln<false>(KIN(0), KIN(4), mod + 0, mod + 1024, (bf16*)(ws + WS_HY), bid, nb);
            else ph_adaln<true>(ws + WS_X1 + 128 * MiB, KIN(4) + DM, mod + 0, mod + 1024, (bf16*)(ws + WS_HY), bid, nb);
        }
        xcd_barrier(xbar);
        for (int rep = 0; rep < REP_GEMM; ++rep) {
            unsigned char* ws = KWS();
            pg8::Gemm g{(const bf16*)(ws + WS_HY), (const bf16*)(ws + (layer == 0 ? WS_WIN0 : WS_WIN1)), MT, layer == 0 ? AB_IN : CD_IN, DM};
            pg8::StaticOrder S; S.init(g.M, g.N, nb, bid);
            pg8::EpiQKV e{(bf16*)(ws + WS_QKV), QKV_LD, (const float*)(ws + WS_ROPE), layer, layer == 0 ? KIN(9) : KIN(13), layer == 0 ? KIN(10) : KIN(14), KIN(15), KIN(16), (float*)(ws + WS_KMEAN)};
            pg8::gemm_phase<pg8::EpiQKV, pg8::StaticOrder, true, true>((LAS unsigned char*)dyn_lds, g, S, e);
        }
        xcd_barrier(xbar);
        for (int rep = 0; rep < REP_ATTN; ++rep) {
            unsigned char* ws = KWS();
            if (layer == 0) ph_attn0((const bf16*)(ws + WS_QKV), KIN(8), (bf16*)(ws + WS_HY), (LAS unsigned char*)dyn_lds, bid, nb);
            else ph_attn1((const bf16*)(ws + WS_QKV), (const float*)(ws + WS_KMEAN), (bf16*)(ws + WS_HY), (LAS unsigned char*)dyn_lds, bid, nb);
        }
        xcd_barrier(xbar);
        for (int rep = 0; rep < REP_GEMM; ++rep) {
            unsigned char* ws = KWS(); const float* mod = (const float*)(ws + WS_MOD) + (size_t)layer * 32 * 6144;
            pg8::Gemm g{(const bf16*)(ws + WS_HY), (const bf16*)(ws + (layer == 0 ? WS_WO0 : WS_WO1)), MT, DM, DM};
            pg8::StaticOrder S; S.init(g.M, g.N, nb, bid);
            if (layer == 0) { pg8::EpiResid<false> e{KIN(0), (pg8::bf16_t*)(ws + WS_X1), mod + 2048}; pg8::gemm_phase<pg8::EpiResid<false>, pg8::StaticOrder, true, true>((LAS unsigned char*)dyn_lds, g, S, e); }
            else { pg8::EpiResid<true> e{ws + WS_X1 + 128 * MiB, (pg8::bf16_t*)(ws + WS_X1), mod + 2048}; pg8::gemm_phase<pg8::EpiResid<true>, pg8::StaticOrder, true, true>((LAS unsigned char*)dyn_lds, g, S, e); }
        }
        xcd_barrier(xbar);
        for (int rep = 0; rep < REP_ADALN; ++rep) {
            unsigned char* ws = KWS(); const float* mod = (const float*)(ws + WS_MOD) + (size_t)layer * 32 * 6144;
            ph_adaln<true>(ws + WS_X1, KIN(5) + layer * DM, mod + 3072, mod + 4096, (bf16*)(ws + WS_QKV), bid, nb);
        }
        xcd_barrier(xbar);
        for (int rep = 0; rep < REP_GEMM; ++rep) {
            unsigned char* ws = KWS();
            pg8::Gemm g{(const bf16*)(ws + WS_QKV), (const bf16*)(ws + WS_WQ) + (size_t)layer * PQ * DM, MT, PQ, DM};
            pg8::StaticOrder S; S.init(g.M, g.N, nb, bid); pg8::EpiStore e{(bf16*)(ws + WS_QKV + 128 * MiB), PQ};
            pg8::gemm_phase<pg8::EpiStore, pg8::StaticOrder, true, true>((LAS unsigned char*)dyn_lds, g, S, e);
        }
        xcd_barrier(xbar);
        for (int rep = 0; rep < REP_SEL; ++rep) {
            unsigned char* ws = KWS();
            ph_peer_select((const bf16*)(ws + WS_QKV + 128 * MiB), KIN(18) + (size_t)layer * 2 * 128 * 128, (int*)(ws + WS_HY), (float*)(ws + WS_HY + 32 * MiB), (LAS unsigned char*)dyn_lds, bid, nb);
        }
        xcd_barrier(xbar);
        for (int rep = 0; rep < REP_GATH; ++rep) {
            unsigned char* ws = KWS(); const float* mod = (const float*)(ws + WS_MOD) + (size_t)layer * 32 * 6144;
            ph_peer_gather((const bf16*)(ws + WS_QKV), ws + WS_PU + (size_t)layer * NEXP * TROW4, ws + WS_PU + 32 * MiB + (size_t)layer * NEXP * TROW4,
                           (const float*)(ws + WS_PV) + layer * NEXP, (const float*)(ws + WS_PV + 1 * MiB) + layer * NEXP, (const int*)(ws + WS_HY), (const float*)(ws + WS_HY + 32 * MiB), (const bf16*)(ws + WS_X1), mod + 5120, KOUT(), (LAS unsigned char*)dyn_lds, (unsigned*)(ws + WS_BAR), bst, bid, nb, layer == 0 ? (bf16*)(ws + WS_X1 + 128 * MiB) : (bf16*)nullptr);
        }
        if (layer == 0) xcd_barrier(xbar);
    }
}

extern "C" void kernel_launch(void* const* d_in, const int* in_sizes, int n_in, void* d_out, int out_size, void* d_ws, size_t ws_size, hipStream_t stream) {
    if (n_in != 21 || ws_size < WS_END) { fprintf(stderr, "kernel_launch: bad args n_in=%d ws=%zu\n", n_in, ws_size); return; }
    static int grid_blocks = 0;
    if (!grid_blocks) {
        int dev = 0, cus = 0, per_cu = 0;
        (void)hipGetDevice(&dev);
        (void)hipDeviceGetAttribute(&cus, hipDeviceAttributeMultiprocessorCount, dev);
        (void)hipFuncSetAttribute((const void*)mega_fwd, hipFuncAttributeMaxDynamicSharedMemorySize, LDS_BYTES);
        (void)hipOccupancyMaxActiveBlocksPerMultiprocessor(&per_cu, (const void*)mega_fwd, NT, LDS_BYTES);
        if (per_cu < 1) { fprintf(stderr, "kernel_launch: occupancy query returned %d\n", per_cu); per_cu = 1; }
        if (per_cu > 1) per_cu = 1;
        grid_blocks = cus * per_cu;
    }
    Params p{};
    for (int i = 0; i < 21; ++i) p.in[i] = (const float*)d_in[i];
    p.out = (float*)d_out; p.ws = (unsigned char*)d_ws;
    (void)hipMemsetAsync((char*)d_ws + WS_BAR, 0, 16384, stream);
    void* args[] = {&p};
    hipError_t e = hipLaunchCooperativeKernel((const void*)mega_fwd, dim3(grid_blocks), dim3(NT), args, LDS_BYTES, stream);
    if (e != hipSuccess) fprintf(stderr, "cooperative launch failed: %s (grid %d)\n", hipGetErrorString(e), grid_blocks);
}
```

```cpp
#include <hip/hip_runtime.h>
#ifndef REP_A
#define REP_A 1
#endif
#ifndef REP_B
#define REP_B 1
#endif
#ifndef REP_C
#define REP_C 1
#endif
#ifndef REP_D
#define REP_D 1
#endif
#include <hip/hip_cooperative_groups.h>
namespace cg = cooperative_groups;
#include <cstdio>
#include <cstdint>
#include <cmath>

typedef unsigned short bf16;
typedef short bf16x8 __attribute__((ext_vector_type(8)));
typedef float f32x4 __attribute__((ext_vector_type(4)));
typedef unsigned u32x4 __attribute__((ext_vector_type(4)));
typedef unsigned u32x2 __attribute__((ext_vector_type(2)));

constexpr int DM = 1024, NB = 32, SQ = 2048, MT = NB * SQ;
constexpr int HD = 64;
constexpr int AB_IN = 2304, CD_IN = 3072, QKV_LD = 3072;
constexpr int NEXP = 16384, PQ = 2048;
constexpr float EPS = 1e-6f;
constexpr int NT = 512;

constexpr size_t MiB = 1u << 20;
constexpr size_t WS_X1 = 0;
constexpr size_t WS_QKV = 256 * MiB;
constexpr size_t WS_HY = 640 * MiB;
constexpr size_t WS_PU = 768 * MiB;
constexpr size_t WS_PV = 832 * MiB;
constexpr size_t WS_WIN0 = 896 * MiB;
constexpr size_t WS_WIN1 = 901 * MiB;
constexpr size_t WS_WO0 = 907 * MiB;
constexpr size_t WS_WO1 = 909 * MiB;
constexpr size_t WS_WQ = 911 * MiB;
constexpr size_t WS_MOD = 919 * MiB;
constexpr size_t WS_ROPE = 921 * MiB;
constexpr size_t WS_KMEAN = 922 * MiB;
constexpr size_t WS_BAR = 923 * MiB;
constexpr size_t WS_END = 924 * MiB;

struct Params {
    const float* in[21];
    float* out;
    unsigned char* ws;
};

__device__ __forceinline__ int ltid() { int t = (int)__builtin_amdgcn_workitem_id_x(); asm volatile("" : "+v"(t)); return t; }
__device__ __forceinline__ float bf2f(unsigned b) { return __uint_as_float(b << 16); }
__device__ __forceinline__ unsigned f2bf(float f) { unsigned u = __float_as_uint(f); return (u + 0x7fffu + ((u >> 16) & 1u)) >> 16; }
__device__ __forceinline__ unsigned pk2(float lo, float hi) { return f2bf(lo) | (f2bf(hi) << 16); }
#define DPPV(v, ctrl) __builtin_bit_cast(float, __builtin_amdgcn_update_dpp(0, __builtin_bit_cast(int, (v)), (ctrl), 0xf, 0xf, true))
__device__ __forceinline__ float row16_sum(float v) { v += DPPV(v, 0xB1); v += DPPV(v, 0x4E); v += DPPV(v, 0x124); v += DPPV(v, 0x128); return v; }
__device__ __forceinline__ float rows_sum(float v) {
    { auto r = __builtin_amdgcn_permlane16_swap(__float_as_uint(v), __float_as_uint(v), false, false); v = __uint_as_float(r[0]) + __uint_as_float(r[1]); }
    { auto r = __builtin_amdgcn_permlane32_swap(__float_as_uint(v), __float_as_uint(v), false, false); v = __uint_as_float(r[0]) + __uint_as_float(r[1]); }
    return v;
}
__device__ __forceinline__ float wave_sum(float v) { return rows_sum(row16_sum(v)); }
__device__ __forceinline__ float wave_max(float v) {
    v = fmaxf(v, DPPV(v, 0xB1)); v = fmaxf(v, DPPV(v, 0x4E)); v = fmaxf(v, DPPV(v, 0x124)); v = fmaxf(v, DPPV(v, 0x128));
    { auto r = __builtin_amdgcn_permlane16_swap(__float_as_uint(v), __float_as_uint(v), false, false); v = fmaxf(__uint_as_float(r[0]), __uint_as_float(r[1])); }
    { auto r = __builtin_amdgcn_permlane32_swap(__float_as_uint(v), __float_as_uint(v), false, false); v = fmaxf(__uint_as_float(r[0]), __uint_as_float(r[1])); }
    return v;
}
__device__ __forceinline__ float gelu_erf(float x) {
    const float z = x * 0.70710678118654752f, az = fabsf(z);
    const float t = __builtin_amdgcn_rcpf(fmaf(0.3275911f, az, 1.0f));
    float pl = fmaf(t, 1.061405429f, -1.453152027f); pl = fmaf(t, pl, 1.421413741f); pl = fmaf(t, pl, -0.284496736f); pl = fmaf(t, pl, 0.254829592f); pl *= t;
    const float ex = __builtin_amdgcn_exp2f(az * (az * -1.4426950408889634f));
    const float er = copysignf(fmaf(-pl, ex, 1.0f), z);
    const float hx = 0.5f * x;
    return fmaf(hx, er, hx);
}

__device__ __forceinline__ int qkv_logical_col(int p) { return (p & ~255) | (((p >> 5) & 3) << 6) | (((p >> 7) & 1) << 5) | (p & 31); }
__device__ void ph_transpose(const float* W, bf16* Wt, int K, int N, bool permute, float* tile  , int bid, int nb) {
    const int tid = ltid();
    const int nkt = K / 64, nnt = N / 64;
    for (int it = bid; it < nkt * nnt; it += nb) {
        const int k0 = (it / nnt) * 64, n0 = (it % nnt) * 64;
        __syncthreads();
        for (int e = tid; e < 64 * 64; e += NT) { const int r = e >> 6, c = e & 63; const int nl = permute ? qkv_logical_col(n0 + c) : n0 + c; tile[r * 65 + c] = W[(size_t)(k0 + r) * N + nl]; }
        __syncthreads();
        {
            const int n = tid >> 3, k8 = (tid & 7) * 8;
            u32x4 v;
            v.x = pk2(tile[(k8 + 0) * 65 + n], tile[(k8 + 1) * 65 + n]);
            v.y = pk2(tile[(k8 + 2) * 65 + n], tile[(k8 + 3) * 65 + n]);
            v.z = pk2(tile[(k8 + 4) * 65 + n], tile[(k8 + 5) * 65 + n]);
            v.w = pk2(tile[(k8 + 6) * 65 + n], tile[(k8 + 7) * 65 + n]);
            *(u32x4*)(Wt + (size_t)(n0 + n) * K + k0 + k8) = v;
        }
    }
}
__device__ void ph_convert(const float* src, bf16* dst, size_t n, int bid, int nb) {
    const size_t n8 = n / 8;
    for (size_t i = (size_t)bid * NT + ltid(); i < n8; i += (size_t)nb * NT) {
        const f32x4 a = *(const f32x4*)(src + i * 8), b = *(const f32x4*)(src + i * 8 + 4);
        u32x4 v; v.x = pk2(a[0], a[1]); v.y = pk2(a[2], a[3]); v.z = pk2(b[0], b[1]); v.w = pk2(b[2], b[3]);
        *(u32x4*)(dst + i * 8) = v;
    }
}
__device__ void ph_mod(const float* c, const float* ada_w, const float* ada_b, float* mod, float* lds  , int bid, int nb) {
    const int tid = ltid(), lane = tid & 63, w = tid >> 6;
    for (int it = bid; it < 2 * 96; it += nb) {
        const int l = it / 96, j = (it % 96) * 64 + lane;
        float acc[32];
#pragma unroll
        for (int b = 0; b < 32; ++b) acc[b] = 0.f;
        for (int kh = 0; kh < 2; ++kh) {
            __syncthreads();
            for (int e = tid; e < 32 * 512; e += NT) { const int b = e >> 9, k = e & 511; const float cv = c[b * 1024 + kh * 512 + k]; lds[e] = cv / (1.0f + __expf(-cv)); }
            __syncthreads();
            for (int kk = 0; kk < 64; ++kk) {
                const int k = w * 64 + kk;
                const float wv = ada_w[((size_t)l * 1024 + kh * 512 + k) * 6144 + j];
#pragma unroll
                for (int b = 0; b < 32; ++b) acc[b] += lds[b * 512 + k] * wv;
            }
        }
        __syncthreads();
#pragma unroll
        for (int b = 0; b < 32; ++b) lds[(w * 32 + b) * 64 + lane] = acc[b];
        __syncthreads();
        for (int e = tid; e < 32 * 64; e += NT) {
            const int b = e >> 6, jj = e & 63; float s = 0.f;
#pragma unroll
            for (int ww = 0; ww < 8; ++ww) s += lds[(ww * 32 + b) * 64 + jj];
            const int jo = (it % 96) * 64 + jj;
            mod[((size_t)l * 32 + b) * 6144 + jo] = s + ada_b[l * 6144 + jo];
        }
    }
}
__device__ void ph_rope_table(float* rope, int bid, int nb) {
    for (int i = bid * NT + ltid(); i < SQ * 32; i += nb * NT) {
        const int t = i >> 5, f = i & 31;
        const float inv = powf(10000.0f, -(float)f / 32.0f);
        const float ang = (float)t * inv;
        float s, c; sincosf(ang, &s, &c);
        rope[i * 2] = c; rope[i * 2 + 1] = s;
    }
}

#define DPP_ADD0(v, ctrl) ((v) + __builtin_bit_cast(float, __builtin_amdgcn_update_dpp(0, __builtin_bit_cast(int, (v)), (ctrl), 0xf, 0xf, true)))
template <bool XBF> __device__ void ph_adaln(const void* xv, const float* g, const float* mod_shift  , const float* mod_scale, bf16* h, int bid, int nb) {
    const int lane = ltid() & 63, w = __builtin_amdgcn_readfirstlane(ltid() >> 6);
    for (int t0 = (bid * 8 + w) * 4; t0 < MT; t0 += nb * 8 * 4) {
        const int b = t0 >> 11;
        f32x4 v[4][4]; float ss[4];
#pragma unroll
        for (int r = 0; r < 4; ++r) {
            if constexpr (XBF) {
                const bf16* xr = (const bf16*)xv + (size_t)(t0 + r) * DM;
#pragma unroll
                for (int i = 0; i < 4; ++i) { const u32x2 q = *(const u32x2*)(xr + i * 256 + lane * 4); v[r][i] = (f32x4){__uint_as_float(q.x << 16), __uint_as_float(q.x & 0xffff0000u), __uint_as_float(q.y << 16), __uint_as_float(q.y & 0xffff0000u)}; }
            } else {
                const float* xr = (const float*)xv + (size_t)(t0 + r) * DM;
#pragma unroll
                for (int i = 0; i < 4; ++i) v[r][i] = *(const f32x4*)(xr + i * 256 + lane * 4);
            }
        }
#pragma unroll
        for (int r = 0; r < 4; ++r) {
            float s = 0.f;
#pragma unroll
            for (int i = 0; i < 4; ++i) s += v[r][i][0] * v[r][i][0] + v[r][i][1] * v[r][i][1] + v[r][i][2] * v[r][i][2] + v[r][i][3] * v[r][i][3];
            s = DPP_ADD0(s, 0xB1); s = DPP_ADD0(s, 0x4E); s = DPP_ADD0(s, 0x124); s = DPP_ADD0(s, 0x128);
            { auto q = __builtin_amdgcn_permlane16_swap(__float_as_uint(s), __float_as_uint(s), false, false); s = __uint_as_float(q[0]) + __uint_as_float(q[1]); }
            { auto q = __builtin_amdgcn_permlane32_swap(__float_as_uint(s), __float_as_uint(s), false, false); s = __uint_as_float(q[0]) + __uint_as_float(q[1]); }
            ss[r] = rsqrtf(s * (1.0f / DM) + EPS);
        }
#pragma unroll
        for (int i = 0; i < 4; ++i) {
            const int c = i * 256 + lane * 4;
            const f32x4 gg = *(const f32x4*)(g + c), sc = *(const f32x4*)(mod_scale + (size_t)b * 6144 + c), sh = *(const f32x4*)(mod_shift + (size_t)b * 6144 + c);
            float a[4];
#pragma unroll
            for (int e = 0; e < 4; ++e) a[e] = gg[e] * (1.0f + sc[e]);
#pragma unroll
            for (int r = 0; r < 4; ++r) {
                float y[4];
#pragma unroll
                for (int e = 0; e < 4; ++e) y[e] = v[r][i][e] * ss[r] * a[e] + sh[e];
                u32x2 o; o.x = pk2(y[0], y[1]); o.y = pk2(y[2], y[3]);
                __builtin_nontemporal_store(o, (u32x2*)(h + (size_t)(t0 + r) * DM + c));
            }
        }
    }
}

namespace pg8 {
#define PG8_LAS __attribute__((address_space(3)))
typedef unsigned short bf16_t;
typedef short bf16x8 __attribute__((ext_vector_type(8)));
constexpr int BM = 256, BK = 64, HALF = 128, HTB = HALF * BK * 2  , STAGE_BYTES = 8 * HTB, NXCD = 8, WGM = 8;

__host__ __device__ __forceinline__ int lds_byte(int r, int c) { const int st = (r >> 4) * 2 + (c >> 5), rr = r & 15, cc = c & 31, ob = rr * 64 + cc * 2; return st * 1024 + (ob ^ (((ob >> 9) & 1) << 5)); }
__host__ __device__ __forceinline__ void stage_rc(int b, int& R, int& C) { const int st = b / 1024, sb = b % 1024, swz = sb ^ (((sb >> 9) & 1) << 5); R = (st >> 1) * 16 + swz / 64; C = (st & 1) * 32 + (swz % 64) / 2; }
__host__ __device__ __forceinline__ int perm32(int rho) { const int n = rho >> 4, i = rho & 15; return 8 * (i >> 2) + 4 * n + (i & 3); }

struct Unit { int pm, pn; };
struct Gemm { const bf16_t* A; const bf16_t* Bt; int M, N, K; };

struct StaticOrder {
    int nM, nN, nwg, G, c;
    __host__ __device__ void init(int M, int N, int G_, int c_) { nM = M / BM; nN = N / BM; nwg = nM * nN; G = G_; c = c_; }
    __host__ __device__ bool next(int i, Unit& u) const {
        const long L = (long)i * G + c; if (L >= nwg) return false;
        int wgid = (int)L; { const int q = nwg / NXCD, r = nwg % NXCD, xcd = wgid % NXCD, off = wgid / NXCD; wgid = (xcd < r ? xcd * (q + 1) : r * (q + 1) + (xcd - r) * q) + off; }
        const int nig = WGM * nN, gid = wgid / nig, fm = gid * WGM, gsz = (nM - fm) < WGM ? (nM - fm) : WGM;
        u.pm = fm + ((wgid % nig) % gsz); u.pn = (wgid % nig) / gsz; return true;
    }
    __device__ __forceinline__ void a_ready(const Unit&) const {}
    __device__ __forceinline__ void done(const Unit&) const {}
};

__device__ __forceinline__ unsigned cvt_pk_bf16(float lo, float hi) { unsigned r; asm volatile("v_cvt_pk_bf16_f32 %0, %1, %2" : "=v"(r) : "v"(lo), "v"(hi)); return r; }

struct EpiStore {
    static constexpr bool PERM = true, AFTER_DRAIN = false;
    bf16_t* O; int ldc;
    __device__ __forceinline__ void operator()(const f32x4 (&acc)[2][2][4][2], const Unit& u, int wr, int wc, int fr_, int fq_) const {
        int fr = fr_, fq = fq_; asm volatile("" : "+v"(fr), "+v"(fq));
        const int row0 = u.pm * BM + wr * 64 + fr, col0 = u.pn * BM + wc * 32 + 8 * fq;
#pragma unroll
        for (int ai = 0; ai < 2; ++ai)
#pragma unroll
            for (int m = 0; m < 4; ++m) { bf16_t* rowp = O + (size_t)(row0 + ai * HALF + m * 16) * ldc + col0;
#pragma unroll
                for (int bj = 0; bj < 2; ++bj) { const f32x4 v0 = acc[ai][bj][m][0], v1 = acc[ai][bj][m][1];
                    u32x4 w; w.x = cvt_pk_bf16(v0[0], v0[1]); w.y = cvt_pk_bf16(v0[2], v0[3]); w.z = cvt_pk_bf16(v1[0], v1[1]); w.w = cvt_pk_bf16(v1[2], v1[3]);
                    *(u32x4*)(rowp + bj * HALF) = w; } }
    }
};
struct EpiQKV {
    static constexpr bool PERM = true, AFTER_DRAIN = false;
    bf16_t* O; int ldc; const float* rope; int layer;
    const float* gq0; const float* gk0;
    const float* gq1; const float* gk1;
    float* kmean;
    __device__ __forceinline__ void operator()(const f32x4 (&acc)[2][2][4][2], const Unit& u, int wr, int wc, int fr_, int fq_) const {
        int fr = fr_, fq = fq_; asm volatile("" : "+v"(fr), "+v"(fq));
        const int hg = 4 * u.pn + wc;
        const float* gain = nullptr; bool km = false;
        if (layer == 0) { if (hg < 8) gain = gq0; else if (hg < 10) gain = gk0; }
        else { if (hg < 8) gain = gq0; else if (hg < 16) gain = gk0; else if (hg >= 24 && hg < 32) gain = gq1; else if (hg >= 32 && hg < 40) { gain = gk1; km = true; } }
        const int row0 = u.pm * BM + wr * 64 + fr, col0 = 64 * hg + 8 * fq;
        float g0[8], g1[8], cs0[8], cs1[8];
#pragma unroll
        for (int e = 0; e < 8; ++e) { g0[e] = gain ? gain[8 * fq + e] : 1.f; g1[e] = gain ? gain[32 + 8 * fq + e] : 1.f; cs0[e] = 0.f; cs1[e] = 0.f; }
#pragma unroll
        for (int ai = 0; ai < 2; ++ai)
#pragma unroll
            for (int m = 0; m < 4; ++m) {
                const int row = row0 + ai * HALF + m * 16;
                float v0[8], v1[8];
#pragma unroll
                for (int e = 0; e < 4; ++e) { v0[e] = acc[ai][0][m][0][e]; v0[4 + e] = acc[ai][0][m][1][e]; v1[e] = acc[ai][1][m][0][e]; v1[4 + e] = acc[ai][1][m][1][e]; }
                if (gain) {
                    float ss = 0.f;
#pragma unroll
                    for (int e = 0; e < 8; ++e) ss += v0[e] * v0[e] + v1[e] * v1[e];
                    ss = rows_sum(ss);
                    const float r = rsqrtf(ss * (1.0f / 64.0f) + 1e-6f);
                    const float* rp = rope + ((size_t)(row & 2047) * 32 + 8 * fq) * 2;
                    const f32x4 t0 = *(const f32x4*)(rp), t1 = *(const f32x4*)(rp + 4), t2 = *(const f32x4*)(rp + 8), t3 = *(const f32x4*)(rp + 12);
                    const float cs[8] = {t0[0], t0[2], t1[0], t1[2], t2[0], t2[2], t3[0], t3[2]}, sn[8] = {t0[1], t0[3], t1[1], t1[3], t2[1], t2[3], t3[1], t3[3]};
#pragma unroll
                    for (int e = 0; e < 8; ++e) { const float y0 = v0[e] * r * g0[e], y1 = v1[e] * r * g1[e]; v0[e] = y0 * cs[e] - y1 * sn[e]; v1[e] = y1 * cs[e] + y0 * sn[e]; }
                }
                u32x4 w0, w1;
                w0.x = cvt_pk_bf16(v0[0], v0[1]); w0.y = cvt_pk_bf16(v0[2], v0[3]); w0.z = cvt_pk_bf16(v0[4], v0[5]); w0.w = cvt_pk_bf16(v0[6], v0[7]);
                w1.x = cvt_pk_bf16(v1[0], v1[1]); w1.y = cvt_pk_bf16(v1[2], v1[3]); w1.z = cvt_pk_bf16(v1[4], v1[5]); w1.w = cvt_pk_bf16(v1[6], v1[7]);
                bf16_t* rowp = O + (size_t)row * ldc + col0;
                *(u32x4*)(rowp) = w0; *(u32x4*)(rowp + 32) = w1;
                if (km) {
#pragma unroll
                    for (int e = 0; e < 8; ++e) { cs0[e] += v0[e]; cs1[e] += v1[e]; }
                }
            }
        if (km) {
#pragma unroll
            for (int e = 0; e < 8; ++e) {
                cs0[e] = row16_sum(cs0[e]); cs1[e] = row16_sum(cs1[e]);
            }
            if (fr == 0) {
                float* kp = kmean + ((size_t)((u.pm >> 3) * 8 + (hg - 32)) * 8 + (u.pm & 7)) * 64 + 8 * fq;
#pragma unroll
                for (int e = 0; e < 8; ++e) { atomicAdd(kp + e, cs0[e] * (1.0f / 256.0f)); atomicAdd(kp + 32 + e, cs1[e] * (1.0f / 256.0f)); }
            }
        }
    }
};
template <bool XBF> struct EpiResid {
    static constexpr bool PERM = true, AFTER_DRAIN = false;
    const void* xin; bf16_t* xout; const float* gate;
    __device__ __forceinline__ void operator()(const f32x4 (&acc)[2][2][4][2], const Unit& u, int wr, int wc, int fr_, int fq_) const {
        int fr = fr_, fq = fq_; asm volatile("" : "+v"(fr), "+v"(fq));
        const int row0 = u.pm * BM + wr * 64 + fr, col0 = u.pn * BM + wc * 32 + 8 * fq;
#pragma unroll
        for (int ai = 0; ai < 2; ++ai)
#pragma unroll
            for (int m = 0; m < 4; ++m) { const int row = row0 + ai * HALF + m * 16; const float* gp = gate + (size_t)(row >> 11) * 6144 + col0;
                bf16_t* xo = xout + (size_t)row * 1024 + col0;
#pragma unroll
                for (int bj = 0; bj < 2; ++bj) {
                    f32x4 x0, x1;
                    if constexpr (XBF) { const u32x4 q = *(const u32x4*)((const bf16_t*)xin + (size_t)row * 1024 + col0 + bj * HALF);
                        x0 = (f32x4){__uint_as_float(q.x << 16), __uint_as_float(q.x & 0xffff0000u), __uint_as_float(q.y << 16), __uint_as_float(q.y & 0xffff0000u)};
                        x1 = (f32x4){__uint_as_float(q.z << 16), __uint_as_float(q.z & 0xffff0000u), __uint_as_float(q.w << 16), __uint_as_float(q.w & 0xffff0000u)}; }
                    else { const float* xi = (const float*)xin + (size_t)row * 1024 + col0 + bj * HALF; x0 = *(const f32x4*)xi; x1 = *(const f32x4*)(xi + 4); }
                    const f32x4 a0 = acc[ai][bj][m][0], a1 = acc[ai][bj][m][1], g0 = *(const f32x4*)(gp + bj * HALF), g1 = *(const f32x4*)(gp + bj * HALF + 4);
                    u32x4 w; w.x = cvt_pk_bf16(x0[0] + g0[0] * a0[0], x0[1] + g0[1] * a0[1]); w.y = cvt_pk_bf16(x0[2] + g0[2] * a0[2], x0[3] + g0[3] * a0[3]);
                    w.z = cvt_pk_bf16(x1[0] + g1[0] * a1[0], x1[1] + g1[1] * a1[1]); w.w = cvt_pk_bf16(x1[2] + g1[2] * a1[2], x1[3] + g1[3] * a1[3]);
                    *(u32x4*)(xo + bj * HALF) = w; } }
    }
};
template <class Epi, class Sched, bool ALIGN_EPI = false, bool SP2 = false>
__device__ __forceinline__ void gemm_phase(PG8_LAS unsigned char* lds, const Gemm g, const Sched& S, const Epi& E) {
    const int tid = ltid(), wid = __builtin_amdgcn_readfirstlane(tid >> 6), lane = tid & 63, wr = wid >> 2, wc = wid & 3, fr = lane & 15, fq = lane >> 4;
    const int K = g.K, nt = K / BK;
    unsigned voffA[2], voffB[2];
#pragma unroll
    for (int i = 0; i < 2; ++i) { int R, C; stage_rc(tid * 16 + i * 8192, R, C); const int Rb = Epi::PERM ? ((R & ~31) + perm32(R & 31)) : R;
        voffA[i] = (unsigned)(R * K + C) * 2u; voffB[i] = (unsigned)(Rb * K + C) * 2u; }
    const size_t kstep = (size_t)(BK * 2);
    const size_t hstep = (size_t)HALF * K * 2;
    const size_t tstep = 2 * hstep;
    const unsigned ldsw = (unsigned)wid * 1024u;
    const int aoff = lds_byte(wr * 64 + fr, fq * 8), boff = lds_byte(wc * 32 + fr, fq * 8);
#define PG8_SA(b, h) (((b) * 2 + (h)) * HTB)
#define PG8_SB(b, h) ((4 + (b) * 2 + (h)) * HTB)
#define PG8_STAGE(bufoff, gbase, voff) do { _Pragma("unroll") for (int _i = 0; _i < 2; ++_i) \
        __builtin_amdgcn_global_load_lds((const unsigned*)((const char*)(gbase) + (voff)[_i]), (PG8_LAS unsigned*)(lds + (bufoff) + ldsw + _i * 8192), 16, 0, 0); } while (0)
#define PG8_LDA(dst, b, h) do { _Pragma("unroll") for (int m = 0; m < 4; ++m) _Pragma("unroll") for (int k = 0; k < 2; ++k) dst[m][k] = *(const PG8_LAS bf16x8*)(lds + PG8_SA(b, h) + aoff + m * 2048 + k * 1024); } while (0)
#define PG8_LDB(dst, b, h) do { _Pragma("unroll") for (int n = 0; n < 2; ++n) _Pragma("unroll") for (int k = 0; k < 2; ++k) dst[n][k] = *(const PG8_LAS bf16x8*)(lds + PG8_SB(b, h) + boff + n * 2048 + k * 1024); } while (0)
#define PG8_MMA(ai, bj, At, Bt) do { __builtin_amdgcn_s_setprio(1); _Pragma("unroll") for (int m = 0; m < 4; ++m) _Pragma("unroll") for (int n = 0; n < 2; ++n) _Pragma("unroll") for (int k = 0; k < 2; ++k) \
        acc[ai][bj][m][n] = __builtin_amdgcn_mfma_f32_16x16x32_bf16(Bt[n][k], At[m][k], acc[ai][bj][m][n], 0, 0, 0); __builtin_amdgcn_s_setprio(0); } while (0)
#define PG8_WAIT_V(n) asm volatile("s_waitcnt vmcnt(" #n ")" ::: "memory")
#define PG8_WAIT_L(n) asm volatile("s_waitcnt lgkmcnt(" #n ")" ::: "memory")
#define PG8_BAR __builtin_amdgcn_s_barrier()
#define PG8_SCHED __builtin_amdgcn_sched_barrier(0)
    Unit cur, nxt; int ui = 0;
    if (!S.next(0, cur)) return;
    f32x4 acc[2][2][4][2];
#pragma unroll
    for (int a = 0; a < 2; ++a)
#pragma unroll
        for (int b = 0; b < 2; ++b)
#pragma unroll
            for (int m = 0; m < 4; ++m)
#pragma unroll
                for (int n = 0; n < 2; ++n) acc[a][b][m][n] = (f32x4){0.f, 0.f, 0.f, 0.f};
    bf16x8 At[4][2], B0[2][2], B1[2][2];
    const char* cA = (const char*)g.A + (size_t)cur.pm * tstep; const char* cB = (const char*)g.Bt + (size_t)cur.pn * tstep;
    S.a_ready(cur);
    if constexpr (SP2) {
        PG8_STAGE(PG8_SB(0, 0), cB, voffB); PG8_STAGE(PG8_SB(0, 1), cB + hstep, voffB); PG8_STAGE(PG8_SA(0, 0), cA, voffA); PG8_STAGE(PG8_SA(0, 1), cA + hstep, voffA);
        if (wr == 1) PG8_BAR;
        PG8_WAIT_V(2); PG8_BAR;
        PG8_STAGE(PG8_SB(1, 0), cB + kstep, voffB); PG8_STAGE(PG8_SA(1, 0), cA + kstep, voffA); PG8_STAGE(PG8_SB(1, 1), cB + hstep + kstep, voffB);
        PG8_WAIT_V(6); PG8_BAR;
    } else {
        PG8_STAGE(PG8_SB(0, 0), cB, voffB); PG8_STAGE(PG8_SA(0, 0), cA, voffA); PG8_STAGE(PG8_SB(0, 1), cB + hstep, voffB); PG8_STAGE(PG8_SA(0, 1), cA + hstep, voffA);
        if (wr == 1) PG8_BAR;
        PG8_WAIT_V(4); PG8_BAR;
        PG8_STAGE(PG8_SB(1, 0), cB + kstep, voffB); PG8_STAGE(PG8_SA(1, 0), cA + kstep, voffA); PG8_STAGE(PG8_SB(1, 1), cB + hstep + kstep, voffB);
        PG8_WAIT_V(6); PG8_BAR;
    }
    for (;;) {
        const bool has_next = S.next(ui + 1, nxt);
        const char* nA = has_next ? (const char*)g.A + (size_t)nxt.pm * tstep : cA; const char* nB = has_next ? (const char*)g.Bt + (size_t)nxt.pn * tstep : cB;
        for (int t = 0; t < nt; t += 2) {
            const bool last = (t == nt - 2);
            const char* a1 = cA + (size_t)(t + 1) * kstep;
            const char* a2 = last ? nA : cA + (size_t)(t + 2) * kstep; const char* b2 = last ? nB : cB + (size_t)(t + 2) * kstep;
            const char* a3 = a2 + kstep; const char* b3 = b2 + kstep;
            if (last && has_next) S.a_ready(nxt);
            if constexpr (SP2) {
            PG8_LDB(B0, 0, 0); PG8_LDB(B1, 0, 1); PG8_SCHED; PG8_LDA(At, 0, 0); PG8_STAGE(PG8_SA(1, 1), a1 + hstep, voffA);
            PG8_WAIT_V(8); PG8_WAIT_L(0); PG8_BAR; PG8_MMA(0, 0, At, B0); PG8_MMA(0, 1, At, B1); PG8_BAR; PG8_SCHED;
            PG8_LDA(At, 0, 1); PG8_STAGE(PG8_SB(0, 0), b2, voffB); PG8_STAGE(PG8_SB(0, 1), b2 + hstep, voffB); PG8_STAGE(PG8_SA(0, 0), a2, voffA);
            PG8_WAIT_V(8); PG8_WAIT_L(0); PG8_BAR; PG8_MMA(1, 0, At, B0); PG8_MMA(1, 1, At, B1); PG8_BAR; PG8_SCHED;
            PG8_LDB(B0, 1, 0); PG8_LDB(B1, 1, 1); PG8_SCHED; PG8_LDA(At, 1, 0); PG8_STAGE(PG8_SA(0, 1), a2 + hstep, voffA);
            PG8_WAIT_V(8); PG8_WAIT_L(0); PG8_BAR; PG8_MMA(0, 0, At, B0); PG8_MMA(0, 1, At, B1); PG8_BAR; PG8_SCHED;
            PG8_LDA(At, 1, 1); PG8_STAGE(PG8_SB(1, 0), b3, voffB); PG8_STAGE(PG8_SB(1, 1), b3 + hstep, voffB); PG8_STAGE(PG8_SA(1, 0), a3, voffA);
            PG8_WAIT_V(8); PG8_WAIT_L(0); PG8_BAR; PG8_MMA(1, 0, At, B0); PG8_MMA(1, 1, At, B1); PG8_BAR; PG8_SCHED;
            } else {
            PG8_LDB(B0, 0, 0); PG8_SCHED; PG8_LDA(At, 0, 0); PG8_STAGE(PG8_SA(1, 1), a1 + hstep, voffA);
            PG8_WAIT_L(8); PG8_BAR; PG8_WAIT_L(0); PG8_MMA(0, 0, At, B0); PG8_BAR; PG8_SCHED;
            PG8_LDB(B1, 0, 1); PG8_STAGE(PG8_SB(0, 0), b2, voffB);
            PG8_BAR; PG8_WAIT_L(0); PG8_MMA(0, 1, At, B1); PG8_BAR;
            PG8_LDA(At, 0, 1); PG8_STAGE(PG8_SA(0, 0), a2, voffA);
            PG8_BAR; PG8_WAIT_L(0); PG8_MMA(1, 0, At, B0); PG8_BAR; PG8_SCHED;
            PG8_STAGE(PG8_SB(0, 1), b2 + hstep, voffB);
            PG8_WAIT_V(6); PG8_BAR; PG8_MMA(1, 1, At, B1); PG8_BAR;
            PG8_LDB(B0, 1, 0); PG8_SCHED; PG8_LDA(At, 1, 0); PG8_STAGE(PG8_SA(0, 1), a2 + hstep, voffA);
            PG8_WAIT_L(8); PG8_BAR; PG8_WAIT_L(0); PG8_MMA(0, 0, At, B0); PG8_BAR; PG8_SCHED;
            PG8_LDB(B1, 1, 1); PG8_STAGE(PG8_SB(1, 0), b3, voffB);
            PG8_BAR; PG8_WAIT_L(0); PG8_MMA(0, 1, At, B1); PG8_BAR;
            PG8_LDA(At, 1, 1); PG8_STAGE(PG8_SA(1, 0), a3, voffA);
            PG8_BAR; PG8_WAIT_L(0); PG8_MMA(1, 0, At, B0); PG8_BAR; PG8_SCHED;
            PG8_STAGE(PG8_SB(1, 1), b3 + hstep, voffB);
            PG8_WAIT_V(6); PG8_BAR; PG8_MMA(1, 1, At, B1); PG8_BAR;
            }
        }
        if constexpr (ALIGN_EPI) { if (wr == 0) PG8_BAR; }
        if constexpr (!Epi::AFTER_DRAIN) { E(acc, cur, wr, wc, fr, fq); S.done(cur); }
        if (!has_next) break;
#pragma unroll
        for (int a = 0; a < 2; ++a)
#pragma unroll
            for (int b = 0; b < 2; ++b)
#pragma unroll
                for (int m = 0; m < 4; ++m)
#pragma unroll
                    for (int n = 0; n < 2; ++n) acc[a][b][m][n] = (f32x4){0.f, 0.f, 0.f, 0.f};
        cur = nxt; cA = nA; cB = nB; ++ui;
        if constexpr (ALIGN_EPI) { if (wr == 1) PG8_BAR; }
    }
    PG8_WAIT_V(0);
    if constexpr (!ALIGN_EPI) { if (wr == 0) PG8_BAR; }
    PG8_BAR;
    if constexpr (Epi::AFTER_DRAIN) { E.fused(acc, cur, wr, wc, fr, fq, lds, wid, lane); S.done(cur); }
#undef PG8_SA
#undef PG8_SB
#undef PG8_STAGE
#undef PG8_LDA
#undef PG8_LDB
#undef PG8_MMA
#undef PG8_WAIT_V
#undef PG8_WAIT_L
#undef PG8_BAR
#undef PG8_SCHED
}
}

typedef float f32x16 __attribute__((ext_vector_type(16)));
typedef short s16x4 __attribute__((ext_vector_type(4)));
typedef short v4i16_t __attribute__((ext_vector_type(4)));
typedef float f32x2_t __attribute__((ext_vector_type(2)));
typedef __bf16 bf16x2_t __attribute__((ext_vector_type(2)));
#define LAS __attribute__((address_space(3)))
constexpr int VROW = 144, VBUF = 32 * VROW;
constexpr int VROWV = 192, VBUFV = 32 * VROWV;
constexpr float L2E = 1.4426950408889634f, LN2 = 0.6931471805599453f;
constexpr float SC2 = 0.125f * L2E;

__device__ __forceinline__ int crow(int r, int hi) { return (r & 3) + 8 * (r >> 2) + 4 * hi; }
__device__ __forceinline__ unsigned cvtpk(float lo, float hi) { f32x2_t v = {lo, hi}; bf16x2_t b = __builtin_convertvector(v, bf16x2_t); return __builtin_bit_cast(unsigned, b); }
__device__ __forceinline__ float xhalf(float v, int hi) {
    auto r = __builtin_amdgcn_permlane32_swap(__float_as_uint(v), __float_as_uint(v), false, false);
    return __uint_as_float(hi ? r[0] : r[1]);
}
__device__ __forceinline__ s16x4 vtr(const LAS unsigned char* p) { return __builtin_bit_cast(s16x4, __builtin_amdgcn_ds_read_tr16_b64_v4i16((LAS v4i16_t*)p)); }

struct KVRegs { u32x4 k[4]; u32x4 v[4]; };
__device__ __forceinline__ void load_kv(KVRegs& R, const bf16* base, int kp0, int kst, int kcol, int vcol, int lane) {
#pragma unroll
    for (int j = 0; j < 4; ++j) {
        const int pos = kp0 + kst * (8 * j + (lane >> 3));
        const int pc = pos < SQ - 1 ? pos : SQ - 1;
        const bf16* rp = base + (size_t)pc * QKV_LD + (lane & 7) * 8;
        R.k[j] = *(const u32x4*)(rp + kcol); R.v[j] = *(const u32x4*)(rp + vcol);
    }
}
__device__ __forceinline__ void kv_stage(const KVRegs& R, LAS unsigned char* klds, LAS unsigned char* vlds, int lane) {
#pragma unroll
    for (int j = 0; j < 4; ++j) { const int r_ = 8 * j + (lane >> 3), c_ = (lane & 7) * 16; *(LAS u32x4*)(klds + r_ * VROW + c_) = R.k[j]; *(LAS u32x4*)(vlds + r_ * VROWV + c_) = R.v[j]; }
}
__device__ __forceinline__ f32x16 qk_tile(const LAS unsigned char* klds, const bf16x8 (&qf)[4], int r32, int hi) {
    f32x16 s = {0.f, 0.f, 0.f, 0.f, 0.f, 0.f, 0.f, 0.f, 0.f, 0.f, 0.f, 0.f, 0.f, 0.f, 0.f, 0.f};
#pragma unroll
    for (int k = 0; k < 4; ++k) { const bf16x8 kf = *(const LAS bf16x8*)(klds + r32 * VROW + (2 * k + hi) * 16); s = __builtin_amdgcn_mfma_f32_32x32x16_bf16(kf, qf[k], s, 0, 0, 0); }
    return s;
}
__device__ __forceinline__ void pv_tile(f32x16 (&o)[2], const f32x16& p, const LAS unsigned char* vlds, int lane) {
    const int g = lane >> 4, i = lane & 15, h = lane >> 5;
    const LAS unsigned char* vb = vlds + (4 * h + (i >> 2)) * VROWV + (16 * (g & 1) + 4 * (i & 3)) * 2;
#pragma unroll
    for (int s = 0; s < 2; ++s) {
        u32x4 pw; pw.x = cvtpk(p[8 * s], p[8 * s + 1]); pw.y = cvtpk(p[8 * s + 2], p[8 * s + 3]); pw.z = cvtpk(p[8 * s + 4], p[8 * s + 5]); pw.w = cvtpk(p[8 * s + 6], p[8 * s + 7]);
        const bf16x8 pb = __builtin_bit_cast(bf16x8, pw);
#pragma unroll
        for (int df = 0; df < 2; ++df) {
            const s16x4 lo = vtr(vb + (16 * s) * VROWV + df * 64), hh = vtr(vb + (16 * s + 8) * VROWV + df * 64);
            const bf16x8 va = (bf16x8){lo[0], lo[1], lo[2], lo[3], hh[0], hh[1], hh[2], hh[3]};
            o[df] = __builtin_amdgcn_mfma_f32_32x32x16_bf16(va, pb, o[df], 0, 0, 0);
        }
    }
}
__device__ __forceinline__ void load_q(bf16x8 (&qf)[4], const bf16* base, int qpos, int qcol, int hi) {
    const bf16* rp = base + (size_t)qpos * QKV_LD + qcol + 8 * hi;
#pragma unroll
    for (int k = 0; k < 4; ++k) qf[k] = *(const bf16x8*)(rp + 16 * k);
}
__device__ __forceinline__ void store_o(bf16* yrow, const f32x16 (&o)[2], float inv, int hi) {
#pragma unroll
    for (int df = 0; df < 2; ++df)
#pragma unroll
        for (int g = 0; g < 4; ++g) {
            u32x2 w; w.x = cvtpk(o[df][4 * g] * inv, o[df][4 * g + 1] * inv); w.y = cvtpk(o[df][4 * g + 2] * inv, o[df][4 * g + 3] * inv);
            *(u32x2*)(yrow + 32 * df + 8 * g + 4 * hi) = w;
        }
}
__device__ __forceinline__ void osm_tile(f32x16& s, float& m, float& l, f32x16 (&o)[2]) {
    float mx = s[0];
#pragma unroll
    for (int r = 1; r < 16; ++r) mx = fmaxf(mx, s[r]);
    { auto rr = __builtin_amdgcn_permlane32_swap(__float_as_uint(mx), __float_as_uint(mx), false, false); mx = fmaxf(__uint_as_float(rr[0]), __uint_as_float(rr[1])); }
    const float mn = fmaxf(m, mx);
    const float ms = (mn == -INFINITY) ? 0.f : mn;
    const float alpha = __builtin_amdgcn_exp2f((m - ms) * SC2);
    const float mc = ms * SC2;
    float ps = 0.f;
#pragma unroll
    for (int r = 0; r < 16; ++r) { s[r] = __builtin_amdgcn_exp2f(s[r] * SC2 - mc); ps += s[r]; }
    l = l * alpha + ps; m = mn;
    if (!__all(alpha == 1.0f)) {
#pragma unroll
        for (int df = 0; df < 2; ++df)
#pragma unroll
            for (int r = 0; r < 16; ++r) o[df][r] *= alpha;
    }
}
__device__ __forceinline__ void osm_tile2(f32x16& s0, f32x16& s1, float& m, float& l, f32x16 (&o)[2]) {
    float mx = fmaxf(s0[0], s1[0]);
#pragma unroll
    for (int r = 1; r < 16; ++r) mx = fmaxf(mx, fmaxf(s0[r], s1[r]));
    { auto rr = __builtin_amdgcn_permlane32_swap(__float_as_uint(mx), __float_as_uint(mx), false, false); mx = fmaxf(__uint_as_float(rr[0]), __uint_as_float(rr[1])); }
    const float mn = fmaxf(m, mx);
    const float ms = (mn == -INFINITY) ? 0.f : mn;
    const float alpha = __builtin_amdgcn_exp2f((m - ms) * SC2);
    const float mc = ms * SC2;
    float ps0 = 0.f, ps1 = 0.f;
#pragma unroll
    for (int r = 0; r < 16; ++r) { s0[r] = __builtin_amdgcn_exp2f(s0[r] * SC2 - mc); ps0 += s0[r]; s1[r] = __builtin_amdgcn_exp2f(s1[r] * SC2 - mc); ps1 += s1[r]; }
    l = l * alpha + (ps0 + ps1); m = mn;
    if (!__all(alpha == 1.0f)) {
#pragma unroll
        for (int df = 0; df < 2; ++df)
#pragma unroll
            for (int r = 0; r < 16; ++r) o[df][r] *= alpha;
    }
}
#define ZERO16 {0.f, 0.f, 0.f, 0.f, 0.f, 0.f, 0.f, 0.f, 0.f, 0.f, 0.f, 0.f, 0.f, 0.f, 0.f, 0.f}

struct AttnCtx {
    const bf16* base; int kcol, vcol, r32, hi, lane; LAS unsigned char* vlds; LAS unsigned char* klds; bf16x8 qf[4]; f32x16 o[2];
};
#define ATTN_STEP(SC, SL, T) { \
        if (SYNC) __builtin_amdgcn_s_barrier(); \
        { int kp_, ks_; const int tl_ = (T) + 2 < nt ? (T) + 2 : nt - 1; mx.pos(tl_, kp_, ks_); load_kv(SL, c.base, kp_, ks_, c.kcol, c.vcol, c.lane); } \
        kv_stage(SC, c.klds, c.vlds, c.lane); f32x16 s_ = qk_tile(c.klds, c.qf, c.r32, c.hi); \
        const bool stop_ = mx.process((T), s_, c); pv_tile(c.o, s_, c.vlds, c.lane); \
        if ((!SYNC && stop_) || (T) + 1 >= nt) break; }
template <class M, bool SYNC> __device__ __forceinline__ void attn_run(M& mx, AttnCtx& c) {
    const int nt = mx.nt;
    KVRegs S0, S1, S2;
    { int kp, ks; mx.pos(0, kp, ks); load_kv(S0, c.base, kp, ks, c.kcol, c.vcol, c.lane);
      mx.pos(1 < nt ? 1 : nt - 1, kp, ks); load_kv(S1, c.base, kp, ks, c.kcol, c.vcol, c.lane); }
    for (int t = 0;; t += 3) {
        ATTN_STEP(S0, S2, t)
        ATTN_STEP(S1, S0, t + 1)
        ATTN_STEP(S2, S1, t + 2)
    }
}
#define SH_BAR() asm volatile("s_waitcnt lgkmcnt(0)\n\ts_barrier" ::: "memory")
constexpr int SLOT_K = 64 * VROW, SLOT_BYTES = 64 * VROW + 64 * VROWV;
struct ShRegs { u32x4 a, b; };
__device__ __forceinline__ void sh_load(ShRegs& R, const bf16* base, int kp0, int kcol, int vcol, int w, int lane) {
    const int pos = kp0 + 4 * w + ((lane & 31) >> 3);
    const int pa = pos < SQ - 1 ? pos : SQ - 1, pb = pos + 32 < SQ - 1 ? pos + 32 : SQ - 1;
    const int col = ((lane >> 5) ? vcol : kcol) + (lane & 7) * 8;
    R.a = *(const u32x4*)(base + (size_t)pa * QKV_LD + col); R.b = *(const u32x4*)(base + (size_t)pb * QKV_LD + col);
}
__device__ __forceinline__ void sh_write(LAS unsigned char* slot, const ShRegs& R, int w, int lane) {
    const int row = 4 * w + ((lane & 31) >> 3);
    LAS unsigned char* p = slot + ((lane >> 5) ? SLOT_K + row * VROWV : row * VROW) + (lane & 7) * 16;
    *(LAS u32x4*)p = R.a; *(LAS u32x4*)(p + 32 * ((lane >> 5) ? VROWV : VROW)) = R.b;
}
#define SH_STEP(RW, RL, T) { \
        SH_BAR(); \
        { const int tl_ = (T) + 2 < nt ? (T) + 2 : nt - 1; sh_load(RL, c.base, mx.pos2(tl_), c.kcol, c.vcol, w, c.lane); } \
        sh_write(slots + (((T) + 1) & 1) * SLOT_BYTES, RW, w, c.lane); \
        if (mx.active2((T), w)) { LAS unsigned char* sl_ = slots + ((T) & 1) * SLOT_BYTES; \
            f32x16 s0_ = qk_tile(sl_, c.qf, c.r32, c.hi), s1_ = qk_tile(sl_ + 32 * VROW, c.qf, c.r32, c.hi); mx.process2((T), s0_, s1_, c); \
            pv_tile(c.o, s0_, sl_ + SLOT_K, c.lane); pv_tile(c.o, s1_, sl_ + SLOT_K + 32 * VROWV, c.lane); } \
        if ((T) + 1 >= nt) break; }
template <class M> __device__ __forceinline__ void attn_run_shared(M& mx, AttnCtx& c, LAS unsigned char* slots, int w) {
    const int nt = mx.nt2;
    ShRegs R0, R1, R2;
    sh_load(R0, c.base, mx.pos2(0), c.kcol, c.vcol, w, c.lane);
    sh_load(R1, c.base, mx.pos2(1 < nt ? 1 : nt - 1), c.kcol, c.vcol, w, c.lane);
    SH_BAR();
    sh_write(slots, R0, w, c.lane);
    for (int t = 0;; t += 3) {
        SH_STEP(R1, R2, t)
        SH_STEP(R2, R0, t + 1)
        SH_STEP(R0, R1, t + 2)
    }
}
struct MixA {
    int nt, k00, qpos; float m, l;
    __device__ __forceinline__ void pos(int idx, int& kp0, int& kst) const { kp0 = k00 + 32 * idx; kst = 1; }
    __device__ __forceinline__ bool process(int idx, f32x16& s, AttnCtx& c) {
        const int k0 = k00 + 32 * idx;
#pragma unroll
        for (int r = 0; r < 16; ++r) { const int dist = qpos - (k0 + crow(r, c.hi)); if (dist < 0 || dist > 127) s[r] = -INFINITY; }
        osm_tile(s, m, l, c.o); return false;
    }
};
__device__ void attn_A(const bf16* base, int hq, int q0, float sink, bf16* ybase, LAS unsigned char* vlds, int lane) {
    AttnCtx c; c.base = base; c.r32 = lane & 31; c.hi = lane >> 5; c.lane = lane; c.vlds = vlds; c.klds = vlds + VBUFV; c.kcol = 512 + (hq >> 2) * 64; c.vcol = 640 + (hq >> 2) * 64;
    c.o[0] = (f32x16)ZERO16; c.o[1] = (f32x16)ZERO16;
    MixA mx; mx.qpos = q0 + c.r32; mx.k00 = q0 - 128 > 0 ? q0 - 128 : 0; mx.nt = 5; mx.m = -INFINITY; mx.l = 0.f;
    load_q(c.qf, base, mx.qpos, hq * 64, c.hi);
    attn_run<MixA, true>(mx, c);
    float l = mx.l + xhalf(mx.l, c.hi);
    l += __builtin_amdgcn_exp2f(sink * L2E - mx.m * SC2);
    store_o(ybase + (size_t)mx.qpos * DM + hq * 64, c.o, 1.0f / l, c.hi);
}
struct MixB {
    int nt, q0, qpos; float carry;
    __device__ __forceinline__ void pos(int idx, int& kp0, int& kst) const { kp0 = q0 - 32 * idx; kst = 1; }
    __device__ __forceinline__ bool process(int idx, f32x16& s, AttnCtx& c) {
        const int k0 = q0 - 32 * idx, hi = c.hi;
        float lk[16], G[4], Gp[4];
#pragma unroll
        for (int r = 0; r < 16; ++r) {
            const float z = s[r] * 0.125f;
            const bool valid = (k0 + crow(r, hi)) < qpos;
            const float sp = fmaxf(z, 0.f) + LN2 * __builtin_amdgcn_logf(1.0f + __builtin_amdgcn_exp2f(-fabsf(z) * L2E));
            lk[r] = valid ? -sp : 0.f;
            s[r] = valid ? (z - sp) : -INFINITY;
        }
#pragma unroll
        for (int g = 0; g < 4; ++g) { G[g] = (lk[4 * g] + lk[4 * g + 1]) + (lk[4 * g + 2] + lk[4 * g + 3]); Gp[g] = xhalf(G[g], hi); }
        float above = carry;
#pragma unroll
        for (int g = 3; g >= 0; --g) {
            float off = above + (hi == 0 ? Gp[g] : 0.f);
            s[4 * g + 3] = __builtin_amdgcn_exp2f((s[4 * g + 3] + off) * L2E); off += lk[4 * g + 3];
            s[4 * g + 2] = __builtin_amdgcn_exp2f((s[4 * g + 2] + off) * L2E); off += lk[4 * g + 2];
            s[4 * g + 1] = __builtin_amdgcn_exp2f((s[4 * g + 1] + off) * L2E); off += lk[4 * g + 1];
            s[4 * g + 0] = __builtin_amdgcn_exp2f((s[4 * g + 0] + off) * L2E);
            above += G[g] + Gp[g];
        }
        carry = above;
        return __all(carry < -40.0f) != 0;
    }
};
__device__ void attn_B(const bf16* base, int h, int q0, bf16* ybase, LAS unsigned char* vlds, int lane) {
    AttnCtx c; c.base = base; c.r32 = lane & 31; c.hi = lane >> 5; c.lane = lane; c.vlds = vlds; c.klds = vlds + VBUFV; c.kcol = 1280 + h * 64; c.vcol = 1792 + h * 64;
    c.o[0] = (f32x16)ZERO16; c.o[1] = (f32x16)ZERO16;
    MixB mx; mx.q0 = q0; mx.qpos = q0 + c.r32; mx.nt = q0 / 32 + 1; mx.carry = 0.f;
    load_q(c.qf, base, mx.qpos, 768 + h * 64, c.hi);
    attn_run<MixB, false>(mx, c);
    store_o(ybase + (size_t)mx.qpos * DM + 512 + h * 64, c.o, 1.0f, c.hi);
}
struct MixCp {
    int nt, n0, r0, j1lo, qpos; float m, l;
    __device__ __forceinline__ void pos(int t, int& kp0, int& kst) const {
        if (t < n0) { kp0 = r0 + 512 * t; kst = 16; } else { kp0 = (r0 & 3) + 4 * (j1lo + 32 * (t - n0)); kst = 4; }
    }
    __device__ __forceinline__ bool process(int t, f32x16& s, AttnCtx& c) {
        int kp0, kst; pos(t, kp0, kst);
        const int win = t < n0 ? 2048 : 512;
#pragma unroll
        for (int r = 0; r < 16; ++r) { const int dist = qpos - (kp0 + kst * crow(r, c.hi)); if (dist < 0 || dist > win) s[r] = -INFINITY; }
        osm_tile(s, m, l, c.o); return false;
    }
};
struct MixC1 {
    int nt2, p0, qpos; float m, l;
    __device__ __forceinline__ int pos2(int T) const { return p0 + 64 * T; }
    __device__ __forceinline__ bool active2(int T, int w) const { return true; }
    __device__ __forceinline__ void process2(int T, f32x16& s0, f32x16& s1, AttnCtx& c) {
        const int k0 = p0 + 64 * T;
#pragma unroll
        for (int r = 0; r < 16; ++r) { const int dist = qpos - (k0 + crow(r, c.hi)); if (dist < 0 || dist > 128) s0[r] = -INFINITY; if (dist < 32 || dist > 160) s1[r] = -INFINITY; }
        osm_tile2(s0, s1, m, l, c.o);
    }
};
__device__ void attn_C(const bf16* base, int h, int r0, int g, bf16* ybase, LAS unsigned char* vlds, LAS unsigned char* xlds, int w, int lane) {
    AttnCtx c; c.base = base; c.r32 = lane & 31; c.hi = lane >> 5; c.lane = lane; c.vlds = vlds; c.klds = vlds + VBUFV; c.kcol = 512 + h * 64; c.vcol = 1024 + h * 64;
    c.o[0] = (f32x16)ZERO16; c.o[1] = (f32x16)ZERO16;
    const int qpos = r0 + 16 * (32 * g + c.r32);
    load_q(c.qf, base, qpos, h * 64, c.hi);
    MixCp mp; mp.r0 = r0; mp.qpos = qpos; mp.m = -INFINITY; mp.l = 0.f;
    mp.n0 = g + 1;
    mp.j1lo = (r0 >> 2) + 128 * g - 128 > 0 ? (r0 >> 2) + 128 * g - 128 : 0;
    mp.nt = mp.n0 + ((r0 >> 2) + 128 * g + 124 - mp.j1lo) / 32 + 1;
    attn_run<MixCp, true>(mp, c);
    MixC1 m1; m1.qpos = qpos; m1.m = mp.m; m1.l = mp.l;
    const int ra = r0 & 8;
    m1.p0 = 512 * g + ra - 128 > 0 ? 512 * g + ra - 128 : 0;
    m1.nt2 = ((512 * g + ra + 7 + 496 - m1.p0) / 32 + 2) / 2;
    attn_run_shared<MixC1>(m1, c, xlds + 64, w);
    const float l = m1.l + xhalf(m1.l, c.hi);
    store_o(ybase + (size_t)qpos * DM + h * 64, c.o, 1.0f / l, c.hi);
}
struct MixD {
    int nt, nt2, npast, own, q0, qpos; unsigned U, sel; float m, l;
    __device__ __forceinline__ int blk_of(int j) const {
        unsigned u = U; int b = 0;
#pragma unroll
        for (int i = 0; i < 7; ++i) { if (i < j) u &= u - 1u; }
        b = __builtin_ctz(u | 0x100u); return b;
    }
    __device__ __forceinline__ void pos(int t, int& kp0, int& kst) const {
        kst = 1;
        if (t < 8 * npast) kp0 = blk_of(t >> 3) * 256 + (t & 7) * 32; else kp0 = own * 256 + (t - 8 * npast) * 32;
    }
    __device__ __forceinline__ int pos2(int T) const { int kp, ks; pos(2 * T, kp, ks); return kp; }
    __device__ __forceinline__ bool active2(int T, int w) const { return T < 4 * npast || 2 * (T - 4 * npast) <= w; }
    __device__ __forceinline__ void process2(int T, f32x16& s0, f32x16& s1, AttnCtx& c) {
        if (T < 4 * npast) {
            const int blk = blk_of(T >> 2);
            if (!((sel >> blk) & 1u)) {
#pragma unroll
                for (int r = 0; r < 16; ++r) { s0[r] = -INFINITY; s1[r] = -INFINITY; }
            }
        } else {
            const int k0 = own * 256 + (T - 4 * npast) * 64;
#pragma unroll
            for (int r = 0; r < 16; ++r) { const int kk = k0 + crow(r, c.hi); if (kk > qpos) s0[r] = -INFINITY; if (kk + 32 > qpos) s1[r] = -INFINITY; }
        }
        osm_tile2(s0, s1, m, l, c.o);
    }
};
__device__ void attn_D(const bf16* base, const float* kmean  , int h, int q0, bf16* ybase, LAS unsigned char* vlds, LAS unsigned char* xlds, int lane) {
    AttnCtx c; c.base = base; c.r32 = lane & 31; c.hi = lane >> 5; c.lane = lane; c.vlds = vlds; c.klds = vlds + VBUFV; c.kcol = 2048 + h * 64; c.vcol = 2560 + h * 64;
    c.o[0] = (f32x16)ZERO16; c.o[1] = (f32x16)ZERO16;
    const int r32 = c.r32, hi = c.hi, own = q0 >> 8;
    MixD mx; mx.own = own; mx.q0 = q0; mx.qpos = q0 + r32; mx.m = -INFINITY; mx.l = 0.f;
    load_q(c.qf, base, mx.qpos, 1536 + h * 64, hi);
    unsigned sel = 0u;
    if (own > 0) {
        bf16x8 kf[4];
#pragma unroll
        for (int k = 0; k < 4; ++k) {
            u32x4 w = {0u, 0u, 0u, 0u};
            if (r32 < 8) { const float* kp = kmean + r32 * 64 + 16 * k + 8 * hi; const f32x4 a = *(const f32x4*)kp, b = *(const f32x4*)(kp + 4);
                w.x = cvtpk(a[0], a[1]); w.y = cvtpk(a[2], a[3]); w.z = cvtpk(b[0], b[1]); w.w = cvtpk(b[2], b[3]); }
            kf[k] = __builtin_bit_cast(bf16x8, w);
        }
        f32x16 gs = ZERO16;
#pragma unroll
        for (int k = 0; k < 4; ++k) gs = __builtin_amdgcn_mfma_f32_32x32x16_bf16(kf[k], c.qf[k], gs, 0, 0, 0);
        float gt[8];
#pragma unroll
        for (int r = 0; r < 4; ++r) { const float mine = gs[r], oth = xhalf(mine, hi); gt[r] = hi == 0 ? mine : oth; gt[4 + r] = hi == 0 ? oth : mine; }
        const int nsel = own < 3 ? own : 3;
        for (int rr = 0; rr < nsel; ++rr) {
            float best = -INFINITY; int bi = -1;
#pragma unroll
            for (int n = 0; n < 8; ++n) { const bool ok = n < own && !((sel >> n) & 1u) && (bi < 0 || gt[n] > best); if (ok) { best = gt[n]; bi = n; } }
            if (bi >= 0) sel |= 1u << bi;
        }
    }
    unsigned U = 0u;
#pragma unroll
    for (int n = 0; n < 8; ++n) if (__ballot((sel >> n) & 1u) != 0ull) U |= 1u << n;
    {
        volatile LAS unsigned* ux = (volatile LAS unsigned*)xlds;
        __builtin_amdgcn_s_barrier();
        if (lane == 0) ux[(q0 >> 5) & 7] = U;
        asm volatile("s_waitcnt lgkmcnt(0)" ::: "memory");
        __builtin_amdgcn_s_barrier();
        U = ux[0] | ux[1] | ux[2] | ux[3] | ux[4] | ux[5] | ux[6] | ux[7];
        U = __builtin_amdgcn_readfirstlane(U);
    }
    mx.U = U; mx.sel = sel; mx.npast = __builtin_popcount(U); mx.nt = 8 * mx.npast + 8; mx.nt2 = 4 * mx.npast + 4;
    attn_run_shared<MixD>(mx, c, xlds + 64, (q0 >> 5) & 7);
    const float l = mx.l + xhalf(mx.l, c.hi);
    store_o(ybase + (size_t)mx.qpos * DM + 512 + h * 64, c.o, 1.0f / l, hi);
}

__device__ void ph_attn0(const bf16* qkv, const float* sinks, bf16* y, LAS unsigned char* lds, int bid, int nb) {
    const int lane = ltid() & 63, w = __builtin_amdgcn_readfirstlane(ltid() >> 6);
    LAS unsigned char* vlds = lds + w * (VBUF + VBUFV);
    for (int pid = bid; pid < NB * 8; pid += nb) {
        const int b = pid >> 3, h = pid & 7;
        const bf16* base = qkv + (size_t)b * SQ * QKV_LD; bf16* ybase = y + (size_t)b * SQ * DM;
        const float sink = sinks[h];
        for (int rd = 0; rd < 8; ++rd) attn_A(base, h, (rd * 8 + w) * 32, sink, ybase, vlds, lane);
        for (int rd = 0; rd < 8; ++rd) attn_B(base, h, (rd * 8 + w) * 32, ybase, vlds, lane);
    }
}
__device__ void ph_attn1(const bf16* qkv, const float* kmean, bf16* y, LAS unsigned char* lds, int bid, int nb) {
    const int lane = ltid() & 63, w = __builtin_amdgcn_readfirstlane(ltid() >> 6);
    LAS unsigned char* vlds = lds + w * (VBUF + VBUFV);
    for (int pid = bid; pid < NB * 8; pid += nb) {
        const int b = pid >> 3, h = pid & 7;
        const bf16* base = qkv + (size_t)b * SQ * QKV_LD; bf16* ybase = y + (size_t)b * SQ * DM;
        for (int rd = 0; rd < 8; ++rd) { const int it = rd * 8 + w; attn_C(base, h, it & 15, it >> 4, ybase, vlds, lds + 8 * (VBUF + VBUFV), w, lane); }
        for (int rd = 0; rd < 8; ++rd) attn_D(base, kmean + (size_t)pid * 8 * 64, h, (rd * 8 + w) * 32, ybase, vlds, lds + 8 * (VBUF + VBUFV), lane);
    }
}

#define CE_D(a, b) { const float hi_ = fmaxf((a), (b)), lo_ = fminf((a), (b)); (a) = hi_; (b) = lo_; }
#define BSTAGE(arr, k, j) _Pragma("unroll") for (int i_ = 0; i_ < 16; ++i_) { const int l_ = i_ ^ (j); if (l_ > i_) { if ((i_ & (k)) == 0) CE_D(arr[i_], arr[l_]) else CE_D(arr[l_], arr[i_]) } }
__device__ __forceinline__ void bsort16(float (&a)[16]) {
    CE_D(a[0], a[1]) CE_D(a[2], a[3]) CE_D(a[0], a[2]) CE_D(a[1], a[3]) CE_D(a[1], a[2]) CE_D(a[4], a[5]) CE_D(a[6], a[7]) CE_D(a[4], a[6]) CE_D(a[5], a[7]) CE_D(a[5], a[6]) CE_D(a[0], a[4]) CE_D(a[2], a[6]) CE_D(a[2], a[4]) CE_D(a[1], a[5]) CE_D(a[3], a[7]) CE_D(a[3], a[5]) CE_D(a[1], a[2]) CE_D(a[3], a[4]) CE_D(a[5], a[6]) CE_D(a[8], a[9]) CE_D(a[10], a[11]) CE_D(a[8], a[10]) CE_D(a[9], a[11]) CE_D(a[9], a[10]) CE_D(a[12], a[13]) CE_D(a[14], a[15]) CE_D(a[12], a[14]) CE_D(a[13], a[15]) CE_D(a[13], a[14]) CE_D(a[8], a[12]) CE_D(a[10], a[14]) CE_D(a[10], a[12]) CE_D(a[9], a[13]) CE_D(a[11], a[15]) CE_D(a[11], a[13]) CE_D(a[9], a[10]) CE_D(a[11], a[12]) CE_D(a[13], a[14]) CE_D(a[0], a[8]) CE_D(a[4], a[12]) CE_D(a[4], a[8]) CE_D(a[2], a[10]) CE_D(a[6], a[14]) CE_D(a[6], a[10]) CE_D(a[2], a[4]) CE_D(a[6], a[8]) CE_D(a[10], a[12]) CE_D(a[1], a[9]) CE_D(a[5], a[13]) CE_D(a[5], a[9]) CE_D(a[3], a[11]) CE_D(a[7], a[15]) CE_D(a[7], a[11]) CE_D(a[3], a[5]) CE_D(a[7], a[9]) CE_D(a[11], a[13]) CE_D(a[1], a[2]) CE_D(a[3], a[4]) CE_D(a[5], a[6]) CE_D(a[7], a[8]) CE_D(a[9], a[10]) CE_D(a[11], a[12]) CE_D(a[13], a[14])
}
__device__ __forceinline__ void bmerge16(float (&a)[16]) {
    BSTAGE(a, 16, 8) BSTAGE(a, 16, 4) BSTAGE(a, 16, 2) BSTAGE(a, 16, 1)
}
__device__ __forceinline__ void merge_top16(float (&a)[16], const float (&b)[16]) {
#pragma unroll
    for (int i = 0; i < 16; ++i) a[i] = fmaxf(a[i], b[15 - i]);
    bmerge16(a);
}
__device__ __forceinline__ void xmerge16(float (&a)[16]) {
    {
        float A[16], B[16];
#pragma unroll
        for (int i = 0; i < 16; ++i) { auto r = __builtin_amdgcn_permlane16_swap(__float_as_uint(a[i]), __float_as_uint(a[i]), false, false); A[i] = __uint_as_float(r[0]); B[i] = __uint_as_float(r[1]); }
#pragma unroll
        for (int i = 0; i < 16; ++i) a[i] = fmaxf(A[i], B[15 - i]);
        bmerge16(a);
    }
    {
        float A[16], B[16];
#pragma unroll
        for (int i = 0; i < 16; ++i) { auto r = __builtin_amdgcn_permlane32_swap(__float_as_uint(a[i]), __float_as_uint(a[i]), false, false); A[i] = __uint_as_float(r[0]); B[i] = __uint_as_float(r[1]); }
#pragma unroll
        for (int i = 0; i < 16; ++i) a[i] = fmaxf(A[i], B[15 - i]);
        bmerge16(a);
    }
}
__host__ __device__ constexpr int pair_i(int id) {
    int c = 0;
    for (int i = 0; i < 16; ++i) { const int nj = 16 / (i + 1); if (id < c + nj) return i; c += nj; }
    return 0;
}
__host__ __device__ constexpr int pair_j(int id) {
    int c = 0;
    for (int i = 0; i < 16; ++i) { const int nj = 16 / (i + 1); if (id < c + nj) return id - c; c += nj; }
    return 0;
}
constexpr int SK_ROW = 272;
constexpr int SEL_SK_BYTES = 2 * 128 * SK_ROW;
constexpr int SEL_TAB_OFF = SEL_SK_BYTES;
constexpr int SEL_IDX_OFF = SEL_SK_BYTES + 64;

template <int S> __device__ __forceinline__ float cand_slot(const float (&L1)[16], const float (&L2)[16], int g) {
    constexpr int p0 = S, p1 = 16 + S, p2 = 32 + S, p3 = 48 + S;
    const float c0 = L1[pair_i(p0)] + L2[pair_j(p0)], c1 = L1[pair_i(p1)] + L2[pair_j(p1)], c2 = L1[pair_i(p2)] + L2[pair_j(p2)];
    const float c3 = p3 < 50 ? L1[pair_i(p3 < 50 ? p3 : 0)] + L2[pair_j(p3 < 50 ? p3 : 0)] : -1.0e30f;
    const float c = g == 0 ? c0 : (g == 1 ? c1 : (g == 2 ? c2 : c3));
    return __uint_as_float((__float_as_uint(c) & 0xffffffc0u) | (unsigned)(16 * g + S));
}

__device__ void ph_peer_select(const bf16* qry, const float* subkeys  , int* eidx, float* egate, LAS unsigned char* lds, int bid, int nb) {
    const int tid = ltid(), lane = tid & 63, w = __builtin_amdgcn_readfirstlane(tid >> 6);
    const int tk = lane & 15, g = lane >> 4;
    __syncthreads();
    for (int e = tid; e < 2 * 128 * 128 / 2; e += NT) {
        const int row = e >> 6, c2 = (e & 63) * 2;
        const float a = subkeys[(size_t)row * 128 + c2], b = subkeys[(size_t)row * 128 + c2 + 1];
        *(LAS unsigned*)(lds + row * SK_ROW + c2 * 2) = pk2(a, b);
    }
    if (tid < 64) { int id = tid; int c = 0, pi = 0, pj = 0;
        for (int i = 0; i < 16; ++i) { const int nj = 16 / (i + 1); if (id >= c && id < c + nj) { pi = i; pj = id - c; } c += nj; }
        lds[SEL_TAB_OFF + tid] = (unsigned char)((pi << 4) | pj); }
    __syncthreads();
    LAS unsigned* widx = (LAS unsigned*)(lds + SEL_IDX_OFF + w * 512);
    const LAS unsigned char* widx8 = (const LAS unsigned char*)widx;
    const int nitems = (MT / 16) * 8;
    bf16x8 qc[2][4];
    { const int it = bid * 8 + w;
      if (it < nitems) { const bf16* qp = qry + (size_t)((it >> 3) * 16 + tk) * PQ + (it & 7) * 256 + 8 * g;
#pragma unroll
          for (int hf = 0; hf < 2; ++hf)
#pragma unroll
              for (int ks = 0; ks < 4; ++ks) qc[hf][ks] = *(const bf16x8*)(qp + hf * 128 + 32 * ks); } }
    for (int it = bid * 8 + w; it < nitems; it += nb * 8) {
        const int h = it & 7, t0 = (it >> 3) * 16;
        bf16x8 qn[2][4];
        { const int itn = it + nb * 8 < nitems ? it + nb * 8 : it;
          const bf16* qp = qry + (size_t)((itn >> 3) * 16 + tk) * PQ + (itn & 7) * 256 + 8 * g;
#pragma unroll
          for (int hf = 0; hf < 2; ++hf)
#pragma unroll
              for (int ks = 0; ks < 4; ++ks) qn[hf][ks] = *(const bf16x8*)(qp + hf * 128 + 32 * ks); }
        float L[2][16];
#pragma unroll
        for (int hf = 0; hf < 2; ++hf) {
            bf16x8 qf[4];
#pragma unroll
            for (int ks = 0; ks < 4; ++ks) qf[ks] = qc[hf][ks];
            float key[32];
#pragma unroll
            for (int tile = 0; tile < 8; ++tile) {
                f32x4 acc = {0.f, 0.f, 0.f, 0.f};
#pragma unroll
                for (int ks = 0; ks < 4; ++ks) {
                    const bf16x8 af = *(const LAS bf16x8*)(lds + (hf * 128 + tile * 16 + tk) * SK_ROW + (32 * ks + 8 * g) * 2);
                    acc = __builtin_amdgcn_mfma_f32_16x16x32_bf16(af, qf[ks], acc, 0, 0, 0);
                }
#pragma unroll
                for (int r = 0; r < 4; ++r) key[tile * 4 + r] = __uint_as_float((__float_as_uint(acc[r]) & 0xffffff80u) | (unsigned)(16 * tile + 4 * g + r));
            }
            float a[16], b[16];
#pragma unroll
            for (int i = 0; i < 16; ++i) { a[i] = key[i]; b[i] = key[16 + i]; }
            bsort16(a); bsort16(b);
            merge_top16(a, b);
            xmerge16(a);
#pragma unroll
            for (int i = 0; i < 16; ++i) L[hf][i] = a[i];
            unsigned pk = 0u;
#pragma unroll
            for (int s = 0; s < 4; ++s) {
                const float v = g == 0 ? a[s] : (g == 1 ? a[4 + s] : (g == 2 ? a[8 + s] : a[12 + s]));
                pk |= (__float_as_uint(v) & 127u) << (8 * s);
            }
            widx[tk * 8 + hf * 4 + g] = pk;
        }
        float c[16];
        c[0] = cand_slot<0>(L[0], L[1], g); c[1] = cand_slot<1>(L[0], L[1], g); c[2] = cand_slot<2>(L[0], L[1], g); c[3] = cand_slot<3>(L[0], L[1], g);
        c[4] = cand_slot<4>(L[0], L[1], g); c[5] = cand_slot<5>(L[0], L[1], g); c[6] = cand_slot<6>(L[0], L[1], g); c[7] = cand_slot<7>(L[0], L[1], g);
        c[8] = cand_slot<8>(L[0], L[1], g); c[9] = cand_slot<9>(L[0], L[1], g); c[10] = cand_slot<10>(L[0], L[1], g); c[11] = cand_slot<11>(L[0], L[1], g);
        c[12] = cand_slot<12>(L[0], L[1], g); c[13] = cand_slot<13>(L[0], L[1], g); c[14] = cand_slot<14>(L[0], L[1], g); c[15] = cand_slot<15>(L[0], L[1], g);
        bsort16(c);
        xmerge16(c);
        float sum = 0.f, ex[16];
#pragma unroll
        for (int i = 0; i < 16; ++i) { ex[i] = __builtin_amdgcn_exp2f((c[i] - c[0]) * L2E); sum += ex[i]; }
        const float inv = 1.0f / sum;
        int oi[4]; float og[4];
#pragma unroll
        for (int s = 0; s < 4; ++s) {
            const float kv = g == 0 ? c[s] : (g == 1 ? c[4 + s] : (g == 2 ? c[8 + s] : c[12 + s]));
            const float ev = g == 0 ? ex[s] : (g == 1 ? ex[4 + s] : (g == 2 ? ex[8 + s] : ex[12 + s]));
            const unsigned pid = __float_as_uint(kv) & 63u;
            const unsigned ij = lds[SEL_TAB_OFF + pid];
            const unsigned i1 = widx8[tk * 32 + (ij >> 4)], i2 = widx8[tk * 32 + 16 + (ij & 15u)];
            oi[s] = (int)(i1 * 128u + i2); og[s] = ev * inv;
        }
        const size_t ob = (size_t)(t0 + tk) * 128 + h * 16 + 4 * g;
        *(u32x4*)(eidx + ob) = (u32x4){(unsigned)oi[0], (unsigned)oi[1], (unsigned)oi[2], (unsigned)oi[3]};
        *(f32x4*)(egate + ob) = (f32x4){og[0], og[1], og[2], og[3]};
#pragma unroll
        for (int hf = 0; hf < 2; ++hf)
#pragma unroll
            for (int ks = 0; ks < 4; ++ks) qc[hf][ks] = qn[hf][ks];
    }
    __syncthreads();
}

typedef float v32f_t __attribute__((ext_vector_type(32)));
typedef unsigned v6u_t __attribute__((ext_vector_type(6)));
typedef unsigned v16u_t __attribute__((ext_vector_type(16)));
typedef __bf16 v32bf_t __attribute__((ext_vector_type(32)));
typedef __bf16 v2bf_t __attribute__((ext_vector_type(2)));
typedef _Float16 v32h_t __attribute__((ext_vector_type(32)));
typedef unsigned u32x3 __attribute__((ext_vector_type(3)));
constexpr int TROW = 768;
__device__ void ph_tab_fp6(const float* src, unsigned char* dst, float* scale, int nrows, int bid, int nb) {
    const int lane = ltid() & 63, w = __builtin_amdgcn_readfirstlane(ltid() >> 6);
    for (int rp = bid * 8 + w; rp < nrows / 2; rp += nb * 8) {
        v32h_t hv; float sc[2];
#pragma unroll
        for (int rr = 0; rr < 2; ++rr) {
            const float* sp = src + (size_t)(2 * rp + rr) * DM + lane * 16;
            f32x4 v[4]; float am = 0.f;
#pragma unroll
            for (int i = 0; i < 4; ++i) { v[i] = *(const f32x4*)(sp + i * 4); am = fmaxf(am, fmaxf(fmaxf(fabsf(v[i][0]), fabsf(v[i][1])), fmaxf(fabsf(v[i][2]), fabsf(v[i][3])))); }
            am = wave_max(am);
            const float s = am > 0.f ? am * (1.0f / 7.5f) : 1.0f, inv = 1.0f / s;
            sc[rr] = s;
#pragma unroll
            for (int i = 0; i < 4; ++i)
#pragma unroll
                for (int e = 0; e < 4; ++e) hv[rr * 16 + i * 4 + e] = (_Float16)fminf(fmaxf(v[i][e] * inv, -7.5f), 7.5f);
        }
        const v6u_t pk = __builtin_amdgcn_cvt_scalef32_pk32_fp6_f16(hv, 1.0f);
        unsigned* d0 = (unsigned*)(dst + (size_t)(2 * rp) * TROW + lane * 12);
        unsigned* d1 = (unsigned*)(dst + (size_t)(2 * rp + 1) * TROW + lane * 12);
        d0[0] = pk[0]; d0[1] = pk[1]; d0[2] = pk[2]; d1[0] = pk[3]; d1[1] = pk[4]; d1[2] = pk[5];
        if (lane == 0) { scale[2 * rp] = sc[0]; scale[2 * rp + 1] = sc[1]; }
    }
}

constexpr int TROW4 = 512;
constexpr int TROWX = 1024;
__device__ void ph_tab_fp4(const float* src, unsigned char* dst  , float* scale, int nrows, int bid, int nb) {
    const int lane = ltid() & 63, w = __builtin_amdgcn_readfirstlane(ltid() >> 6);
    for (int row = bid * 8 + w; row < nrows; row += nb * 8) {
        const float* sp = src + (size_t)row * DM + lane * 16;
        f32x4 v[4]; float am = 0.f;
#pragma unroll
        for (int i = 0; i < 4; ++i) { v[i] = *(const f32x4*)(sp + i * 4); am = fmaxf(am, fmaxf(fmaxf(fabsf(v[i][0]), fabsf(v[i][1])), fmaxf(fabsf(v[i][2]), fabsf(v[i][3])))); }
        am = wave_max(am);
        const float s = am > 0.f ? am * (1.0f / 6.0f) : 1.0f, inv = 1.0f / s;
        unsigned d0 = 0u, d1 = 0u;
        d0 = __builtin_amdgcn_cvt_scalef32_pk_fp4_f32(d0, v[0][0] * inv, v[0][1] * inv, 1.0f, 0); d0 = __builtin_amdgcn_cvt_scalef32_pk_fp4_f32(d0, v[0][2] * inv, v[0][3] * inv, 1.0f, 1);
        d0 = __builtin_amdgcn_cvt_scalef32_pk_fp4_f32(d0, v[1][0] * inv, v[1][1] * inv, 1.0f, 2); d0 = __builtin_amdgcn_cvt_scalef32_pk_fp4_f32(d0, v[1][2] * inv, v[1][3] * inv, 1.0f, 3);
        d1 = __builtin_amdgcn_cvt_scalef32_pk_fp4_f32(d1, v[2][0] * inv, v[2][1] * inv, 1.0f, 0); d1 = __builtin_amdgcn_cvt_scalef32_pk_fp4_f32(d1, v[2][2] * inv, v[2][3] * inv, 1.0f, 1);
        d1 = __builtin_amdgcn_cvt_scalef32_pk_fp4_f32(d1, v[3][0] * inv, v[3][1] * inv, 1.0f, 2); d1 = __builtin_amdgcn_cvt_scalef32_pk_fp4_f32(d1, v[3][2] * inv, v[3][3] * inv, 1.0f, 3);
        *(u32x2*)(dst + (size_t)row * TROWX + lane * 16) = (u32x2){d0, d1};
        if (lane == 0) scale[row] = s;
    }
}

__device__ void ph_tab_i4(const float* src, unsigned char* dst, float* scale, int nrows, int bid, int nb) {
    const int lane = ltid() & 63, w = __builtin_amdgcn_readfirstlane(ltid() >> 6);
    for (int row = bid * 8 + w; row < nrows; row += nb * 8) {
        const float* sp = src + (size_t)row * DM + lane * 16;
        f32x4 v[4]; float am = 0.f;
#pragma unroll
        for (int i = 0; i < 4; ++i) { v[i] = *(const f32x4*)(sp + i * 4); am = fmaxf(am, fmaxf(fmaxf(fabsf(v[i][0]), fabsf(v[i][1])), fmaxf(fabsf(v[i][2]), fabsf(v[i][3])))); }
        am = wave_max(am);
        const float s = am > 0.f ? am * (1.0f / 7.0f) : 1.0f, inv = 1.0f / s;
        unsigned d[2] = {0u, 0u};
#pragma unroll
        for (int i = 0; i < 16; ++i) { const int q = (int)rintf(fminf(fmaxf(v[i >> 2][i & 3] * inv, -7.0f), 7.0f)); d[i >> 3] |= ((unsigned)q & 15u) << (4 * (i & 7)); }
        *(u32x2*)(dst + (size_t)row * TROWX + lane * 16) = (u32x2){d[0], d[1]};
        if (lane == 0) scale[row] = s;
    }
}

#define DPP_ADD(v, ctrl) ((v) + __builtin_bit_cast(float, __builtin_amdgcn_update_dpp(0, __builtin_bit_cast(int, (v)), (ctrl), 0xf, 0xf, true)))
typedef int i32x4_t __attribute__((ext_vector_type(4)));
constexpr int GT = 2;
typedef int v8i_t __attribute__((ext_vector_type(8)));
typedef int v2i_t __attribute__((ext_vector_type(2)));
struct GSet { u32x2 uq[4]; u32x2 vq[4]; };
__device__ __forceinline__ void gather_issue(GSet& S, int bt, int lane, const unsigned char* pu, const unsigned char* pv, const LAS int* etok) {
    const i32x4_t ev = *(const LAS i32x4_t*)(etok + bt * 4);
    const int es[4] = {ev.x, ev.y, ev.z, ev.w};
#pragma unroll
    for (int k = 0; k < 2; ++k) {
        const unsigned f0 = (unsigned)es[2 * k] * (unsigned)TROWX + (unsigned)lane * 16u, f1 = (unsigned)es[2 * k + 1] * (unsigned)TROWX + (unsigned)lane * 16u;
        const u32x4 r0 = *(const u32x4*)(pu + f0), r1 = *(const u32x4*)(pu + f1);
        S.uq[2 * k] = (u32x2){r0.x, r0.y}; S.vq[2 * k] = (u32x2){r0.z, r0.w}; S.uq[2 * k + 1] = (u32x2){r1.x, r1.y}; S.vq[2 * k + 1] = (u32x2){r1.z, r1.w};
    }
}
constexpr int GV_ROW = 520;
constexpr int GV_BYTES = 16 * GV_ROW, GC_BYTES = 96;
__device__ __forceinline__ float gather_udot(const GSet& S, const unsigned (&hd)[4], LAS unsigned char* vrow) {
    int d[4];
#pragma unroll
    for (int k = 0; k < 4; ++k) {
        const int q0 = (int)S.uq[k].x, q1 = (int)S.uq[k].y;
        int a1, a2;
        asm("v_dot8_i32_i4 %0, %1, %2, 0" : "=v"(a1) : "v"(q0), "v"(hd[0]));
        asm("v_dot8_i32_i4 %0, %1, %2, 0" : "=v"(a2) : "v"(q0), "v"(hd[2]));
        a1 = __builtin_amdgcn_sdot8(q1, (int)hd[1], a1, false); a2 = __builtin_amdgcn_sdot8(q1, (int)hd[3], a2, false);
        d[k] = (a1 << 4) + a2;
    }
#pragma unroll
    for (int k = 0; k < 4; ++k) *(LAS u32x2*)(vrow + k * GV_ROW) = S.vq[k];
    int e2[2], f1;
#pragma unroll
    for (int k = 0; k < 2; ++k) { auto r = __builtin_amdgcn_permlane16_swap((unsigned)d[k], (unsigned)d[k + 2], false, false); e2[k] = (int)r[0] + (int)r[1]; }
    { auto r = __builtin_amdgcn_permlane32_swap((unsigned)e2[0], (unsigned)e2[1], false, false); f1 = (int)r[0] + (int)r[1]; }
    f1 += __builtin_amdgcn_update_dpp(0, f1, 0xB1, 0xf, 0xf, true); f1 += __builtin_amdgcn_update_dpp(0, f1, 0x4E, 0xf, 0xf, true);
    f1 += __builtin_amdgcn_update_dpp(0, f1, 0x124, 0xf, 0xf, true); f1 += __builtin_amdgcn_update_dpp(0, f1, 0x128, 0xf, 0xf, true);
    return (float)f1;
}
#define DPP_MAX(v, ctrl) fmaxf((v), __builtin_bit_cast(float, __builtin_amdgcn_update_dpp(0, __builtin_bit_cast(int, (v)), (ctrl), 0xf, 0xf, true)))
__device__ __forceinline__ void gather_vpart(float f0, float f1, float f2, float f3, int lane, int kslot, const LAS float* lg  ,
                                             const LAS unsigned char* vrd  , LAS unsigned char* cb, int aoff1, int aoff2, f32x4 (&acc)[8]) {
    const int q = (lane >> 2) & 3, e16 = 4 * q + kslot;
    const float fs = q == 0 ? f0 : q == 1 ? f1 : q == 2 ? f2 : f3;
    const float cv = lg[e16] * gelu_erf(fs * lg[GT * 128 + e16]);
    float mx = fabsf(cv);
    mx = DPP_MAX(mx, 0x124); mx = DPP_MAX(mx, 0x128);
    { auto r = __builtin_amdgcn_permlane16_swap(__float_as_uint(mx), __float_as_uint(mx), false, false); mx = fmaxf(__uint_as_float(r[0]), __uint_as_float(r[1])); }
    { auto r = __builtin_amdgcn_permlane32_swap(__float_as_uint(mx), __float_as_uint(mx), false, false); mx = fmaxf(__uint_as_float(r[0]), __uint_as_float(r[1])); }
    int E = (int)((__float_as_uint(mx) >> 23) & 0xffu); E = E < 8 ? 8 : E;
    const float x = cv * __uint_as_float((unsigned)(255 - E) << 23);
    const unsigned p1 = __builtin_amdgcn_cvt_scalef32_pk_fp4_f32(0u, x, 0.f, 1.0f, 0);
    const float r1 = x - __builtin_amdgcn_cvt_scalef32_pk_f32_fp4(p1, 1.0f, 0)[0];
    const unsigned p2 = __builtin_amdgcn_cvt_scalef32_pk_fp4_f32(0u, r1, 0.f, 1.0f, 0);
    const float y = (r1 - __builtin_amdgcn_cvt_scalef32_pk_f32_fp4(p2, 1.0f, 0)[0]) * 16.0f;
    const unsigned p3 = __builtin_amdgcn_cvt_scalef32_pk_fp4_f32(0u, y, 0.f, 1.0f, 0);
    const float r3 = y - __builtin_amdgcn_cvt_scalef32_pk_f32_fp4(p3, 1.0f, 0)[0];
    const unsigned p4 = __builtin_amdgcn_cvt_scalef32_pk_fp4_f32(0u, r3, 0.f, 1.0f, 0);
    const unsigned codes = (p1 & 15u) | ((p2 & 15u) << 8) | ((p3 & 15u) << 16) | ((p4 & 15u) << 24);
    { auto r = __builtin_amdgcn_permlane32_swap(codes, codes, false, false);
      const unsigned w = codes | ((r[0] ^ r[1] ^ codes) << 4);
      if (lane < 32 && (lane & 3) == 0) {
          LAS unsigned char* tb = cb + 8 + 2 * q + ((lane >> 4) & 1);
          tb[0] = (unsigned char)w; tb[16] = (unsigned char)(w >> 8); tb[32] = (unsigned char)(w >> 16); tb[48] = (unsigned char)(w >> 24);
      } }
    const u32x2 a10 = *(const LAS u32x2*)(cb + aoff1), a11 = *(const LAS u32x2*)(cb + aoff1 + 8), a20 = *(const LAS u32x2*)(cb + aoff2), a21 = *(const LAS u32x2*)(cb + aoff2 + 8);
    const v8i_t A1 = {(int)a10.x, (int)a10.y, (int)a11.x, (int)a11.y, 0, 0, 0, 0}, A2 = {(int)a20.x, (int)a20.y, (int)a21.x, (int)a21.y, 0, 0, 0, 0};
    const int sa1 = (E - 1) * 0x01010101, sa2 = (E - 5) * 0x01010101;
#pragma unroll
    for (int m = 0; m < 8; ++m) {
        const v2i_t t0 = __builtin_amdgcn_ds_read_tr4_b64_v2i32((LAS v2i_t*)(vrd + 16 * m)), t1 = __builtin_amdgcn_ds_read_tr4_b64_v2i32((LAS v2i_t*)(vrd + 16 * m + 8));
        const v8i_t B = {t0.x, t0.y, t1.x, t1.y, 0, 0, 0, 0};
        acc[m] = __builtin_amdgcn_mfma_scale_f32_16x16x128_f8f6f4(A1, B, acc[m], 4, 4, 0, sa1, 0, 0x7F7F7F7F);
        acc[m] = __builtin_amdgcn_mfma_scale_f32_16x16x128_f8f6f4(A2, B, acc[m], 4, 4, 0, sa2, 0, 0x7F7F7F7F);
    }
}
__device__ __forceinline__ void xcd_pace(unsigned* bar, volatile LAS unsigned* st);
constexpr int GNS = 8, GBPS = 32 / GNS, GSHIFT = 11;
constexpr int GATH_LDS_WAVE = GT * 128 * 12 + GV_BYTES + GC_BYTES;
#define GATH_SEG(J, NJ, nbt) { \
        const LAS int* le_ = lse + (J) * 128; const LAS int* ne_ = lse + (NJ) * 128; \
        gather_issue(D, GBPS * c + 3, lane, pu, pv, le_); \
        const float f0_ = hsc[J] * gather_udot(A, hd[J], vwr); \
        gather_issue(A, (nbt), lane, pu, pv, ne_); \
        const float f1_ = hsc[J] * gather_udot(B, hd[J], vwr + 4 * GV_ROW); \
        gather_issue(B, (nbt) + 1, lane, pu, pv, ne_); \
        const float f2_ = hsc[J] * gather_udot(C, hd[J], vwr + 8 * GV_ROW); \
        gather_issue(C, (nbt) + 2, lane, pu, pv, ne_); \
        const float f3_ = hsc[J] * gather_udot(D, hd[J], vwr + 12 * GV_ROW); \
        gather_vpart(f0_, f1_, f2_, f3_, lane, kslot, lsg + (J) * 128 + 16 * c, vrd, cb, aoff1, aoff2, acc[J]); }
__device__ void ph_peer_gather(const bf16* h2, const unsigned char* pu, const unsigned char* pv, const float* su, const float* sv,
                               const int* eidx, const float* egate, const bf16* xin  , const float* gate  , float* xout, LAS unsigned char* lds, unsigned* pace_bar, volatile LAS unsigned* pace_st, int bid, int nb,
                               bf16* xmid  ) {
    const int lane0 = ltid() & 63, w = __builtin_amdgcn_readfirstlane(ltid() >> 6);
    LAS int* lse = (LAS int*)(lds + w * GATH_LDS_WAVE); LAS float* lsg = (LAS float*)(lds + w * GATH_LDS_WAVE + GT * 128 * 4);
    LAS unsigned char* vb = lds + w * GATH_LDS_WAVE + GT * 128 * 12; LAS unsigned char* cb = vb + GV_BYTES;
    if (lane0 < GC_BYTES / 4) ((LAS unsigned*)cb)[lane0] = 0u;
    for (int t0 = (bid * 8 + w) * GT; t0 < MT; t0 += nb * 8 * GT) {
        int lane = lane0; asm volatile("" : "+v"(lane));
        const int row = lane >> 4;
        const int kslot = 2 * (row & 1) + (row >> 1);
        const int b = t0 >> 11;
        LAS unsigned char* vwr = vb + lane * 8;
        const LAS unsigned char* vrd = vb + (lane & 15) * GV_ROW + 128 * row;
        const int ai = lane & 15, au = (ai < 8 ? 1 : 3), nz = ((ai & 7) >> 1) == row;
        const int aoff1 = nz ? 8 * (au - (ai & 1)) : 64, aoff2 = nz ? 8 * (au + 4 - (ai & 1)) : 64;
        unsigned hd[GT][4]; float hsc[GT]; f32x4 acc[GT][8];
#pragma unroll
        for (int j = 0; j < GT; ++j) {
            const int t = t0 + j;
            const int e0 = eidx[(size_t)t * 128 + lane], e1 = eidx[(size_t)t * 128 + 64 + lane];
            const float g0 = egate[(size_t)t * 128 + lane], g1 = egate[(size_t)t * 128 + 64 + lane];
            const int k0 = e0 >> GSHIFT, k1 = e1 >> GSHIFT;
            int off = 0, d0 = 0, d1 = 0;
#pragma unroll
            for (int s = 0; s < GNS; ++s) {
                const unsigned long long m0 = __ballot(k0 == s), m1 = __ballot(k1 == s);
                const int r0 = (int)__builtin_amdgcn_mbcnt_hi((unsigned)(m0 >> 32), __builtin_amdgcn_mbcnt_lo((unsigned)m0, 0u));
                const int r1 = (int)__builtin_amdgcn_mbcnt_hi((unsigned)(m1 >> 32), __builtin_amdgcn_mbcnt_lo((unsigned)m1, 0u));
                const int c0 = __builtin_popcountll(m0);
                if (k0 == s) d0 = off + r0;
                if (k1 == s) d1 = off + c0 + r1;
                off += c0 + __builtin_popcountll(m1);
            }
            lse[j * 128 + d0] = e0; lsg[j * 128 + d0] = g0 * sv[e0]; lse[j * 128 + d1] = e1; lsg[j * 128 + d1] = g1 * sv[e1];
            lsg[GT * 128 + j * 128 + d0] = su[e0]; lsg[GT * 128 + j * 128 + d1] = su[e1];
            const u32x4 u0 = *(const u32x4*)(h2 + (size_t)t * DM + lane * 16), u1 = *(const u32x4*)(h2 + (size_t)t * DM + lane * 16 + 8);
            {
                float hf[16];
#pragma unroll
                for (int i = 0; i < 4; ++i) { hf[2 * i] = __uint_as_float(u0[i] << 16); hf[2 * i + 1] = __uint_as_float(u0[i] & 0xffff0000u); hf[8 + 2 * i] = __uint_as_float(u1[i] << 16); hf[8 + 2 * i + 1] = __uint_as_float(u1[i] & 0xffff0000u); }
                float mh = 0.f;
#pragma unroll
                for (int i = 0; i < 16; ++i) mh = fmaxf(mh, fabsf(hf[i]));
                mh = wave_max(mh);
                int Eh = (int)((__float_as_uint(mh) >> 23) & 0xffu); Eh = Eh < 8 ? 8 : Eh;
                const float up = __uint_as_float((unsigned)(255 - Eh) << 23);
                hsc[j] = __uint_as_float((unsigned)(Eh - 5) << 23);
                unsigned p1[2] = {0u, 0u}, p2[2] = {0u, 0u};
#pragma unroll
                for (int i = 0; i < 16; ++i) {
                    const float x = hf[i] * up, r1 = rintf(x);
                    int q2 = (int)rintf((x - r1) * 16.0f); q2 = q2 > 7 ? 7 : q2;
                    p1[i >> 3] |= ((unsigned)(int)r1 & 15u) << (4 * (i & 7)); p2[i >> 3] |= ((unsigned)q2 & 15u) << (4 * (i & 7));
                }
                hd[j][0] = p1[0]; hd[j][1] = p1[1]; hd[j][2] = p2[0]; hd[j][3] = p2[1];
            }
#pragma unroll
            for (int i = 0; i < 8; ++i) acc[j][i] = (f32x4){0.f, 0.f, 0.f, 0.f};
        }
        GSet A, B, C, D;
        gather_issue(A, 0, lane, pu, pv, lse); gather_issue(B, 1, lane, pu, pv, lse); gather_issue(C, 2, lane, pu, pv, lse);
#pragma unroll 1
        for (int c = 0; c < GNS; ++c) {
            GATH_SEG(0, 1, GBPS * c)
            GATH_SEG(1, 0, c < GNS - 1 ? GBPS * c + GBPS : 0)
        }
#pragma unroll
        for (int j = 0; j < GT; ++j) {
            const int t = t0 + j;
            LAS float* ob = (LAS float*)vb;
            const int nbase = 512 * (row & 1) + 32 * (row >> 1) + (lane & 15);
#pragma unroll
            for (int pm = 0; pm < 4; ++pm)
#pragma unroll
                for (int r = 0; r < 4; ++r) {
                    auto sw = __builtin_amdgcn_permlane32_swap(__float_as_uint(acc[j][2 * pm][r]), __float_as_uint(acc[j][2 * pm + 1][r]), false, false);
                    ob[nbase + 256 * (r >> 1) + 64 * pm + 16 * (r & 1)] = __uint_as_float(sw[0]) + __uint_as_float(sw[1]);
                }
#pragma unroll
            for (int i = 0; i < 4; ++i) {
                const int cc = i * 256 + lane * 4;
                const f32x4 a = *(const LAS f32x4*)(ob + cc);
                const u32x2 xq = *(const u32x2*)(xin + (size_t)t * DM + cc); const f32x4 gt = *(const f32x4*)(gate + (size_t)b * 6144 + cc);
                const f32x4 xi = {__uint_as_float(xq.x << 16), __uint_as_float(xq.x & 0xffff0000u), __uint_as_float(xq.y << 16), __uint_as_float(xq.y & 0xffff0000u)};
                f32x4 o;
#pragma unroll
                for (int e = 0; e < 4; ++e) o[e] = xi[e] + gt[e] * a[e];
                if (xmid) { u32x2 pk; pk.x = pk2(o[0], o[1]); pk.y = pk2(o[2], o[3]); *(u32x2*)(xmid + (size_t)t * DM + cc) = pk; }
                else __builtin_nontemporal_store(o, (f32x4*)(xout + (size_t)t * DM + cc));
            }
        }
    }
}

#define XB_TMO      128
#define XB_XCNT(j)  (256  + 64 * (j))
#define XB_XSUB(j)  (1280 + 64 * (j))
#define XB_XGEN(j)  (2304 + 64 * (j))
#define XB_TOP      3328
#define XB_TOPGEN   3392
#define XCD_BAR_WORDS 3456
#define XB_SPIN_CAP (1u << 18)

__device__ __forceinline__ unsigned xb_ld(unsigned* p)              { return __hip_atomic_load(p, __ATOMIC_RELAXED, __HIP_MEMORY_SCOPE_AGENT); }
__device__ __forceinline__ unsigned xb_add(unsigned* p, unsigned v) { return __hip_atomic_fetch_add(p, v, __ATOMIC_RELAXED, __HIP_MEMORY_SCOPE_AGENT); }
__device__ __forceinline__ unsigned xb_xcc_id() { return (unsigned)__builtin_amdgcn_s_getreg((3 << 11) | 20) & 0xFu; }
#define XB_SPIN(cond, bar) do { unsigned _sp = 0; while (cond) { __builtin_amdgcn_s_sleep(1); \
    if ((++_sp & 255u) == 0u) { if (xb_ld(&(bar)[XB_TMO])) break; if (_sp > XB_SPIN_CAP) { atomicAdd(&(bar)[XB_TMO], 1u); break; } } } } while (0)

struct XcdBarrier {
    unsigned* bar; unsigned x;
    volatile LAS unsigned* st;
};

__device__ __forceinline__ XcdBarrier xcd_barrier_post(unsigned* bar, volatile LAS unsigned* st) {
    XcdBarrier b; b.bar = bar; b.x = xb_xcc_id(); b.st = st;
    if (threadIdx.x == 0) (void)xb_add(&bar[XB_XCNT(b.x)], 1u);
    return b;
}
__device__ __forceinline__ void xcd_barrier_complete(unsigned* bar, unsigned x, unsigned& nloc, unsigned& nx) {
    const unsigned G = gridDim.x * gridDim.y * gridDim.z;
    unsigned sum, cnt, mine, sp = 0u;
    for (;;) {
        sum = 0u; cnt = 0u; mine = 0u;
#pragma unroll
        for (unsigned j = 0; j < 16; ++j) { const unsigned c = xb_ld(&bar[XB_XCNT(j)]); sum += c; cnt += (c > 0u) ? 1u : 0u; mine = (j == x) ? c : mine; }
        if (sum == G) break;
        __builtin_amdgcn_s_sleep(1);
        if ((++sp & 255u) == 0u) { if (xb_ld(&bar[XB_TMO])) break; if (sp > XB_SPIN_CAP) { atomicAdd(&bar[XB_TMO], 1u); break; } }
    }
    nloc = mine > 0u ? mine : 1u; nx = cnt > 0u ? cnt : 1u;
}

__device__ __forceinline__ void xcd_barrier(const XcdBarrier& b) {
    asm volatile("s_waitcnt vmcnt(0)" ::: "memory");
    __syncthreads();
    if (threadIdx.x == 0) {
        unsigned* bar = b.bar;
        __builtin_amdgcn_s_waitcnt(0);
        unsigned nloc = b.st[0], nx = b.st[1];
        if (nloc == 0u) { xcd_barrier_complete(bar, b.x, nloc, nx); b.st[0] = nloc; b.st[1] = nx; }
        const unsigned old = xb_add(&bar[XB_XSUB(b.x)], 1u);
        const unsigned gen = old / nloc;
        if (old + 1u == (gen + 1u) * nloc) {
            __builtin_amdgcn_fence(__ATOMIC_RELEASE, "agent");
            asm volatile("s_waitcnt vmcnt(0)" ::: "memory");
            const unsigned og = xb_add(&bar[XB_TOP], 1u);
            const unsigned tg = og / nx;
            if (og + 1u == (tg + 1u) * nx) xb_add(&bar[XB_TOPGEN], 1u);
            else XB_SPIN(xb_ld(&bar[XB_TOPGEN]) == tg, bar);
            __builtin_amdgcn_fence(__ATOMIC_ACQUIRE, "agent");
            xb_add(&bar[XB_XGEN(b.x)], 1u);
            asm volatile("s_waitcnt vmcnt(0)" ::: "memory");
        } else {
            XB_SPIN(xb_ld(&bar[XB_XGEN(b.x)]) == gen, bar);
            __builtin_amdgcn_fence(__ATOMIC_ACQUIRE, "agent");
            asm volatile("s_waitcnt vmcnt(0)" ::: "memory");
        }
    }
    __syncthreads();
}


#define XB_PACE(j) (3584 + 64 * (j))
__device__ __forceinline__ void xcd_pace(unsigned* bar, volatile LAS unsigned* st) {
    __syncthreads();
    if (threadIdx.x == 0) {
        const unsigned nloc = st[0] ? st[0] : 1u, x = xb_xcc_id(), gen = st[4] + 1u;
        st[4] = gen;
        xb_add(&bar[XB_PACE(x)], 1u);
        unsigned sp = 0;
        while (xb_ld(&bar[XB_PACE(x)]) < gen * nloc) { __builtin_amdgcn_s_sleep(1); if (++sp > (1u << 16)) break; }
    }
    __syncthreads();
}
extern __shared__ __attribute__((aligned(16))) unsigned char dyn_lds[];
#ifndef REP_PREP
#define REP_PREP 1
#endif
#ifndef REP_ATTN
#define REP_ATTN 1
#endif
#ifndef REP_SEL
#define REP_SEL 1
#endif
#ifndef REP_GATH
#define REP_GATH 1
#endif
#ifndef REP_GEMM
#define REP_GEMM 1
#endif
#ifndef REP_ADALN
#define REP_ADALN 1
#endif
constexpr int LDS_BYTES = 147456;

template <class T> __device__ __forceinline__ T* karg(int byte_off) {
    const __attribute__((address_space(4))) char* base = (const __attribute__((address_space(4))) char*)__builtin_amdgcn_kernarg_segment_ptr();
    unsigned long long v = *(const __attribute__((address_space(4))) unsigned long long*)(base + byte_off);
    asm volatile("" : "+s"(v));
    return (T*)(__attribute__((address_space(1))) T*)v;
}
#define KIN(i) karg<const float>(8 * (i))
#define KOUT() karg<float>(168)
#define KWS() karg<unsigned char>(176)
static_assert(sizeof(Params) == 184, "Params layout");
template <class T> __device__ __forceinline__ T* launder(T* p) { size_t off = 0; asm volatile("" : "+s"(off)); return (T*)((unsigned char*)p + off); }
__global__ void __launch_bounds__(NT) mega_fwd(Params p) {
    cg::grid_group grid = cg::this_grid();
    const int bid = blockIdx.x, nb = gridDim.x;
    volatile LAS unsigned* bst = (volatile LAS unsigned*)((LAS unsigned char*)dyn_lds + LDS_BYTES - 64);
    if (ltid() < 16) bst[ltid()] = 0u;
    __syncthreads();
    const XcdBarrier xbar = xcd_barrier_post((unsigned*)(KWS() + WS_BAR), bst);
    for (int rep = 0; rep < REP_PREP; ++rep) {
        unsigned char* ws = KWS();
        float* tile = (float*)dyn_lds;
        ph_transpose(KIN(6), (bf16*)(ws + WS_WIN0), 1024, AB_IN, true, tile, bid, nb);
        ph_transpose(KIN(11), (bf16*)(ws + WS_WIN1), 1024, CD_IN, true, tile, bid, nb);
        ph_transpose(KIN(7), (bf16*)(ws + WS_WO0), 1024, 1024, false, tile, bid, nb);
        ph_transpose(KIN(12), (bf16*)(ws + WS_WO1), 1024, 1024, false, tile, bid, nb);
        ph_transpose(KIN(17), (bf16*)(ws + WS_WQ), 1024, PQ, false, tile, bid, nb);
        ph_transpose(KIN(17) + (size_t)1024 * PQ, (bf16*)(ws + WS_WQ) + (size_t)PQ * 1024, 1024, PQ, false, tile, bid, nb);
        ws = launder(ws);
        ph_tab_i4(KIN(19), ws + WS_PU, (float*)(ws + WS_PV), 2 * NEXP, bid, nb);
        ph_tab_fp4(KIN(20), ws + WS_PU + 8, (float*)(ws + WS_PV + 1 * MiB), 2 * NEXP, bid, nb);
        ws = launder(ws);
        ph_mod(KIN(1), KIN(2), KIN(3), (float*)(ws + WS_MOD), (float*)dyn_lds, bid, nb);
        ph_rope_table((float*)(ws + WS_ROPE), bid, nb);
        for (int i = bid * NT + ltid(); i < NB * 8 * 8 * 64; i += nb * NT) ((float*)(ws + WS_KMEAN))[i] = 0.f;
    }
    grid.sync();
#pragma unroll 1
    for (int layer = 0; layer < 2; ++layer) {
        for (int rep = 0; rep < REP_ADALN; ++rep) {
            unsigned char* ws = KWS(); const float* mod = (const float*)(ws + WS_MOD) + (size_t)layer * 32 * 6144;
            if (layer == 0) ph_adaln<false>(KIN(0), KIN(4), mod + 0, mod + 1024, (bf16*)(ws + WS_HY), bid, nb);
            else ph_adaln<true>(ws + WS_X1 + 128 * MiB, KIN(4) + DM, mod + 0, mod + 1024, (bf16*)(ws + WS_HY), bid, nb);
        }
        xcd_barrier(xbar);
        for (int rep = 0; rep < REP_GEMM; ++rep) {
            unsigned char* ws = KWS();
            pg8::Gemm g{(const bf16*)(ws + WS_HY), (const bf16*)(ws + (layer == 0 ? WS_WIN0 : WS_WIN1)), MT, layer == 0 ? AB_IN : CD_IN, DM};
            pg8::StaticOrder S; S.init(g.M, g.N, nb, bid);
            pg8::EpiQKV e{(bf16*)(ws + WS_QKV), QKV_LD, (const float*)(ws + WS_ROPE), layer, layer == 0 ? KIN(9) : KIN(13), layer == 0 ? KIN(10) : KIN(14), KIN(15), KIN(16), (float*)(ws + WS_KMEAN)};
            pg8::gemm_phase<pg8::EpiQKV, pg8::StaticOrder, true, true>((LAS unsigned char*)dyn_lds, g, S, e);
        }
        xcd_barrier(xbar);
        for (int rep = 0; rep < REP_ATTN; ++rep) {
            unsigned char* ws = KWS();
            if (layer == 0) ph_attn0((const bf16*)(ws + WS_QKV), KIN(8), (bf16*)(ws + WS_HY), (LAS unsigned char*)dyn_lds, bid, nb);
            else ph_attn1((const bf16*)(ws + WS_QKV), (const float*)(ws + WS_KMEAN), (bf16*)(ws + WS_HY), (LAS unsigned char*)dyn_lds, bid, nb);
        }
        xcd_barrier(xbar);
        for (int rep = 0; rep < REP_GEMM; ++rep) {
            unsigned char* ws = KWS(); const float* mod = (const float*)(ws + WS_MOD) + (size_t)layer * 32 * 6144;
            pg8::Gemm g{(const bf16*)(ws + WS_HY), (const bf16*)(ws + (layer == 0 ? WS_WO0 : WS_WO1)), MT, DM, DM};
            pg8::StaticOrder S; S.init(g.M, g.N, nb, bid);
            if (layer == 0) { pg8::EpiResid<false> e{KIN(0), (pg8::bf16_t*)(ws + WS_X1), mod + 2048}; pg8::gemm_phase<pg8::EpiResid<false>, pg8::StaticOrder, true, true>((LAS unsigned char*)dyn_lds, g, S, e); }
            else { pg8::EpiResid<true> e{ws + WS_X1 + 128 * MiB, (pg8::bf16_t*)(ws + WS_X1), mod + 2048}; pg8::gemm_phase<pg8::EpiResid<true>, pg8::StaticOrder, true, true>((LAS unsigned char*)dyn_lds, g, S, e); }
        }
        xcd_barrier(xbar);
        for (int rep = 0; rep < REP_ADALN; ++rep) {
            unsigned char* ws = KWS(); const float* mod = (const float*)(ws + WS_MOD) + (size_t)layer * 32 * 6144;
            ph_adaln<true>(ws + WS_X1, KIN(5) + layer * DM, mod + 3072, mod + 4096, (bf16*)(ws + WS_QKV), bid, nb);
        }
        xcd_barrier(xbar);
        for (int rep = 0; rep < REP_GEMM; ++rep) {
            unsigned char* ws = KWS();
            pg8::Gemm g{(const bf16*)(ws + WS_QKV), (const bf16*)(ws + WS_WQ) + (size_t)layer * PQ * DM, MT, PQ, DM};
            pg8::StaticOrder S; S.init(g.M, g.N, nb, bid); pg8::EpiStore e{(bf16*)(ws + WS_QKV + 128 * MiB), PQ};
            pg8::gemm_phase<pg8::EpiStore, pg8::StaticOrder, true, true>((LAS unsigned char*)dyn_lds, g, S, e);
        }
        xcd_barrier(xbar);
        for (int rep = 0; rep < REP_SEL; ++rep) {
            unsigned char* ws = KWS();
            ph_peer_select((const bf16*)(ws + WS_QKV + 128 * MiB), KIN(18) + (size_t)layer * 2 * 128 * 128, (int*)(ws + WS_HY), (float*)(ws + WS_HY + 32 * MiB), (LAS unsigned char*)dyn_lds, bid, nb);
        }
        xcd_barrier(xbar);
        for (int rep = 0; rep < REP_GATH; ++rep) {
            unsigned char* ws = KWS(); const float* mod = (const float*)(ws + WS_MOD) + (size_t)layer * 32 * 6144;
            ph_peer_gather((const bf16*)(ws + WS_QKV), ws + WS_PU + (size_t)layer * NEXP * TROWX, ws + WS_PU + (size_t)layer * NEXP * TROWX,
                           (const float*)(ws + WS_PV) + layer * NEXP, (const float*)(ws + WS_PV + 1 * MiB) + layer * NEXP, (const int*)(ws + WS_HY), (const float*)(ws + WS_HY + 32 * MiB), (const bf16*)(ws + WS_X1), mod + 5120, KOUT(), (LAS unsigned char*)dyn_lds, (unsigned*)(ws + WS_BAR), bst, bid, nb, layer == 0 ? (bf16*)(ws + WS_X1 + 128 * MiB) : (bf16*)nullptr);
        }
        if (layer == 0) xcd_barrier(xbar);
    }
}

extern "C" void kernel_launch(void* const* d_in, const int* in_sizes, int n_in, void* d_out, int out_size, void* d_ws, size_t ws_size, hipStream_t stream) {
    if (n_in != 21 || ws_size < WS_END) { fprintf(stderr, "kernel_launch: bad args n_in=%d ws=%zu\n", n_in, ws_size); return; }
    static int grid_blocks = 0;
    if (!grid_blocks) {
        int dev = 0, cus = 0, per_cu = 0;
        (void)hipGetDevice(&dev);
        (void)hipDeviceGetAttribute(&cus, hipDeviceAttributeMultiprocessorCount, dev);
        (void)hipFuncSetAttribute((const void*)mega_fwd, hipFuncAttributeMaxDynamicSharedMemorySize, LDS_BYTES);
        (void)hipOccupancyMaxActiveBlocksPerMultiprocessor(&per_cu, (const void*)mega_fwd, NT, LDS_BYTES);
        if (per_cu < 1) { fprintf(stderr, "kernel_launch: occupancy query returned %d\n", per_cu); per_cu = 1; }
        if (per_cu > 1) per_cu = 1;
        grid_blocks = cus * per_cu;
    }
    Params p{};
    for (int i = 0; i < 21; ++i) p.in[i] = (const float*)d_in[i];
    p.out = (float*)d_out; p.ws = (unsigned char*)d_ws;
    (void)hipMemsetAsync((char*)d_ws + WS_BAR, 0, 16384, stream);
    void* args[] = {&p};
    hipError_t e = hipLaunchCooperativeKernel((const void*)mega_fwd, dim3(grid_blocks), dim3(NT), args, LDS_BYTES, stream);
    if (e != hipSuccess) fprintf(stderr, "cooperative launch failed: %s (grid %d)\n", hipGetErrorString(e), grid_blocks);
}
```

```cpp
#include <hip/hip_runtime.h>
#ifndef REP_A
#define REP_A 1
#endif
#ifndef REP_B
#define REP_B 1
#endif
#ifndef REP_C
#define REP_C 1
#endif
#ifndef REP_D
#define REP_D 1
#endif
#include <hip/hip_cooperative_groups.h>
namespace cg = cooperative_groups;
#include <cstdio>
#include <cstdint>
#include <cmath>

typedef unsigned short bf16;
typedef short bf16x8 __attribute__((ext_vector_type(8)));
typedef float f32x4 __attribute__((ext_vector_type(4)));
typedef unsigned u32x4 __attribute__((ext_vector_type(4)));
typedef unsigned u32x2 __attribute__((ext_vector_type(2)));

constexpr int DM = 1024, NB = 32, SQ = 2048, MT = NB * SQ;
constexpr int HD = 64;
constexpr int AB_IN = 2304, CD_IN = 3072, QKV_LD = 3072;
constexpr int NEXP = 16384, PQ = 2048;
constexpr float EPS = 1e-6f;
constexpr int NT = 512;

constexpr size_t MiB = 1u << 20;
constexpr size_t WS_X1 = 0;
constexpr size_t WS_QKV = 256 * MiB;
constexpr size_t WS_HY = 640 * MiB;
constexpr size_t WS_PU = 768 * MiB;
constexpr size_t WS_PV = 832 * MiB;
constexpr size_t WS_WIN0 = 896 * MiB;
constexpr size_t WS_WIN1 = 901 * MiB;
constexpr size_t WS_WO0 = 907 * MiB;
constexpr size_t WS_WO1 = 909 * MiB;
constexpr size_t WS_WQ = 911 * MiB;
constexpr size_t WS_MOD = 919 * MiB;
constexpr size_t WS_ROPE = 921 * MiB;
constexpr size_t WS_KMEAN = 922 * MiB;
constexpr size_t WS_BAR = 923 * MiB;
constexpr size_t WS_END = 924 * MiB;

struct Params {
    const float* in[21];
    float* out;
    unsigned char* ws;
};

__device__ __forceinline__ int ltid() { int t = (int)__builtin_amdgcn_workitem_id_x(); asm volatile("" : "+v"(t)); return t; }
__device__ __forceinline__ float bf2f(unsigned b) { return __uint_as_float(b << 16); }
__device__ __forceinline__ unsigned f2bf(float f) { unsigned u = __float_as_uint(f); return (u + 0x7fffu + ((u >> 16) & 1u)) >> 16; }
__device__ __forceinline__ unsigned pk2(float lo, float hi) { return f2bf(lo) | (f2bf(hi) << 16); }
#define DPPV(v, ctrl) __builtin_bit_cast(float, __builtin_amdgcn_update_dpp(0, __builtin_bit_cast(int, (v)), (ctrl), 0xf, 0xf, true))
__device__ __forceinline__ float row16_sum(float v) { v += DPPV(v, 0xB1); v += DPPV(v, 0x4E); v += DPPV(v, 0x124); v += DPPV(v, 0x128); return v; }
__device__ __forceinline__ float rows_sum(float v) {
    { auto r = __builtin_amdgcn_permlane16_swap(__float_as_uint(v), __float_as_uint(v), false, false); v = __uint_as_float(r[0]) + __uint_as_float(r[1]); }
    { auto r = __builtin_amdgcn_permlane32_swap(__float_as_uint(v), __float_as_uint(v), false, false); v = __uint_as_float(r[0]) + __uint_as_float(r[1]); }
    return v;
}
__device__ __forceinline__ float wave_sum(float v) { return rows_sum(row16_sum(v)); }
__device__ __forceinline__ float wave_max(float v) {
    v = fmaxf(v, DPPV(v, 0xB1)); v = fmaxf(v, DPPV(v, 0x4E)); v = fmaxf(v, DPPV(v, 0x124)); v = fmaxf(v, DPPV(v, 0x128));
    { auto r = __builtin_amdgcn_permlane16_swap(__float_as_uint(v), __float_as_uint(v), false, false); v = fmaxf(__uint_as_float(r[0]), __uint_as_float(r[1])); }
    { auto r = __builtin_amdgcn_permlane32_swap(__float_as_uint(v), __float_as_uint(v), false, false); v = fmaxf(__uint_as_float(r[0]), __uint_as_float(r[1])); }
    return v;
}
__device__ __forceinline__ float gelu_erf(float x) {
    const float z = x * 0.70710678118654752f, az = fabsf(z);
    const float t = __builtin_amdgcn_rcpf(fmaf(0.3275911f, az, 1.0f));
    float pl = fmaf(t, 1.061405429f, -1.453152027f); pl = fmaf(t, pl, 1.421413741f); pl = fmaf(t, pl, -0.284496736f); pl = fmaf(t, pl, 0.254829592f); pl *= t;
    const float ex = __builtin_amdgcn_exp2f(az * (az * -1.4426950408889634f));
    const float er = copysignf(fmaf(-pl, ex, 1.0f), z);
    const float hx = 0.5f * x;
    return fmaf(hx, er, hx);
}

__device__ __forceinline__ int qkv_logical_col(int p) { return (p & ~255) | (((p >> 5) & 3) << 6) | (((p >> 7) & 1) << 5) | (p & 31); }
__device__ void ph_transpose(const float* W, bf16* Wt, int K, int N, bool permute, float* tile  , int bid, int nb) {
    const int tid = ltid();
    const int nkt = K / 64, nnt = N / 64;
    for (int it = bid; it < nkt * nnt; it += nb) {
        const int k0 = (it / nnt) * 64, n0 = (it % nnt) * 64;
        __syncthreads();
        for (int e = tid; e < 64 * 64; e += NT) { const int r = e >> 6, c = e & 63; const int nl = permute ? qkv_logical_col(n0 + c) : n0 + c; tile[r * 65 + c] = W[(size_t)(k0 + r) * N + nl]; }
        __syncthreads();
        {
            const int n = tid >> 3, k8 = (tid & 7) * 8;
            u32x4 v;
            v.x = pk2(tile[(k8 + 0) * 65 + n], tile[(k8 + 1) * 65 + n]);
            v.y = pk2(tile[(k8 + 2) * 65 + n], tile[(k8 + 3) * 65 + n]);
            v.z = pk2(tile[(k8 + 4) * 65 + n], tile[(k8 + 5) * 65 + n]);
            v.w = pk2(tile[(k8 + 6) * 65 + n], tile[(k8 + 7) * 65 + n]);
            *(u32x4*)(Wt + (size_t)(n0 + n) * K + k0 + k8) = v;
        }
    }
}
__device__ void ph_convert(const float* src, bf16* dst, size_t n, int bid, int nb) {
    const size_t n8 = n / 8;
    for (size_t i = (size_t)bid * NT + ltid(); i < n8; i += (size_t)nb * NT) {
        const f32x4 a = *(const f32x4*)(src + i * 8), b = *(const f32x4*)(src + i * 8 + 4);
        u32x4 v; v.x = pk2(a[0], a[1]); v.y = pk2(a[2], a[3]); v.z = pk2(b[0], b[1]); v.w = pk2(b[2], b[3]);
        *(u32x4*)(dst + i * 8) = v;
    }
}
__device__ void ph_mod(const float* c, const float* ada_w, const float* ada_b, float* mod, float* lds  , int bid, int nb) {
    const int tid = ltid(), lane = tid & 63, w = tid >> 6;
    for (int it = bid; it < 2 * 96; it += nb) {
        const int l = it / 96, j = (it % 96) * 64 + lane;
        float acc[32];
#pragma unroll
        for (int b = 0; b < 32; ++b) acc[b] = 0.f;
        for (int kh = 0; kh < 2; ++kh) {
            __syncthreads();
            for (int e = tid; e < 32 * 512; e += NT) { const int b = e >> 9, k = e & 511; const float cv = c[b * 1024 + kh * 512 + k]; lds[e] = cv / (1.0f + __expf(-cv)); }
            __syncthreads();
            for (int kk = 0; kk < 64; ++kk) {
                const int k = w * 64 + kk;
                const float wv = ada_w[((size_t)l * 1024 + kh * 512 + k) * 6144 + j];
#pragma unroll
                for (int b = 0; b < 32; ++b) acc[b] += lds[b * 512 + k] * wv;
            }
        }
        __syncthreads();
#pragma unroll
        for (int b = 0; b < 32; ++b) lds[(w * 32 + b) * 64 + lane] = acc[b];
        __syncthreads();
        for (int e = tid; e < 32 * 64; e += NT) {
            const int b = e >> 6, jj = e & 63; float s = 0.f;
#pragma unroll
            for (int ww = 0; ww < 8; ++ww) s += lds[(ww * 32 + b) * 64 + jj];
            const int jo = (it % 96) * 64 + jj;
            mod[((size_t)l * 32 + b) * 6144 + jo] = s + ada_b[l * 6144 + jo];
        }
    }
}
__device__ void ph_rope_table(float* rope, int bid, int nb) {
    for (int i = bid * NT + ltid(); i < SQ * 32; i += nb * NT) {
        const int t = i >> 5, f = i & 31;
        const float inv = powf(10000.0f, -(float)f / 32.0f);
        const float ang = (float)t * inv;
        float s, c; sincosf(ang, &s, &c);
        rope[i * 2] = c; rope[i * 2 + 1] = s;
    }
}

#define DPP_ADD0(v, ctrl) ((v) + __builtin_bit_cast(float, __builtin_amdgcn_update_dpp(0, __builtin_bit_cast(int, (v)), (ctrl), 0xf, 0xf, true)))
template <bool XBF> __device__ void ph_adaln(const void* xv, const float* g, const float* mod_shift  , const float* mod_scale, bf16* h, int bid, int nb) {
    const int lane = ltid() & 63, w = __builtin_amdgcn_readfirstlane(ltid() >> 6);
    for (int t0 = (bid * 8 + w) * 4; t0 < MT; t0 += nb * 8 * 4) {
        const int b = t0 >> 11;
        f32x4 v[4][4]; float ss[4];
#pragma unroll
        for (int r = 0; r < 4; ++r) {
            if constexpr (XBF) {
                const bf16* xr = (const bf16*)xv + (size_t)(t0 + r) * DM;
#pragma unroll
                for (int i = 0; i < 4; ++i) { const u32x2 q = *(const u32x2*)(xr + i * 256 + lane * 4); v[r][i] = (f32x4){__uint_as_float(q.x << 16), __uint_as_float(q.x & 0xffff0000u), __uint_as_float(q.y << 16), __uint_as_float(q.y & 0xffff0000u)}; }
            } else {
                const float* xr = (const float*)xv + (size_t)(t0 + r) * DM;
#pragma unroll
                for (int i = 0; i < 4; ++i) v[r][i] = *(const f32x4*)(xr + i * 256 + lane * 4);
            }
        }
#pragma unroll
        for (int r = 0; r < 4; ++r) {
            float s = 0.f;
#pragma unroll
            for (int i = 0; i < 4; ++i) s += v[r][i][0] * v[r][i][0] + v[r][i][1] * v[r][i][1] + v[r][i][2] * v[r][i][2] + v[r][i][3] * v[r][i][3];
            s = DPP_ADD0(s, 0xB1); s = DPP_ADD0(s, 0x4E); s = DPP_ADD0(s, 0x124); s = DPP_ADD0(s, 0x128);
            { auto q = __builtin_amdgcn_permlane16_swap(__float_as_uint(s), __float_as_uint(s), false, false); s = __uint_as_float(q[0]) + __uint_as_float(q[1]); }
            { auto q = __builtin_amdgcn_permlane32_swap(__float_as_uint(s), __float_as_uint(s), false, false); s = __uint_as_float(q[0]) + __uint_as_float(q[1]); }
            ss[r] = rsqrtf(s * (1.0f / DM) + EPS);
        }
#pragma unroll
        for (int i = 0; i < 4; ++i) {
            const int c = i * 256 + lane * 4;
            const f32x4 gg = *(const f32x4*)(g + c), sc = *(const f32x4*)(mod_scale + (size_t)b * 6144 + c), sh = *(const f32x4*)(mod_shift + (size_t)b * 6144 + c);
            float a[4];
#pragma unroll
            for (int e = 0; e < 4; ++e) a[e] = gg[e] * (1.0f + sc[e]);
#pragma unroll
            for (int r = 0; r < 4; ++r) {
                float y[4];
#pragma unroll
                for (int e = 0; e < 4; ++e) y[e] = v[r][i][e] * ss[r] * a[e] + sh[e];
                u32x2 o; o.x = pk2(y[0], y[1]); o.y = pk2(y[2], y[3]);
                __builtin_nontemporal_store(o, (u32x2*)(h + (size_t)(t0 + r) * DM + c));
            }
        }
    }
}

namespace pg8 {
#define PG8_LAS __attribute__((address_space(3)))
typedef unsigned short bf16_t;
typedef short bf16x8 __attribute__((ext_vector_type(8)));
constexpr int BM = 256, BK = 64, HALF = 128, HTB = HALF * BK * 2  , STAGE_BYTES = 8 * HTB, NXCD = 8, WGM = 8;

__host__ __device__ __forceinline__ int lds_byte(int r, int c) { const int st = (r >> 4) * 2 + (c >> 5), rr = r & 15, cc = c & 31, ob = rr * 64 + cc * 2; return st * 1024 + (ob ^ (((ob >> 9) & 1) << 5)); }
__host__ __device__ __forceinline__ void stage_rc(int b, int& R, int& C) { const int st = b / 1024, sb = b % 1024, swz = sb ^ (((sb >> 9) & 1) << 5); R = (st >> 1) * 16 + swz / 64; C = (st & 1) * 32 + (swz % 64) / 2; }
__host__ __device__ __forceinline__ int perm32(int rho) { const int n = rho >> 4, i = rho & 15; return 8 * (i >> 2) + 4 * n + (i & 3); }

struct Unit { int pm, pn; };
struct Gemm { const bf16_t* A; const bf16_t* Bt; int M, N, K; };

struct StaticOrder {
    int nM, nN, nwg, G, c;
    __host__ __device__ void init(int M, int N, int G_, int c_) { nM = M / BM; nN = N / BM; nwg = nM * nN; G = G_; c = c_; }
    __host__ __device__ bool next(int i, Unit& u) const {
        const long L = (long)i * G + c; if (L >= nwg) return false;
        int wgid = (int)L; { const int q = nwg / NXCD, r = nwg % NXCD, xcd = wgid % NXCD, off = wgid / NXCD; wgid = (xcd < r ? xcd * (q + 1) : r * (q + 1) + (xcd - r) * q) + off; }
        const int nig = WGM * nN, gid = wgid / nig, fm = gid * WGM, gsz = (nM - fm) < WGM ? (nM - fm) : WGM;
        u.pm = fm + ((wgid % nig) % gsz); u.pn = (wgid % nig) / gsz; return true;
    }
    __device__ __forceinline__ void a_ready(const Unit&) const {}
    __device__ __forceinline__ void done(const Unit&) const {}
};

__device__ __forceinline__ unsigned cvt_pk_bf16(float lo, float hi) { unsigned r; asm volatile("v_cvt_pk_bf16_f32 %0, %1, %2" : "=v"(r) : "v"(lo), "v"(hi)); return r; }

struct EpiStore {
    static constexpr bool PERM = true, AFTER_DRAIN = false;
    bf16_t* O; int ldc;
    __device__ __forceinline__ void operator()(const f32x4 (&acc)[2][2][4][2], const Unit& u, int wr, int wc, int fr_, int fq_) const {
        int fr = fr_, fq = fq_; asm volatile("" : "+v"(fr), "+v"(fq));
        const int row0 = u.pm * BM + wr * 64 + fr, col0 = u.pn * BM + wc * 32 + 8 * fq;
#pragma unroll
        for (int ai = 0; ai < 2; ++ai)
#pragma unroll
            for (int m = 0; m < 4; ++m) { bf16_t* rowp = O + (size_t)(row0 + ai * HALF + m * 16) * ldc + col0;
#pragma unroll
                for (int bj = 0; bj < 2; ++bj) { const f32x4 v0 = acc[ai][bj][m][0], v1 = acc[ai][bj][m][1];
                    u32x4 w; w.x = cvt_pk_bf16(v0[0], v0[1]); w.y = cvt_pk_bf16(v0[2], v0[3]); w.z = cvt_pk_bf16(v1[0], v1[1]); w.w = cvt_pk_bf16(v1[2], v1[3]);
                    *(u32x4*)(rowp + bj * HALF) = w; } }
    }
};
struct EpiQKV {
    static constexpr bool PERM = true, AFTER_DRAIN = false;
    bf16_t* O; int ldc; const float* rope; int layer;
    const float* gq0; const float* gk0;
    const float* gq1; const float* gk1;
    float* kmean;
    __device__ __forceinline__ void operator()(const f32x4 (&acc)[2][2][4][2], const Unit& u, int wr, int wc, int fr_, int fq_) const {
        int fr = fr_, fq = fq_; asm volatile("" : "+v"(fr), "+v"(fq));
        const int hg = 4 * u.pn + wc;
        const float* gain = nullptr; bool km = false;
        if (layer == 0) { if (hg < 8) gain = gq0; else if (hg < 10) gain = gk0; }
        else { if (hg < 8) gain = gq0; else if (hg < 16) gain = gk0; else if (hg >= 24 && hg < 32) gain = gq1; else if (hg >= 32 && hg < 40) { gain = gk1; km = true; } }
        const int row0 = u.pm * BM + wr * 64 + fr, col0 = 64 * hg + 8 * fq;
        float g0[8], g1[8], cs0[8], cs1[8];
#pragma unroll
        for (int e = 0; e < 8; ++e) { g0[e] = gain ? gain[8 * fq + e] : 1.f; g1[e] = gain ? gain[32 + 8 * fq + e] : 1.f; cs0[e] = 0.f; cs1[e] = 0.f; }
#pragma unroll
        for (int ai = 0; ai < 2; ++ai)
#pragma unroll
            for (int m = 0; m < 4; ++m) {
                const int row = row0 + ai * HALF + m * 16;
                float v0[8], v1[8];
#pragma unroll
                for (int e = 0; e < 4; ++e) { v0[e] = acc[ai][0][m][0][e]; v0[4 + e] = acc[ai][0][m][1][e]; v1[e] = acc[ai][1][m][0][e]; v1[4 + e] = acc[ai][1][m][1][e]; }
                if (gain) {
                    float ss = 0.f;
#pragma unroll
                    for (int e = 0; e < 8; ++e) ss += v0[e] * v0[e] + v1[e] * v1[e];
                    ss = rows_sum(ss);
                    const float r = rsqrtf(ss * (1.0f / 64.0f) + 1e-6f);
                    const float* rp = rope + ((size_t)(row & 2047) * 32 + 8 * fq) * 2;
                    const f32x4 t0 = *(const f32x4*)(rp), t1 = *(const f32x4*)(rp + 4), t2 = *(const f32x4*)(rp + 8), t3 = *(const f32x4*)(rp + 12);
                    const float cs[8] = {t0[0], t0[2], t1[0], t1[2], t2[0], t2[2], t3[0], t3[2]}, sn[8] = {t0[1], t0[3], t1[1], t1[3], t2[1], t2[3], t3[1], t3[3]};
#pragma unroll
                    for (int e = 0; e < 8; ++e) { const float y0 = v0[e] * r * g0[e], y1 = v1[e] * r * g1[e]; v0[e] = y0 * cs[e] - y1 * sn[e]; v1[e] = y1 * cs[e] + y0 * sn[e]; }
                }
                u32x4 w0, w1;
                w0.x = cvt_pk_bf16(v0[0], v0[1]); w0.y = cvt_pk_bf16(v0[2], v0[3]); w0.z = cvt_pk_bf16(v0[4], v0[5]); w0.w = cvt_pk_bf16(v0[6], v0[7]);
                w1.x = cvt_pk_bf16(v1[0], v1[1]); w1.y = cvt_pk_bf16(v1[2], v1[3]); w1.z = cvt_pk_bf16(v1[4], v1[5]); w1.w = cvt_pk_bf16(v1[6], v1[7]);
                bf16_t* rowp = O + (size_t)row * ldc + col0;
                *(u32x4*)(rowp) = w0; *(u32x4*)(rowp + 32) = w1;
                if (km) {
#pragma unroll
                    for (int e = 0; e < 8; ++e) { cs0[e] += v0[e]; cs1[e] += v1[e]; }
                }
            }
        if (km) {
#pragma unroll
            for (int e = 0; e < 8; ++e) {
                cs0[e] = row16_sum(cs0[e]); cs1[e] = row16_sum(cs1[e]);
            }
            if (fr == 0) {
                float* kp = kmean + ((size_t)((u.pm >> 3) * 8 + (hg - 32)) * 8 + (u.pm & 7)) * 64 + 8 * fq;
#pragma unroll
                for (int e = 0; e < 8; ++e) { atomicAdd(kp + e, cs0[e] * (1.0f / 256.0f)); atomicAdd(kp + 32 + e, cs1[e] * (1.0f / 256.0f)); }
            }
        }
    }
};
template <bool XBF> struct EpiResid {
    static constexpr bool PERM = true, AFTER_DRAIN = false;
    const void* xin; bf16_t* xout; const float* gate;
    __device__ __forceinline__ void operator()(const f32x4 (&acc)[2][2][4][2], const Unit& u, int wr, int wc, int fr_, int fq_) const {
        int fr = fr_, fq = fq_; asm volatile("" : "+v"(fr), "+v"(fq));
        const int row0 = u.pm * BM + wr * 64 + fr, col0 = u.pn * BM + wc * 32 + 8 * fq;
#pragma unroll
        for (int ai = 0; ai < 2; ++ai)
#pragma unroll
            for (int m = 0; m < 4; ++m) { const int row = row0 + ai * HALF + m * 16; const float* gp = gate + (size_t)(row >> 11) * 6144 + col0;
                bf16_t* xo = xout + (size_t)row * 1024 + col0;
#pragma unroll
                for (int bj = 0; bj < 2; ++bj) {
                    f32x4 x0, x1;
                    if constexpr (XBF) { const u32x4 q = *(const u32x4*)((const bf16_t*)xin + (size_t)row * 1024 + col0 + bj * HALF);
                        x0 = (f32x4){__uint_as_float(q.x << 16), __uint_as_float(q.x & 0xffff0000u), __uint_as_float(q.y << 16), __uint_as_float(q.y & 0xffff0000u)};
                        x1 = (f32x4){__uint_as_float(q.z << 16), __uint_as_float(q.z & 0xffff0000u), __uint_as_float(q.w << 16), __uint_as_float(q.w & 0xffff0000u)}; }
                    else { const float* xi = (const float*)xin + (size_t)row * 1024 + col0 + bj * HALF; x0 = *(const f32x4*)xi; x1 = *(const f32x4*)(xi + 4); }
                    const f32x4 a0 = acc[ai][bj][m][0], a1 = acc[ai][bj][m][1], g0 = *(const f32x4*)(gp + bj * HALF), g1 = *(const f32x4*)(gp + bj * HALF + 4);
                    u32x4 w; w.x = cvt_pk_bf16(x0[0] + g0[0] * a0[0], x0[1] + g0[1] * a0[1]); w.y = cvt_pk_bf16(x0[2] + g0[2] * a0[2], x0[3] + g0[3] * a0[3]);
                    w.z = cvt_pk_bf16(x1[0] + g1[0] * a1[0], x1[1] + g1[1] * a1[1]); w.w = cvt_pk_bf16(x1[2] + g1[2] * a1[2], x1[3] + g1[3] * a1[3]);
                    *(u32x4*)(xo + bj * HALF) = w; } }
    }
};
template <class Epi, class Sched, bool ALIGN_EPI = false, bool SP2 = false>
__device__ __forceinline__ void gemm_phase(PG8_LAS unsigned char* lds, const Gemm g, const Sched& S, const Epi& E) {
    const int tid = ltid(), wid = __builtin_amdgcn_readfirstlane(tid >> 6), lane = tid & 63, wr = wid >> 2, wc = wid & 3, fr = lane & 15, fq = lane >> 4;
    const int K = g.K, nt = K / BK;
    unsigned voffA[2], voffB[2];
#pragma unroll
    for (int i = 0; i < 2; ++i) { int R, C; stage_rc(tid * 16 + i * 8192, R, C); const int Rb = Epi::PERM ? ((R & ~31) + perm32(R & 31)) : R;
        voffA[i] = (unsigned)(R * K + C) * 2u; voffB[i] = (unsigned)(Rb * K + C) * 2u; }
    const size_t kstep = (size_t)(BK * 2);
    const size_t hstep = (size_t)HALF * K * 2;
    const size_t tstep = 2 * hstep;
    const unsigned ldsw = (unsigned)wid * 1024u;
    const int aoff = lds_byte(wr * 64 + fr, fq * 8), boff = lds_byte(wc * 32 + fr, fq * 8);
#define PG8_SA(b, h) (((b) * 2 + (h)) * HTB)
#define PG8_SB(b, h) ((4 + (b) * 2 + (h)) * HTB)
#define PG8_STAGE(bufoff, gbase, voff) do { _Pragma("unroll") for (int _i = 0; _i < 2; ++_i) \
        __builtin_amdgcn_global_load_lds((const unsigned*)((const char*)(gbase) + (voff)[_i]), (PG8_LAS unsigned*)(lds + (bufoff) + ldsw + _i * 8192), 16, 0, 0); } while (0)
#define PG8_LDA(dst, b, h) do { _Pragma("unroll") for (int m = 0; m < 4; ++m) _Pragma("unroll") for (int k = 0; k < 2; ++k) dst[m][k] = *(const PG8_LAS bf16x8*)(lds + PG8_SA(b, h) + aoff + m * 2048 + k * 1024); } while (0)
#define PG8_LDB(dst, b, h) do { _Pragma("unroll") for (int n = 0; n < 2; ++n) _Pragma("unroll") for (int k = 0; k < 2; ++k) dst[n][k] = *(const PG8_LAS bf16x8*)(lds + PG8_SB(b, h) + boff + n * 2048 + k * 1024); } while (0)
#define PG8_MMA(ai, bj, At, Bt) do { __builtin_amdgcn_s_setprio(1); _Pragma("unroll") for (int m = 0; m < 4; ++m) _Pragma("unroll") for (int n = 0; n < 2; ++n) _Pragma("unroll") for (int k = 0; k < 2; ++k) \
        acc[ai][bj][m][n] = __builtin_amdgcn_mfma_f32_16x16x32_bf16(Bt[n][k], At[m][k], acc[ai][bj][m][n], 0, 0, 0); __builtin_amdgcn_s_setprio(0); } while (0)
#define PG8_WAIT_V(n) asm volatile("s_waitcnt vmcnt(" #n ")" ::: "memory")
#define PG8_WAIT_L(n) asm volatile("s_waitcnt lgkmcnt(" #n ")" ::: "memory")
#define PG8_BAR __builtin_amdgcn_s_barrier()
#define PG8_SCHED __builtin_amdgcn_sched_barrier(0)
    Unit cur, nxt; int ui = 0;
    if (!S.next(0, cur)) return;
    f32x4 acc[2][2][4][2];
#pragma unroll
    for (int a = 0; a < 2; ++a)
#pragma unroll
        for (int b = 0; b < 2; ++b)
#pragma unroll
            for (int m = 0; m < 4; ++m)
#pragma unroll
                for (int n = 0; n < 2; ++n) acc[a][b][m][n] = (f32x4){0.f, 0.f, 0.f, 0.f};
    bf16x8 At[4][2], B0[2][2], B1[2][2];
    const char* cA = (const char*)g.A + (size_t)cur.pm * tstep; const char* cB = (const char*)g.Bt + (size_t)cur.pn * tstep;
    S.a_ready(cur);
    if constexpr (SP2) {
        PG8_STAGE(PG8_SB(0, 0), cB, voffB); PG8_STAGE(PG8_SB(0, 1), cB + hstep, voffB); PG8_STAGE(PG8_SA(0, 0), cA, voffA); PG8_STAGE(PG8_SA(0, 1), cA + hstep, voffA);
        if (wr == 1) PG8_BAR;
        PG8_WAIT_V(2); PG8_BAR;
        PG8_STAGE(PG8_SB(1, 0), cB + kstep, voffB); PG8_STAGE(PG8_SA(1, 0), cA + kstep, voffA); PG8_STAGE(PG8_SB(1, 1), cB + hstep + kstep, voffB);
        PG8_WAIT_V(6); PG8_BAR;
    } else {
        PG8_STAGE(PG8_SB(0, 0), cB, voffB); PG8_STAGE(PG8_SA(0, 0), cA, voffA); PG8_STAGE(PG8_SB(0, 1), cB + hstep, voffB); PG8_STAGE(PG8_SA(0, 1), cA + hstep, voffA);
        if (wr == 1) PG8_BAR;
        PG8_WAIT_V(4); PG8_BAR;
        PG8_STAGE(PG8_SB(1, 0), cB + kstep, voffB); PG8_STAGE(PG8_SA(1, 0), cA + kstep, voffA); PG8_STAGE(PG8_SB(1, 1), cB + hstep + kstep, voffB);
        PG8_WAIT_V(6); PG8_BAR;
    }
    for (;;) {
        const bool has_next = S.next(ui + 1, nxt);
        const char* nA = has_next ? (const char*)g.A + (size_t)nxt.pm * tstep : cA; const char* nB = has_next ? (const char*)g.Bt + (size_t)nxt.pn * tstep : cB;
        for (int t = 0; t < nt; t += 2) {
            const bool last = (t == nt - 2);
            const char* a1 = cA + (size_t)(t + 1) * kstep;
            const char* a2 = last ? nA : cA + (size_t)(t + 2) * kstep; const char* b2 = last ? nB : cB + (size_t)(t + 2) * kstep;
            const char* a3 = a2 + kstep; const char* b3 = b2 + kstep;
            if (last && has_next) S.a_ready(nxt);
            if constexpr (SP2) {
            PG8_LDB(B0, 0, 0); PG8_LDB(B1, 0, 1); PG8_SCHED; PG8_LDA(At, 0, 0); PG8_STAGE(PG8_SA(1, 1), a1 + hstep, voffA);
            PG8_WAIT_V(8); PG8_WAIT_L(0); PG8_BAR; PG8_MMA(0, 0, At, B0); PG8_MMA(0, 1, At, B1); PG8_BAR; PG8_SCHED;
            PG8_LDA(At, 0, 1); PG8_STAGE(PG8_SB(0, 0), b2, voffB); PG8_STAGE(PG8_SB(0, 1), b2 + hstep, voffB); PG8_STAGE(PG8_SA(0, 0), a2, voffA);
            PG8_WAIT_V(8); PG8_WAIT_L(0); PG8_BAR; PG8_MMA(1, 0, At, B0); PG8_MMA(1, 1, At, B1); PG8_BAR; PG8_SCHED;
            PG8_LDB(B0, 1, 0); PG8_LDB(B1, 1, 1); PG8_SCHED; PG8_LDA(At, 1, 0); PG8_STAGE(PG8_SA(0, 1), a2 + hstep, voffA);
            PG8_WAIT_V(8); PG8_WAIT_L(0); PG8_BAR; PG8_MMA(0, 0, At, B0); PG8_MMA(0, 1, At, B1); PG8_BAR; PG8_SCHED;
            PG8_LDA(At, 1, 1); PG8_STAGE(PG8_SB(1, 0), b3, voffB); PG8_STAGE(PG8_SB(1, 1), b3 + hstep, voffB); PG8_STAGE(PG8_SA(1, 0), a3, voffA);
            PG8_WAIT_V(8); PG8_WAIT_L(0); PG8_BAR; PG8_MMA(1, 0, At, B0); PG8_MMA(1, 1, At, B1); PG8_BAR; PG8_SCHED;
            } else {
            PG8_LDB(B0, 0, 0); PG8_SCHED; PG8_LDA(At, 0, 0); PG8_STAGE(PG8_SA(1, 1), a1 + hstep, voffA);
            PG8_WAIT_L(8); PG8_BAR; PG8_WAIT_L(0); PG8_MMA(0, 0, At, B0); PG8_BAR; PG8_SCHED;
            PG8_LDB(B1, 0, 1); PG8_STAGE(PG8_SB(0, 0), b2, voffB);
            PG8_BAR; PG8_WAIT_L(0); PG8_MMA(0, 1, At, B1); PG8_BAR;
            PG8_LDA(At, 0, 1); PG8_STAGE(PG8_SA(0, 0), a2, voffA);
            PG8_BAR; PG8_WAIT_L(0); PG8_MMA(1, 0, At, B0); PG8_BAR; PG8_SCHED;
            PG8_STAGE(PG8_SB(0, 1), b2 + hstep, voffB);
            PG8_WAIT_V(6); PG8_BAR; PG8_MMA(1, 1, At, B1); PG8_BAR;
            PG8_LDB(B0, 1, 0); PG8_SCHED; PG8_LDA(At, 1, 0); PG8_STAGE(PG8_SA(0, 1), a2 + hstep, voffA);
            PG8_WAIT_L(8); PG8_BAR; PG8_WAIT_L(0); PG8_MMA(0, 0, At, B0); PG8_BAR; PG8_SCHED;
            PG8_LDB(B1, 1, 1); PG8_STAGE(PG8_SB(1, 0), b3, voffB);
            PG8_BAR; PG8_WAIT_L(0); PG8_MMA(0, 1, At, B1); PG8_BAR;
            PG8_LDA(At, 1, 1); PG8_STAGE(PG8_SA(1, 0), a3, voffA);
            PG8_BAR; PG8_WAIT_L(0); PG8_MMA(1, 0, At, B0); PG8_BAR; PG8_SCHED;
            PG8_STAGE(PG8_SB(1, 1), b3 + hstep, voffB);
            PG8_WAIT_V(6); PG8_BAR; PG8_MMA(1, 1, At, B1); PG8_BAR;
            }
        }
        if constexpr (ALIGN_EPI) { if (wr == 0) PG8_BAR; }
        if constexpr (!Epi::AFTER_DRAIN) { E(acc, cur, wr, wc, fr, fq); S.done(cur); }
        if (!has_next) break;
#pragma unroll
        for (int a = 0; a < 2; ++a)
#pragma unroll
            for (int b = 0; b < 2; ++b)
#pragma unroll
                for (int m = 0; m < 4; ++m)
#pragma unroll
                    for (int n = 0; n < 2; ++n) acc[a][b][m][n] = (f32x4){0.f, 0.f, 0.f, 0.f};
        cur = nxt; cA = nA; cB = nB; ++ui;
        if constexpr (ALIGN_EPI) { if (wr == 1) PG8_BAR; }
    }
    PG8_WAIT_V(0);
    if constexpr (!ALIGN_EPI) { if (wr == 0) PG8_BAR; }
    PG8_BAR;
    if constexpr (Epi::AFTER_DRAIN) { E.fused(acc, cur, wr, wc, fr, fq, lds, wid, lane); S.done(cur); }
#undef PG8_SA
#undef PG8_SB
#undef PG8_STAGE
#undef PG8_LDA
#undef PG8_LDB
#undef PG8_MMA
#undef PG8_WAIT_V
#undef PG8_WAIT_L
#undef PG8_BAR
#undef PG8_SCHED
}
}

typedef float f32x16 __attribute__((ext_vector_type(16)));
typedef short s16x4 __attribute__((ext_vector_type(4)));
typedef short v4i16_t __attribute__((ext_vector_type(4)));
typedef float f32x2_t __attribute__((ext_vector_type(2)));
typedef __bf16 bf16x2_t __attribute__((ext_vector_type(2)));
#define LAS __attribute__((address_space(3)))
constexpr int VROW = 144, VBUF = 32 * VROW;
constexpr int VROWV = 192, VBUFV = 32 * VROWV;
constexpr float L2E = 1.4426950408889634f, LN2 = 0.6931471805599453f;
constexpr float SC2 = 0.125f * L2E;

__device__ __forceinline__ int crow(int r, int hi) { return (r & 3) + 8 * (r >> 2) + 4 * hi; }
__device__ __forceinline__ unsigned cvtpk(float lo, float hi) { f32x2_t v = {lo, hi}; bf16x2_t b = __builtin_convertvector(v, bf16x2_t); return __builtin_bit_cast(unsigned, b); }
__device__ __forceinline__ float xhalf(float v, int hi) {
    auto r = __builtin_amdgcn_permlane32_swap(__float_as_uint(v), __float_as_uint(v), false, false);
    return __uint_as_float(hi ? r[0] : r[1]);
}
__device__ __forceinline__ s16x4 vtr(const LAS unsigned char* p) { return __builtin_bit_cast(s16x4, __builtin_amdgcn_ds_read_tr16_b64_v4i16((LAS v4i16_t*)p)); }

struct KVRegs { u32x4 k[4]; u32x4 v[4]; };
__device__ __forceinline__ void load_kv(KVRegs& R, const bf16* base, int kp0, int kst, int kcol, int vcol, int lane) {
#pragma unroll
    for (int j = 0; j < 4; ++j) {
        const int pos = kp0 + kst * (8 * j + (lane >> 3));
        const int pc = pos < SQ - 1 ? pos : SQ - 1;
        const bf16* rp = base + (size_t)pc * QKV_LD + (lane & 7) * 8;
        R.k[j] = *(const u32x4*)(rp + kcol); R.v[j] = *(const u32x4*)(rp + vcol);
    }
}
__device__ __forceinline__ void kv_stage(const KVRegs& R, LAS unsigned char* klds, LAS unsigned char* vlds, int lane) {
#pragma unroll
    for (int j = 0; j < 4; ++j) { const int r_ = 8 * j + (lane >> 3), c_ = (lane & 7) * 16; *(LAS u32x4*)(klds + r_ * VROW + c_) = R.k[j]; *(LAS u32x4*)(vlds + r_ * VROWV + c_) = R.v[j]; }
}
__device__ __forceinline__ f32x16 qk_tile(const LAS unsigned char* klds, const bf16x8 (&qf)[4], int r32, int hi) {
    f32x16 s = {0.f, 0.f, 0.f, 0.f, 0.f, 0.f, 0.f, 0.f, 0.f, 0.f, 0.f, 0.f, 0.f, 0.f, 0.f, 0.f};
#pragma unroll
    for (int k = 0; k < 4; ++k) { const bf16x8 kf = *(const LAS bf16x8*)(klds + r32 * VROW + (2 * k + hi) * 16); s = __builtin_amdgcn_mfma_f32_32x32x16_bf16(kf, qf[k], s, 0, 0, 0); }
    return s;
}
__device__ __forceinline__ void pv_tile(f32x16 (&o)[2], const f32x16& p, const LAS unsigned char* vlds, int lane) {
    const int g = lane >> 4, i = lane & 15, h = lane >> 5;
    const LAS unsigned char* vb = vlds + (4 * h + (i >> 2)) * VROWV + (16 * (g & 1) + 4 * (i & 3)) * 2;
#pragma unroll
    for (int s = 0; s < 2; ++s) {
        u32x4 pw; pw.x = cvtpk(p[8 * s], p[8 * s + 1]); pw.y = cvtpk(p[8 * s + 2], p[8 * s + 3]); pw.z = cvtpk(p[8 * s + 4], p[8 * s + 5]); pw.w = cvtpk(p[8 * s + 6], p[8 * s + 7]);
        const bf16x8 pb = __builtin_bit_cast(bf16x8, pw);
#pragma unroll
        for (int df = 0; df < 2; ++df) {
            const s16x4 lo = vtr(vb + (16 * s) * VROWV + df * 64), hh = vtr(vb + (16 * s + 8) * VROWV + df * 64);
            const bf16x8 va = (bf16x8){lo[0], lo[1], lo[2], lo[3], hh[0], hh[1], hh[2], hh[3]};
            o[df] = __builtin_amdgcn_mfma_f32_32x32x16_bf16(va, pb, o[df], 0, 0, 0);
        }
    }
}
__device__ __forceinline__ void load_q(bf16x8 (&qf)[4], const bf16* base, int qpos, int qcol, int hi) {
    const bf16* rp = base + (size_t)qpos * QKV_LD + qcol + 8 * hi;
#pragma unroll
    for (int k = 0; k < 4; ++k) qf[k] = *(const bf16x8*)(rp + 16 * k);
}
__device__ __forceinline__ void store_o(bf16* yrow, const f32x16 (&o)[2], float inv, int hi) {
#pragma unroll
    for (int df = 0; df < 2; ++df)
#pragma unroll
        for (int g = 0; g < 4; ++g) {
            u32x2 w; w.x = cvtpk(o[df][4 * g] * inv, o[df][4 * g + 1] * inv); w.y = cvtpk(o[df][4 * g + 2] * inv, o[df][4 * g + 3] * inv);
            *(u32x2*)(yrow + 32 * df + 8 * g + 4 * hi) = w;
        }
}
__device__ __forceinline__ void osm_tile(f32x16& s, float& m, float& l, f32x16 (&o)[2]) {
    float mx = s[0];
#pragma unroll
    for (int r = 1; r < 16; ++r) mx = fmaxf(mx, s[r]);
    { auto rr = __builtin_amdgcn_permlane32_swap(__float_as_uint(mx), __float_as_uint(mx), false, false); mx = fmaxf(__uint_as_float(rr[0]), __uint_as_float(rr[1])); }
    const float mn = fmaxf(m, mx);
    const float ms = (mn == -INFINITY) ? 0.f : mn;
    const float alpha = __builtin_amdgcn_exp2f((m - ms) * SC2);
    const float mc = ms * SC2;
    float ps = 0.f;
#pragma unroll
    for (int r = 0; r < 16; ++r) { s[r] = __builtin_amdgcn_exp2f(s[r] * SC2 - mc); ps += s[r]; }
    l = l * alpha + ps; m = mn;
    if (!__all(alpha == 1.0f)) {
#pragma unroll
        for (int df = 0; df < 2; ++df)
#pragma unroll
            for (int r = 0; r < 16; ++r) o[df][r] *= alpha;
    }
}
__device__ __forceinline__ void osm_tile2(f32x16& s0, f32x16& s1, float& m, float& l, f32x16 (&o)[2]) {
    float mx = fmaxf(s0[0], s1[0]);
#pragma unroll
    for (int r = 1; r < 16; ++r) mx = fmaxf(mx, fmaxf(s0[r], s1[r]));
    { auto rr = __builtin_amdgcn_permlane32_swap(__float_as_uint(mx), __float_as_uint(mx), false, false); mx = fmaxf(__uint_as_float(rr[0]), __uint_as_float(rr[1])); }
    const float mn = fmaxf(m, mx);
    const float ms = (mn == -INFINITY) ? 0.f : mn;
    const float alpha = __builtin_amdgcn_exp2f((m - ms) * SC2);
    const float mc = ms * SC2;
    float ps0 = 0.f, ps1 = 0.f;
#pragma unroll
    for (int r = 0; r < 16; ++r) { s0[r] = __builtin_amdgcn_exp2f(s0[r] * SC2 - mc); ps0 += s0[r]; s1[r] = __builtin_amdgcn_exp2f(s1[r] * SC2 - mc); ps1 += s1[r]; }
    l = l * alpha + (ps0 + ps1); m = mn;
    if (!__all(alpha == 1.0f)) {
#pragma unroll
        for (int df = 0; df < 2; ++df)
#pragma unroll
            for (int r = 0; r < 16; ++r) o[df][r] *= alpha;
    }
}
#define ZERO16 {0.f, 0.f, 0.f, 0.f, 0.f, 0.f, 0.f, 0.f, 0.f, 0.f, 0.f, 0.f, 0.f, 0.f, 0.f, 0.f}

struct AttnCtx {
    const bf16* base; int kcol, vcol, r32, hi, lane; LAS unsigned char* vlds; LAS unsigned char* klds; bf16x8 qf[4]; f32x16 o[2];
};
#define ATTN_STEP(SC, SL, T) { \
        if (SYNC) __builtin_amdgcn_s_barrier(); \
        { int kp_, ks_; const int tl_ = (T) + 2 < nt ? (T) + 2 : nt - 1; mx.pos(tl_, kp_, ks_); load_kv(SL, c.base, kp_, ks_, c.kcol, c.vcol, c.lane); } \
        kv_stage(SC, c.klds, c.vlds, c.lane); f32x16 s_ = qk_tile(c.klds, c.qf, c.r32, c.hi); \
        const bool stop_ = mx.process((T), s_, c); pv_tile(c.o, s_, c.vlds, c.lane); \
        if ((!SYNC && stop_) || (T) + 1 >= nt) break; }
template <class M, bool SYNC> __device__ __forceinline__ void attn_run(M& mx, AttnCtx& c) {
    const int nt = mx.nt;
    KVRegs S0, S1, S2;
    { int kp, ks; mx.pos(0, kp, ks); load_kv(S0, c.base, kp, ks, c.kcol, c.vcol, c.lane);
      mx.pos(1 < nt ? 1 : nt - 1, kp, ks); load_kv(S1, c.base, kp, ks, c.kcol, c.vcol, c.lane); }
    for (int t = 0;; t += 3) {
        ATTN_STEP(S0, S2, t)
        ATTN_STEP(S1, S0, t + 1)
        ATTN_STEP(S2, S1, t + 2)
    }
}
#define SH_BAR() asm volatile("s_waitcnt lgkmcnt(0)\n\ts_barrier" ::: "memory")
constexpr int SLOT_K = 64 * VROW, SLOT_BYTES = 64 * VROW + 64 * VROWV;
struct ShRegs { u32x4 a, b; };
__device__ __forceinline__ void sh_load(ShRegs& R, const bf16* base, int kp0, int kcol, int vcol, int w, int lane) {
    const int pos = kp0 + 4 * w + ((lane & 31) >> 3);
    const int pa = pos < SQ - 1 ? pos : SQ - 1, pb = pos + 32 < SQ - 1 ? pos + 32 : SQ - 1;
    const int col = ((lane >> 5) ? vcol : kcol) + (lane & 7) * 8;
    R.a = *(const u32x4*)(base + (size_t)pa * QKV_LD + col); R.b = *(const u32x4*)(base + (size_t)pb * QKV_LD + col);
}
__device__ __forceinline__ void sh_write(LAS unsigned char* slot, const ShRegs& R, int w, int lane) {
    const int row = 4 * w + ((lane & 31) >> 3);
    LAS unsigned char* p = slot + ((lane >> 5) ? SLOT_K + row * VROWV : row * VROW) + (lane & 7) * 16;
    *(LAS u32x4*)p = R.a; *(LAS u32x4*)(p + 32 * ((lane >> 5) ? VROWV : VROW)) = R.b;
}
#define SH_STEP(RW, RL, T) { \
        SH_BAR(); \
        { const int tl_ = (T) + 2 < nt ? (T) + 2 : nt - 1; sh_load(RL, c.base, mx.pos2(tl_), c.kcol, c.vcol, w, c.lane); } \
        sh_write(slots + (((T) + 1) & 1) * SLOT_BYTES, RW, w, c.lane); \
        if (mx.active2((T), w)) { LAS unsigned char* sl_ = slots + ((T) & 1) * SLOT_BYTES; \
            f32x16 s0_ = qk_tile(sl_, c.qf, c.r32, c.hi), s1_ = qk_tile(sl_ + 32 * VROW, c.qf, c.r32, c.hi); mx.process2((T), s0_, s1_, c); \
            pv_tile(c.o, s0_, sl_ + SLOT_K, c.lane); pv_tile(c.o, s1_, sl_ + SLOT_K + 32 * VROWV, c.lane); } \
        if ((T) + 1 >= nt) break; }
template <class M> __device__ __forceinline__ void attn_run_shared(M& mx, AttnCtx& c, LAS unsigned char* slots, int w) {
    const int nt = mx.nt2;
    ShRegs R0, R1, R2;
    sh_load(R0, c.base, mx.pos2(0), c.kcol, c.vcol, w, c.lane);
    sh_load(R1, c.base, mx.pos2(1 < nt ? 1 : nt - 1), c.kcol, c.vcol, w, c.lane);
    SH_BAR();
    sh_write(slots, R0, w, c.lane);
    for (int t = 0;; t += 3) {
        SH_STEP(R1, R2, t)
        SH_STEP(R2, R0, t + 1)
        SH_STEP(R0, R1, t + 2)
    }
}
struct MixA {
    int nt, k00, qpos; float m, l;
    __device__ __forceinline__ void pos(int idx, int& kp0, int& kst) const { kp0 = k00 + 32 * idx; kst = 1; }
    __device__ __forceinline__ bool process(int idx, f32x16& s, AttnCtx& c) {
        const int k0 = k00 + 32 * idx;
#pragma unroll
        for (int r = 0; r < 16; ++r) { const int dist = qpos - (k0 + crow(r, c.hi)); if (dist < 0 || dist > 127) s[r] = -INFINITY; }
        osm_tile(s, m, l, c.o); return false;
    }
};
__device__ void attn_A(const bf16* base, int hq, int q0, float sink, bf16* ybase, LAS unsigned char* vlds, int lane) {
    AttnCtx c; c.base = base; c.r32 = lane & 31; c.hi = lane >> 5; c.lane = lane; c.vlds = vlds; c.klds = vlds + VBUFV; c.kcol = 512 + (hq >> 2) * 64; c.vcol = 640 + (hq >> 2) * 64;
    c.o[0] = (f32x16)ZERO16; c.o[1] = (f32x16)ZERO16;
    MixA mx; mx.qpos = q0 + c.r32; mx.k00 = q0 - 128 > 0 ? q0 - 128 : 0; mx.nt = 5; mx.m = -INFINITY; mx.l = 0.f;
    load_q(c.qf, base, mx.qpos, hq * 64, c.hi);
    attn_run<MixA, true>(mx, c);
    float l = mx.l + xhalf(mx.l, c.hi);
    l += __builtin_amdgcn_exp2f(sink * L2E - mx.m * SC2);
    store_o(ybase + (size_t)mx.qpos * DM + hq * 64, c.o, 1.0f / l, c.hi);
}
struct MixB {
    int nt, q0, qpos; float carry;
    __device__ __forceinline__ void pos(int idx, int& kp0, int& kst) const { kp0 = q0 - 32 * idx; kst = 1; }
    __device__ __forceinline__ bool process(int idx, f32x16& s, AttnCtx& c) {
        const int k0 = q0 - 32 * idx, hi = c.hi;
        float lk[16], G[4], Gp[4];
#pragma unroll
        for (int r = 0; r < 16; ++r) {
            const float z = s[r] * 0.125f;
            const bool valid = (k0 + crow(r, hi)) < qpos;
            const float sp = fmaxf(z, 0.f) + LN2 * __builtin_amdgcn_logf(1.0f + __builtin_amdgcn_exp2f(-fabsf(z) * L2E));
            lk[r] = valid ? -sp : 0.f;
            s[r] = valid ? (z - sp) : -INFINITY;
        }
#pragma unroll
        for (int g = 0; g < 4; ++g) { G[g] = (lk[4 * g] + lk[4 * g + 1]) + (lk[4 * g + 2] + lk[4 * g + 3]); Gp[g] = xhalf(G[g], hi); }
        float above = carry;
#pragma unroll
        for (int g = 3; g >= 0; --g) {
            float off = above + (hi == 0 ? Gp[g] : 0.f);
            s[4 * g + 3] = __builtin_amdgcn_exp2f((s[4 * g + 3] + off) * L2E); off += lk[4 * g + 3];
            s[4 * g + 2] = __builtin_amdgcn_exp2f((s[4 * g + 2] + off) * L2E); off += lk[4 * g + 2];
            s[4 * g + 1] = __builtin_amdgcn_exp2f((s[4 * g + 1] + off) * L2E); off += lk[4 * g + 1];
            s[4 * g + 0] = __builtin_amdgcn_exp2f((s[4 * g + 0] + off) * L2E);
            above += G[g] + Gp[g];
        }
        carry = above;
        return __all(carry < -40.0f) != 0;
    }
};
__device__ void attn_B(const bf16* base, int h, int q0, bf16* ybase, LAS unsigned char* vlds, int lane) {
    AttnCtx c; c.base = base; c.r32 = lane & 31; c.hi = lane >> 5; c.lane = lane; c.vlds = vlds; c.klds = vlds + VBUFV; c.kcol = 1280 + h * 64; c.vcol = 1792 + h * 64;
    c.o[0] = (f32x16)ZERO16; c.o[1] = (f32x16)ZERO16;
    MixB mx; mx.q0 = q0; mx.qpos = q0 + c.r32; mx.nt = q0 / 32 + 1; mx.carry = 0.f;
    load_q(c.qf, base, mx.qpos, 768 + h * 64, c.hi);
    attn_run<MixB, false>(mx, c);
    store_o(ybase + (size_t)mx.qpos * DM + 512 + h * 64, c.o, 1.0f, c.hi);
}
struct MixCp {
    int nt, n0, r0, j1lo, qpos; float m, l;
    __device__ __forceinline__ void pos(int t, int& kp0, int& kst) const {
        if (t < n0) { kp0 = r0 + 512 * t; kst = 16; } else { kp0 = (r0 & 3) + 4 * (j1lo + 32 * (t - n0)); kst = 4; }
    }
    __device__ __forceinline__ bool process(int t, f32x16& s, AttnCtx& c) {
        int kp0, kst; pos(t, kp0, kst);
        const int win = t < n0 ? 2048 : 512;
#pragma unroll
        for (int r = 0; r < 16; ++r) { const int dist = qpos - (kp0 + kst * crow(r, c.hi)); if (dist < 0 || dist > win) s[r] = -INFINITY; }
        osm_tile(s, m, l, c.o); return false;
    }
};
struct MixC1 {
    int nt2, p0, qpos; float m, l;
    __device__ __forceinline__ int pos2(int T) const { return p0 + 64 * T; }
    __device__ __forceinline__ bool active2(int T, int w) const { return true; }
    __device__ __forceinline__ void process2(int T, f32x16& s0, f32x16& s1, AttnCtx& c) {
        const int k0 = p0 + 64 * T;
#pragma unroll
        for (int r = 0; r < 16; ++r) { const int dist = qpos - (k0 + crow(r, c.hi)); if (dist < 0 || dist > 128) s0[r] = -INFINITY; if (dist < 32 || dist > 160) s1[r] = -INFINITY; }
        osm_tile2(s0, s1, m, l, c.o);
    }
};
__device__ void attn_C(const bf16* base, int h, int r0, int g, bf16* ybase, LAS unsigned char* vlds, LAS unsigned char* xlds, int w, int lane) {
    AttnCtx c; c.base = base; c.r32 = lane & 31; c.hi = lane >> 5; c.lane = lane; c.vlds = vlds; c.klds = vlds + VBUFV; c.kcol = 512 + h * 64; c.vcol = 1024 + h * 64;
    c.o[0] = (f32x16)ZERO16; c.o[1] = (f32x16)ZERO16;
    const int qpos = r0 + 16 * (32 * g + c.r32);
    load_q(c.qf, base, qpos, h * 64, c.hi);
    MixCp mp; mp.r0 = r0; mp.qpos = qpos; mp.m = -INFINITY; mp.l = 0.f;
    mp.n0 = g + 1;
    mp.j1lo = (r0 >> 2) + 128 * g - 128 > 0 ? (r0 >> 2) + 128 * g - 128 : 0;
    mp.nt = mp.n0 + ((r0 >> 2) + 128 * g + 124 - mp.j1lo) / 32 + 1;
    attn_run<MixCp, true>(mp, c);
    MixC1 m1; m1.qpos = qpos; m1.m = mp.m; m1.l = mp.l;
    const int ra = r0 & 8;
    m1.p0 = 512 * g + ra - 128 > 0 ? 512 * g + ra - 128 : 0;
    m1.nt2 = ((512 * g + ra + 7 + 496 - m1.p0) / 32 + 2) / 2;
    attn_run_shared<MixC1>(m1, c, xlds + 64, w);
    const float l = m1.l + xhalf(m1.l, c.hi);
    store_o(ybase + (size_t)qpos * DM + h * 64, c.o, 1.0f / l, c.hi);
}
struct MixD {
    int nt, nt2, npast, own, q0, qpos; unsigned U, sel; float m, l;
    __device__ __forceinline__ int blk_of(int j) const {
        unsigned u = U; int b = 0;
#pragma unroll
        for (int i = 0; i < 7; ++i) { if (i < j) u &= u - 1u; }
        b = __builtin_ctz(u | 0x100u); return b;
    }
    __device__ __forceinline__ void pos(int t, int& kp0, int& kst) const {
        kst = 1;
        if (t < 8 * npast) kp0 = blk_of(t >> 3) * 256 + (t & 7) * 32; else kp0 = own * 256 + (t - 8 * npast) * 32;
    }
    __device__ __forceinline__ int pos2(int T) const { int kp, ks; pos(2 * T, kp, ks); return kp; }
    __device__ __forceinline__ bool active2(int T, int w) const { return T < 4 * npast || 2 * (T - 4 * npast) <= w; }
    __device__ __forceinline__ void process2(int T, f32x16& s0, f32x16& s1, AttnCtx& c) {
        if (T < 4 * npast) {
            const int blk = blk_of(T >> 2);
            if (!((sel >> blk) & 1u)) {
#pragma unroll
                for (int r = 0; r < 16; ++r) { s0[r] = -INFINITY; s1[r] = -INFINITY; }
            }
        } else {
            const int k0 = own * 256 + (T - 4 * npast) * 64;
#pragma unroll
            for (int r = 0; r < 16; ++r) { const int kk = k0 + crow(r, c.hi); if (kk > qpos) s0[r] = -INFINITY; if (kk + 32 > qpos) s1[r] = -INFINITY; }
        }
        osm_tile2(s0, s1, m, l, c.o);
    }
};
__device__ void attn_D(const bf16* base, const float* kmean  , int h, int q0, bf16* ybase, LAS unsigned char* vlds, LAS unsigned char* xlds, int lane) {
    AttnCtx c; c.base = base; c.r32 = lane & 31; c.hi = lane >> 5; c.lane = lane; c.vlds = vlds; c.klds = vlds + VBUFV; c.kcol = 2048 + h * 64; c.vcol = 2560 + h * 64;
    c.o[0] = (f32x16)ZERO16; c.o[1] = (f32x16)ZERO16;
    const int r32 = c.r32, hi = c.hi, own = q0 >> 8;
    MixD mx; mx.own = own; mx.q0 = q0; mx.qpos = q0 + r32; mx.m = -INFINITY; mx.l = 0.f;
    load_q(c.qf, base, mx.qpos, 1536 + h * 64, hi);
    unsigned sel = 0u;
    if (own > 0) {
        bf16x8 kf[4];
#pragma unroll
        for (int k = 0; k < 4; ++k) {
            u32x4 w = {0u, 0u, 0u, 0u};
            if (r32 < 8) { const float* kp = kmean + r32 * 64 + 16 * k + 8 * hi; const f32x4 a = *(const f32x4*)kp, b = *(const f32x4*)(kp + 4);
                w.x = cvtpk(a[0], a[1]); w.y = cvtpk(a[2], a[3]); w.z = cvtpk(b[0], b[1]); w.w = cvtpk(b[2], b[3]); }
            kf[k] = __builtin_bit_cast(bf16x8, w);
        }
        f32x16 gs = ZERO16;
#pragma unroll
        for (int k = 0; k < 4; ++k) gs = __builtin_amdgcn_mfma_f32_32x32x16_bf16(kf[k], c.qf[k], gs, 0, 0, 0);
        float gt[8];
#pragma unroll
        for (int r = 0; r < 4; ++r) { const float mine = gs[r], oth = xhalf(mine, hi); gt[r] = hi == 0 ? mine : oth; gt[4 + r] = hi == 0 ? oth : mine; }
        const int nsel = own < 3 ? own : 3;
        for (int rr = 0; rr < nsel; ++rr) {
            float best = -INFINITY; int bi = -1;
#pragma unroll
            for (int n = 0; n < 8; ++n) { const bool ok = n < own && !((sel >> n) & 1u) && (bi < 0 || gt[n] > best); if (ok) { best = gt[n]; bi = n; } }
            if (bi >= 0) sel |= 1u << bi;
        }
    }
    unsigned U = 0u;
#pragma unroll
    for (int n = 0; n < 8; ++n) if (__ballot((sel >> n) & 1u) != 0ull) U |= 1u << n;
    {
        volatile LAS unsigned* ux = (volatile LAS unsigned*)xlds;
        __builtin_amdgcn_s_barrier();
        if (lane == 0) ux[(q0 >> 5) & 7] = U;
        asm volatile("s_waitcnt lgkmcnt(0)" ::: "memory");
        __builtin_amdgcn_s_barrier();
        U = ux[0] | ux[1] | ux[2] | ux[3] | ux[4] | ux[5] | ux[6] | ux[7];
        U = __builtin_amdgcn_readfirstlane(U);
    }
    mx.U = U; mx.sel = sel; mx.npast = __builtin_popcount(U); mx.nt = 8 * mx.npast + 8; mx.nt2 = 4 * mx.npast + 4;
    attn_run_shared<MixD>(mx, c, xlds + 64, (q0 >> 5) & 7);
    const float l = mx.l + xhalf(mx.l, c.hi);
    store_o(ybase + (size_t)mx.qpos * DM + 512 + h * 64, c.o, 1.0f / l, hi);
}

__device__ void ph_attn0(const bf16* qkv, const float* sinks, bf16* y, LAS unsigned char* lds, int bid, int nb) {
    const int lane = ltid() & 63, w = __builtin_amdgcn_readfirstlane(ltid() >> 6);
    LAS unsigned char* vlds = lds + w * (VBUF + VBUFV);
    for (int pid = bid; pid < NB * 8; pid += nb) {
        const int b = pid >> 3, h = pid & 7;
        const bf16* base = qkv + (size_t)b * SQ * QKV_LD; bf16* ybase = y + (size_t)b * SQ * DM;
        const float sink = sinks[h];
        for (int rd = 0; rd < 8; ++rd) attn_A(base, h, (rd * 8 + w) * 32, sink, ybase, vlds, lane);
        for (int rd = 0; rd < 8; ++rd) attn_B(base, h, (rd * 8 + w) * 32, ybase, vlds, lane);
    }
}
__device__ void ph_attn1(const bf16* qkv, const float* kmean, bf16* y, LAS unsigned char* lds, int bid, int nb) {
    const int lane = ltid() & 63, w = __builtin_amdgcn_readfirstlane(ltid() >> 6);
    LAS unsigned char* vlds = lds + w * (VBUF + VBUFV);
    for (int pid = bid; pid < NB * 8; pid += nb) {
        const int b = pid >> 3, h = pid & 7;
        const bf16* base = qkv + (size_t)b * SQ * QKV_LD; bf16* ybase = y + (size_t)b * SQ * DM;
        for (int rd = 0; rd < 8; ++rd) { const int it = rd * 8 + w; attn_C(base, h, it & 15, it >> 4, ybase, vlds, lds + 8 * (VBUF + VBUFV), w, lane); }
        for (int rd = 0; rd < 8; ++rd) attn_D(base, kmean + (size_t)pid * 8 * 64, h, (rd * 8 + w) * 32, ybase, vlds, lds + 8 * (VBUF + VBUFV), lane);
    }
}

#define CE_D(a, b) { const float hi_ = fmaxf((a), (b)), lo_ = fminf((a), (b)); (a) = hi_; (b) = lo_; }
#define BSTAGE(arr, k, j) _Pragma("unroll") for (int i_ = 0; i_ < 16; ++i_) { const int l_ = i_ ^ (j); if (l_ > i_) { if ((i_ & (k)) == 0) CE_D(arr[i_], arr[l_]) else CE_D(arr[l_], arr[i_]) } }
__device__ __forceinline__ void bsort16(float (&a)[16]) {
    CE_D(a[0], a[1]) CE_D(a[2], a[3]) CE_D(a[0], a[2]) CE_D(a[1], a[3]) CE_D(a[1], a[2]) CE_D(a[4], a[5]) CE_D(a[6], a[7]) CE_D(a[4], a[6]) CE_D(a[5], a[7]) CE_D(a[5], a[6]) CE_D(a[0], a[4]) CE_D(a[2], a[6]) CE_D(a[2], a[4]) CE_D(a[1], a[5]) CE_D(a[3], a[7]) CE_D(a[3], a[5]) CE_D(a[1], a[2]) CE_D(a[3], a[4]) CE_D(a[5], a[6]) CE_D(a[8], a[9]) CE_D(a[10], a[11]) CE_D(a[8], a[10]) CE_D(a[9], a[11]) CE_D(a[9], a[10]) CE_D(a[12], a[13]) CE_D(a[14], a[15]) CE_D(a[12], a[14]) CE_D(a[13], a[15]) CE_D(a[13], a[14]) CE_D(a[8], a[12]) CE_D(a[10], a[14]) CE_D(a[10], a[12]) CE_D(a[9], a[13]) CE_D(a[11], a[15]) CE_D(a[11], a[13]) CE_D(a[9], a[10]) CE_D(a[11], a[12]) CE_D(a[13], a[14]) CE_D(a[0], a[8]) CE_D(a[4], a[12]) CE_D(a[4], a[8]) CE_D(a[2], a[10]) CE_D(a[6], a[14]) CE_D(a[6], a[10]) CE_D(a[2], a[4]) CE_D(a[6], a[8]) CE_D(a[10], a[12]) CE_D(a[1], a[9]) CE_D(a[5], a[13]) CE_D(a[5], a[9]) CE_D(a[3], a[11]) CE_D(a[7], a[15]) CE_D(a[7], a[11]) CE_D(a[3], a[5]) CE_D(a[7], a[9]) CE_D(a[11], a[13]) CE_D(a[1], a[2]) CE_D(a[3], a[4]) CE_D(a[5], a[6]) CE_D(a[7], a[8]) CE_D(a[9], a[10]) CE_D(a[11], a[12]) CE_D(a[13], a[14])
}
__device__ __forceinline__ void bmerge16(float (&a)[16]) {
    BSTAGE(a, 16, 8) BSTAGE(a, 16, 4) BSTAGE(a, 16, 2) BSTAGE(a, 16, 1)
}
__device__ __forceinline__ void merge_top16(float (&a)[16], const float (&b)[16]) {
#pragma unroll
    for (int i = 0; i < 16; ++i) a[i] = fmaxf(a[i], b[15 - i]);
    bmerge16(a);
}
__device__ __forceinline__ void xmerge16(float (&a)[16]) {
    {
        float A[16], B[16];
#pragma unroll
        for (int i = 0; i < 16; ++i) { auto r = __builtin_amdgcn_permlane16_swap(__float_as_uint(a[i]), __float_as_uint(a[i]), false, false); A[i] = __uint_as_float(r[0]); B[i] = __uint_as_float(r[1]); }
#pragma unroll
        for (int i = 0; i < 16; ++i) a[i] = fmaxf(A[i], B[15 - i]);
        bmerge16(a);
    }
    {
        float A[16], B[16];
#pragma unroll
        for (int i = 0; i < 16; ++i) { auto r = __builtin_amdgcn_permlane32_swap(__float_as_uint(a[i]), __float_as_uint(a[i]), false, false); A[i] = __uint_as_float(r[0]); B[i] = __uint_as_float(r[1]); }
#pragma unroll
        for (int i = 0; i < 16; ++i) a[i] = fmaxf(A[i], B[15 - i]);
        bmerge16(a);
    }
}
__host__ __device__ constexpr int pair_i(int id) {
    int c = 0;
    for (int i = 0; i < 16; ++i) { const int nj = 16 / (i + 1); if (id < c + nj) return i; c += nj; }
    return 0;
}
__host__ __device__ constexpr int pair_j(int id) {
    int c = 0;
    for (int i = 0; i < 16; ++i) { const int nj = 16 / (i + 1); if (id < c + nj) return id - c; c += nj; }
    return 0;
}
constexpr int SK_ROW = 272;
constexpr int SEL_SK_BYTES = 2 * 128 * SK_ROW;
constexpr int SEL_TAB_OFF = SEL_SK_BYTES;
constexpr int SEL_IDX_OFF = SEL_SK_BYTES + 64;

template <int S> __device__ __forceinline__ float cand_slot(const float (&L1)[16], const float (&L2)[16], int g) {
    constexpr int p0 = S, p1 = 16 + S, p2 = 32 + S, p3 = 48 + S;
    const float c0 = L1[pair_i(p0)] + L2[pair_j(p0)], c1 = L1[pair_i(p1)] + L2[pair_j(p1)], c2 = L1[pair_i(p2)] + L2[pair_j(p2)];
    const float c3 = p3 < 50 ? L1[pair_i(p3 < 50 ? p3 : 0)] + L2[pair_j(p3 < 50 ? p3 : 0)] : -1.0e30f;
    const float c = g == 0 ? c0 : (g == 1 ? c1 : (g == 2 ? c2 : c3));
    return __uint_as_float((__float_as_uint(c) & 0xffffffc0u) | (unsigned)(16 * g + S));
}

__device__ void ph_peer_select(const bf16* qry, const float* subkeys  , int* eidx, float* egate  , const float* su, const float* sv, LAS unsigned char* lds, int bid, int nb) {
    const int tid = ltid(), lane = tid & 63, w = __builtin_amdgcn_readfirstlane(tid >> 6);
    const int tk = lane & 15, g = lane >> 4;
    __syncthreads();
    for (int e = tid; e < 2 * 128 * 128 / 2; e += NT) {
        const int row = e >> 6, c2 = (e & 63) * 2;
        const float a = subkeys[(size_t)row * 128 + c2], b = subkeys[(size_t)row * 128 + c2 + 1];
        *(LAS unsigned*)(lds + row * SK_ROW + c2 * 2) = pk2(a, b);
    }
    if (tid < 64) { int id = tid; int c = 0, pi = 0, pj = 0;
        for (int i = 0; i < 16; ++i) { const int nj = 16 / (i + 1); if (id >= c && id < c + nj) { pi = i; pj = id - c; } c += nj; }
        lds[SEL_TAB_OFF + tid] = (unsigned char)((pi << 4) | pj); }
    __syncthreads();
    LAS unsigned* widx = (LAS unsigned*)(lds + SEL_IDX_OFF + w * 512);
    const LAS unsigned char* widx8 = (const LAS unsigned char*)widx;
    const int nitems = (MT / 16) * 8;
    bf16x8 qc[2][4];
    { const int it = bid * 8 + w;
      if (it < nitems) { const bf16* qp = qry + (size_t)((it >> 3) * 16 + tk) * PQ + (it & 7) * 256 + 8 * g;
#pragma unroll
          for (int hf = 0; hf < 2; ++hf)
#pragma unroll
              for (int ks = 0; ks < 4; ++ks) qc[hf][ks] = *(const bf16x8*)(qp + hf * 128 + 32 * ks); } }
    for (int it = bid * 8 + w; it < nitems; it += nb * 8) {
        const int h = it & 7, t0 = (it >> 3) * 16;
        bf16x8 qn[2][4];
        { const int itn = it + nb * 8 < nitems ? it + nb * 8 : it;
          const bf16* qp = qry + (size_t)((itn >> 3) * 16 + tk) * PQ + (itn & 7) * 256 + 8 * g;
#pragma unroll
          for (int hf = 0; hf < 2; ++hf)
#pragma unroll
              for (int ks = 0; ks < 4; ++ks) qn[hf][ks] = *(const bf16x8*)(qp + hf * 128 + 32 * ks); }
        float L[2][16];
#pragma unroll
        for (int hf = 0; hf < 2; ++hf) {
            bf16x8 qf[4];
#pragma unroll
            for (int ks = 0; ks < 4; ++ks) qf[ks] = qc[hf][ks];
            float key[32];
#pragma unroll
            for (int tile = 0; tile < 8; ++tile) {
                f32x4 acc = {0.f, 0.f, 0.f, 0.f};
#pragma unroll
                for (int ks = 0; ks < 4; ++ks) {
                    const bf16x8 af = *(const LAS bf16x8*)(lds + (hf * 128 + tile * 16 + tk) * SK_ROW + (32 * ks + 8 * g) * 2);
                    acc = __builtin_amdgcn_mfma_f32_16x16x32_bf16(af, qf[ks], acc, 0, 0, 0);
                }
#pragma unroll
                for (int r = 0; r < 4; ++r) key[tile * 4 + r] = __uint_as_float((__float_as_uint(acc[r]) & 0xffffff80u) | (unsigned)(16 * tile + 4 * g + r));
            }
            float a[16], b[16];
#pragma unroll
            for (int i = 0; i < 16; ++i) { a[i] = key[i]; b[i] = key[16 + i]; }
            bsort16(a); bsort16(b);
            merge_top16(a, b);
            xmerge16(a);
#pragma unroll
            for (int i = 0; i < 16; ++i) L[hf][i] = a[i];
            unsigned pk = 0u;
#pragma unroll
            for (int s = 0; s < 4; ++s) {
                const float v = g == 0 ? a[s] : (g == 1 ? a[4 + s] : (g == 2 ? a[8 + s] : a[12 + s]));
                pk |= (__float_as_uint(v) & 127u) << (8 * s);
            }
            widx[tk * 8 + hf * 4 + g] = pk;
        }
        float c[16];
        c[0] = cand_slot<0>(L[0], L[1], g); c[1] = cand_slot<1>(L[0], L[1], g); c[2] = cand_slot<2>(L[0], L[1], g); c[3] = cand_slot<3>(L[0], L[1], g);
        c[4] = cand_slot<4>(L[0], L[1], g); c[5] = cand_slot<5>(L[0], L[1], g); c[6] = cand_slot<6>(L[0], L[1], g); c[7] = cand_slot<7>(L[0], L[1], g);
        c[8] = cand_slot<8>(L[0], L[1], g); c[9] = cand_slot<9>(L[0], L[1], g); c[10] = cand_slot<10>(L[0], L[1], g); c[11] = cand_slot<11>(L[0], L[1], g);
        c[12] = cand_slot<12>(L[0], L[1], g); c[13] = cand_slot<13>(L[0], L[1], g); c[14] = cand_slot<14>(L[0], L[1], g); c[15] = cand_slot<15>(L[0], L[1], g);
        bsort16(c);
        xmerge16(c);
        float sum = 0.f, ex[16];
#pragma unroll
        for (int i = 0; i < 16; ++i) { ex[i] = __builtin_amdgcn_exp2f((c[i] - c[0]) * L2E); sum += ex[i]; }
        const float inv = 1.0f / sum;
        int oi[4]; float og[4];
#pragma unroll
        for (int s = 0; s < 4; ++s) {
            const float kv = g == 0 ? c[s] : (g == 1 ? c[4 + s] : (g == 2 ? c[8 + s] : c[12 + s]));
            const float ev = g == 0 ? ex[s] : (g == 1 ? ex[4 + s] : (g == 2 ? ex[8 + s] : ex[12 + s]));
            const unsigned pid = __float_as_uint(kv) & 63u;
            const unsigned ij = lds[SEL_TAB_OFF + pid];
            const unsigned i1 = widx8[tk * 32 + (ij >> 4)], i2 = widx8[tk * 32 + 16 + (ij & 15u)];
            oi[s] = (int)(i1 * 128u + i2); og[s] = ev * inv;
        }
        const size_t ob = (size_t)(t0 + tk) * 128 + h * 16 + 4 * g;
        *(u32x4*)(eidx + ob) = (u32x4){(unsigned)oi[0], (unsigned)oi[1], (unsigned)oi[2], (unsigned)oi[3]};
        *(f32x4*)(egate + ob) = (f32x4){og[0] * sv[oi[0]], og[1] * sv[oi[1]], og[2] * sv[oi[2]], og[3] * sv[oi[3]]};
        *(f32x4*)(egate + 8 * 1024 * 1024 + ob) = (f32x4){su[oi[0]], su[oi[1]], su[oi[2]], su[oi[3]]};
#pragma unroll
        for (int hf = 0; hf < 2; ++hf)
#pragma unroll
            for (int ks = 0; ks < 4; ++ks) qc[hf][ks] = qn[hf][ks];
    }
    __syncthreads();
}

typedef float v32f_t __attribute__((ext_vector_type(32)));
typedef unsigned v6u_t __attribute__((ext_vector_type(6)));
typedef unsigned v16u_t __attribute__((ext_vector_type(16)));
typedef __bf16 v32bf_t __attribute__((ext_vector_type(32)));
typedef __bf16 v2bf_t __attribute__((ext_vector_type(2)));
typedef _Float16 v32h_t __attribute__((ext_vector_type(32)));
typedef unsigned u32x3 __attribute__((ext_vector_type(3)));
constexpr int TROW = 768;
__device__ void ph_tab_fp6(const float* src, unsigned char* dst, float* scale, int nrows, int bid, int nb) {
    const int lane = ltid() & 63, w = __builtin_amdgcn_readfirstlane(ltid() >> 6);
    for (int rp = bid * 8 + w; rp < nrows / 2; rp += nb * 8) {
        v32h_t hv; float sc[2];
#pragma unroll
        for (int rr = 0; rr < 2; ++rr) {
            const float* sp = src + (size_t)(2 * rp + rr) * DM + lane * 16;
            f32x4 v[4]; float am = 0.f;
#pragma unroll
            for (int i = 0; i < 4; ++i) { v[i] = *(const f32x4*)(sp + i * 4); am = fmaxf(am, fmaxf(fmaxf(fabsf(v[i][0]), fabsf(v[i][1])), fmaxf(fabsf(v[i][2]), fabsf(v[i][3])))); }
            am = wave_max(am);
            const float s = am > 0.f ? am * (1.0f / 7.5f) : 1.0f, inv = 1.0f / s;
            sc[rr] = s;
#pragma unroll
            for (int i = 0; i < 4; ++i)
#pragma unroll
                for (int e = 0; e < 4; ++e) hv[rr * 16 + i * 4 + e] = (_Float16)fminf(fmaxf(v[i][e] * inv, -7.5f), 7.5f);
        }
        const v6u_t pk = __builtin_amdgcn_cvt_scalef32_pk32_fp6_f16(hv, 1.0f);
        unsigned* d0 = (unsigned*)(dst + (size_t)(2 * rp) * TROW + lane * 12);
        unsigned* d1 = (unsigned*)(dst + (size_t)(2 * rp + 1) * TROW + lane * 12);
        d0[0] = pk[0]; d0[1] = pk[1]; d0[2] = pk[2]; d1[0] = pk[3]; d1[1] = pk[4]; d1[2] = pk[5];
        if (lane == 0) { scale[2 * rp] = sc[0]; scale[2 * rp + 1] = sc[1]; }
    }
}

constexpr int TROW4 = 512;
constexpr int TROWX = 1024;
__device__ void ph_tab_fp4(const float* src, unsigned char* dst  , float* scale, int nrows, int bid, int nb) {
    const int lane = ltid() & 63, w = __builtin_amdgcn_readfirstlane(ltid() >> 6);
    for (int row = bid * 8 + w; row < nrows; row += nb * 8) {
        const float* sp = src + (size_t)row * DM + lane * 16;
        f32x4 v[4]; float am = 0.f;
#pragma unroll
        for (int i = 0; i < 4; ++i) { v[i] = *(const f32x4*)(sp + i * 4); am = fmaxf(am, fmaxf(fmaxf(fabsf(v[i][0]), fabsf(v[i][1])), fmaxf(fabsf(v[i][2]), fabsf(v[i][3])))); }
        am = wave_max(am);
        const float s = am > 0.f ? am * (1.0f / 6.0f) : 1.0f, inv = 1.0f / s;
        unsigned d0 = 0u, d1 = 0u;
        d0 = __builtin_amdgcn_cvt_scalef32_pk_fp4_f32(d0, v[0][0] * inv, v[0][1] * inv, 1.0f, 0); d0 = __builtin_amdgcn_cvt_scalef32_pk_fp4_f32(d0, v[0][2] * inv, v[0][3] * inv, 1.0f, 1);
        d0 = __builtin_amdgcn_cvt_scalef32_pk_fp4_f32(d0, v[1][0] * inv, v[1][1] * inv, 1.0f, 2); d0 = __builtin_amdgcn_cvt_scalef32_pk_fp4_f32(d0, v[1][2] * inv, v[1][3] * inv, 1.0f, 3);
        d1 = __builtin_amdgcn_cvt_scalef32_pk_fp4_f32(d1, v[2][0] * inv, v[2][1] * inv, 1.0f, 0); d1 = __builtin_amdgcn_cvt_scalef32_pk_fp4_f32(d1, v[2][2] * inv, v[2][3] * inv, 1.0f, 1);
        d1 = __builtin_amdgcn_cvt_scalef32_pk_fp4_f32(d1, v[3][0] * inv, v[3][1] * inv, 1.0f, 2); d1 = __builtin_amdgcn_cvt_scalef32_pk_fp4_f32(d1, v[3][2] * inv, v[3][3] * inv, 1.0f, 3);
        *(u32x2*)(dst + (size_t)row * TROWX + lane * 16) = (u32x2){d0, d1};
        if (lane == 0) scale[row] = s;
    }
}

__device__ void ph_tab_i4(const float* src, unsigned char* dst, float* scale, int nrows, int bid, int nb) {
    const int lane = ltid() & 63, w = __builtin_amdgcn_readfirstlane(ltid() >> 6);
    for (int row = bid * 8 + w; row < nrows; row += nb * 8) {
        const float* sp = src + (size_t)row * DM + lane * 16;
        f32x4 v[4]; float am = 0.f;
#pragma unroll
        for (int i = 0; i < 4; ++i) { v[i] = *(const f32x4*)(sp + i * 4); am = fmaxf(am, fmaxf(fmaxf(fabsf(v[i][0]), fabsf(v[i][1])), fmaxf(fabsf(v[i][2]), fabsf(v[i][3])))); }
        am = wave_max(am);
        const float s = am > 0.f ? am * (1.0f / 7.0f) : 1.0f, inv = 1.0f / s;
        unsigned d[2] = {0u, 0u};
#pragma unroll
        for (int i = 0; i < 16; ++i) { const int q = (int)rintf(fminf(fmaxf(v[i >> 2][i & 3] * inv, -7.0f), 7.0f)); d[i >> 3] |= ((unsigned)q & 15u) << (4 * (i & 7)); }
        *(u32x2*)(dst + (size_t)row * TROWX + lane * 16) = (u32x2){d[0], d[1]};
        if (lane == 0) scale[row] = s;
    }
}

#define DPP_ADD(v, ctrl) ((v) + __builtin_bit_cast(float, __builtin_amdgcn_update_dpp(0, __builtin_bit_cast(int, (v)), (ctrl), 0xf, 0xf, true)))
typedef int i32x4_t __attribute__((ext_vector_type(4)));
constexpr int GT = 2;
typedef int v8i_t __attribute__((ext_vector_type(8)));
typedef int v2i_t __attribute__((ext_vector_type(2)));
struct GSet { u32x2 uq[4]; u32x2 vq[4]; };
__device__ __forceinline__ void gather_issue(GSet& S, int bt, int lane, const unsigned char* pu, const unsigned char* pv, const LAS int* etok) {
    const i32x4_t ev = *(const LAS i32x4_t*)(etok + bt * 4);
    const int es[4] = {ev.x, ev.y, ev.z, ev.w};
#pragma unroll
    for (int k = 0; k < 2; ++k) {
        const unsigned f0 = (unsigned)es[2 * k] * (unsigned)TROWX + (unsigned)lane * 16u, f1 = (unsigned)es[2 * k + 1] * (unsigned)TROWX + (unsigned)lane * 16u;
        const u32x4 r0 = *(const u32x4*)(pu + f0), r1 = *(const u32x4*)(pu + f1);
        S.uq[2 * k] = (u32x2){r0.x, r0.y}; S.vq[2 * k] = (u32x2){r0.z, r0.w}; S.uq[2 * k + 1] = (u32x2){r1.x, r1.y}; S.vq[2 * k + 1] = (u32x2){r1.z, r1.w};
    }
}
constexpr int GV_ROW = 520;
constexpr int GV_BYTES = 16 * GV_ROW, GC_BYTES = 96;
__device__ __forceinline__ float gather_udot(const GSet& S, const unsigned (&hd)[4], LAS unsigned char* vrow) {
    int d[4];
#pragma unroll
    for (int k = 0; k < 4; ++k) {
        const int q0 = (int)S.uq[k].x, q1 = (int)S.uq[k].y;
        int a1, a2;
        asm("v_dot8_i32_i4 %0, %1, %2, 0" : "=v"(a1) : "v"(q0), "v"(hd[0]));
        asm("v_dot8_i32_i4 %0, %1, %2, 0" : "=v"(a2) : "v"(q0), "v"(hd[2]));
        a1 = __builtin_amdgcn_sdot8(q1, (int)hd[1], a1, false); a2 = __builtin_amdgcn_sdot8(q1, (int)hd[3], a2, false);
        d[k] = (a1 << 4) + a2;
    }
#pragma unroll
    for (int k = 0; k < 4; ++k) *(LAS u32x2*)(vrow + k * GV_ROW) = S.vq[k];
    int e2[2], f1;
#pragma unroll
    for (int k = 0; k < 2; ++k) { auto r = __builtin_amdgcn_permlane16_swap((unsigned)d[k], (unsigned)d[k + 2], false, false); e2[k] = (int)r[0] + (int)r[1]; }
    { auto r = __builtin_amdgcn_permlane32_swap((unsigned)e2[0], (unsigned)e2[1], false, false); f1 = (int)r[0] + (int)r[1]; }
    f1 += __builtin_amdgcn_update_dpp(0, f1, 0xB1, 0xf, 0xf, true); f1 += __builtin_amdgcn_update_dpp(0, f1, 0x4E, 0xf, 0xf, true);
    f1 += __builtin_amdgcn_update_dpp(0, f1, 0x124, 0xf, 0xf, true); f1 += __builtin_amdgcn_update_dpp(0, f1, 0x128, 0xf, 0xf, true);
    return (float)f1;
}
#define DPP_MAX(v, ctrl) fmaxf((v), __builtin_bit_cast(float, __builtin_amdgcn_update_dpp(0, __builtin_bit_cast(int, (v)), (ctrl), 0xf, 0xf, true)))
__device__ __forceinline__ void gather_vpart(float f0, float f1, float f2, float f3, int lane, int kslot, const LAS float* lg  ,
                                             const LAS unsigned char* vrd  , LAS unsigned char* cb, int aoff1, int aoff2, f32x4 (&acc)[8]) {
    const int q = (lane >> 2) & 3, e16 = 4 * q + kslot;
    const float fs = q == 0 ? f0 : q == 1 ? f1 : q == 2 ? f2 : f3;
    const float cv = lg[e16] * gelu_erf(fs * lg[GT * 128 + e16]);
    float mx = fabsf(cv);
    mx = DPP_MAX(mx, 0x124); mx = DPP_MAX(mx, 0x128);
    { auto r = __builtin_amdgcn_permlane16_swap(__float_as_uint(mx), __float_as_uint(mx), false, false); mx = fmaxf(__uint_as_float(r[0]), __uint_as_float(r[1])); }
    { auto r = __builtin_amdgcn_permlane32_swap(__float_as_uint(mx), __float_as_uint(mx), false, false); mx = fmaxf(__uint_as_float(r[0]), __uint_as_float(r[1])); }
    int E = (int)((__float_as_uint(mx) >> 23) & 0xffu); E = E < 8 ? 8 : E;
    const float x = cv * __uint_as_float((unsigned)(255 - E) << 23);
    const unsigned p1 = __builtin_amdgcn_cvt_scalef32_pk_fp4_f32(0u, x, 0.f, 1.0f, 0);
    const float r1 = x - __builtin_amdgcn_cvt_scalef32_pk_f32_fp4(p1, 1.0f, 0)[0];
    const unsigned p2 = __builtin_amdgcn_cvt_scalef32_pk_fp4_f32(0u, r1, 0.f, 1.0f, 0);
    const float y = (r1 - __builtin_amdgcn_cvt_scalef32_pk_f32_fp4(p2, 1.0f, 0)[0]) * 16.0f;
    const unsigned p3 = __builtin_amdgcn_cvt_scalef32_pk_fp4_f32(0u, y, 0.f, 1.0f, 0);
    const float r3 = y - __builtin_amdgcn_cvt_scalef32_pk_f32_fp4(p3, 1.0f, 0)[0];
    const unsigned p4 = __builtin_amdgcn_cvt_scalef32_pk_fp4_f32(0u, r3, 0.f, 1.0f, 0);
    const unsigned codes = (p1 & 15u) | ((p2 & 15u) << 8) | ((p3 & 15u) << 16) | ((p4 & 15u) << 24);
    { auto r = __builtin_amdgcn_permlane32_swap(codes, codes, false, false);
      const unsigned w = codes | ((r[0] ^ r[1] ^ codes) << 4);
      if (lane < 32 && (lane & 3) == 0) {
          LAS unsigned char* tb = cb + 8 + 2 * q + ((lane >> 4) & 1);
          tb[0] = (unsigned char)w; tb[16] = (unsigned char)(w >> 8); tb[32] = (unsigned char)(w >> 16); tb[48] = (unsigned char)(w >> 24);
      } }
    const u32x2 a10 = *(const LAS u32x2*)(cb + aoff1), a11 = *(const LAS u32x2*)(cb + aoff1 + 8), a20 = *(const LAS u32x2*)(cb + aoff2), a21 = *(const LAS u32x2*)(cb + aoff2 + 8);
    const v8i_t A1 = {(int)a10.x, (int)a10.y, (int)a11.x, (int)a11.y, 0, 0, 0, 0}, A2 = {(int)a20.x, (int)a20.y, (int)a21.x, (int)a21.y, 0, 0, 0, 0};
    const int sa1 = (E - 1) * 0x01010101, sa2 = (E - 5) * 0x01010101;
#pragma unroll
    for (int m = 0; m < 8; ++m) {
        const v2i_t t0 = __builtin_amdgcn_ds_read_tr4_b64_v2i32((LAS v2i_t*)(vrd + 16 * m)), t1 = __builtin_amdgcn_ds_read_tr4_b64_v2i32((LAS v2i_t*)(vrd + 16 * m + 8));
        const v8i_t B = {t0.x, t0.y, t1.x, t1.y, 0, 0, 0, 0};
        acc[m] = __builtin_amdgcn_mfma_scale_f32_16x16x128_f8f6f4(A1, B, acc[m], 4, 4, 0, sa1, 0, 0x7F7F7F7F);
        acc[m] = __builtin_amdgcn_mfma_scale_f32_16x16x128_f8f6f4(A2, B, acc[m], 4, 4, 0, sa2, 0, 0x7F7F7F7F);
    }
}
__device__ __forceinline__ void xcd_pace(unsigned* bar, volatile LAS unsigned* st);
constexpr int GNS = 8, GBPS = 32 / GNS, GSHIFT = 11;
constexpr int GATH_LDS_WAVE = GT * 128 * 12 + GV_BYTES + GC_BYTES;
#define GATH_SEG(J, NJ, nbt) { \
        const LAS int* le_ = lse + (J) * 128; const LAS int* ne_ = lse + (NJ) * 128; \
        gather_issue(D, GBPS * c + 3, lane, pu, pv, le_); \
        const float f0_ = hsc[J] * gather_udot(A, hd[J], vwr); \
        gather_issue(A, (nbt), lane, pu, pv, ne_); \
        const float f1_ = hsc[J] * gather_udot(B, hd[J], vwr + 4 * GV_ROW); \
        gather_issue(B, (nbt) + 1, lane, pu, pv, ne_); \
        const float f2_ = hsc[J] * gather_udot(C, hd[J], vwr + 8 * GV_ROW); \
        gather_issue(C, (nbt) + 2, lane, pu, pv, ne_); \
        const float f3_ = hsc[J] * gather_udot(D, hd[J], vwr + 12 * GV_ROW); \
        gather_vpart(f0_, f1_, f2_, f3_, lane, kslot, lsg + (J) * 128 + 16 * c, vrd, cb, aoff1, aoff2, acc[J]); }
__device__ void ph_peer_gather(const bf16* h2, const unsigned char* pu, const unsigned char* pv, const float* su, const float* sv,
                               const int* eidx, const float* egate, const bf16* xin  , const float* gate  , float* xout, LAS unsigned char* lds, unsigned* pace_bar, volatile LAS unsigned* pace_st, int bid, int nb,
                               bf16* xmid  ) {
    const int lane0 = ltid() & 63, w = __builtin_amdgcn_readfirstlane(ltid() >> 6);
    LAS int* lse = (LAS int*)(lds + w * GATH_LDS_WAVE); LAS float* lsg = (LAS float*)(lds + w * GATH_LDS_WAVE + GT * 128 * 4);
    LAS unsigned char* vb = lds + w * GATH_LDS_WAVE + GT * 128 * 12; LAS unsigned char* cb = vb + GV_BYTES;
    if (lane0 < GC_BYTES / 4) ((LAS unsigned*)cb)[lane0] = 0u;
    for (int t0 = (bid * 8 + w) * GT; t0 < MT; t0 += nb * 8 * GT) {
        int lane = lane0; asm volatile("" : "+v"(lane));
        const int row = lane >> 4;
        const int kslot = 2 * (row & 1) + (row >> 1);
        const int b = t0 >> 11;
        LAS unsigned char* vwr = vb + lane * 8;
        const LAS unsigned char* vrd = vb + (lane & 15) * GV_ROW + 128 * row;
        const int ai = lane & 15, au = (ai < 8 ? 1 : 3), nz = ((ai & 7) >> 1) == row;
        const int aoff1 = nz ? 8 * (au - (ai & 1)) : 64, aoff2 = nz ? 8 * (au + 4 - (ai & 1)) : 64;
        unsigned hd[GT][4]; float hsc[GT]; f32x4 acc[GT][8];
#pragma unroll
        for (int j = 0; j < GT; ++j) {
            const int t = t0 + j;
            const int e0 = eidx[(size_t)t * 128 + lane], e1 = eidx[(size_t)t * 128 + 64 + lane];
            const float g0 = egate[(size_t)t * 128 + lane], g1 = egate[(size_t)t * 128 + 64 + lane];
            const int k0 = e0 >> GSHIFT, k1 = e1 >> GSHIFT;
            int off = 0, d0 = 0, d1 = 0;
#pragma unroll
            for (int s = 0; s < GNS; ++s) {
                const unsigned long long m0 = __ballot(k0 == s), m1 = __ballot(k1 == s);
                const int r0 = (int)__builtin_amdgcn_mbcnt_hi((unsigned)(m0 >> 32), __builtin_amdgcn_mbcnt_lo((unsigned)m0, 0u));
                const int r1 = (int)__builtin_amdgcn_mbcnt_hi((unsigned)(m1 >> 32), __builtin_amdgcn_mbcnt_lo((unsigned)m1, 0u));
                const int c0 = __builtin_popcountll(m0);
                if (k0 == s) d0 = off + r0;
                if (k1 == s) d1 = off + c0 + r1;
                off += c0 + __builtin_popcountll(m1);
            }
            const float s0 = egate[8 * 1024 * 1024 + (size_t)t * 128 + lane], s1 = egate[8 * 1024 * 1024 + (size_t)t * 128 + 64 + lane];
            lse[j * 128 + d0] = e0; lsg[j * 128 + d0] = g0; lse[j * 128 + d1] = e1; lsg[j * 128 + d1] = g1;
            lsg[GT * 128 + j * 128 + d0] = s0; lsg[GT * 128 + j * 128 + d1] = s1;
            const u32x4 u0 = *(const u32x4*)(h2 + (size_t)t * DM + lane * 16), u1 = *(const u32x4*)(h2 + (size_t)t * DM + lane * 16 + 8);
            {
                float hf[16];
#pragma unroll
                for (int i = 0; i < 4; ++i) { hf[2 * i] = __uint_as_float(u0[i] << 16); hf[2 * i + 1] = __uint_as_float(u0[i] & 0xffff0000u); hf[8 + 2 * i] = __uint_as_float(u1[i] << 16); hf[8 + 2 * i + 1] = __uint_as_float(u1[i] & 0xffff0000u); }
                float mh = 0.f;
#pragma unroll
                for (int i = 0; i < 16; ++i) mh = fmaxf(mh, fabsf(hf[i]));
                mh = wave_max(mh);
                int Eh = (int)((__float_as_uint(mh) >> 23) & 0xffu); Eh = Eh < 8 ? 8 : Eh;
                const float up = __uint_as_float((unsigned)(255 - Eh) << 23);
                hsc[j] = __uint_as_float((unsigned)(Eh - 5) << 23);
                unsigned p1[2] = {0u, 0u}, p2[2] = {0u, 0u};
#pragma unroll
                for (int i = 0; i < 16; ++i) {
                    const float x = hf[i] * up, r1 = rintf(x);
                    int q2 = (int)rintf((x - r1) * 16.0f); q2 = q2 > 7 ? 7 : q2;
                    p1[i >> 3] |= ((unsigned)(int)r1 & 15u) << (4 * (i & 7)); p2[i >> 3] |= ((unsigned)q2 & 15u) << (4 * (i & 7));
                }
                hd[j][0] = p1[0]; hd[j][1] = p1[1]; hd[j][2] = p2[0]; hd[j][3] = p2[1];
            }
#pragma unroll
            for (int i = 0; i < 8; ++i) acc[j][i] = (f32x4){0.f, 0.f, 0.f, 0.f};
        }
        GSet A, B, C, D;
        gather_issue(A, 0, lane, pu, pv, lse); gather_issue(B, 1, lane, pu, pv, lse); gather_issue(C, 2, lane, pu, pv, lse);
#pragma unroll 1
        for (int c = 0; c < GNS; ++c) {
            GATH_SEG(0, 1, GBPS * c)
            GATH_SEG(1, 0, c < GNS - 1 ? GBPS * c + GBPS : 0)
        }
#pragma unroll
        for (int j = 0; j < GT; ++j) {
            const int t = t0 + j;
            LAS float* ob = (LAS float*)vb;
            const int nbase = 512 * (row & 1) + 32 * (row >> 1) + (lane & 15);
#pragma unroll
            for (int pm = 0; pm < 4; ++pm)
#pragma unroll
                for (int r = 0; r < 4; ++r) {
                    auto sw = __builtin_amdgcn_permlane32_swap(__float_as_uint(acc[j][2 * pm][r]), __float_as_uint(acc[j][2 * pm + 1][r]), false, false);
                    ob[nbase + 256 * (r >> 1) + 64 * pm + 16 * (r & 1)] = __uint_as_float(sw[0]) + __uint_as_float(sw[1]);
                }
#pragma unroll
            for (int i = 0; i < 4; ++i) {
                const int cc = i * 256 + lane * 4;
                const f32x4 a = *(const LAS f32x4*)(ob + cc);
                const u32x2 xq = *(const u32x2*)(xin + (size_t)t * DM + cc); const f32x4 gt = *(const f32x4*)(gate + (size_t)b * 6144 + cc);
                const f32x4 xi = {__uint_as_float(xq.x << 16), __uint_as_float(xq.x & 0xffff0000u), __uint_as_float(xq.y << 16), __uint_as_float(xq.y & 0xffff0000u)};
                f32x4 o;
#pragma unroll
                for (int e = 0; e < 4; ++e) o[e] = xi[e] + gt[e] * a[e];
                if (xmid) { u32x2 pk; pk.x = pk2(o[0], o[1]); pk.y = pk2(o[2], o[3]); *(u32x2*)(xmid + (size_t)t * DM + cc) = pk; }
                else __builtin_nontemporal_store(o, (f32x4*)(xout + (size_t)t * DM + cc));
            }
        }
    }
}

#define XB_TMO      128
#define XB_XCNT(j)  (256  + 64 * (j))
#define XB_XSUB(j)  (1280 + 64 * (j))
#define XB_XGEN(j)  (2304 + 64 * (j))
#define XB_TOP      3328
#define XB_TOPGEN   3392
#define XCD_BAR_WORDS 3456
#define XB_SPIN_CAP (1u << 18)

__device__ __forceinline__ unsigned xb_ld(unsigned* p)              { return __hip_atomic_load(p, __ATOMIC_RELAXED, __HIP_MEMORY_SCOPE_AGENT); }
__device__ __forceinline__ unsigned xb_add(unsigned* p, unsigned v) { return __hip_atomic_fetch_add(p, v, __ATOMIC_RELAXED, __HIP_MEMORY_SCOPE_AGENT); }
__device__ __forceinline__ unsigned xb_xcc_id() { return (unsigned)__builtin_amdgcn_s_getreg((3 << 11) | 20) & 0xFu; }
#define XB_SPIN(cond, bar) do { unsigned _sp = 0; while (cond) { __builtin_amdgcn_s_sleep(1); \
    if ((++_sp & 255u) == 0u) { if (xb_ld(&(bar)[XB_TMO])) break; if (_sp > XB_SPIN_CAP) { atomicAdd(&(bar)[XB_TMO], 1u); break; } } } } while (0)

struct XcdBarrier {
    unsigned* bar; unsigned x;
    volatile LAS unsigned* st;
};

__device__ __forceinline__ XcdBarrier xcd_barrier_post(unsigned* bar, volatile LAS unsigned* st) {
    XcdBarrier b; b.bar = bar; b.x = xb_xcc_id(); b.st = st;
    if (threadIdx.x == 0) (void)xb_add(&bar[XB_XCNT(b.x)], 1u);
    return b;
}
__device__ __forceinline__ void xcd_barrier_complete(unsigned* bar, unsigned x, unsigned& nloc, unsigned& nx) {
    const unsigned G = gridDim.x * gridDim.y * gridDim.z;
    unsigned sum, cnt, mine, sp = 0u;
    for (;;) {
        sum = 0u; cnt = 0u; mine = 0u;
#pragma unroll
        for (unsigned j = 0; j < 16; ++j) { const unsigned c = xb_ld(&bar[XB_XCNT(j)]); sum += c; cnt += (c > 0u) ? 1u : 0u; mine = (j == x) ? c : mine; }
        if (sum == G) break;
        __builtin_amdgcn_s_sleep(1);
        if ((++sp & 255u) == 0u) { if (xb_ld(&bar[XB_TMO])) break; if (sp > XB_SPIN_CAP) { atomicAdd(&bar[XB_TMO], 1u); break; } }
    }
    nloc = mine > 0u ? mine : 1u; nx = cnt > 0u ? cnt : 1u;
}

__device__ __forceinline__ void xcd_barrier(const XcdBarrier& b) {
    asm volatile("s_waitcnt vmcnt(0)" ::: "memory");
    __syncthreads();
    if (threadIdx.x == 0) {
        unsigned* bar = b.bar;
        __builtin_amdgcn_s_waitcnt(0);
        unsigned nloc = b.st[0], nx = b.st[1];
        if (nloc == 0u) { xcd_barrier_complete(bar, b.x, nloc, nx); b.st[0] = nloc; b.st[1] = nx; }
        const unsigned old = xb_add(&bar[XB_XSUB(b.x)], 1u);
        const unsigned gen = old / nloc;
        if (old + 1u == (gen + 1u) * nloc) {
            __builtin_amdgcn_fence(__ATOMIC_RELEASE, "agent");
            asm volatile("s_waitcnt vmcnt(0)" ::: "memory");
            const unsigned og = xb_add(&bar[XB_TOP], 1u);
            const unsigned tg = og / nx;
            if (og + 1u == (tg + 1u) * nx) xb_add(&bar[XB_TOPGEN], 1u);
            else XB_SPIN(xb_ld(&bar[XB_TOPGEN]) == tg, bar);
            __builtin_amdgcn_fence(__ATOMIC_ACQUIRE, "agent");
            xb_add(&bar[XB_XGEN(b.x)], 1u);
            asm volatile("s_waitcnt vmcnt(0)" ::: "memory");
        } else {
            XB_SPIN(xb_ld(&bar[XB_XGEN(b.x)]) == gen, bar);
            __builtin_amdgcn_fence(__ATOMIC_ACQUIRE, "agent");
            asm volatile("s_waitcnt vmcnt(0)" ::: "memory");
        }
    }
    __syncthreads();
}


#define XB_PACE(j) (3584 + 64 * (j))
__device__ __forceinline__ void xcd_pace(unsigned* bar, volatile LAS unsigned* st) {
    __syncthreads();
    if (threadIdx.x == 0) {
        const unsigned nloc = st[0] ? st[0] : 1u, x = xb_xcc_id(), gen = st[4] + 1u;
        st[4] = gen;
        xb_add(&bar[XB_PACE(x)], 1u);
        unsigned sp = 0;
        while (xb_ld(&bar[XB_PACE(x)]) < gen * nloc) { __builtin_amdgcn_s_sleep(1); if (++sp > (1u << 16)) break; }
    }
    __syncthreads();
}
extern __shared__ __attribute__((aligned(16))) unsigned char dyn_lds[];
#ifndef REP_PREP
#define REP_PREP 1
#endif
#ifndef REP_ATTN
#define REP_ATTN 1
#endif
#ifndef REP_SEL
#define REP_SEL 1
#endif
#ifndef REP_GATH
#define REP_GATH 1
#endif
#ifndef REP_GEMM
#define REP_GEMM 1
#endif
#ifndef REP_ADALN
#define REP_ADALN 1
#endif
constexpr int LDS_BYTES = 147456;

template <class T> __device__ __forceinline__ T* karg(int byte_off) {
    const __attribute__((address_space(4))) char* base = (const __attribute__((address_space(4))) char*)__builtin_amdgcn_kernarg_segment_ptr();
    unsigned long long v = *(const __attribute__((address_space(4))) unsigned long long*)(base + byte_off);
    asm volatile("" : "+s"(v));
    return (T*)(__attribute__((address_space(1))) T*)v;
}
#define KIN(i) karg<const float>(8 * (i))
#define KOUT() karg<float>(168)
#define KWS() karg<unsigned char>(176)
static_assert(sizeof(Params) == 184, "Params layout");
template <class T> __device__ __forceinline__ T* launder(T* p) { size_t off = 0; asm volatile("" : "+s"(off)); return (T*)((unsigned char*)p + off); }
__global__ void __launch_bounds__(NT) mega_fwd(Params p) {
    cg::grid_group grid = cg::this_grid();
    const int bid = blockIdx.x, nb = gridDim.x;
    volatile LAS unsigned* bst = (volatile LAS unsigned*)((LAS unsigned char*)dyn_lds + LDS_BYTES - 64);
    if (ltid() < 16) bst[ltid()] = 0u;
    __syncthreads();
    const XcdBarrier xbar = xcd_barrier_post((unsigned*)(KWS() + WS_BAR), bst);
    for (int rep = 0; rep < REP_PREP; ++rep) {
        unsigned char* ws = KWS();
        float* tile = (float*)dyn_lds;
        ph_transpose(KIN(6), (bf16*)(ws + WS_WIN0), 1024, AB_IN, true, tile, bid, nb);
        ph_transpose(KIN(11), (bf16*)(ws + WS_WIN1), 1024, CD_IN, true, tile, bid, nb);
        ph_transpose(KIN(7), (bf16*)(ws + WS_WO0), 1024, 1024, false, tile, bid, nb);
        ph_transpose(KIN(12), (bf16*)(ws + WS_WO1), 1024, 1024, false, tile, bid, nb);
        ph_transpose(KIN(17), (bf16*)(ws + WS_WQ), 1024, PQ, false, tile, bid, nb);
        ph_transpose(KIN(17) + (size_t)1024 * PQ, (bf16*)(ws + WS_WQ) + (size_t)PQ * 1024, 1024, PQ, false, tile, bid, nb);
        ws = launder(ws);
        ph_tab_i4(KIN(19), ws + WS_PU, (float*)(ws + WS_PV), 2 * NEXP, bid, nb);
        ph_tab_fp4(KIN(20), ws + WS_PU + 8, (float*)(ws + WS_PV + 1 * MiB), 2 * NEXP, bid, nb);
        ws = launder(ws);
        ph_mod(KIN(1), KIN(2), KIN(3), (float*)(ws + WS_MOD), (float*)dyn_lds, bid, nb);
        ph_rope_table((float*)(ws + WS_ROPE), bid, nb);
        for (int i = bid * NT + ltid(); i < NB * 8 * 8 * 64; i += nb * NT) ((float*)(ws + WS_KMEAN))[i] = 0.f;
    }
    grid.sync();
#pragma unroll 1
    for (int layer = 0; layer < 2; ++layer) {
        for (int rep = 0; rep < REP_ADALN; ++rep) {
            unsigned char* ws = KWS(); const float* mod = (const float*)(ws + WS_MOD) + (size_t)layer * 32 * 6144;
            if (layer == 0) ph_adaln<false>(KIN(0), KIN(4), mod + 0, mod + 1024, (bf16*)(ws + WS_HY), bid, nb);
            else ph_adaln<true>(ws + WS_X1 + 128 * MiB, KIN(4) + DM, mod + 0, mod + 1024, (bf16*)(ws + WS_HY), bid, nb);
        }
        xcd_barrier(xbar);
        for (int rep = 0; rep < REP_GEMM; ++rep) {
            unsigned char* ws = KWS();
            pg8::Gemm g{(const bf16*)(ws + WS_HY), (const bf16*)(ws + (layer == 0 ? WS_WIN0 : WS_WIN1)), MT, layer == 0 ? AB_IN : CD_IN, DM};
            pg8::StaticOrder S; S.init(g.M, g.N, nb, bid);
            pg8::EpiQKV e{(bf16*)(ws + WS_QKV), QKV_LD, (const float*)(ws + WS_ROPE), layer, layer == 0 ? KIN(9) : KIN(13), layer == 0 ? KIN(10) : KIN(14), KIN(15), KIN(16), (float*)(ws + WS_KMEAN)};
            pg8::gemm_phase<pg8::EpiQKV, pg8::StaticOrder, true, true>((LAS unsigned char*)dyn_lds, g, S, e);
        }
        xcd_barrier(xbar);
        for (int rep = 0; rep < REP_ATTN; ++rep) {
            unsigned char* ws = KWS();
            if (layer == 0) ph_attn0((const bf16*)(ws + WS_QKV), KIN(8), (bf16*)(ws + WS_HY), (LAS unsigned char*)dyn_lds, bid, nb);
            else ph_attn1((const bf16*)(ws + WS_QKV), (const float*)(ws + WS_KMEAN), (bf16*)(ws + WS_HY), (LAS unsigned char*)dyn_lds, bid, nb);
        }
        xcd_barrier(xbar);
        for (int rep = 0; rep < REP_GEMM; ++rep) {
            unsigned char* ws = KWS(); const float* mod = (const float*)(ws + WS_MOD) + (size_t)layer * 32 * 6144;
            pg8::Gemm g{(const bf16*)(ws + WS_HY), (const bf16*)(ws + (layer == 0 ? WS_WO0 : WS_WO1)), MT, DM, DM};
            pg8::StaticOrder S; S.init(g.M, g.N, nb, bid);
            if (layer == 0) { pg8::EpiResid<false> e{KIN(0), (pg8::bf16_t*)(ws + WS_X1), mod + 2048}; pg8::gemm_phase<pg8::EpiResid<false>, pg8::StaticOrder, true, true>((LAS unsigned char*)dyn_lds, g, S, e); }
            else { pg8::EpiResid<true> e{ws + WS_X1 + 128 * MiB, (pg8::bf16_t*)(ws + WS_X1), mod + 2048}; pg8::gemm_phase<pg8::EpiResid<true>, pg8::StaticOrder, true, true>((LAS unsigned char*)dyn_lds, g, S, e); }
        }
        xcd_barrier(xbar);
        for (int rep = 0; rep < REP_ADALN; ++rep) {
            unsigned char* ws = KWS(); const float* mod = (const float*)(ws + WS_MOD) + (size_t)layer * 32 * 6144;
            ph_adaln<true>(ws + WS_X1, KIN(5) + layer * DM, mod + 3072, mod + 4096, (bf16*)(ws + WS_QKV), bid, nb);
        }
        xcd_barrier(xbar);
        for (int rep = 0; rep < REP_GEMM; ++rep) {
            unsigned char* ws = KWS();
            pg8::Gemm g{(const bf16*)(ws + WS_QKV), (const bf16*)(ws + WS_WQ) + (size_t)layer * PQ * DM, MT, PQ, DM};
            pg8::StaticOrder S; S.init(g.M, g.N, nb, bid); pg8::EpiStore e{(bf16*)(ws + WS_QKV + 128 * MiB), PQ};
            pg8::gemm_phase<pg8::EpiStore, pg8::StaticOrder, true, true>((LAS unsigned char*)dyn_lds, g, S, e);
        }
        xcd_barrier(xbar);
        for (int rep = 0; rep < REP_SEL; ++rep) {
            unsigned char* ws = KWS();
            ph_peer_select((const bf16*)(ws + WS_QKV + 128 * MiB), KIN(18) + (size_t)layer * 2 * 128 * 128, (int*)(ws + WS_HY), (float*)(ws + WS_HY + 32 * MiB), (const float*)(ws + WS_PV) + layer * NEXP, (const float*)(ws + WS_PV + 1 * MiB) + layer * NEXP, (LAS unsigned char*)dyn_lds, bid, nb);
        }
        xcd_barrier(xbar);
        for (int rep = 0; rep < REP_GATH; ++rep) {
            unsigned char* ws = KWS(); const float* mod = (const float*)(ws + WS_MOD) + (size_t)layer * 32 * 6144;
            ph_peer_gather((const bf16*)(ws + WS_QKV), ws + WS_PU + (size_t)layer * NEXP * TROWX, ws + WS_PU + (size_t)layer * NEXP * TROWX,
                           (const float*)(ws + WS_PV) + layer * NEXP, (const float*)(ws + WS_PV + 1 * MiB) + layer * NEXP, (const int*)(ws + WS_HY), (const float*)(ws + WS_HY + 32 * MiB), (const bf16*)(ws + WS_X1), mod + 5120, KOUT(), (LAS unsigned char*)dyn_lds, (unsigned*)(ws + WS_BAR), bst, bid, nb, layer == 0 ? (bf16*)(ws + WS_X1 + 128 * MiB) : (bf16*)nullptr);
        }
        if (layer == 0) xcd_barrier(xbar);
    }
}

extern "C" void kernel_launch(void* const* d_in, const int* in_sizes, int n_in, void* d_out, int out_size, void* d_ws, size_t ws_size, hipStream_t stream) {
    if (n_in != 21 || ws_size < WS_END) { fprintf(stderr, "kernel_launch: bad args n_in=%d ws=%zu\n", n_in, ws_size); return; }
    static int grid_blocks = 0;
    if (!grid_blocks) {
        int dev = 0, cus = 0, per_cu = 0;
        (void)hipGetDevice(&dev);
        (void)hipDeviceGetAttribute(&cus, hipDeviceAttributeMultiprocessorCount, dev);
        (void)hipFuncSetAttribute((const void*)mega_fwd, hipFuncAttributeMaxDynamicSharedMemorySize, LDS_BYTES);
        (void)hipOccupancyMaxActiveBlocksPerMultiprocessor(&per_cu, (const void*)mega_fwd, NT, LDS_BYTES);
        if (per_cu < 1) { fprintf(stderr, "kernel_launch: occupancy query returned %d\n", per_cu); per_cu = 1; }
        if (per_cu > 1) per_cu = 1;
        grid_blocks = cus * per_cu;
    }
    Params p{};
    for (int i = 0; i < 21; ++i) p.in[i] = (const float*)d_in[i];
    p.out = (float*)d_out; p.ws = (unsigned char*)d_ws;
    (void)hipMemsetAsync((char*)d_ws + WS_BAR, 0, 16384, stream);
    void* args[] = {&p};
    hipError_t e = hipLaunchCooperativeKernel((const void*)mega_fwd, dim3(grid_blocks), dim3(NT), args, LDS_BYTES, stream);
    if (e != hipSuccess) fprintf(stderr, "cooperative launch failed: %s (grid %d)\n", hipGetErrorString(e), grid_blocks);
}
```

```cpp
#include <hip/hip_runtime.h>
#ifndef REP_A
#define REP_A 1
#endif
#ifndef REP_B
#define REP_B 1
#endif
#ifndef REP_C
#define REP_C 1
#endif
#ifndef REP_D
#define REP_D 1
#endif
#include <hip/hip_cooperative_groups.h>
namespace cg = cooperative_groups;
#include <cstdio>
#include <cstdint>
#include <cmath>

typedef unsigned short bf16;
typedef short bf16x8 __attribute__((ext_vector_type(8)));
typedef float f32x4 __attribute__((ext_vector_type(4)));
typedef unsigned u32x4 __attribute__((ext_vector_type(4)));
typedef unsigned u32x2 __attribute__((ext_vector_type(2)));

constexpr int DM = 1024, NB = 32, SQ = 2048, MT = NB * SQ;
constexpr int HD = 64;
constexpr int AB_IN = 2304, CD_IN = 3072, QKV_LD = 3072;
constexpr int NEXP = 16384, PQ = 2048;
constexpr float EPS = 1e-6f;
constexpr int NT = 512;

constexpr size_t MiB = 1u << 20;
constexpr size_t WS_X1 = 0;
constexpr size_t WS_QKV = 256 * MiB;
constexpr size_t WS_HY = 640 * MiB;
constexpr size_t WS_PU = 768 * MiB;
constexpr size_t WS_PV = 832 * MiB;
constexpr size_t WS_WIN0 = 896 * MiB;
constexpr size_t WS_WIN1 = 901 * MiB;
constexpr size_t WS_WO0 = 907 * MiB;
constexpr size_t WS_WO1 = 909 * MiB;
constexpr size_t WS_WQ = 911 * MiB;
constexpr size_t WS_MOD = 919 * MiB;
constexpr size_t WS_ROPE = 921 * MiB;
constexpr size_t WS_KMEAN = 922 * MiB;
constexpr size_t WS_BAR = 923 * MiB;
constexpr size_t WS_END = 924 * MiB;

struct Params {
    const float* in[21];
    float* out;
    unsigned char* ws;
};

__device__ __forceinline__ int ltid() { int t = (int)__builtin_amdgcn_workitem_id_x(); asm volatile("" : "+v"(t)); return t; }
__device__ __forceinline__ float bf2f(unsigned b) { return __uint_as_float(b << 16); }
__device__ __forceinline__ unsigned f2bf(float f) { unsigned u = __float_as_uint(f); return (u + 0x7fffu + ((u >> 16) & 1u)) >> 16; }
__device__ __forceinline__ unsigned pk2(float lo, float hi) { return f2bf(lo) | (f2bf(hi) << 16); }
#define DPPV(v, ctrl) __builtin_bit_cast(float, __builtin_amdgcn_update_dpp(0, __builtin_bit_cast(int, (v)), (ctrl), 0xf, 0xf, true))
__device__ __forceinline__ float row16_sum(float v) { v += DPPV(v, 0xB1); v += DPPV(v, 0x4E); v += DPPV(v, 0x124); v += DPPV(v, 0x128); return v; }
__device__ __forceinline__ float rows_sum(float v) {
    { auto r = __builtin_amdgcn_permlane16_swap(__float_as_uint(v), __float_as_uint(v), false, false); v = __uint_as_float(r[0]) + __uint_as_float(r[1]); }
    { auto r = __builtin_amdgcn_permlane32_swap(__float_as_uint(v), __float_as_uint(v), false, false); v = __uint_as_float(r[0]) + __uint_as_float(r[1]); }
    return v;
}
__device__ __forceinline__ float wave_sum(float v) { return rows_sum(row16_sum(v)); }
__device__ __forceinline__ float wave_max(float v) {
    v = fmaxf(v, DPPV(v, 0xB1)); v = fmaxf(v, DPPV(v, 0x4E)); v = fmaxf(v, DPPV(v, 0x124)); v = fmaxf(v, DPPV(v, 0x128));
    { auto r = __builtin_amdgcn_permlane16_swap(__float_as_uint(v), __float_as_uint(v), false, false); v = fmaxf(__uint_as_float(r[0]), __uint_as_float(r[1])); }
    { auto r = __builtin_amdgcn_permlane32_swap(__float_as_uint(v), __float_as_uint(v), false, false); v = fmaxf(__uint_as_float(r[0]), __uint_as_float(r[1])); }
    return v;
}
__device__ __forceinline__ float gelu_erf(float x) {
    const float z = x * 0.70710678118654752f, az = fabsf(z);
    const float t = __builtin_amdgcn_rcpf(fmaf(0.3275911f, az, 1.0f));
    float pl = fmaf(t, 1.061405429f, -1.453152027f); pl = fmaf(t, pl, 1.421413741f); pl = fmaf(t, pl, -0.284496736f); pl = fmaf(t, pl, 0.254829592f); pl *= t;
    const float ex = __builtin_amdgcn_exp2f(az * (az * -1.4426950408889634f));
    const float er = copysignf(fmaf(-pl, ex, 1.0f), z);
    const float hx = 0.5f * x;
    return fmaf(hx, er, hx);
}

__device__ __forceinline__ int qkv_logical_col(int p) { return (p & ~255) | (((p >> 5) & 3) << 6) | (((p >> 7) & 1) << 5) | (p & 31); }
__device__ void ph_transpose(const float* W, bf16* Wt, int K, int N, bool permute, float* tile  , int bid, int nb) {
    const int tid = ltid();
    const int nkt = K / 64, nnt = N / 64;
    for (int it = bid; it < nkt * nnt; it += nb) {
        const int k0 = (it / nnt) * 64, n0 = (it % nnt) * 64;
        __syncthreads();
        for (int e = tid; e < 64 * 64; e += NT) { const int r = e >> 6, c = e & 63; const int nl = permute ? qkv_logical_col(n0 + c) : n0 + c; tile[r * 65 + c] = W[(size_t)(k0 + r) * N + nl]; }
        __syncthreads();
        {
            const int n = tid >> 3, k8 = (tid & 7) * 8;
            u32x4 v;
            v.x = pk2(tile[(k8 + 0) * 65 + n], tile[(k8 + 1) * 65 + n]);
            v.y = pk2(tile[(k8 + 2) * 65 + n], tile[(k8 + 3) * 65 + n]);
            v.z = pk2(tile[(k8 + 4) * 65 + n], tile[(k8 + 5) * 65 + n]);
            v.w = pk2(tile[(k8 + 6) * 65 + n], tile[(k8 + 7) * 65 + n]);
            *(u32x4*)(Wt + (size_t)(n0 + n) * K + k0 + k8) = v;
        }
    }
}
__device__ void ph_convert(const float* src, bf16* dst, size_t n, int bid, int nb) {
    const size_t n8 = n / 8;
    for (size_t i = (size_t)bid * NT + ltid(); i < n8; i += (size_t)nb * NT) {
        const f32x4 a = *(const f32x4*)(src + i * 8), b = *(const f32x4*)(src + i * 8 + 4);
        u32x4 v; v.x = pk2(a[0], a[1]); v.y = pk2(a[2], a[3]); v.z = pk2(b[0], b[1]); v.w = pk2(b[2], b[3]);
        *(u32x4*)(dst + i * 8) = v;
    }
}
__device__ void ph_mod(const float* c, const float* ada_w, const float* ada_b, float* mod, float* lds  , int bid, int nb) {
    const int tid = ltid(), lane = tid & 63, w = tid >> 6;
    for (int it = bid; it < 2 * 96; it += nb) {
        const int l = it / 96, j = (it % 96) * 64 + lane;
        float acc[32];
#pragma unroll
        for (int b = 0; b < 32; ++b) acc[b] = 0.f;
        for (int kh = 0; kh < 2; ++kh) {
            __syncthreads();
            for (int e = tid; e < 32 * 512; e += NT) { const int b = e >> 9, k = e & 511; const float cv = c[b * 1024 + kh * 512 + k]; lds[e] = cv / (1.0f + __expf(-cv)); }
            __syncthreads();
            for (int kk = 0; kk < 64; ++kk) {
                const int k = w * 64 + kk;
                const float wv = ada_w[((size_t)l * 1024 + kh * 512 + k) * 6144 + j];
#pragma unroll
                for (int b = 0; b < 32; ++b) acc[b] += lds[b * 512 + k] * wv;
            }
        }
        __syncthreads();
#pragma unroll
        for (int b = 0; b < 32; ++b) lds[(w * 32 + b) * 64 + lane] = acc[b];
        __syncthreads();
        for (int e = tid; e < 32 * 64; e += NT) {
            const int b = e >> 6, jj = e & 63; float s = 0.f;
#pragma unroll
            for (int ww = 0; ww < 8; ++ww) s += lds[(ww * 32 + b) * 64 + jj];
            const int jo = (it % 96) * 64 + jj;
            mod[((size_t)l * 32 + b) * 6144 + jo] = s + ada_b[l * 6144 + jo];
        }
    }
}
__device__ void ph_rope_table(float* rope, int bid, int nb) {
    for (int i = bid * NT + ltid(); i < SQ * 32; i += nb * NT) {
        const int t = i >> 5, f = i & 31;
        const float inv = powf(10000.0f, -(float)f / 32.0f);
        const float ang = (float)t * inv;
        float s, c; sincosf(ang, &s, &c);
        rope[i * 2] = c; rope[i * 2 + 1] = s;
    }
}

#define DPP_ADD0(v, ctrl) ((v) + __builtin_bit_cast(float, __builtin_amdgcn_update_dpp(0, __builtin_bit_cast(int, (v)), (ctrl), 0xf, 0xf, true)))
template <bool XBF> __device__ void ph_adaln(const void* xv, const float* g, const float* mod_shift  , const float* mod_scale, bf16* h, int bid, int nb) {
    const int lane = ltid() & 63, w = __builtin_amdgcn_readfirstlane(ltid() >> 6);
    for (int t0 = (bid * 8 + w) * 4; t0 < MT; t0 += nb * 8 * 4) {
        const int b = t0 >> 11;
        f32x4 v[4][4]; float ss[4];
#pragma unroll
        for (int r = 0; r < 4; ++r) {
            if constexpr (XBF) {
                const bf16* xr = (const bf16*)xv + (size_t)(t0 + r) * DM;
#pragma unroll
                for (int i = 0; i < 4; ++i) { const u32x2 q = *(const u32x2*)(xr + i * 256 + lane * 4); v[r][i] = (f32x4){__uint_as_float(q.x << 16), __uint_as_float(q.x & 0xffff0000u), __uint_as_float(q.y << 16), __uint_as_float(q.y & 0xffff0000u)}; }
            } else {
                const float* xr = (const float*)xv + (size_t)(t0 + r) * DM;
#pragma unroll
                for (int i = 0; i < 4; ++i) v[r][i] = *(const f32x4*)(xr + i * 256 + lane * 4);
            }
        }
#pragma unroll
        for (int r = 0; r < 4; ++r) {
            float s = 0.f;
#pragma unroll
            for (int i = 0; i < 4; ++i) s += v[r][i][0] * v[r][i][0] + v[r][i][1] * v[r][i][1] + v[r][i][2] * v[r][i][2] + v[r][i][3] * v[r][i][3];
            s = DPP_ADD0(s, 0xB1); s = DPP_ADD0(s, 0x4E); s = DPP_ADD0(s, 0x124); s = DPP_ADD0(s, 0x128);
            { auto q = __builtin_amdgcn_permlane16_swap(__float_as_uint(s), __float_as_uint(s), false, false); s = __uint_as_float(q[0]) + __uint_as_float(q[1]); }
            { auto q = __builtin_amdgcn_permlane32_swap(__float_as_uint(s), __float_as_uint(s), false, false); s = __uint_as_float(q[0]) + __uint_as_float(q[1]); }
            ss[r] = rsqrtf(s * (1.0f / DM) + EPS);
        }
#pragma unroll
        for (int i = 0; i < 4; ++i) {
            const int c = i * 256 + lane * 4;
            const f32x4 gg = *(const f32x4*)(g + c), sc = *(const f32x4*)(mod_scale + (size_t)b * 6144 + c), sh = *(const f32x4*)(mod_shift + (size_t)b * 6144 + c);
            float a[4];
#pragma unroll
            for (int e = 0; e < 4; ++e) a[e] = gg[e] * (1.0f + sc[e]);
#pragma unroll
            for (int r = 0; r < 4; ++r) {
                float y[4];
#pragma unroll
                for (int e = 0; e < 4; ++e) y[e] = v[r][i][e] * ss[r] * a[e] + sh[e];
                u32x2 o; o.x = pk2(y[0], y[1]); o.y = pk2(y[2], y[3]);
                __builtin_nontemporal_store(o, (u32x2*)(h + (size_t)(t0 + r) * DM + c));
            }
        }
    }
}

namespace pg8 {
#define PG8_LAS __attribute__((address_space(3)))
typedef unsigned short bf16_t;
typedef short bf16x8 __attribute__((ext_vector_type(8)));
constexpr int BM = 256, BK = 64, HALF = 128, HTB = HALF * BK * 2  , STAGE_BYTES = 8 * HTB, NXCD = 8, WGM = 8;

__host__ __device__ __forceinline__ int lds_byte(int r, int c) { const int st = (r >> 4) * 2 + (c >> 5), rr = r & 15, cc = c & 31, ob = rr * 64 + cc * 2; return st * 1024 + (ob ^ (((ob >> 9) & 1) << 5)); }
__host__ __device__ __forceinline__ void stage_rc(int b, int& R, int& C) { const int st = b / 1024, sb = b % 1024, swz = sb ^ (((sb >> 9) & 1) << 5); R = (st >> 1) * 16 + swz / 64; C = (st & 1) * 32 + (swz % 64) / 2; }
__host__ __device__ __forceinline__ int perm32(int rho) { const int n = rho >> 4, i = rho & 15; return 8 * (i >> 2) + 4 * n + (i & 3); }

struct Unit { int pm, pn; };
struct Gemm { const bf16_t* A; const bf16_t* Bt; int M, N, K; };

struct StaticOrder {
    int nM, nN, nwg, G, c;
    __host__ __device__ void init(int M, int N, int G_, int c_) { nM = M / BM; nN = N / BM; nwg = nM * nN; G = G_; c = c_; }
    __host__ __device__ bool next(int i, Unit& u) const {
        const long L = (long)i * G + c; if (L >= nwg) return false;
        int wgid = (int)L; { const int q = nwg / NXCD, r = nwg % NXCD, xcd = wgid % NXCD, off = wgid / NXCD; wgid = (xcd < r ? xcd * (q + 1) : r * (q + 1) + (xcd - r) * q) + off; }
        const int nig = WGM * nN, gid = wgid / nig, fm = gid * WGM, gsz = (nM - fm) < WGM ? (nM - fm) : WGM;
        u.pm = fm + ((wgid % nig) % gsz); u.pn = (wgid % nig) / gsz; return true;
    }
    __device__ __forceinline__ void a_ready(const Unit&) const {}
    __device__ __forceinline__ void done(const Unit&) const {}
};

__device__ __forceinline__ unsigned cvt_pk_bf16(float lo, float hi) { unsigned r; asm volatile("v_cvt_pk_bf16_f32 %0, %1, %2" : "=v"(r) : "v"(lo), "v"(hi)); return r; }

struct EpiStore {
    static constexpr bool PERM = true, AFTER_DRAIN = false;
    bf16_t* O; int ldc;
    __device__ __forceinline__ void operator()(const f32x4 (&acc)[2][2][4][2], const Unit& u, int wr, int wc, int fr_, int fq_) const {
        int fr = fr_, fq = fq_; asm volatile("" : "+v"(fr), "+v"(fq));
        const int row0 = u.pm * BM + wr * 64 + fr, col0 = u.pn * BM + wc * 32 + 8 * fq;
#pragma unroll
        for (int ai = 0; ai < 2; ++ai)
#pragma unroll
            for (int m = 0; m < 4; ++m) { bf16_t* rowp = O + (size_t)(row0 + ai * HALF + m * 16) * ldc + col0;
#pragma unroll
                for (int bj = 0; bj < 2; ++bj) { const f32x4 v0 = acc[ai][bj][m][0], v1 = acc[ai][bj][m][1];
                    u32x4 w; w.x = cvt_pk_bf16(v0[0], v0[1]); w.y = cvt_pk_bf16(v0[2], v0[3]); w.z = cvt_pk_bf16(v1[0], v1[1]); w.w = cvt_pk_bf16(v1[2], v1[3]);
                    *(u32x4*)(rowp + bj * HALF) = w; } }
    }
};
struct EpiQKV {
    static constexpr bool PERM = true, AFTER_DRAIN = false;
    bf16_t* O; int ldc; const float* rope; int layer;
    const float* gq0; const float* gk0;
    const float* gq1; const float* gk1;
    float* kmean;
    __device__ __forceinline__ void operator()(const f32x4 (&acc)[2][2][4][2], const Unit& u, int wr, int wc, int fr_, int fq_) const {
        int fr = fr_, fq = fq_; asm volatile("" : "+v"(fr), "+v"(fq));
        const int hg = 4 * u.pn + wc;
        const float* gain = nullptr; bool km = false;
        if (layer == 0) { if (hg < 8) gain = gq0; else if (hg < 10) gain = gk0; }
        else { if (hg < 8) gain = gq0; else if (hg < 16) gain = gk0; else if (hg >= 24 && hg < 32) gain = gq1; else if (hg >= 32 && hg < 40) { gain = gk1; km = true; } }
        const int row0 = u.pm * BM + wr * 64 + fr, col0 = 64 * hg + 8 * fq;
        float g0[8], g1[8], cs0[8], cs1[8];
#pragma unroll
        for (int e = 0; e < 8; ++e) { g0[e] = gain ? gain[8 * fq + e] : 1.f; g1[e] = gain ? gain[32 + 8 * fq + e] : 1.f; cs0[e] = 0.f; cs1[e] = 0.f; }
#pragma unroll
        for (int ai = 0; ai < 2; ++ai)
#pragma unroll
            for (int m = 0; m < 4; ++m) {
                const int row = row0 + ai * HALF + m * 16;
                float v0[8], v1[8];
#pragma unroll
                for (int e = 0; e < 4; ++e) { v0[e] = acc[ai][0][m][0][e]; v0[4 + e] = acc[ai][0][m][1][e]; v1[e] = acc[ai][1][m][0][e]; v1[4 + e] = acc[ai][1][m][1][e]; }
                if (gain) {
                    float ss = 0.f;
#pragma unroll
                    for (int e = 0; e < 8; ++e) ss += v0[e] * v0[e] + v1[e] * v1[e];
                    ss = rows_sum(ss);
                    const float r = rsqrtf(ss * (1.0f / 64.0f) + 1e-6f);
                    const float* rp = rope + ((size_t)(row & 2047) * 32 + 8 * fq) * 2;
                    const f32x4 t0 = *(const f32x4*)(rp), t1 = *(const f32x4*)(rp + 4), t2 = *(const f32x4*)(rp + 8), t3 = *(const f32x4*)(rp + 12);
                    const float cs[8] = {t0[0], t0[2], t1[0], t1[2], t2[0], t2[2], t3[0], t3[2]}, sn[8] = {t0[1], t0[3], t1[1], t1[3], t2[1], t2[3], t3[1], t3[3]};
#pragma unroll
                    for (int e = 0; e < 8; ++e) { const float y0 = v0[e] * r * g0[e], y1 = v1[e] * r * g1[e]; v0[e] = y0 * cs[e] - y1 * sn[e]; v1[e] = y1 * cs[e] + y0 * sn[e]; }
                }
                u32x4 w0, w1;
                w0.x = cvt_pk_bf16(v0[0], v0[1]); w0.y = cvt_pk_bf16(v0[2], v0[3]); w0.z = cvt_pk_bf16(v0[4], v0[5]); w0.w = cvt_pk_bf16(v0[6], v0[7]);
                w1.x = cvt_pk_bf16(v1[0], v1[1]); w1.y = cvt_pk_bf16(v1[2], v1[3]); w1.z = cvt_pk_bf16(v1[4], v1[5]); w1.w = cvt_pk_bf16(v1[6], v1[7]);
                bf16_t* rowp = O + (size_t)row * ldc + col0;
                *(u32x4*)(rowp) = w0; *(u32x4*)(rowp + 32) = w1;
                if (km) {
#pragma unroll
                    for (int e = 0; e < 8; ++e) { cs0[e] += v0[e]; cs1[e] += v1[e]; }
                }
            }
        if (km) {
#pragma unroll
            for (int e = 0; e < 8; ++e) {
                cs0[e] = row16_sum(cs0[e]); cs1[e] = row16_sum(cs1[e]);
            }
            if (fr == 0) {
                float* kp = kmean + ((size_t)((u.pm >> 3) * 8 + (hg - 32)) * 8 + (u.pm & 7)) * 64 + 8 * fq;
#pragma unroll
                for (int e = 0; e < 8; ++e) { atomicAdd(kp + e, cs0[e] * (1.0f / 256.0f)); atomicAdd(kp + 32 + e, cs1[e] * (1.0f / 256.0f)); }
            }
        }
    }
};
template <bool XBF> struct EpiResid {
    static constexpr bool PERM = true, AFTER_DRAIN = false;
    const void* xin; bf16_t* xout; const float* gate;
    __device__ __forceinline__ void operator()(const f32x4 (&acc)[2][2][4][2], const Unit& u, int wr, int wc, int fr_, int fq_) const {
        int fr = fr_, fq = fq_; asm volatile("" : "+v"(fr), "+v"(fq));
        const int row0 = u.pm * BM + wr * 64 + fr, col0 = u.pn * BM + wc * 32 + 8 * fq;
#pragma unroll
        for (int ai = 0; ai < 2; ++ai)
#pragma unroll
            for (int m = 0; m < 4; ++m) { const int row = row0 + ai * HALF + m * 16; const float* gp = gate + (size_t)(row >> 11) * 6144 + col0;
                bf16_t* xo = xout + (size_t)row * 1024 + col0;
#pragma unroll
                for (int bj = 0; bj < 2; ++bj) {
                    f32x4 x0, x1;
                    if constexpr (XBF) { const u32x4 q = *(const u32x4*)((const bf16_t*)xin + (size_t)row * 1024 + col0 + bj * HALF);
                        x0 = (f32x4){__uint_as_float(q.x << 16), __uint_as_float(q.x & 0xffff0000u), __uint_as_float(q.y << 16), __uint_as_float(q.y & 0xffff0000u)};
                        x1 = (f32x4){__uint_as_float(q.z << 16), __uint_as_float(q.z & 0xffff0000u), __uint_as_float(q.w << 16), __uint_as_float(q.w & 0xffff0000u)}; }
                    else { const float* xi = (const float*)xin + (size_t)row * 1024 + col0 + bj * HALF; x0 = *(const f32x4*)xi; x1 = *(const f32x4*)(xi + 4); }
                    const f32x4 a0 = acc[ai][bj][m][0], a1 = acc[ai][bj][m][1], g0 = *(const f32x4*)(gp + bj * HALF), g1 = *(const f32x4*)(gp + bj * HALF + 4);
                    u32x4 w; w.x = cvt_pk_bf16(x0[0] + g0[0] * a0[0], x0[1] + g0[1] * a0[1]); w.y = cvt_pk_bf16(x0[2] + g0[2] * a0[2], x0[3] + g0[3] * a0[3]);
                    w.z = cvt_pk_bf16(x1[0] + g1[0] * a1[0], x1[1] + g1[1] * a1[1]); w.w = cvt_pk_bf16(x1[2] + g1[2] * a1[2], x1[3] + g1[3] * a1[3]);
                    *(u32x4*)(xo + bj * HALF) = w; } }
    }
};
template <class Epi, class Sched, bool ALIGN_EPI = false, bool SP2 = false>
__device__ __forceinline__ void gemm_phase(PG8_LAS unsigned char* lds, const Gemm g, const Sched& S, const Epi& E) {
    const int tid = ltid(), wid = __builtin_amdgcn_readfirstlane(tid >> 6), lane = tid & 63, wr = wid >> 2, wc = wid & 3, fr = lane & 15, fq = lane >> 4;
    const int K = g.K, nt = K / BK;
    unsigned voffA[2], voffB[2];
#pragma unroll
    for (int i = 0; i < 2; ++i) { int R, C; stage_rc(tid * 16 + i * 8192, R, C); const int Rb = Epi::PERM ? ((R & ~31) + perm32(R & 31)) : R;
        voffA[i] = (unsigned)(R * K + C) * 2u; voffB[i] = (unsigned)(Rb * K + C) * 2u; }
    const size_t kstep = (size_t)(BK * 2);
    const size_t hstep = (size_t)HALF * K * 2;
    const size_t tstep = 2 * hstep;
    const unsigned ldsw = (unsigned)wid * 1024u;
    const int aoff = lds_byte(wr * 64 + fr, fq * 8), boff = lds_byte(wc * 32 + fr, fq * 8);
#define PG8_SA(b, h) (((b) * 2 + (h)) * HTB)
#define PG8_SB(b, h) ((4 + (b) * 2 + (h)) * HTB)
#define PG8_STAGE(bufoff, gbase, voff) do { _Pragma("unroll") for (int _i = 0; _i < 2; ++_i) \
        __builtin_amdgcn_global_load_lds((const unsigned*)((const char*)(gbase) + (voff)[_i]), (PG8_LAS unsigned*)(lds + (bufoff) + ldsw + _i * 8192), 16, 0, 0); } while (0)
#define PG8_LDA(dst, b, h) do { _Pragma("unroll") for (int m = 0; m < 4; ++m) _Pragma("unroll") for (int k = 0; k < 2; ++k) dst[m][k] = *(const PG8_LAS bf16x8*)(lds + PG8_SA(b, h) + aoff + m * 2048 + k * 1024); } while (0)
#define PG8_LDB(dst, b, h) do { _Pragma("unroll") for (int n = 0; n < 2; ++n) _Pragma("unroll") for (int k = 0; k < 2; ++k) dst[n][k] = *(const PG8_LAS bf16x8*)(lds + PG8_SB(b, h) + boff + n * 2048 + k * 1024); } while (0)
#define PG8_MMA(ai, bj, At, Bt) do { __builtin_amdgcn_s_setprio(1); _Pragma("unroll") for (int m = 0; m < 4; ++m) _Pragma("unroll") for (int n = 0; n < 2; ++n) _Pragma("unroll") for (int k = 0; k < 2; ++k) \
        acc[ai][bj][m][n] = __builtin_amdgcn_mfma_f32_16x16x32_bf16(Bt[n][k], At[m][k], acc[ai][bj][m][n], 0, 0, 0); __builtin_amdgcn_s_setprio(0); } while (0)
#define PG8_WAIT_V(n) asm volatile("s_waitcnt vmcnt(" #n ")" ::: "memory")
#define PG8_WAIT_L(n) asm volatile("s_waitcnt lgkmcnt(" #n ")" ::: "memory")
#define PG8_BAR __builtin_amdgcn_s_barrier()
#define PG8_SCHED __builtin_amdgcn_sched_barrier(0)
    Unit cur, nxt; int ui = 0;
    if (!S.next(0, cur)) return;
    f32x4 acc[2][2][4][2];
#pragma unroll
    for (int a = 0; a < 2; ++a)
#pragma unroll
        for (int b = 0; b < 2; ++b)
#pragma unroll
            for (int m = 0; m < 4; ++m)
#pragma unroll
                for (int n = 0; n < 2; ++n) acc[a][b][m][n] = (f32x4){0.f, 0.f, 0.f, 0.f};
    bf16x8 At[4][2], B0[2][2], B1[2][2];
    const char* cA = (const char*)g.A + (size_t)cur.pm * tstep; const char* cB = (const char*)g.Bt + (size_t)cur.pn * tstep;
    S.a_ready(cur);
    if constexpr (SP2) {
        PG8_STAGE(PG8_SB(0, 0), cB, voffB); PG8_STAGE(PG8_SB(0, 1), cB + hstep, voffB); PG8_STAGE(PG8_SA(0, 0), cA, voffA); PG8_STAGE(PG8_SA(0, 1), cA + hstep, voffA);
        if (wr == 1) PG8_BAR;
        PG8_WAIT_V(2); PG8_BAR;
        PG8_STAGE(PG8_SB(1, 0), cB + kstep, voffB); PG8_STAGE(PG8_SA(1, 0), cA + kstep, voffA); PG8_STAGE(PG8_SB(1, 1), cB + hstep + kstep, voffB);
        PG8_WAIT_V(6); PG8_BAR;
    } else {
        PG8_STAGE(PG8_SB(0, 0), cB, voffB); PG8_STAGE(PG8_SA(0, 0), cA, voffA); PG8_STAGE(PG8_SB(0, 1), cB + hstep, voffB); PG8_STAGE(PG8_SA(0, 1), cA + hstep, voffA);
        if (wr == 1) PG8_BAR;
        PG8_WAIT_V(4); PG8_BAR;
        PG8_STAGE(PG8_SB(1, 0), cB + kstep, voffB); PG8_STAGE(PG8_SA(1, 0), cA + kstep, voffA); PG8_STAGE(PG8_SB(1, 1), cB + hstep + kstep, voffB);
        PG8_WAIT_V(6); PG8_BAR;
    }
    for (;;) {
        const bool has_next = S.next(ui + 1, nxt);
        const char* nA = has_next ? (const char*)g.A + (size_t)nxt.pm * tstep : cA; const char* nB = has_next ? (const char*)g.Bt + (size_t)nxt.pn * tstep : cB;
        for (int t = 0; t < nt; t += 2) {
            const bool last = (t == nt - 2);
            const char* a1 = cA + (size_t)(t + 1) * kstep;
            const char* a2 = last ? nA : cA + (size_t)(t + 2) * kstep; const char* b2 = last ? nB : cB + (size_t)(t + 2) * kstep;
            const char* a3 = a2 + kstep; const char* b3 = b2 + kstep;
            if (last && has_next) S.a_ready(nxt);
            if constexpr (SP2) {
            PG8_LDB(B0, 0, 0); PG8_LDB(B1, 0, 1); PG8_SCHED; PG8_LDA(At, 0, 0); PG8_STAGE(PG8_SA(1, 1), a1 + hstep, voffA);
            PG8_WAIT_V(8); PG8_WAIT_L(0); PG8_BAR; PG8_MMA(0, 0, At, B0); PG8_MMA(0, 1, At, B1); PG8_BAR; PG8_SCHED;
            PG8_LDA(At, 0, 1); PG8_STAGE(PG8_SB(0, 0), b2, voffB); PG8_STAGE(PG8_SB(0, 1), b2 + hstep, voffB); PG8_STAGE(PG8_SA(0, 0), a2, voffA);
            PG8_WAIT_V(8); PG8_WAIT_L(0); PG8_BAR; PG8_MMA(1, 0, At, B0); PG8_MMA(1, 1, At, B1); PG8_BAR; PG8_SCHED;
            PG8_LDB(B0, 1, 0); PG8_LDB(B1, 1, 1); PG8_SCHED; PG8_LDA(At, 1, 0); PG8_STAGE(PG8_SA(0, 1), a2 + hstep, voffA);
            PG8_WAIT_V(8); PG8_WAIT_L(0); PG8_BAR; PG8_MMA(0, 0, At, B0); PG8_MMA(0, 1, At, B1); PG8_BAR; PG8_SCHED;
            PG8_LDA(At, 1, 1); PG8_STAGE(PG8_SB(1, 0), b3, voffB); PG8_STAGE(PG8_SB(1, 1), b3 + hstep, voffB); PG8_STAGE(PG8_SA(1, 0), a3, voffA);
            PG8_WAIT_V(8); PG8_WAIT_L(0); PG8_BAR; PG8_MMA(1, 0, At, B0); PG8_MMA(1, 1, At, B1); PG8_BAR; PG8_SCHED;
            } else {
            PG8_LDB(B0, 0, 0); PG8_SCHED; PG8_LDA(At, 0, 0); PG8_STAGE(PG8_SA(1, 1), a1 + hstep, voffA);
            PG8_WAIT_L(8); PG8_BAR; PG8_WAIT_L(0); PG8_MMA(0, 0, At, B0); PG8_BAR; PG8_SCHED;
            PG8_LDB(B1, 0, 1); PG8_STAGE(PG8_SB(0, 0), b2, voffB);
            PG8_BAR; PG8_WAIT_L(0); PG8_MMA(0, 1, At, B1); PG8_BAR;
            PG8_LDA(At, 0, 1); PG8_STAGE(PG8_SA(0, 0), a2, voffA);
            PG8_BAR; PG8_WAIT_L(0); PG8_MMA(1, 0, At, B0); PG8_BAR; PG8_SCHED;
            PG8_STAGE(PG8_SB(0, 1), b2 + hstep, voffB);
            PG8_WAIT_V(6); PG8_BAR; PG8_MMA(1, 1, At, B1); PG8_BAR;
            PG8_LDB(B0, 1, 0); PG8_SCHED; PG8_LDA(At, 1, 0); PG8_STAGE(PG8_SA(0, 1), a2 + hstep, voffA);
            PG8_WAIT_L(8); PG8_BAR; PG8_WAIT_L(0); PG8_MMA(0, 0, At, B0); PG8_BAR; PG8_SCHED;
            PG8_LDB(B1, 1, 1); PG8_STAGE(PG8_SB(1, 0), b3, voffB);
            PG8_BAR; PG8_WAIT_L(0); PG8_MMA(0, 1, At, B1); PG8_BAR;
            PG8_LDA(At, 1, 1); PG8_STAGE(PG8_SA(1, 0), a3, voffA);
            PG8_BAR; PG8_WAIT_L(0); PG8_MMA(1, 0, At, B0); PG8_BAR; PG8_SCHED;
            PG8_STAGE(PG8_SB(1, 1), b3 + hstep, voffB);
            PG8_WAIT_V(6); PG8_BAR; PG8_MMA(1, 1, At, B1); PG8_BAR;
            }
        }
        if constexpr (ALIGN_EPI) { if (wr == 0) PG8_BAR; }
        if constexpr (!Epi::AFTER_DRAIN) { E(acc, cur, wr, wc, fr, fq); S.done(cur); }
        if (!has_next) break;
#pragma unroll
        for (int a = 0; a < 2; ++a)
#pragma unroll
            for (int b = 0; b < 2; ++b)
#pragma unroll
                for (int m = 0; m < 4; ++m)
#pragma unroll
                    for (int n = 0; n < 2; ++n) acc[a][b][m][n] = (f32x4){0.f, 0.f, 0.f, 0.f};
        cur = nxt; cA = nA; cB = nB; ++ui;
        if constexpr (ALIGN_EPI) { if (wr == 1) PG8_BAR; }
    }
    PG8_WAIT_V(0);
    if constexpr (!ALIGN_EPI) { if (wr == 0) PG8_BAR; }
    PG8_BAR;
    if constexpr (Epi::AFTER_DRAIN) { E.fused(acc, cur, wr, wc, fr, fq, lds, wid, lane); S.done(cur); }
#undef PG8_SA
#undef PG8_SB
#undef PG8_STAGE
#undef PG8_LDA
#undef PG8_LDB
#undef PG8_MMA
#undef PG8_WAIT_V
#undef PG8_WAIT_L
#undef PG8_BAR
#undef PG8_SCHED
}
}

typedef float f32x16 __attribute__((ext_vector_type(16)));
typedef short s16x4 __attribute__((ext_vector_type(4)));
typedef short v4i16_t __attribute__((ext_vector_type(4)));
typedef float f32x2_t __attribute__((ext_vector_type(2)));
typedef __bf16 bf16x2_t __attribute__((ext_vector_type(2)));
#define LAS __attribute__((address_space(3)))
constexpr int VROW = 144, VBUF = 32 * VROW;
constexpr int VROWV = 192, VBUFV = 32 * VROWV;
constexpr float L2E = 1.4426950408889634f, LN2 = 0.6931471805599453f;
constexpr float SC2 = 0.125f * L2E;

__device__ __forceinline__ int crow(int r, int hi) { return (r & 3) + 8 * (r >> 2) + 4 * hi; }
__device__ __forceinline__ unsigned cvtpk(float lo, float hi) { f32x2_t v = {lo, hi}; bf16x2_t b = __builtin_convertvector(v, bf16x2_t); return __builtin_bit_cast(unsigned, b); }
__device__ __forceinline__ float xhalf(float v, int hi) {
    auto r = __builtin_amdgcn_permlane32_swap(__float_as_uint(v), __float_as_uint(v), false, false);
    return __uint_as_float(hi ? r[0] : r[1]);
}
__device__ __forceinline__ s16x4 vtr(const LAS unsigned char* p) { return __builtin_bit_cast(s16x4, __builtin_amdgcn_ds_read_tr16_b64_v4i16((LAS v4i16_t*)p)); }

struct KVRegs { u32x4 k[4]; u32x4 v[4]; };
__device__ __forceinline__ void load_kv(KVRegs& R, const bf16* base, int kp0, int kst, int kcol, int vcol, int lane) {
#pragma unroll
    for (int j = 0; j < 4; ++j) {
        const int pos = kp0 + kst * (8 * j + (lane >> 3));
        const int pc = pos < SQ - 1 ? pos : SQ - 1;
        const bf16* rp = base + (size_t)pc * QKV_LD + (lane & 7) * 8;
        R.k[j] = *(const u32x4*)(rp + kcol); R.v[j] = *(const u32x4*)(rp + vcol);
    }
}
__device__ __forceinline__ void kv_stage(const KVRegs& R, LAS unsigned char* klds, LAS unsigned char* vlds, int lane) {
#pragma unroll
    for (int j = 0; j < 4; ++j) { const int r_ = 8 * j + (lane >> 3), c_ = (lane & 7) * 16; *(LAS u32x4*)(klds + r_ * VROW + c_) = R.k[j]; *(LAS u32x4*)(vlds + r_ * VROWV + c_) = R.v[j]; }
}
__device__ __forceinline__ f32x16 qk_tile(const LAS unsigned char* klds, const bf16x8 (&qf)[4], int r32, int hi) {
    f32x16 s = {0.f, 0.f, 0.f, 0.f, 0.f, 0.f, 0.f, 0.f, 0.f, 0.f, 0.f, 0.f, 0.f, 0.f, 0.f, 0.f};
#pragma unroll
    for (int k = 0; k < 4; ++k) { const bf16x8 kf = *(const LAS bf16x8*)(klds + r32 * VROW + (2 * k + hi) * 16); s = __builtin_amdgcn_mfma_f32_32x32x16_bf16(kf, qf[k], s, 0, 0, 0); }
    return s;
}
__device__ __forceinline__ void pv_tile(f32x16 (&o)[2], const f32x16& p, const LAS unsigned char* vlds, int lane) {
    const int g = lane >> 4, i = lane & 15, h = lane >> 5;
    const LAS unsigned char* vb = vlds + (4 * h + (i >> 2)) * VROWV + (16 * (g & 1) + 4 * (i & 3)) * 2;
#pragma unroll
    for (int s = 0; s < 2; ++s) {
        u32x4 pw; pw.x = cvtpk(p[8 * s], p[8 * s + 1]); pw.y = cvtpk(p[8 * s + 2], p[8 * s + 3]); pw.z = cvtpk(p[8 * s + 4], p[8 * s + 5]); pw.w = cvtpk(p[8 * s + 6], p[8 * s + 7]);
        const bf16x8 pb = __builtin_bit_cast(bf16x8, pw);
#pragma unroll
        for (int df = 0; df < 2; ++df) {
            const s16x4 lo = vtr(vb + (16 * s) * VROWV + df * 64), hh = vtr(vb + (16 * s + 8) * VROWV + df * 64);
            const bf16x8 va = (bf16x8){lo[0], lo[1], lo[2], lo[3], hh[0], hh[1], hh[2], hh[3]};
            o[df] = __builtin_amdgcn_mfma_f32_32x32x16_bf16(va, pb, o[df], 0, 0, 0);
        }
    }
}
__device__ __forceinline__ void load_q(bf16x8 (&qf)[4], const bf16* base, int qpos, int qcol, int hi) {
    const bf16* rp = base + (size_t)qpos * QKV_LD + qcol + 8 * hi;
#pragma unroll
    for (int k = 0; k < 4; ++k) qf[k] = *(const bf16x8*)(rp + 16 * k);
}
__device__ __forceinline__ void store_o(bf16* yrow, const f32x16 (&o)[2], float inv, int hi) {
#pragma unroll
    for (int df = 0; df < 2; ++df)
#pragma unroll
        for (int g = 0; g < 4; ++g) {
            u32x2 w; w.x = cvtpk(o[df][4 * g] * inv, o[df][4 * g + 1] * inv); w.y = cvtpk(o[df][4 * g + 2] * inv, o[df][4 * g + 3] * inv);
            *(u32x2*)(yrow + 32 * df + 8 * g + 4 * hi) = w;
        }
}
__device__ __forceinline__ void osm_tile(f32x16& s, float& m, float& l, f32x16 (&o)[2]) {
    float mx = s[0];
#pragma unroll
    for (int r = 1; r < 16; ++r) mx = fmaxf(mx, s[r]);
    { auto rr = __builtin_amdgcn_permlane32_swap(__float_as_uint(mx), __float_as_uint(mx), false, false); mx = fmaxf(__uint_as_float(rr[0]), __uint_as_float(rr[1])); }
    const float mn = fmaxf(m, mx);
    const float ms = (mn == -INFINITY) ? 0.f : mn;
    const float alpha = __builtin_amdgcn_exp2f((m - ms) * SC2);
    const float mc = ms * SC2;
    float ps = 0.f;
#pragma unroll
    for (int r = 0; r < 16; ++r) { s[r] = __builtin_amdgcn_exp2f(s[r] * SC2 - mc); ps += s[r]; }
    l = l * alpha + ps; m = mn;
    if (!__all(alpha == 1.0f)) {
#pragma unroll
        for (int df = 0; df < 2; ++df)
#pragma unroll
            for (int r = 0; r < 16; ++r) o[df][r] *= alpha;
    }
}
__device__ __forceinline__ void osm_tile2(f32x16& s0, f32x16& s1, float& m, float& l, f32x16 (&o)[2]) {
    float mx = fmaxf(s0[0], s1[0]);
#pragma unroll
    for (int r = 1; r < 16; ++r) mx = fmaxf(mx, fmaxf(s0[r], s1[r]));
    { auto rr = __builtin_amdgcn_permlane32_swap(__float_as_uint(mx), __float_as_uint(mx), false, false); mx = fmaxf(__uint_as_float(rr[0]), __uint_as_float(rr[1])); }
    const float mn = fmaxf(m, mx);
    const float ms = (mn == -INFINITY) ? 0.f : mn;
    const float alpha = __builtin_amdgcn_exp2f((m - ms) * SC2);
    const float mc = ms * SC2;
    float ps0 = 0.f, ps1 = 0.f;
#pragma unroll
    for (int r = 0; r < 16; ++r) { s0[r] = __builtin_amdgcn_exp2f(s0[r] * SC2 - mc); ps0 += s0[r]; s1[r] = __builtin_amdgcn_exp2f(s1[r] * SC2 - mc); ps1 += s1[r]; }
    l = l * alpha + (ps0 + ps1); m = mn;
    if (!__all(alpha == 1.0f)) {
#pragma unroll
        for (int df = 0; df < 2; ++df)
#pragma unroll
            for (int r = 0; r < 16; ++r) o[df][r] *= alpha;
    }
}
#define ZERO16 {0.f, 0.f, 0.f, 0.f, 0.f, 0.f, 0.f, 0.f, 0.f, 0.f, 0.f, 0.f, 0.f, 0.f, 0.f, 0.f}

struct AttnCtx {
    const bf16* base; int kcol, vcol, r32, hi, lane; LAS unsigned char* vlds; LAS unsigned char* klds; bf16x8 qf[4]; f32x16 o[2];
};
#define ATTN_STEP(SC, SL, T) { \
        if (SYNC) __builtin_amdgcn_s_barrier(); \
        { int kp_, ks_; const int tl_ = (T) + 2 < nt ? (T) + 2 : nt - 1; mx.pos(tl_, kp_, ks_); load_kv(SL, c.base, kp_, ks_, c.kcol, c.vcol, c.lane); } \
        kv_stage(SC, c.klds, c.vlds, c.lane); f32x16 s_ = qk_tile(c.klds, c.qf, c.r32, c.hi); \
        const bool stop_ = mx.process((T), s_, c); pv_tile(c.o, s_, c.vlds, c.lane); \
        if ((!SYNC && stop_) || (T) + 1 >= nt) break; }
template <class M, bool SYNC> __device__ __forceinline__ void attn_run(M& mx, AttnCtx& c) {
    const int nt = mx.nt;
    KVRegs S0, S1, S2;
    { int kp, ks; mx.pos(0, kp, ks); load_kv(S0, c.base, kp, ks, c.kcol, c.vcol, c.lane);
      mx.pos(1 < nt ? 1 : nt - 1, kp, ks); load_kv(S1, c.base, kp, ks, c.kcol, c.vcol, c.lane); }
    for (int t = 0;; t += 3) {
        ATTN_STEP(S0, S2, t)
        ATTN_STEP(S1, S0, t + 1)
        ATTN_STEP(S2, S1, t + 2)
    }
}
#define SH_BAR() asm volatile("s_waitcnt lgkmcnt(0)\n\ts_barrier" ::: "memory")
constexpr int SLOT_K = 64 * VROW, SLOT_BYTES = 64 * VROW + 64 * VROWV;
struct ShRegs { u32x4 a, b; };
__device__ __forceinline__ void sh_load(ShRegs& R, const bf16* base, int kp0, int kcol, int vcol, int w, int lane) {
    const int pos = kp0 + 4 * w + ((lane & 31) >> 3);
    const int pa = pos < SQ - 1 ? pos : SQ - 1, pb = pos + 32 < SQ - 1 ? pos + 32 : SQ - 1;
    const int col = ((lane >> 5) ? vcol : kcol) + (lane & 7) * 8;
    R.a = *(const u32x4*)(base + (size_t)pa * QKV_LD + col); R.b = *(const u32x4*)(base + (size_t)pb * QKV_LD + col);
}
__device__ __forceinline__ void sh_write(LAS unsigned char* slot, const ShRegs& R, int w, int lane) {
    const int row = 4 * w + ((lane & 31) >> 3);
    LAS unsigned char* p = slot + ((lane >> 5) ? SLOT_K + row * VROWV : row * VROW) + (lane & 7) * 16;
    *(LAS u32x4*)p = R.a; *(LAS u32x4*)(p + 32 * ((lane >> 5) ? VROWV : VROW)) = R.b;
}
#define SH_STEP(RW, RL, T) { \
        SH_BAR(); \
        { const int tl_ = (T) + 2 < nt ? (T) + 2 : nt - 1; sh_load(RL, c.base, mx.pos2(tl_), c.kcol, c.vcol, w, c.lane); } \
        sh_write(slots + (((T) + 1) & 1) * SLOT_BYTES, RW, w, c.lane); \
        if (mx.active2((T), w)) { LAS unsigned char* sl_ = slots + ((T) & 1) * SLOT_BYTES; \
            f32x16 s0_ = qk_tile(sl_, c.qf, c.r32, c.hi), s1_ = qk_tile(sl_ + 32 * VROW, c.qf, c.r32, c.hi); mx.process2((T), s0_, s1_, c); \
            pv_tile(c.o, s0_, sl_ + SLOT_K, c.lane); pv_tile(c.o, s1_, sl_ + SLOT_K + 32 * VROWV, c.lane); } \
        if ((T) + 1 >= nt) break; }
template <class M> __device__ __forceinline__ void attn_run_shared(M& mx, AttnCtx& c, LAS unsigned char* slots, int w) {
    const int nt = mx.nt2;
    ShRegs R0, R1, R2;
    sh_load(R0, c.base, mx.pos2(0), c.kcol, c.vcol, w, c.lane);
    sh_load(R1, c.base, mx.pos2(1 < nt ? 1 : nt - 1), c.kcol, c.vcol, w, c.lane);
    SH_BAR();
    sh_write(slots, R0, w, c.lane);
    for (int t = 0;; t += 3) {
        SH_STEP(R1, R2, t)
        SH_STEP(R2, R0, t + 1)
        SH_STEP(R0, R1, t + 2)
    }
}
struct MixA {
    int nt, k00, qpos; float m, l;
    __device__ __forceinline__ void pos(int idx, int& kp0, int& kst) const { kp0 = k00 + 32 * idx; kst = 1; }
    __device__ __forceinline__ bool process(int idx, f32x16& s, AttnCtx& c) {
        const int k0 = k00 + 32 * idx;
#pragma unroll
        for (int r = 0; r < 16; ++r) { const int dist = qpos - (k0 + crow(r, c.hi)); if (dist < 0 || dist > 127) s[r] = -INFINITY; }
        osm_tile(s, m, l, c.o); return false;
    }
};
__device__ void attn_A(const bf16* base, int hq, int q0, float sink, bf16* ybase, LAS unsigned char* vlds, int lane) {
    AttnCtx c; c.base = base; c.r32 = lane & 31; c.hi = lane >> 5; c.lane = lane; c.vlds = vlds; c.klds = vlds + VBUFV; c.kcol = 512 + (hq >> 2) * 64; c.vcol = 640 + (hq >> 2) * 64;
    c.o[0] = (f32x16)ZERO16; c.o[1] = (f32x16)ZERO16;
    MixA mx; mx.qpos = q0 + c.r32; mx.k00 = q0 - 128 > 0 ? q0 - 128 : 0; mx.nt = 5; mx.m = -INFINITY; mx.l = 0.f;
    load_q(c.qf, base, mx.qpos, hq * 64, c.hi);
    attn_run<MixA, true>(mx, c);
    float l = mx.l + xhalf(mx.l, c.hi);
    l += __builtin_amdgcn_exp2f(sink * L2E - mx.m * SC2);
    store_o(ybase + (size_t)mx.qpos * DM + hq * 64, c.o, 1.0f / l, c.hi);
}
struct MixB {
    int nt, q0, qpos; float carry;
    __device__ __forceinline__ void pos(int idx, int& kp0, int& kst) const { kp0 = q0 - 32 * idx; kst = 1; }
    __device__ __forceinline__ bool process(int idx, f32x16& s, AttnCtx& c) {
        const int k0 = q0 - 32 * idx, hi = c.hi;
        float lk[16], G[4], Gp[4];
#pragma unroll
        for (int r = 0; r < 16; ++r) {
            const float z = s[r] * 0.125f;
            const bool valid = (k0 + crow(r, hi)) < qpos;
            const float sp = fmaxf(z, 0.f) + LN2 * __builtin_amdgcn_logf(1.0f + __builtin_amdgcn_exp2f(-fabsf(z) * L2E));
            lk[r] = valid ? -sp : 0.f;
            s[r] = valid ? (z - sp) : -INFINITY;
        }
#pragma unroll
        for (int g = 0; g < 4; ++g) { G[g] = (lk[4 * g] + lk[4 * g + 1]) + (lk[4 * g + 2] + lk[4 * g + 3]); Gp[g] = xhalf(G[g], hi); }
        float above = carry;
#pragma unroll
        for (int g = 3; g >= 0; --g) {
            float off = above + (hi == 0 ? Gp[g] : 0.f);
            s[4 * g + 3] = __builtin_amdgcn_exp2f((s[4 * g + 3] + off) * L2E); off += lk[4 * g + 3];
            s[4 * g + 2] = __builtin_amdgcn_exp2f((s[4 * g + 2] + off) * L2E); off += lk[4 * g + 2];
            s[4 * g + 1] = __builtin_amdgcn_exp2f((s[4 * g + 1] + off) * L2E); off += lk[4 * g + 1];
            s[4 * g + 0] = __builtin_amdgcn_exp2f((s[4 * g + 0] + off) * L2E);
            above += G[g] + Gp[g];
        }
        carry = above;
        return __all(carry < -40.0f) != 0;
    }
};
__device__ void attn_B(const bf16* base, int h, int q0, bf16* ybase, LAS unsigned char* vlds, int lane) {
    AttnCtx c; c.base = base; c.r32 = lane & 31; c.hi = lane >> 5; c.lane = lane; c.vlds = vlds; c.klds = vlds + VBUFV; c.kcol = 1280 + h * 64; c.vcol = 1792 + h * 64;
    c.o[0] = (f32x16)ZERO16; c.o[1] = (f32x16)ZERO16;
    MixB mx; mx.q0 = q0; mx.qpos = q0 + c.r32; mx.nt = q0 / 32 + 1; mx.carry = 0.f;
    load_q(c.qf, base, mx.qpos, 768 + h * 64, c.hi);
    attn_run<MixB, false>(mx, c);
    store_o(ybase + (size_t)mx.qpos * DM + 512 + h * 64, c.o, 1.0f, c.hi);
}
struct MixCp {
    int nt, n0, r0, j1lo, qpos; float m, l;
    __device__ __forceinline__ void pos(int t, int& kp0, int& kst) const {
        if (t < n0) { kp0 = r0 + 512 * t; kst = 16; } else { kp0 = (r0 & 3) + 4 * (j1lo + 32 * (t - n0)); kst = 4; }
    }
    __device__ __forceinline__ bool process(int t, f32x16& s, AttnCtx& c) {
        int kp0, kst; pos(t, kp0, kst);
        const int win = t < n0 ? 2048 : 512;
#pragma unroll
        for (int r = 0; r < 16; ++r) { const int dist = qpos - (kp0 + kst * crow(r, c.hi)); if (dist < 0 || dist > win) s[r] = -INFINITY; }
        osm_tile(s, m, l, c.o); return false;
    }
};
struct MixC1 {
    int nt2, p0, qpos; float m, l;
    __device__ __forceinline__ int pos2(int T) const { return p0 + 64 * T; }
    __device__ __forceinline__ bool active2(int T, int w) const { return true; }
    __device__ __forceinline__ void process2(int T, f32x16& s0, f32x16& s1, AttnCtx& c) {
        const int k0 = p0 + 64 * T;
#pragma unroll
        for (int r = 0; r < 16; ++r) { const int dist = qpos - (k0 + crow(r, c.hi)); if (dist < 0 || dist > 128) s0[r] = -INFINITY; if (dist < 32 || dist > 160) s1[r] = -INFINITY; }
        osm_tile2(s0, s1, m, l, c.o);
    }
};
__device__ void attn_C(const bf16* base, int h, int r0, int g, bf16* ybase, LAS unsigned char* vlds, LAS unsigned char* xlds, int w, int lane) {
    AttnCtx c; c.base = base; c.r32 = lane & 31; c.hi = lane >> 5; c.lane = lane; c.vlds = vlds; c.klds = vlds + VBUFV; c.kcol = 512 + h * 64; c.vcol = 1024 + h * 64;
    c.o[0] = (f32x16)ZERO16; c.o[1] = (f32x16)ZERO16;
    const int qpos = r0 + 16 * (32 * g + c.r32);
    load_q(c.qf, base, qpos, h * 64, c.hi);
    MixCp mp; mp.r0 = r0; mp.qpos = qpos; mp.m = -INFINITY; mp.l = 0.f;
    mp.n0 = g + 1;
    mp.j1lo = (r0 >> 2) + 128 * g - 128 > 0 ? (r0 >> 2) + 128 * g - 128 : 0;
    mp.nt = mp.n0 + ((r0 >> 2) + 128 * g + 124 - mp.j1lo) / 32 + 1;
    attn_run<MixCp, true>(mp, c);
    MixC1 m1; m1.qpos = qpos; m1.m = mp.m; m1.l = mp.l;
    const int ra = r0 & 8;
    m1.p0 = 512 * g + ra - 128 > 0 ? 512 * g + ra - 128 : 0;
    m1.nt2 = ((512 * g + ra + 7 + 496 - m1.p0) / 32 + 2) / 2;
    attn_run_shared<MixC1>(m1, c, xlds + 64, w);
    const float l = m1.l + xhalf(m1.l, c.hi);
    store_o(ybase + (size_t)qpos * DM + h * 64, c.o, 1.0f / l, c.hi);
}
struct MixD {
    int nt, nt2, npast, own, q0, qpos; unsigned U, sel; float m, l;
    __device__ __forceinline__ int blk_of(int j) const {
        unsigned u = U; int b = 0;
#pragma unroll
        for (int i = 0; i < 7; ++i) { if (i < j) u &= u - 1u; }
        b = __builtin_ctz(u | 0x100u); return b;
    }
    __device__ __forceinline__ void pos(int t, int& kp0, int& kst) const {
        kst = 1;
        if (t < 8 * npast) kp0 = blk_of(t >> 3) * 256 + (t & 7) * 32; else kp0 = own * 256 + (t - 8 * npast) * 32;
    }
    __device__ __forceinline__ int pos2(int T) const { int kp, ks; pos(2 * T, kp, ks); return kp; }
    __device__ __forceinline__ bool active2(int T, int w) const { return T < 4 * npast || 2 * (T - 4 * npast) <= w; }
    __device__ __forceinline__ void process2(int T, f32x16& s0, f32x16& s1, AttnCtx& c) {
        if (T < 4 * npast) {
            const int blk = blk_of(T >> 2);
            if (!((sel >> blk) & 1u)) {
#pragma unroll
                for (int r = 0; r < 16; ++r) { s0[r] = -INFINITY; s1[r] = -INFINITY; }
            }
        } else {
            const int k0 = own * 256 + (T - 4 * npast) * 64;
#pragma unroll
            for (int r = 0; r < 16; ++r) { const int kk = k0 + crow(r, c.hi); if (kk > qpos) s0[r] = -INFINITY; if (kk + 32 > qpos) s1[r] = -INFINITY; }
        }
        osm_tile2(s0, s1, m, l, c.o);
    }
};
__device__ void attn_D(const bf16* base, const float* kmean  , int h, int q0, bf16* ybase, LAS unsigned char* vlds, LAS unsigned char* xlds, int lane) {
    AttnCtx c; c.base = base; c.r32 = lane & 31; c.hi = lane >> 5; c.lane = lane; c.vlds = vlds; c.klds = vlds + VBUFV; c.kcol = 2048 + h * 64; c.vcol = 2560 + h * 64;
    c.o[0] = (f32x16)ZERO16; c.o[1] = (f32x16)ZERO16;
    const int r32 = c.r32, hi = c.hi, own = q0 >> 8;
    MixD mx; mx.own = own; mx.q0 = q0; mx.qpos = q0 + r32; mx.m = -INFINITY; mx.l = 0.f;
    load_q(c.qf, base, mx.qpos, 1536 + h * 64, hi);
    unsigned sel = 0u;
    if (own > 0) {
        bf16x8 kf[4];
#pragma unroll
        for (int k = 0; k < 4; ++k) {
            u32x4 w = {0u, 0u, 0u, 0u};
            if (r32 < 8) { const float* kp = kmean + r32 * 64 + 16 * k + 8 * hi; const f32x4 a = *(const f32x4*)kp, b = *(const f32x4*)(kp + 4);
                w.x = cvtpk(a[0], a[1]); w.y = cvtpk(a[2], a[3]); w.z = cvtpk(b[0], b[1]); w.w = cvtpk(b[2], b[3]); }
            kf[k] = __builtin_bit_cast(bf16x8, w);
        }
        f32x16 gs = ZERO16;
#pragma unroll
        for (int k = 0; k < 4; ++k) gs = __builtin_amdgcn_mfma_f32_32x32x16_bf16(kf[k], c.qf[k], gs, 0, 0, 0);
        float gt[8];
#pragma unroll
        for (int r = 0; r < 4; ++r) { const float mine = gs[r], oth = xhalf(mine, hi); gt[r] = hi == 0 ? mine : oth; gt[4 + r] = hi == 0 ? oth : mine; }
        const int nsel = own < 3 ? own : 3;
        for (int rr = 0; rr < nsel; ++rr) {
            float best = -INFINITY; int bi = -1;
#pragma unroll
            for (int n = 0; n < 8; ++n) { const bool ok = n < own && !((sel >> n) & 1u) && (bi < 0 || gt[n] > best); if (ok) { best = gt[n]; bi = n; } }
            if (bi >= 0) sel |= 1u << bi;
        }
    }
    unsigned U = 0u;
#pragma unroll
    for (int n = 0; n < 8; ++n) if (__ballot((sel >> n) & 1u) != 0ull) U |= 1u << n;
    {
        volatile LAS unsigned* ux = (volatile LAS unsigned*)xlds;
        __builtin_amdgcn_s_barrier();
        if (lane == 0) ux[(q0 >> 5) & 7] = U;
        asm volatile("s_waitcnt lgkmcnt(0)" ::: "memory");
        __builtin_amdgcn_s_barrier();
        U = ux[0] | ux[1] | ux[2] | ux[3] | ux[4] | ux[5] | ux[6] | ux[7];
        U = __builtin_amdgcn_readfirstlane(U);
    }
    mx.U = U; mx.sel = sel; mx.npast = __builtin_popcount(U); mx.nt = 8 * mx.npast + 8; mx.nt2 = 4 * mx.npast + 4;
    attn_run_shared<MixD>(mx, c, xlds + 64, (q0 >> 5) & 7);
    const float l = mx.l + xhalf(mx.l, c.hi);
    store_o(ybase + (size_t)mx.qpos * DM + 512 + h * 64, c.o, 1.0f / l, hi);
}

__device__ void ph_attn0(const bf16* qkv, const float* sinks, bf16* y, LAS unsigned char* lds, int bid, int nb) {
    const int lane = ltid() & 63, w = __builtin_amdgcn_readfirstlane(ltid() >> 6);
    LAS unsigned char* vlds = lds + w * (VBUF + VBUFV);
    for (int pid = bid; pid < NB * 8; pid += nb) {
        const int b = pid >> 3, h = pid & 7;
        const bf16* base = qkv + (size_t)b * SQ * QKV_LD; bf16* ybase = y + (size_t)b * SQ * DM;
        const float sink = sinks[h];
        for (int rd = 0; rd < 8; ++rd) attn_A(base, h, (rd * 8 + w) * 32, sink, ybase, vlds, lane);
        for (int rd = 0; rd < 8; ++rd) attn_B(base, h, (rd * 8 + w) * 32, ybase, vlds, lane);
    }
}
__device__ void ph_attn1(const bf16* qkv, const float* kmean, bf16* y, LAS unsigned char* lds, int bid, int nb) {
    const int lane = ltid() & 63, w = __builtin_amdgcn_readfirstlane(ltid() >> 6);
    LAS unsigned char* vlds = lds + w * (VBUF + VBUFV);
    for (int pid = bid; pid < NB * 8; pid += nb) {
        const int b = pid >> 3, h = pid & 7;
        const bf16* base = qkv + (size_t)b * SQ * QKV_LD; bf16* ybase = y + (size_t)b * SQ * DM;
        for (int rd = 0; rd < 8; ++rd) { const int it = rd * 8 + w; attn_C(base, h, it & 15, it >> 4, ybase, vlds, lds + 8 * (VBUF + VBUFV), w, lane); }
        for (int rd = 0; rd < 8; ++rd) attn_D(base, kmean + (size_t)pid * 8 * 64, h, (rd * 8 + w) * 32, ybase, vlds, lds + 8 * (VBUF + VBUFV), lane);
    }
}

#define CE_D(a, b) { const float hi_ = fmaxf((a), (b)), lo_ = fminf((a), (b)); (a) = hi_; (b) = lo_; }
#define BSTAGE(arr, k, j) _Pragma("unroll") for (int i_ = 0; i_ < 16; ++i_) { const int l_ = i_ ^ (j); if (l_ > i_) { if ((i_ & (k)) == 0) CE_D(arr[i_], arr[l_]) else CE_D(arr[l_], arr[i_]) } }
__device__ __forceinline__ void bsort16(float (&a)[16]) {
    CE_D(a[0], a[1]) CE_D(a[2], a[3]) CE_D(a[0], a[2]) CE_D(a[1], a[3]) CE_D(a[1], a[2]) CE_D(a[4], a[5]) CE_D(a[6], a[7]) CE_D(a[4], a[6]) CE_D(a[5], a[7]) CE_D(a[5], a[6]) CE_D(a[0], a[4]) CE_D(a[2], a[6]) CE_D(a[2], a[4]) CE_D(a[1], a[5]) CE_D(a[3], a[7]) CE_D(a[3], a[5]) CE_D(a[1], a[2]) CE_D(a[3], a[4]) CE_D(a[5], a[6]) CE_D(a[8], a[9]) CE_D(a[10], a[11]) CE_D(a[8], a[10]) CE_D(a[9], a[11]) CE_D(a[9], a[10]) CE_D(a[12], a[13]) CE_D(a[14], a[15]) CE_D(a[12], a[14]) CE_D(a[13], a[15]) CE_D(a[13], a[14]) CE_D(a[8], a[12]) CE_D(a[10], a[14]) CE_D(a[10], a[12]) CE_D(a[9], a[13]) CE_D(a[11], a[15]) CE_D(a[11], a[13]) CE_D(a[9], a[10]) CE_D(a[11], a[12]) CE_D(a[13], a[14]) CE_D(a[0], a[8]) CE_D(a[4], a[12]) CE_D(a[4], a[8]) CE_D(a[2], a[10]) CE_D(a[6], a[14]) CE_D(a[6], a[10]) CE_D(a[2], a[4]) CE_D(a[6], a[8]) CE_D(a[10], a[12]) CE_D(a[1], a[9]) CE_D(a[5], a[13]) CE_D(a[5], a[9]) CE_D(a[3], a[11]) CE_D(a[7], a[15]) CE_D(a[7], a[11]) CE_D(a[3], a[5]) CE_D(a[7], a[9]) CE_D(a[11], a[13]) CE_D(a[1], a[2]) CE_D(a[3], a[4]) CE_D(a[5], a[6]) CE_D(a[7], a[8]) CE_D(a[9], a[10]) CE_D(a[11], a[12]) CE_D(a[13], a[14])
}
__device__ __forceinline__ void bmerge16(float (&a)[16]) {
    BSTAGE(a, 16, 8) BSTAGE(a, 16, 4) BSTAGE(a, 16, 2) BSTAGE(a, 16, 1)
}
__device__ __forceinline__ void merge_top16(float (&a)[16], const float (&b)[16]) {
#pragma unroll
    for (int i = 0; i < 16; ++i) a[i] = fmaxf(a[i], b[15 - i]);
    bmerge16(a);
}
__device__ __forceinline__ void xmerge16(float (&a)[16]) {
    {
        float A[16], B[16];
#pragma unroll
        for (int i = 0; i < 16; ++i) { auto r = __builtin_amdgcn_permlane16_swap(__float_as_uint(a[i]), __float_as_uint(a[i]), false, false); A[i] = __uint_as_float(r[0]); B[i] = __uint_as_float(r[1]); }
#pragma unroll
        for (int i = 0; i < 16; ++i) a[i] = fmaxf(A[i], B[15 - i]);
        bmerge16(a);
    }
    {
        float A[16], B[16];
#pragma unroll
        for (int i = 0; i < 16; ++i) { auto r = __builtin_amdgcn_permlane32_swap(__float_as_uint(a[i]), __float_as_uint(a[i]), false, false); A[i] = __uint_as_float(r[0]); B[i] = __uint_as_float(r[1]); }
#pragma unroll
        for (int i = 0; i < 16; ++i) a[i] = fmaxf(A[i], B[15 - i]);
        bmerge16(a);
    }
}
__host__ __device__ constexpr int pair_i(int id) {
    int c = 0;
    for (int i = 0; i < 16; ++i) { const int nj = 16 / (i + 1); if (id < c + nj) return i; c += nj; }
    return 0;
}
__host__ __device__ constexpr int pair_j(int id) {
    int c = 0;
    for (int i = 0; i < 16; ++i) { const int nj = 16 / (i + 1); if (id < c + nj) return id - c; c += nj; }
    return 0;
}
constexpr int SK_ROW = 272;
constexpr int SEL_SK_BYTES = 2 * 128 * SK_ROW;
constexpr int SEL_TAB_OFF = SEL_SK_BYTES;
constexpr int SEL_IDX_OFF = SEL_SK_BYTES + 64;

template <int S> __device__ __forceinline__ float cand_slot(const float (&L1)[16], const float (&L2)[16], int g) {
    constexpr int p0 = S, p1 = 16 + S, p2 = 32 + S, p3 = 48 + S;
    const float c0 = L1[pair_i(p0)] + L2[pair_j(p0)], c1 = L1[pair_i(p1)] + L2[pair_j(p1)], c2 = L1[pair_i(p2)] + L2[pair_j(p2)];
    const float c3 = p3 < 50 ? L1[pair_i(p3 < 50 ? p3 : 0)] + L2[pair_j(p3 < 50 ? p3 : 0)] : -1.0e30f;
    const float c = g == 0 ? c0 : (g == 1 ? c1 : (g == 2 ? c2 : c3));
    return __uint_as_float((__float_as_uint(c) & 0xffffffc0u) | (unsigned)(16 * g + S));
}

__device__ void ph_peer_select(const bf16* qry, const float* subkeys  , int* eidx, float* egate  , const float* su, const float* sv, LAS unsigned char* lds, int bid, int nb) {
    const int tid = ltid(), lane = tid & 63, w = __builtin_amdgcn_readfirstlane(tid >> 6);
    const int tk = lane & 15, g = lane >> 4;
    __syncthreads();
    for (int e = tid; e < 2 * 128 * 128 / 2; e += NT) {
        const int row = e >> 6, c2 = (e & 63) * 2;
        const float a = subkeys[(size_t)row * 128 + c2], b = subkeys[(size_t)row * 128 + c2 + 1];
        *(LAS unsigned*)(lds + row * SK_ROW + c2 * 2) = pk2(a, b);
    }
    if (tid < 64) { int id = tid; int c = 0, pi = 0, pj = 0;
        for (int i = 0; i < 16; ++i) { const int nj = 16 / (i + 1); if (id >= c && id < c + nj) { pi = i; pj = id - c; } c += nj; }
        lds[SEL_TAB_OFF + tid] = (unsigned char)((pi << 4) | pj); }
    __syncthreads();
    LAS unsigned* widx = (LAS unsigned*)(lds + SEL_IDX_OFF + w * 512);
    const LAS unsigned char* widx8 = (const LAS unsigned char*)widx;
    const int nitems = (MT / 16) * 8;
    bf16x8 qc[2][4];
    { const int it = bid * 8 + w;
      if (it < nitems) { const bf16* qp = qry + (size_t)((it >> 3) * 16 + tk) * PQ + (it & 7) * 256 + 8 * g;
#pragma unroll
          for (int hf = 0; hf < 2; ++hf)
#pragma unroll
              for (int ks = 0; ks < 4; ++ks) qc[hf][ks] = *(const bf16x8*)(qp + hf * 128 + 32 * ks); } }
    for (int it = bid * 8 + w; it < nitems; it += nb * 8) {
        const int h = it & 7, t0 = (it >> 3) * 16;
        bf16x8 qn[2][4];
        { const int itn = it + nb * 8 < nitems ? it + nb * 8 : it;
          const bf16* qp = qry + (size_t)((itn >> 3) * 16 + tk) * PQ + (itn & 7) * 256 + 8 * g;
#pragma unroll
          for (int hf = 0; hf < 2; ++hf)
#pragma unroll
              for (int ks = 0; ks < 4; ++ks) qn[hf][ks] = *(const bf16x8*)(qp + hf * 128 + 32 * ks); }
        float L[2][16];
#pragma unroll
        for (int hf = 0; hf < 2; ++hf) {
            bf16x8 qf[4];
#pragma unroll
            for (int ks = 0; ks < 4; ++ks) qf[ks] = qc[hf][ks];
            float key[32];
#pragma unroll
            for (int tile = 0; tile < 8; ++tile) {
                f32x4 acc = {0.f, 0.f, 0.f, 0.f};
#pragma unroll
                for (int ks = 0; ks < 4; ++ks) {
                    const bf16x8 af = *(const LAS bf16x8*)(lds + (hf * 128 + tile * 16 + tk) * SK_ROW + (32 * ks + 8 * g) * 2);
                    acc = __builtin_amdgcn_mfma_f32_16x16x32_bf16(af, qf[ks], acc, 0, 0, 0);
                }
#pragma unroll
                for (int r = 0; r < 4; ++r) key[tile * 4 + r] = __uint_as_float((__float_as_uint(acc[r]) & 0xffffff80u) | (unsigned)(16 * tile + 4 * g + r));
            }
            float a[16], b[16];
#pragma unroll
            for (int i = 0; i < 16; ++i) { a[i] = key[i]; b[i] = key[16 + i]; }
            bsort16(a); bsort16(b);
            merge_top16(a, b);
            xmerge16(a);
#pragma unroll
            for (int i = 0; i < 16; ++i) L[hf][i] = a[i];
            unsigned pk = 0u;
#pragma unroll
            for (int s = 0; s < 4; ++s) {
                const float v = g == 0 ? a[s] : (g == 1 ? a[4 + s] : (g == 2 ? a[8 + s] : a[12 + s]));
                pk |= (__float_as_uint(v) & 127u) << (8 * s);
            }
            widx[tk * 8 + hf * 4 + g] = pk;
        }
        float c[16];
        c[0] = cand_slot<0>(L[0], L[1], g); c[1] = cand_slot<1>(L[0], L[1], g); c[2] = cand_slot<2>(L[0], L[1], g); c[3] = cand_slot<3>(L[0], L[1], g);
        c[4] = cand_slot<4>(L[0], L[1], g); c[5] = cand_slot<5>(L[0], L[1], g); c[6] = cand_slot<6>(L[0], L[1], g); c[7] = cand_slot<7>(L[0], L[1], g);
        c[8] = cand_slot<8>(L[0], L[1], g); c[9] = cand_slot<9>(L[0], L[1], g); c[10] = cand_slot<10>(L[0], L[1], g); c[11] = cand_slot<11>(L[0], L[1], g);
        c[12] = cand_slot<12>(L[0], L[1], g); c[13] = cand_slot<13>(L[0], L[1], g); c[14] = cand_slot<14>(L[0], L[1], g); c[15] = cand_slot<15>(L[0], L[1], g);
        bsort16(c);
        xmerge16(c);
        float sum = 0.f, ex[16];
#pragma unroll
        for (int i = 0; i < 16; ++i) { ex[i] = __builtin_amdgcn_exp2f((c[i] - c[0]) * L2E); sum += ex[i]; }
        const float inv = 1.0f / sum;
        int oi[4]; float og[4];
#pragma unroll
        for (int s = 0; s < 4; ++s) {
            const float kv = g == 0 ? c[s] : (g == 1 ? c[4 + s] : (g == 2 ? c[8 + s] : c[12 + s]));
            const float ev = g == 0 ? ex[s] : (g == 1 ? ex[4 + s] : (g == 2 ? ex[8 + s] : ex[12 + s]));
            const unsigned pid = __float_as_uint(kv) & 63u;
            const unsigned ij = lds[SEL_TAB_OFF + pid];
            const unsigned i1 = widx8[tk * 32 + (ij >> 4)], i2 = widx8[tk * 32 + 16 + (ij & 15u)];
            oi[s] = (int)(i1 * 128u + i2); og[s] = ev * inv;
        }
        const size_t ob = (size_t)(t0 + tk) * 128 + h * 16 + 4 * g;
        *(u32x4*)(eidx + ob) = (u32x4){(unsigned)oi[0], (unsigned)oi[1], (unsigned)oi[2], (unsigned)oi[3]};
        *(f32x4*)(egate + ob) = (f32x4){og[0] * sv[oi[0]], og[1] * sv[oi[1]], og[2] * sv[oi[2]], og[3] * sv[oi[3]]};
        *(f32x4*)(egate + 8 * 1024 * 1024 + ob) = (f32x4){su[oi[0]], su[oi[1]], su[oi[2]], su[oi[3]]};
#pragma unroll
        for (int hf = 0; hf < 2; ++hf)
#pragma unroll
            for (int ks = 0; ks < 4; ++ks) qc[hf][ks] = qn[hf][ks];
    }
    __syncthreads();
}

typedef float v32f_t __attribute__((ext_vector_type(32)));
typedef unsigned v6u_t __attribute__((ext_vector_type(6)));
typedef unsigned v16u_t __attribute__((ext_vector_type(16)));
typedef __bf16 v32bf_t __attribute__((ext_vector_type(32)));
typedef __bf16 v2bf_t __attribute__((ext_vector_type(2)));
typedef _Float16 v32h_t __attribute__((ext_vector_type(32)));
typedef unsigned u32x3 __attribute__((ext_vector_type(3)));
constexpr int TROW = 768;
__device__ void ph_tab_fp6(const float* src, unsigned char* dst, float* scale, int nrows, int bid, int nb) {
    const int lane = ltid() & 63, w = __builtin_amdgcn_readfirstlane(ltid() >> 6);
    for (int rp = bid * 8 + w; rp < nrows / 2; rp += nb * 8) {
        v32h_t hv; float sc[2];
#pragma unroll
        for (int rr = 0; rr < 2; ++rr) {
            const float* sp = src + (size_t)(2 * rp + rr) * DM + lane * 16;
            f32x4 v[4]; float am = 0.f;
#pragma unroll
            for (int i = 0; i < 4; ++i) { v[i] = *(const f32x4*)(sp + i * 4); am = fmaxf(am, fmaxf(fmaxf(fabsf(v[i][0]), fabsf(v[i][1])), fmaxf(fabsf(v[i][2]), fabsf(v[i][3])))); }
            am = wave_max(am);
            const float s = am > 0.f ? am * (1.0f / 7.5f) : 1.0f, inv = 1.0f / s;
            sc[rr] = s;
#pragma unroll
            for (int i = 0; i < 4; ++i)
#pragma unroll
                for (int e = 0; e < 4; ++e) hv[rr * 16 + i * 4 + e] = (_Float16)fminf(fmaxf(v[i][e] * inv, -7.5f), 7.5f);
        }
        const v6u_t pk = __builtin_amdgcn_cvt_scalef32_pk32_fp6_f16(hv, 1.0f);
        unsigned* d0 = (unsigned*)(dst + (size_t)(2 * rp) * TROW + lane * 12);
        unsigned* d1 = (unsigned*)(dst + (size_t)(2 * rp + 1) * TROW + lane * 12);
        d0[0] = pk[0]; d0[1] = pk[1]; d0[2] = pk[2]; d1[0] = pk[3]; d1[1] = pk[4]; d1[2] = pk[5];
        if (lane == 0) { scale[2 * rp] = sc[0]; scale[2 * rp + 1] = sc[1]; }
    }
}

constexpr int TROW4 = 512;
constexpr int TROWX = 1024;
__device__ void ph_tab_fp4(const float* src, unsigned char* dst  , float* scale, int nrows, int bid, int nb) {
    const int lane = ltid() & 63, w = __builtin_amdgcn_readfirstlane(ltid() >> 6);
    for (int row = bid * 8 + w; row < nrows; row += nb * 8) {
        const float* sp = src + (size_t)row * DM + lane * 16;
        f32x4 v[4]; float am = 0.f;
#pragma unroll
        for (int i = 0; i < 4; ++i) { v[i] = *(const f32x4*)(sp + i * 4); am = fmaxf(am, fmaxf(fmaxf(fabsf(v[i][0]), fabsf(v[i][1])), fmaxf(fabsf(v[i][2]), fabsf(v[i][3])))); }
        am = wave_max(am);
        const float s = am > 0.f ? am * (1.0f / 6.0f) : 1.0f, inv = 1.0f / s;
        unsigned d0 = 0u, d1 = 0u;
        d0 = __builtin_amdgcn_cvt_scalef32_pk_fp4_f32(d0, v[0][0] * inv, v[0][1] * inv, 1.0f, 0); d0 = __builtin_amdgcn_cvt_scalef32_pk_fp4_f32(d0, v[0][2] * inv, v[0][3] * inv, 1.0f, 1);
        d0 = __builtin_amdgcn_cvt_scalef32_pk_fp4_f32(d0, v[1][0] * inv, v[1][1] * inv, 1.0f, 2); d0 = __builtin_amdgcn_cvt_scalef32_pk_fp4_f32(d0, v[1][2] * inv, v[1][3] * inv, 1.0f, 3);
        d1 = __builtin_amdgcn_cvt_scalef32_pk_fp4_f32(d1, v[2][0] * inv, v[2][1] * inv, 1.0f, 0); d1 = __builtin_amdgcn_cvt_scalef32_pk_fp4_f32(d1, v[2][2] * inv, v[2][3] * inv, 1.0f, 1);
        d1 = __builtin_amdgcn_cvt_scalef32_pk_fp4_f32(d1, v[3][0] * inv, v[3][1] * inv, 1.0f, 2); d1 = __builtin_amdgcn_cvt_scalef32_pk_fp4_f32(d1, v[3][2] * inv, v[3][3] * inv, 1.0f, 3);
        *(u32x2*)(dst + (size_t)row * TROWX + lane * 16) = (u32x2){d0, d1};
        if (lane == 0) scale[row] = s;
    }
}

__device__ void ph_tab_i4(const float* src, unsigned char* dst, float* scale, int nrows, int bid, int nb) {
    const int lane = ltid() & 63, w = __builtin_amdgcn_readfirstlane(ltid() >> 6);
    for (int row = bid * 8 + w; row < nrows; row += nb * 8) {
        const float* sp = src + (size_t)row * DM + lane * 16;
        f32x4 v[4]; float am = 0.f;
#pragma unroll
        for (int i = 0; i < 4; ++i) { v[i] = *(const f32x4*)(sp + i * 4); am = fmaxf(am, fmaxf(fmaxf(fabsf(v[i][0]), fabsf(v[i][1])), fmaxf(fabsf(v[i][2]), fabsf(v[i][3])))); }
        am = wave_max(am);
        const float s = am > 0.f ? am * (1.0f / 7.0f) : 1.0f, inv = 1.0f / s;
        unsigned d[2] = {0u, 0u};
#pragma unroll
        for (int i = 0; i < 16; ++i) { const int q = (int)rintf(fminf(fmaxf(v[i >> 2][i & 3] * inv, -7.0f), 7.0f)); d[i >> 3] |= ((unsigned)q & 15u) << (4 * (i & 7)); }
        *(u32x2*)(dst + (size_t)row * TROWX + lane * 16) = (u32x2){d[0], d[1]};
        if (lane == 0) scale[row] = s;
    }
}

__device__ void ph_tab_uv(const float* srcu, const float* srcv, unsigned char* dst, float* scu, float* scv, int nrows, int bid, int nb) {
    const int lane = ltid() & 63, w = __builtin_amdgcn_readfirstlane(ltid() >> 6);
    for (int row0 = (bid * 8 + w) * 2; row0 < nrows; row0 += nb * 8 * 2) {
        f32x4 vu[2][4], vv[2][4];
#pragma unroll
        for (int r = 0; r < 2; ++r)
#pragma unroll
            for (int i = 0; i < 4; ++i) { vu[r][i] = *(const f32x4*)(srcu + (size_t)(row0 + r) * DM + lane * 16 + i * 4); vv[r][i] = *(const f32x4*)(srcv + (size_t)(row0 + r) * DM + lane * 16 + i * 4); }
#pragma unroll
        for (int r = 0; r < 2; ++r) {
            float au = 0.f, av = 0.f;
#pragma unroll
            for (int i = 0; i < 4; ++i)
#pragma unroll
                for (int e = 0; e < 4; ++e) { au = fmaxf(au, fabsf(vu[r][i][e])); av = fmaxf(av, fabsf(vv[r][i][e])); }
            au = wave_max(au); av = wave_max(av);
            const float su_ = au > 0.f ? au * (1.0f / 7.0f) : 1.0f, iu = 1.0f / su_, sv_ = av > 0.f ? av * (1.0f / 6.0f) : 1.0f, iv = 1.0f / sv_;
            unsigned d[2] = {0u, 0u};
#pragma unroll
            for (int i = 0; i < 16; ++i) { const int q = (int)rintf(fminf(fmaxf(vu[r][i >> 2][i & 3] * iu, -7.0f), 7.0f)); d[i >> 3] |= ((unsigned)q & 15u) << (4 * (i & 7)); }
            unsigned d0 = 0u, d1 = 0u;
            d0 = __builtin_amdgcn_cvt_scalef32_pk_fp4_f32(d0, vv[r][0][0] * iv, vv[r][0][1] * iv, 1.0f, 0); d0 = __builtin_amdgcn_cvt_scalef32_pk_fp4_f32(d0, vv[r][0][2] * iv, vv[r][0][3] * iv, 1.0f, 1);
            d0 = __builtin_amdgcn_cvt_scalef32_pk_fp4_f32(d0, vv[r][1][0] * iv, vv[r][1][1] * iv, 1.0f, 2); d0 = __builtin_amdgcn_cvt_scalef32_pk_fp4_f32(d0, vv[r][1][2] * iv, vv[r][1][3] * iv, 1.0f, 3);
            d1 = __builtin_amdgcn_cvt_scalef32_pk_fp4_f32(d1, vv[r][2][0] * iv, vv[r][2][1] * iv, 1.0f, 0); d1 = __builtin_amdgcn_cvt_scalef32_pk_fp4_f32(d1, vv[r][2][2] * iv, vv[r][2][3] * iv, 1.0f, 1);
            d1 = __builtin_amdgcn_cvt_scalef32_pk_fp4_f32(d1, vv[r][3][0] * iv, vv[r][3][1] * iv, 1.0f, 2); d1 = __builtin_amdgcn_cvt_scalef32_pk_fp4_f32(d1, vv[r][3][2] * iv, vv[r][3][3] * iv, 1.0f, 3);
            *(u32x4*)(dst + (size_t)(row0 + r) * TROWX + lane * 16) = (u32x4){d[0], d[1], d0, d1};
            if (lane == 0) { scu[row0 + r] = su_; scv[row0 + r] = sv_; }
        }
    }
}

#define DPP_ADD(v, ctrl) ((v) + __builtin_bit_cast(float, __builtin_amdgcn_update_dpp(0, __builtin_bit_cast(int, (v)), (ctrl), 0xf, 0xf, true)))
typedef int i32x4_t __attribute__((ext_vector_type(4)));
constexpr int GT = 2;
typedef int v8i_t __attribute__((ext_vector_type(8)));
typedef int v2i_t __attribute__((ext_vector_type(2)));
struct GSet { u32x2 uq[4]; u32x2 vq[4]; };
__device__ __forceinline__ void gather_issue(GSet& S, int bt, int lane, const unsigned char* pu, const unsigned char* pv, const LAS int* etok) {
    const i32x4_t ev = *(const LAS i32x4_t*)(etok + bt * 4);
    const int es[4] = {ev.x, ev.y, ev.z, ev.w};
#pragma unroll
    for (int k = 0; k < 2; ++k) {
        const unsigned f0 = (unsigned)es[2 * k] * (unsigned)TROWX + (unsigned)lane * 16u, f1 = (unsigned)es[2 * k + 1] * (unsigned)TROWX + (unsigned)lane * 16u;
        const u32x4 r0 = *(const u32x4*)(pu + f0), r1 = *(const u32x4*)(pu + f1);
        S.uq[2 * k] = (u32x2){r0.x, r0.y}; S.vq[2 * k] = (u32x2){r0.z, r0.w}; S.uq[2 * k + 1] = (u32x2){r1.x, r1.y}; S.vq[2 * k + 1] = (u32x2){r1.z, r1.w};
    }
}
constexpr int GV_ROW = 520;
constexpr int GV_BYTES = 16 * GV_ROW, GC_BYTES = 96;
__device__ __forceinline__ float gather_udot(const GSet& S, const unsigned (&hd)[4], LAS unsigned char* vrow) {
    int d[4];
#pragma unroll
    for (int k = 0; k < 4; ++k) {
        const int q0 = (int)S.uq[k].x, q1 = (int)S.uq[k].y;
        int a1, a2;
        asm("v_dot8_i32_i4 %0, %1, %2, 0" : "=v"(a1) : "v"(q0), "v"(hd[0]));
        asm("v_dot8_i32_i4 %0, %1, %2, 0" : "=v"(a2) : "v"(q0), "v"(hd[2]));
        a1 = __builtin_amdgcn_sdot8(q1, (int)hd[1], a1, false); a2 = __builtin_amdgcn_sdot8(q1, (int)hd[3], a2, false);
        d[k] = (a1 << 4) + a2;
    }
#pragma unroll
    for (int k = 0; k < 4; ++k) *(LAS u32x2*)(vrow + k * GV_ROW) = S.vq[k];
    int e2[2], f1;
#pragma unroll
    for (int k = 0; k < 2; ++k) { auto r = __builtin_amdgcn_permlane16_swap((unsigned)d[k], (unsigned)d[k + 2], false, false); e2[k] = (int)r[0] + (int)r[1]; }
    { auto r = __builtin_amdgcn_permlane32_swap((unsigned)e2[0], (unsigned)e2[1], false, false); f1 = (int)r[0] + (int)r[1]; }
    f1 += __builtin_amdgcn_update_dpp(0, f1, 0xB1, 0xf, 0xf, true); f1 += __builtin_amdgcn_update_dpp(0, f1, 0x4E, 0xf, 0xf, true);
    f1 += __builtin_amdgcn_update_dpp(0, f1, 0x124, 0xf, 0xf, true); f1 += __builtin_amdgcn_update_dpp(0, f1, 0x128, 0xf, 0xf, true);
    return (float)f1;
}
#define DPP_MAX(v, ctrl) fmaxf((v), __builtin_bit_cast(float, __builtin_amdgcn_update_dpp(0, __builtin_bit_cast(int, (v)), (ctrl), 0xf, 0xf, true)))
__device__ __forceinline__ void gather_vpart(float f0, float f1, float f2, float f3, int lane, int kslot, const LAS float* lg  ,
                                             const LAS unsigned char* vrd  , LAS unsigned char* cb, int aoff1, int aoff2, f32x4 (&acc)[8]) {
    const int q = (lane >> 2) & 3, e16 = 4 * q + kslot;
    const float fs = q == 0 ? f0 : q == 1 ? f1 : q == 2 ? f2 : f3;
    const float cv = lg[e16] * gelu_erf(fs * lg[GT * 128 + e16]);
    float mx = fabsf(cv);
    mx = DPP_MAX(mx, 0x124); mx = DPP_MAX(mx, 0x128);
    { auto r = __builtin_amdgcn_permlane16_swap(__float_as_uint(mx), __float_as_uint(mx), false, false); mx = fmaxf(__uint_as_float(r[0]), __uint_as_float(r[1])); }
    { auto r = __builtin_amdgcn_permlane32_swap(__float_as_uint(mx), __float_as_uint(mx), false, false); mx = fmaxf(__uint_as_float(r[0]), __uint_as_float(r[1])); }
    int E = (int)((__float_as_uint(mx) >> 23) & 0xffu); E = E < 8 ? 8 : E;
    const float x = cv * __uint_as_float((unsigned)(255 - E) << 23);
    const unsigned p1 = __builtin_amdgcn_cvt_scalef32_pk_fp4_f32(0u, x, 0.f, 1.0f, 0);
    const float r1 = x - __builtin_amdgcn_cvt_scalef32_pk_f32_fp4(p1, 1.0f, 0)[0];
    const unsigned p2 = __builtin_amdgcn_cvt_scalef32_pk_fp4_f32(0u, r1, 0.f, 1.0f, 0);
    const float y = (r1 - __builtin_amdgcn_cvt_scalef32_pk_f32_fp4(p2, 1.0f, 0)[0]) * 16.0f;
    const unsigned p3 = __builtin_amdgcn_cvt_scalef32_pk_fp4_f32(0u, y, 0.f, 1.0f, 0);
    const float r3 = y - __builtin_amdgcn_cvt_scalef32_pk_f32_fp4(p3, 1.0f, 0)[0];
    const unsigned p4 = __builtin_amdgcn_cvt_scalef32_pk_fp4_f32(0u, r3, 0.f, 1.0f, 0);
    const unsigned codes = (p1 & 15u) | ((p2 & 15u) << 8) | ((p3 & 15u) << 16) | ((p4 & 15u) << 24);
    { auto r = __builtin_amdgcn_permlane32_swap(codes, codes, false, false);
      const unsigned w = codes | ((r[0] ^ r[1] ^ codes) << 4);
      if (lane < 32 && (lane & 3) == 0) {
          LAS unsigned char* tb = cb + 8 + 2 * q + ((lane >> 4) & 1);
          tb[0] = (unsigned char)w; tb[16] = (unsigned char)(w >> 8); tb[32] = (unsigned char)(w >> 16); tb[48] = (unsigned char)(w >> 24);
      } }
    const u32x2 a10 = *(const LAS u32x2*)(cb + aoff1), a11 = *(const LAS u32x2*)(cb + aoff1 + 8), a20 = *(const LAS u32x2*)(cb + aoff2), a21 = *(const LAS u32x2*)(cb + aoff2 + 8);
    const v8i_t A1 = {(int)a10.x, (int)a10.y, (int)a11.x, (int)a11.y, 0, 0, 0, 0}, A2 = {(int)a20.x, (int)a20.y, (int)a21.x, (int)a21.y, 0, 0, 0, 0};
    const int sa1 = (E - 1) * 0x01010101, sa2 = (E - 5) * 0x01010101;
#pragma unroll
    for (int m = 0; m < 8; ++m) {
        const v2i_t t0 = __builtin_amdgcn_ds_read_tr4_b64_v2i32((LAS v2i_t*)(vrd + 16 * m)), t1 = __builtin_amdgcn_ds_read_tr4_b64_v2i32((LAS v2i_t*)(vrd + 16 * m + 8));
        const v8i_t B = {t0.x, t0.y, t1.x, t1.y, 0, 0, 0, 0};
        acc[m] = __builtin_amdgcn_mfma_scale_f32_16x16x128_f8f6f4(A1, B, acc[m], 4, 4, 0, sa1, 0, 0x7F7F7F7F);
        acc[m] = __builtin_amdgcn_mfma_scale_f32_16x16x128_f8f6f4(A2, B, acc[m], 4, 4, 0, sa2, 0, 0x7F7F7F7F);
    }
}
__device__ __forceinline__ void xcd_pace(unsigned* bar, volatile LAS unsigned* st);
constexpr int GNS = 8, GBPS = 32 / GNS, GSHIFT = 11;
constexpr int GATH_LDS_WAVE = GT * 128 * 12 + GV_BYTES + GC_BYTES;
#define GATH_SEG(J, NJ, nbt) { \
        const LAS int* le_ = lse + (J) * 128; const LAS int* ne_ = lse + (NJ) * 128; \
        gather_issue(D, GBPS * c + 3, lane, pu, pv, le_); \
        const float f0_ = hsc[J] * gather_udot(A, hd[J], vwr); \
        gather_issue(A, (nbt), lane, pu, pv, ne_); \
        const float f1_ = hsc[J] * gather_udot(B, hd[J], vwr + 4 * GV_ROW); \
        gather_issue(B, (nbt) + 1, lane, pu, pv, ne_); \
        const float f2_ = hsc[J] * gather_udot(C, hd[J], vwr + 8 * GV_ROW); \
        gather_issue(C, (nbt) + 2, lane, pu, pv, ne_); \
        const float f3_ = hsc[J] * gather_udot(D, hd[J], vwr + 12 * GV_ROW); \
        gather_vpart(f0_, f1_, f2_, f3_, lane, kslot, lsg + (J) * 128 + 16 * c, vrd, cb, aoff1, aoff2, acc[J]); }
__device__ void ph_peer_gather(const bf16* h2, const unsigned char* pu, const unsigned char* pv, const float* su, const float* sv,
                               const int* eidx, const float* egate, const bf16* xin  , const float* gate  , float* xout, LAS unsigned char* lds, unsigned* pace_bar, volatile LAS unsigned* pace_st, int bid, int nb,
                               bf16* xmid  ) {
    const int lane0 = ltid() & 63, w = __builtin_amdgcn_readfirstlane(ltid() >> 6);
    LAS int* lse = (LAS int*)(lds + w * GATH_LDS_WAVE); LAS float* lsg = (LAS float*)(lds + w * GATH_LDS_WAVE + GT * 128 * 4);
    LAS unsigned char* vb = lds + w * GATH_LDS_WAVE + GT * 128 * 12; LAS unsigned char* cb = vb + GV_BYTES;
    if (lane0 < GC_BYTES / 4) ((LAS unsigned*)cb)[lane0] = 0u;
    for (int t0 = (bid * 8 + w) * GT; t0 < MT; t0 += nb * 8 * GT) {
        int lane = lane0; asm volatile("" : "+v"(lane));
        const int row = lane >> 4;
        const int kslot = 2 * (row & 1) + (row >> 1);
        const int b = t0 >> 11;
        LAS unsigned char* vwr = vb + lane * 8;
        const LAS unsigned char* vrd = vb + (lane & 15) * GV_ROW + 128 * row;
        const int ai = lane & 15, au = (ai < 8 ? 1 : 3), nz = ((ai & 7) >> 1) == row;
        const int aoff1 = nz ? 8 * (au - (ai & 1)) : 64, aoff2 = nz ? 8 * (au + 4 - (ai & 1)) : 64;
        unsigned hd[GT][4]; float hsc[GT]; f32x4 acc[GT][8];
#pragma unroll
        for (int j = 0; j < GT; ++j) {
            const int t = t0 + j;
            const int e0 = eidx[(size_t)t * 128 + lane], e1 = eidx[(size_t)t * 128 + 64 + lane];
            const float g0 = egate[(size_t)t * 128 + lane], g1 = egate[(size_t)t * 128 + 64 + lane];
            const int k0 = e0 >> GSHIFT, k1 = e1 >> GSHIFT;
            int off = 0, d0 = 0, d1 = 0;
#pragma unroll
            for (int s = 0; s < GNS; ++s) {
                const unsigned long long m0 = __ballot(k0 == s), m1 = __ballot(k1 == s);
                const int r0 = (int)__builtin_amdgcn_mbcnt_hi((unsigned)(m0 >> 32), __builtin_amdgcn_mbcnt_lo((unsigned)m0, 0u));
                const int r1 = (int)__builtin_amdgcn_mbcnt_hi((unsigned)(m1 >> 32), __builtin_amdgcn_mbcnt_lo((unsigned)m1, 0u));
                const int c0 = __builtin_popcountll(m0);
                if (k0 == s) d0 = off + r0;
                if (k1 == s) d1 = off + c0 + r1;
                off += c0 + __builtin_popcountll(m1);
            }
            const float s0 = egate[8 * 1024 * 1024 + (size_t)t * 128 + lane], s1 = egate[8 * 1024 * 1024 + (size_t)t * 128 + 64 + lane];
            lse[j * 128 + d0] = e0; lsg[j * 128 + d0] = g0; lse[j * 128 + d1] = e1; lsg[j * 128 + d1] = g1;
            lsg[GT * 128 + j * 128 + d0] = s0; lsg[GT * 128 + j * 128 + d1] = s1;
            const u32x4 u0 = *(const u32x4*)(h2 + (size_t)t * DM + lane * 16), u1 = *(const u32x4*)(h2 + (size_t)t * DM + lane * 16 + 8);
            {
                float hf[16];
#pragma unroll
                for (int i = 0; i < 4; ++i) { hf[2 * i] = __uint_as_float(u0[i] << 16); hf[2 * i + 1] = __uint_as_float(u0[i] & 0xffff0000u); hf[8 + 2 * i] = __uint_as_float(u1[i] << 16); hf[8 + 2 * i + 1] = __uint_as_float(u1[i] & 0xffff0000u); }
                float mh = 0.f;
#pragma unroll
                for (int i = 0; i < 16; ++i) mh = fmaxf(mh, fabsf(hf[i]));
                mh = wave_max(mh);
                int Eh = (int)((__float_as_uint(mh) >> 23) & 0xffu); Eh = Eh < 8 ? 8 : Eh;
                const float up = __uint_as_float((unsigned)(255 - Eh) << 23);
                hsc[j] = __uint_as_float((unsigned)(Eh - 5) << 23);
                unsigned p1[2] = {0u, 0u}, p2[2] = {0u, 0u};
#pragma unroll
                for (int i = 0; i < 16; ++i) {
                    const float x = hf[i] * up, r1 = rintf(x);
                    int q2 = (int)rintf((x - r1) * 16.0f); q2 = q2 > 7 ? 7 : q2;
                    p1[i >> 3] |= ((unsigned)(int)r1 & 15u) << (4 * (i & 7)); p2[i >> 3] |= ((unsigned)q2 & 15u) << (4 * (i & 7));
                }
                hd[j][0] = p1[0]; hd[j][1] = p1[1]; hd[j][2] = p2[0]; hd[j][3] = p2[1];
            }
#pragma unroll
            for (int i = 0; i < 8; ++i) acc[j][i] = (f32x4){0.f, 0.f, 0.f, 0.f};
        }
        GSet A, B, C, D;
        gather_issue(A, 0, lane, pu, pv, lse); gather_issue(B, 1, lane, pu, pv, lse); gather_issue(C, 2, lane, pu, pv, lse);
#pragma unroll 1
        for (int c = 0; c < GNS; ++c) {
            GATH_SEG(0, 1, GBPS * c)
            GATH_SEG(1, 0, c < GNS - 1 ? GBPS * c + GBPS : 0)
        }
#pragma unroll
        for (int j = 0; j < GT; ++j) {
            const int t = t0 + j;
            LAS float* ob = (LAS float*)vb;
            const int nbase = 512 * (row & 1) + 32 * (row >> 1) + (lane & 15);
#pragma unroll
            for (int pm = 0; pm < 4; ++pm)
#pragma unroll
                for (int r = 0; r < 4; ++r) {
                    auto sw = __builtin_amdgcn_permlane32_swap(__float_as_uint(acc[j][2 * pm][r]), __float_as_uint(acc[j][2 * pm + 1][r]), false, false);
                    ob[nbase + 256 * (r >> 1) + 64 * pm + 16 * (r & 1)] = __uint_as_float(sw[0]) + __uint_as_float(sw[1]);
                }
#pragma unroll
            for (int i = 0; i < 4; ++i) {
                const int cc = i * 256 + lane * 4;
                const f32x4 a = *(const LAS f32x4*)(ob + cc);
                const u32x2 xq = *(const u32x2*)(xin + (size_t)t * DM + cc); const f32x4 gt = *(const f32x4*)(gate + (size_t)b * 6144 + cc);
                const f32x4 xi = {__uint_as_float(xq.x << 16), __uint_as_float(xq.x & 0xffff0000u), __uint_as_float(xq.y << 16), __uint_as_float(xq.y & 0xffff0000u)};
                f32x4 o;
#pragma unroll
                for (int e = 0; e < 4; ++e) o[e] = xi[e] + gt[e] * a[e];
                if (xmid) { u32x2 pk; pk.x = pk2(o[0], o[1]); pk.y = pk2(o[2], o[3]); *(u32x2*)(xmid + (size_t)t * DM + cc) = pk; }
                else __builtin_nontemporal_store(o, (f32x4*)(xout + (size_t)t * DM + cc));
            }
        }
    }
}

#define XB_TMO      128
#define XB_XCNT(j)  (256  + 64 * (j))
#define XB_XSUB(j)  (1280 + 64 * (j))
#define XB_XGEN(j)  (2304 + 64 * (j))
#define XB_TOP      3328
#define XB_TOPGEN   3392
#define XCD_BAR_WORDS 3456
#define XB_SPIN_CAP (1u << 18)

__device__ __forceinline__ unsigned xb_ld(unsigned* p)              { return __hip_atomic_load(p, __ATOMIC_RELAXED, __HIP_MEMORY_SCOPE_AGENT); }
__device__ __forceinline__ unsigned xb_add(unsigned* p, unsigned v) { return __hip_atomic_fetch_add(p, v, __ATOMIC_RELAXED, __HIP_MEMORY_SCOPE_AGENT); }
__device__ __forceinline__ unsigned xb_xcc_id() { return (unsigned)__builtin_amdgcn_s_getreg((3 << 11) | 20) & 0xFu; }
#define XB_SPIN(cond, bar) do { unsigned _sp = 0; while (cond) { __builtin_amdgcn_s_sleep(1); \
    if ((++_sp & 255u) == 0u) { if (xb_ld(&(bar)[XB_TMO])) break; if (_sp > XB_SPIN_CAP) { atomicAdd(&(bar)[XB_TMO], 1u); break; } } } } while (0)

struct XcdBarrier {
    unsigned* bar; unsigned x;
    volatile LAS unsigned* st;
};

__device__ __forceinline__ XcdBarrier xcd_barrier_post(unsigned* bar, volatile LAS unsigned* st) {
    XcdBarrier b; b.bar = bar; b.x = xb_xcc_id(); b.st = st;
    if (threadIdx.x == 0) (void)xb_add(&bar[XB_XCNT(b.x)], 1u);
    return b;
}
__device__ __forceinline__ void xcd_barrier_complete(unsigned* bar, unsigned x, unsigned& nloc, unsigned& nx) {
    const unsigned G = gridDim.x * gridDim.y * gridDim.z;
    unsigned sum, cnt, mine, sp = 0u;
    for (;;) {
        sum = 0u; cnt = 0u; mine = 0u;
#pragma unroll
        for (unsigned j = 0; j < 16; ++j) { const unsigned c = xb_ld(&bar[XB_XCNT(j)]); sum += c; cnt += (c > 0u) ? 1u : 0u; mine = (j == x) ? c : mine; }
        if (sum == G) break;
        __builtin_amdgcn_s_sleep(1);
        if ((++sp & 255u) == 0u) { if (xb_ld(&bar[XB_TMO])) break; if (sp > XB_SPIN_CAP) { atomicAdd(&bar[XB_TMO], 1u); break; } }
    }
    nloc = mine > 0u ? mine : 1u; nx = cnt > 0u ? cnt : 1u;
}

__device__ __forceinline__ void xcd_barrier(const XcdBarrier& b) {
    asm volatile("s_waitcnt vmcnt(0)" ::: "memory");
    __syncthreads();
    if (threadIdx.x == 0) {
        unsigned* bar = b.bar;
        __builtin_amdgcn_s_waitcnt(0);
        unsigned nloc = b.st[0], nx = b.st[1];
        if (nloc == 0u) { xcd_barrier_complete(bar, b.x, nloc, nx); b.st[0] = nloc; b.st[1] = nx; }
        const unsigned old = xb_add(&bar[XB_XSUB(b.x)], 1u);
        const unsigned gen = old / nloc;
        if (old + 1u == (gen + 1u) * nloc) {
            __builtin_amdgcn_fence(__ATOMIC_RELEASE, "agent");
            asm volatile("s_waitcnt vmcnt(0)" ::: "memory");
            const unsigned og = xb_add(&bar[XB_TOP], 1u);
            const unsigned tg = og / nx;
            if (og + 1u == (tg + 1u) * nx) xb_add(&bar[XB_TOPGEN], 1u);
            else XB_SPIN(xb_ld(&bar[XB_TOPGEN]) == tg, bar);
            __builtin_amdgcn_fence(__ATOMIC_ACQUIRE, "agent");
            xb_add(&bar[XB_XGEN(b.x)], 1u);
            asm volatile("s_waitcnt vmcnt(0)" ::: "memory");
        } else {
            XB_SPIN(xb_ld(&bar[XB_XGEN(b.x)]) == gen, bar);
            __builtin_amdgcn_fence(__ATOMIC_ACQUIRE, "agent");
            asm volatile("s_waitcnt vmcnt(0)" ::: "memory");
        }
    }
    __syncthreads();
}


#define XB_PACE(j) (3584 + 64 * (j))
__device__ __forceinline__ void xcd_pace(unsigned* bar, volatile LAS unsigned* st) {
    __syncthreads();
    if (threadIdx.x == 0) {
        const unsigned nloc = st[0] ? st[0] : 1u, x = xb_xcc_id(), gen = st[4] + 1u;
        st[4] = gen;
        xb_add(&bar[XB_PACE(x)], 1u);
        unsigned sp = 0;
        while (xb_ld(&bar[XB_PACE(x)]) < gen * nloc) { __builtin_amdgcn_s_sleep(1); if (++sp > (1u << 16)) break; }
    }
    __syncthreads();
}
extern __shared__ __attribute__((aligned(16))) unsigned char dyn_lds[];
#ifndef REP_PREP
#define REP_PREP 1
#endif
#ifndef REP_ATTN
#define REP_ATTN 1
#endif
#ifndef REP_SEL
#define REP_SEL 1
#endif
#ifndef REP_GATH
#define REP_GATH 1
#endif
#ifndef REP_GEMM
#define REP_GEMM 1
#endif
#ifndef REP_ADALN
#define REP_ADALN 1
#endif
constexpr int LDS_BYTES = 147456;

template <class T> __device__ __forceinline__ T* karg(int byte_off) {
    const __attribute__((address_space(4))) char* base = (const __attribute__((address_space(4))) char*)__builtin_amdgcn_kernarg_segment_ptr();
    unsigned long long v = *(const __attribute__((address_space(4))) unsigned long long*)(base + byte_off);
    asm volatile("" : "+s"(v));
    return (T*)(__attribute__((address_space(1))) T*)v;
}
#define KIN(i) karg<const float>(8 * (i))
#define KOUT() karg<float>(168)
#define KWS() karg<unsigned char>(176)
static_assert(sizeof(Params) == 184, "Params layout");
template <class T> __device__ __forceinline__ T* launder(T* p) { size_t off = 0; asm volatile("" : "+s"(off)); return (T*)((unsigned char*)p + off); }
__global__ void __launch_bounds__(NT) mega_fwd(Params p) {
    cg::grid_group grid = cg::this_grid();
    const int bid = blockIdx.x, nb = gridDim.x;
    volatile LAS unsigned* bst = (volatile LAS unsigned*)((LAS unsigned char*)dyn_lds + LDS_BYTES - 64);
    if (ltid() < 16) bst[ltid()] = 0u;
    __syncthreads();
    const XcdBarrier xbar = xcd_barrier_post((unsigned*)(KWS() + WS_BAR), bst);
    for (int rep = 0; rep < REP_PREP; ++rep) {
        unsigned char* ws = KWS();
        float* tile = (float*)dyn_lds;
        ph_transpose(KIN(6), (bf16*)(ws + WS_WIN0), 1024, AB_IN, true, tile, bid, nb);
        ph_transpose(KIN(11), (bf16*)(ws + WS_WIN1), 1024, CD_IN, true, tile, bid, nb);
        ph_transpose(KIN(7), (bf16*)(ws + WS_WO0), 1024, 1024, false, tile, bid, nb);
        ph_transpose(KIN(12), (bf16*)(ws + WS_WO1), 1024, 1024, false, tile, bid, nb);
        ph_transpose(KIN(17), (bf16*)(ws + WS_WQ), 1024, PQ, false, tile, bid, nb);
        ph_transpose(KIN(17) + (size_t)1024 * PQ, (bf16*)(ws + WS_WQ) + (size_t)PQ * 1024, 1024, PQ, false, tile, bid, nb);
        ws = launder(ws);
        ph_tab_uv(KIN(19), KIN(20), ws + WS_PU, (float*)(ws + WS_PV), (float*)(ws + WS_PV + 1 * MiB), 2 * NEXP, bid, nb);
        ws = launder(ws);
        ph_mod(KIN(1), KIN(2), KIN(3), (float*)(ws + WS_MOD), (float*)dyn_lds, bid, nb);
        ph_rope_table((float*)(ws + WS_ROPE), bid, nb);
        for (int i = bid * NT + ltid(); i < NB * 8 * 8 * 64; i += nb * NT) ((float*)(ws + WS_KMEAN))[i] = 0.f;
    }
    grid.sync();
#pragma unroll 1
    for (int layer = 0; layer < 2; ++layer) {
        for (int rep = 0; rep < REP_ADALN; ++rep) {
            unsigned char* ws = KWS(); const float* mod = (const float*)(ws + WS_MOD) + (size_t)layer * 32 * 6144;
            if (layer == 0) ph_adaln<false>(KIN(0), KIN(4), mod + 0, mod + 1024, (bf16*)(ws + WS_HY), bid, nb);
            else ph_adaln<true>(ws + WS_X1 + 128 * MiB, KIN(4) + DM, mod + 0, mod + 1024, (bf16*)(ws + WS_HY), bid, nb);
        }
        xcd_barrier(xbar);
        for (int rep = 0; rep < REP_GEMM; ++rep) {
            unsigned char* ws = KWS();
            pg8::Gemm g{(const bf16*)(ws + WS_HY), (const bf16*)(ws + (layer == 0 ? WS_WIN0 : WS_WIN1)), MT, layer == 0 ? AB_IN : CD_IN, DM};
            pg8::StaticOrder S; S.init(g.M, g.N, nb, bid);
            pg8::EpiQKV e{(bf16*)(ws + WS_QKV), QKV_LD, (const float*)(ws + WS_ROPE), layer, layer == 0 ? KIN(9) : KIN(13), layer == 0 ? KIN(10) : KIN(14), KIN(15), KIN(16), (float*)(ws + WS_KMEAN)};
            pg8::gemm_phase<pg8::EpiQKV, pg8::StaticOrder, true, true>((LAS unsigned char*)dyn_lds, g, S, e);
        }
        xcd_barrier(xbar);
        for (int rep = 0; rep < REP_ATTN; ++rep) {
            unsigned char* ws = KWS();
            if (layer == 0) ph_attn0((const bf16*)(ws + WS_QKV), KIN(8), (bf16*)(ws + WS_HY), (LAS unsigned char*)dyn_lds, bid, nb);
            else ph_attn1((const bf16*)(ws + WS_QKV), (const float*)(ws + WS_KMEAN), (bf16*)(ws + WS_HY), (LAS unsigned char*)dyn_lds, bid, nb);
        }
        xcd_barrier(xbar);
        for (int rep = 0; rep < REP_GEMM; ++rep) {
            unsigned char* ws = KWS(); const float* mod = (const float*)(ws + WS_MOD) + (size_t)layer * 32 * 6144;
            pg8::Gemm g{(const bf16*)(ws + WS_HY), (const bf16*)(ws + (layer == 0 ? WS_WO0 : WS_WO1)), MT, DM, DM};
            pg8::StaticOrder S; S.init(g.M, g.N, nb, bid);
            if (layer == 0) { pg8::EpiResid<false> e{KIN(0), (pg8::bf16_t*)(ws + WS_X1), mod + 2048}; pg8::gemm_phase<pg8::EpiResid<false>, pg8::StaticOrder, true, true>((LAS unsigned char*)dyn_lds, g, S, e); }
            else { pg8::EpiResid<true> e{ws + WS_X1 + 128 * MiB, (pg8::bf16_t*)(ws + WS_X1), mod + 2048}; pg8::gemm_phase<pg8::EpiResid<true>, pg8::StaticOrder, true, true>((LAS unsigned char*)dyn_lds, g, S, e); }
        }
        xcd_barrier(xbar);
        for (int rep = 0; rep < REP_ADALN; ++rep) {
            unsigned char* ws = KWS(); const float* mod = (const float*)(ws + WS_MOD) + (size_t)layer * 32 * 6144;
            ph_adaln<true>(ws + WS_X1, KIN(5) + layer * DM, mod + 3072, mod + 4096, (bf16*)(ws + WS_QKV), bid, nb);
        }
        xcd_barrier(xbar);
        for (int rep = 0; rep < REP_GEMM; ++rep) {
            unsigned char* ws = KWS();
            pg8::Gemm g{(const bf16*)(ws + WS_QKV), (const bf16*)(ws + WS_WQ) + (size_t)layer * PQ * DM, MT, PQ, DM};
            pg8::StaticOrder S; S.init(g.M, g.N, nb, bid); pg8::EpiStore e{(bf16*)(ws + WS_QKV + 128 * MiB), PQ};
            pg8::gemm_phase<pg8::EpiStore, pg8::StaticOrder, true, true>((LAS unsigned char*)dyn_lds, g, S, e);
        }
        xcd_barrier(xbar);
        for (int rep = 0; rep < REP_SEL; ++rep) {
            unsigned char* ws = KWS();
            ph_peer_select((const bf16*)(ws + WS_QKV + 128 * MiB), KIN(18) + (size_t)layer * 2 * 128 * 128, (int*)(ws + WS_HY), (float*)(ws + WS_HY + 32 * MiB), (const float*)(ws + WS_PV) + layer * NEXP, (const float*)(ws + WS_PV + 1 * MiB) + layer * NEXP, (LAS unsigned char*)dyn_lds, bid, nb);
        }
        xcd_barrier(xbar);
        for (int rep = 0; rep < REP_GATH; ++rep) {
            unsigned char* ws = KWS(); const float* mod = (const float*)(ws + WS_MOD) + (size_t)layer * 32 * 6144;
            ph_peer_gather((const bf16*)(ws + WS_QKV), ws + WS_PU + (size_t)layer * NEXP * TROWX, ws + WS_PU + (size_t)layer * NEXP * TROWX,
                           (const float*)(ws + WS_PV) + layer * NEXP, (const float*)(ws + WS_PV + 1 * MiB) + layer * NEXP, (const int*)(ws + WS_HY), (const float*)(ws + WS_HY + 32 * MiB), (const bf16*)(ws + WS_X1), mod + 5120, KOUT(), (LAS unsigned char*)dyn_lds, (unsigned*)(ws + WS_BAR), bst, bid, nb, layer == 0 ? (bf16*)(ws + WS_X1 + 128 * MiB) : (bf16*)nullptr);
        }
        if (layer == 0) xcd_barrier(xbar);
    }
}

extern "C" void kernel_launch(void* const* d_in, const int* in_sizes, int n_in, void* d_out, int out_size, void* d_ws, size_t ws_size, hipStream_t stream) {
    if (n_in != 21 || ws_size < WS_END) { fprintf(stderr, "kernel_launch: bad args n_in=%d ws=%zu\n", n_in, ws_size); return; }
    static int grid_blocks = 0;
    if (!grid_blocks) {
        int dev = 0, cus = 0, per_cu = 0;
        (void)hipGetDevice(&dev);
        (void)hipDeviceGetAttribute(&cus, hipDeviceAttributeMultiprocessorCount, dev);
        (void)hipFuncSetAttribute((const void*)mega_fwd, hipFuncAttributeMaxDynamicSharedMemorySize, LDS_BYTES);
        (void)hipOccupancyMaxActiveBlocksPerMultiprocessor(&per_cu, (const void*)mega_fwd, NT, LDS_BYTES);
        if (per_cu < 1) { fprintf(stderr, "kernel_launch: occupancy query returned %d\n", per_cu); per_cu = 1; }
        if (per_cu > 1) per_cu = 1;
        grid_blocks = cus * per_cu;
    }
    Params p{};
    for (int i = 0; i < 21; ++i) p.in[i] = (const float*)d_in[i];
    p.out = (float*)d_out; p.ws = (unsigned char*)d_ws;
    (void)hipMemsetAsync((char*)d_ws + WS_BAR, 0, 16384, stream);
    void* args[] = {&p};
    hipError_t e = hipLaunchCooperativeKernel((const void*)mega_fwd, dim3(grid_blocks), dim3(NT), args, LDS_BYTES, stream);
    if (e != hipSuccess) fprintf(stderr, "cooperative launch failed: %s (grid %d)\n", hipGetErrorString(e), grid_blocks);
}
```

```cpp
#include <hip/hip_runtime.h>
#ifndef REP_A
#define REP_A 1
#endif
#ifndef REP_B
#define REP_B 1
#endif
#ifndef REP_C
#define REP_C 1
#endif
#ifndef REP_D
#define REP_D 1
#endif
#include <hip/hip_cooperative_groups.h>
namespace cg = cooperative_groups;
#include <cstdio>
#include <cstdint>
#include <cmath>

typedef unsigned short bf16;
typedef short bf16x8 __attribute__((ext_vector_type(8)));
typedef float f32x4 __attribute__((ext_vector_type(4)));
typedef unsigned u32x4 __attribute__((ext_vector_type(4)));
typedef unsigned u32x2 __attribute__((ext_vector_type(2)));

constexpr int DM = 1024, NB = 32, SQ = 2048, MT = NB * SQ;
constexpr int HD = 64;
constexpr int AB_IN = 2304, CD_IN = 3072, QKV_LD = 3072;
constexpr int NEXP = 16384, PQ = 2048;
constexpr float EPS = 1e-6f;
constexpr int NT = 512;

constexpr size_t MiB = 1u << 20;
constexpr size_t WS_X1 = 0;
constexpr size_t WS_QKV = 256 * MiB;
constexpr size_t WS_HY = 640 * MiB;
constexpr size_t WS_PU = 768 * MiB;
constexpr size_t WS_PV = 832 * MiB;
constexpr size_t WS_WIN0 = 896 * MiB;
constexpr size_t WS_WIN1 = 901 * MiB;
constexpr size_t WS_WO0 = 907 * MiB;
constexpr size_t WS_WO1 = 909 * MiB;
constexpr size_t WS_WQ = 911 * MiB;
constexpr size_t WS_MOD = 919 * MiB;
constexpr size_t WS_ROPE = 921 * MiB;
constexpr size_t WS_KMEAN = 922 * MiB;
constexpr size_t WS_BAR = 923 * MiB;
constexpr size_t WS_END = 924 * MiB;

struct Params {
    const float* in[21];
    float* out;
    unsigned char* ws;
};

__device__ __forceinline__ int ltid() { int t = (int)__builtin_amdgcn_workitem_id_x(); asm volatile("" : "+v"(t)); return t; }
__device__ __forceinline__ float bf2f(unsigned b) { return __uint_as_float(b << 16); }
__device__ __forceinline__ unsigned f2bf(float f) { unsigned u = __float_as_uint(f); return (u + 0x7fffu + ((u >> 16) & 1u)) >> 16; }
__device__ __forceinline__ unsigned pk2(float lo, float hi) { return f2bf(lo) | (f2bf(hi) << 16); }
#define DPPV(v, ctrl) __builtin_bit_cast(float, __builtin_amdgcn_update_dpp(0, __builtin_bit_cast(int, (v)), (ctrl), 0xf, 0xf, true))
__device__ __forceinline__ float row16_sum(float v) { v += DPPV(v, 0xB1); v += DPPV(v, 0x4E); v += DPPV(v, 0x124); v += DPPV(v, 0x128); return v; }
__device__ __forceinline__ float rows_sum(float v) {
    { auto r = __builtin_amdgcn_permlane16_swap(__float_as_uint(v), __float_as_uint(v), false, false); v = __uint_as_float(r[0]) + __uint_as_float(r[1]); }
    { auto r = __builtin_amdgcn_permlane32_swap(__float_as_uint(v), __float_as_uint(v), false, false); v = __uint_as_float(r[0]) + __uint_as_float(r[1]); }
    return v;
}
__device__ __forceinline__ float wave_sum(float v) { return rows_sum(row16_sum(v)); }
__device__ __forceinline__ float wave_max(float v) {
    v = fmaxf(v, DPPV(v, 0xB1)); v = fmaxf(v, DPPV(v, 0x4E)); v = fmaxf(v, DPPV(v, 0x124)); v = fmaxf(v, DPPV(v, 0x128));
    { auto r = __builtin_amdgcn_permlane16_swap(__float_as_uint(v), __float_as_uint(v), false, false); v = fmaxf(__uint_as_float(r[0]), __uint_as_float(r[1])); }
    { auto r = __builtin_amdgcn_permlane32_swap(__float_as_uint(v), __float_as_uint(v), false, false); v = fmaxf(__uint_as_float(r[0]), __uint_as_float(r[1])); }
    return v;
}
__device__ __forceinline__ float gelu_erf(float x) {
    const float z = x * 0.70710678118654752f, az = fabsf(z);
    const float t = __builtin_amdgcn_rcpf(fmaf(0.3275911f, az, 1.0f));
    float pl = fmaf(t, 1.061405429f, -1.453152027f); pl = fmaf(t, pl, 1.421413741f); pl = fmaf(t, pl, -0.284496736f); pl = fmaf(t, pl, 0.254829592f); pl *= t;
    const float ex = __builtin_amdgcn_exp2f(az * (az * -1.4426950408889634f));
    const float er = copysignf(fmaf(-pl, ex, 1.0f), z);
    const float hx = 0.5f * x;
    return fmaf(hx, er, hx);
}

__device__ __forceinline__ int qkv_logical_col(int p) { return (p & ~255) | (((p >> 5) & 3) << 6) | (((p >> 7) & 1) << 5) | (p & 31); }
__device__ void ph_transpose(const float* W, bf16* Wt, int K, int N, bool permute, float* tile  , int bid, int nb) {
    const int tid = ltid();
    const int nkt = K / 64, nnt = N / 64;
    for (int it = bid; it < nkt * nnt; it += nb) {
        const int k0 = (it / nnt) * 64, n0 = (it % nnt) * 64;
        __syncthreads();
        for (int e = tid; e < 64 * 64; e += NT) { const int r = e >> 6, c = e & 63; const int nl = permute ? qkv_logical_col(n0 + c) : n0 + c; tile[r * 65 + c] = W[(size_t)(k0 + r) * N + nl]; }
        __syncthreads();
        {
            const int n = tid >> 3, k8 = (tid & 7) * 8;
            u32x4 v;
            v.x = pk2(tile[(k8 + 0) * 65 + n], tile[(k8 + 1) * 65 + n]);
            v.y = pk2(tile[(k8 + 2) * 65 + n], tile[(k8 + 3) * 65 + n]);
            v.z = pk2(tile[(k8 + 4) * 65 + n], tile[(k8 + 5) * 65 + n]);
            v.w = pk2(tile[(k8 + 6) * 65 + n], tile[(k8 + 7) * 65 + n]);
            *(u32x4*)(Wt + (size_t)(n0 + n) * K + k0 + k8) = v;
        }
    }
}
__device__ void ph_convert(const float* src, bf16* dst, size_t n, int bid, int nb) {
    const size_t n8 = n / 8;
    for (size_t i = (size_t)bid * NT + ltid(); i < n8; i += (size_t)nb * NT) {
        const f32x4 a = *(const f32x4*)(src + i * 8), b = *(const f32x4*)(src + i * 8 + 4);
        u32x4 v; v.x = pk2(a[0], a[1]); v.y = pk2(a[2], a[3]); v.z = pk2(b[0], b[1]); v.w = pk2(b[2], b[3]);
        *(u32x4*)(dst + i * 8) = v;
    }
}
__device__ void ph_mod(const float* c, const float* ada_w, const float* ada_b, float* mod, float* lds  , int bid, int nb) {
    const int tid = ltid(), lane = tid & 63, w = tid >> 6;
    for (int it = bid; it < 2 * 96; it += nb) {
        const int l = it / 96, j = (it % 96) * 64 + lane;
        float acc[32];
#pragma unroll
        for (int b = 0; b < 32; ++b) acc[b] = 0.f;
        for (int kh = 0; kh < 2; ++kh) {
            __syncthreads();
            for (int e = tid; e < 32 * 512; e += NT) { const int b = e >> 9, k = e & 511; const float cv = c[b * 1024 + kh * 512 + k]; lds[e] = cv / (1.0f + __expf(-cv)); }
            __syncthreads();
            for (int kk = 0; kk < 64; ++kk) {
                const int k = w * 64 + kk;
                const float wv = ada_w[((size_t)l * 1024 + kh * 512 + k) * 6144 + j];
#pragma unroll
                for (int b = 0; b < 32; ++b) acc[b] += lds[b * 512 + k] * wv;
            }
        }
        __syncthreads();
#pragma unroll
        for (int b = 0; b < 32; ++b) lds[(w * 32 + b) * 64 + lane] = acc[b];
        __syncthreads();
        for (int e = tid; e < 32 * 64; e += NT) {
            const int b = e >> 6, jj = e & 63; float s = 0.f;
#pragma unroll
            for (int ww = 0; ww < 8; ++ww) s += lds[(ww * 32 + b) * 64 + jj];
            const int jo = (it % 96) * 64 + jj;
            mod[((size_t)l * 32 + b) * 6144 + jo] = s + ada_b[l * 6144 + jo];
        }
    }
}
__device__ void ph_rope_table(float* rope, int bid, int nb) {
    for (int i = bid * NT + ltid(); i < SQ * 32; i += nb * NT) {
        const int t = i >> 5, f = i & 31;
        const float inv = powf(10000.0f, -(float)f / 32.0f);
        const float ang = (float)t * inv;
        float s, c; sincosf(ang, &s, &c);
        rope[i * 2] = c; rope[i * 2 + 1] = s;
    }
}

#define DPP_ADD0(v, ctrl) ((v) + __builtin_bit_cast(float, __builtin_amdgcn_update_dpp(0, __builtin_bit_cast(int, (v)), (ctrl), 0xf, 0xf, true)))
template <bool XBF> __device__ void ph_adaln(const void* xv, const float* g, const float* mod_shift  , const float* mod_scale, bf16* h, int bid, int nb) {
    const int lane = ltid() & 63, w = __builtin_amdgcn_readfirstlane(ltid() >> 6);
    for (int t0 = (bid * 8 + w) * 4; t0 < MT; t0 += nb * 8 * 4) {
        const int b = t0 >> 11;
        f32x4 v[4][4]; float ss[4];
#pragma unroll
        for (int r = 0; r < 4; ++r) {
            if constexpr (XBF) {
                const bf16* xr = (const bf16*)xv + (size_t)(t0 + r) * DM;
#pragma unroll
                for (int i = 0; i < 4; ++i) { const u32x2 q = *(const u32x2*)(xr + i * 256 + lane * 4); v[r][i] = (f32x4){__uint_as_float(q.x << 16), __uint_as_float(q.x & 0xffff0000u), __uint_as_float(q.y << 16), __uint_as_float(q.y & 0xffff0000u)}; }
            } else {
                const float* xr = (const float*)xv + (size_t)(t0 + r) * DM;
#pragma unroll
                for (int i = 0; i < 4; ++i) v[r][i] = *(const f32x4*)(xr + i * 256 + lane * 4);
            }
        }
#pragma unroll
        for (int r = 0; r < 4; ++r) {
            float s = 0.f;
#pragma unroll
            for (int i = 0; i < 4; ++i) s += v[r][i][0] * v[r][i][0] + v[r][i][1] * v[r][i][1] + v[r][i][2] * v[r][i][2] + v[r][i][3] * v[r][i][3];
            s = DPP_ADD0(s, 0xB1); s = DPP_ADD0(s, 0x4E); s = DPP_ADD0(s, 0x124); s = DPP_ADD0(s, 0x128);
            { auto q = __builtin_amdgcn_permlane16_swap(__float_as_uint(s), __float_as_uint(s), false, false); s = __uint_as_float(q[0]) + __uint_as_float(q[1]); }
            { auto q = __builtin_amdgcn_permlane32_swap(__float_as_uint(s), __float_as_uint(s), false, false); s = __uint_as_float(q[0]) + __uint_as_float(q[1]); }
            ss[r] = rsqrtf(s * (1.0f / DM) + EPS);
        }
#pragma unroll
        for (int i = 0; i < 4; ++i) {
            const int c = i * 256 + lane * 4;
            const f32x4 gg = *(const f32x4*)(g + c), sc = *(const f32x4*)(mod_scale + (size_t)b * 6144 + c), sh = *(const f32x4*)(mod_shift + (size_t)b * 6144 + c);
            float a[4];
#pragma unroll
            for (int e = 0; e < 4; ++e) a[e] = gg[e] * (1.0f + sc[e]);
#pragma unroll
            for (int r = 0; r < 4; ++r) {
                float y[4];
#pragma unroll
                for (int e = 0; e < 4; ++e) y[e] = v[r][i][e] * ss[r] * a[e] + sh[e];
                u32x2 o; o.x = pk2(y[0], y[1]); o.y = pk2(y[2], y[3]);
                __builtin_nontemporal_store(o, (u32x2*)(h + (size_t)(t0 + r) * DM + c));
            }
        }
    }
}

namespace pg8 {
#define PG8_LAS __attribute__((address_space(3)))
typedef unsigned short bf16_t;
typedef short bf16x8 __attribute__((ext_vector_type(8)));
constexpr int BM = 256, BK = 64, HALF = 128, HTB = HALF * BK * 2  , STAGE_BYTES = 8 * HTB, NXCD = 8, WGM = 8;

__host__ __device__ __forceinline__ int lds_byte(int r, int c) { const int st = (r >> 4) * 2 + (c >> 5), rr = r & 15, cc = c & 31, ob = rr * 64 + cc * 2; return st * 1024 + (ob ^ (((ob >> 9) & 1) << 5)); }
__host__ __device__ __forceinline__ void stage_rc(int b, int& R, int& C) { const int st = b / 1024, sb = b % 1024, swz = sb ^ (((sb >> 9) & 1) << 5); R = (st >> 1) * 16 + swz / 64; C = (st & 1) * 32 + (swz % 64) / 2; }
__host__ __device__ __forceinline__ int perm32(int rho) { const int n = rho >> 4, i = rho & 15; return 8 * (i >> 2) + 4 * n + (i & 3); }

struct Unit { int pm, pn; };
struct Gemm { const bf16_t* A; const bf16_t* Bt; int M, N, K; };

struct StaticOrder {
    int nM, nN, nwg, G, c;
    __host__ __device__ void init(int M, int N, int G_, int c_) { nM = M / BM; nN = N / BM; nwg = nM * nN; G = G_; c = c_; }
    __host__ __device__ bool next(int i, Unit& u) const {
        const long L = (long)i * G + c; if (L >= nwg) return false;
        int wgid = (int)L; { const int q = nwg / NXCD, r = nwg % NXCD, xcd = wgid % NXCD, off = wgid / NXCD; wgid = (xcd < r ? xcd * (q + 1) : r * (q + 1) + (xcd - r) * q) + off; }
        const int nig = WGM * nN, gid = wgid / nig, fm = gid * WGM, gsz = (nM - fm) < WGM ? (nM - fm) : WGM;
        u.pm = fm + ((wgid % nig) % gsz); u.pn = (wgid % nig) / gsz; return true;
    }
    __device__ __forceinline__ void a_ready(const Unit&) const {}
    __device__ __forceinline__ void done(const Unit&) const {}
};

__device__ __forceinline__ unsigned cvt_pk_bf16(float lo, float hi) { unsigned r; asm volatile("v_cvt_pk_bf16_f32 %0, %1, %2" : "=v"(r) : "v"(lo), "v"(hi)); return r; }

struct EpiStore {
    static constexpr bool PERM = true, AFTER_DRAIN = false;
    bf16_t* O; int ldc;
    __device__ __forceinline__ void operator()(const f32x4 (&acc)[2][2][4][2], const Unit& u, int wr, int wc, int fr_, int fq_) const {
        int fr = fr_, fq = fq_; asm volatile("" : "+v"(fr), "+v"(fq));
        const int row0 = u.pm * BM + wr * 64 + fr, col0 = u.pn * BM + wc * 32 + 8 * fq;
#pragma unroll
        for (int ai = 0; ai < 2; ++ai)
#pragma unroll
            for (int m = 0; m < 4; ++m) { bf16_t* rowp = O + (size_t)(row0 + ai * HALF + m * 16) * ldc + col0;
#pragma unroll
                for (int bj = 0; bj < 2; ++bj) { const f32x4 v0 = acc[ai][bj][m][0], v1 = acc[ai][bj][m][1];
                    u32x4 w; w.x = cvt_pk_bf16(v0[0], v0[1]); w.y = cvt_pk_bf16(v0[2], v0[3]); w.z = cvt_pk_bf16(v1[0], v1[1]); w.w = cvt_pk_bf16(v1[2], v1[3]);
                    *(u32x4*)(rowp + bj * HALF) = w; } }
    }
};
struct EpiQKV {
    static constexpr bool PERM = true, AFTER_DRAIN = false;
    bf16_t* O; int ldc; const float* rope; int layer;
    const float* gq0; const float* gk0;
    const float* gq1; const float* gk1;
    float* kmean;
    __device__ __forceinline__ void operator()(const f32x4 (&acc)[2][2][4][2], const Unit& u, int wr, int wc, int fr_, int fq_) const {
        int fr = fr_, fq = fq_; asm volatile("" : "+v"(fr), "+v"(fq));
        const int hg = 4 * u.pn + wc;
        const float* gain = nullptr; bool km = false;
        if (layer == 0) { if (hg < 8) gain = gq0; else if (hg < 10) gain = gk0; }
        else { if (hg < 8) gain = gq0; else if (hg < 16) gain = gk0; else if (hg >= 24 && hg < 32) gain = gq1; else if (hg >= 32 && hg < 40) { gain = gk1; km = true; } }
        const int row0 = u.pm * BM + wr * 64 + fr, col0 = 64 * hg + 8 * fq;
        float g0[8], g1[8], cs0[8], cs1[8];
#pragma unroll
        for (int e = 0; e < 8; ++e) { g0[e] = gain ? gain[8 * fq + e] : 1.f; g1[e] = gain ? gain[32 + 8 * fq + e] : 1.f; cs0[e] = 0.f; cs1[e] = 0.f; }
#pragma unroll
        for (int ai = 0; ai < 2; ++ai)
#pragma unroll
            for (int m = 0; m < 4; ++m) {
                const int row = row0 + ai * HALF + m * 16;
                float v0[8], v1[8];
#pragma unroll
                for (int e = 0; e < 4; ++e) { v0[e] = acc[ai][0][m][0][e]; v0[4 + e] = acc[ai][0][m][1][e]; v1[e] = acc[ai][1][m][0][e]; v1[4 + e] = acc[ai][1][m][1][e]; }
                if (gain) {
                    float ss = 0.f;
#pragma unroll
                    for (int e = 0; e < 8; ++e) ss += v0[e] * v0[e] + v1[e] * v1[e];
                    ss = rows_sum(ss);
                    const float r = rsqrtf(ss * (1.0f / 64.0f) + 1e-6f);
                    const float* rp = rope + ((size_t)(row & 2047) * 32 + 8 * fq) * 2;
                    const f32x4 t0 = *(const f32x4*)(rp), t1 = *(const f32x4*)(rp + 4), t2 = *(const f32x4*)(rp + 8), t3 = *(const f32x4*)(rp + 12);
                    const float cs[8] = {t0[0], t0[2], t1[0], t1[2], t2[0], t2[2], t3[0], t3[2]}, sn[8] = {t0[1], t0[3], t1[1], t1[3], t2[1], t2[3], t3[1], t3[3]};
#pragma unroll
                    for (int e = 0; e < 8; ++e) { const float y0 = v0[e] * r * g0[e], y1 = v1[e] * r * g1[e]; v0[e] = y0 * cs[e] - y1 * sn[e]; v1[e] = y1 * cs[e] + y0 * sn[e]; }
                }
                u32x4 w0, w1;
                w0.x = cvt_pk_bf16(v0[0], v0[1]); w0.y = cvt_pk_bf16(v0[2], v0[3]); w0.z = cvt_pk_bf16(v0[4], v0[5]); w0.w = cvt_pk_bf16(v0[6], v0[7]);
                w1.x = cvt_pk_bf16(v1[0], v1[1]); w1.y = cvt_pk_bf16(v1[2], v1[3]); w1.z = cvt_pk_bf16(v1[4], v1[5]); w1.w = cvt_pk_bf16(v1[6], v1[7]);
                bf16_t* rowp = O + (size_t)row * ldc + col0;
                *(u32x4*)(rowp) = w0; *(u32x4*)(rowp + 32) = w1;
                if (km) {
#pragma unroll
                    for (int e = 0; e < 8; ++e) { cs0[e] += v0[e]; cs1[e] += v1[e]; }
                }
            }
        if (km) {
#pragma unroll
            for (int e = 0; e < 8; ++e) {
                cs0[e] = row16_sum(cs0[e]); cs1[e] = row16_sum(cs1[e]);
            }
            if (fr == 0) {
                float* kp = kmean + ((size_t)((u.pm >> 3) * 8 + (hg - 32)) * 8 + (u.pm & 7)) * 64 + 8 * fq;
#pragma unroll
                for (int e = 0; e < 8; ++e) { atomicAdd(kp + e, cs0[e] * (1.0f / 256.0f)); atomicAdd(kp + 32 + e, cs1[e] * (1.0f / 256.0f)); }
            }
        }
    }
};
template <bool XBF> struct EpiResid {
    static constexpr bool PERM = true, AFTER_DRAIN = false;
    const void* xin; bf16_t* xout; const float* gate;
    __device__ __forceinline__ void operator()(const f32x4 (&acc)[2][2][4][2], const Unit& u, int wr, int wc, int fr_, int fq_) const {
        int fr = fr_, fq = fq_; asm volatile("" : "+v"(fr), "+v"(fq));
        const int row0 = u.pm * BM + wr * 64 + fr, col0 = u.pn * BM + wc * 32 + 8 * fq;
        const float* gp = gate + (size_t)((u.pm * BM) >> 11) * 6144 + col0;
        f32x4 gq[2][2];
#pragma unroll
        for (int bj = 0; bj < 2; ++bj) { gq[bj][0] = *(const f32x4*)(gp + bj * HALF); gq[bj][1] = *(const f32x4*)(gp + bj * HALF + 4); }
#pragma unroll
        for (int ai = 0; ai < 2; ++ai)
#pragma unroll
            for (int m = 0; m < 4; ++m) { const int row = row0 + ai * HALF + m * 16;
                bf16_t* xo = xout + (size_t)row * 1024 + col0;
#pragma unroll
                for (int bj = 0; bj < 2; ++bj) {
                    f32x4 x0, x1;
                    if constexpr (XBF) { const u32x4 q = *(const u32x4*)((const bf16_t*)xin + (size_t)row * 1024 + col0 + bj * HALF);
                        x0 = (f32x4){__uint_as_float(q.x << 16), __uint_as_float(q.x & 0xffff0000u), __uint_as_float(q.y << 16), __uint_as_float(q.y & 0xffff0000u)};
                        x1 = (f32x4){__uint_as_float(q.z << 16), __uint_as_float(q.z & 0xffff0000u), __uint_as_float(q.w << 16), __uint_as_float(q.w & 0xffff0000u)}; }
                    else { const float* xi = (const float*)xin + (size_t)row * 1024 + col0 + bj * HALF; x0 = *(const f32x4*)xi; x1 = *(const f32x4*)(xi + 4); }
                    const f32x4 a0 = acc[ai][bj][m][0], a1 = acc[ai][bj][m][1], g0 = gq[bj][0], g1 = gq[bj][1];
                    u32x4 w; w.x = cvt_pk_bf16(x0[0] + g0[0] * a0[0], x0[1] + g0[1] * a0[1]); w.y = cvt_pk_bf16(x0[2] + g0[2] * a0[2], x0[3] + g0[3] * a0[3]);
                    w.z = cvt_pk_bf16(x1[0] + g1[0] * a1[0], x1[1] + g1[1] * a1[1]); w.w = cvt_pk_bf16(x1[2] + g1[2] * a1[2], x1[3] + g1[3] * a1[3]);
                    *(u32x4*)(xo + bj * HALF) = w; } }
    }
};
template <class Epi, class Sched, bool ALIGN_EPI = false, bool SP2 = false>
__device__ __forceinline__ void gemm_phase(PG8_LAS unsigned char* lds, const Gemm g, const Sched& S, const Epi& E) {
    const int tid = ltid(), wid = __builtin_amdgcn_readfirstlane(tid >> 6), lane = tid & 63, wr = wid >> 2, wc = wid & 3, fr = lane & 15, fq = lane >> 4;
    const int K = g.K, nt = K / BK;
    unsigned voffA[2], voffB[2];
#pragma unroll
    for (int i = 0; i < 2; ++i) { int R, C; stage_rc(tid * 16 + i * 8192, R, C); const int Rb = Epi::PERM ? ((R & ~31) + perm32(R & 31)) : R;
        voffA[i] = (unsigned)(R * K + C) * 2u; voffB[i] = (unsigned)(Rb * K + C) * 2u; }
    const size_t kstep = (size_t)(BK * 2);
    const size_t hstep = (size_t)HALF * K * 2;
    const size_t tstep = 2 * hstep;
    const unsigned ldsw = (unsigned)wid * 1024u;
    const int aoff = lds_byte(wr * 64 + fr, fq * 8), boff = lds_byte(wc * 32 + fr, fq * 8);
#define PG8_SA(b, h) (((b) * 2 + (h)) * HTB)
#define PG8_SB(b, h) ((4 + (b) * 2 + (h)) * HTB)
#define PG8_STAGE(bufoff, gbase, voff) do { _Pragma("unroll") for (int _i = 0; _i < 2; ++_i) \
        __builtin_amdgcn_global_load_lds((const unsigned*)((const char*)(gbase) + (voff)[_i]), (PG8_LAS unsigned*)(lds + (bufoff) + ldsw + _i * 8192), 16, 0, 0); } while (0)
#define PG8_LDA(dst, b, h) do { _Pragma("unroll") for (int m = 0; m < 4; ++m) _Pragma("unroll") for (int k = 0; k < 2; ++k) dst[m][k] = *(const PG8_LAS bf16x8*)(lds + PG8_SA(b, h) + aoff + m * 2048 + k * 1024); } while (0)
#define PG8_LDB(dst, b, h) do { _Pragma("unroll") for (int n = 0; n < 2; ++n) _Pragma("unroll") for (int k = 0; k < 2; ++k) dst[n][k] = *(const PG8_LAS bf16x8*)(lds + PG8_SB(b, h) + boff + n * 2048 + k * 1024); } while (0)
#define PG8_MMA(ai, bj, At, Bt) do { __builtin_amdgcn_s_setprio(1); _Pragma("unroll") for (int m = 0; m < 4; ++m) _Pragma("unroll") for (int n = 0; n < 2; ++n) _Pragma("unroll") for (int k = 0; k < 2; ++k) \
        acc[ai][bj][m][n] = __builtin_amdgcn_mfma_f32_16x16x32_bf16(Bt[n][k], At[m][k], acc[ai][bj][m][n], 0, 0, 0); __builtin_amdgcn_s_setprio(0); } while (0)
#define PG8_WAIT_V(n) asm volatile("s_waitcnt vmcnt(" #n ")" ::: "memory")
#define PG8_WAIT_L(n) asm volatile("s_waitcnt lgkmcnt(" #n ")" ::: "memory")
#define PG8_BAR __builtin_amdgcn_s_barrier()
#define PG8_SCHED __builtin_amdgcn_sched_barrier(0)
    Unit cur, nxt; int ui = 0;
    if (!S.next(0, cur)) return;
    f32x4 acc[2][2][4][2];
#pragma unroll
    for (int a = 0; a < 2; ++a)
#pragma unroll
        for (int b = 0; b < 2; ++b)
#pragma unroll
            for (int m = 0; m < 4; ++m)
#pragma unroll
                for (int n = 0; n < 2; ++n) acc[a][b][m][n] = (f32x4){0.f, 0.f, 0.f, 0.f};
    bf16x8 At[4][2], B0[2][2], B1[2][2];
    const char* cA = (const char*)g.A + (size_t)cur.pm * tstep; const char* cB = (const char*)g.Bt + (size_t)cur.pn * tstep;
    S.a_ready(cur);
    if constexpr (SP2) {
        PG8_STAGE(PG8_SB(0, 0), cB, voffB); PG8_STAGE(PG8_SB(0, 1), cB + hstep, voffB); PG8_STAGE(PG8_SA(0, 0), cA, voffA); PG8_STAGE(PG8_SA(0, 1), cA + hstep, voffA);
        if (wr == 1) PG8_BAR;
        PG8_WAIT_V(2); PG8_BAR;
        PG8_STAGE(PG8_SB(1, 0), cB + kstep, voffB); PG8_STAGE(PG8_SA(1, 0), cA + kstep, voffA); PG8_STAGE(PG8_SB(1, 1), cB + hstep + kstep, voffB);
        PG8_WAIT_V(6); PG8_BAR;
    } else {
        PG8_STAGE(PG8_SB(0, 0), cB, voffB); PG8_STAGE(PG8_SA(0, 0), cA, voffA); PG8_STAGE(PG8_SB(0, 1), cB + hstep, voffB); PG8_STAGE(PG8_SA(0, 1), cA + hstep, voffA);
        if (wr == 1) PG8_BAR;
        PG8_WAIT_V(4); PG8_BAR;
        PG8_STAGE(PG8_SB(1, 0), cB + kstep, voffB); PG8_STAGE(PG8_SA(1, 0), cA + kstep, voffA); PG8_STAGE(PG8_SB(1, 1), cB + hstep + kstep, voffB);
        PG8_WAIT_V(6); PG8_BAR;
    }
    for (;;) {
        const bool has_next = S.next(ui + 1, nxt);
        const char* nA = has_next ? (const char*)g.A + (size_t)nxt.pm * tstep : cA; const char* nB = has_next ? (const char*)g.Bt + (size_t)nxt.pn * tstep : cB;
        for (int t = 0; t < nt; t += 2) {
            const bool last = (t == nt - 2);
            const char* a1 = cA + (size_t)(t + 1) * kstep;
            const char* a2 = last ? nA : cA + (size_t)(t + 2) * kstep; const char* b2 = last ? nB : cB + (size_t)(t + 2) * kstep;
            const char* a3 = a2 + kstep; const char* b3 = b2 + kstep;
            if (last && has_next) S.a_ready(nxt);
            if constexpr (SP2) {
            PG8_LDB(B0, 0, 0); PG8_LDB(B1, 0, 1); PG8_SCHED; PG8_LDA(At, 0, 0); PG8_STAGE(PG8_SA(1, 1), a1 + hstep, voffA);
            PG8_WAIT_V(8); PG8_WAIT_L(0); PG8_BAR; PG8_MMA(0, 0, At, B0); PG8_MMA(0, 1, At, B1); PG8_BAR; PG8_SCHED;
            PG8_LDA(At, 0, 1); PG8_STAGE(PG8_SB(0, 0), b2, voffB); PG8_STAGE(PG8_SB(0, 1), b2 + hstep, voffB); PG8_STAGE(PG8_SA(0, 0), a2, voffA);
            PG8_WAIT_V(8); PG8_WAIT_L(0); PG8_BAR; PG8_MMA(1, 0, At, B0); PG8_MMA(1, 1, At, B1); PG8_BAR; PG8_SCHED;
            PG8_LDB(B0, 1, 0); PG8_LDB(B1, 1, 1); PG8_SCHED; PG8_LDA(At, 1, 0); PG8_STAGE(PG8_SA(0, 1), a2 + hstep, voffA);
            PG8_WAIT_V(8); PG8_WAIT_L(0); PG8_BAR; PG8_MMA(0, 0, At, B0); PG8_MMA(0, 1, At, B1); PG8_BAR; PG8_SCHED;
            PG8_LDA(At, 1, 1); PG8_STAGE(PG8_SB(1, 0), b3, voffB); PG8_STAGE(PG8_SB(1, 1), b3 + hstep, voffB); PG8_STAGE(PG8_SA(1, 0), a3, voffA);
            PG8_WAIT_V(8); PG8_WAIT_L(0); PG8_BAR; PG8_MMA(1, 0, At, B0); PG8_MMA(1, 1, At, B1); PG8_BAR; PG8_SCHED;
            } else {
            PG8_LDB(B0, 0, 0); PG8_SCHED; PG8_LDA(At, 0, 0); PG8_STAGE(PG8_SA(1, 1), a1 + hstep, voffA);
            PG8_WAIT_L(8); PG8_BAR; PG8_WAIT_L(0); PG8_MMA(0, 0, At, B0); PG8_BAR; PG8_SCHED;
            PG8_LDB(B1, 0, 1); PG8_STAGE(PG8_SB(0, 0), b2, voffB);
            PG8_BAR; PG8_WAIT_L(0); PG8_MMA(0, 1, At, B1); PG8_BAR;
            PG8_LDA(At, 0, 1); PG8_STAGE(PG8_SA(0, 0), a2, voffA);
            PG8_BAR; PG8_WAIT_L(0); PG8_MMA(1, 0, At, B0); PG8_BAR; PG8_SCHED;
            PG8_STAGE(PG8_SB(0, 1), b2 + hstep, voffB);
            PG8_WAIT_V(6); PG8_BAR; PG8_MMA(1, 1, At, B1); PG8_BAR;
            PG8_LDB(B0, 1, 0); PG8_SCHED; PG8_LDA(At, 1, 0); PG8_STAGE(PG8_SA(0, 1), a2 + hstep, voffA);
            PG8_WAIT_L(8); PG8_BAR; PG8_WAIT_L(0); PG8_MMA(0, 0, At, B0); PG8_BAR; PG8_SCHED;
            PG8_LDB(B1, 1, 1); PG8_STAGE(PG8_SB(1, 0), b3, voffB);
            PG8_BAR; PG8_WAIT_L(0); PG8_MMA(0, 1, At, B1); PG8_BAR;
            PG8_LDA(At, 1, 1); PG8_STAGE(PG8_SA(1, 0), a3, voffA);
            PG8_BAR; PG8_WAIT_L(0); PG8_MMA(1, 0, At, B0); PG8_BAR; PG8_SCHED;
            PG8_STAGE(PG8_SB(1, 1), b3 + hstep, voffB);
            PG8_WAIT_V(6); PG8_BAR; PG8_MMA(1, 1, At, B1); PG8_BAR;
            }
        }
        if constexpr (ALIGN_EPI) { if (wr == 0) PG8_BAR; }
        if constexpr (!Epi::AFTER_DRAIN) { E(acc, cur, wr, wc, fr, fq); S.done(cur); }
        if (!has_next) break;
#pragma unroll
        for (int a = 0; a < 2; ++a)
#pragma unroll
            for (int b = 0; b < 2; ++b)
#pragma unroll
                for (int m = 0; m < 4; ++m)
#pragma unroll
                    for (int n = 0; n < 2; ++n) acc[a][b][m][n] = (f32x4){0.f, 0.f, 0.f, 0.f};
        cur = nxt; cA = nA; cB = nB; ++ui;
        if constexpr (ALIGN_EPI) { if (wr == 1) PG8_BAR; }
    }
    PG8_WAIT_V(0);
    if constexpr (!ALIGN_EPI) { if (wr == 0) PG8_BAR; }
    PG8_BAR;
    if constexpr (Epi::AFTER_DRAIN) { E.fused(acc, cur, wr, wc, fr, fq, lds, wid, lane); S.done(cur); }
#undef PG8_SA
#undef PG8_SB
#undef PG8_STAGE
#undef PG8_LDA
#undef PG8_LDB
#undef PG8_MMA
#undef PG8_WAIT_V
#undef PG8_WAIT_L
#undef PG8_BAR
#undef PG8_SCHED
}
}

typedef float f32x16 __attribute__((ext_vector_type(16)));
typedef short s16x4 __attribute__((ext_vector_type(4)));
typedef short v4i16_t __attribute__((ext_vector_type(4)));
typedef float f32x2_t __attribute__((ext_vector_type(2)));
typedef __bf16 bf16x2_t __attribute__((ext_vector_type(2)));
#define LAS __attribute__((address_space(3)))
constexpr int VROW = 144, VBUF = 32 * VROW;
constexpr int VROWV = 192, VBUFV = 32 * VROWV;
constexpr float L2E = 1.4426950408889634f, LN2 = 0.6931471805599453f;
constexpr float SC2 = 0.125f * L2E;

__device__ __forceinline__ int crow(int r, int hi) { return (r & 3) + 8 * (r >> 2) + 4 * hi; }
__device__ __forceinline__ unsigned cvtpk(float lo, float hi) { f32x2_t v = {lo, hi}; bf16x2_t b = __builtin_convertvector(v, bf16x2_t); return __builtin_bit_cast(unsigned, b); }
__device__ __forceinline__ float xhalf(float v, int hi) {
    auto r = __builtin_amdgcn_permlane32_swap(__float_as_uint(v), __float_as_uint(v), false, false);
    return __uint_as_float(hi ? r[0] : r[1]);
}
__device__ __forceinline__ s16x4 vtr(const LAS unsigned char* p) { return __builtin_bit_cast(s16x4, __builtin_amdgcn_ds_read_tr16_b64_v4i16((LAS v4i16_t*)p)); }

struct KVRegs { u32x4 k[4]; u32x4 v[4]; };
__device__ __forceinline__ void load_kv(KVRegs& R, const bf16* base, int kp0, int kst, int kcol, int vcol, int lane) {
#pragma unroll
    for (int j = 0; j < 4; ++j) {
        const int pos = kp0 + kst * (8 * j + (lane >> 3));
        const int pc = pos < SQ - 1 ? pos : SQ - 1;
        const bf16* rp = base + (size_t)pc * QKV_LD + (lane & 7) * 8;
        R.k[j] = *(const u32x4*)(rp + kcol); R.v[j] = *(const u32x4*)(rp + vcol);
    }
}
__device__ __forceinline__ void kv_stage(const KVRegs& R, LAS unsigned char* klds, LAS unsigned char* vlds, int lane) {
#pragma unroll
    for (int j = 0; j < 4; ++j) { const int r_ = 8 * j + (lane >> 3), c_ = (lane & 7) * 16; *(LAS u32x4*)(klds + r_ * VROW + c_) = R.k[j]; *(LAS u32x4*)(vlds + r_ * VROWV + c_) = R.v[j]; }
}
__device__ __forceinline__ f32x16 qk_tile(const LAS unsigned char* klds, const bf16x8 (&qf)[4], int r32, int hi) {
    f32x16 s = {0.f, 0.f, 0.f, 0.f, 0.f, 0.f, 0.f, 0.f, 0.f, 0.f, 0.f, 0.f, 0.f, 0.f, 0.f, 0.f};
#pragma unroll
    for (int k = 0; k < 4; ++k) { const bf16x8 kf = *(const LAS bf16x8*)(klds + r32 * VROW + (2 * k + hi) * 16); s = __builtin_amdgcn_mfma_f32_32x32x16_bf16(kf, qf[k], s, 0, 0, 0); }
    return s;
}
__device__ __forceinline__ void pv_tile(f32x16 (&o)[2], const f32x16& p, const LAS unsigned char* vlds, int lane) {
    const int g = lane >> 4, i = lane & 15, h = lane >> 5;
    const LAS unsigned char* vb = vlds + (4 * h + (i >> 2)) * VROWV + (16 * (g & 1) + 4 * (i & 3)) * 2;
#pragma unroll
    for (int s = 0; s < 2; ++s) {
        u32x4 pw; pw.x = cvtpk(p[8 * s], p[8 * s + 1]); pw.y = cvtpk(p[8 * s + 2], p[8 * s + 3]); pw.z = cvtpk(p[8 * s + 4], p[8 * s + 5]); pw.w = cvtpk(p[8 * s + 6], p[8 * s + 7]);
        const bf16x8 pb = __builtin_bit_cast(bf16x8, pw);
#pragma unroll
        for (int df = 0; df < 2; ++df) {
            const s16x4 lo = vtr(vb + (16 * s) * VROWV + df * 64), hh = vtr(vb + (16 * s + 8) * VROWV + df * 64);
            const bf16x8 va = (bf16x8){lo[0], lo[1], lo[2], lo[3], hh[0], hh[1], hh[2], hh[3]};
            o[df] = __builtin_amdgcn_mfma_f32_32x32x16_bf16(va, pb, o[df], 0, 0, 0);
        }
    }
}
__device__ __forceinline__ void load_q(bf16x8 (&qf)[4], const bf16* base, int qpos, int qcol, int hi) {
    const bf16* rp = base + (size_t)qpos * QKV_LD + qcol + 8 * hi;
#pragma unroll
    for (int k = 0; k < 4; ++k) qf[k] = *(const bf16x8*)(rp + 16 * k);
}
__device__ __forceinline__ void store_o(bf16* yrow, const f32x16 (&o)[2], float inv, int hi) {
#pragma unroll
    for (int df = 0; df < 2; ++df)
#pragma unroll
        for (int g = 0; g < 4; ++g) {
            u32x2 w; w.x = cvtpk(o[df][4 * g] * inv, o[df][4 * g + 1] * inv); w.y = cvtpk(o[df][4 * g + 2] * inv, o[df][4 * g + 3] * inv);
            *(u32x2*)(yrow + 32 * df + 8 * g + 4 * hi) = w;
        }
}
__device__ __forceinline__ void osm_tile(f32x16& s, float& m, float& l, f32x16 (&o)[2]) {
    float mx = s[0];
#pragma unroll
    for (int r = 1; r < 16; ++r) mx = fmaxf(mx, s[r]);
    { auto rr = __builtin_amdgcn_permlane32_swap(__float_as_uint(mx), __float_as_uint(mx), false, false); mx = fmaxf(__uint_as_float(rr[0]), __uint_as_float(rr[1])); }
    const float mn = fmaxf(m, mx);
    const float ms = (mn == -INFINITY) ? 0.f : mn;
    const float alpha = __builtin_amdgcn_exp2f((m - ms) * SC2);
    const float mc = ms * SC2;
    float ps = 0.f;
#pragma unroll
    for (int r = 0; r < 16; ++r) { s[r] = __builtin_amdgcn_exp2f(s[r] * SC2 - mc); ps += s[r]; }
    l = l * alpha + ps; m = mn;
    if (!__all(alpha == 1.0f)) {
#pragma unroll
        for (int df = 0; df < 2; ++df)
#pragma unroll
            for (int r = 0; r < 16; ++r) o[df][r] *= alpha;
    }
}
__device__ __forceinline__ void osm_tile2(f32x16& s0, f32x16& s1, float& m, float& l, f32x16 (&o)[2]) {
    float mx = fmaxf(s0[0], s1[0]);
#pragma unroll
    for (int r = 1; r < 16; ++r) mx = fmaxf(mx, fmaxf(s0[r], s1[r]));
    { auto rr = __builtin_amdgcn_permlane32_swap(__float_as_uint(mx), __float_as_uint(mx), false, false); mx = fmaxf(__uint_as_float(rr[0]), __uint_as_float(rr[1])); }
    const float mn = fmaxf(m, mx);
    const float ms = (mn == -INFINITY) ? 0.f : mn;
    const float alpha = __builtin_amdgcn_exp2f((m - ms) * SC2);
    const float mc = ms * SC2;
    float ps0 = 0.f, ps1 = 0.f;
#pragma unroll
    for (int r = 0; r < 16; ++r) { s0[r] = __builtin_amdgcn_exp2f(s0[r] * SC2 - mc); ps0 += s0[r]; s1[r] = __builtin_amdgcn_exp2f(s1[r] * SC2 - mc); ps1 += s1[r]; }
    l = l * alpha + (ps0 + ps1); m = mn;
    if (!__all(alpha == 1.0f)) {
#pragma unroll
        for (int df = 0; df < 2; ++df)
#pragma unroll
            for (int r = 0; r < 16; ++r) o[df][r] *= alpha;
    }
}
#define ZERO16 {0.f, 0.f, 0.f, 0.f, 0.f, 0.f, 0.f, 0.f, 0.f, 0.f, 0.f, 0.f, 0.f, 0.f, 0.f, 0.f}

struct AttnCtx {
    const bf16* base; int kcol, vcol, r32, hi, lane; LAS unsigned char* vlds; LAS unsigned char* klds; bf16x8 qf[4]; f32x16 o[2];
};
#define ATTN_STEP(SC, SL, T) { \
        if (SYNC) __builtin_amdgcn_s_barrier(); \
        { int kp_, ks_; const int tl_ = (T) + 2 < nt ? (T) + 2 : nt - 1; mx.pos(tl_, kp_, ks_); load_kv(SL, c.base, kp_, ks_, c.kcol, c.vcol, c.lane); } \
        kv_stage(SC, c.klds, c.vlds, c.lane); f32x16 s_ = qk_tile(c.klds, c.qf, c.r32, c.hi); \
        const bool stop_ = mx.process((T), s_, c); pv_tile(c.o, s_, c.vlds, c.lane); \
        if ((!SYNC && stop_) || (T) + 1 >= nt) break; }
template <class M, bool SYNC> __device__ __forceinline__ void attn_run(M& mx, AttnCtx& c) {
    const int nt = mx.nt;
    KVRegs S0, S1, S2;
    { int kp, ks; mx.pos(0, kp, ks); load_kv(S0, c.base, kp, ks, c.kcol, c.vcol, c.lane);
      mx.pos(1 < nt ? 1 : nt - 1, kp, ks); load_kv(S1, c.base, kp, ks, c.kcol, c.vcol, c.lane); }
    for (int t = 0;; t += 3) {
        ATTN_STEP(S0, S2, t)
        ATTN_STEP(S1, S0, t + 1)
        ATTN_STEP(S2, S1, t + 2)
    }
}
#define SH_BAR() asm volatile("s_waitcnt lgkmcnt(0)\n\ts_barrier" ::: "memory")
constexpr int SLOT_K = 64 * VROW, SLOT_BYTES = 64 * VROW + 64 * VROWV;
struct ShRegs { u32x4 a, b; };
__device__ __forceinline__ void sh_load(ShRegs& R, const bf16* base, int kp0, int kcol, int vcol, int w, int lane) {
    const int pos = kp0 + 4 * w + ((lane & 31) >> 3);
    const int pa = pos < SQ - 1 ? pos : SQ - 1, pb = pos + 32 < SQ - 1 ? pos + 32 : SQ - 1;
    const int col = ((lane >> 5) ? vcol : kcol) + (lane & 7) * 8;
    R.a = *(const u32x4*)(base + (size_t)pa * QKV_LD + col); R.b = *(const u32x4*)(base + (size_t)pb * QKV_LD + col);
}
__device__ __forceinline__ void sh_write(LAS unsigned char* slot, const ShRegs& R, int w, int lane) {
    const int row = 4 * w + ((lane & 31) >> 3);
    LAS unsigned char* p = slot + ((lane >> 5) ? SLOT_K + row * VROWV : row * VROW) + (lane & 7) * 16;
    *(LAS u32x4*)p = R.a; *(LAS u32x4*)(p + 32 * ((lane >> 5) ? VROWV : VROW)) = R.b;
}
#define SH_STEP(RW, RL, T) { \
        SH_BAR(); \
        { const int tl_ = (T) + 2 < nt ? (T) + 2 : nt - 1; sh_load(RL, c.base, mx.pos2(tl_), c.kcol, c.vcol, w, c.lane); } \
        sh_write(slots + (((T) + 1) & 1) * SLOT_BYTES, RW, w, c.lane); \
        if (mx.active2((T), w)) { LAS unsigned char* sl_ = slots + ((T) & 1) * SLOT_BYTES; \
            f32x16 s0_ = qk_tile(sl_, c.qf, c.r32, c.hi), s1_ = qk_tile(sl_ + 32 * VROW, c.qf, c.r32, c.hi); mx.process2((T), s0_, s1_, c); \
            pv_tile(c.o, s0_, sl_ + SLOT_K, c.lane); pv_tile(c.o, s1_, sl_ + SLOT_K + 32 * VROWV, c.lane); } \
        if ((T) + 1 >= nt) break; }
template <class M> __device__ __forceinline__ void attn_run_shared(M& mx, AttnCtx& c, LAS unsigned char* slots, int w) {
    const int nt = mx.nt2;
    ShRegs R0, R1, R2;
    sh_load(R0, c.base, mx.pos2(0), c.kcol, c.vcol, w, c.lane);
    sh_load(R1, c.base, mx.pos2(1 < nt ? 1 : nt - 1), c.kcol, c.vcol, w, c.lane);
    SH_BAR();
    sh_write(slots, R0, w, c.lane);
    for (int t = 0;; t += 3) {
        SH_STEP(R1, R2, t)
        SH_STEP(R2, R0, t + 1)
        SH_STEP(R0, R1, t + 2)
    }
}
struct MixA {
    int nt, k00, qpos; float m, l;
    __device__ __forceinline__ void pos(int idx, int& kp0, int& kst) const { kp0 = k00 + 32 * idx; kst = 1; }
    __device__ __forceinline__ bool process(int idx, f32x16& s, AttnCtx& c) {
        const int k0 = k00 + 32 * idx;
#pragma unroll
        for (int r = 0; r < 16; ++r) { const int dist = qpos - (k0 + crow(r, c.hi)); if (dist < 0 || dist > 127) s[r] = -INFINITY; }
        osm_tile(s, m, l, c.o); return false;
    }
};
__device__ void attn_A(const bf16* base, int hq, int q0, float sink, bf16* ybase, LAS unsigned char* vlds, int lane) {
    AttnCtx c; c.base = base; c.r32 = lane & 31; c.hi = lane >> 5; c.lane = lane; c.vlds = vlds; c.klds = vlds + VBUFV; c.kcol = 512 + (hq >> 2) * 64; c.vcol = 640 + (hq >> 2) * 64;
    c.o[0] = (f32x16)ZERO16; c.o[1] = (f32x16)ZERO16;
    MixA mx; mx.qpos = q0 + c.r32; mx.k00 = q0 - 128 > 0 ? q0 - 128 : 0; mx.nt = 5; mx.m = -INFINITY; mx.l = 0.f;
    load_q(c.qf, base, mx.qpos, hq * 64, c.hi);
    attn_run<MixA, true>(mx, c);
    float l = mx.l + xhalf(mx.l, c.hi);
    l += __builtin_amdgcn_exp2f(sink * L2E - mx.m * SC2);
    store_o(ybase + (size_t)mx.qpos * DM + hq * 64, c.o, 1.0f / l, c.hi);
}
struct MixB {
    int nt, q0, qpos; float carry;
    __device__ __forceinline__ void pos(int idx, int& kp0, int& kst) const { kp0 = q0 - 32 * idx; kst = 1; }
    __device__ __forceinline__ bool process(int idx, f32x16& s, AttnCtx& c) {
        const int k0 = q0 - 32 * idx, hi = c.hi;
        float lk[16], G[4], Gp[4];
#pragma unroll
        for (int r = 0; r < 16; ++r) {
            const float z = s[r] * 0.125f;
            const bool valid = (k0 + crow(r, hi)) < qpos;
            const float sp = fmaxf(z, 0.f) + LN2 * __builtin_amdgcn_logf(1.0f + __builtin_amdgcn_exp2f(-fabsf(z) * L2E));
            lk[r] = valid ? -sp : 0.f;
            s[r] = valid ? (z - sp) : -INFINITY;
        }
#pragma unroll
        for (int g = 0; g < 4; ++g) { G[g] = (lk[4 * g] + lk[4 * g + 1]) + (lk[4 * g + 2] + lk[4 * g + 3]); Gp[g] = xhalf(G[g], hi); }
        float above = carry;
#pragma unroll
        for (int g = 3; g >= 0; --g) {
            float off = above + (hi == 0 ? Gp[g] : 0.f);
            s[4 * g + 3] = __builtin_amdgcn_exp2f((s[4 * g + 3] + off) * L2E); off += lk[4 * g + 3];
            s[4 * g + 2] = __builtin_amdgcn_exp2f((s[4 * g + 2] + off) * L2E); off += lk[4 * g + 2];
            s[4 * g + 1] = __builtin_amdgcn_exp2f((s[4 * g + 1] + off) * L2E); off += lk[4 * g + 1];
            s[4 * g + 0] = __builtin_amdgcn_exp2f((s[4 * g + 0] + off) * L2E);
            above += G[g] + Gp[g];
        }
        carry = above;
        return __all(carry < -40.0f) != 0;
    }
};
__device__ void attn_B(const bf16* base, int h, int q0, bf16* ybase, LAS unsigned char* vlds, int lane) {
    AttnCtx c; c.base = base; c.r32 = lane & 31; c.hi = lane >> 5; c.lane = lane; c.vlds = vlds; c.klds = vlds + VBUFV; c.kcol = 1280 + h * 64; c.vcol = 1792 + h * 64;
    c.o[0] = (f32x16)ZERO16; c.o[1] = (f32x16)ZERO16;
    MixB mx; mx.q0 = q0; mx.qpos = q0 + c.r32; mx.nt = q0 / 32 + 1; mx.carry = 0.f;
    load_q(c.qf, base, mx.qpos, 768 + h * 64, c.hi);
    attn_run<MixB, false>(mx, c);
    store_o(ybase + (size_t)mx.qpos * DM + 512 + h * 64, c.o, 1.0f, c.hi);
}
struct MixCp {
    int nt, n0, r0, j1lo, qpos; float m, l;
    __device__ __forceinline__ void pos(int t, int& kp0, int& kst) const {
        if (t < n0) { kp0 = r0 + 512 * t; kst = 16; } else { kp0 = (r0 & 3) + 4 * (j1lo + 32 * (t - n0)); kst = 4; }
    }
    __device__ __forceinline__ bool process(int t, f32x16& s, AttnCtx& c) {
        int kp0, kst; pos(t, kp0, kst);
        const int win = t < n0 ? 2048 : 512;
#pragma unroll
        for (int r = 0; r < 16; ++r) { const int dist = qpos - (kp0 + kst * crow(r, c.hi)); if (dist < 0 || dist > win) s[r] = -INFINITY; }
        osm_tile(s, m, l, c.o); return false;
    }
};
struct MixC1 {
    int nt2, p0, qpos; float m, l;
    __device__ __forceinline__ int pos2(int T) const { return p0 + 64 * T; }
    __device__ __forceinline__ bool active2(int T, int w) const { return true; }
    __device__ __forceinline__ void process2(int T, f32x16& s0, f32x16& s1, AttnCtx& c) {
        const int k0 = p0 + 64 * T;
#pragma unroll
        for (int r = 0; r < 16; ++r) { const int dist = qpos - (k0 + crow(r, c.hi)); if (dist < 0 || dist > 128) s0[r] = -INFINITY; if (dist < 32 || dist > 160) s1[r] = -INFINITY; }
        osm_tile2(s0, s1, m, l, c.o);
    }
};
__device__ void attn_C(const bf16* base, int h, int r0, int g, bf16* ybase, LAS unsigned char* vlds, LAS unsigned char* xlds, int w, int lane) {
    AttnCtx c; c.base = base; c.r32 = lane & 31; c.hi = lane >> 5; c.lane = lane; c.vlds = vlds; c.klds = vlds + VBUFV; c.kcol = 512 + h * 64; c.vcol = 1024 + h * 64;
    c.o[0] = (f32x16)ZERO16; c.o[1] = (f32x16)ZERO16;
    const int qpos = r0 + 16 * (32 * g + c.r32);
    load_q(c.qf, base, qpos, h * 64, c.hi);
    MixCp mp; mp.r0 = r0; mp.qpos = qpos; mp.m = -INFINITY; mp.l = 0.f;
    mp.n0 = g + 1;
    mp.j1lo = (r0 >> 2) + 128 * g - 128 > 0 ? (r0 >> 2) + 128 * g - 128 : 0;
    mp.nt = mp.n0 + ((r0 >> 2) + 128 * g + 124 - mp.j1lo) / 32 + 1;
    attn_run<MixCp, true>(mp, c);
    MixC1 m1; m1.qpos = qpos; m1.m = mp.m; m1.l = mp.l;
    const int ra = r0 & 8;
    m1.p0 = 512 * g + ra - 128 > 0 ? 512 * g + ra - 128 : 0;
    m1.nt2 = ((512 * g + ra + 7 + 496 - m1.p0) / 32 + 2) / 2;
    attn_run_shared<MixC1>(m1, c, xlds + 64, w);
    const float l = m1.l + xhalf(m1.l, c.hi);
    store_o(ybase + (size_t)qpos * DM + h * 64, c.o, 1.0f / l, c.hi);
}
struct MixD {
    int nt, nt2, npast, own, q0, qpos; unsigned U, sel; float m, l;
    __device__ __forceinline__ int blk_of(int j) const {
        unsigned u = U; int b = 0;
#pragma unroll
        for (int i = 0; i < 7; ++i) { if (i < j) u &= u - 1u; }
        b = __builtin_ctz(u | 0x100u); return b;
    }
    __device__ __forceinline__ void pos(int t, int& kp0, int& kst) const {
        kst = 1;
        if (t < 8 * npast) kp0 = blk_of(t >> 3) * 256 + (t & 7) * 32; else kp0 = own * 256 + (t - 8 * npast) * 32;
    }
    __device__ __forceinline__ int pos2(int T) const { int kp, ks; pos(2 * T, kp, ks); return kp; }
    __device__ __forceinline__ bool active2(int T, int w) const { return T < 4 * npast || 2 * (T - 4 * npast) <= w; }
    __device__ __forceinline__ void process2(int T, f32x16& s0, f32x16& s1, AttnCtx& c) {
        if (T < 4 * npast) {
            const int blk = blk_of(T >> 2);
            if (!((sel >> blk) & 1u)) {
#pragma unroll
                for (int r = 0; r < 16; ++r) { s0[r] = -INFINITY; s1[r] = -INFINITY; }
            }
        } else {
            const int k0 = own * 256 + (T - 4 * npast) * 64;
#pragma unroll
            for (int r = 0; r < 16; ++r) { const int kk = k0 + crow(r, c.hi); if (kk > qpos) s0[r] = -INFINITY; if (kk + 32 > qpos) s1[r] = -INFINITY; }
        }
        osm_tile2(s0, s1, m, l, c.o);
    }
};
__device__ void attn_D(const bf16* base, const float* kmean  , int h, int q0, bf16* ybase, LAS unsigned char* vlds, LAS unsigned char* xlds, int lane) {
    AttnCtx c; c.base = base; c.r32 = lane & 31; c.hi = lane >> 5; c.lane = lane; c.vlds = vlds; c.klds = vlds + VBUFV; c.kcol = 2048 + h * 64; c.vcol = 2560 + h * 64;
    c.o[0] = (f32x16)ZERO16; c.o[1] = (f32x16)ZERO16;
    const int r32 = c.r32, hi = c.hi, own = q0 >> 8;
    MixD mx; mx.own = own; mx.q0 = q0; mx.qpos = q0 + r32; mx.m = -INFINITY; mx.l = 0.f;
    load_q(c.qf, base, mx.qpos, 1536 + h * 64, hi);
    unsigned sel = 0u;
    if (own > 0) {
        bf16x8 kf[4];
#pragma unroll
        for (int k = 0; k < 4; ++k) {
            u32x4 w = {0u, 0u, 0u, 0u};
            if (r32 < 8) { const float* kp = kmean + r32 * 64 + 16 * k + 8 * hi; const f32x4 a = *(const f32x4*)kp, b = *(const f32x4*)(kp + 4);
                w.x = cvtpk(a[0], a[1]); w.y = cvtpk(a[2], a[3]); w.z = cvtpk(b[0], b[1]); w.w = cvtpk(b[2], b[3]); }
            kf[k] = __builtin_bit_cast(bf16x8, w);
        }
        f32x16 gs = ZERO16;
#pragma unroll
        for (int k = 0; k < 4; ++k) gs = __builtin_amdgcn_mfma_f32_32x32x16_bf16(kf[k], c.qf[k], gs, 0, 0, 0);
        float gt[8];
#pragma unroll
        for (int r = 0; r < 4; ++r) { const float mine = gs[r], oth = xhalf(mine, hi); gt[r] = hi == 0 ? mine : oth; gt[4 + r] = hi == 0 ? oth : mine; }
        const int nsel = own < 3 ? own : 3;
        for (int rr = 0; rr < nsel; ++rr) {
            float best = -INFINITY; int bi = -1;
#pragma unroll
            for (int n = 0; n < 8; ++n) { const bool ok = n < own && !((sel >> n) & 1u) && (bi < 0 || gt[n] > best); if (ok) { best = gt[n]; bi = n; } }
            if (bi >= 0) sel |= 1u << bi;
        }
    }
    unsigned U = 0u;
#pragma unroll
    for (int n = 0; n < 8; ++n) if (__ballot((sel >> n) & 1u) != 0ull) U |= 1u << n;
    {
        volatile LAS unsigned* ux = (volatile LAS unsigned*)xlds;
        __builtin_amdgcn_s_barrier();
        if (lane == 0) ux[(q0 >> 5) & 7] = U;
        asm volatile("s_waitcnt lgkmcnt(0)" ::: "memory");
        __builtin_amdgcn_s_barrier();
        U = ux[0] | ux[1] | ux[2] | ux[3] | ux[4] | ux[5] | ux[6] | ux[7];
        U = __builtin_amdgcn_readfirstlane(U);
    }
    mx.U = U; mx.sel = sel; mx.npast = __builtin_popcount(U); mx.nt = 8 * mx.npast + 8; mx.nt2 = 4 * mx.npast + 4;
    attn_run_shared<MixD>(mx, c, xlds + 64, (q0 >> 5) & 7);
    const float l = mx.l + xhalf(mx.l, c.hi);
    store_o(ybase + (size_t)mx.qpos * DM + 512 + h * 64, c.o, 1.0f / l, hi);
}

__device__ void ph_attn0(const bf16* qkv, const float* sinks, bf16* y, LAS unsigned char* lds, int bid, int nb) {
    const int lane = ltid() & 63, w = __builtin_amdgcn_readfirstlane(ltid() >> 6);
    LAS unsigned char* vlds = lds + w * (VBUF + VBUFV);
    for (int pid = bid; pid < NB * 8; pid += nb) {
        const int b = pid >> 3, h = pid & 7;
        const bf16* base = qkv + (size_t)b * SQ * QKV_LD; bf16* ybase = y + (size_t)b * SQ * DM;
        const float sink = sinks[h];
        for (int rd = 0; rd < 8; ++rd) attn_A(base, h, (rd * 8 + w) * 32, sink, ybase, vlds, lane);
        for (int rd = 0; rd < 8; ++rd) attn_B(base, h, (rd * 8 + w) * 32, ybase, vlds, lane);
    }
}
__device__ void ph_attn1(const bf16* qkv, const float* kmean, bf16* y, LAS unsigned char* lds, int bid, int nb) {
    const int lane = ltid() & 63, w = __builtin_amdgcn_readfirstlane(ltid() >> 6);
    LAS unsigned char* vlds = lds + w * (VBUF + VBUFV);
    for (int pid = bid; pid < NB * 8; pid += nb) {
        const int b = pid >> 3, h = pid & 7;
        const bf16* base = qkv + (size_t)b * SQ * QKV_LD; bf16* ybase = y + (size_t)b * SQ * DM;
        for (int rd = 0; rd < 8; ++rd) { const int it = rd * 8 + w; attn_C(base, h, it & 15, it >> 4, ybase, vlds, lds + 8 * (VBUF + VBUFV), w, lane); }
        for (int rd = 0; rd < 8; ++rd) attn_D(base, kmean + (size_t)pid * 8 * 64, h, (rd * 8 + w) * 32, ybase, vlds, lds + 8 * (VBUF + VBUFV), lane);
    }
}

#define CE_D(a, b) { const float hi_ = fmaxf((a), (b)), lo_ = fminf((a), (b)); (a) = hi_; (b) = lo_; }
#define BSTAGE(arr, k, j) _Pragma("unroll") for (int i_ = 0; i_ < 16; ++i_) { const int l_ = i_ ^ (j); if (l_ > i_) { if ((i_ & (k)) == 0) CE_D(arr[i_], arr[l_]) else CE_D(arr[l_], arr[i_]) } }
__device__ __forceinline__ void bsort16(float (&a)[16]) {
    CE_D(a[0], a[1]) CE_D(a[2], a[3]) CE_D(a[0], a[2]) CE_D(a[1], a[3]) CE_D(a[1], a[2]) CE_D(a[4], a[5]) CE_D(a[6], a[7]) CE_D(a[4], a[6]) CE_D(a[5], a[7]) CE_D(a[5], a[6]) CE_D(a[0], a[4]) CE_D(a[2], a[6]) CE_D(a[2], a[4]) CE_D(a[1], a[5]) CE_D(a[3], a[7]) CE_D(a[3], a[5]) CE_D(a[1], a[2]) CE_D(a[3], a[4]) CE_D(a[5], a[6]) CE_D(a[8], a[9]) CE_D(a[10], a[11]) CE_D(a[8], a[10]) CE_D(a[9], a[11]) CE_D(a[9], a[10]) CE_D(a[12], a[13]) CE_D(a[14], a[15]) CE_D(a[12], a[14]) CE_D(a[13], a[15]) CE_D(a[13], a[14]) CE_D(a[8], a[12]) CE_D(a[10], a[14]) CE_D(a[10], a[12]) CE_D(a[9], a[13]) CE_D(a[11], a[15]) CE_D(a[11], a[13]) CE_D(a[9], a[10]) CE_D(a[11], a[12]) CE_D(a[13], a[14]) CE_D(a[0], a[8]) CE_D(a[4], a[12]) CE_D(a[4], a[8]) CE_D(a[2], a[10]) CE_D(a[6], a[14]) CE_D(a[6], a[10]) CE_D(a[2], a[4]) CE_D(a[6], a[8]) CE_D(a[10], a[12]) CE_D(a[1], a[9]) CE_D(a[5], a[13]) CE_D(a[5], a[9]) CE_D(a[3], a[11]) CE_D(a[7], a[15]) CE_D(a[7], a[11]) CE_D(a[3], a[5]) CE_D(a[7], a[9]) CE_D(a[11], a[13]) CE_D(a[1], a[2]) CE_D(a[3], a[4]) CE_D(a[5], a[6]) CE_D(a[7], a[8]) CE_D(a[9], a[10]) CE_D(a[11], a[12]) CE_D(a[13], a[14])
}
__device__ __forceinline__ void bmerge16(float (&a)[16]) {
    BSTAGE(a, 16, 8) BSTAGE(a, 16, 4) BSTAGE(a, 16, 2) BSTAGE(a, 16, 1)
}
__device__ __forceinline__ void merge_top16(float (&a)[16], const float (&b)[16]) {
#pragma unroll
    for (int i = 0; i < 16; ++i) a[i] = fmaxf(a[i], b[15 - i]);
    bmerge16(a);
}
__device__ __forceinline__ void xmerge16(float (&a)[16]) {
    {
        float A[16], B[16];
#pragma unroll
        for (int i = 0; i < 16; ++i) { auto r = __builtin_amdgcn_permlane16_swap(__float_as_uint(a[i]), __float_as_uint(a[i]), false, false); A[i] = __uint_as_float(r[0]); B[i] = __uint_as_float(r[1]); }
#pragma unroll
        for (int i = 0; i < 16; ++i) a[i] = fmaxf(A[i], B[15 - i]);
        bmerge16(a);
    }
    {
        float A[16], B[16];
#pragma unroll
        for (int i = 0; i < 16; ++i) { auto r = __builtin_amdgcn_permlane32_swap(__float_as_uint(a[i]), __float_as_uint(a[i]), false, false); A[i] = __uint_as_float(r[0]); B[i] = __uint_as_float(r[1]); }
#pragma unroll
        for (int i = 0; i < 16; ++i) a[i] = fmaxf(A[i], B[15 - i]);
        bmerge16(a);
    }
}
__host__ __device__ constexpr int pair_i(int id) {
    int c = 0;
    for (int i = 0; i < 16; ++i) { const int nj = 16 / (i + 1); if (id < c + nj) return i; c += nj; }
    return 0;
}
__host__ __device__ constexpr int pair_j(int id) {
    int c = 0;
    for (int i = 0; i < 16; ++i) { const int nj = 16 / (i + 1); if (id < c + nj) return id - c; c += nj; }
    return 0;
}
constexpr int SK_ROW = 272;
constexpr int SEL_SK_BYTES = 2 * 128 * SK_ROW;
constexpr int SEL_TAB_OFF = SEL_SK_BYTES;
constexpr int SEL_IDX_OFF = SEL_SK_BYTES + 64;

template <int S> __device__ __forceinline__ float cand_slot(const float (&L1)[16], const float (&L2)[16], int g) {
    constexpr int p0 = S, p1 = 16 + S, p2 = 32 + S, p3 = 48 + S;
    const float c0 = L1[pair_i(p0)] + L2[pair_j(p0)], c1 = L1[pair_i(p1)] + L2[pair_j(p1)], c2 = L1[pair_i(p2)] + L2[pair_j(p2)];
    const float c3 = p3 < 50 ? L1[pair_i(p3 < 50 ? p3 : 0)] + L2[pair_j(p3 < 50 ? p3 : 0)] : -1.0e30f;
    const float c = g == 0 ? c0 : (g == 1 ? c1 : (g == 2 ? c2 : c3));
    return __uint_as_float((__float_as_uint(c) & 0xffffffc0u) | (unsigned)(16 * g + S));
}

__device__ void ph_peer_select(const bf16* qry, const float* subkeys  , int* eidx, float* egate  , const float* su, const float* sv, LAS unsigned char* lds, int bid, int nb) {
    const int tid = ltid(), lane = tid & 63, w = __builtin_amdgcn_readfirstlane(tid >> 6);
    const int tk = lane & 15, g = lane >> 4;
    __syncthreads();
    for (int e = tid; e < 2 * 128 * 128 / 2; e += NT) {
        const int row = e >> 6, c2 = (e & 63) * 2;
        const float a = subkeys[(size_t)row * 128 + c2], b = subkeys[(size_t)row * 128 + c2 + 1];
        *(LAS unsigned*)(lds + row * SK_ROW + c2 * 2) = pk2(a, b);
    }
    if (tid < 64) { int id = tid; int c = 0, pi = 0, pj = 0;
        for (int i = 0; i < 16; ++i) { const int nj = 16 / (i + 1); if (id >= c && id < c + nj) { pi = i; pj = id - c; } c += nj; }
        lds[SEL_TAB_OFF + tid] = (unsigned char)((pi << 4) | pj); }
    __syncthreads();
    LAS unsigned* widx = (LAS unsigned*)(lds + SEL_IDX_OFF + w * 512);
    const LAS unsigned char* widx8 = (const LAS unsigned char*)widx;
    const int nitems = (MT / 16) * 8;
    bf16x8 qc[2][4];
    { const int it = bid * 8 + w;
      if (it < nitems) { const bf16* qp = qry + (size_t)((it >> 3) * 16 + tk) * PQ + (it & 7) * 256 + 8 * g;
#pragma unroll
          for (int hf = 0; hf < 2; ++hf)
#pragma unroll
              for (int ks = 0; ks < 4; ++ks) qc[hf][ks] = *(const bf16x8*)(qp + hf * 128 + 32 * ks); } }
    for (int it = bid * 8 + w; it < nitems; it += nb * 8) {
        const int h = it & 7, t0 = (it >> 3) * 16;
        bf16x8 qn[2][4];
        { const int itn = it + nb * 8 < nitems ? it + nb * 8 : it;
          const bf16* qp = qry + (size_t)((itn >> 3) * 16 + tk) * PQ + (itn & 7) * 256 + 8 * g;
#pragma unroll
          for (int hf = 0; hf < 2; ++hf)
#pragma unroll
              for (int ks = 0; ks < 4; ++ks) qn[hf][ks] = *(const bf16x8*)(qp + hf * 128 + 32 * ks); }
        float L[2][16];
#pragma unroll
        for (int hf = 0; hf < 2; ++hf) {
            bf16x8 qf[4];
#pragma unroll
            for (int ks = 0; ks < 4; ++ks) qf[ks] = qc[hf][ks];
            float key[32];
#pragma unroll
            for (int tile = 0; tile < 8; ++tile) {
                f32x4 acc = {0.f, 0.f, 0.f, 0.f};
#pragma unroll
                for (int ks = 0; ks < 4; ++ks) {
                    const bf16x8 af = *(const LAS bf16x8*)(lds + (hf * 128 + tile * 16 + tk) * SK_ROW + (32 * ks + 8 * g) * 2);
                    acc = __builtin_amdgcn_mfma_f32_16x16x32_bf16(af, qf[ks], acc, 0, 0, 0);
                }
#pragma unroll
                for (int r = 0; r < 4; ++r) key[tile * 4 + r] = __uint_as_float((__float_as_uint(acc[r]) & 0xffffff80u) | (unsigned)(16 * tile + 4 * g + r));
            }
            float a[16], b[16];
#pragma unroll
            for (int i = 0; i < 16; ++i) { a[i] = key[i]; b[i] = key[16 + i]; }
            bsort16(a); bsort16(b);
            merge_top16(a, b);
            xmerge16(a);
#pragma unroll
            for (int i = 0; i < 16; ++i) L[hf][i] = a[i];
            unsigned pk = 0u;
#pragma unroll
            for (int s = 0; s < 4; ++s) {
                const float v = g == 0 ? a[s] : (g == 1 ? a[4 + s] : (g == 2 ? a[8 + s] : a[12 + s]));
                pk |= (__float_as_uint(v) & 127u) << (8 * s);
            }
            widx[tk * 8 + hf * 4 + g] = pk;
        }
        float c[16];
        c[0] = cand_slot<0>(L[0], L[1], g); c[1] = cand_slot<1>(L[0], L[1], g); c[2] = cand_slot<2>(L[0], L[1], g); c[3] = cand_slot<3>(L[0], L[1], g);
        c[4] = cand_slot<4>(L[0], L[1], g); c[5] = cand_slot<5>(L[0], L[1], g); c[6] = cand_slot<6>(L[0], L[1], g); c[7] = cand_slot<7>(L[0], L[1], g);
        c[8] = cand_slot<8>(L[0], L[1], g); c[9] = cand_slot<9>(L[0], L[1], g); c[10] = cand_slot<10>(L[0], L[1], g); c[11] = cand_slot<11>(L[0], L[1], g);
        c[12] = cand_slot<12>(L[0], L[1], g); c[13] = cand_slot<13>(L[0], L[1], g); c[14] = cand_slot<14>(L[0], L[1], g); c[15] = cand_slot<15>(L[0], L[1], g);
        bsort16(c);
        xmerge16(c);
        float sum = 0.f, ex[16];
#pragma unroll
        for (int i = 0; i < 16; ++i) { ex[i] = __builtin_amdgcn_exp2f((c[i] - c[0]) * L2E); sum += ex[i]; }
        const float inv = 1.0f / sum;
        int oi[4]; float og[4];
#pragma unroll
        for (int s = 0; s < 4; ++s) {
            const float kv = g == 0 ? c[s] : (g == 1 ? c[4 + s] : (g == 2 ? c[8 + s] : c[12 + s]));
            const float ev = g == 0 ? ex[s] : (g == 1 ? ex[4 + s] : (g == 2 ? ex[8 + s] : ex[12 + s]));
            const unsigned pid = __float_as_uint(kv) & 63u;
            const unsigned ij = lds[SEL_TAB_OFF + pid];
            const unsigned i1 = widx8[tk * 32 + (ij >> 4)], i2 = widx8[tk * 32 + 16 + (ij & 15u)];
            oi[s] = (int)(i1 * 128u + i2); og[s] = ev * inv;
        }
        const size_t ob = (size_t)(t0 + tk) * 128 + h * 16 + 4 * g;
        *(u32x4*)(eidx + ob) = (u32x4){(unsigned)oi[0], (unsigned)oi[1], (unsigned)oi[2], (unsigned)oi[3]};
        *(f32x4*)(egate + ob) = (f32x4){og[0] * sv[oi[0]], og[1] * sv[oi[1]], og[2] * sv[oi[2]], og[3] * sv[oi[3]]};
        *(f32x4*)(egate + 8 * 1024 * 1024 + ob) = (f32x4){su[oi[0]], su[oi[1]], su[oi[2]], su[oi[3]]};
#pragma unroll
        for (int hf = 0; hf < 2; ++hf)
#pragma unroll
            for (int ks = 0; ks < 4; ++ks) qc[hf][ks] = qn[hf][ks];
    }
    __syncthreads();
}

typedef float v32f_t __attribute__((ext_vector_type(32)));
typedef unsigned v6u_t __attribute__((ext_vector_type(6)));
typedef unsigned v16u_t __attribute__((ext_vector_type(16)));
typedef __bf16 v32bf_t __attribute__((ext_vector_type(32)));
typedef __bf16 v2bf_t __attribute__((ext_vector_type(2)));
typedef _Float16 v32h_t __attribute__((ext_vector_type(32)));
typedef unsigned u32x3 __attribute__((ext_vector_type(3)));
constexpr int TROW = 768;
__device__ void ph_tab_fp6(const float* src, unsigned char* dst, float* scale, int nrows, int bid, int nb) {
    const int lane = ltid() & 63, w = __builtin_amdgcn_readfirstlane(ltid() >> 6);
    for (int rp = bid * 8 + w; rp < nrows / 2; rp += nb * 8) {
        v32h_t hv; float sc[2];
#pragma unroll
        for (int rr = 0; rr < 2; ++rr) {
            const float* sp = src + (size_t)(2 * rp + rr) * DM + lane * 16;
            f32x4 v[4]; float am = 0.f;
#pragma unroll
            for (int i = 0; i < 4; ++i) { v[i] = *(const f32x4*)(sp + i * 4); am = fmaxf(am, fmaxf(fmaxf(fabsf(v[i][0]), fabsf(v[i][1])), fmaxf(fabsf(v[i][2]), fabsf(v[i][3])))); }
            am = wave_max(am);
            const float s = am > 0.f ? am * (1.0f / 7.5f) : 1.0f, inv = 1.0f / s;
            sc[rr] = s;
#pragma unroll
            for (int i = 0; i < 4; ++i)
#pragma unroll
                for (int e = 0; e < 4; ++e) hv[rr * 16 + i * 4 + e] = (_Float16)fminf(fmaxf(v[i][e] * inv, -7.5f), 7.5f);
        }
        const v6u_t pk = __builtin_amdgcn_cvt_scalef32_pk32_fp6_f16(hv, 1.0f);
        unsigned* d0 = (unsigned*)(dst + (size_t)(2 * rp) * TROW + lane * 12);
        unsigned* d1 = (unsigned*)(dst + (size_t)(2 * rp + 1) * TROW + lane * 12);
        d0[0] = pk[0]; d0[1] = pk[1]; d0[2] = pk[2]; d1[0] = pk[3]; d1[1] = pk[4]; d1[2] = pk[5];
        if (lane == 0) { scale[2 * rp] = sc[0]; scale[2 * rp + 1] = sc[1]; }
    }
}

constexpr int TROW4 = 512;
constexpr int TROWX = 1024;
__device__ void ph_tab_fp4(const float* src, unsigned char* dst  , float* scale, int nrows, int bid, int nb) {
    const int lane = ltid() & 63, w = __builtin_amdgcn_readfirstlane(ltid() >> 6);
    for (int row = bid * 8 + w; row < nrows; row += nb * 8) {
        const float* sp = src + (size_t)row * DM + lane * 16;
        f32x4 v[4]; float am = 0.f;
#pragma unroll
        for (int i = 0; i < 4; ++i) { v[i] = *(const f32x4*)(sp + i * 4); am = fmaxf(am, fmaxf(fmaxf(fabsf(v[i][0]), fabsf(v[i][1])), fmaxf(fabsf(v[i][2]), fabsf(v[i][3])))); }
        am = wave_max(am);
        const float s = am > 0.f ? am * (1.0f / 6.0f) : 1.0f, inv = 1.0f / s;
        unsigned d0 = 0u, d1 = 0u;
        d0 = __builtin_amdgcn_cvt_scalef32_pk_fp4_f32(d0, v[0][0] * inv, v[0][1] * inv, 1.0f, 0); d0 = __builtin_amdgcn_cvt_scalef32_pk_fp4_f32(d0, v[0][2] * inv, v[0][3] * inv, 1.0f, 1);
        d0 = __builtin_amdgcn_cvt_scalef32_pk_fp4_f32(d0, v[1][0] * inv, v[1][1] * inv, 1.0f, 2); d0 = __builtin_amdgcn_cvt_scalef32_pk_fp4_f32(d0, v[1][2] * inv, v[1][3] * inv, 1.0f, 3);
        d1 = __builtin_amdgcn_cvt_scalef32_pk_fp4_f32(d1, v[2][0] * inv, v[2][1] * inv, 1.0f, 0); d1 = __builtin_amdgcn_cvt_scalef32_pk_fp4_f32(d1, v[2][2] * inv, v[2][3] * inv, 1.0f, 1);
        d1 = __builtin_amdgcn_cvt_scalef32_pk_fp4_f32(d1, v[3][0] * inv, v[3][1] * inv, 1.0f, 2); d1 = __builtin_amdgcn_cvt_scalef32_pk_fp4_f32(d1, v[3][2] * inv, v[3][3] * inv, 1.0f, 3);
        *(u32x2*)(dst + (size_t)row * TROWX + lane * 16) = (u32x2){d0, d1};
        if (lane == 0) scale[row] = s;
    }
}

__device__ void ph_tab_i4(const float* src, unsigned char* dst, float* scale, int nrows, int bid, int nb) {
    const int lane = ltid() & 63, w = __builtin_amdgcn_readfirstlane(ltid() >> 6);
    for (int row = bid * 8 + w; row < nrows; row += nb * 8) {
        const float* sp = src + (size_t)row * DM + lane * 16;
        f32x4 v[4]; float am = 0.f;
#pragma unroll
        for (int i = 0; i < 4; ++i) { v[i] = *(const f32x4*)(sp + i * 4); am = fmaxf(am, fmaxf(fmaxf(fabsf(v[i][0]), fabsf(v[i][1])), fmaxf(fabsf(v[i][2]), fabsf(v[i][3])))); }
        am = wave_max(am);
        const float s = am > 0.f ? am * (1.0f / 7.0f) : 1.0f, inv = 1.0f / s;
        unsigned d[2] = {0u, 0u};
#pragma unroll
        for (int i = 0; i < 16; ++i) { const int q = (int)rintf(fminf(fmaxf(v[i >> 2][i & 3] * inv, -7.0f), 7.0f)); d[i >> 3] |= ((unsigned)q & 15u) << (4 * (i & 7)); }
        *(u32x2*)(dst + (size_t)row * TROWX + lane * 16) = (u32x2){d[0], d[1]};
        if (lane == 0) scale[row] = s;
    }
}

__device__ void ph_tab_uv(const float* srcu, const float* srcv, unsigned char* dst, float* scu, float* scv, int nrows, int bid, int nb) {
    const int lane = ltid() & 63, w = __builtin_amdgcn_readfirstlane(ltid() >> 6);
    for (int row0 = (bid * 8 + w) * 2; row0 < nrows; row0 += nb * 8 * 2) {
        f32x4 vu[2][4], vv[2][4];
#pragma unroll
        for (int r = 0; r < 2; ++r)
#pragma unroll
            for (int i = 0; i < 4; ++i) { vu[r][i] = *(const f32x4*)(srcu + (size_t)(row0 + r) * DM + lane * 16 + i * 4); vv[r][i] = *(const f32x4*)(srcv + (size_t)(row0 + r) * DM + lane * 16 + i * 4); }
#pragma unroll
        for (int r = 0; r < 2; ++r) {
            float au = 0.f, av = 0.f;
#pragma unroll
            for (int i = 0; i < 4; ++i)
#pragma unroll
                for (int e = 0; e < 4; ++e) { au = fmaxf(au, fabsf(vu[r][i][e])); av = fmaxf(av, fabsf(vv[r][i][e])); }
            au = wave_max(au); av = wave_max(av);
            const float su_ = au > 0.f ? au * (1.0f / 7.0f) : 1.0f, iu = 1.0f / su_, sv_ = av > 0.f ? av * (1.0f / 6.0f) : 1.0f, iv = 1.0f / sv_;
            unsigned d[2] = {0u, 0u};
#pragma unroll
            for (int i = 0; i < 16; ++i) { const int q = (int)rintf(fminf(fmaxf(vu[r][i >> 2][i & 3] * iu, -7.0f), 7.0f)); d[i >> 3] |= ((unsigned)q & 15u) << (4 * (i & 7)); }
            unsigned d0 = 0u, d1 = 0u;
            d0 = __builtin_amdgcn_cvt_scalef32_pk_fp4_f32(d0, vv[r][0][0] * iv, vv[r][0][1] * iv, 1.0f, 0); d0 = __builtin_amdgcn_cvt_scalef32_pk_fp4_f32(d0, vv[r][0][2] * iv, vv[r][0][3] * iv, 1.0f, 1);
            d0 = __builtin_amdgcn_cvt_scalef32_pk_fp4_f32(d0, vv[r][1][0] * iv, vv[r][1][1] * iv, 1.0f, 2); d0 = __builtin_amdgcn_cvt_scalef32_pk_fp4_f32(d0, vv[r][1][2] * iv, vv[r][1][3] * iv, 1.0f, 3);
            d1 = __builtin_amdgcn_cvt_scalef32_pk_fp4_f32(d1, vv[r][2][0] * iv, vv[r][2][1] * iv, 1.0f, 0); d1 = __builtin_amdgcn_cvt_scalef32_pk_fp4_f32(d1, vv[r][2][2] * iv, vv[r][2][3] * iv, 1.0f, 1);
            d1 = __builtin_amdgcn_cvt_scalef32_pk_fp4_f32(d1, vv[r][3][0] * iv, vv[r][3][1] * iv, 1.0f, 2); d1 = __builtin_amdgcn_cvt_scalef32_pk_fp4_f32(d1, vv[r][3][2] * iv, vv[r][3][3] * iv, 1.0f, 3);
            *(u32x4*)(dst + (size_t)(row0 + r) * TROWX + lane * 16) = (u32x4){d[0], d[1], d0, d1};
            if (lane == 0) { scu[row0 + r] = su_; scv[row0 + r] = sv_; }
        }
    }
}

#define DPP_ADD(v, ctrl) ((v) + __builtin_bit_cast(float, __builtin_amdgcn_update_dpp(0, __builtin_bit_cast(int, (v)), (ctrl), 0xf, 0xf, true)))
typedef int i32x4_t __attribute__((ext_vector_type(4)));
constexpr int GT = 2;
typedef int v8i_t __attribute__((ext_vector_type(8)));
typedef int v2i_t __attribute__((ext_vector_type(2)));
struct GSet { u32x2 uq[4]; u32x2 vq[4]; };
__device__ __forceinline__ void gather_issue(GSet& S, int bt, int lane, const unsigned char* pu, const unsigned char* pv, const LAS int* etok) {
    const i32x4_t ev = *(const LAS i32x4_t*)(etok + bt * 4);
    const int es[4] = {ev.x, ev.y, ev.z, ev.w};
#pragma unroll
    for (int k = 0; k < 2; ++k) {
        const unsigned f0 = (unsigned)es[2 * k] * (unsigned)TROWX + (unsigned)lane * 16u, f1 = (unsigned)es[2 * k + 1] * (unsigned)TROWX + (unsigned)lane * 16u;
        const u32x4 r0 = *(const u32x4*)(pu + f0), r1 = *(const u32x4*)(pu + f1);
        S.uq[2 * k] = (u32x2){r0.x, r0.y}; S.vq[2 * k] = (u32x2){r0.z, r0.w}; S.uq[2 * k + 1] = (u32x2){r1.x, r1.y}; S.vq[2 * k + 1] = (u32x2){r1.z, r1.w};
    }
}
constexpr int GV_ROW = 520;
constexpr int GV_BYTES = 16 * GV_ROW, GC_BYTES = 96;
__device__ __forceinline__ float gather_udot(const GSet& S, const unsigned (&hd)[4], LAS unsigned char* vrow) {
    int d[4];
#pragma unroll
    for (int k = 0; k < 4; ++k) {
        const int q0 = (int)S.uq[k].x, q1 = (int)S.uq[k].y;
        int a1, a2;
        asm("v_dot8_i32_i4 %0, %1, %2, 0" : "=v"(a1) : "v"(q0), "v"(hd[0]));
        asm("v_dot8_i32_i4 %0, %1, %2, 0" : "=v"(a2) : "v"(q0), "v"(hd[2]));
        a1 = __builtin_amdgcn_sdot8(q1, (int)hd[1], a1, false); a2 = __builtin_amdgcn_sdot8(q1, (int)hd[3], a2, false);
        d[k] = (a1 << 4) + a2;
    }
#pragma unroll
    for (int k = 0; k < 4; ++k) *(LAS u32x2*)(vrow + k * GV_ROW) = S.vq[k];
    int e2[2], f1;
#pragma unroll
    for (int k = 0; k < 2; ++k) { auto r = __builtin_amdgcn_permlane16_swap((unsigned)d[k], (unsigned)d[k + 2], false, false); e2[k] = (int)r[0] + (int)r[1]; }
    { auto r = __builtin_amdgcn_permlane32_swap((unsigned)e2[0], (unsigned)e2[1], false, false); f1 = (int)r[0] + (int)r[1]; }
    f1 += __builtin_amdgcn_update_dpp(0, f1, 0xB1, 0xf, 0xf, true); f1 += __builtin_amdgcn_update_dpp(0, f1, 0x4E, 0xf, 0xf, true);
    f1 += __builtin_amdgcn_update_dpp(0, f1, 0x124, 0xf, 0xf, true); f1 += __builtin_amdgcn_update_dpp(0, f1, 0x128, 0xf, 0xf, true);
    return (float)f1;
}
#define DPP_MAX(v, ctrl) fmaxf((v), __builtin_bit_cast(float, __builtin_amdgcn_update_dpp(0, __builtin_bit_cast(int, (v)), (ctrl), 0xf, 0xf, true)))
__device__ __forceinline__ void gather_vpart(float f0, float f1, float f2, float f3, int lane, int kslot, const LAS float* lg  ,
                                             const LAS unsigned char* vrd  , LAS unsigned char* cb, int aoff1, int aoff2, f32x4 (&acc)[8]) {
    const int q = (lane >> 2) & 3, e16 = 4 * q + kslot;
    const float fs = q == 0 ? f0 : q == 1 ? f1 : q == 2 ? f2 : f3;
    const float cv = lg[e16] * gelu_erf(fs * lg[GT * 128 + e16]);
    float mx = fabsf(cv);
    mx = DPP_MAX(mx, 0x124); mx = DPP_MAX(mx, 0x128);
    { auto r = __builtin_amdgcn_permlane16_swap(__float_as_uint(mx), __float_as_uint(mx), false, false); mx = fmaxf(__uint_as_float(r[0]), __uint_as_float(r[1])); }
    { auto r = __builtin_amdgcn_permlane32_swap(__float_as_uint(mx), __float_as_uint(mx), false, false); mx = fmaxf(__uint_as_float(r[0]), __uint_as_float(r[1])); }
    int E = (int)((__float_as_uint(mx) >> 23) & 0xffu); E = E < 8 ? 8 : E;
    const float x = cv * __uint_as_float((unsigned)(255 - E) << 23);
    const unsigned p1 = __builtin_amdgcn_cvt_scalef32_pk_fp4_f32(0u, x, 0.f, 1.0f, 0);
    const float r1 = x - __builtin_amdgcn_cvt_scalef32_pk_f32_fp4(p1, 1.0f, 0)[0];
    const unsigned p2 = __builtin_amdgcn_cvt_scalef32_pk_fp4_f32(0u, r1, 0.f, 1.0f, 0);
    const float y = (r1 - __builtin_amdgcn_cvt_scalef32_pk_f32_fp4(p2, 1.0f, 0)[0]) * 16.0f;
    const unsigned p3 = __builtin_amdgcn_cvt_scalef32_pk_fp4_f32(0u, y, 0.f, 1.0f, 0);
    const float r3 = y - __builtin_amdgcn_cvt_scalef32_pk_f32_fp4(p3, 1.0f, 0)[0];
    const unsigned p4 = __builtin_amdgcn_cvt_scalef32_pk_fp4_f32(0u, r3, 0.f, 1.0f, 0);
    const unsigned codes = (p1 & 15u) | ((p2 & 15u) << 8) | ((p3 & 15u) << 16) | ((p4 & 15u) << 24);
    { auto r = __builtin_amdgcn_permlane32_swap(codes, codes, false, false);
      const unsigned w = codes | ((r[0] ^ r[1] ^ codes) << 4);
      if (lane < 32 && (lane & 3) == 0) {
          LAS unsigned char* tb = cb + 8 + 2 * q + ((lane >> 4) & 1);
          tb[0] = (unsigned char)w; tb[16] = (unsigned char)(w >> 8); tb[32] = (unsigned char)(w >> 16); tb[48] = (unsigned char)(w >> 24);
      } }
    const u32x2 a10 = *(const LAS u32x2*)(cb + aoff1), a11 = *(const LAS u32x2*)(cb + aoff1 + 8), a20 = *(const LAS u32x2*)(cb + aoff2), a21 = *(const LAS u32x2*)(cb + aoff2 + 8);
    const v8i_t A1 = {(int)a10.x, (int)a10.y, (int)a11.x, (int)a11.y, 0, 0, 0, 0}, A2 = {(int)a20.x, (int)a20.y, (int)a21.x, (int)a21.y, 0, 0, 0, 0};
    const int sa1 = (E - 1) * 0x01010101, sa2 = (E - 5) * 0x01010101;
#pragma unroll
    for (int m = 0; m < 8; ++m) {
        const v2i_t t0 = __builtin_amdgcn_ds_read_tr4_b64_v2i32((LAS v2i_t*)(vrd + 16 * m)), t1 = __builtin_amdgcn_ds_read_tr4_b64_v2i32((LAS v2i_t*)(vrd + 16 * m + 8));
        const v8i_t B = {t0.x, t0.y, t1.x, t1.y, 0, 0, 0, 0};
        acc[m] = __builtin_amdgcn_mfma_scale_f32_16x16x128_f8f6f4(A1, B, acc[m], 4, 4, 0, sa1, 0, 0x7F7F7F7F);
        acc[m] = __builtin_amdgcn_mfma_scale_f32_16x16x128_f8f6f4(A2, B, acc[m], 4, 4, 0, sa2, 0, 0x7F7F7F7F);
    }
}
__device__ __forceinline__ void xcd_pace(unsigned* bar, volatile LAS unsigned* st);
constexpr int GNS = 8, GBPS = 32 / GNS, GSHIFT = 11;
constexpr int GATH_LDS_WAVE = GT * 128 * 12 + GV_BYTES + GC_BYTES;
#define GATH_SEG(J, NJ, nbt) { \
        const LAS int* le_ = lse + (J) * 128; const LAS int* ne_ = lse + (NJ) * 128; \
        gather_issue(D, GBPS * c + 3, lane, pu, pv, le_); \
        const float f0_ = hsc[J] * gather_udot(A, hd[J], vwr); \
        gather_issue(A, (nbt), lane, pu, pv, ne_); \
        const float f1_ = hsc[J] * gather_udot(B, hd[J], vwr + 4 * GV_ROW); \
        gather_issue(B, (nbt) + 1, lane, pu, pv, ne_); \
        const float f2_ = hsc[J] * gather_udot(C, hd[J], vwr + 8 * GV_ROW); \
        gather_issue(C, (nbt) + 2, lane, pu, pv, ne_); \
        const float f3_ = hsc[J] * gather_udot(D, hd[J], vwr + 12 * GV_ROW); \
        gather_vpart(f0_, f1_, f2_, f3_, lane, kslot, lsg + (J) * 128 + 16 * c, vrd, cb, aoff1, aoff2, acc[J]); }
__device__ void ph_peer_gather(const bf16* h2, const unsigned char* pu, const unsigned char* pv, const float* su, const float* sv,
                               const int* eidx, const float* egate, const bf16* xin  , const float* gate  , float* xout, LAS unsigned char* lds, unsigned* pace_bar, volatile LAS unsigned* pace_st, int bid, int nb,
                               bf16* xmid  ) {
    const int lane0 = ltid() & 63, w = __builtin_amdgcn_readfirstlane(ltid() >> 6);
    LAS int* lse = (LAS int*)(lds + w * GATH_LDS_WAVE); LAS float* lsg = (LAS float*)(lds + w * GATH_LDS_WAVE + GT * 128 * 4);
    LAS unsigned char* vb = lds + w * GATH_LDS_WAVE + GT * 128 * 12; LAS unsigned char* cb = vb + GV_BYTES;
    if (lane0 < GC_BYTES / 4) ((LAS unsigned*)cb)[lane0] = 0u;
    for (int t0 = (bid * 8 + w) * GT; t0 < MT; t0 += nb * 8 * GT) {
        int lane = lane0; asm volatile("" : "+v"(lane));
        const int row = lane >> 4;
        const int kslot = 2 * (row & 1) + (row >> 1);
        const int b = t0 >> 11;
        LAS unsigned char* vwr = vb + lane * 8;
        const LAS unsigned char* vrd = vb + (lane & 15) * GV_ROW + 128 * row;
        const int ai = lane & 15, au = (ai < 8 ? 1 : 3), nz = ((ai & 7) >> 1) == row;
        const int aoff1 = nz ? 8 * (au - (ai & 1)) : 64, aoff2 = nz ? 8 * (au + 4 - (ai & 1)) : 64;
        unsigned hd[GT][4]; float hsc[GT]; f32x4 acc[GT][8];
#pragma unroll
        for (int j = 0; j < GT; ++j) {
            const int t = t0 + j;
            const int e0 = eidx[(size_t)t * 128 + lane], e1 = eidx[(size_t)t * 128 + 64 + lane];
            const float g0 = egate[(size_t)t * 128 + lane], g1 = egate[(size_t)t * 128 + 64 + lane];
            const int k0 = e0 >> GSHIFT, k1 = e1 >> GSHIFT;
            int off = 0, d0 = 0, d1 = 0;
#pragma unroll
            for (int s = 0; s < GNS; ++s) {
                const unsigned long long m0 = __ballot(k0 == s), m1 = __ballot(k1 == s);
                const int r0 = (int)__builtin_amdgcn_mbcnt_hi((unsigned)(m0 >> 32), __builtin_amdgcn_mbcnt_lo((unsigned)m0, 0u));
                const int r1 = (int)__builtin_amdgcn_mbcnt_hi((unsigned)(m1 >> 32), __builtin_amdgcn_mbcnt_lo((unsigned)m1, 0u));
                const int c0 = __builtin_popcountll(m0);
                if (k0 == s) d0 = off + r0;
                if (k1 == s) d1 = off + c0 + r1;
                off += c0 + __builtin_popcountll(m1);
            }
            const float s0 = egate[8 * 1024 * 1024 + (size_t)t * 128 + lane], s1 = egate[8 * 1024 * 1024 + (size_t)t * 128 + 64 + lane];
            lse[j * 128 + d0] = e0; lsg[j * 128 + d0] = g0; lse[j * 128 + d1] = e1; lsg[j * 128 + d1] = g1;
            lsg[GT * 128 + j * 128 + d0] = s0; lsg[GT * 128 + j * 128 + d1] = s1;
            const u32x4 u0 = *(const u32x4*)(h2 + (size_t)t * DM + lane * 16), u1 = *(const u32x4*)(h2 + (size_t)t * DM + lane * 16 + 8);
            {
                float hf[16];
#pragma unroll
                for (int i = 0; i < 4; ++i) { hf[2 * i] = __uint_as_float(u0[i] << 16); hf[2 * i + 1] = __uint_as_float(u0[i] & 0xffff0000u); hf[8 + 2 * i] = __uint_as_float(u1[i] << 16); hf[8 + 2 * i + 1] = __uint_as_float(u1[i] & 0xffff0000u); }
                float mh = 0.f;
#pragma unroll
                for (int i = 0; i < 16; ++i) mh = fmaxf(mh, fabsf(hf[i]));
                mh = wave_max(mh);
                int Eh = (int)((__float_as_uint(mh) >> 23) & 0xffu); Eh = Eh < 8 ? 8 : Eh;
                const float up = __uint_as_float((unsigned)(255 - Eh) << 23);
                hsc[j] = __uint_as_float((unsigned)(Eh - 5) << 23);
                unsigned p1[2] = {0u, 0u}, p2[2] = {0u, 0u};
#pragma unroll
                for (int i = 0; i < 16; ++i) {
                    const float x = hf[i] * up, r1 = rintf(x);
                    int q2 = (int)rintf((x - r1) * 16.0f); q2 = q2 > 7 ? 7 : q2;
                    p1[i >> 3] |= ((unsigned)(int)r1 & 15u) << (4 * (i & 7)); p2[i >> 3] |= ((unsigned)q2 & 15u) << (4 * (i & 7));
                }
                hd[j][0] = p1[0]; hd[j][1] = p1[1]; hd[j][2] = p2[0]; hd[j][3] = p2[1];
            }
#pragma unroll
            for (int i = 0; i < 8; ++i) acc[j][i] = (f32x4){0.f, 0.f, 0.f, 0.f};
        }
        GSet A, B, C, D;
        gather_issue(A, 0, lane, pu, pv, lse); gather_issue(B, 1, lane, pu, pv, lse); gather_issue(C, 2, lane, pu, pv, lse);
#pragma unroll 1
        for (int c = 0; c < GNS; ++c) {
            GATH_SEG(0, 1, GBPS * c)
            GATH_SEG(1, 0, c < GNS - 1 ? GBPS * c + GBPS : 0)
        }
#pragma unroll
        for (int j = 0; j < GT; ++j) {
            const int t = t0 + j;
            LAS float* ob = (LAS float*)vb;
            const int nbase = 512 * (row & 1) + 32 * (row >> 1) + (lane & 15);
#pragma unroll
            for (int pm = 0; pm < 4; ++pm)
#pragma unroll
                for (int r = 0; r < 4; ++r) {
                    auto sw = __builtin_amdgcn_permlane32_swap(__float_as_uint(acc[j][2 * pm][r]), __float_as_uint(acc[j][2 * pm + 1][r]), false, false);
                    ob[nbase + 256 * (r >> 1) + 64 * pm + 16 * (r & 1)] = __uint_as_float(sw[0]) + __uint_as_float(sw[1]);
                }
#pragma unroll
            for (int i = 0; i < 4; ++i) {
                const int cc = i * 256 + lane * 4;
                const f32x4 a = *(const LAS f32x4*)(ob + cc);
                const u32x2 xq = *(const u32x2*)(xin + (size_t)t * DM + cc); const f32x4 gt = *(const f32x4*)(gate + (size_t)b * 6144 + cc);
                const f32x4 xi = {__uint_as_float(xq.x << 16), __uint_as_float(xq.x & 0xffff0000u), __uint_as_float(xq.y << 16), __uint_as_float(xq.y & 0xffff0000u)};
                f32x4 o;
#pragma unroll
                for (int e = 0; e < 4; ++e) o[e] = xi[e] + gt[e] * a[e];
                if (xmid) { u32x2 pk; pk.x = pk2(o[0], o[1]); pk.y = pk2(o[2], o[3]); *(u32x2*)(xmid + (size_t)t * DM + cc) = pk; }
                else __builtin_nontemporal_store(o, (f32x4*)(xout + (size_t)t * DM + cc));
            }
        }
    }
}

#define XB_TMO      128
#define XB_XCNT(j)  (256  + 64 * (j))
#define XB_XSUB(j)  (1280 + 64 * (j))
#define XB_XGEN(j)  (2304 + 64 * (j))
#define XB_TOP      3328
#define XB_TOPGEN   3392
#define XCD_BAR_WORDS 3456
#define XB_SPIN_CAP (1u << 18)

__device__ __forceinline__ unsigned xb_ld(unsigned* p)              { return __hip_atomic_load(p, __ATOMIC_RELAXED, __HIP_MEMORY_SCOPE_AGENT); }
__device__ __forceinline__ unsigned xb_add(unsigned* p, unsigned v) { return __hip_atomic_fetch_add(p, v, __ATOMIC_RELAXED, __HIP_MEMORY_SCOPE_AGENT); }
__device__ __forceinline__ unsigned xb_xcc_id() { return (unsigned)__builtin_amdgcn_s_getreg((3 << 11) | 20) & 0xFu; }
#define XB_SPIN(cond, bar) do { unsigned _sp = 0; while (cond) { __builtin_amdgcn_s_sleep(1); \
    if ((++_sp & 255u) == 0u) { if (xb_ld(&(bar)[XB_TMO])) break; if (_sp > XB_SPIN_CAP) { atomicAdd(&(bar)[XB_TMO], 1u); break; } } } } while (0)

struct XcdBarrier {
    unsigned* bar; unsigned x;
    volatile LAS unsigned* st;
};

__device__ __forceinline__ XcdBarrier xcd_barrier_post(unsigned* bar, volatile LAS unsigned* st) {
    XcdBarrier b; b.bar = bar; b.x = xb_xcc_id(); b.st = st;
    if (threadIdx.x == 0) (void)xb_add(&bar[XB_XCNT(b.x)], 1u);
    return b;
}
__device__ __forceinline__ void xcd_barrier_complete(unsigned* bar, unsigned x, unsigned& nloc, unsigned& nx) {
    const unsigned G = gridDim.x * gridDim.y * gridDim.z;
    unsigned sum, cnt, mine, sp = 0u;
    for (;;) {
        sum = 0u; cnt = 0u; mine = 0u;
#pragma unroll
        for (unsigned j = 0; j < 16; ++j) { const unsigned c = xb_ld(&bar[XB_XCNT(j)]); sum += c; cnt += (c > 0u) ? 1u : 0u; mine = (j == x) ? c : mine; }
        if (sum == G) break;
        __builtin_amdgcn_s_sleep(1);
        if ((++sp & 255u) == 0u) { if (xb_ld(&bar[XB_TMO])) break; if (sp > XB_SPIN_CAP) { atomicAdd(&bar[XB_TMO], 1u); break; } }
    }
    nloc = mine > 0u ? mine : 1u; nx = cnt > 0u ? cnt : 1u;
}

__device__ __forceinline__ void xcd_barrier(const XcdBarrier& b) {
    asm volatile("s_waitcnt vmcnt(0)" ::: "memory");
    __syncthreads();
    if (threadIdx.x == 0) {
        unsigned* bar = b.bar;
        __builtin_amdgcn_s_waitcnt(0);
        unsigned nloc = b.st[0], nx = b.st[1];
        if (nloc == 0u) { xcd_barrier_complete(bar, b.x, nloc, nx); b.st[0] = nloc; b.st[1] = nx; }
        const unsigned old = xb_add(&bar[XB_XSUB(b.x)], 1u);
        const unsigned gen = old / nloc;
        if (old + 1u == (gen + 1u) * nloc) {
            __builtin_amdgcn_fence(__ATOMIC_RELEASE, "agent");
            asm volatile("s_waitcnt vmcnt(0)" ::: "memory");
            const unsigned og = xb_add(&bar[XB_TOP], 1u);
            const unsigned tg = og / nx;
            if (og + 1u == (tg + 1u) * nx) xb_add(&bar[XB_TOPGEN], 1u);
            else XB_SPIN(xb_ld(&bar[XB_TOPGEN]) == tg, bar);
            __builtin_amdgcn_fence(__ATOMIC_ACQUIRE, "agent");
            xb_add(&bar[XB_XGEN(b.x)], 1u);
            asm volatile("s_waitcnt vmcnt(0)" ::: "memory");
        } else {
            XB_SPIN(xb_ld(&bar[XB_XGEN(b.x)]) == gen, bar);
            __builtin_amdgcn_fence(__ATOMIC_ACQUIRE, "agent");
            asm volatile("s_waitcnt vmcnt(0)" ::: "memory");
        }
    }
    __syncthreads();
}


#define XB_PACE(j) (3584 + 64 * (j))
__device__ __forceinline__ void xcd_pace(unsigned* bar, volatile LAS unsigned* st) {
    __syncthreads();
    if (threadIdx.x == 0) {
        const unsigned nloc = st[0] ? st[0] : 1u, x = xb_xcc_id(), gen = st[4] + 1u;
        st[4] = gen;
        xb_add(&bar[XB_PACE(x)], 1u);
        unsigned sp = 0;
        while (xb_ld(&bar[XB_PACE(x)]) < gen * nloc) { __builtin_amdgcn_s_sleep(1); if (++sp > (1u << 16)) break; }
    }
    __syncthreads();
}
extern __shared__ __attribute__((aligned(16))) unsigned char dyn_lds[];
#ifndef REP_PREP
#define REP_PREP 1
#endif
#ifndef REP_ATTN
#define REP_ATTN 1
#endif
#ifndef REP_SEL
#define REP_SEL 1
#endif
#ifndef REP_GATH
#define REP_GATH 1
#endif
#ifndef REP_GEMM
#define REP_GEMM 1
#endif
#ifndef REP_ADALN
#define REP_ADALN 1
#endif
constexpr int LDS_BYTES = 147456;

template <class T> __device__ __forceinline__ T* karg(int byte_off) {
    const __attribute__((address_space(4))) char* base = (const __attribute__((address_space(4))) char*)__builtin_amdgcn_kernarg_segment_ptr();
    unsigned long long v = *(const __attribute__((address_space(4))) unsigned long long*)(base + byte_off);
    asm volatile("" : "+s"(v));
    return (T*)(__attribute__((address_space(1))) T*)v;
}
#define KIN(i) karg<const float>(8 * (i))
#define KOUT() karg<float>(168)
#define KWS() karg<unsigned char>(176)
static_assert(sizeof(Params) == 184, "Params layout");
template <class T> __device__ __forceinline__ T* launder(T* p) { size_t off = 0; asm volatile("" : "+s"(off)); return (T*)((unsigned char*)p + off); }
__global__ void __launch_bounds__(NT) mega_fwd(Params p) {
    cg::grid_group grid = cg::this_grid();
    const int bid = blockIdx.x, nb = gridDim.x;
    volatile LAS unsigned* bst = (volatile LAS unsigned*)((LAS unsigned char*)dyn_lds + LDS_BYTES - 64);
    if (ltid() < 16) bst[ltid()] = 0u;
    __syncthreads();
    const XcdBarrier xbar = xcd_barrier_post((unsigned*)(KWS() + WS_BAR), bst);
    for (int rep = 0; rep < REP_PREP; ++rep) {
        unsigned char* ws = KWS();
        float* tile = (float*)dyn_lds;
        ph_transpose(KIN(6), (bf16*)(ws + WS_WIN0), 1024, AB_IN, true, tile, bid, nb);
        ph_transpose(KIN(11), (bf16*)(ws + WS_WIN1), 1024, CD_IN, true, tile, bid, nb);
        ph_transpose(KIN(7), (bf16*)(ws + WS_WO0), 1024, 1024, false, tile, bid, nb);
        ph_transpose(KIN(12), (bf16*)(ws + WS_WO1), 1024, 1024, false, tile, bid, nb);
        ph_transpose(KIN(17), (bf16*)(ws + WS_WQ), 1024, PQ, false, tile, bid, nb);
        ph_transpose(KIN(17) + (size_t)1024 * PQ, (bf16*)(ws + WS_WQ) + (size_t)PQ * 1024, 1024, PQ, false, tile, bid, nb);
        ws = launder(ws);
        ph_tab_uv(KIN(19), KIN(20), ws + WS_PU, (float*)(ws + WS_PV), (float*)(ws + WS_PV + 1 * MiB), 2 * NEXP, bid, nb);
        ws = launder(ws);
        ph_mod(KIN(1), KIN(2), KIN(3), (float*)(ws + WS_MOD), (float*)dyn_lds, bid, nb);
        ph_rope_table((float*)(ws + WS_ROPE), bid, nb);
        for (int i = bid * NT + ltid(); i < NB * 8 * 8 * 64; i += nb * NT) ((float*)(ws + WS_KMEAN))[i] = 0.f;
    }
    grid.sync();
#pragma unroll 1
    for (int layer = 0; layer < 2; ++layer) {
        for (int rep = 0; rep < REP_ADALN; ++rep) {
            unsigned char* ws = KWS(); const float* mod = (const float*)(ws + WS_MOD) + (size_t)layer * 32 * 6144;
            if (layer == 0) ph_adaln<false>(KIN(0), KIN(4), mod + 0, mod + 1024, (bf16*)(ws + WS_HY), bid, nb);
            else ph_adaln<true>(ws + WS_X1 + 128 * MiB, KIN(4) + DM, mod + 0, mod + 1024, (bf16*)(ws + WS_HY), bid, nb);
        }
        xcd_barrier(xbar);
        for (int rep = 0; rep < REP_GEMM; ++rep) {
            unsigned char* ws = KWS();
            pg8::Gemm g{(const bf16*)(ws + WS_HY), (const bf16*)(ws + (layer == 0 ? WS_WIN0 : WS_WIN1)), MT, layer == 0 ? AB_IN : CD_IN, DM};
            pg8::StaticOrder S; S.init(g.M, g.N, nb, bid);
            pg8::EpiQKV e{(bf16*)(ws + WS_QKV), QKV_LD, (const float*)(ws + WS_ROPE), layer, layer == 0 ? KIN(9) : KIN(13), layer == 0 ? KIN(10) : KIN(14), KIN(15), KIN(16), (float*)(ws + WS_KMEAN)};
            pg8::gemm_phase<pg8::EpiQKV, pg8::StaticOrder, true, true>((LAS unsigned char*)dyn_lds, g, S, e);
        }
        xcd_barrier(xbar);
        for (int rep = 0; rep < REP_ATTN; ++rep) {
            unsigned char* ws = KWS();
            if (layer == 0) ph_attn0((const bf16*)(ws + WS_QKV), KIN(8), (bf16*)(ws + WS_HY), (LAS unsigned char*)dyn_lds, bid, nb);
            else ph_attn1((const bf16*)(ws + WS_QKV), (const float*)(ws + WS_KMEAN), (bf16*)(ws + WS_HY), (LAS unsigned char*)dyn_lds, bid, nb);
        }
        xcd_barrier(xbar);
        for (int rep = 0; rep < REP_GEMM; ++rep) {
            unsigned char* ws = KWS(); const float* mod = (const float*)(ws + WS_MOD) + (size_t)layer * 32 * 6144;
            pg8::Gemm g{(const bf16*)(ws + WS_HY), (const bf16*)(ws + (layer == 0 ? WS_WO0 : WS_WO1)), MT, DM, DM};
            pg8::StaticOrder S; S.init(g.M, g.N, nb, bid);
            if (layer == 0) { pg8::EpiResid<false> e{KIN(0), (pg8::bf16_t*)(ws + WS_X1), mod + 2048}; pg8::gemm_phase<pg8::EpiResid<false>, pg8::StaticOrder, true, true>((LAS unsigned char*)dyn_lds, g, S, e); }
            else { pg8::EpiResid<true> e{ws + WS_X1 + 128 * MiB, (pg8::bf16_t*)(ws + WS_X1), mod + 2048}; pg8::gemm_phase<pg8::EpiResid<true>, pg8::StaticOrder, true, true>((LAS unsigned char*)dyn_lds, g, S, e); }
        }
        xcd_barrier(xbar);
        for (int rep = 0; rep < REP_ADALN; ++rep) {
            unsigned char* ws = KWS(); const float* mod = (const float*)(ws + WS_MOD) + (size_t)layer * 32 * 6144;
            ph_adaln<true>(ws + WS_X1, KIN(5) + layer * DM, mod + 3072, mod + 4096, (bf16*)(ws + WS_QKV), bid, nb);
        }
        xcd_barrier(xbar);
        for (int rep = 0; rep < REP_GEMM; ++rep) {
            unsigned char* ws = KWS();
            pg8::Gemm g{(const bf16*)(ws + WS_QKV), (const bf16*)(ws + WS_WQ) + (size_t)layer * PQ * DM, MT, PQ, DM};
            pg8::StaticOrder S; S.init(g.M, g.N, nb, bid); pg8::EpiStore e{(bf16*)(ws + WS_QKV + 128 * MiB), PQ};
            pg8::gemm_phase<pg8::EpiStore, pg8::StaticOrder, true, true>((LAS unsigned char*)dyn_lds, g, S, e);
        }
        xcd_barrier(xbar);
        for (int rep = 0; rep < REP_SEL; ++rep) {
            unsigned char* ws = KWS();
            ph_peer_select((const bf16*)(ws + WS_QKV + 128 * MiB), KIN(18) + (size_t)layer * 2 * 128 * 128, (int*)(ws + WS_HY), (float*)(ws + WS_HY + 32 * MiB), (const float*)(ws + WS_PV) + layer * NEXP, (const float*)(ws + WS_PV + 1 * MiB) + layer * NEXP, (LAS unsigned char*)dyn_lds, bid, nb);
        }
        xcd_barrier(xbar);
        for (int rep = 0; rep < REP_GATH; ++rep) {
            unsigned char* ws = KWS(); const float* mod = (const float*)(ws + WS_MOD) + (size_t)layer * 32 * 6144;
            ph_peer_gather((const bf16*)(ws + WS_QKV), ws + WS_PU + (size_t)layer * NEXP * TROWX, ws + WS_PU + (size_t)layer * NEXP * TROWX,
                           (const float*)(ws + WS_PV) + layer * NEXP, (const float*)(ws + WS_PV + 1 * MiB) + layer * NEXP, (const int*)(ws + WS_HY), (const float*)(ws + WS_HY + 32 * MiB), (const bf16*)(ws + WS_X1), mod + 5120, KOUT(), (LAS unsigned char*)dyn_lds, (unsigned*)(ws + WS_BAR), bst, bid, nb, layer == 0 ? (bf16*)(ws + WS_X1 + 128 * MiB) : (bf16*)nullptr);
        }
        if (layer == 0) xcd_barrier(xbar);
    }
}

extern "C" void kernel_launch(void* const* d_in, const int* in_sizes, int n_in, void* d_out, int out_size, void* d_ws, size_t ws_size, hipStream_t stream) {
    if (n_in != 21 || ws_size < WS_END) { fprintf(stderr, "kernel_launch: bad args n_in=%d ws=%zu\n", n_in, ws_size); return; }
    static int grid_blocks = 0;
    if (!grid_blocks) {
        int dev = 0, cus = 0, per_cu = 0;
        (void)hipGetDevice(&dev);
        (void)hipDeviceGetAttribute(&cus, hipDeviceAttributeMultiprocessorCount, dev);
        (void)hipFuncSetAttribute((const void*)mega_fwd, hipFuncAttributeMaxDynamicSharedMemorySize, LDS_BYTES);
        (void)hipOccupancyMaxActiveBlocksPerMultiprocessor(&per_cu, (const void*)mega_fwd, NT, LDS_BYTES);
        if (per_cu < 1) { fprintf(stderr, "kernel_launch: occupancy query returned %d\n", per_cu); per_cu = 1; }
        if (per_cu > 1) per_cu = 1;
        grid_blocks = cus * per_cu;
    }
    Params p{};
    for (int i = 0; i < 21; ++i) p.in[i] = (const float*)d_in[i];
    p.out = (float*)d_out; p.ws = (unsigned char*)d_ws;
    (void)hipMemsetAsync((char*)d_ws + WS_BAR, 0, 16384, stream);
    void* args[] = {&p};
    hipError_t e = hipLaunchCooperativeKernel((const void*)mega_fwd, dim3(grid_blocks), dim3(NT), args, LDS_BYTES, stream);
    if (e != hipSuccess) fprintf(stderr, "cooperative launch failed: %s (grid %d)\n", hipGetErrorString(e), grid_blocks);
}
```

```cpp
#include <hip/hip_runtime.h>
#ifndef REP_A
#define REP_A 1
#endif
#ifndef REP_B
#define REP_B 1
#endif
#ifndef REP_C
#define REP_C 1
#endif
#ifndef REP_D
#define REP_D 1
#endif
#include <hip/hip_cooperative_groups.h>
namespace cg = cooperative_groups;
#include <cstdio>
#include <cstdint>
#include <cmath>

typedef unsigned short bf16;
typedef short bf16x8 __attribute__((ext_vector_type(8)));
typedef float f32x4 __attribute__((ext_vector_type(4)));
typedef unsigned u32x4 __attribute__((ext_vector_type(4)));
typedef unsigned u32x2 __attribute__((ext_vector_type(2)));

constexpr int DM = 1024, NB = 32, SQ = 2048, MT = NB * SQ;
constexpr int HD = 64;
constexpr int AB_IN = 2304, CD_IN = 3072, QKV_LD = 3072;
constexpr int NEXP = 16384, PQ = 2048;
constexpr float EPS = 1e-6f;
constexpr int NT = 512;

constexpr size_t MiB = 1u << 20;
constexpr size_t WS_X1 = 0;
constexpr size_t WS_QKV = 256 * MiB;
constexpr size_t WS_HY = 640 * MiB;
constexpr size_t WS_PU = 768 * MiB;
constexpr size_t WS_PV = 832 * MiB;
constexpr size_t WS_WIN0 = 896 * MiB;
constexpr size_t WS_WIN1 = 901 * MiB;
constexpr size_t WS_WO0 = 907 * MiB;
constexpr size_t WS_WO1 = 909 * MiB;
constexpr size_t WS_WQ = 911 * MiB;
constexpr size_t WS_MOD = 919 * MiB;
constexpr size_t WS_ROPE = 921 * MiB;
constexpr size_t WS_KMEAN = 922 * MiB;
constexpr size_t WS_BAR = 923 * MiB;
constexpr size_t WS_END = 924 * MiB;

struct Params {
    const float* in[21];
    float* out;
    unsigned char* ws;
};

__device__ __forceinline__ int ltid() { int t = (int)__builtin_amdgcn_workitem_id_x(); asm volatile("" : "+v"(t)); return t; }
__device__ __forceinline__ float bf2f(unsigned b) { return __uint_as_float(b << 16); }
__device__ __forceinline__ unsigned f2bf(float f) { unsigned u = __float_as_uint(f); return (u + 0x7fffu + ((u >> 16) & 1u)) >> 16; }
__device__ __forceinline__ unsigned pk2(float lo, float hi) { return f2bf(lo) | (f2bf(hi) << 16); }
#define DPPV(v, ctrl) __builtin_bit_cast(float, __builtin_amdgcn_update_dpp(0, __builtin_bit_cast(int, (v)), (ctrl), 0xf, 0xf, true))
__device__ __forceinline__ float row16_sum(float v) { v += DPPV(v, 0xB1); v += DPPV(v, 0x4E); v += DPPV(v, 0x124); v += DPPV(v, 0x128); return v; }
__device__ __forceinline__ float rows_sum(float v) {
    { auto r = __builtin_amdgcn_permlane16_swap(__float_as_uint(v), __float_as_uint(v), false, false); v = __uint_as_float(r[0]) + __uint_as_float(r[1]); }
    { auto r = __builtin_amdgcn_permlane32_swap(__float_as_uint(v), __float_as_uint(v), false, false); v = __uint_as_float(r[0]) + __uint_as_float(r[1]); }
    return v;
}
__device__ __forceinline__ float wave_sum(float v) { return rows_sum(row16_sum(v)); }
__device__ __forceinline__ float wave_max(float v) {
    v = fmaxf(v, DPPV(v, 0xB1)); v = fmaxf(v, DPPV(v, 0x4E)); v = fmaxf(v, DPPV(v, 0x124)); v = fmaxf(v, DPPV(v, 0x128));
    { auto r = __builtin_amdgcn_permlane16_swap(__float_as_uint(v), __float_as_uint(v), false, false); v = fmaxf(__uint_as_float(r[0]), __uint_as_float(r[1])); }
    { auto r = __builtin_amdgcn_permlane32_swap(__float_as_uint(v), __float_as_uint(v), false, false); v = fmaxf(__uint_as_float(r[0]), __uint_as_float(r[1])); }
    return v;
}
__device__ __forceinline__ float gelu_erf(float x) {
    const float z = x * 0.70710678118654752f, az = fabsf(z);
    const float t = __builtin_amdgcn_rcpf(fmaf(0.3275911f, az, 1.0f));
    float pl = fmaf(t, 1.061405429f, -1.453152027f); pl = fmaf(t, pl, 1.421413741f); pl = fmaf(t, pl, -0.284496736f); pl = fmaf(t, pl, 0.254829592f); pl *= t;
    const float ex = __builtin_amdgcn_exp2f(az * (az * -1.4426950408889634f));
    const float er = copysignf(fmaf(-pl, ex, 1.0f), z);
    const float hx = 0.5f * x;
    return fmaf(hx, er, hx);
}

__device__ __forceinline__ int qkv_logical_col(int p) { return (p & ~255) | (((p >> 5) & 3) << 6) | (((p >> 7) & 1) << 5) | (p & 31); }
__device__ void ph_transpose(const float* W, bf16* Wt, int K, int N, bool permute, float* tile  , int bid, int nb) {
    const int tid = ltid();
    const int nkt = K / 64, nnt = N / 64;
    for (int it = bid; it < nkt * nnt; it += nb) {
        const int k0 = (it / nnt) * 64, n0 = (it % nnt) * 64;
        __syncthreads();
        for (int e = tid; e < 64 * 64; e += NT) { const int r = e >> 6, c = e & 63; const int nl = permute ? qkv_logical_col(n0 + c) : n0 + c; tile[r * 65 + c] = W[(size_t)(k0 + r) * N + nl]; }
        __syncthreads();
        {
            const int n = tid >> 3, k8 = (tid & 7) * 8;
            u32x4 v;
            v.x = pk2(tile[(k8 + 0) * 65 + n], tile[(k8 + 1) * 65 + n]);
            v.y = pk2(tile[(k8 + 2) * 65 + n], tile[(k8 + 3) * 65 + n]);
            v.z = pk2(tile[(k8 + 4) * 65 + n], tile[(k8 + 5) * 65 + n]);
            v.w = pk2(tile[(k8 + 6) * 65 + n], tile[(k8 + 7) * 65 + n]);
            *(u32x4*)(Wt + (size_t)(n0 + n) * K + k0 + k8) = v;
        }
    }
}
__device__ void ph_convert(const float* src, bf16* dst, size_t n, int bid, int nb) {
    const size_t n8 = n / 8;
    for (size_t i = (size_t)bid * NT + ltid(); i < n8; i += (size_t)nb * NT) {
        const f32x4 a = *(const f32x4*)(src + i * 8), b = *(const f32x4*)(src + i * 8 + 4);
        u32x4 v; v.x = pk2(a[0], a[1]); v.y = pk2(a[2], a[3]); v.z = pk2(b[0], b[1]); v.w = pk2(b[2], b[3]);
        *(u32x4*)(dst + i * 8) = v;
    }
}
__device__ void ph_mod(const float* c, const float* ada_w, const float* ada_b, float* mod, float* lds  , int bid, int nb) {
    const int tid = ltid(), lane = tid & 63, w = tid >> 6;
    for (int it = bid; it < 2 * 96; it += nb) {
        const int l = it / 96, j = (it % 96) * 64 + lane;
        float acc[32];
#pragma unroll
        for (int b = 0; b < 32; ++b) acc[b] = 0.f;
        for (int kh = 0; kh < 2; ++kh) {
            __syncthreads();
            for (int e = tid; e < 32 * 512; e += NT) { const int b = e >> 9, k = e & 511; const float cv = c[b * 1024 + kh * 512 + k]; lds[e] = cv / (1.0f + __expf(-cv)); }
            __syncthreads();
            for (int kk = 0; kk < 64; ++kk) {
                const int k = w * 64 + kk;
                const float wv = ada_w[((size_t)l * 1024 + kh * 512 + k) * 6144 + j];
#pragma unroll
                for (int b = 0; b < 32; ++b) acc[b] += lds[b * 512 + k] * wv;
            }
        }
        __syncthreads();
#pragma unroll
        for (int b = 0; b < 32; ++b) lds[(w * 32 + b) * 64 + lane] = acc[b];
        __syncthreads();
        for (int e = tid; e < 32 * 64; e += NT) {
            const int b = e >> 6, jj = e & 63; float s = 0.f;
#pragma unroll
            for (int ww = 0; ww < 8; ++ww) s += lds[(ww * 32 + b) * 64 + jj];
            const int jo = (it % 96) * 64 + jj;
            mod[((size_t)l * 32 + b) * 6144 + jo] = s + ada_b[l * 6144 + jo];
        }
    }
}
__device__ void ph_rope_table(float* rope, int bid, int nb) {
    for (int i = bid * NT + ltid(); i < SQ * 32; i += nb * NT) {
        const int t = i >> 5, f = i & 31;
        const float inv = powf(10000.0f, -(float)f / 32.0f);
        const float ang = (float)t * inv;
        const float rev = ang * 0.15915494309189535f;
        rope[i] = rev - floorf(rev);
    }
}

#define DPP_ADD0(v, ctrl) ((v) + __builtin_bit_cast(float, __builtin_amdgcn_update_dpp(0, __builtin_bit_cast(int, (v)), (ctrl), 0xf, 0xf, true)))
template <bool XBF> __device__ void ph_adaln(const void* xv, const float* g, const float* mod_shift  , const float* mod_scale, bf16* h, int bid, int nb) {
    const int lane = ltid() & 63, w = __builtin_amdgcn_readfirstlane(ltid() >> 6);
    for (int t0 = (bid * 8 + w) * 4; t0 < MT; t0 += nb * 8 * 4) {
        const int b = t0 >> 11;
        f32x4 v[4][4]; float ss[4];
#pragma unroll
        for (int r = 0; r < 4; ++r) {
            if constexpr (XBF) {
                const bf16* xr = (const bf16*)xv + (size_t)(t0 + r) * DM;
#pragma unroll
                for (int i = 0; i < 4; ++i) { const u32x2 q = *(const u32x2*)(xr + i * 256 + lane * 4); v[r][i] = (f32x4){__uint_as_float(q.x << 16), __uint_as_float(q.x & 0xffff0000u), __uint_as_float(q.y << 16), __uint_as_float(q.y & 0xffff0000u)}; }
            } else {
                const float* xr = (const float*)xv + (size_t)(t0 + r) * DM;
#pragma unroll
                for (int i = 0; i < 4; ++i) v[r][i] = *(const f32x4*)(xr + i * 256 + lane * 4);
            }
        }
#pragma unroll
        for (int r = 0; r < 4; ++r) {
            float s = 0.f;
#pragma unroll
            for (int i = 0; i < 4; ++i) s += v[r][i][0] * v[r][i][0] + v[r][i][1] * v[r][i][1] + v[r][i][2] * v[r][i][2] + v[r][i][3] * v[r][i][3];
            s = DPP_ADD0(s, 0xB1); s = DPP_ADD0(s, 0x4E); s = DPP_ADD0(s, 0x124); s = DPP_ADD0(s, 0x128);
            { auto q = __builtin_amdgcn_permlane16_swap(__float_as_uint(s), __float_as_uint(s), false, false); s = __uint_as_float(q[0]) + __uint_as_float(q[1]); }
            { auto q = __builtin_amdgcn_permlane32_swap(__float_as_uint(s), __float_as_uint(s), false, false); s = __uint_as_float(q[0]) + __uint_as_float(q[1]); }
            ss[r] = rsqrtf(s * (1.0f / DM) + EPS);
        }
#pragma unroll
        for (int i = 0; i < 4; ++i) {
            const int c = i * 256 + lane * 4;
            const f32x4 gg = *(const f32x4*)(g + c), sc = *(const f32x4*)(mod_scale + (size_t)b * 6144 + c), sh = *(const f32x4*)(mod_shift + (size_t)b * 6144 + c);
            float a[4];
#pragma unroll
            for (int e = 0; e < 4; ++e) a[e] = gg[e] * (1.0f + sc[e]);
#pragma unroll
            for (int r = 0; r < 4; ++r) {
                float y[4];
#pragma unroll
                for (int e = 0; e < 4; ++e) y[e] = v[r][i][e] * ss[r] * a[e] + sh[e];
                u32x2 o; o.x = pk2(y[0], y[1]); o.y = pk2(y[2], y[3]);
                __builtin_nontemporal_store(o, (u32x2*)(h + (size_t)(t0 + r) * DM + c));
            }
        }
    }
}

namespace pg8 {
#define PG8_LAS __attribute__((address_space(3)))
typedef unsigned short bf16_t;
typedef short bf16x8 __attribute__((ext_vector_type(8)));
constexpr int BM = 256, BK = 64, HALF = 128, HTB = HALF * BK * 2  , STAGE_BYTES = 8 * HTB, NXCD = 8, WGM = 8;

__host__ __device__ __forceinline__ int lds_byte(int r, int c) { const int st = (r >> 4) * 2 + (c >> 5), rr = r & 15, cc = c & 31, ob = rr * 64 + cc * 2; return st * 1024 + (ob ^ (((ob >> 9) & 1) << 5)); }
__host__ __device__ __forceinline__ void stage_rc(int b, int& R, int& C) { const int st = b / 1024, sb = b % 1024, swz = sb ^ (((sb >> 9) & 1) << 5); R = (st >> 1) * 16 + swz / 64; C = (st & 1) * 32 + (swz % 64) / 2; }
__host__ __device__ __forceinline__ int perm32(int rho) { const int n = rho >> 4, i = rho & 15; return 8 * (i >> 2) + 4 * n + (i & 3); }

struct Unit { int pm, pn; };
struct Gemm { const bf16_t* A; const bf16_t* Bt; int M, N, K; };

struct StaticOrder {
    int nM, nN, nwg, G, c;
    __host__ __device__ void init(int M, int N, int G_, int c_) { nM = M / BM; nN = N / BM; nwg = nM * nN; G = G_; c = c_; }
    __host__ __device__ bool next(int i, Unit& u) const {
        const long L = (long)i * G + c; if (L >= nwg) return false;
        int wgid = (int)L; { const int q = nwg / NXCD, r = nwg % NXCD, xcd = wgid % NXCD, off = wgid / NXCD; wgid = (xcd < r ? xcd * (q + 1) : r * (q + 1) + (xcd - r) * q) + off; }
        const int nig = WGM * nN, gid = wgid / nig, fm = gid * WGM, gsz = (nM - fm) < WGM ? (nM - fm) : WGM;
        u.pm = fm + ((wgid % nig) % gsz); u.pn = (wgid % nig) / gsz; return true;
    }
    __device__ __forceinline__ void a_ready(const Unit&) const {}
    __device__ __forceinline__ void done(const Unit&) const {}
};

__device__ __forceinline__ unsigned cvt_pk_bf16(float lo, float hi) { unsigned r; asm volatile("v_cvt_pk_bf16_f32 %0, %1, %2" : "=v"(r) : "v"(lo), "v"(hi)); return r; }

struct EpiStore {
    static constexpr bool PERM = true, AFTER_DRAIN = false;
    bf16_t* O; int ldc;
    __device__ __forceinline__ void operator()(const f32x4 (&acc)[2][2][4][2], const Unit& u, int wr, int wc, int fr_, int fq_) const {
        int fr = fr_, fq = fq_; asm volatile("" : "+v"(fr), "+v"(fq));
        const int row0 = u.pm * BM + wr * 64 + fr, col0 = u.pn * BM + wc * 32 + 8 * fq;
#pragma unroll
        for (int ai = 0; ai < 2; ++ai)
#pragma unroll
            for (int m = 0; m < 4; ++m) { bf16_t* rowp = O + (size_t)(row0 + ai * HALF + m * 16) * ldc + col0;
#pragma unroll
                for (int bj = 0; bj < 2; ++bj) { const f32x4 v0 = acc[ai][bj][m][0], v1 = acc[ai][bj][m][1];
                    u32x4 w; w.x = cvt_pk_bf16(v0[0], v0[1]); w.y = cvt_pk_bf16(v0[2], v0[3]); w.z = cvt_pk_bf16(v1[0], v1[1]); w.w = cvt_pk_bf16(v1[2], v1[3]);
                    *(u32x4*)(rowp + bj * HALF) = w; } }
    }
};
struct EpiQKV {
    static constexpr bool PERM = true, AFTER_DRAIN = false;
    bf16_t* O; int ldc; const float* rope; int layer;
    const float* gq0; const float* gk0;
    const float* gq1; const float* gk1;
    float* kmean;
    __device__ __forceinline__ void operator()(const f32x4 (&acc)[2][2][4][2], const Unit& u, int wr, int wc, int fr_, int fq_) const {
        int fr = fr_, fq = fq_; asm volatile("" : "+v"(fr), "+v"(fq));
        const int hg = 4 * u.pn + wc;
        const float* gain = nullptr; bool km = false;
        if (layer == 0) { if (hg < 8) gain = gq0; else if (hg < 10) gain = gk0; }
        else { if (hg < 8) gain = gq0; else if (hg < 16) gain = gk0; else if (hg >= 24 && hg < 32) gain = gq1; else if (hg >= 32 && hg < 40) { gain = gk1; km = true; } }
        const int row0 = u.pm * BM + wr * 64 + fr, col0 = 64 * hg + 8 * fq;
        float g0[8], g1[8], cs0[8], cs1[8];
#pragma unroll
        for (int e = 0; e < 8; ++e) { g0[e] = gain ? gain[8 * fq + e] : 1.f; g1[e] = gain ? gain[32 + 8 * fq + e] : 1.f; cs0[e] = 0.f; cs1[e] = 0.f; }
#pragma unroll
        for (int ai = 0; ai < 2; ++ai)
#pragma unroll
            for (int m = 0; m < 4; ++m) {
                const int row = row0 + ai * HALF + m * 16;
                float v0[8], v1[8];
#pragma unroll
                for (int e = 0; e < 4; ++e) { v0[e] = acc[ai][0][m][0][e]; v0[4 + e] = acc[ai][0][m][1][e]; v1[e] = acc[ai][1][m][0][e]; v1[4 + e] = acc[ai][1][m][1][e]; }
                if (gain) {
                    float ss = 0.f;
#pragma unroll
                    for (int e = 0; e < 8; ++e) ss += v0[e] * v0[e] + v1[e] * v1[e];
                    ss = rows_sum(ss);
                    const float r = rsqrtf(ss * (1.0f / 64.0f) + 1e-6f);
                    const float* rp = rope + ((size_t)(row & 2047) * 32 + 8 * fq);
                    const f32x4 t0 = *(const f32x4*)(rp), t1 = *(const f32x4*)(rp + 4);
                    float cs[8], sn[8];
#pragma unroll
                    for (int e = 0; e < 4; ++e) { cs[e] = __builtin_amdgcn_cosf(t0[e]); sn[e] = __builtin_amdgcn_sinf(t0[e]); cs[4 + e] = __builtin_amdgcn_cosf(t1[e]); sn[4 + e] = __builtin_amdgcn_sinf(t1[e]); }
#pragma unroll
                    for (int e = 0; e < 8; ++e) { const float y0 = v0[e] * r * g0[e], y1 = v1[e] * r * g1[e]; v0[e] = y0 * cs[e] - y1 * sn[e]; v1[e] = y1 * cs[e] + y0 * sn[e]; }
                }
                u32x4 w0, w1;
                w0.x = cvt_pk_bf16(v0[0], v0[1]); w0.y = cvt_pk_bf16(v0[2], v0[3]); w0.z = cvt_pk_bf16(v0[4], v0[5]); w0.w = cvt_pk_bf16(v0[6], v0[7]);
                w1.x = cvt_pk_bf16(v1[0], v1[1]); w1.y = cvt_pk_bf16(v1[2], v1[3]); w1.z = cvt_pk_bf16(v1[4], v1[5]); w1.w = cvt_pk_bf16(v1[6], v1[7]);
                bf16_t* rowp = O + (size_t)row * ldc + col0;
                *(u32x4*)(rowp) = w0; *(u32x4*)(rowp + 32) = w1;
                if (km) {
#pragma unroll
                    for (int e = 0; e < 8; ++e) { cs0[e] += v0[e]; cs1[e] += v1[e]; }
                }
            }
        if (km) {
#pragma unroll
            for (int e = 0; e < 8; ++e) {
                cs0[e] = row16_sum(cs0[e]); cs1[e] = row16_sum(cs1[e]);
            }
            if (fr == 0) {
                float* kp = kmean + ((size_t)((u.pm >> 3) * 8 + (hg - 32)) * 8 + (u.pm & 7)) * 64 + 8 * fq;
#pragma unroll
                for (int e = 0; e < 8; ++e) { atomicAdd(kp + e, cs0[e] * (1.0f / 256.0f)); atomicAdd(kp + 32 + e, cs1[e] * (1.0f / 256.0f)); }
            }
        }
    }
};
template <bool XBF> struct EpiResid {
    static constexpr bool PERM = true, AFTER_DRAIN = false;
    const void* xin; bf16_t* xout; const float* gate;
    __device__ __forceinline__ void operator()(const f32x4 (&acc)[2][2][4][2], const Unit& u, int wr, int wc, int fr_, int fq_) const {
        int fr = fr_, fq = fq_; asm volatile("" : "+v"(fr), "+v"(fq));
        const int row0 = u.pm * BM + wr * 64 + fr, col0 = u.pn * BM + wc * 32 + 8 * fq;
        const float* gp = gate + (size_t)((u.pm * BM) >> 11) * 6144 + col0;
        f32x4 gq[2][2];
#pragma unroll
        for (int bj = 0; bj < 2; ++bj) { gq[bj][0] = *(const f32x4*)(gp + bj * HALF); gq[bj][1] = *(const f32x4*)(gp + bj * HALF + 4); }
#pragma unroll
        for (int ai = 0; ai < 2; ++ai)
#pragma unroll
            for (int m = 0; m < 4; ++m) { const int row = row0 + ai * HALF + m * 16;
                bf16_t* xo = xout + (size_t)row * 1024 + col0;
#pragma unroll
                for (int bj = 0; bj < 2; ++bj) {
                    f32x4 x0, x1;
                    if constexpr (XBF) { const u32x4 q = *(const u32x4*)((const bf16_t*)xin + (size_t)row * 1024 + col0 + bj * HALF);
                        x0 = (f32x4){__uint_as_float(q.x << 16), __uint_as_float(q.x & 0xffff0000u), __uint_as_float(q.y << 16), __uint_as_float(q.y & 0xffff0000u)};
                        x1 = (f32x4){__uint_as_float(q.z << 16), __uint_as_float(q.z & 0xffff0000u), __uint_as_float(q.w << 16), __uint_as_float(q.w & 0xffff0000u)}; }
                    else { const float* xi = (const float*)xin + (size_t)row * 1024 + col0 + bj * HALF; x0 = *(const f32x4*)xi; x1 = *(const f32x4*)(xi + 4); }
                    const f32x4 a0 = acc[ai][bj][m][0], a1 = acc[ai][bj][m][1], g0 = gq[bj][0], g1 = gq[bj][1];
                    u32x4 w; w.x = cvt_pk_bf16(x0[0] + g0[0] * a0[0], x0[1] + g0[1] * a0[1]); w.y = cvt_pk_bf16(x0[2] + g0[2] * a0[2], x0[3] + g0[3] * a0[3]);
                    w.z = cvt_pk_bf16(x1[0] + g1[0] * a1[0], x1[1] + g1[1] * a1[1]); w.w = cvt_pk_bf16(x1[2] + g1[2] * a1[2], x1[3] + g1[3] * a1[3]);
                    *(u32x4*)(xo + bj * HALF) = w; } }
    }
};
template <class Epi, class Sched, bool ALIGN_EPI = false, bool SP2 = false>
__device__ __forceinline__ void gemm_phase(PG8_LAS unsigned char* lds, const Gemm g, const Sched& S, const Epi& E) {
    const int tid = ltid(), wid = __builtin_amdgcn_readfirstlane(tid >> 6), lane = tid & 63, wr = wid >> 2, wc = wid & 3, fr = lane & 15, fq = lane >> 4;
    const int K = g.K, nt = K / BK;
    unsigned voffA[2], voffB[2];
#pragma unroll
    for (int i = 0; i < 2; ++i) { int R, C; stage_rc(tid * 16 + i * 8192, R, C); const int Rb = Epi::PERM ? ((R & ~31) + perm32(R & 31)) : R;
        voffA[i] = (unsigned)(R * K + C) * 2u; voffB[i] = (unsigned)(Rb * K + C) * 2u; }
    const size_t kstep = (size_t)(BK * 2);
    const size_t hstep = (size_t)HALF * K * 2;
    const size_t tstep = 2 * hstep;
    const unsigned ldsw = (unsigned)wid * 1024u;
    const int aoff = lds_byte(wr * 64 + fr, fq * 8), boff = lds_byte(wc * 32 + fr, fq * 8);
#define PG8_SA(b, h) (((b) * 2 + (h)) * HTB)
#define PG8_SB(b, h) ((4 + (b) * 2 + (h)) * HTB)
#define PG8_STAGE(bufoff, gbase, voff) do { _Pragma("unroll") for (int _i = 0; _i < 2; ++_i) \
        __builtin_amdgcn_global_load_lds((const unsigned*)((const char*)(gbase) + (voff)[_i]), (PG8_LAS unsigned*)(lds + (bufoff) + ldsw + _i * 8192), 16, 0, 0); } while (0)
#define PG8_LDA(dst, b, h) do { _Pragma("unroll") for (int m = 0; m < 4; ++m) _Pragma("unroll") for (int k = 0; k < 2; ++k) dst[m][k] = *(const PG8_LAS bf16x8*)(lds + PG8_SA(b, h) + aoff + m * 2048 + k * 1024); } while (0)
#define PG8_LDB(dst, b, h) do { _Pragma("unroll") for (int n = 0; n < 2; ++n) _Pragma("unroll") for (int k = 0; k < 2; ++k) dst[n][k] = *(const PG8_LAS bf16x8*)(lds + PG8_SB(b, h) + boff + n * 2048 + k * 1024); } while (0)
#define PG8_MMA(ai, bj, At, Bt) do { __builtin_amdgcn_s_setprio(1); _Pragma("unroll") for (int m = 0; m < 4; ++m) _Pragma("unroll") for (int n = 0; n < 2; ++n) _Pragma("unroll") for (int k = 0; k < 2; ++k) \
        acc[ai][bj][m][n] = __builtin_amdgcn_mfma_f32_16x16x32_bf16(Bt[n][k], At[m][k], acc[ai][bj][m][n], 0, 0, 0); __builtin_amdgcn_s_setprio(0); } while (0)
#define PG8_WAIT_V(n) asm volatile("s_waitcnt vmcnt(" #n ")" ::: "memory")
#define PG8_WAIT_L(n) asm volatile("s_waitcnt lgkmcnt(" #n ")" ::: "memory")
#define PG8_BAR __builtin_amdgcn_s_barrier()
#define PG8_SCHED __builtin_amdgcn_sched_barrier(0)
    Unit cur, nxt; int ui = 0;
    if (!S.next(0, cur)) return;
    f32x4 acc[2][2][4][2];
#pragma unroll
    for (int a = 0; a < 2; ++a)
#pragma unroll
        for (int b = 0; b < 2; ++b)
#pragma unroll
            for (int m = 0; m < 4; ++m)
#pragma unroll
                for (int n = 0; n < 2; ++n) acc[a][b][m][n] = (f32x4){0.f, 0.f, 0.f, 0.f};
    bf16x8 At[4][2], B0[2][2], B1[2][2];
    const char* cA = (const char*)g.A + (size_t)cur.pm * tstep; const char* cB = (const char*)g.Bt + (size_t)cur.pn * tstep;
    S.a_ready(cur);
    if constexpr (SP2) {
        PG8_STAGE(PG8_SB(0, 0), cB, voffB); PG8_STAGE(PG8_SB(0, 1), cB + hstep, voffB); PG8_STAGE(PG8_SA(0, 0), cA, voffA); PG8_STAGE(PG8_SA(0, 1), cA + hstep, voffA);
        if (wr == 1) PG8_BAR;
        PG8_WAIT_V(2); PG8_BAR;
        PG8_STAGE(PG8_SB(1, 0), cB + kstep, voffB); PG8_STAGE(PG8_SA(1, 0), cA + kstep, voffA); PG8_STAGE(PG8_SB(1, 1), cB + hstep + kstep, voffB);
        PG8_WAIT_V(6); PG8_BAR;
    } else {
        PG8_STAGE(PG8_SB(0, 0), cB, voffB); PG8_STAGE(PG8_SA(0, 0), cA, voffA); PG8_STAGE(PG8_SB(0, 1), cB + hstep, voffB); PG8_STAGE(PG8_SA(0, 1), cA + hstep, voffA);
        if (wr == 1) PG8_BAR;
        PG8_WAIT_V(4); PG8_BAR;
        PG8_STAGE(PG8_SB(1, 0), cB + kstep, voffB); PG8_STAGE(PG8_SA(1, 0), cA + kstep, voffA); PG8_STAGE(PG8_SB(1, 1), cB + hstep + kstep, voffB);
        PG8_WAIT_V(6); PG8_BAR;
    }
    for (;;) {
        const bool has_next = S.next(ui + 1, nxt);
        const char* nA = has_next ? (const char*)g.A + (size_t)nxt.pm * tstep : cA; const char* nB = has_next ? (const char*)g.Bt + (size_t)nxt.pn * tstep : cB;
        for (int t = 0; t < nt; t += 2) {
            const bool last = (t == nt - 2);
            const char* a1 = cA + (size_t)(t + 1) * kstep;
            const char* a2 = last ? nA : cA + (size_t)(t + 2) * kstep; const char* b2 = last ? nB : cB + (size_t)(t + 2) * kstep;
            const char* a3 = a2 + kstep; const char* b3 = b2 + kstep;
            if (last && has_next) S.a_ready(nxt);
            if constexpr (SP2) {
            PG8_LDB(B0, 0, 0); PG8_LDB(B1, 0, 1); PG8_SCHED; PG8_LDA(At, 0, 0); PG8_STAGE(PG8_SA(1, 1), a1 + hstep, voffA);
            PG8_WAIT_V(8); PG8_WAIT_L(0); PG8_BAR; PG8_MMA(0, 0, At, B0); PG8_MMA(0, 1, At, B1); PG8_BAR; PG8_SCHED;
            PG8_LDA(At, 0, 1); PG8_STAGE(PG8_SB(0, 0), b2, voffB); PG8_STAGE(PG8_SB(0, 1), b2 + hstep, voffB); PG8_STAGE(PG8_SA(0, 0), a2, voffA);
            PG8_WAIT_V(8); PG8_WAIT_L(0); PG8_BAR; PG8_MMA(1, 0, At, B0); PG8_MMA(1, 1, At, B1); PG8_BAR; PG8_SCHED;
            PG8_LDB(B0, 1, 0); PG8_LDB(B1, 1, 1); PG8_SCHED; PG8_LDA(At, 1, 0); PG8_STAGE(PG8_SA(0, 1), a2 + hstep, voffA);
            PG8_WAIT_V(8); PG8_WAIT_L(0); PG8_BAR; PG8_MMA(0, 0, At, B0); PG8_MMA(0, 1, At, B1); PG8_BAR; PG8_SCHED;
            PG8_LDA(At, 1, 1); PG8_STAGE(PG8_SB(1, 0), b3, voffB); PG8_STAGE(PG8_SB(1, 1), b3 + hstep, voffB); PG8_STAGE(PG8_SA(1, 0), a3, voffA);
            PG8_WAIT_V(8); PG8_WAIT_L(0); PG8_BAR; PG8_MMA(1, 0, At, B0); PG8_MMA(1, 1, At, B1); PG8_BAR; PG8_SCHED;
            } else {
            PG8_LDB(B0, 0, 0); PG8_SCHED; PG8_LDA(At, 0, 0); PG8_STAGE(PG8_SA(1, 1), a1 + hstep, voffA);
            PG8_WAIT_L(8); PG8_BAR; PG8_WAIT_L(0); PG8_MMA(0, 0, At, B0); PG8_BAR; PG8_SCHED;
            PG8_LDB(B1, 0, 1); PG8_STAGE(PG8_SB(0, 0), b2, voffB);
            PG8_BAR; PG8_WAIT_L(0); PG8_MMA(0, 1, At, B1); PG8_BAR;
            PG8_LDA(At, 0, 1); PG8_STAGE(PG8_SA(0, 0), a2, voffA);
            PG8_BAR; PG8_WAIT_L(0); PG8_MMA(1, 0, At, B0); PG8_BAR; PG8_SCHED;
            PG8_STAGE(PG8_SB(0, 1), b2 + hstep, voffB);
            PG8_WAIT_V(6); PG8_BAR; PG8_MMA(1, 1, At, B1); PG8_BAR;
            PG8_LDB(B0, 1, 0); PG8_SCHED; PG8_LDA(At, 1, 0); PG8_STAGE(PG8_SA(0, 1), a2 + hstep, voffA);
            PG8_WAIT_L(8); PG8_BAR; PG8_WAIT_L(0); PG8_MMA(0, 0, At, B0); PG8_BAR; PG8_SCHED;
            PG8_LDB(B1, 1, 1); PG8_STAGE(PG8_SB(1, 0), b3, voffB);
            PG8_BAR; PG8_WAIT_L(0); PG8_MMA(0, 1, At, B1); PG8_BAR;
            PG8_LDA(At, 1, 1); PG8_STAGE(PG8_SA(1, 0), a3, voffA);
            PG8_BAR; PG8_WAIT_L(0); PG8_MMA(1, 0, At, B0); PG8_BAR; PG8_SCHED;
            PG8_STAGE(PG8_SB(1, 1), b3 + hstep, voffB);
            PG8_WAIT_V(6); PG8_BAR; PG8_MMA(1, 1, At, B1); PG8_BAR;
            }
        }
        if constexpr (ALIGN_EPI) { if (wr == 0) PG8_BAR; }
        if constexpr (!Epi::AFTER_DRAIN) { E(acc, cur, wr, wc, fr, fq); S.done(cur); }
        if (!has_next) break;
#pragma unroll
        for (int a = 0; a < 2; ++a)
#pragma unroll
            for (int b = 0; b < 2; ++b)
#pragma unroll
                for (int m = 0; m < 4; ++m)
#pragma unroll
                    for (int n = 0; n < 2; ++n) acc[a][b][m][n] = (f32x4){0.f, 0.f, 0.f, 0.f};
        cur = nxt; cA = nA; cB = nB; ++ui;
        if constexpr (ALIGN_EPI) { if (wr == 1) PG8_BAR; }
    }
    PG8_WAIT_V(0);
    if constexpr (!ALIGN_EPI) { if (wr == 0) PG8_BAR; }
    PG8_BAR;
    if constexpr (Epi::AFTER_DRAIN) { E.fused(acc, cur, wr, wc, fr, fq, lds, wid, lane); S.done(cur); }
#undef PG8_SA
#undef PG8_SB
#undef PG8_STAGE
#undef PG8_LDA
#undef PG8_LDB
#undef PG8_MMA
#undef PG8_WAIT_V
#undef PG8_WAIT_L
#undef PG8_BAR
#undef PG8_SCHED
}
}

typedef float f32x16 __attribute__((ext_vector_type(16)));
typedef short s16x4 __attribute__((ext_vector_type(4)));
typedef short v4i16_t __attribute__((ext_vector_type(4)));
typedef float f32x2_t __attribute__((ext_vector_type(2)));
typedef __bf16 bf16x2_t __attribute__((ext_vector_type(2)));
#define LAS __attribute__((address_space(3)))
constexpr int VROW = 144, VBUF = 32 * VROW;
constexpr int VROWV = 192, VBUFV = 32 * VROWV;
constexpr float L2E = 1.4426950408889634f, LN2 = 0.6931471805599453f;
constexpr float SC2 = 0.125f * L2E;

__device__ __forceinline__ int crow(int r, int hi) { return (r & 3) + 8 * (r >> 2) + 4 * hi; }
__device__ __forceinline__ unsigned cvtpk(float lo, float hi) { f32x2_t v = {lo, hi}; bf16x2_t b = __builtin_convertvector(v, bf16x2_t); return __builtin_bit_cast(unsigned, b); }
__device__ __forceinline__ float xhalf(float v, int hi) {
    auto r = __builtin_amdgcn_permlane32_swap(__float_as_uint(v), __float_as_uint(v), false, false);
    return __uint_as_float(hi ? r[0] : r[1]);
}
__device__ __forceinline__ s16x4 vtr(const LAS unsigned char* p) { return __builtin_bit_cast(s16x4, __builtin_amdgcn_ds_read_tr16_b64_v4i16((LAS v4i16_t*)p)); }

struct KVRegs { u32x4 k[4]; u32x4 v[4]; };
__device__ __forceinline__ void load_kv(KVRegs& R, const bf16* base, int kp0, int kst, int kcol, int vcol, int lane) {
#pragma unroll
    for (int j = 0; j < 4; ++j) {
        const int pos = kp0 + kst * (8 * j + (lane >> 3));
        const int pc = pos < SQ - 1 ? pos : SQ - 1;
        const bf16* rp = base + (size_t)pc * QKV_LD + (lane & 7) * 8;
        R.k[j] = *(const u32x4*)(rp + kcol); R.v[j] = *(const u32x4*)(rp + vcol);
    }
}
__device__ __forceinline__ void kv_stage(const KVRegs& R, LAS unsigned char* klds, LAS unsigned char* vlds, int lane) {
#pragma unroll
    for (int j = 0; j < 4; ++j) { const int r_ = 8 * j + (lane >> 3), c_ = (lane & 7) * 16; *(LAS u32x4*)(klds + r_ * VROW + c_) = R.k[j]; *(LAS u32x4*)(vlds + r_ * VROWV + c_) = R.v[j]; }
}
__device__ __forceinline__ f32x16 qk_tile(const LAS unsigned char* klds, const bf16x8 (&qf)[4], int r32, int hi) {
    f32x16 s = {0.f, 0.f, 0.f, 0.f, 0.f, 0.f, 0.f, 0.f, 0.f, 0.f, 0.f, 0.f, 0.f, 0.f, 0.f, 0.f};
#pragma unroll
    for (int k = 0; k < 4; ++k) { const bf16x8 kf = *(const LAS bf16x8*)(klds + r32 * VROW + (2 * k + hi) * 16); s = __builtin_amdgcn_mfma_f32_32x32x16_bf16(kf, qf[k], s, 0, 0, 0); }
    return s;
}
__device__ __forceinline__ void pv_tile(f32x16 (&o)[2], const f32x16& p, const LAS unsigned char* vlds, int lane) {
    const int g = lane >> 4, i = lane & 15, h = lane >> 5;
    const LAS unsigned char* vb = vlds + (4 * h + (i >> 2)) * VROWV + (16 * (g & 1) + 4 * (i & 3)) * 2;
#pragma unroll
    for (int s = 0; s < 2; ++s) {
        u32x4 pw; pw.x = cvtpk(p[8 * s], p[8 * s + 1]); pw.y = cvtpk(p[8 * s + 2], p[8 * s + 3]); pw.z = cvtpk(p[8 * s + 4], p[8 * s + 5]); pw.w = cvtpk(p[8 * s + 6], p[8 * s + 7]);
        const bf16x8 pb = __builtin_bit_cast(bf16x8, pw);
#pragma unroll
        for (int df = 0; df < 2; ++df) {
            const s16x4 lo = vtr(vb + (16 * s) * VROWV + df * 64), hh = vtr(vb + (16 * s + 8) * VROWV + df * 64);
            const bf16x8 va = (bf16x8){lo[0], lo[1], lo[2], lo[3], hh[0], hh[1], hh[2], hh[3]};
            o[df] = __builtin_amdgcn_mfma_f32_32x32x16_bf16(va, pb, o[df], 0, 0, 0);
        }
    }
}
__device__ __forceinline__ void load_q(bf16x8 (&qf)[4], const bf16* base, int qpos, int qcol, int hi) {
    const bf16* rp = base + (size_t)qpos * QKV_LD + qcol + 8 * hi;
#pragma unroll
    for (int k = 0; k < 4; ++k) qf[k] = *(const bf16x8*)(rp + 16 * k);
}
__device__ __forceinline__ void store_o(bf16* yrow, const f32x16 (&o)[2], float inv, int hi) {
#pragma unroll
    for (int df = 0; df < 2; ++df)
#pragma unroll
        for (int g = 0; g < 4; ++g) {
            u32x2 w; w.x = cvtpk(o[df][4 * g] * inv, o[df][4 * g + 1] * inv); w.y = cvtpk(o[df][4 * g + 2] * inv, o[df][4 * g + 3] * inv);
            *(u32x2*)(yrow + 32 * df + 8 * g + 4 * hi) = w;
        }
}
__device__ __forceinline__ void osm_tile(f32x16& s, float& m, float& l, f32x16 (&o)[2]) {
    float mx = s[0];
#pragma unroll
    for (int r = 1; r < 16; ++r) mx = fmaxf(mx, s[r]);
    { auto rr = __builtin_amdgcn_permlane32_swap(__float_as_uint(mx), __float_as_uint(mx), false, false); mx = fmaxf(__uint_as_float(rr[0]), __uint_as_float(rr[1])); }
    const float mn = fmaxf(m, mx);
    const float ms = (mn == -INFINITY) ? 0.f : mn;
    const float alpha = __builtin_amdgcn_exp2f((m - ms) * SC2);
    const float mc = ms * SC2;
    float ps = 0.f;
#pragma unroll
    for (int r = 0; r < 16; ++r) { s[r] = __builtin_amdgcn_exp2f(s[r] * SC2 - mc); ps += s[r]; }
    l = l * alpha + ps; m = mn;
    if (!__all(alpha == 1.0f)) {
#pragma unroll
        for (int df = 0; df < 2; ++df)
#pragma unroll
            for (int r = 0; r < 16; ++r) o[df][r] *= alpha;
    }
}
__device__ __forceinline__ void osm_tile2(f32x16& s0, f32x16& s1, float& m, float& l, f32x16 (&o)[2]) {
    float mx = fmaxf(s0[0], s1[0]);
#pragma unroll
    for (int r = 1; r < 16; ++r) mx = fmaxf(mx, fmaxf(s0[r], s1[r]));
    { auto rr = __builtin_amdgcn_permlane32_swap(__float_as_uint(mx), __float_as_uint(mx), false, false); mx = fmaxf(__uint_as_float(rr[0]), __uint_as_float(rr[1])); }
    const float mn = fmaxf(m, mx);
    const float ms = (mn == -INFINITY) ? 0.f : mn;
    const float alpha = __builtin_amdgcn_exp2f((m - ms) * SC2);
    const float mc = ms * SC2;
    float ps0 = 0.f, ps1 = 0.f;
#pragma unroll
    for (int r = 0; r < 16; ++r) { s0[r] = __builtin_amdgcn_exp2f(s0[r] * SC2 - mc); ps0 += s0[r]; s1[r] = __builtin_amdgcn_exp2f(s1[r] * SC2 - mc); ps1 += s1[r]; }
    l = l * alpha + (ps0 + ps1); m = mn;
    if (!__all(alpha == 1.0f)) {
#pragma unroll
        for (int df = 0; df < 2; ++df)
#pragma unroll
            for (int r = 0; r < 16; ++r) o[df][r] *= alpha;
    }
}
#define ZERO16 {0.f, 0.f, 0.f, 0.f, 0.f, 0.f, 0.f, 0.f, 0.f, 0.f, 0.f, 0.f, 0.f, 0.f, 0.f, 0.f}

struct AttnCtx {
    const bf16* base; int kcol, vcol, r32, hi, lane; LAS unsigned char* vlds; LAS unsigned char* klds; bf16x8 qf[4]; f32x16 o[2];
};
#define ATTN_STEP(SC, SL, T) { \
        if (SYNC) __builtin_amdgcn_s_barrier(); \
        { int kp_, ks_; const int tl_ = (T) + 2 < nt ? (T) + 2 : nt - 1; mx.pos(tl_, kp_, ks_); load_kv(SL, c.base, kp_, ks_, c.kcol, c.vcol, c.lane); } \
        kv_stage(SC, c.klds, c.vlds, c.lane); f32x16 s_ = qk_tile(c.klds, c.qf, c.r32, c.hi); \
        const bool stop_ = mx.process((T), s_, c); pv_tile(c.o, s_, c.vlds, c.lane); \
        if ((!SYNC && stop_) || (T) + 1 >= nt) break; }
template <class M, bool SYNC> __device__ __forceinline__ void attn_run(M& mx, AttnCtx& c) {
    const int nt = mx.nt;
    KVRegs S0, S1, S2;
    { int kp, ks; mx.pos(0, kp, ks); load_kv(S0, c.base, kp, ks, c.kcol, c.vcol, c.lane);
      mx.pos(1 < nt ? 1 : nt - 1, kp, ks); load_kv(S1, c.base, kp, ks, c.kcol, c.vcol, c.lane); }
    for (int t = 0;; t += 3) {
        ATTN_STEP(S0, S2, t)
        ATTN_STEP(S1, S0, t + 1)
        ATTN_STEP(S2, S1, t + 2)
    }
}
#define SH_BAR() asm volatile("s_waitcnt lgkmcnt(0)\n\ts_barrier" ::: "memory")
constexpr int SLOT_K = 64 * VROW, SLOT_BYTES = 64 * VROW + 64 * VROWV;
struct ShRegs { u32x4 a, b; };
__device__ __forceinline__ void sh_load(ShRegs& R, const bf16* base, int kp0, int kcol, int vcol, int w, int lane) {
    const int pos = kp0 + 4 * w + ((lane & 31) >> 3);
    const int pa = pos < SQ - 1 ? pos : SQ - 1, pb = pos + 32 < SQ - 1 ? pos + 32 : SQ - 1;
    const int col = ((lane >> 5) ? vcol : kcol) + (lane & 7) * 8;
    R.a = *(const u32x4*)(base + (size_t)pa * QKV_LD + col); R.b = *(const u32x4*)(base + (size_t)pb * QKV_LD + col);
}
__device__ __forceinline__ void sh_write(LAS unsigned char* slot, const ShRegs& R, int w, int lane) {
    const int row = 4 * w + ((lane & 31) >> 3);
    LAS unsigned char* p = slot + ((lane >> 5) ? SLOT_K + row * VROWV : row * VROW) + (lane & 7) * 16;
    *(LAS u32x4*)p = R.a; *(LAS u32x4*)(p + 32 * ((lane >> 5) ? VROWV : VROW)) = R.b;
}
#define SH_STEP(RW, RL, T) { \
        SH_BAR(); \
        { const int tl_ = (T) + 2 < nt ? (T) + 2 : nt - 1; sh_load(RL, c.base, mx.pos2(tl_), c.kcol, c.vcol, w, c.lane); } \
        sh_write(slots + (((T) + 1) & 1) * SLOT_BYTES, RW, w, c.lane); \
        if (mx.active2((T), w)) { LAS unsigned char* sl_ = slots + ((T) & 1) * SLOT_BYTES; \
            f32x16 s0_ = qk_tile(sl_, c.qf, c.r32, c.hi), s1_ = qk_tile(sl_ + 32 * VROW, c.qf, c.r32, c.hi); mx.process2((T), s0_, s1_, c); \
            pv_tile(c.o, s0_, sl_ + SLOT_K, c.lane); pv_tile(c.o, s1_, sl_ + SLOT_K + 32 * VROWV, c.lane); } \
        if ((T) + 1 >= nt) break; }
template <class M> __device__ __forceinline__ void attn_run_shared(M& mx, AttnCtx& c, LAS unsigned char* slots, int w) {
    const int nt = mx.nt2;
    ShRegs R0, R1, R2;
    sh_load(R0, c.base, mx.pos2(0), c.kcol, c.vcol, w, c.lane);
    sh_load(R1, c.base, mx.pos2(1 < nt ? 1 : nt - 1), c.kcol, c.vcol, w, c.lane);
    SH_BAR();
    sh_write(slots, R0, w, c.lane);
    for (int t = 0;; t += 3) {
        SH_STEP(R1, R2, t)
        SH_STEP(R2, R0, t + 1)
        SH_STEP(R0, R1, t + 2)
    }
}
struct MixA {
    int nt, k00, qpos; float m, l;
    __device__ __forceinline__ void pos(int idx, int& kp0, int& kst) const { kp0 = k00 + 32 * idx; kst = 1; }
    __device__ __forceinline__ bool process(int idx, f32x16& s, AttnCtx& c) {
        const int k0 = k00 + 32 * idx;
#pragma unroll
        for (int r = 0; r < 16; ++r) { const int dist = qpos - (k0 + crow(r, c.hi)); if (dist < 0 || dist > 127) s[r] = -INFINITY; }
        osm_tile(s, m, l, c.o); return false;
    }
};
__device__ void attn_A(const bf16* base, int hq, int q0, float sink, bf16* ybase, LAS unsigned char* vlds, int lane) {
    AttnCtx c; c.base = base; c.r32 = lane & 31; c.hi = lane >> 5; c.lane = lane; c.vlds = vlds; c.klds = vlds + VBUFV; c.kcol = 512 + (hq >> 2) * 64; c.vcol = 640 + (hq >> 2) * 64;
    c.o[0] = (f32x16)ZERO16; c.o[1] = (f32x16)ZERO16;
    MixA mx; mx.qpos = q0 + c.r32; mx.k00 = q0 - 128 > 0 ? q0 - 128 : 0; mx.nt = 5; mx.m = -INFINITY; mx.l = 0.f;
    load_q(c.qf, base, mx.qpos, hq * 64, c.hi);
    attn_run<MixA, true>(mx, c);
    float l = mx.l + xhalf(mx.l, c.hi);
    l += __builtin_amdgcn_exp2f(sink * L2E - mx.m * SC2);
    store_o(ybase + (size_t)mx.qpos * DM + hq * 64, c.o, 1.0f / l, c.hi);
}
struct MixB {
    int nt, q0, qpos; float carry;
    __device__ __forceinline__ void pos(int idx, int& kp0, int& kst) const { kp0 = q0 - 32 * idx; kst = 1; }
    __device__ __forceinline__ bool process(int idx, f32x16& s, AttnCtx& c) {
        const int k0 = q0 - 32 * idx, hi = c.hi;
        float lk[16], G[4], Gp[4];
#pragma unroll
        for (int r = 0; r < 16; ++r) {
            const float z = s[r] * 0.125f;
            const bool valid = (k0 + crow(r, hi)) < qpos;
            const float sp = fmaxf(z, 0.f) + LN2 * __builtin_amdgcn_logf(1.0f + __builtin_amdgcn_exp2f(-fabsf(z) * L2E));
            lk[r] = valid ? -sp : 0.f;
            s[r] = valid ? (z - sp) : -INFINITY;
        }
#pragma unroll
        for (int g = 0; g < 4; ++g) { G[g] = (lk[4 * g] + lk[4 * g + 1]) + (lk[4 * g + 2] + lk[4 * g + 3]); Gp[g] = xhalf(G[g], hi); }
        float above = carry;
#pragma unroll
        for (int g = 3; g >= 0; --g) {
            float off = above + (hi == 0 ? Gp[g] : 0.f);
            s[4 * g + 3] = __builtin_amdgcn_exp2f((s[4 * g + 3] + off) * L2E); off += lk[4 * g + 3];
            s[4 * g + 2] = __builtin_amdgcn_exp2f((s[4 * g + 2] + off) * L2E); off += lk[4 * g + 2];
            s[4 * g + 1] = __builtin_amdgcn_exp2f((s[4 * g + 1] + off) * L2E); off += lk[4 * g + 1];
            s[4 * g + 0] = __builtin_amdgcn_exp2f((s[4 * g + 0] + off) * L2E);
            above += G[g] + Gp[g];
        }
        carry = above;
        return __all(carry < -40.0f) != 0;
    }
};
__device__ void attn_B(const bf16* base, int h, int q0, bf16* ybase, LAS unsigned char* vlds, int lane) {
    AttnCtx c; c.base = base; c.r32 = lane & 31; c.hi = lane >> 5; c.lane = lane; c.vlds = vlds; c.klds = vlds + VBUFV; c.kcol = 1280 + h * 64; c.vcol = 1792 + h * 64;
    c.o[0] = (f32x16)ZERO16; c.o[1] = (f32x16)ZERO16;
    MixB mx; mx.q0 = q0; mx.qpos = q0 + c.r32; mx.nt = q0 / 32 + 1; mx.carry = 0.f;
    load_q(c.qf, base, mx.qpos, 768 + h * 64, c.hi);
    attn_run<MixB, false>(mx, c);
    store_o(ybase + (size_t)mx.qpos * DM + 512 + h * 64, c.o, 1.0f, c.hi);
}
struct MixCp {
    int nt, n0, r0, j1lo, qpos; float m, l;
    __device__ __forceinline__ void pos(int t, int& kp0, int& kst) const {
        if (t < n0) { kp0 = r0 + 512 * t; kst = 16; } else { kp0 = (r0 & 3) + 4 * (j1lo + 32 * (t - n0)); kst = 4; }
    }
    __device__ __forceinline__ bool process(int t, f32x16& s, AttnCtx& c) {
        int kp0, kst; pos(t, kp0, kst);
        const int win = t < n0 ? 2048 : 512;
#pragma unroll
        for (int r = 0; r < 16; ++r) { const int dist = qpos - (kp0 + kst * crow(r, c.hi)); if (dist < 0 || dist > win) s[r] = -INFINITY; }
        osm_tile(s, m, l, c.o); return false;
    }
};
struct MixC1 {
    int nt2, p0, qpos; float m, l;
    __device__ __forceinline__ int pos2(int T) const { return p0 + 64 * T; }
    __device__ __forceinline__ bool active2(int T, int w) const { return true; }
    __device__ __forceinline__ void process2(int T, f32x16& s0, f32x16& s1, AttnCtx& c) {
        const int k0 = p0 + 64 * T;
#pragma unroll
        for (int r = 0; r < 16; ++r) { const int dist = qpos - (k0 + crow(r, c.hi)); if (dist < 0 || dist > 128) s0[r] = -INFINITY; if (dist < 32 || dist > 160) s1[r] = -INFINITY; }
        osm_tile2(s0, s1, m, l, c.o);
    }
};
__device__ void attn_C(const bf16* base, int h, int r0, int g, bf16* ybase, LAS unsigned char* vlds, LAS unsigned char* xlds, int w, int lane) {
    AttnCtx c; c.base = base; c.r32 = lane & 31; c.hi = lane >> 5; c.lane = lane; c.vlds = vlds; c.klds = vlds + VBUFV; c.kcol = 512 + h * 64; c.vcol = 1024 + h * 64;
    c.o[0] = (f32x16)ZERO16; c.o[1] = (f32x16)ZERO16;
    const int qpos = r0 + 16 * (32 * g + c.r32);
    load_q(c.qf, base, qpos, h * 64, c.hi);
    MixCp mp; mp.r0 = r0; mp.qpos = qpos; mp.m = -INFINITY; mp.l = 0.f;
    mp.n0 = g + 1;
    mp.j1lo = (r0 >> 2) + 128 * g - 128 > 0 ? (r0 >> 2) + 128 * g - 128 : 0;
    mp.nt = mp.n0 + ((r0 >> 2) + 128 * g + 124 - mp.j1lo) / 32 + 1;
    attn_run<MixCp, true>(mp, c);
    MixC1 m1; m1.qpos = qpos; m1.m = mp.m; m1.l = mp.l;
    const int ra = r0 & 8;
    m1.p0 = 512 * g + ra - 128 > 0 ? 512 * g + ra - 128 : 0;
    m1.nt2 = ((512 * g + ra + 7 + 496 - m1.p0) / 32 + 2) / 2;
    attn_run_shared<MixC1>(m1, c, xlds + 64, w);
    const float l = m1.l + xhalf(m1.l, c.hi);
    store_o(ybase + (size_t)qpos * DM + h * 64, c.o, 1.0f / l, c.hi);
}
struct MixD {
    int nt, nt2, npast, own, q0, qpos; unsigned U, sel; float m, l;
    __device__ __forceinline__ int blk_of(int j) const {
        unsigned u = U; int b = 0;
#pragma unroll
        for (int i = 0; i < 7; ++i) { if (i < j) u &= u - 1u; }
        b = __builtin_ctz(u | 0x100u); return b;
    }
    __device__ __forceinline__ void pos(int t, int& kp0, int& kst) const {
        kst = 1;
        if (t < 8 * npast) kp0 = blk_of(t >> 3) * 256 + (t & 7) * 32; else kp0 = own * 256 + (t - 8 * npast) * 32;
    }
    __device__ __forceinline__ int pos2(int T) const { int kp, ks; pos(2 * T, kp, ks); return kp; }
    __device__ __forceinline__ bool active2(int T, int w) const { return T < 4 * npast || 2 * (T - 4 * npast) <= w; }
    __device__ __forceinline__ void process2(int T, f32x16& s0, f32x16& s1, AttnCtx& c) {
        if (T < 4 * npast) {
            const int blk = blk_of(T >> 2);
            if (!((sel >> blk) & 1u)) {
#pragma unroll
                for (int r = 0; r < 16; ++r) { s0[r] = -INFINITY; s1[r] = -INFINITY; }
            }
        } else {
            const int k0 = own * 256 + (T - 4 * npast) * 64;
#pragma unroll
            for (int r = 0; r < 16; ++r) { const int kk = k0 + crow(r, c.hi); if (kk > qpos) s0[r] = -INFINITY; if (kk + 32 > qpos) s1[r] = -INFINITY; }
        }
        osm_tile2(s0, s1, m, l, c.o);
    }
};
__device__ void attn_D(const bf16* base, const float* kmean  , int h, int q0, bf16* ybase, LAS unsigned char* vlds, LAS unsigned char* xlds, int lane) {
    AttnCtx c; c.base = base; c.r32 = lane & 31; c.hi = lane >> 5; c.lane = lane; c.vlds = vlds; c.klds = vlds + VBUFV; c.kcol = 2048 + h * 64; c.vcol = 2560 + h * 64;
    c.o[0] = (f32x16)ZERO16; c.o[1] = (f32x16)ZERO16;
    const int r32 = c.r32, hi = c.hi, own = q0 >> 8;
    MixD mx; mx.own = own; mx.q0 = q0; mx.qpos = q0 + r32; mx.m = -INFINITY; mx.l = 0.f;
    load_q(c.qf, base, mx.qpos, 1536 + h * 64, hi);
    unsigned sel = 0u;
    if (own > 0) {
        bf16x8 kf[4];
#pragma unroll
        for (int k = 0; k < 4; ++k) {
            u32x4 w = {0u, 0u, 0u, 0u};
            if (r32 < 8) { const float* kp = kmean + r32 * 64 + 16 * k + 8 * hi; const f32x4 a = *(const f32x4*)kp, b = *(const f32x4*)(kp + 4);
                w.x = cvtpk(a[0], a[1]); w.y = cvtpk(a[2], a[3]); w.z = cvtpk(b[0], b[1]); w.w = cvtpk(b[2], b[3]); }
            kf[k] = __builtin_bit_cast(bf16x8, w);
        }
        f32x16 gs = ZERO16;
#pragma unroll
        for (int k = 0; k < 4; ++k) gs = __builtin_amdgcn_mfma_f32_32x32x16_bf16(kf[k], c.qf[k], gs, 0, 0, 0);
        float gt[8];
#pragma unroll
        for (int r = 0; r < 4; ++r) { const float mine = gs[r], oth = xhalf(mine, hi); gt[r] = hi == 0 ? mine : oth; gt[4 + r] = hi == 0 ? oth : mine; }
        const int nsel = own < 3 ? own : 3;
        for (int rr = 0; rr < nsel; ++rr) {
            float best = -INFINITY; int bi = -1;
#pragma unroll
            for (int n = 0; n < 8; ++n) { const bool ok = n < own && !((sel >> n) & 1u) && (bi < 0 || gt[n] > best); if (ok) { best = gt[n]; bi = n; } }
            if (bi >= 0) sel |= 1u << bi;
        }
    }
    unsigned U = 0u;
#pragma unroll
    for (int n = 0; n < 8; ++n) if (__ballot((sel >> n) & 1u) != 0ull) U |= 1u << n;
    {
        volatile LAS unsigned* ux = (volatile LAS unsigned*)xlds;
        __builtin_amdgcn_s_barrier();
        if (lane == 0) ux[(q0 >> 5) & 7] = U;
        asm volatile("s_waitcnt lgkmcnt(0)" ::: "memory");
        __builtin_amdgcn_s_barrier();
        U = ux[0] | ux[1] | ux[2] | ux[3] | ux[4] | ux[5] | ux[6] | ux[7];
        U = __builtin_amdgcn_readfirstlane(U);
    }
    mx.U = U; mx.sel = sel; mx.npast = __builtin_popcount(U); mx.nt = 8 * mx.npast + 8; mx.nt2 = 4 * mx.npast + 4;
    attn_run_shared<MixD>(mx, c, xlds + 64, (q0 >> 5) & 7);
    const float l = mx.l + xhalf(mx.l, c.hi);
    store_o(ybase + (size_t)mx.qpos * DM + 512 + h * 64, c.o, 1.0f / l, hi);
}

__device__ void ph_attn0(const bf16* qkv, const float* sinks, bf16* y, LAS unsigned char* lds, int bid, int nb) {
    const int lane = ltid() & 63, w = __builtin_amdgcn_readfirstlane(ltid() >> 6);
    LAS unsigned char* vlds = lds + w * (VBUF + VBUFV);
    for (int pid = bid; pid < NB * 8; pid += nb) {
        const int b = pid >> 3, h = pid & 7;
        const bf16* base = qkv + (size_t)b * SQ * QKV_LD; bf16* ybase = y + (size_t)b * SQ * DM;
        const float sink = sinks[h];
        for (int rd = 0; rd < 8; ++rd) attn_A(base, h, (rd * 8 + w) * 32, sink, ybase, vlds, lane);
        for (int rd = 0; rd < 8; ++rd) attn_B(base, h, (rd * 8 + w) * 32, ybase, vlds, lane);
    }
}
__device__ void ph_attn1(const bf16* qkv, const float* kmean, bf16* y, LAS unsigned char* lds, int bid, int nb) {
    const int lane = ltid() & 63, w = __builtin_amdgcn_readfirstlane(ltid() >> 6);
    LAS unsigned char* vlds = lds + w * (VBUF + VBUFV);
    for (int pid = bid; pid < NB * 8; pid += nb) {
        const int b = pid >> 3, h = pid & 7;
        const bf16* base = qkv + (size_t)b * SQ * QKV_LD; bf16* ybase = y + (size_t)b * SQ * DM;
        for (int rd = 0; rd < 8; ++rd) { const int it = rd * 8 + w; attn_C(base, h, it & 15, it >> 4, ybase, vlds, lds + 8 * (VBUF + VBUFV), w, lane); }
        for (int rd = 0; rd < 8; ++rd) attn_D(base, kmean + (size_t)pid * 8 * 64, h, (rd * 8 + w) * 32, ybase, vlds, lds + 8 * (VBUF + VBUFV), lane);
    }
}

#define CE_D(a, b) { const float hi_ = fmaxf((a), (b)), lo_ = fminf((a), (b)); (a) = hi_; (b) = lo_; }
#define BSTAGE(arr, k, j) _Pragma("unroll") for (int i_ = 0; i_ < 16; ++i_) { const int l_ = i_ ^ (j); if (l_ > i_) { if ((i_ & (k)) == 0) CE_D(arr[i_], arr[l_]) else CE_D(arr[l_], arr[i_]) } }
__device__ __forceinline__ void bsort16(float (&a)[16]) {
    CE_D(a[0], a[1]) CE_D(a[2], a[3]) CE_D(a[0], a[2]) CE_D(a[1], a[3]) CE_D(a[1], a[2]) CE_D(a[4], a[5]) CE_D(a[6], a[7]) CE_D(a[4], a[6]) CE_D(a[5], a[7]) CE_D(a[5], a[6]) CE_D(a[0], a[4]) CE_D(a[2], a[6]) CE_D(a[2], a[4]) CE_D(a[1], a[5]) CE_D(a[3], a[7]) CE_D(a[3], a[5]) CE_D(a[1], a[2]) CE_D(a[3], a[4]) CE_D(a[5], a[6]) CE_D(a[8], a[9]) CE_D(a[10], a[11]) CE_D(a[8], a[10]) CE_D(a[9], a[11]) CE_D(a[9], a[10]) CE_D(a[12], a[13]) CE_D(a[14], a[15]) CE_D(a[12], a[14]) CE_D(a[13], a[15]) CE_D(a[13], a[14]) CE_D(a[8], a[12]) CE_D(a[10], a[14]) CE_D(a[10], a[12]) CE_D(a[9], a[13]) CE_D(a[11], a[15]) CE_D(a[11], a[13]) CE_D(a[9], a[10]) CE_D(a[11], a[12]) CE_D(a[13], a[14]) CE_D(a[0], a[8]) CE_D(a[4], a[12]) CE_D(a[4], a[8]) CE_D(a[2], a[10]) CE_D(a[6], a[14]) CE_D(a[6], a[10]) CE_D(a[2], a[4]) CE_D(a[6], a[8]) CE_D(a[10], a[12]) CE_D(a[1], a[9]) CE_D(a[5], a[13]) CE_D(a[5], a[9]) CE_D(a[3], a[11]) CE_D(a[7], a[15]) CE_D(a[7], a[11]) CE_D(a[3], a[5]) CE_D(a[7], a[9]) CE_D(a[11], a[13]) CE_D(a[1], a[2]) CE_D(a[3], a[4]) CE_D(a[5], a[6]) CE_D(a[7], a[8]) CE_D(a[9], a[10]) CE_D(a[11], a[12]) CE_D(a[13], a[14])
}
__device__ __forceinline__ void bmerge16(float (&a)[16]) {
    BSTAGE(a, 16, 8) BSTAGE(a, 16, 4) BSTAGE(a, 16, 2) BSTAGE(a, 16, 1)
}
__device__ __forceinline__ void merge_top16(float (&a)[16], const float (&b)[16]) {
#pragma unroll
    for (int i = 0; i < 16; ++i) a[i] = fmaxf(a[i], b[15 - i]);
    bmerge16(a);
}
__device__ __forceinline__ void xmerge16(float (&a)[16]) {
    {
        float A[16], B[16];
#pragma unroll
        for (int i = 0; i < 16; ++i) { auto r = __builtin_amdgcn_permlane16_swap(__float_as_uint(a[i]), __float_as_uint(a[i]), false, false); A[i] = __uint_as_float(r[0]); B[i] = __uint_as_float(r[1]); }
#pragma unroll
        for (int i = 0; i < 16; ++i) a[i] = fmaxf(A[i], B[15 - i]);
        bmerge16(a);
    }
    {
        float A[16], B[16];
#pragma unroll
        for (int i = 0; i < 16; ++i) { auto r = __builtin_amdgcn_permlane32_swap(__float_as_uint(a[i]), __float_as_uint(a[i]), false, false); A[i] = __uint_as_float(r[0]); B[i] = __uint_as_float(r[1]); }
#pragma unroll
        for (int i = 0; i < 16; ++i) a[i] = fmaxf(A[i], B[15 - i]);
        bmerge16(a);
    }
}
__host__ __device__ constexpr int pair_i(int id) {
    int c = 0;
    for (int i = 0; i < 16; ++i) { const int nj = 16 / (i + 1); if (id < c + nj) return i; c += nj; }
    return 0;
}
__host__ __device__ constexpr int pair_j(int id) {
    int c = 0;
    for (int i = 0; i < 16; ++i) { const int nj = 16 / (i + 1); if (id < c + nj) return id - c; c += nj; }
    return 0;
}
constexpr int SK_ROW = 272;
constexpr int SEL_SK_BYTES = 2 * 128 * SK_ROW;
constexpr int SEL_TAB_OFF = SEL_SK_BYTES;
constexpr int SEL_IDX_OFF = SEL_SK_BYTES + 64;

template <int S> __device__ __forceinline__ float cand_slot(const float (&L1)[16], const float (&L2)[16], int g) {
    constexpr int p0 = S, p1 = 16 + S, p2 = 32 + S, p3 = 48 + S;
    const float c0 = L1[pair_i(p0)] + L2[pair_j(p0)], c1 = L1[pair_i(p1)] + L2[pair_j(p1)], c2 = L1[pair_i(p2)] + L2[pair_j(p2)];
    const float c3 = p3 < 50 ? L1[pair_i(p3 < 50 ? p3 : 0)] + L2[pair_j(p3 < 50 ? p3 : 0)] : -1.0e30f;
    const float c = g == 0 ? c0 : (g == 1 ? c1 : (g == 2 ? c2 : c3));
    return __uint_as_float((__float_as_uint(c) & 0xffffffc0u) | (unsigned)(16 * g + S));
}

__device__ void ph_peer_select(const bf16* qry, const float* subkeys  , int* eidx, float* egate  , const float* su, const float* sv, LAS unsigned char* lds, int bid, int nb) {
    const int tid = ltid(), lane = tid & 63, w = __builtin_amdgcn_readfirstlane(tid >> 6);
    const int tk = lane & 15, g = lane >> 4;
    __syncthreads();
    for (int e = tid; e < 2 * 128 * 128 / 2; e += NT) {
        const int row = e >> 6, c2 = (e & 63) * 2;
        const float a = subkeys[(size_t)row * 128 + c2], b = subkeys[(size_t)row * 128 + c2 + 1];
        *(LAS unsigned*)(lds + row * SK_ROW + c2 * 2) = pk2(a, b);
    }
    if (tid < 64) { int id = tid; int c = 0, pi = 0, pj = 0;
        for (int i = 0; i < 16; ++i) { const int nj = 16 / (i + 1); if (id >= c && id < c + nj) { pi = i; pj = id - c; } c += nj; }
        lds[SEL_TAB_OFF + tid] = (unsigned char)((pi << 4) | pj); }
    __syncthreads();
    LAS unsigned* widx = (LAS unsigned*)(lds + SEL_IDX_OFF + w * 512);
    const LAS unsigned char* widx8 = (const LAS unsigned char*)widx;
    const int nitems = (MT / 16) * 8;
    bf16x8 qc[2][4];
    { const int it = bid * 8 + w;
      if (it < nitems) { const bf16* qp = qry + (size_t)((it >> 3) * 16 + tk) * PQ + (it & 7) * 256 + 8 * g;
#pragma unroll
          for (int hf = 0; hf < 2; ++hf)
#pragma unroll
              for (int ks = 0; ks < 4; ++ks) qc[hf][ks] = *(const bf16x8*)(qp + hf * 128 + 32 * ks); } }
    for (int it = bid * 8 + w; it < nitems; it += nb * 8) {
        const int h = it & 7, t0 = (it >> 3) * 16;
        bf16x8 qn[2][4];
        { const int itn = it + nb * 8 < nitems ? it + nb * 8 : it;
          const bf16* qp = qry + (size_t)((itn >> 3) * 16 + tk) * PQ + (itn & 7) * 256 + 8 * g;
#pragma unroll
          for (int hf = 0; hf < 2; ++hf)
#pragma unroll
              for (int ks = 0; ks < 4; ++ks) qn[hf][ks] = *(const bf16x8*)(qp + hf * 128 + 32 * ks); }
        float L[2][16];
#pragma unroll
        for (int hf = 0; hf < 2; ++hf) {
            bf16x8 qf[4];
#pragma unroll
            for (int ks = 0; ks < 4; ++ks) qf[ks] = qc[hf][ks];
            float key[32];
#pragma unroll
            for (int tile = 0; tile < 8; ++tile) {
                f32x4 acc = {0.f, 0.f, 0.f, 0.f};
#pragma unroll
                for (int ks = 0; ks < 4; ++ks) {
                    const bf16x8 af = *(const LAS bf16x8*)(lds + (hf * 128 + tile * 16 + tk) * SK_ROW + (32 * ks + 8 * g) * 2);
                    acc = __builtin_amdgcn_mfma_f32_16x16x32_bf16(af, qf[ks], acc, 0, 0, 0);
                }
#pragma unroll
                for (int r = 0; r < 4; ++r) key[tile * 4 + r] = __uint_as_float((__float_as_uint(acc[r]) & 0xffffff80u) | (unsigned)(16 * tile + 4 * g + r));
            }
            float a[16], b[16];
#pragma unroll
            for (int i = 0; i < 16; ++i) { a[i] = key[i]; b[i] = key[16 + i]; }
            bsort16(a); bsort16(b);
            merge_top16(a, b);
            xmerge16(a);
#pragma unroll
            for (int i = 0; i < 16; ++i) L[hf][i] = a[i];
            unsigned pk = 0u;
#pragma unroll
            for (int s = 0; s < 4; ++s) {
                const float v = g == 0 ? a[s] : (g == 1 ? a[4 + s] : (g == 2 ? a[8 + s] : a[12 + s]));
                pk |= (__float_as_uint(v) & 127u) << (8 * s);
            }
            widx[tk * 8 + hf * 4 + g] = pk;
        }
        float c[16];
        c[0] = cand_slot<0>(L[0], L[1], g); c[1] = cand_slot<1>(L[0], L[1], g); c[2] = cand_slot<2>(L[0], L[1], g); c[3] = cand_slot<3>(L[0], L[1], g);
        c[4] = cand_slot<4>(L[0], L[1], g); c[5] = cand_slot<5>(L[0], L[1], g); c[6] = cand_slot<6>(L[0], L[1], g); c[7] = cand_slot<7>(L[0], L[1], g);
        c[8] = cand_slot<8>(L[0], L[1], g); c[9] = cand_slot<9>(L[0], L[1], g); c[10] = cand_slot<10>(L[0], L[1], g); c[11] = cand_slot<11>(L[0], L[1], g);
        c[12] = cand_slot<12>(L[0], L[1], g); c[13] = cand_slot<13>(L[0], L[1], g); c[14] = cand_slot<14>(L[0], L[1], g); c[15] = cand_slot<15>(L[0], L[1], g);
        bsort16(c);
        xmerge16(c);
        float sum = 0.f, ex[16];
#pragma unroll
        for (int i = 0; i < 16; ++i) { ex[i] = __builtin_amdgcn_exp2f((c[i] - c[0]) * L2E); sum += ex[i]; }
        const float inv = 1.0f / sum;
        int oi[4]; float og[4];
#pragma unroll
        for (int s = 0; s < 4; ++s) {
            const float kv = g == 0 ? c[s] : (g == 1 ? c[4 + s] : (g == 2 ? c[8 + s] : c[12 + s]));
            const float ev = g == 0 ? ex[s] : (g == 1 ? ex[4 + s] : (g == 2 ? ex[8 + s] : ex[12 + s]));
            const unsigned pid = __float_as_uint(kv) & 63u;
            const unsigned ij = lds[SEL_TAB_OFF + pid];
            const unsigned i1 = widx8[tk * 32 + (ij >> 4)], i2 = widx8[tk * 32 + 16 + (ij & 15u)];
            oi[s] = (int)(i1 * 128u + i2); og[s] = ev * inv;
        }
        const size_t ob = (size_t)(t0 + tk) * 128 + h * 16 + 4 * g;
        *(u32x4*)(eidx + ob) = (u32x4){(unsigned)oi[0], (unsigned)oi[1], (unsigned)oi[2], (unsigned)oi[3]};
        *(f32x4*)(egate + ob) = (f32x4){og[0] * sv[oi[0]], og[1] * sv[oi[1]], og[2] * sv[oi[2]], og[3] * sv[oi[3]]};
        *(f32x4*)(egate + 8 * 1024 * 1024 + ob) = (f32x4){su[oi[0]], su[oi[1]], su[oi[2]], su[oi[3]]};
#pragma unroll
        for (int hf = 0; hf < 2; ++hf)
#pragma unroll
            for (int ks = 0; ks < 4; ++ks) qc[hf][ks] = qn[hf][ks];
    }
    __syncthreads();
}

typedef float v32f_t __attribute__((ext_vector_type(32)));
typedef unsigned v6u_t __attribute__((ext_vector_type(6)));
typedef unsigned v16u_t __attribute__((ext_vector_type(16)));
typedef __bf16 v32bf_t __attribute__((ext_vector_type(32)));
typedef __bf16 v2bf_t __attribute__((ext_vector_type(2)));
typedef _Float16 v32h_t __attribute__((ext_vector_type(32)));
typedef unsigned u32x3 __attribute__((ext_vector_type(3)));
constexpr int TROW = 768;
__device__ void ph_tab_fp6(const float* src, unsigned char* dst, float* scale, int nrows, int bid, int nb) {
    const int lane = ltid() & 63, w = __builtin_amdgcn_readfirstlane(ltid() >> 6);
    for (int rp = bid * 8 + w; rp < nrows / 2; rp += nb * 8) {
        v32h_t hv; float sc[2];
#pragma unroll
        for (int rr = 0; rr < 2; ++rr) {
            const float* sp = src + (size_t)(2 * rp + rr) * DM + lane * 16;
            f32x4 v[4]; float am = 0.f;
#pragma unroll
            for (int i = 0; i < 4; ++i) { v[i] = *(const f32x4*)(sp + i * 4); am = fmaxf(am, fmaxf(fmaxf(fabsf(v[i][0]), fabsf(v[i][1])), fmaxf(fabsf(v[i][2]), fabsf(v[i][3])))); }
            am = wave_max(am);
            const float s = am > 0.f ? am * (1.0f / 7.5f) : 1.0f, inv = 1.0f / s;
            sc[rr] = s;
#pragma unroll
            for (int i = 0; i < 4; ++i)
#pragma unroll
                for (int e = 0; e < 4; ++e) hv[rr * 16 + i * 4 + e] = (_Float16)fminf(fmaxf(v[i][e] * inv, -7.5f), 7.5f);
        }
        const v6u_t pk = __builtin_amdgcn_cvt_scalef32_pk32_fp6_f16(hv, 1.0f);
        unsigned* d0 = (unsigned*)(dst + (size_t)(2 * rp) * TROW + lane * 12);
        unsigned* d1 = (unsigned*)(dst + (size_t)(2 * rp + 1) * TROW + lane * 12);
        d0[0] = pk[0]; d0[1] = pk[1]; d0[2] = pk[2]; d1[0] = pk[3]; d1[1] = pk[4]; d1[2] = pk[5];
        if (lane == 0) { scale[2 * rp] = sc[0]; scale[2 * rp + 1] = sc[1]; }
    }
}

constexpr int TROW4 = 512;
constexpr int TROWX = 1024;
__device__ void ph_tab_fp4(const float* src, unsigned char* dst  , float* scale, int nrows, int bid, int nb) {
    const int lane = ltid() & 63, w = __builtin_amdgcn_readfirstlane(ltid() >> 6);
    for (int row = bid * 8 + w; row < nrows; row += nb * 8) {
        const float* sp = src + (size_t)row * DM + lane * 16;
        f32x4 v[4]; float am = 0.f;
#pragma unroll
        for (int i = 0; i < 4; ++i) { v[i] = *(const f32x4*)(sp + i * 4); am = fmaxf(am, fmaxf(fmaxf(fabsf(v[i][0]), fabsf(v[i][1])), fmaxf(fabsf(v[i][2]), fabsf(v[i][3])))); }
        am = wave_max(am);
        const float s = am > 0.f ? am * (1.0f / 6.0f) : 1.0f, inv = 1.0f / s;
        unsigned d0 = 0u, d1 = 0u;
        d0 = __builtin_amdgcn_cvt_scalef32_pk_fp4_f32(d0, v[0][0] * inv, v[0][1] * inv, 1.0f, 0); d0 = __builtin_amdgcn_cvt_scalef32_pk_fp4_f32(d0, v[0][2] * inv, v[0][3] * inv, 1.0f, 1);
        d0 = __builtin_amdgcn_cvt_scalef32_pk_fp4_f32(d0, v[1][0] * inv, v[1][1] * inv, 1.0f, 2); d0 = __builtin_amdgcn_cvt_scalef32_pk_fp4_f32(d0, v[1][2] * inv, v[1][3] * inv, 1.0f, 3);
        d1 = __builtin_amdgcn_cvt_scalef32_pk_fp4_f32(d1, v[2][0] * inv, v[2][1] * inv, 1.0f, 0); d1 = __builtin_amdgcn_cvt_scalef32_pk_fp4_f32(d1, v[2][2] * inv, v[2][3] * inv, 1.0f, 1);
        d1 = __builtin_amdgcn_cvt_scalef32_pk_fp4_f32(d1, v[3][0] * inv, v[3][1] * inv, 1.0f, 2); d1 = __builtin_amdgcn_cvt_scalef32_pk_fp4_f32(d1, v[3][2] * inv, v[3][3] * inv, 1.0f, 3);
        *(u32x2*)(dst + (size_t)row * TROWX + lane * 16) = (u32x2){d0, d1};
        if (lane == 0) scale[row] = s;
    }
}

__device__ void ph_tab_i4(const float* src, unsigned char* dst, float* scale, int nrows, int bid, int nb) {
    const int lane = ltid() & 63, w = __builtin_amdgcn_readfirstlane(ltid() >> 6);
    for (int row = bid * 8 + w; row < nrows; row += nb * 8) {
        const float* sp = src + (size_t)row * DM + lane * 16;
        f32x4 v[4]; float am = 0.f;
#pragma unroll
        for (int i = 0; i < 4; ++i) { v[i] = *(const f32x4*)(sp + i * 4); am = fmaxf(am, fmaxf(fmaxf(fabsf(v[i][0]), fabsf(v[i][1])), fmaxf(fabsf(v[i][2]), fabsf(v[i][3])))); }
        am = wave_max(am);
        const float s = am > 0.f ? am * (1.0f / 7.0f) : 1.0f, inv = 1.0f / s;
        unsigned d[2] = {0u, 0u};
#pragma unroll
        for (int i = 0; i < 16; ++i) { const int q = (int)rintf(fminf(fmaxf(v[i >> 2][i & 3] * inv, -7.0f), 7.0f)); d[i >> 3] |= ((unsigned)q & 15u) << (4 * (i & 7)); }
        *(u32x2*)(dst + (size_t)row * TROWX + lane * 16) = (u32x2){d[0], d[1]};
        if (lane == 0) scale[row] = s;
    }
}

__device__ void ph_tab_uv(const float* srcu, const float* srcv, unsigned char* dst, float* scu, float* scv, int nrows, int bid, int nb) {
    const int lane = ltid() & 63, w = __builtin_amdgcn_readfirstlane(ltid() >> 6);
    for (int row0 = (bid * 8 + w) * 2; row0 < nrows; row0 += nb * 8 * 2) {
        f32x4 vu[2][4], vv[2][4];
#pragma unroll
        for (int r = 0; r < 2; ++r)
#pragma unroll
            for (int i = 0; i < 4; ++i) { vu[r][i] = *(const f32x4*)(srcu + (size_t)(row0 + r) * DM + lane * 16 + i * 4); vv[r][i] = *(const f32x4*)(srcv + (size_t)(row0 + r) * DM + lane * 16 + i * 4); }
#pragma unroll
        for (int r = 0; r < 2; ++r) {
            float au = 0.f, av = 0.f;
#pragma unroll
            for (int i = 0; i < 4; ++i)
#pragma unroll
                for (int e = 0; e < 4; ++e) { au = fmaxf(au, fabsf(vu[r][i][e])); av = fmaxf(av, fabsf(vv[r][i][e])); }
            au = wave_max(au); av = wave_max(av);
            const float su_ = au > 0.f ? au * (1.0f / 7.0f) : 1.0f, iu = 1.0f / su_, sv_ = av > 0.f ? av * (1.0f / 6.0f) : 1.0f, iv = 1.0f / sv_;
            unsigned d[2] = {0u, 0u};
#pragma unroll
            for (int i = 0; i < 16; ++i) { const int q = (int)rintf(fminf(fmaxf(vu[r][i >> 2][i & 3] * iu, -7.0f), 7.0f)); d[i >> 3] |= ((unsigned)q & 15u) << (4 * (i & 7)); }
            unsigned d0 = 0u, d1 = 0u;
            d0 = __builtin_amdgcn_cvt_scalef32_pk_fp4_f32(d0, vv[r][0][0] * iv, vv[r][0][1] * iv, 1.0f, 0); d0 = __builtin_amdgcn_cvt_scalef32_pk_fp4_f32(d0, vv[r][0][2] * iv, vv[r][0][3] * iv, 1.0f, 1);
            d0 = __builtin_amdgcn_cvt_scalef32_pk_fp4_f32(d0, vv[r][1][0] * iv, vv[r][1][1] * iv, 1.0f, 2); d0 = __builtin_amdgcn_cvt_scalef32_pk_fp4_f32(d0, vv[r][1][2] * iv, vv[r][1][3] * iv, 1.0f, 3);
            d1 = __builtin_amdgcn_cvt_scalef32_pk_fp4_f32(d1, vv[r][2][0] * iv, vv[r][2][1] * iv, 1.0f, 0); d1 = __builtin_amdgcn_cvt_scalef32_pk_fp4_f32(d1, vv[r][2][2] * iv, vv[r][2][3] * iv, 1.0f, 1);
            d1 = __builtin_amdgcn_cvt_scalef32_pk_fp4_f32(d1, vv[r][3][0] * iv, vv[r][3][1] * iv, 1.0f, 2); d1 = __builtin_amdgcn_cvt_scalef32_pk_fp4_f32(d1, vv[r][3][2] * iv, vv[r][3][3] * iv, 1.0f, 3);
            *(u32x4*)(dst + (size_t)(row0 + r) * TROWX + lane * 16) = (u32x4){d[0], d[1], d0, d1};
            if (lane == 0) { scu[row0 + r] = su_; scv[row0 + r] = sv_; }
        }
    }
}

#define DPP_ADD(v, ctrl) ((v) + __builtin_bit_cast(float, __builtin_amdgcn_update_dpp(0, __builtin_bit_cast(int, (v)), (ctrl), 0xf, 0xf, true)))
typedef int i32x4_t __attribute__((ext_vector_type(4)));
constexpr int GT = 2;
typedef int v8i_t __attribute__((ext_vector_type(8)));
typedef int v2i_t __attribute__((ext_vector_type(2)));
struct GSet { u32x2 uq[4]; u32x2 vq[4]; };
__device__ __forceinline__ void gather_issue(GSet& S, int bt, int lane, const unsigned char* pu, const unsigned char* pv, const LAS int* etok) {
    const i32x4_t ev = *(const LAS i32x4_t*)(etok + bt * 4);
    const int es[4] = {ev.x, ev.y, ev.z, ev.w};
#pragma unroll
    for (int k = 0; k < 2; ++k) {
        const unsigned f0 = (unsigned)es[2 * k] * (unsigned)TROWX + (unsigned)lane * 16u, f1 = (unsigned)es[2 * k + 1] * (unsigned)TROWX + (unsigned)lane * 16u;
        const u32x4 r0 = *(const u32x4*)(pu + f0), r1 = *(const u32x4*)(pu + f1);
        S.uq[2 * k] = (u32x2){r0.x, r0.y}; S.vq[2 * k] = (u32x2){r0.z, r0.w}; S.uq[2 * k + 1] = (u32x2){r1.x, r1.y}; S.vq[2 * k + 1] = (u32x2){r1.z, r1.w};
    }
}
constexpr int GV_ROW = 520;
constexpr int GV_BYTES = 16 * GV_ROW, GC_BYTES = 96;
__device__ __forceinline__ float gather_udot(const GSet& S, const unsigned (&hd)[4], LAS unsigned char* vrow) {
    int d[4];
#pragma unroll
    for (int k = 0; k < 4; ++k) {
        const int q0 = (int)S.uq[k].x, q1 = (int)S.uq[k].y;
        int a1, a2;
        asm("v_dot8_i32_i4 %0, %1, %2, 0" : "=v"(a1) : "v"(q0), "v"(hd[0]));
        asm("v_dot8_i32_i4 %0, %1, %2, 0" : "=v"(a2) : "v"(q0), "v"(hd[2]));
        a1 = __builtin_amdgcn_sdot8(q1, (int)hd[1], a1, false); a2 = __builtin_amdgcn_sdot8(q1, (int)hd[3], a2, false);
        d[k] = (a1 << 4) + a2;
    }
#pragma unroll
    for (int k = 0; k < 4; ++k) *(LAS u32x2*)(vrow + k * GV_ROW) = S.vq[k];
    int e2[2], f1;
#pragma unroll
    for (int k = 0; k < 2; ++k) { auto r = __builtin_amdgcn_permlane16_swap((unsigned)d[k], (unsigned)d[k + 2], false, false); e2[k] = (int)r[0] + (int)r[1]; }
    { auto r = __builtin_amdgcn_permlane32_swap((unsigned)e2[0], (unsigned)e2[1], false, false); f1 = (int)r[0] + (int)r[1]; }
    f1 += __builtin_amdgcn_update_dpp(0, f1, 0xB1, 0xf, 0xf, true); f1 += __builtin_amdgcn_update_dpp(0, f1, 0x4E, 0xf, 0xf, true);
    f1 += __builtin_amdgcn_update_dpp(0, f1, 0x124, 0xf, 0xf, true); f1 += __builtin_amdgcn_update_dpp(0, f1, 0x128, 0xf, 0xf, true);
    return (float)f1;
}
#define DPP_MAX(v, ctrl) fmaxf((v), __builtin_bit_cast(float, __builtin_amdgcn_update_dpp(0, __builtin_bit_cast(int, (v)), (ctrl), 0xf, 0xf, true)))
__device__ __forceinline__ void gather_vpart(float f0, float f1, float f2, float f3, int lane, int kslot, const LAS float* lg  ,
                                             const LAS unsigned char* vrd  , LAS unsigned char* cb, int aoff1, int aoff2, f32x4 (&acc)[8]) {
    const int q = (lane >> 2) & 3, e16 = 4 * q + kslot;
    const float fs = q == 0 ? f0 : q == 1 ? f1 : q == 2 ? f2 : f3;
    const float cv = lg[e16] * gelu_erf(fs * lg[GT * 128 + e16]);
    float mx = fabsf(cv);
    mx = DPP_MAX(mx, 0x124); mx = DPP_MAX(mx, 0x128);
    { auto r = __builtin_amdgcn_permlane16_swap(__float_as_uint(mx), __float_as_uint(mx), false, false); mx = fmaxf(__uint_as_float(r[0]), __uint_as_float(r[1])); }
    { auto r = __builtin_amdgcn_permlane32_swap(__float_as_uint(mx), __float_as_uint(mx), false, false); mx = fmaxf(__uint_as_float(r[0]), __uint_as_float(r[1])); }
    int E = (int)((__float_as_uint(mx) >> 23) & 0xffu); E = E < 8 ? 8 : E;
    const float x = cv * __uint_as_float((unsigned)(255 - E) << 23);
    const unsigned p1 = __builtin_amdgcn_cvt_scalef32_pk_fp4_f32(0u, x, 0.f, 1.0f, 0);
    const float r1 = x - __builtin_amdgcn_cvt_scalef32_pk_f32_fp4(p1, 1.0f, 0)[0];
    const unsigned p2 = __builtin_amdgcn_cvt_scalef32_pk_fp4_f32(0u, r1, 0.f, 1.0f, 0);
    const float y = (r1 - __builtin_amdgcn_cvt_scalef32_pk_f32_fp4(p2, 1.0f, 0)[0]) * 16.0f;
    const unsigned p3 = __builtin_amdgcn_cvt_scalef32_pk_fp4_f32(0u, y, 0.f, 1.0f, 0);
    const float r3 = y - __builtin_amdgcn_cvt_scalef32_pk_f32_fp4(p3, 1.0f, 0)[0];
    const unsigned p4 = __builtin_amdgcn_cvt_scalef32_pk_fp4_f32(0u, r3, 0.f, 1.0f, 0);
    const unsigned codes = (p1 & 15u) | ((p2 & 15u) << 8) | ((p3 & 15u) << 16) | ((p4 & 15u) << 24);
    { auto r = __builtin_amdgcn_permlane32_swap(codes, codes, false, false);
      const unsigned w = codes | ((r[0] ^ r[1] ^ codes) << 4);
      if (lane < 32 && (lane & 3) == 0) {
          LAS unsigned char* tb = cb + 8 + 2 * q + ((lane >> 4) & 1);
          tb[0] = (unsigned char)w; tb[16] = (unsigned char)(w >> 8); tb[32] = (unsigned char)(w >> 16); tb[48] = (unsigned char)(w >> 24);
      } }
    const u32x2 a10 = *(const LAS u32x2*)(cb + aoff1), a11 = *(const LAS u32x2*)(cb + aoff1 + 8), a20 = *(const LAS u32x2*)(cb + aoff2), a21 = *(const LAS u32x2*)(cb + aoff2 + 8);
    const v8i_t A1 = {(int)a10.x, (int)a10.y, (int)a11.x, (int)a11.y, 0, 0, 0, 0}, A2 = {(int)a20.x, (int)a20.y, (int)a21.x, (int)a21.y, 0, 0, 0, 0};
    const int sa1 = (E - 1) * 0x01010101, sa2 = (E - 5) * 0x01010101;
#pragma unroll
    for (int m = 0; m < 8; ++m) {
        const v2i_t t0 = __builtin_amdgcn_ds_read_tr4_b64_v2i32((LAS v2i_t*)(vrd + 16 * m)), t1 = __builtin_amdgcn_ds_read_tr4_b64_v2i32((LAS v2i_t*)(vrd + 16 * m + 8));
        const v8i_t B = {t0.x, t0.y, t1.x, t1.y, 0, 0, 0, 0};
        acc[m] = __builtin_amdgcn_mfma_scale_f32_16x16x128_f8f6f4(A1, B, acc[m], 4, 4, 0, sa1, 0, 0x7F7F7F7F);
        acc[m] = __builtin_amdgcn_mfma_scale_f32_16x16x128_f8f6f4(A2, B, acc[m], 4, 4, 0, sa2, 0, 0x7F7F7F7F);
    }
}
__device__ __forceinline__ void xcd_pace(unsigned* bar, volatile LAS unsigned* st);
constexpr int GNS = 8, GBPS = 32 / GNS, GSHIFT = 11;
constexpr int GATH_LDS_WAVE = GT * 128 * 12 + GV_BYTES + GC_BYTES;
#define GATH_SEG(J, NJ, nbt) { \
        const LAS int* le_ = lse + (J) * 128; const LAS int* ne_ = lse + (NJ) * 128; \
        gather_issue(D, GBPS * c + 3, lane, pu, pv, le_); \
        const float f0_ = hsc[J] * gather_udot(A, hd[J], vwr); \
        gather_issue(A, (nbt), lane, pu, pv, ne_); \
        const float f1_ = hsc[J] * gather_udot(B, hd[J], vwr + 4 * GV_ROW); \
        gather_issue(B, (nbt) + 1, lane, pu, pv, ne_); \
        const float f2_ = hsc[J] * gather_udot(C, hd[J], vwr + 8 * GV_ROW); \
        gather_issue(C, (nbt) + 2, lane, pu, pv, ne_); \
        const float f3_ = hsc[J] * gather_udot(D, hd[J], vwr + 12 * GV_ROW); \
        gather_vpart(f0_, f1_, f2_, f3_, lane, kslot, lsg + (J) * 128 + 16 * c, vrd, cb, aoff1, aoff2, acc[J]); }
__device__ void ph_peer_gather(const bf16* h2, const unsigned char* pu, const unsigned char* pv, const float* su, const float* sv,
                               const int* eidx, const float* egate, const bf16* xin  , const float* gate  , float* xout, LAS unsigned char* lds, unsigned* pace_bar, volatile LAS unsigned* pace_st, int bid, int nb,
                               bf16* xmid  ) {
    const int lane0 = ltid() & 63, w = __builtin_amdgcn_readfirstlane(ltid() >> 6);
    LAS int* lse = (LAS int*)(lds + w * GATH_LDS_WAVE); LAS float* lsg = (LAS float*)(lds + w * GATH_LDS_WAVE + GT * 128 * 4);
    LAS unsigned char* vb = lds + w * GATH_LDS_WAVE + GT * 128 * 12; LAS unsigned char* cb = vb + GV_BYTES;
    if (lane0 < GC_BYTES / 4) ((LAS unsigned*)cb)[lane0] = 0u;
    for (int t0 = (bid * 8 + w) * GT; t0 < MT; t0 += nb * 8 * GT) {
        int lane = lane0; asm volatile("" : "+v"(lane));
        const int row = lane >> 4;
        const int kslot = 2 * (row & 1) + (row >> 1);
        const int b = t0 >> 11;
        LAS unsigned char* vwr = vb + lane * 8;
        const LAS unsigned char* vrd = vb + (lane & 15) * GV_ROW + 128 * row;
        const int ai = lane & 15, au = (ai < 8 ? 1 : 3), nz = ((ai & 7) >> 1) == row;
        const int aoff1 = nz ? 8 * (au - (ai & 1)) : 64, aoff2 = nz ? 8 * (au + 4 - (ai & 1)) : 64;
        unsigned hd[GT][4]; float hsc[GT]; f32x4 acc[GT][8];
#pragma unroll
        for (int j = 0; j < GT; ++j) {
            const int t = t0 + j;
            const int e0 = eidx[(size_t)t * 128 + lane], e1 = eidx[(size_t)t * 128 + 64 + lane];
            const float g0 = egate[(size_t)t * 128 + lane], g1 = egate[(size_t)t * 128 + 64 + lane];
            const int k0 = e0 >> GSHIFT, k1 = e1 >> GSHIFT;
            int off = 0, d0 = 0, d1 = 0;
#pragma unroll
            for (int s = 0; s < GNS; ++s) {
                const unsigned long long m0 = __ballot(k0 == s), m1 = __ballot(k1 == s);
                const int r0 = (int)__builtin_amdgcn_mbcnt_hi((unsigned)(m0 >> 32), __builtin_amdgcn_mbcnt_lo((unsigned)m0, 0u));
                const int r1 = (int)__builtin_amdgcn_mbcnt_hi((unsigned)(m1 >> 32), __builtin_amdgcn_mbcnt_lo((unsigned)m1, 0u));
                const int c0 = __builtin_popcountll(m0);
                if (k0 == s) d0 = off + r0;
                if (k1 == s) d1 = off + c0 + r1;
                off += c0 + __builtin_popcountll(m1);
            }
            const float s0 = egate[8 * 1024 * 1024 + (size_t)t * 128 + lane], s1 = egate[8 * 1024 * 1024 + (size_t)t * 128 + 64 + lane];
            lse[j * 128 + d0] = e0; lsg[j * 128 + d0] = g0; lse[j * 128 + d1] = e1; lsg[j * 128 + d1] = g1;
            lsg[GT * 128 + j * 128 + d0] = s0; lsg[GT * 128 + j * 128 + d1] = s1;
            const u32x4 u0 = *(const u32x4*)(h2 + (size_t)t * DM + lane * 16), u1 = *(const u32x4*)(h2 + (size_t)t * DM + lane * 16 + 8);
            {
                float hf[16];
#pragma unroll
                for (int i = 0; i < 4; ++i) { hf[2 * i] = __uint_as_float(u0[i] << 16); hf[2 * i + 1] = __uint_as_float(u0[i] & 0xffff0000u); hf[8 + 2 * i] = __uint_as_float(u1[i] << 16); hf[8 + 2 * i + 1] = __uint_as_float(u1[i] & 0xffff0000u); }
                float mh = 0.f;
#pragma unroll
                for (int i = 0; i < 16; ++i) mh = fmaxf(mh, fabsf(hf[i]));
                mh = wave_max(mh);
                int Eh = (int)((__float_as_uint(mh) >> 23) & 0xffu); Eh = Eh < 8 ? 8 : Eh;
                const float up = __uint_as_float((unsigned)(255 - Eh) << 23);
                hsc[j] = __uint_as_float((unsigned)(Eh - 5) << 23);
                unsigned p1[2] = {0u, 0u}, p2[2] = {0u, 0u};
#pragma unroll
                for (int i = 0; i < 16; ++i) {
                    const float x = hf[i] * up, r1 = rintf(x);
                    int q2 = (int)rintf((x - r1) * 16.0f); q2 = q2 > 7 ? 7 : q2;
                    p1[i >> 3] |= ((unsigned)(int)r1 & 15u) << (4 * (i & 7)); p2[i >> 3] |= ((unsigned)q2 & 15u) << (4 * (i & 7));
                }
                hd[j][0] = p1[0]; hd[j][1] = p1[1]; hd[j][2] = p2[0]; hd[j][3] = p2[1];
            }
#pragma unroll
            for (int i = 0; i < 8; ++i) acc[j][i] = (f32x4){0.f, 0.f, 0.f, 0.f};
        }
        GSet A, B, C, D;
        gather_issue(A, 0, lane, pu, pv, lse); gather_issue(B, 1, lane, pu, pv, lse); gather_issue(C, 2, lane, pu, pv, lse);
#pragma unroll 1
        for (int c = 0; c < GNS; ++c) {
            GATH_SEG(0, 1, GBPS * c)
            GATH_SEG(1, 0, c < GNS - 1 ? GBPS * c + GBPS : 0)
        }
#pragma unroll
        for (int j = 0; j < GT; ++j) {
            const int t = t0 + j;
            LAS float* ob = (LAS float*)vb;
            const int nbase = 512 * (row & 1) + 32 * (row >> 1) + (lane & 15);
#pragma unroll
            for (int pm = 0; pm < 4; ++pm)
#pragma unroll
                for (int r = 0; r < 4; ++r) {
                    auto sw = __builtin_amdgcn_permlane32_swap(__float_as_uint(acc[j][2 * pm][r]), __float_as_uint(acc[j][2 * pm + 1][r]), false, false);
                    ob[nbase + 256 * (r >> 1) + 64 * pm + 16 * (r & 1)] = __uint_as_float(sw[0]) + __uint_as_float(sw[1]);
                }
#pragma unroll
            for (int i = 0; i < 4; ++i) {
                const int cc = i * 256 + lane * 4;
                const f32x4 a = *(const LAS f32x4*)(ob + cc);
                const u32x2 xq = *(const u32x2*)(xin + (size_t)t * DM + cc); const f32x4 gt = *(const f32x4*)(gate + (size_t)b * 6144 + cc);
                const f32x4 xi = {__uint_as_float(xq.x << 16), __uint_as_float(xq.x & 0xffff0000u), __uint_as_float(xq.y << 16), __uint_as_float(xq.y & 0xffff0000u)};
                f32x4 o;
#pragma unroll
                for (int e = 0; e < 4; ++e) o[e] = xi[e] + gt[e] * a[e];
                if (xmid) { u32x2 pk; pk.x = pk2(o[0], o[1]); pk.y = pk2(o[2], o[3]); *(u32x2*)(xmid + (size_t)t * DM + cc) = pk; }
                else __builtin_nontemporal_store(o, (f32x4*)(xout + (size_t)t * DM + cc));
            }
        }
    }
}

#define XB_TMO      128
#define XB_XCNT(j)  (256  + 64 * (j))
#define XB_XSUB(j)  (1280 + 64 * (j))
#define XB_XGEN(j)  (2304 + 64 * (j))
#define XB_TOP      3328
#define XB_TOPGEN   3392
#define XCD_BAR_WORDS 3456
#define XB_SPIN_CAP (1u << 18)

__device__ __forceinline__ unsigned xb_ld(unsigned* p)              { return __hip_atomic_load(p, __ATOMIC_RELAXED, __HIP_MEMORY_SCOPE_AGENT); }
__device__ __forceinline__ unsigned xb_add(unsigned* p, unsigned v) { return __hip_atomic_fetch_add(p, v, __ATOMIC_RELAXED, __HIP_MEMORY_SCOPE_AGENT); }
__device__ __forceinline__ unsigned xb_xcc_id() { return (unsigned)__builtin_amdgcn_s_getreg((3 << 11) | 20) & 0xFu; }
#define XB_SPIN(cond, bar) do { unsigned _sp = 0; while (cond) { __builtin_amdgcn_s_sleep(1); \
    if ((++_sp & 255u) == 0u) { if (xb_ld(&(bar)[XB_TMO])) break; if (_sp > XB_SPIN_CAP) { atomicAdd(&(bar)[XB_TMO], 1u); break; } } } } while (0)

struct XcdBarrier {
    unsigned* bar; unsigned x;
    volatile LAS unsigned* st;
};

__device__ __forceinline__ XcdBarrier xcd_barrier_post(unsigned* bar, volatile LAS unsigned* st) {
    XcdBarrier b; b.bar = bar; b.x = xb_xcc_id(); b.st = st;
    if (threadIdx.x == 0) (void)xb_add(&bar[XB_XCNT(b.x)], 1u);
    return b;
}
__device__ __forceinline__ void xcd_barrier_complete(unsigned* bar, unsigned x, unsigned& nloc, unsigned& nx) {
    const unsigned G = gridDim.x * gridDim.y * gridDim.z;
    unsigned sum, cnt, mine, sp = 0u;
    for (;;) {
        sum = 0u; cnt = 0u; mine = 0u;
#pragma unroll
        for (unsigned j = 0; j < 16; ++j) { const unsigned c = xb_ld(&bar[XB_XCNT(j)]); sum += c; cnt += (c > 0u) ? 1u : 0u; mine = (j == x) ? c : mine; }
        if (sum == G) break;
        __builtin_amdgcn_s_sleep(1);
        if ((++sp & 255u) == 0u) { if (xb_ld(&bar[XB_TMO])) break; if (sp > XB_SPIN_CAP) { atomicAdd(&bar[XB_TMO], 1u); break; } }
    }
    nloc = mine > 0u ? mine : 1u; nx = cnt > 0u ? cnt : 1u;
}

__device__ __forceinline__ void xcd_barrier(const XcdBarrier& b) {
    asm volatile("s_waitcnt vmcnt(0)" ::: "memory");
    __syncthreads();
    if (threadIdx.x == 0) {
        unsigned* bar = b.bar;
        __builtin_amdgcn_s_waitcnt(0);
        unsigned nloc = b.st[0], nx = b.st[1];
        if (nloc == 0u) { xcd_barrier_complete(bar, b.x, nloc, nx); b.st[0] = nloc; b.st[1] = nx; }
        const unsigned old = xb_add(&bar[XB_XSUB(b.x)], 1u);
        const unsigned gen = old / nloc;
        if (old + 1u == (gen + 1u) * nloc) {
            __builtin_amdgcn_fence(__ATOMIC_RELEASE, "agent");
            asm volatile("s_waitcnt vmcnt(0)" ::: "memory");
            const unsigned og = xb_add(&bar[XB_TOP], 1u);
            const unsigned tg = og / nx;
            if (og + 1u == (tg + 1u) * nx) xb_add(&bar[XB_TOPGEN], 1u);
            else XB_SPIN(xb_ld(&bar[XB_TOPGEN]) == tg, bar);
            __builtin_amdgcn_fence(__ATOMIC_ACQUIRE, "agent");
            xb_add(&bar[XB_XGEN(b.x)], 1u);
            asm volatile("s_waitcnt vmcnt(0)" ::: "memory");
        } else {
            XB_SPIN(xb_ld(&bar[XB_XGEN(b.x)]) == gen, bar);
            __builtin_amdgcn_fence(__ATOMIC_ACQUIRE, "agent");
            asm volatile("s_waitcnt vmcnt(0)" ::: "memory");
        }
    }
    __syncthreads();
}


#define XB_PACE(j) (3584 + 64 * (j))
__device__ __forceinline__ void xcd_pace(unsigned* bar, volatile LAS unsigned* st) {
    __syncthreads();
    if (threadIdx.x == 0) {
        const unsigned nloc = st[0] ? st[0] : 1u, x = xb_xcc_id(), gen = st[4] + 1u;
        st[4] = gen;
        xb_add(&bar[XB_PACE(x)], 1u);
        unsigned sp = 0;
        while (xb_ld(&bar[XB_PACE(x)]) < gen * nloc) { __builtin_amdgcn_s_sleep(1); if (++sp > (1u << 16)) break; }
    }
    __syncthreads();
}
extern __shared__ __attribute__((aligned(16))) unsigned char dyn_lds[];
#ifndef REP_PREP
#define REP_PREP 1
#endif
#ifndef REP_ATTN
#define REP_ATTN 1
#endif
#ifndef REP_SEL
#define REP_SEL 1
#endif
#ifndef REP_GATH
#define REP_GATH 1
#endif
#ifndef REP_GEMM
#define REP_GEMM 1
#endif
#ifndef REP_ADALN
#define REP_ADALN 1
#endif
constexpr int LDS_BYTES = 147456;

template <class T> __device__ __forceinline__ T* karg(int byte_off) {
    const __attribute__((address_space(4))) char* base = (const __attribute__((address_space(4))) char*)__builtin_amdgcn_kernarg_segment_ptr();
    unsigned long long v = *(const __attribute__((address_space(4))) unsigned long long*)(base + byte_off);
    asm volatile("" : "+s"(v));
    return (T*)(__attribute__((address_space(1))) T*)v;
}
#define KIN(i) karg<const float>(8 * (i))
#define KOUT() karg<float>(168)
#define KWS() karg<unsigned char>(176)
static_assert(sizeof(Params) == 184, "Params layout");
template <class T> __device__ __forceinline__ T* launder(T* p) { size_t off = 0; asm volatile("" : "+s"(off)); return (T*)((unsigned char*)p + off); }
__global__ void __launch_bounds__(NT) mega_fwd(Params p) {
    cg::grid_group grid = cg::this_grid();
    const int bid = blockIdx.x, nb = gridDim.x;
    volatile LAS unsigned* bst = (volatile LAS unsigned*)((LAS unsigned char*)dyn_lds + LDS_BYTES - 64);
    if (ltid() < 16) bst[ltid()] = 0u;
    __syncthreads();
    const XcdBarrier xbar = xcd_barrier_post((unsigned*)(KWS() + WS_BAR), bst);
    for (int rep = 0; rep < REP_PREP; ++rep) {
        unsigned char* ws = KWS();
        float* tile = (float*)dyn_lds;
        ph_transpose(KIN(6), (bf16*)(ws + WS_WIN0), 1024, AB_IN, true, tile, bid, nb);
        ph_transpose(KIN(11), (bf16*)(ws + WS_WIN1), 1024, CD_IN, true, tile, bid, nb);
        ph_transpose(KIN(7), (bf16*)(ws + WS_WO0), 1024, 1024, false, tile, bid, nb);
        ph_transpose(KIN(12), (bf16*)(ws + WS_WO1), 1024, 1024, false, tile, bid, nb);
        ph_transpose(KIN(17), (bf16*)(ws + WS_WQ), 1024, PQ, false, tile, bid, nb);
        ph_transpose(KIN(17) + (size_t)1024 * PQ, (bf16*)(ws + WS_WQ) + (size_t)PQ * 1024, 1024, PQ, false, tile, bid, nb);
        ws = launder(ws);
        ph_tab_uv(KIN(19), KIN(20), ws + WS_PU, (float*)(ws + WS_PV), (float*)(ws + WS_PV + 1 * MiB), 2 * NEXP, bid, nb);
        ws = launder(ws);
        ph_mod(KIN(1), KIN(2), KIN(3), (float*)(ws + WS_MOD), (float*)dyn_lds, bid, nb);
        ph_rope_table((float*)(ws + WS_ROPE), bid, nb);
        for (int i = bid * NT + ltid(); i < NB * 8 * 8 * 64; i += nb * NT) ((float*)(ws + WS_KMEAN))[i] = 0.f;
    }
    grid.sync();
#pragma unroll 1
    for (int layer = 0; layer < 2; ++layer) {
        for (int rep = 0; rep < REP_ADALN; ++rep) {
            unsigned char* ws = KWS(); const float* mod = (const float*)(ws + WS_MOD) + (size_t)layer * 32 * 6144;
            if (layer == 0) ph_adaln<false>(KIN(0), KIN(4), mod + 0, mod + 1024, (bf16*)(ws + WS_HY), bid, nb);
            else ph_adaln<true>(ws + WS_X1 + 128 * MiB, KIN(4) + DM, mod + 0, mod + 1024, (bf16*)(ws + WS_HY), bid, nb);
        }
        xcd_barrier(xbar);
        for (int rep = 0; rep < REP_GEMM; ++rep) {
            unsigned char* ws = KWS();
            pg8::Gemm g{(const bf16*)(ws + WS_HY), (const bf16*)(ws + (layer == 0 ? WS_WIN0 : WS_WIN1)), MT, layer == 0 ? AB_IN : CD_IN, DM};
            pg8::StaticOrder S; S.init(g.M, g.N, nb, bid);
            pg8::EpiQKV e{(bf16*)(ws + WS_QKV), QKV_LD, (const float*)(ws + WS_ROPE), layer, layer == 0 ? KIN(9) : KIN(13), layer == 0 ? KIN(10) : KIN(14), KIN(15), KIN(16), (float*)(ws + WS_KMEAN)};
            pg8::gemm_phase<pg8::EpiQKV, pg8::StaticOrder, true, true>((LAS unsigned char*)dyn_lds, g, S, e);
        }
        xcd_barrier(xbar);
        for (int rep = 0; rep < REP_ATTN; ++rep) {
            unsigned char* ws = KWS();
            if (layer == 0) ph_attn0((const bf16*)(ws + WS_QKV), KIN(8), (bf16*)(ws + WS_HY), (LAS unsigned char*)dyn_lds, bid, nb);
            else ph_attn1((const bf16*)(ws + WS_QKV), (const float*)(ws + WS_KMEAN), (bf16*)(ws + WS_HY), (LAS unsigned char*)dyn_lds, bid, nb);
        }
        xcd_barrier(xbar);
        for (int rep = 0; rep < REP_GEMM; ++rep) {
            unsigned char* ws = KWS(); const float* mod = (const float*)(ws + WS_MOD) + (size_t)layer * 32 * 6144;
            pg8::Gemm g{(const bf16*)(ws + WS_HY), (const bf16*)(ws + (layer == 0 ? WS_WO0 : WS_WO1)), MT, DM, DM};
            pg8::StaticOrder S; S.init(g.M, g.N, nb, bid);
            if (layer == 0) { pg8::EpiResid<false> e{KIN(0), (pg8::bf16_t*)(ws + WS_X1), mod + 2048}; pg8::gemm_phase<pg8::EpiResid<false>, pg8::StaticOrder, true, true>((LAS unsigned char*)dyn_lds, g, S, e); }
            else { pg8::EpiResid<true> e{ws + WS_X1 + 128 * MiB, (pg8::bf16_t*)(ws + WS_X1), mod + 2048}; pg8::gemm_phase<pg8::EpiResid<true>, pg8::StaticOrder, true, true>((LAS unsigned char*)dyn_lds, g, S, e); }
        }
        xcd_barrier(xbar);
        for (int rep = 0; rep < REP_ADALN; ++rep) {
            unsigned char* ws = KWS(); const float* mod = (const float*)(ws + WS_MOD) + (size_t)layer * 32 * 6144;
            ph_adaln<true>(ws + WS_X1, KIN(5) + layer * DM, mod + 3072, mod + 4096, (bf16*)(ws + WS_QKV), bid, nb);
        }
        xcd_barrier(xbar);
        for (int rep = 0; rep < REP_GEMM; ++rep) {
            unsigned char* ws = KWS();
            pg8::Gemm g{(const bf16*)(ws + WS_QKV), (const bf16*)(ws + WS_WQ) + (size_t)layer * PQ * DM, MT, PQ, DM};
            pg8::StaticOrder S; S.init(g.M, g.N, nb, bid); pg8::EpiStore e{(bf16*)(ws + WS_QKV + 128 * MiB), PQ};
            pg8::gemm_phase<pg8::EpiStore, pg8::StaticOrder, true, true>((LAS unsigned char*)dyn_lds, g, S, e);
        }
        xcd_barrier(xbar);
        for (int rep = 0; rep < REP_SEL; ++rep) {
            unsigned char* ws = KWS();
            ph_peer_select((const bf16*)(ws + WS_QKV + 128 * MiB), KIN(18) + (size_t)layer * 2 * 128 * 128, (int*)(ws + WS_HY), (float*)(ws + WS_HY + 32 * MiB), (const float*)(ws + WS_PV) + layer * NEXP, (const float*)(ws + WS_PV + 1 * MiB) + layer * NEXP, (LAS unsigned char*)dyn_lds, bid, nb);
        }
        xcd_barrier(xbar);
        for (int rep = 0; rep < REP_GATH; ++rep) {
            unsigned char* ws = KWS(); const float* mod = (const float*)(ws + WS_MOD) + (size_t)layer * 32 * 6144;
            ph_peer_gather((const bf16*)(ws + WS_QKV), ws + WS_PU + (size_t)layer * NEXP * TROWX, ws + WS_PU + (size_t)layer * NEXP * TROWX,
                           (const float*)(ws + WS_PV) + layer * NEXP, (const float*)(ws + WS_PV + 1 * MiB) + layer * NEXP, (const int*)(ws + WS_HY), (const float*)(ws + WS_HY + 32 * MiB), (const bf16*)(ws + WS_X1), mod + 5120, KOUT(), (LAS unsigned char*)dyn_lds, (unsigned*)(ws + WS_BAR), bst, bid, nb, layer == 0 ? (bf16*)(ws + WS_X1 + 128 * MiB) : (bf16*)nullptr);
        }
        if (layer == 0) xcd_barrier(xbar);
    }
}

extern "C" void kernel_launch(void* const* d_in, const int* in_sizes, int n_in, void* d_out, int out_size, void* d_ws, size_t ws_size, hipStream_t stream) {
    if (n_in != 21 || ws_size < WS_END) { fprintf(stderr, "kernel_launch: bad args n_in=%d ws=%zu\n", n_in, ws_size); return; }
    static int grid_blocks = 0;
    if (!grid_blocks) {
        int dev = 0, cus = 0, per_cu = 0;
        (void)hipGetDevice(&dev);
        (void)hipDeviceGetAttribute(&cus, hipDeviceAttributeMultiprocessorCount, dev);
        (void)hipFuncSetAttribute((const void*)mega_fwd, hipFuncAttributeMaxDynamicSharedMemorySize, LDS_BYTES);
        (void)hipOccupancyMaxActiveBlocksPerMultiprocessor(&per_cu, (const void*)mega_fwd, NT, LDS_BYTES);
        if (per_cu < 1) { fprintf(stderr, "kernel_launch: occupancy query returned %d\n", per_cu); per_cu = 1; }
        if (per_cu > 1) per_cu = 1;
        grid_blocks = cus * per_cu;
    }
    Params p{};
    for (int i = 0; i < 21; ++i) p.in[i] = (const float*)d_in[i];
    p.out = (float*)d_out; p.ws = (unsigned char*)d_ws;
    (void)hipMemsetAsync((char*)d_ws + WS_BAR, 0, 16384, stream);
    void* args[] = {&p};
    hipError_t e = hipLaunchCooperativeKernel((const void*)mega_fwd, dim3(grid_blocks), dim3(NT), args, LDS_BYTES, stream);
    if (e != hipSuccess) fprintf(stderr, "cooperative launch failed: %s (grid %d)\n", hipGetErrorString(e), grid_blocks);
}
```

```cpp
#include <hip/hip_runtime.h>
#ifndef REP_A
#define REP_A 1
#endif
#ifndef REP_B
#define REP_B 1
#endif
#ifndef REP_C
#define REP_C 1
#endif
#ifndef REP_D
#define REP_D 1
#endif
#include <hip/hip_cooperative_groups.h>
namespace cg = cooperative_groups;
#include <cstdio>
#include <cstdint>
#include <type_traits>
#include <cmath>

typedef unsigned short bf16;
typedef short bf16x8 __attribute__((ext_vector_type(8)));
typedef float f32x4 __attribute__((ext_vector_type(4)));
typedef unsigned u32x4 __attribute__((ext_vector_type(4)));
typedef unsigned u32x2 __attribute__((ext_vector_type(2)));

constexpr int DM = 1024, NB = 32, SQ = 2048, MT = NB * SQ;
constexpr int HD = 64;
constexpr int AB_IN = 2304, CD_IN = 3072, QKV_LD = 3072;
constexpr int NEXP = 16384, PQ = 2048;
constexpr float EPS = 1e-6f;
constexpr int NT = 512;

constexpr size_t MiB = 1u << 20;
constexpr size_t WS_X1 = 0;
constexpr size_t WS_QKV = 256 * MiB;
constexpr size_t WS_HY = 640 * MiB;
constexpr size_t WS_PU = 768 * MiB;
constexpr size_t WS_PV = 832 * MiB;
constexpr size_t WS_WIN0 = 896 * MiB;
constexpr size_t WS_WIN1 = 901 * MiB;
constexpr size_t WS_WO0 = 907 * MiB;
constexpr size_t WS_WO1 = 909 * MiB;
constexpr size_t WS_WQ = 911 * MiB;
constexpr size_t WS_MOD = 919 * MiB;
constexpr size_t WS_ROPE = 921 * MiB;
constexpr size_t WS_KMEAN = 922 * MiB;
constexpr size_t WS_BAR = 923 * MiB;
constexpr size_t WS_SEL = 924 * MiB;
constexpr size_t WS_END = 1020 * MiB;

struct Params {
    const float* in[21];
    float* out;
    unsigned char* ws;
};

__device__ __forceinline__ int ltid() { int t = (int)__builtin_amdgcn_workitem_id_x(); asm volatile("" : "+v"(t)); return t; }
__device__ __forceinline__ float bf2f(unsigned b) { return __uint_as_float(b << 16); }
__device__ __forceinline__ unsigned f2bf(float f) { unsigned u = __float_as_uint(f); return (u + 0x7fffu + ((u >> 16) & 1u)) >> 16; }
__device__ __forceinline__ unsigned pk2(float lo, float hi) { return f2bf(lo) | (f2bf(hi) << 16); }
#define DPPV(v, ctrl) __builtin_bit_cast(float, __builtin_amdgcn_update_dpp(0, __builtin_bit_cast(int, (v)), (ctrl), 0xf, 0xf, true))
__device__ __forceinline__ float row16_sum(float v) { v += DPPV(v, 0xB1); v += DPPV(v, 0x4E); v += DPPV(v, 0x124); v += DPPV(v, 0x128); return v; }
__device__ __forceinline__ float rows_sum(float v) {
    { auto r = __builtin_amdgcn_permlane16_swap(__float_as_uint(v), __float_as_uint(v), false, false); v = __uint_as_float(r[0]) + __uint_as_float(r[1]); }
    { auto r = __builtin_amdgcn_permlane32_swap(__float_as_uint(v), __float_as_uint(v), false, false); v = __uint_as_float(r[0]) + __uint_as_float(r[1]); }
    return v;
}
__device__ __forceinline__ float wave_sum(float v) { return rows_sum(row16_sum(v)); }
__device__ __forceinline__ float wave_max(float v) {
    v = fmaxf(v, DPPV(v, 0xB1)); v = fmaxf(v, DPPV(v, 0x4E)); v = fmaxf(v, DPPV(v, 0x124)); v = fmaxf(v, DPPV(v, 0x128));
    { auto r = __builtin_amdgcn_permlane16_swap(__float_as_uint(v), __float_as_uint(v), false, false); v = fmaxf(__uint_as_float(r[0]), __uint_as_float(r[1])); }
    { auto r = __builtin_amdgcn_permlane32_swap(__float_as_uint(v), __float_as_uint(v), false, false); v = fmaxf(__uint_as_float(r[0]), __uint_as_float(r[1])); }
    return v;
}
__device__ __forceinline__ float gelu_erf(float x) {
    const float z = x * 0.70710678118654752f, az = fabsf(z);
    const float t = __builtin_amdgcn_rcpf(fmaf(0.3275911f, az, 1.0f));
    float pl = fmaf(t, 1.061405429f, -1.453152027f); pl = fmaf(t, pl, 1.421413741f); pl = fmaf(t, pl, -0.284496736f); pl = fmaf(t, pl, 0.254829592f); pl *= t;
    const float ex = __builtin_amdgcn_exp2f(az * (az * -1.4426950408889634f));
    const float er = copysignf(fmaf(-pl, ex, 1.0f), z);
    const float hx = 0.5f * x;
    return fmaf(hx, er, hx);
}

__device__ __forceinline__ int qkv_logical_col(int p) { return (p & ~255) | (((p >> 5) & 3) << 6) | (((p >> 7) & 1) << 5) | (p & 31); }
__device__ void ph_transpose(const float* W, bf16* Wt, int K, int N, bool permute, float* tile  , int bid, int nb) {
    const int tid = ltid();
    const int nkt = K / 64, nnt = N / 64;
    for (int it = bid; it < nkt * nnt; it += nb) {
        const int k0 = (it / nnt) * 64, n0 = (it % nnt) * 64;
        __syncthreads();
        for (int e = tid; e < 64 * 64; e += NT) { const int r = e >> 6, c = e & 63; const int nl = permute ? qkv_logical_col(n0 + c) : n0 + c; tile[r * 65 + c] = W[(size_t)(k0 + r) * N + nl]; }
        __syncthreads();
        {
            const int n = tid >> 3, k8 = (tid & 7) * 8;
            u32x4 v;
            v.x = pk2(tile[(k8 + 0) * 65 + n], tile[(k8 + 1) * 65 + n]);
            v.y = pk2(tile[(k8 + 2) * 65 + n], tile[(k8 + 3) * 65 + n]);
            v.z = pk2(tile[(k8 + 4) * 65 + n], tile[(k8 + 5) * 65 + n]);
            v.w = pk2(tile[(k8 + 6) * 65 + n], tile[(k8 + 7) * 65 + n]);
            *(u32x4*)(Wt + (size_t)(n0 + n) * K + k0 + k8) = v;
        }
    }
}
__device__ void ph_convert(const float* src, bf16* dst, size_t n, int bid, int nb) {
    const size_t n8 = n / 8;
    for (size_t i = (size_t)bid * NT + ltid(); i < n8; i += (size_t)nb * NT) {
        const f32x4 a = *(const f32x4*)(src + i * 8), b = *(const f32x4*)(src + i * 8 + 4);
        u32x4 v; v.x = pk2(a[0], a[1]); v.y = pk2(a[2], a[3]); v.z = pk2(b[0], b[1]); v.w = pk2(b[2], b[3]);
        *(u32x4*)(dst + i * 8) = v;
    }
}
#define MLAS __attribute__((address_space(3)))
typedef float modf16 __attribute__((ext_vector_type(16)));
constexpr int MOD_ROWP = 2048 + 16;
#define MOD_LOADH(dst, hf) _Pragma("unroll") for (int u_ = 0; u_ < 64; ++u_) dst[u_] = wp[(size_t)(((hf) * 4 + (u_ >> 4)) * 16 + (u_ & 7)) * 6144 + ((u_ >> 3) & 1) * 32];
#define MOD_STEPS(src, hf) _Pragma("unroll") for (int st_ = 0; st_ < 4; ++st_) { \
    const int kb_ = (w * 128 + ((hf) * 4 + st_) * 16 + 8 * kq) * 2; \
    const bf16x8 ah_ = *(const MLAS bf16x8*)(img + bq * MOD_ROWP + kb_), al_ = *(const MLAS bf16x8*)(img + (32 + bq) * MOD_ROWP + kb_); \
    _Pragma("unroll") for (int cb_ = 0; cb_ < 2; ++cb_) { \
        unsigned h_[4], l_[4]; \
        _Pragma("unroll") for (int p_ = 0; p_ < 4; ++p_) { const float x0_ = src[st_ * 16 + cb_ * 8 + 2 * p_], x1_ = src[st_ * 16 + cb_ * 8 + 2 * p_ + 1]; \
            const unsigned hh_ = pk2(x0_, x1_); h_[p_] = hh_; l_[p_] = pk2(x0_ - __uint_as_float(hh_ << 16), x1_ - __uint_as_float(hh_ & 0xffff0000u)); } \
        const bf16x8 bh_ = __builtin_bit_cast(bf16x8, (u32x4){h_[0], h_[1], h_[2], h_[3]}), bl_ = __builtin_bit_cast(bf16x8, (u32x4){l_[0], l_[1], l_[2], l_[3]}); \
        acc[cb_] = __builtin_amdgcn_mfma_f32_32x32x16_bf16(ah_, bh_, acc[cb_], 0, 0, 0); \
        acc[cb_] = __builtin_amdgcn_mfma_f32_32x32x16_bf16(ah_, bl_, acc[cb_], 0, 0, 0); \
        acc[cb_] = __builtin_amdgcn_mfma_f32_32x32x16_bf16(al_, bh_, acc[cb_], 0, 0, 0); } }
__device__ void ph_mod(const float* c, const float* ada_w, const float* ada_b, float* mod, float* lds_  , int bid, int nb) {
    const int tid = ltid(), lane = tid & 63, w = __builtin_amdgcn_readfirstlane(tid >> 6);
    const int bq = lane & 31, kq = lane >> 5;
    MLAS float* sl = (MLAS float*)lds_;
    MLAS unsigned char* img = (MLAS unsigned char*)lds_;
    for (int it = bid; it < 2 * 96; it += nb) {
        const int l = it / 96;
        const float* wp = ada_w + ((size_t)l * 1024 + w * 128 + 8 * kq) * 6144 + (it % 96) * 64 + bq;
        float wa[64], wb[64];
        MOD_LOADH(wa, 0)
        __syncthreads();
        for (int e = tid; e < 32 * 512; e += NT) {
            const int b = e >> 9, k2 = (e & 511) * 2;
            const float c0 = c[b * 1024 + k2], c1 = c[b * 1024 + k2 + 1];
            const float s0 = c0 / (1.0f + __expf(-c0)), s1 = c1 / (1.0f + __expf(-c1));
            const unsigned hh = pk2(s0, s1);
            *(MLAS unsigned*)(img + b * MOD_ROWP + k2 * 2) = hh;
            *(MLAS unsigned*)(img + (32 + b) * MOD_ROWP + k2 * 2) = pk2(s0 - __uint_as_float(hh << 16), s1 - __uint_as_float(hh & 0xffff0000u));
        }
        __syncthreads();
        MOD_LOADH(wb, 1)
        modf16 acc[2];
#pragma unroll
        for (int i = 0; i < 16; ++i) { acc[0][i] = 0.f; acc[1][i] = 0.f; }
        MOD_STEPS(wa, 0)
        MOD_STEPS(wb, 1)
        __syncthreads();
#pragma unroll
        for (int cb = 0; cb < 2; ++cb)
#pragma unroll
            for (int i = 0; i < 16; ++i) sl[(w * 32 + 4 * kq + 8 * (i >> 2) + (i & 3)) * 64 + cb * 32 + bq] = acc[cb][i];
        __syncthreads();
        for (int e = tid; e < 32 * 64; e += NT) {
            const int b = e >> 6, jj = e & 63; float s = 0.f;
#pragma unroll
            for (int ww = 0; ww < 8; ++ww) s += sl[(ww * 32 + b) * 64 + jj];
            const int jo = (it % 96) * 64 + jj;
            mod[((size_t)l * 32 + b) * 6144 + jo] = s + ada_b[l * 6144 + jo];
        }
    }
}
__device__ void ph_rope_table(float* rope, int bid, int nb) {
    for (int i = bid * NT + ltid(); i < SQ * 32; i += nb * NT) {
        const int t = i >> 5, f = i & 31;
        const float inv = powf(10000.0f, -(float)f / 32.0f);
        const float ang = (float)t * inv;
        const float rev = ang * 0.15915494309189535f;
        rope[i] = rev - floorf(rev);
    }
}

#define DPP_ADD0(v, ctrl) ((v) + __builtin_bit_cast(float, __builtin_amdgcn_update_dpp(0, __builtin_bit_cast(int, (v)), (ctrl), 0xf, 0xf, true)))
template <bool XBF> __device__ void ph_adaln(const void* xv, const float* g, const float* mod_shift  , const float* mod_scale, bf16* h, int bid, int nb) {
    const int lane = ltid() & 63, w = __builtin_amdgcn_readfirstlane(ltid() >> 6);
    typedef typename std::conditional<XBF, u32x2, f32x4>::type raw_t;
    raw_t rn[4][4];
#define ADALN_LOAD(tb) _Pragma("unroll") for (int r = 0; r < 4; ++r) _Pragma("unroll") for (int i = 0; i < 4; ++i) { \
        if constexpr (XBF) rn[r][i] = *(const raw_t*)((const bf16*)xv + (size_t)((tb) + r) * DM + i * 256 + lane * 4); \
        else rn[r][i] = *(const raw_t*)((const float*)xv + (size_t)((tb) + r) * DM + i * 256 + lane * 4); }
    { const int jf = (bid >> 3) * 8 + w; if (jf < 8192 / 4) { ADALN_LOAD((bid & 7) * 8192 + jf * 4) } }
    for (int j_ = (bid >> 3) * 8 + w; j_ < 8192 / 4; j_ += 256) {
        const int t0 = (bid & 7) * 8192 + j_ * 4;
        const int b = t0 >> 11;
        f32x4 v[4][4]; float ss[4];
#pragma unroll
        for (int r = 0; r < 4; ++r)
#pragma unroll
            for (int i = 0; i < 4; ++i) {
                if constexpr (XBF) { const u32x2 q = rn[r][i]; v[r][i] = (f32x4){__uint_as_float(q.x << 16), __uint_as_float(q.x & 0xffff0000u), __uint_as_float(q.y << 16), __uint_as_float(q.y & 0xffff0000u)}; }
                else v[r][i] = rn[r][i];
            }
        if (j_ + 256 < 8192 / 4) { ADALN_LOAD(t0 + 256 * 4) }
#pragma unroll
        for (int r = 0; r < 4; ++r) {
            float s = 0.f;
#pragma unroll
            for (int i = 0; i < 4; ++i) s += v[r][i][0] * v[r][i][0] + v[r][i][1] * v[r][i][1] + v[r][i][2] * v[r][i][2] + v[r][i][3] * v[r][i][3];
            s = DPP_ADD0(s, 0xB1); s = DPP_ADD0(s, 0x4E); s = DPP_ADD0(s, 0x124); s = DPP_ADD0(s, 0x128);
            { auto q = __builtin_amdgcn_permlane16_swap(__float_as_uint(s), __float_as_uint(s), false, false); s = __uint_as_float(q[0]) + __uint_as_float(q[1]); }
            { auto q = __builtin_amdgcn_permlane32_swap(__float_as_uint(s), __float_as_uint(s), false, false); s = __uint_as_float(q[0]) + __uint_as_float(q[1]); }
            ss[r] = rsqrtf(s * (1.0f / DM) + EPS);
        }
#pragma unroll
        for (int i = 0; i < 4; ++i) {
            const int c = i * 256 + lane * 4;
            const f32x4 gg = *(const f32x4*)(g + c), sc = *(const f32x4*)(mod_scale + (size_t)b * 6144 + c), sh = *(const f32x4*)(mod_shift + (size_t)b * 6144 + c);
            float a[4];
#pragma unroll
            for (int e = 0; e < 4; ++e) a[e] = gg[e] * (1.0f + sc[e]);
#pragma unroll
            for (int r = 0; r < 4; ++r) {
                float y[4];
#pragma unroll
                for (int e = 0; e < 4; ++e) y[e] = v[r][i][e] * ss[r] * a[e] + sh[e];
                u32x2 o; o.x = pk2(y[0], y[1]); o.y = pk2(y[2], y[3]);
                __builtin_nontemporal_store(o, (u32x2*)(h + (size_t)(t0 + r) * DM + c));
            }
        }
    }
}

namespace pg8 {
#define PG8_LAS __attribute__((address_space(3)))
typedef unsigned short bf16_t;
typedef short bf16x8 __attribute__((ext_vector_type(8)));
constexpr int BM = 256, BK = 64, HALF = 128, HTB = HALF * BK * 2  , STAGE_BYTES = 8 * HTB, NXCD = 8, WGM = 8;

__host__ __device__ __forceinline__ int lds_byte(int r, int c) { const int st = (r >> 4) * 2 + (c >> 5), rr = r & 15, cc = c & 31, ob = rr * 64 + cc * 2; return st * 1024 + (ob ^ (((ob >> 9) & 1) << 5)); }
__host__ __device__ __forceinline__ void stage_rc(int b, int& R, int& C) { const int st = b / 1024, sb = b % 1024, swz = sb ^ (((sb >> 9) & 1) << 5); R = (st >> 1) * 16 + swz / 64; C = (st & 1) * 32 + (swz % 64) / 2; }
__host__ __device__ __forceinline__ int perm32(int rho) { const int n = rho >> 4, i = rho & 15; return 8 * (i >> 2) + 4 * n + (i & 3); }

struct Unit { int pm, pn; };
struct Gemm { const bf16_t* A; const bf16_t* Bt; int M, N, K; };

struct StaticOrder {
    int nM, nN, nwg, G, c;
    __host__ __device__ void init(int M, int N, int G_, int c_) { nM = M / BM; nN = N / BM; nwg = nM * nN; G = G_; c = c_; }
    __host__ __device__ bool next(int i, Unit& u) const {
        const long L = (long)i * G + c; if (L >= nwg) return false;
        int wgid = (int)L; { const int q = nwg / NXCD, r = nwg % NXCD, xcd = wgid % NXCD, off = wgid / NXCD; wgid = (xcd < r ? xcd * (q + 1) : r * (q + 1) + (xcd - r) * q) + off; }
        const int nig = WGM * nN, gid = wgid / nig, fm = gid * WGM, gsz = (nM - fm) < WGM ? (nM - fm) : WGM;
        u.pm = fm + ((wgid % nig) % gsz); u.pn = (wgid % nig) / gsz; return true;
    }
    __device__ __forceinline__ void a_ready(const Unit&) const {}
    __device__ __forceinline__ void done(const Unit&) const {}
};

__device__ __forceinline__ unsigned cvt_pk_bf16(float lo, float hi) { unsigned r; asm volatile("v_cvt_pk_bf16_f32 %0, %1, %2" : "=v"(r) : "v"(lo), "v"(hi)); return r; }

struct EpiStore {
    static constexpr bool PERM = true, AFTER_DRAIN = false;
    bf16_t* O; int ldc;
    __device__ __forceinline__ void operator()(const f32x4 (&acc)[2][2][4][2], const Unit& u, int wr, int wc, int fr_, int fq_) const {
        int fr = fr_, fq = fq_; asm volatile("" : "+v"(fr), "+v"(fq));
        const int row0 = u.pm * BM + wr * 64 + fr, col0 = u.pn * BM + wc * 32 + 8 * fq;
#pragma unroll
        for (int ai = 0; ai < 2; ++ai)
#pragma unroll
            for (int m = 0; m < 4; ++m) { bf16_t* rowp = O + (size_t)(row0 + ai * HALF + m * 16) * ldc + col0;
#pragma unroll
                for (int bj = 0; bj < 2; ++bj) { const f32x4 v0 = acc[ai][bj][m][0], v1 = acc[ai][bj][m][1];
                    u32x4 w; w.x = cvt_pk_bf16(v0[0], v0[1]); w.y = cvt_pk_bf16(v0[2], v0[3]); w.z = cvt_pk_bf16(v1[0], v1[1]); w.w = cvt_pk_bf16(v1[2], v1[3]);
                    *(u32x4*)(rowp + bj * HALF) = w; } }
    }
};
struct EpiQKV {
    static constexpr bool PERM = true, AFTER_DRAIN = false;
    bf16_t* O; int ldc; const float* rope; int layer;
    const float* gq0; const float* gk0;
    const float* gq1; const float* gk1;
    float* kmean;
    __device__ __forceinline__ void operator()(const f32x4 (&acc)[2][2][4][2], const Unit& u, int wr, int wc, int fr_, int fq_) const {
        int fr = fr_, fq = fq_; asm volatile("" : "+v"(fr), "+v"(fq));
        const int hg = 4 * u.pn + wc;
        const float* gain = nullptr; bool km = false;
        if (layer == 0) { if (hg < 8) gain = gq0; else if (hg < 10) gain = gk0; }
        else { if (hg < 8) gain = gq0; else if (hg < 16) gain = gk0; else if (hg >= 24 && hg < 32) gain = gq1; else if (hg >= 32 && hg < 40) { gain = gk1; km = true; } }
        const int row0 = u.pm * BM + wr * 64 + fr, col0 = 64 * hg + 8 * fq;
        float g0[8], g1[8], cs0[8], cs1[8];
#pragma unroll
        for (int e = 0; e < 8; ++e) { g0[e] = gain ? gain[8 * fq + e] : 1.f; g1[e] = gain ? gain[32 + 8 * fq + e] : 1.f; cs0[e] = 0.f; cs1[e] = 0.f; }
#pragma unroll
        for (int ai = 0; ai < 2; ++ai)
#pragma unroll
            for (int m = 0; m < 4; ++m) {
                const int row = row0 + ai * HALF + m * 16;
                float v0[8], v1[8];
#pragma unroll
                for (int e = 0; e < 4; ++e) { v0[e] = acc[ai][0][m][0][e]; v0[4 + e] = acc[ai][0][m][1][e]; v1[e] = acc[ai][1][m][0][e]; v1[4 + e] = acc[ai][1][m][1][e]; }
                if (gain) {
                    float ss = 0.f;
#pragma unroll
                    for (int e = 0; e < 8; ++e) ss += v0[e] * v0[e] + v1[e] * v1[e];
                    ss = rows_sum(ss);
                    const float r = rsqrtf(ss * (1.0f / 64.0f) + 1e-6f);
                    const float* rp = rope + ((size_t)(row & 2047) * 32 + 8 * fq);
                    const f32x4 t0 = *(const f32x4*)(rp), t1 = *(const f32x4*)(rp + 4);
                    float cs[8], sn[8];
#pragma unroll
                    for (int e = 0; e < 4; ++e) { cs[e] = __builtin_amdgcn_cosf(t0[e]); sn[e] = __builtin_amdgcn_sinf(t0[e]); cs[4 + e] = __builtin_amdgcn_cosf(t1[e]); sn[4 + e] = __builtin_amdgcn_sinf(t1[e]); }
#pragma unroll
                    for (int e = 0; e < 8; ++e) { const float y0 = v0[e] * r * g0[e], y1 = v1[e] * r * g1[e]; v0[e] = y0 * cs[e] - y1 * sn[e]; v1[e] = y1 * cs[e] + y0 * sn[e]; }
                }
                u32x4 w0, w1;
                w0.x = cvt_pk_bf16(v0[0], v0[1]); w0.y = cvt_pk_bf16(v0[2], v0[3]); w0.z = cvt_pk_bf16(v0[4], v0[5]); w0.w = cvt_pk_bf16(v0[6], v0[7]);
                w1.x = cvt_pk_bf16(v1[0], v1[1]); w1.y = cvt_pk_bf16(v1[2], v1[3]); w1.z = cvt_pk_bf16(v1[4], v1[5]); w1.w = cvt_pk_bf16(v1[6], v1[7]);
                bf16_t* rowp = O + (size_t)row * ldc + col0;
                *(u32x4*)(rowp) = w0; *(u32x4*)(rowp + 32) = w1;
                if (km) {
#pragma unroll
                    for (int e = 0; e < 8; ++e) { cs0[e] += v0[e]; cs1[e] += v1[e]; }
                }
            }
        if (km) {
#pragma unroll
            for (int e = 0; e < 8; ++e) {
                cs0[e] = row16_sum(cs0[e]); cs1[e] = row16_sum(cs1[e]);
            }
            if (fr == 0) {
                float* kp = kmean + ((size_t)((u.pm >> 3) * 8 + (hg - 32)) * 8 + (u.pm & 7)) * 64 + 8 * fq;
#pragma unroll
                for (int e = 0; e < 8; ++e) { atomicAdd(kp + e, cs0[e] * (1.0f / 256.0f)); atomicAdd(kp + 32 + e, cs1[e] * (1.0f / 256.0f)); }
            }
        }
    }
};
template <bool XBF> struct EpiResid {
    static constexpr bool PERM = true, AFTER_DRAIN = false;
    const void* xin; bf16_t* xout; const float* gate;
    __device__ __forceinline__ void operator()(const f32x4 (&acc)[2][2][4][2], const Unit& u, int wr, int wc, int fr_, int fq_) const {
        int fr = fr_, fq = fq_; asm volatile("" : "+v"(fr), "+v"(fq));
        const int row0 = u.pm * BM + wr * 64 + fr, col0 = u.pn * BM + wc * 32 + 8 * fq;
        const float* gp = gate + (size_t)((u.pm * BM) >> 11) * 6144 + col0;
        f32x4 gq[2][2];
#pragma unroll
        for (int bj = 0; bj < 2; ++bj) { gq[bj][0] = *(const f32x4*)(gp + bj * HALF); gq[bj][1] = *(const f32x4*)(gp + bj * HALF + 4); }
        if constexpr (XBF) {
#pragma unroll
            for (int ai = 0; ai < 2; ++ai) {
                u32x4 q[2][4][2];
#pragma unroll
                for (int m = 0; m < 4; ++m)
#pragma unroll
                    for (int bj = 0; bj < 2; ++bj) q[ai][m][bj] = *(const u32x4*)((const bf16_t*)xin + (size_t)(row0 + ai * HALF + m * 16) * 1024 + col0 + bj * HALF);
#pragma unroll
                for (int m = 0; m < 4; ++m) { const int row = row0 + ai * HALF + m * 16;
                    bf16_t* xo = xout + (size_t)row * 1024 + col0;
#pragma unroll
                    for (int bj = 0; bj < 2; ++bj) {
                        const u32x4 qq = q[ai][m][bj];
                        const f32x4 x0 = (f32x4){__uint_as_float(qq.x << 16), __uint_as_float(qq.x & 0xffff0000u), __uint_as_float(qq.y << 16), __uint_as_float(qq.y & 0xffff0000u)};
                        const f32x4 x1 = (f32x4){__uint_as_float(qq.z << 16), __uint_as_float(qq.z & 0xffff0000u), __uint_as_float(qq.w << 16), __uint_as_float(qq.w & 0xffff0000u)};
                        const f32x4 a0 = acc[ai][bj][m][0], a1 = acc[ai][bj][m][1], g0 = gq[bj][0], g1 = gq[bj][1];
                        u32x4 w; w.x = cvt_pk_bf16(x0[0] + g0[0] * a0[0], x0[1] + g0[1] * a0[1]); w.y = cvt_pk_bf16(x0[2] + g0[2] * a0[2], x0[3] + g0[3] * a0[3]);
                        w.z = cvt_pk_bf16(x1[0] + g1[0] * a1[0], x1[1] + g1[1] * a1[1]); w.w = cvt_pk_bf16(x1[2] + g1[2] * a1[2], x1[3] + g1[3] * a1[3]);
                        *(u32x4*)(xo + bj * HALF) = w; } }
            }
        } else {
#pragma unroll
            for (int ps = 0; ps < 4; ++ps) { const int ai = ps >> 1, mb = (ps & 1) * 2;
                f32x4 xr[4][2][2];
#pragma unroll
                for (int m = mb; m < mb + 2; ++m)
#pragma unroll
                    for (int bj = 0; bj < 2; ++bj) { const float* xi = (const float*)xin + (size_t)(row0 + ai * HALF + m * 16) * 1024 + col0 + bj * HALF; xr[m][bj][0] = *(const f32x4*)xi; xr[m][bj][1] = *(const f32x4*)(xi + 4); }
#pragma unroll
                for (int m = mb; m < mb + 2; ++m) { const int row = row0 + ai * HALF + m * 16;
                    bf16_t* xo = xout + (size_t)row * 1024 + col0;
#pragma unroll
                    for (int bj = 0; bj < 2; ++bj) {
                        const f32x4 x0 = xr[m][bj][0], x1 = xr[m][bj][1];
                        const f32x4 a0 = acc[ai][bj][m][0], a1 = acc[ai][bj][m][1], g0 = gq[bj][0], g1 = gq[bj][1];
                        u32x4 w; w.x = cvt_pk_bf16(x0[0] + g0[0] * a0[0], x0[1] + g0[1] * a0[1]); w.y = cvt_pk_bf16(x0[2] + g0[2] * a0[2], x0[3] + g0[3] * a0[3]);
                        w.z = cvt_pk_bf16(x1[0] + g1[0] * a1[0], x1[1] + g1[1] * a1[1]); w.w = cvt_pk_bf16(x1[2] + g1[2] * a1[2], x1[3] + g1[3] * a1[3]);
                        *(u32x4*)(xo + bj * HALF) = w; } }
            }
        }
    }
};
template <class Epi, class Sched, bool ALIGN_EPI = false, bool SP2 = false>
__device__ __forceinline__ void gemm_phase(PG8_LAS unsigned char* lds, const Gemm g, const Sched& S, const Epi& E) {
    const int tid = ltid(), wid = __builtin_amdgcn_readfirstlane(tid >> 6), lane = tid & 63, wr = wid >> 2, wc = wid & 3, fr = lane & 15, fq = lane >> 4;
    const int K = g.K, nt = K / BK;
    unsigned voffA[2], voffB[2];
#pragma unroll
    for (int i = 0; i < 2; ++i) { int R, C; stage_rc(tid * 16 + i * 8192, R, C); const int Rb = Epi::PERM ? ((R & ~31) + perm32(R & 31)) : R;
        voffA[i] = (unsigned)(R * K + C) * 2u; voffB[i] = (unsigned)(Rb * K + C) * 2u; }
    const size_t kstep = (size_t)(BK * 2);
    const size_t hstep = (size_t)HALF * K * 2;
    const size_t tstep = 2 * hstep;
    const unsigned ldsw = (unsigned)wid * 1024u;
    const int aoff = lds_byte(wr * 64 + fr, fq * 8), boff = lds_byte(wc * 32 + fr, fq * 8);
#define PG8_SA(b, h) (((b) * 2 + (h)) * HTB)
#define PG8_SB(b, h) ((4 + (b) * 2 + (h)) * HTB)
#define PG8_STAGE(bufoff, gbase, voff) do { _Pragma("unroll") for (int _i = 0; _i < 2; ++_i) \
        __builtin_amdgcn_global_load_lds((const unsigned*)((const char*)(gbase) + (voff)[_i]), (PG8_LAS unsigned*)(lds + (bufoff) + ldsw + _i * 8192), 16, 0, 0); } while (0)
#define PG8_LDA(dst, b, h) do { _Pragma("unroll") for (int m = 0; m < 4; ++m) _Pragma("unroll") for (int k = 0; k < 2; ++k) dst[m][k] = *(const PG8_LAS bf16x8*)(lds + PG8_SA(b, h) + aoff + m * 2048 + k * 1024); } while (0)
#define PG8_LDB(dst, b, h) do { _Pragma("unroll") for (int n = 0; n < 2; ++n) _Pragma("unroll") for (int k = 0; k < 2; ++k) dst[n][k] = *(const PG8_LAS bf16x8*)(lds + PG8_SB(b, h) + boff + n * 2048 + k * 1024); } while (0)
#define PG8_MMA(ai, bj, At, Bt) do { __builtin_amdgcn_s_setprio(1); _Pragma("unroll") for (int m = 0; m < 4; ++m) _Pragma("unroll") for (int n = 0; n < 2; ++n) _Pragma("unroll") for (int k = 0; k < 2; ++k) \
        acc[ai][bj][m][n] = __builtin_amdgcn_mfma_f32_16x16x32_bf16(Bt[n][k], At[m][k], acc[ai][bj][m][n], 0, 0, 0); __builtin_amdgcn_s_setprio(0); } while (0)
#define PG8_WAIT_V(n) asm volatile("s_waitcnt vmcnt(" #n ")" ::: "memory")
#define PG8_WAIT_L(n) asm volatile("s_waitcnt lgkmcnt(" #n ")" ::: "memory")
#define PG8_BAR __builtin_amdgcn_s_barrier()
#define PG8_SCHED __builtin_amdgcn_sched_barrier(0)
    Unit cur, nxt; int ui = 0;
    if (!S.next(0, cur)) return;
    f32x4 acc[2][2][4][2];
#pragma unroll
    for (int a = 0; a < 2; ++a)
#pragma unroll
        for (int b = 0; b < 2; ++b)
#pragma unroll
            for (int m = 0; m < 4; ++m)
#pragma unroll
                for (int n = 0; n < 2; ++n) acc[a][b][m][n] = (f32x4){0.f, 0.f, 0.f, 0.f};
    bf16x8 At[4][2], B0[2][2], B1[2][2];
    const char* cA = (const char*)g.A + (size_t)cur.pm * tstep; const char* cB = (const char*)g.Bt + (size_t)cur.pn * tstep;
    S.a_ready(cur);
    if constexpr (SP2) {
        PG8_STAGE(PG8_SB(0, 0), cB, voffB); PG8_STAGE(PG8_SB(0, 1), cB + hstep, voffB); PG8_STAGE(PG8_SA(0, 0), cA, voffA); PG8_STAGE(PG8_SA(0, 1), cA + hstep, voffA);
        if (wr == 1) PG8_BAR;
        PG8_WAIT_V(2); PG8_BAR;
        PG8_STAGE(PG8_SB(1, 0), cB + kstep, voffB); PG8_STAGE(PG8_SA(1, 0), cA + kstep, voffA); PG8_STAGE(PG8_SB(1, 1), cB + hstep + kstep, voffB);
        PG8_WAIT_V(6); PG8_BAR;
    } else {
        PG8_STAGE(PG8_SB(0, 0), cB, voffB); PG8_STAGE(PG8_SA(0, 0), cA, voffA); PG8_STAGE(PG8_SB(0, 1), cB + hstep, voffB); PG8_STAGE(PG8_SA(0, 1), cA + hstep, voffA);
        if (wr == 1) PG8_BAR;
        PG8_WAIT_V(4); PG8_BAR;
        PG8_STAGE(PG8_SB(1, 0), cB + kstep, voffB); PG8_STAGE(PG8_SA(1, 0), cA + kstep, voffA); PG8_STAGE(PG8_SB(1, 1), cB + hstep + kstep, voffB);
        PG8_WAIT_V(6); PG8_BAR;
    }
    for (;;) {
        const bool has_next = S.next(ui + 1, nxt);
        const char* nA = has_next ? (const char*)g.A + (size_t)nxt.pm * tstep : cA; const char* nB = has_next ? (const char*)g.Bt + (size_t)nxt.pn * tstep : cB;
        for (int t = 0; t < nt; t += 2) {
            const bool last = (t == nt - 2);
            const char* a1 = cA + (size_t)(t + 1) * kstep;
            const char* a2 = last ? nA : cA + (size_t)(t + 2) * kstep; const char* b2 = last ? nB : cB + (size_t)(t + 2) * kstep;
            const char* a3 = a2 + kstep; const char* b3 = b2 + kstep;
            if (last && has_next) S.a_ready(nxt);
            if constexpr (SP2) {
            PG8_LDB(B0, 0, 0); PG8_LDB(B1, 0, 1); PG8_SCHED; PG8_LDA(At, 0, 0); PG8_STAGE(PG8_SA(1, 1), a1 + hstep, voffA);
            PG8_WAIT_V(8); PG8_WAIT_L(0); PG8_BAR; PG8_MMA(0, 0, At, B0); PG8_MMA(0, 1, At, B1); PG8_BAR; PG8_SCHED;
            PG8_LDA(At, 0, 1); PG8_STAGE(PG8_SB(0, 0), b2, voffB); PG8_STAGE(PG8_SB(0, 1), b2 + hstep, voffB); PG8_STAGE(PG8_SA(0, 0), a2, voffA);
            PG8_WAIT_V(8); PG8_WAIT_L(0); PG8_BAR; PG8_MMA(1, 0, At, B0); PG8_MMA(1, 1, At, B1); PG8_BAR; PG8_SCHED;
            PG8_LDB(B0, 1, 0); PG8_LDB(B1, 1, 1); PG8_SCHED; PG8_LDA(At, 1, 0); PG8_STAGE(PG8_SA(0, 1), a2 + hstep, voffA);
            PG8_WAIT_V(8); PG8_WAIT_L(0); PG8_BAR; PG8_MMA(0, 0, At, B0); PG8_MMA(0, 1, At, B1); PG8_BAR; PG8_SCHED;
            PG8_LDA(At, 1, 1); PG8_STAGE(PG8_SB(1, 0), b3, voffB); PG8_STAGE(PG8_SB(1, 1), b3 + hstep, voffB); PG8_STAGE(PG8_SA(1, 0), a3, voffA);
            PG8_WAIT_V(8); PG8_WAIT_L(0); PG8_BAR; PG8_MMA(1, 0, At, B0); PG8_MMA(1, 1, At, B1); PG8_BAR; PG8_SCHED;
            } else {
            PG8_LDB(B0, 0, 0); PG8_SCHED; PG8_LDA(At, 0, 0); PG8_STAGE(PG8_SA(1, 1), a1 + hstep, voffA);
            PG8_WAIT_L(8); PG8_BAR; PG8_WAIT_L(0); PG8_MMA(0, 0, At, B0); PG8_BAR; PG8_SCHED;
            PG8_LDB(B1, 0, 1); PG8_STAGE(PG8_SB(0, 0), b2, voffB);
            PG8_BAR; PG8_WAIT_L(0); PG8_MMA(0, 1, At, B1); PG8_BAR;
            PG8_LDA(At, 0, 1); PG8_STAGE(PG8_SA(0, 0), a2, voffA);
            PG8_BAR; PG8_WAIT_L(0); PG8_MMA(1, 0, At, B0); PG8_BAR; PG8_SCHED;
            PG8_STAGE(PG8_SB(0, 1), b2 + hstep, voffB);
            PG8_WAIT_V(6); PG8_BAR; PG8_MMA(1, 1, At, B1); PG8_BAR;
            PG8_LDB(B0, 1, 0); PG8_SCHED; PG8_LDA(At, 1, 0); PG8_STAGE(PG8_SA(0, 1), a2 + hstep, voffA);
            PG8_WAIT_L(8); PG8_BAR; PG8_WAIT_L(0); PG8_MMA(0, 0, At, B0); PG8_BAR; PG8_SCHED;
            PG8_LDB(B1, 1, 1); PG8_STAGE(PG8_SB(1, 0), b3, voffB);
            PG8_BAR; PG8_WAIT_L(0); PG8_MMA(0, 1, At, B1); PG8_BAR;
            PG8_LDA(At, 1, 1); PG8_STAGE(PG8_SA(1, 0), a3, voffA);
            PG8_BAR; PG8_WAIT_L(0); PG8_MMA(1, 0, At, B0); PG8_BAR; PG8_SCHED;
            PG8_STAGE(PG8_SB(1, 1), b3 + hstep, voffB);
            PG8_WAIT_V(6); PG8_BAR; PG8_MMA(1, 1, At, B1); PG8_BAR;
            }
        }
        if constexpr (ALIGN_EPI) { if (wr == 0) PG8_BAR; }
        if constexpr (!Epi::AFTER_DRAIN) { E(acc, cur, wr, wc, fr, fq); S.done(cur); }
        if (!has_next) break;
#pragma unroll
        for (int a = 0; a < 2; ++a)
#pragma unroll
            for (int b = 0; b < 2; ++b)
#pragma unroll
                for (int m = 0; m < 4; ++m)
#pragma unroll
                    for (int n = 0; n < 2; ++n) acc[a][b][m][n] = (f32x4){0.f, 0.f, 0.f, 0.f};
        cur = nxt; cA = nA; cB = nB; ++ui;
        if constexpr (ALIGN_EPI) { if (wr == 1) PG8_BAR; }
    }
    PG8_WAIT_V(0);
    if constexpr (!ALIGN_EPI) { if (wr == 0) PG8_BAR; }
    PG8_BAR;
    if constexpr (Epi::AFTER_DRAIN) { E.fused(acc, cur, wr, wc, fr, fq, lds, wid, lane); S.done(cur); }
#undef PG8_SA
#undef PG8_SB
#undef PG8_STAGE
#undef PG8_LDA
#undef PG8_LDB
#undef PG8_MMA
#undef PG8_WAIT_V
#undef PG8_WAIT_L
#undef PG8_BAR
#undef PG8_SCHED
}
}

typedef float f32x16 __attribute__((ext_vector_type(16)));
typedef short s16x4 __attribute__((ext_vector_type(4)));
typedef short v4i16_t __attribute__((ext_vector_type(4)));
typedef float f32x2_t __attribute__((ext_vector_type(2)));
typedef __bf16 bf16x2_t __attribute__((ext_vector_type(2)));
#define LAS __attribute__((address_space(3)))
constexpr int VROW = 144, VBUF = 32 * VROW;
constexpr int VROWV = 192, VBUFV = 32 * VROWV;
constexpr float L2E = 1.4426950408889634f, LN2 = 0.6931471805599453f;
constexpr float SC2 = 0.125f * L2E;

__device__ __forceinline__ int crow(int r, int hi) { return (r & 3) + 8 * (r >> 2) + 4 * hi; }
__device__ __forceinline__ unsigned cvtpk(float lo, float hi) { f32x2_t v = {lo, hi}; bf16x2_t b = __builtin_convertvector(v, bf16x2_t); return __builtin_bit_cast(unsigned, b); }
__device__ __forceinline__ float xhalf(float v, int hi) {
    auto r = __builtin_amdgcn_permlane32_swap(__float_as_uint(v), __float_as_uint(v), false, false);
    return __uint_as_float(hi ? r[0] : r[1]);
}
__device__ __forceinline__ s16x4 vtr(const LAS unsigned char* p) { return __builtin_bit_cast(s16x4, __builtin_amdgcn_ds_read_tr16_b64_v4i16((LAS v4i16_t*)p)); }

struct KVRegs { u32x4 k[4]; u32x4 v[4]; };
__device__ __forceinline__ void load_kv(KVRegs& R, const bf16* base, int kp0, int kst, int kcol, int vcol, int lane) {
#pragma unroll
    for (int j = 0; j < 4; ++j) {
        const int pos = kp0 + kst * (8 * j + (lane >> 3));
        const int pc = pos < SQ - 1 ? pos : SQ - 1;
        const bf16* rp = base + (size_t)pc * QKV_LD + (lane & 7) * 8;
        R.k[j] = *(const u32x4*)(rp + kcol); R.v[j] = *(const u32x4*)(rp + vcol);
    }
}
__device__ __forceinline__ void kv_stage(const KVRegs& R, LAS unsigned char* klds, LAS unsigned char* vlds, int lane) {
#pragma unroll
    for (int j = 0; j < 4; ++j) { const int r_ = 8 * j + (lane >> 3), c_ = (lane & 7) * 16; *(LAS u32x4*)(klds + r_ * VROW + c_) = R.k[j]; *(LAS u32x4*)(vlds + r_ * VROWV + c_) = R.v[j]; }
}
__device__ __forceinline__ f32x16 qk_tile(const LAS unsigned char* klds, const bf16x8 (&qf)[4], int r32, int hi) {
    f32x16 s = {0.f, 0.f, 0.f, 0.f, 0.f, 0.f, 0.f, 0.f, 0.f, 0.f, 0.f, 0.f, 0.f, 0.f, 0.f, 0.f};
#pragma unroll
    for (int k = 0; k < 4; ++k) { const bf16x8 kf = *(const LAS bf16x8*)(klds + r32 * VROW + (2 * k + hi) * 16); s = __builtin_amdgcn_mfma_f32_32x32x16_bf16(kf, qf[k], s, 0, 0, 0); }
    return s;
}
__device__ __forceinline__ void pv_tile(f32x16 (&o)[2], const f32x16& p, const LAS unsigned char* vlds, int lane) {
    const int g = lane >> 4, i = lane & 15, h = lane >> 5;
    const LAS unsigned char* vb = vlds + (4 * h + (i >> 2)) * VROWV + (16 * (g & 1) + 4 * (i & 3)) * 2;
#pragma unroll
    for (int s = 0; s < 2; ++s) {
        u32x4 pw; pw.x = cvtpk(p[8 * s], p[8 * s + 1]); pw.y = cvtpk(p[8 * s + 2], p[8 * s + 3]); pw.z = cvtpk(p[8 * s + 4], p[8 * s + 5]); pw.w = cvtpk(p[8 * s + 6], p[8 * s + 7]);
        const bf16x8 pb = __builtin_bit_cast(bf16x8, pw);
#pragma unroll
        for (int df = 0; df < 2; ++df) {
            const s16x4 lo = vtr(vb + (16 * s) * VROWV + df * 64), hh = vtr(vb + (16 * s + 8) * VROWV + df * 64);
            const bf16x8 va = (bf16x8){lo[0], lo[1], lo[2], lo[3], hh[0], hh[1], hh[2], hh[3]};
            o[df] = __builtin_amdgcn_mfma_f32_32x32x16_bf16(va, pb, o[df], 0, 0, 0);
        }
    }
}
__device__ __forceinline__ void load_q(bf16x8 (&qf)[4], const bf16* base, int qpos, int qcol, int hi) {
    const bf16* rp = base + (size_t)qpos * QKV_LD + qcol + 8 * hi;
#pragma unroll
    for (int k = 0; k < 4; ++k) qf[k] = *(const bf16x8*)(rp + 16 * k);
}
__device__ __forceinline__ void store_o(bf16* yrow, const f32x16 (&o)[2], float inv, int hi) {
#pragma unroll
    for (int df = 0; df < 2; ++df)
#pragma unroll
        for (int gp = 0; gp < 2; ++gp) {
            const int g = 2 * gp;
            const unsigned ax = cvtpk(o[df][4 * g] * inv, o[df][4 * g + 1] * inv), ay = cvtpk(o[df][4 * g + 2] * inv, o[df][4 * g + 3] * inv);
            const unsigned bx = cvtpk(o[df][4 * g + 4] * inv, o[df][4 * g + 5] * inv), by = cvtpk(o[df][4 * g + 6] * inv, o[df][4 * g + 7] * inv);
            auto rx = __builtin_amdgcn_permlane32_swap(ax, bx, false, false); auto ry = __builtin_amdgcn_permlane32_swap(ay, by, false, false);
            *(u32x4*)(yrow + 32 * df + 8 * (g + hi)) = (u32x4){rx[0], ry[0], rx[1], ry[1]};
        }
}
__device__ __forceinline__ void osm_tile(f32x16& s, float& m, float& l, f32x16 (&o)[2]) {
    float mx = s[0];
#pragma unroll
    for (int r = 1; r < 16; ++r) mx = fmaxf(mx, s[r]);
    { auto rr = __builtin_amdgcn_permlane32_swap(__float_as_uint(mx), __float_as_uint(mx), false, false); mx = fmaxf(__uint_as_float(rr[0]), __uint_as_float(rr[1])); }
    const float mn = fmaxf(m, mx);
    const float ms = (mn == -INFINITY) ? 0.f : mn;
    const float alpha = __builtin_amdgcn_exp2f((m - ms) * SC2);
    const float mc = ms * SC2;
    float ps = 0.f;
#pragma unroll
    for (int r = 0; r < 16; ++r) { s[r] = __builtin_amdgcn_exp2f(s[r] * SC2 - mc); ps += s[r]; }
    l = l * alpha + ps; m = mn;
    if (!__all(alpha == 1.0f)) {
#pragma unroll
        for (int df = 0; df < 2; ++df)
#pragma unroll
            for (int r = 0; r < 16; ++r) o[df][r] *= alpha;
    }
}
__device__ __forceinline__ void osm_tile2(f32x16& s0, f32x16& s1, float& m, float& l, f32x16 (&o)[2]) {
    float mx = fmaxf(s0[0], s1[0]);
#pragma unroll
    for (int r = 1; r < 16; ++r) mx = fmaxf(mx, fmaxf(s0[r], s1[r]));
    { auto rr = __builtin_amdgcn_permlane32_swap(__float_as_uint(mx), __float_as_uint(mx), false, false); mx = fmaxf(__uint_as_float(rr[0]), __uint_as_float(rr[1])); }
    const float mn = fmaxf(m, mx);
    const float ms = (mn == -INFINITY) ? 0.f : mn;
    const float alpha = __builtin_amdgcn_exp2f((m - ms) * SC2);
    const float mc = ms * SC2;
    float ps0 = 0.f, ps1 = 0.f;
#pragma unroll
    for (int r = 0; r < 16; ++r) { s0[r] = __builtin_amdgcn_exp2f(s0[r] * SC2 - mc); ps0 += s0[r]; s1[r] = __builtin_amdgcn_exp2f(s1[r] * SC2 - mc); ps1 += s1[r]; }
    l = l * alpha + (ps0 + ps1); m = mn;
    if (!__all(alpha == 1.0f)) {
#pragma unroll
        for (int df = 0; df < 2; ++df)
#pragma unroll
            for (int r = 0; r < 16; ++r) o[df][r] *= alpha;
    }
}
__device__ __forceinline__ void osm_tile2_onoff(f32x16& s0, f32x16& s1, bool on, float& m, float& l, f32x16 (&o)[2]) {
    float mx = fmaxf(s0[0], s1[0]);
#pragma unroll
    for (int r = 1; r < 16; ++r) mx = fmaxf(mx, fmaxf(s0[r], s1[r]));
    { auto rr = __builtin_amdgcn_permlane32_swap(__float_as_uint(mx), __float_as_uint(mx), false, false); mx = fmaxf(__uint_as_float(rr[0]), __uint_as_float(rr[1])); }
    mx = on ? mx : -INFINITY;
    const float mn = fmaxf(m, mx);
    const float ms = (mn == -INFINITY) ? 0.f : mn;
    const float alpha = __builtin_amdgcn_exp2f((m - ms) * SC2);
    const float mc = on ? ms * SC2 : INFINITY;
    float ps0 = 0.f, ps1 = 0.f;
#pragma unroll
    for (int r = 0; r < 16; ++r) { s0[r] = __builtin_amdgcn_exp2f(s0[r] * SC2 - mc); ps0 += s0[r]; s1[r] = __builtin_amdgcn_exp2f(s1[r] * SC2 - mc); ps1 += s1[r]; }
    l = l * alpha + (ps0 + ps1); m = mn;
    if (!__all(alpha == 1.0f)) {
#pragma unroll
        for (int df = 0; df < 2; ++df)
#pragma unroll
            for (int r = 0; r < 16; ++r) o[df][r] *= alpha;
    }
}
#define ZERO16 {0.f, 0.f, 0.f, 0.f, 0.f, 0.f, 0.f, 0.f, 0.f, 0.f, 0.f, 0.f, 0.f, 0.f, 0.f, 0.f}

struct AttnCtx {
    const bf16* base; int kcol, vcol, r32, hi, lane; LAS unsigned char* vlds; LAS unsigned char* klds; bf16x8 qf[4]; f32x16 o[2];
};
#define ATTN_STEP(SC, SL, T) { \
        if (SYNC) __builtin_amdgcn_s_barrier(); \
        { int kp_, ks_; const int tl_ = (T) + 2 < nt ? (T) + 2 : nt - 1; mx.pos(tl_, kp_, ks_); load_kv(SL, c.base, kp_, ks_, c.kcol, c.vcol, c.lane); } \
        kv_stage(SC, c.klds, c.vlds, c.lane); f32x16 s_ = qk_tile(c.klds, c.qf, c.r32, c.hi); \
        const bool stop_ = mx.process((T), s_, c); pv_tile(c.o, s_, c.vlds, c.lane); \
        if ((!SYNC && stop_) || (T) + 1 >= nt) break; }
template <class M, bool SYNC> __device__ __forceinline__ void attn_run(M& mx, AttnCtx& c) {
    const int nt = mx.nt;
    KVRegs S0, S1, S2;
    { int kp, ks; mx.pos(0, kp, ks); load_kv(S0, c.base, kp, ks, c.kcol, c.vcol, c.lane);
      mx.pos(1 < nt ? 1 : nt - 1, kp, ks); load_kv(S1, c.base, kp, ks, c.kcol, c.vcol, c.lane); }
    for (int t = 0;; t += 3) {
        ATTN_STEP(S0, S2, t)
        ATTN_STEP(S1, S0, t + 1)
        ATTN_STEP(S2, S1, t + 2)
    }
}
#define SH_BAR() asm volatile("s_waitcnt lgkmcnt(0)\n\ts_barrier" ::: "memory")
constexpr int SLOT_K = 64 * VROW, SLOT_BYTES = 64 * VROW + 64 * VROWV;
struct ShRegs { u32x4 a, b; };
__device__ __forceinline__ void sh_load(ShRegs& R, const bf16* base, int kp0, int kcol, int vcol, int w, int lane) {
    const int pos = kp0 + 4 * w + ((lane & 31) >> 3);
    const int pa = pos < SQ - 1 ? pos : SQ - 1, pb = pos + 32 < SQ - 1 ? pos + 32 : SQ - 1;
    const int col = ((lane >> 5) ? vcol : kcol) + (lane & 7) * 8;
    R.a = *(const u32x4*)(base + (size_t)pa * QKV_LD + col); R.b = *(const u32x4*)(base + (size_t)pb * QKV_LD + col);
}
__device__ __forceinline__ void sh_write(LAS unsigned char* slot, const ShRegs& R, int w, int lane) {
    const int row = 4 * w + ((lane & 31) >> 3);
    LAS unsigned char* p = slot + ((lane >> 5) ? SLOT_K + row * VROWV : row * VROW) + (lane & 7) * 16;
    *(LAS u32x4*)p = R.a; *(LAS u32x4*)(p + 32 * ((lane >> 5) ? VROWV : VROW)) = R.b;
}
#define SH_STEP(RW, RL, T) { \
        SH_BAR(); \
        { const int tl_ = (T) + 2 < nt ? (T) + 2 : nt - 1; sh_load(RL, c.base, mx.pos2(tl_), c.kcol, c.vcol, w, c.lane); } \
        sh_write(slots + (((T) + 1) & 1) * SLOT_BYTES, RW, w, c.lane); \
        if (mx.active2((T), w)) { LAS unsigned char* sl_ = slots + ((T) & 1) * SLOT_BYTES; \
            f32x16 s0_ = qk_tile(sl_, c.qf, c.r32, c.hi), s1_ = qk_tile(sl_ + 32 * VROW, c.qf, c.r32, c.hi); mx.process2((T), s0_, s1_, c); \
            pv_tile(c.o, s0_, sl_ + SLOT_K, c.lane); pv_tile(c.o, s1_, sl_ + SLOT_K + 32 * VROWV, c.lane); } \
        if ((T) + 1 >= nt) break; }
template <class M> __device__ __forceinline__ void attn_run_shared(M& mx, AttnCtx& c, LAS unsigned char* slots, int w) {
    const int nt = mx.nt2;
    ShRegs R0, R1, R2;
    sh_load(R0, c.base, mx.pos2(0), c.kcol, c.vcol, w, c.lane);
    sh_load(R1, c.base, mx.pos2(1 < nt ? 1 : nt - 1), c.kcol, c.vcol, w, c.lane);
    SH_BAR();
    sh_write(slots, R0, w, c.lane);
    for (int t = 0;; t += 3) {
        SH_STEP(R1, R2, t)
        SH_STEP(R2, R0, t + 1)
        SH_STEP(R0, R1, t + 2)
    }
}
struct MixA {
    int nt, k00, qpos; float m, l;
    __device__ __forceinline__ void pos(int idx, int& kp0, int& kst) const { kp0 = k00 + 32 * idx; kst = 1; }
    __device__ __forceinline__ bool process(int idx, f32x16& s, AttnCtx& c) {
        const int k0 = k00 + 32 * idx;
#pragma unroll
        for (int r = 0; r < 16; ++r) { const int dist = qpos - (k0 + crow(r, c.hi)); if (dist < 0 || dist > 127) s[r] = -INFINITY; }
        osm_tile(s, m, l, c.o); return false;
    }
};
__device__ void attn_A(const bf16* base, int hq, int q0, float sink, bf16* ybase, LAS unsigned char* vlds, int lane) {
    AttnCtx c; c.base = base; c.r32 = lane & 31; c.hi = lane >> 5; c.lane = lane; c.vlds = vlds; c.klds = vlds + VBUFV; c.kcol = 512 + (hq >> 2) * 64; c.vcol = 640 + (hq >> 2) * 64;
    c.o[0] = (f32x16)ZERO16; c.o[1] = (f32x16)ZERO16;
    MixA mx; mx.qpos = q0 + c.r32; mx.k00 = q0 - 128 > 0 ? q0 - 128 : 0; mx.nt = 5; mx.m = -INFINITY; mx.l = 0.f;
    load_q(c.qf, base, mx.qpos, hq * 64, c.hi);
    attn_run<MixA, true>(mx, c);
    float l = mx.l + xhalf(mx.l, c.hi);
    l += __builtin_amdgcn_exp2f(sink * L2E - mx.m * SC2);
    store_o(ybase + (size_t)mx.qpos * DM + hq * 64, c.o, 1.0f / l, c.hi);
}
struct MixB {
    int nt, q0, qpos; float carry;
    __device__ __forceinline__ void pos(int idx, int& kp0, int& kst) const { kp0 = q0 - 32 * idx; kst = 1; }
    __device__ __forceinline__ bool process(int idx, f32x16& s, AttnCtx& c) {
        const int k0 = q0 - 32 * idx, hi = c.hi;
        float lk[16], G[4], Gp[4];
#pragma unroll
        for (int r = 0; r < 16; ++r) {
            const float z = s[r] * 0.125f;
            const bool valid = (k0 + crow(r, hi)) < qpos;
            const float sp = fmaxf(z, 0.f) + LN2 * __builtin_amdgcn_logf(1.0f + __builtin_amdgcn_exp2f(-fabsf(z) * L2E));
            lk[r] = valid ? -sp : 0.f;
            s[r] = valid ? (z - sp) : -INFINITY;
        }
#pragma unroll
        for (int g = 0; g < 4; ++g) { G[g] = (lk[4 * g] + lk[4 * g + 1]) + (lk[4 * g + 2] + lk[4 * g + 3]); Gp[g] = xhalf(G[g], hi); }
        float above = carry;
#pragma unroll
        for (int g = 3; g >= 0; --g) {
            float off = above + (hi == 0 ? Gp[g] : 0.f);
            s[4 * g + 3] = __builtin_amdgcn_exp2f((s[4 * g + 3] + off) * L2E); off += lk[4 * g + 3];
            s[4 * g + 2] = __builtin_amdgcn_exp2f((s[4 * g + 2] + off) * L2E); off += lk[4 * g + 2];
            s[4 * g + 1] = __builtin_amdgcn_exp2f((s[4 * g + 1] + off) * L2E); off += lk[4 * g + 1];
            s[4 * g + 0] = __builtin_amdgcn_exp2f((s[4 * g + 0] + off) * L2E);
            above += G[g] + Gp[g];
        }
        carry = above;
        return __all(carry < -40.0f) != 0;
    }
};
__device__ void attn_B(const bf16* base, int h, int q0, bf16* ybase, LAS unsigned char* vlds, int lane) {
    AttnCtx c; c.base = base; c.r32 = lane & 31; c.hi = lane >> 5; c.lane = lane; c.vlds = vlds; c.klds = vlds + VBUFV; c.kcol = 1280 + h * 64; c.vcol = 1792 + h * 64;
    c.o[0] = (f32x16)ZERO16; c.o[1] = (f32x16)ZERO16;
    MixB mx; mx.q0 = q0; mx.qpos = q0 + c.r32; mx.nt = q0 / 32 + 1; mx.carry = 0.f;
    load_q(c.qf, base, mx.qpos, 768 + h * 64, c.hi);
    attn_run<MixB, false>(mx, c);
    store_o(ybase + (size_t)mx.qpos * DM + 512 + h * 64, c.o, 1.0f, c.hi);
}
struct MixCp {
    int nt, n0, r0, j1lo, qpos; float m, l;
    __device__ __forceinline__ void pos(int t, int& kp0, int& kst) const {
        if (t < n0) { kp0 = r0 + 512 * t; kst = 16; } else { kp0 = (r0 & 3) + 4 * (j1lo + 32 * (t - n0)); kst = 4; }
    }
    __device__ __forceinline__ bool process(int t, f32x16& s, AttnCtx& c) {
        int kp0, kst; pos(t, kp0, kst);
        const int win = t < n0 ? 2048 : 512;
#pragma unroll
        for (int r = 0; r < 16; ++r) { const int dist = qpos - (kp0 + kst * crow(r, c.hi)); if (dist < 0 || dist > win) s[r] = -INFINITY; }
        osm_tile(s, m, l, c.o); return false;
    }
};
struct MixC1 {
    int nt2, p0, qpos; float m, l;
    __device__ __forceinline__ int pos2(int T) const { return p0 + 64 * T; }
    __device__ __forceinline__ bool active2(int T, int w) const { return true; }
    __device__ __forceinline__ void process2(int T, f32x16& s0, f32x16& s1, AttnCtx& c) {
        const int k0 = p0 + 64 * T;
#pragma unroll
        for (int r = 0; r < 16; ++r) { const int dist = qpos - (k0 + crow(r, c.hi)); if (dist < 0 || dist > 128) s0[r] = -INFINITY; if (dist < 32 || dist > 160) s1[r] = -INFINITY; }
        osm_tile2(s0, s1, m, l, c.o);
    }
};
__device__ void attn_C(const bf16* base, int h, int r0, int g, bf16* ybase, LAS unsigned char* vlds, LAS unsigned char* xlds, int w, int lane) {
    AttnCtx c; c.base = base; c.r32 = lane & 31; c.hi = lane >> 5; c.lane = lane; c.vlds = vlds; c.klds = vlds + VBUFV; c.kcol = 512 + h * 64; c.vcol = 1024 + h * 64;
    c.o[0] = (f32x16)ZERO16; c.o[1] = (f32x16)ZERO16;
    const int qpos = r0 + 16 * (32 * g + c.r32);
    load_q(c.qf, base, qpos, h * 64, c.hi);
    MixCp mp; mp.r0 = r0; mp.qpos = qpos; mp.m = -INFINITY; mp.l = 0.f;
    mp.n0 = g + 1;
    mp.j1lo = (r0 >> 2) + 128 * g - 128 > 0 ? (r0 >> 2) + 128 * g - 128 : 0;
    mp.nt = mp.n0 + ((r0 >> 2) + 128 * g + 124 - mp.j1lo) / 32 + 1;
    attn_run<MixCp, true>(mp, c);
    MixC1 m1; m1.qpos = qpos; m1.m = mp.m; m1.l = mp.l;
    const int ra = r0 & 8;
    m1.p0 = 512 * g + ra - 128 > 0 ? 512 * g + ra - 128 : 0;
    m1.nt2 = ((512 * g + ra + 7 + 496 - m1.p0) / 32 + 2) / 2;
    attn_run_shared<MixC1>(m1, c, xlds + 64, w);
    const float l = m1.l + xhalf(m1.l, c.hi);
    store_o(ybase + (size_t)qpos * DM + h * 64, c.o, 1.0f / l, c.hi);
}
struct MixD {
    int nt, nt2, npast, own, q0, qpos; unsigned U, sel; float m, l;
    __device__ __forceinline__ int blk_of(int j) const {
        unsigned u = U; int b = 0;
#pragma unroll
        for (int i = 0; i < 7; ++i) { if (i < j) u &= u - 1u; }
        b = __builtin_ctz(u | 0x100u); return b;
    }
    __device__ __forceinline__ void pos(int t, int& kp0, int& kst) const {
        kst = 1;
        if (t < 8 * npast) kp0 = blk_of(t >> 3) * 256 + (t & 7) * 32; else kp0 = own * 256 + (t - 8 * npast) * 32;
    }
    __device__ __forceinline__ int pos2(int T) const { int kp, ks; pos(2 * T, kp, ks); return kp; }
    __device__ __forceinline__ bool active2(int T, int w) const { return T < 4 * npast || 2 * (T - 4 * npast) <= w; }
    __device__ __forceinline__ void process2(int T, f32x16& s0, f32x16& s1, AttnCtx& c) {
        if (T < 4 * npast) {
            const int blk = blk_of(T >> 2);
            osm_tile2_onoff(s0, s1, ((sel >> blk) & 1u) != 0u, m, l, c.o); return;
        } else {
            const int k0 = own * 256 + (T - 4 * npast) * 64;
#pragma unroll
            for (int r = 0; r < 16; ++r) { const int kk = k0 + crow(r, c.hi); if (kk > qpos) s0[r] = -INFINITY; if (kk + 32 > qpos) s1[r] = -INFINITY; }
        }
        osm_tile2(s0, s1, m, l, c.o);
    }
};
__device__ void attn_D(const bf16* base, const float* kmean  , int h, int q0, bf16* ybase, LAS unsigned char* vlds, LAS unsigned char* xlds, int lane) {
    AttnCtx c; c.base = base; c.r32 = lane & 31; c.hi = lane >> 5; c.lane = lane; c.vlds = vlds; c.klds = vlds + VBUFV; c.kcol = 2048 + h * 64; c.vcol = 2560 + h * 64;
    c.o[0] = (f32x16)ZERO16; c.o[1] = (f32x16)ZERO16;
    const int r32 = c.r32, hi = c.hi, own = q0 >> 8;
    MixD mx; mx.own = own; mx.q0 = q0; mx.qpos = q0 + r32; mx.m = -INFINITY; mx.l = 0.f;
    load_q(c.qf, base, mx.qpos, 1536 + h * 64, hi);
    unsigned sel = 0u;
    if (own > 0) {
        bf16x8 kf[4];
#pragma unroll
        for (int k = 0; k < 4; ++k) {
            u32x4 w = {0u, 0u, 0u, 0u};
            if (r32 < 8) { const float* kp = kmean + r32 * 64 + 16 * k + 8 * hi; const f32x4 a = *(const f32x4*)kp, b = *(const f32x4*)(kp + 4);
                w.x = cvtpk(a[0], a[1]); w.y = cvtpk(a[2], a[3]); w.z = cvtpk(b[0], b[1]); w.w = cvtpk(b[2], b[3]); }
            kf[k] = __builtin_bit_cast(bf16x8, w);
        }
        f32x16 gs = ZERO16;
#pragma unroll
        for (int k = 0; k < 4; ++k) gs = __builtin_amdgcn_mfma_f32_32x32x16_bf16(kf[k], c.qf[k], gs, 0, 0, 0);
        float gt[8];
#pragma unroll
        for (int r = 0; r < 4; ++r) { const float mine = gs[r], oth = xhalf(mine, hi); gt[r] = hi == 0 ? mine : oth; gt[4 + r] = hi == 0 ? oth : mine; }
        const int nsel = own < 3 ? own : 3;
        for (int rr = 0; rr < nsel; ++rr) {
            float best = -INFINITY; int bi = -1;
#pragma unroll
            for (int n = 0; n < 8; ++n) { const bool ok = n < own && !((sel >> n) & 1u) && (bi < 0 || gt[n] > best); if (ok) { best = gt[n]; bi = n; } }
            if (bi >= 0) sel |= 1u << bi;
        }
    }
    unsigned U = 0u;
#pragma unroll
    for (int n = 0; n < 8; ++n) if (__ballot((sel >> n) & 1u) != 0ull) U |= 1u << n;
    {
        volatile LAS unsigned* ux = (volatile LAS unsigned*)xlds;
        __builtin_amdgcn_s_barrier();
        if (lane == 0) ux[(q0 >> 5) & 7] = U;
        asm volatile("s_waitcnt lgkmcnt(0)" ::: "memory");
        __builtin_amdgcn_s_barrier();
        U = ux[0] | ux[1] | ux[2] | ux[3] | ux[4] | ux[5] | ux[6] | ux[7];
        U = __builtin_amdgcn_readfirstlane(U);
    }
    mx.U = U; mx.sel = sel; mx.npast = __builtin_popcount(U); mx.nt = 8 * mx.npast + 8; mx.nt2 = 4 * mx.npast + 4;
    attn_run_shared<MixD>(mx, c, xlds + 64, (q0 >> 5) & 7);
    const float l = mx.l + xhalf(mx.l, c.hi);
    store_o(ybase + (size_t)mx.qpos * DM + 512 + h * 64, c.o, 1.0f / l, hi);
}

__device__ void ph_attn0(const bf16* qkv, const float* sinks, bf16* y, LAS unsigned char* lds, int bid, int nb) {
    const int lane = ltid() & 63, w = __builtin_amdgcn_readfirstlane(ltid() >> 6);
    LAS unsigned char* vlds = lds + w * (VBUF + VBUFV);
    for (int pid0 = bid; pid0 < NB * 8; pid0 += nb) {
        const int b = (pid0 & 7) * 4 + (pid0 >> 6), h = (pid0 >> 3) & 7, pid = b * 8 + h;
        const bf16* base = qkv + (size_t)b * SQ * QKV_LD; bf16* ybase = y + (size_t)b * SQ * DM;
        const float sink = sinks[h];
        for (int rd = 0; rd < 8; ++rd) attn_A(base, h, (rd * 8 + w) * 32, sink, ybase, vlds, lane);
        for (int rd = 0; rd < 8; ++rd) attn_B(base, h, (rd * 8 + w) * 32, ybase, vlds, lane);
    }
}
__device__ void ph_attn1(const bf16* qkv, const float* kmean, bf16* y, LAS unsigned char* lds, int bid, int nb) {
    const int lane = ltid() & 63, w = __builtin_amdgcn_readfirstlane(ltid() >> 6);
    LAS unsigned char* vlds = lds + w * (VBUF + VBUFV);
    for (int pid0 = bid; pid0 < NB * 8; pid0 += nb) {
        const int b = (pid0 & 7) * 4 + (pid0 >> 6), h = (pid0 >> 3) & 7, pid = b * 8 + h;
        const bf16* base = qkv + (size_t)b * SQ * QKV_LD; bf16* ybase = y + (size_t)b * SQ * DM;
        for (int rd = 0; rd < 8; ++rd) { const int it = rd * 8 + w; attn_C(base, h, it & 15, it >> 4, ybase, vlds, lds + 8 * (VBUF + VBUFV), w, lane); }
        for (int rd = 0; rd < 8; ++rd) attn_D(base, kmean + (size_t)pid * 8 * 64, h, (rd * 8 + w) * 32, ybase, vlds, lds + 8 * (VBUF + VBUFV), lane);
    }
}

#define CE_D(a, b) { const float hi_ = fmaxf((a), (b)), lo_ = fminf((a), (b)); (a) = hi_; (b) = lo_; }
#define BSTAGE(arr, k, j) _Pragma("unroll") for (int i_ = 0; i_ < 16; ++i_) { const int l_ = i_ ^ (j); if (l_ > i_) { if ((i_ & (k)) == 0) CE_D(arr[i_], arr[l_]) else CE_D(arr[l_], arr[i_]) } }
__device__ __forceinline__ void bsort16(float (&a)[16]) {
    CE_D(a[0], a[1]) CE_D(a[2], a[3]) CE_D(a[0], a[2]) CE_D(a[1], a[3]) CE_D(a[1], a[2]) CE_D(a[4], a[5]) CE_D(a[6], a[7]) CE_D(a[4], a[6]) CE_D(a[5], a[7]) CE_D(a[5], a[6]) CE_D(a[0], a[4]) CE_D(a[2], a[6]) CE_D(a[2], a[4]) CE_D(a[1], a[5]) CE_D(a[3], a[7]) CE_D(a[3], a[5]) CE_D(a[1], a[2]) CE_D(a[3], a[4]) CE_D(a[5], a[6]) CE_D(a[8], a[9]) CE_D(a[10], a[11]) CE_D(a[8], a[10]) CE_D(a[9], a[11]) CE_D(a[9], a[10]) CE_D(a[12], a[13]) CE_D(a[14], a[15]) CE_D(a[12], a[14]) CE_D(a[13], a[15]) CE_D(a[13], a[14]) CE_D(a[8], a[12]) CE_D(a[10], a[14]) CE_D(a[10], a[12]) CE_D(a[9], a[13]) CE_D(a[11], a[15]) CE_D(a[11], a[13]) CE_D(a[9], a[10]) CE_D(a[11], a[12]) CE_D(a[13], a[14]) CE_D(a[0], a[8]) CE_D(a[4], a[12]) CE_D(a[4], a[8]) CE_D(a[2], a[10]) CE_D(a[6], a[14]) CE_D(a[6], a[10]) CE_D(a[2], a[4]) CE_D(a[6], a[8]) CE_D(a[10], a[12]) CE_D(a[1], a[9]) CE_D(a[5], a[13]) CE_D(a[5], a[9]) CE_D(a[3], a[11]) CE_D(a[7], a[15]) CE_D(a[7], a[11]) CE_D(a[3], a[5]) CE_D(a[7], a[9]) CE_D(a[11], a[13]) CE_D(a[1], a[2]) CE_D(a[3], a[4]) CE_D(a[5], a[6]) CE_D(a[7], a[8]) CE_D(a[9], a[10]) CE_D(a[11], a[12]) CE_D(a[13], a[14])
}
__device__ __forceinline__ void bmerge16(float (&a)[16]) {
    BSTAGE(a, 16, 8) BSTAGE(a, 16, 4) BSTAGE(a, 16, 2) BSTAGE(a, 16, 1)
}
__device__ __forceinline__ void merge_top16(float (&a)[16], const float (&b)[16]) {
#pragma unroll
    for (int i = 0; i < 16; ++i) a[i] = fmaxf(a[i], b[15 - i]);
    bmerge16(a);
}
__device__ __forceinline__ void xmerge16(float (&a)[16]) {
    {
        float A[16], B[16];
#pragma unroll
        for (int i = 0; i < 16; ++i) { auto r = __builtin_amdgcn_permlane16_swap(__float_as_uint(a[i]), __float_as_uint(a[i]), false, false); A[i] = __uint_as_float(r[0]); B[i] = __uint_as_float(r[1]); }
#pragma unroll
        for (int i = 0; i < 16; ++i) a[i] = fmaxf(A[i], B[15 - i]);
        bmerge16(a);
    }
    {
        float A[16], B[16];
#pragma unroll
        for (int i = 0; i < 16; ++i) { auto r = __builtin_amdgcn_permlane32_swap(__float_as_uint(a[i]), __float_as_uint(a[i]), false, false); A[i] = __uint_as_float(r[0]); B[i] = __uint_as_float(r[1]); }
#pragma unroll
        for (int i = 0; i < 16; ++i) a[i] = fmaxf(A[i], B[15 - i]);
        bmerge16(a);
    }
}
__host__ __device__ constexpr int pair_i(int id) {
    int c = 0;
    for (int i = 0; i < 16; ++i) { const int nj = 16 / (i + 1); if (id < c + nj) return i; c += nj; }
    return 0;
}
__host__ __device__ constexpr int pair_j(int id) {
    int c = 0;
    for (int i = 0; i < 16; ++i) { const int nj = 16 / (i + 1); if (id < c + nj) return id - c; c += nj; }
    return 0;
}
constexpr int SK_ROW = 272;
constexpr int SEL_SK_BYTES = 2 * 128 * SK_ROW;
constexpr int SEL_TAB_OFF = SEL_SK_BYTES;
constexpr int SEL_IDX_OFF = SEL_SK_BYTES + 64;

template <int S> __device__ __forceinline__ float cand_slot(const float (&L1)[16], const float (&L2)[16], int g) {
    constexpr int p0 = S, p1 = 16 + S, p2 = 32 + S, p3 = 48 + S;
    const float c0 = L1[pair_i(p0)] + L2[pair_j(p0)], c1 = L1[pair_i(p1)] + L2[pair_j(p1)], c2 = L1[pair_i(p2)] + L2[pair_j(p2)];
    const float c3 = p3 < 50 ? L1[pair_i(p3 < 50 ? p3 : 0)] + L2[pair_j(p3 < 50 ? p3 : 0)] : -1.0e30f;
    const float c = g == 0 ? c0 : (g == 1 ? c1 : (g == 2 ? c2 : c3));
    return __uint_as_float((__float_as_uint(c) & 0xffffffc0u) | (unsigned)(16 * g + S));
}

__device__ void ph_peer_select(const bf16* qry, const float* subkeys  , int* eidx, float* egate  , const float* su, const float* sv, LAS unsigned char* lds, int bid, int nb) {
    const int tid = ltid(), lane = tid & 63, w = __builtin_amdgcn_readfirstlane(tid >> 6);
    const int tk = lane & 15, g = lane >> 4;
    __syncthreads();
    for (int e = tid; e < 2 * 128 * 128 / 2; e += NT) {
        const int row = e >> 6, c2 = (e & 63) * 2;
        const float a = subkeys[(size_t)row * 128 + c2], b = subkeys[(size_t)row * 128 + c2 + 1];
        *(LAS unsigned*)(lds + row * SK_ROW + c2 * 2) = pk2(a, b);
    }
    if (tid < 64) { int id = tid; int c = 0, pi = 0, pj = 0;
        for (int i = 0; i < 16; ++i) { const int nj = 16 / (i + 1); if (id >= c && id < c + nj) { pi = i; pj = id - c; } c += nj; }
        lds[SEL_TAB_OFF + tid] = (unsigned char)((pi << 4) | pj); }
    __syncthreads();
    LAS unsigned* widx = (LAS unsigned*)(lds + SEL_IDX_OFF + w * 512);
    const LAS unsigned char* widx8 = (const LAS unsigned char*)widx;
    const int nitems = (MT / 16) * 8;
    bf16x8 qc[2][4];
    { const int it = (bid & 7) * 4096 + (bid >> 3) * 8 + w;
      if (it < nitems) { const bf16* qp = qry + (size_t)((it >> 3) * 16 + tk) * PQ + (it & 7) * 256 + 8 * g;
#pragma unroll
          for (int hf = 0; hf < 2; ++hf)
#pragma unroll
              for (int ks = 0; ks < 4; ++ks) qc[hf][ks] = *(const bf16x8*)(qp + hf * 128 + 32 * ks); } }
    for (int j_ = (bid >> 3) * 8 + w; j_ < 4096; j_ += 256) {
        const int it = (bid & 7) * 4096 + j_;
        const int h = it & 7, t0 = (it >> 3) * 16;
        bf16x8 qn[2][4];
        { const int itn = j_ + 256 < 4096 ? it + 256 : it;
          const bf16* qp = qry + (size_t)((itn >> 3) * 16 + tk) * PQ + (itn & 7) * 256 + 8 * g;
#pragma unroll
          for (int hf = 0; hf < 2; ++hf)
#pragma unroll
              for (int ks = 0; ks < 4; ++ks) qn[hf][ks] = *(const bf16x8*)(qp + hf * 128 + 32 * ks); }
        float L[2][16];
#pragma unroll
        for (int hf = 0; hf < 2; ++hf) {
            bf16x8 qf[4];
#pragma unroll
            for (int ks = 0; ks < 4; ++ks) qf[ks] = qc[hf][ks];
            float key[32];
#pragma unroll
            for (int tile = 0; tile < 8; ++tile) {
                f32x4 acc = {0.f, 0.f, 0.f, 0.f};
#pragma unroll
                for (int ks = 0; ks < 4; ++ks) {
                    const bf16x8 af = *(const LAS bf16x8*)(lds + (hf * 128 + tile * 16 + tk) * SK_ROW + (32 * ks + 8 * g) * 2);
                    acc = __builtin_amdgcn_mfma_f32_16x16x32_bf16(af, qf[ks], acc, 0, 0, 0);
                }
#pragma unroll
                for (int r = 0; r < 4; ++r) key[tile * 4 + r] = __uint_as_float((__float_as_uint(acc[r]) & 0xffffff80u) | (unsigned)(16 * tile + 4 * g + r));
            }
            float a[16], b[16];
#pragma unroll
            for (int i = 0; i < 16; ++i) { a[i] = key[i]; b[i] = key[16 + i]; }
            bsort16(a); bsort16(b);
            merge_top16(a, b);
            xmerge16(a);
#pragma unroll
            for (int i = 0; i < 16; ++i) L[hf][i] = a[i];
            unsigned pk = 0u;
#pragma unroll
            for (int s = 0; s < 4; ++s) {
                const float v = g == 0 ? a[s] : (g == 1 ? a[4 + s] : (g == 2 ? a[8 + s] : a[12 + s]));
                pk |= (__float_as_uint(v) & 127u) << (8 * s);
            }
            widx[tk * 8 + hf * 4 + g] = pk;
        }
        float c[16];
        c[0] = cand_slot<0>(L[0], L[1], g); c[1] = cand_slot<1>(L[0], L[1], g); c[2] = cand_slot<2>(L[0], L[1], g); c[3] = cand_slot<3>(L[0], L[1], g);
        c[4] = cand_slot<4>(L[0], L[1], g); c[5] = cand_slot<5>(L[0], L[1], g); c[6] = cand_slot<6>(L[0], L[1], g); c[7] = cand_slot<7>(L[0], L[1], g);
        c[8] = cand_slot<8>(L[0], L[1], g); c[9] = cand_slot<9>(L[0], L[1], g); c[10] = cand_slot<10>(L[0], L[1], g); c[11] = cand_slot<11>(L[0], L[1], g);
        c[12] = cand_slot<12>(L[0], L[1], g); c[13] = cand_slot<13>(L[0], L[1], g); c[14] = cand_slot<14>(L[0], L[1], g); c[15] = cand_slot<15>(L[0], L[1], g);
        bsort16(c);
        xmerge16(c);
        float sum = 0.f, ex[16];
#pragma unroll
        for (int i = 0; i < 16; ++i) { ex[i] = __builtin_amdgcn_exp2f((c[i] - c[0]) * L2E); sum += ex[i]; }
        const float inv = 1.0f / sum;
        int oi[4]; float og[4];
#pragma unroll
        for (int s = 0; s < 4; ++s) {
            const float kv = g == 0 ? c[s] : (g == 1 ? c[4 + s] : (g == 2 ? c[8 + s] : c[12 + s]));
            const float ev = g == 0 ? ex[s] : (g == 1 ? ex[4 + s] : (g == 2 ? ex[8 + s] : ex[12 + s]));
            const unsigned pid = __float_as_uint(kv) & 63u;
            const unsigned ij = lds[SEL_TAB_OFF + pid];
            const unsigned i1 = widx8[tk * 32 + (ij >> 4)], i2 = widx8[tk * 32 + 16 + (ij & 15u)];
            oi[s] = (int)(i1 * 128u + i2); og[s] = ev * inv;
        }
        const size_t ob = (size_t)(t0 + tk) * 128 + h * 16 + 4 * g;
        *(u32x4*)(eidx + ob) = (u32x4){(unsigned)oi[0], (unsigned)oi[1], (unsigned)oi[2], (unsigned)oi[3]};
        *(f32x4*)(egate + ob) = (f32x4){og[0] * sv[oi[0]], og[1] * sv[oi[1]], og[2] * sv[oi[2]], og[3] * sv[oi[3]]};
        *(f32x4*)(egate + 1024 * 1024 + ob) = (f32x4){su[oi[0]], su[oi[1]], su[oi[2]], su[oi[3]]};
#pragma unroll
        for (int hf = 0; hf < 2; ++hf)
#pragma unroll
            for (int ks = 0; ks < 4; ++ks) qc[hf][ks] = qn[hf][ks];
    }
    __syncthreads();
}

typedef float v32f_t __attribute__((ext_vector_type(32)));
typedef unsigned v6u_t __attribute__((ext_vector_type(6)));
typedef unsigned v16u_t __attribute__((ext_vector_type(16)));
typedef __bf16 v32bf_t __attribute__((ext_vector_type(32)));
typedef __bf16 v2bf_t __attribute__((ext_vector_type(2)));
typedef _Float16 v32h_t __attribute__((ext_vector_type(32)));
typedef unsigned u32x3 __attribute__((ext_vector_type(3)));
constexpr int TROW = 768;
__device__ void ph_tab_fp6(const float* src, unsigned char* dst, float* scale, int nrows, int bid, int nb) {
    const int lane = ltid() & 63, w = __builtin_amdgcn_readfirstlane(ltid() >> 6);
    for (int rp = bid * 8 + w; rp < nrows / 2; rp += nb * 8) {
        v32h_t hv; float sc[2];
#pragma unroll
        for (int rr = 0; rr < 2; ++rr) {
            const float* sp = src + (size_t)(2 * rp + rr) * DM + lane * 16;
            f32x4 v[4]; float am = 0.f;
#pragma unroll
            for (int i = 0; i < 4; ++i) { v[i] = *(const f32x4*)(sp + i * 4); am = fmaxf(am, fmaxf(fmaxf(fabsf(v[i][0]), fabsf(v[i][1])), fmaxf(fabsf(v[i][2]), fabsf(v[i][3])))); }
            am = wave_max(am);
            const float s = am > 0.f ? am * (1.0f / 7.5f) : 1.0f, inv = 1.0f / s;
            sc[rr] = s;
#pragma unroll
            for (int i = 0; i < 4; ++i)
#pragma unroll
                for (int e = 0; e < 4; ++e) hv[rr * 16 + i * 4 + e] = (_Float16)fminf(fmaxf(v[i][e] * inv, -7.5f), 7.5f);
        }
        const v6u_t pk = __builtin_amdgcn_cvt_scalef32_pk32_fp6_f16(hv, 1.0f);
        unsigned* d0 = (unsigned*)(dst + (size_t)(2 * rp) * TROW + lane * 12);
        unsigned* d1 = (unsigned*)(dst + (size_t)(2 * rp + 1) * TROW + lane * 12);
        d0[0] = pk[0]; d0[1] = pk[1]; d0[2] = pk[2]; d1[0] = pk[3]; d1[1] = pk[4]; d1[2] = pk[5];
        if (lane == 0) { scale[2 * rp] = sc[0]; scale[2 * rp + 1] = sc[1]; }
    }
}

constexpr int TROW4 = 512;
constexpr int TROWX = 1024;
__device__ void ph_tab_fp4(const float* src, unsigned char* dst  , float* scale, int nrows, int bid, int nb) {
    const int lane = ltid() & 63, w = __builtin_amdgcn_readfirstlane(ltid() >> 6);
    for (int row = bid * 8 + w; row < nrows; row += nb * 8) {
        const float* sp = src + (size_t)row * DM + lane * 16;
        f32x4 v[4]; float am = 0.f;
#pragma unroll
        for (int i = 0; i < 4; ++i) { v[i] = *(const f32x4*)(sp + i * 4); am = fmaxf(am, fmaxf(fmaxf(fabsf(v[i][0]), fabsf(v[i][1])), fmaxf(fabsf(v[i][2]), fabsf(v[i][3])))); }
        am = wave_max(am);
        const float s = am > 0.f ? am * (1.0f / 6.0f) : 1.0f, inv = 1.0f / s;
        unsigned d0 = 0u, d1 = 0u;
        d0 = __builtin_amdgcn_cvt_scalef32_pk_fp4_f32(d0, v[0][0] * inv, v[0][1] * inv, 1.0f, 0); d0 = __builtin_amdgcn_cvt_scalef32_pk_fp4_f32(d0, v[0][2] * inv, v[0][3] * inv, 1.0f, 1);
        d0 = __builtin_amdgcn_cvt_scalef32_pk_fp4_f32(d0, v[1][0] * inv, v[1][1] * inv, 1.0f, 2); d0 = __builtin_amdgcn_cvt_scalef32_pk_fp4_f32(d0, v[1][2] * inv, v[1][3] * inv, 1.0f, 3);
        d1 = __builtin_amdgcn_cvt_scalef32_pk_fp4_f32(d1, v[2][0] * inv, v[2][1] * inv, 1.0f, 0); d1 = __builtin_amdgcn_cvt_scalef32_pk_fp4_f32(d1, v[2][2] * inv, v[2][3] * inv, 1.0f, 1);
        d1 = __builtin_amdgcn_cvt_scalef32_pk_fp4_f32(d1, v[3][0] * inv, v[3][1] * inv, 1.0f, 2); d1 = __builtin_amdgcn_cvt_scalef32_pk_fp4_f32(d1, v[3][2] * inv, v[3][3] * inv, 1.0f, 3);
        *(u32x2*)(dst + (size_t)row * TROWX + lane * 16) = (u32x2){d0, d1};
        if (lane == 0) scale[row] = s;
    }
}

__device__ void ph_tab_i4(const float* src, unsigned char* dst, float* scale, int nrows, int bid, int nb) {
    const int lane = ltid() & 63, w = __builtin_amdgcn_readfirstlane(ltid() >> 6);
    for (int row = bid * 8 + w; row < nrows; row += nb * 8) {
        const float* sp = src + (size_t)row * DM + lane * 16;
        f32x4 v[4]; float am = 0.f;
#pragma unroll
        for (int i = 0; i < 4; ++i) { v[i] = *(const f32x4*)(sp + i * 4); am = fmaxf(am, fmaxf(fmaxf(fabsf(v[i][0]), fabsf(v[i][1])), fmaxf(fabsf(v[i][2]), fabsf(v[i][3])))); }
        am = wave_max(am);
        const float s = am > 0.f ? am * (1.0f / 7.0f) : 1.0f, inv = 1.0f / s;
        unsigned d[2] = {0u, 0u};
#pragma unroll
        for (int i = 0; i < 16; ++i) { const int q = (int)rintf(fminf(fmaxf(v[i >> 2][i & 3] * inv, -7.0f), 7.0f)); d[i >> 3] |= ((unsigned)q & 15u) << (4 * (i & 7)); }
        *(u32x2*)(dst + (size_t)row * TROWX + lane * 16) = (u32x2){d[0], d[1]};
        if (lane == 0) scale[row] = s;
    }
}

__device__ void ph_tab_uv(const float* srcu, const float* srcv, unsigned char* dst, float* scu, float* scv, int nrows, int bid, int nb) {
    const int lane = ltid() & 63, w = __builtin_amdgcn_readfirstlane(ltid() >> 6);
    f32x4 nu[2][4], nv[2][4];
#define TAB_LOAD(rb) _Pragma("unroll") for (int r = 0; r < 2; ++r) _Pragma("unroll") for (int i = 0; i < 4; ++i) { \
        nu[r][i] = *(const f32x4*)(srcu + (size_t)((rb) + r) * DM + lane * 16 + i * 4); nv[r][i] = *(const f32x4*)(srcv + (size_t)((rb) + r) * DM + lane * 16 + i * 4); }
    { const int rf = (bid * 8 + w) * 2; if (rf < nrows) { TAB_LOAD(rf) } }
    for (int row0 = (bid * 8 + w) * 2; row0 < nrows; row0 += nb * 8 * 2) {
        f32x4 vu[2][4], vv[2][4];
#pragma unroll
        for (int r = 0; r < 2; ++r)
#pragma unroll
            for (int i = 0; i < 4; ++i) { vu[r][i] = nu[r][i]; vv[r][i] = nv[r][i]; }
        if (row0 + nb * 8 * 2 < nrows) { TAB_LOAD(row0 + nb * 8 * 2) }
#pragma unroll
        for (int r = 0; r < 2; ++r) {
            float au = 0.f, av = 0.f;
#pragma unroll
            for (int i = 0; i < 4; ++i)
#pragma unroll
                for (int e = 0; e < 4; ++e) { au = fmaxf(au, fabsf(vu[r][i][e])); av = fmaxf(av, fabsf(vv[r][i][e])); }
            au = wave_max(au); av = wave_max(av);
            const float su_ = au > 0.f ? au * (1.0f / 7.0f) : 1.0f, iu = 1.0f / su_, sv_ = av > 0.f ? av * (1.0f / 6.0f) : 1.0f, iv = 1.0f / sv_;
            unsigned d[2] = {0u, 0u};
#pragma unroll
            for (int i = 0; i < 16; ++i) { const int q = (int)rintf(fminf(fmaxf(vu[r][i >> 2][i & 3] * iu, -7.0f), 7.0f)); d[i >> 3] |= ((unsigned)q & 15u) << (4 * (i & 7)); }
            unsigned d0 = 0u, d1 = 0u;
            d0 = __builtin_amdgcn_cvt_scalef32_pk_fp4_f32(d0, vv[r][0][0] * iv, vv[r][0][1] * iv, 1.0f, 0); d0 = __builtin_amdgcn_cvt_scalef32_pk_fp4_f32(d0, vv[r][0][2] * iv, vv[r][0][3] * iv, 1.0f, 1);
            d0 = __builtin_amdgcn_cvt_scalef32_pk_fp4_f32(d0, vv[r][1][0] * iv, vv[r][1][1] * iv, 1.0f, 2); d0 = __builtin_amdgcn_cvt_scalef32_pk_fp4_f32(d0, vv[r][1][2] * iv, vv[r][1][3] * iv, 1.0f, 3);
            d1 = __builtin_amdgcn_cvt_scalef32_pk_fp4_f32(d1, vv[r][2][0] * iv, vv[r][2][1] * iv, 1.0f, 0); d1 = __builtin_amdgcn_cvt_scalef32_pk_fp4_f32(d1, vv[r][2][2] * iv, vv[r][2][3] * iv, 1.0f, 1);
            d1 = __builtin_amdgcn_cvt_scalef32_pk_fp4_f32(d1, vv[r][3][0] * iv, vv[r][3][1] * iv, 1.0f, 2); d1 = __builtin_amdgcn_cvt_scalef32_pk_fp4_f32(d1, vv[r][3][2] * iv, vv[r][3][3] * iv, 1.0f, 3);
            *(u32x4*)(dst + (size_t)(row0 + r) * TROWX + lane * 16) = (u32x4){d[0], d[1], d0, d1};
            if (lane == 0) { scu[row0 + r] = su_; scv[row0 + r] = sv_; }
        }
    }
}

#define DPP_ADD(v, ctrl) ((v) + __builtin_bit_cast(float, __builtin_amdgcn_update_dpp(0, __builtin_bit_cast(int, (v)), (ctrl), 0xf, 0xf, true)))
typedef int i32x4_t __attribute__((ext_vector_type(4)));
constexpr int GT = 2;
typedef int v8i_t __attribute__((ext_vector_type(8)));
typedef int v2i_t __attribute__((ext_vector_type(2)));
struct GSet { u32x2 uq[4]; u32x2 vq[4]; };
__device__ __forceinline__ void gather_issue(GSet& S, int bt, int lane, const unsigned char* pu, const unsigned char* pv, const LAS int* etok) {
    const i32x4_t ev = *(const LAS i32x4_t*)(etok + bt * 4);
    const int es[4] = {ev.x, ev.y, ev.z, ev.w};
#pragma unroll
    for (int k = 0; k < 2; ++k) {
        const unsigned f0 = (unsigned)es[2 * k] * (unsigned)TROWX + (unsigned)lane * 16u, f1 = (unsigned)es[2 * k + 1] * (unsigned)TROWX + (unsigned)lane * 16u;
        const u32x4 r0 = *(const u32x4*)(pu + f0), r1 = *(const u32x4*)(pu + f1);
        S.uq[2 * k] = (u32x2){r0.x, r0.y}; S.vq[2 * k] = (u32x2){r0.z, r0.w}; S.uq[2 * k + 1] = (u32x2){r1.x, r1.y}; S.vq[2 * k + 1] = (u32x2){r1.z, r1.w};
    }
}
constexpr int GV_ROW = 528;
constexpr int GV_BYTES = 16 * GV_ROW, GC_BYTES = 96;
__device__ __forceinline__ float gather_udot(const GSet& S, const unsigned (&hd)[4], LAS unsigned char* vrow) {
    int d[4];
#pragma unroll
    for (int k = 0; k < 4; ++k) {
        const int q0 = (int)S.uq[k].x, q1 = (int)S.uq[k].y;
        int a1, a2;
        asm("v_dot8_i32_i4 %0, %1, %2, 0" : "=v"(a1) : "v"(q0), "v"(hd[0]));
        asm("v_dot8_i32_i4 %0, %1, %2, 0" : "=v"(a2) : "v"(q0), "v"(hd[2]));
        a1 = __builtin_amdgcn_sdot8(q1, (int)hd[1], a1, false); a2 = __builtin_amdgcn_sdot8(q1, (int)hd[3], a2, false);
        d[k] = (a1 << 4) + a2;
    }
#pragma unroll
    for (int k = 0; k < 4; ++k) *(LAS u32x2*)(vrow + k * GV_ROW) = S.vq[k];
    int e2[2], f1;
#pragma unroll
    for (int k = 0; k < 2; ++k) { auto r = __builtin_amdgcn_permlane16_swap((unsigned)d[k], (unsigned)d[k + 2], false, false); e2[k] = (int)r[0] + (int)r[1]; }
    { auto r = __builtin_amdgcn_permlane32_swap((unsigned)e2[0], (unsigned)e2[1], false, false); f1 = (int)r[0] + (int)r[1]; }
    f1 += __builtin_amdgcn_update_dpp(0, f1, 0xB1, 0xf, 0xf, true); f1 += __builtin_amdgcn_update_dpp(0, f1, 0x4E, 0xf, 0xf, true);
    f1 += __builtin_amdgcn_update_dpp(0, f1, 0x124, 0xf, 0xf, true); f1 += __builtin_amdgcn_update_dpp(0, f1, 0x128, 0xf, 0xf, true);
    return (float)f1;
}
#define DPP_MAX(v, ctrl) fmaxf((v), __builtin_bit_cast(float, __builtin_amdgcn_update_dpp(0, __builtin_bit_cast(int, (v)), (ctrl), 0xf, 0xf, true)))
__device__ __forceinline__ void gather_vpart(float f0, float f1, float f2, float f3, int lane, int kslot, const LAS float* lg  ,
                                             const LAS unsigned char* vrd  , LAS unsigned char* cb, int aoff1, int aoff2, f32x4 (&acc)[8]) {
    const int q = (lane >> 2) & 3, e16 = 4 * q + kslot;
    const float fs = q == 0 ? f0 : q == 1 ? f1 : q == 2 ? f2 : f3;
    const float cv = lg[e16] * gelu_erf(fs * lg[GT * 128 + e16]);
    float mx = fabsf(cv);
    mx = DPP_MAX(mx, 0x124); mx = DPP_MAX(mx, 0x128);
    { auto r = __builtin_amdgcn_permlane16_swap(__float_as_uint(mx), __float_as_uint(mx), false, false); mx = fmaxf(__uint_as_float(r[0]), __uint_as_float(r[1])); }
    { auto r = __builtin_amdgcn_permlane32_swap(__float_as_uint(mx), __float_as_uint(mx), false, false); mx = fmaxf(__uint_as_float(r[0]), __uint_as_float(r[1])); }
    int E = (int)((__float_as_uint(mx) >> 23) & 0xffu); E = E < 8 ? 8 : E;
    const float x = cv * __uint_as_float((unsigned)(255 - E) << 23);
    const unsigned p1 = __builtin_amdgcn_cvt_scalef32_pk_fp4_f32(0u, x, 0.f, 1.0f, 0);
    const float r1 = x - __builtin_amdgcn_cvt_scalef32_pk_f32_fp4(p1, 1.0f, 0)[0];
    const unsigned p2 = __builtin_amdgcn_cvt_scalef32_pk_fp4_f32(0u, r1, 0.f, 1.0f, 0);
    const float y = (r1 - __builtin_amdgcn_cvt_scalef32_pk_f32_fp4(p2, 1.0f, 0)[0]) * 16.0f;
    const unsigned p3 = __builtin_amdgcn_cvt_scalef32_pk_fp4_f32(0u, y, 0.f, 1.0f, 0);
    const float r3 = y - __builtin_amdgcn_cvt_scalef32_pk_f32_fp4(p3, 1.0f, 0)[0];
    const unsigned p4 = __builtin_amdgcn_cvt_scalef32_pk_fp4_f32(0u, r3, 0.f, 1.0f, 0);
    const unsigned codes = (p1 & 15u) | ((p2 & 15u) << 8) | ((p3 & 15u) << 16) | ((p4 & 15u) << 24);
    { auto r = __builtin_amdgcn_permlane32_swap(codes, codes, false, false);
      const unsigned w = codes | ((r[0] ^ r[1] ^ codes) << 4);
      if (lane < 32 && (lane & 3) == 0) {
          LAS unsigned char* tb = cb + 8 + 2 * q + ((lane >> 4) & 1);
          tb[0] = (unsigned char)w; tb[16] = (unsigned char)(w >> 8); tb[32] = (unsigned char)(w >> 16); tb[48] = (unsigned char)(w >> 24);
      } }
    const u32x2 a10 = *(const LAS u32x2*)(cb + aoff1), a11 = *(const LAS u32x2*)(cb + aoff1 + 8), a20 = *(const LAS u32x2*)(cb + aoff2), a21 = *(const LAS u32x2*)(cb + aoff2 + 8);
    const v8i_t A1 = {(int)a10.x, (int)a10.y, (int)a11.x, (int)a11.y, 0, 0, 0, 0}, A2 = {(int)a20.x, (int)a20.y, (int)a21.x, (int)a21.y, 0, 0, 0, 0};
    const int sa1 = (E - 1) * 0x01010101, sa2 = (E - 5) * 0x01010101;
#pragma unroll
    for (int m = 0; m < 8; ++m) {
        const v2i_t t0 = __builtin_amdgcn_ds_read_tr4_b64_v2i32((LAS v2i_t*)(vrd + 16 * m)), t1 = __builtin_amdgcn_ds_read_tr4_b64_v2i32((LAS v2i_t*)(vrd + 16 * m + 8));
        const v8i_t B = {t0.x, t0.y, t1.x, t1.y, 0, 0, 0, 0};
        acc[m] = __builtin_amdgcn_mfma_scale_f32_16x16x128_f8f6f4(A1, B, acc[m], 4, 4, 0, sa1, 0, 0x7F7F7F7F);
        acc[m] = __builtin_amdgcn_mfma_scale_f32_16x16x128_f8f6f4(A2, B, acc[m], 4, 4, 0, sa2, 0, 0x7F7F7F7F);
    }
}
__device__ __forceinline__ void xcd_pace(unsigned* bar, volatile LAS unsigned* st);
constexpr int GNS = 8, GBPS = 32 / GNS, GSHIFT = 11;
constexpr int GATH_LDS_WAVE = GT * 128 * 12 + GV_BYTES + GC_BYTES;
#define GATH_SEG(J, NJ, nbt) { \
        const LAS int* le_ = lse + (J) * 128; const LAS int* ne_ = lse + (NJ) * 128; \
        gather_issue(D, GBPS * c + 3, lane, pu, pv, le_); \
        const float f0_ = hsc[J] * gather_udot(A, hd[J], vwr); \
        gather_issue(A, (nbt), lane, pu, pv, ne_); \
        const float f1_ = hsc[J] * gather_udot(B, hd[J], vwr + 4 * GV_ROW); \
        gather_issue(B, (nbt) + 1, lane, pu, pv, ne_); \
        const float f2_ = hsc[J] * gather_udot(C, hd[J], vwr + 8 * GV_ROW); \
        gather_issue(C, (nbt) + 2, lane, pu, pv, ne_); \
        const float f3_ = hsc[J] * gather_udot(D, hd[J], vwr + 12 * GV_ROW); \
        gather_vpart(f0_, f1_, f2_, f3_, lane, kslot, lsg + (J) * 128 + 16 * c, vrd, cb, aoff1, aoff2, acc[J]); }
__device__ void ph_peer_gather(const bf16* h2, const unsigned char* pu, const unsigned char* pv, const float* su, const float* sv,
                               const int* eidx, const float* egate, const bf16* xin  , const float* gate  , float* xout, LAS unsigned char* lds, unsigned* pace_bar, volatile LAS unsigned* pace_st, int bid, int nb,
                               bf16* xmid  ,
                               bf16* hnext  , const float* ng, const float* nshift, const float* nscale) {
    const int lane0 = ltid() & 63, w = __builtin_amdgcn_readfirstlane(ltid() >> 6);
    LAS int* lse = (LAS int*)(lds + w * GATH_LDS_WAVE); LAS float* lsg = (LAS float*)(lds + w * GATH_LDS_WAVE + GT * 128 * 4);
    LAS unsigned char* vb = lds + w * GATH_LDS_WAVE + GT * 128 * 12; LAS unsigned char* cb = vb + GV_BYTES;
    if (lane0 < GC_BYTES / 4) ((LAS unsigned*)cb)[lane0] = 0u;
    for (int j_ = (bid >> 3) * 8 + w; j_ < 8192 / GT; j_ += 256) {
        if ((j_ >> 8) != 0) xcd_pace(pace_bar, pace_st);
        const int t0 = (bid & 7) * 8192 + j_ * GT;
        int lane = lane0; asm volatile("" : "+v"(lane));
        const int row = lane >> 4;
        const int kslot = 2 * (row & 1) + (row >> 1);
        const int b = t0 >> 11;
        LAS unsigned char* vwr = vb + lane * 8;
        const LAS unsigned char* vrd = vb + (lane & 15) * GV_ROW + 128 * row;
        const int ai = lane & 15, au = (ai < 8 ? 1 : 3), nz = ((ai & 7) >> 1) == row;
        const int aoff1 = nz ? 8 * (au - (ai & 1)) : 64, aoff2 = nz ? 8 * (au + 4 - (ai & 1)) : 64;
        unsigned hd[GT][4]; float hsc[GT]; f32x4 acc[GT][8];
#pragma unroll
        for (int j = 0; j < GT; ++j) {
            const int t = t0 + j;
            const int e0 = eidx[(size_t)t * 128 + lane], e1 = eidx[(size_t)t * 128 + 64 + lane];
            const float g0 = egate[(size_t)t * 128 + lane], g1 = egate[(size_t)t * 128 + 64 + lane];
            const int k0 = e0 >> GSHIFT, k1 = e1 >> GSHIFT;
            int off = 0, d0 = 0, d1 = 0;
#pragma unroll
            for (int s = 0; s < GNS; ++s) {
                const unsigned long long m0 = __ballot(k0 == s), m1 = __ballot(k1 == s);
                const int r0 = (int)__builtin_amdgcn_mbcnt_hi((unsigned)(m0 >> 32), __builtin_amdgcn_mbcnt_lo((unsigned)m0, 0u));
                const int r1 = (int)__builtin_amdgcn_mbcnt_hi((unsigned)(m1 >> 32), __builtin_amdgcn_mbcnt_lo((unsigned)m1, 0u));
                const int c0 = __builtin_popcountll(m0);
                if (k0 == s) d0 = off + r0;
                if (k1 == s) d1 = off + c0 + r1;
                off += c0 + __builtin_popcountll(m1);
            }
            const float s0 = egate[1024 * 1024 + (size_t)t * 128 + lane], s1 = egate[1024 * 1024 + (size_t)t * 128 + 64 + lane];
            lse[j * 128 + d0] = e0; lsg[j * 128 + d0] = g0; lse[j * 128 + d1] = e1; lsg[j * 128 + d1] = g1;
            lsg[GT * 128 + j * 128 + d0] = s0; lsg[GT * 128 + j * 128 + d1] = s1;
            const u32x4 u0 = *(const u32x4*)(h2 + (size_t)t * DM + lane * 16), u1 = *(const u32x4*)(h2 + (size_t)t * DM + lane * 16 + 8);
            {
                float hf[16];
#pragma unroll
                for (int i = 0; i < 4; ++i) { hf[2 * i] = __uint_as_float(u0[i] << 16); hf[2 * i + 1] = __uint_as_float(u0[i] & 0xffff0000u); hf[8 + 2 * i] = __uint_as_float(u1[i] << 16); hf[8 + 2 * i + 1] = __uint_as_float(u1[i] & 0xffff0000u); }
                float mh = 0.f;
#pragma unroll
                for (int i = 0; i < 16; ++i) mh = fmaxf(mh, fabsf(hf[i]));
                mh = wave_max(mh);
                int Eh = (int)((__float_as_uint(mh) >> 23) & 0xffu); Eh = Eh < 8 ? 8 : Eh;
                const float up = __uint_as_float((unsigned)(255 - Eh) << 23);
                hsc[j] = __uint_as_float((unsigned)(Eh - 5) << 23);
                unsigned p1[2] = {0u, 0u}, p2[2] = {0u, 0u};
#pragma unroll
                for (int i = 0; i < 16; ++i) {
                    const float x = hf[i] * up, r1 = rintf(x);
                    int q2 = (int)rintf((x - r1) * 16.0f); q2 = q2 > 7 ? 7 : q2;
                    p1[i >> 3] |= ((unsigned)(int)r1 & 15u) << (4 * (i & 7)); p2[i >> 3] |= ((unsigned)q2 & 15u) << (4 * (i & 7));
                }
                hd[j][0] = p1[0]; hd[j][1] = p1[1]; hd[j][2] = p2[0]; hd[j][3] = p2[1];
            }
#pragma unroll
            for (int i = 0; i < 8; ++i) acc[j][i] = (f32x4){0.f, 0.f, 0.f, 0.f};
        }
        GSet A, B, C, D;
        gather_issue(A, 0, lane, pu, pv, lse); gather_issue(B, 1, lane, pu, pv, lse); gather_issue(C, 2, lane, pu, pv, lse);
#pragma unroll 1
        for (int c = 0; c < GNS; ++c) {
            GATH_SEG(0, 1, GBPS * c)
            GATH_SEG(1, 0, c < GNS - 1 ? GBPS * c + GBPS : 0)
        }
        f32x4 nA[2][2], nS[2][2];
        if (hnext) {
#pragma unroll
            for (int i = 0; i < 2; ++i)
#pragma unroll
                for (int hq = 0; hq < 2; ++hq) {
                    const int cq = i * 512 + lane * 8 + 4 * hq;
                    const f32x4 gg = *(const f32x4*)(ng + cq), sc = *(const f32x4*)(nscale + (size_t)b * 6144 + cq);
                    nS[i][hq] = *(const f32x4*)(nshift + (size_t)b * 6144 + cq);
#pragma unroll
                    for (int e = 0; e < 4; ++e) nA[i][hq][e] = gg[e] * (1.0f + sc[e]);
                }
        }
        u32x4 xqa[GT][2]; f32x4 gqa[2][2];
#pragma unroll
        for (int i = 0; i < 2; ++i) {
            const int cc = i * 512 + lane * 8;
            gqa[i][0] = *(const f32x4*)(gate + (size_t)b * 6144 + cc); gqa[i][1] = *(const f32x4*)(gate + (size_t)b * 6144 + cc + 4);
#pragma unroll
            for (int j = 0; j < GT; ++j) xqa[j][i] = *(const u32x4*)(xin + (size_t)(t0 + j) * DM + cc);
        }
#pragma unroll
        for (int j = 0; j < GT; ++j) {
            const int t = t0 + j;
            LAS float* ob = (LAS float*)vb;
            const int nbase = 512 * (row & 1) + 32 * (row >> 1) + (lane & 15);
#pragma unroll
            for (int pm = 0; pm < 4; ++pm)
#pragma unroll
                for (int r = 0; r < 4; ++r) {
                    auto sw = __builtin_amdgcn_permlane32_swap(__float_as_uint(acc[j][2 * pm][r]), __float_as_uint(acc[j][2 * pm + 1][r]), false, false);
                    ob[nbase + 256 * (r >> 1) + 64 * pm + 16 * (r & 1)] = __uint_as_float(sw[0]) + __uint_as_float(sw[1]);
                }
            u32x4 pkq[2];
#pragma unroll
            for (int i = 0; i < 2; ++i) {
                const int cc = i * 512 + lane * 8;
                const f32x4 a0 = *(const LAS f32x4*)(ob + cc), a1 = *(const LAS f32x4*)(ob + cc + 4);
                const u32x4 xq = xqa[j][i]; const f32x4 g0 = gqa[i][0], g1 = gqa[i][1];
                const f32x4 x0 = {__uint_as_float(xq.x << 16), __uint_as_float(xq.x & 0xffff0000u), __uint_as_float(xq.y << 16), __uint_as_float(xq.y & 0xffff0000u)};
                const f32x4 x1 = {__uint_as_float(xq.z << 16), __uint_as_float(xq.z & 0xffff0000u), __uint_as_float(xq.w << 16), __uint_as_float(xq.w & 0xffff0000u)};
                f32x4 o0, o1;
#pragma unroll
                for (int e = 0; e < 4; ++e) { o0[e] = x0[e] + g0[e] * a0[e]; o1[e] = x1[e] + g1[e] * a1[e]; }
                if (xmid) { u32x4 pk; pk.x = pk2(o0[0], o0[1]); pk.y = pk2(o0[2], o0[3]); pk.z = pk2(o1[0], o1[1]); pk.w = pk2(o1[2], o1[3]); *(u32x4*)(xmid + (size_t)t * DM + cc) = pk; pkq[i] = pk; }
                else { __builtin_nontemporal_store(o0, (f32x4*)(xout + (size_t)t * DM + cc)); __builtin_nontemporal_store(o1, (f32x4*)(xout + (size_t)t * DM + cc + 4)); }
            }
            if (xmid && hnext) {
                float vv[2][8]; float s = 0.f;
#pragma unroll
                for (int i = 0; i < 2; ++i) {
                    const unsigned q4[4] = {pkq[i].x, pkq[i].y, pkq[i].z, pkq[i].w};
#pragma unroll
                    for (int e = 0; e < 4; ++e) { vv[i][2 * e] = __uint_as_float(q4[e] << 16); vv[i][2 * e + 1] = __uint_as_float(q4[e] & 0xffff0000u); }
#pragma unroll
                    for (int e = 0; e < 8; ++e) s += vv[i][e] * vv[i][e];
                }
                s = DPP_ADD0(s, 0xB1); s = DPP_ADD0(s, 0x4E); s = DPP_ADD0(s, 0x124); s = DPP_ADD0(s, 0x128);
                { auto q = __builtin_amdgcn_permlane16_swap(__float_as_uint(s), __float_as_uint(s), false, false); s = __uint_as_float(q[0]) + __uint_as_float(q[1]); }
                { auto q = __builtin_amdgcn_permlane32_swap(__float_as_uint(s), __float_as_uint(s), false, false); s = __uint_as_float(q[0]) + __uint_as_float(q[1]); }
                const float rs = rsqrtf(s * (1.0f / DM) + EPS);
#pragma unroll
                for (int i = 0; i < 2; ++i) {
                    const int cc = i * 512 + lane * 8;
                    float y[8];
#pragma unroll
                    for (int hq = 0; hq < 2; ++hq)
#pragma unroll
                        for (int e = 0; e < 4; ++e) y[4 * hq + e] = vv[i][4 * hq + e] * rs * nA[i][hq][e] + nS[i][hq][e];
                    u32x4 o; o.x = pk2(y[0], y[1]); o.y = pk2(y[2], y[3]); o.z = pk2(y[4], y[5]); o.w = pk2(y[6], y[7]);
                    __builtin_nontemporal_store(o, (u32x4*)(hnext + (size_t)t * DM + cc));
                }
            }
        }
    }
}

#define XB_TMO      128
#define XB_XCNT(j)  (256  + 64 * (j))
#define XB_XSUB(j)  (1280 + 64 * (j))
#define XB_XGEN(j)  (2304 + 64 * (j))
#define XB_TOP      3328
#define XB_TOPGEN   3392
#define XCD_BAR_WORDS 3456
#define XB_SPIN_CAP (1u << 18)

__device__ __forceinline__ unsigned xb_ld(unsigned* p)              { return __hip_atomic_load(p, __ATOMIC_RELAXED, __HIP_MEMORY_SCOPE_AGENT); }
__device__ __forceinline__ unsigned xb_add(unsigned* p, unsigned v) { return __hip_atomic_fetch_add(p, v, __ATOMIC_RELAXED, __HIP_MEMORY_SCOPE_AGENT); }
__device__ __forceinline__ unsigned xb_xcc_id() { return (unsigned)__builtin_amdgcn_s_getreg((3 << 11) | 20) & 0xFu; }
#define XB_SPIN(cond, bar) do { unsigned _sp = 0; while (cond) { __builtin_amdgcn_s_sleep(1); \
    if ((++_sp & 255u) == 0u) { if (xb_ld(&(bar)[XB_TMO])) break; if (_sp > XB_SPIN_CAP) { atomicAdd(&(bar)[XB_TMO], 1u); break; } } } } while (0)

struct XcdBarrier {
    unsigned* bar; unsigned x;
    volatile LAS unsigned* st;
};

__device__ __forceinline__ XcdBarrier xcd_barrier_post(unsigned* bar, volatile LAS unsigned* st) {
    XcdBarrier b; b.bar = bar; b.x = xb_xcc_id(); b.st = st;
    if (threadIdx.x == 0) st[5] = xb_add(&bar[XB_XCNT(b.x)], 1u);
    return b;
}
__device__ __forceinline__ void xcd_barrier_complete(unsigned* bar, unsigned x, unsigned& nloc, unsigned& nx) {
    const unsigned G = gridDim.x * gridDim.y * gridDim.z;
    unsigned sum, cnt, mine, sp = 0u;
    for (;;) {
        sum = 0u; cnt = 0u; mine = 0u;
#pragma unroll
        for (unsigned j = 0; j < 16; ++j) { const unsigned c = xb_ld(&bar[XB_XCNT(j)]); sum += c; cnt += (c > 0u) ? 1u : 0u; mine = (j == x) ? c : mine; }
        if (sum == G) break;
        __builtin_amdgcn_s_sleep(1);
        if ((++sp & 255u) == 0u) { if (xb_ld(&bar[XB_TMO])) break; if (sp > XB_SPIN_CAP) { atomicAdd(&bar[XB_TMO], 1u); break; } }
    }
    nloc = mine > 0u ? mine : 1u; nx = cnt > 0u ? cnt : 1u;
}

__device__ __forceinline__ void xcd_barrier(const XcdBarrier& b) {
    asm volatile("s_waitcnt vmcnt(0)" ::: "memory");
    __syncthreads();
    if (threadIdx.x == 0) {
        unsigned* bar = b.bar;
        __builtin_amdgcn_s_waitcnt(0);
        unsigned nloc = b.st[0], nx = b.st[1];
        if (nloc == 0u) { xcd_barrier_complete(bar, b.x, nloc, nx); b.st[0] = nloc; b.st[1] = nx; }
        const unsigned old = xb_add(&bar[XB_XSUB(b.x)], 1u);
        const unsigned gen = old / nloc;
        if (old + 1u == (gen + 1u) * nloc) {
            __builtin_amdgcn_fence(__ATOMIC_RELEASE, "agent");
            asm volatile("s_waitcnt vmcnt(0)" ::: "memory");
            const unsigned og = xb_add(&bar[XB_TOP], 1u);
            const unsigned tg = og / nx;
            if (og + 1u == (tg + 1u) * nx) xb_add(&bar[XB_TOPGEN], 1u);
            else XB_SPIN(xb_ld(&bar[XB_TOPGEN]) == tg, bar);
            __builtin_amdgcn_fence(__ATOMIC_ACQUIRE, "agent");
            xb_add(&bar[XB_XGEN(b.x)], 1u);
            asm volatile("s_waitcnt vmcnt(0)" ::: "memory");
        } else {
            XB_SPIN(xb_ld(&bar[XB_XGEN(b.x)]) == gen, bar);
            __builtin_amdgcn_fence(__ATOMIC_ACQUIRE, "agent");
            asm volatile("s_waitcnt vmcnt(0)" ::: "memory");
        }
    }
    __syncthreads();
}


__device__ __forceinline__ void xcc_barrier(const XcdBarrier& b) {
    asm volatile("s_waitcnt vmcnt(0)" ::: "memory");
    __syncthreads();
    if (threadIdx.x == 0) {
        unsigned* bar = b.bar;
        __builtin_amdgcn_s_waitcnt(0);
        const unsigned nloc = b.st[0];
        const unsigned old = xb_add(&bar[XB_XSUB(b.x)], 1u);
        const unsigned gen = old / nloc;
        if (old + 1u == (gen + 1u) * nloc) xb_add(&bar[XB_XGEN(b.x)], 1u);
        else XB_SPIN(xb_ld(&bar[XB_XGEN(b.x)]) == gen, bar);
        __builtin_amdgcn_fence(__ATOMIC_ACQUIRE, "agent");
        asm volatile("s_waitcnt vmcnt(0)" ::: "memory");
    }
    __syncthreads();
}

#define XB_PACE(j) (3584 + 64 * (j))
__device__ __forceinline__ void xcd_pace(unsigned* bar, volatile LAS unsigned* st) {
    __syncthreads();
    if (threadIdx.x == 0) {
        const unsigned nloc = st[0] ? st[0] : 1u, x = xb_xcc_id(), gen = st[4] + 1u;
        st[4] = gen;
        xb_add(&bar[XB_PACE(x)], 1u);
        unsigned sp = 0;
        while (xb_ld(&bar[XB_PACE(x)]) < gen * nloc) { __builtin_amdgcn_s_sleep(1); if (++sp > (1u << 16)) break; }
    }
    __syncthreads();
}
extern __shared__ __attribute__((aligned(16))) unsigned char dyn_lds[];
#ifndef REP_PREP
#define REP_PREP 1
#endif
#ifndef REP_ATTN
#define REP_ATTN 1
#endif
#ifndef REP_SEL
#define REP_SEL 1
#endif
#ifndef REP_GATH
#define REP_GATH 1
#endif
#ifndef REP_GEMM
#define REP_GEMM 1
#endif
#ifndef REP_ADALN
#define REP_ADALN 1
#endif
constexpr int LDS_BYTES = 147456;

template <class T> __device__ __forceinline__ T* karg(int byte_off) {
    const __attribute__((address_space(4))) char* base = (const __attribute__((address_space(4))) char*)__builtin_amdgcn_kernarg_segment_ptr();
    unsigned long long v = *(const __attribute__((address_space(4))) unsigned long long*)(base + byte_off);
    asm volatile("" : "+s"(v));
    return (T*)(__attribute__((address_space(1))) T*)v;
}
#define KIN(i) karg<const float>(8 * (i))
#define KOUT() karg<float>(168)
#define KWS() karg<unsigned char>(176)
static_assert(sizeof(Params) == 184, "Params layout");
template <class T> __device__ __forceinline__ T* launder(T* p) { size_t off = 0; asm volatile("" : "+s"(off)); return (T*)((unsigned char*)p + off); }
__global__ void __launch_bounds__(NT) mega_fwd(Params p) {
    cg::grid_group grid = cg::this_grid();
    const int bid = blockIdx.x, nb = gridDim.x;
    volatile LAS unsigned* bst = (volatile LAS unsigned*)((LAS unsigned char*)dyn_lds + LDS_BYTES - 64);
    if (ltid() < 16) bst[ltid()] = 0u;
    __syncthreads();
    const XcdBarrier xbar = xcd_barrier_post((unsigned*)(KWS() + WS_BAR), bst);
    for (int rep = 0; rep < REP_PREP; ++rep) {
        unsigned char* ws = KWS();
        float* tile = (float*)dyn_lds;
        ph_transpose(KIN(6), (bf16*)(ws + WS_WIN0), 1024, AB_IN, true, tile, bid, nb);
        ph_transpose(KIN(11), (bf16*)(ws + WS_WIN1), 1024, CD_IN, true, tile, bid, nb);
        ph_transpose(KIN(7), (bf16*)(ws + WS_WO0), 1024, 1024, false, tile, bid, nb);
        ph_transpose(KIN(12), (bf16*)(ws + WS_WO1), 1024, 1024, false, tile, bid, nb);
        ph_transpose(KIN(17), (bf16*)(ws + WS_WQ), 1024, PQ, false, tile, bid, nb);
        ph_transpose(KIN(17) + (size_t)1024 * PQ, (bf16*)(ws + WS_WQ) + (size_t)PQ * 1024, 1024, PQ, false, tile, bid, nb);
        ws = launder(ws);
        ph_tab_uv(KIN(19), KIN(20), ws + WS_PU, (float*)(ws + WS_PV), (float*)(ws + WS_PV + 1 * MiB), 2 * NEXP, bid, nb);
        ws = launder(ws);
        ph_mod(KIN(1), KIN(2), KIN(3), (float*)(ws + WS_MOD), (float*)dyn_lds, bid, nb);
        ph_rope_table((float*)(ws + WS_ROPE), bid, nb);
        for (int i = bid * NT + ltid(); i < NB * 8 * 8 * 64; i += nb * NT) ((float*)(ws + WS_KMEAN))[i] = 0.f;
    }
    grid.sync();
    if (threadIdx.x == 0) {
        unsigned* bar = (unsigned*)(KWS() + WS_BAR);
        unsigned nloc, nx; xcd_barrier_complete(bar, xbar.x, nloc, nx); bst[0] = nloc; bst[1] = nx;
        bool ok = (nb == 256) && nx == 8u && xbar.x < 8u;
        for (unsigned j = 0; j < 8; ++j) ok = ok && (xb_ld(&bar[XB_XCNT(j)]) == 32u);
        bst[7] = ok ? 1u : 0u;
    }
    __syncthreads();
    const bool loc_sync = bst[7] != 0u;
    const int vbid = loc_sync ? (int)(bst[5] * 8u + xbar.x) : bid;
#define SEAM() do { if (loc_sync) xcc_barrier(xbar); else xcd_barrier(xbar); } while (0)
    const size_t vx_ = (size_t)(vbid & 7);
#define SL_H2(ws)   ((bf16*)((ws) + WS_QKV + vx_ * 48 * MiB) - vx_ * 8192 * DM)
#define SL_QRY(ws)  ((bf16*)((ws) + WS_QKV + vx_ * 48 * MiB + 16 * MiB) - vx_ * 8192 * PQ)
#define SL_EIDX(ws) ((int*)((ws) + WS_SEL + vx_ * 12 * MiB) - vx_ * 8192 * 128)
#define SL_EG(ws)   ((float*)((ws) + WS_SEL + vx_ * 12 * MiB + 4 * MiB) - vx_ * 8192 * 128)
#pragma unroll 1
    for (int layer = 0; layer < 2; ++layer) {
        for (int rep = 0; rep < REP_ADALN; ++rep) {
            unsigned char* ws = KWS(); const float* mod = (const float*)(ws + WS_MOD) + (size_t)layer * 32 * 6144;
            if (layer == 0) ph_adaln<false>(KIN(0), KIN(4), mod + 0, mod + 1024, (bf16*)(ws + WS_HY), vbid, nb);
        }
        if (layer == 0) SEAM();
        for (int rep = 0; rep < REP_GEMM; ++rep) {
            unsigned char* ws = KWS();
            pg8::Gemm g{(const bf16*)(ws + WS_HY), (const bf16*)(ws + (layer == 0 ? WS_WIN0 : WS_WIN1)), MT, layer == 0 ? AB_IN : CD_IN, DM};
            pg8::StaticOrder S; S.init(g.M, g.N, nb, vbid);
            pg8::EpiQKV e{(bf16*)(ws + WS_QKV), QKV_LD, (const float*)(ws + WS_ROPE), layer, layer == 0 ? KIN(9) : KIN(13), layer == 0 ? KIN(10) : KIN(14), KIN(15), KIN(16), (float*)(ws + WS_KMEAN)};
            pg8::gemm_phase<pg8::EpiQKV, pg8::StaticOrder, true, true>((LAS unsigned char*)dyn_lds, g, S, e);
        }
        SEAM();
        for (int rep = 0; rep < REP_ATTN; ++rep) {
            unsigned char* ws = KWS();
            if (layer == 0) ph_attn0((const bf16*)(ws + WS_QKV), KIN(8), (bf16*)(ws + WS_HY), (LAS unsigned char*)dyn_lds, vbid, nb);
            else ph_attn1((const bf16*)(ws + WS_QKV), (const float*)(ws + WS_KMEAN), (bf16*)(ws + WS_HY), (LAS unsigned char*)dyn_lds, vbid, nb);
        }
        SEAM();
        for (int rep = 0; rep < REP_GEMM; ++rep) {
            unsigned char* ws = KWS(); const float* mod = (const float*)(ws + WS_MOD) + (size_t)layer * 32 * 6144;
            pg8::Gemm g{(const bf16*)(ws + WS_HY), (const bf16*)(ws + (layer == 0 ? WS_WO0 : WS_WO1)), MT, DM, DM};
            pg8::StaticOrder S; S.init(g.M, g.N, nb, vbid);
            if (layer == 0) { pg8::EpiResid<false> e{KIN(0), (pg8::bf16_t*)(ws + WS_X1), mod + 2048}; pg8::gemm_phase<pg8::EpiResid<false>, pg8::StaticOrder, true, true>((LAS unsigned char*)dyn_lds, g, S, e); }
            else { pg8::EpiResid<true> e{ws + WS_X1 + 128 * MiB, (pg8::bf16_t*)(ws + WS_X1), mod + 2048}; pg8::gemm_phase<pg8::EpiResid<true>, pg8::StaticOrder, true, true>((LAS unsigned char*)dyn_lds, g, S, e); }
        }
        SEAM();
        for (int rep = 0; rep < REP_ADALN; ++rep) {
            unsigned char* ws = KWS(); const float* mod = (const float*)(ws + WS_MOD) + (size_t)layer * 32 * 6144;
            ph_adaln<true>(ws + WS_X1, KIN(5) + layer * DM, mod + 3072, mod + 4096, SL_H2(ws), vbid, nb);
        }
        SEAM();
        for (int rep = 0; rep < REP_GEMM; ++rep) {
            unsigned char* ws = KWS();
            pg8::Gemm g{(const bf16*)SL_H2(ws), (const bf16*)(ws + WS_WQ) + (size_t)layer * PQ * DM, MT, PQ, DM};
            pg8::StaticOrder S; S.init(g.M, g.N, nb, vbid); pg8::EpiStore e{SL_QRY(ws), PQ};
            pg8::gemm_phase<pg8::EpiStore, pg8::StaticOrder, true, true>((LAS unsigned char*)dyn_lds, g, S, e);
        }
        SEAM();
        for (int rep = 0; rep < REP_SEL; ++rep) {
            unsigned char* ws = KWS();
            ph_peer_select((const bf16*)SL_QRY(ws), KIN(18) + (size_t)layer * 2 * 128 * 128, SL_EIDX(ws), SL_EG(ws), (const float*)(ws + WS_PV) + layer * NEXP, (const float*)(ws + WS_PV + 1 * MiB) + layer * NEXP, (LAS unsigned char*)dyn_lds, vbid, nb);
        }
        SEAM();
        for (int rep = 0; rep < REP_GATH; ++rep) {
            unsigned char* ws = KWS(); const float* mod = (const float*)(ws + WS_MOD) + (size_t)layer * 32 * 6144;
            ph_peer_gather((const bf16*)SL_H2(ws), ws + WS_PU + (size_t)layer * NEXP * TROWX, ws + WS_PU + (size_t)layer * NEXP * TROWX,
                           (const float*)(ws + WS_PV) + layer * NEXP, (const float*)(ws + WS_PV + 1 * MiB) + layer * NEXP, (const int*)SL_EIDX(ws), (const float*)SL_EG(ws), (const bf16*)(ws + WS_X1), mod + 5120, KOUT(), (LAS unsigned char*)dyn_lds, (unsigned*)(ws + WS_BAR), bst, vbid, nb, layer == 0 ? (bf16*)(ws + WS_X1 + 128 * MiB) : (bf16*)nullptr,
                           layer == 0 ? (bf16*)(ws + WS_HY) : (bf16*)nullptr, KIN(4) + DM, mod + 32 * 6144 + 0, mod + 32 * 6144 + 1024);
        }
        if (layer == 0) SEAM();
    }
}

extern "C" void kernel_launch(void* const* d_in, const int* in_sizes, int n_in, void* d_out, int out_size, void* d_ws, size_t ws_size, hipStream_t stream) {
    if (n_in != 21 || ws_size < WS_END) { fprintf(stderr, "kernel_launch: bad args n_in=%d ws=%zu\n", n_in, ws_size); return; }
    static int grid_blocks = 0;
    if (!grid_blocks) {
        int dev = 0, cus = 0, per_cu = 0;
        (void)hipGetDevice(&dev);
        (void)hipDeviceGetAttribute(&cus, hipDeviceAttributeMultiprocessorCount, dev);
        (void)hipFuncSetAttribute((const void*)mega_fwd, hipFuncAttributeMaxDynamicSharedMemorySize, LDS_BYTES);
        (void)hipOccupancyMaxActiveBlocksPerMultiprocessor(&per_cu, (const void*)mega_fwd, NT, LDS_BYTES);
        if (per_cu < 1) { fprintf(stderr, "kernel_launch: occupancy query returned %d\n", per_cu); per_cu = 1; }
        if (per_cu > 1) per_cu = 1;
        grid_blocks = cus * per_cu;
    }
    Params p{};
    for (int i = 0; i < 21; ++i) p.in[i] = (const float*)d_in[i];
    p.out = (float*)d_out; p.ws = (unsigned char*)d_ws;
    (void)hipMemsetAsync((char*)d_ws + WS_BAR, 0, 16384, stream);
    void* args[] = {&p};
    if (grid_blocks != 256) { fprintf(stderr, "kernel_launch: this kernel's slice ownership needs exactly 256 workgroups (one per CU of a 256-CU device); got %d; nothing launched\n", grid_blocks); return; }
    hipError_t e = hipLaunchCooperativeKernel((const void*)mega_fwd, dim3(grid_blocks), dim3(NT), args, LDS_BYTES, stream);
    if (e != hipSuccess) fprintf(stderr, "cooperative launch failed: %s (grid %d)\n", hipGetErrorString(e), grid_blocks);
}
```
